# Optimizing an MI355X kernel written in HIP

```python
import math
import jax, jax.numpy as jnp
from jax import lax
import numpy as np

D_MODEL = 1024
BATCH = 8
SEQ = 2048
DEPTH = 1

GDN_HEADS = 4
GDN_HEAD_DIM = 128
GDN_WIDTH = GDN_HEADS * GDN_HEAD_DIM
GDN_CONV = 4
GDN_CHUNK = 64
DIL_HEADS = 8
DIL_HEAD_DIM = 64
DIL_WIDTH = DIL_HEADS * DIL_HEAD_DIM
DIL_PATTERNS = ((128, 1), (512, 4), (2048, 16))
BAND_BLOCK = 128
MIX_WIDTH = GDN_WIDTH + DIL_WIDTH
IN_COLS = 3 * GDN_WIDTH + GDN_WIDTH + 2 * GDN_HEADS + 3 * DIL_WIDTH
D_FF = 2816
FFN_CONV = 3
EPS = 1e-6

kernel_name = "hymba_gdn_dilated_convffn"


def rmsnorm(x, w):
    xf = x.astype(jnp.float32)
    y = xf * lax.rsqrt(jnp.mean(xf * xf, axis=-1, keepdims=True) + EPS)
    return (y * w.astype(jnp.float32)).astype(x.dtype)


def l2norm(x):
    return x * lax.rsqrt(jnp.sum(x * x, axis=-1, keepdims=True) + EPS)


def causal_dwconv(x, w):
    K = w.shape[0]
    S = x.shape[1]
    xp = jnp.pad(x, ((0, 0), (K - 1, 0), (0, 0)))
    out = xp[:, 0:S, :] * w[0]
    for i in range(1, K):
        out = out + xp[:, i:i + S, :] * w[i]
    return out


def gated_delta_rule(q, k, v, g, beta):
    B, S, H, Dk = q.shape
    Dv = v.shape[-1]
    C = GDN_CHUNK
    nc = S // C

    def chunk_vec(t):
        return t.reshape(B, nc, C, H, t.shape[-1]).transpose(1, 0, 3, 2, 4)

    def chunk_sc(t):
        return t.reshape(B, nc, C, H).transpose(1, 0, 3, 2)

    qc, kc, vc = chunk_vec(q), chunk_vec(k), chunk_vec(v)
    bc = chunk_sc(beta)
    gc = jnp.cumsum(chunk_sc(g), axis=-1)
    idx = jnp.arange(C)
    incl = idx[:, None] >= idx[None, :]
    strict = idx[:, None] > idx[None, :]
    diff = gc[..., :, None] - gc[..., None, :]
    dec_incl = jnp.where(incl, jnp.exp(jnp.where(incl, diff, 0.0)), 0.0)
    dec_strict = jnp.where(strict, dec_incl, 0.0)
    kk = jnp.einsum('nbhtd,nbhjd->nbhtj', kc, kc)
    lmat = dec_strict * kk * bc[..., None, :]
    gam = jnp.exp(gc)[..., None]
    rhs = jnp.concatenate([vc, gam * kc], axis=-1)
    sol = lax.linalg.triangular_solve(lmat, rhs, left_side=True, lower=True, unit_diagonal=True)
    u_v, w_k = sol[..., :Dv], sol[..., Dv:]
    attn = dec_incl * jnp.einsum('nbhtd,nbhjd->nbhtj', qc, kc) * bc[..., None, :]
    q_dec = gam * qc
    k_end = kc * (jnp.exp(gc[..., -1:] - gc) * bc)[..., None]
    g_end = jnp.exp(gc[..., -1])

    def step(state, xs):
        uv, wk, qd, at, ke, ge = xs
        u = uv - jnp.einsum('bhck,bhkv->bhcv', wk, state)
        o = jnp.einsum('bhck,bhkv->bhcv', qd, state) + jnp.einsum('bhcj,bhjv->bhcv', at, u)
        state = ge[..., None, None] * state + jnp.einsum('bhck,bhcv->bhkv', ke, u)
        return state, o

    s0 = jnp.zeros((B, H, Dk, Dv), jnp.float32)
    _, o = lax.scan(step, s0, (u_v, w_k, q_dec, attn, k_end, g_end))
    return o.transpose(1, 0, 3, 2, 4).reshape(B, S, H, Dv)


def band_attention(q, k, v, n_back):
    L, Dh = q.shape[-2], q.shape[-1]
    nb = -(-L // BAND_BLOCK)
    pad = nb * BAND_BLOCK - L
    padcfg = [(0, 0)] * (q.ndim - 2) + [(0, pad), (0, 0)]
    lead = q.shape[:-2]

    def blocks(t):
        return jnp.pad(t, padcfg).reshape(*lead, nb, BAND_BLOCK, Dh)

    qb, kb, vb = blocks(q), blocks(k), blocks(v)

    def with_prev(t):
        prev = jnp.concatenate([jnp.zeros_like(t[..., :1, :, :]), t[..., :-1, :, :]], axis=-3)
        return jnp.concatenate([prev, t], axis=-2)

    kk, vv = with_prev(kb), with_prev(vb)
    s = jnp.einsum('...nqd,...nkd->...nqk', qb, kk)
    blk = jnp.arange(nb)[:, None, None] * BAND_BLOCK
    qpos = blk + jnp.arange(BAND_BLOCK)[None, :, None]
    kpos = blk - BAND_BLOCK + jnp.arange(2 * BAND_BLOCK)[None, None, :]
    dist = qpos - kpos
    valid = (dist >= 0) & (dist <= n_back) & (kpos >= 0)
    s = jnp.where(valid, s, -jnp.inf)
    m = jnp.max(s, axis=-1)
    p = jnp.exp(s - m[..., None])
    den = jnp.sum(p, axis=-1)
    num = jnp.einsum('...nqk,...nkd->...nqd', p, vv)
    num = num.reshape(*lead, nb * BAND_BLOCK, Dh)[..., :L, :]
    den = den.reshape(*lead, nb * BAND_BLOCK)[..., :L]
    m = m.reshape(*lead, nb * BAND_BLOCK)[..., :L]
    return num, den, m


def dilated_attention(q, k, v):
    B, S, H, Dh = q.shape
    qf = q.astype(jnp.float32).transpose(0, 2, 1, 3) * (Dh ** -0.5)
    kf = k.astype(jnp.float32).transpose(0, 2, 1, 3)
    vf = v.astype(jnp.float32).transpose(0, 2, 1, 3)
    nums, dens, ms = [], [], []
    for window, dil in DIL_PATTERNS:
        L = S // dil

        def stride(t):
            return t.reshape(B, H, L, dil, Dh).transpose(0, 1, 3, 2, 4)

        num, den, m = band_attention(stride(qf), stride(kf), stride(vf), window // dil)
        nums.append(num.transpose(0, 1, 3, 2, 4).reshape(B, H, S, Dh))
        dens.append(den.transpose(0, 1, 3, 2).reshape(B, H, S))
        ms.append(m.transpose(0, 1, 3, 2).reshape(B, H, S))
    m_all = jnp.maximum(jnp.maximum(ms[0], ms[1]), ms[2])
    wts = [jnp.exp(mi - m_all) for mi in ms]
    num_tot = wts[0][..., None] * nums[0] + wts[1][..., None] * nums[1] + wts[2][..., None] * nums[2]
    den_tot = wts[0] * dens[0] + wts[1] * dens[1] + wts[2] * dens[2]
    out = num_tot / den_tot[..., None]
    return out.transpose(0, 2, 1, 3).reshape(B, S, H * Dh)


def hybrid_layer(x, norm1_w, w_in, conv_qkv_w, a_log, dt_bias, gdn_norm_w, w_out,
                 norm2_w, w_up, ffn_conv_w, w_down):
    B, S, _ = x.shape
    h = rmsnorm(x, norm1_w)
    proj = h @ w_in
    o1 = 3 * GDN_WIDTH
    o2 = o1 + GDN_WIDTH
    o3 = o2 + GDN_HEADS
    o4 = o3 + GDN_HEADS
    qkv_a, z_a, b_a, a_a, qkv_b = (proj[..., :o1], proj[..., o1:o2], proj[..., o2:o3],
                                   proj[..., o3:o4], proj[..., o4:])
    qkv_a = jax.nn.silu(causal_dwconv(qkv_a, conv_qkv_w)).astype(jnp.float32)
    qa = qkv_a[..., :GDN_WIDTH].reshape(B, S, GDN_HEADS, GDN_HEAD_DIM)
    ka = qkv_a[..., GDN_WIDTH:2 * GDN_WIDTH].reshape(B, S, GDN_HEADS, GDN_HEAD_DIM)
    va = qkv_a[..., 2 * GDN_WIDTH:].reshape(B, S, GDN_HEADS, GDN_HEAD_DIM)
    qa = l2norm(qa) * (GDN_HEAD_DIM ** -0.5)
    ka = l2norm(ka)
    beta = jax.nn.sigmoid(b_a.astype(jnp.float32))
    g = -jnp.exp(a_log.astype(jnp.float32)) * jax.nn.softplus(
        a_a.astype(jnp.float32) + dt_bias.astype(jnp.float32))
    o_a = gated_delta_rule(qa, ka, va, g, beta)
    z = z_a.astype(jnp.float32).reshape(B, S, GDN_HEADS, GDN_HEAD_DIM)
    o_a = (rmsnorm(o_a, gdn_norm_w) * jax.nn.silu(z)).reshape(B, S, GDN_WIDTH).astype(x.dtype)
    qb = qkv_b[..., :DIL_WIDTH].reshape(B, S, DIL_HEADS, DIL_HEAD_DIM)
    kb = qkv_b[..., DIL_WIDTH:2 * DIL_WIDTH].reshape(B, S, DIL_HEADS, DIL_HEAD_DIM)
    vb = qkv_b[..., 2 * DIL_WIDTH:].reshape(B, S, DIL_HEADS, DIL_HEAD_DIM)
    o_b = dilated_attention(qb, kb, vb).astype(x.dtype)
    x = x + jnp.concatenate([o_a, o_b], axis=-1) @ w_out
    h = rmsnorm(x, norm2_w)
    u = causal_dwconv(h @ w_up, ffn_conv_w)
    gate, up = u[..., :D_FF], u[..., D_FF:]
    x = x + (jax.nn.silu(gate) * up) @ w_down
    return x


def setup_inputs(seed: int = 0) -> dict:
    key = jax.random.key(seed)
    ks = jax.random.split(key, 14)
    f32 = jnp.float32
    x = jax.random.normal(ks[0], (BATCH, SEQ, D_MODEL), f32)
    norm1_w = 1.0 + 0.02 * jax.random.normal(ks[1], (DEPTH, D_MODEL), f32)
    w_in = jax.random.normal(ks[2], (DEPTH, D_MODEL, IN_COLS), f32) * D_MODEL ** -0.5
    conv_qkv_w = jax.random.normal(ks[3], (DEPTH, GDN_CONV, 3 * GDN_WIDTH), f32) * GDN_CONV ** -0.5
    a_log = jnp.log(jax.random.uniform(ks[4], (DEPTH, GDN_HEADS), f32, 1.0, 16.0))
    dt = jnp.exp(jax.random.uniform(ks[5], (DEPTH, GDN_HEADS), f32, math.log(1e-3), math.log(1e-1)))
    dt_bias = dt + jnp.log(-jnp.expm1(-dt))
    gdn_norm_w = 1.0 + 0.02 * jax.random.normal(ks[6], (DEPTH, GDN_HEAD_DIM), f32)
    w_out = jax.random.normal(ks[7], (DEPTH, MIX_WIDTH, D_MODEL), f32) * MIX_WIDTH ** -0.5
    norm2_w = 1.0 + 0.02 * jax.random.normal(ks[8], (DEPTH, D_MODEL), f32)
    w_up = jax.random.normal(ks[9], (DEPTH, D_MODEL, 2 * D_FF), f32) * D_MODEL ** -0.5
    ffn_conv_w = jax.random.normal(ks[10], (DEPTH, FFN_CONV, 2 * D_FF), f32) * FFN_CONV ** -0.5
    w_down = jax.random.normal(ks[11], (DEPTH, D_FF, D_MODEL), f32) * D_FF ** -0.5
    final_norm_w = 1.0 + 0.02 * jax.random.normal(ks[12], (D_MODEL,), f32)
    return {"x": x, "norm1_w": norm1_w, "w_in": w_in, "conv_qkv_w": conv_qkv_w,
            "a_log": a_log, "dt_bias": dt_bias, "gdn_norm_w": gdn_norm_w, "w_out": w_out,
            "norm2_w": norm2_w, "w_up": w_up, "ffn_conv_w": ffn_conv_w, "w_down": w_down,
            "final_norm_w": final_norm_w}


def reference(x, norm1_w, w_in, conv_qkv_w, a_log, dt_bias, gdn_norm_w, w_out,
              norm2_w, w_up, ffn_conv_w, w_down, final_norm_w):
    for l in range(DEPTH):
        x = hybrid_layer(x, norm1_w[l], w_in[l], conv_qkv_w[l], a_log[l], dt_bias[l],
                         gdn_norm_w[l], w_out[l], norm2_w[l], w_up[l], ffn_conv_w[l], w_down[l])
    return rmsnorm(x, final_norm_w)
```

```cpp
#include <hip/hip_runtime.h>
#include <hip/hip_cooperative_groups.h>
#include <cstdio>
#include <cstdint>
namespace cg = cooperative_groups;
namespace pg8 {
#define PG8_LAS __attribute__((address_space(3)))
typedef unsigned short bf16_t;
typedef short bf16x8 __attribute__((ext_vector_type(8)));
typedef float f32x4 __attribute__((ext_vector_type(4)));
typedef unsigned u32x4 __attribute__((ext_vector_type(4)));
constexpr int BM = 256, BK = 64, HALF = 128, HTB = HALF * BK * 2  , STAGE_BYTES = 8 * HTB, NXCD = 8, WGM = 8;

__host__ __device__ __forceinline__ int lds_byte(int r, int c) { const int st = (r >> 4) * 2 + (c >> 5), rr = r & 15, cc = c & 31, ob = rr * 64 + cc * 2; return st * 1024 + (ob ^ (((ob >> 9) & 1) << 5)); }
__host__ __device__ __forceinline__ void stage_rc(int b, int& R, int& C) { const int st = b / 1024, sb = b % 1024, swz = sb ^ (((sb >> 9) & 1) << 5); R = (st >> 1) * 16 + swz / 64; C = (st & 1) * 32 + (swz % 64) / 2; }
__host__ __device__ __forceinline__ int perm32(int rho) { const int n = rho >> 4, i = rho & 15; return 8 * (i >> 2) + 4 * n + (i & 3); }

struct Unit { int pm, pn; };
struct Gemm { const bf16_t* A; const bf16_t* Bt; int M, N, K; };

struct StaticOrder {
    int nM, nN, nwg, G, c;
    __host__ __device__ void init(int M, int N, int G_, int c_) { nM = M / BM; nN = N / BM; nwg = nM * nN; G = G_; c = c_; }
    __host__ __device__ bool next(int i, Unit& u) const {
        const long L = (long)i * G + c; if (L >= nwg) return false;
        int wgid = (int)L; { const int q = nwg / NXCD, r = nwg % NXCD, xcd = wgid % NXCD, off = wgid / NXCD; wgid = (xcd < r ? xcd * (q + 1) : r * (q + 1) + (xcd - r) * q) + off; }
        const int nig = WGM * nN, gid = wgid / nig, fm = gid * WGM, gsz = (nM - fm) < WGM ? (nM - fm) : WGM;
        u.pm = fm + ((wgid % nig) % gsz); u.pn = (wgid % nig) / gsz; return true;
    }
    __device__ __forceinline__ void a_ready(const Unit&) const {}
    __device__ __forceinline__ void done(const Unit&) const {}
};

__device__ __forceinline__ unsigned cvt_pk_bf16(float lo, float hi) { unsigned r; asm volatile("v_cvt_pk_bf16_f32 %0, %1, %2" : "=v"(r) : "v"(lo), "v"(hi)); return r; }
constexpr float RMS_EPS = 1e-6f;
struct EpiBf16S {
    static constexpr bool PERM = true, AFTER_DRAIN = false;
    bf16_t* O; int ldc; const float* ssq;
    __device__ __forceinline__ void operator()(const f32x4 (&acc)[2][2][4][2], const Unit& u, int wr, int wc, int fr, int fq) const {
        const int row0 = u.pm * BM + wr * 64 + fr; const int col0 = u.pn * BM + wc * 32 + 8 * fq;
#pragma unroll
        for (int ai = 0; ai < 2; ++ai)
#pragma unroll
            for (int m = 0; m < 4; ++m) { const int row = row0 + ai * HALF + m * 16; bf16_t* rowp = O + (size_t)row * ldc + col0;
                const float sc = ssq ? rsqrtf(ssq[row] * (1.0f / 1024.0f) + RMS_EPS) : 1.0f;
#pragma unroll
                for (int bj = 0; bj < 2; ++bj) { const f32x4 v0 = acc[ai][bj][m][0] * sc, v1 = acc[ai][bj][m][1] * sc;
                    u32x4 w; w.x = cvt_pk_bf16(v0[0], v0[1]); w.y = cvt_pk_bf16(v0[2], v0[3]); w.z = cvt_pk_bf16(v1[0], v1[1]); w.w = cvt_pk_bf16(v1[2], v1[3]);
                    *(u32x4*)(rowp + bj * HALF) = w; } }
    }
};
struct EpiResid {
    static constexpr bool PERM = false, AFTER_DRAIN = false;
    const float* base; float* out; bf16_t* xb; float* ssq; int ldc;
    __device__ __forceinline__ void operator()(const f32x4 (&acc)[2][2][4][2], const Unit& u, int wr, int wc, int fr, int fq) const {
        typedef unsigned u32x2v __attribute__((ext_vector_type(2)));
        const int col0 = u.pn * BM + wc * 32 + 4 * fq;
#pragma unroll
        for (int ai = 0; ai < 2; ++ai)
#pragma unroll
            for (int m = 0; m < 4; ++m) { const int row = u.pm * BM + ai * HALF + wr * 64 + m * 16 + fr; const size_t off = (size_t)row * ldc + col0; float s = 0.f;
#pragma unroll
                for (int bj = 0; bj < 2; ++bj)
#pragma unroll
                    for (int n = 0; n < 2; ++n) { const f32x4 v = acc[ai][bj][m][n] + *(const f32x4*)(base + off + bj * HALF + n * 16);
                        *(f32x4*)(out + off + bj * HALF + n * 16) = v; s += (v[0] * v[0] + v[1] * v[1]) + (v[2] * v[2] + v[3] * v[3]);
                        if (xb) { u32x2v w; w.x = cvt_pk_bf16(v[0], v[1]); w.y = cvt_pk_bf16(v[2], v[3]); *(u32x2v*)(xb + off + bj * HALF + n * 16) = w; } }
                if (ssq) { s += __shfl_xor(s, 16); s += __shfl_xor(s, 32); if (fq == 0) atomicAdd(ssq + row, s); }
                asm volatile("" ::: "memory"); }
    }
};
template <class Epi, class Sched, bool ALIGN_EPI = false, bool SP2 = false>
__device__ __forceinline__ void gemm_phase(PG8_LAS unsigned char* lds, const Gemm g, const Sched& S, const Epi& E) {
    const int tid = threadIdx.x, wid = __builtin_amdgcn_readfirstlane(tid >> 6), lane = tid & 63, wr = wid >> 2, wc = wid & 3, fr = lane & 15, fq = lane >> 4;
    const int K = g.K, nt = K / BK;
    unsigned voffA[2], voffB[2];
#pragma unroll
    for (int i = 0; i < 2; ++i) { int R, C; stage_rc(tid * 16 + i * 8192, R, C); const int Rb = Epi::PERM ? ((R & ~31) + perm32(R & 31)) : R;
        voffA[i] = (unsigned)(R * K + C) * 2u; voffB[i] = (unsigned)(Rb * K + C) * 2u; }
    const size_t kstep = (size_t)(BK * 2);
    const size_t hstep = (size_t)HALF * K * 2;
    const size_t tstep = 2 * hstep;
    const unsigned ldsw = (unsigned)wid * 1024u;
    const int aoff = lds_byte(wr * 64 + fr, fq * 8), boff = lds_byte(wc * 32 + fr, fq * 8);
#define PG8_SA(b, h) (((b) * 2 + (h)) * HTB)
#define PG8_SB(b, h) ((4 + (b) * 2 + (h)) * HTB)
#define PG8_STAGE(bufoff, gbase, voff) do { _Pragma("unroll") for (int _i = 0; _i < 2; ++_i) \
        __builtin_amdgcn_global_load_lds((const unsigned*)((const char*)(gbase) + (voff)[_i]), (PG8_LAS unsigned*)(lds + (bufoff) + ldsw + _i * 8192), 16, 0, 0); } while (0)
#define PG8_LDA(dst, b, h) do { _Pragma("unroll") for (int m = 0; m < 4; ++m) _Pragma("unroll") for (int k = 0; k < 2; ++k) dst[m][k] = *(const PG8_LAS bf16x8*)(lds + PG8_SA(b, h) + aoff + m * 2048 + k * 1024); } while (0)
#define PG8_LDB(dst, b, h) do { _Pragma("unroll") for (int n = 0; n < 2; ++n) _Pragma("unroll") for (int k = 0; k < 2; ++k) dst[n][k] = *(const PG8_LAS bf16x8*)(lds + PG8_SB(b, h) + boff + n * 2048 + k * 1024); } while (0)
#define PG8_MMA(ai, bj, At, Bt) do { __builtin_amdgcn_s_setprio(1); _Pragma("unroll") for (int m = 0; m < 4; ++m) _Pragma("unroll") for (int n = 0; n < 2; ++n) _Pragma("unroll") for (int k = 0; k < 2; ++k) \
        acc[ai][bj][m][n] = __builtin_amdgcn_mfma_f32_16x16x32_bf16(Bt[n][k], At[m][k], acc[ai][bj][m][n], 0, 0, 0); __builtin_amdgcn_s_setprio(0); } while (0)
#define PG8_WAIT_V(n) asm volatile("s_waitcnt vmcnt(" #n ")" ::: "memory")
#define PG8_WAIT_L(n) asm volatile("s_waitcnt lgkmcnt(" #n ")" ::: "memory")
#define PG8_BAR __builtin_amdgcn_s_barrier()
#define PG8_SCHED __builtin_amdgcn_sched_barrier(0)
    Unit cur, nxt; int ui = 0;
    if (!S.next(0, cur)) return;
    f32x4 acc[2][2][4][2];
#pragma unroll
    for (int a = 0; a < 2; ++a)
#pragma unroll
        for (int b = 0; b < 2; ++b)
#pragma unroll
            for (int m = 0; m < 4; ++m)
#pragma unroll
                for (int n = 0; n < 2; ++n) acc[a][b][m][n] = (f32x4){0.f, 0.f, 0.f, 0.f};
    bf16x8 At[4][2], B0[2][2], B1[2][2];
    const char* cA = (const char*)g.A + (size_t)cur.pm * tstep; const char* cB = (const char*)g.Bt + (size_t)cur.pn * tstep;
    S.a_ready(cur);
    if constexpr (SP2) {
        PG8_STAGE(PG8_SB(0, 0), cB, voffB); PG8_STAGE(PG8_SB(0, 1), cB + hstep, voffB); PG8_STAGE(PG8_SA(0, 0), cA, voffA); PG8_STAGE(PG8_SA(0, 1), cA + hstep, voffA);
        if (wr == 1) PG8_BAR;
        PG8_WAIT_V(2); PG8_BAR;
        PG8_STAGE(PG8_SB(1, 0), cB + kstep, voffB); PG8_STAGE(PG8_SA(1, 0), cA + kstep, voffA); PG8_STAGE(PG8_SB(1, 1), cB + hstep + kstep, voffB);
        PG8_WAIT_V(6); PG8_BAR;
    } else {
        PG8_STAGE(PG8_SB(0, 0), cB, voffB); PG8_STAGE(PG8_SA(0, 0), cA, voffA); PG8_STAGE(PG8_SB(0, 1), cB + hstep, voffB); PG8_STAGE(PG8_SA(0, 1), cA + hstep, voffA);
        if (wr == 1) PG8_BAR;
        PG8_WAIT_V(4); PG8_BAR;
        PG8_STAGE(PG8_SB(1, 0), cB + kstep, voffB); PG8_STAGE(PG8_SA(1, 0), cA + kstep, voffA); PG8_STAGE(PG8_SB(1, 1), cB + hstep + kstep, voffB);
        PG8_WAIT_V(6); PG8_BAR;
    }
    for (;;) {
        const bool has_next = S.next(ui + 1, nxt);
        const char* nA = has_next ? (const char*)g.A + (size_t)nxt.pm * tstep : cA; const char* nB = has_next ? (const char*)g.Bt + (size_t)nxt.pn * tstep : cB;
        for (int t = 0; t < nt; t += 2) {
            const bool last = (t == nt - 2);
            const char* a1 = cA + (size_t)(t + 1) * kstep;
            const char* a2 = last ? nA : cA + (size_t)(t + 2) * kstep; const char* b2 = last ? nB : cB + (size_t)(t + 2) * kstep;
            const char* a3 = a2 + kstep; const char* b3 = b2 + kstep;
            if (last && has_next) S.a_ready(nxt);
            if constexpr (SP2) {
            PG8_LDB(B0, 0, 0); PG8_LDB(B1, 0, 1); PG8_SCHED; PG8_LDA(At, 0, 0); PG8_STAGE(PG8_SA(1, 1), a1 + hstep, voffA);
            PG8_WAIT_V(8); PG8_WAIT_L(0); PG8_BAR; PG8_MMA(0, 0, At, B0); PG8_MMA(0, 1, At, B1); PG8_BAR; PG8_SCHED;
            PG8_LDA(At, 0, 1); PG8_STAGE(PG8_SB(0, 0), b2, voffB); PG8_STAGE(PG8_SB(0, 1), b2 + hstep, voffB); PG8_STAGE(PG8_SA(0, 0), a2, voffA);
            PG8_WAIT_V(8); PG8_WAIT_L(0); PG8_BAR; PG8_MMA(1, 0, At, B0); PG8_MMA(1, 1, At, B1); PG8_BAR; PG8_SCHED;
            PG8_LDB(B0, 1, 0); PG8_LDB(B1, 1, 1); PG8_SCHED; PG8_LDA(At, 1, 0); PG8_STAGE(PG8_SA(0, 1), a2 + hstep, voffA);
            PG8_WAIT_V(8); PG8_WAIT_L(0); PG8_BAR; PG8_MMA(0, 0, At, B0); PG8_MMA(0, 1, At, B1); PG8_BAR; PG8_SCHED;
            PG8_LDA(At, 1, 1); PG8_STAGE(PG8_SB(1, 0), b3, voffB); PG8_STAGE(PG8_SB(1, 1), b3 + hstep, voffB); PG8_STAGE(PG8_SA(1, 0), a3, voffA);
            PG8_WAIT_V(8); PG8_WAIT_L(0); PG8_BAR; PG8_MMA(1, 0, At, B0); PG8_MMA(1, 1, At, B1); PG8_BAR; PG8_SCHED;
            } else {
            PG8_LDB(B0, 0, 0); PG8_SCHED; PG8_LDA(At, 0, 0); PG8_STAGE(PG8_SA(1, 1), a1 + hstep, voffA);
            PG8_WAIT_L(8); PG8_BAR; PG8_WAIT_L(0); PG8_MMA(0, 0, At, B0); PG8_BAR; PG8_SCHED;
            PG8_LDB(B1, 0, 1); PG8_STAGE(PG8_SB(0, 0), b2, voffB);
            PG8_BAR; PG8_WAIT_L(0); PG8_MMA(0, 1, At, B1); PG8_BAR;
            PG8_LDA(At, 0, 1); PG8_STAGE(PG8_SA(0, 0), a2, voffA);
            PG8_BAR; PG8_WAIT_L(0); PG8_MMA(1, 0, At, B0); PG8_BAR; PG8_SCHED;
            PG8_STAGE(PG8_SB(0, 1), b2 + hstep, voffB);
            PG8_WAIT_V(6); PG8_BAR; PG8_MMA(1, 1, At, B1); PG8_BAR;
            PG8_LDB(B0, 1, 0); PG8_SCHED; PG8_LDA(At, 1, 0); PG8_STAGE(PG8_SA(0, 1), a2 + hstep, voffA);
            PG8_WAIT_L(8); PG8_BAR; PG8_WAIT_L(0); PG8_MMA(0, 0, At, B0); PG8_BAR; PG8_SCHED;
            PG8_LDB(B1, 1, 1); PG8_STAGE(PG8_SB(1, 0), b3, voffB);
            PG8_BAR; PG8_WAIT_L(0); PG8_MMA(0, 1, At, B1); PG8_BAR;
            PG8_LDA(At, 1, 1); PG8_STAGE(PG8_SA(1, 0), a3, voffA);
            PG8_BAR; PG8_WAIT_L(0); PG8_MMA(1, 0, At, B0); PG8_BAR; PG8_SCHED;
            PG8_STAGE(PG8_SB(1, 1), b3 + hstep, voffB);
            PG8_WAIT_V(6); PG8_BAR; PG8_MMA(1, 1, At, B1); PG8_BAR;
            }
        }
        if constexpr (ALIGN_EPI) { if (wr == 0) PG8_BAR; }
        if constexpr (!Epi::AFTER_DRAIN) { E(acc, cur, wr, wc, fr, fq); S.done(cur); }
        if (!has_next) break;
#pragma unroll
        for (int a = 0; a < 2; ++a)
#pragma unroll
            for (int b = 0; b < 2; ++b)
#pragma unroll
                for (int m = 0; m < 4; ++m)
#pragma unroll
                    for (int n = 0; n < 2; ++n) acc[a][b][m][n] = (f32x4){0.f, 0.f, 0.f, 0.f};
        cur = nxt; cA = nA; cB = nB; ++ui;
        if constexpr (ALIGN_EPI) { if (wr == 1) PG8_BAR; }
    }
    PG8_WAIT_V(0);
    if constexpr (!ALIGN_EPI) { if (wr == 0) PG8_BAR; }
    PG8_BAR;
    if constexpr (Epi::AFTER_DRAIN) { E.fused(acc, cur, wr, wc, fr, fq, lds, wid, lane); S.done(cur); }
#undef PG8_SA
#undef PG8_SB
#undef PG8_STAGE
#undef PG8_LDA
#undef PG8_LDB
#undef PG8_MMA
#undef PG8_WAIT_V
#undef PG8_WAIT_L
#undef PG8_BAR
#undef PG8_SCHED
}
}
#ifndef PG8_SP2
#define PG8_SP2 true
#endif
#ifndef PG8_ALIGN
#define PG8_ALIGN true
#endif
constexpr int NB = 8, SEQ = 2048, DM = 1024, M = NB * SEQ;
constexpr int GH = 4, GD = 128, GW = 512, AH = 8, AD = 64;
constexpr int INC = 3592, NP = 3584;
constexpr int DFF = 2816, NUP = 2 * DFF;
constexpr int PC_QA = 0, PC_KA = 512, PC_VA = 1024, PC_Z = 1536, PC_QB = 2048, PC_KB = 2560, PC_VB = 3072;
constexpr size_t MiB = 1u << 20;
constexpr size_t WS_CTL = 0, WS_AB = 1 * MiB, WS_SSQ = 1 * MiB + 768 * 1024, WS_WIN = 2 * MiB, WS_WOUT = 9 * MiB, WS_WUP = 11 * MiB, WS_WDN = 22 * MiB;
constexpr size_t WS_XN = 28 * MiB, WS_PROJ = 60 * MiB, WS_CAT = 172 * MiB, WS_OA = 204 * MiB, WS_Y = 60 * MiB, WS_ACT = 148 * MiB, WS_END = 256 * MiB;
using pg8::RMS_EPS;
constexpr int NWAVES = 8, NTHR = 512;
constexpr int LDS_BYTES = 147456;
#define LAS __attribute__((address_space(3)))
typedef unsigned short bf16;
typedef unsigned v4u __attribute__((ext_vector_type(4)));
typedef unsigned v2u __attribute__((ext_vector_type(2)));
typedef float f32x4 __attribute__((ext_vector_type(4)));
__device__ __forceinline__ float bf2f(unsigned b) { return __uint_as_float(b << 16); }
__device__ __forceinline__ float bflo(unsigned w) { return __uint_as_float(w << 16); }
__device__ __forceinline__ float bfhi(unsigned w) { return __uint_as_float(w & 0xffff0000u); }
__device__ __forceinline__ unsigned pk2(float lo, float hi) { return pg8::cvt_pk_bf16(lo, hi); }
__device__ __forceinline__ float wave_sum(float v) {
#pragma unroll
    for (int o = 1; o < 64; o <<= 1) v += __shfl_xor(v, o);
    return v;
}
__device__ __forceinline__ float silu_f(float x) { return x / (1.0f + __expf(-x)); }
__device__ __forceinline__ float sigmoid_f(float x) { return 1.0f / (1.0f + __expf(-x)); }
__device__ __forceinline__ float softplus_f(float x) { return x > 20.f ? x : log1pf(__expf(x)); }

struct Args { const float* in[13]; float* out; unsigned char* ws; int ph_lo, ph_hi, coop, pad; };

__device__ __forceinline__ void p0_transpose_item(const float* W, int ldw, int k0, int sn0, bf16* WT, int K, int dn0, const float* kscale, LAS float* scr, int lane) {
#pragma unroll 8
    for (int i = 0; i < 32; ++i) { const int kk = 2 * i + (lane >> 5); float v = W[(size_t)(k0 + kk) * ldw + sn0 + (lane & 31)]; if (kscale) v *= kscale[k0 + kk]; scr[kk * 33 + (lane & 31)] = v; }
    asm volatile("s_waitcnt lgkmcnt(0)" ::: "memory");
    const int c = lane & 7;
#pragma unroll
    for (int j = 0; j < 4; ++j) { const int n = (lane >> 3) + 8 * j; const LAS float* s = scr + (8 * c) * 33 + n;
        v4u o; o.x = pk2(s[0 * 33], s[1 * 33]); o.y = pk2(s[2 * 33], s[3 * 33]); o.z = pk2(s[4 * 33], s[5 * 33]); o.w = pk2(s[6 * 33], s[7 * 33]);
        *(v4u*)(WT + (size_t)(dn0 + n) * K + k0 + 8 * c) = o; }
    asm volatile("s_waitcnt lgkmcnt(0)" ::: "memory");
}

__device__ __forceinline__ void p0_prologue(const Args& A, LAS unsigned char* lds, int tid, int lane, int wave) {
    const float* x = A.in[0]; const float* nw1 = A.in[1]; const float* w_in = A.in[2]; const float* w_out = A.in[7]; const float* nw2 = A.in[8];
    const float* w_up = A.in[9]; const float* w_dn = A.in[11];
    unsigned char* ws = A.ws;
    bf16* WIN = (bf16*)(ws + WS_WIN); bf16* WOUT = (bf16*)(ws + WS_WOUT); bf16* WUP = (bf16*)(ws + WS_WUP); bf16* WDN = (bf16*)(ws + WS_WDN);
    bf16* XN = (bf16*)(ws + WS_XN); float* AB = (float*)(ws + WS_AB); float* SSQ = (float*)(ws + WS_SSQ);
    LAS float* scr = (LAS float*)(lds + wave * 9216);
    LAS float* wab = (LAS float*)(lds + 73728);
    const int G = gridDim.x, gw = blockIdx.x * NWAVES + wave, NGW = G * NWAVES;
    for (int i = blockIdx.x * NTHR + tid; i < M; i += G * NTHR) SSQ[i] = 0.f;
    for (int idx = tid; idx < 8192; idx += NTHR) { const int k = idx >> 3, j = idx & 7; wab[j * 1024 + k] = nw1[k] * w_in[(size_t)k * INC + 2048 + j]; }
    constexpr int I_IN = 16 * (NP / 32), I_OUT = 16 * 32, I_UP = 16 * (NUP / 32), I_DN = (DFF / 64) * 32;
    constexpr int NITEMS = I_IN + I_OUT + I_UP + I_DN;
    for (int it = gw; it < NITEMS; it += NGW) {
        int r = it;
        if (r < I_IN) { const int nblk = NP / 32, kb = r / nblk, nb = r % nblk, n0 = 32 * nb; p0_transpose_item(w_in, INC, 64 * kb, n0 + (n0 >= 2048 ? 8 : 0), WIN, DM, n0, nullptr, scr, lane); continue; } r -= I_IN;
        if (r < I_OUT) { const int kb = r / 32, nb = r % 32; p0_transpose_item(w_out, DM, 64 * kb, 32 * nb, WOUT, DM, 32 * nb, nullptr, scr, lane); continue; } r -= I_OUT;
        if (r < I_UP) { const int nblk = NUP / 32, kb = r / nblk, nb = r % nblk, n0 = 32 * nb, pn = n0 >> 8, j0 = n0 & 255;
            const int s0 = (j0 < 128) ? (128 * pn + j0) : (DFF + 128 * pn + j0 - 128);
            p0_transpose_item(w_up, NUP, 64 * kb, s0, WUP, DM, n0, nw2, scr, lane); continue; } r -= I_UP;
        { const int kb = r / 32, nb = r % 32; p0_transpose_item(w_dn, DM, 64 * kb, 32 * nb, WDN, DFF, 32 * nb, nullptr, scr, lane); }
    }
    __syncthreads();
    for (int m = gw; m < M; m += NGW) {
        const f32x4* xr = (const f32x4*)(x + (size_t)m * DM) + lane; const f32x4* nr = (const f32x4*)nw1 + lane;
        f32x4 v[4]; float s = 0.f;
#pragma unroll
        for (int j = 0; j < 4; ++j) { v[j] = xr[64 * j]; s += (v[j].x * v[j].x + v[j].y * v[j].y) + (v[j].z * v[j].z + v[j].w * v[j].w); }
        const float rstd = rsqrtf(wave_sum(s) * (1.f / DM) + RMS_EPS);
        float ab[8];
#pragma unroll
        for (int q = 0; q < 8; ++q) { float a = 0.f;
#pragma unroll
            for (int j = 0; j < 4; ++j) { const f32x4 w = *(const LAS f32x4*)(wab + q * 1024 + 256 * j + 4 * lane); a += (v[j].x * w.x + v[j].y * w.y) + (v[j].z * w.z + v[j].w * w.w); }
            ab[q] = wave_sum(a) * rstd; }
        if (lane == 0) { *(f32x4*)(AB + (size_t)m * 8) = (f32x4){ab[0], ab[1], ab[2], ab[3]}; *(f32x4*)(AB + (size_t)m * 8 + 4) = (f32x4){ab[4], ab[5], ab[6], ab[7]}; }
        v2u* o8 = (v2u*)(XN + (size_t)m * DM) + lane;
#pragma unroll
        for (int j = 0; j < 4; ++j) { const f32x4 n = nr[64 * j]; v2u o; o.x = pk2(v[j].x * rstd * n.x, v[j].y * rstd * n.y); o.y = pk2(v[j].z * rstd * n.z, v[j].w * rstd * n.w); o8[64 * j] = o; }
    }
}

__device__ __forceinline__ void gdn_simple(const Args& A, LAS unsigned char* lds, int tid, int lane, int wave) {
    const bf16* PROJ = (const bf16*)(A.ws + WS_PROJ); const float* AB = (const float*)(A.ws + WS_AB); float* OA = (float*)(A.ws + WS_OA);
    const float* cw = A.in[3]; const float* a_log = A.in[4]; const float* dt_bias = A.in[5];
    LAS float* qs = (LAS float*)lds; LAS float* ks = qs + 16 * 128; LAS float* vs = ks + 16 * 128; LAS float* av = vs + 16 * 128; LAS float* bv = av + 16;
    for (int task = blockIdx.x; task < NB * GH; task += gridDim.x) {
        const int b = task / GH, h = task % GH, v = tid >> 2, part = tid & 3;
        float S[32];
#pragma unroll
        for (int i = 0; i < 32; ++i) S[i] = 0.f;
        const float Ah = __expf(a_log[h]), dtb = dt_bias[h];
        for (int blk = 0; blk < SEQ / 16; ++blk) {
            const int t0 = blk * 16;
            for (int idx = tid; idx < 16 * 384; idx += NTHR) {
                const int tt = idx / 384, c = idx % 384, which = c >> 7, d = c & 127, col = which * 512 + h * 128 + d, t = t0 + tt;
                float acc = 0.f;
#pragma unroll
                for (int i = 0; i < 4; ++i) { const int ts = t - 3 + i; if (ts >= 0) acc += cw[i * 1536 + col] * bf2f(PROJ[(size_t)(b * SEQ + ts) * NP + col]); }
                qs[which * 2048 + tt * 128 + d] = silu_f(acc);
            }
            if (tid < 16) { const size_t row = (size_t)b * SEQ + t0 + tid; bv[tid] = sigmoid_f(AB[row * 8 + h]); av[tid] = __expf(-Ah * softplus_f(AB[row * 8 + 4 + h] + dtb)); }
            __syncthreads();
#pragma unroll
            for (int r = 0; r < 4; ++r) { const int row = 4 * wave + r; LAS float* arr = qs + row * 128;
                const float v0 = arr[lane], v1 = arr[lane + 64]; const float s = wave_sum(v0 * v0 + v1 * v1);
                const float sc = rsqrtf(s + RMS_EPS) * (row < 16 ? 0.08838834764831845f : 1.0f); arr[lane] = v0 * sc; arr[lane + 64] = v1 * sc; }
            __syncthreads();
            for (int tt = 0; tt < 16; ++tt) {
                const float a = av[tt], bt = bv[tt], vt = vs[tt * 128 + v];
                float kS = 0.f;
#pragma unroll
                for (int i = 0; i < 32; ++i) kS += ks[tt * 128 + 32 * part + i] * S[i];
                kS += __shfl_xor(kS, 1); kS += __shfl_xor(kS, 2);
                const float c = bt * (vt - a * kS); float o = 0.f;
#pragma unroll
                for (int i = 0; i < 32; ++i) { S[i] = a * S[i] + ks[tt * 128 + 32 * part + i] * c; o += qs[tt * 128 + 32 * part + i] * S[i]; }
                o += __shfl_xor(o, 1); o += __shfl_xor(o, 2);
                if (part == 0) OA[(size_t)(b * SEQ + t0 + tt) * GW + h * 128 + v] = o;
            }
            __syncthreads();
        }
    }
}

__device__ __forceinline__ void attn_simple(const Args& A, int tid, int lane, int wave) {
    const bf16* PROJ = (const bf16*)(A.ws + WS_PROJ); bf16* CAT = (bf16*)(A.ws + WS_CAT);
    for (int wt = blockIdx.x * NWAVES + wave; wt < (M / 64) * AH; wt += gridDim.x * NWAVES) {
        const int h = wt % AH, tb = wt / AH, row = tb * 64 + lane, b = row / SEQ, t = row % SEQ;
        float q[64], acc[64];
        { const v4u* qp = (const v4u*)(PROJ + (size_t)row * NP + PC_QB + h * 64);
#pragma unroll
          for (int j = 0; j < 8; ++j) { const v4u w = qp[j]; q[8 * j + 0] = bflo(w.x) * 0.125f; q[8 * j + 1] = bfhi(w.x) * 0.125f; q[8 * j + 2] = bflo(w.y) * 0.125f; q[8 * j + 3] = bfhi(w.y) * 0.125f;
              q[8 * j + 4] = bflo(w.z) * 0.125f; q[8 * j + 5] = bfhi(w.z) * 0.125f; q[8 * j + 6] = bflo(w.w) * 0.125f; q[8 * j + 7] = bfhi(w.w) * 0.125f; } }
#pragma unroll
        for (int j = 0; j < 64; ++j) acc[j] = 0.f;
        float mx = -1e30f, l = 0.f;
        for (int br = 0; br < 3; ++br) {
            const int stride = br == 0 ? 1 : (br == 1 ? 4 : 16);
            for (int i = 0; i <= 128; ++i) {
                const int tk = t - i * stride; if (tk < 0) break;
                const size_t krow = (size_t)(b * SEQ + tk) * NP;
                const v4u* kp = (const v4u*)(PROJ + krow + PC_KB + h * 64); const v4u* vp = (const v4u*)(PROJ + krow + PC_VB + h * 64);
                float s = 0.f;
#pragma unroll
                for (int j = 0; j < 8; ++j) { const v4u w = kp[j]; s += q[8 * j + 0] * bflo(w.x) + q[8 * j + 1] * bfhi(w.x) + q[8 * j + 2] * bflo(w.y) + q[8 * j + 3] * bfhi(w.y)
                                                                       + q[8 * j + 4] * bflo(w.z) + q[8 * j + 5] * bfhi(w.z) + q[8 * j + 6] * bflo(w.w) + q[8 * j + 7] * bfhi(w.w); }
                const float mn = fmaxf(mx, s), sc = __expf(mx - mn), p = __expf(s - mn); mx = mn; l = l * sc + p;
#pragma unroll
                for (int j = 0; j < 8; ++j) { const v4u w = vp[j];
                    acc[8 * j + 0] = acc[8 * j + 0] * sc + p * bflo(w.x); acc[8 * j + 1] = acc[8 * j + 1] * sc + p * bfhi(w.x); acc[8 * j + 2] = acc[8 * j + 2] * sc + p * bflo(w.y); acc[8 * j + 3] = acc[8 * j + 3] * sc + p * bfhi(w.y);
                    acc[8 * j + 4] = acc[8 * j + 4] * sc + p * bflo(w.z); acc[8 * j + 5] = acc[8 * j + 5] * sc + p * bfhi(w.z); acc[8 * j + 6] = acc[8 * j + 6] * sc + p * bflo(w.w); acc[8 * j + 7] = acc[8 * j + 7] * sc + p * bfhi(w.w); }
            }
        }
        const float inv = 1.0f / l; v4u* op = (v4u*)(CAT + (size_t)row * DM + GW + h * 64);
#pragma unroll
        for (int j = 0; j < 8; ++j) { v4u w; w.x = pk2(acc[8 * j] * inv, acc[8 * j + 1] * inv); w.y = pk2(acc[8 * j + 2] * inv, acc[8 * j + 3] * inv); w.z = pk2(acc[8 * j + 4] * inv, acc[8 * j + 5] * inv); w.w = pk2(acc[8 * j + 6] * inv, acc[8 * j + 7] * inv); op[j] = w; }
    }
}
__device__ __forceinline__ void gated_norm(const Args& A, int lane, int wave) {
    const bf16* PROJ = (const bf16*)(A.ws + WS_PROJ); bf16* CAT = (bf16*)(A.ws + WS_CAT); const float* OA = (const float*)(A.ws + WS_OA); const float* gw = A.in[6];
    const float w0 = gw[2 * lane], w1 = gw[2 * lane + 1];
    for (int wt = blockIdx.x * NWAVES + wave; wt < M * GH; wt += gridDim.x * NWAVES) {
        const int row = wt / GH, h = wt % GH;
        const float2 o = *(const float2*)(OA + (size_t)row * GW + h * 128 + 2 * lane);
        const unsigned zz = *(const unsigned*)(PROJ + (size_t)row * NP + PC_Z + h * 128 + 2 * lane);
        const float ms = wave_sum(o.x * o.x + o.y * o.y) * (1.0f / 128.0f), r = rsqrtf(ms + RMS_EPS);
        *(unsigned*)(CAT + (size_t)row * DM + h * 128 + 2 * lane) = pk2(o.x * r * w0 * silu_f(bflo(zz)), o.y * r * w1 * silu_f(bfhi(zz)));
    }
}
__device__ __forceinline__ void ffn_conv_half(const Args& A, int half, int tid) {
    const bf16* Y = (const bf16*)(A.ws + WS_Y); bf16* ACT = (bf16*)(A.ws + WS_ACT); const float* fw = A.in[10];
    constexpr int HC = DFF / 2;
    for (size_t it = (size_t)blockIdx.x * NTHR + tid; it < (size_t)M * (HC / 8); it += (size_t)gridDim.x * NTHR) {
        const int row = (int)(it / (HC / 8)), g8 = (int)(it % (HC / 8)), cl = g8 * 8, pn = cl >> 7, j = cl & 127, t = row % SEQ, ch = half * HC + cl;
        float ga[8], ua[8];
#pragma unroll
        for (int e = 0; e < 8; ++e) { ga[e] = 0.f; ua[e] = 0.f; }
#pragma unroll
        for (int i = 0; i < 3; ++i) { const int ts = t - 2 + i; if (ts < 0) continue;
            const bf16* yr = Y + (size_t)(row - 2 + i) * DFF + 256 * pn + j; const v4u g = *(const v4u*)yr, u = *(const v4u*)(yr + 128);
            const f32x4 wg0 = *(const f32x4*)(fw + i * NUP + ch), wg1 = *(const f32x4*)(fw + i * NUP + ch + 4), wu0 = *(const f32x4*)(fw + i * NUP + DFF + ch), wu1 = *(const f32x4*)(fw + i * NUP + DFF + ch + 4);
            ga[0] += wg0.x * bflo(g.x); ga[1] += wg0.y * bfhi(g.x); ga[2] += wg0.z * bflo(g.y); ga[3] += wg0.w * bfhi(g.y); ga[4] += wg1.x * bflo(g.z); ga[5] += wg1.y * bfhi(g.z); ga[6] += wg1.z * bflo(g.w); ga[7] += wg1.w * bfhi(g.w);
            ua[0] += wu0.x * bflo(u.x); ua[1] += wu0.y * bfhi(u.x); ua[2] += wu0.z * bflo(u.y); ua[3] += wu0.w * bfhi(u.y); ua[4] += wu1.x * bflo(u.z); ua[5] += wu1.y * bfhi(u.z); ua[6] += wu1.z * bflo(u.w); ua[7] += wu1.w * bfhi(u.w); }
        v4u o; o.x = pk2(silu_f(ga[0]) * ua[0], silu_f(ga[1]) * ua[1]); o.y = pk2(silu_f(ga[2]) * ua[2], silu_f(ga[3]) * ua[3]); o.z = pk2(silu_f(ga[4]) * ua[4], silu_f(ga[5]) * ua[5]); o.w = pk2(silu_f(ga[6]) * ua[6], silu_f(ga[7]) * ua[7]);
        *(v4u*)(ACT + (size_t)row * DFF + ch) = o;
    }
}
__device__ __forceinline__ void final_norm(const Args& A, int lane, int wave) {
    float* out = A.out; const float* fnw = A.in[12];
    for (int m = blockIdx.x * NWAVES + wave; m < M; m += gridDim.x * NWAVES) {
        f32x4* xr = (f32x4*)(out + (size_t)m * DM) + lane; const f32x4* nr = (const f32x4*)fnw + lane;
        f32x4 v[4]; float s = 0.f;
#pragma unroll
        for (int j = 0; j < 4; ++j) { v[j] = xr[64 * j]; s += (v[j].x * v[j].x + v[j].y * v[j].y) + (v[j].z * v[j].z + v[j].w * v[j].w); }
        const float rstd = rsqrtf(wave_sum(s) * (1.f / DM) + RMS_EPS);
#pragma unroll
        for (int j = 0; j < 4; ++j) { const f32x4 n = nr[64 * j]; xr[64 * j] = (f32x4){v[j].x * rstd * n.x, v[j].y * rstd * n.y, v[j].z * rstd * n.z, v[j].w * rstd * n.w}; }
    }
}

constexpr int N_PHASES = 11;
__global__ void __launch_bounds__(NTHR, 2) mk_fwd(Args args) {
    extern __shared__ __attribute__((aligned(16))) unsigned char lds_raw[];
    LAS unsigned char* lds = (LAS unsigned char*)lds_raw;
    const int tid = threadIdx.x, lane = tid & 63, wave = __builtin_amdgcn_readfirstlane(tid >> 6);
    const int lo = args.ph_lo, hi = args.ph_hi;
    unsigned char* ws = args.ws;
    bf16* WIN = (bf16*)(ws + WS_WIN); bf16* WOUT = (bf16*)(ws + WS_WOUT); bf16* WUP = (bf16*)(ws + WS_WUP); bf16* WDN = (bf16*)(ws + WS_WDN);
    bf16* XN = (bf16*)(ws + WS_XN); bf16* PROJ = (bf16*)(ws + WS_PROJ); bf16* CAT = (bf16*)(ws + WS_CAT); bf16* Y = (bf16*)(ws + WS_Y); bf16* ACT = (bf16*)(ws + WS_ACT);
    float* SSQ = (float*)(ws + WS_SSQ);
#define IN(k) (lo <= (k) && (k) < hi)
#define SEAM(k) do { if (IN(k) && IN((k) + 1)) { cg::this_grid().sync(); } } while (0)
    if (IN(0)) { p0_prologue(args, lds, tid, lane, wave); } SEAM(0);
    if (IN(1)) { pg8::Gemm g{XN, WIN, M, NP, DM}; pg8::StaticOrder S; S.init(M, NP, gridDim.x, blockIdx.x); pg8::EpiBf16S E{PROJ, NP, nullptr};
        pg8::gemm_phase<pg8::EpiBf16S, pg8::StaticOrder, PG8_ALIGN, PG8_SP2>(lds, g, S, E); } SEAM(1);
    if (IN(2)) { gdn_simple(args, lds, tid, lane, wave); } SEAM(2);
    if (IN(3)) { attn_simple(args, tid, lane, wave); gated_norm(args, lane, wave); } SEAM(3);
    if (IN(4)) { pg8::Gemm g{CAT, WOUT, M, DM, DM}; pg8::StaticOrder S; S.init(M, DM, gridDim.x, blockIdx.x); pg8::EpiResid E{args.in[0], args.out, XN, SSQ, DM};
        pg8::gemm_phase<pg8::EpiResid, pg8::StaticOrder, PG8_ALIGN, PG8_SP2>(lds, g, S, E); } SEAM(4);
#pragma unroll 1
    for (int half = 0; half < 2; ++half) {
        if (IN(5 + 2 * half)) { pg8::Gemm g{XN, WUP + (size_t)half * DFF * DM, M, DFF, DM}; pg8::StaticOrder S; S.init(M, DFF, gridDim.x, blockIdx.x); pg8::EpiBf16S E{Y, DFF, SSQ};
            pg8::gemm_phase<pg8::EpiBf16S, pg8::StaticOrder, PG8_ALIGN, PG8_SP2>(lds, g, S, E); } SEAM(5 + 2 * half);
        if (IN(6 + 2 * half)) { ffn_conv_half(args, half, tid); } SEAM(6 + 2 * half);
    }
    if (IN(9)) { pg8::Gemm g{ACT, WDN, M, DM, DFF}; pg8::StaticOrder S; S.init(M, DM, gridDim.x, blockIdx.x); pg8::EpiResid E{args.out, args.out, nullptr, nullptr, DM};
        pg8::gemm_phase<pg8::EpiResid, pg8::StaticOrder, PG8_ALIGN, PG8_SP2>(lds, g, S, E); } SEAM(9);
    if (IN(10)) { final_norm(args, lane, wave); }
#undef IN
#undef SEAM
}

#ifndef MK_ONE_LAUNCH
#define MK_ONE_LAUNCH 1
#endif
extern "C" void kernel_launch(void* const* d_in, const int* in_sizes, int n_in, void* d_out, int out_size, void* d_ws, size_t ws_size, hipStream_t stream) {
    static int grid = 0;
    if (grid == 0) {
        if (n_in != 13 || out_size != M * DM || ws_size < WS_END) { fprintf(stderr, "kernel_launch: unexpected shapes n_in %d out %d ws %zu\n", n_in, out_size, ws_size); grid = -1; return; }
        int dev = 0, cus = 0, per_cu = 0;
        hipGetDevice(&dev); hipDeviceGetAttribute(&cus, hipDeviceAttributeMultiprocessorCount, dev);
        hipFuncSetAttribute((const void*)mk_fwd, hipFuncAttributeMaxDynamicSharedMemorySize, LDS_BYTES);
        hipOccupancyMaxActiveBlocksPerMultiprocessor(&per_cu, (const void*)mk_fwd, NTHR, LDS_BYTES);
        (void)hipGetLastError();
        if (per_cu < 1) { fprintf(stderr, "kernel_launch: occupancy query says %d blocks per CU\n", per_cu); per_cu = 1; }
        grid = cus;
    }
    if (grid < 0) return;
    Args a{};
    for (int i = 0; i < 13; ++i) a.in[i] = (const float*)d_in[i];
    a.out = (float*)d_out; a.ws = (unsigned char*)d_ws;
#if MK_ONE_LAUNCH
    a.ph_lo = 0; a.ph_hi = N_PHASES; a.coop = 1;
    void* kargs[] = {&a};
    hipError_t e = hipLaunchCooperativeKernel((const void*)mk_fwd, dim3(grid), dim3(NTHR), kargs, LDS_BYTES, stream);
    if (e != hipSuccess) fprintf(stderr, "cooperative launch failed: %s (grid %d)\n", hipGetErrorString(e), grid);
#else
    for (int p = 0; p < N_PHASES; ++p) { a.ph_lo = p; a.ph_hi = p + 1; a.coop = 0; hipLaunchKernelGGL(mk_fwd, dim3(grid), dim3(NTHR), LDS_BYTES, stream, a); }
#endif
}
```

```cpp
#include <hip/hip_runtime.h>
#include <hip/hip_cooperative_groups.h>
#include <cstdio>
#include <cstdint>
namespace cg = cooperative_groups;
namespace pg8 {
#define PG8_LAS __attribute__((address_space(3)))
typedef unsigned short bf16_t;
typedef short bf16x8 __attribute__((ext_vector_type(8)));
typedef float f32x4 __attribute__((ext_vector_type(4)));
typedef unsigned u32x4 __attribute__((ext_vector_type(4)));
constexpr int BM = 256, BK = 64, HALF = 128, HTB = HALF * BK * 2  , STAGE_BYTES = 8 * HTB, NXCD = 8, WGM = 8;

__host__ __device__ __forceinline__ int lds_byte(int r, int c) { const int st = (r >> 4) * 2 + (c >> 5), rr = r & 15, cc = c & 31, ob = rr * 64 + cc * 2; return st * 1024 + (ob ^ (((ob >> 9) & 1) << 5)); }
__host__ __device__ __forceinline__ void stage_rc(int b, int& R, int& C) { const int st = b / 1024, sb = b % 1024, swz = sb ^ (((sb >> 9) & 1) << 5); R = (st >> 1) * 16 + swz / 64; C = (st & 1) * 32 + (swz % 64) / 2; }
__host__ __device__ __forceinline__ int perm32(int rho) { const int n = rho >> 4, i = rho & 15; return 8 * (i >> 2) + 4 * n + (i & 3); }

struct Unit { int pm, pn; };
struct Gemm { const bf16_t* A; const bf16_t* Bt; int M, N, K; };

struct StaticOrder {
    int nM, nN, nwg, G, c;
    __host__ __device__ void init(int M, int N, int G_, int c_) { nM = M / BM; nN = N / BM; nwg = nM * nN; G = G_; c = c_; }
    __host__ __device__ bool next(int i, Unit& u) const {
        const long L = (long)i * G + c; if (L >= nwg) return false;
        int wgid = (int)L; { const int q = nwg / NXCD, r = nwg % NXCD, xcd = wgid % NXCD, off = wgid / NXCD; wgid = (xcd < r ? xcd * (q + 1) : r * (q + 1) + (xcd - r) * q) + off; }
        const int nig = WGM * nN, gid = wgid / nig, fm = gid * WGM, gsz = (nM - fm) < WGM ? (nM - fm) : WGM;
        u.pm = fm + ((wgid % nig) % gsz); u.pn = (wgid % nig) / gsz; return true;
    }
    __device__ __forceinline__ void a_ready(const Unit&) const {}
    __device__ __forceinline__ void done(const Unit&) const {}
};

__device__ __forceinline__ unsigned cvt_pk_bf16(float lo, float hi) { unsigned r; asm volatile("v_cvt_pk_bf16_f32 %0, %1, %2" : "=v"(r) : "v"(lo), "v"(hi)); return r; }
constexpr float RMS_EPS = 1e-6f;
struct EpiBf16S {
    static constexpr bool PERM = true, AFTER_DRAIN = false;
    bf16_t* O; int ldc; const float* ssq;
    __device__ __forceinline__ void operator()(const f32x4 (&acc)[2][2][4][2], const Unit& u, int wr, int wc, int fr, int fq) const {
        const int row0 = u.pm * BM + wr * 64 + fr; const int col0 = u.pn * BM + wc * 32 + 8 * fq;
#pragma unroll
        for (int ai = 0; ai < 2; ++ai)
#pragma unroll
            for (int m = 0; m < 4; ++m) { const int row = row0 + ai * HALF + m * 16; bf16_t* rowp = O + (size_t)row * ldc + col0;
                const float sc = ssq ? rsqrtf(ssq[row] * (1.0f / 1024.0f) + RMS_EPS) : 1.0f;
#pragma unroll
                for (int bj = 0; bj < 2; ++bj) { const f32x4 v0 = acc[ai][bj][m][0] * sc, v1 = acc[ai][bj][m][1] * sc;
                    u32x4 w; w.x = cvt_pk_bf16(v0[0], v0[1]); w.y = cvt_pk_bf16(v0[2], v0[3]); w.z = cvt_pk_bf16(v1[0], v1[1]); w.w = cvt_pk_bf16(v1[2], v1[3]);
                    *(u32x4*)(rowp + bj * HALF) = w; } }
    }
};
struct EpiResid {
    static constexpr bool PERM = false, AFTER_DRAIN = false;
    const float* base; float* out; bf16_t* xb; float* ssq; int ldc;
    __device__ __forceinline__ void operator()(const f32x4 (&acc)[2][2][4][2], const Unit& u, int wr, int wc, int fr, int fq) const {
        typedef unsigned u32x2v __attribute__((ext_vector_type(2)));
        const int col0 = u.pn * BM + wc * 32 + 4 * fq;
#pragma unroll
        for (int ai = 0; ai < 2; ++ai)
#pragma unroll
            for (int m = 0; m < 4; ++m) { const int row = u.pm * BM + ai * HALF + wr * 64 + m * 16 + fr; const size_t off = (size_t)row * ldc + col0; float s = 0.f;
#pragma unroll
                for (int bj = 0; bj < 2; ++bj)
#pragma unroll
                    for (int n = 0; n < 2; ++n) { const f32x4 v = acc[ai][bj][m][n] + *(const f32x4*)(base + off + bj * HALF + n * 16);
                        *(f32x4*)(out + off + bj * HALF + n * 16) = v; s += (v[0] * v[0] + v[1] * v[1]) + (v[2] * v[2] + v[3] * v[3]);
                        if (xb) { u32x2v w; w.x = cvt_pk_bf16(v[0], v[1]); w.y = cvt_pk_bf16(v[2], v[3]); *(u32x2v*)(xb + off + bj * HALF + n * 16) = w; } }
                if (ssq) { s += __shfl_xor(s, 16); s += __shfl_xor(s, 32); if (fq == 0) atomicAdd(ssq + row, s); }
                asm volatile("" ::: "memory"); }
    }
};
template <class Epi, class Sched, bool ALIGN_EPI = false, bool SP2 = false>
__device__ __forceinline__ void gemm_phase(PG8_LAS unsigned char* lds, const Gemm g, const Sched& S, const Epi& E) {
    const int tid = threadIdx.x, wid = __builtin_amdgcn_readfirstlane(tid >> 6), lane = tid & 63, wr = wid >> 2, wc = wid & 3, fr = lane & 15, fq = lane >> 4;
    const int K = g.K, nt = K / BK;
    unsigned voffA[2], voffB[2];
#pragma unroll
    for (int i = 0; i < 2; ++i) { int R, C; stage_rc(tid * 16 + i * 8192, R, C); const int Rb = Epi::PERM ? ((R & ~31) + perm32(R & 31)) : R;
        voffA[i] = (unsigned)(R * K + C) * 2u; voffB[i] = (unsigned)(Rb * K + C) * 2u; }
    const size_t kstep = (size_t)(BK * 2);
    const size_t hstep = (size_t)HALF * K * 2;
    const size_t tstep = 2 * hstep;
    const unsigned ldsw = (unsigned)wid * 1024u;
    const int aoff = lds_byte(wr * 64 + fr, fq * 8), boff = lds_byte(wc * 32 + fr, fq * 8);
#define PG8_SA(b, h) (((b) * 2 + (h)) * HTB)
#define PG8_SB(b, h) ((4 + (b) * 2 + (h)) * HTB)
#define PG8_STAGE(bufoff, gbase, voff) do { _Pragma("unroll") for (int _i = 0; _i < 2; ++_i) \
        __builtin_amdgcn_global_load_lds((const unsigned*)((const char*)(gbase) + (voff)[_i]), (PG8_LAS unsigned*)(lds + (bufoff) + ldsw + _i * 8192), 16, 0, 0); } while (0)
#define PG8_LDA(dst, b, h) do { _Pragma("unroll") for (int m = 0; m < 4; ++m) _Pragma("unroll") for (int k = 0; k < 2; ++k) dst[m][k] = *(const PG8_LAS bf16x8*)(lds + PG8_SA(b, h) + aoff + m * 2048 + k * 1024); } while (0)
#define PG8_LDB(dst, b, h) do { _Pragma("unroll") for (int n = 0; n < 2; ++n) _Pragma("unroll") for (int k = 0; k < 2; ++k) dst[n][k] = *(const PG8_LAS bf16x8*)(lds + PG8_SB(b, h) + boff + n * 2048 + k * 1024); } while (0)
#define PG8_MMA(ai, bj, At, Bt) do { __builtin_amdgcn_s_setprio(1); _Pragma("unroll") for (int m = 0; m < 4; ++m) _Pragma("unroll") for (int n = 0; n < 2; ++n) _Pragma("unroll") for (int k = 0; k < 2; ++k) \
        acc[ai][bj][m][n] = __builtin_amdgcn_mfma_f32_16x16x32_bf16(Bt[n][k], At[m][k], acc[ai][bj][m][n], 0, 0, 0); __builtin_amdgcn_s_setprio(0); } while (0)
#define PG8_WAIT_V(n) asm volatile("s_waitcnt vmcnt(" #n ")" ::: "memory")
#define PG8_WAIT_L(n) asm volatile("s_waitcnt lgkmcnt(" #n ")" ::: "memory")
#define PG8_BAR __builtin_amdgcn_s_barrier()
#define PG8_SCHED __builtin_amdgcn_sched_barrier(0)
    Unit cur, nxt; int ui = 0;
    if (!S.next(0, cur)) return;
    f32x4 acc[2][2][4][2];
#pragma unroll
    for (int a = 0; a < 2; ++a)
#pragma unroll
        for (int b = 0; b < 2; ++b)
#pragma unroll
            for (int m = 0; m < 4; ++m)
#pragma unroll
                for (int n = 0; n < 2; ++n) acc[a][b][m][n] = (f32x4){0.f, 0.f, 0.f, 0.f};
    bf16x8 At[4][2], B0[2][2], B1[2][2];
    const char* cA = (const char*)g.A + (size_t)cur.pm * tstep; const char* cB = (const char*)g.Bt + (size_t)cur.pn * tstep;
    S.a_ready(cur);
    if constexpr (SP2) {
        PG8_STAGE(PG8_SB(0, 0), cB, voffB); PG8_STAGE(PG8_SB(0, 1), cB + hstep, voffB); PG8_STAGE(PG8_SA(0, 0), cA, voffA); PG8_STAGE(PG8_SA(0, 1), cA + hstep, voffA);
        if (wr == 1) PG8_BAR;
        PG8_WAIT_V(2); PG8_BAR;
        PG8_STAGE(PG8_SB(1, 0), cB + kstep, voffB); PG8_STAGE(PG8_SA(1, 0), cA + kstep, voffA); PG8_STAGE(PG8_SB(1, 1), cB + hstep + kstep, voffB);
        PG8_WAIT_V(6); PG8_BAR;
    } else {
        PG8_STAGE(PG8_SB(0, 0), cB, voffB); PG8_STAGE(PG8_SA(0, 0), cA, voffA); PG8_STAGE(PG8_SB(0, 1), cB + hstep, voffB); PG8_STAGE(PG8_SA(0, 1), cA + hstep, voffA);
        if (wr == 1) PG8_BAR;
        PG8_WAIT_V(4); PG8_BAR;
        PG8_STAGE(PG8_SB(1, 0), cB + kstep, voffB); PG8_STAGE(PG8_SA(1, 0), cA + kstep, voffA); PG8_STAGE(PG8_SB(1, 1), cB + hstep + kstep, voffB);
        PG8_WAIT_V(6); PG8_BAR;
    }
    for (;;) {
        const bool has_next = S.next(ui + 1, nxt);
        const char* nA = has_next ? (const char*)g.A + (size_t)nxt.pm * tstep : cA; const char* nB = has_next ? (const char*)g.Bt + (size_t)nxt.pn * tstep : cB;
        for (int t = 0; t < nt; t += 2) {
            const bool last = (t == nt - 2);
            const char* a1 = cA + (size_t)(t + 1) * kstep;
            const char* a2 = last ? nA : cA + (size_t)(t + 2) * kstep; const char* b2 = last ? nB : cB + (size_t)(t + 2) * kstep;
            const char* a3 = a2 + kstep; const char* b3 = b2 + kstep;
            if (last && has_next) S.a_ready(nxt);
            if constexpr (SP2) {
            PG8_LDB(B0, 0, 0); PG8_LDB(B1, 0, 1); PG8_SCHED; PG8_LDA(At, 0, 0); PG8_STAGE(PG8_SA(1, 1), a1 + hstep, voffA);
            PG8_WAIT_V(8); PG8_WAIT_L(0); PG8_BAR; PG8_MMA(0, 0, At, B0); PG8_MMA(0, 1, At, B1); PG8_BAR; PG8_SCHED;
            PG8_LDA(At, 0, 1); PG8_STAGE(PG8_SB(0, 0), b2, voffB); PG8_STAGE(PG8_SB(0, 1), b2 + hstep, voffB); PG8_STAGE(PG8_SA(0, 0), a2, voffA);
            PG8_WAIT_V(8); PG8_WAIT_L(0); PG8_BAR; PG8_MMA(1, 0, At, B0); PG8_MMA(1, 1, At, B1); PG8_BAR; PG8_SCHED;
            PG8_LDB(B0, 1, 0); PG8_LDB(B1, 1, 1); PG8_SCHED; PG8_LDA(At, 1, 0); PG8_STAGE(PG8_SA(0, 1), a2 + hstep, voffA);
            PG8_WAIT_V(8); PG8_WAIT_L(0); PG8_BAR; PG8_MMA(0, 0, At, B0); PG8_MMA(0, 1, At, B1); PG8_BAR; PG8_SCHED;
            PG8_LDA(At, 1, 1); PG8_STAGE(PG8_SB(1, 0), b3, voffB); PG8_STAGE(PG8_SB(1, 1), b3 + hstep, voffB); PG8_STAGE(PG8_SA(1, 0), a3, voffA);
            PG8_WAIT_V(8); PG8_WAIT_L(0); PG8_BAR; PG8_MMA(1, 0, At, B0); PG8_MMA(1, 1, At, B1); PG8_BAR; PG8_SCHED;
            } else {
            PG8_LDB(B0, 0, 0); PG8_SCHED; PG8_LDA(At, 0, 0); PG8_STAGE(PG8_SA(1, 1), a1 + hstep, voffA);
            PG8_WAIT_L(8); PG8_BAR; PG8_WAIT_L(0); PG8_MMA(0, 0, At, B0); PG8_BAR; PG8_SCHED;
            PG8_LDB(B1, 0, 1); PG8_STAGE(PG8_SB(0, 0), b2, voffB);
            PG8_BAR; PG8_WAIT_L(0); PG8_MMA(0, 1, At, B1); PG8_BAR;
            PG8_LDA(At, 0, 1); PG8_STAGE(PG8_SA(0, 0), a2, voffA);
            PG8_BAR; PG8_WAIT_L(0); PG8_MMA(1, 0, At, B0); PG8_BAR; PG8_SCHED;
            PG8_STAGE(PG8_SB(0, 1), b2 + hstep, voffB);
            PG8_WAIT_V(6); PG8_BAR; PG8_MMA(1, 1, At, B1); PG8_BAR;
            PG8_LDB(B0, 1, 0); PG8_SCHED; PG8_LDA(At, 1, 0); PG8_STAGE(PG8_SA(0, 1), a2 + hstep, voffA);
            PG8_WAIT_L(8); PG8_BAR; PG8_WAIT_L(0); PG8_MMA(0, 0, At, B0); PG8_BAR; PG8_SCHED;
            PG8_LDB(B1, 1, 1); PG8_STAGE(PG8_SB(1, 0), b3, voffB);
            PG8_BAR; PG8_WAIT_L(0); PG8_MMA(0, 1, At, B1); PG8_BAR;
            PG8_LDA(At, 1, 1); PG8_STAGE(PG8_SA(1, 0), a3, voffA);
            PG8_BAR; PG8_WAIT_L(0); PG8_MMA(1, 0, At, B0); PG8_BAR; PG8_SCHED;
            PG8_STAGE(PG8_SB(1, 1), b3 + hstep, voffB);
            PG8_WAIT_V(6); PG8_BAR; PG8_MMA(1, 1, At, B1); PG8_BAR;
            }
        }
        if constexpr (ALIGN_EPI) { if (wr == 0) PG8_BAR; }
        if constexpr (!Epi::AFTER_DRAIN) { E(acc, cur, wr, wc, fr, fq); S.done(cur); }
        if (!has_next) break;
#pragma unroll
        for (int a = 0; a < 2; ++a)
#pragma unroll
            for (int b = 0; b < 2; ++b)
#pragma unroll
                for (int m = 0; m < 4; ++m)
#pragma unroll
                    for (int n = 0; n < 2; ++n) acc[a][b][m][n] = (f32x4){0.f, 0.f, 0.f, 0.f};
        cur = nxt; cA = nA; cB = nB; ++ui;
        if constexpr (ALIGN_EPI) { if (wr == 1) PG8_BAR; }
    }
    PG8_WAIT_V(0);
    if constexpr (!ALIGN_EPI) { if (wr == 0) PG8_BAR; }
    PG8_BAR;
    if constexpr (Epi::AFTER_DRAIN) { E.fused(acc, cur, wr, wc, fr, fq, lds, wid, lane); S.done(cur); }
#undef PG8_SA
#undef PG8_SB
#undef PG8_STAGE
#undef PG8_LDA
#undef PG8_LDB
#undef PG8_MMA
#undef PG8_WAIT_V
#undef PG8_WAIT_L
#undef PG8_BAR
#undef PG8_SCHED
}
}
#ifndef PG8_SP2
#define PG8_SP2 true
#endif
#ifndef PG8_ALIGN
#define PG8_ALIGN true
#endif
constexpr int NB = 8, SEQ = 2048, DM = 1024, M = NB * SEQ;
constexpr int GH = 4, GD = 128, GW = 512, AH = 8, AD = 64;
constexpr int INC = 3592, NP = 3584;
constexpr int DFF = 2816, NUP = 2 * DFF;
constexpr int PC_QA = 0, PC_KA = 512, PC_VA = 1024, PC_Z = 1536, PC_QB = 2048, PC_KB = 2560, PC_VB = 3072;
constexpr size_t MiB = 1u << 20;
constexpr size_t WS_CTL = 0, WS_AB = 1 * MiB, WS_SSQ = 1 * MiB + 768 * 1024, WS_WIN = 2 * MiB, WS_WOUT = 9 * MiB, WS_WUP = 11 * MiB, WS_WDN = 22 * MiB;
constexpr size_t WS_XN = 28 * MiB, WS_PROJ = 60 * MiB, WS_CAT = 172 * MiB, WS_OA = 204 * MiB, WS_Y = 60 * MiB, WS_ACT = 148 * MiB, WS_END = 256 * MiB;
using pg8::RMS_EPS;
constexpr size_t WS_GE = WS_SSQ + 65536;
constexpr int GOPS_CHUNK = 57344;
constexpr int NWAVES = 8, NTHR = 512;
constexpr int LDS_BYTES = 147456;
#define LAS __attribute__((address_space(3)))
typedef unsigned short bf16;
typedef unsigned v4u __attribute__((ext_vector_type(4)));
typedef unsigned v2u __attribute__((ext_vector_type(2)));
typedef float f32x4 __attribute__((ext_vector_type(4)));
__device__ __forceinline__ float bf2f(unsigned b) { return __uint_as_float(b << 16); }
__device__ __forceinline__ float bflo(unsigned w) { return __uint_as_float(w << 16); }
__device__ __forceinline__ float bfhi(unsigned w) { return __uint_as_float(w & 0xffff0000u); }
__device__ __forceinline__ unsigned pk2(float lo, float hi) { return pg8::cvt_pk_bf16(lo, hi); }
__device__ __forceinline__ float wave_sum(float v) {
#pragma unroll
    for (int o = 1; o < 64; o <<= 1) v += __shfl_xor(v, o);
    return v;
}
__device__ __forceinline__ float silu_f(float x) { return x / (1.0f + __expf(-x)); }
__device__ __forceinline__ float sigmoid_f(float x) { return 1.0f / (1.0f + __expf(-x)); }
__device__ __forceinline__ float softplus_f(float x) { return x > 20.f ? x : log1pf(__expf(x)); }

struct Args { const float* in[13]; float* out; unsigned char* ws; int ph_lo, ph_hi, coop, pad; };

__device__ __forceinline__ void p0_transpose_item(const float* W, int ldw, int k0, int sn0, bf16* WT, int K, int dn0, const float* kscale, LAS float* scr, int lane) {
#pragma unroll 8
    for (int i = 0; i < 32; ++i) { const int kk = 2 * i + (lane >> 5); float v = W[(size_t)(k0 + kk) * ldw + sn0 + (lane & 31)]; if (kscale) v *= kscale[k0 + kk]; scr[kk * 33 + (lane & 31)] = v; }
    asm volatile("s_waitcnt lgkmcnt(0)" ::: "memory");
    const int c = lane & 7;
#pragma unroll
    for (int j = 0; j < 4; ++j) { const int n = (lane >> 3) + 8 * j; const LAS float* s = scr + (8 * c) * 33 + n;
        v4u o; o.x = pk2(s[0 * 33], s[1 * 33]); o.y = pk2(s[2 * 33], s[3 * 33]); o.z = pk2(s[4 * 33], s[5 * 33]); o.w = pk2(s[6 * 33], s[7 * 33]);
        *(v4u*)(WT + (size_t)(dn0 + n) * K + k0 + 8 * c) = o; }
    asm volatile("s_waitcnt lgkmcnt(0)" ::: "memory");
}

__device__ __forceinline__ void p0_prologue(const Args& A, LAS unsigned char* lds, int tid, int lane, int wave) {
    const float* x = A.in[0]; const float* nw1 = A.in[1]; const float* w_in = A.in[2]; const float* w_out = A.in[7]; const float* nw2 = A.in[8];
    const float* w_up = A.in[9]; const float* w_dn = A.in[11];
    unsigned char* ws = A.ws;
    bf16* WIN = (bf16*)(ws + WS_WIN); bf16* WOUT = (bf16*)(ws + WS_WOUT); bf16* WUP = (bf16*)(ws + WS_WUP); bf16* WDN = (bf16*)(ws + WS_WDN);
    bf16* XN = (bf16*)(ws + WS_XN); float* AB = (float*)(ws + WS_AB); float* SSQ = (float*)(ws + WS_SSQ);
    LAS float* scr = (LAS float*)(lds + wave * 9216);
    LAS float* wab = (LAS float*)(lds + 73728);
    const int G = gridDim.x, gw = blockIdx.x * NWAVES + wave, NGW = G * NWAVES;
    for (int i = blockIdx.x * NTHR + tid; i < M; i += G * NTHR) SSQ[i] = 0.f;
    if (blockIdx.x == 0 && tid < 64) ((unsigned*)(ws + WS_CTL))[tid] = 0u;
    for (int idx = tid; idx < 8192; idx += NTHR) { const int k = idx >> 3, j = idx & 7; wab[j * 1024 + k] = nw1[k] * w_in[(size_t)k * INC + 2048 + j]; }
    constexpr int I_IN = 16 * (NP / 32), I_OUT = 16 * 32, I_UP = 16 * (NUP / 32), I_DN = (DFF / 64) * 32;
    constexpr int NITEMS = I_IN + I_OUT + I_UP + I_DN;
    for (int it = gw; it < NITEMS; it += NGW) {
        int r = it;
        if (r < I_IN) { const int nblk = NP / 32, kb = r / nblk, nb = r % nblk, n0 = 32 * nb; p0_transpose_item(w_in, INC, 64 * kb, n0 + (n0 >= 2048 ? 8 : 0), WIN, DM, n0, nullptr, scr, lane); continue; } r -= I_IN;
        if (r < I_OUT) { const int kb = r / 32, nb = r % 32; p0_transpose_item(w_out, DM, 64 * kb, 32 * nb, WOUT, DM, 32 * nb, nullptr, scr, lane); continue; } r -= I_OUT;
        if (r < I_UP) { const int nblk = NUP / 32, kb = r / nblk, nb = r % nblk, n0 = 32 * nb, pn = n0 >> 8, j0 = n0 & 255;
            const int s0 = (j0 < 128) ? (128 * pn + j0) : (DFF + 128 * pn + j0 - 128);
            p0_transpose_item(w_up, NUP, 64 * kb, s0, WUP, DM, n0, nw2, scr, lane); continue; } r -= I_UP;
        { const int kb = r / 32, nb = r % 32; p0_transpose_item(w_dn, DM, 64 * kb, 32 * nb, WDN, DFF, 32 * nb, nullptr, scr, lane); }
    }
    __syncthreads();
    for (int m = gw; m < M; m += NGW) {
        const f32x4* xr = (const f32x4*)(x + (size_t)m * DM) + lane; const f32x4* nr = (const f32x4*)nw1 + lane;
        f32x4 v[4]; float s = 0.f;
#pragma unroll
        for (int j = 0; j < 4; ++j) { v[j] = xr[64 * j]; s += (v[j].x * v[j].x + v[j].y * v[j].y) + (v[j].z * v[j].z + v[j].w * v[j].w); }
        const float rstd = rsqrtf(wave_sum(s) * (1.f / DM) + RMS_EPS);
        float ab[8];
#pragma unroll
        for (int q = 0; q < 8; ++q) { float a = 0.f;
#pragma unroll
            for (int j = 0; j < 4; ++j) { const f32x4 w = *(const LAS f32x4*)(wab + q * 1024 + 256 * j + 4 * lane); a += (v[j].x * w.x + v[j].y * w.y) + (v[j].z * w.z + v[j].w * w.w); }
            ab[q] = wave_sum(a) * rstd; }
        if (lane == 0) { *(f32x4*)(AB + (size_t)m * 8) = (f32x4){ab[0], ab[1], ab[2], ab[3]}; *(f32x4*)(AB + (size_t)m * 8 + 4) = (f32x4){ab[4], ab[5], ab[6], ab[7]}; }
        v2u* o8 = (v2u*)(XN + (size_t)m * DM) + lane;
#pragma unroll
        for (int j = 0; j < 4; ++j) { const f32x4 n = nr[64 * j]; v2u o; o.x = pk2(v[j].x * rstd * n.x, v[j].y * rstd * n.y); o.y = pk2(v[j].z * rstd * n.z, v[j].w * rstd * n.w); o8[64 * j] = o; }
    }
}

__device__ __forceinline__ void gdn_simple(const Args& A, LAS unsigned char* lds, int tid, int lane, int wave) {
    const bf16* PROJ = (const bf16*)(A.ws + WS_PROJ); const float* AB = (const float*)(A.ws + WS_AB); float* OA = (float*)(A.ws + WS_OA);
    const float* cw = A.in[3]; const float* a_log = A.in[4]; const float* dt_bias = A.in[5];
    LAS float* qs = (LAS float*)lds; LAS float* ks = qs + 16 * 128; LAS float* vs = ks + 16 * 128; LAS float* av = vs + 16 * 128; LAS float* bv = av + 16;
    for (int task = blockIdx.x; task < NB * GH; task += gridDim.x) {
        const int b = task / GH, h = task % GH, v = tid >> 2, part = tid & 3;
        float S[32];
#pragma unroll
        for (int i = 0; i < 32; ++i) S[i] = 0.f;
        const float Ah = __expf(a_log[h]), dtb = dt_bias[h];
        for (int blk = 0; blk < SEQ / 16; ++blk) {
            const int t0 = blk * 16;
            for (int idx = tid; idx < 16 * 384; idx += NTHR) {
                const int tt = idx / 384, c = idx % 384, which = c >> 7, d = c & 127, col = which * 512 + h * 128 + d, t = t0 + tt;
                float acc = 0.f;
#pragma unroll
                for (int i = 0; i < 4; ++i) { const int ts = t - 3 + i; if (ts >= 0) acc += cw[i * 1536 + col] * bf2f(PROJ[(size_t)(b * SEQ + ts) * NP + col]); }
                qs[which * 2048 + tt * 128 + d] = silu_f(acc);
            }
            if (tid < 16) { const size_t row = (size_t)b * SEQ + t0 + tid; bv[tid] = sigmoid_f(AB[row * 8 + h]); av[tid] = __expf(-Ah * softplus_f(AB[row * 8 + 4 + h] + dtb)); }
            __syncthreads();
#pragma unroll
            for (int r = 0; r < 4; ++r) { const int row = 4 * wave + r; LAS float* arr = qs + row * 128;
                const float v0 = arr[lane], v1 = arr[lane + 64]; const float s = wave_sum(v0 * v0 + v1 * v1);
                const float sc = rsqrtf(s + RMS_EPS) * (row < 16 ? 0.08838834764831845f : 1.0f); arr[lane] = v0 * sc; arr[lane + 64] = v1 * sc; }
            __syncthreads();
            for (int tt = 0; tt < 16; ++tt) {
                const float a = av[tt], bt = bv[tt], vt = vs[tt * 128 + v];
                float kS = 0.f;
#pragma unroll
                for (int i = 0; i < 32; ++i) kS += ks[tt * 128 + 32 * part + i] * S[i];
                kS += __shfl_xor(kS, 1); kS += __shfl_xor(kS, 2);
                const float c = bt * (vt - a * kS); float o = 0.f;
#pragma unroll
                for (int i = 0; i < 32; ++i) { S[i] = a * S[i] + ks[tt * 128 + 32 * part + i] * c; o += qs[tt * 128 + 32 * part + i] * S[i]; }
                o += __shfl_xor(o, 1); o += __shfl_xor(o, 2);
                if (part == 0) OA[(size_t)(b * SEQ + t0 + tt) * GW + h * 128 + v] = o;
            }
            __syncthreads();
        }
    }
}


template <int J, int K, int N> struct SolveLd {
    static __device__ __forceinline__ void run(f32x4 (&l)[16], unsigned lbase) {
        if constexpr (K < N) { constexpr int t40 = ((J + 1) >> 2) << 2;
            asm volatile("ds_read_b128 %0, %1 offset:%2" : "=v"(l[K]) : "v"(lbase), "i"((J * 68 + t40 + 4 * K) * 4)); SolveLd<J, K + 1, N>::run(l, lbase); }
    }
};
template <int J> struct SolveCol {
    static __device__ __forceinline__ void run(float (&R)[64], unsigned lbase) {
        if constexpr (J < 63) {
            constexpr int t40 = ((J + 1) >> 2) << 2, nld = (64 - t40) >> 2;
            f32x4 l[16];
            SolveLd<J, 0, nld>::run(l, lbase);
            asm volatile("s_waitcnt lgkmcnt(0)" ::: "memory");
#pragma unroll
            for (int k = 0; k < nld; ++k) asm volatile("" : "+v"(l[k]));
#pragma unroll
            for (int k = 0; k < nld; ++k) {
#pragma unroll
                for (int e = 0; e < 4; ++e) if (t40 + 4 * k + e > J) R[t40 + 4 * k + e] -= l[k][e] * R[J]; }
            SolveCol<J + 1>::run(R, lbase);
        }
    }
};

typedef short bf16x8 __attribute__((ext_vector_type(8)));
__device__ __forceinline__ void gdn_prep(const Args& A, LAS unsigned char* lds, int tid0, int lane0, int wave) {
    const bf16* PROJ = (const bf16*)(A.ws + WS_PROJ); const float* AB = (const float*)(A.ws + WS_AB);
    const float* cw = A.in[3]; const float* a_log = A.in[4]; const float* dt_bias = A.in[5];
    float* UV = (float*)(A.ws + WS_XN); unsigned char* GOPS = (unsigned char*)A.out; float* GE = (float*)(A.ws + WS_GE);
    LAS float* Qs = (LAS float*)lds; LAS float* Ks = (LAS float*)(lds + 33792); LAS float* Vs = (LAS float*)(lds + 67584);
    LAS bf16* Qb = (LAS bf16*)(lds + 101376); LAS bf16* Kb = (LAS bf16*)(lds + 118784);
    LAS float* gcs = (LAS float*)(lds + 136192); LAS float* bts = gcs + 64; LAS float* egs = gcs + 128; LAS float* kes = gcs + 192;
    LAS float* LsT = (LAS float*)lds; LAS bf16* ATs = (LAS bf16*)(lds + 17408); LAS bf16* WKs = Kb;
#pragma unroll 1
    for (int task = blockIdx.x; task < NB * GH * 32; task += gridDim.x) {
        int tid = tid0, lane = lane0; asm volatile("" : "+v"(tid), "+v"(lane));
        const int fr = lane & 15, fq = lane >> 4;
        const int bh = task >> 5, n = task & 31, b = bh >> 2, h = bh & 3, t0 = 64 * n, row0 = b * SEQ + t0;
        unsigned char* gops = GOPS + (size_t)task * GOPS_CHUNK;
        for (int idx = tid; idx < 3072; idx += NTHR) {
            const int tt = idx / 48, c8 = idx % 48, which = c8 >> 4, d0 = (c8 & 15) * 8, col = which * 512 + h * 128 + d0;
            float acc[8];
#pragma unroll
            for (int e = 0; e < 8; ++e) acc[e] = 0.f;
#pragma unroll
            for (int i = 0; i < 4; ++i) { const int ts = t0 + tt - 3 + i; if (ts < 0) continue;
                const v4u w = *(const v4u*)(PROJ + (size_t)(b * SEQ + ts) * NP + col); const f32x4 c0 = *(const f32x4*)(cw + i * 1536 + col), c1 = *(const f32x4*)(cw + i * 1536 + col + 4);
                acc[0] += c0.x * bflo(w.x); acc[1] += c0.y * bfhi(w.x); acc[2] += c0.z * bflo(w.y); acc[3] += c0.w * bfhi(w.y);
                acc[4] += c1.x * bflo(w.z); acc[5] += c1.y * bfhi(w.z); acc[6] += c1.z * bflo(w.w); acc[7] += c1.w * bfhi(w.w); }
            LAS float* dst = (which == 0 ? Qs : (which == 1 ? Ks : Vs)) + tt * 132 + d0;
            *(LAS f32x4*)dst = (f32x4){silu_f(acc[0]), silu_f(acc[1]), silu_f(acc[2]), silu_f(acc[3])};
            *(LAS f32x4*)(dst + 4) = (f32x4){silu_f(acc[4]), silu_f(acc[5]), silu_f(acc[6]), silu_f(acc[7])};
        }
        if (wave == 0) {
            const size_t row = (size_t)row0 + lane; const float beta = sigmoid_f(AB[row * 8 + h]);
            float g = -__expf(a_log[h]) * softplus_f(AB[row * 8 + 4 + h] + dt_bias[h]);
#pragma unroll
            for (int o = 1; o < 64; o <<= 1) { const float t = __shfl_up(g, o); if (lane >= o) g += t; }
            const float glast = __shfl(g, 63);
            gcs[lane] = g; bts[lane] = beta; egs[lane] = __expf(g); kes[lane] = __expf(glast - g) * beta;
            if (lane == 63) GE[task] = __expf(g);
        }
        __syncthreads();
#pragma unroll 2
        for (int r = 0; r < 8; ++r) { const int row = 8 * wave + r;
            { const float v0 = Qs[row * 132 + lane], v1 = Qs[row * 132 + lane + 64]; const float sc = rsqrtf(wave_sum(v0 * v0 + v1 * v1) + RMS_EPS) * 0.08838834764831845f;
              Qb[row * 136 + lane] = (bf16)(pk2(v0 * sc, 0.f) & 0xffffu); Qb[row * 136 + lane + 64] = (bf16)(pk2(v1 * sc, 0.f) & 0xffffu); }
            { const float v0 = Ks[row * 132 + lane], v1 = Ks[row * 132 + lane + 64]; const float sc = rsqrtf(wave_sum(v0 * v0 + v1 * v1) + RMS_EPS);
              Ks[row * 132 + lane] = v0 * sc; Ks[row * 132 + lane + 64] = v1 * sc; Kb[row * 136 + lane] = (bf16)(pk2(v0 * sc, 0.f) & 0xffffu); Kb[row * 136 + lane + 64] = (bf16)(pk2(v1 * sc, 0.f) & 0xffffu); }
        }
        __syncthreads();
#pragma unroll 1
        for (int jb = wave; jb < 20; jb += 8) {
            const int kind = jb >= 10 ? 1 : 0, idx = jb - 10 * kind, ti = idx < 1 ? 0 : (idx < 3 ? 1 : (idx < 6 ? 2 : 3)), tj = idx - ti * (ti + 1) / 2;
            const LAS bf16* As = kind ? Qb : Kb; f32x4 d = (f32x4){0.f, 0.f, 0.f, 0.f};
#pragma unroll
            for (int ks = 0; ks < 4; ++ks) { const bf16x8 a = *(const LAS bf16x8*)(As + (16 * ti + fr) * 136 + 32 * ks + 8 * fq), bb = *(const LAS bf16x8*)(Kb + (16 * tj + fr) * 136 + 32 * ks + 8 * fq);
                d = __builtin_amdgcn_mfma_f32_16x16x32_bf16(a, bb, d, 0, 0, 0); }
            const int j = 16 * tj + fr; const float gj = gcs[j], bj = bts[j]; float val[4];
#pragma unroll
            for (int e = 0; e < 4; ++e) { const int t = 16 * ti + 4 * fq + e; const float x = d[e] * __expf(gcs[t] - gj) * bj; val[e] = (kind ? (t >= j) : (t > j)) ? x : 0.f; }
            if (kind == 0) *(LAS f32x4*)(LsT + j * 68 + 16 * ti + 4 * fq) = (f32x4){val[0], val[1], val[2], val[3]};
            else {
#pragma unroll
                for (int e = 0; e < 4; ++e) ATs[(16 * ti + 4 * fq + e) * 72 + j] = (bf16)(pk2(val[e], 0.f) & 0xffffu); }
        }
        __syncthreads();
        float R[64];
        if (wave < 4) {
            if (wave < 2) {
#pragma unroll
                for (int t = 0; t < 64; ++t) R[t] = Vs[t * 132 + 64 * wave + lane];
            } else {
#pragma unroll
                for (int t = 0; t < 64; ++t) R[t] = egs[t] * Ks[t * 132 + 64 * (wave - 2) + lane];
            }
            SolveCol<0>::run(R, (unsigned)(uintptr_t)LsT);
            if (wave < 2) {
                float* uvp = UV + (size_t)task * 64 * 128 + 64 * wave + lane; asm volatile("" : "+v"(uvp));
#pragma unroll
                for (int t = 0; t < 64; ++t) { uvp[t * 128] = R[t]; if ((t & 7) == 7) asm volatile("" : "+v"(uvp)); }
            } else {
#pragma unroll
                for (int t = 0; t < 64; ++t) WKs[t * 136 + 64 * (wave - 2) + lane] = (bf16)(pk2(R[t], 0.f) & 0xffffu);
            }
        } else {
            const int rt = tid - 256;
            for (int q = rt; q < 1024; q += 256) { const int blk = q >> 6, l2 = q & 63, i = l2 & 15, f = l2 >> 4, mb = blk >> 2, ks = blk & 3, t = 16 * mb + i;
                const v2u p0 = *(const LAS v2u*)(Qb + t * 136 + 32 * ks + 4 * f), p1 = *(const LAS v2u*)(Qb + t * 136 + 32 * ks + 16 + 4 * f); const float e = egs[t];
                v4u o; o.x = pk2(bflo(p0.x) * e, bfhi(p0.x) * e); o.y = pk2(bflo(p0.y) * e, bfhi(p0.y) * e); o.z = pk2(bflo(p1.x) * e, bfhi(p1.x) * e); o.w = pk2(bflo(p1.y) * e, bfhi(p1.y) * e);
                *(v4u*)(gops + 16384 + q * 16) = o; }
            for (int q = rt; q < 512; q += 256) { const int blk = q >> 6, l2 = q & 63, i = l2 & 15, f = l2 >> 4, mb = blk >> 1, ks2 = blk & 1, t = 16 * mb + i;
                v2u p0 = (v2u){0u, 0u}, p1 = (v2u){0u, 0u};
                if (2 * ks2 <= mb) p0 = *(const LAS v2u*)(ATs + t * 72 + 32 * ks2 + 4 * f);
                if (2 * ks2 + 1 <= mb) p1 = *(const LAS v2u*)(ATs + t * 72 + 32 * ks2 + 16 + 4 * f);
                *(v4u*)(gops + 32768 + q * 16) = (v4u){p0.x, p0.y, p1.x, p1.y}; }
            for (int q = rt; q < 1024; q += 256) { const int blk = q >> 6, l2 = q & 63, i = l2 & 15, f = l2 >> 4, dkb = blk >> 1, ks2 = blk & 1, dk = 16 * dkb + i; float v[8];
#pragma unroll
                for (int e = 0; e < 8; ++e) { const int c = 32 * ks2 + 16 * (e >> 2) + 4 * f + (e & 3); v[e] = Ks[c * 132 + dk] * kes[c]; }
                *(v4u*)(gops + 40960 + q * 16) = (v4u){pk2(v[0], v[1]), pk2(v[2], v[3]), pk2(v[4], v[5]), pk2(v[6], v[7])}; }
        }
        __syncthreads();
        for (int q = tid; q < 1024; q += NTHR) { const int blk = q >> 6, l2 = q & 63, i = l2 & 15, f = l2 >> 4, mb = blk >> 2, ks = blk & 3, t = 16 * mb + i;
            const v2u p0 = *(const LAS v2u*)(WKs + t * 136 + 32 * ks + 4 * f), p1 = *(const LAS v2u*)(WKs + t * 136 + 32 * ks + 16 + 4 * f);
            *(v4u*)(gops + q * 16) = (v4u){p0.x, p0.y, p1.x, p1.y}; }
        __syncthreads();
    }
}

__device__ __forceinline__ bf16x8 pack8(const f32x4 a, const f32x4 b) {
    v4u w; w.x = pk2(a[0], a[1]); w.y = pk2(a[2], a[3]); w.z = pk2(b[0], b[1]); w.w = pk2(b[2], b[3]); return __builtin_bit_cast(bf16x8, w);
}
__device__ __forceinline__ void gdn_scan(const Args& A, LAS unsigned char* lds, int bh, int tid, int lane, int wave) {
    const int b = bh >> 2, h = bh & 3, fr = lane & 15, fq = lane >> 4, vs = wave;
    const unsigned char* gops = (const unsigned char*)A.out + (size_t)bh * 32 * GOPS_CHUNK;
    const float* UV = (const float*)(A.ws + WS_XN) + (size_t)bh * 32 * 64 * 128; const float* GE = (const float*)(A.ws + WS_GE) + bh * 32;
    const bf16* PROJ = (const bf16*)(A.ws + WS_PROJ); bf16* CAT = (bf16*)(A.ws + WS_CAT);
    LAS float* ssqp = (LAS float*)(lds + 2 * GOPS_CHUNK);
    const float gwv = A.in[6][16 * vs + fr];
    f32x4 S[8];
#pragma unroll
    for (int i = 0; i < 8; ++i) S[i] = (f32x4){0.f, 0.f, 0.f, 0.f};
    float uvc[16], uvn[16];
#define SCAN_DMA(chunk, bufoff) do { for (int p_ = wave; p_ < 56; p_ += 8) __builtin_amdgcn_global_load_lds((const unsigned*)(gops + (size_t)(chunk) * GOPS_CHUNK + p_ * 1024 + lane * 16), (LAS unsigned*)(lds + (bufoff) + p_ * 1024), 16, 0, 0); } while (0)
    SCAN_DMA(0, 0);
#pragma unroll
    for (int i = 0; i < 16; ++i) uvc[i] = UV[(size_t)(16 * (i >> 2) + 4 * fq + (i & 3)) * 128 + 16 * vs + fr];
    asm volatile("s_waitcnt vmcnt(0)" ::: "memory"); __syncthreads();
#pragma unroll 1
    for (int n = 0; n < 32; ++n) {
        const LAS unsigned char* cur = lds + (n & 1) * GOPS_CHUNK;
        if (n + 1 < 32) { SCAN_DMA(n + 1, ((n + 1) & 1) * GOPS_CHUNK);
#pragma unroll
            for (int i = 0; i < 16; ++i) uvn[i] = UV[((size_t)(n + 1) * 64 + 16 * (i >> 2) + 4 * fq + (i & 3)) * 128 + 16 * vs + fr]; }
        const size_t row0 = (size_t)b * SEQ + 64 * n;
        unsigned short zr[16];
#pragma unroll
        for (int i = 0; i < 16; ++i) zr[i] = PROJ[(row0 + 16 * (i >> 2) + 4 * fq + (i & 3)) * NP + PC_Z + h * 128 + 16 * vs + fr];
        const float ge = GE[n];
        bf16x8 Sb[4];
#pragma unroll
        for (int ks = 0; ks < 4; ++ks) Sb[ks] = pack8(S[2 * ks], S[2 * ks + 1]);
        f32x4 u[4];
#pragma unroll
        for (int mb = 0; mb < 4; ++mb) { f32x4 p = (f32x4){0.f, 0.f, 0.f, 0.f};
#pragma unroll
            for (int ks = 0; ks < 4; ++ks) p = __builtin_amdgcn_mfma_f32_16x16x32_bf16(*(const LAS bf16x8*)(cur + ((mb * 4 + ks) * 64 + lane) * 16), Sb[ks], p, 0, 0, 0);
            u[mb] = (f32x4){uvc[4 * mb] - p[0], uvc[4 * mb + 1] - p[1], uvc[4 * mb + 2] - p[2], uvc[4 * mb + 3] - p[3]}; }
        bf16x8 ub[2]; ub[0] = pack8(u[0], u[1]); ub[1] = pack8(u[2], u[3]);
        f32x4 o[4];
#pragma unroll
        for (int mb = 0; mb < 4; ++mb) { f32x4 acc = (f32x4){0.f, 0.f, 0.f, 0.f};
#pragma unroll
            for (int ks = 0; ks < 4; ++ks) acc = __builtin_amdgcn_mfma_f32_16x16x32_bf16(*(const LAS bf16x8*)(cur + 16384 + ((mb * 4 + ks) * 64 + lane) * 16), Sb[ks], acc, 0, 0, 0);
#pragma unroll
            for (int ks2 = 0; ks2 < 2; ++ks2) if (ks2 <= (mb >> 1)) acc = __builtin_amdgcn_mfma_f32_16x16x32_bf16(*(const LAS bf16x8*)(cur + 32768 + ((mb * 2 + ks2) * 64 + lane) * 16), ub[ks2], acc, 0, 0, 0);
            o[mb] = acc; }
#pragma unroll
        for (int dkb = 0; dkb < 8; ++dkb) { f32x4 acc = S[dkb] * ge;
#pragma unroll
            for (int ks2 = 0; ks2 < 2; ++ks2) acc = __builtin_amdgcn_mfma_f32_16x16x32_bf16(*(const LAS bf16x8*)(cur + 40960 + ((dkb * 2 + ks2) * 64 + lane) * 16), ub[ks2], acc, 0, 0, 0);
            S[dkb] = acc; }
#pragma unroll
        for (int i = 0; i < 16; ++i) { float s = o[i >> 2][i & 3]; s *= s; s += __shfl_xor(s, 1); s += __shfl_xor(s, 2); s += __shfl_xor(s, 4); s += __shfl_xor(s, 8);
            if (fr == 0) ssqp[(16 * (i >> 2) + 4 * fq + (i & 3)) * 8 + wave] = s; }
        __syncthreads();
#pragma unroll
        for (int i = 0; i < 16; ++i) { const int t = 16 * (i >> 2) + 4 * fq + (i & 3); const f32x4 p0 = *(const LAS f32x4*)(ssqp + t * 8), p1 = *(const LAS f32x4*)(ssqp + t * 8 + 4);
            const float ms = ((p0.x + p0.y) + (p0.z + p0.w) + (p1.x + p1.y) + (p1.z + p1.w)) * (1.0f / 128.0f), r = rsqrtf(ms + RMS_EPS);
            const float y = o[i >> 2][i & 3] * r * gwv * silu_f(bf2f(zr[i]));
            CAT[(row0 + t) * DM + h * 128 + 16 * vs + fr] = (bf16)(pk2(y, 0.f) & 0xffffu); }
#pragma unroll
        for (int i = 0; i < 16; ++i) uvc[i] = uvn[i];
        asm volatile("s_waitcnt vmcnt(0)" ::: "memory"); __syncthreads();
    }
#undef SCAN_DMA
}

__device__ __forceinline__ void attn_simple(const Args& A, int tid, int lane, int wave) {
    const bf16* PROJ = (const bf16*)(A.ws + WS_PROJ); bf16* CAT = (bf16*)(A.ws + WS_CAT);
    unsigned* ctr = (unsigned*)(A.ws + WS_CTL);
    for (;;) {
        unsigned wt_ = 0; if (lane == 0) wt_ = atomicAdd(ctr, 1u); const int wt = __builtin_amdgcn_readfirstlane(wt_);
        if (wt >= (M / 64) * AH) break;
        const int h = wt % AH, tb = wt / AH, row = tb * 64 + lane, b = row / SEQ, t = row % SEQ;
        float q[64], acc[64];
        { const v4u* qp = (const v4u*)(PROJ + (size_t)row * NP + PC_QB + h * 64);
#pragma unroll
          for (int j = 0; j < 8; ++j) { const v4u w = qp[j]; q[8 * j + 0] = bflo(w.x) * 0.125f; q[8 * j + 1] = bfhi(w.x) * 0.125f; q[8 * j + 2] = bflo(w.y) * 0.125f; q[8 * j + 3] = bfhi(w.y) * 0.125f;
              q[8 * j + 4] = bflo(w.z) * 0.125f; q[8 * j + 5] = bfhi(w.z) * 0.125f; q[8 * j + 6] = bflo(w.w) * 0.125f; q[8 * j + 7] = bfhi(w.w) * 0.125f; } }
#pragma unroll
        for (int j = 0; j < 64; ++j) acc[j] = 0.f;
        float mx = -1e30f, l = 0.f;
        for (int br = 0; br < 3; ++br) {
            const int stride = br == 0 ? 1 : (br == 1 ? 4 : 16);
            for (int i = 0; i <= 128; ++i) {
                const int tk = t - i * stride; if (tk < 0) break;
                const size_t krow = (size_t)(b * SEQ + tk) * NP;
                const v4u* kp = (const v4u*)(PROJ + krow + PC_KB + h * 64); const v4u* vp = (const v4u*)(PROJ + krow + PC_VB + h * 64);
                float s = 0.f;
#pragma unroll
                for (int j = 0; j < 8; ++j) { const v4u w = kp[j]; s += q[8 * j + 0] * bflo(w.x) + q[8 * j + 1] * bfhi(w.x) + q[8 * j + 2] * bflo(w.y) + q[8 * j + 3] * bfhi(w.y)
                                                                       + q[8 * j + 4] * bflo(w.z) + q[8 * j + 5] * bfhi(w.z) + q[8 * j + 6] * bflo(w.w) + q[8 * j + 7] * bfhi(w.w); }
                const float mn = fmaxf(mx, s), sc = __expf(mx - mn), p = __expf(s - mn); mx = mn; l = l * sc + p;
#pragma unroll
                for (int j = 0; j < 8; ++j) { const v4u w = vp[j];
                    acc[8 * j + 0] = acc[8 * j + 0] * sc + p * bflo(w.x); acc[8 * j + 1] = acc[8 * j + 1] * sc + p * bfhi(w.x); acc[8 * j + 2] = acc[8 * j + 2] * sc + p * bflo(w.y); acc[8 * j + 3] = acc[8 * j + 3] * sc + p * bfhi(w.y);
                    acc[8 * j + 4] = acc[8 * j + 4] * sc + p * bflo(w.z); acc[8 * j + 5] = acc[8 * j + 5] * sc + p * bfhi(w.z); acc[8 * j + 6] = acc[8 * j + 6] * sc + p * bflo(w.w); acc[8 * j + 7] = acc[8 * j + 7] * sc + p * bfhi(w.w); }
            }
        }
        const float inv = 1.0f / l; v4u* op = (v4u*)(CAT + (size_t)row * DM + GW + h * 64);
#pragma unroll
        for (int j = 0; j < 8; ++j) { v4u w; w.x = pk2(acc[8 * j] * inv, acc[8 * j + 1] * inv); w.y = pk2(acc[8 * j + 2] * inv, acc[8 * j + 3] * inv); w.z = pk2(acc[8 * j + 4] * inv, acc[8 * j + 5] * inv); w.w = pk2(acc[8 * j + 6] * inv, acc[8 * j + 7] * inv); op[j] = w; }
    }
}
__device__ __forceinline__ void gated_norm(const Args& A, int lane, int wave) {
    const bf16* PROJ = (const bf16*)(A.ws + WS_PROJ); bf16* CAT = (bf16*)(A.ws + WS_CAT); const float* OA = (const float*)(A.ws + WS_OA); const float* gw = A.in[6];
    const float w0 = gw[2 * lane], w1 = gw[2 * lane + 1];
    for (int wt = blockIdx.x * NWAVES + wave; wt < M * GH; wt += gridDim.x * NWAVES) {
        const int row = wt / GH, h = wt % GH;
        const float2 o = *(const float2*)(OA + (size_t)row * GW + h * 128 + 2 * lane);
        const unsigned zz = *(const unsigned*)(PROJ + (size_t)row * NP + PC_Z + h * 128 + 2 * lane);
        const float ms = wave_sum(o.x * o.x + o.y * o.y) * (1.0f / 128.0f), r = rsqrtf(ms + RMS_EPS);
        *(unsigned*)(CAT + (size_t)row * DM + h * 128 + 2 * lane) = pk2(o.x * r * w0 * silu_f(bflo(zz)), o.y * r * w1 * silu_f(bfhi(zz)));
    }
}
__device__ __forceinline__ void ffn_conv_half(const Args& A, int half, int tid) {
    const bf16* Y = (const bf16*)(A.ws + WS_Y); bf16* ACT = (bf16*)(A.ws + WS_ACT); const float* fw = A.in[10];
    constexpr int HC = DFF / 2;
    for (size_t it = (size_t)blockIdx.x * NTHR + tid; it < (size_t)M * (HC / 8); it += (size_t)gridDim.x * NTHR) {
        const int row = (int)(it / (HC / 8)), g8 = (int)(it % (HC / 8)), cl = g8 * 8, pn = cl >> 7, j = cl & 127, t = row % SEQ, ch = half * HC + cl;
        float ga[8], ua[8];
#pragma unroll
        for (int e = 0; e < 8; ++e) { ga[e] = 0.f; ua[e] = 0.f; }
#pragma unroll
        for (int i = 0; i < 3; ++i) { const int ts = t - 2 + i; if (ts < 0) continue;
            const bf16* yr = Y + (size_t)(row - 2 + i) * DFF + 256 * pn + j; const v4u g = *(const v4u*)yr, u = *(const v4u*)(yr + 128);
            const f32x4 wg0 = *(const f32x4*)(fw + i * NUP + ch), wg1 = *(const f32x4*)(fw + i * NUP + ch + 4), wu0 = *(const f32x4*)(fw + i * NUP + DFF + ch), wu1 = *(const f32x4*)(fw + i * NUP + DFF + ch + 4);
            ga[0] += wg0.x * bflo(g.x); ga[1] += wg0.y * bfhi(g.x); ga[2] += wg0.z * bflo(g.y); ga[3] += wg0.w * bfhi(g.y); ga[4] += wg1.x * bflo(g.z); ga[5] += wg1.y * bfhi(g.z); ga[6] += wg1.z * bflo(g.w); ga[7] += wg1.w * bfhi(g.w);
            ua[0] += wu0.x * bflo(u.x); ua[1] += wu0.y * bfhi(u.x); ua[2] += wu0.z * bflo(u.y); ua[3] += wu0.w * bfhi(u.y); ua[4] += wu1.x * bflo(u.z); ua[5] += wu1.y * bfhi(u.z); ua[6] += wu1.z * bflo(u.w); ua[7] += wu1.w * bfhi(u.w); }
        v4u o; o.x = pk2(silu_f(ga[0]) * ua[0], silu_f(ga[1]) * ua[1]); o.y = pk2(silu_f(ga[2]) * ua[2], silu_f(ga[3]) * ua[3]); o.z = pk2(silu_f(ga[4]) * ua[4], silu_f(ga[5]) * ua[5]); o.w = pk2(silu_f(ga[6]) * ua[6], silu_f(ga[7]) * ua[7]);
        *(v4u*)(ACT + (size_t)row * DFF + ch) = o;
    }
}
__device__ __forceinline__ void final_norm(const Args& A, int lane, int wave) {
    float* out = A.out; const float* fnw = A.in[12];
    for (int m = blockIdx.x * NWAVES + wave; m < M; m += gridDim.x * NWAVES) {
        f32x4* xr = (f32x4*)(out + (size_t)m * DM) + lane; const f32x4* nr = (const f32x4*)fnw + lane;
        f32x4 v[4]; float s = 0.f;
#pragma unroll
        for (int j = 0; j < 4; ++j) { v[j] = xr[64 * j]; s += (v[j].x * v[j].x + v[j].y * v[j].y) + (v[j].z * v[j].z + v[j].w * v[j].w); }
        const float rstd = rsqrtf(wave_sum(s) * (1.f / DM) + RMS_EPS);
#pragma unroll
        for (int j = 0; j < 4; ++j) { const f32x4 n = nr[64 * j]; xr[64 * j] = (f32x4){v[j].x * rstd * n.x, v[j].y * rstd * n.y, v[j].z * rstd * n.z, v[j].w * rstd * n.w}; }
    }
}

constexpr int N_PHASES = 11;
__global__ void __launch_bounds__(NTHR, 2) mk_fwd(Args args) {
    extern __shared__ __attribute__((aligned(16))) unsigned char lds_raw[];
    LAS unsigned char* lds = (LAS unsigned char*)lds_raw;
    const int tid = threadIdx.x, lane = tid & 63, wave = __builtin_amdgcn_readfirstlane(tid >> 6);
    const int lo = args.ph_lo, hi = args.ph_hi;
    unsigned char* ws = args.ws;
    bf16* WIN = (bf16*)(ws + WS_WIN); bf16* WOUT = (bf16*)(ws + WS_WOUT); bf16* WUP = (bf16*)(ws + WS_WUP); bf16* WDN = (bf16*)(ws + WS_WDN);
    bf16* XN = (bf16*)(ws + WS_XN); bf16* PROJ = (bf16*)(ws + WS_PROJ); bf16* CAT = (bf16*)(ws + WS_CAT); bf16* Y = (bf16*)(ws + WS_Y); bf16* ACT = (bf16*)(ws + WS_ACT);
    float* SSQ = (float*)(ws + WS_SSQ);
#define IN(k) (lo <= (k) && (k) < hi)
#define SEAM(k) do { if (IN(k) && IN((k) + 1)) { cg::this_grid().sync(); } } while (0)
    if (IN(0)) { p0_prologue(args, lds, tid, lane, wave); } SEAM(0);
    if (IN(1)) { pg8::Gemm g{XN, WIN, M, NP, DM}; pg8::StaticOrder S; S.init(M, NP, gridDim.x, blockIdx.x); pg8::EpiBf16S E{PROJ, NP, nullptr};
        pg8::gemm_phase<pg8::EpiBf16S, pg8::StaticOrder, PG8_ALIGN, PG8_SP2>(lds, g, S, E); } SEAM(1);
    if (IN(2)) { gdn_prep(args, lds, tid, lane, wave); } SEAM(2);
    if (IN(3)) { if (blockIdx.x < NB * GH) gdn_scan(args, lds, blockIdx.x, tid, lane, wave); attn_simple(args, tid, lane, wave); } SEAM(3);
    if (IN(4)) { pg8::Gemm g{CAT, WOUT, M, DM, DM}; pg8::StaticOrder S; S.init(M, DM, gridDim.x, blockIdx.x); pg8::EpiResid E{args.in[0], args.out, XN, SSQ, DM};
        pg8::gemm_phase<pg8::EpiResid, pg8::StaticOrder, PG8_ALIGN, PG8_SP2>(lds, g, S, E); } SEAM(4);
#pragma unroll 1
    for (int half = 0; half < 2; ++half) {
        if (IN(5 + 2 * half)) { pg8::Gemm g{XN, WUP + (size_t)half * DFF * DM, M, DFF, DM}; pg8::StaticOrder S; S.init(M, DFF, gridDim.x, blockIdx.x); pg8::EpiBf16S E{Y, DFF, SSQ};
            pg8::gemm_phase<pg8::EpiBf16S, pg8::StaticOrder, PG8_ALIGN, PG8_SP2>(lds, g, S, E); } SEAM(5 + 2 * half);
        if (IN(6 + 2 * half)) { ffn_conv_half(args, half, tid); } SEAM(6 + 2 * half);
    }
    if (IN(9)) { pg8::Gemm g{ACT, WDN, M, DM, DFF}; pg8::StaticOrder S; S.init(M, DM, gridDim.x, blockIdx.x); pg8::EpiResid E{args.out, args.out, nullptr, nullptr, DM};
        pg8::gemm_phase<pg8::EpiResid, pg8::StaticOrder, PG8_ALIGN, PG8_SP2>(lds, g, S, E); } SEAM(9);
    if (IN(10)) { final_norm(args, lane, wave); }
#undef IN
#undef SEAM
}

#ifndef MK_ONE_LAUNCH
#define MK_ONE_LAUNCH 1
#endif
extern "C" void kernel_launch(void* const* d_in, const int* in_sizes, int n_in, void* d_out, int out_size, void* d_ws, size_t ws_size, hipStream_t stream) {
    static int grid = 0;
    if (grid == 0) {
        if (n_in != 13 || out_size != M * DM || ws_size < WS_END) { fprintf(stderr, "kernel_launch: unexpected shapes n_in %d out %d ws %zu\n", n_in, out_size, ws_size); grid = -1; return; }
        int dev = 0, cus = 0, per_cu = 0;
        hipGetDevice(&dev); hipDeviceGetAttribute(&cus, hipDeviceAttributeMultiprocessorCount, dev);
        hipFuncSetAttribute((const void*)mk_fwd, hipFuncAttributeMaxDynamicSharedMemorySize, LDS_BYTES);
        hipOccupancyMaxActiveBlocksPerMultiprocessor(&per_cu, (const void*)mk_fwd, NTHR, LDS_BYTES);
        (void)hipGetLastError();
        if (per_cu < 1) { fprintf(stderr, "kernel_launch: occupancy query says %d blocks per CU\n", per_cu); per_cu = 1; }
        grid = cus;
    }
    if (grid < 0) return;
    Args a{};
    for (int i = 0; i < 13; ++i) a.in[i] = (const float*)d_in[i];
    a.out = (float*)d_out; a.ws = (unsigned char*)d_ws;
#if MK_ONE_LAUNCH
    a.ph_lo = 0; a.ph_hi = N_PHASES; a.coop = 1;
    void* kargs[] = {&a};
    hipError_t e = hipLaunchCooperativeKernel((const void*)mk_fwd, dim3(grid), dim3(NTHR), kargs, LDS_BYTES, stream);
    if (e != hipSuccess) fprintf(stderr, "cooperative launch failed: %s (grid %d)\n", hipGetErrorString(e), grid);
#else
    for (int p = 0; p < N_PHASES; ++p) { a.ph_lo = p; a.ph_hi = p + 1; a.coop = 0; hipLaunchKernelGGL(mk_fwd, dim3(grid), dim3(NTHR), LDS_BYTES, stream, a); }
#endif
}
```

```cpp
#include <hip/hip_runtime.h>
#include <hip/hip_cooperative_groups.h>
#include <cstdio>
#include <cstdint>
namespace cg = cooperative_groups;
namespace pg8 {
#define PG8_LAS __attribute__((address_space(3)))
typedef unsigned short bf16_t;
typedef short bf16x8 __attribute__((ext_vector_type(8)));
typedef float f32x4 __attribute__((ext_vector_type(4)));
typedef unsigned u32x4 __attribute__((ext_vector_type(4)));
constexpr int BM = 256, BK = 64, HALF = 128, HTB = HALF * BK * 2  , STAGE_BYTES = 8 * HTB, NXCD = 8, WGM = 8;

__host__ __device__ __forceinline__ int lds_byte(int r, int c) { const int st = (r >> 4) * 2 + (c >> 5), rr = r & 15, cc = c & 31, ob = rr * 64 + cc * 2; return st * 1024 + (ob ^ (((ob >> 9) & 1) << 5)); }
__host__ __device__ __forceinline__ void stage_rc(int b, int& R, int& C) { const int st = b / 1024, sb = b % 1024, swz = sb ^ (((sb >> 9) & 1) << 5); R = (st >> 1) * 16 + swz / 64; C = (st & 1) * 32 + (swz % 64) / 2; }
__host__ __device__ __forceinline__ int perm32(int rho) { const int n = rho >> 4, i = rho & 15; return 8 * (i >> 2) + 4 * n + (i & 3); }

struct Unit { int pm, pn; };
struct Gemm { const bf16_t* A; const bf16_t* Bt; int M, N, K; };

struct StaticOrder {
    int nM, nN, nwg, G, c;
    __host__ __device__ void init(int M, int N, int G_, int c_) { nM = M / BM; nN = N / BM; nwg = nM * nN; G = G_; c = c_; }
    __host__ __device__ bool next(int i, Unit& u) const {
        const long L = (long)i * G + c; if (L >= nwg) return false;
        int wgid = (int)L; { const int q = nwg / NXCD, r = nwg % NXCD, xcd = wgid % NXCD, off = wgid / NXCD; wgid = (xcd < r ? xcd * (q + 1) : r * (q + 1) + (xcd - r) * q) + off; }
        const int nig = WGM * nN, gid = wgid / nig, fm = gid * WGM, gsz = (nM - fm) < WGM ? (nM - fm) : WGM;
        u.pm = fm + ((wgid % nig) % gsz); u.pn = (wgid % nig) / gsz; return true;
    }
    __device__ __forceinline__ void a_ready(const Unit&) const {}
    __device__ __forceinline__ void done(const Unit&) const {}
};

__device__ __forceinline__ unsigned cvt_pk_bf16(float lo, float hi) { unsigned r; asm volatile("v_cvt_pk_bf16_f32 %0, %1, %2" : "=v"(r) : "v"(lo), "v"(hi)); return r; }
constexpr float RMS_EPS = 1e-6f;
struct EpiBf16S {
    static constexpr bool PERM = true, AFTER_DRAIN = false;
    bf16_t* O; int ldc; const float* ssq;
    __device__ __forceinline__ void operator()(const f32x4 (&acc)[2][2][4][2], const Unit& u, int wr, int wc, int fr, int fq) const {
        const int row0 = u.pm * BM + wr * 64 + fr; const int col0 = u.pn * BM + wc * 32 + 8 * fq;
#pragma unroll
        for (int ai = 0; ai < 2; ++ai)
#pragma unroll
            for (int m = 0; m < 4; ++m) { const int row = row0 + ai * HALF + m * 16; bf16_t* rowp = O + (size_t)row * ldc + col0;
                const float sc = ssq ? rsqrtf(ssq[row] * (1.0f / 1024.0f) + RMS_EPS) : 1.0f;
#pragma unroll
                for (int bj = 0; bj < 2; ++bj) { const f32x4 v0 = acc[ai][bj][m][0] * sc, v1 = acc[ai][bj][m][1] * sc;
                    u32x4 w; w.x = cvt_pk_bf16(v0[0], v0[1]); w.y = cvt_pk_bf16(v0[2], v0[3]); w.z = cvt_pk_bf16(v1[0], v1[1]); w.w = cvt_pk_bf16(v1[2], v1[3]);
                    *(u32x4*)(rowp + bj * HALF) = w; } }
    }
};
struct EpiResid {
    static constexpr bool PERM = false, AFTER_DRAIN = false;
    const float* base; float* out; bf16_t* xb; float* ssq; int ldc;
    __device__ __forceinline__ void operator()(const f32x4 (&acc)[2][2][4][2], const Unit& u, int wr, int wc, int fr, int fq) const {
        typedef unsigned u32x2v __attribute__((ext_vector_type(2)));
        const int col0 = u.pn * BM + wc * 32 + 4 * fq;
#pragma unroll
        for (int ai = 0; ai < 2; ++ai)
#pragma unroll
            for (int m = 0; m < 4; ++m) { const int row = u.pm * BM + ai * HALF + wr * 64 + m * 16 + fr; const size_t off = (size_t)row * ldc + col0; float s = 0.f;
#pragma unroll
                for (int bj = 0; bj < 2; ++bj)
#pragma unroll
                    for (int n = 0; n < 2; ++n) { const f32x4 v = acc[ai][bj][m][n] + *(const f32x4*)(base + off + bj * HALF + n * 16);
                        *(f32x4*)(out + off + bj * HALF + n * 16) = v; s += (v[0] * v[0] + v[1] * v[1]) + (v[2] * v[2] + v[3] * v[3]);
                        if (xb) { u32x2v w; w.x = cvt_pk_bf16(v[0], v[1]); w.y = cvt_pk_bf16(v[2], v[3]); *(u32x2v*)(xb + off + bj * HALF + n * 16) = w; } }
                if (ssq) { s += __shfl_xor(s, 16); s += __shfl_xor(s, 32); if (fq == 0) atomicAdd(ssq + row, s); }
                asm volatile("" ::: "memory"); }
    }
};
template <class Epi, class Sched, bool ALIGN_EPI = false, bool SP2 = false>
__device__ __forceinline__ void gemm_phase(PG8_LAS unsigned char* lds, const Gemm g, const Sched& S, const Epi& E) {
    const int tid = threadIdx.x, wid = __builtin_amdgcn_readfirstlane(tid >> 6), lane = tid & 63, wr = wid >> 2, wc = wid & 3, fr = lane & 15, fq = lane >> 4;
    const int K = g.K, nt = K / BK;
    unsigned voffA[2], voffB[2];
#pragma unroll
    for (int i = 0; i < 2; ++i) { int R, C; stage_rc(tid * 16 + i * 8192, R, C); const int Rb = Epi::PERM ? ((R & ~31) + perm32(R & 31)) : R;
        voffA[i] = (unsigned)(R * K + C) * 2u; voffB[i] = (unsigned)(Rb * K + C) * 2u; }
    const size_t kstep = (size_t)(BK * 2);
    const size_t hstep = (size_t)HALF * K * 2;
    const size_t tstep = 2 * hstep;
    const unsigned ldsw = (unsigned)wid * 1024u;
    const int aoff = lds_byte(wr * 64 + fr, fq * 8), boff = lds_byte(wc * 32 + fr, fq * 8);
#define PG8_SA(b, h) (((b) * 2 + (h)) * HTB)
#define PG8_SB(b, h) ((4 + (b) * 2 + (h)) * HTB)
#define PG8_STAGE(bufoff, gbase, voff) do { _Pragma("unroll") for (int _i = 0; _i < 2; ++_i) \
        __builtin_amdgcn_global_load_lds((const unsigned*)((const char*)(gbase) + (voff)[_i]), (PG8_LAS unsigned*)(lds + (bufoff) + ldsw + _i * 8192), 16, 0, 0); } while (0)
#define PG8_LDA(dst, b, h) do { _Pragma("unroll") for (int m = 0; m < 4; ++m) _Pragma("unroll") for (int k = 0; k < 2; ++k) dst[m][k] = *(const PG8_LAS bf16x8*)(lds + PG8_SA(b, h) + aoff + m * 2048 + k * 1024); } while (0)
#define PG8_LDB(dst, b, h) do { _Pragma("unroll") for (int n = 0; n < 2; ++n) _Pragma("unroll") for (int k = 0; k < 2; ++k) dst[n][k] = *(const PG8_LAS bf16x8*)(lds + PG8_SB(b, h) + boff + n * 2048 + k * 1024); } while (0)
#define PG8_MMA(ai, bj, At, Bt) do { __builtin_amdgcn_s_setprio(1); _Pragma("unroll") for (int m = 0; m < 4; ++m) _Pragma("unroll") for (int n = 0; n < 2; ++n) _Pragma("unroll") for (int k = 0; k < 2; ++k) \
        acc[ai][bj][m][n] = __builtin_amdgcn_mfma_f32_16x16x32_bf16(Bt[n][k], At[m][k], acc[ai][bj][m][n], 0, 0, 0); __builtin_amdgcn_s_setprio(0); } while (0)
#define PG8_WAIT_V(n) asm volatile("s_waitcnt vmcnt(" #n ")" ::: "memory")
#define PG8_WAIT_L(n) asm volatile("s_waitcnt lgkmcnt(" #n ")" ::: "memory")
#define PG8_BAR __builtin_amdgcn_s_barrier()
#define PG8_SCHED __builtin_amdgcn_sched_barrier(0)
    Unit cur, nxt; int ui = 0;
    if (!S.next(0, cur)) return;
    f32x4 acc[2][2][4][2];
#pragma unroll
    for (int a = 0; a < 2; ++a)
#pragma unroll
        for (int b = 0; b < 2; ++b)
#pragma unroll
            for (int m = 0; m < 4; ++m)
#pragma unroll
                for (int n = 0; n < 2; ++n) acc[a][b][m][n] = (f32x4){0.f, 0.f, 0.f, 0.f};
    bf16x8 At[4][2], B0[2][2], B1[2][2];
    const char* cA = (const char*)g.A + (size_t)cur.pm * tstep; const char* cB = (const char*)g.Bt + (size_t)cur.pn * tstep;
    S.a_ready(cur);
    if constexpr (SP2) {
        PG8_STAGE(PG8_SB(0, 0), cB, voffB); PG8_STAGE(PG8_SB(0, 1), cB + hstep, voffB); PG8_STAGE(PG8_SA(0, 0), cA, voffA); PG8_STAGE(PG8_SA(0, 1), cA + hstep, voffA);
        if (wr == 1) PG8_BAR;
        PG8_WAIT_V(2); PG8_BAR;
        PG8_STAGE(PG8_SB(1, 0), cB + kstep, voffB); PG8_STAGE(PG8_SA(1, 0), cA + kstep, voffA); PG8_STAGE(PG8_SB(1, 1), cB + hstep + kstep, voffB);
        PG8_WAIT_V(6); PG8_BAR;
    } else {
        PG8_STAGE(PG8_SB(0, 0), cB, voffB); PG8_STAGE(PG8_SA(0, 0), cA, voffA); PG8_STAGE(PG8_SB(0, 1), cB + hstep, voffB); PG8_STAGE(PG8_SA(0, 1), cA + hstep, voffA);
        if (wr == 1) PG8_BAR;
        PG8_WAIT_V(4); PG8_BAR;
        PG8_STAGE(PG8_SB(1, 0), cB + kstep, voffB); PG8_STAGE(PG8_SA(1, 0), cA + kstep, voffA); PG8_STAGE(PG8_SB(1, 1), cB + hstep + kstep, voffB);
        PG8_WAIT_V(6); PG8_BAR;
    }
    for (;;) {
        const bool has_next = S.next(ui + 1, nxt);
        const char* nA = has_next ? (const char*)g.A + (size_t)nxt.pm * tstep : cA; const char* nB = has_next ? (const char*)g.Bt + (size_t)nxt.pn * tstep : cB;
        for (int t = 0; t < nt; t += 2) {
            const bool last = (t == nt - 2);
            const char* a1 = cA + (size_t)(t + 1) * kstep;
            const char* a2 = last ? nA : cA + (size_t)(t + 2) * kstep; const char* b2 = last ? nB : cB + (size_t)(t + 2) * kstep;
            const char* a3 = a2 + kstep; const char* b3 = b2 + kstep;
            if (last && has_next) S.a_ready(nxt);
            if constexpr (SP2) {
            PG8_LDB(B0, 0, 0); PG8_LDB(B1, 0, 1); PG8_SCHED; PG8_LDA(At, 0, 0); PG8_STAGE(PG8_SA(1, 1), a1 + hstep, voffA);
            PG8_WAIT_V(8); PG8_WAIT_L(0); PG8_BAR; PG8_MMA(0, 0, At, B0); PG8_MMA(0, 1, At, B1); PG8_BAR; PG8_SCHED;
            PG8_LDA(At, 0, 1); PG8_STAGE(PG8_SB(0, 0), b2, voffB); PG8_STAGE(PG8_SB(0, 1), b2 + hstep, voffB); PG8_STAGE(PG8_SA(0, 0), a2, voffA);
            PG8_WAIT_V(8); PG8_WAIT_L(0); PG8_BAR; PG8_MMA(1, 0, At, B0); PG8_MMA(1, 1, At, B1); PG8_BAR; PG8_SCHED;
            PG8_LDB(B0, 1, 0); PG8_LDB(B1, 1, 1); PG8_SCHED; PG8_LDA(At, 1, 0); PG8_STAGE(PG8_SA(0, 1), a2 + hstep, voffA);
            PG8_WAIT_V(8); PG8_WAIT_L(0); PG8_BAR; PG8_MMA(0, 0, At, B0); PG8_MMA(0, 1, At, B1); PG8_BAR; PG8_SCHED;
            PG8_LDA(At, 1, 1); PG8_STAGE(PG8_SB(1, 0), b3, voffB); PG8_STAGE(PG8_SB(1, 1), b3 + hstep, voffB); PG8_STAGE(PG8_SA(1, 0), a3, voffA);
            PG8_WAIT_V(8); PG8_WAIT_L(0); PG8_BAR; PG8_MMA(1, 0, At, B0); PG8_MMA(1, 1, At, B1); PG8_BAR; PG8_SCHED;
            } else {
            PG8_LDB(B0, 0, 0); PG8_SCHED; PG8_LDA(At, 0, 0); PG8_STAGE(PG8_SA(1, 1), a1 + hstep, voffA);
            PG8_WAIT_L(8); PG8_BAR; PG8_WAIT_L(0); PG8_MMA(0, 0, At, B0); PG8_BAR; PG8_SCHED;
            PG8_LDB(B1, 0, 1); PG8_STAGE(PG8_SB(0, 0), b2, voffB);
            PG8_BAR; PG8_WAIT_L(0); PG8_MMA(0, 1, At, B1); PG8_BAR;
            PG8_LDA(At, 0, 1); PG8_STAGE(PG8_SA(0, 0), a2, voffA);
            PG8_BAR; PG8_WAIT_L(0); PG8_MMA(1, 0, At, B0); PG8_BAR; PG8_SCHED;
            PG8_STAGE(PG8_SB(0, 1), b2 + hstep, voffB);
            PG8_WAIT_V(6); PG8_BAR; PG8_MMA(1, 1, At, B1); PG8_BAR;
            PG8_LDB(B0, 1, 0); PG8_SCHED; PG8_LDA(At, 1, 0); PG8_STAGE(PG8_SA(0, 1), a2 + hstep, voffA);
            PG8_WAIT_L(8); PG8_BAR; PG8_WAIT_L(0); PG8_MMA(0, 0, At, B0); PG8_BAR; PG8_SCHED;
            PG8_LDB(B1, 1, 1); PG8_STAGE(PG8_SB(1, 0), b3, voffB);
            PG8_BAR; PG8_WAIT_L(0); PG8_MMA(0, 1, At, B1); PG8_BAR;
            PG8_LDA(At, 1, 1); PG8_STAGE(PG8_SA(1, 0), a3, voffA);
            PG8_BAR; PG8_WAIT_L(0); PG8_MMA(1, 0, At, B0); PG8_BAR; PG8_SCHED;
            PG8_STAGE(PG8_SB(1, 1), b3 + hstep, voffB);
            PG8_WAIT_V(6); PG8_BAR; PG8_MMA(1, 1, At, B1); PG8_BAR;
            }
        }
        if constexpr (ALIGN_EPI) { if (wr == 0) PG8_BAR; }
        if constexpr (!Epi::AFTER_DRAIN) { E(acc, cur, wr, wc, fr, fq); S.done(cur); }
        if (!has_next) break;
#pragma unroll
        for (int a = 0; a < 2; ++a)
#pragma unroll
            for (int b = 0; b < 2; ++b)
#pragma unroll
                for (int m = 0; m < 4; ++m)
#pragma unroll
                    for (int n = 0; n < 2; ++n) acc[a][b][m][n] = (f32x4){0.f, 0.f, 0.f, 0.f};
        cur = nxt; cA = nA; cB = nB; ++ui;
        if constexpr (ALIGN_EPI) { if (wr == 1) PG8_BAR; }
    }
    PG8_WAIT_V(0);
    if constexpr (!ALIGN_EPI) { if (wr == 0) PG8_BAR; }
    PG8_BAR;
    if constexpr (Epi::AFTER_DRAIN) { E.fused(acc, cur, wr, wc, fr, fq, lds, wid, lane); S.done(cur); }
#undef PG8_SA
#undef PG8_SB
#undef PG8_STAGE
#undef PG8_LDA
#undef PG8_LDB
#undef PG8_MMA
#undef PG8_WAIT_V
#undef PG8_WAIT_L
#undef PG8_BAR
#undef PG8_SCHED
}
}
#ifndef PG8_SP2
#define PG8_SP2 true
#endif
#ifndef PG8_ALIGN
#define PG8_ALIGN true
#endif
constexpr int NB = 8, SEQ = 2048, DM = 1024, M = NB * SEQ;
constexpr int GH = 4, GD = 128, GW = 512, AH = 8, AD = 64;
constexpr int INC = 3592, NP = 3584;
constexpr int DFF = 2816, NUP = 2 * DFF;
constexpr int PC_QA = 0, PC_KA = 512, PC_VA = 1024, PC_Z = 1536, PC_QB = 2048, PC_KB = 2560, PC_VB = 3072;
constexpr size_t MiB = 1u << 20;
constexpr size_t WS_CTL = 0, WS_AB = 1 * MiB, WS_SSQ = 1 * MiB + 768 * 1024, WS_WIN = 2 * MiB, WS_WOUT = 9 * MiB, WS_WUP = 11 * MiB, WS_WDN = 22 * MiB;
constexpr size_t WS_XN = 28 * MiB, WS_PROJ = 60 * MiB, WS_CAT = 172 * MiB, WS_OA = 204 * MiB, WS_Y = 60 * MiB, WS_ACT = 148 * MiB, WS_END = 256 * MiB;
using pg8::RMS_EPS;
constexpr size_t WS_GE = WS_SSQ + 65536;
constexpr int GOPS_CHUNK = 57344;
constexpr int NWAVES = 8, NTHR = 512;
constexpr int LDS_BYTES = 147456;
#define LAS __attribute__((address_space(3)))
typedef unsigned short bf16;
typedef unsigned v4u __attribute__((ext_vector_type(4)));
typedef unsigned v2u __attribute__((ext_vector_type(2)));
typedef float f32x4 __attribute__((ext_vector_type(4)));
__device__ __forceinline__ float bf2f(unsigned b) { return __uint_as_float(b << 16); }
__device__ __forceinline__ float bflo(unsigned w) { return __uint_as_float(w << 16); }
__device__ __forceinline__ float bfhi(unsigned w) { return __uint_as_float(w & 0xffff0000u); }
__device__ __forceinline__ unsigned pk2(float lo, float hi) { return pg8::cvt_pk_bf16(lo, hi); }
__device__ __forceinline__ float wave_sum(float v) {
#pragma unroll
    for (int o = 1; o < 64; o <<= 1) v += __shfl_xor(v, o);
    return v;
}
__device__ __forceinline__ float silu_f(float x) { return x / (1.0f + __expf(-x)); }
__device__ __forceinline__ float sigmoid_f(float x) { return 1.0f / (1.0f + __expf(-x)); }
__device__ __forceinline__ float softplus_f(float x) { return x > 20.f ? x : log1pf(__expf(x)); }

struct Args { const float* in[13]; float* out; unsigned char* ws; int ph_lo, ph_hi, coop, pad; };

__device__ __forceinline__ void p0_transpose_item(const float* W, int ldw, int k0, int sn0, bf16* WT, int K, int dn0, const float* kscale, LAS float* scr, int lane) {
#pragma unroll 8
    for (int i = 0; i < 32; ++i) { const int kk = 2 * i + (lane >> 5); float v = W[(size_t)(k0 + kk) * ldw + sn0 + (lane & 31)]; if (kscale) v *= kscale[k0 + kk]; scr[kk * 33 + (lane & 31)] = v; }
    asm volatile("s_waitcnt lgkmcnt(0)" ::: "memory");
    const int c = lane & 7;
#pragma unroll
    for (int j = 0; j < 4; ++j) { const int n = (lane >> 3) + 8 * j; const LAS float* s = scr + (8 * c) * 33 + n;
        v4u o; o.x = pk2(s[0 * 33], s[1 * 33]); o.y = pk2(s[2 * 33], s[3 * 33]); o.z = pk2(s[4 * 33], s[5 * 33]); o.w = pk2(s[6 * 33], s[7 * 33]);
        *(v4u*)(WT + (size_t)(dn0 + n) * K + k0 + 8 * c) = o; }
    asm volatile("s_waitcnt lgkmcnt(0)" ::: "memory");
}

__device__ __forceinline__ void p0_prologue(const Args& A, LAS unsigned char* lds, int tid, int lane, int wave) {
    const float* x = A.in[0]; const float* nw1 = A.in[1]; const float* w_in = A.in[2]; const float* w_out = A.in[7]; const float* nw2 = A.in[8];
    const float* w_up = A.in[9]; const float* w_dn = A.in[11];
    unsigned char* ws = A.ws;
    bf16* WIN = (bf16*)(ws + WS_WIN); bf16* WOUT = (bf16*)(ws + WS_WOUT); bf16* WUP = (bf16*)(ws + WS_WUP); bf16* WDN = (bf16*)(ws + WS_WDN);
    bf16* XN = (bf16*)(ws + WS_XN); float* AB = (float*)(ws + WS_AB); float* SSQ = (float*)(ws + WS_SSQ);
    LAS float* scr = (LAS float*)(lds + wave * 9216);
    LAS float* wab = (LAS float*)(lds + 73728);
    const int G = gridDim.x, gw = blockIdx.x * NWAVES + wave, NGW = G * NWAVES;
    for (int i = blockIdx.x * NTHR + tid; i < M; i += G * NTHR) SSQ[i] = 0.f;
    if (blockIdx.x == 0 && tid < 64) ((unsigned*)(ws + WS_CTL))[tid] = 0u;
    for (int idx = tid; idx < 8192; idx += NTHR) { const int k = idx >> 3, j = idx & 7; wab[j * 1024 + k] = nw1[k] * w_in[(size_t)k * INC + 2048 + j]; }
    constexpr int I_IN = 16 * (NP / 32), I_OUT = 16 * 32, I_UP = 16 * (NUP / 32), I_DN = (DFF / 64) * 32;
    constexpr int NITEMS = I_IN + I_OUT + I_UP + I_DN;
    for (int it = gw; it < NITEMS; it += NGW) {
        int r = it;
        if (r < I_IN) { const int nblk = NP / 32, kb = r / nblk, nb = r % nblk, n0 = 32 * nb; p0_transpose_item(w_in, INC, 64 * kb, n0 + (n0 >= 2048 ? 8 : 0), WIN, DM, n0, nullptr, scr, lane); continue; } r -= I_IN;
        if (r < I_OUT) { const int kb = r / 32, nb = r % 32; p0_transpose_item(w_out, DM, 64 * kb, 32 * nb, WOUT, DM, 32 * nb, nullptr, scr, lane); continue; } r -= I_OUT;
        if (r < I_UP) { const int nblk = NUP / 32, kb = r / nblk, nb = r % nblk, n0 = 32 * nb, pn = n0 >> 8, j0 = n0 & 255;
            const int s0 = (j0 < 128) ? (128 * pn + j0) : (DFF + 128 * pn + j0 - 128);
            p0_transpose_item(w_up, NUP, 64 * kb, s0, WUP, DM, n0, nw2, scr, lane); continue; } r -= I_UP;
        { const int kb = r / 32, nb = r % 32; p0_transpose_item(w_dn, DM, 64 * kb, 32 * nb, WDN, DFF, 32 * nb, nullptr, scr, lane); }
    }
    __syncthreads();
    for (int m = gw; m < M; m += NGW) {
        const f32x4* xr = (const f32x4*)(x + (size_t)m * DM) + lane; const f32x4* nr = (const f32x4*)nw1 + lane;
        f32x4 v[4]; float s = 0.f;
#pragma unroll
        for (int j = 0; j < 4; ++j) { v[j] = xr[64 * j]; s += (v[j].x * v[j].x + v[j].y * v[j].y) + (v[j].z * v[j].z + v[j].w * v[j].w); }
        const float rstd = rsqrtf(wave_sum(s) * (1.f / DM) + RMS_EPS);
        float ab[8];
#pragma unroll
        for (int q = 0; q < 8; ++q) { float a = 0.f;
#pragma unroll
            for (int j = 0; j < 4; ++j) { const f32x4 w = *(const LAS f32x4*)(wab + q * 1024 + 256 * j + 4 * lane); a += (v[j].x * w.x + v[j].y * w.y) + (v[j].z * w.z + v[j].w * w.w); }
            ab[q] = wave_sum(a) * rstd; }
        if (lane == 0) { *(f32x4*)(AB + (size_t)m * 8) = (f32x4){ab[0], ab[1], ab[2], ab[3]}; *(f32x4*)(AB + (size_t)m * 8 + 4) = (f32x4){ab[4], ab[5], ab[6], ab[7]}; }
        v2u* o8 = (v2u*)(XN + (size_t)m * DM) + lane;
#pragma unroll
        for (int j = 0; j < 4; ++j) { const f32x4 n = nr[64 * j]; v2u o; o.x = pk2(v[j].x * rstd * n.x, v[j].y * rstd * n.y); o.y = pk2(v[j].z * rstd * n.z, v[j].w * rstd * n.w); o8[64 * j] = o; }
    }
}

__device__ __forceinline__ void gdn_simple(const Args& A, LAS unsigned char* lds, int tid, int lane, int wave) {
    const bf16* PROJ = (const bf16*)(A.ws + WS_PROJ); const float* AB = (const float*)(A.ws + WS_AB); float* OA = (float*)(A.ws + WS_OA);
    const float* cw = A.in[3]; const float* a_log = A.in[4]; const float* dt_bias = A.in[5];
    LAS float* qs = (LAS float*)lds; LAS float* ks = qs + 16 * 128; LAS float* vs = ks + 16 * 128; LAS float* av = vs + 16 * 128; LAS float* bv = av + 16;
    for (int task = blockIdx.x; task < NB * GH; task += gridDim.x) {
        const int b = task / GH, h = task % GH, v = tid >> 2, part = tid & 3;
        float S[32];
#pragma unroll
        for (int i = 0; i < 32; ++i) S[i] = 0.f;
        const float Ah = __expf(a_log[h]), dtb = dt_bias[h];
        for (int blk = 0; blk < SEQ / 16; ++blk) {
            const int t0 = blk * 16;
            for (int idx = tid; idx < 16 * 384; idx += NTHR) {
                const int tt = idx / 384, c = idx % 384, which = c >> 7, d = c & 127, col = which * 512 + h * 128 + d, t = t0 + tt;
                float acc = 0.f;
#pragma unroll
                for (int i = 0; i < 4; ++i) { const int ts = t - 3 + i; if (ts >= 0) acc += cw[i * 1536 + col] * bf2f(PROJ[(size_t)(b * SEQ + ts) * NP + col]); }
                qs[which * 2048 + tt * 128 + d] = silu_f(acc);
            }
            if (tid < 16) { const size_t row = (size_t)b * SEQ + t0 + tid; bv[tid] = sigmoid_f(AB[row * 8 + h]); av[tid] = __expf(-Ah * softplus_f(AB[row * 8 + 4 + h] + dtb)); }
            __syncthreads();
#pragma unroll
            for (int r = 0; r < 4; ++r) { const int row = 4 * wave + r; LAS float* arr = qs + row * 128;
                const float v0 = arr[lane], v1 = arr[lane + 64]; const float s = wave_sum(v0 * v0 + v1 * v1);
                const float sc = rsqrtf(s + RMS_EPS) * (row < 16 ? 0.08838834764831845f : 1.0f); arr[lane] = v0 * sc; arr[lane + 64] = v1 * sc; }
            __syncthreads();
            for (int tt = 0; tt < 16; ++tt) {
                const float a = av[tt], bt = bv[tt], vt = vs[tt * 128 + v];
                float kS = 0.f;
#pragma unroll
                for (int i = 0; i < 32; ++i) kS += ks[tt * 128 + 32 * part + i] * S[i];
                kS += __shfl_xor(kS, 1); kS += __shfl_xor(kS, 2);
                const float c = bt * (vt - a * kS); float o = 0.f;
#pragma unroll
                for (int i = 0; i < 32; ++i) { S[i] = a * S[i] + ks[tt * 128 + 32 * part + i] * c; o += qs[tt * 128 + 32 * part + i] * S[i]; }
                o += __shfl_xor(o, 1); o += __shfl_xor(o, 2);
                if (part == 0) OA[(size_t)(b * SEQ + t0 + tt) * GW + h * 128 + v] = o;
            }
            __syncthreads();
        }
    }
}


template <int J, int K, int N> struct SolveLd {
    static __device__ __forceinline__ void run(f32x4 (&l)[16], unsigned lbase) {
        if constexpr (K < N) { constexpr int t40 = ((J + 1) >> 2) << 2;
            asm volatile("ds_read_b128 %0, %1 offset:%2" : "=v"(l[K]) : "v"(lbase), "i"((J * 68 + t40 + 4 * K) * 4)); SolveLd<J, K + 1, N>::run(l, lbase); }
    }
};
template <int J> struct SolveCol {
    static __device__ __forceinline__ void run(float (&R)[64], unsigned lbase) {
        if constexpr (J < 63) {
            constexpr int t40 = ((J + 1) >> 2) << 2, nld = (64 - t40) >> 2;
            f32x4 l[16];
            SolveLd<J, 0, nld>::run(l, lbase);
            asm volatile("s_waitcnt lgkmcnt(0)" ::: "memory");
#pragma unroll
            for (int k = 0; k < nld; ++k) asm volatile("" : "+v"(l[k]));
#pragma unroll
            for (int k = 0; k < nld; ++k) {
#pragma unroll
                for (int e = 0; e < 4; ++e) if (t40 + 4 * k + e > J) R[t40 + 4 * k + e] -= l[k][e] * R[J]; }
            SolveCol<J + 1>::run(R, lbase);
        }
    }
};

typedef short bf16x8 __attribute__((ext_vector_type(8)));
__device__ __forceinline__ void gdn_prep(const Args& A, LAS unsigned char* lds, int tid0, int lane0, int wave) {
    const bf16* PROJ = (const bf16*)(A.ws + WS_PROJ); const float* AB = (const float*)(A.ws + WS_AB);
    const float* cw = A.in[3]; const float* a_log = A.in[4]; const float* dt_bias = A.in[5];
    float* UV = (float*)(A.ws + WS_XN); unsigned char* GOPS = (unsigned char*)A.out; float* GE = (float*)(A.ws + WS_GE);
    LAS float* Qs = (LAS float*)lds; LAS float* Ks = (LAS float*)(lds + 33792); LAS float* Vs = (LAS float*)(lds + 67584);
    LAS bf16* Qb = (LAS bf16*)(lds + 101376); LAS bf16* Kb = (LAS bf16*)(lds + 118784);
    LAS float* gcs = (LAS float*)(lds + 136192); LAS float* bts = gcs + 64; LAS float* egs = gcs + 128; LAS float* kes = gcs + 192;
    LAS float* LsT = (LAS float*)lds; LAS bf16* ATs = (LAS bf16*)(lds + 17408); LAS bf16* WKs = Kb;
#pragma unroll 1
    for (int task = blockIdx.x; task < NB * GH * 32; task += gridDim.x) {
        int tid = tid0, lane = lane0; asm volatile("" : "+v"(tid), "+v"(lane));
        const int fr = lane & 15, fq = lane >> 4;
        const int bh = task >> 5, n = task & 31, b = bh >> 2, h = bh & 3, t0 = 64 * n, row0 = b * SEQ + t0;
        unsigned char* gops = GOPS + (size_t)task * GOPS_CHUNK;
        for (int idx = tid; idx < 3072; idx += NTHR) {
            const int tt = idx / 48, c8 = idx % 48, which = c8 >> 4, d0 = (c8 & 15) * 8, col = which * 512 + h * 128 + d0;
            float acc[8];
#pragma unroll
            for (int e = 0; e < 8; ++e) acc[e] = 0.f;
#pragma unroll
            for (int i = 0; i < 4; ++i) { const int ts = t0 + tt - 3 + i; if (ts < 0) continue;
                const v4u w = *(const v4u*)(PROJ + (size_t)(b * SEQ + ts) * NP + col); const f32x4 c0 = *(const f32x4*)(cw + i * 1536 + col), c1 = *(const f32x4*)(cw + i * 1536 + col + 4);
                acc[0] += c0.x * bflo(w.x); acc[1] += c0.y * bfhi(w.x); acc[2] += c0.z * bflo(w.y); acc[3] += c0.w * bfhi(w.y);
                acc[4] += c1.x * bflo(w.z); acc[5] += c1.y * bfhi(w.z); acc[6] += c1.z * bflo(w.w); acc[7] += c1.w * bfhi(w.w); }
            LAS float* dst = (which == 0 ? Qs : (which == 1 ? Ks : Vs)) + tt * 132 + d0;
            *(LAS f32x4*)dst = (f32x4){silu_f(acc[0]), silu_f(acc[1]), silu_f(acc[2]), silu_f(acc[3])};
            *(LAS f32x4*)(dst + 4) = (f32x4){silu_f(acc[4]), silu_f(acc[5]), silu_f(acc[6]), silu_f(acc[7])};
        }
        if (wave == 0) {
            const size_t row = (size_t)row0 + lane; const float beta = sigmoid_f(AB[row * 8 + h]);
            float g = -__expf(a_log[h]) * softplus_f(AB[row * 8 + 4 + h] + dt_bias[h]);
#pragma unroll
            for (int o = 1; o < 64; o <<= 1) { const float t = __shfl_up(g, o); if (lane >= o) g += t; }
            const float glast = __shfl(g, 63);
            gcs[lane] = g; bts[lane] = beta; egs[lane] = __expf(g); kes[lane] = __expf(glast - g) * beta;
            if (lane == 63) GE[task] = __expf(g);
        }
        __syncthreads();
#pragma unroll 2
        for (int r = 0; r < 8; ++r) { const int row = 8 * wave + r;
            { const float v0 = Qs[row * 132 + lane], v1 = Qs[row * 132 + lane + 64]; const float sc = rsqrtf(wave_sum(v0 * v0 + v1 * v1) + RMS_EPS) * 0.08838834764831845f;
              Qb[row * 136 + lane] = (bf16)(pk2(v0 * sc, 0.f) & 0xffffu); Qb[row * 136 + lane + 64] = (bf16)(pk2(v1 * sc, 0.f) & 0xffffu); }
            { const float v0 = Ks[row * 132 + lane], v1 = Ks[row * 132 + lane + 64]; const float sc = rsqrtf(wave_sum(v0 * v0 + v1 * v1) + RMS_EPS);
              Ks[row * 132 + lane] = v0 * sc; Ks[row * 132 + lane + 64] = v1 * sc; Kb[row * 136 + lane] = (bf16)(pk2(v0 * sc, 0.f) & 0xffffu); Kb[row * 136 + lane + 64] = (bf16)(pk2(v1 * sc, 0.f) & 0xffffu); }
        }
        __syncthreads();
#pragma unroll 1
        for (int jb = wave; jb < 20; jb += 8) {
            const int kind = jb >= 10 ? 1 : 0, idx = jb - 10 * kind, ti = idx < 1 ? 0 : (idx < 3 ? 1 : (idx < 6 ? 2 : 3)), tj = idx - ti * (ti + 1) / 2;
            const LAS bf16* As = kind ? Qb : Kb; f32x4 d = (f32x4){0.f, 0.f, 0.f, 0.f};
#pragma unroll
            for (int ks = 0; ks < 4; ++ks) { const bf16x8 a = *(const LAS bf16x8*)(As + (16 * ti + fr) * 136 + 32 * ks + 8 * fq), bb = *(const LAS bf16x8*)(Kb + (16 * tj + fr) * 136 + 32 * ks + 8 * fq);
                d = __builtin_amdgcn_mfma_f32_16x16x32_bf16(a, bb, d, 0, 0, 0); }
            const int j = 16 * tj + fr; const float gj = gcs[j], bj = bts[j]; float val[4];
#pragma unroll
            for (int e = 0; e < 4; ++e) { const int t = 16 * ti + 4 * fq + e; const float x = d[e] * __expf(gcs[t] - gj) * bj; val[e] = (kind ? (t >= j) : (t > j)) ? x : 0.f; }
            if (kind == 0) *(LAS f32x4*)(LsT + j * 68 + 16 * ti + 4 * fq) = (f32x4){val[0], val[1], val[2], val[3]};
            else {
#pragma unroll
                for (int e = 0; e < 4; ++e) ATs[(16 * ti + 4 * fq + e) * 72 + j] = (bf16)(pk2(val[e], 0.f) & 0xffffu); }
        }
        __syncthreads();
        float R[64];
        if (wave < 4) {
            if (wave < 2) {
#pragma unroll
                for (int t = 0; t < 64; ++t) R[t] = Vs[t * 132 + 64 * wave + lane];
            } else {
#pragma unroll
                for (int t = 0; t < 64; ++t) R[t] = egs[t] * Ks[t * 132 + 64 * (wave - 2) + lane];
            }
            SolveCol<0>::run(R, (unsigned)(uintptr_t)LsT);
            if (wave < 2) {
                float* uvp = UV + (size_t)task * 64 * 128 + 64 * wave + lane; asm volatile("" : "+v"(uvp));
#pragma unroll
                for (int t = 0; t < 64; ++t) { uvp[t * 128] = R[t]; if ((t & 7) == 7) asm volatile("" : "+v"(uvp)); }
            } else {
#pragma unroll
                for (int t = 0; t < 64; ++t) WKs[t * 136 + 64 * (wave - 2) + lane] = (bf16)(pk2(R[t], 0.f) & 0xffffu);
            }
        } else {
            const int rt = tid - 256;
            for (int q = rt; q < 1024; q += 256) { const int blk = q >> 6, l2 = q & 63, i = l2 & 15, f = l2 >> 4, mb = blk >> 2, ks = blk & 3, t = 16 * mb + i;
                const v2u p0 = *(const LAS v2u*)(Qb + t * 136 + 32 * ks + 4 * f), p1 = *(const LAS v2u*)(Qb + t * 136 + 32 * ks + 16 + 4 * f); const float e = egs[t];
                v4u o; o.x = pk2(bflo(p0.x) * e, bfhi(p0.x) * e); o.y = pk2(bflo(p0.y) * e, bfhi(p0.y) * e); o.z = pk2(bflo(p1.x) * e, bfhi(p1.x) * e); o.w = pk2(bflo(p1.y) * e, bfhi(p1.y) * e);
                *(v4u*)(gops + 16384 + q * 16) = o; }
            for (int q = rt; q < 512; q += 256) { const int blk = q >> 6, l2 = q & 63, i = l2 & 15, f = l2 >> 4, mb = blk >> 1, ks2 = blk & 1, t = 16 * mb + i;
                v2u p0 = (v2u){0u, 0u}, p1 = (v2u){0u, 0u};
                if (2 * ks2 <= mb) p0 = *(const LAS v2u*)(ATs + t * 72 + 32 * ks2 + 4 * f);
                if (2 * ks2 + 1 <= mb) p1 = *(const LAS v2u*)(ATs + t * 72 + 32 * ks2 + 16 + 4 * f);
                *(v4u*)(gops + 32768 + q * 16) = (v4u){p0.x, p0.y, p1.x, p1.y}; }
            for (int q = rt; q < 1024; q += 256) { const int blk = q >> 6, l2 = q & 63, i = l2 & 15, f = l2 >> 4, dkb = blk >> 1, ks2 = blk & 1, dk = 16 * dkb + i; float v[8];
#pragma unroll
                for (int e = 0; e < 8; ++e) { const int c = 32 * ks2 + 16 * (e >> 2) + 4 * f + (e & 3); v[e] = Ks[c * 132 + dk] * kes[c]; }
                *(v4u*)(gops + 40960 + q * 16) = (v4u){pk2(v[0], v[1]), pk2(v[2], v[3]), pk2(v[4], v[5]), pk2(v[6], v[7])}; }
        }
        __syncthreads();
        for (int q = tid; q < 1024; q += NTHR) { const int blk = q >> 6, l2 = q & 63, i = l2 & 15, f = l2 >> 4, mb = blk >> 2, ks = blk & 3, t = 16 * mb + i;
            const v2u p0 = *(const LAS v2u*)(WKs + t * 136 + 32 * ks + 4 * f), p1 = *(const LAS v2u*)(WKs + t * 136 + 32 * ks + 16 + 4 * f);
            *(v4u*)(gops + q * 16) = (v4u){p0.x, p0.y, p1.x, p1.y}; }
        __syncthreads();
    }
}

__device__ __forceinline__ bf16x8 pack8(const f32x4 a, const f32x4 b) {
    v4u w; w.x = pk2(a[0], a[1]); w.y = pk2(a[2], a[3]); w.z = pk2(b[0], b[1]); w.w = pk2(b[2], b[3]); return __builtin_bit_cast(bf16x8, w);
}
__device__ __forceinline__ void gdn_scan(const Args& A, LAS unsigned char* lds, int bh, int tid, int lane, int wave) {
    const int b = bh >> 2, h = bh & 3, fr = lane & 15, fq = lane >> 4, vs = wave;
    const unsigned char* gops = (const unsigned char*)A.out + (size_t)bh * 32 * GOPS_CHUNK;
    const float* UV = (const float*)(A.ws + WS_XN) + (size_t)bh * 32 * 64 * 128; const float* GE = (const float*)(A.ws + WS_GE) + bh * 32;
    const bf16* PROJ = (const bf16*)(A.ws + WS_PROJ); bf16* CAT = (bf16*)(A.ws + WS_CAT);
    LAS float* ssqp = (LAS float*)(lds + 2 * GOPS_CHUNK);
    const float gwv = A.in[6][16 * vs + fr];
    f32x4 S[8];
#pragma unroll
    for (int i = 0; i < 8; ++i) S[i] = (f32x4){0.f, 0.f, 0.f, 0.f};
    float uvc[16], uvn[16];
#define SCAN_DMA(chunk, bufoff) do { for (int p_ = wave; p_ < 56; p_ += 8) __builtin_amdgcn_global_load_lds((const unsigned*)(gops + (size_t)(chunk) * GOPS_CHUNK + p_ * 1024 + lane * 16), (LAS unsigned*)(lds + (bufoff) + p_ * 1024), 16, 0, 0); } while (0)
    SCAN_DMA(0, 0);
#pragma unroll
    for (int i = 0; i < 16; ++i) uvc[i] = UV[(size_t)(16 * (i >> 2) + 4 * fq + (i & 3)) * 128 + 16 * vs + fr];
    asm volatile("s_waitcnt vmcnt(0)" ::: "memory"); __syncthreads();
#pragma unroll 1
    for (int n = 0; n < 32; ++n) {
        const LAS unsigned char* cur = lds + (n & 1) * GOPS_CHUNK;
        if (n + 1 < 32) { SCAN_DMA(n + 1, ((n + 1) & 1) * GOPS_CHUNK);
#pragma unroll
            for (int i = 0; i < 16; ++i) uvn[i] = UV[((size_t)(n + 1) * 64 + 16 * (i >> 2) + 4 * fq + (i & 3)) * 128 + 16 * vs + fr]; }
        const size_t row0 = (size_t)b * SEQ + 64 * n;
        unsigned short zr[16];
#pragma unroll
        for (int i = 0; i < 16; ++i) zr[i] = PROJ[(row0 + 16 * (i >> 2) + 4 * fq + (i & 3)) * NP + PC_Z + h * 128 + 16 * vs + fr];
        const float ge = GE[n];
        bf16x8 Sb[4];
#pragma unroll
        for (int ks = 0; ks < 4; ++ks) Sb[ks] = pack8(S[2 * ks], S[2 * ks + 1]);
        f32x4 u[4];
#pragma unroll
        for (int mb = 0; mb < 4; ++mb) { f32x4 p = (f32x4){0.f, 0.f, 0.f, 0.f};
#pragma unroll
            for (int ks = 0; ks < 4; ++ks) p = __builtin_amdgcn_mfma_f32_16x16x32_bf16(*(const LAS bf16x8*)(cur + ((mb * 4 + ks) * 64 + lane) * 16), Sb[ks], p, 0, 0, 0);
            u[mb] = (f32x4){uvc[4 * mb] - p[0], uvc[4 * mb + 1] - p[1], uvc[4 * mb + 2] - p[2], uvc[4 * mb + 3] - p[3]}; }
        bf16x8 ub[2]; ub[0] = pack8(u[0], u[1]); ub[1] = pack8(u[2], u[3]);
        f32x4 o[4];
#pragma unroll
        for (int mb = 0; mb < 4; ++mb) { f32x4 acc = (f32x4){0.f, 0.f, 0.f, 0.f};
#pragma unroll
            for (int ks = 0; ks < 4; ++ks) acc = __builtin_amdgcn_mfma_f32_16x16x32_bf16(*(const LAS bf16x8*)(cur + 16384 + ((mb * 4 + ks) * 64 + lane) * 16), Sb[ks], acc, 0, 0, 0);
#pragma unroll
            for (int ks2 = 0; ks2 < 2; ++ks2) if (ks2 <= (mb >> 1)) acc = __builtin_amdgcn_mfma_f32_16x16x32_bf16(*(const LAS bf16x8*)(cur + 32768 + ((mb * 2 + ks2) * 64 + lane) * 16), ub[ks2], acc, 0, 0, 0);
            o[mb] = acc; }
#pragma unroll
        for (int dkb = 0; dkb < 8; ++dkb) { f32x4 acc = S[dkb] * ge;
#pragma unroll
            for (int ks2 = 0; ks2 < 2; ++ks2) acc = __builtin_amdgcn_mfma_f32_16x16x32_bf16(*(const LAS bf16x8*)(cur + 40960 + ((dkb * 2 + ks2) * 64 + lane) * 16), ub[ks2], acc, 0, 0, 0);
            S[dkb] = acc; }
#pragma unroll
        for (int i = 0; i < 16; ++i) { float s = o[i >> 2][i & 3]; s *= s; s += __shfl_xor(s, 1); s += __shfl_xor(s, 2); s += __shfl_xor(s, 4); s += __shfl_xor(s, 8);
            if (fr == 0) ssqp[(16 * (i >> 2) + 4 * fq + (i & 3)) * 8 + wave] = s; }
        __syncthreads();
#pragma unroll
        for (int i = 0; i < 16; ++i) { const int t = 16 * (i >> 2) + 4 * fq + (i & 3); const f32x4 p0 = *(const LAS f32x4*)(ssqp + t * 8), p1 = *(const LAS f32x4*)(ssqp + t * 8 + 4);
            const float ms = ((p0.x + p0.y) + (p0.z + p0.w) + (p1.x + p1.y) + (p1.z + p1.w)) * (1.0f / 128.0f), r = rsqrtf(ms + RMS_EPS);
            const float y = o[i >> 2][i & 3] * r * gwv * silu_f(bf2f(zr[i]));
            CAT[(row0 + t) * DM + h * 128 + 16 * vs + fr] = (bf16)(pk2(y, 0.f) & 0xffffu); }
#pragma unroll
        for (int i = 0; i < 16; ++i) uvc[i] = uvn[i];
        asm volatile("s_waitcnt vmcnt(0)" ::: "memory"); __syncthreads();
    }
#undef SCAN_DMA
}


__device__ __forceinline__ void attn_fast(const Args& A, LAS unsigned char* lds, int lane, int wave) {
    const bf16* PROJ = (const bf16*)(A.ws + WS_PROJ); bf16* CAT = (bf16*)(A.ws + WS_CAT);
    unsigned* ctr = (unsigned*)(A.ws + WS_CTL);
    LAS bf16* Vt = (LAS bf16*)(lds + wave * 8192);
    const int fr = lane & 15, fq = lane >> 4;
    const int kk = lane & 31, vslot = 8 * ((kk & 15) >> 2) + 4 * (kk >> 4) + (kk & 3), vch = lane >> 5;
    constexpr float SC = 0.125f * 1.4426950408889634f;
    for (;;) {
        unsigned wt_ = 0; if (lane == 0) wt_ = atomicAdd(ctr, 1u); const int wt = __builtin_amdgcn_readfirstlane(wt_);
        if (wt >= NB * AH * 8 * 16) break;
        const int T = 7 - (wt >> 10), rem = wt & 1023, b = rem >> 7, h = (rem >> 4) & 7, c = rem & 15, t0 = 256 * T;
        const bf16* Pb = PROJ + (size_t)b * SEQ * NP;
        const int tq = t0 + c + 16 * fr;
        bf16x8 qf[2];
#pragma unroll
        for (int ks = 0; ks < 2; ++ks) qf[ks] = *(const bf16x8*)(Pb + (size_t)tq * NP + PC_QB + h * 64 + 32 * ks + 8 * fq);
        const int lo2 = c, n2 = ((t0 + 240) >> 4) + 1, g2 = (n2 + 31) >> 5;
        const int lo1 = max(t0 + c - 512, c & 3), n1 = ((t0 + c + 240 - lo1) >> 2) + 1, g1 = (n1 + 31) >> 5;
        const int lo0 = max(t0 + c - 128, 0), n0 = (t0 + c + 240 - lo0) + 1, g0 = (n0 + 31) >> 5;
        const int NG = g2 + g1 + g0;
        f32x4 O[4];
#pragma unroll
        for (int i = 0; i < 4; ++i) O[i] = (f32x4){0.f, 0.f, 0.f, 0.f};
        float mrun = -INFINITY, lrun = 0.f;
        v4u kc[4], vc[4], kn[4], vn[4];
#define ATT_DEC(f, kst, str) do { if ((f) < g2) { str = 16; kst = lo2 + 512 * (f); } else if ((f) < g2 + g1) { str = 4; kst = lo1 + 128 * ((f) - g2); } else { str = 1; kst = lo0 + 32 * ((f) - g2 - g1); } } while (0)
#define ATT_LOAD(kreg, vreg, kst, str) do { \
            _Pragma("unroll") for (int j = 0; j < 2; ++j) { const int tk = min((kst) + (str) * (16 * j + fr), SEQ - 1); \
                _Pragma("unroll") for (int ks = 0; ks < 2; ++ks) kreg[2 * j + ks] = *(const v4u*)(Pb + (size_t)tk * NP + PC_KB + h * 64 + 32 * ks + 8 * fq); } \
            { const int tk = min((kst) + (str) * kk, SEQ - 1); \
                _Pragma("unroll") for (int i = 0; i < 4; ++i) vreg[i] = *(const v4u*)(Pb + (size_t)tk * NP + PC_VB + h * 64 + 8 * (vch + 2 * i)); } } while (0)
        int kst, str; ATT_DEC(0, kst, str); ATT_LOAD(kc, vc, kst, str);
#pragma unroll 1
        for (int f = 0; f < NG; ++f) {
            int kstn = 0, strn = 1;
            if (f + 1 < NG) { ATT_DEC(f + 1, kstn, strn); ATT_LOAD(kn, vn, kstn, strn); }
            f32x4 d0 = (f32x4){0.f, 0.f, 0.f, 0.f}, d1 = d0;
#pragma unroll
            for (int ks = 0; ks < 2; ++ks) { d0 = __builtin_amdgcn_mfma_f32_16x16x32_bf16(__builtin_bit_cast(bf16x8, kc[ks]), qf[ks], d0, 0, 0, 0);
                                             d1 = __builtin_amdgcn_mfma_f32_16x16x32_bf16(__builtin_bit_cast(bf16x8, kc[2 + ks]), qf[ks], d1, 0, 0, 0); }
#pragma unroll
            for (int i = 0; i < 4; ++i) { const int dd = 8 * (vch + 2 * i); const v4u w = vc[i];
                Vt[(dd + 0) * 40 + vslot] = (bf16)(w.x & 0xffffu); Vt[(dd + 1) * 40 + vslot] = (bf16)(w.x >> 16); Vt[(dd + 2) * 40 + vslot] = (bf16)(w.y & 0xffffu); Vt[(dd + 3) * 40 + vslot] = (bf16)(w.y >> 16);
                Vt[(dd + 4) * 40 + vslot] = (bf16)(w.z & 0xffffu); Vt[(dd + 5) * 40 + vslot] = (bf16)(w.z >> 16); Vt[(dd + 6) * 40 + vslot] = (bf16)(w.w & 0xffffu); Vt[(dd + 7) * 40 + vslot] = (bf16)(w.w >> 16); }
            float s[8]; const int span = 128 * str; float mloc = -INFINITY;
#pragma unroll
            for (int e = 0; e < 8; ++e) { const int tk = kst + str * (16 * (e >> 2) + 4 * fq + (e & 3)); const int dt = tq - tk; const float x = (e < 4 ? d0[e & 3] : d1[e & 3]) * SC;
                s[e] = (dt >= 0 && dt <= span) ? x : -INFINITY; mloc = fmaxf(mloc, s[e]); }
            mloc = fmaxf(mloc, __shfl_xor(mloc, 16)); mloc = fmaxf(mloc, __shfl_xor(mloc, 32));
            const float mnew = fmaxf(mrun, mloc), alpha = __builtin_amdgcn_exp2f(mrun - mnew); mrun = mnew;
            float psum = 0.f;
#pragma unroll
            for (int e = 0; e < 8; ++e) { s[e] = __builtin_amdgcn_exp2f(s[e] - mnew); psum += s[e]; }
            lrun = lrun * alpha + psum;
            const bf16x8 pb = pack8((f32x4){s[0], s[1], s[2], s[3]}, (f32x4){s[4], s[5], s[6], s[7]});
#pragma unroll
            for (int db = 0; db < 4; ++db) { const bf16x8 a = *(const LAS bf16x8*)(Vt + (16 * db + fr) * 40 + 8 * fq);
                O[db] = __builtin_amdgcn_mfma_f32_16x16x32_bf16(a, pb, O[db] * alpha, 0, 0, 0); }
#pragma unroll
            for (int i = 0; i < 4; ++i) { kc[i] = kn[i]; vc[i] = vn[i]; }
            kst = kstn; str = strn;
        }
#undef ATT_DEC
#undef ATT_LOAD
        lrun += __shfl_xor(lrun, 16); lrun += __shfl_xor(lrun, 32);
        const float inv = 1.0f / lrun;
        bf16* op = CAT + ((size_t)b * SEQ + tq) * DM + GW + h * 64 + 4 * fq;
#pragma unroll
        for (int db = 0; db < 4; ++db) { v2u w; w.x = pk2(O[db][0] * inv, O[db][1] * inv); w.y = pk2(O[db][2] * inv, O[db][3] * inv); *(v2u*)(op + 16 * db) = w; }
    }
}

__device__ __forceinline__ void attn_simple(const Args& A, int tid, int lane, int wave) {
    const bf16* PROJ = (const bf16*)(A.ws + WS_PROJ); bf16* CAT = (bf16*)(A.ws + WS_CAT);
    unsigned* ctr = (unsigned*)(A.ws + WS_CTL);
    for (;;) {
        unsigned wt_ = 0; if (lane == 0) wt_ = atomicAdd(ctr, 1u); const int wt = __builtin_amdgcn_readfirstlane(wt_);
        if (wt >= (M / 64) * AH) break;
        const int h = wt % AH, tb = wt / AH, row = tb * 64 + lane, b = row / SEQ, t = row % SEQ;
        float q[64], acc[64];
        { const v4u* qp = (const v4u*)(PROJ + (size_t)row * NP + PC_QB + h * 64);
#pragma unroll
          for (int j = 0; j < 8; ++j) { const v4u w = qp[j]; q[8 * j + 0] = bflo(w.x) * 0.125f; q[8 * j + 1] = bfhi(w.x) * 0.125f; q[8 * j + 2] = bflo(w.y) * 0.125f; q[8 * j + 3] = bfhi(w.y) * 0.125f;
              q[8 * j + 4] = bflo(w.z) * 0.125f; q[8 * j + 5] = bfhi(w.z) * 0.125f; q[8 * j + 6] = bflo(w.w) * 0.125f; q[8 * j + 7] = bfhi(w.w) * 0.125f; } }
#pragma unroll
        for (int j = 0; j < 64; ++j) acc[j] = 0.f;
        float mx = -1e30f, l = 0.f;
        for (int br = 0; br < 3; ++br) {
            const int stride = br == 0 ? 1 : (br == 1 ? 4 : 16);
            for (int i = 0; i <= 128; ++i) {
                const int tk = t - i * stride; if (tk < 0) break;
                const size_t krow = (size_t)(b * SEQ + tk) * NP;
                const v4u* kp = (const v4u*)(PROJ + krow + PC_KB + h * 64); const v4u* vp = (const v4u*)(PROJ + krow + PC_VB + h * 64);
                float s = 0.f;
#pragma unroll
                for (int j = 0; j < 8; ++j) { const v4u w = kp[j]; s += q[8 * j + 0] * bflo(w.x) + q[8 * j + 1] * bfhi(w.x) + q[8 * j + 2] * bflo(w.y) + q[8 * j + 3] * bfhi(w.y)
                                                                       + q[8 * j + 4] * bflo(w.z) + q[8 * j + 5] * bfhi(w.z) + q[8 * j + 6] * bflo(w.w) + q[8 * j + 7] * bfhi(w.w); }
                const float mn = fmaxf(mx, s), sc = __expf(mx - mn), p = __expf(s - mn); mx = mn; l = l * sc + p;
#pragma unroll
                for (int j = 0; j < 8; ++j) { const v4u w = vp[j];
                    acc[8 * j + 0] = acc[8 * j + 0] * sc + p * bflo(w.x); acc[8 * j + 1] = acc[8 * j + 1] * sc + p * bfhi(w.x); acc[8 * j + 2] = acc[8 * j + 2] * sc + p * bflo(w.y); acc[8 * j + 3] = acc[8 * j + 3] * sc + p * bfhi(w.y);
                    acc[8 * j + 4] = acc[8 * j + 4] * sc + p * bflo(w.z); acc[8 * j + 5] = acc[8 * j + 5] * sc + p * bfhi(w.z); acc[8 * j + 6] = acc[8 * j + 6] * sc + p * bflo(w.w); acc[8 * j + 7] = acc[8 * j + 7] * sc + p * bfhi(w.w); }
            }
        }
        const float inv = 1.0f / l; v4u* op = (v4u*)(CAT + (size_t)row * DM + GW + h * 64);
#pragma unroll
        for (int j = 0; j < 8; ++j) { v4u w; w.x = pk2(acc[8 * j] * inv, acc[8 * j + 1] * inv); w.y = pk2(acc[8 * j + 2] * inv, acc[8 * j + 3] * inv); w.z = pk2(acc[8 * j + 4] * inv, acc[8 * j + 5] * inv); w.w = pk2(acc[8 * j + 6] * inv, acc[8 * j + 7] * inv); op[j] = w; }
    }
}
__device__ __forceinline__ void gated_norm(const Args& A, int lane, int wave) {
    const bf16* PROJ = (const bf16*)(A.ws + WS_PROJ); bf16* CAT = (bf16*)(A.ws + WS_CAT); const float* OA = (const float*)(A.ws + WS_OA); const float* gw = A.in[6];
    const float w0 = gw[2 * lane], w1 = gw[2 * lane + 1];
    for (int wt = blockIdx.x * NWAVES + wave; wt < M * GH; wt += gridDim.x * NWAVES) {
        const int row = wt / GH, h = wt % GH;
        const float2 o = *(const float2*)(OA + (size_t)row * GW + h * 128 + 2 * lane);
        const unsigned zz = *(const unsigned*)(PROJ + (size_t)row * NP + PC_Z + h * 128 + 2 * lane);
        const float ms = wave_sum(o.x * o.x + o.y * o.y) * (1.0f / 128.0f), r = rsqrtf(ms + RMS_EPS);
        *(unsigned*)(CAT + (size_t)row * DM + h * 128 + 2 * lane) = pk2(o.x * r * w0 * silu_f(bflo(zz)), o.y * r * w1 * silu_f(bfhi(zz)));
    }
}
__device__ __forceinline__ void ffn_conv_half(const Args& A, int half, int tid) {
    const bf16* Y = (const bf16*)(A.ws + WS_Y); bf16* ACT = (bf16*)(A.ws + WS_ACT); const float* fw = A.in[10];
    constexpr int HC = DFF / 2;
    for (size_t it = (size_t)blockIdx.x * NTHR + tid; it < (size_t)M * (HC / 8); it += (size_t)gridDim.x * NTHR) {
        const int row = (int)(it / (HC / 8)), g8 = (int)(it % (HC / 8)), cl = g8 * 8, pn = cl >> 7, j = cl & 127, t = row % SEQ, ch = half * HC + cl;
        float ga[8], ua[8];
#pragma unroll
        for (int e = 0; e < 8; ++e) { ga[e] = 0.f; ua[e] = 0.f; }
#pragma unroll
        for (int i = 0; i < 3; ++i) { const int ts = t - 2 + i; if (ts < 0) continue;
            const bf16* yr = Y + (size_t)(row - 2 + i) * DFF + 256 * pn + j; const v4u g = *(const v4u*)yr, u = *(const v4u*)(yr + 128);
            const f32x4 wg0 = *(const f32x4*)(fw + i * NUP + ch), wg1 = *(const f32x4*)(fw + i * NUP + ch + 4), wu0 = *(const f32x4*)(fw + i * NUP + DFF + ch), wu1 = *(const f32x4*)(fw + i * NUP + DFF + ch + 4);
            ga[0] += wg0.x * bflo(g.x); ga[1] += wg0.y * bfhi(g.x); ga[2] += wg0.z * bflo(g.y); ga[3] += wg0.w * bfhi(g.y); ga[4] += wg1.x * bflo(g.z); ga[5] += wg1.y * bfhi(g.z); ga[6] += wg1.z * bflo(g.w); ga[7] += wg1.w * bfhi(g.w);
            ua[0] += wu0.x * bflo(u.x); ua[1] += wu0.y * bfhi(u.x); ua[2] += wu0.z * bflo(u.y); ua[3] += wu0.w * bfhi(u.y); ua[4] += wu1.x * bflo(u.z); ua[5] += wu1.y * bfhi(u.z); ua[6] += wu1.z * bflo(u.w); ua[7] += wu1.w * bfhi(u.w); }
        v4u o; o.x = pk2(silu_f(ga[0]) * ua[0], silu_f(ga[1]) * ua[1]); o.y = pk2(silu_f(ga[2]) * ua[2], silu_f(ga[3]) * ua[3]); o.z = pk2(silu_f(ga[4]) * ua[4], silu_f(ga[5]) * ua[5]); o.w = pk2(silu_f(ga[6]) * ua[6], silu_f(ga[7]) * ua[7]);
        *(v4u*)(ACT + (size_t)row * DFF + ch) = o;
    }
}
__device__ __forceinline__ void final_norm(const Args& A, int lane, int wave) {
    float* out = A.out; const float* fnw = A.in[12];
    for (int m = blockIdx.x * NWAVES + wave; m < M; m += gridDim.x * NWAVES) {
        f32x4* xr = (f32x4*)(out + (size_t)m * DM) + lane; const f32x4* nr = (const f32x4*)fnw + lane;
        f32x4 v[4]; float s = 0.f;
#pragma unroll
        for (int j = 0; j < 4; ++j) { v[j] = xr[64 * j]; s += (v[j].x * v[j].x + v[j].y * v[j].y) + (v[j].z * v[j].z + v[j].w * v[j].w); }
        const float rstd = rsqrtf(wave_sum(s) * (1.f / DM) + RMS_EPS);
#pragma unroll
        for (int j = 0; j < 4; ++j) { const f32x4 n = nr[64 * j]; xr[64 * j] = (f32x4){v[j].x * rstd * n.x, v[j].y * rstd * n.y, v[j].z * rstd * n.z, v[j].w * rstd * n.w}; }
    }
}

constexpr int N_PHASES = 11;
__global__ void __launch_bounds__(NTHR, 2) mk_fwd(Args args) {
    extern __shared__ __attribute__((aligned(16))) unsigned char lds_raw[];
    LAS unsigned char* lds = (LAS unsigned char*)lds_raw;
    const int tid = threadIdx.x, lane = tid & 63, wave = __builtin_amdgcn_readfirstlane(tid >> 6);
    const int lo = args.ph_lo, hi = args.ph_hi;
    unsigned char* ws = args.ws;
    bf16* WIN = (bf16*)(ws + WS_WIN); bf16* WOUT = (bf16*)(ws + WS_WOUT); bf16* WUP = (bf16*)(ws + WS_WUP); bf16* WDN = (bf16*)(ws + WS_WDN);
    bf16* XN = (bf16*)(ws + WS_XN); bf16* PROJ = (bf16*)(ws + WS_PROJ); bf16* CAT = (bf16*)(ws + WS_CAT); bf16* Y = (bf16*)(ws + WS_Y); bf16* ACT = (bf16*)(ws + WS_ACT);
    float* SSQ = (float*)(ws + WS_SSQ);
#define IN(k) (lo <= (k) && (k) < hi)
#define SEAM(k) do { if (IN(k) && IN((k) + 1)) { cg::this_grid().sync(); } } while (0)
    if (IN(0)) { p0_prologue(args, lds, tid, lane, wave); } SEAM(0);
    if (IN(1)) { pg8::Gemm g{XN, WIN, M, NP, DM}; pg8::StaticOrder S; S.init(M, NP, gridDim.x, blockIdx.x); pg8::EpiBf16S E{PROJ, NP, nullptr};
        pg8::gemm_phase<pg8::EpiBf16S, pg8::StaticOrder, PG8_ALIGN, PG8_SP2>(lds, g, S, E); } SEAM(1);
    if (IN(2)) { gdn_prep(args, lds, tid, lane, wave); } SEAM(2);
    if (IN(3)) { if (blockIdx.x < NB * GH) gdn_scan(args, lds, blockIdx.x, tid, lane, wave); attn_fast(args, lds, lane, wave); } SEAM(3);
    if (IN(4)) { pg8::Gemm g{CAT, WOUT, M, DM, DM}; pg8::StaticOrder S; S.init(M, DM, gridDim.x, blockIdx.x); pg8::EpiResid E{args.in[0], args.out, XN, SSQ, DM};
        pg8::gemm_phase<pg8::EpiResid, pg8::StaticOrder, PG8_ALIGN, PG8_SP2>(lds, g, S, E); } SEAM(4);
#pragma unroll 1
    for (int half = 0; half < 2; ++half) {
        if (IN(5 + 2 * half)) { pg8::Gemm g{XN, WUP + (size_t)half * DFF * DM, M, DFF, DM}; pg8::StaticOrder S; S.init(M, DFF, gridDim.x, blockIdx.x); pg8::EpiBf16S E{Y, DFF, SSQ};
            pg8::gemm_phase<pg8::EpiBf16S, pg8::StaticOrder, PG8_ALIGN, PG8_SP2>(lds, g, S, E); } SEAM(5 + 2 * half);
        if (IN(6 + 2 * half)) { ffn_conv_half(args, half, tid); } SEAM(6 + 2 * half);
    }
    if (IN(9)) { pg8::Gemm g{ACT, WDN, M, DM, DFF}; pg8::StaticOrder S; S.init(M, DM, gridDim.x, blockIdx.x); pg8::EpiResid E{args.out, args.out, nullptr, nullptr, DM};
        pg8::gemm_phase<pg8::EpiResid, pg8::StaticOrder, PG8_ALIGN, PG8_SP2>(lds, g, S, E); } SEAM(9);
    if (IN(10)) { final_norm(args, lane, wave); }
#undef IN
#undef SEAM
}

#ifndef MK_ONE_LAUNCH
#define MK_ONE_LAUNCH 1
#endif
extern "C" void kernel_launch(void* const* d_in, const int* in_sizes, int n_in, void* d_out, int out_size, void* d_ws, size_t ws_size, hipStream_t stream) {
    static int grid = 0;
    if (grid == 0) {
        if (n_in != 13 || out_size != M * DM || ws_size < WS_END) { fprintf(stderr, "kernel_launch: unexpected shapes n_in %d out %d ws %zu\n", n_in, out_size, ws_size); grid = -1; return; }
        int dev = 0, cus = 0, per_cu = 0;
        hipGetDevice(&dev); hipDeviceGetAttribute(&cus, hipDeviceAttributeMultiprocessorCount, dev);
        hipFuncSetAttribute((const void*)mk_fwd, hipFuncAttributeMaxDynamicSharedMemorySize, LDS_BYTES);
        hipOccupancyMaxActiveBlocksPerMultiprocessor(&per_cu, (const void*)mk_fwd, NTHR, LDS_BYTES);
        (void)hipGetLastError();
        if (per_cu < 1) { fprintf(stderr, "kernel_launch: occupancy query says %d blocks per CU\n", per_cu); per_cu = 1; }
        grid = cus;
    }
    if (grid < 0) return;
    Args a{};
    for (int i = 0; i < 13; ++i) a.in[i] = (const float*)d_in[i];
    a.out = (float*)d_out; a.ws = (unsigned char*)d_ws;
#if MK_ONE_LAUNCH
    a.ph_lo = 0; a.ph_hi = N_PHASES; a.coop = 1;
    void* kargs[] = {&a};
    hipError_t e = hipLaunchCooperativeKernel((const void*)mk_fwd, dim3(grid), dim3(NTHR), kargs, LDS_BYTES, stream);
    if (e != hipSuccess) fprintf(stderr, "cooperative launch failed: %s (grid %d)\n", hipGetErrorString(e), grid);
#else
    for (int p = 0; p < N_PHASES; ++p) { a.ph_lo = p; a.ph_hi = p + 1; a.coop = 0; hipLaunchKernelGGL(mk_fwd, dim3(grid), dim3(NTHR), LDS_BYTES, stream, a); }
#endif
}
```

```cpp
#include <hip/hip_runtime.h>
#include <hip/hip_cooperative_groups.h>
#include <cstdio>
#include <cstdint>
namespace cg = cooperative_groups;
namespace pg8 {
#define PG8_LAS __attribute__((address_space(3)))
typedef unsigned short bf16_t;
typedef short bf16x8 __attribute__((ext_vector_type(8)));
typedef float f32x4 __attribute__((ext_vector_type(4)));
typedef unsigned u32x4 __attribute__((ext_vector_type(4)));
constexpr int BM = 256, BK = 64, HALF = 128, HTB = HALF * BK * 2  , STAGE_BYTES = 8 * HTB, NXCD = 8, WGM = 8;

__host__ __device__ __forceinline__ int lds_byte(int r, int c) { const int st = (r >> 4) * 2 + (c >> 5), rr = r & 15, cc = c & 31, ob = rr * 64 + cc * 2; return st * 1024 + (ob ^ (((ob >> 9) & 1) << 5)); }
__host__ __device__ __forceinline__ void stage_rc(int b, int& R, int& C) { const int st = b / 1024, sb = b % 1024, swz = sb ^ (((sb >> 9) & 1) << 5); R = (st >> 1) * 16 + swz / 64; C = (st & 1) * 32 + (swz % 64) / 2; }
__host__ __device__ __forceinline__ int perm32(int rho) { const int n = rho >> 4, i = rho & 15; return 8 * (i >> 2) + 4 * n + (i & 3); }

struct Unit { int pm, pn; };
struct Gemm { const bf16_t* A; const bf16_t* Bt; int M, N, K; };

struct StaticOrder {
    int nM, nN, nwg, G, c;
    __host__ __device__ void init(int M, int N, int G_, int c_) { nM = M / BM; nN = N / BM; nwg = nM * nN; G = G_; c = c_; }
    __host__ __device__ bool next(int i, Unit& u) const {
        const long L = (long)i * G + c; if (L >= nwg) return false;
        int wgid = (int)L; { const int q = nwg / NXCD, r = nwg % NXCD, xcd = wgid % NXCD, off = wgid / NXCD; wgid = (xcd < r ? xcd * (q + 1) : r * (q + 1) + (xcd - r) * q) + off; }
        const int nig = WGM * nN, gid = wgid / nig, fm = gid * WGM, gsz = (nM - fm) < WGM ? (nM - fm) : WGM;
        u.pm = fm + ((wgid % nig) % gsz); u.pn = (wgid % nig) / gsz; return true;
    }
    __device__ __forceinline__ void a_ready(const Unit&) const {}
    __device__ __forceinline__ void done(const Unit&) const {}
};

__device__ __forceinline__ unsigned cvt_pk_bf16(float lo, float hi) { unsigned r; asm volatile("v_cvt_pk_bf16_f32 %0, %1, %2" : "=v"(r) : "v"(lo), "v"(hi)); return r; }
constexpr float RMS_EPS = 1e-6f;
struct EpiBf16S {
    static constexpr bool PERM = true, AFTER_DRAIN = false;
    bf16_t* O; int ldc; const float* ssq;
    __device__ __forceinline__ void operator()(const f32x4 (&acc)[2][2][4][2], const Unit& u, int wr, int wc, int fr, int fq) const {
        const int row0 = u.pm * BM + wr * 64 + fr; const int col0 = u.pn * BM + wc * 32 + 8 * fq;
#pragma unroll
        for (int ai = 0; ai < 2; ++ai)
#pragma unroll
            for (int m = 0; m < 4; ++m) { const int row = row0 + ai * HALF + m * 16; bf16_t* rowp = O + (size_t)row * ldc + col0;
                const float sc = ssq ? rsqrtf(ssq[row] * (1.0f / 1024.0f) + RMS_EPS) : 1.0f;
#pragma unroll
                for (int bj = 0; bj < 2; ++bj) { const f32x4 v0 = acc[ai][bj][m][0] * sc, v1 = acc[ai][bj][m][1] * sc;
                    u32x4 w; w.x = cvt_pk_bf16(v0[0], v0[1]); w.y = cvt_pk_bf16(v0[2], v0[3]); w.z = cvt_pk_bf16(v1[0], v1[1]); w.w = cvt_pk_bf16(v1[2], v1[3]);
                    *(u32x4*)(rowp + bj * HALF) = w; } }
    }
};
struct EpiResid {
    static constexpr bool PERM = false, AFTER_DRAIN = false;
    const float* base; float* out; bf16_t* xb; float* ssq; int ldc;
    __device__ __forceinline__ void operator()(const f32x4 (&acc)[2][2][4][2], const Unit& u, int wr, int wc, int fr, int fq) const {
        typedef unsigned u32x2v __attribute__((ext_vector_type(2)));
        const int col0 = u.pn * BM + wc * 32 + 4 * fq;
#pragma unroll
        for (int ai = 0; ai < 2; ++ai)
#pragma unroll
            for (int m = 0; m < 4; ++m) { const int row = u.pm * BM + ai * HALF + wr * 64 + m * 16 + fr; const size_t off = (size_t)row * ldc + col0; float s = 0.f;
#pragma unroll
                for (int bj = 0; bj < 2; ++bj)
#pragma unroll
                    for (int n = 0; n < 2; ++n) { const f32x4 v = acc[ai][bj][m][n] + *(const f32x4*)(base + off + bj * HALF + n * 16);
                        *(f32x4*)(out + off + bj * HALF + n * 16) = v; s += (v[0] * v[0] + v[1] * v[1]) + (v[2] * v[2] + v[3] * v[3]);
                        if (xb) { u32x2v w; w.x = cvt_pk_bf16(v[0], v[1]); w.y = cvt_pk_bf16(v[2], v[3]); *(u32x2v*)(xb + off + bj * HALF + n * 16) = w; } }
                if (ssq) { s += __shfl_xor(s, 16); s += __shfl_xor(s, 32); if (fq == 0) atomicAdd(ssq + row, s); }
                asm volatile("" ::: "memory"); }
    }
};
template <class Epi, class Sched, bool ALIGN_EPI = false, bool SP2 = false>
__device__ __forceinline__ void gemm_phase(PG8_LAS unsigned char* lds, const Gemm g, const Sched& S, const Epi& E) {
    const int tid = threadIdx.x, wid = __builtin_amdgcn_readfirstlane(tid >> 6), lane = tid & 63, wr = wid >> 2, wc = wid & 3, fr = lane & 15, fq = lane >> 4;
    const int K = g.K, nt = K / BK;
    unsigned voffA[2], voffB[2];
#pragma unroll
    for (int i = 0; i < 2; ++i) { int R, C; stage_rc(tid * 16 + i * 8192, R, C); const int Rb = Epi::PERM ? ((R & ~31) + perm32(R & 31)) : R;
        voffA[i] = (unsigned)(R * K + C) * 2u; voffB[i] = (unsigned)(Rb * K + C) * 2u; }
    const size_t kstep = (size_t)(BK * 2);
    const size_t hstep = (size_t)HALF * K * 2;
    const size_t tstep = 2 * hstep;
    const unsigned ldsw = (unsigned)wid * 1024u;
    const int aoff = lds_byte(wr * 64 + fr, fq * 8), boff = lds_byte(wc * 32 + fr, fq * 8);
#define PG8_SA(b, h) (((b) * 2 + (h)) * HTB)
#define PG8_SB(b, h) ((4 + (b) * 2 + (h)) * HTB)
#define PG8_STAGE(bufoff, gbase, voff) do { _Pragma("unroll") for (int _i = 0; _i < 2; ++_i) \
        __builtin_amdgcn_global_load_lds((const unsigned*)((const char*)(gbase) + (voff)[_i]), (PG8_LAS unsigned*)(lds + (bufoff) + ldsw + _i * 8192), 16, 0, 0); } while (0)
#define PG8_LDA(dst, b, h) do { _Pragma("unroll") for (int m = 0; m < 4; ++m) _Pragma("unroll") for (int k = 0; k < 2; ++k) dst[m][k] = *(const PG8_LAS bf16x8*)(lds + PG8_SA(b, h) + aoff + m * 2048 + k * 1024); } while (0)
#define PG8_LDB(dst, b, h) do { _Pragma("unroll") for (int n = 0; n < 2; ++n) _Pragma("unroll") for (int k = 0; k < 2; ++k) dst[n][k] = *(const PG8_LAS bf16x8*)(lds + PG8_SB(b, h) + boff + n * 2048 + k * 1024); } while (0)
#define PG8_MMA(ai, bj, At, Bt) do { __builtin_amdgcn_s_setprio(1); _Pragma("unroll") for (int m = 0; m < 4; ++m) _Pragma("unroll") for (int n = 0; n < 2; ++n) _Pragma("unroll") for (int k = 0; k < 2; ++k) \
        acc[ai][bj][m][n] = __builtin_amdgcn_mfma_f32_16x16x32_bf16(Bt[n][k], At[m][k], acc[ai][bj][m][n], 0, 0, 0); __builtin_amdgcn_s_setprio(0); } while (0)
#define PG8_WAIT_V(n) asm volatile("s_waitcnt vmcnt(" #n ")" ::: "memory")
#define PG8_WAIT_L(n) asm volatile("s_waitcnt lgkmcnt(" #n ")" ::: "memory")
#define PG8_BAR __builtin_amdgcn_s_barrier()
#define PG8_SCHED __builtin_amdgcn_sched_barrier(0)
    Unit cur, nxt; int ui = 0;
    if (!S.next(0, cur)) return;
    f32x4 acc[2][2][4][2];
#pragma unroll
    for (int a = 0; a < 2; ++a)
#pragma unroll
        for (int b = 0; b < 2; ++b)
#pragma unroll
            for (int m = 0; m < 4; ++m)
#pragma unroll
                for (int n = 0; n < 2; ++n) acc[a][b][m][n] = (f32x4){0.f, 0.f, 0.f, 0.f};
    bf16x8 At[4][2], B0[2][2], B1[2][2];
    const char* cA = (const char*)g.A + (size_t)cur.pm * tstep; const char* cB = (const char*)g.Bt + (size_t)cur.pn * tstep;
    S.a_ready(cur);
    if constexpr (SP2) {
        PG8_STAGE(PG8_SB(0, 0), cB, voffB); PG8_STAGE(PG8_SB(0, 1), cB + hstep, voffB); PG8_STAGE(PG8_SA(0, 0), cA, voffA); PG8_STAGE(PG8_SA(0, 1), cA + hstep, voffA);
        if (wr == 1) PG8_BAR;
        PG8_WAIT_V(2); PG8_BAR;
        PG8_STAGE(PG8_SB(1, 0), cB + kstep, voffB); PG8_STAGE(PG8_SA(1, 0), cA + kstep, voffA); PG8_STAGE(PG8_SB(1, 1), cB + hstep + kstep, voffB);
        PG8_WAIT_V(6); PG8_BAR;
    } else {
        PG8_STAGE(PG8_SB(0, 0), cB, voffB); PG8_STAGE(PG8_SA(0, 0), cA, voffA); PG8_STAGE(PG8_SB(0, 1), cB + hstep, voffB); PG8_STAGE(PG8_SA(0, 1), cA + hstep, voffA);
        if (wr == 1) PG8_BAR;
        PG8_WAIT_V(4); PG8_BAR;
        PG8_STAGE(PG8_SB(1, 0), cB + kstep, voffB); PG8_STAGE(PG8_SA(1, 0), cA + kstep, voffA); PG8_STAGE(PG8_SB(1, 1), cB + hstep + kstep, voffB);
        PG8_WAIT_V(6); PG8_BAR;
    }
    for (;;) {
        const bool has_next = S.next(ui + 1, nxt);
        const char* nA = has_next ? (const char*)g.A + (size_t)nxt.pm * tstep : cA; const char* nB = has_next ? (const char*)g.Bt + (size_t)nxt.pn * tstep : cB;
        for (int t = 0; t < nt; t += 2) {
            const bool last = (t == nt - 2);
            const char* a1 = cA + (size_t)(t + 1) * kstep;
            const char* a2 = last ? nA : cA + (size_t)(t + 2) * kstep; const char* b2 = last ? nB : cB + (size_t)(t + 2) * kstep;
            const char* a3 = a2 + kstep; const char* b3 = b2 + kstep;
            if (last && has_next) S.a_ready(nxt);
            if constexpr (SP2) {
            PG8_LDB(B0, 0, 0); PG8_LDB(B1, 0, 1); PG8_SCHED; PG8_LDA(At, 0, 0); PG8_STAGE(PG8_SA(1, 1), a1 + hstep, voffA);
            PG8_WAIT_V(8); PG8_WAIT_L(0); PG8_BAR; PG8_MMA(0, 0, At, B0); PG8_MMA(0, 1, At, B1); PG8_BAR; PG8_SCHED;
            PG8_LDA(At, 0, 1); PG8_STAGE(PG8_SB(0, 0), b2, voffB); PG8_STAGE(PG8_SB(0, 1), b2 + hstep, voffB); PG8_STAGE(PG8_SA(0, 0), a2, voffA);
            PG8_WAIT_V(8); PG8_WAIT_L(0); PG8_BAR; PG8_MMA(1, 0, At, B0); PG8_MMA(1, 1, At, B1); PG8_BAR; PG8_SCHED;
            PG8_LDB(B0, 1, 0); PG8_LDB(B1, 1, 1); PG8_SCHED; PG8_LDA(At, 1, 0); PG8_STAGE(PG8_SA(0, 1), a2 + hstep, voffA);
            PG8_WAIT_V(8); PG8_WAIT_L(0); PG8_BAR; PG8_MMA(0, 0, At, B0); PG8_MMA(0, 1, At, B1); PG8_BAR; PG8_SCHED;
            PG8_LDA(At, 1, 1); PG8_STAGE(PG8_SB(1, 0), b3, voffB); PG8_STAGE(PG8_SB(1, 1), b3 + hstep, voffB); PG8_STAGE(PG8_SA(1, 0), a3, voffA);
            PG8_WAIT_V(8); PG8_WAIT_L(0); PG8_BAR; PG8_MMA(1, 0, At, B0); PG8_MMA(1, 1, At, B1); PG8_BAR; PG8_SCHED;
            } else {
            PG8_LDB(B0, 0, 0); PG8_SCHED; PG8_LDA(At, 0, 0); PG8_STAGE(PG8_SA(1, 1), a1 + hstep, voffA);
            PG8_WAIT_L(8); PG8_BAR; PG8_WAIT_L(0); PG8_MMA(0, 0, At, B0); PG8_BAR; PG8_SCHED;
            PG8_LDB(B1, 0, 1); PG8_STAGE(PG8_SB(0, 0), b2, voffB);
            PG8_BAR; PG8_WAIT_L(0); PG8_MMA(0, 1, At, B1); PG8_BAR;
            PG8_LDA(At, 0, 1); PG8_STAGE(PG8_SA(0, 0), a2, voffA);
            PG8_BAR; PG8_WAIT_L(0); PG8_MMA(1, 0, At, B0); PG8_BAR; PG8_SCHED;
            PG8_STAGE(PG8_SB(0, 1), b2 + hstep, voffB);
            PG8_WAIT_V(6); PG8_BAR; PG8_MMA(1, 1, At, B1); PG8_BAR;
            PG8_LDB(B0, 1, 0); PG8_SCHED; PG8_LDA(At, 1, 0); PG8_STAGE(PG8_SA(0, 1), a2 + hstep, voffA);
            PG8_WAIT_L(8); PG8_BAR; PG8_WAIT_L(0); PG8_MMA(0, 0, At, B0); PG8_BAR; PG8_SCHED;
            PG8_LDB(B1, 1, 1); PG8_STAGE(PG8_SB(1, 0), b3, voffB);
            PG8_BAR; PG8_WAIT_L(0); PG8_MMA(0, 1, At, B1); PG8_BAR;
            PG8_LDA(At, 1, 1); PG8_STAGE(PG8_SA(1, 0), a3, voffA);
            PG8_BAR; PG8_WAIT_L(0); PG8_MMA(1, 0, At, B0); PG8_BAR; PG8_SCHED;
            PG8_STAGE(PG8_SB(1, 1), b3 + hstep, voffB);
            PG8_WAIT_V(6); PG8_BAR; PG8_MMA(1, 1, At, B1); PG8_BAR;
            }
        }
        if constexpr (ALIGN_EPI) { if (wr == 0) PG8_BAR; }
        if constexpr (!Epi::AFTER_DRAIN) { E(acc, cur, wr, wc, fr, fq); S.done(cur); }
        if (!has_next) break;
#pragma unroll
        for (int a = 0; a < 2; ++a)
#pragma unroll
            for (int b = 0; b < 2; ++b)
#pragma unroll
                for (int m = 0; m < 4; ++m)
#pragma unroll
                    for (int n = 0; n < 2; ++n) acc[a][b][m][n] = (f32x4){0.f, 0.f, 0.f, 0.f};
        cur = nxt; cA = nA; cB = nB; ++ui;
        if constexpr (ALIGN_EPI) { if (wr == 1) PG8_BAR; }
    }
    PG8_WAIT_V(0);
    if constexpr (!ALIGN_EPI) { if (wr == 0) PG8_BAR; }
    PG8_BAR;
    if constexpr (Epi::AFTER_DRAIN) { E.fused(acc, cur, wr, wc, fr, fq, lds, wid, lane); S.done(cur); }
#undef PG8_SA
#undef PG8_SB
#undef PG8_STAGE
#undef PG8_LDA
#undef PG8_LDB
#undef PG8_MMA
#undef PG8_WAIT_V
#undef PG8_WAIT_L
#undef PG8_BAR
#undef PG8_SCHED
}
}
#ifndef PG8_SP2
#define PG8_SP2 true
#endif
#ifndef PG8_ALIGN
#define PG8_ALIGN true
#endif
constexpr int NB = 8, SEQ = 2048, DM = 1024, M = NB * SEQ;
constexpr int GH = 4, GD = 128, GW = 512, AH = 8, AD = 64;
constexpr int INC = 3592, NP = 3584;
constexpr int DFF = 2816, NUP = 2 * DFF;
constexpr int PC_QA = 0, PC_KA = 512, PC_VA = 1024, PC_Z = 1536, PC_QB = 2048, PC_KB = 2560, PC_VB = 3072;
constexpr size_t MiB = 1u << 20;
constexpr size_t WS_CTL = 0, WS_AB = 1 * MiB, WS_SSQ = 1 * MiB + 768 * 1024, WS_WIN = 2 * MiB, WS_WOUT = 9 * MiB, WS_WUP = 11 * MiB, WS_WDN = 22 * MiB;
constexpr size_t WS_XN = 28 * MiB, WS_PROJ = 60 * MiB, WS_CAT = 172 * MiB, WS_OA = 204 * MiB, WS_Y = 60 * MiB, WS_ACT = 148 * MiB, WS_END = 256 * MiB;
using pg8::RMS_EPS;
constexpr size_t WS_GE = WS_SSQ + 65536;
constexpr int GOPS_CHUNK = 57344;
constexpr int NWAVES = 8, NTHR = 512;
constexpr int LDS_BYTES = 147456;
#define LAS __attribute__((address_space(3)))
typedef unsigned short bf16;
typedef unsigned v4u __attribute__((ext_vector_type(4)));
typedef unsigned v2u __attribute__((ext_vector_type(2)));
typedef float f32x4 __attribute__((ext_vector_type(4)));
__device__ __forceinline__ float bf2f(unsigned b) { return __uint_as_float(b << 16); }
__device__ __forceinline__ float bflo(unsigned w) { return __uint_as_float(w << 16); }
__device__ __forceinline__ float bfhi(unsigned w) { return __uint_as_float(w & 0xffff0000u); }
__device__ __forceinline__ unsigned pk2(float lo, float hi) { return pg8::cvt_pk_bf16(lo, hi); }
__device__ __forceinline__ float wave_sum(float v) {
#pragma unroll
    for (int o = 1; o < 64; o <<= 1) v += __shfl_xor(v, o);
    return v;
}
__device__ __forceinline__ float silu_f(float x) { return x / (1.0f + __expf(-x)); }
__device__ __forceinline__ float sigmoid_f(float x) { return 1.0f / (1.0f + __expf(-x)); }
__device__ __forceinline__ float softplus_f(float x) { return x > 20.f ? x : log1pf(__expf(x)); }

struct Args { const float* in[13]; float* out; unsigned char* ws; int ph_lo, ph_hi, coop, pad; };

__device__ __forceinline__ void p0_transpose_item(const float* W, int ldw, int k0, int sn0, bf16* WT, int K, int dn0, const float* kscale, LAS float* scr, int lane) {
#pragma unroll 8
    for (int i = 0; i < 32; ++i) { const int kk = 2 * i + (lane >> 5); float v = W[(size_t)(k0 + kk) * ldw + sn0 + (lane & 31)]; if (kscale) v *= kscale[k0 + kk]; scr[kk * 33 + (lane & 31)] = v; }
    asm volatile("s_waitcnt lgkmcnt(0)" ::: "memory");
    const int c = lane & 7;
#pragma unroll
    for (int j = 0; j < 4; ++j) { const int n = (lane >> 3) + 8 * j; const LAS float* s = scr + (8 * c) * 33 + n;
        v4u o; o.x = pk2(s[0 * 33], s[1 * 33]); o.y = pk2(s[2 * 33], s[3 * 33]); o.z = pk2(s[4 * 33], s[5 * 33]); o.w = pk2(s[6 * 33], s[7 * 33]);
        *(v4u*)(WT + (size_t)(dn0 + n) * K + k0 + 8 * c) = o; }
    asm volatile("s_waitcnt lgkmcnt(0)" ::: "memory");
}

__device__ __forceinline__ void p0_prologue(const Args& A, LAS unsigned char* lds, int tid, int lane, int wave) {
    const float* x = A.in[0]; const float* nw1 = A.in[1]; const float* w_in = A.in[2]; const float* w_out = A.in[7]; const float* nw2 = A.in[8];
    const float* w_up = A.in[9]; const float* w_dn = A.in[11];
    unsigned char* ws = A.ws;
    bf16* WIN = (bf16*)(ws + WS_WIN); bf16* WOUT = (bf16*)(ws + WS_WOUT); bf16* WUP = (bf16*)(ws + WS_WUP); bf16* WDN = (bf16*)(ws + WS_WDN);
    bf16* XN = (bf16*)(ws + WS_XN); float* AB = (float*)(ws + WS_AB); float* SSQ = (float*)(ws + WS_SSQ);
    LAS float* scr = (LAS float*)(lds + wave * 9216);
    LAS float* wab = (LAS float*)(lds + 73728);
    const int G = gridDim.x, gw = blockIdx.x * NWAVES + wave, NGW = G * NWAVES;
    for (int i = blockIdx.x * NTHR + tid; i < M; i += G * NTHR) SSQ[i] = 0.f;
    if (blockIdx.x == 0 && tid < 64) ((unsigned*)(ws + WS_CTL))[tid] = 0u;
    for (int idx = tid; idx < 8192; idx += NTHR) { const int k = idx >> 3, j = idx & 7; wab[j * 1024 + k] = nw1[k] * w_in[(size_t)k * INC + 2048 + j]; }
    constexpr int I_IN = 16 * (NP / 32), I_OUT = 16 * 32, I_UP = 16 * (NUP / 32), I_DN = (DFF / 64) * 32;
    constexpr int NITEMS = I_IN + I_OUT + I_UP + I_DN;
    for (int it = gw; it < NITEMS; it += NGW) {
        int r = it;
        if (r < I_IN) { const int nblk = NP / 32, kb = r / nblk, nb = r % nblk, n0 = 32 * nb; p0_transpose_item(w_in, INC, 64 * kb, n0 + (n0 >= 2048 ? 8 : 0), WIN, DM, n0, nullptr, scr, lane); continue; } r -= I_IN;
        if (r < I_OUT) { const int kb = r / 32, nb = r % 32; p0_transpose_item(w_out, DM, 64 * kb, 32 * nb, WOUT, DM, 32 * nb, nullptr, scr, lane); continue; } r -= I_OUT;
        if (r < I_UP) { const int nblk = NUP / 32, kb = r / nblk, nb = r % nblk, n0 = 32 * nb, pn = n0 >> 8, j0 = n0 & 255;
            const int s0 = (j0 < 128) ? (128 * pn + j0) : (DFF + 128 * pn + j0 - 128);
            p0_transpose_item(w_up, NUP, 64 * kb, s0, WUP, DM, n0, nw2, scr, lane); continue; } r -= I_UP;
        { const int kb = r / 32, nb = r % 32; p0_transpose_item(w_dn, DM, 64 * kb, 32 * nb, WDN, DFF, 32 * nb, nullptr, scr, lane); }
    }
    __syncthreads();
    for (int m = gw; m < M; m += NGW) {
        const f32x4* xr = (const f32x4*)(x + (size_t)m * DM) + lane; const f32x4* nr = (const f32x4*)nw1 + lane;
        f32x4 v[4]; float s = 0.f;
#pragma unroll
        for (int j = 0; j < 4; ++j) { v[j] = xr[64 * j]; s += (v[j].x * v[j].x + v[j].y * v[j].y) + (v[j].z * v[j].z + v[j].w * v[j].w); }
        const float rstd = rsqrtf(wave_sum(s) * (1.f / DM) + RMS_EPS);
        float ab[8];
#pragma unroll
        for (int q = 0; q < 8; ++q) { float a = 0.f;
#pragma unroll
            for (int j = 0; j < 4; ++j) { const f32x4 w = *(const LAS f32x4*)(wab + q * 1024 + 256 * j + 4 * lane); a += (v[j].x * w.x + v[j].y * w.y) + (v[j].z * w.z + v[j].w * w.w); }
            ab[q] = wave_sum(a) * rstd; }
        if (lane == 0) { *(f32x4*)(AB + (size_t)m * 8) = (f32x4){ab[0], ab[1], ab[2], ab[3]}; *(f32x4*)(AB + (size_t)m * 8 + 4) = (f32x4){ab[4], ab[5], ab[6], ab[7]}; }
        v2u* o8 = (v2u*)(XN + (size_t)m * DM) + lane;
#pragma unroll
        for (int j = 0; j < 4; ++j) { const f32x4 n = nr[64 * j]; v2u o; o.x = pk2(v[j].x * rstd * n.x, v[j].y * rstd * n.y); o.y = pk2(v[j].z * rstd * n.z, v[j].w * rstd * n.w); o8[64 * j] = o; }
    }
}

__device__ __forceinline__ void gdn_simple(const Args& A, LAS unsigned char* lds, int tid, int lane, int wave) {
    const bf16* PROJ = (const bf16*)(A.ws + WS_PROJ); const float* AB = (const float*)(A.ws + WS_AB); float* OA = (float*)(A.ws + WS_OA);
    const float* cw = A.in[3]; const float* a_log = A.in[4]; const float* dt_bias = A.in[5];
    LAS float* qs = (LAS float*)lds; LAS float* ks = qs + 16 * 128; LAS float* vs = ks + 16 * 128; LAS float* av = vs + 16 * 128; LAS float* bv = av + 16;
    for (int task = blockIdx.x; task < NB * GH; task += gridDim.x) {
        const int b = task / GH, h = task % GH, v = tid >> 2, part = tid & 3;
        float S[32];
#pragma unroll
        for (int i = 0; i < 32; ++i) S[i] = 0.f;
        const float Ah = __expf(a_log[h]), dtb = dt_bias[h];
        for (int blk = 0; blk < SEQ / 16; ++blk) {
            const int t0 = blk * 16;
            for (int idx = tid; idx < 16 * 384; idx += NTHR) {
                const int tt = idx / 384, c = idx % 384, which = c >> 7, d = c & 127, col = which * 512 + h * 128 + d, t = t0 + tt;
                float acc = 0.f;
#pragma unroll
                for (int i = 0; i < 4; ++i) { const int ts = t - 3 + i; if (ts >= 0) acc += cw[i * 1536 + col] * bf2f(PROJ[(size_t)(b * SEQ + ts) * NP + col]); }
                qs[which * 2048 + tt * 128 + d] = silu_f(acc);
            }
            if (tid < 16) { const size_t row = (size_t)b * SEQ + t0 + tid; bv[tid] = sigmoid_f(AB[row * 8 + h]); av[tid] = __expf(-Ah * softplus_f(AB[row * 8 + 4 + h] + dtb)); }
            __syncthreads();
#pragma unroll
            for (int r = 0; r < 4; ++r) { const int row = 4 * wave + r; LAS float* arr = qs + row * 128;
                const float v0 = arr[lane], v1 = arr[lane + 64]; const float s = wave_sum(v0 * v0 + v1 * v1);
                const float sc = rsqrtf(s + RMS_EPS) * (row < 16 ? 0.08838834764831845f : 1.0f); arr[lane] = v0 * sc; arr[lane + 64] = v1 * sc; }
            __syncthreads();
            for (int tt = 0; tt < 16; ++tt) {
                const float a = av[tt], bt = bv[tt], vt = vs[tt * 128 + v];
                float kS = 0.f;
#pragma unroll
                for (int i = 0; i < 32; ++i) kS += ks[tt * 128 + 32 * part + i] * S[i];
                kS += __shfl_xor(kS, 1); kS += __shfl_xor(kS, 2);
                const float c = bt * (vt - a * kS); float o = 0.f;
#pragma unroll
                for (int i = 0; i < 32; ++i) { S[i] = a * S[i] + ks[tt * 128 + 32 * part + i] * c; o += qs[tt * 128 + 32 * part + i] * S[i]; }
                o += __shfl_xor(o, 1); o += __shfl_xor(o, 2);
                if (part == 0) OA[(size_t)(b * SEQ + t0 + tt) * GW + h * 128 + v] = o;
            }
            __syncthreads();
        }
    }
}


template <int J, int K, int N> struct SolveLd {
    static __device__ __forceinline__ void run(f32x4 (&l)[16], unsigned lbase) {
        if constexpr (K < N) { constexpr int t40 = ((J + 1) >> 2) << 2;
            asm volatile("ds_read_b128 %0, %1 offset:%2" : "=v"(l[K]) : "v"(lbase), "i"((J * 68 + t40 + 4 * K) * 4)); SolveLd<J, K + 1, N>::run(l, lbase); }
    }
};
template <int J> struct SolveCol {
    static __device__ __forceinline__ void run(float (&R)[64], unsigned lbase) {
        if constexpr (J < 63) {
            constexpr int t40 = ((J + 1) >> 2) << 2, nld = (64 - t40) >> 2;
            f32x4 l[16];
            SolveLd<J, 0, nld>::run(l, lbase);
            asm volatile("s_waitcnt lgkmcnt(0)" ::: "memory");
#pragma unroll
            for (int k = 0; k < nld; ++k) asm volatile("" : "+v"(l[k]));
#pragma unroll
            for (int k = 0; k < nld; ++k) {
#pragma unroll
                for (int e = 0; e < 4; ++e) if (t40 + 4 * k + e > J) R[t40 + 4 * k + e] -= l[k][e] * R[J]; }
            SolveCol<J + 1>::run(R, lbase);
        }
    }
};

typedef short bf16x8 __attribute__((ext_vector_type(8)));
__device__ __forceinline__ void gdn_prep(const Args& A, LAS unsigned char* lds, int tid0, int lane0, int wave) {
    const bf16* PROJ = (const bf16*)(A.ws + WS_PROJ); const float* AB = (const float*)(A.ws + WS_AB);
    const float* cw = A.in[3]; const float* a_log = A.in[4]; const float* dt_bias = A.in[5];
    float* UV = (float*)(A.ws + WS_XN); unsigned char* GOPS = (unsigned char*)A.out; float* GE = (float*)(A.ws + WS_GE);
    LAS float* Qs = (LAS float*)lds; LAS float* Ks = (LAS float*)(lds + 33792); LAS float* Vs = (LAS float*)(lds + 67584);
    LAS bf16* Qb = (LAS bf16*)(lds + 101376); LAS bf16* Kb = (LAS bf16*)(lds + 118784);
    LAS float* gcs = (LAS float*)(lds + 136192); LAS float* bts = gcs + 64; LAS float* egs = gcs + 128; LAS float* kes = gcs + 192;
    LAS float* LsT = (LAS float*)lds; LAS bf16* ATs = (LAS bf16*)(lds + 17408); LAS bf16* WKs = Kb;
#pragma unroll 1
    for (int task = blockIdx.x; task < NB * GH * 32; task += gridDim.x) {
        int tid = tid0, lane = lane0; asm volatile("" : "+v"(tid), "+v"(lane));
        const int fr = lane & 15, fq = lane >> 4;
        const int bh = task >> 5, n = task & 31, b = bh >> 2, h = bh & 3, t0 = 64 * n, row0 = b * SEQ + t0;
        unsigned char* gops = GOPS + (size_t)task * GOPS_CHUNK;
        for (int idx = tid; idx < 3072; idx += NTHR) {
            const int tt = idx / 48, c8 = idx % 48, which = c8 >> 4, d0 = (c8 & 15) * 8, col = which * 512 + h * 128 + d0;
            float acc[8];
#pragma unroll
            for (int e = 0; e < 8; ++e) acc[e] = 0.f;
#pragma unroll
            for (int i = 0; i < 4; ++i) { const int ts = t0 + tt - 3 + i; if (ts < 0) continue;
                const v4u w = *(const v4u*)(PROJ + (size_t)(b * SEQ + ts) * NP + col); const f32x4 c0 = *(const f32x4*)(cw + i * 1536 + col), c1 = *(const f32x4*)(cw + i * 1536 + col + 4);
                acc[0] += c0.x * bflo(w.x); acc[1] += c0.y * bfhi(w.x); acc[2] += c0.z * bflo(w.y); acc[3] += c0.w * bfhi(w.y);
                acc[4] += c1.x * bflo(w.z); acc[5] += c1.y * bfhi(w.z); acc[6] += c1.z * bflo(w.w); acc[7] += c1.w * bfhi(w.w); }
            LAS float* dst = (which == 0 ? Qs : (which == 1 ? Ks : Vs)) + tt * 132 + d0;
            *(LAS f32x4*)dst = (f32x4){silu_f(acc[0]), silu_f(acc[1]), silu_f(acc[2]), silu_f(acc[3])};
            *(LAS f32x4*)(dst + 4) = (f32x4){silu_f(acc[4]), silu_f(acc[5]), silu_f(acc[6]), silu_f(acc[7])};
        }
        if (wave == 0) {
            const size_t row = (size_t)row0 + lane; const float beta = sigmoid_f(AB[row * 8 + h]);
            float g = -__expf(a_log[h]) * softplus_f(AB[row * 8 + 4 + h] + dt_bias[h]);
#pragma unroll
            for (int o = 1; o < 64; o <<= 1) { const float t = __shfl_up(g, o); if (lane >= o) g += t; }
            const float glast = __shfl(g, 63);
            gcs[lane] = g; bts[lane] = beta; egs[lane] = __expf(g); kes[lane] = __expf(glast - g) * beta;
            if (lane == 63) GE[task] = __expf(g);
        }
        __syncthreads();
#pragma unroll 2
        for (int r = 0; r < 8; ++r) { const int row = 8 * wave + r;
            { const float v0 = Qs[row * 132 + lane], v1 = Qs[row * 132 + lane + 64]; const float sc = rsqrtf(wave_sum(v0 * v0 + v1 * v1) + RMS_EPS) * 0.08838834764831845f;
              Qb[row * 136 + lane] = (bf16)(pk2(v0 * sc, 0.f) & 0xffffu); Qb[row * 136 + lane + 64] = (bf16)(pk2(v1 * sc, 0.f) & 0xffffu); }
            { const float v0 = Ks[row * 132 + lane], v1 = Ks[row * 132 + lane + 64]; const float sc = rsqrtf(wave_sum(v0 * v0 + v1 * v1) + RMS_EPS);
              Ks[row * 132 + lane] = v0 * sc; Ks[row * 132 + lane + 64] = v1 * sc; Kb[row * 136 + lane] = (bf16)(pk2(v0 * sc, 0.f) & 0xffffu); Kb[row * 136 + lane + 64] = (bf16)(pk2(v1 * sc, 0.f) & 0xffffu); }
        }
        __syncthreads();
#pragma unroll 1
        for (int jb = wave; jb < 20; jb += 8) {
            const int kind = jb >= 10 ? 1 : 0, idx = jb - 10 * kind, ti = idx < 1 ? 0 : (idx < 3 ? 1 : (idx < 6 ? 2 : 3)), tj = idx - ti * (ti + 1) / 2;
            const LAS bf16* As = kind ? Qb : Kb; f32x4 d = (f32x4){0.f, 0.f, 0.f, 0.f};
#pragma unroll
            for (int ks = 0; ks < 4; ++ks) { const bf16x8 a = *(const LAS bf16x8*)(As + (16 * ti + fr) * 136 + 32 * ks + 8 * fq), bb = *(const LAS bf16x8*)(Kb + (16 * tj + fr) * 136 + 32 * ks + 8 * fq);
                d = __builtin_amdgcn_mfma_f32_16x16x32_bf16(a, bb, d, 0, 0, 0); }
            const int j = 16 * tj + fr; const float gj = gcs[j], bj = bts[j]; float val[4];
#pragma unroll
            for (int e = 0; e < 4; ++e) { const int t = 16 * ti + 4 * fq + e; const float x = d[e] * __expf(gcs[t] - gj) * bj; val[e] = (kind ? (t >= j) : (t > j)) ? x : 0.f; }
            if (kind == 0) *(LAS f32x4*)(LsT + j * 68 + 16 * ti + 4 * fq) = (f32x4){val[0], val[1], val[2], val[3]};
            else {
#pragma unroll
                for (int e = 0; e < 4; ++e) ATs[(16 * ti + 4 * fq + e) * 72 + j] = (bf16)(pk2(val[e], 0.f) & 0xffffu); }
        }
        __syncthreads();
        float R[64];
        if (wave < 4) {
            if (wave < 2) {
#pragma unroll
                for (int t = 0; t < 64; ++t) R[t] = Vs[t * 132 + 64 * wave + lane];
            } else {
#pragma unroll
                for (int t = 0; t < 64; ++t) R[t] = egs[t] * Ks[t * 132 + 64 * (wave - 2) + lane];
            }
            SolveCol<0>::run(R, (unsigned)(uintptr_t)LsT);
            if (wave < 2) {
                float* uvp = UV + (size_t)task * 64 * 128 + 64 * wave + lane; asm volatile("" : "+v"(uvp));
#pragma unroll
                for (int t = 0; t < 64; ++t) { uvp[t * 128] = R[t]; if ((t & 7) == 7) asm volatile("" : "+v"(uvp)); }
            } else {
#pragma unroll
                for (int t = 0; t < 64; ++t) WKs[t * 136 + 64 * (wave - 2) + lane] = (bf16)(pk2(R[t], 0.f) & 0xffffu);
            }
        } else {
            const int rt = tid - 256;
            for (int q = rt; q < 1024; q += 256) { const int blk = q >> 6, l2 = q & 63, i = l2 & 15, f = l2 >> 4, mb = blk >> 2, ks = blk & 3, t = 16 * mb + i;
                const v2u p0 = *(const LAS v2u*)(Qb + t * 136 + 32 * ks + 4 * f), p1 = *(const LAS v2u*)(Qb + t * 136 + 32 * ks + 16 + 4 * f); const float e = egs[t];
                v4u o; o.x = pk2(bflo(p0.x) * e, bfhi(p0.x) * e); o.y = pk2(bflo(p0.y) * e, bfhi(p0.y) * e); o.z = pk2(bflo(p1.x) * e, bfhi(p1.x) * e); o.w = pk2(bflo(p1.y) * e, bfhi(p1.y) * e);
                *(v4u*)(gops + 16384 + q * 16) = o; }
            for (int q = rt; q < 512; q += 256) { const int blk = q >> 6, l2 = q & 63, i = l2 & 15, f = l2 >> 4, mb = blk >> 1, ks2 = blk & 1, t = 16 * mb + i;
                v2u p0 = (v2u){0u, 0u}, p1 = (v2u){0u, 0u};
                if (2 * ks2 <= mb) p0 = *(const LAS v2u*)(ATs + t * 72 + 32 * ks2 + 4 * f);
                if (2 * ks2 + 1 <= mb) p1 = *(const LAS v2u*)(ATs + t * 72 + 32 * ks2 + 16 + 4 * f);
                *(v4u*)(gops + 32768 + q * 16) = (v4u){p0.x, p0.y, p1.x, p1.y}; }
            for (int q = rt; q < 1024; q += 256) { const int blk = q >> 6, l2 = q & 63, i = l2 & 15, f = l2 >> 4, dkb = blk >> 1, ks2 = blk & 1, dk = 16 * dkb + i; float v[8];
#pragma unroll
                for (int e = 0; e < 8; ++e) { const int c = 32 * ks2 + 16 * (e >> 2) + 4 * f + (e & 3); v[e] = Ks[c * 132 + dk] * kes[c]; }
                *(v4u*)(gops + 40960 + q * 16) = (v4u){pk2(v[0], v[1]), pk2(v[2], v[3]), pk2(v[4], v[5]), pk2(v[6], v[7])}; }
        }
        __syncthreads();
        for (int q = tid; q < 1024; q += NTHR) { const int blk = q >> 6, l2 = q & 63, i = l2 & 15, f = l2 >> 4, mb = blk >> 2, ks = blk & 3, t = 16 * mb + i;
            const v2u p0 = *(const LAS v2u*)(WKs + t * 136 + 32 * ks + 4 * f), p1 = *(const LAS v2u*)(WKs + t * 136 + 32 * ks + 16 + 4 * f);
            *(v4u*)(gops + q * 16) = (v4u){p0.x, p0.y, p1.x, p1.y}; }
        __syncthreads();
    }
}

__device__ __forceinline__ bf16x8 pack8(const f32x4 a, const f32x4 b) {
    v4u w; w.x = pk2(a[0], a[1]); w.y = pk2(a[2], a[3]); w.z = pk2(b[0], b[1]); w.w = pk2(b[2], b[3]); return __builtin_bit_cast(bf16x8, w);
}
__device__ __forceinline__ void gdn_scan(const Args& A, LAS unsigned char* lds, int bh, int tid, int lane, int wave) {
    const int b = bh >> 2, h = bh & 3, fr = lane & 15, fq = lane >> 4, vs = wave;
    const unsigned char* gops = (const unsigned char*)A.out + (size_t)bh * 32 * GOPS_CHUNK;
    const float* UV = (const float*)(A.ws + WS_XN) + (size_t)bh * 32 * 64 * 128; const float* GE = (const float*)(A.ws + WS_GE) + bh * 32;
    const bf16* PROJ = (const bf16*)(A.ws + WS_PROJ); bf16* CAT = (bf16*)(A.ws + WS_CAT);
    LAS float* ssqp = (LAS float*)(lds + 2 * GOPS_CHUNK);
    const float gwv = A.in[6][16 * vs + fr];
    f32x4 S[8];
#pragma unroll
    for (int i = 0; i < 8; ++i) S[i] = (f32x4){0.f, 0.f, 0.f, 0.f};
    float uvc[16], uvn[16];
#define SCAN_DMA(chunk, bufoff) do { for (int p_ = wave; p_ < 56; p_ += 8) __builtin_amdgcn_global_load_lds((const unsigned*)(gops + (size_t)(chunk) * GOPS_CHUNK + p_ * 1024 + lane * 16), (LAS unsigned*)(lds + (bufoff) + p_ * 1024), 16, 0, 0); } while (0)
    SCAN_DMA(0, 0);
#pragma unroll
    for (int i = 0; i < 16; ++i) uvc[i] = UV[(size_t)(16 * (i >> 2) + 4 * fq + (i & 3)) * 128 + 16 * vs + fr];
    asm volatile("s_waitcnt vmcnt(0)" ::: "memory"); __syncthreads();
#pragma unroll 1
    for (int n = 0; n < 32; ++n) {
        const LAS unsigned char* cur = lds + (n & 1) * GOPS_CHUNK;
        if (n + 1 < 32) { SCAN_DMA(n + 1, ((n + 1) & 1) * GOPS_CHUNK);
#pragma unroll
            for (int i = 0; i < 16; ++i) uvn[i] = UV[((size_t)(n + 1) * 64 + 16 * (i >> 2) + 4 * fq + (i & 3)) * 128 + 16 * vs + fr]; }
        const size_t row0 = (size_t)b * SEQ + 64 * n;
        unsigned short zr[16];
#pragma unroll
        for (int i = 0; i < 16; ++i) zr[i] = PROJ[(row0 + 16 * (i >> 2) + 4 * fq + (i & 3)) * NP + PC_Z + h * 128 + 16 * vs + fr];
        const float ge = GE[n];
        bf16x8 Sb[4];
#pragma unroll
        for (int ks = 0; ks < 4; ++ks) Sb[ks] = pack8(S[2 * ks], S[2 * ks + 1]);
        f32x4 u[4];
#pragma unroll
        for (int mb = 0; mb < 4; ++mb) { f32x4 p = (f32x4){0.f, 0.f, 0.f, 0.f};
#pragma unroll
            for (int ks = 0; ks < 4; ++ks) p = __builtin_amdgcn_mfma_f32_16x16x32_bf16(*(const LAS bf16x8*)(cur + ((mb * 4 + ks) * 64 + lane) * 16), Sb[ks], p, 0, 0, 0);
            u[mb] = (f32x4){uvc[4 * mb] - p[0], uvc[4 * mb + 1] - p[1], uvc[4 * mb + 2] - p[2], uvc[4 * mb + 3] - p[3]}; }
        bf16x8 ub[2]; ub[0] = pack8(u[0], u[1]); ub[1] = pack8(u[2], u[3]);
        f32x4 o[4];
#pragma unroll
        for (int mb = 0; mb < 4; ++mb) { f32x4 acc = (f32x4){0.f, 0.f, 0.f, 0.f};
#pragma unroll
            for (int ks = 0; ks < 4; ++ks) acc = __builtin_amdgcn_mfma_f32_16x16x32_bf16(*(const LAS bf16x8*)(cur + 16384 + ((mb * 4 + ks) * 64 + lane) * 16), Sb[ks], acc, 0, 0, 0);
#pragma unroll
            for (int ks2 = 0; ks2 < 2; ++ks2) if (ks2 <= (mb >> 1)) acc = __builtin_amdgcn_mfma_f32_16x16x32_bf16(*(const LAS bf16x8*)(cur + 32768 + ((mb * 2 + ks2) * 64 + lane) * 16), ub[ks2], acc, 0, 0, 0);
            o[mb] = acc; }
#pragma unroll
        for (int dkb = 0; dkb < 8; ++dkb) { f32x4 acc = S[dkb] * ge;
#pragma unroll
            for (int ks2 = 0; ks2 < 2; ++ks2) acc = __builtin_amdgcn_mfma_f32_16x16x32_bf16(*(const LAS bf16x8*)(cur + 40960 + ((dkb * 2 + ks2) * 64 + lane) * 16), ub[ks2], acc, 0, 0, 0);
            S[dkb] = acc; }
#pragma unroll
        for (int i = 0; i < 16; ++i) { float s = o[i >> 2][i & 3]; s *= s; s += __shfl_xor(s, 1); s += __shfl_xor(s, 2); s += __shfl_xor(s, 4); s += __shfl_xor(s, 8);
            if (fr == 0) ssqp[(16 * (i >> 2) + 4 * fq + (i & 3)) * 8 + wave] = s; }
        __syncthreads();
#pragma unroll
        for (int i = 0; i < 16; ++i) { const int t = 16 * (i >> 2) + 4 * fq + (i & 3); const f32x4 p0 = *(const LAS f32x4*)(ssqp + t * 8), p1 = *(const LAS f32x4*)(ssqp + t * 8 + 4);
            const float ms = ((p0.x + p0.y) + (p0.z + p0.w) + (p1.x + p1.y) + (p1.z + p1.w)) * (1.0f / 128.0f), r = rsqrtf(ms + RMS_EPS);
            const float y = o[i >> 2][i & 3] * r * gwv * silu_f(bf2f(zr[i]));
            CAT[(row0 + t) * DM + h * 128 + 16 * vs + fr] = (bf16)(pk2(y, 0.f) & 0xffffu); }
#pragma unroll
        for (int i = 0; i < 16; ++i) uvc[i] = uvn[i];
        asm volatile("s_waitcnt vmcnt(0)" ::: "memory"); __syncthreads();
    }
#undef SCAN_DMA
}


__device__ __forceinline__ void attn_fast(const Args& A, LAS unsigned char* lds, int lane, int wave) {
    const bf16* PROJ = (const bf16*)(A.ws + WS_PROJ); bf16* CAT = (bf16*)(A.ws + WS_CAT);
    unsigned* ctr = (unsigned*)(A.ws + WS_CTL);
    LAS bf16* Vt = (LAS bf16*)(lds + wave * 8192);
    const int fr = lane & 15, fq = lane >> 4;
    const int kk = lane & 31, vslot = 8 * ((kk & 15) >> 2) + 4 * (kk >> 4) + (kk & 3), vch = lane >> 5;
    constexpr float SC = 0.125f * 1.4426950408889634f;
    for (;;) {
        unsigned wt_ = 0; if (lane == 0) wt_ = atomicAdd(ctr, 1u); const int wt = __builtin_amdgcn_readfirstlane(wt_);
        if (wt >= NB * AH * 8 * 16) break;
        const int T = 7 - (wt >> 10), rem = wt & 1023, b = rem >> 7, h = (rem >> 4) & 7, c = rem & 15, t0 = 256 * T;
        const bf16* Pb = PROJ + (size_t)b * SEQ * NP;
        const int tq = t0 + c + 16 * fr;
        bf16x8 qf[2];
#pragma unroll
        for (int ks = 0; ks < 2; ++ks) qf[ks] = *(const bf16x8*)(Pb + (size_t)tq * NP + PC_QB + h * 64 + 32 * ks + 8 * fq);
        const int lo2 = c, n2 = ((t0 + 240) >> 4) + 1, g2 = (n2 + 31) >> 5;
        const int lo1 = max(t0 + c - 512, c & 3), n1 = ((t0 + c + 240 - lo1) >> 2) + 1, g1 = (n1 + 31) >> 5;
        const int lo0 = max(t0 + c - 128, 0), n0 = (t0 + c + 240 - lo0) + 1, g0 = (n0 + 31) >> 5;
        const int NG = g2 + g1 + g0;
        f32x4 O[4];
#pragma unroll
        for (int i = 0; i < 4; ++i) O[i] = (f32x4){0.f, 0.f, 0.f, 0.f};
        float mrun = -INFINITY, lrun = 0.f;
        v4u kc[4], vc[4], kn[4], vn[4];
#define ATT_DEC(f, kst, str) do { if ((f) < g2) { str = 16; kst = lo2 + 512 * (f); } else if ((f) < g2 + g1) { str = 4; kst = lo1 + 128 * ((f) - g2); } else { str = 1; kst = lo0 + 32 * ((f) - g2 - g1); } } while (0)
#define ATT_LOAD(kreg, vreg, kst, str) do { \
            _Pragma("unroll") for (int j = 0; j < 2; ++j) { const int tk = min((kst) + (str) * (16 * j + fr), SEQ - 1); \
                _Pragma("unroll") for (int ks = 0; ks < 2; ++ks) kreg[2 * j + ks] = *(const v4u*)(Pb + (size_t)tk * NP + PC_KB + h * 64 + 32 * ks + 8 * fq); } \
            { const int tk = min((kst) + (str) * kk, SEQ - 1); \
                _Pragma("unroll") for (int i = 0; i < 4; ++i) vreg[i] = *(const v4u*)(Pb + (size_t)tk * NP + PC_VB + h * 64 + 8 * (vch + 2 * i)); } } while (0)
        int kst, str; ATT_DEC(0, kst, str); ATT_LOAD(kc, vc, kst, str);
#pragma unroll 1
        for (int f = 0; f < NG; ++f) {
            int kstn = 0, strn = 1;
            if (f + 1 < NG) { ATT_DEC(f + 1, kstn, strn); ATT_LOAD(kn, vn, kstn, strn); }
            f32x4 d0 = (f32x4){0.f, 0.f, 0.f, 0.f}, d1 = d0;
#pragma unroll
            for (int ks = 0; ks < 2; ++ks) { d0 = __builtin_amdgcn_mfma_f32_16x16x32_bf16(__builtin_bit_cast(bf16x8, kc[ks]), qf[ks], d0, 0, 0, 0);
                                             d1 = __builtin_amdgcn_mfma_f32_16x16x32_bf16(__builtin_bit_cast(bf16x8, kc[2 + ks]), qf[ks], d1, 0, 0, 0); }
#pragma unroll
            for (int i = 0; i < 4; ++i) { const int dd = 8 * (vch + 2 * i); const v4u w = vc[i];
                Vt[(dd + 0) * 40 + vslot] = (bf16)(w.x & 0xffffu); Vt[(dd + 1) * 40 + vslot] = (bf16)(w.x >> 16); Vt[(dd + 2) * 40 + vslot] = (bf16)(w.y & 0xffffu); Vt[(dd + 3) * 40 + vslot] = (bf16)(w.y >> 16);
                Vt[(dd + 4) * 40 + vslot] = (bf16)(w.z & 0xffffu); Vt[(dd + 5) * 40 + vslot] = (bf16)(w.z >> 16); Vt[(dd + 6) * 40 + vslot] = (bf16)(w.w & 0xffffu); Vt[(dd + 7) * 40 + vslot] = (bf16)(w.w >> 16); }
            float s[8]; const int span = 128 * str; float mloc = -INFINITY;
#pragma unroll
            for (int e = 0; e < 8; ++e) { const int tk = kst + str * (16 * (e >> 2) + 4 * fq + (e & 3)); const int dt = tq - tk; const float x = (e < 4 ? d0[e & 3] : d1[e & 3]) * SC;
                s[e] = (dt >= 0 && dt <= span) ? x : -INFINITY; mloc = fmaxf(mloc, s[e]); }
            mloc = fmaxf(mloc, __shfl_xor(mloc, 16)); mloc = fmaxf(mloc, __shfl_xor(mloc, 32));
            const float mnew = fmaxf(mrun, mloc), alpha = __builtin_amdgcn_exp2f(mrun - mnew); mrun = mnew;
            float psum = 0.f;
#pragma unroll
            for (int e = 0; e < 8; ++e) { s[e] = __builtin_amdgcn_exp2f(s[e] - mnew); psum += s[e]; }
            lrun = lrun * alpha + psum;
            const bf16x8 pb = pack8((f32x4){s[0], s[1], s[2], s[3]}, (f32x4){s[4], s[5], s[6], s[7]});
#pragma unroll
            for (int db = 0; db < 4; ++db) { const bf16x8 a = *(const LAS bf16x8*)(Vt + (16 * db + fr) * 40 + 8 * fq);
                O[db] = __builtin_amdgcn_mfma_f32_16x16x32_bf16(a, pb, O[db] * alpha, 0, 0, 0); }
#pragma unroll
            for (int i = 0; i < 4; ++i) { kc[i] = kn[i]; vc[i] = vn[i]; }
            kst = kstn; str = strn;
        }
#undef ATT_DEC
#undef ATT_LOAD
        lrun += __shfl_xor(lrun, 16); lrun += __shfl_xor(lrun, 32);
        const float inv = 1.0f / lrun;
        bf16* op = CAT + ((size_t)b * SEQ + tq) * DM + GW + h * 64 + 4 * fq;
#pragma unroll
        for (int db = 0; db < 4; ++db) { v2u w; w.x = pk2(O[db][0] * inv, O[db][1] * inv); w.y = pk2(O[db][2] * inv, O[db][3] * inv); *(v2u*)(op + 16 * db) = w; }
    }
}

__device__ __forceinline__ void attn_simple(const Args& A, int tid, int lane, int wave) {
    const bf16* PROJ = (const bf16*)(A.ws + WS_PROJ); bf16* CAT = (bf16*)(A.ws + WS_CAT);
    unsigned* ctr = (unsigned*)(A.ws + WS_CTL);
    for (;;) {
        unsigned wt_ = 0; if (lane == 0) wt_ = atomicAdd(ctr, 1u); const int wt = __builtin_amdgcn_readfirstlane(wt_);
        if (wt >= (M / 64) * AH) break;
        const int h = wt % AH, tb = wt / AH, row = tb * 64 + lane, b = row / SEQ, t = row % SEQ;
        float q[64], acc[64];
        { const v4u* qp = (const v4u*)(PROJ + (size_t)row * NP + PC_QB + h * 64);
#pragma unroll
          for (int j = 0; j < 8; ++j) { const v4u w = qp[j]; q[8 * j + 0] = bflo(w.x) * 0.125f; q[8 * j + 1] = bfhi(w.x) * 0.125f; q[8 * j + 2] = bflo(w.y) * 0.125f; q[8 * j + 3] = bfhi(w.y) * 0.125f;
              q[8 * j + 4] = bflo(w.z) * 0.125f; q[8 * j + 5] = bfhi(w.z) * 0.125f; q[8 * j + 6] = bflo(w.w) * 0.125f; q[8 * j + 7] = bfhi(w.w) * 0.125f; } }
#pragma unroll
        for (int j = 0; j < 64; ++j) acc[j] = 0.f;
        float mx = -1e30f, l = 0.f;
        for (int br = 0; br < 3; ++br) {
            const int stride = br == 0 ? 1 : (br == 1 ? 4 : 16);
            for (int i = 0; i <= 128; ++i) {
                const int tk = t - i * stride; if (tk < 0) break;
                const size_t krow = (size_t)(b * SEQ + tk) * NP;
                const v4u* kp = (const v4u*)(PROJ + krow + PC_KB + h * 64); const v4u* vp = (const v4u*)(PROJ + krow + PC_VB + h * 64);
                float s = 0.f;
#pragma unroll
                for (int j = 0; j < 8; ++j) { const v4u w = kp[j]; s += q[8 * j + 0] * bflo(w.x) + q[8 * j + 1] * bfhi(w.x) + q[8 * j + 2] * bflo(w.y) + q[8 * j + 3] * bfhi(w.y)
                                                                       + q[8 * j + 4] * bflo(w.z) + q[8 * j + 5] * bfhi(w.z) + q[8 * j + 6] * bflo(w.w) + q[8 * j + 7] * bfhi(w.w); }
                const float mn = fmaxf(mx, s), sc = __expf(mx - mn), p = __expf(s - mn); mx = mn; l = l * sc + p;
#pragma unroll
                for (int j = 0; j < 8; ++j) { const v4u w = vp[j];
                    acc[8 * j + 0] = acc[8 * j + 0] * sc + p * bflo(w.x); acc[8 * j + 1] = acc[8 * j + 1] * sc + p * bfhi(w.x); acc[8 * j + 2] = acc[8 * j + 2] * sc + p * bflo(w.y); acc[8 * j + 3] = acc[8 * j + 3] * sc + p * bfhi(w.y);
                    acc[8 * j + 4] = acc[8 * j + 4] * sc + p * bflo(w.z); acc[8 * j + 5] = acc[8 * j + 5] * sc + p * bfhi(w.z); acc[8 * j + 6] = acc[8 * j + 6] * sc + p * bflo(w.w); acc[8 * j + 7] = acc[8 * j + 7] * sc + p * bfhi(w.w); }
            }
        }
        const float inv = 1.0f / l; v4u* op = (v4u*)(CAT + (size_t)row * DM + GW + h * 64);
#pragma unroll
        for (int j = 0; j < 8; ++j) { v4u w; w.x = pk2(acc[8 * j] * inv, acc[8 * j + 1] * inv); w.y = pk2(acc[8 * j + 2] * inv, acc[8 * j + 3] * inv); w.z = pk2(acc[8 * j + 4] * inv, acc[8 * j + 5] * inv); w.w = pk2(acc[8 * j + 6] * inv, acc[8 * j + 7] * inv); op[j] = w; }
    }
}
__device__ __forceinline__ void gated_norm(const Args& A, int lane, int wave) {
    const bf16* PROJ = (const bf16*)(A.ws + WS_PROJ); bf16* CAT = (bf16*)(A.ws + WS_CAT); const float* OA = (const float*)(A.ws + WS_OA); const float* gw = A.in[6];
    const float w0 = gw[2 * lane], w1 = gw[2 * lane + 1];
    for (int wt = blockIdx.x * NWAVES + wave; wt < M * GH; wt += gridDim.x * NWAVES) {
        const int row = wt / GH, h = wt % GH;
        const float2 o = *(const float2*)(OA + (size_t)row * GW + h * 128 + 2 * lane);
        const unsigned zz = *(const unsigned*)(PROJ + (size_t)row * NP + PC_Z + h * 128 + 2 * lane);
        const float ms = wave_sum(o.x * o.x + o.y * o.y) * (1.0f / 128.0f), r = rsqrtf(ms + RMS_EPS);
        *(unsigned*)(CAT + (size_t)row * DM + h * 128 + 2 * lane) = pk2(o.x * r * w0 * silu_f(bflo(zz)), o.y * r * w1 * silu_f(bfhi(zz)));
    }
}
__device__ __forceinline__ void ffn_conv_half(const Args& A, int half, int tid) {
    const bf16* Y = (const bf16*)(A.ws + WS_Y); bf16* ACT = (bf16*)(A.ws + WS_ACT); const float* fw = A.in[10];
    constexpr int HC = DFF / 2;
    for (size_t it = (size_t)blockIdx.x * NTHR + tid; it < (size_t)M * (HC / 8); it += (size_t)gridDim.x * NTHR) {
        const int row = (int)(it / (HC / 8)), g8 = (int)(it % (HC / 8)), cl = g8 * 8, pn = cl >> 7, j = cl & 127, t = row % SEQ, ch = half * HC + cl;
        float ga[8], ua[8];
#pragma unroll
        for (int e = 0; e < 8; ++e) { ga[e] = 0.f; ua[e] = 0.f; }
#pragma unroll
        for (int i = 0; i < 3; ++i) { const int ts = t - 2 + i; if (ts < 0) continue;
            const bf16* yr = Y + (size_t)(row - 2 + i) * DFF + 256 * pn + j; const v4u g = *(const v4u*)yr, u = *(const v4u*)(yr + 128);
            const f32x4 wg0 = *(const f32x4*)(fw + i * NUP + ch), wg1 = *(const f32x4*)(fw + i * NUP + ch + 4), wu0 = *(const f32x4*)(fw + i * NUP + DFF + ch), wu1 = *(const f32x4*)(fw + i * NUP + DFF + ch + 4);
            ga[0] += wg0.x * bflo(g.x); ga[1] += wg0.y * bfhi(g.x); ga[2] += wg0.z * bflo(g.y); ga[3] += wg0.w * bfhi(g.y); ga[4] += wg1.x * bflo(g.z); ga[5] += wg1.y * bfhi(g.z); ga[6] += wg1.z * bflo(g.w); ga[7] += wg1.w * bfhi(g.w);
            ua[0] += wu0.x * bflo(u.x); ua[1] += wu0.y * bfhi(u.x); ua[2] += wu0.z * bflo(u.y); ua[3] += wu0.w * bfhi(u.y); ua[4] += wu1.x * bflo(u.z); ua[5] += wu1.y * bfhi(u.z); ua[6] += wu1.z * bflo(u.w); ua[7] += wu1.w * bfhi(u.w); }
        v4u o; o.x = pk2(silu_f(ga[0]) * ua[0], silu_f(ga[1]) * ua[1]); o.y = pk2(silu_f(ga[2]) * ua[2], silu_f(ga[3]) * ua[3]); o.z = pk2(silu_f(ga[4]) * ua[4], silu_f(ga[5]) * ua[5]); o.w = pk2(silu_f(ga[6]) * ua[6], silu_f(ga[7]) * ua[7]);
        *(v4u*)(ACT + (size_t)row * DFF + ch) = o;
    }
}
__device__ __forceinline__ void final_norm(const Args& A, int lane, int wave) {
    float* out = A.out; const float* fnw = A.in[12];
    for (int m = blockIdx.x * NWAVES + wave; m < M; m += gridDim.x * NWAVES) {
        f32x4* xr = (f32x4*)(out + (size_t)m * DM) + lane; const f32x4* nr = (const f32x4*)fnw + lane;
        f32x4 v[4]; float s = 0.f;
#pragma unroll
        for (int j = 0; j < 4; ++j) { v[j] = xr[64 * j]; s += (v[j].x * v[j].x + v[j].y * v[j].y) + (v[j].z * v[j].z + v[j].w * v[j].w); }
        const float rstd = rsqrtf(wave_sum(s) * (1.f / DM) + RMS_EPS);
#pragma unroll
        for (int j = 0; j < 4; ++j) { const f32x4 n = nr[64 * j]; xr[64 * j] = (f32x4){v[j].x * rstd * n.x, v[j].y * rstd * n.y, v[j].z * rstd * n.z, v[j].w * rstd * n.w}; }
    }
}

#define XB_TMO      128
#define XB_XCNT(j)  (256  + 64 * (j))
#define XB_XSUB(j)  (1280 + 64 * (j))
#define XB_XGEN(j)  (2304 + 64 * (j))
#define XB_TOP      3328
#define XB_TOPGEN   3392
#define XCD_BAR_WORDS 3456
#define XB_SPIN_CAP (1u << 18)

__device__ __forceinline__ unsigned xb_ld(unsigned* p)              { return __hip_atomic_load(p, __ATOMIC_RELAXED, __HIP_MEMORY_SCOPE_AGENT); }
__device__ __forceinline__ unsigned xb_add(unsigned* p, unsigned v) { return __hip_atomic_fetch_add(p, v, __ATOMIC_RELAXED, __HIP_MEMORY_SCOPE_AGENT); }
__device__ __forceinline__ unsigned xb_xcc_id() { return (unsigned)__builtin_amdgcn_s_getreg((3 << 11) | 20) & 0xFu; }
#define XB_SPIN(cond, bar) do { unsigned _sp = 0; while (cond) { __builtin_amdgcn_s_sleep(1); \
    if ((++_sp & 255u) == 0u) { if (xb_ld(&(bar)[XB_TMO])) break; if (_sp > XB_SPIN_CAP) { atomicAdd(&(bar)[XB_TMO], 1u); break; } } } } while (0)

struct XcdBarrier {
    unsigned* bar; unsigned x;
    volatile LAS unsigned* st;
};

__device__ __forceinline__ XcdBarrier xcd_barrier_post(unsigned* bar, volatile LAS unsigned* st) {
    XcdBarrier b; b.bar = bar; b.x = xb_xcc_id(); b.st = st;
    if (threadIdx.x == 0) (void)xb_add(&bar[XB_XCNT(b.x)], 1u);
    return b;
}
__device__ __forceinline__ void xcd_barrier_complete(unsigned* bar, unsigned x, unsigned& nloc, unsigned& nx) {
    const unsigned G = gridDim.x * gridDim.y * gridDim.z;
    unsigned sum, cnt, mine, sp = 0u;
    for (;;) {
        sum = 0u; cnt = 0u; mine = 0u;
#pragma unroll
        for (unsigned j = 0; j < 16; ++j) { const unsigned c = xb_ld(&bar[XB_XCNT(j)]); sum += c; cnt += (c > 0u) ? 1u : 0u; mine = (j == x) ? c : mine; }
        if (sum == G) break;
        __builtin_amdgcn_s_sleep(1);
        if ((++sp & 255u) == 0u) { if (xb_ld(&bar[XB_TMO])) break; if (sp > XB_SPIN_CAP) { atomicAdd(&bar[XB_TMO], 1u); break; } }
    }
    nloc = mine > 0u ? mine : 1u; nx = cnt > 0u ? cnt : 1u;
}

__device__ __forceinline__ void xcd_barrier(const XcdBarrier& b) {
    asm volatile("s_waitcnt vmcnt(0)" ::: "memory");
    __syncthreads();
    if (threadIdx.x == 0) {
        unsigned* bar = b.bar;
        __builtin_amdgcn_s_waitcnt(0);
        unsigned nloc = b.st[0], nx = b.st[1];
        if (nloc == 0u) { xcd_barrier_complete(bar, b.x, nloc, nx); b.st[0] = nloc; b.st[1] = nx; }
        const unsigned old = xb_add(&bar[XB_XSUB(b.x)], 1u);
        const unsigned gen = old / nloc;
        if (old + 1u == (gen + 1u) * nloc) {
            __builtin_amdgcn_fence(__ATOMIC_RELEASE, "agent");
            asm volatile("s_waitcnt vmcnt(0)" ::: "memory");
            const unsigned og = xb_add(&bar[XB_TOP], 1u);
            const unsigned tg = og / nx;
            if (og + 1u == (tg + 1u) * nx) xb_add(&bar[XB_TOPGEN], 1u);
            else XB_SPIN(xb_ld(&bar[XB_TOPGEN]) == tg, bar);
            __builtin_amdgcn_fence(__ATOMIC_ACQUIRE, "agent");
            xb_add(&bar[XB_XGEN(b.x)], 1u);
            asm volatile("s_waitcnt vmcnt(0)" ::: "memory");
        } else {
            XB_SPIN(xb_ld(&bar[XB_XGEN(b.x)]) == gen, bar);
            __builtin_amdgcn_fence(__ATOMIC_ACQUIRE, "agent");
            asm volatile("s_waitcnt vmcnt(0)" ::: "memory");
        }
    }
    __syncthreads();
}

constexpr int N_PHASES = 11;
__global__ void __launch_bounds__(NTHR, 2) mk_fwd(Args args) {
    extern __shared__ __attribute__((aligned(16))) unsigned char lds_raw[];
    LAS unsigned char* lds = (LAS unsigned char*)lds_raw;
    const int tid = threadIdx.x, lane = tid & 63, wave = __builtin_amdgcn_readfirstlane(tid >> 6);
    const int lo = args.ph_lo, hi = args.ph_hi;
    unsigned char* ws = args.ws;
    bf16* WIN = (bf16*)(ws + WS_WIN); bf16* WOUT = (bf16*)(ws + WS_WOUT); bf16* WUP = (bf16*)(ws + WS_WUP); bf16* WDN = (bf16*)(ws + WS_WDN);
    bf16* XN = (bf16*)(ws + WS_XN); bf16* PROJ = (bf16*)(ws + WS_PROJ); bf16* CAT = (bf16*)(ws + WS_CAT); bf16* Y = (bf16*)(ws + WS_Y); bf16* ACT = (bf16*)(ws + WS_ACT);
    float* SSQ = (float*)(ws + WS_SSQ);
#define IN(k) (lo <= (k) && (k) < hi)
#define SEAM(k) do { if (IN(k) && IN((k) + 1)) { if ((k) == 0) cg::this_grid().sync(); else xcd_barrier(bar); } } while (0)
    { volatile LAS unsigned* st = (volatile LAS unsigned*)(lds + LDS_BYTES - 64); if (tid < 2) st[tid] = 0u; }
    __syncthreads();
    XcdBarrier bar = xcd_barrier_post((unsigned*)(ws + WS_CTL) + 4096, (volatile LAS unsigned*)(lds + LDS_BYTES - 64));
    if (IN(0)) { p0_prologue(args, lds, tid, lane, wave); } SEAM(0);
    if (IN(1)) { pg8::Gemm g{XN, WIN, M, NP, DM}; pg8::StaticOrder S; S.init(M, NP, gridDim.x, blockIdx.x); pg8::EpiBf16S E{PROJ, NP, nullptr};
        pg8::gemm_phase<pg8::EpiBf16S, pg8::StaticOrder, PG8_ALIGN, PG8_SP2>(lds, g, S, E); } SEAM(1);
    if (IN(2)) { gdn_prep(args, lds, tid, lane, wave); } SEAM(2);
    if (IN(3)) { if (blockIdx.x < NB * GH) gdn_scan(args, lds, blockIdx.x, tid, lane, wave); attn_fast(args, lds, lane, wave); } SEAM(3);
    if (IN(4)) { pg8::Gemm g{CAT, WOUT, M, DM, DM}; pg8::StaticOrder S; S.init(M, DM, gridDim.x, blockIdx.x); pg8::EpiResid E{args.in[0], args.out, XN, SSQ, DM};
        pg8::gemm_phase<pg8::EpiResid, pg8::StaticOrder, PG8_ALIGN, PG8_SP2>(lds, g, S, E); } SEAM(4);
#pragma unroll 1
    for (int half = 0; half < 2; ++half) {
        if (IN(5 + 2 * half)) { pg8::Gemm g{XN, WUP + (size_t)half * DFF * DM, M, DFF, DM}; pg8::StaticOrder S; S.init(M, DFF, gridDim.x, blockIdx.x); pg8::EpiBf16S E{Y, DFF, SSQ};
            pg8::gemm_phase<pg8::EpiBf16S, pg8::StaticOrder, PG8_ALIGN, PG8_SP2>(lds, g, S, E); } SEAM(5 + 2 * half);
        if (IN(6 + 2 * half)) { ffn_conv_half(args, half, tid); } SEAM(6 + 2 * half);
    }
    if (IN(9)) { pg8::Gemm g{ACT, WDN, M, DM, DFF}; pg8::StaticOrder S; S.init(M, DM, gridDim.x, blockIdx.x); pg8::EpiResid E{args.out, args.out, nullptr, nullptr, DM};
        pg8::gemm_phase<pg8::EpiResid, pg8::StaticOrder, PG8_ALIGN, PG8_SP2>(lds, g, S, E); } SEAM(9);
    if (IN(10)) { final_norm(args, lane, wave); }
#undef IN
#undef SEAM
}

#ifndef MK_ONE_LAUNCH
#define MK_ONE_LAUNCH 1
#endif
extern "C" void kernel_launch(void* const* d_in, const int* in_sizes, int n_in, void* d_out, int out_size, void* d_ws, size_t ws_size, hipStream_t stream) {
    static int grid = 0;
    if (grid == 0) {
        if (n_in != 13 || out_size != M * DM || ws_size < WS_END) { fprintf(stderr, "kernel_launch: unexpected shapes n_in %d out %d ws %zu\n", n_in, out_size, ws_size); grid = -1; return; }
        int dev = 0, cus = 0, per_cu = 0;
        hipGetDevice(&dev); hipDeviceGetAttribute(&cus, hipDeviceAttributeMultiprocessorCount, dev);
        hipFuncSetAttribute((const void*)mk_fwd, hipFuncAttributeMaxDynamicSharedMemorySize, LDS_BYTES);
        hipOccupancyMaxActiveBlocksPerMultiprocessor(&per_cu, (const void*)mk_fwd, NTHR, LDS_BYTES);
        (void)hipGetLastError();
        if (per_cu < 1) { fprintf(stderr, "kernel_launch: occupancy query says %d blocks per CU\n", per_cu); per_cu = 1; }
        grid = cus;
    }
    if (grid < 0) return;
    if (hipMemsetAsync((char*)d_ws + WS_CTL, 0, 65536, stream) != hipSuccess) { fprintf(stderr, "kernel_launch: memset failed\n"); return; }
    Args a{};
    for (int i = 0; i < 13; ++i) a.in[i] = (const float*)d_in[i];
    a.out = (float*)d_out; a.ws = (unsigned char*)d_ws;
#if MK_ONE_LAUNCH
    a.ph_lo = 0; a.ph_hi = N_PHASES; a.coop = 1;
    void* kargs[] = {&a};
    hipError_t e = hipLaunchCooperativeKernel((const void*)mk_fwd, dim3(grid), dim3(NTHR), kargs, LDS_BYTES, stream);
    if (e != hipSuccess) fprintf(stderr, "cooperative launch failed: %s (grid %d)\n", hipGetErrorString(e), grid);
#else
    for (int p = 0; p < N_PHASES; ++p) { a.ph_lo = p; a.ph_hi = p + 1; a.coop = 0; hipLaunchKernelGGL(mk_fwd, dim3(grid), dim3(NTHR), LDS_BYTES, stream, a); }
#endif
}
```

```cpp
#include <hip/hip_runtime.h>
#include <hip/hip_cooperative_groups.h>
#include <cstdio>
#include <cstdint>
namespace cg = cooperative_groups;
namespace pg8 {
#define PG8_LAS __attribute__((address_space(3)))
typedef unsigned short bf16_t;
typedef short bf16x8 __attribute__((ext_vector_type(8)));
typedef float f32x4 __attribute__((ext_vector_type(4)));
typedef unsigned u32x4 __attribute__((ext_vector_type(4)));
constexpr int BM = 256, BK = 64, HALF = 128, HTB = HALF * BK * 2  , STAGE_BYTES = 8 * HTB, NXCD = 8, WGM = 8;

__host__ __device__ __forceinline__ int lds_byte(int r, int c) { const int st = (r >> 4) * 2 + (c >> 5), rr = r & 15, cc = c & 31, ob = rr * 64 + cc * 2; return st * 1024 + (ob ^ (((ob >> 9) & 1) << 5)); }
__host__ __device__ __forceinline__ void stage_rc(int b, int& R, int& C) { const int st = b / 1024, sb = b % 1024, swz = sb ^ (((sb >> 9) & 1) << 5); R = (st >> 1) * 16 + swz / 64; C = (st & 1) * 32 + (swz % 64) / 2; }
__host__ __device__ __forceinline__ int perm32(int rho) { const int n = rho >> 4, i = rho & 15; return 8 * (i >> 2) + 4 * n + (i & 3); }

struct Unit { int pm, pn; };
struct Gemm { const bf16_t* A; const bf16_t* Bt; int M, N, K; };

struct StaticOrder {
    int nM, nN, nwg, G, c;
    __host__ __device__ void init(int M, int N, int G_, int c_) { nM = M / BM; nN = N / BM; nwg = nM * nN; G = G_; c = c_; }
    __host__ __device__ bool next(int i, Unit& u) const {
        const long L = (long)i * G + c; if (L >= nwg) return false;
        int wgid = (int)L; { const int q = nwg / NXCD, r = nwg % NXCD, xcd = wgid % NXCD, off = wgid / NXCD; wgid = (xcd < r ? xcd * (q + 1) : r * (q + 1) + (xcd - r) * q) + off; }
        const int nig = WGM * nN, gid = wgid / nig, fm = gid * WGM, gsz = (nM - fm) < WGM ? (nM - fm) : WGM;
        u.pm = fm + ((wgid % nig) % gsz); u.pn = (wgid % nig) / gsz; return true;
    }
    __device__ __forceinline__ void a_ready(const Unit&) const {}
    __device__ __forceinline__ void done(const Unit&) const {}
};

__device__ __forceinline__ unsigned cvt_pk_bf16(float lo, float hi) { unsigned r; asm volatile("v_cvt_pk_bf16_f32 %0, %1, %2" : "=v"(r) : "v"(lo), "v"(hi)); return r; }
constexpr float RMS_EPS = 1e-6f;
struct EpiBf16S {
    static constexpr bool PERM = true, AFTER_DRAIN = false;
    bf16_t* O; int ldc; const float* ssq;
    __device__ __forceinline__ void operator()(const f32x4 (&acc)[2][2][4][2], const Unit& u, int wr, int wc, int fr, int fq) const {
        const int row0 = u.pm * BM + wr * 64 + fr; const int col0 = u.pn * BM + wc * 32 + 8 * fq;
#pragma unroll
        for (int ai = 0; ai < 2; ++ai)
#pragma unroll
            for (int m = 0; m < 4; ++m) { const int row = row0 + ai * HALF + m * 16; bf16_t* rowp = O + (size_t)row * ldc + col0;
                const float sc = ssq ? rsqrtf(ssq[row] * (1.0f / 1024.0f) + RMS_EPS) : 1.0f;
#pragma unroll
                for (int bj = 0; bj < 2; ++bj) { const f32x4 v0 = acc[ai][bj][m][0] * sc, v1 = acc[ai][bj][m][1] * sc;
                    u32x4 w; w.x = cvt_pk_bf16(v0[0], v0[1]); w.y = cvt_pk_bf16(v0[2], v0[3]); w.z = cvt_pk_bf16(v1[0], v1[1]); w.w = cvt_pk_bf16(v1[2], v1[3]);
                    *(u32x4*)(rowp + bj * HALF) = w; } }
    }
};
struct EpiResid {
    static constexpr bool PERM = false, AFTER_DRAIN = false;
    const float* base; float* out; bf16_t* xb; float* ssq; int ldc;
    __device__ __forceinline__ void operator()(const f32x4 (&acc)[2][2][4][2], const Unit& u, int wr, int wc, int fr, int fq) const {
        typedef unsigned u32x2v __attribute__((ext_vector_type(2)));
        const int col0 = u.pn * BM + wc * 32 + 4 * fq;
#pragma unroll
        for (int ai = 0; ai < 2; ++ai)
#pragma unroll
            for (int m = 0; m < 4; ++m) { const int row = u.pm * BM + ai * HALF + wr * 64 + m * 16 + fr; const size_t off = (size_t)row * ldc + col0; float s = 0.f;
#pragma unroll
                for (int bj = 0; bj < 2; ++bj)
#pragma unroll
                    for (int n = 0; n < 2; ++n) { const f32x4 v = acc[ai][bj][m][n] + *(const f32x4*)(base + off + bj * HALF + n * 16);
                        *(f32x4*)(out + off + bj * HALF + n * 16) = v; s += (v[0] * v[0] + v[1] * v[1]) + (v[2] * v[2] + v[3] * v[3]);
                        if (xb) { u32x2v w; w.x = cvt_pk_bf16(v[0], v[1]); w.y = cvt_pk_bf16(v[2], v[3]); *(u32x2v*)(xb + off + bj * HALF + n * 16) = w; } }
                if (ssq) { s += __shfl_xor(s, 16); s += __shfl_xor(s, 32); if (fq == 0) atomicAdd(ssq + row, s); }
                asm volatile("" ::: "memory"); }
    }
};
template <class Epi, class Sched, bool ALIGN_EPI = false, bool SP2 = false>
__device__ __forceinline__ void gemm_phase(PG8_LAS unsigned char* lds, const Gemm g, const Sched& S, const Epi& E) {
    const int tid = threadIdx.x, wid = __builtin_amdgcn_readfirstlane(tid >> 6), lane = tid & 63, wr = wid >> 2, wc = wid & 3, fr = lane & 15, fq = lane >> 4;
    const int K = g.K, nt = K / BK;
    unsigned voffA[2], voffB[2];
#pragma unroll
    for (int i = 0; i < 2; ++i) { int R, C; stage_rc(tid * 16 + i * 8192, R, C); const int Rb = Epi::PERM ? ((R & ~31) + perm32(R & 31)) : R;
        voffA[i] = (unsigned)(R * K + C) * 2u; voffB[i] = (unsigned)(Rb * K + C) * 2u; }
    const size_t kstep = (size_t)(BK * 2);
    const size_t hstep = (size_t)HALF * K * 2;
    const size_t tstep = 2 * hstep;
    const unsigned ldsw = (unsigned)wid * 1024u;
    const int aoff = lds_byte(wr * 64 + fr, fq * 8), boff = lds_byte(wc * 32 + fr, fq * 8);
#define PG8_SA(b, h) (((b) * 2 + (h)) * HTB)
#define PG8_SB(b, h) ((4 + (b) * 2 + (h)) * HTB)
#define PG8_STAGE(bufoff, gbase, voff) do { _Pragma("unroll") for (int _i = 0; _i < 2; ++_i) \
        __builtin_amdgcn_global_load_lds((const unsigned*)((const char*)(gbase) + (voff)[_i]), (PG8_LAS unsigned*)(lds + (bufoff) + ldsw + _i * 8192), 16, 0, 0); } while (0)
#define PG8_LDA(dst, b, h) do { _Pragma("unroll") for (int m = 0; m < 4; ++m) _Pragma("unroll") for (int k = 0; k < 2; ++k) dst[m][k] = *(const PG8_LAS bf16x8*)(lds + PG8_SA(b, h) + aoff + m * 2048 + k * 1024); } while (0)
#define PG8_LDB(dst, b, h) do { _Pragma("unroll") for (int n = 0; n < 2; ++n) _Pragma("unroll") for (int k = 0; k < 2; ++k) dst[n][k] = *(const PG8_LAS bf16x8*)(lds + PG8_SB(b, h) + boff + n * 2048 + k * 1024); } while (0)
#define PG8_MMA(ai, bj, At, Bt) do { __builtin_amdgcn_s_setprio(1); _Pragma("unroll") for (int m = 0; m < 4; ++m) _Pragma("unroll") for (int n = 0; n < 2; ++n) _Pragma("unroll") for (int k = 0; k < 2; ++k) \
        acc[ai][bj][m][n] = __builtin_amdgcn_mfma_f32_16x16x32_bf16(Bt[n][k], At[m][k], acc[ai][bj][m][n], 0, 0, 0); __builtin_amdgcn_s_setprio(0); } while (0)
#define PG8_WAIT_V(n) asm volatile("s_waitcnt vmcnt(" #n ")" ::: "memory")
#define PG8_WAIT_L(n) asm volatile("s_waitcnt lgkmcnt(" #n ")" ::: "memory")
#define PG8_BAR __builtin_amdgcn_s_barrier()
#define PG8_SCHED __builtin_amdgcn_sched_barrier(0)
    Unit cur, nxt; int ui = 0;
    if (!S.next(0, cur)) return;
    f32x4 acc[2][2][4][2];
#pragma unroll
    for (int a = 0; a < 2; ++a)
#pragma unroll
        for (int b = 0; b < 2; ++b)
#pragma unroll
            for (int m = 0; m < 4; ++m)
#pragma unroll
                for (int n = 0; n < 2; ++n) acc[a][b][m][n] = (f32x4){0.f, 0.f, 0.f, 0.f};
    bf16x8 At[4][2], B0[2][2], B1[2][2];
    const char* cA = (const char*)g.A + (size_t)cur.pm * tstep; const char* cB = (const char*)g.Bt + (size_t)cur.pn * tstep;
    S.a_ready(cur);
    if constexpr (SP2) {
        PG8_STAGE(PG8_SB(0, 0), cB, voffB); PG8_STAGE(PG8_SB(0, 1), cB + hstep, voffB); PG8_STAGE(PG8_SA(0, 0), cA, voffA); PG8_STAGE(PG8_SA(0, 1), cA + hstep, voffA);
        if (wr == 1) PG8_BAR;
        PG8_WAIT_V(2); PG8_BAR;
        PG8_STAGE(PG8_SB(1, 0), cB + kstep, voffB); PG8_STAGE(PG8_SA(1, 0), cA + kstep, voffA); PG8_STAGE(PG8_SB(1, 1), cB + hstep + kstep, voffB);
        PG8_WAIT_V(6); PG8_BAR;
    } else {
        PG8_STAGE(PG8_SB(0, 0), cB, voffB); PG8_STAGE(PG8_SA(0, 0), cA, voffA); PG8_STAGE(PG8_SB(0, 1), cB + hstep, voffB); PG8_STAGE(PG8_SA(0, 1), cA + hstep, voffA);
        if (wr == 1) PG8_BAR;
        PG8_WAIT_V(4); PG8_BAR;
        PG8_STAGE(PG8_SB(1, 0), cB + kstep, voffB); PG8_STAGE(PG8_SA(1, 0), cA + kstep, voffA); PG8_STAGE(PG8_SB(1, 1), cB + hstep + kstep, voffB);
        PG8_WAIT_V(6); PG8_BAR;
    }
    for (;;) {
        const bool has_next = S.next(ui + 1, nxt);
        const char* nA = has_next ? (const char*)g.A + (size_t)nxt.pm * tstep : cA; const char* nB = has_next ? (const char*)g.Bt + (size_t)nxt.pn * tstep : cB;
        for (int t = 0; t < nt; t += 2) {
            const bool last = (t == nt - 2);
            const char* a1 = cA + (size_t)(t + 1) * kstep;
            const char* a2 = last ? nA : cA + (size_t)(t + 2) * kstep; const char* b2 = last ? nB : cB + (size_t)(t + 2) * kstep;
            const char* a3 = a2 + kstep; const char* b3 = b2 + kstep;
            if (last && has_next) S.a_ready(nxt);
            if constexpr (SP2) {
            PG8_LDB(B0, 0, 0); PG8_LDB(B1, 0, 1); PG8_SCHED; PG8_LDA(At, 0, 0); PG8_STAGE(PG8_SA(1, 1), a1 + hstep, voffA);
            PG8_WAIT_V(8); PG8_WAIT_L(0); PG8_BAR; PG8_MMA(0, 0, At, B0); PG8_MMA(0, 1, At, B1); PG8_BAR; PG8_SCHED;
            PG8_LDA(At, 0, 1); PG8_STAGE(PG8_SB(0, 0), b2, voffB); PG8_STAGE(PG8_SB(0, 1), b2 + hstep, voffB); PG8_STAGE(PG8_SA(0, 0), a2, voffA);
            PG8_WAIT_V(8); PG8_WAIT_L(0); PG8_BAR; PG8_MMA(1, 0, At, B0); PG8_MMA(1, 1, At, B1); PG8_BAR; PG8_SCHED;
            PG8_LDB(B0, 1, 0); PG8_LDB(B1, 1, 1); PG8_SCHED; PG8_LDA(At, 1, 0); PG8_STAGE(PG8_SA(0, 1), a2 + hstep, voffA);
            PG8_WAIT_V(8); PG8_WAIT_L(0); PG8_BAR; PG8_MMA(0, 0, At, B0); PG8_MMA(0, 1, At, B1); PG8_BAR; PG8_SCHED;
            PG8_LDA(At, 1, 1); PG8_STAGE(PG8_SB(1, 0), b3, voffB); PG8_STAGE(PG8_SB(1, 1), b3 + hstep, voffB); PG8_STAGE(PG8_SA(1, 0), a3, voffA);
            PG8_WAIT_V(8); PG8_WAIT_L(0); PG8_BAR; PG8_MMA(1, 0, At, B0); PG8_MMA(1, 1, At, B1); PG8_BAR; PG8_SCHED;
            } else {
            PG8_LDB(B0, 0, 0); PG8_SCHED; PG8_LDA(At, 0, 0); PG8_STAGE(PG8_SA(1, 1), a1 + hstep, voffA);
            PG8_WAIT_L(8); PG8_BAR; PG8_WAIT_L(0); PG8_MMA(0, 0, At, B0); PG8_BAR; PG8_SCHED;
            PG8_LDB(B1, 0, 1); PG8_STAGE(PG8_SB(0, 0), b2, voffB);
            PG8_BAR; PG8_WAIT_L(0); PG8_MMA(0, 1, At, B1); PG8_BAR;
            PG8_LDA(At, 0, 1); PG8_STAGE(PG8_SA(0, 0), a2, voffA);
            PG8_BAR; PG8_WAIT_L(0); PG8_MMA(1, 0, At, B0); PG8_BAR; PG8_SCHED;
            PG8_STAGE(PG8_SB(0, 1), b2 + hstep, voffB);
            PG8_WAIT_V(6); PG8_BAR; PG8_MMA(1, 1, At, B1); PG8_BAR;
            PG8_LDB(B0, 1, 0); PG8_SCHED; PG8_LDA(At, 1, 0); PG8_STAGE(PG8_SA(0, 1), a2 + hstep, voffA);
            PG8_WAIT_L(8); PG8_BAR; PG8_WAIT_L(0); PG8_MMA(0, 0, At, B0); PG8_BAR; PG8_SCHED;
            PG8_LDB(B1, 1, 1); PG8_STAGE(PG8_SB(1, 0), b3, voffB);
            PG8_BAR; PG8_WAIT_L(0); PG8_MMA(0, 1, At, B1); PG8_BAR;
            PG8_LDA(At, 1, 1); PG8_STAGE(PG8_SA(1, 0), a3, voffA);
            PG8_BAR; PG8_WAIT_L(0); PG8_MMA(1, 0, At, B0); PG8_BAR; PG8_SCHED;
            PG8_STAGE(PG8_SB(1, 1), b3 + hstep, voffB);
            PG8_WAIT_V(6); PG8_BAR; PG8_MMA(1, 1, At, B1); PG8_BAR;
            }
        }
        if constexpr (ALIGN_EPI) { if (wr == 0) PG8_BAR; }
        if constexpr (!Epi::AFTER_DRAIN) { E(acc, cur, wr, wc, fr, fq); S.done(cur); }
        if (!has_next) break;
#pragma unroll
        for (int a = 0; a < 2; ++a)
#pragma unroll
            for (int b = 0; b < 2; ++b)
#pragma unroll
                for (int m = 0; m < 4; ++m)
#pragma unroll
                    for (int n = 0; n < 2; ++n) acc[a][b][m][n] = (f32x4){0.f, 0.f, 0.f, 0.f};
        cur = nxt; cA = nA; cB = nB; ++ui;
        if constexpr (ALIGN_EPI) { if (wr == 1) PG8_BAR; }
    }
    PG8_WAIT_V(0);
    if constexpr (!ALIGN_EPI) { if (wr == 0) PG8_BAR; }
    PG8_BAR;
    if constexpr (Epi::AFTER_DRAIN) { E.fused(acc, cur, wr, wc, fr, fq, lds, wid, lane); S.done(cur); }
#undef PG8_SA
#undef PG8_SB
#undef PG8_STAGE
#undef PG8_LDA
#undef PG8_LDB
#undef PG8_MMA
#undef PG8_WAIT_V
#undef PG8_WAIT_L
#undef PG8_BAR
#undef PG8_SCHED
}
}
#ifndef PG8_SP2
#define PG8_SP2 true
#endif
#ifndef PG8_ALIGN
#define PG8_ALIGN true
#endif
constexpr int NB = 8, SEQ = 2048, DM = 1024, M = NB * SEQ;
constexpr int GH = 4, GD = 128, GW = 512, AH = 8, AD = 64;
constexpr int INC = 3592, NP = 3584;
constexpr int DFF = 2816, NUP = 2 * DFF;
constexpr int PC_QA = 0, PC_KA = 512, PC_VA = 1024, PC_Z = 1536, PC_QB = 2048, PC_KB = 2560, PC_VB = 3072;
constexpr size_t MiB = 1u << 20;
constexpr size_t WS_CTL = 0, WS_AB = 1 * MiB, WS_SSQ = 1 * MiB + 768 * 1024, WS_WIN = 2 * MiB, WS_WOUT = 9 * MiB, WS_WUP = 11 * MiB, WS_WDN = 22 * MiB;
constexpr size_t WS_XN = 28 * MiB, WS_PROJ = 60 * MiB, WS_CAT = 172 * MiB, WS_OA = 204 * MiB, WS_Y = 60 * MiB, WS_ACT = 148 * MiB, WS_END = 256 * MiB;
using pg8::RMS_EPS;
constexpr size_t WS_GE = WS_SSQ + 65536;
constexpr int GOPS_CHUNK = 57344;
constexpr int SCAN_BUF = GOPS_CHUNK + 16384;
constexpr int NWAVES = 8, NTHR = 512;
constexpr int LDS_BYTES = 155648;
#define LAS __attribute__((address_space(3)))
typedef unsigned short bf16;
typedef unsigned v4u __attribute__((ext_vector_type(4)));
typedef unsigned v2u __attribute__((ext_vector_type(2)));
typedef float f32x4 __attribute__((ext_vector_type(4)));
__device__ __forceinline__ float bf2f(unsigned b) { return __uint_as_float(b << 16); }
__device__ __forceinline__ float bflo(unsigned w) { return __uint_as_float(w << 16); }
__device__ __forceinline__ float bfhi(unsigned w) { return __uint_as_float(w & 0xffff0000u); }
__device__ __forceinline__ unsigned pk2(float lo, float hi) { return pg8::cvt_pk_bf16(lo, hi); }
__device__ __forceinline__ float wave_sum(float v) {
#pragma unroll
    for (int o = 1; o < 64; o <<= 1) v += __shfl_xor(v, o);
    return v;
}
__device__ __forceinline__ float silu_f(float x) { return x / (1.0f + __expf(-x)); }
__device__ __forceinline__ float sigmoid_f(float x) { return 1.0f / (1.0f + __expf(-x)); }
__device__ __forceinline__ float softplus_f(float x) { return x > 20.f ? x : log1pf(__expf(x)); }

struct Args { const float* in[13]; float* out; unsigned char* ws; int ph_lo, ph_hi, coop, pad; };

__device__ __forceinline__ void p0_transpose_item(const float* W, int ldw, int k0, int sn0, bf16* WT, int K, int dn0, const float* kscale, LAS float* scr, int lane) {
#pragma unroll 8
    for (int i = 0; i < 32; ++i) { const int kk = 2 * i + (lane >> 5); float v = W[(size_t)(k0 + kk) * ldw + sn0 + (lane & 31)]; if (kscale) v *= kscale[k0 + kk]; scr[kk * 33 + (lane & 31)] = v; }
    asm volatile("s_waitcnt lgkmcnt(0)" ::: "memory");
    const int c = lane & 7;
#pragma unroll
    for (int j = 0; j < 4; ++j) { const int n = (lane >> 3) + 8 * j; const LAS float* s = scr + (8 * c) * 33 + n;
        v4u o; o.x = pk2(s[0 * 33], s[1 * 33]); o.y = pk2(s[2 * 33], s[3 * 33]); o.z = pk2(s[4 * 33], s[5 * 33]); o.w = pk2(s[6 * 33], s[7 * 33]);
        *(v4u*)(WT + (size_t)(dn0 + n) * K + k0 + 8 * c) = o; }
    asm volatile("s_waitcnt lgkmcnt(0)" ::: "memory");
}

__device__ __forceinline__ void p0_prologue(const Args& A, LAS unsigned char* lds, int tid, int lane, int wave) {
    const float* x = A.in[0]; const float* nw1 = A.in[1]; const float* w_in = A.in[2]; const float* w_out = A.in[7]; const float* nw2 = A.in[8];
    const float* w_up = A.in[9]; const float* w_dn = A.in[11];
    unsigned char* ws = A.ws;
    bf16* WIN = (bf16*)(ws + WS_WIN); bf16* WOUT = (bf16*)(ws + WS_WOUT); bf16* WUP = (bf16*)(ws + WS_WUP); bf16* WDN = (bf16*)(ws + WS_WDN);
    bf16* XN = (bf16*)(ws + WS_XN); float* AB = (float*)(ws + WS_AB); float* SSQ = (float*)(ws + WS_SSQ);
    LAS float* scr = (LAS float*)(lds + wave * 9216);
    LAS float* wab = (LAS float*)(lds + 73728);
    const int G = gridDim.x, gw = blockIdx.x * NWAVES + wave, NGW = G * NWAVES;
    for (int i = blockIdx.x * NTHR + tid; i < M; i += G * NTHR) SSQ[i] = 0.f;
    if (blockIdx.x == 0 && tid < 64) ((unsigned*)(ws + WS_CTL))[tid] = 0u;
    for (int idx = tid; idx < 8192; idx += NTHR) { const int k = idx >> 3, j = idx & 7; wab[j * 1024 + k] = nw1[k] * w_in[(size_t)k * INC + 2048 + j]; }
    constexpr int I_IN = 16 * (NP / 32), I_OUT = 16 * 32, I_UP = 16 * (NUP / 32), I_DN = (DFF / 64) * 32;
    constexpr int NITEMS = I_IN + I_OUT + I_UP + I_DN;
    for (int it = gw; it < NITEMS; it += NGW) {
        int r = it;
        if (r < I_IN) { const int nblk = NP / 32, kb = r / nblk, nb = r % nblk, n0 = 32 * nb; p0_transpose_item(w_in, INC, 64 * kb, n0 + (n0 >= 2048 ? 8 : 0), WIN, DM, n0, nullptr, scr, lane); continue; } r -= I_IN;
        if (r < I_OUT) { const int kb = r / 32, nb = r % 32; p0_transpose_item(w_out, DM, 64 * kb, 32 * nb, WOUT, DM, 32 * nb, nullptr, scr, lane); continue; } r -= I_OUT;
        if (r < I_UP) { const int nblk = NUP / 32, kb = r / nblk, nb = r % nblk, n0 = 32 * nb, pn = n0 >> 8, j0 = n0 & 255;
            const int s0 = (j0 < 128) ? (128 * pn + j0) : (DFF + 128 * pn + j0 - 128);
            p0_transpose_item(w_up, NUP, 64 * kb, s0, WUP, DM, n0, nw2, scr, lane); continue; } r -= I_UP;
        { const int kb = r / 32, nb = r % 32; p0_transpose_item(w_dn, DM, 64 * kb, 32 * nb, WDN, DFF, 32 * nb, nullptr, scr, lane); }
    }
    __syncthreads();
    for (int m = gw; m < M; m += NGW) {
        const f32x4* xr = (const f32x4*)(x + (size_t)m * DM) + lane; const f32x4* nr = (const f32x4*)nw1 + lane;
        f32x4 v[4]; float s = 0.f;
#pragma unroll
        for (int j = 0; j < 4; ++j) { v[j] = xr[64 * j]; s += (v[j].x * v[j].x + v[j].y * v[j].y) + (v[j].z * v[j].z + v[j].w * v[j].w); }
        const float rstd = rsqrtf(wave_sum(s) * (1.f / DM) + RMS_EPS);
        float ab[8];
#pragma unroll
        for (int q = 0; q < 8; ++q) { float a = 0.f;
#pragma unroll
            for (int j = 0; j < 4; ++j) { const f32x4 w = *(const LAS f32x4*)(wab + q * 1024 + 256 * j + 4 * lane); a += (v[j].x * w.x + v[j].y * w.y) + (v[j].z * w.z + v[j].w * w.w); }
            ab[q] = wave_sum(a) * rstd; }
        if (lane == 0) { *(f32x4*)(AB + (size_t)m * 8) = (f32x4){ab[0], ab[1], ab[2], ab[3]}; *(f32x4*)(AB + (size_t)m * 8 + 4) = (f32x4){ab[4], ab[5], ab[6], ab[7]}; }
        v2u* o8 = (v2u*)(XN + (size_t)m * DM) + lane;
#pragma unroll
        for (int j = 0; j < 4; ++j) { const f32x4 n = nr[64 * j]; v2u o; o.x = pk2(v[j].x * rstd * n.x, v[j].y * rstd * n.y); o.y = pk2(v[j].z * rstd * n.z, v[j].w * rstd * n.w); o8[64 * j] = o; }
    }
}

__device__ __forceinline__ void gdn_simple(const Args& A, LAS unsigned char* lds, int tid, int lane, int wave) {
    const bf16* PROJ = (const bf16*)(A.ws + WS_PROJ); const float* AB = (const float*)(A.ws + WS_AB); float* OA = (float*)(A.ws + WS_OA);
    const float* cw = A.in[3]; const float* a_log = A.in[4]; const float* dt_bias = A.in[5];
    LAS float* qs = (LAS float*)lds; LAS float* ks = qs + 16 * 128; LAS float* vs = ks + 16 * 128; LAS float* av = vs + 16 * 128; LAS float* bv = av + 16;
    for (int task = blockIdx.x; task < NB * GH; task += gridDim.x) {
        const int b = task / GH, h = task % GH, v = tid >> 2, part = tid & 3;
        float S[32];
#pragma unroll
        for (int i = 0; i < 32; ++i) S[i] = 0.f;
        const float Ah = __expf(a_log[h]), dtb = dt_bias[h];
        for (int blk = 0; blk < SEQ / 16; ++blk) {
            const int t0 = blk * 16;
            for (int idx = tid; idx < 16 * 384; idx += NTHR) {
                const int tt = idx / 384, c = idx % 384, which = c >> 7, d = c & 127, col = which * 512 + h * 128 + d, t = t0 + tt;
                float acc = 0.f;
#pragma unroll
                for (int i = 0; i < 4; ++i) { const int ts = t - 3 + i; if (ts >= 0) acc += cw[i * 1536 + col] * bf2f(PROJ[(size_t)(b * SEQ + ts) * NP + col]); }
                qs[which * 2048 + tt * 128 + d] = silu_f(acc);
            }
            if (tid < 16) { const size_t row = (size_t)b * SEQ + t0 + tid; bv[tid] = sigmoid_f(AB[row * 8 + h]); av[tid] = __expf(-Ah * softplus_f(AB[row * 8 + 4 + h] + dtb)); }
            __syncthreads();
#pragma unroll
            for (int r = 0; r < 4; ++r) { const int row = 4 * wave + r; LAS float* arr = qs + row * 128;
                const float v0 = arr[lane], v1 = arr[lane + 64]; const float s = wave_sum(v0 * v0 + v1 * v1);
                const float sc = rsqrtf(s + RMS_EPS) * (row < 16 ? 0.08838834764831845f : 1.0f); arr[lane] = v0 * sc; arr[lane + 64] = v1 * sc; }
            __syncthreads();
            for (int tt = 0; tt < 16; ++tt) {
                const float a = av[tt], bt = bv[tt], vt = vs[tt * 128 + v];
                float kS = 0.f;
#pragma unroll
                for (int i = 0; i < 32; ++i) kS += ks[tt * 128 + 32 * part + i] * S[i];
                kS += __shfl_xor(kS, 1); kS += __shfl_xor(kS, 2);
                const float c = bt * (vt - a * kS); float o = 0.f;
#pragma unroll
                for (int i = 0; i < 32; ++i) { S[i] = a * S[i] + ks[tt * 128 + 32 * part + i] * c; o += qs[tt * 128 + 32 * part + i] * S[i]; }
                o += __shfl_xor(o, 1); o += __shfl_xor(o, 2);
                if (part == 0) OA[(size_t)(b * SEQ + t0 + tt) * GW + h * 128 + v] = o;
            }
            __syncthreads();
        }
    }
}


template <int J, int K, int N> struct SolveLd {
    static __device__ __forceinline__ void run(f32x4 (&l)[16], unsigned lbase) {
        if constexpr (K < N) { constexpr int t40 = ((J + 1) >> 2) << 2;
            asm volatile("ds_read_b128 %0, %1 offset:%2" : "=v"(l[K]) : "v"(lbase), "i"((J * 68 + t40 + 4 * K) * 4)); SolveLd<J, K + 1, N>::run(l, lbase); }
    }
};
template <int J> struct SolveCol {
    static __device__ __forceinline__ void run(float (&R)[64], unsigned lbase) {
        if constexpr (J < 63) {
            constexpr int t40 = ((J + 1) >> 2) << 2, nld = (64 - t40) >> 2;
            f32x4 l[16];
            SolveLd<J, 0, nld>::run(l, lbase);
            asm volatile("s_waitcnt lgkmcnt(0)" ::: "memory");
#pragma unroll
            for (int k = 0; k < nld; ++k) asm volatile("" : "+v"(l[k]));
#pragma unroll
            for (int k = 0; k < nld; ++k) {
#pragma unroll
                for (int e = 0; e < 4; ++e) if (t40 + 4 * k + e > J) R[t40 + 4 * k + e] -= l[k][e] * R[J]; }
            SolveCol<J + 1>::run(R, lbase);
        }
    }
};

typedef short bf16x8 __attribute__((ext_vector_type(8)));
__device__ __forceinline__ void gdn_prep(const Args& A, LAS unsigned char* lds, int tid0, int lane0, int wave) {
    const bf16* PROJ = (const bf16*)(A.ws + WS_PROJ); const float* AB = (const float*)(A.ws + WS_AB);
    const float* cw = A.in[3]; const float* a_log = A.in[4]; const float* dt_bias = A.in[5];
    unsigned char* UVF = A.ws + WS_XN; unsigned char* GOPS = (unsigned char*)A.out; float* GE = (float*)(A.ws + WS_GE);
    LAS float* Qs = (LAS float*)lds; LAS float* Ks = (LAS float*)(lds + 33792); LAS float* Vs = (LAS float*)(lds + 67584);
    LAS bf16* Qb = (LAS bf16*)(lds + 101376); LAS bf16* Kb = (LAS bf16*)(lds + 118784);
    LAS float* gcs = (LAS float*)(lds + 136192); LAS float* bts = gcs + 64; LAS float* egs = gcs + 128; LAS float* kes = gcs + 192;
    LAS float* LsT = (LAS float*)lds; LAS bf16* ATs = (LAS bf16*)(lds + 17408); LAS bf16* WKs = Kb;
#pragma unroll 1
    for (int task = blockIdx.x; task < NB * GH * 32; task += gridDim.x) {
        int tid = tid0, lane = lane0; asm volatile("" : "+v"(tid), "+v"(lane));
        const int fr = lane & 15, fq = lane >> 4;
        const int bh = task >> 5, n = task & 31, b = bh >> 2, h = bh & 3, t0 = 64 * n, row0 = b * SEQ + t0;
        unsigned char* gops = GOPS + (size_t)task * GOPS_CHUNK;
        for (int idx = tid; idx < 3072; idx += NTHR) {
            const int tt = idx / 48, c8 = idx % 48, which = c8 >> 4, d0 = (c8 & 15) * 8, col = which * 512 + h * 128 + d0;
            float acc[8];
#pragma unroll
            for (int e = 0; e < 8; ++e) acc[e] = 0.f;
#pragma unroll
            for (int i = 0; i < 4; ++i) { const int ts = t0 + tt - 3 + i; if (ts < 0) continue;
                const v4u w = *(const v4u*)(PROJ + (size_t)(b * SEQ + ts) * NP + col); const f32x4 c0 = *(const f32x4*)(cw + i * 1536 + col), c1 = *(const f32x4*)(cw + i * 1536 + col + 4);
                acc[0] += c0.x * bflo(w.x); acc[1] += c0.y * bfhi(w.x); acc[2] += c0.z * bflo(w.y); acc[3] += c0.w * bfhi(w.y);
                acc[4] += c1.x * bflo(w.z); acc[5] += c1.y * bfhi(w.z); acc[6] += c1.z * bflo(w.w); acc[7] += c1.w * bfhi(w.w); }
            LAS float* dst = (which == 0 ? Qs : (which == 1 ? Ks : Vs)) + tt * 132 + d0;
            *(LAS f32x4*)dst = (f32x4){silu_f(acc[0]), silu_f(acc[1]), silu_f(acc[2]), silu_f(acc[3])};
            *(LAS f32x4*)(dst + 4) = (f32x4){silu_f(acc[4]), silu_f(acc[5]), silu_f(acc[6]), silu_f(acc[7])};
        }
        if (wave == 0) {
            const size_t row = (size_t)row0 + lane; const float beta = sigmoid_f(AB[row * 8 + h]);
            float g = -__expf(a_log[h]) * softplus_f(AB[row * 8 + 4 + h] + dt_bias[h]);
#pragma unroll
            for (int o = 1; o < 64; o <<= 1) { const float t = __shfl_up(g, o); if (lane >= o) g += t; }
            const float glast = __shfl(g, 63);
            gcs[lane] = g; bts[lane] = beta; egs[lane] = __expf(g); kes[lane] = __expf(glast - g) * beta;
            if (lane == 63) GE[task] = __expf(g);
        }
        __syncthreads();
#pragma unroll 2
        for (int r = 0; r < 8; ++r) { const int row = 8 * wave + r;
            { const float v0 = Qs[row * 132 + lane], v1 = Qs[row * 132 + lane + 64]; const float sc = rsqrtf(wave_sum(v0 * v0 + v1 * v1) + RMS_EPS) * 0.08838834764831845f;
              Qb[row * 136 + lane] = (bf16)(pk2(v0 * sc, 0.f) & 0xffffu); Qb[row * 136 + lane + 64] = (bf16)(pk2(v1 * sc, 0.f) & 0xffffu); }
            { const float v0 = Ks[row * 132 + lane], v1 = Ks[row * 132 + lane + 64]; const float sc = rsqrtf(wave_sum(v0 * v0 + v1 * v1) + RMS_EPS);
              Ks[row * 132 + lane] = v0 * sc; Ks[row * 132 + lane + 64] = v1 * sc; Kb[row * 136 + lane] = (bf16)(pk2(v0 * sc, 0.f) & 0xffffu); Kb[row * 136 + lane + 64] = (bf16)(pk2(v1 * sc, 0.f) & 0xffffu); }
        }
        __syncthreads();
#pragma unroll 1
        for (int jb = wave; jb < 20; jb += 8) {
            const int kind = jb >= 10 ? 1 : 0, idx = jb - 10 * kind, ti = idx < 1 ? 0 : (idx < 3 ? 1 : (idx < 6 ? 2 : 3)), tj = idx - ti * (ti + 1) / 2;
            const LAS bf16* As = kind ? Qb : Kb; f32x4 d = (f32x4){0.f, 0.f, 0.f, 0.f};
#pragma unroll
            for (int ks = 0; ks < 4; ++ks) { const bf16x8 a = *(const LAS bf16x8*)(As + (16 * ti + fr) * 136 + 32 * ks + 8 * fq), bb = *(const LAS bf16x8*)(Kb + (16 * tj + fr) * 136 + 32 * ks + 8 * fq);
                d = __builtin_amdgcn_mfma_f32_16x16x32_bf16(a, bb, d, 0, 0, 0); }
            const int j = 16 * tj + fr; const float gj = gcs[j], bj = bts[j]; float val[4];
#pragma unroll
            for (int e = 0; e < 4; ++e) { const int t = 16 * ti + 4 * fq + e; const float x = d[e] * __expf(gcs[t] - gj) * bj; val[e] = (kind ? (t >= j) : (t > j)) ? x : 0.f; }
            if (kind == 0) *(LAS f32x4*)(LsT + j * 68 + 16 * ti + 4 * fq) = (f32x4){val[0], val[1], val[2], val[3]};
            else {
#pragma unroll
                for (int e = 0; e < 4; ++e) ATs[(16 * ti + 4 * fq + e) * 72 + j] = (bf16)(pk2(val[e], 0.f) & 0xffffu); }
        }
        __syncthreads();
        float R[64];
        if (wave < 4) {
            if (wave < 2) {
#pragma unroll
                for (int t = 0; t < 64; ++t) R[t] = Vs[t * 132 + 64 * wave + lane];
            } else {
#pragma unroll
                for (int t = 0; t < 64; ++t) R[t] = egs[t] * Ks[t * 132 + 64 * (wave - 2) + lane];
            }
            SolveCol<0>::run(R, (unsigned)(uintptr_t)LsT);
            if (wave < 2) {
                const int v = 64 * wave + lane; unsigned char* uvp = UVF + (size_t)task * 16384 + (size_t)((v >> 4) * 4 * 64 + (v & 15)) * 8; asm volatile("" : "+v"(uvp));
#pragma unroll
                for (int g = 0; g < 16; ++g) { v2u w; w.x = pk2(R[4 * g], R[4 * g + 1]); w.y = pk2(R[4 * g + 2], R[4 * g + 3]); *(v2u*)(uvp + ((g >> 2) * 64 + 16 * (g & 3)) * 8) = w; }
            } else {
#pragma unroll
                for (int t = 0; t < 64; ++t) WKs[t * 136 + 64 * (wave - 2) + lane] = (bf16)(pk2(R[t], 0.f) & 0xffffu);
            }
        } else {
            const int rt = tid - 256;
            for (int q = rt; q < 1024; q += 256) { const int blk = q >> 6, l2 = q & 63, i = l2 & 15, f = l2 >> 4, mb = blk >> 2, ks = blk & 3, t = 16 * mb + i;
                const v2u p0 = *(const LAS v2u*)(Qb + t * 136 + 32 * ks + 4 * f), p1 = *(const LAS v2u*)(Qb + t * 136 + 32 * ks + 16 + 4 * f); const float e = egs[t];
                v4u o; o.x = pk2(bflo(p0.x) * e, bfhi(p0.x) * e); o.y = pk2(bflo(p0.y) * e, bfhi(p0.y) * e); o.z = pk2(bflo(p1.x) * e, bfhi(p1.x) * e); o.w = pk2(bflo(p1.y) * e, bfhi(p1.y) * e);
                *(v4u*)(gops + 16384 + q * 16) = o; }
            for (int q = rt; q < 512; q += 256) { const int blk = q >> 6, l2 = q & 63, i = l2 & 15, f = l2 >> 4, mb = blk >> 1, ks2 = blk & 1, t = 16 * mb + i;
                v2u p0 = (v2u){0u, 0u}, p1 = (v2u){0u, 0u};
                if (2 * ks2 <= mb) p0 = *(const LAS v2u*)(ATs + t * 72 + 32 * ks2 + 4 * f);
                if (2 * ks2 + 1 <= mb) p1 = *(const LAS v2u*)(ATs + t * 72 + 32 * ks2 + 16 + 4 * f);
                *(v4u*)(gops + 32768 + q * 16) = (v4u){p0.x, p0.y, p1.x, p1.y}; }
            for (int q = rt; q < 1024; q += 256) { const int blk = q >> 6, l2 = q & 63, i = l2 & 15, f = l2 >> 4, dkb = blk >> 1, ks2 = blk & 1, dk = 16 * dkb + i; float v[8];
#pragma unroll
                for (int e = 0; e < 8; ++e) { const int c = 32 * ks2 + 16 * (e >> 2) + 4 * f + (e & 3); v[e] = Ks[c * 132 + dk] * kes[c]; }
                *(v4u*)(gops + 40960 + q * 16) = (v4u){pk2(v[0], v[1]), pk2(v[2], v[3]), pk2(v[4], v[5]), pk2(v[6], v[7])}; }
        }
        __syncthreads();
        for (int q = tid; q < 1024; q += NTHR) { const int blk = q >> 6, l2 = q & 63, i = l2 & 15, f = l2 >> 4, mb = blk >> 2, ks = blk & 3, t = 16 * mb + i;
            const v2u p0 = *(const LAS v2u*)(WKs + t * 136 + 32 * ks + 4 * f), p1 = *(const LAS v2u*)(WKs + t * 136 + 32 * ks + 16 + 4 * f);
            *(v4u*)(gops + q * 16) = (v4u){p0.x, p0.y, p1.x, p1.y}; }
        __syncthreads();
    }
}

__device__ __forceinline__ bf16x8 pack8(const f32x4 a, const f32x4 b) {
    v4u w; w.x = pk2(a[0], a[1]); w.y = pk2(a[2], a[3]); w.z = pk2(b[0], b[1]); w.w = pk2(b[2], b[3]); return __builtin_bit_cast(bf16x8, w);
}
__device__ __forceinline__ void gdn_scan(const Args& A, LAS unsigned char* lds, int bh, int tid, int lane, int wave) {
    const int b = bh >> 2, h = bh & 3, fr = lane & 15, fq = lane >> 4, vs = wave;
    const unsigned char* gops = (const unsigned char*)A.out + (size_t)bh * 32 * GOPS_CHUNK;
    const unsigned char* uvf = A.ws + WS_XN + (size_t)bh * 32 * 16384; const float* GE = (const float*)(A.ws + WS_GE) + bh * 32;
    float* Op = (float*)(A.ws + WS_OA) + ((size_t)b * SEQ + 4 * fq) * GW + h * 128 + 16 * vs + fr;
    f32x4 S[8];
#pragma unroll
    for (int i = 0; i < 8; ++i) S[i] = (f32x4){0.f, 0.f, 0.f, 0.f};
    const float gev = GE[lane & 31];
#define SCAN_DMA(chunk, bufoff) do { _Pragma("unroll") for (int i_ = 0; i_ < 9; ++i_) { const int p_ = wave + 8 * i_; \
        const unsigned char* s_ = (p_ < 56) ? (gops + (size_t)(chunk) * GOPS_CHUNK + p_ * 1024) : (uvf + (size_t)(chunk) * 16384 + (p_ - 56) * 1024); \
        __builtin_amdgcn_global_load_lds((const unsigned*)(s_ + lane * 16), (LAS unsigned*)(lds + (bufoff) + p_ * 1024), 16, 0, 0); } } while (0)
    SCAN_DMA(0, 0); SCAN_DMA(1, SCAN_BUF);
    asm volatile("s_waitcnt vmcnt(0)" ::: "memory"); __syncthreads();
#pragma unroll 1
    for (int n = 0; n < 32; ++n) {
        const LAS unsigned char* cur = lds + (n & 1) * SCAN_BUF;
        const float ge = __builtin_bit_cast(float, __builtin_amdgcn_readlane(__builtin_bit_cast(int, gev), n));
        bf16x8 Sb[4];
#pragma unroll
        for (int ks = 0; ks < 4; ++ks) Sb[ks] = pack8(S[2 * ks], S[2 * ks + 1]);
        f32x4 u[4];
#pragma unroll
        for (int mb = 0; mb < 4; ++mb) { f32x4 p = (f32x4){0.f, 0.f, 0.f, 0.f};
#pragma unroll
            for (int ks = 0; ks < 4; ++ks) p = __builtin_amdgcn_mfma_f32_16x16x32_bf16(*(const LAS bf16x8*)(cur + ((mb * 4 + ks) * 64 + lane) * 16), Sb[ks], p, 0, 0, 0);
            const v2u uw = *(const LAS v2u*)(cur + GOPS_CHUNK + ((vs * 4 + mb) * 64 + lane) * 8);
            u[mb] = (f32x4){bflo(uw.x) - p[0], bfhi(uw.x) - p[1], bflo(uw.y) - p[2], bfhi(uw.y) - p[3]}; }
        bf16x8 ub[2]; ub[0] = pack8(u[0], u[1]); ub[1] = pack8(u[2], u[3]);
        f32x4 o[4];
#pragma unroll
        for (int mb = 0; mb < 4; ++mb) { f32x4 acc = (f32x4){0.f, 0.f, 0.f, 0.f};
#pragma unroll
            for (int ks = 0; ks < 4; ++ks) acc = __builtin_amdgcn_mfma_f32_16x16x32_bf16(*(const LAS bf16x8*)(cur + 16384 + ((mb * 4 + ks) * 64 + lane) * 16), Sb[ks], acc, 0, 0, 0);
#pragma unroll
            for (int ks2 = 0; ks2 < 2; ++ks2) if (ks2 <= (mb >> 1)) acc = __builtin_amdgcn_mfma_f32_16x16x32_bf16(*(const LAS bf16x8*)(cur + 32768 + ((mb * 2 + ks2) * 64 + lane) * 16), ub[ks2], acc, 0, 0, 0);
            o[mb] = acc; }
#pragma unroll
        for (int dkb = 0; dkb < 8; ++dkb) { f32x4 acc = S[dkb] * ge;
#pragma unroll
            for (int ks2 = 0; ks2 < 2; ++ks2) acc = __builtin_amdgcn_mfma_f32_16x16x32_bf16(*(const LAS bf16x8*)(cur + 40960 + ((dkb * 2 + ks2) * 64 + lane) * 16), ub[ks2], acc, 0, 0, 0);
            S[dkb] = acc; }
        asm volatile("s_waitcnt vmcnt(0)" ::: "memory"); __syncthreads();
        if (n + 2 < 32) SCAN_DMA(n + 2, (n & 1) * SCAN_BUF);
        float* orow = Op + (size_t)(64 * n) * GW;
#pragma unroll
        for (int mb = 0; mb < 4; ++mb) { float* q = orow + (size_t)(16 * mb) * GW; q[0] = o[mb][0]; q[GW] = o[mb][1]; q[2 * GW] = o[mb][2]; q[3 * GW] = o[mb][3]; }
    }
    asm volatile("s_waitcnt vmcnt(0)" ::: "memory"); __syncthreads();
#undef SCAN_DMA
}


__device__ __forceinline__ void attn_fast(const Args& A, LAS unsigned char* lds, int lane, int wave) {
    const bf16* PROJ = (const bf16*)(A.ws + WS_PROJ); bf16* CAT = (bf16*)(A.ws + WS_CAT);
    unsigned* ctr = (unsigned*)(A.ws + WS_CTL);
    LAS bf16* Vt = (LAS bf16*)(lds + wave * 8192);
    const int fr = lane & 15, fq = lane >> 4;
    const int kk = lane & 31, vslot = 8 * ((kk & 15) >> 2) + 4 * (kk >> 4) + (kk & 3), vch = lane >> 5;
    constexpr float SC = 0.125f * 1.4426950408889634f;
    for (;;) {
        unsigned wt_ = 0; if (lane == 0) wt_ = atomicAdd(ctr, 1u); const int wt = __builtin_amdgcn_readfirstlane(wt_);
        if (wt >= NB * AH * 8 * 16) break;
        const int T = 7 - (wt >> 10), rem = wt & 1023, b = rem >> 7, h = (rem >> 4) & 7, c = rem & 15, t0 = 256 * T;
        const bf16* Pb = PROJ + (size_t)b * SEQ * NP;
        const int tq = t0 + c + 16 * fr;
        bf16x8 qf[2];
#pragma unroll
        for (int ks = 0; ks < 2; ++ks) qf[ks] = *(const bf16x8*)(Pb + (size_t)tq * NP + PC_QB + h * 64 + 32 * ks + 8 * fq);
        const int lo2 = c, n2 = ((t0 + 240) >> 4) + 1, g2 = (n2 + 31) >> 5;
        const int lo1 = max(t0 + c - 512, c & 3), n1 = ((t0 + c + 240 - lo1) >> 2) + 1, g1 = (n1 + 31) >> 5;
        const int lo0 = max(t0 + c - 128, 0), n0 = (t0 + c + 240 - lo0) + 1, g0 = (n0 + 31) >> 5;
        const int NG = g2 + g1 + g0;
        f32x4 O[4];
#pragma unroll
        for (int i = 0; i < 4; ++i) O[i] = (f32x4){0.f, 0.f, 0.f, 0.f};
        float mrun = -INFINITY, lrun = 0.f;
        v4u kc[4], vc[4], kn[4], vn[4];
#define ATT_DEC(f, kst, str) do { if ((f) < g2) { str = 16; kst = lo2 + 512 * (f); } else if ((f) < g2 + g1) { str = 4; kst = lo1 + 128 * ((f) - g2); } else { str = 1; kst = lo0 + 32 * ((f) - g2 - g1); } } while (0)
#define ATT_LOAD(kreg, vreg, kst, str) do { \
            _Pragma("unroll") for (int j = 0; j < 2; ++j) { const int tk = min((kst) + (str) * (16 * j + fr), SEQ - 1); \
                _Pragma("unroll") for (int ks = 0; ks < 2; ++ks) kreg[2 * j + ks] = *(const v4u*)(Pb + (size_t)tk * NP + PC_KB + h * 64 + 32 * ks + 8 * fq); } \
            { const int tk = min((kst) + (str) * kk, SEQ - 1); \
                _Pragma("unroll") for (int i = 0; i < 4; ++i) vreg[i] = *(const v4u*)(Pb + (size_t)tk * NP + PC_VB + h * 64 + 8 * (vch + 2 * i)); } } while (0)
        int kst, str; ATT_DEC(0, kst, str); ATT_LOAD(kc, vc, kst, str);
#pragma unroll 1
        for (int f = 0; f < NG; ++f) {
            int kstn = 0, strn = 1;
            if (f + 1 < NG) { ATT_DEC(f + 1, kstn, strn); ATT_LOAD(kn, vn, kstn, strn); }
            f32x4 d0 = (f32x4){0.f, 0.f, 0.f, 0.f}, d1 = d0;
#pragma unroll
            for (int ks = 0; ks < 2; ++ks) { d0 = __builtin_amdgcn_mfma_f32_16x16x32_bf16(__builtin_bit_cast(bf16x8, kc[ks]), qf[ks], d0, 0, 0, 0);
                                             d1 = __builtin_amdgcn_mfma_f32_16x16x32_bf16(__builtin_bit_cast(bf16x8, kc[2 + ks]), qf[ks], d1, 0, 0, 0); }
#pragma unroll
            for (int i = 0; i < 4; ++i) { const int dd = 8 * (vch + 2 * i); const v4u w = vc[i];
                Vt[(dd + 0) * 40 + vslot] = (bf16)(w.x & 0xffffu); Vt[(dd + 1) * 40 + vslot] = (bf16)(w.x >> 16); Vt[(dd + 2) * 40 + vslot] = (bf16)(w.y & 0xffffu); Vt[(dd + 3) * 40 + vslot] = (bf16)(w.y >> 16);
                Vt[(dd + 4) * 40 + vslot] = (bf16)(w.z & 0xffffu); Vt[(dd + 5) * 40 + vslot] = (bf16)(w.z >> 16); Vt[(dd + 6) * 40 + vslot] = (bf16)(w.w & 0xffffu); Vt[(dd + 7) * 40 + vslot] = (bf16)(w.w >> 16); }
            float s[8]; const int span = 128 * str; float mloc = -INFINITY;
#pragma unroll
            for (int e = 0; e < 8; ++e) { const int tk = kst + str * (16 * (e >> 2) + 4 * fq + (e & 3)); const int dt = tq - tk; const float x = (e < 4 ? d0[e & 3] : d1[e & 3]) * SC;
                s[e] = (dt >= 0 && dt <= span) ? x : -INFINITY; mloc = fmaxf(mloc, s[e]); }
            mloc = fmaxf(mloc, __shfl_xor(mloc, 16)); mloc = fmaxf(mloc, __shfl_xor(mloc, 32));
            const float mnew = fmaxf(mrun, mloc), alpha = __builtin_amdgcn_exp2f(mrun - mnew); mrun = mnew;
            float psum = 0.f;
#pragma unroll
            for (int e = 0; e < 8; ++e) { s[e] = __builtin_amdgcn_exp2f(s[e] - mnew); psum += s[e]; }
            lrun = lrun * alpha + psum;
            const bf16x8 pb = pack8((f32x4){s[0], s[1], s[2], s[3]}, (f32x4){s[4], s[5], s[6], s[7]});
#pragma unroll
            for (int db = 0; db < 4; ++db) { const bf16x8 a = *(const LAS bf16x8*)(Vt + (16 * db + fr) * 40 + 8 * fq);
                O[db] = __builtin_amdgcn_mfma_f32_16x16x32_bf16(a, pb, O[db] * alpha, 0, 0, 0); }
#pragma unroll
            for (int i = 0; i < 4; ++i) { kc[i] = kn[i]; vc[i] = vn[i]; }
            kst = kstn; str = strn;
        }
#undef ATT_DEC
#undef ATT_LOAD
        lrun += __shfl_xor(lrun, 16); lrun += __shfl_xor(lrun, 32);
        const float inv = 1.0f / lrun;
        bf16* op = CAT + ((size_t)b * SEQ + tq) * DM + GW + h * 64 + 4 * fq;
#pragma unroll
        for (int db = 0; db < 4; ++db) { v2u w; w.x = pk2(O[db][0] * inv, O[db][1] * inv); w.y = pk2(O[db][2] * inv, O[db][3] * inv); *(v2u*)(op + 16 * db) = w; }
    }
}

__device__ __forceinline__ void attn_simple(const Args& A, int tid, int lane, int wave) {
    const bf16* PROJ = (const bf16*)(A.ws + WS_PROJ); bf16* CAT = (bf16*)(A.ws + WS_CAT);
    unsigned* ctr = (unsigned*)(A.ws + WS_CTL);
    for (;;) {
        unsigned wt_ = 0; if (lane == 0) wt_ = atomicAdd(ctr, 1u); const int wt = __builtin_amdgcn_readfirstlane(wt_);
        if (wt >= (M / 64) * AH) break;
        const int h = wt % AH, tb = wt / AH, row = tb * 64 + lane, b = row / SEQ, t = row % SEQ;
        float q[64], acc[64];
        { const v4u* qp = (const v4u*)(PROJ + (size_t)row * NP + PC_QB + h * 64);
#pragma unroll
          for (int j = 0; j < 8; ++j) { const v4u w = qp[j]; q[8 * j + 0] = bflo(w.x) * 0.125f; q[8 * j + 1] = bfhi(w.x) * 0.125f; q[8 * j + 2] = bflo(w.y) * 0.125f; q[8 * j + 3] = bfhi(w.y) * 0.125f;
              q[8 * j + 4] = bflo(w.z) * 0.125f; q[8 * j + 5] = bfhi(w.z) * 0.125f; q[8 * j + 6] = bflo(w.w) * 0.125f; q[8 * j + 7] = bfhi(w.w) * 0.125f; } }
#pragma unroll
        for (int j = 0; j < 64; ++j) acc[j] = 0.f;
        float mx = -1e30f, l = 0.f;
        for (int br = 0; br < 3; ++br) {
            const int stride = br == 0 ? 1 : (br == 1 ? 4 : 16);
            for (int i = 0; i <= 128; ++i) {
                const int tk = t - i * stride; if (tk < 0) break;
                const size_t krow = (size_t)(b * SEQ + tk) * NP;
                const v4u* kp = (const v4u*)(PROJ + krow + PC_KB + h * 64); const v4u* vp = (const v4u*)(PROJ + krow + PC_VB + h * 64);
                float s = 0.f;
#pragma unroll
                for (int j = 0; j < 8; ++j) { const v4u w = kp[j]; s += q[8 * j + 0] * bflo(w.x) + q[8 * j + 1] * bfhi(w.x) + q[8 * j + 2] * bflo(w.y) + q[8 * j + 3] * bfhi(w.y)
                                                                       + q[8 * j + 4] * bflo(w.z) + q[8 * j + 5] * bfhi(w.z) + q[8 * j + 6] * bflo(w.w) + q[8 * j + 7] * bfhi(w.w); }
                const float mn = fmaxf(mx, s), sc = __expf(mx - mn), p = __expf(s - mn); mx = mn; l = l * sc + p;
#pragma unroll
                for (int j = 0; j < 8; ++j) { const v4u w = vp[j];
                    acc[8 * j + 0] = acc[8 * j + 0] * sc + p * bflo(w.x); acc[8 * j + 1] = acc[8 * j + 1] * sc + p * bfhi(w.x); acc[8 * j + 2] = acc[8 * j + 2] * sc + p * bflo(w.y); acc[8 * j + 3] = acc[8 * j + 3] * sc + p * bfhi(w.y);
                    acc[8 * j + 4] = acc[8 * j + 4] * sc + p * bflo(w.z); acc[8 * j + 5] = acc[8 * j + 5] * sc + p * bfhi(w.z); acc[8 * j + 6] = acc[8 * j + 6] * sc + p * bflo(w.w); acc[8 * j + 7] = acc[8 * j + 7] * sc + p * bfhi(w.w); }
            }
        }
        const float inv = 1.0f / l; v4u* op = (v4u*)(CAT + (size_t)row * DM + GW + h * 64);
#pragma unroll
        for (int j = 0; j < 8; ++j) { v4u w; w.x = pk2(acc[8 * j] * inv, acc[8 * j + 1] * inv); w.y = pk2(acc[8 * j + 2] * inv, acc[8 * j + 3] * inv); w.z = pk2(acc[8 * j + 4] * inv, acc[8 * j + 5] * inv); w.w = pk2(acc[8 * j + 6] * inv, acc[8 * j + 7] * inv); op[j] = w; }
    }
}
__device__ __forceinline__ void gated_norm(const Args& A, int lane, int wave) {
    const bf16* PROJ = (const bf16*)(A.ws + WS_PROJ); bf16* CAT = (bf16*)(A.ws + WS_CAT); const float* OA = (const float*)(A.ws + WS_OA); const float* gw = A.in[6];
    const float w0 = gw[2 * lane], w1 = gw[2 * lane + 1];
    for (int wt = blockIdx.x * NWAVES + wave; wt < M * GH; wt += gridDim.x * NWAVES) {
        const int row = wt / GH, h = wt % GH;
        const float2 o = *(const float2*)(OA + (size_t)row * GW + h * 128 + 2 * lane);
        const unsigned zz = *(const unsigned*)(PROJ + (size_t)row * NP + PC_Z + h * 128 + 2 * lane);
        const float ms = wave_sum(o.x * o.x + o.y * o.y) * (1.0f / 128.0f), r = rsqrtf(ms + RMS_EPS);
        *(unsigned*)(CAT + (size_t)row * DM + h * 128 + 2 * lane) = pk2(o.x * r * w0 * silu_f(bflo(zz)), o.y * r * w1 * silu_f(bfhi(zz)));
    }
}
__device__ __forceinline__ void ffn_conv_half(const Args& A, int half, int tid) {
    const bf16* Y = (const bf16*)(A.ws + WS_Y); bf16* ACT = (bf16*)(A.ws + WS_ACT); const float* fw = A.in[10];
    constexpr int HC = DFF / 2;
    for (size_t it = (size_t)blockIdx.x * NTHR + tid; it < (size_t)M * (HC / 8); it += (size_t)gridDim.x * NTHR) {
        const int row = (int)(it / (HC / 8)), g8 = (int)(it % (HC / 8)), cl = g8 * 8, pn = cl >> 7, j = cl & 127, t = row % SEQ, ch = half * HC + cl;
        float ga[8], ua[8];
#pragma unroll
        for (int e = 0; e < 8; ++e) { ga[e] = 0.f; ua[e] = 0.f; }
#pragma unroll
        for (int i = 0; i < 3; ++i) { const int ts = t - 2 + i; if (ts < 0) continue;
            const bf16* yr = Y + (size_t)(row - 2 + i) * DFF + 256 * pn + j; const v4u g = *(const v4u*)yr, u = *(const v4u*)(yr + 128);
            const f32x4 wg0 = *(const f32x4*)(fw + i * NUP + ch), wg1 = *(const f32x4*)(fw + i * NUP + ch + 4), wu0 = *(const f32x4*)(fw + i * NUP + DFF + ch), wu1 = *(const f32x4*)(fw + i * NUP + DFF + ch + 4);
            ga[0] += wg0.x * bflo(g.x); ga[1] += wg0.y * bfhi(g.x); ga[2] += wg0.z * bflo(g.y); ga[3] += wg0.w * bfhi(g.y); ga[4] += wg1.x * bflo(g.z); ga[5] += wg1.y * bfhi(g.z); ga[6] += wg1.z * bflo(g.w); ga[7] += wg1.w * bfhi(g.w);
            ua[0] += wu0.x * bflo(u.x); ua[1] += wu0.y * bfhi(u.x); ua[2] += wu0.z * bflo(u.y); ua[3] += wu0.w * bfhi(u.y); ua[4] += wu1.x * bflo(u.z); ua[5] += wu1.y * bfhi(u.z); ua[6] += wu1.z * bflo(u.w); ua[7] += wu1.w * bfhi(u.w); }
        v4u o; o.x = pk2(silu_f(ga[0]) * ua[0], silu_f(ga[1]) * ua[1]); o.y = pk2(silu_f(ga[2]) * ua[2], silu_f(ga[3]) * ua[3]); o.z = pk2(silu_f(ga[4]) * ua[4], silu_f(ga[5]) * ua[5]); o.w = pk2(silu_f(ga[6]) * ua[6], silu_f(ga[7]) * ua[7]);
        *(v4u*)(ACT + (size_t)row * DFF + ch) = o;
    }
}
__device__ __forceinline__ void final_norm(const Args& A, int lane, int wave) {
    float* out = A.out; const float* fnw = A.in[12];
    for (int m = blockIdx.x * NWAVES + wave; m < M; m += gridDim.x * NWAVES) {
        f32x4* xr = (f32x4*)(out + (size_t)m * DM) + lane; const f32x4* nr = (const f32x4*)fnw + lane;
        f32x4 v[4]; float s = 0.f;
#pragma unroll
        for (int j = 0; j < 4; ++j) { v[j] = xr[64 * j]; s += (v[j].x * v[j].x + v[j].y * v[j].y) + (v[j].z * v[j].z + v[j].w * v[j].w); }
        const float rstd = rsqrtf(wave_sum(s) * (1.f / DM) + RMS_EPS);
#pragma unroll
        for (int j = 0; j < 4; ++j) { const f32x4 n = nr[64 * j]; xr[64 * j] = (f32x4){v[j].x * rstd * n.x, v[j].y * rstd * n.y, v[j].z * rstd * n.z, v[j].w * rstd * n.w}; }
    }
}

#define XB_TMO      128
#define XB_XCNT(j)  (256  + 64 * (j))
#define XB_XSUB(j)  (1280 + 64 * (j))
#define XB_XGEN(j)  (2304 + 64 * (j))
#define XB_TOP      3328
#define XB_TOPGEN   3392
#define XCD_BAR_WORDS 3456
#define XB_SPIN_CAP (1u << 18)

__device__ __forceinline__ unsigned xb_ld(unsigned* p)              { return __hip_atomic_load(p, __ATOMIC_RELAXED, __HIP_MEMORY_SCOPE_AGENT); }
__device__ __forceinline__ unsigned xb_add(unsigned* p, unsigned v) { return __hip_atomic_fetch_add(p, v, __ATOMIC_RELAXED, __HIP_MEMORY_SCOPE_AGENT); }
__device__ __forceinline__ unsigned xb_xcc_id() { return (unsigned)__builtin_amdgcn_s_getreg((3 << 11) | 20) & 0xFu; }
#define XB_SPIN(cond, bar) do { unsigned _sp = 0; while (cond) { __builtin_amdgcn_s_sleep(1); \
    if ((++_sp & 255u) == 0u) { if (xb_ld(&(bar)[XB_TMO])) break; if (_sp > XB_SPIN_CAP) { atomicAdd(&(bar)[XB_TMO], 1u); break; } } } } while (0)

struct XcdBarrier {
    unsigned* bar; unsigned x;
    volatile LAS unsigned* st;
};

__device__ __forceinline__ XcdBarrier xcd_barrier_post(unsigned* bar, volatile LAS unsigned* st) {
    XcdBarrier b; b.bar = bar; b.x = xb_xcc_id(); b.st = st;
    if (threadIdx.x == 0) (void)xb_add(&bar[XB_XCNT(b.x)], 1u);
    return b;
}
__device__ __forceinline__ void xcd_barrier_complete(unsigned* bar, unsigned x, unsigned& nloc, unsigned& nx) {
    const unsigned G = gridDim.x * gridDim.y * gridDim.z;
    unsigned sum, cnt, mine, sp = 0u;
    for (;;) {
        sum = 0u; cnt = 0u; mine = 0u;
#pragma unroll
        for (unsigned j = 0; j < 16; ++j) { const unsigned c = xb_ld(&bar[XB_XCNT(j)]); sum += c; cnt += (c > 0u) ? 1u : 0u; mine = (j == x) ? c : mine; }
        if (sum == G) break;
        __builtin_amdgcn_s_sleep(1);
        if ((++sp & 255u) == 0u) { if (xb_ld(&bar[XB_TMO])) break; if (sp > XB_SPIN_CAP) { atomicAdd(&bar[XB_TMO], 1u); break; } }
    }
    nloc = mine > 0u ? mine : 1u; nx = cnt > 0u ? cnt : 1u;
}

__device__ __forceinline__ void xcd_barrier(const XcdBarrier& b) {
    asm volatile("s_waitcnt vmcnt(0)" ::: "memory");
    __syncthreads();
    if (threadIdx.x == 0) {
        unsigned* bar = b.bar;
        __builtin_amdgcn_s_waitcnt(0);
        unsigned nloc = b.st[0], nx = b.st[1];
        if (nloc == 0u) { xcd_barrier_complete(bar, b.x, nloc, nx); b.st[0] = nloc; b.st[1] = nx; }
        const unsigned old = xb_add(&bar[XB_XSUB(b.x)], 1u);
        const unsigned gen = old / nloc;
        if (old + 1u == (gen + 1u) * nloc) {
            __builtin_amdgcn_fence(__ATOMIC_RELEASE, "agent");
            asm volatile("s_waitcnt vmcnt(0)" ::: "memory");
            const unsigned og = xb_add(&bar[XB_TOP], 1u);
            const unsigned tg = og / nx;
            if (og + 1u == (tg + 1u) * nx) xb_add(&bar[XB_TOPGEN], 1u);
            else XB_SPIN(xb_ld(&bar[XB_TOPGEN]) == tg, bar);
            __builtin_amdgcn_fence(__ATOMIC_ACQUIRE, "agent");
            xb_add(&bar[XB_XGEN(b.x)], 1u);
            asm volatile("s_waitcnt vmcnt(0)" ::: "memory");
        } else {
            XB_SPIN(xb_ld(&bar[XB_XGEN(b.x)]) == gen, bar);
            __builtin_amdgcn_fence(__ATOMIC_ACQUIRE, "agent");
            asm volatile("s_waitcnt vmcnt(0)" ::: "memory");
        }
    }
    __syncthreads();
}

constexpr int N_PHASES = 12;
__global__ void __launch_bounds__(NTHR, 2) mk_fwd(Args args) {
    extern __shared__ __attribute__((aligned(16))) unsigned char lds_raw[];
    LAS unsigned char* lds = (LAS unsigned char*)lds_raw;
    const int tid = threadIdx.x, lane = tid & 63, wave = __builtin_amdgcn_readfirstlane(tid >> 6);
    const int lo = args.ph_lo, hi = args.ph_hi;
    unsigned char* ws = args.ws;
    bf16* WIN = (bf16*)(ws + WS_WIN); bf16* WOUT = (bf16*)(ws + WS_WOUT); bf16* WUP = (bf16*)(ws + WS_WUP); bf16* WDN = (bf16*)(ws + WS_WDN);
    bf16* XN = (bf16*)(ws + WS_XN); bf16* PROJ = (bf16*)(ws + WS_PROJ); bf16* CAT = (bf16*)(ws + WS_CAT); bf16* Y = (bf16*)(ws + WS_Y); bf16* ACT = (bf16*)(ws + WS_ACT);
    float* SSQ = (float*)(ws + WS_SSQ);
#define IN(k) (lo <= (k) && (k) < hi)
#define SEAM(k) do { if (IN(k) && IN((k) + 1)) { if ((k) == 0) cg::this_grid().sync(); else xcd_barrier(bar); } } while (0)
    { volatile LAS unsigned* st = (volatile LAS unsigned*)(lds + LDS_BYTES - 64); if (tid < 2) st[tid] = 0u; }
    __syncthreads();
    XcdBarrier bar = xcd_barrier_post((unsigned*)(ws + WS_CTL) + 4096, (volatile LAS unsigned*)(lds + LDS_BYTES - 64));
    if (IN(0)) { p0_prologue(args, lds, tid, lane, wave); } SEAM(0);
    if (IN(1)) { pg8::Gemm g{XN, WIN, M, NP, DM}; pg8::StaticOrder S; S.init(M, NP, gridDim.x, blockIdx.x); pg8::EpiBf16S E{PROJ, NP, nullptr};
        pg8::gemm_phase<pg8::EpiBf16S, pg8::StaticOrder, PG8_ALIGN, PG8_SP2>(lds, g, S, E); } SEAM(1);
    if (IN(2)) { gdn_prep(args, lds, tid, lane, wave); } SEAM(2);
    if (IN(3)) { if (blockIdx.x < NB * GH) gdn_scan(args, lds, blockIdx.x, tid, lane, wave); attn_fast(args, lds, lane, wave); } SEAM(3);
    if (IN(4)) { gated_norm(args, lane, wave); } SEAM(4);
    if (IN(5)) { pg8::Gemm g{CAT, WOUT, M, DM, DM}; pg8::StaticOrder S; S.init(M, DM, gridDim.x, blockIdx.x); pg8::EpiResid E{args.in[0], args.out, XN, SSQ, DM};
        pg8::gemm_phase<pg8::EpiResid, pg8::StaticOrder, PG8_ALIGN, PG8_SP2>(lds, g, S, E); } SEAM(5);
#pragma unroll 1
    for (int half = 0; half < 2; ++half) {
        if (IN(6 + 2 * half)) { pg8::Gemm g{XN, WUP + (size_t)half * DFF * DM, M, DFF, DM}; pg8::StaticOrder S; S.init(M, DFF, gridDim.x, blockIdx.x); pg8::EpiBf16S E{Y, DFF, SSQ};
            pg8::gemm_phase<pg8::EpiBf16S, pg8::StaticOrder, PG8_ALIGN, PG8_SP2>(lds, g, S, E); } SEAM(6 + 2 * half);
        if (IN(7 + 2 * half)) { ffn_conv_half(args, half, tid); } SEAM(7 + 2 * half);
    }
    if (IN(10)) { pg8::Gemm g{ACT, WDN, M, DM, DFF}; pg8::StaticOrder S; S.init(M, DM, gridDim.x, blockIdx.x); pg8::EpiResid E{args.out, args.out, nullptr, nullptr, DM};
        pg8::gemm_phase<pg8::EpiResid, pg8::StaticOrder, PG8_ALIGN, PG8_SP2>(lds, g, S, E); } SEAM(10);
    if (IN(11)) { final_norm(args, lane, wave); }
#undef IN
#undef SEAM
}

#ifndef MK_ONE_LAUNCH
#define MK_ONE_LAUNCH 1
#endif
extern "C" void kernel_launch(void* const* d_in, const int* in_sizes, int n_in, void* d_out, int out_size, void* d_ws, size_t ws_size, hipStream_t stream) {
    static int grid = 0;
    if (grid == 0) {
        if (n_in != 13 || out_size != M * DM || ws_size < WS_END) { fprintf(stderr, "kernel_launch: unexpected shapes n_in %d out %d ws %zu\n", n_in, out_size, ws_size); grid = -1; return; }
        int dev = 0, cus = 0, per_cu = 0;
        hipGetDevice(&dev); hipDeviceGetAttribute(&cus, hipDeviceAttributeMultiprocessorCount, dev);
        hipFuncSetAttribute((const void*)mk_fwd, hipFuncAttributeMaxDynamicSharedMemorySize, LDS_BYTES);
        hipOccupancyMaxActiveBlocksPerMultiprocessor(&per_cu, (const void*)mk_fwd, NTHR, LDS_BYTES);
        (void)hipGetLastError();
        if (per_cu < 1) { fprintf(stderr, "kernel_launch: occupancy query says %d blocks per CU\n", per_cu); per_cu = 1; }
        grid = cus;
    }
    if (grid < 0) return;
    if (hipMemsetAsync((char*)d_ws + WS_CTL, 0, 65536, stream) != hipSuccess) { fprintf(stderr, "kernel_launch: memset failed\n"); return; }
    Args a{};
    for (int i = 0; i < 13; ++i) a.in[i] = (const float*)d_in[i];
    a.out = (float*)d_out; a.ws = (unsigned char*)d_ws;
#if MK_ONE_LAUNCH
    a.ph_lo = 0; a.ph_hi = N_PHASES; a.coop = 1;
    void* kargs[] = {&a};
    hipError_t e = hipLaunchCooperativeKernel((const void*)mk_fwd, dim3(grid), dim3(NTHR), kargs, LDS_BYTES, stream);
    if (e != hipSuccess) fprintf(stderr, "cooperative launch failed: %s (grid %d)\n", hipGetErrorString(e), grid);
#else
    for (int p = 0; p < N_PHASES; ++p) { a.ph_lo = p; a.ph_hi = p + 1; a.coop = 0; hipLaunchKernelGGL(mk_fwd, dim3(grid), dim3(NTHR), LDS_BYTES, stream, a); }
#endif
}
```

```cpp
#include <hip/hip_runtime.h>
#include <hip/hip_cooperative_groups.h>
#include <cstdio>
#include <cstdint>
namespace cg = cooperative_groups;
namespace pg8 {
#define PG8_LAS __attribute__((address_space(3)))
typedef unsigned short bf16_t;
typedef short bf16x8 __attribute__((ext_vector_type(8)));
typedef float f32x4 __attribute__((ext_vector_type(4)));
typedef unsigned u32x4 __attribute__((ext_vector_type(4)));
constexpr int BM = 256, BK = 64, HALF = 128, HTB = HALF * BK * 2  , STAGE_BYTES = 8 * HTB, NXCD = 8, WGM = 8;

__host__ __device__ __forceinline__ int lds_byte(int r, int c) { const int st = (r >> 4) * 2 + (c >> 5), rr = r & 15, cc = c & 31, ob = rr * 64 + cc * 2; return st * 1024 + (ob ^ (((ob >> 9) & 1) << 5)); }
__host__ __device__ __forceinline__ void stage_rc(int b, int& R, int& C) { const int st = b / 1024, sb = b % 1024, swz = sb ^ (((sb >> 9) & 1) << 5); R = (st >> 1) * 16 + swz / 64; C = (st & 1) * 32 + (swz % 64) / 2; }
__host__ __device__ __forceinline__ int perm32(int rho) { const int n = rho >> 4, i = rho & 15; return 8 * (i >> 2) + 4 * n + (i & 3); }

struct Unit { int pm, pn; };
struct Gemm { const bf16_t* A; const bf16_t* Bt; int M, N, K; };

struct StaticOrder {
    int nM, nN, nwg, G, c;
    __host__ __device__ void init(int M, int N, int G_, int c_) { nM = M / BM; nN = N / BM; nwg = nM * nN; G = G_; c = c_; }
    __host__ __device__ bool next(int i, Unit& u) const {
        const long L = (long)i * G + c; if (L >= nwg) return false;
        int wgid = (int)L; { const int q = nwg / NXCD, r = nwg % NXCD, xcd = wgid % NXCD, off = wgid / NXCD; wgid = (xcd < r ? xcd * (q + 1) : r * (q + 1) + (xcd - r) * q) + off; }
        const int nig = WGM * nN, gid = wgid / nig, fm = gid * WGM, gsz = (nM - fm) < WGM ? (nM - fm) : WGM;
        u.pm = fm + ((wgid % nig) % gsz); u.pn = (wgid % nig) / gsz; return true;
    }
    __device__ __forceinline__ void a_ready(const Unit&) const {}
    __device__ __forceinline__ void done(const Unit&) const {}
};

__device__ __forceinline__ unsigned cvt_pk_bf16(float lo, float hi) { unsigned r; asm volatile("v_cvt_pk_bf16_f32 %0, %1, %2" : "=v"(r) : "v"(lo), "v"(hi)); return r; }
constexpr float RMS_EPS = 1e-6f;
struct EpiBf16S {
    static constexpr bool PERM = true, AFTER_DRAIN = false;
    bf16_t* O; int ldc; const float* ssq;
    __device__ __forceinline__ void operator()(const f32x4 (&acc)[2][2][4][2], const Unit& u, int wr, int wc, int fr, int fq) const {
        const int row0 = u.pm * BM + wr * 64 + fr; const int col0 = u.pn * BM + wc * 32 + 8 * fq;
#pragma unroll
        for (int ai = 0; ai < 2; ++ai)
#pragma unroll
            for (int m = 0; m < 4; ++m) { const int row = row0 + ai * HALF + m * 16; bf16_t* rowp = O + (size_t)row * ldc + col0;
                const float sc = ssq ? rsqrtf(ssq[row] * (1.0f / 1024.0f) + RMS_EPS) : 1.0f;
#pragma unroll
                for (int bj = 0; bj < 2; ++bj) { const f32x4 v0 = acc[ai][bj][m][0] * sc, v1 = acc[ai][bj][m][1] * sc;
                    u32x4 w; w.x = cvt_pk_bf16(v0[0], v0[1]); w.y = cvt_pk_bf16(v0[2], v0[3]); w.z = cvt_pk_bf16(v1[0], v1[1]); w.w = cvt_pk_bf16(v1[2], v1[3]);
                    *(u32x4*)(rowp + bj * HALF) = w; } }
    }
};
struct EpiResid {
    static constexpr bool PERM = false, AFTER_DRAIN = false;
    const float* base; float* out; bf16_t* xb; float* ssq; int ldc;
    __device__ __forceinline__ void operator()(const f32x4 (&acc)[2][2][4][2], const Unit& u, int wr, int wc, int fr, int fq) const {
        typedef unsigned u32x2v __attribute__((ext_vector_type(2)));
        const int col0 = u.pn * BM + wc * 32 + 4 * fq;
#pragma unroll
        for (int ai = 0; ai < 2; ++ai)
#pragma unroll
            for (int m = 0; m < 4; ++m) { const int row = u.pm * BM + ai * HALF + wr * 64 + m * 16 + fr; const size_t off = (size_t)row * ldc + col0; float s = 0.f;
#pragma unroll
                for (int bj = 0; bj < 2; ++bj)
#pragma unroll
                    for (int n = 0; n < 2; ++n) { const f32x4 v = acc[ai][bj][m][n] + *(const f32x4*)(base + off + bj * HALF + n * 16);
                        *(f32x4*)(out + off + bj * HALF + n * 16) = v; s += (v[0] * v[0] + v[1] * v[1]) + (v[2] * v[2] + v[3] * v[3]);
                        if (xb) { u32x2v w; w.x = cvt_pk_bf16(v[0], v[1]); w.y = cvt_pk_bf16(v[2], v[3]); *(u32x2v*)(xb + off + bj * HALF + n * 16) = w; } }
                if (ssq) { s += __shfl_xor(s, 16); s += __shfl_xor(s, 32); if (fq == 0) atomicAdd(ssq + row, s); }
                asm volatile("" ::: "memory"); }
    }
};

__device__ __forceinline__ float dpp_ror1(float v) { return __builtin_bit_cast(float, __builtin_amdgcn_update_dpp(0, __builtin_bit_cast(int, v), 0x121, 0xf, 0xf, false)); }
__device__ __forceinline__ float dpp_ror2(float v) { return __builtin_bit_cast(float, __builtin_amdgcn_update_dpp(0, __builtin_bit_cast(int, v), 0x122, 0xf, 0xf, false)); }
struct EpiConvGate {
    static constexpr bool PERM = true, AFTER_DRAIN = false;
    static constexpr size_t CG_SSQ = (1u << 20) + 768 * 1024, CG_ACT = (size_t)148 << 20, CG_YH = (size_t)236 << 20, CG_UPART = (size_t)240 << 20;
    unsigned char* ws; const float* fw; PG8_LAS unsigned char* ldsb;
    __device__ __forceinline__ void operator()(f32x4 (&acc)[2][2][4][2], const Unit& u, int wr, int wc, int fr0, int fq0) const {
        int fr = fr0, fq = fq0; asm volatile("" : "+v"(fr), "+v"(fq));
        bf16_t* ACT = (bf16_t*)(ws + CG_ACT); const float* ssq = (const float*)(ws + CG_SSQ); float* YH = (float*)(ws + CG_YH); float* UPART = (float*)(ws + CG_UPART);
        PG8_LAS float* halo = (PG8_LAS float*)(ldsb + STAGE_BYTES);
        int cl = wc * 32 + 8 * fq;
        int ch = u.pn * 128 + cl;
        if (fr >= 14) {
#pragma unroll
            for (int ai = 0; ai < 2; ++ai) { const float sc = rsqrtf(ssq[u.pm * BM + ai * HALF + wr * 64 + 48 + fr] * (1.0f / 1024.0f) + RMS_EPS);
#pragma unroll
                for (int bj = 0; bj < 2; ++bj)
#pragma unroll
                    for (int n = 0; n < 2; ++n) { const f32x4 v = acc[ai][bj][3][n] * sc; *(PG8_LAS f32x4*)(halo + (((wr * 2 + ai) * 2 + (fr - 14)) * 256 + bj * 128 + cl + 4 * n)) = v;
                        if (ai == 1 && wr == 1) *(f32x4*)(YH + ((size_t)(u.pm * 22 + u.pn) * 2 + (fr - 14)) * 256 + bj * 128 + cl + 4 * n) = v; } }
        }
        asm volatile("s_waitcnt lgkmcnt(0)" ::: "memory"); __builtin_amdgcn_s_barrier(); asm volatile("" ::: "memory");
        typedef unsigned u32x2v __attribute__((ext_vector_type(2)));
#pragma unroll 1
        for (int n = 0; n < 2; ++n) {
            asm volatile("" : "+v"(fr), "+v"(fq));
            cl = wc * 32 + 8 * fq; ch = u.pn * 128 + cl;
            f32x4 w[3][2];
#pragma unroll
            for (int i = 0; i < 3; ++i)
#pragma unroll
                for (int bj = 0; bj < 2; ++bj) w[i][bj] = *(const f32x4*)(fw + (size_t)i * 5632 + bj * 2816 + ch + 4 * n);
#pragma unroll
            for (int ai = 0; ai < 2; ++ai) {
                const bool top = (ai == 0 && wr == 0);
                const int pblk = (ai == 0) ? 0 : (wr == 0 ? 2 : 1);
                f32x4 pv[2];
#pragma unroll
                for (int bj = 0; bj < 2; ++bj) pv[bj] = top ? (f32x4){0.f, 0.f, 0.f, 0.f} : *(const PG8_LAS f32x4*)(halo + ((pblk * 2 + (fr & 1)) * 256 + bj * 128 + cl + 4 * n));
#pragma unroll
                for (int m = 0; m < 4; ++m) {
                    const int row = u.pm * BM + ai * HALF + wr * 64 + m * 16 + fr; const float sc = rsqrtf(ssq[row] * (1.0f / 1024.0f) + RMS_EPS);
                    f32x4 cu[2];
#pragma unroll
                    for (int bj = 0; bj < 2; ++bj) { const f32x4 ya = (n == 0) ? acc[ai][bj][m][0] : acc[ai][bj][m][1]; const f32x4 yv = (f32x4){ya[0] * sc, ya[1] * sc, ya[2] * sc, ya[3] * sc};
#pragma unroll
                        for (int k = 0; k < 4; ++k) { const float y = yv[k], pp = pv[bj][k];
                            const float a1 = dpp_ror1(y), a2 = dpp_ror2(y), b1 = dpp_ror1(pp), b2 = dpp_ror2(pp);
                            const float p1 = (fr == 0) ? b1 : a1, p2 = (fr < 2) ? b2 : a2;
                            cu[bj][k] = w[2][bj][k] * y + w[1][bj][k] * p1 + w[0][bj][k] * p2; }
                        pv[bj] = yv; }
                    if (top && m == 0 && fr < 2 && (u.pm & 7) != 0) {
#pragma unroll
                        for (int bj = 0; bj < 2; ++bj) *(f32x4*)(UPART + ((size_t)(u.pm * 22 + u.pn) * 2 + fr) * 256 + bj * 128 + cl + 4 * n) = cu[bj];
                    }
                    u32x2v o;
#define PG8_SG(k_) (cu[0][k_] / (1.0f + __expf(-cu[0][k_])) * cu[1][k_])
                    o.x = cvt_pk_bf16(PG8_SG(0), PG8_SG(1)); o.y = cvt_pk_bf16(PG8_SG(2), PG8_SG(3));
#undef PG8_SG
                    *(u32x2v*)(ACT + (size_t)row * 2816 + ch + 4 * n) = o;
                    asm volatile("" ::: "memory");
                }
            }
        }
        asm volatile("s_waitcnt lgkmcnt(0)" ::: "memory"); __builtin_amdgcn_s_barrier(); asm volatile("" ::: "memory");
    }
};
template <class Epi, class Sched, bool ALIGN_EPI = false, bool SP2 = false>
__device__ __forceinline__ void gemm_phase(PG8_LAS unsigned char* lds, const Gemm g, const Sched& S, const Epi& E) {
    const int tid = threadIdx.x, wid = __builtin_amdgcn_readfirstlane(tid >> 6), lane = tid & 63, wr = wid >> 2, wc = wid & 3, fr = lane & 15, fq = lane >> 4;
    const int K = g.K, nt = K / BK;
    unsigned voffA[2], voffB[2];
#pragma unroll
    for (int i = 0; i < 2; ++i) { int R, C; stage_rc(tid * 16 + i * 8192, R, C); const int Rb = Epi::PERM ? ((R & ~31) + perm32(R & 31)) : R;
        voffA[i] = (unsigned)(R * K + C) * 2u; voffB[i] = (unsigned)(Rb * K + C) * 2u; }
    const size_t kstep = (size_t)(BK * 2);
    const size_t hstep = (size_t)HALF * K * 2;
    const size_t tstep = 2 * hstep;
    const unsigned ldsw = (unsigned)wid * 1024u;
    const int aoff = lds_byte(wr * 64 + fr, fq * 8), boff = lds_byte(wc * 32 + fr, fq * 8);
#define PG8_SA(b, h) (((b) * 2 + (h)) * HTB)
#define PG8_SB(b, h) ((4 + (b) * 2 + (h)) * HTB)
#define PG8_STAGE(bufoff, gbase, voff) do { _Pragma("unroll") for (int _i = 0; _i < 2; ++_i) \
        __builtin_amdgcn_global_load_lds((const unsigned*)((const char*)(gbase) + (voff)[_i]), (PG8_LAS unsigned*)(lds + (bufoff) + ldsw + _i * 8192), 16, 0, 0); } while (0)
#define PG8_LDA(dst, b, h) do { _Pragma("unroll") for (int m = 0; m < 4; ++m) _Pragma("unroll") for (int k = 0; k < 2; ++k) dst[m][k] = *(const PG8_LAS bf16x8*)(lds + PG8_SA(b, h) + aoff + m * 2048 + k * 1024); } while (0)
#define PG8_LDB(dst, b, h) do { _Pragma("unroll") for (int n = 0; n < 2; ++n) _Pragma("unroll") for (int k = 0; k < 2; ++k) dst[n][k] = *(const PG8_LAS bf16x8*)(lds + PG8_SB(b, h) + boff + n * 2048 + k * 1024); } while (0)
#define PG8_MMA(ai, bj, At, Bt) do { __builtin_amdgcn_s_setprio(1); _Pragma("unroll") for (int m = 0; m < 4; ++m) _Pragma("unroll") for (int n = 0; n < 2; ++n) _Pragma("unroll") for (int k = 0; k < 2; ++k) \
        acc[ai][bj][m][n] = __builtin_amdgcn_mfma_f32_16x16x32_bf16(Bt[n][k], At[m][k], acc[ai][bj][m][n], 0, 0, 0); __builtin_amdgcn_s_setprio(0); } while (0)
#define PG8_WAIT_V(n) asm volatile("s_waitcnt vmcnt(" #n ")" ::: "memory")
#define PG8_WAIT_L(n) asm volatile("s_waitcnt lgkmcnt(" #n ")" ::: "memory")
#define PG8_BAR __builtin_amdgcn_s_barrier()
#define PG8_SCHED __builtin_amdgcn_sched_barrier(0)
    Unit cur, nxt; int ui = 0;
    if (!S.next(0, cur)) return;
    f32x4 acc[2][2][4][2];
#pragma unroll
    for (int a = 0; a < 2; ++a)
#pragma unroll
        for (int b = 0; b < 2; ++b)
#pragma unroll
            for (int m = 0; m < 4; ++m)
#pragma unroll
                for (int n = 0; n < 2; ++n) acc[a][b][m][n] = (f32x4){0.f, 0.f, 0.f, 0.f};
    bf16x8 At[4][2], B0[2][2], B1[2][2];
    const char* cA = (const char*)g.A + (size_t)cur.pm * tstep; const char* cB = (const char*)g.Bt + (size_t)cur.pn * tstep;
    S.a_ready(cur);
    if constexpr (SP2) {
        PG8_STAGE(PG8_SB(0, 0), cB, voffB); PG8_STAGE(PG8_SB(0, 1), cB + hstep, voffB); PG8_STAGE(PG8_SA(0, 0), cA, voffA); PG8_STAGE(PG8_SA(0, 1), cA + hstep, voffA);
        if (wr == 1) PG8_BAR;
        PG8_WAIT_V(2); PG8_BAR;
        PG8_STAGE(PG8_SB(1, 0), cB + kstep, voffB); PG8_STAGE(PG8_SA(1, 0), cA + kstep, voffA); PG8_STAGE(PG8_SB(1, 1), cB + hstep + kstep, voffB);
        PG8_WAIT_V(6); PG8_BAR;
    } else {
        PG8_STAGE(PG8_SB(0, 0), cB, voffB); PG8_STAGE(PG8_SA(0, 0), cA, voffA); PG8_STAGE(PG8_SB(0, 1), cB + hstep, voffB); PG8_STAGE(PG8_SA(0, 1), cA + hstep, voffA);
        if (wr == 1) PG8_BAR;
        PG8_WAIT_V(4); PG8_BAR;
        PG8_STAGE(PG8_SB(1, 0), cB + kstep, voffB); PG8_STAGE(PG8_SA(1, 0), cA + kstep, voffA); PG8_STAGE(PG8_SB(1, 1), cB + hstep + kstep, voffB);
        PG8_WAIT_V(6); PG8_BAR;
    }
    for (;;) {
        const bool has_next = S.next(ui + 1, nxt);
        const char* nA = has_next ? (const char*)g.A + (size_t)nxt.pm * tstep : cA; const char* nB = has_next ? (const char*)g.Bt + (size_t)nxt.pn * tstep : cB;
        for (int t = 0; t < nt; t += 2) {
            const bool last = (t == nt - 2);
            const char* a1 = cA + (size_t)(t + 1) * kstep;
            const char* a2 = last ? nA : cA + (size_t)(t + 2) * kstep; const char* b2 = last ? nB : cB + (size_t)(t + 2) * kstep;
            const char* a3 = a2 + kstep; const char* b3 = b2 + kstep;
            if (last && has_next) S.a_ready(nxt);
            if constexpr (SP2) {
            PG8_LDB(B0, 0, 0); PG8_LDB(B1, 0, 1); PG8_SCHED; PG8_LDA(At, 0, 0); PG8_STAGE(PG8_SA(1, 1), a1 + hstep, voffA);
            PG8_WAIT_V(8); PG8_WAIT_L(0); PG8_BAR; PG8_MMA(0, 0, At, B0); PG8_MMA(0, 1, At, B1); PG8_BAR; PG8_SCHED;
            PG8_LDA(At, 0, 1); PG8_STAGE(PG8_SB(0, 0), b2, voffB); PG8_STAGE(PG8_SB(0, 1), b2 + hstep, voffB); PG8_STAGE(PG8_SA(0, 0), a2, voffA);
            PG8_WAIT_V(8); PG8_WAIT_L(0); PG8_BAR; PG8_MMA(1, 0, At, B0); PG8_MMA(1, 1, At, B1); PG8_BAR; PG8_SCHED;
            PG8_LDB(B0, 1, 0); PG8_LDB(B1, 1, 1); PG8_SCHED; PG8_LDA(At, 1, 0); PG8_STAGE(PG8_SA(0, 1), a2 + hstep, voffA);
            PG8_WAIT_V(8); PG8_WAIT_L(0); PG8_BAR; PG8_MMA(0, 0, At, B0); PG8_MMA(0, 1, At, B1); PG8_BAR; PG8_SCHED;
            PG8_LDA(At, 1, 1); PG8_STAGE(PG8_SB(1, 0), b3, voffB); PG8_STAGE(PG8_SB(1, 1), b3 + hstep, voffB); PG8_STAGE(PG8_SA(1, 0), a3, voffA);
            PG8_WAIT_V(8); PG8_WAIT_L(0); PG8_BAR; PG8_MMA(1, 0, At, B0); PG8_MMA(1, 1, At, B1); PG8_BAR; PG8_SCHED;
            } else {
            PG8_LDB(B0, 0, 0); PG8_SCHED; PG8_LDA(At, 0, 0); PG8_STAGE(PG8_SA(1, 1), a1 + hstep, voffA);
            PG8_WAIT_L(8); PG8_BAR; PG8_WAIT_L(0); PG8_MMA(0, 0, At, B0); PG8_BAR; PG8_SCHED;
            PG8_LDB(B1, 0, 1); PG8_STAGE(PG8_SB(0, 0), b2, voffB);
            PG8_BAR; PG8_WAIT_L(0); PG8_MMA(0, 1, At, B1); PG8_BAR;
            PG8_LDA(At, 0, 1); PG8_STAGE(PG8_SA(0, 0), a2, voffA);
            PG8_BAR; PG8_WAIT_L(0); PG8_MMA(1, 0, At, B0); PG8_BAR; PG8_SCHED;
            PG8_STAGE(PG8_SB(0, 1), b2 + hstep, voffB);
            PG8_WAIT_V(6); PG8_BAR; PG8_MMA(1, 1, At, B1); PG8_BAR;
            PG8_LDB(B0, 1, 0); PG8_SCHED; PG8_LDA(At, 1, 0); PG8_STAGE(PG8_SA(0, 1), a2 + hstep, voffA);
            PG8_WAIT_L(8); PG8_BAR; PG8_WAIT_L(0); PG8_MMA(0, 0, At, B0); PG8_BAR; PG8_SCHED;
            PG8_LDB(B1, 1, 1); PG8_STAGE(PG8_SB(1, 0), b3, voffB);
            PG8_BAR; PG8_WAIT_L(0); PG8_MMA(0, 1, At, B1); PG8_BAR;
            PG8_LDA(At, 1, 1); PG8_STAGE(PG8_SA(1, 0), a3, voffA);
            PG8_BAR; PG8_WAIT_L(0); PG8_MMA(1, 0, At, B0); PG8_BAR; PG8_SCHED;
            PG8_STAGE(PG8_SB(1, 1), b3 + hstep, voffB);
            PG8_WAIT_V(6); PG8_BAR; PG8_MMA(1, 1, At, B1); PG8_BAR;
            }
        }
        if constexpr (ALIGN_EPI) { if (wr == 0) PG8_BAR; }
        if constexpr (!Epi::AFTER_DRAIN) { E(acc, cur, wr, wc, fr, fq); S.done(cur); }
        if (!has_next) break;
#pragma unroll
        for (int a = 0; a < 2; ++a)
#pragma unroll
            for (int b = 0; b < 2; ++b)
#pragma unroll
                for (int m = 0; m < 4; ++m)
#pragma unroll
                    for (int n = 0; n < 2; ++n) acc[a][b][m][n] = (f32x4){0.f, 0.f, 0.f, 0.f};
        cur = nxt; cA = nA; cB = nB; ++ui;
        if constexpr (ALIGN_EPI) { if (wr == 1) PG8_BAR; }
    }
    PG8_WAIT_V(0);
    if constexpr (!ALIGN_EPI) { if (wr == 0) PG8_BAR; }
    PG8_BAR;
    if constexpr (Epi::AFTER_DRAIN) { E.fused(acc, cur, wr, wc, fr, fq, lds, wid, lane); S.done(cur); }
#undef PG8_SA
#undef PG8_SB
#undef PG8_STAGE
#undef PG8_LDA
#undef PG8_LDB
#undef PG8_MMA
#undef PG8_WAIT_V
#undef PG8_WAIT_L
#undef PG8_BAR
#undef PG8_SCHED
}
}
#ifndef PG8_SP2
#define PG8_SP2 true
#endif
#ifndef PG8_ALIGN
#define PG8_ALIGN true
#endif
constexpr int NB = 8, SEQ = 2048, DM = 1024, M = NB * SEQ;
constexpr int GH = 4, GD = 128, GW = 512, AH = 8, AD = 64;
constexpr int INC = 3592, NP = 3584;
constexpr int DFF = 2816, NUP = 2 * DFF;
constexpr int PC_QA = 0, PC_KA = 512, PC_VA = 1024, PC_Z = 1536, PC_QB = 2048, PC_KB = 2560, PC_VB = 3072;
constexpr size_t MiB = 1u << 20;
constexpr size_t WS_CTL = 0, WS_AB = 1 * MiB, WS_SSQ = 1 * MiB + 768 * 1024, WS_WIN = 2 * MiB, WS_WOUT = 9 * MiB, WS_WUP = 11 * MiB, WS_WDN = 22 * MiB;
constexpr size_t WS_XN = 28 * MiB, WS_PROJ = 60 * MiB, WS_CAT = 172 * MiB, WS_OA = 204 * MiB, WS_Y = 60 * MiB, WS_ACT = 148 * MiB, WS_END = 256 * MiB;
using pg8::RMS_EPS;
constexpr size_t WS_YH = 236 * MiB, WS_UPART = 240 * MiB;
constexpr size_t WS_GE = WS_SSQ + 65536;
constexpr int GOPS_CHUNK = 57344;
constexpr int SCAN_BUF = GOPS_CHUNK + 16384;
constexpr int NWAVES = 8, NTHR = 512;
constexpr int LDS_BYTES = 155648;
#define LAS __attribute__((address_space(3)))
typedef unsigned short bf16;
typedef unsigned v4u __attribute__((ext_vector_type(4)));
typedef unsigned v2u __attribute__((ext_vector_type(2)));
typedef float f32x4 __attribute__((ext_vector_type(4)));
__device__ __forceinline__ float bf2f(unsigned b) { return __uint_as_float(b << 16); }
__device__ __forceinline__ float bflo(unsigned w) { return __uint_as_float(w << 16); }
__device__ __forceinline__ float bfhi(unsigned w) { return __uint_as_float(w & 0xffff0000u); }
__device__ __forceinline__ unsigned pk2(float lo, float hi) { return pg8::cvt_pk_bf16(lo, hi); }
__device__ __forceinline__ float wave_sum(float v) {
#pragma unroll
    for (int o = 1; o < 64; o <<= 1) v += __shfl_xor(v, o);
    return v;
}
__device__ __forceinline__ float silu_f(float x) { return x / (1.0f + __expf(-x)); }
__device__ __forceinline__ float sigmoid_f(float x) { return 1.0f / (1.0f + __expf(-x)); }
__device__ __forceinline__ float softplus_f(float x) { return x > 20.f ? x : log1pf(__expf(x)); }

struct Args { const float* in[13]; float* out; unsigned char* ws; int ph_lo, ph_hi, coop, pad; };

__device__ __forceinline__ void p0_transpose_item(const float* W, int ldw, int k0, int sn0, bf16* WT, int K, int dn0, const float* kscale, LAS float* scr, int lane) {
#pragma unroll 8
    for (int i = 0; i < 32; ++i) { const int kk = 2 * i + (lane >> 5); float v = W[(size_t)(k0 + kk) * ldw + sn0 + (lane & 31)]; if (kscale) v *= kscale[k0 + kk]; scr[kk * 33 + (lane & 31)] = v; }
    asm volatile("s_waitcnt lgkmcnt(0)" ::: "memory");
    const int c = lane & 7;
#pragma unroll
    for (int j = 0; j < 4; ++j) { const int n = (lane >> 3) + 8 * j; const LAS float* s = scr + (8 * c) * 33 + n;
        v4u o; o.x = pk2(s[0 * 33], s[1 * 33]); o.y = pk2(s[2 * 33], s[3 * 33]); o.z = pk2(s[4 * 33], s[5 * 33]); o.w = pk2(s[6 * 33], s[7 * 33]);
        *(v4u*)(WT + (size_t)(dn0 + n) * K + k0 + 8 * c) = o; }
    asm volatile("s_waitcnt lgkmcnt(0)" ::: "memory");
}

__device__ __forceinline__ void p0_prologue(const Args& A, LAS unsigned char* lds, int tid, int lane, int wave) {
    const float* x = A.in[0]; const float* nw1 = A.in[1]; const float* w_in = A.in[2]; const float* w_out = A.in[7]; const float* nw2 = A.in[8];
    const float* w_up = A.in[9]; const float* w_dn = A.in[11];
    unsigned char* ws = A.ws;
    bf16* WIN = (bf16*)(ws + WS_WIN); bf16* WOUT = (bf16*)(ws + WS_WOUT); bf16* WUP = (bf16*)(ws + WS_WUP); bf16* WDN = (bf16*)(ws + WS_WDN);
    bf16* XN = (bf16*)(ws + WS_XN); float* AB = (float*)(ws + WS_AB); float* SSQ = (float*)(ws + WS_SSQ);
    LAS float* scr = (LAS float*)(lds + wave * 9216);
    LAS float* wab = (LAS float*)(lds + 73728);
    const int G = gridDim.x, gw = blockIdx.x * NWAVES + wave, NGW = G * NWAVES;
    for (int i = blockIdx.x * NTHR + tid; i < M; i += G * NTHR) SSQ[i] = 0.f;
    if (blockIdx.x == 0 && tid < 64) ((unsigned*)(ws + WS_CTL))[tid] = 0u;
    for (int idx = tid; idx < 8192; idx += NTHR) { const int k = idx >> 3, j = idx & 7; wab[j * 1024 + k] = nw1[k] * w_in[(size_t)k * INC + 2048 + j]; }
    constexpr int I_IN = 16 * (NP / 32), I_OUT = 16 * 32, I_UP = 16 * (NUP / 32), I_DN = (DFF / 64) * 32;
    constexpr int NITEMS = I_IN + I_OUT + I_UP + I_DN;
    for (int it = gw; it < NITEMS; it += NGW) {
        int r = it;
        if (r < I_IN) { const int nblk = NP / 32, kb = r / nblk, nb = r % nblk, n0 = 32 * nb; p0_transpose_item(w_in, INC, 64 * kb, n0 + (n0 >= 2048 ? 8 : 0), WIN, DM, n0, nullptr, scr, lane); continue; } r -= I_IN;
        if (r < I_OUT) { const int kb = r / 32, nb = r % 32; p0_transpose_item(w_out, DM, 64 * kb, 32 * nb, WOUT, DM, 32 * nb, nullptr, scr, lane); continue; } r -= I_OUT;
        if (r < I_UP) { const int nblk = NUP / 32, kb = r / nblk, nb = r % nblk, n0 = 32 * nb, pn = n0 >> 8, j0 = n0 & 255;
            const int s0 = (j0 < 128) ? (128 * pn + j0) : (DFF + 128 * pn + j0 - 128);
            p0_transpose_item(w_up, NUP, 64 * kb, s0, WUP, DM, n0, nw2, scr, lane); continue; } r -= I_UP;
        { const int kb = r / 32, nb = r % 32; p0_transpose_item(w_dn, DM, 64 * kb, 32 * nb, WDN, DFF, 32 * nb, nullptr, scr, lane); }
    }
    __syncthreads();
    for (int m = gw; m < M; m += NGW) {
        const f32x4* xr = (const f32x4*)(x + (size_t)m * DM) + lane; const f32x4* nr = (const f32x4*)nw1 + lane;
        f32x4 v[4]; float s = 0.f;
#pragma unroll
        for (int j = 0; j < 4; ++j) { v[j] = xr[64 * j]; s += (v[j].x * v[j].x + v[j].y * v[j].y) + (v[j].z * v[j].z + v[j].w * v[j].w); }
        const float rstd = rsqrtf(wave_sum(s) * (1.f / DM) + RMS_EPS);
        float ab[8];
#pragma unroll
        for (int q = 0; q < 8; ++q) { float a = 0.f;
#pragma unroll
            for (int j = 0; j < 4; ++j) { const f32x4 w = *(const LAS f32x4*)(wab + q * 1024 + 256 * j + 4 * lane); a += (v[j].x * w.x + v[j].y * w.y) + (v[j].z * w.z + v[j].w * w.w); }
            ab[q] = wave_sum(a) * rstd; }
        if (lane == 0) { *(f32x4*)(AB + (size_t)m * 8) = (f32x4){ab[0], ab[1], ab[2], ab[3]}; *(f32x4*)(AB + (size_t)m * 8 + 4) = (f32x4){ab[4], ab[5], ab[6], ab[7]}; }
        v2u* o8 = (v2u*)(XN + (size_t)m * DM) + lane;
#pragma unroll
        for (int j = 0; j < 4; ++j) { const f32x4 n = nr[64 * j]; v2u o; o.x = pk2(v[j].x * rstd * n.x, v[j].y * rstd * n.y); o.y = pk2(v[j].z * rstd * n.z, v[j].w * rstd * n.w); o8[64 * j] = o; }
    }
}

__device__ __forceinline__ void gdn_simple(const Args& A, LAS unsigned char* lds, int tid, int lane, int wave) {
    const bf16* PROJ = (const bf16*)(A.ws + WS_PROJ); const float* AB = (const float*)(A.ws + WS_AB); float* OA = (float*)(A.ws + WS_OA);
    const float* cw = A.in[3]; const float* a_log = A.in[4]; const float* dt_bias = A.in[5];
    LAS float* qs = (LAS float*)lds; LAS float* ks = qs + 16 * 128; LAS float* vs = ks + 16 * 128; LAS float* av = vs + 16 * 128; LAS float* bv = av + 16;
    for (int task = blockIdx.x; task < NB * GH; task += gridDim.x) {
        const int b = task / GH, h = task % GH, v = tid >> 2, part = tid & 3;
        float S[32];
#pragma unroll
        for (int i = 0; i < 32; ++i) S[i] = 0.f;
        const float Ah = __expf(a_log[h]), dtb = dt_bias[h];
        for (int blk = 0; blk < SEQ / 16; ++blk) {
            const int t0 = blk * 16;
            for (int idx = tid; idx < 16 * 384; idx += NTHR) {
                const int tt = idx / 384, c = idx % 384, which = c >> 7, d = c & 127, col = which * 512 + h * 128 + d, t = t0 + tt;
                float acc = 0.f;
#pragma unroll
                for (int i = 0; i < 4; ++i) { const int ts = t - 3 + i; if (ts >= 0) acc += cw[i * 1536 + col] * bf2f(PROJ[(size_t)(b * SEQ + ts) * NP + col]); }
                qs[which * 2048 + tt * 128 + d] = silu_f(acc);
            }
            if (tid < 16) { const size_t row = (size_t)b * SEQ + t0 + tid; bv[tid] = sigmoid_f(AB[row * 8 + h]); av[tid] = __expf(-Ah * softplus_f(AB[row * 8 + 4 + h] + dtb)); }
            __syncthreads();
#pragma unroll
            for (int r = 0; r < 4; ++r) { const int row = 4 * wave + r; LAS float* arr = qs + row * 128;
                const float v0 = arr[lane], v1 = arr[lane + 64]; const float s = wave_sum(v0 * v0 + v1 * v1);
                const float sc = rsqrtf(s + RMS_EPS) * (row < 16 ? 0.08838834764831845f : 1.0f); arr[lane] = v0 * sc; arr[lane + 64] = v1 * sc; }
            __syncthreads();
            for (int tt = 0; tt < 16; ++tt) {
                const float a = av[tt], bt = bv[tt], vt = vs[tt * 128 + v];
                float kS = 0.f;
#pragma unroll
                for (int i = 0; i < 32; ++i) kS += ks[tt * 128 + 32 * part + i] * S[i];
                kS += __shfl_xor(kS, 1); kS += __shfl_xor(kS, 2);
                const float c = bt * (vt - a * kS); float o = 0.f;
#pragma unroll
                for (int i = 0; i < 32; ++i) { S[i] = a * S[i] + ks[tt * 128 + 32 * part + i] * c; o += qs[tt * 128 + 32 * part + i] * S[i]; }
                o += __shfl_xor(o, 1); o += __shfl_xor(o, 2);
                if (part == 0) OA[(size_t)(b * SEQ + t0 + tt) * GW + h * 128 + v] = o;
            }
            __syncthreads();
        }
    }
}


template <int J, int K, int N> struct SolveLd {
    static __device__ __forceinline__ void run(f32x4 (&l)[16], unsigned lbase) {
        if constexpr (K < N) { constexpr int t40 = ((J + 1) >> 2) << 2;
            asm volatile("ds_read_b128 %0, %1 offset:%2" : "=v"(l[K]) : "v"(lbase), "i"((J * 68 + t40 + 4 * K) * 4)); SolveLd<J, K + 1, N>::run(l, lbase); }
    }
};
template <int J> struct SolveCol {
    static __device__ __forceinline__ void run(float (&R)[64], unsigned lbase) {
        if constexpr (J < 63) {
            constexpr int t40 = ((J + 1) >> 2) << 2, nld = (64 - t40) >> 2;
            f32x4 l[16];
            SolveLd<J, 0, nld>::run(l, lbase);
            asm volatile("s_waitcnt lgkmcnt(0)" ::: "memory");
#pragma unroll
            for (int k = 0; k < nld; ++k) asm volatile("" : "+v"(l[k]));
#pragma unroll
            for (int k = 0; k < nld; ++k) {
#pragma unroll
                for (int e = 0; e < 4; ++e) if (t40 + 4 * k + e > J) R[t40 + 4 * k + e] -= l[k][e] * R[J]; }
            SolveCol<J + 1>::run(R, lbase);
        }
    }
};

typedef short bf16x8 __attribute__((ext_vector_type(8)));
__device__ __forceinline__ void gdn_prep(const Args& A, LAS unsigned char* lds, int tid0, int lane0, int wave) {
    const bf16* PROJ = (const bf16*)(A.ws + WS_PROJ); const float* AB = (const float*)(A.ws + WS_AB);
    const float* cw = A.in[3]; const float* a_log = A.in[4]; const float* dt_bias = A.in[5];
    unsigned char* UVF = A.ws + WS_XN; unsigned char* GOPS = (unsigned char*)A.out; float* GE = (float*)(A.ws + WS_GE);
    LAS float* Qs = (LAS float*)lds; LAS float* Ks = (LAS float*)(lds + 33792); LAS float* Vs = (LAS float*)(lds + 67584);
    LAS bf16* Qb = (LAS bf16*)(lds + 101376); LAS bf16* Kb = (LAS bf16*)(lds + 118784);
    LAS float* gcs = (LAS float*)(lds + 136192); LAS float* bts = gcs + 64; LAS float* egs = gcs + 128; LAS float* kes = gcs + 192;
    LAS float* LsT = (LAS float*)lds; LAS bf16* ATs = (LAS bf16*)(lds + 17408); LAS bf16* WKs = Kb;
#pragma unroll 1
    for (int task = blockIdx.x; task < NB * GH * 32; task += gridDim.x) {
        int tid = tid0, lane = lane0; asm volatile("" : "+v"(tid), "+v"(lane));
        const int fr = lane & 15, fq = lane >> 4;
        const int bh = task >> 5, n = task & 31, b = bh >> 2, h = bh & 3, t0 = 64 * n, row0 = b * SEQ + t0;
        unsigned char* gops = GOPS + (size_t)task * GOPS_CHUNK;
        for (int idx = tid; idx < 3072; idx += NTHR) {
            const int tt = idx / 48, c8 = idx % 48, which = c8 >> 4, d0 = (c8 & 15) * 8, col = which * 512 + h * 128 + d0;
            float acc[8];
#pragma unroll
            for (int e = 0; e < 8; ++e) acc[e] = 0.f;
#pragma unroll
            for (int i = 0; i < 4; ++i) { const int ts = t0 + tt - 3 + i; if (ts < 0) continue;
                const v4u w = *(const v4u*)(PROJ + (size_t)(b * SEQ + ts) * NP + col); const f32x4 c0 = *(const f32x4*)(cw + i * 1536 + col), c1 = *(const f32x4*)(cw + i * 1536 + col + 4);
                acc[0] += c0.x * bflo(w.x); acc[1] += c0.y * bfhi(w.x); acc[2] += c0.z * bflo(w.y); acc[3] += c0.w * bfhi(w.y);
                acc[4] += c1.x * bflo(w.z); acc[5] += c1.y * bfhi(w.z); acc[6] += c1.z * bflo(w.w); acc[7] += c1.w * bfhi(w.w); }
            LAS float* dst = (which == 0 ? Qs : (which == 1 ? Ks : Vs)) + tt * 132 + d0;
            *(LAS f32x4*)dst = (f32x4){silu_f(acc[0]), silu_f(acc[1]), silu_f(acc[2]), silu_f(acc[3])};
            *(LAS f32x4*)(dst + 4) = (f32x4){silu_f(acc[4]), silu_f(acc[5]), silu_f(acc[6]), silu_f(acc[7])};
        }
        if (wave == 0) {
            const size_t row = (size_t)row0 + lane; const float beta = sigmoid_f(AB[row * 8 + h]);
            float g = -__expf(a_log[h]) * softplus_f(AB[row * 8 + 4 + h] + dt_bias[h]);
#pragma unroll
            for (int o = 1; o < 64; o <<= 1) { const float t = __shfl_up(g, o); if (lane >= o) g += t; }
            const float glast = __shfl(g, 63);
            gcs[lane] = g; bts[lane] = beta; egs[lane] = __expf(g); kes[lane] = __expf(glast - g) * beta;
            if (lane == 63) GE[task] = __expf(g);
        }
        __syncthreads();
#pragma unroll 2
        for (int r = 0; r < 8; ++r) { const int row = 8 * wave + r;
            { const float v0 = Qs[row * 132 + lane], v1 = Qs[row * 132 + lane + 64]; const float sc = rsqrtf(wave_sum(v0 * v0 + v1 * v1) + RMS_EPS) * 0.08838834764831845f;
              Qb[row * 136 + lane] = (bf16)(pk2(v0 * sc, 0.f) & 0xffffu); Qb[row * 136 + lane + 64] = (bf16)(pk2(v1 * sc, 0.f) & 0xffffu); }
            { const float v0 = Ks[row * 132 + lane], v1 = Ks[row * 132 + lane + 64]; const float sc = rsqrtf(wave_sum(v0 * v0 + v1 * v1) + RMS_EPS);
              Ks[row * 132 + lane] = v0 * sc; Ks[row * 132 + lane + 64] = v1 * sc; Kb[row * 136 + lane] = (bf16)(pk2(v0 * sc, 0.f) & 0xffffu); Kb[row * 136 + lane + 64] = (bf16)(pk2(v1 * sc, 0.f) & 0xffffu); }
        }
        __syncthreads();
#pragma unroll 1
        for (int jb = wave; jb < 20; jb += 8) {
            const int kind = jb >= 10 ? 1 : 0, idx = jb - 10 * kind, ti = idx < 1 ? 0 : (idx < 3 ? 1 : (idx < 6 ? 2 : 3)), tj = idx - ti * (ti + 1) / 2;
            const LAS bf16* As = kind ? Qb : Kb; f32x4 d = (f32x4){0.f, 0.f, 0.f, 0.f};
#pragma unroll
            for (int ks = 0; ks < 4; ++ks) { const bf16x8 a = *(const LAS bf16x8*)(As + (16 * ti + fr) * 136 + 32 * ks + 8 * fq), bb = *(const LAS bf16x8*)(Kb + (16 * tj + fr) * 136 + 32 * ks + 8 * fq);
                d = __builtin_amdgcn_mfma_f32_16x16x32_bf16(a, bb, d, 0, 0, 0); }
            const int j = 16 * tj + fr; const float gj = gcs[j], bj = bts[j]; float val[4];
#pragma unroll
            for (int e = 0; e < 4; ++e) { const int t = 16 * ti + 4 * fq + e; const float x = d[e] * __expf(gcs[t] - gj) * bj; val[e] = (kind ? (t >= j) : (t > j)) ? x : 0.f; }
            if (kind == 0) *(LAS f32x4*)(LsT + j * 68 + 16 * ti + 4 * fq) = (f32x4){val[0], val[1], val[2], val[3]};
            else {
#pragma unroll
                for (int e = 0; e < 4; ++e) ATs[(16 * ti + 4 * fq + e) * 72 + j] = (bf16)(pk2(val[e], 0.f) & 0xffffu); }
        }
        __syncthreads();
        float R[64];
        if (wave < 4) {
            if (wave < 2) {
#pragma unroll
                for (int t = 0; t < 64; ++t) R[t] = Vs[t * 132 + 64 * wave + lane];
            } else {
#pragma unroll
                for (int t = 0; t < 64; ++t) R[t] = egs[t] * Ks[t * 132 + 64 * (wave - 2) + lane];
            }
            SolveCol<0>::run(R, (unsigned)(uintptr_t)LsT);
            if (wave < 2) {
                const int v = 64 * wave + lane; unsigned char* uvp = UVF + (size_t)task * 16384 + (size_t)((v >> 4) * 4 * 64 + (v & 15)) * 8; asm volatile("" : "+v"(uvp));
#pragma unroll
                for (int g = 0; g < 16; ++g) { v2u w; w.x = pk2(R[4 * g], R[4 * g + 1]); w.y = pk2(R[4 * g + 2], R[4 * g + 3]); *(v2u*)(uvp + ((g >> 2) * 64 + 16 * (g & 3)) * 8) = w; }
            } else {
#pragma unroll
                for (int t = 0; t < 64; ++t) WKs[t * 136 + 64 * (wave - 2) + lane] = (bf16)(pk2(R[t], 0.f) & 0xffffu);
            }
        } else {
            const int rt = tid - 256;
            for (int q = rt; q < 1024; q += 256) { const int blk = q >> 6, l2 = q & 63, i = l2 & 15, f = l2 >> 4, mb = blk >> 2, ks = blk & 3, t = 16 * mb + i;
                const v2u p0 = *(const LAS v2u*)(Qb + t * 136 + 32 * ks + 4 * f), p1 = *(const LAS v2u*)(Qb + t * 136 + 32 * ks + 16 + 4 * f); const float e = egs[t];
                v4u o; o.x = pk2(bflo(p0.x) * e, bfhi(p0.x) * e); o.y = pk2(bflo(p0.y) * e, bfhi(p0.y) * e); o.z = pk2(bflo(p1.x) * e, bfhi(p1.x) * e); o.w = pk2(bflo(p1.y) * e, bfhi(p1.y) * e);
                *(v4u*)(gops + 16384 + q * 16) = o; }
            for (int q = rt; q < 512; q += 256) { const int blk = q >> 6, l2 = q & 63, i = l2 & 15, f = l2 >> 4, mb = blk >> 1, ks2 = blk & 1, t = 16 * mb + i;
                v2u p0 = (v2u){0u, 0u}, p1 = (v2u){0u, 0u};
                if (2 * ks2 <= mb) p0 = *(const LAS v2u*)(ATs + t * 72 + 32 * ks2 + 4 * f);
                if (2 * ks2 + 1 <= mb) p1 = *(const LAS v2u*)(ATs + t * 72 + 32 * ks2 + 16 + 4 * f);
                *(v4u*)(gops + 32768 + q * 16) = (v4u){p0.x, p0.y, p1.x, p1.y}; }
            for (int q = rt; q < 1024; q += 256) { const int blk = q >> 6, l2 = q & 63, i = l2 & 15, f = l2 >> 4, dkb = blk >> 1, ks2 = blk & 1, dk = 16 * dkb + i; float v[8];
#pragma unroll
                for (int e = 0; e < 8; ++e) { const int c = 32 * ks2 + 16 * (e >> 2) + 4 * f + (e & 3); v[e] = Ks[c * 132 + dk] * kes[c]; }
                *(v4u*)(gops + 40960 + q * 16) = (v4u){pk2(v[0], v[1]), pk2(v[2], v[3]), pk2(v[4], v[5]), pk2(v[6], v[7])}; }
        }
        __syncthreads();
        for (int q = tid; q < 1024; q += NTHR) { const int blk = q >> 6, l2 = q & 63, i = l2 & 15, f = l2 >> 4, mb = blk >> 2, ks = blk & 3, t = 16 * mb + i;
            const v2u p0 = *(const LAS v2u*)(WKs + t * 136 + 32 * ks + 4 * f), p1 = *(const LAS v2u*)(WKs + t * 136 + 32 * ks + 16 + 4 * f);
            *(v4u*)(gops + q * 16) = (v4u){p0.x, p0.y, p1.x, p1.y}; }
        __syncthreads();
    }
}

__device__ __forceinline__ bf16x8 pack8(const f32x4 a, const f32x4 b) {
    v4u w; w.x = pk2(a[0], a[1]); w.y = pk2(a[2], a[3]); w.z = pk2(b[0], b[1]); w.w = pk2(b[2], b[3]); return __builtin_bit_cast(bf16x8, w);
}
__device__ __forceinline__ void gdn_scan(const Args& A, LAS unsigned char* lds, int bh, int tid, int lane, int wave) {
    const int b = bh >> 2, h = bh & 3, fr = lane & 15, fq = lane >> 4, vs = wave;
    const unsigned char* gops = (const unsigned char*)A.out + (size_t)bh * 32 * GOPS_CHUNK;
    const unsigned char* uvf = A.ws + WS_XN + (size_t)bh * 32 * 16384; const float* GE = (const float*)(A.ws + WS_GE) + bh * 32;
    float* Op = (float*)(A.ws + WS_OA) + ((size_t)b * SEQ + 4 * fq) * GW + h * 128 + 16 * vs + fr;
    f32x4 S[8];
#pragma unroll
    for (int i = 0; i < 8; ++i) S[i] = (f32x4){0.f, 0.f, 0.f, 0.f};
    const float gev = GE[lane & 31];
#define SCAN_DMA(chunk, bufoff) do { _Pragma("unroll") for (int i_ = 0; i_ < 9; ++i_) { const int p_ = wave + 8 * i_; \
        const unsigned char* s_ = (p_ < 56) ? (gops + (size_t)(chunk) * GOPS_CHUNK + p_ * 1024) : (uvf + (size_t)(chunk) * 16384 + (p_ - 56) * 1024); \
        __builtin_amdgcn_global_load_lds((const unsigned*)(s_ + lane * 16), (LAS unsigned*)(lds + (bufoff) + p_ * 1024), 16, 0, 0); } } while (0)
    SCAN_DMA(0, 0); SCAN_DMA(1, SCAN_BUF);
    asm volatile("s_waitcnt vmcnt(0)" ::: "memory"); __syncthreads();
#pragma unroll 1
    for (int n = 0; n < 32; ++n) {
        const LAS unsigned char* cur = lds + (n & 1) * SCAN_BUF;
        const float ge = __builtin_bit_cast(float, __builtin_amdgcn_readlane(__builtin_bit_cast(int, gev), n));
        bf16x8 Sb[4];
#pragma unroll
        for (int ks = 0; ks < 4; ++ks) Sb[ks] = pack8(S[2 * ks], S[2 * ks + 1]);
        f32x4 u[4];
#pragma unroll
        for (int mb = 0; mb < 4; ++mb) { f32x4 p = (f32x4){0.f, 0.f, 0.f, 0.f};
#pragma unroll
            for (int ks = 0; ks < 4; ++ks) p = __builtin_amdgcn_mfma_f32_16x16x32_bf16(*(const LAS bf16x8*)(cur + ((mb * 4 + ks) * 64 + lane) * 16), Sb[ks], p, 0, 0, 0);
            const v2u uw = *(const LAS v2u*)(cur + GOPS_CHUNK + ((vs * 4 + mb) * 64 + lane) * 8);
            u[mb] = (f32x4){bflo(uw.x) - p[0], bfhi(uw.x) - p[1], bflo(uw.y) - p[2], bfhi(uw.y) - p[3]}; }
        bf16x8 ub[2]; ub[0] = pack8(u[0], u[1]); ub[1] = pack8(u[2], u[3]);
        f32x4 o[4];
#pragma unroll
        for (int mb = 0; mb < 4; ++mb) { f32x4 acc = (f32x4){0.f, 0.f, 0.f, 0.f};
#pragma unroll
            for (int ks = 0; ks < 4; ++ks) acc = __builtin_amdgcn_mfma_f32_16x16x32_bf16(*(const LAS bf16x8*)(cur + 16384 + ((mb * 4 + ks) * 64 + lane) * 16), Sb[ks], acc, 0, 0, 0);
#pragma unroll
            for (int ks2 = 0; ks2 < 2; ++ks2) if (ks2 <= (mb >> 1)) acc = __builtin_amdgcn_mfma_f32_16x16x32_bf16(*(const LAS bf16x8*)(cur + 32768 + ((mb * 2 + ks2) * 64 + lane) * 16), ub[ks2], acc, 0, 0, 0);
            o[mb] = acc; }
#pragma unroll
        for (int dkb = 0; dkb < 8; ++dkb) { f32x4 acc = S[dkb] * ge;
#pragma unroll
            for (int ks2 = 0; ks2 < 2; ++ks2) acc = __builtin_amdgcn_mfma_f32_16x16x32_bf16(*(const LAS bf16x8*)(cur + 40960 + ((dkb * 2 + ks2) * 64 + lane) * 16), ub[ks2], acc, 0, 0, 0);
            S[dkb] = acc; }
        asm volatile("s_waitcnt vmcnt(0)" ::: "memory"); __syncthreads();
        if (n + 2 < 32) SCAN_DMA(n + 2, (n & 1) * SCAN_BUF);
        float* orow = Op + (size_t)(64 * n) * GW;
#pragma unroll
        for (int mb = 0; mb < 4; ++mb) { float* q = orow + (size_t)(16 * mb) * GW; q[0] = o[mb][0]; q[GW] = o[mb][1]; q[2 * GW] = o[mb][2]; q[3 * GW] = o[mb][3]; }
    }
    asm volatile("s_waitcnt vmcnt(0)" ::: "memory"); __syncthreads();
#undef SCAN_DMA
}


__device__ __forceinline__ void attn_fast(const Args& A, LAS unsigned char* lds, int lane, int wave) {
    const bf16* PROJ = (const bf16*)(A.ws + WS_PROJ); bf16* CAT = (bf16*)(A.ws + WS_CAT);
    unsigned* ctr = (unsigned*)(A.ws + WS_CTL);
    LAS bf16* Vt = (LAS bf16*)(lds + wave * 8192);
    const int fr = lane & 15, fq = lane >> 4;
    const int kk = lane & 31, vslot = 8 * ((kk & 15) >> 2) + 4 * (kk >> 4) + (kk & 3), vch = lane >> 5;
    constexpr float SC = 0.125f * 1.4426950408889634f;
    for (;;) {
        unsigned wt_ = 0; if (lane == 0) wt_ = atomicAdd(ctr, 1u); const int wt = __builtin_amdgcn_readfirstlane(wt_);
        if (wt >= NB * AH * 8 * 16) break;
        const int T = 7 - (wt >> 10), rem = wt & 1023, b = rem >> 7, h = (rem >> 4) & 7, c = rem & 15, t0 = 256 * T;
        const bf16* Pb = PROJ + (size_t)b * SEQ * NP;
        const int tq = t0 + c + 16 * fr;
        bf16x8 qf[2];
#pragma unroll
        for (int ks = 0; ks < 2; ++ks) qf[ks] = *(const bf16x8*)(Pb + (size_t)tq * NP + PC_QB + h * 64 + 32 * ks + 8 * fq);
        const int lo2 = c, n2 = ((t0 + 240) >> 4) + 1, g2 = (n2 + 31) >> 5;
        const int lo1 = max(t0 + c - 512, c & 3), n1 = ((t0 + c + 240 - lo1) >> 2) + 1, g1 = (n1 + 31) >> 5;
        const int lo0 = max(t0 + c - 128, 0), n0 = (t0 + c + 240 - lo0) + 1, g0 = (n0 + 31) >> 5;
        const int NG = g2 + g1 + g0;
        f32x4 O[4];
#pragma unroll
        for (int i = 0; i < 4; ++i) O[i] = (f32x4){0.f, 0.f, 0.f, 0.f};
        float mrun = -INFINITY, lrun = 0.f;
        v4u kc[4], vc[4], kn[4], vn[4];
#define ATT_DEC(f, kst, str) do { if ((f) < g2) { str = 16; kst = lo2 + 512 * (f); } else if ((f) < g2 + g1) { str = 4; kst = lo1 + 128 * ((f) - g2); } else { str = 1; kst = lo0 + 32 * ((f) - g2 - g1); } } while (0)
#define ATT_LOAD(kreg, vreg, kst, str) do { \
            _Pragma("unroll") for (int j = 0; j < 2; ++j) { const int tk = min((kst) + (str) * (16 * j + fr), SEQ - 1); \
                _Pragma("unroll") for (int ks = 0; ks < 2; ++ks) kreg[2 * j + ks] = *(const v4u*)(Pb + (size_t)tk * NP + PC_KB + h * 64 + 32 * ks + 8 * fq); } \
            { const int tk = min((kst) + (str) * kk, SEQ - 1); \
                _Pragma("unroll") for (int i = 0; i < 4; ++i) vreg[i] = *(const v4u*)(Pb + (size_t)tk * NP + PC_VB + h * 64 + 8 * (vch + 2 * i)); } } while (0)
        int kst, str; ATT_DEC(0, kst, str); ATT_LOAD(kc, vc, kst, str);
#pragma unroll 1
        for (int f = 0; f < NG; ++f) {
            int kstn = 0, strn = 1;
            if (f + 1 < NG) { ATT_DEC(f + 1, kstn, strn); ATT_LOAD(kn, vn, kstn, strn); }
            f32x4 d0 = (f32x4){0.f, 0.f, 0.f, 0.f}, d1 = d0;
#pragma unroll
            for (int ks = 0; ks < 2; ++ks) { d0 = __builtin_amdgcn_mfma_f32_16x16x32_bf16(__builtin_bit_cast(bf16x8, kc[ks]), qf[ks], d0, 0, 0, 0);
                                             d1 = __builtin_amdgcn_mfma_f32_16x16x32_bf16(__builtin_bit_cast(bf16x8, kc[2 + ks]), qf[ks], d1, 0, 0, 0); }
#pragma unroll
            for (int i = 0; i < 4; ++i) { const int dd = 8 * (vch + 2 * i); const v4u w = vc[i];
                Vt[(dd + 0) * 40 + vslot] = (bf16)(w.x & 0xffffu); Vt[(dd + 1) * 40 + vslot] = (bf16)(w.x >> 16); Vt[(dd + 2) * 40 + vslot] = (bf16)(w.y & 0xffffu); Vt[(dd + 3) * 40 + vslot] = (bf16)(w.y >> 16);
                Vt[(dd + 4) * 40 + vslot] = (bf16)(w.z & 0xffffu); Vt[(dd + 5) * 40 + vslot] = (bf16)(w.z >> 16); Vt[(dd + 6) * 40 + vslot] = (bf16)(w.w & 0xffffu); Vt[(dd + 7) * 40 + vslot] = (bf16)(w.w >> 16); }
            float s[8]; const int span = 128 * str; float mloc = -INFINITY;
#pragma unroll
            for (int e = 0; e < 8; ++e) { const int tk = kst + str * (16 * (e >> 2) + 4 * fq + (e & 3)); const int dt = tq - tk; const float x = (e < 4 ? d0[e & 3] : d1[e & 3]) * SC;
                s[e] = (dt >= 0 && dt <= span) ? x : -INFINITY; mloc = fmaxf(mloc, s[e]); }
            mloc = fmaxf(mloc, __shfl_xor(mloc, 16)); mloc = fmaxf(mloc, __shfl_xor(mloc, 32));
            const float mnew = fmaxf(mrun, mloc), alpha = __builtin_amdgcn_exp2f(mrun - mnew); mrun = mnew;
            float psum = 0.f;
#pragma unroll
            for (int e = 0; e < 8; ++e) { s[e] = __builtin_amdgcn_exp2f(s[e] - mnew); psum += s[e]; }
            lrun = lrun * alpha + psum;
            const bf16x8 pb = pack8((f32x4){s[0], s[1], s[2], s[3]}, (f32x4){s[4], s[5], s[6], s[7]});
#pragma unroll
            for (int db = 0; db < 4; ++db) { const bf16x8 a = *(const LAS bf16x8*)(Vt + (16 * db + fr) * 40 + 8 * fq);
                O[db] = __builtin_amdgcn_mfma_f32_16x16x32_bf16(a, pb, O[db] * alpha, 0, 0, 0); }
#pragma unroll
            for (int i = 0; i < 4; ++i) { kc[i] = kn[i]; vc[i] = vn[i]; }
            kst = kstn; str = strn;
        }
#undef ATT_DEC
#undef ATT_LOAD
        lrun += __shfl_xor(lrun, 16); lrun += __shfl_xor(lrun, 32);
        const float inv = 1.0f / lrun;
        bf16* op = CAT + ((size_t)b * SEQ + tq) * DM + GW + h * 64 + 4 * fq;
#pragma unroll
        for (int db = 0; db < 4; ++db) { v2u w; w.x = pk2(O[db][0] * inv, O[db][1] * inv); w.y = pk2(O[db][2] * inv, O[db][3] * inv); *(v2u*)(op + 16 * db) = w; }
    }
}

__device__ __forceinline__ void attn_simple(const Args& A, int tid, int lane, int wave) {
    const bf16* PROJ = (const bf16*)(A.ws + WS_PROJ); bf16* CAT = (bf16*)(A.ws + WS_CAT);
    unsigned* ctr = (unsigned*)(A.ws + WS_CTL);
    for (;;) {
        unsigned wt_ = 0; if (lane == 0) wt_ = atomicAdd(ctr, 1u); const int wt = __builtin_amdgcn_readfirstlane(wt_);
        if (wt >= (M / 64) * AH) break;
        const int h = wt % AH, tb = wt / AH, row = tb * 64 + lane, b = row / SEQ, t = row % SEQ;
        float q[64], acc[64];
        { const v4u* qp = (const v4u*)(PROJ + (size_t)row * NP + PC_QB + h * 64);
#pragma unroll
          for (int j = 0; j < 8; ++j) { const v4u w = qp[j]; q[8 * j + 0] = bflo(w.x) * 0.125f; q[8 * j + 1] = bfhi(w.x) * 0.125f; q[8 * j + 2] = bflo(w.y) * 0.125f; q[8 * j + 3] = bfhi(w.y) * 0.125f;
              q[8 * j + 4] = bflo(w.z) * 0.125f; q[8 * j + 5] = bfhi(w.z) * 0.125f; q[8 * j + 6] = bflo(w.w) * 0.125f; q[8 * j + 7] = bfhi(w.w) * 0.125f; } }
#pragma unroll
        for (int j = 0; j < 64; ++j) acc[j] = 0.f;
        float mx = -1e30f, l = 0.f;
        for (int br = 0; br < 3; ++br) {
            const int stride = br == 0 ? 1 : (br == 1 ? 4 : 16);
            for (int i = 0; i <= 128; ++i) {
                const int tk = t - i * stride; if (tk < 0) break;
                const size_t krow = (size_t)(b * SEQ + tk) * NP;
                const v4u* kp = (const v4u*)(PROJ + krow + PC_KB + h * 64); const v4u* vp = (const v4u*)(PROJ + krow + PC_VB + h * 64);
                float s = 0.f;
#pragma unroll
                for (int j = 0; j < 8; ++j) { const v4u w = kp[j]; s += q[8 * j + 0] * bflo(w.x) + q[8 * j + 1] * bfhi(w.x) + q[8 * j + 2] * bflo(w.y) + q[8 * j + 3] * bfhi(w.y)
                                                                       + q[8 * j + 4] * bflo(w.z) + q[8 * j + 5] * bfhi(w.z) + q[8 * j + 6] * bflo(w.w) + q[8 * j + 7] * bfhi(w.w); }
                const float mn = fmaxf(mx, s), sc = __expf(mx - mn), p = __expf(s - mn); mx = mn; l = l * sc + p;
#pragma unroll
                for (int j = 0; j < 8; ++j) { const v4u w = vp[j];
                    acc[8 * j + 0] = acc[8 * j + 0] * sc + p * bflo(w.x); acc[8 * j + 1] = acc[8 * j + 1] * sc + p * bfhi(w.x); acc[8 * j + 2] = acc[8 * j + 2] * sc + p * bflo(w.y); acc[8 * j + 3] = acc[8 * j + 3] * sc + p * bfhi(w.y);
                    acc[8 * j + 4] = acc[8 * j + 4] * sc + p * bflo(w.z); acc[8 * j + 5] = acc[8 * j + 5] * sc + p * bfhi(w.z); acc[8 * j + 6] = acc[8 * j + 6] * sc + p * bflo(w.w); acc[8 * j + 7] = acc[8 * j + 7] * sc + p * bfhi(w.w); }
            }
        }
        const float inv = 1.0f / l; v4u* op = (v4u*)(CAT + (size_t)row * DM + GW + h * 64);
#pragma unroll
        for (int j = 0; j < 8; ++j) { v4u w; w.x = pk2(acc[8 * j] * inv, acc[8 * j + 1] * inv); w.y = pk2(acc[8 * j + 2] * inv, acc[8 * j + 3] * inv); w.z = pk2(acc[8 * j + 4] * inv, acc[8 * j + 5] * inv); w.w = pk2(acc[8 * j + 6] * inv, acc[8 * j + 7] * inv); op[j] = w; }
    }
}
__device__ __forceinline__ void gated_norm(const Args& A, int lane, int wave) {
    const bf16* PROJ = (const bf16*)(A.ws + WS_PROJ); bf16* CAT = (bf16*)(A.ws + WS_CAT); const float* OA = (const float*)(A.ws + WS_OA); const float* gw = A.in[6];
    const float w0 = gw[2 * lane], w1 = gw[2 * lane + 1];
    for (int wt = blockIdx.x * NWAVES + wave; wt < M * GH; wt += gridDim.x * NWAVES) {
        const int row = wt / GH, h = wt % GH;
        const float2 o = *(const float2*)(OA + (size_t)row * GW + h * 128 + 2 * lane);
        const unsigned zz = *(const unsigned*)(PROJ + (size_t)row * NP + PC_Z + h * 128 + 2 * lane);
        const float ms = wave_sum(o.x * o.x + o.y * o.y) * (1.0f / 128.0f), r = rsqrtf(ms + RMS_EPS);
        *(unsigned*)(CAT + (size_t)row * DM + h * 128 + 2 * lane) = pk2(o.x * r * w0 * silu_f(bflo(zz)), o.y * r * w1 * silu_f(bfhi(zz)));
    }
}
__device__ __forceinline__ void ffn_conv_half(const Args& A, int half, int tid) {
    const bf16* Y = (const bf16*)(A.ws + WS_Y); bf16* ACT = (bf16*)(A.ws + WS_ACT); const float* fw = A.in[10];
    constexpr int HC = DFF / 2;
    for (size_t it = (size_t)blockIdx.x * NTHR + tid; it < (size_t)M * (HC / 8); it += (size_t)gridDim.x * NTHR) {
        const int row = (int)(it / (HC / 8)), g8 = (int)(it % (HC / 8)), cl = g8 * 8, pn = cl >> 7, j = cl & 127, t = row % SEQ, ch = half * HC + cl;
        float ga[8], ua[8];
#pragma unroll
        for (int e = 0; e < 8; ++e) { ga[e] = 0.f; ua[e] = 0.f; }
#pragma unroll
        for (int i = 0; i < 3; ++i) { const int ts = t - 2 + i; if (ts < 0) continue;
            const bf16* yr = Y + (size_t)(row - 2 + i) * DFF + 256 * pn + j; const v4u g = *(const v4u*)yr, u = *(const v4u*)(yr + 128);
            const f32x4 wg0 = *(const f32x4*)(fw + i * NUP + ch), wg1 = *(const f32x4*)(fw + i * NUP + ch + 4), wu0 = *(const f32x4*)(fw + i * NUP + DFF + ch), wu1 = *(const f32x4*)(fw + i * NUP + DFF + ch + 4);
            ga[0] += wg0.x * bflo(g.x); ga[1] += wg0.y * bfhi(g.x); ga[2] += wg0.z * bflo(g.y); ga[3] += wg0.w * bfhi(g.y); ga[4] += wg1.x * bflo(g.z); ga[5] += wg1.y * bfhi(g.z); ga[6] += wg1.z * bflo(g.w); ga[7] += wg1.w * bfhi(g.w);
            ua[0] += wu0.x * bflo(u.x); ua[1] += wu0.y * bfhi(u.x); ua[2] += wu0.z * bflo(u.y); ua[3] += wu0.w * bfhi(u.y); ua[4] += wu1.x * bflo(u.z); ua[5] += wu1.y * bfhi(u.z); ua[6] += wu1.z * bflo(u.w); ua[7] += wu1.w * bfhi(u.w); }
        v4u o; o.x = pk2(silu_f(ga[0]) * ua[0], silu_f(ga[1]) * ua[1]); o.y = pk2(silu_f(ga[2]) * ua[2], silu_f(ga[3]) * ua[3]); o.z = pk2(silu_f(ga[4]) * ua[4], silu_f(ga[5]) * ua[5]); o.w = pk2(silu_f(ga[6]) * ua[6], silu_f(ga[7]) * ua[7]);
        *(v4u*)(ACT + (size_t)row * DFF + ch) = o;
    }
}

__device__ __forceinline__ void ffn_fixup(const Args& A, int tid) {
    const float* YH = (const float*)(A.ws + WS_YH); const float* UP = (const float*)(A.ws + WS_UPART); bf16* ACT = (bf16*)(A.ws + WS_ACT); const float* fw = A.in[10];
    for (int it = blockIdx.x * NTHR + tid; it < 64 * 22 * 2 * 128; it += gridDim.x * NTHR) {
        const int c = it & 127, r = (it >> 7) & 1, tile = it >> 8, pm = tile / 22, pn = tile % 22; if ((pm & 7) == 0) continue;
        const int ch = pn * 128 + c; const float* up = UP + ((size_t)tile * 2 + r) * 256; const float* yh = YH + (size_t)((pm - 1) * 22 + pn) * 2 * 256;
        float g = up[c], u = up[128 + c];
        const float wg0 = fw[ch], wg1 = fw[5632 + ch], wu0 = fw[2816 + ch], wu1 = fw[5632 + 2816 + ch];
        if (r == 0) { g += wg0 * yh[c] + wg1 * yh[256 + c]; u += wu0 * yh[128 + c] + wu1 * yh[256 + 128 + c]; }
        else { g += wg0 * yh[256 + c]; u += wu0 * yh[256 + 128 + c]; }
        ACT[(size_t)(pm * 256 + r) * DFF + ch] = (bf16)(pk2(silu_f(g) * u, 0.f) & 0xffffu);
    }
}
__device__ __forceinline__ void final_norm(const Args& A, int lane, int wave) {
    float* out = A.out; const float* fnw = A.in[12];
    for (int m = blockIdx.x * NWAVES + wave; m < M; m += gridDim.x * NWAVES) {
        f32x4* xr = (f32x4*)(out + (size_t)m * DM) + lane; const f32x4* nr = (const f32x4*)fnw + lane;
        f32x4 v[4]; float s = 0.f;
#pragma unroll
        for (int j = 0; j < 4; ++j) { v[j] = xr[64 * j]; s += (v[j].x * v[j].x + v[j].y * v[j].y) + (v[j].z * v[j].z + v[j].w * v[j].w); }
        const float rstd = rsqrtf(wave_sum(s) * (1.f / DM) + RMS_EPS);
#pragma unroll
        for (int j = 0; j < 4; ++j) { const f32x4 n = nr[64 * j]; xr[64 * j] = (f32x4){v[j].x * rstd * n.x, v[j].y * rstd * n.y, v[j].z * rstd * n.z, v[j].w * rstd * n.w}; }
    }
}

#define XB_TMO      128
#define XB_XCNT(j)  (256  + 64 * (j))
#define XB_XSUB(j)  (1280 + 64 * (j))
#define XB_XGEN(j)  (2304 + 64 * (j))
#define XB_TOP      3328
#define XB_TOPGEN   3392
#define XCD_BAR_WORDS 3456
#define XB_SPIN_CAP (1u << 18)

__device__ __forceinline__ unsigned xb_ld(unsigned* p)              { return __hip_atomic_load(p, __ATOMIC_RELAXED, __HIP_MEMORY_SCOPE_AGENT); }
__device__ __forceinline__ unsigned xb_add(unsigned* p, unsigned v) { return __hip_atomic_fetch_add(p, v, __ATOMIC_RELAXED, __HIP_MEMORY_SCOPE_AGENT); }
__device__ __forceinline__ unsigned xb_xcc_id() { return (unsigned)__builtin_amdgcn_s_getreg((3 << 11) | 20) & 0xFu; }
#define XB_SPIN(cond, bar) do { unsigned _sp = 0; while (cond) { __builtin_amdgcn_s_sleep(1); \
    if ((++_sp & 255u) == 0u) { if (xb_ld(&(bar)[XB_TMO])) break; if (_sp > XB_SPIN_CAP) { atomicAdd(&(bar)[XB_TMO], 1u); break; } } } } while (0)

struct XcdBarrier {
    unsigned* bar; unsigned x;
    volatile LAS unsigned* st;
};

__device__ __forceinline__ XcdBarrier xcd_barrier_post(unsigned* bar, volatile LAS unsigned* st) {
    XcdBarrier b; b.bar = bar; b.x = xb_xcc_id(); b.st = st;
    if (threadIdx.x == 0) (void)xb_add(&bar[XB_XCNT(b.x)], 1u);
    return b;
}
__device__ __forceinline__ void xcd_barrier_complete(unsigned* bar, unsigned x, unsigned& nloc, unsigned& nx) {
    const unsigned G = gridDim.x * gridDim.y * gridDim.z;
    unsigned sum, cnt, mine, sp = 0u;
    for (;;) {
        sum = 0u; cnt = 0u; mine = 0u;
#pragma unroll
        for (unsigned j = 0; j < 16; ++j) { const unsigned c = xb_ld(&bar[XB_XCNT(j)]); sum += c; cnt += (c > 0u) ? 1u : 0u; mine = (j == x) ? c : mine; }
        if (sum == G) break;
        __builtin_amdgcn_s_sleep(1);
        if ((++sp & 255u) == 0u) { if (xb_ld(&bar[XB_TMO])) break; if (sp > XB_SPIN_CAP) { atomicAdd(&bar[XB_TMO], 1u); break; } }
    }
    nloc = mine > 0u ? mine : 1u; nx = cnt > 0u ? cnt : 1u;
}

__device__ __forceinline__ void xcd_barrier(const XcdBarrier& b) {
    asm volatile("s_waitcnt vmcnt(0)" ::: "memory");
    __syncthreads();
    if (threadIdx.x == 0) {
        unsigned* bar = b.bar;
        __builtin_amdgcn_s_waitcnt(0);
        unsigned nloc = b.st[0], nx = b.st[1];
        if (nloc == 0u) { xcd_barrier_complete(bar, b.x, nloc, nx); b.st[0] = nloc; b.st[1] = nx; }
        const unsigned old = xb_add(&bar[XB_XSUB(b.x)], 1u);
        const unsigned gen = old / nloc;
        if (old + 1u == (gen + 1u) * nloc) {
            __builtin_amdgcn_fence(__ATOMIC_RELEASE, "agent");
            asm volatile("s_waitcnt vmcnt(0)" ::: "memory");
            const unsigned og = xb_add(&bar[XB_TOP], 1u);
            const unsigned tg = og / nx;
            if (og + 1u == (tg + 1u) * nx) xb_add(&bar[XB_TOPGEN], 1u);
            else XB_SPIN(xb_ld(&bar[XB_TOPGEN]) == tg, bar);
            __builtin_amdgcn_fence(__ATOMIC_ACQUIRE, "agent");
            xb_add(&bar[XB_XGEN(b.x)], 1u);
            asm volatile("s_waitcnt vmcnt(0)" ::: "memory");
        } else {
            XB_SPIN(xb_ld(&bar[XB_XGEN(b.x)]) == gen, bar);
            __builtin_amdgcn_fence(__ATOMIC_ACQUIRE, "agent");
            asm volatile("s_waitcnt vmcnt(0)" ::: "memory");
        }
    }
    __syncthreads();
}

constexpr int N_PHASES = 10;
__global__ void __launch_bounds__(NTHR, 2) mk_fwd(Args args) {
    extern __shared__ __attribute__((aligned(16))) unsigned char lds_raw[];
    LAS unsigned char* lds = (LAS unsigned char*)lds_raw;
    const int tid = threadIdx.x, lane = tid & 63, wave = __builtin_amdgcn_readfirstlane(tid >> 6);
    const int lo = args.ph_lo, hi = args.ph_hi;
    unsigned char* ws = args.ws;
    bf16* WIN = (bf16*)(ws + WS_WIN); bf16* WOUT = (bf16*)(ws + WS_WOUT); bf16* WUP = (bf16*)(ws + WS_WUP); bf16* WDN = (bf16*)(ws + WS_WDN);
    bf16* XN = (bf16*)(ws + WS_XN); bf16* PROJ = (bf16*)(ws + WS_PROJ); bf16* CAT = (bf16*)(ws + WS_CAT); bf16* Y = (bf16*)(ws + WS_Y); bf16* ACT = (bf16*)(ws + WS_ACT);
    float* SSQ = (float*)(ws + WS_SSQ);
#define IN(k) (lo <= (k) && (k) < hi)
#define SEAM(k) do { if (IN(k) && IN((k) + 1)) { if ((k) == 0) cg::this_grid().sync(); else xcd_barrier(bar); } } while (0)
    { volatile LAS unsigned* st = (volatile LAS unsigned*)(lds + LDS_BYTES - 64); if (tid < 2) st[tid] = 0u; }
    __syncthreads();
    XcdBarrier bar = xcd_barrier_post((unsigned*)(ws + WS_CTL) + 4096, (volatile LAS unsigned*)(lds + LDS_BYTES - 64));
    if (IN(0)) { p0_prologue(args, lds, tid, lane, wave); } SEAM(0);
    if (IN(1)) { pg8::Gemm g{XN, WIN, M, NP, DM}; pg8::StaticOrder S; S.init(M, NP, gridDim.x, blockIdx.x); pg8::EpiBf16S E{PROJ, NP, nullptr};
        pg8::gemm_phase<pg8::EpiBf16S, pg8::StaticOrder, PG8_ALIGN, PG8_SP2>(lds, g, S, E); } SEAM(1);
    if (IN(2)) { gdn_prep(args, lds, tid, lane, wave); } SEAM(2);
    if (IN(3)) { if (blockIdx.x < NB * GH) gdn_scan(args, lds, blockIdx.x, tid, lane, wave); attn_fast(args, lds, lane, wave); } SEAM(3);
    if (IN(4)) { gated_norm(args, lane, wave); } SEAM(4);
    if (IN(5)) { pg8::Gemm g{CAT, WOUT, M, DM, DM}; pg8::StaticOrder S; S.init(M, DM, gridDim.x, blockIdx.x); pg8::EpiResid E{args.in[0], args.out, XN, SSQ, DM};
        pg8::gemm_phase<pg8::EpiResid, pg8::StaticOrder, PG8_ALIGN, PG8_SP2>(lds, g, S, E); } SEAM(5);
    if (IN(6)) { pg8::Gemm g{XN, WUP, M, NUP, DM}; pg8::StaticOrder S; S.init(M, NUP, gridDim.x, blockIdx.x);
        static_assert(pg8::EpiConvGate::CG_SSQ == WS_SSQ && pg8::EpiConvGate::CG_ACT == WS_ACT && pg8::EpiConvGate::CG_YH == WS_YH && pg8::EpiConvGate::CG_UPART == WS_UPART, "d_ws map");
        pg8::EpiConvGate E{ws, args.in[10], lds};
        pg8::gemm_phase<pg8::EpiConvGate, pg8::StaticOrder, true, PG8_SP2>(lds, g, S, E); } SEAM(6);
    if (IN(7)) { ffn_fixup(args, tid); } SEAM(7);
    if (IN(8)) { pg8::Gemm g{ACT, WDN, M, DM, DFF}; pg8::StaticOrder S; S.init(M, DM, gridDim.x, blockIdx.x); pg8::EpiResid E{args.out, args.out, nullptr, nullptr, DM};
        pg8::gemm_phase<pg8::EpiResid, pg8::StaticOrder, PG8_ALIGN, PG8_SP2>(lds, g, S, E); } SEAM(8);
    if (IN(9)) { final_norm(args, lane, wave); }
#undef IN
#undef SEAM
}

#ifndef MK_ONE_LAUNCH
#define MK_ONE_LAUNCH 1
#endif
extern "C" void kernel_launch(void* const* d_in, const int* in_sizes, int n_in, void* d_out, int out_size, void* d_ws, size_t ws_size, hipStream_t stream) {
    static int grid = 0;
    if (grid == 0) {
        if (n_in != 13 || out_size != M * DM || ws_size < WS_END) { fprintf(stderr, "kernel_launch: unexpected shapes n_in %d out %d ws %zu\n", n_in, out_size, ws_size); grid = -1; return; }
        int dev = 0, cus = 0, per_cu = 0;
        hipGetDevice(&dev); hipDeviceGetAttribute(&cus, hipDeviceAttributeMultiprocessorCount, dev);
        hipFuncSetAttribute((const void*)mk_fwd, hipFuncAttributeMaxDynamicSharedMemorySize, LDS_BYTES);
        hipOccupancyMaxActiveBlocksPerMultiprocessor(&per_cu, (const void*)mk_fwd, NTHR, LDS_BYTES);
        (void)hipGetLastError();
        if (per_cu < 1) { fprintf(stderr, "kernel_launch: occupancy query says %d blocks per CU\n", per_cu); per_cu = 1; }
        grid = cus;
    }
    if (grid < 0) return;
    if (hipMemsetAsync((char*)d_ws + WS_CTL, 0, 65536, stream) != hipSuccess) { fprintf(stderr, "kernel_launch: memset failed\n"); return; }
    Args a{};
    for (int i = 0; i < 13; ++i) a.in[i] = (const float*)d_in[i];
    a.out = (float*)d_out; a.ws = (unsigned char*)d_ws;
#if MK_ONE_LAUNCH
    a.ph_lo = 0; a.ph_hi = N_PHASES; a.coop = 1;
    void* kargs[] = {&a};
    hipError_t e = hipLaunchCooperativeKernel((const void*)mk_fwd, dim3(grid), dim3(NTHR), kargs, LDS_BYTES, stream);
    if (e != hipSuccess) fprintf(stderr, "cooperative launch failed: %s (grid %d)\n", hipGetErrorString(e), grid);
#else
    for (int p = 0; p < N_PHASES; ++p) { a.ph_lo = p; a.ph_hi = p + 1; a.coop = 0; hipLaunchKernelGGL(mk_fwd, dim3(grid), dim3(NTHR), LDS_BYTES, stream, a); }
#endif
}
```

```cpp
#include <hip/hip_runtime.h>
#include <hip/hip_cooperative_groups.h>
#include <cstdio>
#include <cstdint>
namespace cg = cooperative_groups;
namespace pg8 {
#define PG8_LAS __attribute__((address_space(3)))
typedef unsigned short bf16_t;
typedef short bf16x8 __attribute__((ext_vector_type(8)));
typedef float f32x4 __attribute__((ext_vector_type(4)));
typedef unsigned u32x4 __attribute__((ext_vector_type(4)));
constexpr int BM = 256, BK = 64, HALF = 128, HTB = HALF * BK * 2  , STAGE_BYTES = 8 * HTB, NXCD = 8, WGM = 8;

__host__ __device__ __forceinline__ int lds_byte(int r, int c) { const int st = (r >> 4) * 2 + (c >> 5), rr = r & 15, cc = c & 31, ob = rr * 64 + cc * 2; return st * 1024 + (ob ^ (((ob >> 9) & 1) << 5)); }
__host__ __device__ __forceinline__ void stage_rc(int b, int& R, int& C) { const int st = b / 1024, sb = b % 1024, swz = sb ^ (((sb >> 9) & 1) << 5); R = (st >> 1) * 16 + swz / 64; C = (st & 1) * 32 + (swz % 64) / 2; }
__host__ __device__ __forceinline__ int perm32(int rho) { const int n = rho >> 4, i = rho & 15; return 8 * (i >> 2) + 4 * n + (i & 3); }

struct Unit { int pm, pn; };
struct Gemm { const bf16_t* A; const bf16_t* Bt; int M, N, K; };

struct StaticOrder {
    int nM, nN, nwg, G, c;
    __host__ __device__ void init(int M, int N, int G_, int c_) { nM = M / BM; nN = N / BM; nwg = nM * nN; G = G_; c = c_; }
    __host__ __device__ bool next(int i, Unit& u) const {
        const long L = (long)i * G + c; if (L >= nwg) return false;
        int wgid = (int)L; { const int q = nwg / NXCD, r = nwg % NXCD, xcd = wgid % NXCD, off = wgid / NXCD; wgid = (xcd < r ? xcd * (q + 1) : r * (q + 1) + (xcd - r) * q) + off; }
        const int nig = WGM * nN, gid = wgid / nig, fm = gid * WGM, gsz = (nM - fm) < WGM ? (nM - fm) : WGM;
        u.pm = fm + ((wgid % nig) % gsz); u.pn = (wgid % nig) / gsz; return true;
    }
    __device__ __forceinline__ void a_ready(const Unit&) const {}
    __device__ __forceinline__ void done(const Unit&) const {}
};

__device__ __forceinline__ unsigned cvt_pk_bf16(float lo, float hi) { unsigned r; asm volatile("v_cvt_pk_bf16_f32 %0, %1, %2" : "=v"(r) : "v"(lo), "v"(hi)); return r; }
constexpr float RMS_EPS = 1e-6f;
struct EpiBf16S {
    static constexpr bool PERM = true, AFTER_DRAIN = false;
    bf16_t* O; int ldc; const float* ssq;
    __device__ __forceinline__ void operator()(const f32x4 (&acc)[2][2][4][2], const Unit& u, int wr, int wc, int fr, int fq) const {
        const int row0 = u.pm * BM + wr * 64 + fr; const int col0 = u.pn * BM + wc * 32 + 8 * fq;
#pragma unroll
        for (int ai = 0; ai < 2; ++ai)
#pragma unroll
            for (int m = 0; m < 4; ++m) { const int row = row0 + ai * HALF + m * 16; bf16_t* rowp = O + (size_t)row * ldc + col0;
                const float sc = ssq ? rsqrtf(ssq[row] * (1.0f / 1024.0f) + RMS_EPS) : 1.0f;
#pragma unroll
                for (int bj = 0; bj < 2; ++bj) { const f32x4 v0 = acc[ai][bj][m][0] * sc, v1 = acc[ai][bj][m][1] * sc;
                    u32x4 w; w.x = cvt_pk_bf16(v0[0], v0[1]); w.y = cvt_pk_bf16(v0[2], v0[3]); w.z = cvt_pk_bf16(v1[0], v1[1]); w.w = cvt_pk_bf16(v1[2], v1[3]);
                    *(u32x4*)(rowp + bj * HALF) = w; } }
    }
};
struct EpiResid {
    static constexpr bool PERM = false, AFTER_DRAIN = false;
    const float* base; float* out; bf16_t* xb; float* ssq; int ldc;
    __device__ __forceinline__ void operator()(const f32x4 (&acc)[2][2][4][2], const Unit& u, int wr, int wc, int fr, int fq) const {
        typedef unsigned u32x2v __attribute__((ext_vector_type(2)));
        const int col0 = u.pn * BM + wc * 32 + 4 * fq;
#pragma unroll
        for (int ai = 0; ai < 2; ++ai)
#pragma unroll
            for (int m = 0; m < 4; ++m) { const int row = u.pm * BM + ai * HALF + wr * 64 + m * 16 + fr; const size_t off = (size_t)row * ldc + col0; float s = 0.f;
#pragma unroll
                for (int bj = 0; bj < 2; ++bj)
#pragma unroll
                    for (int n = 0; n < 2; ++n) { const f32x4 v = acc[ai][bj][m][n] + *(const f32x4*)(base + off + bj * HALF + n * 16);
                        *(f32x4*)(out + off + bj * HALF + n * 16) = v; s += (v[0] * v[0] + v[1] * v[1]) + (v[2] * v[2] + v[3] * v[3]);
                        if (xb) { u32x2v w; w.x = cvt_pk_bf16(v[0], v[1]); w.y = cvt_pk_bf16(v[2], v[3]); *(u32x2v*)(xb + off + bj * HALF + n * 16) = w; } }
                if (ssq) { s += __shfl_xor(s, 16); s += __shfl_xor(s, 32); if (fq == 0) atomicAdd(ssq + row, s); }
                asm volatile("" ::: "memory"); }
    }
};

__device__ __forceinline__ float dpp_ror1(float v) { return __builtin_bit_cast(float, __builtin_amdgcn_update_dpp(0, __builtin_bit_cast(int, v), 0x121, 0xf, 0xf, false)); }
__device__ __forceinline__ float dpp_ror2(float v) { return __builtin_bit_cast(float, __builtin_amdgcn_update_dpp(0, __builtin_bit_cast(int, v), 0x122, 0xf, 0xf, false)); }
struct EpiConvGate {
    static constexpr bool PERM = true, AFTER_DRAIN = false;
    static constexpr size_t CG_SSQ = (1u << 20) + 768 * 1024, CG_ACT = (size_t)148 << 20, CG_YH = (size_t)236 << 20, CG_UPART = (size_t)240 << 20;
    unsigned char* ws; const float* fw; PG8_LAS unsigned char* ldsb;
    __device__ __forceinline__ void operator()(f32x4 (&acc)[2][2][4][2], const Unit& u, int wr, int wc, int fr0, int fq0) const {
        int fr = fr0, fq = fq0; asm volatile("" : "+v"(fr), "+v"(fq));
        bf16_t* ACT = (bf16_t*)(ws + CG_ACT); const float* ssq = (const float*)(ws + CG_SSQ); float* YH = (float*)(ws + CG_YH); float* UPART = (float*)(ws + CG_UPART);
        PG8_LAS float* halo = (PG8_LAS float*)(ldsb + STAGE_BYTES);
        int cl = wc * 32 + 8 * fq;
        int ch = u.pn * 128 + cl;
        if (fr >= 14) {
#pragma unroll
            for (int ai = 0; ai < 2; ++ai) { const float sc = rsqrtf(ssq[u.pm * BM + ai * HALF + wr * 64 + 48 + fr] * (1.0f / 1024.0f) + RMS_EPS);
#pragma unroll
                for (int bj = 0; bj < 2; ++bj)
#pragma unroll
                    for (int n = 0; n < 2; ++n) { const f32x4 v = acc[ai][bj][3][n] * sc; *(PG8_LAS f32x4*)(halo + (((wr * 2 + ai) * 2 + (fr - 14)) * 256 + bj * 128 + cl + 4 * n)) = v;
                        if (ai == 1 && wr == 1) *(f32x4*)(YH + ((size_t)(u.pm * 22 + u.pn) * 2 + (fr - 14)) * 256 + bj * 128 + cl + 4 * n) = v; } }
        }
        asm volatile("s_waitcnt lgkmcnt(0)" ::: "memory"); __builtin_amdgcn_s_barrier(); asm volatile("" ::: "memory");
        typedef unsigned u32x2v __attribute__((ext_vector_type(2)));
#pragma unroll 1
        for (int n = 0; n < 2; ++n) {
            asm volatile("" : "+v"(fr), "+v"(fq));
            cl = wc * 32 + 8 * fq; ch = u.pn * 128 + cl;
            f32x4 w[3][2];
#pragma unroll
            for (int i = 0; i < 3; ++i)
#pragma unroll
                for (int bj = 0; bj < 2; ++bj) w[i][bj] = *(const f32x4*)(fw + (size_t)i * 5632 + bj * 2816 + ch + 4 * n);
#pragma unroll
            for (int ai = 0; ai < 2; ++ai) {
                const bool top = (ai == 0 && wr == 0);
                const int pblk = (ai == 0) ? 0 : (wr == 0 ? 2 : 1);
                f32x4 pv[2];
#pragma unroll
                for (int bj = 0; bj < 2; ++bj) pv[bj] = top ? (f32x4){0.f, 0.f, 0.f, 0.f} : *(const PG8_LAS f32x4*)(halo + ((pblk * 2 + (fr & 1)) * 256 + bj * 128 + cl + 4 * n));
#pragma unroll
                for (int m = 0; m < 4; ++m) {
                    const int row = u.pm * BM + ai * HALF + wr * 64 + m * 16 + fr; const float sc = rsqrtf(ssq[row] * (1.0f / 1024.0f) + RMS_EPS);
                    f32x4 cu[2];
#pragma unroll
                    for (int bj = 0; bj < 2; ++bj) { const f32x4 ya = (n == 0) ? acc[ai][bj][m][0] : acc[ai][bj][m][1]; const f32x4 yv = (f32x4){ya[0] * sc, ya[1] * sc, ya[2] * sc, ya[3] * sc};
#pragma unroll
                        for (int k = 0; k < 4; ++k) { const float y = yv[k], pp = pv[bj][k];
                            const float a1 = dpp_ror1(y), a2 = dpp_ror2(y), b1 = dpp_ror1(pp), b2 = dpp_ror2(pp);
                            const float p1 = (fr == 0) ? b1 : a1, p2 = (fr < 2) ? b2 : a2;
                            cu[bj][k] = w[2][bj][k] * y + w[1][bj][k] * p1 + w[0][bj][k] * p2; }
                        pv[bj] = yv; }
                    if (top && m == 0 && fr < 2 && (u.pm & 7) != 0) {
#pragma unroll
                        for (int bj = 0; bj < 2; ++bj) *(f32x4*)(UPART + ((size_t)(u.pm * 22 + u.pn) * 2 + fr) * 256 + bj * 128 + cl + 4 * n) = cu[bj];
                    }
                    u32x2v o;
#define PG8_SG(k_) (cu[0][k_] / (1.0f + __expf(-cu[0][k_])) * cu[1][k_])
                    o.x = cvt_pk_bf16(PG8_SG(0), PG8_SG(1)); o.y = cvt_pk_bf16(PG8_SG(2), PG8_SG(3));
#undef PG8_SG
                    *(u32x2v*)(ACT + (size_t)row * 2816 + ch + 4 * n) = o;
                    asm volatile("" ::: "memory");
                }
            }
        }
        asm volatile("s_waitcnt lgkmcnt(0)" ::: "memory"); __builtin_amdgcn_s_barrier(); asm volatile("" ::: "memory");
    }
};
template <class Epi, class Sched, bool ALIGN_EPI = false, bool SP2 = false>
__device__ __forceinline__ void gemm_phase(PG8_LAS unsigned char* lds, const Gemm g, const Sched& S, const Epi& E) {
    const int tid = threadIdx.x, wid = __builtin_amdgcn_readfirstlane(tid >> 6), lane = tid & 63, wr = wid >> 2, wc = wid & 3, fr = lane & 15, fq = lane >> 4;
    const int K = g.K, nt = K / BK;
    unsigned voffA[2], voffB[2];
#pragma unroll
    for (int i = 0; i < 2; ++i) { int R, C; stage_rc(tid * 16 + i * 8192, R, C); const int Rb = Epi::PERM ? ((R & ~31) + perm32(R & 31)) : R;
        voffA[i] = (unsigned)(R * K + C) * 2u; voffB[i] = (unsigned)(Rb * K + C) * 2u; }
    const size_t kstep = (size_t)(BK * 2);
    const size_t hstep = (size_t)HALF * K * 2;
    const size_t tstep = 2 * hstep;
    const unsigned ldsw = (unsigned)wid * 1024u;
    const int aoff = lds_byte(wr * 64 + fr, fq * 8), boff = lds_byte(wc * 32 + fr, fq * 8);
#define PG8_SA(b, h) (((b) * 2 + (h)) * HTB)
#define PG8_SB(b, h) ((4 + (b) * 2 + (h)) * HTB)
#define PG8_STAGE(bufoff, gbase, voff) do { _Pragma("unroll") for (int _i = 0; _i < 2; ++_i) \
        __builtin_amdgcn_global_load_lds((const unsigned*)((const char*)(gbase) + (voff)[_i]), (PG8_LAS unsigned*)(lds + (bufoff) + ldsw + _i * 8192), 16, 0, 0); } while (0)
#define PG8_LDA(dst, b, h) do { _Pragma("unroll") for (int m = 0; m < 4; ++m) _Pragma("unroll") for (int k = 0; k < 2; ++k) dst[m][k] = *(const PG8_LAS bf16x8*)(lds + PG8_SA(b, h) + aoff + m * 2048 + k * 1024); } while (0)
#define PG8_LDB(dst, b, h) do { _Pragma("unroll") for (int n = 0; n < 2; ++n) _Pragma("unroll") for (int k = 0; k < 2; ++k) dst[n][k] = *(const PG8_LAS bf16x8*)(lds + PG8_SB(b, h) + boff + n * 2048 + k * 1024); } while (0)
#define PG8_MMA(ai, bj, At, Bt) do { __builtin_amdgcn_s_setprio(1); _Pragma("unroll") for (int m = 0; m < 4; ++m) _Pragma("unroll") for (int n = 0; n < 2; ++n) _Pragma("unroll") for (int k = 0; k < 2; ++k) \
        acc[ai][bj][m][n] = __builtin_amdgcn_mfma_f32_16x16x32_bf16(Bt[n][k], At[m][k], acc[ai][bj][m][n], 0, 0, 0); __builtin_amdgcn_s_setprio(0); } while (0)
#define PG8_WAIT_V(n) asm volatile("s_waitcnt vmcnt(" #n ")" ::: "memory")
#define PG8_WAIT_L(n) asm volatile("s_waitcnt lgkmcnt(" #n ")" ::: "memory")
#define PG8_BAR __builtin_amdgcn_s_barrier()
#define PG8_SCHED __builtin_amdgcn_sched_barrier(0)
    Unit cur, nxt; int ui = 0;
    if (!S.next(0, cur)) return;
    f32x4 acc[2][2][4][2];
#pragma unroll
    for (int a = 0; a < 2; ++a)
#pragma unroll
        for (int b = 0; b < 2; ++b)
#pragma unroll
            for (int m = 0; m < 4; ++m)
#pragma unroll
                for (int n = 0; n < 2; ++n) acc[a][b][m][n] = (f32x4){0.f, 0.f, 0.f, 0.f};
    bf16x8 At[4][2], B0[2][2], B1[2][2];
    const char* cA = (const char*)g.A + (size_t)cur.pm * tstep; const char* cB = (const char*)g.Bt + (size_t)cur.pn * tstep;
    S.a_ready(cur);
    if constexpr (SP2) {
        PG8_STAGE(PG8_SB(0, 0), cB, voffB); PG8_STAGE(PG8_SB(0, 1), cB + hstep, voffB); PG8_STAGE(PG8_SA(0, 0), cA, voffA); PG8_STAGE(PG8_SA(0, 1), cA + hstep, voffA);
        if (wr == 1) PG8_BAR;
        PG8_WAIT_V(2); PG8_BAR;
        PG8_STAGE(PG8_SB(1, 0), cB + kstep, voffB); PG8_STAGE(PG8_SA(1, 0), cA + kstep, voffA); PG8_STAGE(PG8_SB(1, 1), cB + hstep + kstep, voffB);
        PG8_WAIT_V(6); PG8_BAR;
    } else {
        PG8_STAGE(PG8_SB(0, 0), cB, voffB); PG8_STAGE(PG8_SA(0, 0), cA, voffA); PG8_STAGE(PG8_SB(0, 1), cB + hstep, voffB); PG8_STAGE(PG8_SA(0, 1), cA + hstep, voffA);
        if (wr == 1) PG8_BAR;
        PG8_WAIT_V(4); PG8_BAR;
        PG8_STAGE(PG8_SB(1, 0), cB + kstep, voffB); PG8_STAGE(PG8_SA(1, 0), cA + kstep, voffA); PG8_STAGE(PG8_SB(1, 1), cB + hstep + kstep, voffB);
        PG8_WAIT_V(6); PG8_BAR;
    }
    for (;;) {
        const bool has_next = S.next(ui + 1, nxt);
        const char* nA = has_next ? (const char*)g.A + (size_t)nxt.pm * tstep : cA; const char* nB = has_next ? (const char*)g.Bt + (size_t)nxt.pn * tstep : cB;
        for (int t = 0; t < nt; t += 2) {
            const bool last = (t == nt - 2);
            const char* a1 = cA + (size_t)(t + 1) * kstep;
            const char* a2 = last ? nA : cA + (size_t)(t + 2) * kstep; const char* b2 = last ? nB : cB + (size_t)(t + 2) * kstep;
            const char* a3 = a2 + kstep; const char* b3 = b2 + kstep;
            if (last && has_next) S.a_ready(nxt);
            if constexpr (SP2) {
            PG8_LDB(B0, 0, 0); PG8_LDB(B1, 0, 1); PG8_SCHED; PG8_LDA(At, 0, 0); PG8_STAGE(PG8_SA(1, 1), a1 + hstep, voffA);
            PG8_WAIT_V(8); PG8_WAIT_L(0); PG8_BAR; PG8_MMA(0, 0, At, B0); PG8_MMA(0, 1, At, B1); PG8_BAR; PG8_SCHED;
            PG8_LDA(At, 0, 1); PG8_STAGE(PG8_SB(0, 0), b2, voffB); PG8_STAGE(PG8_SB(0, 1), b2 + hstep, voffB); PG8_STAGE(PG8_SA(0, 0), a2, voffA);
            PG8_WAIT_V(8); PG8_WAIT_L(0); PG8_BAR; PG8_MMA(1, 0, At, B0); PG8_MMA(1, 1, At, B1); PG8_BAR; PG8_SCHED;
            PG8_LDB(B0, 1, 0); PG8_LDB(B1, 1, 1); PG8_SCHED; PG8_LDA(At, 1, 0); PG8_STAGE(PG8_SA(0, 1), a2 + hstep, voffA);
            PG8_WAIT_V(8); PG8_WAIT_L(0); PG8_BAR; PG8_MMA(0, 0, At, B0); PG8_MMA(0, 1, At, B1); PG8_BAR; PG8_SCHED;
            PG8_LDA(At, 1, 1); PG8_STAGE(PG8_SB(1, 0), b3, voffB); PG8_STAGE(PG8_SB(1, 1), b3 + hstep, voffB); PG8_STAGE(PG8_SA(1, 0), a3, voffA);
            PG8_WAIT_V(8); PG8_WAIT_L(0); PG8_BAR; PG8_MMA(1, 0, At, B0); PG8_MMA(1, 1, At, B1); PG8_BAR; PG8_SCHED;
            } else {
            PG8_LDB(B0, 0, 0); PG8_SCHED; PG8_LDA(At, 0, 0); PG8_STAGE(PG8_SA(1, 1), a1 + hstep, voffA);
            PG8_WAIT_L(8); PG8_BAR; PG8_WAIT_L(0); PG8_MMA(0, 0, At, B0); PG8_BAR; PG8_SCHED;
            PG8_LDB(B1, 0, 1); PG8_STAGE(PG8_SB(0, 0), b2, voffB);
            PG8_BAR; PG8_WAIT_L(0); PG8_MMA(0, 1, At, B1); PG8_BAR;
            PG8_LDA(At, 0, 1); PG8_STAGE(PG8_SA(0, 0), a2, voffA);
            PG8_BAR; PG8_WAIT_L(0); PG8_MMA(1, 0, At, B0); PG8_BAR; PG8_SCHED;
            PG8_STAGE(PG8_SB(0, 1), b2 + hstep, voffB);
            PG8_WAIT_V(6); PG8_BAR; PG8_MMA(1, 1, At, B1); PG8_BAR;
            PG8_LDB(B0, 1, 0); PG8_SCHED; PG8_LDA(At, 1, 0); PG8_STAGE(PG8_SA(0, 1), a2 + hstep, voffA);
            PG8_WAIT_L(8); PG8_BAR; PG8_WAIT_L(0); PG8_MMA(0, 0, At, B0); PG8_BAR; PG8_SCHED;
            PG8_LDB(B1, 1, 1); PG8_STAGE(PG8_SB(1, 0), b3, voffB);
            PG8_BAR; PG8_WAIT_L(0); PG8_MMA(0, 1, At, B1); PG8_BAR;
            PG8_LDA(At, 1, 1); PG8_STAGE(PG8_SA(1, 0), a3, voffA);
            PG8_BAR; PG8_WAIT_L(0); PG8_MMA(1, 0, At, B0); PG8_BAR; PG8_SCHED;
            PG8_STAGE(PG8_SB(1, 1), b3 + hstep, voffB);
            PG8_WAIT_V(6); PG8_BAR; PG8_MMA(1, 1, At, B1); PG8_BAR;
            }
        }
        if constexpr (ALIGN_EPI) { if (wr == 0) PG8_BAR; }
        if constexpr (!Epi::AFTER_DRAIN) { E(acc, cur, wr, wc, fr, fq); S.done(cur); }
        if (!has_next) break;
#pragma unroll
        for (int a = 0; a < 2; ++a)
#pragma unroll
            for (int b = 0; b < 2; ++b)
#pragma unroll
                for (int m = 0; m < 4; ++m)
#pragma unroll
                    for (int n = 0; n < 2; ++n) acc[a][b][m][n] = (f32x4){0.f, 0.f, 0.f, 0.f};
        cur = nxt; cA = nA; cB = nB; ++ui;
        if constexpr (ALIGN_EPI) { if (wr == 1) PG8_BAR; }
    }
    PG8_WAIT_V(0);
    if constexpr (!ALIGN_EPI) { if (wr == 0) PG8_BAR; }
    PG8_BAR;
    if constexpr (Epi::AFTER_DRAIN) { E.fused(acc, cur, wr, wc, fr, fq, lds, wid, lane); S.done(cur); }
#undef PG8_SA
#undef PG8_SB
#undef PG8_STAGE
#undef PG8_LDA
#undef PG8_LDB
#undef PG8_MMA
#undef PG8_WAIT_V
#undef PG8_WAIT_L
#undef PG8_BAR
#undef PG8_SCHED
}
}
#ifndef PG8_SP2
#define PG8_SP2 true
#endif
#ifndef PG8_ALIGN
#define PG8_ALIGN true
#endif
constexpr int NB = 8, SEQ = 2048, DM = 1024, M = NB * SEQ;
constexpr int GH = 4, GD = 128, GW = 512, AH = 8, AD = 64;
constexpr int INC = 3592, NP = 3584;
constexpr int DFF = 2816, NUP = 2 * DFF;
constexpr int PC_QA = 0, PC_KA = 512, PC_VA = 1024, PC_Z = 1536, PC_QB = 2048, PC_KB = 2560, PC_VB = 3072;
constexpr size_t MiB = 1u << 20;
constexpr size_t WS_CTL = 0, WS_AB = 1 * MiB, WS_SSQ = 1 * MiB + 768 * 1024, WS_WIN = 2 * MiB, WS_WOUT = 9 * MiB, WS_WUP = 11 * MiB, WS_WDN = 22 * MiB;
constexpr size_t WS_XN = 28 * MiB, WS_PROJ = 60 * MiB, WS_CAT = 172 * MiB, WS_OA = 204 * MiB, WS_Y = 60 * MiB, WS_ACT = 148 * MiB, WS_END = 256 * MiB;
using pg8::RMS_EPS;
constexpr size_t WS_YH = 236 * MiB, WS_UPART = 240 * MiB;
constexpr size_t WS_GE = WS_SSQ + 65536;
constexpr int GOPS_CHUNK = 57344;
constexpr int SCAN_BUF = GOPS_CHUNK + 16384;
constexpr int NWAVES = 8, NTHR = 512;
constexpr int LDS_BYTES = 155648;
#define LAS __attribute__((address_space(3)))
typedef unsigned short bf16;
typedef unsigned v4u __attribute__((ext_vector_type(4)));
typedef unsigned v2u __attribute__((ext_vector_type(2)));
typedef float f32x4 __attribute__((ext_vector_type(4)));
__device__ __forceinline__ float bf2f(unsigned b) { return __uint_as_float(b << 16); }
__device__ __forceinline__ float bflo(unsigned w) { return __uint_as_float(w << 16); }
__device__ __forceinline__ float bfhi(unsigned w) { return __uint_as_float(w & 0xffff0000u); }
__device__ __forceinline__ unsigned pk2(float lo, float hi) { return pg8::cvt_pk_bf16(lo, hi); }
__device__ __forceinline__ float wave_sum(float v) {
#pragma unroll
    for (int o = 1; o < 64; o <<= 1) v += __shfl_xor(v, o);
    return v;
}
__device__ __forceinline__ float silu_f(float x) { return x / (1.0f + __expf(-x)); }
__device__ __forceinline__ float sigmoid_f(float x) { return 1.0f / (1.0f + __expf(-x)); }
__device__ __forceinline__ float softplus_f(float x) { return x > 20.f ? x : log1pf(__expf(x)); }

struct Args { const float* in[13]; float* out; unsigned char* ws; int ph_lo, ph_hi, coop, pad; };

__device__ __forceinline__ void p0_transpose_item(const float* W, int ldw, int k0, int sn0, bf16* WT, int K, int dn0, const float* kscale, LAS float* scr, int lane) {
#pragma unroll 8
    for (int i = 0; i < 32; ++i) { const int kk = 2 * i + (lane >> 5); float v = W[(size_t)(k0 + kk) * ldw + sn0 + (lane & 31)]; if (kscale) v *= kscale[k0 + kk]; scr[kk * 33 + (lane & 31)] = v; }
    asm volatile("s_waitcnt lgkmcnt(0)" ::: "memory");
    const int c = lane & 7;
#pragma unroll
    for (int j = 0; j < 4; ++j) { const int n = (lane >> 3) + 8 * j; const LAS float* s = scr + (8 * c) * 33 + n;
        v4u o; o.x = pk2(s[0 * 33], s[1 * 33]); o.y = pk2(s[2 * 33], s[3 * 33]); o.z = pk2(s[4 * 33], s[5 * 33]); o.w = pk2(s[6 * 33], s[7 * 33]);
        *(v4u*)(WT + (size_t)(dn0 + n) * K + k0 + 8 * c) = o; }
    asm volatile("s_waitcnt lgkmcnt(0)" ::: "memory");
}

__device__ __forceinline__ void p0_prologue(const Args& A, LAS unsigned char* lds, int tid, int lane, int wave) {
    const float* x = A.in[0]; const float* nw1 = A.in[1]; const float* w_in = A.in[2]; const float* w_out = A.in[7]; const float* nw2 = A.in[8];
    const float* w_up = A.in[9]; const float* w_dn = A.in[11];
    unsigned char* ws = A.ws;
    bf16* WIN = (bf16*)(ws + WS_WIN); bf16* WOUT = (bf16*)(ws + WS_WOUT); bf16* WUP = (bf16*)(ws + WS_WUP); bf16* WDN = (bf16*)(ws + WS_WDN);
    bf16* XN = (bf16*)(ws + WS_XN); float* AB = (float*)(ws + WS_AB); float* SSQ = (float*)(ws + WS_SSQ);
    LAS float* scr = (LAS float*)(lds + wave * 9216);
    LAS float* wab = (LAS float*)(lds + 73728);
    const int G = gridDim.x, gw = blockIdx.x * NWAVES + wave, NGW = G * NWAVES;
    for (int i = blockIdx.x * NTHR + tid; i < M; i += G * NTHR) SSQ[i] = 0.f;
    if (blockIdx.x == 0 && tid < 64) ((unsigned*)(ws + WS_CTL))[tid] = 0u;
    for (int idx = tid; idx < 8192; idx += NTHR) { const int k = idx >> 3, j = idx & 7; wab[j * 1024 + k] = nw1[k] * w_in[(size_t)k * INC + 2048 + j]; }
    constexpr int I_IN = 16 * (NP / 32), I_OUT = 16 * 32, I_UP = 16 * (NUP / 32), I_DN = (DFF / 64) * 32;
    constexpr int NITEMS = I_IN + I_OUT + I_UP + I_DN;
    for (int it = gw; it < NITEMS; it += NGW) {
        int r = it;
        if (r < I_IN) { const int nblk = NP / 32, kb = r / nblk, nb = r % nblk, n0 = 32 * nb; p0_transpose_item(w_in, INC, 64 * kb, n0 + (n0 >= 2048 ? 8 : 0), WIN, DM, n0, nullptr, scr, lane); continue; } r -= I_IN;
        if (r < I_OUT) { const int kb = r / 32, nb = r % 32; p0_transpose_item(w_out, DM, 64 * kb, 32 * nb, WOUT, DM, 32 * nb, nullptr, scr, lane); continue; } r -= I_OUT;
        if (r < I_UP) { const int nblk = NUP / 32, kb = r / nblk, nb = r % nblk, n0 = 32 * nb, pn = n0 >> 8, j0 = n0 & 255;
            const int s0 = (j0 < 128) ? (128 * pn + j0) : (DFF + 128 * pn + j0 - 128);
            p0_transpose_item(w_up, NUP, 64 * kb, s0, WUP, DM, n0, nw2, scr, lane); continue; } r -= I_UP;
        { const int kb = r / 32, nb = r % 32; p0_transpose_item(w_dn, DM, 64 * kb, 32 * nb, WDN, DFF, 32 * nb, nullptr, scr, lane); }
    }
    __syncthreads();
    for (int m = gw; m < M; m += NGW) {
        const f32x4* xr = (const f32x4*)(x + (size_t)m * DM) + lane; const f32x4* nr = (const f32x4*)nw1 + lane;
        f32x4 v[4]; float s = 0.f;
#pragma unroll
        for (int j = 0; j < 4; ++j) { v[j] = xr[64 * j]; s += (v[j].x * v[j].x + v[j].y * v[j].y) + (v[j].z * v[j].z + v[j].w * v[j].w); }
        const float rstd = rsqrtf(wave_sum(s) * (1.f / DM) + RMS_EPS);
        float ab[8];
#pragma unroll
        for (int q = 0; q < 8; ++q) { float a = 0.f;
#pragma unroll
            for (int j = 0; j < 4; ++j) { const f32x4 w = *(const LAS f32x4*)(wab + q * 1024 + 256 * j + 4 * lane); a += (v[j].x * w.x + v[j].y * w.y) + (v[j].z * w.z + v[j].w * w.w); }
            ab[q] = wave_sum(a) * rstd; }
        if (lane == 0) { *(f32x4*)(AB + (size_t)m * 8) = (f32x4){ab[0], ab[1], ab[2], ab[3]}; *(f32x4*)(AB + (size_t)m * 8 + 4) = (f32x4){ab[4], ab[5], ab[6], ab[7]}; }
        v2u* o8 = (v2u*)(XN + (size_t)m * DM) + lane;
#pragma unroll
        for (int j = 0; j < 4; ++j) { const f32x4 n = nr[64 * j]; v2u o; o.x = pk2(v[j].x * rstd * n.x, v[j].y * rstd * n.y); o.y = pk2(v[j].z * rstd * n.z, v[j].w * rstd * n.w); o8[64 * j] = o; }
    }
}

__device__ __forceinline__ void gdn_simple(const Args& A, LAS unsigned char* lds, int tid, int lane, int wave) {
    const bf16* PROJ = (const bf16*)(A.ws + WS_PROJ); const float* AB = (const float*)(A.ws + WS_AB); float* OA = (float*)(A.ws + WS_OA);
    const float* cw = A.in[3]; const float* a_log = A.in[4]; const float* dt_bias = A.in[5];
    LAS float* qs = (LAS float*)lds; LAS float* ks = qs + 16 * 128; LAS float* vs = ks + 16 * 128; LAS float* av = vs + 16 * 128; LAS float* bv = av + 16;
    for (int task = blockIdx.x; task < NB * GH; task += gridDim.x) {
        const int b = task / GH, h = task % GH, v = tid >> 2, part = tid & 3;
        float S[32];
#pragma unroll
        for (int i = 0; i < 32; ++i) S[i] = 0.f;
        const float Ah = __expf(a_log[h]), dtb = dt_bias[h];
        for (int blk = 0; blk < SEQ / 16; ++blk) {
            const int t0 = blk * 16;
            for (int idx = tid; idx < 16 * 384; idx += NTHR) {
                const int tt = idx / 384, c = idx % 384, which = c >> 7, d = c & 127, col = which * 512 + h * 128 + d, t = t0 + tt;
                float acc = 0.f;
#pragma unroll
                for (int i = 0; i < 4; ++i) { const int ts = t - 3 + i; if (ts >= 0) acc += cw[i * 1536 + col] * bf2f(PROJ[(size_t)(b * SEQ + ts) * NP + col]); }
                qs[which * 2048 + tt * 128 + d] = silu_f(acc);
            }
            if (tid < 16) { const size_t row = (size_t)b * SEQ + t0 + tid; bv[tid] = sigmoid_f(AB[row * 8 + h]); av[tid] = __expf(-Ah * softplus_f(AB[row * 8 + 4 + h] + dtb)); }
            __syncthreads();
#pragma unroll
            for (int r = 0; r < 4; ++r) { const int row = 4 * wave + r; LAS float* arr = qs + row * 128;
                const float v0 = arr[lane], v1 = arr[lane + 64]; const float s = wave_sum(v0 * v0 + v1 * v1);
                const float sc = rsqrtf(s + RMS_EPS) * (row < 16 ? 0.08838834764831845f : 1.0f); arr[lane] = v0 * sc; arr[lane + 64] = v1 * sc; }
            __syncthreads();
            for (int tt = 0; tt < 16; ++tt) {
                const float a = av[tt], bt = bv[tt], vt = vs[tt * 128 + v];
                float kS = 0.f;
#pragma unroll
                for (int i = 0; i < 32; ++i) kS += ks[tt * 128 + 32 * part + i] * S[i];
                kS += __shfl_xor(kS, 1); kS += __shfl_xor(kS, 2);
                const float c = bt * (vt - a * kS); float o = 0.f;
#pragma unroll
                for (int i = 0; i < 32; ++i) { S[i] = a * S[i] + ks[tt * 128 + 32 * part + i] * c; o += qs[tt * 128 + 32 * part + i] * S[i]; }
                o += __shfl_xor(o, 1); o += __shfl_xor(o, 2);
                if (part == 0) OA[(size_t)(b * SEQ + t0 + tt) * GW + h * 128 + v] = o;
            }
            __syncthreads();
        }
    }
}


template <int J, int K, int N> struct SolveLd {
    static __device__ __forceinline__ void run(f32x4 (&l)[16], unsigned lbase) {
        if constexpr (K < N) { constexpr int t40 = ((J + 1) >> 2) << 2;
            asm volatile("ds_read_b128 %0, %1 offset:%2" : "=v"(l[K]) : "v"(lbase), "i"((J * 68 + t40 + 4 * K) * 4)); SolveLd<J, K + 1, N>::run(l, lbase); }
    }
};
template <int J> struct SolveCol {
    static __device__ __forceinline__ void run(float (&R)[64], unsigned lbase) {
        if constexpr (J < 63) {
            constexpr int t40 = ((J + 1) >> 2) << 2, nld = (64 - t40) >> 2;
            f32x4 l[16];
            SolveLd<J, 0, nld>::run(l, lbase);
            asm volatile("s_waitcnt lgkmcnt(0)" ::: "memory");
#pragma unroll
            for (int k = 0; k < nld; ++k) asm volatile("" : "+v"(l[k]));
#pragma unroll
            for (int k = 0; k < nld; ++k) {
#pragma unroll
                for (int e = 0; e < 4; ++e) if (t40 + 4 * k + e > J) R[t40 + 4 * k + e] -= l[k][e] * R[J]; }
            SolveCol<J + 1>::run(R, lbase);
        }
    }
};

typedef short bf16x8 __attribute__((ext_vector_type(8)));
__device__ __forceinline__ void gdn_prep(const Args& A, LAS unsigned char* lds, int tid0, int lane0, int wave) {
    const bf16* PROJ = (const bf16*)(A.ws + WS_PROJ); const float* AB = (const float*)(A.ws + WS_AB);
    const float* cw = A.in[3]; const float* a_log = A.in[4]; const float* dt_bias = A.in[5];
    unsigned char* UVF = A.ws + WS_XN; unsigned char* GOPS = (unsigned char*)A.out; float* GE = (float*)(A.ws + WS_GE);
    LAS float* Qs = (LAS float*)lds; LAS float* Ks = (LAS float*)(lds + 33792); LAS float* Vs = (LAS float*)(lds + 67584);
    LAS bf16* Qb = (LAS bf16*)(lds + 101376); LAS bf16* Kb = (LAS bf16*)(lds + 118784);
    LAS float* gcs = (LAS float*)(lds + 136192); LAS float* bts = gcs + 64; LAS float* egs = gcs + 128; LAS float* kes = gcs + 192;
    LAS float* LsT = (LAS float*)lds; LAS bf16* ATs = (LAS bf16*)(lds + 17408); LAS bf16* WKs = Kb;
#pragma unroll 1
    for (int task = blockIdx.x; task < NB * GH * 32; task += gridDim.x) {
        int tid = tid0, lane = lane0; asm volatile("" : "+v"(tid), "+v"(lane));
        const int fr = lane & 15, fq = lane >> 4;
        const int bh = task >> 5, n = task & 31, b = bh >> 2, h = bh & 3, t0 = 64 * n, row0 = b * SEQ + t0;
        unsigned char* gops = GOPS + (size_t)task * GOPS_CHUNK;
        for (int idx = tid; idx < 3072; idx += NTHR) {
            const int tt = idx / 48, c8 = idx % 48, which = c8 >> 4, d0 = (c8 & 15) * 8, col = which * 512 + h * 128 + d0;
            float acc[8];
#pragma unroll
            for (int e = 0; e < 8; ++e) acc[e] = 0.f;
#pragma unroll
            for (int i = 0; i < 4; ++i) { const int ts = t0 + tt - 3 + i; if (ts < 0) continue;
                const v4u w = *(const v4u*)(PROJ + (size_t)(b * SEQ + ts) * NP + col); const f32x4 c0 = *(const f32x4*)(cw + i * 1536 + col), c1 = *(const f32x4*)(cw + i * 1536 + col + 4);
                acc[0] += c0.x * bflo(w.x); acc[1] += c0.y * bfhi(w.x); acc[2] += c0.z * bflo(w.y); acc[3] += c0.w * bfhi(w.y);
                acc[4] += c1.x * bflo(w.z); acc[5] += c1.y * bfhi(w.z); acc[6] += c1.z * bflo(w.w); acc[7] += c1.w * bfhi(w.w); }
            LAS float* dst = (which == 0 ? Qs : (which == 1 ? Ks : Vs)) + tt * 132 + d0;
            *(LAS f32x4*)dst = (f32x4){silu_f(acc[0]), silu_f(acc[1]), silu_f(acc[2]), silu_f(acc[3])};
            *(LAS f32x4*)(dst + 4) = (f32x4){silu_f(acc[4]), silu_f(acc[5]), silu_f(acc[6]), silu_f(acc[7])};
        }
        if (wave == 0) {
            const size_t row = (size_t)row0 + lane; const float beta = sigmoid_f(AB[row * 8 + h]);
            float g = -__expf(a_log[h]) * softplus_f(AB[row * 8 + 4 + h] + dt_bias[h]);
#pragma unroll
            for (int o = 1; o < 64; o <<= 1) { const float t = __shfl_up(g, o); if (lane >= o) g += t; }
            const float glast = __shfl(g, 63);
            gcs[lane] = g; bts[lane] = beta; egs[lane] = __expf(g); kes[lane] = __expf(glast - g) * beta;
            if (lane == 63) GE[task] = __expf(g);
        }
        __syncthreads();
#pragma unroll 2
        for (int r = 0; r < 8; ++r) { const int row = 8 * wave + r;
            { const float v0 = Qs[row * 132 + lane], v1 = Qs[row * 132 + lane + 64]; const float sc = rsqrtf(wave_sum(v0 * v0 + v1 * v1) + RMS_EPS) * 0.08838834764831845f;
              Qb[row * 136 + lane] = (bf16)(pk2(v0 * sc, 0.f) & 0xffffu); Qb[row * 136 + lane + 64] = (bf16)(pk2(v1 * sc, 0.f) & 0xffffu); }
            { const float v0 = Ks[row * 132 + lane], v1 = Ks[row * 132 + lane + 64]; const float sc = rsqrtf(wave_sum(v0 * v0 + v1 * v1) + RMS_EPS);
              Ks[row * 132 + lane] = v0 * sc; Ks[row * 132 + lane + 64] = v1 * sc; Kb[row * 136 + lane] = (bf16)(pk2(v0 * sc, 0.f) & 0xffffu); Kb[row * 136 + lane + 64] = (bf16)(pk2(v1 * sc, 0.f) & 0xffffu); }
        }
        __syncthreads();
#pragma unroll 1
        for (int jb = wave; jb < 20; jb += 8) {
            const int kind = jb >= 10 ? 1 : 0, idx = jb - 10 * kind, ti = idx < 1 ? 0 : (idx < 3 ? 1 : (idx < 6 ? 2 : 3)), tj = idx - ti * (ti + 1) / 2;
            const LAS bf16* As = kind ? Qb : Kb; f32x4 d = (f32x4){0.f, 0.f, 0.f, 0.f};
#pragma unroll
            for (int ks = 0; ks < 4; ++ks) { const bf16x8 a = *(const LAS bf16x8*)(As + (16 * ti + fr) * 136 + 32 * ks + 8 * fq), bb = *(const LAS bf16x8*)(Kb + (16 * tj + fr) * 136 + 32 * ks + 8 * fq);
                d = __builtin_amdgcn_mfma_f32_16x16x32_bf16(a, bb, d, 0, 0, 0); }
            const int j = 16 * tj + fr; const float gj = gcs[j], bj = bts[j]; float val[4];
#pragma unroll
            for (int e = 0; e < 4; ++e) { const int t = 16 * ti + 4 * fq + e; const float x = d[e] * __expf(gcs[t] - gj) * bj; val[e] = (kind ? (t >= j) : (t > j)) ? x : 0.f; }
            if (kind == 0) *(LAS f32x4*)(LsT + j * 68 + 16 * ti + 4 * fq) = (f32x4){val[0], val[1], val[2], val[3]};
            else {
#pragma unroll
                for (int e = 0; e < 4; ++e) ATs[(16 * ti + 4 * fq + e) * 72 + j] = (bf16)(pk2(val[e], 0.f) & 0xffffu); }
        }
        __syncthreads();
        float R[64];
        if (wave < 4) {
            if (wave < 2) {
#pragma unroll
                for (int t = 0; t < 64; ++t) R[t] = Vs[t * 132 + 64 * wave + lane];
            } else {
#pragma unroll
                for (int t = 0; t < 64; ++t) R[t] = egs[t] * Ks[t * 132 + 64 * (wave - 2) + lane];
            }
            SolveCol<0>::run(R, (unsigned)(uintptr_t)LsT);
            if (wave < 2) {
                const int v = 64 * wave + lane; unsigned char* uvp = UVF + (size_t)task * 16384 + (size_t)((v >> 4) * 4 * 64 + (v & 15)) * 8; asm volatile("" : "+v"(uvp));
#pragma unroll
                for (int g = 0; g < 16; ++g) { v2u w; w.x = pk2(R[4 * g], R[4 * g + 1]); w.y = pk2(R[4 * g + 2], R[4 * g + 3]); *(v2u*)(uvp + ((g >> 2) * 64 + 16 * (g & 3)) * 8) = w; }
            } else {
#pragma unroll
                for (int t = 0; t < 64; ++t) WKs[t * 136 + 64 * (wave - 2) + lane] = (bf16)(pk2(R[t], 0.f) & 0xffffu);
            }
        } else {
            const int rt = tid - 256;
            for (int q = rt; q < 1024; q += 256) { const int blk = q >> 6, l2 = q & 63, i = l2 & 15, f = l2 >> 4, mb = blk >> 2, ks = blk & 3, t = 16 * mb + i;
                const v2u p0 = *(const LAS v2u*)(Qb + t * 136 + 32 * ks + 4 * f), p1 = *(const LAS v2u*)(Qb + t * 136 + 32 * ks + 16 + 4 * f); const float e = egs[t];
                v4u o; o.x = pk2(bflo(p0.x) * e, bfhi(p0.x) * e); o.y = pk2(bflo(p0.y) * e, bfhi(p0.y) * e); o.z = pk2(bflo(p1.x) * e, bfhi(p1.x) * e); o.w = pk2(bflo(p1.y) * e, bfhi(p1.y) * e);
                *(v4u*)(gops + 16384 + q * 16) = o; }
            for (int q = rt; q < 512; q += 256) { const int blk = q >> 6, l2 = q & 63, i = l2 & 15, f = l2 >> 4, mb = blk >> 1, ks2 = blk & 1, t = 16 * mb + i;
                v2u p0 = (v2u){0u, 0u}, p1 = (v2u){0u, 0u};
                if (2 * ks2 <= mb) p0 = *(const LAS v2u*)(ATs + t * 72 + 32 * ks2 + 4 * f);
                if (2 * ks2 + 1 <= mb) p1 = *(const LAS v2u*)(ATs + t * 72 + 32 * ks2 + 16 + 4 * f);
                *(v4u*)(gops + 32768 + q * 16) = (v4u){p0.x, p0.y, p1.x, p1.y}; }
            for (int q = rt; q < 1024; q += 256) { const int blk = q >> 6, l2 = q & 63, i = l2 & 15, f = l2 >> 4, dkb = blk >> 1, ks2 = blk & 1, dk = 16 * dkb + i; float v[8];
#pragma unroll
                for (int e = 0; e < 8; ++e) { const int c = 32 * ks2 + 16 * (e >> 2) + 4 * f + (e & 3); v[e] = Ks[c * 132 + dk] * kes[c]; }
                *(v4u*)(gops + 40960 + q * 16) = (v4u){pk2(v[0], v[1]), pk2(v[2], v[3]), pk2(v[4], v[5]), pk2(v[6], v[7])}; }
        }
        __syncthreads();
        for (int q = tid; q < 1024; q += NTHR) { const int blk = q >> 6, l2 = q & 63, i = l2 & 15, f = l2 >> 4, mb = blk >> 2, ks = blk & 3, t = 16 * mb + i;
            const v2u p0 = *(const LAS v2u*)(WKs + t * 136 + 32 * ks + 4 * f), p1 = *(const LAS v2u*)(WKs + t * 136 + 32 * ks + 16 + 4 * f);
            *(v4u*)(gops + q * 16) = (v4u){p0.x, p0.y, p1.x, p1.y}; }
        __syncthreads();
    }
}

__device__ __forceinline__ bf16x8 pack8(const f32x4 a, const f32x4 b) {
    v4u w; w.x = pk2(a[0], a[1]); w.y = pk2(a[2], a[3]); w.z = pk2(b[0], b[1]); w.w = pk2(b[2], b[3]); return __builtin_bit_cast(bf16x8, w);
}
__device__ __forceinline__ void gdn_scan(const Args& A, LAS unsigned char* lds, int bh, int tid, int lane, int wave) {
    const int b = bh >> 2, h = bh & 3, fr = lane & 15, fq = lane >> 4, vs = wave;
    const unsigned char* gops = (const unsigned char*)A.out + (size_t)bh * 32 * GOPS_CHUNK;
    const unsigned char* uvf = A.ws + WS_XN + (size_t)bh * 32 * 16384; const float* GE = (const float*)(A.ws + WS_GE) + bh * 32;
    float* Op = (float*)(A.ws + WS_OA) + ((size_t)b * SEQ + 4 * fq) * GW + h * 128 + 16 * vs + fr;
    f32x4 S[8];
#pragma unroll
    for (int i = 0; i < 8; ++i) S[i] = (f32x4){0.f, 0.f, 0.f, 0.f};
    const float gev = GE[lane & 31];
#define SCAN_DMA(chunk, bufoff) do { _Pragma("unroll") for (int i_ = 0; i_ < 9; ++i_) { const int p_ = wave + 8 * i_; \
        const unsigned char* s_ = (p_ < 56) ? (gops + (size_t)(chunk) * GOPS_CHUNK + p_ * 1024) : (uvf + (size_t)(chunk) * 16384 + (p_ - 56) * 1024); \
        __builtin_amdgcn_global_load_lds((const unsigned*)(s_ + lane * 16), (LAS unsigned*)(lds + (bufoff) + p_ * 1024), 16, 0, 0); } } while (0)
    SCAN_DMA(0, 0); SCAN_DMA(1, SCAN_BUF);
    asm volatile("s_waitcnt vmcnt(0)" ::: "memory"); __syncthreads();
#pragma unroll 1
    for (int n = 0; n < 32; ++n) {
        const LAS unsigned char* cur = lds + (n & 1) * SCAN_BUF;
        const float ge = __builtin_bit_cast(float, __builtin_amdgcn_readlane(__builtin_bit_cast(int, gev), n));
        bf16x8 Sb[4];
#pragma unroll
        for (int ks = 0; ks < 4; ++ks) Sb[ks] = pack8(S[2 * ks], S[2 * ks + 1]);
        f32x4 u[4];
#pragma unroll
        for (int mb = 0; mb < 4; ++mb) { f32x4 p = (f32x4){0.f, 0.f, 0.f, 0.f};
#pragma unroll
            for (int ks = 0; ks < 4; ++ks) p = __builtin_amdgcn_mfma_f32_16x16x32_bf16(*(const LAS bf16x8*)(cur + ((mb * 4 + ks) * 64 + lane) * 16), Sb[ks], p, 0, 0, 0);
            const v2u uw = *(const LAS v2u*)(cur + GOPS_CHUNK + ((vs * 4 + mb) * 64 + lane) * 8);
            u[mb] = (f32x4){bflo(uw.x) - p[0], bfhi(uw.x) - p[1], bflo(uw.y) - p[2], bfhi(uw.y) - p[3]}; }
        bf16x8 ub[2]; ub[0] = pack8(u[0], u[1]); ub[1] = pack8(u[2], u[3]);
        f32x4 o[4];
#pragma unroll
        for (int mb = 0; mb < 4; ++mb) { f32x4 acc = (f32x4){0.f, 0.f, 0.f, 0.f};
#pragma unroll
            for (int ks = 0; ks < 4; ++ks) acc = __builtin_amdgcn_mfma_f32_16x16x32_bf16(*(const LAS bf16x8*)(cur + 16384 + ((mb * 4 + ks) * 64 + lane) * 16), Sb[ks], acc, 0, 0, 0);
#pragma unroll
            for (int ks2 = 0; ks2 < 2; ++ks2) if (ks2 <= (mb >> 1)) acc = __builtin_amdgcn_mfma_f32_16x16x32_bf16(*(const LAS bf16x8*)(cur + 32768 + ((mb * 2 + ks2) * 64 + lane) * 16), ub[ks2], acc, 0, 0, 0);
            o[mb] = acc; }
#pragma unroll
        for (int dkb = 0; dkb < 8; ++dkb) { f32x4 acc = S[dkb] * ge;
#pragma unroll
            for (int ks2 = 0; ks2 < 2; ++ks2) acc = __builtin_amdgcn_mfma_f32_16x16x32_bf16(*(const LAS bf16x8*)(cur + 40960 + ((dkb * 2 + ks2) * 64 + lane) * 16), ub[ks2], acc, 0, 0, 0);
            S[dkb] = acc; }
        asm volatile("s_waitcnt vmcnt(0)" ::: "memory"); __syncthreads();
        if (n + 2 < 32) SCAN_DMA(n + 2, (n & 1) * SCAN_BUF);
        float* orow = Op + (size_t)(64 * n) * GW;
#pragma unroll
        for (int mb = 0; mb < 4; ++mb) { float* q = orow + (size_t)(16 * mb) * GW; q[0] = o[mb][0]; q[GW] = o[mb][1]; q[2 * GW] = o[mb][2]; q[3 * GW] = o[mb][3]; }
    }
    asm volatile("s_waitcnt vmcnt(0)" ::: "memory"); __syncthreads();
#undef SCAN_DMA
}


__device__ __forceinline__ void attn_fast(const Args& A, LAS unsigned char* lds, int lane, int wave) {
    const bf16* PROJ = (const bf16*)(A.ws + WS_PROJ); bf16* CAT = (bf16*)(A.ws + WS_CAT);
    unsigned* ctr = (unsigned*)(A.ws + WS_CTL);
    LAS bf16* Vt = (LAS bf16*)(lds + wave * 8192);
    const int fr = lane & 15, fq = lane >> 4;
    const int kk = lane & 31, vslot = 8 * ((kk & 15) >> 2) + 4 * (kk >> 4) + (kk & 3), vch = lane >> 5;
    constexpr float SC = 0.125f * 1.4426950408889634f;
    for (;;) {
        unsigned wt_ = 0; if (lane == 0) wt_ = atomicAdd(ctr, 1u); const int wt = __builtin_amdgcn_readfirstlane(wt_);
        if (wt >= NB * AH * 8 * 16) break;
        const int T = 7 - (wt >> 10), rem = wt & 1023, b = rem >> 7, h = (rem >> 4) & 7, c = rem & 15, t0 = 256 * T;
        const bf16* Pb = PROJ + (size_t)b * SEQ * NP;
        const int tq = t0 + c + 16 * fr;
        bf16x8 qf[2];
#pragma unroll
        for (int ks = 0; ks < 2; ++ks) qf[ks] = *(const bf16x8*)(Pb + (size_t)tq * NP + PC_QB + h * 64 + 32 * ks + 8 * fq);
        const int lo2 = c, n2 = ((t0 + 240) >> 4) + 1, g2 = (n2 + 31) >> 5;
        const int lo1 = max(t0 + c - 512, c & 3), n1 = ((t0 + c + 240 - lo1) >> 2) + 1, g1 = (n1 + 31) >> 5;
        const int lo0 = max(t0 + c - 128, 0), n0 = (t0 + c + 240 - lo0) + 1, g0 = (n0 + 31) >> 5;
        const int NG = g2 + g1 + g0;
        f32x4 O[4];
#pragma unroll
        for (int i = 0; i < 4; ++i) O[i] = (f32x4){0.f, 0.f, 0.f, 0.f};
        float mrun = -INFINITY, lrun = 0.f;
        v4u kc[4], vc[4], kn[4], vn[4];
#define ATT_DEC(f, kst, str) do { if ((f) < g2) { str = 16; kst = lo2 + 512 * (f); } else if ((f) < g2 + g1) { str = 4; kst = lo1 + 128 * ((f) - g2); } else { str = 1; kst = lo0 + 32 * ((f) - g2 - g1); } } while (0)
#define ATT_LOAD(kreg, vreg, kst, str) do { \
            _Pragma("unroll") for (int j = 0; j < 2; ++j) { const int tk = min((kst) + (str) * (16 * j + fr), SEQ - 1); \
                _Pragma("unroll") for (int ks = 0; ks < 2; ++ks) kreg[2 * j + ks] = *(const v4u*)(Pb + (size_t)tk * NP + PC_KB + h * 64 + 32 * ks + 8 * fq); } \
            { const int tk = min((kst) + (str) * kk, SEQ - 1); \
                _Pragma("unroll") for (int i = 0; i < 4; ++i) vreg[i] = *(const v4u*)(Pb + (size_t)tk * NP + PC_VB + h * 64 + 8 * (vch + 2 * i)); } } while (0)
        int kst, str; ATT_DEC(0, kst, str); ATT_LOAD(kc, vc, kst, str);
#pragma unroll 1
        for (int f = 0; f < NG; ++f) {
            int kstn = 0, strn = 1;
            if (f + 1 < NG) { ATT_DEC(f + 1, kstn, strn); ATT_LOAD(kn, vn, kstn, strn); }
            f32x4 d0 = (f32x4){0.f, 0.f, 0.f, 0.f}, d1 = d0;
#pragma unroll
            for (int ks = 0; ks < 2; ++ks) { d0 = __builtin_amdgcn_mfma_f32_16x16x32_bf16(__builtin_bit_cast(bf16x8, kc[ks]), qf[ks], d0, 0, 0, 0);
                                             d1 = __builtin_amdgcn_mfma_f32_16x16x32_bf16(__builtin_bit_cast(bf16x8, kc[2 + ks]), qf[ks], d1, 0, 0, 0); }
#pragma unroll
            for (int i = 0; i < 4; ++i) { const int dd = 8 * (vch + 2 * i); const v4u w = vc[i];
                Vt[(dd + 0) * 40 + vslot] = (bf16)(w.x & 0xffffu); Vt[(dd + 1) * 40 + vslot] = (bf16)(w.x >> 16); Vt[(dd + 2) * 40 + vslot] = (bf16)(w.y & 0xffffu); Vt[(dd + 3) * 40 + vslot] = (bf16)(w.y >> 16);
                Vt[(dd + 4) * 40 + vslot] = (bf16)(w.z & 0xffffu); Vt[(dd + 5) * 40 + vslot] = (bf16)(w.z >> 16); Vt[(dd + 6) * 40 + vslot] = (bf16)(w.w & 0xffffu); Vt[(dd + 7) * 40 + vslot] = (bf16)(w.w >> 16); }
            float s[8]; const int span = 128 * str; float mloc = -INFINITY;
#pragma unroll
            for (int e = 0; e < 8; ++e) { const int tk = kst + str * (16 * (e >> 2) + 4 * fq + (e & 3)); const int dt = tq - tk; const float x = (e < 4 ? d0[e & 3] : d1[e & 3]) * SC;
                s[e] = (dt >= 0 && dt <= span) ? x : -INFINITY; mloc = fmaxf(mloc, s[e]); }
            mloc = fmaxf(mloc, __shfl_xor(mloc, 16)); mloc = fmaxf(mloc, __shfl_xor(mloc, 32));
            const float mnew = fmaxf(mrun, mloc), alpha = __builtin_amdgcn_exp2f(mrun - mnew); mrun = mnew;
            float psum = 0.f;
#pragma unroll
            for (int e = 0; e < 8; ++e) { s[e] = __builtin_amdgcn_exp2f(s[e] - mnew); psum += s[e]; }
            lrun = lrun * alpha + psum;
            const bf16x8 pb = pack8((f32x4){s[0], s[1], s[2], s[3]}, (f32x4){s[4], s[5], s[6], s[7]});
#pragma unroll
            for (int db = 0; db < 4; ++db) { const bf16x8 a = *(const LAS bf16x8*)(Vt + (16 * db + fr) * 40 + 8 * fq);
                O[db] = __builtin_amdgcn_mfma_f32_16x16x32_bf16(a, pb, O[db] * alpha, 0, 0, 0); }
#pragma unroll
            for (int i = 0; i < 4; ++i) { kc[i] = kn[i]; vc[i] = vn[i]; }
            kst = kstn; str = strn;
        }
#undef ATT_DEC
#undef ATT_LOAD
        lrun += __shfl_xor(lrun, 16); lrun += __shfl_xor(lrun, 32);
        const float inv = 1.0f / lrun;
        bf16* op = CAT + ((size_t)b * SEQ + tq) * DM + GW + h * 64 + 4 * fq;
#pragma unroll
        for (int db = 0; db < 4; ++db) { v2u w; w.x = pk2(O[db][0] * inv, O[db][1] * inv); w.y = pk2(O[db][2] * inv, O[db][3] * inv); *(v2u*)(op + 16 * db) = w; }
    }
}

__device__ __forceinline__ void attn_simple(const Args& A, int tid, int lane, int wave) {
    const bf16* PROJ = (const bf16*)(A.ws + WS_PROJ); bf16* CAT = (bf16*)(A.ws + WS_CAT);
    unsigned* ctr = (unsigned*)(A.ws + WS_CTL);
    for (;;) {
        unsigned wt_ = 0; if (lane == 0) wt_ = atomicAdd(ctr, 1u); const int wt = __builtin_amdgcn_readfirstlane(wt_);
        if (wt >= (M / 64) * AH) break;
        const int h = wt % AH, tb = wt / AH, row = tb * 64 + lane, b = row / SEQ, t = row % SEQ;
        float q[64], acc[64];
        { const v4u* qp = (const v4u*)(PROJ + (size_t)row * NP + PC_QB + h * 64);
#pragma unroll
          for (int j = 0; j < 8; ++j) { const v4u w = qp[j]; q[8 * j + 0] = bflo(w.x) * 0.125f; q[8 * j + 1] = bfhi(w.x) * 0.125f; q[8 * j + 2] = bflo(w.y) * 0.125f; q[8 * j + 3] = bfhi(w.y) * 0.125f;
              q[8 * j + 4] = bflo(w.z) * 0.125f; q[8 * j + 5] = bfhi(w.z) * 0.125f; q[8 * j + 6] = bflo(w.w) * 0.125f; q[8 * j + 7] = bfhi(w.w) * 0.125f; } }
#pragma unroll
        for (int j = 0; j < 64; ++j) acc[j] = 0.f;
        float mx = -1e30f, l = 0.f;
        for (int br = 0; br < 3; ++br) {
            const int stride = br == 0 ? 1 : (br == 1 ? 4 : 16);
            for (int i = 0; i <= 128; ++i) {
                const int tk = t - i * stride; if (tk < 0) break;
                const size_t krow = (size_t)(b * SEQ + tk) * NP;
                const v4u* kp = (const v4u*)(PROJ + krow + PC_KB + h * 64); const v4u* vp = (const v4u*)(PROJ + krow + PC_VB + h * 64);
                float s = 0.f;
#pragma unroll
                for (int j = 0; j < 8; ++j) { const v4u w = kp[j]; s += q[8 * j + 0] * bflo(w.x) + q[8 * j + 1] * bfhi(w.x) + q[8 * j + 2] * bflo(w.y) + q[8 * j + 3] * bfhi(w.y)
                                                                       + q[8 * j + 4] * bflo(w.z) + q[8 * j + 5] * bfhi(w.z) + q[8 * j + 6] * bflo(w.w) + q[8 * j + 7] * bfhi(w.w); }
                const float mn = fmaxf(mx, s), sc = __expf(mx - mn), p = __expf(s - mn); mx = mn; l = l * sc + p;
#pragma unroll
                for (int j = 0; j < 8; ++j) { const v4u w = vp[j];
                    acc[8 * j + 0] = acc[8 * j + 0] * sc + p * bflo(w.x); acc[8 * j + 1] = acc[8 * j + 1] * sc + p * bfhi(w.x); acc[8 * j + 2] = acc[8 * j + 2] * sc + p * bflo(w.y); acc[8 * j + 3] = acc[8 * j + 3] * sc + p * bfhi(w.y);
                    acc[8 * j + 4] = acc[8 * j + 4] * sc + p * bflo(w.z); acc[8 * j + 5] = acc[8 * j + 5] * sc + p * bfhi(w.z); acc[8 * j + 6] = acc[8 * j + 6] * sc + p * bflo(w.w); acc[8 * j + 7] = acc[8 * j + 7] * sc + p * bfhi(w.w); }
            }
        }
        const float inv = 1.0f / l; v4u* op = (v4u*)(CAT + (size_t)row * DM + GW + h * 64);
#pragma unroll
        for (int j = 0; j < 8; ++j) { v4u w; w.x = pk2(acc[8 * j] * inv, acc[8 * j + 1] * inv); w.y = pk2(acc[8 * j + 2] * inv, acc[8 * j + 3] * inv); w.z = pk2(acc[8 * j + 4] * inv, acc[8 * j + 5] * inv); w.w = pk2(acc[8 * j + 6] * inv, acc[8 * j + 7] * inv); op[j] = w; }
    }
}
__device__ __forceinline__ void gated_norm(const Args& A, int lane, int wave) {
    const bf16* PROJ = (const bf16*)(A.ws + WS_PROJ); bf16* CAT = (bf16*)(A.ws + WS_CAT); const float* OA = (const float*)(A.ws + WS_OA); const float* gw = A.in[6];
    const float w0 = gw[2 * lane], w1 = gw[2 * lane + 1];
    for (int wt = blockIdx.x * NWAVES + wave; wt < M * GH; wt += gridDim.x * NWAVES) {
        const int row = wt / GH, h = wt % GH;
        const float2 o = *(const float2*)(OA + (size_t)row * GW + h * 128 + 2 * lane);
        const unsigned zz = *(const unsigned*)(PROJ + (size_t)row * NP + PC_Z + h * 128 + 2 * lane);
        const float ms = wave_sum(o.x * o.x + o.y * o.y) * (1.0f / 128.0f), r = rsqrtf(ms + RMS_EPS);
        *(unsigned*)(CAT + (size_t)row * DM + h * 128 + 2 * lane) = pk2(o.x * r * w0 * silu_f(bflo(zz)), o.y * r * w1 * silu_f(bfhi(zz)));
    }
}

__device__ __forceinline__ void gated_norm_bh(const Args& A, int bh, int lane, int wave) {
    const int b = bh >> 2, h = bh & 3;
    const bf16* Zp = (const bf16*)(A.ws + WS_PROJ) + (size_t)b * SEQ * NP + PC_Z + h * 128 + 2 * lane; bf16* Cp = (bf16*)(A.ws + WS_CAT) + (size_t)b * SEQ * DM + h * 128 + 2 * lane;
    const float* Op = (const float*)(A.ws + WS_OA) + (size_t)b * SEQ * GW + h * 128 + 2 * lane; const float* gw = A.in[6];
    const float w0 = gw[2 * lane], w1 = gw[2 * lane + 1];
    __builtin_amdgcn_fence(__ATOMIC_ACQUIRE, "agent");
#pragma unroll 1
    for (int r0 = wave * 4; r0 < SEQ; r0 += NWAVES * 4) {
        float2 o[4]; unsigned zz[4];
#pragma unroll
        for (int i = 0; i < 4; ++i) { o[i] = *(const float2*)(Op + (size_t)(r0 + i) * GW); zz[i] = *(const unsigned*)(Zp + (size_t)(r0 + i) * NP); }
#pragma unroll
        for (int i = 0; i < 4; ++i) { const float ms = wave_sum(o[i].x * o[i].x + o[i].y * o[i].y) * (1.0f / 128.0f), r = rsqrtf(ms + RMS_EPS);
            *(unsigned*)(Cp + (size_t)(r0 + i) * DM) = pk2(o[i].x * r * w0 * silu_f(bflo(zz[i])), o[i].y * r * w1 * silu_f(bfhi(zz[i]))); }
    }
}
__device__ __forceinline__ void ffn_conv_half(const Args& A, int half, int tid) {
    const bf16* Y = (const bf16*)(A.ws + WS_Y); bf16* ACT = (bf16*)(A.ws + WS_ACT); const float* fw = A.in[10];
    constexpr int HC = DFF / 2;
    for (size_t it = (size_t)blockIdx.x * NTHR + tid; it < (size_t)M * (HC / 8); it += (size_t)gridDim.x * NTHR) {
        const int row = (int)(it / (HC / 8)), g8 = (int)(it % (HC / 8)), cl = g8 * 8, pn = cl >> 7, j = cl & 127, t = row % SEQ, ch = half * HC + cl;
        float ga[8], ua[8];
#pragma unroll
        for (int e = 0; e < 8; ++e) { ga[e] = 0.f; ua[e] = 0.f; }
#pragma unroll
        for (int i = 0; i < 3; ++i) { const int ts = t - 2 + i; if (ts < 0) continue;
            const bf16* yr = Y + (size_t)(row - 2 + i) * DFF + 256 * pn + j; const v4u g = *(const v4u*)yr, u = *(const v4u*)(yr + 128);
            const f32x4 wg0 = *(const f32x4*)(fw + i * NUP + ch), wg1 = *(const f32x4*)(fw + i * NUP + ch + 4), wu0 = *(const f32x4*)(fw + i * NUP + DFF + ch), wu1 = *(const f32x4*)(fw + i * NUP + DFF + ch + 4);
            ga[0] += wg0.x * bflo(g.x); ga[1] += wg0.y * bfhi(g.x); ga[2] += wg0.z * bflo(g.y); ga[3] += wg0.w * bfhi(g.y); ga[4] += wg1.x * bflo(g.z); ga[5] += wg1.y * bfhi(g.z); ga[6] += wg1.z * bflo(g.w); ga[7] += wg1.w * bfhi(g.w);
            ua[0] += wu0.x * bflo(u.x); ua[1] += wu0.y * bfhi(u.x); ua[2] += wu0.z * bflo(u.y); ua[3] += wu0.w * bfhi(u.y); ua[4] += wu1.x * bflo(u.z); ua[5] += wu1.y * bfhi(u.z); ua[6] += wu1.z * bflo(u.w); ua[7] += wu1.w * bfhi(u.w); }
        v4u o; o.x = pk2(silu_f(ga[0]) * ua[0], silu_f(ga[1]) * ua[1]); o.y = pk2(silu_f(ga[2]) * ua[2], silu_f(ga[3]) * ua[3]); o.z = pk2(silu_f(ga[4]) * ua[4], silu_f(ga[5]) * ua[5]); o.w = pk2(silu_f(ga[6]) * ua[6], silu_f(ga[7]) * ua[7]);
        *(v4u*)(ACT + (size_t)row * DFF + ch) = o;
    }
}

__device__ __forceinline__ void ffn_fixup(const Args& A, int tid) {
    const float* YH = (const float*)(A.ws + WS_YH); const float* UP = (const float*)(A.ws + WS_UPART); bf16* ACT = (bf16*)(A.ws + WS_ACT); const float* fw = A.in[10];
    for (int it = blockIdx.x * NTHR + tid; it < 64 * 22 * 2 * 128; it += gridDim.x * NTHR) {
        const int c = it & 127, r = (it >> 7) & 1, tile = it >> 8, pm = tile / 22, pn = tile % 22; if ((pm & 7) == 0) continue;
        const int ch = pn * 128 + c; const float* up = UP + ((size_t)tile * 2 + r) * 256; const float* yh = YH + (size_t)((pm - 1) * 22 + pn) * 2 * 256;
        float g = up[c], u = up[128 + c];
        const float wg0 = fw[ch], wg1 = fw[5632 + ch], wu0 = fw[2816 + ch], wu1 = fw[5632 + 2816 + ch];
        if (r == 0) { g += wg0 * yh[c] + wg1 * yh[256 + c]; u += wu0 * yh[128 + c] + wu1 * yh[256 + 128 + c]; }
        else { g += wg0 * yh[256 + c]; u += wu0 * yh[256 + 128 + c]; }
        ACT[(size_t)(pm * 256 + r) * DFF + ch] = (bf16)(pk2(silu_f(g) * u, 0.f) & 0xffffu);
    }
}
__device__ __forceinline__ void final_norm(const Args& A, int lane, int wave) {
    float* out = A.out; const float* fnw = A.in[12];
    for (int m = blockIdx.x * NWAVES + wave; m < M; m += gridDim.x * NWAVES) {
        f32x4* xr = (f32x4*)(out + (size_t)m * DM) + lane; const f32x4* nr = (const f32x4*)fnw + lane;
        f32x4 v[4]; float s = 0.f;
#pragma unroll
        for (int j = 0; j < 4; ++j) { v[j] = xr[64 * j]; s += (v[j].x * v[j].x + v[j].y * v[j].y) + (v[j].z * v[j].z + v[j].w * v[j].w); }
        const float rstd = rsqrtf(wave_sum(s) * (1.f / DM) + RMS_EPS);
#pragma unroll
        for (int j = 0; j < 4; ++j) { const f32x4 n = nr[64 * j]; xr[64 * j] = (f32x4){v[j].x * rstd * n.x, v[j].y * rstd * n.y, v[j].z * rstd * n.z, v[j].w * rstd * n.w}; }
    }
}

#define XB_TMO      128
#define XB_XCNT(j)  (256  + 64 * (j))
#define XB_XSUB(j)  (1280 + 64 * (j))
#define XB_XGEN(j)  (2304 + 64 * (j))
#define XB_TOP      3328
#define XB_TOPGEN   3392
#define XCD_BAR_WORDS 3456
#define XB_SPIN_CAP (1u << 18)

__device__ __forceinline__ unsigned xb_ld(unsigned* p)              { return __hip_atomic_load(p, __ATOMIC_RELAXED, __HIP_MEMORY_SCOPE_AGENT); }
__device__ __forceinline__ unsigned xb_add(unsigned* p, unsigned v) { return __hip_atomic_fetch_add(p, v, __ATOMIC_RELAXED, __HIP_MEMORY_SCOPE_AGENT); }
__device__ __forceinline__ unsigned xb_xcc_id() { return (unsigned)__builtin_amdgcn_s_getreg((3 << 11) | 20) & 0xFu; }
#define XB_SPIN(cond, bar) do { unsigned _sp = 0; while (cond) { __builtin_amdgcn_s_sleep(1); \
    if ((++_sp & 255u) == 0u) { if (xb_ld(&(bar)[XB_TMO])) break; if (_sp > XB_SPIN_CAP) { atomicAdd(&(bar)[XB_TMO], 1u); break; } } } } while (0)

struct XcdBarrier {
    unsigned* bar; unsigned x;
    volatile LAS unsigned* st;
};

__device__ __forceinline__ XcdBarrier xcd_barrier_post(unsigned* bar, volatile LAS unsigned* st) {
    XcdBarrier b; b.bar = bar; b.x = xb_xcc_id(); b.st = st;
    if (threadIdx.x == 0) (void)xb_add(&bar[XB_XCNT(b.x)], 1u);
    return b;
}
__device__ __forceinline__ void xcd_barrier_complete(unsigned* bar, unsigned x, unsigned& nloc, unsigned& nx) {
    const unsigned G = gridDim.x * gridDim.y * gridDim.z;
    unsigned sum, cnt, mine, sp = 0u;
    for (;;) {
        sum = 0u; cnt = 0u; mine = 0u;
#pragma unroll
        for (unsigned j = 0; j < 16; ++j) { const unsigned c = xb_ld(&bar[XB_XCNT(j)]); sum += c; cnt += (c > 0u) ? 1u : 0u; mine = (j == x) ? c : mine; }
        if (sum == G) break;
        __builtin_amdgcn_s_sleep(1);
        if ((++sp & 255u) == 0u) { if (xb_ld(&bar[XB_TMO])) break; if (sp > XB_SPIN_CAP) { atomicAdd(&bar[XB_TMO], 1u); break; } }
    }
    nloc = mine > 0u ? mine : 1u; nx = cnt > 0u ? cnt : 1u;
}

__device__ __forceinline__ void xcd_barrier(const XcdBarrier& b) {
    asm volatile("s_waitcnt vmcnt(0)" ::: "memory");
    __syncthreads();
    if (threadIdx.x == 0) {
        unsigned* bar = b.bar;
        __builtin_amdgcn_s_waitcnt(0);
        unsigned nloc = b.st[0], nx = b.st[1];
        if (nloc == 0u) { xcd_barrier_complete(bar, b.x, nloc, nx); b.st[0] = nloc; b.st[1] = nx; }
        const unsigned old = xb_add(&bar[XB_XSUB(b.x)], 1u);
        const unsigned gen = old / nloc;
        if (old + 1u == (gen + 1u) * nloc) {
            __builtin_amdgcn_fence(__ATOMIC_RELEASE, "agent");
            asm volatile("s_waitcnt vmcnt(0)" ::: "memory");
            const unsigned og = xb_add(&bar[XB_TOP], 1u);
            const unsigned tg = og / nx;
            if (og + 1u == (tg + 1u) * nx) xb_add(&bar[XB_TOPGEN], 1u);
            else XB_SPIN(xb_ld(&bar[XB_TOPGEN]) == tg, bar);
            __builtin_amdgcn_fence(__ATOMIC_ACQUIRE, "agent");
            xb_add(&bar[XB_XGEN(b.x)], 1u);
            asm volatile("s_waitcnt vmcnt(0)" ::: "memory");
        } else {
            XB_SPIN(xb_ld(&bar[XB_XGEN(b.x)]) == gen, bar);
            __builtin_amdgcn_fence(__ATOMIC_ACQUIRE, "agent");
            asm volatile("s_waitcnt vmcnt(0)" ::: "memory");
        }
    }
    __syncthreads();
}

constexpr int N_PHASES = 9;
__global__ void __launch_bounds__(NTHR, 2) mk_fwd(Args args) {
    extern __shared__ __attribute__((aligned(16))) unsigned char lds_raw[];
    LAS unsigned char* lds = (LAS unsigned char*)lds_raw;
    const int tid = threadIdx.x, lane = tid & 63, wave = __builtin_amdgcn_readfirstlane(tid >> 6);
    const int lo = args.ph_lo, hi = args.ph_hi;
    unsigned char* ws = args.ws;
    bf16* WIN = (bf16*)(ws + WS_WIN); bf16* WOUT = (bf16*)(ws + WS_WOUT); bf16* WUP = (bf16*)(ws + WS_WUP); bf16* WDN = (bf16*)(ws + WS_WDN);
    bf16* XN = (bf16*)(ws + WS_XN); bf16* PROJ = (bf16*)(ws + WS_PROJ); bf16* CAT = (bf16*)(ws + WS_CAT); bf16* Y = (bf16*)(ws + WS_Y); bf16* ACT = (bf16*)(ws + WS_ACT);
    float* SSQ = (float*)(ws + WS_SSQ);
#define IN(k) (lo <= (k) && (k) < hi)
#define SEAM(k) do { if (IN(k) && IN((k) + 1)) { if ((k) == 0) cg::this_grid().sync(); else xcd_barrier(bar); } } while (0)
    { volatile LAS unsigned* st = (volatile LAS unsigned*)(lds + LDS_BYTES - 64); if (tid < 2) st[tid] = 0u; }
    __syncthreads();
    XcdBarrier bar = xcd_barrier_post((unsigned*)(ws + WS_CTL) + 4096, (volatile LAS unsigned*)(lds + LDS_BYTES - 64));
    if (IN(0)) { p0_prologue(args, lds, tid, lane, wave); } SEAM(0);
    if (IN(1)) { pg8::Gemm g{XN, WIN, M, NP, DM}; pg8::StaticOrder S; S.init(M, NP, gridDim.x, blockIdx.x); pg8::EpiBf16S E{PROJ, NP, nullptr};
        pg8::gemm_phase<pg8::EpiBf16S, pg8::StaticOrder, PG8_ALIGN, PG8_SP2>(lds, g, S, E); } SEAM(1);
    if (IN(2)) { gdn_prep(args, lds, tid, lane, wave); } SEAM(2);
    if (IN(3)) { if (blockIdx.x < NB * GH) { gdn_scan(args, lds, blockIdx.x, tid, lane, wave); gated_norm_bh(args, blockIdx.x, lane, wave); } attn_fast(args, lds, lane, wave); } SEAM(3);
    if (IN(4)) { pg8::Gemm g{CAT, WOUT, M, DM, DM}; pg8::StaticOrder S; S.init(M, DM, gridDim.x, blockIdx.x); pg8::EpiResid E{args.in[0], args.out, XN, SSQ, DM};
        pg8::gemm_phase<pg8::EpiResid, pg8::StaticOrder, PG8_ALIGN, PG8_SP2>(lds, g, S, E); } SEAM(4);
    if (IN(5)) { pg8::Gemm g{XN, WUP, M, NUP, DM}; pg8::StaticOrder S; S.init(M, NUP, gridDim.x, blockIdx.x);
        static_assert(pg8::EpiConvGate::CG_SSQ == WS_SSQ && pg8::EpiConvGate::CG_ACT == WS_ACT && pg8::EpiConvGate::CG_YH == WS_YH && pg8::EpiConvGate::CG_UPART == WS_UPART, "d_ws map");
        pg8::EpiConvGate E{ws, args.in[10], lds};
        pg8::gemm_phase<pg8::EpiConvGate, pg8::StaticOrder, true, PG8_SP2>(lds, g, S, E); } SEAM(5);
    if (IN(6)) { ffn_fixup(args, tid); } SEAM(6);
    if (IN(7)) { pg8::Gemm g{ACT, WDN, M, DM, DFF}; pg8::StaticOrder S; S.init(M, DM, gridDim.x, blockIdx.x); pg8::EpiResid E{args.out, args.out, nullptr, nullptr, DM};
        pg8::gemm_phase<pg8::EpiResid, pg8::StaticOrder, PG8_ALIGN, PG8_SP2>(lds, g, S, E); } SEAM(7);
    if (IN(8)) { final_norm(args, lane, wave); }
#undef IN
#undef SEAM
}

#ifndef MK_ONE_LAUNCH
#define MK_ONE_LAUNCH 1
#endif
extern "C" void kernel_launch(void* const* d_in, const int* in_sizes, int n_in, void* d_out, int out_size, void* d_ws, size_t ws_size, hipStream_t stream) {
    static int grid = 0;
    if (grid == 0) {
        if (n_in != 13 || out_size != M * DM || ws_size < WS_END) { fprintf(stderr, "kernel_launch: unexpected shapes n_in %d out %d ws %zu\n", n_in, out_size, ws_size); grid = -1; return; }
        int dev = 0, cus = 0, per_cu = 0;
        hipGetDevice(&dev); hipDeviceGetAttribute(&cus, hipDeviceAttributeMultiprocessorCount, dev);
        hipFuncSetAttribute((const void*)mk_fwd, hipFuncAttributeMaxDynamicSharedMemorySize, LDS_BYTES);
        hipOccupancyMaxActiveBlocksPerMultiprocessor(&per_cu, (const void*)mk_fwd, NTHR, LDS_BYTES);
        (void)hipGetLastError();
        if (per_cu < 1) { fprintf(stderr, "kernel_launch: occupancy query says %d blocks per CU\n", per_cu); per_cu = 1; }
        grid = cus;
    }
    if (grid < 0) return;
    if (hipMemsetAsync((char*)d_ws + WS_CTL, 0, 65536, stream) != hipSuccess) { fprintf(stderr, "kernel_launch: memset failed\n"); return; }
    Args a{};
    for (int i = 0; i < 13; ++i) a.in[i] = (const float*)d_in[i];
    a.out = (float*)d_out; a.ws = (unsigned char*)d_ws;
#if MK_ONE_LAUNCH
    a.ph_lo = 0; a.ph_hi = N_PHASES; a.coop = 1;
    void* kargs[] = {&a};
    hipError_t e = hipLaunchCooperativeKernel((const void*)mk_fwd, dim3(grid), dim3(NTHR), kargs, LDS_BYTES, stream);
    if (e != hipSuccess) fprintf(stderr, "cooperative launch failed: %s (grid %d)\n", hipGetErrorString(e), grid);
#else
    for (int p = 0; p < N_PHASES; ++p) { a.ph_lo = p; a.ph_hi = p + 1; a.coop = 0; hipLaunchKernelGGL(mk_fwd, dim3(grid), dim3(NTHR), LDS_BYTES, stream, a); }
#endif
}
```

```cpp
#include <hip/hip_runtime.h>
#include <hip/hip_cooperative_groups.h>
#include <cstdio>
#include <cstdint>
namespace cg = cooperative_groups;
namespace pg8 {
#define PG8_LAS __attribute__((address_space(3)))
typedef unsigned short bf16_t;
typedef short bf16x8 __attribute__((ext_vector_type(8)));
typedef float f32x4 __attribute__((ext_vector_type(4)));
typedef unsigned u32x4 __attribute__((ext_vector_type(4)));
constexpr int BM = 256, BK = 64, HALF = 128, HTB = HALF * BK * 2  , STAGE_BYTES = 8 * HTB, NXCD = 8, WGM = 8;

__host__ __device__ __forceinline__ int lds_byte(int r, int c) { const int st = (r >> 4) * 2 + (c >> 5), rr = r & 15, cc = c & 31, ob = rr * 64 + cc * 2; return st * 1024 + (ob ^ (((ob >> 9) & 1) << 5)); }
__host__ __device__ __forceinline__ void stage_rc(int b, int& R, int& C) { const int st = b / 1024, sb = b % 1024, swz = sb ^ (((sb >> 9) & 1) << 5); R = (st >> 1) * 16 + swz / 64; C = (st & 1) * 32 + (swz % 64) / 2; }
__host__ __device__ __forceinline__ int perm32(int rho) { const int n = rho >> 4, i = rho & 15; return 8 * (i >> 2) + 4 * n + (i & 3); }

struct Unit { int pm, pn; };
struct Gemm { const bf16_t* A; const bf16_t* Bt; int M, N, K; };

struct StaticOrder {
    int nM, nN, nwg, G, c;
    __host__ __device__ void init(int M, int N, int G_, int c_) { nM = M / BM; nN = N / BM; nwg = nM * nN; G = G_; c = c_; }
    __host__ __device__ bool next(int i, Unit& u) const {
        const long L = (long)i * G + c; if (L >= nwg) return false;
        int wgid = (int)L; { const int q = nwg / NXCD, r = nwg % NXCD, xcd = wgid % NXCD, off = wgid / NXCD; wgid = (xcd < r ? xcd * (q + 1) : r * (q + 1) + (xcd - r) * q) + off; }
        const int nig = WGM * nN, gid = wgid / nig, fm = gid * WGM, gsz = (nM - fm) < WGM ? (nM - fm) : WGM;
        u.pm = fm + ((wgid % nig) % gsz); u.pn = (wgid % nig) / gsz; return true;
    }
    __device__ __forceinline__ void a_ready(const Unit&) const {}
    __device__ __forceinline__ void done(const Unit&) const {}
};

__device__ __forceinline__ unsigned cvt_pk_bf16(float lo, float hi) { unsigned r; asm volatile("v_cvt_pk_bf16_f32 %0, %1, %2" : "=v"(r) : "v"(lo), "v"(hi)); return r; }
constexpr float RMS_EPS = 1e-6f;
struct EpiBf16S {
    static constexpr bool PERM = true, AFTER_DRAIN = false;
    bf16_t* O; int ldc; const float* ssq;
    __device__ __forceinline__ void operator()(const f32x4 (&acc)[2][2][4][2], const Unit& u, int wr, int wc, int fr, int fq) const {
        const int row0 = u.pm * BM + wr * 64 + fr; const int col0 = u.pn * BM + wc * 32 + 8 * fq;
#pragma unroll
        for (int ai = 0; ai < 2; ++ai)
#pragma unroll
            for (int m = 0; m < 4; ++m) { const int row = row0 + ai * HALF + m * 16; bf16_t* rowp = O + (size_t)row * ldc + col0;
                const float sc = ssq ? rsqrtf(ssq[row] * (1.0f / 1024.0f) + RMS_EPS) : 1.0f;
#pragma unroll
                for (int bj = 0; bj < 2; ++bj) { const f32x4 v0 = acc[ai][bj][m][0] * sc, v1 = acc[ai][bj][m][1] * sc;
                    u32x4 w; w.x = cvt_pk_bf16(v0[0], v0[1]); w.y = cvt_pk_bf16(v0[2], v0[3]); w.z = cvt_pk_bf16(v1[0], v1[1]); w.w = cvt_pk_bf16(v1[2], v1[3]);
                    *(u32x4*)(rowp + bj * HALF) = w; } }
    }
};
struct EpiResid {
    static constexpr bool PERM = false, AFTER_DRAIN = false;
    const float* base; float* out; bf16_t* xb; float* ssq; int ldc;
    __device__ __forceinline__ void operator()(const f32x4 (&acc)[2][2][4][2], const Unit& u, int wr, int wc, int fr, int fq) const {
        typedef unsigned u32x2v __attribute__((ext_vector_type(2)));
        const int col0 = u.pn * BM + wc * 32 + 4 * fq;
#pragma unroll
        for (int ai = 0; ai < 2; ++ai)
#pragma unroll
            for (int m = 0; m < 4; ++m) { const int row = u.pm * BM + ai * HALF + wr * 64 + m * 16 + fr; const size_t off = (size_t)row * ldc + col0; float s = 0.f;
#pragma unroll
                for (int bj = 0; bj < 2; ++bj)
#pragma unroll
                    for (int n = 0; n < 2; ++n) { const f32x4 v = acc[ai][bj][m][n] + *(const f32x4*)(base + off + bj * HALF + n * 16);
                        *(f32x4*)(out + off + bj * HALF + n * 16) = v; s += (v[0] * v[0] + v[1] * v[1]) + (v[2] * v[2] + v[3] * v[3]);
                        if (xb) { u32x2v w; w.x = cvt_pk_bf16(v[0], v[1]); w.y = cvt_pk_bf16(v[2], v[3]); *(u32x2v*)(xb + off + bj * HALF + n * 16) = w; } }
                if (ssq) { s += __shfl_xor(s, 16); s += __shfl_xor(s, 32); if (fq == 0) atomicAdd(ssq + row, s); }
                asm volatile("" ::: "memory"); }
    }
};

__device__ __forceinline__ float dpp_ror1(float v) { return __builtin_bit_cast(float, __builtin_amdgcn_update_dpp(0, __builtin_bit_cast(int, v), 0x121, 0xf, 0xf, false)); }
__device__ __forceinline__ float dpp_ror2(float v) { return __builtin_bit_cast(float, __builtin_amdgcn_update_dpp(0, __builtin_bit_cast(int, v), 0x122, 0xf, 0xf, false)); }
struct EpiConvGate {
    static constexpr bool PERM = true, AFTER_DRAIN = false;
    static constexpr size_t CG_SSQ = (1u << 20) + 768 * 1024, CG_ACT = (size_t)148 << 20, CG_YH = (size_t)236 << 20, CG_UPART = (size_t)240 << 20;
    unsigned char* ws; const float* fw; PG8_LAS unsigned char* ldsb;
    __device__ __forceinline__ void operator()(f32x4 (&acc)[2][2][4][2], const Unit& u, int wr, int wc, int fr0, int fq0) const {
        int fr = fr0, fq = fq0; asm volatile("" : "+v"(fr), "+v"(fq));
        bf16_t* ACT = (bf16_t*)(ws + CG_ACT); const float* ssq = (const float*)(ws + CG_SSQ); float* YH = (float*)(ws + CG_YH); float* UPART = (float*)(ws + CG_UPART);
        PG8_LAS float* halo = (PG8_LAS float*)(ldsb + STAGE_BYTES);
        int cl = wc * 32 + 8 * fq;
        int ch = u.pn * 128 + cl;
        if (fr >= 14) {
#pragma unroll
            for (int ai = 0; ai < 2; ++ai) { const float sc = rsqrtf(ssq[u.pm * BM + ai * HALF + wr * 64 + 48 + fr] * (1.0f / 1024.0f) + RMS_EPS);
#pragma unroll
                for (int bj = 0; bj < 2; ++bj)
#pragma unroll
                    for (int n = 0; n < 2; ++n) { const f32x4 v = acc[ai][bj][3][n] * sc; *(PG8_LAS f32x4*)(halo + (((wr * 2 + ai) * 2 + (fr - 14)) * 256 + bj * 128 + cl + 4 * n)) = v;
                        if (ai == 1 && wr == 1) *(f32x4*)(YH + ((size_t)(u.pm * 22 + u.pn) * 2 + (fr - 14)) * 256 + bj * 128 + cl + 4 * n) = v; } }
        }
        asm volatile("s_waitcnt lgkmcnt(0)" ::: "memory"); __builtin_amdgcn_s_barrier(); asm volatile("" ::: "memory");
        typedef unsigned u32x2v __attribute__((ext_vector_type(2)));
#pragma unroll 1
        for (int n = 0; n < 2; ++n) {
            asm volatile("" : "+v"(fr), "+v"(fq));
            cl = wc * 32 + 8 * fq; ch = u.pn * 128 + cl;
            f32x4 w[3][2];
#pragma unroll
            for (int i = 0; i < 3; ++i)
#pragma unroll
                for (int bj = 0; bj < 2; ++bj) w[i][bj] = *(const f32x4*)(fw + (size_t)i * 5632 + bj * 2816 + ch + 4 * n);
#pragma unroll
            for (int ai = 0; ai < 2; ++ai) {
                const bool top = (ai == 0 && wr == 0);
                const int pblk = (ai == 0) ? 0 : (wr == 0 ? 2 : 1);
                f32x4 q1[2], q2[2];
#pragma unroll
                for (int bj = 0; bj < 2; ++bj) { const f32x4 pv = top ? (f32x4){0.f, 0.f, 0.f, 0.f} : *(const PG8_LAS f32x4*)(halo + ((pblk * 2 + (fr & 1)) * 256 + bj * 128 + cl + 4 * n));
#pragma unroll
                    for (int k = 0; k < 4; ++k) { q1[bj][k] = dpp_ror1(pv[k]); q2[bj][k] = dpp_ror2(pv[k]); } }
#pragma unroll
                for (int m = 0; m < 4; ++m) {
                    const int row = u.pm * BM + ai * HALF + wr * 64 + m * 16 + fr; const float sc = rsqrtf(ssq[row] * (1.0f / 1024.0f) + RMS_EPS);
                    f32x4 cu[2];
#pragma unroll
                    for (int bj = 0; bj < 2; ++bj) { const f32x4 ya = (n == 0) ? acc[ai][bj][m][0] : acc[ai][bj][m][1];
#pragma unroll
                        for (int k = 0; k < 4; ++k) { const float y = ya[k] * sc;
                            const float a1 = dpp_ror1(y), a2 = dpp_ror2(y);
                            const float p1 = (fr == 0) ? q1[bj][k] : a1, p2 = (fr < 2) ? q2[bj][k] : a2;
                            cu[bj][k] = w[2][bj][k] * y + w[1][bj][k] * p1 + w[0][bj][k] * p2; q1[bj][k] = a1; q2[bj][k] = a2; } }
                    if (top && m == 0 && fr < 2 && (u.pm & 7) != 0) {
#pragma unroll
                        for (int bj = 0; bj < 2; ++bj) *(f32x4*)(UPART + ((size_t)(u.pm * 22 + u.pn) * 2 + fr) * 256 + bj * 128 + cl + 4 * n) = cu[bj];
                    }
                    u32x2v o;
#define PG8_SG(k_) (cu[0][k_] * __builtin_amdgcn_rcpf(1.0f + __expf(-cu[0][k_])) * cu[1][k_])
                    o.x = cvt_pk_bf16(PG8_SG(0), PG8_SG(1)); o.y = cvt_pk_bf16(PG8_SG(2), PG8_SG(3));
#undef PG8_SG
                    *(u32x2v*)(ACT + (size_t)row * 2816 + ch + 4 * n) = o;
                    asm volatile("" ::: "memory");
                }
            }
        }
        asm volatile("s_waitcnt lgkmcnt(0)" ::: "memory"); __builtin_amdgcn_s_barrier(); asm volatile("" ::: "memory");
    }
};
template <class Epi, class Sched, bool ALIGN_EPI = false, bool SP2 = false>
__device__ __forceinline__ void gemm_phase(PG8_LAS unsigned char* lds, const Gemm g, const Sched& S, const Epi& E) {
    const int tid = threadIdx.x, wid = __builtin_amdgcn_readfirstlane(tid >> 6), lane = tid & 63, wr = wid >> 2, wc = wid & 3, fr = lane & 15, fq = lane >> 4;
    const int K = g.K, nt = K / BK;
    unsigned voffA[2], voffB[2];
#pragma unroll
    for (int i = 0; i < 2; ++i) { int R, C; stage_rc(tid * 16 + i * 8192, R, C); const int Rb = Epi::PERM ? ((R & ~31) + perm32(R & 31)) : R;
        voffA[i] = (unsigned)(R * K + C) * 2u; voffB[i] = (unsigned)(Rb * K + C) * 2u; }
    const size_t kstep = (size_t)(BK * 2);
    const size_t hstep = (size_t)HALF * K * 2;
    const size_t tstep = 2 * hstep;
    const unsigned ldsw = (unsigned)wid * 1024u;
    const int aoff = lds_byte(wr * 64 + fr, fq * 8), boff = lds_byte(wc * 32 + fr, fq * 8);
#define PG8_SA(b, h) (((b) * 2 + (h)) * HTB)
#define PG8_SB(b, h) ((4 + (b) * 2 + (h)) * HTB)
#define PG8_STAGE(bufoff, gbase, voff) do { _Pragma("unroll") for (int _i = 0; _i < 2; ++_i) \
        __builtin_amdgcn_global_load_lds((const unsigned*)((const char*)(gbase) + (voff)[_i]), (PG8_LAS unsigned*)(lds + (bufoff) + ldsw + _i * 8192), 16, 0, 0); } while (0)
#define PG8_LDA(dst, b, h) do { _Pragma("unroll") for (int m = 0; m < 4; ++m) _Pragma("unroll") for (int k = 0; k < 2; ++k) dst[m][k] = *(const PG8_LAS bf16x8*)(lds + PG8_SA(b, h) + aoff + m * 2048 + k * 1024); } while (0)
#define PG8_LDB(dst, b, h) do { _Pragma("unroll") for (int n = 0; n < 2; ++n) _Pragma("unroll") for (int k = 0; k < 2; ++k) dst[n][k] = *(const PG8_LAS bf16x8*)(lds + PG8_SB(b, h) + boff + n * 2048 + k * 1024); } while (0)
#define PG8_MMA(ai, bj, At, Bt) do { __builtin_amdgcn_s_setprio(1); _Pragma("unroll") for (int m = 0; m < 4; ++m) _Pragma("unroll") for (int n = 0; n < 2; ++n) _Pragma("unroll") for (int k = 0; k < 2; ++k) \
        acc[ai][bj][m][n] = __builtin_amdgcn_mfma_f32_16x16x32_bf16(Bt[n][k], At[m][k], acc[ai][bj][m][n], 0, 0, 0); __builtin_amdgcn_s_setprio(0); } while (0)
#define PG8_WAIT_V(n) asm volatile("s_waitcnt vmcnt(" #n ")" ::: "memory")
#define PG8_WAIT_L(n) asm volatile("s_waitcnt lgkmcnt(" #n ")" ::: "memory")
#define PG8_BAR __builtin_amdgcn_s_barrier()
#define PG8_SCHED __builtin_amdgcn_sched_barrier(0)
    Unit cur, nxt; int ui = 0;
    if (!S.next(0, cur)) return;
    f32x4 acc[2][2][4][2];
#pragma unroll
    for (int a = 0; a < 2; ++a)
#pragma unroll
        for (int b = 0; b < 2; ++b)
#pragma unroll
            for (int m = 0; m < 4; ++m)
#pragma unroll
                for (int n = 0; n < 2; ++n) acc[a][b][m][n] = (f32x4){0.f, 0.f, 0.f, 0.f};
    bf16x8 At[4][2], B0[2][2], B1[2][2];
    const char* cA = (const char*)g.A + (size_t)cur.pm * tstep; const char* cB = (const char*)g.Bt + (size_t)cur.pn * tstep;
    S.a_ready(cur);
    if constexpr (SP2) {
        PG8_STAGE(PG8_SB(0, 0), cB, voffB); PG8_STAGE(PG8_SB(0, 1), cB + hstep, voffB); PG8_STAGE(PG8_SA(0, 0), cA, voffA); PG8_STAGE(PG8_SA(0, 1), cA + hstep, voffA);
        if (wr == 1) PG8_BAR;
        PG8_WAIT_V(2); PG8_BAR;
        PG8_STAGE(PG8_SB(1, 0), cB + kstep, voffB); PG8_STAGE(PG8_SA(1, 0), cA + kstep, voffA); PG8_STAGE(PG8_SB(1, 1), cB + hstep + kstep, voffB);
        PG8_WAIT_V(6); PG8_BAR;
    } else {
        PG8_STAGE(PG8_SB(0, 0), cB, voffB); PG8_STAGE(PG8_SA(0, 0), cA, voffA); PG8_STAGE(PG8_SB(0, 1), cB + hstep, voffB); PG8_STAGE(PG8_SA(0, 1), cA + hstep, voffA);
        if (wr == 1) PG8_BAR;
        PG8_WAIT_V(4); PG8_BAR;
        PG8_STAGE(PG8_SB(1, 0), cB + kstep, voffB); PG8_STAGE(PG8_SA(1, 0), cA + kstep, voffA); PG8_STAGE(PG8_SB(1, 1), cB + hstep + kstep, voffB);
        PG8_WAIT_V(6); PG8_BAR;
    }
    for (;;) {
        const bool has_next = S.next(ui + 1, nxt);
        const char* nA = has_next ? (const char*)g.A + (size_t)nxt.pm * tstep : cA; const char* nB = has_next ? (const char*)g.Bt + (size_t)nxt.pn * tstep : cB;
        for (int t = 0; t < nt; t += 2) {
            const bool last = (t == nt - 2);
            const char* a1 = cA + (size_t)(t + 1) * kstep;
            const char* a2 = last ? nA : cA + (size_t)(t + 2) * kstep; const char* b2 = last ? nB : cB + (size_t)(t + 2) * kstep;
            const char* a3 = a2 + kstep; const char* b3 = b2 + kstep;
            if (last && has_next) S.a_ready(nxt);
            if constexpr (SP2) {
            PG8_LDB(B0, 0, 0); PG8_LDB(B1, 0, 1); PG8_SCHED; PG8_LDA(At, 0, 0); PG8_STAGE(PG8_SA(1, 1), a1 + hstep, voffA);
            PG8_WAIT_V(8); PG8_WAIT_L(0); PG8_BAR; PG8_MMA(0, 0, At, B0); PG8_MMA(0, 1, At, B1); PG8_BAR; PG8_SCHED;
            PG8_LDA(At, 0, 1); PG8_STAGE(PG8_SB(0, 0), b2, voffB); PG8_STAGE(PG8_SB(0, 1), b2 + hstep, voffB); PG8_STAGE(PG8_SA(0, 0), a2, voffA);
            PG8_WAIT_V(8); PG8_WAIT_L(0); PG8_BAR; PG8_MMA(1, 0, At, B0); PG8_MMA(1, 1, At, B1); PG8_BAR; PG8_SCHED;
            PG8_LDB(B0, 1, 0); PG8_LDB(B1, 1, 1); PG8_SCHED; PG8_LDA(At, 1, 0); PG8_STAGE(PG8_SA(0, 1), a2 + hstep, voffA);
            PG8_WAIT_V(8); PG8_WAIT_L(0); PG8_BAR; PG8_MMA(0, 0, At, B0); PG8_MMA(0, 1, At, B1); PG8_BAR; PG8_SCHED;
            PG8_LDA(At, 1, 1); PG8_STAGE(PG8_SB(1, 0), b3, voffB); PG8_STAGE(PG8_SB(1, 1), b3 + hstep, voffB); PG8_STAGE(PG8_SA(1, 0), a3, voffA);
            PG8_WAIT_V(8); PG8_WAIT_L(0); PG8_BAR; PG8_MMA(1, 0, At, B0); PG8_MMA(1, 1, At, B1); PG8_BAR; PG8_SCHED;
            } else {
            PG8_LDB(B0, 0, 0); PG8_SCHED; PG8_LDA(At, 0, 0); PG8_STAGE(PG8_SA(1, 1), a1 + hstep, voffA);
            PG8_WAIT_L(8); PG8_BAR; PG8_WAIT_L(0); PG8_MMA(0, 0, At, B0); PG8_BAR; PG8_SCHED;
            PG8_LDB(B1, 0, 1); PG8_STAGE(PG8_SB(0, 0), b2, voffB);
            PG8_BAR; PG8_WAIT_L(0); PG8_MMA(0, 1, At, B1); PG8_BAR;
            PG8_LDA(At, 0, 1); PG8_STAGE(PG8_SA(0, 0), a2, voffA);
            PG8_BAR; PG8_WAIT_L(0); PG8_MMA(1, 0, At, B0); PG8_BAR; PG8_SCHED;
            PG8_STAGE(PG8_SB(0, 1), b2 + hstep, voffB);
            PG8_WAIT_V(6); PG8_BAR; PG8_MMA(1, 1, At, B1); PG8_BAR;
            PG8_LDB(B0, 1, 0); PG8_SCHED; PG8_LDA(At, 1, 0); PG8_STAGE(PG8_SA(0, 1), a2 + hstep, voffA);
            PG8_WAIT_L(8); PG8_BAR; PG8_WAIT_L(0); PG8_MMA(0, 0, At, B0); PG8_BAR; PG8_SCHED;
            PG8_LDB(B1, 1, 1); PG8_STAGE(PG8_SB(1, 0), b3, voffB);
            PG8_BAR; PG8_WAIT_L(0); PG8_MMA(0, 1, At, B1); PG8_BAR;
            PG8_LDA(At, 1, 1); PG8_STAGE(PG8_SA(1, 0), a3, voffA);
            PG8_BAR; PG8_WAIT_L(0); PG8_MMA(1, 0, At, B0); PG8_BAR; PG8_SCHED;
            PG8_STAGE(PG8_SB(1, 1), b3 + hstep, voffB);
            PG8_WAIT_V(6); PG8_BAR; PG8_MMA(1, 1, At, B1); PG8_BAR;
            }
        }
        if constexpr (ALIGN_EPI) { if (wr == 0) PG8_BAR; }
        if constexpr (!Epi::AFTER_DRAIN) { E(acc, cur, wr, wc, fr, fq); S.done(cur); }
        if (!has_next) break;
#pragma unroll
        for (int a = 0; a < 2; ++a)
#pragma unroll
            for (int b = 0; b < 2; ++b)
#pragma unroll
                for (int m = 0; m < 4; ++m)
#pragma unroll
                    for (int n = 0; n < 2; ++n) acc[a][b][m][n] = (f32x4){0.f, 0.f, 0.f, 0.f};
        cur = nxt; cA = nA; cB = nB; ++ui;
        if constexpr (ALIGN_EPI) { if (wr == 1) PG8_BAR; }
    }
    PG8_WAIT_V(0);
    if constexpr (!ALIGN_EPI) { if (wr == 0) PG8_BAR; }
    PG8_BAR;
    if constexpr (Epi::AFTER_DRAIN) { E.fused(acc, cur, wr, wc, fr, fq, lds, wid, lane); S.done(cur); }
#undef PG8_SA
#undef PG8_SB
#undef PG8_STAGE
#undef PG8_LDA
#undef PG8_LDB
#undef PG8_MMA
#undef PG8_WAIT_V
#undef PG8_WAIT_L
#undef PG8_BAR
#undef PG8_SCHED
}
}
#ifndef PG8_SP2
#define PG8_SP2 true
#endif
#ifndef PG8_ALIGN
#define PG8_ALIGN true
#endif
constexpr int NB = 8, SEQ = 2048, DM = 1024, M = NB * SEQ;
constexpr int GH = 4, GD = 128, GW = 512, AH = 8, AD = 64;
constexpr int INC = 3592, NP = 3584;
constexpr int DFF = 2816, NUP = 2 * DFF;
constexpr int PC_QA = 0, PC_KA = 512, PC_VA = 1024, PC_Z = 1536, PC_QB = 2048, PC_KB = 2560, PC_VB = 3072;
constexpr size_t MiB = 1u << 20;
constexpr size_t WS_CTL = 0, WS_AB = 1 * MiB, WS_SSQ = 1 * MiB + 768 * 1024, WS_WIN = 2 * MiB, WS_WOUT = 9 * MiB, WS_WUP = 11 * MiB, WS_WDN = 22 * MiB;
constexpr size_t WS_XN = 28 * MiB, WS_PROJ = 60 * MiB, WS_CAT = 172 * MiB, WS_OA = 204 * MiB, WS_Y = 60 * MiB, WS_ACT = 148 * MiB, WS_END = 256 * MiB;
using pg8::RMS_EPS;
constexpr size_t WS_YH = 236 * MiB, WS_UPART = 240 * MiB;
constexpr size_t WS_GE = WS_SSQ + 65536;
constexpr int GOPS_CHUNK = 57344;
constexpr int SCAN_BUF = GOPS_CHUNK + 16384;
constexpr int NWAVES = 8, NTHR = 512;
constexpr int LDS_BYTES = 155648;
#define LAS __attribute__((address_space(3)))
typedef unsigned short bf16;
typedef unsigned v4u __attribute__((ext_vector_type(4)));
typedef unsigned v2u __attribute__((ext_vector_type(2)));
typedef float f32x4 __attribute__((ext_vector_type(4)));
__device__ __forceinline__ float bf2f(unsigned b) { return __uint_as_float(b << 16); }
__device__ __forceinline__ float bflo(unsigned w) { return __uint_as_float(w << 16); }
__device__ __forceinline__ float bfhi(unsigned w) { return __uint_as_float(w & 0xffff0000u); }
__device__ __forceinline__ unsigned pk2(float lo, float hi) { return pg8::cvt_pk_bf16(lo, hi); }
__device__ __forceinline__ float wave_sum(float v) {
#pragma unroll
    for (int o = 1; o < 64; o <<= 1) v += __shfl_xor(v, o);
    return v;
}
__device__ __forceinline__ float silu_f(float x) { return x * __builtin_amdgcn_rcpf(1.0f + __expf(-x)); }
__device__ __forceinline__ float sigmoid_f(float x) { return __builtin_amdgcn_rcpf(1.0f + __expf(-x)); }
__device__ __forceinline__ float softplus_f(float x) { return x > 20.f ? x : log1pf(__expf(x)); }

struct Args { const float* in[13]; float* out; unsigned char* ws; int ph_lo, ph_hi, coop, pad; };

__device__ __forceinline__ void p0_transpose_item(const float* W, int ldw, int k0, int sn0, bf16* WT, int K, int dn0, const float* kscale, LAS float* scr, int lane) {
    float tv[32];
#pragma unroll
    for (int i = 0; i < 32; ++i) { const int kk = 2 * i + (lane >> 5); tv[i] = W[(size_t)(k0 + kk) * ldw + sn0 + (lane & 31)]; }
    if (kscale) {
#pragma unroll
        for (int i = 0; i < 32; ++i) tv[i] *= kscale[k0 + 2 * i + (lane >> 5)]; }
#pragma unroll
    for (int i = 0; i < 32; ++i) scr[(2 * i + (lane >> 5)) * 33 + (lane & 31)] = tv[i];
    asm volatile("s_waitcnt lgkmcnt(0)" ::: "memory");
    const int c = lane & 7;
#pragma unroll
    for (int j = 0; j < 4; ++j) { const int n = (lane >> 3) + 8 * j; const LAS float* s = scr + (8 * c) * 33 + n;
        v4u o; o.x = pk2(s[0 * 33], s[1 * 33]); o.y = pk2(s[2 * 33], s[3 * 33]); o.z = pk2(s[4 * 33], s[5 * 33]); o.w = pk2(s[6 * 33], s[7 * 33]);
        *(v4u*)(WT + (size_t)(dn0 + n) * K + k0 + 8 * c) = o; }
    asm volatile("s_waitcnt lgkmcnt(0)" ::: "memory");
}

__device__ __forceinline__ void p0_prologue(const Args& A, LAS unsigned char* lds, int tid, int lane, int wave) {
    const float* x = A.in[0]; const float* nw1 = A.in[1]; const float* w_in = A.in[2]; const float* w_out = A.in[7]; const float* nw2 = A.in[8];
    const float* w_up = A.in[9]; const float* w_dn = A.in[11];
    unsigned char* ws = A.ws;
    bf16* WIN = (bf16*)(ws + WS_WIN); bf16* WOUT = (bf16*)(ws + WS_WOUT); bf16* WUP = (bf16*)(ws + WS_WUP); bf16* WDN = (bf16*)(ws + WS_WDN);
    bf16* XN = (bf16*)(ws + WS_XN); float* AB = (float*)(ws + WS_AB); float* SSQ = (float*)(ws + WS_SSQ);
    LAS float* scr = (LAS float*)(lds + wave * 9216);
    LAS float* wab = (LAS float*)(lds + 73728);
    const int G = gridDim.x, gw = blockIdx.x * NWAVES + wave, NGW = G * NWAVES;
    for (int i = blockIdx.x * NTHR + tid; i < M; i += G * NTHR) SSQ[i] = 0.f;
    if (blockIdx.x == 0 && tid < 64) ((unsigned*)(ws + WS_CTL))[tid] = 0u;
    for (int idx = tid; idx < 8192; idx += NTHR) { const int k = idx >> 3, j = idx & 7; wab[j * 1024 + k] = nw1[k] * w_in[(size_t)k * INC + 2048 + j]; }
    constexpr int I_IN = 16 * (NP / 32);
    for (int it = gw; it < I_IN; it += NGW) { const int nblk = NP / 32, kb = it / nblk, nb = it % nblk, n0 = 32 * nb; p0_transpose_item(w_in, INC, 64 * kb, n0 + (n0 >= 2048 ? 8 : 0), WIN, DM, n0, nullptr, scr, lane); }
    __syncthreads();
    for (int m0 = gw; m0 < M; m0 += 2 * NGW) {
        const f32x4* nr = (const f32x4*)nw1 + lane;
        f32x4 v[2][4]; float s[2] = {0.f, 0.f};
#pragma unroll
        for (int rr = 0; rr < 2; ++rr) { const int m = min(m0 + rr * NGW, M - 1); const f32x4* xr = (const f32x4*)(x + (size_t)m * DM) + lane;
#pragma unroll
            for (int j = 0; j < 4; ++j) v[rr][j] = xr[64 * j]; }
#pragma unroll
        for (int rr = 0; rr < 2; ++rr)
#pragma unroll
            for (int j = 0; j < 4; ++j) s[rr] += (v[rr][j].x * v[rr][j].x + v[rr][j].y * v[rr][j].y) + (v[rr][j].z * v[rr][j].z + v[rr][j].w * v[rr][j].w);
#pragma unroll
        for (int rr = 0; rr < 2; ++rr) { const int m = m0 + rr * NGW; if (m >= M) break;
            const float rstd = rsqrtf(wave_sum(s[rr]) * (1.f / DM) + RMS_EPS);
            float ab[8];
#pragma unroll
            for (int q = 0; q < 8; ++q) { float a = 0.f;
#pragma unroll
                for (int j = 0; j < 4; ++j) { const f32x4 w = *(const LAS f32x4*)(wab + q * 1024 + 256 * j + 4 * lane); a += (v[rr][j].x * w.x + v[rr][j].y * w.y) + (v[rr][j].z * w.z + v[rr][j].w * w.w); }
                ab[q] = wave_sum(a) * rstd; }
            if (lane == 0) { *(f32x4*)(AB + (size_t)m * 8) = (f32x4){ab[0], ab[1], ab[2], ab[3]}; *(f32x4*)(AB + (size_t)m * 8 + 4) = (f32x4){ab[4], ab[5], ab[6], ab[7]}; }
            v2u* o8 = (v2u*)(XN + (size_t)m * DM) + lane;
#pragma unroll
            for (int j = 0; j < 4; ++j) { const f32x4 n = nr[64 * j]; v2u o; o.x = pk2(v[rr][j].x * rstd * n.x, v[rr][j].y * rstd * n.y); o.y = pk2(v[rr][j].z * rstd * n.z, v[rr][j].w * rstd * n.w); o8[64 * j] = o; }
        }
    }
}


__device__ __forceinline__ void convert_late_weights(const Args& A, LAS unsigned char* lds, int lane, int wave, int gw0, int ngw) {
    const float* w_out = A.in[7]; const float* nw2 = A.in[8]; const float* w_up = A.in[9]; const float* w_dn = A.in[11];
    bf16* WOUT = (bf16*)(A.ws + WS_WOUT); bf16* WUP = (bf16*)(A.ws + WS_WUP); bf16* WDN = (bf16*)(A.ws + WS_WDN);
    LAS float* scr = (LAS float*)(lds + wave * 9216);
    constexpr int I_OUT = 16 * 32, I_UP = 16 * (NUP / 32), I_DN = (DFF / 64) * 32;
    for (int it = gw0; it < I_OUT + I_UP + I_DN; it += ngw) {
        int r = it;
        if (r < I_OUT) { const int kb = r / 32, nb = r % 32; p0_transpose_item(w_out, DM, 64 * kb, 32 * nb, WOUT, DM, 32 * nb, nullptr, scr, lane); continue; } r -= I_OUT;
        if (r < I_UP) { const int nblk = NUP / 32, kb = r / nblk, nb = r % nblk, n0 = 32 * nb, pn = n0 >> 8, j0 = n0 & 255;
            const int s0 = (j0 < 128) ? (128 * pn + j0) : (DFF + 128 * pn + j0 - 128);
            p0_transpose_item(w_up, NUP, 64 * kb, s0, WUP, DM, n0, nw2, scr, lane); continue; } r -= I_UP;
        { const int kb = r / 32, nb = r % 32; p0_transpose_item(w_dn, DM, 64 * kb, 32 * nb, WDN, DFF, 32 * nb, nullptr, scr, lane); }
    }
}
__device__ __forceinline__ void gdn_simple(const Args& A, LAS unsigned char* lds, int tid, int lane, int wave) {
    const bf16* PROJ = (const bf16*)(A.ws + WS_PROJ); const float* AB = (const float*)(A.ws + WS_AB); float* OA = (float*)(A.ws + WS_OA);
    const float* cw = A.in[3]; const float* a_log = A.in[4]; const float* dt_bias = A.in[5];
    LAS float* qs = (LAS float*)lds; LAS float* ks = qs + 16 * 128; LAS float* vs = ks + 16 * 128; LAS float* av = vs + 16 * 128; LAS float* bv = av + 16;
    for (int task = blockIdx.x; task < NB * GH; task += gridDim.x) {
        const int b = task / GH, h = task % GH, v = tid >> 2, part = tid & 3;
        float S[32];
#pragma unroll
        for (int i = 0; i < 32; ++i) S[i] = 0.f;
        const float Ah = __expf(a_log[h]), dtb = dt_bias[h];
        for (int blk = 0; blk < SEQ / 16; ++blk) {
            const int t0 = blk * 16;
            for (int idx = tid; idx < 16 * 384; idx += NTHR) {
                const int tt = idx / 384, c = idx % 384, which = c >> 7, d = c & 127, col = which * 512 + h * 128 + d, t = t0 + tt;
                float acc = 0.f;
#pragma unroll
                for (int i = 0; i < 4; ++i) { const int ts = t - 3 + i; if (ts >= 0) acc += cw[i * 1536 + col] * bf2f(PROJ[(size_t)(b * SEQ + ts) * NP + col]); }
                qs[which * 2048 + tt * 128 + d] = silu_f(acc);
            }
            if (tid < 16) { const size_t row = (size_t)b * SEQ + t0 + tid; bv[tid] = sigmoid_f(AB[row * 8 + h]); av[tid] = __expf(-Ah * softplus_f(AB[row * 8 + 4 + h] + dtb)); }
            __syncthreads();
#pragma unroll
            for (int r = 0; r < 4; ++r) { const int row = 4 * wave + r; LAS float* arr = qs + row * 128;
                const float v0 = arr[lane], v1 = arr[lane + 64]; const float s = wave_sum(v0 * v0 + v1 * v1);
                const float sc = rsqrtf(s + RMS_EPS) * (row < 16 ? 0.08838834764831845f : 1.0f); arr[lane] = v0 * sc; arr[lane + 64] = v1 * sc; }
            __syncthreads();
            for (int tt = 0; tt < 16; ++tt) {
                const float a = av[tt], bt = bv[tt], vt = vs[tt * 128 + v];
                float kS = 0.f;
#pragma unroll
                for (int i = 0; i < 32; ++i) kS += ks[tt * 128 + 32 * part + i] * S[i];
                kS += __shfl_xor(kS, 1); kS += __shfl_xor(kS, 2);
                const float c = bt * (vt - a * kS); float o = 0.f;
#pragma unroll
                for (int i = 0; i < 32; ++i) { S[i] = a * S[i] + ks[tt * 128 + 32 * part + i] * c; o += qs[tt * 128 + 32 * part + i] * S[i]; }
                o += __shfl_xor(o, 1); o += __shfl_xor(o, 2);
                if (part == 0) OA[(size_t)(b * SEQ + t0 + tt) * GW + h * 128 + v] = o;
            }
            __syncthreads();
        }
    }
}


template <int J, int K, int N> struct SolveLd {
    static __device__ __forceinline__ void run(f32x4 (&l)[4], unsigned lbase) {
        if constexpr (K < N) { constexpr int t40 = ((J + 1) >> 2) << 2;
            asm volatile("ds_read_b128 %0, %1 offset:%2" : "=v"(l[K]) : "v"(lbase), "i"((J * 68 + t40 + 4 * K) * 4)); SolveLd<J, K + 1, N>::run(l, lbase); }
    }
};
template <int J> struct SolveCol16 {
    static __device__ __forceinline__ void run(float (&R)[16], unsigned lbase) {
        if constexpr (J < 15) {
            constexpr int t40 = ((J + 1) >> 2) << 2, nld = (16 - t40) >> 2;
            f32x4 l[4];
            SolveLd<J, 0, nld>::run(l, lbase);
            asm volatile("s_waitcnt lgkmcnt(0)" ::: "memory");
#pragma unroll
            for (int k = 0; k < nld; ++k) asm volatile("" : "+v"(l[k]));
#pragma unroll
            for (int k = 0; k < nld; ++k) {
#pragma unroll
                for (int e = 0; e < 4; ++e) if (t40 + 4 * k + e > J) R[t40 + 4 * k + e] += l[k][e] * R[J]; }
            SolveCol16<J + 1>::run(R, lbase);
        }
    }
};

typedef short bf16x8 __attribute__((ext_vector_type(8)));
__device__ __forceinline__ void gdn_prep(const Args& A, LAS unsigned char* lds, int tid0, int lane0, int wave) {
    const bf16* PROJ = (const bf16*)(A.ws + WS_PROJ); const float* AB = (const float*)(A.ws + WS_AB);
    const float* cw = A.in[3]; const float* a_log = A.in[4]; const float* dt_bias = A.in[5];
    unsigned char* UVF = A.ws + WS_XN; unsigned char* GOPS = (unsigned char*)A.out; float* GE = (float*)(A.ws + WS_GE);
    LAS float* Qs = (LAS float*)lds; LAS float* Ks = (LAS float*)(lds + 33792); LAS float* Vs = (LAS float*)(lds + 67584);
    LAS bf16* Qb = (LAS bf16*)(lds + 101376); LAS bf16* Kb = (LAS bf16*)(lds + 118784);
    LAS float* gcs = (LAS float*)(lds + 136192); LAS float* bts = gcs + 64; LAS float* egs = gcs + 128; LAS float* kes = gcs + 192;
    LAS float* LsT = (LAS float*)lds; LAS bf16* ATs = (LAS bf16*)(lds + 17408); LAS bf16* WKs = Kb;
#pragma unroll 1
    for (int task = blockIdx.x; task < NB * GH * 32; task += gridDim.x) {
        int tid = tid0, lane = lane0; asm volatile("" : "+v"(tid), "+v"(lane));
        const int fr = lane & 15, fq = lane >> 4;
        const int bh = task >> 5, n = task & 31, b = bh >> 2, h = bh & 3, t0 = 64 * n, row0 = b * SEQ + t0;
        unsigned char* gops = GOPS + (size_t)task * GOPS_CHUNK;
        for (int idx = tid; idx < 3072; idx += NTHR) {
            const int tt = idx / 48, c8 = idx % 48, which = c8 >> 4, d0 = (c8 & 15) * 8, col = which * 512 + h * 128 + d0;
            float acc[8];
#pragma unroll
            for (int e = 0; e < 8; ++e) acc[e] = 0.f;
#pragma unroll
            for (int i = 0; i < 4; ++i) { const int ts = t0 + tt - 3 + i; if (ts < 0) continue;
                const v4u w = *(const v4u*)(PROJ + (size_t)(b * SEQ + ts) * NP + col); const f32x4 c0 = *(const f32x4*)(cw + i * 1536 + col), c1 = *(const f32x4*)(cw + i * 1536 + col + 4);
                acc[0] += c0.x * bflo(w.x); acc[1] += c0.y * bfhi(w.x); acc[2] += c0.z * bflo(w.y); acc[3] += c0.w * bfhi(w.y);
                acc[4] += c1.x * bflo(w.z); acc[5] += c1.y * bfhi(w.z); acc[6] += c1.z * bflo(w.w); acc[7] += c1.w * bfhi(w.w); }
            LAS float* dst = (which == 0 ? Qs : (which == 1 ? Ks : Vs)) + tt * 132 + d0;
            *(LAS f32x4*)dst = (f32x4){silu_f(acc[0]), silu_f(acc[1]), silu_f(acc[2]), silu_f(acc[3])};
            *(LAS f32x4*)(dst + 4) = (f32x4){silu_f(acc[4]), silu_f(acc[5]), silu_f(acc[6]), silu_f(acc[7])};
        }
        if (wave == 0) {
            const size_t row = (size_t)row0 + lane; const float beta = sigmoid_f(AB[row * 8 + h]);
            float g = -__expf(a_log[h]) * softplus_f(AB[row * 8 + 4 + h] + dt_bias[h]);
#pragma unroll
            for (int o = 1; o < 64; o <<= 1) { const float t = __shfl_up(g, o); if (lane >= o) g += t; }
            const float glast = __shfl(g, 63);
            gcs[lane] = g; bts[lane] = beta; egs[lane] = __expf(g); kes[lane] = __expf(glast - g) * beta;
            if (lane == 63) GE[task] = __expf(g);
        }
        __syncthreads();
#pragma unroll 2
        for (int r = 0; r < 8; ++r) { const int row = 8 * wave + r;
            { const float v0 = Qs[row * 132 + lane], v1 = Qs[row * 132 + lane + 64]; const float sc = rsqrtf(wave_sum(v0 * v0 + v1 * v1) + RMS_EPS) * 0.08838834764831845f;
              Qb[row * 136 + lane] = (bf16)(pk2(v0 * sc, 0.f) & 0xffffu); Qb[row * 136 + lane + 64] = (bf16)(pk2(v1 * sc, 0.f) & 0xffffu); }
            { const float v0 = Ks[row * 132 + lane], v1 = Ks[row * 132 + lane + 64]; const float sc = rsqrtf(wave_sum(v0 * v0 + v1 * v1) + RMS_EPS);
              Ks[row * 132 + lane] = v0 * sc; Ks[row * 132 + lane + 64] = v1 * sc; Kb[row * 136 + lane] = (bf16)(pk2(v0 * sc, 0.f) & 0xffffu); Kb[row * 136 + lane + 64] = (bf16)(pk2(v1 * sc, 0.f) & 0xffffu); }
        }
        __syncthreads();
#pragma unroll 1
        for (int jb = wave; jb < 20; jb += 8) {
            const int kind = jb >= 10 ? 1 : 0, idx = jb - 10 * kind, ti = idx < 1 ? 0 : (idx < 3 ? 1 : (idx < 6 ? 2 : 3)), tj = idx - ti * (ti + 1) / 2;
            const LAS bf16* As = kind ? Qb : Kb; f32x4 d = (f32x4){0.f, 0.f, 0.f, 0.f};
#pragma unroll
            for (int ks = 0; ks < 4; ++ks) { const bf16x8 a = *(const LAS bf16x8*)(As + (16 * ti + fr) * 136 + 32 * ks + 8 * fq), bb = *(const LAS bf16x8*)(Kb + (16 * tj + fr) * 136 + 32 * ks + 8 * fq);
                d = __builtin_amdgcn_mfma_f32_16x16x32_bf16(a, bb, d, 0, 0, 0); }
            const int j = 16 * tj + fr; const float gj = gcs[j], bj = bts[j]; float val[4];
#pragma unroll
            for (int e = 0; e < 4; ++e) { const int t = 16 * ti + 4 * fq + e; const float x = d[e] * __expf(gcs[t] - gj) * bj; val[e] = (kind ? (t >= j) : (t > j)) ? x : 0.f; }
            if (kind == 0) *(LAS f32x4*)(LsT + j * 68 + 16 * ti + 4 * fq) = (f32x4){-val[0], -val[1], -val[2], -val[3]};
            else {
#pragma unroll
                for (int e = 0; e < 4; ++e) ATs[(16 * ti + 4 * fq + e) * 72 + j] = (bf16)(pk2(val[e], 0.f) & 0xffffu); }
        }
        __syncthreads();
        LAS float* Ti = (LAS float*)(lds + 26624);
        if (wave == 0) {
            const int I = lane >> 4, c = lane & 15; float x[16];
#pragma unroll
            for (int r = 0; r < 16; ++r) x[r] = (r == c) ? 1.0f : 0.0f;
            SolveCol16<0>::run(x, (unsigned)(uintptr_t)LsT + (unsigned)(I * (16 * 68 + 16) * 4));
#pragma unroll
            for (int r = 0; r < 16; ++r) Ti[(I * 16 + r) * 20 + c] = x[r];
        } else {
            const int rt = tid - 64;
            for (int q = rt; q < 1024; q += 448) { const int blk = q >> 6, l2 = q & 63, i = l2 & 15, f = l2 >> 4, mb = blk >> 2, ks = blk & 3, t = 16 * mb + i;
                const v2u p0 = *(const LAS v2u*)(Qb + t * 136 + 32 * ks + 4 * f), p1 = *(const LAS v2u*)(Qb + t * 136 + 32 * ks + 16 + 4 * f); const float eg = egs[t];
                v4u o; o.x = pk2(bflo(p0.x) * eg, bfhi(p0.x) * eg); o.y = pk2(bflo(p0.y) * eg, bfhi(p0.y) * eg); o.z = pk2(bflo(p1.x) * eg, bfhi(p1.x) * eg); o.w = pk2(bflo(p1.y) * eg, bfhi(p1.y) * eg);
                *(v4u*)(gops + 16384 + q * 16) = o; }
            for (int q = rt; q < 512; q += 448) { const int blk = q >> 6, l2 = q & 63, i = l2 & 15, f = l2 >> 4, mb = blk >> 1, ks2 = blk & 1, t = 16 * mb + i;
                v2u p0 = (v2u){0u, 0u}, p1 = (v2u){0u, 0u};
                if (2 * ks2 <= mb) p0 = *(const LAS v2u*)(ATs + t * 72 + 32 * ks2 + 4 * f);
                if (2 * ks2 + 1 <= mb) p1 = *(const LAS v2u*)(ATs + t * 72 + 32 * ks2 + 16 + 4 * f);
                *(v4u*)(gops + 32768 + q * 16) = (v4u){p0.x, p0.y, p1.x, p1.y}; }
            for (int q = rt; q < 1024; q += 448) { const int blk = q >> 6, l2 = q & 63, i = l2 & 15, f = l2 >> 4, dkb = blk >> 1, ks2 = blk & 1, dk = 16 * dkb + i; float v[8];
#pragma unroll
                for (int e2 = 0; e2 < 8; ++e2) { const int c = 32 * ks2 + 16 * (e2 >> 2) + 4 * f + (e2 & 3); v[e2] = Ks[c * 132 + dk] * kes[c]; }
                *(v4u*)(gops + 40960 + q * 16) = (v4u){pk2(v[0], v[1]), pk2(v[2], v[3]), pk2(v[4], v[5]), pk2(v[6], v[7])}; }
        }
        __syncthreads();
#pragma unroll 1
        for (int ct = 0; ct < 2; ++ct) {
            const int C = 2 * wave + ct; const bool isv = C < 8; const int col = isv ? 16 * C + fr : 16 * (C - 8) + fr;
            f32x4 X[4];
#pragma unroll
            for (int I = 0; I < 4; ++I) {
                f32x4 acc;
#pragma unroll
                for (int e2 = 0; e2 < 4; ++e2) { const int t = 16 * I + 4 * fq + e2; acc[e2] = isv ? Vs[t * 132 + col] : egs[t] * Ks[t * 132 + col]; }
#pragma unroll
                for (int J = 0; J < 4; ++J) if (J < I) {
#pragma unroll
                    for (int kk = 0; kk < 4; ++kk) acc = __builtin_amdgcn_mfma_f32_16x16x4f32(LsT[(16 * J + 4 * fq + kk) * 68 + 16 * I + fr], X[J][kk], acc, 0, 0, 0); }
                f32x4 xi = (f32x4){0.f, 0.f, 0.f, 0.f};
#pragma unroll
                for (int kk = 0; kk < 4; ++kk) xi = __builtin_amdgcn_mfma_f32_16x16x4f32(Ti[(I * 16 + fr) * 20 + 4 * fq + kk], acc[kk], xi, 0, 0, 0);
                X[I] = xi;
                if (isv) { v2u w; w.x = pk2(xi[0], xi[1]); w.y = pk2(xi[2], xi[3]); *(v2u*)(UVF + (size_t)task * 16384 + (size_t)((C * 4 + I) * 64 + lane) * 8) = w; }
                else {
#pragma unroll
                    for (int e2 = 0; e2 < 4; ++e2) WKs[(16 * I + 4 * fq + e2) * 136 + col] = (bf16)(pk2(xi[e2], 0.f) & 0xffffu); }
            }
        }
        __syncthreads();
        for (int q = tid; q < 1024; q += NTHR) { const int blk = q >> 6, l2 = q & 63, i = l2 & 15, f = l2 >> 4, mb = blk >> 2, ks = blk & 3, t = 16 * mb + i;
            const v2u p0 = *(const LAS v2u*)(WKs + t * 136 + 32 * ks + 4 * f), p1 = *(const LAS v2u*)(WKs + t * 136 + 32 * ks + 16 + 4 * f);
            *(v4u*)(gops + q * 16) = (v4u){p0.x, p0.y, p1.x, p1.y}; }
        __syncthreads();
    }
}

__device__ __forceinline__ bf16x8 pack8(const f32x4 a, const f32x4 b) {
    v4u w; w.x = pk2(a[0], a[1]); w.y = pk2(a[2], a[3]); w.z = pk2(b[0], b[1]); w.w = pk2(b[2], b[3]); return __builtin_bit_cast(bf16x8, w);
}
__device__ __forceinline__ void gdn_scan(const Args& A, LAS unsigned char* lds, int bh, int tid, int lane, int wave) {
    const int b = bh >> 2, h = bh & 3, fr = lane & 15, fq = lane >> 4, vs = wave;
    const unsigned char* gops = (const unsigned char*)A.out + (size_t)bh * 32 * GOPS_CHUNK;
    const unsigned char* uvf = A.ws + WS_XN + (size_t)bh * 32 * 16384; const float* GE = (const float*)(A.ws + WS_GE) + bh * 32;
    float* Op = (float*)(A.ws + WS_OA) + ((size_t)b * SEQ + 4 * fq) * GW + h * 128 + 16 * vs + fr;
    f32x4 S[8];
#pragma unroll
    for (int i = 0; i < 8; ++i) S[i] = (f32x4){0.f, 0.f, 0.f, 0.f};
    const float gev = GE[lane & 31];
#define SCAN_DMA(chunk, bufoff) do { _Pragma("unroll") for (int i_ = 0; i_ < 9; ++i_) { const int p_ = wave + 8 * i_; \
        const unsigned char* s_ = (p_ < 56) ? (gops + (size_t)(chunk) * GOPS_CHUNK + p_ * 1024) : (uvf + (size_t)(chunk) * 16384 + (p_ - 56) * 1024); \
        __builtin_amdgcn_global_load_lds((const unsigned*)(s_ + lane * 16), (LAS unsigned*)(lds + (bufoff) + p_ * 1024), 16, 0, 0); } } while (0)
    SCAN_DMA(0, 0); SCAN_DMA(1, SCAN_BUF);
    asm volatile("s_waitcnt vmcnt(0)" ::: "memory"); __syncthreads();
#pragma unroll 1
    for (int n = 0; n < 32; ++n) {
        const LAS unsigned char* cur = lds + (n & 1) * SCAN_BUF;
        const float ge = __builtin_bit_cast(float, __builtin_amdgcn_readlane(__builtin_bit_cast(int, gev), n));
        bf16x8 Sb[4];
#pragma unroll
        for (int ks = 0; ks < 4; ++ks) Sb[ks] = pack8(S[2 * ks], S[2 * ks + 1]);
        f32x4 u[4];
#pragma unroll
        for (int mb = 0; mb < 4; ++mb) { f32x4 p = (f32x4){0.f, 0.f, 0.f, 0.f};
#pragma unroll
            for (int ks = 0; ks < 4; ++ks) p = __builtin_amdgcn_mfma_f32_16x16x32_bf16(*(const LAS bf16x8*)(cur + ((mb * 4 + ks) * 64 + lane) * 16), Sb[ks], p, 0, 0, 0);
            const v2u uw = *(const LAS v2u*)(cur + GOPS_CHUNK + ((vs * 4 + mb) * 64 + lane) * 8);
            u[mb] = (f32x4){bflo(uw.x) - p[0], bfhi(uw.x) - p[1], bflo(uw.y) - p[2], bfhi(uw.y) - p[3]}; }
        bf16x8 ub[2]; ub[0] = pack8(u[0], u[1]); ub[1] = pack8(u[2], u[3]);
        f32x4 o[4];
#pragma unroll
        for (int mb = 0; mb < 4; ++mb) { f32x4 acc = (f32x4){0.f, 0.f, 0.f, 0.f};
#pragma unroll
            for (int ks = 0; ks < 4; ++ks) acc = __builtin_amdgcn_mfma_f32_16x16x32_bf16(*(const LAS bf16x8*)(cur + 16384 + ((mb * 4 + ks) * 64 + lane) * 16), Sb[ks], acc, 0, 0, 0);
#pragma unroll
            for (int ks2 = 0; ks2 < 2; ++ks2) if (ks2 <= (mb >> 1)) acc = __builtin_amdgcn_mfma_f32_16x16x32_bf16(*(const LAS bf16x8*)(cur + 32768 + ((mb * 2 + ks2) * 64 + lane) * 16), ub[ks2], acc, 0, 0, 0);
            o[mb] = acc; }
#pragma unroll
        for (int dkb = 0; dkb < 8; ++dkb) { f32x4 acc = S[dkb] * ge;
#pragma unroll
            for (int ks2 = 0; ks2 < 2; ++ks2) acc = __builtin_amdgcn_mfma_f32_16x16x32_bf16(*(const LAS bf16x8*)(cur + 40960 + ((dkb * 2 + ks2) * 64 + lane) * 16), ub[ks2], acc, 0, 0, 0);
            S[dkb] = acc; }
        asm volatile("s_waitcnt vmcnt(0)" ::: "memory"); __syncthreads();
        if (n + 2 < 32) SCAN_DMA(n + 2, (n & 1) * SCAN_BUF);
        float* orow = Op + (size_t)(64 * n) * GW;
#pragma unroll
        for (int mb = 0; mb < 4; ++mb) { float* q = orow + (size_t)(16 * mb) * GW; q[0] = o[mb][0]; q[GW] = o[mb][1]; q[2 * GW] = o[mb][2]; q[3 * GW] = o[mb][3]; }
    }
    asm volatile("s_waitcnt vmcnt(0)" ::: "memory"); __syncthreads();
#undef SCAN_DMA
}


__device__ __forceinline__ void attn_fast(const Args& A, LAS unsigned char* lds, int lane, int wave) {
    const bf16* PROJ = (const bf16*)(A.ws + WS_PROJ); bf16* CAT = (bf16*)(A.ws + WS_CAT);
    unsigned* ctr = (unsigned*)(A.ws + WS_CTL);
    LAS bf16* Vt = (LAS bf16*)(lds + wave * 8192);
    const int fr = lane & 15, fq = lane >> 4;
    const int kk = lane & 31, vslot = 8 * ((kk & 15) >> 2) + 4 * (kk >> 4) + (kk & 3), vch = lane >> 5;
    constexpr float SC = 0.125f * 1.4426950408889634f;
    for (;;) {
        unsigned wt_ = 0; if (lane == 0) wt_ = atomicAdd(ctr, 1u); const int wt = __builtin_amdgcn_readfirstlane(wt_);
        if (wt >= NB * AH * 8 * 16) break;
        const int T = 7 - (wt >> 10), rem = wt & 1023, b = rem >> 7, h = (rem >> 4) & 7, c = rem & 15, t0 = 256 * T;
        const bf16* Pb = PROJ + (size_t)b * SEQ * NP;
        const int tq = t0 + c + 16 * fr;
        bf16x8 qf[2];
#pragma unroll
        for (int ks = 0; ks < 2; ++ks) qf[ks] = *(const bf16x8*)(Pb + (size_t)tq * NP + PC_QB + h * 64 + 32 * ks + 8 * fq);
        const int lo2 = c, n2 = ((t0 + 240) >> 4) + 1, g2 = (n2 + 31) >> 5;
        const int lo1 = max(t0 + c - 512, c & 3), n1 = ((t0 + c + 240 - lo1) >> 2) + 1, g1 = (n1 + 31) >> 5;
        const int lo0 = max(t0 + c - 128, 0), n0 = (t0 + c + 240 - lo0) + 1, g0 = (n0 + 31) >> 5;
        const int NG = g2 + g1 + g0;
        f32x4 O[4];
#pragma unroll
        for (int i = 0; i < 4; ++i) O[i] = (f32x4){0.f, 0.f, 0.f, 0.f};
        float mrun = -INFINITY, lrun = 0.f;
        v4u kc[4], vc[4], kn[4], vn[4];
#define ATT_DEC(f, kst, str) do { if ((f) < g2) { str = 16; kst = lo2 + 512 * (f); } else if ((f) < g2 + g1) { str = 4; kst = lo1 + 128 * ((f) - g2); } else { str = 1; kst = lo0 + 32 * ((f) - g2 - g1); } } while (0)
#define ATT_LOAD(kreg, vreg, kst, str) do { \
            _Pragma("unroll") for (int j = 0; j < 2; ++j) { const int tk = min((kst) + (str) * (16 * j + fr), SEQ - 1); \
                _Pragma("unroll") for (int ks = 0; ks < 2; ++ks) kreg[2 * j + ks] = *(const v4u*)(Pb + (size_t)tk * NP + PC_KB + h * 64 + 32 * ks + 8 * fq); } \
            { const int tk = min((kst) + (str) * kk, SEQ - 1); \
                _Pragma("unroll") for (int i = 0; i < 4; ++i) vreg[i] = *(const v4u*)(Pb + (size_t)tk * NP + PC_VB + h * 64 + 8 * (vch + 2 * i)); } } while (0)
        int kst, str; ATT_DEC(0, kst, str); ATT_LOAD(kc, vc, kst, str);
#pragma unroll 1
        for (int f = 0; f < NG; ++f) {
            int kstn = 0, strn = 1;
            if (f + 1 < NG) { ATT_DEC(f + 1, kstn, strn); ATT_LOAD(kn, vn, kstn, strn); }
            f32x4 d0 = (f32x4){0.f, 0.f, 0.f, 0.f}, d1 = d0;
#pragma unroll
            for (int ks = 0; ks < 2; ++ks) { d0 = __builtin_amdgcn_mfma_f32_16x16x32_bf16(__builtin_bit_cast(bf16x8, kc[ks]), qf[ks], d0, 0, 0, 0);
                                             d1 = __builtin_amdgcn_mfma_f32_16x16x32_bf16(__builtin_bit_cast(bf16x8, kc[2 + ks]), qf[ks], d1, 0, 0, 0); }
#pragma unroll
            for (int i = 0; i < 4; ++i) { const int dd = 8 * (vch + 2 * i); const v4u w = vc[i];
                Vt[(dd + 0) * 40 + vslot] = (bf16)(w.x & 0xffffu); Vt[(dd + 1) * 40 + vslot] = (bf16)(w.x >> 16); Vt[(dd + 2) * 40 + vslot] = (bf16)(w.y & 0xffffu); Vt[(dd + 3) * 40 + vslot] = (bf16)(w.y >> 16);
                Vt[(dd + 4) * 40 + vslot] = (bf16)(w.z & 0xffffu); Vt[(dd + 5) * 40 + vslot] = (bf16)(w.z >> 16); Vt[(dd + 6) * 40 + vslot] = (bf16)(w.w & 0xffffu); Vt[(dd + 7) * 40 + vslot] = (bf16)(w.w >> 16); }
            float s[8]; const int span = 128 * str; float mloc = -INFINITY;
#pragma unroll
            for (int e = 0; e < 8; ++e) { const int tk = kst + str * (16 * (e >> 2) + 4 * fq + (e & 3)); const int dt = tq - tk; const float x = (e < 4 ? d0[e & 3] : d1[e & 3]) * SC;
                s[e] = (dt >= 0 && dt <= span) ? x : -INFINITY; mloc = fmaxf(mloc, s[e]); }
            mloc = fmaxf(mloc, __shfl_xor(mloc, 16)); mloc = fmaxf(mloc, __shfl_xor(mloc, 32));
            const float mnew = fmaxf(mrun, mloc), alpha = __builtin_amdgcn_exp2f(mrun - mnew); mrun = mnew;
            float psum = 0.f;
#pragma unroll
            for (int e = 0; e < 8; ++e) { s[e] = __builtin_amdgcn_exp2f(s[e] - mnew); psum += s[e]; }
            lrun = lrun * alpha + psum;
            const bf16x8 pb = pack8((f32x4){s[0], s[1], s[2], s[3]}, (f32x4){s[4], s[5], s[6], s[7]});
#pragma unroll
            for (int db = 0; db < 4; ++db) { const bf16x8 a = *(const LAS bf16x8*)(Vt + (16 * db + fr) * 40 + 8 * fq);
                O[db] = __builtin_amdgcn_mfma_f32_16x16x32_bf16(a, pb, O[db] * alpha, 0, 0, 0); }
#pragma unroll
            for (int i = 0; i < 4; ++i) { kc[i] = kn[i]; vc[i] = vn[i]; }
            kst = kstn; str = strn;
        }
#undef ATT_DEC
#undef ATT_LOAD
        lrun += __shfl_xor(lrun, 16); lrun += __shfl_xor(lrun, 32);
        const float inv = 1.0f / lrun;
        bf16* op = CAT + ((size_t)b * SEQ + tq) * DM + GW + h * 64 + 4 * fq;
#pragma unroll
        for (int db = 0; db < 4; ++db) { v2u w; w.x = pk2(O[db][0] * inv, O[db][1] * inv); w.y = pk2(O[db][2] * inv, O[db][3] * inv); *(v2u*)(op + 16 * db) = w; }
    }
}

__device__ __forceinline__ void attn_simple(const Args& A, int tid, int lane, int wave) {
    const bf16* PROJ = (const bf16*)(A.ws + WS_PROJ); bf16* CAT = (bf16*)(A.ws + WS_CAT);
    unsigned* ctr = (unsigned*)(A.ws + WS_CTL);
    for (;;) {
        unsigned wt_ = 0; if (lane == 0) wt_ = atomicAdd(ctr, 1u); const int wt = __builtin_amdgcn_readfirstlane(wt_);
        if (wt >= (M / 64) * AH) break;
        const int h = wt % AH, tb = wt / AH, row = tb * 64 + lane, b = row / SEQ, t = row % SEQ;
        float q[64], acc[64];
        { const v4u* qp = (const v4u*)(PROJ + (size_t)row * NP + PC_QB + h * 64);
#pragma unroll
          for (int j = 0; j < 8; ++j) { const v4u w = qp[j]; q[8 * j + 0] = bflo(w.x) * 0.125f; q[8 * j + 1] = bfhi(w.x) * 0.125f; q[8 * j + 2] = bflo(w.y) * 0.125f; q[8 * j + 3] = bfhi(w.y) * 0.125f;
              q[8 * j + 4] = bflo(w.z) * 0.125f; q[8 * j + 5] = bfhi(w.z) * 0.125f; q[8 * j + 6] = bflo(w.w) * 0.125f; q[8 * j + 7] = bfhi(w.w) * 0.125f; } }
#pragma unroll
        for (int j = 0; j < 64; ++j) acc[j] = 0.f;
        float mx = -1e30f, l = 0.f;
        for (int br = 0; br < 3; ++br) {
            const int stride = br == 0 ? 1 : (br == 1 ? 4 : 16);
            for (int i = 0; i <= 128; ++i) {
                const int tk = t - i * stride; if (tk < 0) break;
                const size_t krow = (size_t)(b * SEQ + tk) * NP;
                const v4u* kp = (const v4u*)(PROJ + krow + PC_KB + h * 64); const v4u* vp = (const v4u*)(PROJ + krow + PC_VB + h * 64);
                float s = 0.f;
#pragma unroll
                for (int j = 0; j < 8; ++j) { const v4u w = kp[j]; s += q[8 * j + 0] * bflo(w.x) + q[8 * j + 1] * bfhi(w.x) + q[8 * j + 2] * bflo(w.y) + q[8 * j + 3] * bfhi(w.y)
                                                                       + q[8 * j + 4] * bflo(w.z) + q[8 * j + 5] * bfhi(w.z) + q[8 * j + 6] * bflo(w.w) + q[8 * j + 7] * bfhi(w.w); }
                const float mn = fmaxf(mx, s), sc = __expf(mx - mn), p = __expf(s - mn); mx = mn; l = l * sc + p;
#pragma unroll
                for (int j = 0; j < 8; ++j) { const v4u w = vp[j];
                    acc[8 * j + 0] = acc[8 * j + 0] * sc + p * bflo(w.x); acc[8 * j + 1] = acc[8 * j + 1] * sc + p * bfhi(w.x); acc[8 * j + 2] = acc[8 * j + 2] * sc + p * bflo(w.y); acc[8 * j + 3] = acc[8 * j + 3] * sc + p * bfhi(w.y);
                    acc[8 * j + 4] = acc[8 * j + 4] * sc + p * bflo(w.z); acc[8 * j + 5] = acc[8 * j + 5] * sc + p * bfhi(w.z); acc[8 * j + 6] = acc[8 * j + 6] * sc + p * bflo(w.w); acc[8 * j + 7] = acc[8 * j + 7] * sc + p * bfhi(w.w); }
            }
        }
        const float inv = 1.0f / l; v4u* op = (v4u*)(CAT + (size_t)row * DM + GW + h * 64);
#pragma unroll
        for (int j = 0; j < 8; ++j) { v4u w; w.x = pk2(acc[8 * j] * inv, acc[8 * j + 1] * inv); w.y = pk2(acc[8 * j + 2] * inv, acc[8 * j + 3] * inv); w.z = pk2(acc[8 * j + 4] * inv, acc[8 * j + 5] * inv); w.w = pk2(acc[8 * j + 6] * inv, acc[8 * j + 7] * inv); op[j] = w; }
    }
}
__device__ __forceinline__ void gated_norm(const Args& A, int lane, int wave) {
    const bf16* PROJ = (const bf16*)(A.ws + WS_PROJ); bf16* CAT = (bf16*)(A.ws + WS_CAT); const float* OA = (const float*)(A.ws + WS_OA); const float* gw = A.in[6];
    const float w0 = gw[2 * lane], w1 = gw[2 * lane + 1];
    for (int wt = blockIdx.x * NWAVES + wave; wt < M * GH; wt += gridDim.x * NWAVES) {
        const int row = wt / GH, h = wt % GH;
        const float2 o = *(const float2*)(OA + (size_t)row * GW + h * 128 + 2 * lane);
        const unsigned zz = *(const unsigned*)(PROJ + (size_t)row * NP + PC_Z + h * 128 + 2 * lane);
        const float ms = wave_sum(o.x * o.x + o.y * o.y) * (1.0f / 128.0f), r = rsqrtf(ms + RMS_EPS);
        *(unsigned*)(CAT + (size_t)row * DM + h * 128 + 2 * lane) = pk2(o.x * r * w0 * silu_f(bflo(zz)), o.y * r * w1 * silu_f(bfhi(zz)));
    }
}

__device__ __forceinline__ void gated_norm_bh(const Args& A, int bh, int lane, int wave) {
    const int b = bh >> 2, h = bh & 3;
    const bf16* Zp = (const bf16*)(A.ws + WS_PROJ) + (size_t)b * SEQ * NP + PC_Z + h * 128 + 2 * lane; bf16* Cp = (bf16*)(A.ws + WS_CAT) + (size_t)b * SEQ * DM + h * 128 + 2 * lane;
    const float* Op = (const float*)(A.ws + WS_OA) + (size_t)b * SEQ * GW + h * 128 + 2 * lane; const float* gw = A.in[6];
    const float w0 = gw[2 * lane], w1 = gw[2 * lane + 1];
    __builtin_amdgcn_fence(__ATOMIC_ACQUIRE, "agent");
#pragma unroll 1
    for (int r0 = wave * 4; r0 < SEQ; r0 += NWAVES * 4) {
        float2 o[4]; unsigned zz[4];
#pragma unroll
        for (int i = 0; i < 4; ++i) { o[i] = *(const float2*)(Op + (size_t)(r0 + i) * GW); zz[i] = *(const unsigned*)(Zp + (size_t)(r0 + i) * NP); }
#pragma unroll
        for (int i = 0; i < 4; ++i) { const float ms = wave_sum(o[i].x * o[i].x + o[i].y * o[i].y) * (1.0f / 128.0f), r = rsqrtf(ms + RMS_EPS);
            *(unsigned*)(Cp + (size_t)(r0 + i) * DM) = pk2(o[i].x * r * w0 * silu_f(bflo(zz[i])), o[i].y * r * w1 * silu_f(bfhi(zz[i]))); }
    }
}
__device__ __forceinline__ void ffn_conv_half(const Args& A, int half, int tid) {
    const bf16* Y = (const bf16*)(A.ws + WS_Y); bf16* ACT = (bf16*)(A.ws + WS_ACT); const float* fw = A.in[10];
    constexpr int HC = DFF / 2;
    for (size_t it = (size_t)blockIdx.x * NTHR + tid; it < (size_t)M * (HC / 8); it += (size_t)gridDim.x * NTHR) {
        const int row = (int)(it / (HC / 8)), g8 = (int)(it % (HC / 8)), cl = g8 * 8, pn = cl >> 7, j = cl & 127, t = row % SEQ, ch = half * HC + cl;
        float ga[8], ua[8];
#pragma unroll
        for (int e = 0; e < 8; ++e) { ga[e] = 0.f; ua[e] = 0.f; }
#pragma unroll
        for (int i = 0; i < 3; ++i) { const int ts = t - 2 + i; if (ts < 0) continue;
            const bf16* yr = Y + (size_t)(row - 2 + i) * DFF + 256 * pn + j; const v4u g = *(const v4u*)yr, u = *(const v4u*)(yr + 128);
            const f32x4 wg0 = *(const f32x4*)(fw + i * NUP + ch), wg1 = *(const f32x4*)(fw + i * NUP + ch + 4), wu0 = *(const f32x4*)(fw + i * NUP + DFF + ch), wu1 = *(const f32x4*)(fw + i * NUP + DFF + ch + 4);
            ga[0] += wg0.x * bflo(g.x); ga[1] += wg0.y * bfhi(g.x); ga[2] += wg0.z * bflo(g.y); ga[3] += wg0.w * bfhi(g.y); ga[4] += wg1.x * bflo(g.z); ga[5] += wg1.y * bfhi(g.z); ga[6] += wg1.z * bflo(g.w); ga[7] += wg1.w * bfhi(g.w);
            ua[0] += wu0.x * bflo(u.x); ua[1] += wu0.y * bfhi(u.x); ua[2] += wu0.z * bflo(u.y); ua[3] += wu0.w * bfhi(u.y); ua[4] += wu1.x * bflo(u.z); ua[5] += wu1.y * bfhi(u.z); ua[6] += wu1.z * bflo(u.w); ua[7] += wu1.w * bfhi(u.w); }
        v4u o; o.x = pk2(silu_f(ga[0]) * ua[0], silu_f(ga[1]) * ua[1]); o.y = pk2(silu_f(ga[2]) * ua[2], silu_f(ga[3]) * ua[3]); o.z = pk2(silu_f(ga[4]) * ua[4], silu_f(ga[5]) * ua[5]); o.w = pk2(silu_f(ga[6]) * ua[6], silu_f(ga[7]) * ua[7]);
        *(v4u*)(ACT + (size_t)row * DFF + ch) = o;
    }
}

__device__ __forceinline__ void ffn_fixup(const Args& A, int tid) {
    const float* YH = (const float*)(A.ws + WS_YH); const float* UP = (const float*)(A.ws + WS_UPART); bf16* ACT = (bf16*)(A.ws + WS_ACT); const float* fw = A.in[10];
    for (int it = blockIdx.x * NTHR + tid; it < 64 * 22 * 2 * 128; it += gridDim.x * NTHR) {
        const int c = it & 127, r = (it >> 7) & 1, tile = it >> 8, pm = tile / 22, pn = tile % 22; if ((pm & 7) == 0) continue;
        const int ch = pn * 128 + c; const float* up = UP + ((size_t)tile * 2 + r) * 256; const float* yh = YH + (size_t)((pm - 1) * 22 + pn) * 2 * 256;
        float g = up[c], u = up[128 + c];
        const float wg0 = fw[ch], wg1 = fw[5632 + ch], wu0 = fw[2816 + ch], wu1 = fw[5632 + 2816 + ch];
        if (r == 0) { g += wg0 * yh[c] + wg1 * yh[256 + c]; u += wu0 * yh[128 + c] + wu1 * yh[256 + 128 + c]; }
        else { g += wg0 * yh[256 + c]; u += wu0 * yh[256 + 128 + c]; }
        ACT[(size_t)(pm * 256 + r) * DFF + ch] = (bf16)(pk2(silu_f(g) * u, 0.f) & 0xffffu);
    }
}
__device__ __forceinline__ void final_norm(const Args& A, int lane, int wave) {
    float* out = A.out; const float* fnw = A.in[12];
    for (int m = blockIdx.x * NWAVES + wave; m < M; m += gridDim.x * NWAVES) {
        f32x4* xr = (f32x4*)(out + (size_t)m * DM) + lane; const f32x4* nr = (const f32x4*)fnw + lane;
        f32x4 v[4]; float s = 0.f;
#pragma unroll
        for (int j = 0; j < 4; ++j) { v[j] = xr[64 * j]; s += (v[j].x * v[j].x + v[j].y * v[j].y) + (v[j].z * v[j].z + v[j].w * v[j].w); }
        const float rstd = rsqrtf(wave_sum(s) * (1.f / DM) + RMS_EPS);
#pragma unroll
        for (int j = 0; j < 4; ++j) { const f32x4 n = nr[64 * j]; xr[64 * j] = (f32x4){v[j].x * rstd * n.x, v[j].y * rstd * n.y, v[j].z * rstd * n.z, v[j].w * rstd * n.w}; }
    }
}

#define XB_TMO      128
#define XB_XCNT(j)  (256  + 64 * (j))
#define XB_XSUB(j)  (1280 + 64 * (j))
#define XB_XGEN(j)  (2304 + 64 * (j))
#define XB_TOP      3328
#define XB_TOPGEN   3392
#define XCD_BAR_WORDS 3456
#define XB_SPIN_CAP (1u << 18)

__device__ __forceinline__ unsigned xb_ld(unsigned* p)              { return __hip_atomic_load(p, __ATOMIC_RELAXED, __HIP_MEMORY_SCOPE_AGENT); }
__device__ __forceinline__ unsigned xb_add(unsigned* p, unsigned v) { return __hip_atomic_fetch_add(p, v, __ATOMIC_RELAXED, __HIP_MEMORY_SCOPE_AGENT); }
__device__ __forceinline__ unsigned xb_xcc_id() { return (unsigned)__builtin_amdgcn_s_getreg((3 << 11) | 20) & 0xFu; }
#define XB_SPIN(cond, bar) do { unsigned _sp = 0; while (cond) { __builtin_amdgcn_s_sleep(1); \
    if ((++_sp & 255u) == 0u) { if (xb_ld(&(bar)[XB_TMO])) break; if (_sp > XB_SPIN_CAP) { atomicAdd(&(bar)[XB_TMO], 1u); break; } } } } while (0)

struct XcdBarrier {
    unsigned* bar; unsigned x;
    volatile LAS unsigned* st;
};

__device__ __forceinline__ XcdBarrier xcd_barrier_post(unsigned* bar, volatile LAS unsigned* st) {
    XcdBarrier b; b.bar = bar; b.x = xb_xcc_id(); b.st = st;
    if (threadIdx.x == 0) (void)xb_add(&bar[XB_XCNT(b.x)], 1u);
    return b;
}
__device__ __forceinline__ void xcd_barrier_complete(unsigned* bar, unsigned x, unsigned& nloc, unsigned& nx) {
    const unsigned G = gridDim.x * gridDim.y * gridDim.z;
    unsigned sum, cnt, mine, sp = 0u;
    for (;;) {
        sum = 0u; cnt = 0u; mine = 0u;
#pragma unroll
        for (unsigned j = 0; j < 16; ++j) { const unsigned c = xb_ld(&bar[XB_XCNT(j)]); sum += c; cnt += (c > 0u) ? 1u : 0u; mine = (j == x) ? c : mine; }
        if (sum == G) break;
        __builtin_amdgcn_s_sleep(1);
        if ((++sp & 255u) == 0u) { if (xb_ld(&bar[XB_TMO])) break; if (sp > XB_SPIN_CAP) { atomicAdd(&bar[XB_TMO], 1u); break; } }
    }
    nloc = mine > 0u ? mine : 1u; nx = cnt > 0u ? cnt : 1u;
}

__device__ __forceinline__ void xcd_barrier(const XcdBarrier& b) {
    asm volatile("s_waitcnt vmcnt(0)" ::: "memory");
    __syncthreads();
    if (threadIdx.x == 0) {
        unsigned* bar = b.bar;
        __builtin_amdgcn_s_waitcnt(0);
        unsigned nloc = b.st[0], nx = b.st[1];
        if (nloc == 0u) { xcd_barrier_complete(bar, b.x, nloc, nx); b.st[0] = nloc; b.st[1] = nx; }
        const unsigned old = xb_add(&bar[XB_XSUB(b.x)], 1u);
        const unsigned gen = old / nloc;
        if (old + 1u == (gen + 1u) * nloc) {
            __builtin_amdgcn_fence(__ATOMIC_RELEASE, "agent");
            asm volatile("s_waitcnt vmcnt(0)" ::: "memory");
            const unsigned og = xb_add(&bar[XB_TOP], 1u);
            const unsigned tg = og / nx;
            if (og + 1u == (tg + 1u) * nx) xb_add(&bar[XB_TOPGEN], 1u);
            else XB_SPIN(xb_ld(&bar[XB_TOPGEN]) == tg, bar);
            __builtin_amdgcn_fence(__ATOMIC_ACQUIRE, "agent");
            xb_add(&bar[XB_XGEN(b.x)], 1u);
            asm volatile("s_waitcnt vmcnt(0)" ::: "memory");
        } else {
            XB_SPIN(xb_ld(&bar[XB_XGEN(b.x)]) == gen, bar);
            __builtin_amdgcn_fence(__ATOMIC_ACQUIRE, "agent");
            asm volatile("s_waitcnt vmcnt(0)" ::: "memory");
        }
    }
    __syncthreads();
}

constexpr int N_PHASES = 9;
__global__ void __launch_bounds__(NTHR, 2) mk_fwd(Args args) {
    extern __shared__ __attribute__((aligned(16))) unsigned char lds_raw[];
    LAS unsigned char* lds = (LAS unsigned char*)lds_raw;
    const int tid = threadIdx.x, lane = tid & 63, wave = __builtin_amdgcn_readfirstlane(tid >> 6);
    const int lo = args.ph_lo, hi = args.ph_hi;
    unsigned char* ws = args.ws;
    bf16* WIN = (bf16*)(ws + WS_WIN); bf16* WOUT = (bf16*)(ws + WS_WOUT); bf16* WUP = (bf16*)(ws + WS_WUP); bf16* WDN = (bf16*)(ws + WS_WDN);
    bf16* XN = (bf16*)(ws + WS_XN); bf16* PROJ = (bf16*)(ws + WS_PROJ); bf16* CAT = (bf16*)(ws + WS_CAT); bf16* Y = (bf16*)(ws + WS_Y); bf16* ACT = (bf16*)(ws + WS_ACT);
    float* SSQ = (float*)(ws + WS_SSQ);
#define IN(k) (lo <= (k) && (k) < hi)
#define SEAM(k) do { if (IN(k) && IN((k) + 1)) { if ((k) == 0) cg::this_grid().sync(); else xcd_barrier(bar); } } while (0)
    { volatile LAS unsigned* st = (volatile LAS unsigned*)(lds + LDS_BYTES - 64); if (tid < 2) st[tid] = 0u; }
    __syncthreads();
    XcdBarrier bar = xcd_barrier_post((unsigned*)(ws + WS_CTL) + 4096, (volatile LAS unsigned*)(lds + LDS_BYTES - 64));
    if (IN(0)) { p0_prologue(args, lds, tid, lane, wave); } SEAM(0);
    if (IN(1)) { pg8::Gemm g{XN, WIN, M, NP, DM}; pg8::StaticOrder S; S.init(M, NP, gridDim.x, blockIdx.x); pg8::EpiBf16S E{PROJ, NP, nullptr};
        pg8::gemm_phase<pg8::EpiBf16S, pg8::StaticOrder, PG8_ALIGN, PG8_SP2>(lds, g, S, E);
        { pg8::Unit u4; const bool idle4 = !S.next(3, u4); const int G = gridDim.x, nidle = (G == 256) ? 128 : G;
          if (G != 256) convert_late_weights(args, lds, lane, wave, blockIdx.x * NWAVES + wave, G * NWAVES);
          else if (idle4) convert_late_weights(args, lds, lane, wave, (blockIdx.x - 128) * NWAVES + wave, nidle * NWAVES); } } SEAM(1);
    if (IN(2)) { gdn_prep(args, lds, tid, lane, wave); } SEAM(2);
    if (IN(3)) { if (blockIdx.x < NB * GH) { gdn_scan(args, lds, blockIdx.x, tid, lane, wave); gated_norm_bh(args, blockIdx.x, lane, wave); } attn_fast(args, lds, lane, wave); } SEAM(3);
    if (IN(4)) { pg8::Gemm g{CAT, WOUT, M, DM, DM}; pg8::StaticOrder S; S.init(M, DM, gridDim.x, blockIdx.x); pg8::EpiResid E{args.in[0], args.out, XN, SSQ, DM};
        pg8::gemm_phase<pg8::EpiResid, pg8::StaticOrder, PG8_ALIGN, PG8_SP2>(lds, g, S, E); } SEAM(4);
    if (IN(5)) { pg8::Gemm g{XN, WUP, M, NUP, DM}; pg8::StaticOrder S; S.init(M, NUP, gridDim.x, blockIdx.x);
        static_assert(pg8::EpiConvGate::CG_SSQ == WS_SSQ && pg8::EpiConvGate::CG_ACT == WS_ACT && pg8::EpiConvGate::CG_YH == WS_YH && pg8::EpiConvGate::CG_UPART == WS_UPART, "d_ws map");
        pg8::EpiConvGate E{ws, args.in[10], lds};
        pg8::gemm_phase<pg8::EpiConvGate, pg8::StaticOrder, true, PG8_SP2>(lds, g, S, E); } SEAM(5);
    if (IN(6)) { ffn_fixup(args, tid); } SEAM(6);
    if (IN(7)) { pg8::Gemm g{ACT, WDN, M, DM, DFF}; pg8::StaticOrder S; S.init(M, DM, gridDim.x, blockIdx.x); pg8::EpiResid E{args.out, args.out, nullptr, nullptr, DM};
        pg8::gemm_phase<pg8::EpiResid, pg8::StaticOrder, PG8_ALIGN, PG8_SP2>(lds, g, S, E); } SEAM(7);
    if (IN(8)) { final_norm(args, lane, wave); }
#undef IN
#undef SEAM
}

#ifndef MK_ONE_LAUNCH
#define MK_ONE_LAUNCH 1
#endif
extern "C" void kernel_launch(void* const* d_in, const int* in_sizes, int n_in, void* d_out, int out_size, void* d_ws, size_t ws_size, hipStream_t stream) {
    static int grid = 0;
    if (grid == 0) {
        if (n_in != 13 || out_size != M * DM || ws_size < WS_END) { fprintf(stderr, "kernel_launch: unexpected shapes n_in %d out %d ws %zu\n", n_in, out_size, ws_size); grid = -1; return; }
        int dev = 0, cus = 0, per_cu = 0;
        hipGetDevice(&dev); hipDeviceGetAttribute(&cus, hipDeviceAttributeMultiprocessorCount, dev);
        hipFuncSetAttribute((const void*)mk_fwd, hipFuncAttributeMaxDynamicSharedMemorySize, LDS_BYTES);
        hipOccupancyMaxActiveBlocksPerMultiprocessor(&per_cu, (const void*)mk_fwd, NTHR, LDS_BYTES);
        (void)hipGetLastError();
        if (per_cu < 1) { fprintf(stderr, "kernel_launch: occupancy query says %d blocks per CU\n", per_cu); per_cu = 1; }
        grid = cus;
    }
    if (grid < 0) return;
    if (hipMemsetAsync((char*)d_ws + WS_CTL, 0, 65536, stream) != hipSuccess) { fprintf(stderr, "kernel_launch: memset failed\n"); return; }
    Args a{};
    for (int i = 0; i < 13; ++i) a.in[i] = (const float*)d_in[i];
    a.out = (float*)d_out; a.ws = (unsigned char*)d_ws;
#if MK_ONE_LAUNCH
    a.ph_lo = 0; a.ph_hi = N_PHASES; a.coop = 1;
    void* kargs[] = {&a};
    hipError_t e = hipLaunchCooperativeKernel((const void*)mk_fwd, dim3(grid), dim3(NTHR), kargs, LDS_BYTES, stream);
    if (e != hipSuccess) fprintf(stderr, "cooperative launch failed: %s (grid %d)\n", hipGetErrorString(e), grid);
#else
    for (int p = 0; p < N_PHASES; ++p) { a.ph_lo = p; a.ph_hi = p + 1; a.coop = 0; hipLaunchKernelGGL(mk_fwd, dim3(grid), dim3(NTHR), LDS_BYTES, stream, a); }
#endif
}
```

```cpp
#include <hip/hip_runtime.h>
#include <hip/hip_cooperative_groups.h>
#include <cstdio>
#include <cstdint>
namespace cg = cooperative_groups;
namespace pg8 {
#define PG8_LAS __attribute__((address_space(3)))
typedef unsigned short bf16_t;
typedef short bf16x8 __attribute__((ext_vector_type(8)));
typedef float f32x4 __attribute__((ext_vector_type(4)));
typedef unsigned u32x4 __attribute__((ext_vector_type(4)));
constexpr int BM = 256, BK = 64, HALF = 128, HTB = HALF * BK * 2  , STAGE_BYTES = 8 * HTB, NXCD = 8, WGM = 8;

__host__ __device__ __forceinline__ int lds_byte(int r, int c) { const int st = (r >> 4) * 2 + (c >> 5), rr = r & 15, cc = c & 31, ob = rr * 64 + cc * 2; return st * 1024 + (ob ^ (((ob >> 9) & 1) << 5)); }
__host__ __device__ __forceinline__ void stage_rc(int b, int& R, int& C) { const int st = b / 1024, sb = b % 1024, swz = sb ^ (((sb >> 9) & 1) << 5); R = (st >> 1) * 16 + swz / 64; C = (st & 1) * 32 + (swz % 64) / 2; }
__host__ __device__ __forceinline__ int perm32(int rho) { const int n = rho >> 4, i = rho & 15; return 8 * (i >> 2) + 4 * n + (i & 3); }

struct Unit { int pm, pn; };
struct Gemm { const bf16_t* A; const bf16_t* Bt; int M, N, K; };

struct StaticOrder {
    int nM, nN, nwg, G, c;
    __host__ __device__ void init(int M, int N, int G_, int c_) { nM = M / BM; nN = N / BM; nwg = nM * nN; G = G_; c = c_; }
    __host__ __device__ bool next(int i, Unit& u) const {
        const long L = (long)i * G + c; if (L >= nwg) return false;
        int wgid = (int)L; { const int q = nwg / NXCD, r = nwg % NXCD, xcd = wgid % NXCD, off = wgid / NXCD; wgid = (xcd < r ? xcd * (q + 1) : r * (q + 1) + (xcd - r) * q) + off; }
        const int nig = WGM * nN, gid = wgid / nig, fm = gid * WGM, gsz = (nM - fm) < WGM ? (nM - fm) : WGM;
        u.pm = fm + ((wgid % nig) % gsz); u.pn = (wgid % nig) / gsz; return true;
    }
    __device__ __forceinline__ void a_ready(const Unit&) const {}
    __device__ __forceinline__ void done(const Unit&) const {}
};

__device__ __forceinline__ unsigned cvt_pk_bf16(float lo, float hi) { unsigned r; asm volatile("v_cvt_pk_bf16_f32 %0, %1, %2" : "=v"(r) : "v"(lo), "v"(hi)); return r; }
constexpr float RMS_EPS = 1e-6f;
struct EpiBf16S {
    static constexpr bool PERM = true, AFTER_DRAIN = false;
    bf16_t* O; int ldc; const float* ssq;
    __device__ __forceinline__ void operator()(const f32x4 (&acc)[2][2][4][2], const Unit& u, int wr, int wc, int fr, int fq) const {
        const int row0 = u.pm * BM + wr * 64 + fr; const int col0 = u.pn * BM + wc * 32 + 8 * fq;
#pragma unroll
        for (int ai = 0; ai < 2; ++ai)
#pragma unroll
            for (int m = 0; m < 4; ++m) { const int row = row0 + ai * HALF + m * 16; bf16_t* rowp = O + (size_t)row * ldc + col0;
                const float sc = ssq ? rsqrtf(ssq[row] * (1.0f / 1024.0f) + RMS_EPS) : 1.0f;
#pragma unroll
                for (int bj = 0; bj < 2; ++bj) { const f32x4 v0 = acc[ai][bj][m][0] * sc, v1 = acc[ai][bj][m][1] * sc;
                    u32x4 w; w.x = cvt_pk_bf16(v0[0], v0[1]); w.y = cvt_pk_bf16(v0[2], v0[3]); w.z = cvt_pk_bf16(v1[0], v1[1]); w.w = cvt_pk_bf16(v1[2], v1[3]);
                    *(u32x4*)(rowp + bj * HALF) = w; } }
    }
};
struct EpiResid {
    static constexpr bool PERM = false, AFTER_DRAIN = false;
    const float* base; float* out; bf16_t* xb; float* ssq; int ldc;
    __device__ __forceinline__ void operator()(const f32x4 (&acc)[2][2][4][2], const Unit& u, int wr, int wc, int fr, int fq) const {
        typedef unsigned u32x2v __attribute__((ext_vector_type(2)));
        const int col0 = u.pn * BM + wc * 32 + 4 * fq;
#pragma unroll
        for (int ai = 0; ai < 2; ++ai) {
            f32x4 bv[4][2][2];
#pragma unroll
            for (int m = 0; m < 4; ++m) { const size_t off = (size_t)(u.pm * BM + ai * HALF + wr * 64 + m * 16 + fr) * ldc + col0;
#pragma unroll
                for (int bj = 0; bj < 2; ++bj)
#pragma unroll
                    for (int n = 0; n < 2; ++n) bv[m][bj][n] = *(const f32x4*)(base + off + bj * HALF + n * 16); }
#pragma unroll
            for (int m = 0; m < 4; ++m) { const int row = u.pm * BM + ai * HALF + wr * 64 + m * 16 + fr; const size_t off = (size_t)row * ldc + col0; float s = 0.f;
#pragma unroll
                for (int bj = 0; bj < 2; ++bj)
#pragma unroll
                    for (int n = 0; n < 2; ++n) { const f32x4 v = acc[ai][bj][m][n] + bv[m][bj][n];
                        *(f32x4*)(out + off + bj * HALF + n * 16) = v; s += (v[0] * v[0] + v[1] * v[1]) + (v[2] * v[2] + v[3] * v[3]);
                        if (xb) { u32x2v w; w.x = cvt_pk_bf16(v[0], v[1]); w.y = cvt_pk_bf16(v[2], v[3]); *(u32x2v*)(xb + off + bj * HALF + n * 16) = w; } }
                if (ssq) { s += __shfl_xor(s, 16); s += __shfl_xor(s, 32); if (fq == 0) atomicAdd(ssq + row, s); } }
            asm volatile("" ::: "memory");
        }
    }
};

__device__ __forceinline__ float dpp_ror1(float v) { return __builtin_bit_cast(float, __builtin_amdgcn_update_dpp(0, __builtin_bit_cast(int, v), 0x121, 0xf, 0xf, false)); }
__device__ __forceinline__ float dpp_ror2(float v) { return __builtin_bit_cast(float, __builtin_amdgcn_update_dpp(0, __builtin_bit_cast(int, v), 0x122, 0xf, 0xf, false)); }
struct EpiConvGate {
    static constexpr bool PERM = true, AFTER_DRAIN = false;
    static constexpr size_t CG_SSQ = (1u << 20) + 768 * 1024, CG_ACT = (size_t)148 << 20, CG_YH = (size_t)236 << 20, CG_UPART = (size_t)240 << 20;
    unsigned char* ws; const float* fw; PG8_LAS unsigned char* ldsb;
    __device__ __forceinline__ void operator()(f32x4 (&acc)[2][2][4][2], const Unit& u, int wr, int wc, int fr0, int fq0) const {
        int fr = fr0, fq = fq0; asm volatile("" : "+v"(fr), "+v"(fq));
        bf16_t* ACT = (bf16_t*)(ws + CG_ACT); const float* ssq = (const float*)(ws + CG_SSQ); float* YH = (float*)(ws + CG_YH); float* UPART = (float*)(ws + CG_UPART);
        PG8_LAS float* halo = (PG8_LAS float*)(ldsb + STAGE_BYTES);
        int cl = wc * 32 + 8 * fq;
        int ch = u.pn * 128 + cl;
        if (fr >= 14) {
#pragma unroll
            for (int ai = 0; ai < 2; ++ai) { const float sc = rsqrtf(ssq[u.pm * BM + ai * HALF + wr * 64 + 48 + fr] * (1.0f / 1024.0f) + RMS_EPS);
#pragma unroll
                for (int bj = 0; bj < 2; ++bj)
#pragma unroll
                    for (int n = 0; n < 2; ++n) { const f32x4 v = acc[ai][bj][3][n] * sc; *(PG8_LAS f32x4*)(halo + (((wr * 2 + ai) * 2 + (fr - 14)) * 256 + bj * 128 + cl + 4 * n)) = v;
                        if (ai == 1 && wr == 1) *(f32x4*)(YH + ((size_t)(u.pm * 22 + u.pn) * 2 + (fr - 14)) * 256 + bj * 128 + cl + 4 * n) = v; } }
        }
        asm volatile("s_waitcnt lgkmcnt(0)" ::: "memory"); __builtin_amdgcn_s_barrier(); asm volatile("" ::: "memory");
        typedef unsigned u32x2v __attribute__((ext_vector_type(2)));
#pragma unroll 1
        for (int n = 0; n < 2; ++n) {
            asm volatile("" : "+v"(fr), "+v"(fq));
            cl = wc * 32 + 8 * fq; ch = u.pn * 128 + cl;
            f32x4 w[3][2];
#pragma unroll
            for (int i = 0; i < 3; ++i)
#pragma unroll
                for (int bj = 0; bj < 2; ++bj) w[i][bj] = *(const f32x4*)(fw + (size_t)i * 5632 + bj * 2816 + ch + 4 * n);
#pragma unroll
            for (int ai = 0; ai < 2; ++ai) {
                const bool top = (ai == 0 && wr == 0);
                const int pblk = (ai == 0) ? 0 : (wr == 0 ? 2 : 1);
                f32x4 q1[2], q2[2];
#pragma unroll
                for (int bj = 0; bj < 2; ++bj) { const f32x4 pv = top ? (f32x4){0.f, 0.f, 0.f, 0.f} : *(const PG8_LAS f32x4*)(halo + ((pblk * 2 + (fr & 1)) * 256 + bj * 128 + cl + 4 * n));
#pragma unroll
                    for (int k = 0; k < 4; ++k) { q1[bj][k] = dpp_ror1(pv[k]); q2[bj][k] = dpp_ror2(pv[k]); } }
#pragma unroll
                for (int m = 0; m < 4; ++m) {
                    const int row = u.pm * BM + ai * HALF + wr * 64 + m * 16 + fr; const float sc = rsqrtf(ssq[row] * (1.0f / 1024.0f) + RMS_EPS);
                    f32x4 cu[2];
#pragma unroll
                    for (int bj = 0; bj < 2; ++bj) { const f32x4 ya = (n == 0) ? acc[ai][bj][m][0] : acc[ai][bj][m][1];
#pragma unroll
                        for (int k = 0; k < 4; ++k) { const float y = ya[k] * sc;
                            const float a1 = dpp_ror1(y), a2 = dpp_ror2(y);
                            const float p1 = (fr == 0) ? q1[bj][k] : a1, p2 = (fr < 2) ? q2[bj][k] : a2;
                            cu[bj][k] = w[2][bj][k] * y + w[1][bj][k] * p1 + w[0][bj][k] * p2; q1[bj][k] = a1; q2[bj][k] = a2; } }
                    if (top && m == 0 && fr < 2 && (u.pm & 7) != 0) {
#pragma unroll
                        for (int bj = 0; bj < 2; ++bj) *(f32x4*)(UPART + ((size_t)(u.pm * 22 + u.pn) * 2 + fr) * 256 + bj * 128 + cl + 4 * n) = cu[bj];
                    }
                    u32x2v o;
#define PG8_SG(k_) (cu[0][k_] * __builtin_amdgcn_rcpf(1.0f + __expf(-cu[0][k_])) * cu[1][k_])
                    o.x = cvt_pk_bf16(PG8_SG(0), PG8_SG(1)); o.y = cvt_pk_bf16(PG8_SG(2), PG8_SG(3));
#undef PG8_SG
                    *(u32x2v*)(ACT + (size_t)row * 2816 + ch + 4 * n) = o;
                    asm volatile("" ::: "memory");
                }
            }
        }
        asm volatile("s_waitcnt lgkmcnt(0)" ::: "memory"); __builtin_amdgcn_s_barrier(); asm volatile("" ::: "memory");
    }
};
template <class Epi, class Sched, bool ALIGN_EPI = false, bool SP2 = false>
__device__ __forceinline__ void gemm_phase(PG8_LAS unsigned char* lds, const Gemm g, const Sched& S, const Epi& E) {
    const int tid = threadIdx.x, wid = __builtin_amdgcn_readfirstlane(tid >> 6), lane = tid & 63, wr = wid >> 2, wc = wid & 3, fr = lane & 15, fq = lane >> 4;
    const int K = g.K, nt = K / BK;
    unsigned voffA[2], voffB[2];
#pragma unroll
    for (int i = 0; i < 2; ++i) { int R, C; stage_rc(tid * 16 + i * 8192, R, C); const int Rb = Epi::PERM ? ((R & ~31) + perm32(R & 31)) : R;
        voffA[i] = (unsigned)(R * K + C) * 2u; voffB[i] = (unsigned)(Rb * K + C) * 2u; }
    const size_t kstep = (size_t)(BK * 2);
    const size_t hstep = (size_t)HALF * K * 2;
    const size_t tstep = 2 * hstep;
    const unsigned ldsw = (unsigned)wid * 1024u;
    const int aoff = lds_byte(wr * 64 + fr, fq * 8), boff = lds_byte(wc * 32 + fr, fq * 8);
#define PG8_SA(b, h) (((b) * 2 + (h)) * HTB)
#define PG8_SB(b, h) ((4 + (b) * 2 + (h)) * HTB)
#define PG8_STAGE(bufoff, gbase, voff) do { _Pragma("unroll") for (int _i = 0; _i < 2; ++_i) \
        __builtin_amdgcn_global_load_lds((const unsigned*)((const char*)(gbase) + (voff)[_i]), (PG8_LAS unsigned*)(lds + (bufoff) + ldsw + _i * 8192), 16, 0, 0); } while (0)
#define PG8_LDA(dst, b, h) do { _Pragma("unroll") for (int m = 0; m < 4; ++m) _Pragma("unroll") for (int k = 0; k < 2; ++k) dst[m][k] = *(const PG8_LAS bf16x8*)(lds + PG8_SA(b, h) + aoff + m * 2048 + k * 1024); } while (0)
#define PG8_LDB(dst, b, h) do { _Pragma("unroll") for (int n = 0; n < 2; ++n) _Pragma("unroll") for (int k = 0; k < 2; ++k) dst[n][k] = *(const PG8_LAS bf16x8*)(lds + PG8_SB(b, h) + boff + n * 2048 + k * 1024); } while (0)
#define PG8_MMA(ai, bj, At, Bt) do { __builtin_amdgcn_s_setprio(1); _Pragma("unroll") for (int m = 0; m < 4; ++m) _Pragma("unroll") for (int n = 0; n < 2; ++n) _Pragma("unroll") for (int k = 0; k < 2; ++k) \
        acc[ai][bj][m][n] = __builtin_amdgcn_mfma_f32_16x16x32_bf16(Bt[n][k], At[m][k], acc[ai][bj][m][n], 0, 0, 0); __builtin_amdgcn_s_setprio(0); } while (0)
#define PG8_WAIT_V(n) asm volatile("s_waitcnt vmcnt(" #n ")" ::: "memory")
#define PG8_WAIT_L(n) asm volatile("s_waitcnt lgkmcnt(" #n ")" ::: "memory")
#define PG8_BAR __builtin_amdgcn_s_barrier()
#define PG8_SCHED __builtin_amdgcn_sched_barrier(0)
    Unit cur, nxt; int ui = 0;
    if (!S.next(0, cur)) return;
    f32x4 acc[2][2][4][2];
#pragma unroll
    for (int a = 0; a < 2; ++a)
#pragma unroll
        for (int b = 0; b < 2; ++b)
#pragma unroll
            for (int m = 0; m < 4; ++m)
#pragma unroll
                for (int n = 0; n < 2; ++n) acc[a][b][m][n] = (f32x4){0.f, 0.f, 0.f, 0.f};
    bf16x8 At[4][2], B0[2][2], B1[2][2];
    const char* cA = (const char*)g.A + (size_t)cur.pm * tstep; const char* cB = (const char*)g.Bt + (size_t)cur.pn * tstep;
    S.a_ready(cur);
    if constexpr (SP2) {
        PG8_STAGE(PG8_SB(0, 0), cB, voffB); PG8_STAGE(PG8_SB(0, 1), cB + hstep, voffB); PG8_STAGE(PG8_SA(0, 0), cA, voffA); PG8_STAGE(PG8_SA(0, 1), cA + hstep, voffA);
        if (wr == 1) PG8_BAR;
        PG8_WAIT_V(2); PG8_BAR;
        PG8_STAGE(PG8_SB(1, 0), cB + kstep, voffB); PG8_STAGE(PG8_SA(1, 0), cA + kstep, voffA); PG8_STAGE(PG8_SB(1, 1), cB + hstep + kstep, voffB);
        PG8_WAIT_V(6); PG8_BAR;
    } else {
        PG8_STAGE(PG8_SB(0, 0), cB, voffB); PG8_STAGE(PG8_SA(0, 0), cA, voffA); PG8_STAGE(PG8_SB(0, 1), cB + hstep, voffB); PG8_STAGE(PG8_SA(0, 1), cA + hstep, voffA);
        if (wr == 1) PG8_BAR;
        PG8_WAIT_V(4); PG8_BAR;
        PG8_STAGE(PG8_SB(1, 0), cB + kstep, voffB); PG8_STAGE(PG8_SA(1, 0), cA + kstep, voffA); PG8_STAGE(PG8_SB(1, 1), cB + hstep + kstep, voffB);
        PG8_WAIT_V(6); PG8_BAR;
    }
    for (;;) {
        const bool has_next = S.next(ui + 1, nxt);
        const char* nA = has_next ? (const char*)g.A + (size_t)nxt.pm * tstep : cA; const char* nB = has_next ? (const char*)g.Bt + (size_t)nxt.pn * tstep : cB;
        for (int t = 0; t < nt; t += 2) {
            const bool last = (t == nt - 2);
            const char* a1 = cA + (size_t)(t + 1) * kstep;
            const char* a2 = last ? nA : cA + (size_t)(t + 2) * kstep; const char* b2 = last ? nB : cB + (size_t)(t + 2) * kstep;
            const char* a3 = a2 + kstep; const char* b3 = b2 + kstep;
            if (last && has_next) S.a_ready(nxt);
            if constexpr (SP2) {
            PG8_LDB(B0, 0, 0); PG8_LDB(B1, 0, 1); PG8_SCHED; PG8_LDA(At, 0, 0); PG8_STAGE(PG8_SA(1, 1), a1 + hstep, voffA);
            PG8_WAIT_V(8); PG8_WAIT_L(0); PG8_BAR; PG8_MMA(0, 0, At, B0); PG8_MMA(0, 1, At, B1); PG8_BAR; PG8_SCHED;
            PG8_LDA(At, 0, 1); PG8_STAGE(PG8_SB(0, 0), b2, voffB); PG8_STAGE(PG8_SB(0, 1), b2 + hstep, voffB); PG8_STAGE(PG8_SA(0, 0), a2, voffA);
            PG8_WAIT_V(8); PG8_WAIT_L(0); PG8_BAR; PG8_MMA(1, 0, At, B0); PG8_MMA(1, 1, At, B1); PG8_BAR; PG8_SCHED;
            PG8_LDB(B0, 1, 0); PG8_LDB(B1, 1, 1); PG8_SCHED; PG8_LDA(At, 1, 0); PG8_STAGE(PG8_SA(0, 1), a2 + hstep, voffA);
            PG8_WAIT_V(8); PG8_WAIT_L(0); PG8_BAR; PG8_MMA(0, 0, At, B0); PG8_MMA(0, 1, At, B1); PG8_BAR; PG8_SCHED;
            PG8_LDA(At, 1, 1); PG8_STAGE(PG8_SB(1, 0), b3, voffB); PG8_STAGE(PG8_SB(1, 1), b3 + hstep, voffB); PG8_STAGE(PG8_SA(1, 0), a3, voffA);
            PG8_WAIT_V(8); PG8_WAIT_L(0); PG8_BAR; PG8_MMA(1, 0, At, B0); PG8_MMA(1, 1, At, B1); PG8_BAR; PG8_SCHED;
            } else {
            PG8_LDB(B0, 0, 0); PG8_SCHED; PG8_LDA(At, 0, 0); PG8_STAGE(PG8_SA(1, 1), a1 + hstep, voffA);
            PG8_WAIT_L(8); PG8_BAR; PG8_WAIT_L(0); PG8_MMA(0, 0, At, B0); PG8_BAR; PG8_SCHED;
            PG8_LDB(B1, 0, 1); PG8_STAGE(PG8_SB(0, 0), b2, voffB);
            PG8_BAR; PG8_WAIT_L(0); PG8_MMA(0, 1, At, B1); PG8_BAR;
            PG8_LDA(At, 0, 1); PG8_STAGE(PG8_SA(0, 0), a2, voffA);
            PG8_BAR; PG8_WAIT_L(0); PG8_MMA(1, 0, At, B0); PG8_BAR; PG8_SCHED;
            PG8_STAGE(PG8_SB(0, 1), b2 + hstep, voffB);
            PG8_WAIT_V(6); PG8_BAR; PG8_MMA(1, 1, At, B1); PG8_BAR;
            PG8_LDB(B0, 1, 0); PG8_SCHED; PG8_LDA(At, 1, 0); PG8_STAGE(PG8_SA(0, 1), a2 + hstep, voffA);
            PG8_WAIT_L(8); PG8_BAR; PG8_WAIT_L(0); PG8_MMA(0, 0, At, B0); PG8_BAR; PG8_SCHED;
            PG8_LDB(B1, 1, 1); PG8_STAGE(PG8_SB(1, 0), b3, voffB);
            PG8_BAR; PG8_WAIT_L(0); PG8_MMA(0, 1, At, B1); PG8_BAR;
            PG8_LDA(At, 1, 1); PG8_STAGE(PG8_SA(1, 0), a3, voffA);
            PG8_BAR; PG8_WAIT_L(0); PG8_MMA(1, 0, At, B0); PG8_BAR; PG8_SCHED;
            PG8_STAGE(PG8_SB(1, 1), b3 + hstep, voffB);
            PG8_WAIT_V(6); PG8_BAR; PG8_MMA(1, 1, At, B1); PG8_BAR;
            }
        }
        if constexpr (ALIGN_EPI) { if (wr == 0) PG8_BAR; }
        if constexpr (!Epi::AFTER_DRAIN) { E(acc, cur, wr, wc, fr, fq); S.done(cur); }
        if (!has_next) break;
#pragma unroll
        for (int a = 0; a < 2; ++a)
#pragma unroll
            for (int b = 0; b < 2; ++b)
#pragma unroll
                for (int m = 0; m < 4; ++m)
#pragma unroll
                    for (int n = 0; n < 2; ++n) acc[a][b][m][n] = (f32x4){0.f, 0.f, 0.f, 0.f};
        cur = nxt; cA = nA; cB = nB; ++ui;
        if constexpr (ALIGN_EPI) { if (wr == 1) PG8_BAR; }
    }
    PG8_WAIT_V(0);
    if constexpr (!ALIGN_EPI) { if (wr == 0) PG8_BAR; }
    PG8_BAR;
    if constexpr (Epi::AFTER_DRAIN) { E.fused(acc, cur, wr, wc, fr, fq, lds, wid, lane); S.done(cur); }
#undef PG8_SA
#undef PG8_SB
#undef PG8_STAGE
#undef PG8_LDA
#undef PG8_LDB
#undef PG8_MMA
#undef PG8_WAIT_V
#undef PG8_WAIT_L
#undef PG8_BAR
#undef PG8_SCHED
}
}
#ifndef PG8_SP2
#define PG8_SP2 true
#endif
#ifndef PG8_ALIGN
#define PG8_ALIGN true
#endif
constexpr int NB = 8, SEQ = 2048, DM = 1024, M = NB * SEQ;
constexpr int GH = 4, GD = 128, GW = 512, AH = 8, AD = 64;
constexpr int INC = 3592, NP = 3584;
constexpr int DFF = 2816, NUP = 2 * DFF;
constexpr int PC_QA = 0, PC_KA = 512, PC_VA = 1024, PC_Z = 1536, PC_QB = 2048, PC_KB = 2560, PC_VB = 3072;
constexpr size_t MiB = 1u << 20;
constexpr size_t WS_CTL = 0, WS_AB = 1 * MiB, WS_SSQ = 1 * MiB + 768 * 1024, WS_WIN = 2 * MiB, WS_WOUT = 9 * MiB, WS_WUP = 11 * MiB, WS_WDN = 22 * MiB;
constexpr size_t WS_XN = 28 * MiB, WS_PROJ = 60 * MiB, WS_CAT = 172 * MiB, WS_OA = 204 * MiB, WS_Y = 60 * MiB, WS_ACT = 148 * MiB, WS_END = 256 * MiB;
using pg8::RMS_EPS;
constexpr size_t WS_YH = 236 * MiB, WS_UPART = 240 * MiB;
constexpr size_t WS_GE = WS_SSQ + 65536;
constexpr int GOPS_CHUNK = 57344;
constexpr int SCAN_BUF = GOPS_CHUNK + 16384;
constexpr int NWAVES = 8, NTHR = 512;
constexpr int LDS_BYTES = 155648;
#define LAS __attribute__((address_space(3)))
typedef unsigned short bf16;
typedef unsigned v4u __attribute__((ext_vector_type(4)));
typedef unsigned v2u __attribute__((ext_vector_type(2)));
typedef float f32x4 __attribute__((ext_vector_type(4)));
__device__ __forceinline__ float bf2f(unsigned b) { return __uint_as_float(b << 16); }
__device__ __forceinline__ float bflo(unsigned w) { return __uint_as_float(w << 16); }
__device__ __forceinline__ float bfhi(unsigned w) { return __uint_as_float(w & 0xffff0000u); }
__device__ __forceinline__ unsigned pk2(float lo, float hi) { return pg8::cvt_pk_bf16(lo, hi); }
__device__ __forceinline__ float wave_sum(float v) {
#pragma unroll
    for (int o = 1; o < 64; o <<= 1) v += __shfl_xor(v, o);
    return v;
}
__device__ __forceinline__ float silu_f(float x) { return x * __builtin_amdgcn_rcpf(1.0f + __expf(-x)); }
__device__ __forceinline__ float sigmoid_f(float x) { return __builtin_amdgcn_rcpf(1.0f + __expf(-x)); }
__device__ __forceinline__ float softplus_f(float x) { return x > 20.f ? x : log1pf(__expf(x)); }

struct Args { const float* in[13]; float* out; unsigned char* ws; int ph_lo, ph_hi, coop, pad; };

__device__ __forceinline__ void p0_transpose_item(const float* W, int ldw, int k0, int sn0, bf16* WT, int K, int dn0, const float* kscale, LAS float* scr, int lane) {
    float tv[32];
#pragma unroll
    for (int i = 0; i < 32; ++i) { const int kk = 2 * i + (lane >> 5); tv[i] = W[(size_t)(k0 + kk) * ldw + sn0 + (lane & 31)]; }
    if (kscale) {
#pragma unroll
        for (int i = 0; i < 32; ++i) tv[i] *= kscale[k0 + 2 * i + (lane >> 5)]; }
#pragma unroll
    for (int i = 0; i < 32; ++i) scr[(2 * i + (lane >> 5)) * 33 + (lane & 31)] = tv[i];
    asm volatile("s_waitcnt lgkmcnt(0)" ::: "memory");
    const int c = lane & 7;
#pragma unroll
    for (int j = 0; j < 4; ++j) { const int n = (lane >> 3) + 8 * j; const LAS float* s = scr + (8 * c) * 33 + n;
        v4u o; o.x = pk2(s[0 * 33], s[1 * 33]); o.y = pk2(s[2 * 33], s[3 * 33]); o.z = pk2(s[4 * 33], s[5 * 33]); o.w = pk2(s[6 * 33], s[7 * 33]);
        *(v4u*)(WT + (size_t)(dn0 + n) * K + k0 + 8 * c) = o; }
    asm volatile("s_waitcnt lgkmcnt(0)" ::: "memory");
}

__device__ __forceinline__ void p0_prologue(const Args& A, LAS unsigned char* lds, int tid, int lane, int wave) {
    const float* x = A.in[0]; const float* nw1 = A.in[1]; const float* w_in = A.in[2]; const float* w_out = A.in[7]; const float* nw2 = A.in[8];
    const float* w_up = A.in[9]; const float* w_dn = A.in[11];
    unsigned char* ws = A.ws;
    bf16* WIN = (bf16*)(ws + WS_WIN); bf16* WOUT = (bf16*)(ws + WS_WOUT); bf16* WUP = (bf16*)(ws + WS_WUP); bf16* WDN = (bf16*)(ws + WS_WDN);
    bf16* XN = (bf16*)(ws + WS_XN); float* AB = (float*)(ws + WS_AB); float* SSQ = (float*)(ws + WS_SSQ);
    LAS float* scr = (LAS float*)(lds + wave * 9216);
    LAS float* wab = (LAS float*)(lds + 73728);
    const int G = gridDim.x, gw = blockIdx.x * NWAVES + wave, NGW = G * NWAVES;
    for (int i = blockIdx.x * NTHR + tid; i < M; i += G * NTHR) SSQ[i] = 0.f;
    if (blockIdx.x == 0 && tid < 64) ((unsigned*)(ws + WS_CTL))[tid] = 0u;
    for (int idx = tid; idx < 8192; idx += NTHR) { const int k = idx >> 3, j = idx & 7; wab[j * 1024 + k] = nw1[k] * w_in[(size_t)k * INC + 2048 + j]; }
    constexpr int I_IN = 16 * (NP / 32);
    for (int it = gw; it < I_IN; it += NGW) { const int nblk = NP / 32, kb = it / nblk, nb = it % nblk, n0 = 32 * nb; p0_transpose_item(w_in, INC, 64 * kb, n0 + (n0 >= 2048 ? 8 : 0), WIN, DM, n0, nullptr, scr, lane); }
    __syncthreads();
    for (int m0 = gw; m0 < M; m0 += 2 * NGW) {
        const f32x4* nr = (const f32x4*)nw1 + lane;
        f32x4 v[2][4]; float s[2] = {0.f, 0.f};
#pragma unroll
        for (int rr = 0; rr < 2; ++rr) { const int m = min(m0 + rr * NGW, M - 1); const f32x4* xr = (const f32x4*)(x + (size_t)m * DM) + lane;
#pragma unroll
            for (int j = 0; j < 4; ++j) v[rr][j] = xr[64 * j]; }
#pragma unroll
        for (int rr = 0; rr < 2; ++rr)
#pragma unroll
            for (int j = 0; j < 4; ++j) s[rr] += (v[rr][j].x * v[rr][j].x + v[rr][j].y * v[rr][j].y) + (v[rr][j].z * v[rr][j].z + v[rr][j].w * v[rr][j].w);
#pragma unroll
        for (int rr = 0; rr < 2; ++rr) { const int m = m0 + rr * NGW; if (m >= M) break;
            const float rstd = rsqrtf(wave_sum(s[rr]) * (1.f / DM) + RMS_EPS);
            float ab[8];
#pragma unroll
            for (int q = 0; q < 8; ++q) { float a = 0.f;
#pragma unroll
                for (int j = 0; j < 4; ++j) { const f32x4 w = *(const LAS f32x4*)(wab + q * 1024 + 256 * j + 4 * lane); a += (v[rr][j].x * w.x + v[rr][j].y * w.y) + (v[rr][j].z * w.z + v[rr][j].w * w.w); }
                ab[q] = wave_sum(a) * rstd; }
            if (lane == 0) { *(f32x4*)(AB + (size_t)m * 8) = (f32x4){ab[0], ab[1], ab[2], ab[3]}; *(f32x4*)(AB + (size_t)m * 8 + 4) = (f32x4){ab[4], ab[5], ab[6], ab[7]}; }
            v2u* o8 = (v2u*)(XN + (size_t)m * DM) + lane;
#pragma unroll
            for (int j = 0; j < 4; ++j) { const f32x4 n = nr[64 * j]; v2u o; o.x = pk2(v[rr][j].x * rstd * n.x, v[rr][j].y * rstd * n.y); o.y = pk2(v[rr][j].z * rstd * n.z, v[rr][j].w * rstd * n.w); o8[64 * j] = o; }
        }
    }
}


__device__ __forceinline__ void convert_late_weights(const Args& A, LAS unsigned char* lds, int lane, int wave, int gw0, int ngw) {
    const float* w_out = A.in[7]; const float* nw2 = A.in[8]; const float* w_up = A.in[9]; const float* w_dn = A.in[11];
    bf16* WOUT = (bf16*)(A.ws + WS_WOUT); bf16* WUP = (bf16*)(A.ws + WS_WUP); bf16* WDN = (bf16*)(A.ws + WS_WDN);
    LAS float* scr = (LAS float*)(lds + wave * 9216);
    constexpr int I_OUT = 16 * 32, I_UP = 16 * (NUP / 32), I_DN = (DFF / 64) * 32;
    for (int it = gw0; it < I_OUT + I_UP + I_DN; it += ngw) {
        int r = it;
        if (r < I_OUT) { const int kb = r / 32, nb = r % 32; p0_transpose_item(w_out, DM, 64 * kb, 32 * nb, WOUT, DM, 32 * nb, nullptr, scr, lane); continue; } r -= I_OUT;
        if (r < I_UP) { const int nblk = NUP / 32, kb = r / nblk, nb = r % nblk, n0 = 32 * nb, pn = n0 >> 8, j0 = n0 & 255;
            const int s0 = (j0 < 128) ? (128 * pn + j0) : (DFF + 128 * pn + j0 - 128);
            p0_transpose_item(w_up, NUP, 64 * kb, s0, WUP, DM, n0, nw2, scr, lane); continue; } r -= I_UP;
        { const int kb = r / 32, nb = r % 32; p0_transpose_item(w_dn, DM, 64 * kb, 32 * nb, WDN, DFF, 32 * nb, nullptr, scr, lane); }
    }
}
__device__ __forceinline__ void gdn_simple(const Args& A, LAS unsigned char* lds, int tid, int lane, int wave) {
    const bf16* PROJ = (const bf16*)(A.ws + WS_PROJ); const float* AB = (const float*)(A.ws + WS_AB); float* OA = (float*)(A.ws + WS_OA);
    const float* cw = A.in[3]; const float* a_log = A.in[4]; const float* dt_bias = A.in[5];
    LAS float* qs = (LAS float*)lds; LAS float* ks = qs + 16 * 128; LAS float* vs = ks + 16 * 128; LAS float* av = vs + 16 * 128; LAS float* bv = av + 16;
    for (int task = blockIdx.x; task < NB * GH; task += gridDim.x) {
        const int b = task / GH, h = task % GH, v = tid >> 2, part = tid & 3;
        float S[32];
#pragma unroll
        for (int i = 0; i < 32; ++i) S[i] = 0.f;
        const float Ah = __expf(a_log[h]), dtb = dt_bias[h];
        for (int blk = 0; blk < SEQ / 16; ++blk) {
            const int t0 = blk * 16;
            for (int idx = tid; idx < 16 * 384; idx += NTHR) {
                const int tt = idx / 384, c = idx % 384, which = c >> 7, d = c & 127, col = which * 512 + h * 128 + d, t = t0 + tt;
                float acc = 0.f;
#pragma unroll
                for (int i = 0; i < 4; ++i) { const int ts = t - 3 + i; if (ts >= 0) acc += cw[i * 1536 + col] * bf2f(PROJ[(size_t)(b * SEQ + ts) * NP + col]); }
                qs[which * 2048 + tt * 128 + d] = silu_f(acc);
            }
            if (tid < 16) { const size_t row = (size_t)b * SEQ + t0 + tid; bv[tid] = sigmoid_f(AB[row * 8 + h]); av[tid] = __expf(-Ah * softplus_f(AB[row * 8 + 4 + h] + dtb)); }
            __syncthreads();
#pragma unroll
            for (int r = 0; r < 4; ++r) { const int row = 4 * wave + r; LAS float* arr = qs + row * 128;
                const float v0 = arr[lane], v1 = arr[lane + 64]; const float s = wave_sum(v0 * v0 + v1 * v1);
                const float sc = rsqrtf(s + RMS_EPS) * (row < 16 ? 0.08838834764831845f : 1.0f); arr[lane] = v0 * sc; arr[lane + 64] = v1 * sc; }
            __syncthreads();
            for (int tt = 0; tt < 16; ++tt) {
                const float a = av[tt], bt = bv[tt], vt = vs[tt * 128 + v];
                float kS = 0.f;
#pragma unroll
                for (int i = 0; i < 32; ++i) kS += ks[tt * 128 + 32 * part + i] * S[i];
                kS += __shfl_xor(kS, 1); kS += __shfl_xor(kS, 2);
                const float c = bt * (vt - a * kS); float o = 0.f;
#pragma unroll
                for (int i = 0; i < 32; ++i) { S[i] = a * S[i] + ks[tt * 128 + 32 * part + i] * c; o += qs[tt * 128 + 32 * part + i] * S[i]; }
                o += __shfl_xor(o, 1); o += __shfl_xor(o, 2);
                if (part == 0) OA[(size_t)(b * SEQ + t0 + tt) * GW + h * 128 + v] = o;
            }
            __syncthreads();
        }
    }
}


template <int J, int K, int N> struct SolveLd {
    static __device__ __forceinline__ void run(f32x4 (&l)[4], unsigned lbase) {
        if constexpr (K < N) { constexpr int t40 = ((J + 1) >> 2) << 2;
            asm volatile("ds_read_b128 %0, %1 offset:%2" : "=v"(l[K]) : "v"(lbase), "i"((J * 68 + t40 + 4 * K) * 4)); SolveLd<J, K + 1, N>::run(l, lbase); }
    }
};
template <int J> struct SolveCol16 {
    static __device__ __forceinline__ void run(float (&R)[16], unsigned lbase) {
        if constexpr (J < 15) {
            constexpr int t40 = ((J + 1) >> 2) << 2, nld = (16 - t40) >> 2;
            f32x4 l[4];
            SolveLd<J, 0, nld>::run(l, lbase);
            asm volatile("s_waitcnt lgkmcnt(0)" ::: "memory");
#pragma unroll
            for (int k = 0; k < nld; ++k) asm volatile("" : "+v"(l[k]));
#pragma unroll
            for (int k = 0; k < nld; ++k) {
#pragma unroll
                for (int e = 0; e < 4; ++e) if (t40 + 4 * k + e > J) R[t40 + 4 * k + e] += l[k][e] * R[J]; }
            SolveCol16<J + 1>::run(R, lbase);
        }
    }
};

typedef short bf16x8 __attribute__((ext_vector_type(8)));
__device__ __forceinline__ void gdn_prep(const Args& A, LAS unsigned char* lds, int tid0, int lane0, int wave) {
    const bf16* PROJ = (const bf16*)(A.ws + WS_PROJ); const float* AB = (const float*)(A.ws + WS_AB);
    const float* cw = A.in[3]; const float* a_log = A.in[4]; const float* dt_bias = A.in[5];
    unsigned char* UVF = A.ws + WS_XN; unsigned char* GOPS = (unsigned char*)A.out; float* GE = (float*)(A.ws + WS_GE);
    LAS float* Qs = (LAS float*)lds; LAS float* Ks = (LAS float*)(lds + 33792); LAS float* Vs = (LAS float*)(lds + 67584);
    LAS bf16* Qb = (LAS bf16*)(lds + 101376); LAS bf16* Kb = (LAS bf16*)(lds + 118784);
    LAS float* gcs = (LAS float*)(lds + 136192); LAS float* bts = gcs + 64; LAS float* egs = gcs + 128; LAS float* kes = gcs + 192;
    LAS float* LsT = (LAS float*)lds; LAS bf16* ATs = (LAS bf16*)(lds + 17408); LAS bf16* WKs = Kb;
#pragma unroll 1
    for (int task = blockIdx.x; task < NB * GH * 32; task += gridDim.x) {
        int tid = tid0, lane = lane0; asm volatile("" : "+v"(tid), "+v"(lane));
        const int fr = lane & 15, fq = lane >> 4;
        const int bh = task >> 5, n = task & 31, b = bh >> 2, h = bh & 3, t0 = 64 * n, row0 = b * SEQ + t0;
        unsigned char* gops = GOPS + (size_t)task * GOPS_CHUNK;
        if (tid < 384) {
            const int c8 = tid % 48, run = tid / 48, which = c8 >> 4, d0 = (c8 & 15) * 8, col = which * 512 + h * 128 + d0;
            v4u rw[11];
#pragma unroll
            for (int r = 0; r < 11; ++r) { const int ts = t0 + 8 * run - 3 + r; rw[r] = (ts >= 0) ? *(const v4u*)(PROJ + (size_t)(b * SEQ + ts) * NP + col) : (v4u){0u, 0u, 0u, 0u}; }
            f32x4 cwa[4], cwb[4];
#pragma unroll
            for (int j = 0; j < 4; ++j) { cwa[j] = *(const f32x4*)(cw + j * 1536 + col); cwb[j] = *(const f32x4*)(cw + j * 1536 + col + 4); }
            LAS float* dstb = (which == 0 ? Qs : (which == 1 ? Ks : Vs)) + (8 * run) * 132 + d0;
#pragma unroll
            for (int i = 0; i < 8; ++i) {
                float acc[8];
#pragma unroll
                for (int e2 = 0; e2 < 8; ++e2) acc[e2] = 0.f;
#pragma unroll
                for (int j = 0; j < 4; ++j) { const v4u w = rw[i + j];
                    acc[0] += cwa[j].x * bflo(w.x); acc[1] += cwa[j].y * bfhi(w.x); acc[2] += cwa[j].z * bflo(w.y); acc[3] += cwa[j].w * bfhi(w.y);
                    acc[4] += cwb[j].x * bflo(w.z); acc[5] += cwb[j].y * bfhi(w.z); acc[6] += cwb[j].z * bflo(w.w); acc[7] += cwb[j].w * bfhi(w.w); }
                *(LAS f32x4*)(dstb + i * 132) = (f32x4){silu_f(acc[0]), silu_f(acc[1]), silu_f(acc[2]), silu_f(acc[3])};
                *(LAS f32x4*)(dstb + i * 132 + 4) = (f32x4){silu_f(acc[4]), silu_f(acc[5]), silu_f(acc[6]), silu_f(acc[7])};
            }
        }
        if (wave == 0) {
            const size_t row = (size_t)row0 + lane; const float beta = sigmoid_f(AB[row * 8 + h]);
            float g = -__expf(a_log[h]) * softplus_f(AB[row * 8 + 4 + h] + dt_bias[h]);
#pragma unroll
            for (int o = 1; o < 64; o <<= 1) { const float t = __shfl_up(g, o); if (lane >= o) g += t; }
            const float glast = __shfl(g, 63);
            gcs[lane] = g; bts[lane] = beta; egs[lane] = __expf(g); kes[lane] = __expf(glast - g) * beta;
            if (lane == 63) GE[task] = __expf(g);
        }
        __syncthreads();
#pragma unroll 2
        for (int r = 0; r < 8; ++r) { const int row = 8 * wave + r;
            { const float v0 = Qs[row * 132 + lane], v1 = Qs[row * 132 + lane + 64]; const float sc = rsqrtf(wave_sum(v0 * v0 + v1 * v1) + RMS_EPS) * 0.08838834764831845f;
              Qb[row * 136 + lane] = (bf16)(pk2(v0 * sc, 0.f) & 0xffffu); Qb[row * 136 + lane + 64] = (bf16)(pk2(v1 * sc, 0.f) & 0xffffu); }
            { const float v0 = Ks[row * 132 + lane], v1 = Ks[row * 132 + lane + 64]; const float sc = rsqrtf(wave_sum(v0 * v0 + v1 * v1) + RMS_EPS);
              Ks[row * 132 + lane] = v0 * sc; Ks[row * 132 + lane + 64] = v1 * sc; Kb[row * 136 + lane] = (bf16)(pk2(v0 * sc, 0.f) & 0xffffu); Kb[row * 136 + lane + 64] = (bf16)(pk2(v1 * sc, 0.f) & 0xffffu); }
        }
        __syncthreads();
#pragma unroll 1
        for (int jb = wave; jb < 20; jb += 8) {
            const int kind = jb >= 10 ? 1 : 0, idx = jb - 10 * kind, ti = idx < 1 ? 0 : (idx < 3 ? 1 : (idx < 6 ? 2 : 3)), tj = idx - ti * (ti + 1) / 2;
            const LAS bf16* As = kind ? Qb : Kb; f32x4 d = (f32x4){0.f, 0.f, 0.f, 0.f};
#pragma unroll
            for (int ks = 0; ks < 4; ++ks) { const bf16x8 a = *(const LAS bf16x8*)(As + (16 * ti + fr) * 136 + 32 * ks + 8 * fq), bb = *(const LAS bf16x8*)(Kb + (16 * tj + fr) * 136 + 32 * ks + 8 * fq);
                d = __builtin_amdgcn_mfma_f32_16x16x32_bf16(a, bb, d, 0, 0, 0); }
            const int j = 16 * tj + fr; const float gj = gcs[j], bj = bts[j]; float val[4];
#pragma unroll
            for (int e = 0; e < 4; ++e) { const int t = 16 * ti + 4 * fq + e; const float x = d[e] * __expf(gcs[t] - gj) * bj; val[e] = (kind ? (t >= j) : (t > j)) ? x : 0.f; }
            if (kind == 0) *(LAS f32x4*)(LsT + j * 68 + 16 * ti + 4 * fq) = (f32x4){-val[0], -val[1], -val[2], -val[3]};
            else {
#pragma unroll
                for (int e = 0; e < 4; ++e) ATs[(16 * ti + 4 * fq + e) * 72 + j] = (bf16)(pk2(val[e], 0.f) & 0xffffu); }
        }
        __syncthreads();
        LAS float* Ti = (LAS float*)(lds + 26624);
        if (wave == 0) {
            const int I = lane >> 4, c = lane & 15; float x[16];
#pragma unroll
            for (int r = 0; r < 16; ++r) x[r] = (r == c) ? 1.0f : 0.0f;
            SolveCol16<0>::run(x, (unsigned)(uintptr_t)LsT + (unsigned)(I * (16 * 68 + 16) * 4));
#pragma unroll
            for (int r = 0; r < 16; ++r) Ti[(I * 16 + r) * 20 + c] = x[r];
        } else {
            const int rt = tid - 64;
            for (int q = rt; q < 1024; q += 448) { const int blk = q >> 6, l2 = q & 63, i = l2 & 15, f = l2 >> 4, mb = blk >> 2, ks = blk & 3, t = 16 * mb + i;
                const v2u p0 = *(const LAS v2u*)(Qb + t * 136 + 32 * ks + 4 * f), p1 = *(const LAS v2u*)(Qb + t * 136 + 32 * ks + 16 + 4 * f); const float eg = egs[t];
                v4u o; o.x = pk2(bflo(p0.x) * eg, bfhi(p0.x) * eg); o.y = pk2(bflo(p0.y) * eg, bfhi(p0.y) * eg); o.z = pk2(bflo(p1.x) * eg, bfhi(p1.x) * eg); o.w = pk2(bflo(p1.y) * eg, bfhi(p1.y) * eg);
                *(v4u*)(gops + 16384 + q * 16) = o; }
            for (int q = rt; q < 512; q += 448) { const int blk = q >> 6, l2 = q & 63, i = l2 & 15, f = l2 >> 4, mb = blk >> 1, ks2 = blk & 1, t = 16 * mb + i;
                v2u p0 = (v2u){0u, 0u}, p1 = (v2u){0u, 0u};
                if (2 * ks2 <= mb) p0 = *(const LAS v2u*)(ATs + t * 72 + 32 * ks2 + 4 * f);
                if (2 * ks2 + 1 <= mb) p1 = *(const LAS v2u*)(ATs + t * 72 + 32 * ks2 + 16 + 4 * f);
                *(v4u*)(gops + 32768 + q * 16) = (v4u){p0.x, p0.y, p1.x, p1.y}; }
            for (int q = rt; q < 1024; q += 448) { const int blk = q >> 6, l2 = q & 63, i = l2 & 15, f = l2 >> 4, dkb = blk >> 1, ks2 = blk & 1, dk = 16 * dkb + i; float v[8];
#pragma unroll
                for (int e2 = 0; e2 < 8; ++e2) { const int c = 32 * ks2 + 16 * (e2 >> 2) + 4 * f + (e2 & 3); v[e2] = Ks[c * 132 + dk] * kes[c]; }
                *(v4u*)(gops + 40960 + q * 16) = (v4u){pk2(v[0], v[1]), pk2(v[2], v[3]), pk2(v[4], v[5]), pk2(v[6], v[7])}; }
        }
        __syncthreads();
#pragma unroll 1
        for (int ct = 0; ct < 2; ++ct) {
            const int C = 2 * wave + ct; const bool isv = C < 8; const int col = isv ? 16 * C + fr : 16 * (C - 8) + fr;
            f32x4 X[4];
#pragma unroll
            for (int I = 0; I < 4; ++I) {
                f32x4 acc;
#pragma unroll
                for (int e2 = 0; e2 < 4; ++e2) { const int t = 16 * I + 4 * fq + e2; acc[e2] = isv ? Vs[t * 132 + col] : egs[t] * Ks[t * 132 + col]; }
#pragma unroll
                for (int J = 0; J < 4; ++J) if (J < I) {
#pragma unroll
                    for (int kk = 0; kk < 4; ++kk) acc = __builtin_amdgcn_mfma_f32_16x16x4f32(LsT[(16 * J + 4 * fq + kk) * 68 + 16 * I + fr], X[J][kk], acc, 0, 0, 0); }
                f32x4 xi = (f32x4){0.f, 0.f, 0.f, 0.f};
#pragma unroll
                for (int kk = 0; kk < 4; ++kk) xi = __builtin_amdgcn_mfma_f32_16x16x4f32(Ti[(I * 16 + fr) * 20 + 4 * fq + kk], acc[kk], xi, 0, 0, 0);
                X[I] = xi;
                if (isv) { v2u w; w.x = pk2(xi[0], xi[1]); w.y = pk2(xi[2], xi[3]); *(v2u*)(UVF + (size_t)task * 16384 + (size_t)((C * 4 + I) * 64 + lane) * 8) = w; }
                else {
#pragma unroll
                    for (int e2 = 0; e2 < 4; ++e2) WKs[(16 * I + 4 * fq + e2) * 136 + col] = (bf16)(pk2(xi[e2], 0.f) & 0xffffu); }
            }
        }
        __syncthreads();
        for (int q = tid; q < 1024; q += NTHR) { const int blk = q >> 6, l2 = q & 63, i = l2 & 15, f = l2 >> 4, mb = blk >> 2, ks = blk & 3, t = 16 * mb + i;
            const v2u p0 = *(const LAS v2u*)(WKs + t * 136 + 32 * ks + 4 * f), p1 = *(const LAS v2u*)(WKs + t * 136 + 32 * ks + 16 + 4 * f);
            *(v4u*)(gops + q * 16) = (v4u){p0.x, p0.y, p1.x, p1.y}; }
        __syncthreads();
    }
}

__device__ __forceinline__ bf16x8 pack8(const f32x4 a, const f32x4 b) {
    v4u w; w.x = pk2(a[0], a[1]); w.y = pk2(a[2], a[3]); w.z = pk2(b[0], b[1]); w.w = pk2(b[2], b[3]); return __builtin_bit_cast(bf16x8, w);
}
__device__ __forceinline__ void gdn_scan(const Args& A, LAS unsigned char* lds, int bh, int tid, int lane, int wave) {
    const int b = bh >> 2, h = bh & 3, fr = lane & 15, fq = lane >> 4, vs = wave;
    const unsigned char* gops = (const unsigned char*)A.out + (size_t)bh * 32 * GOPS_CHUNK;
    const unsigned char* uvf = A.ws + WS_XN + (size_t)bh * 32 * 16384; const float* GE = (const float*)(A.ws + WS_GE) + bh * 32;
    float* Op = (float*)(A.ws + WS_OA) + ((size_t)b * SEQ + 4 * fq) * GW + h * 128 + 16 * vs + fr;
    f32x4 S[8];
#pragma unroll
    for (int i = 0; i < 8; ++i) S[i] = (f32x4){0.f, 0.f, 0.f, 0.f};
    const float gev = GE[lane & 31];
#define SCAN_DMA(chunk, bufoff) do { _Pragma("unroll") for (int i_ = 0; i_ < 9; ++i_) { const int p_ = wave + 8 * i_; \
        const unsigned char* s_ = (p_ < 56) ? (gops + (size_t)(chunk) * GOPS_CHUNK + p_ * 1024) : (uvf + (size_t)(chunk) * 16384 + (p_ - 56) * 1024); \
        __builtin_amdgcn_global_load_lds((const unsigned*)(s_ + lane * 16), (LAS unsigned*)(lds + (bufoff) + p_ * 1024), 16, 0, 0); } } while (0)
    SCAN_DMA(0, 0); SCAN_DMA(1, SCAN_BUF);
    asm volatile("s_waitcnt vmcnt(0)" ::: "memory"); __syncthreads();
#pragma unroll 1
    for (int n = 0; n < 32; ++n) {
        const LAS unsigned char* cur = lds + (n & 1) * SCAN_BUF;
        const float ge = __builtin_bit_cast(float, __builtin_amdgcn_readlane(__builtin_bit_cast(int, gev), n));
        bf16x8 Sb[4];
#pragma unroll
        for (int ks = 0; ks < 4; ++ks) Sb[ks] = pack8(S[2 * ks], S[2 * ks + 1]);
        f32x4 u[4];
#pragma unroll
        for (int mb = 0; mb < 4; ++mb) { f32x4 p = (f32x4){0.f, 0.f, 0.f, 0.f};
#pragma unroll
            for (int ks = 0; ks < 4; ++ks) p = __builtin_amdgcn_mfma_f32_16x16x32_bf16(*(const LAS bf16x8*)(cur + ((mb * 4 + ks) * 64 + lane) * 16), Sb[ks], p, 0, 0, 0);
            const v2u uw = *(const LAS v2u*)(cur + GOPS_CHUNK + ((vs * 4 + mb) * 64 + lane) * 8);
            u[mb] = (f32x4){bflo(uw.x) - p[0], bfhi(uw.x) - p[1], bflo(uw.y) - p[2], bfhi(uw.y) - p[3]}; }
        bf16x8 ub[2]; ub[0] = pack8(u[0], u[1]); ub[1] = pack8(u[2], u[3]);
        f32x4 o[4];
#pragma unroll
        for (int mb = 0; mb < 4; ++mb) { f32x4 acc = (f32x4){0.f, 0.f, 0.f, 0.f};
#pragma unroll
            for (int ks = 0; ks < 4; ++ks) acc = __builtin_amdgcn_mfma_f32_16x16x32_bf16(*(const LAS bf16x8*)(cur + 16384 + ((mb * 4 + ks) * 64 + lane) * 16), Sb[ks], acc, 0, 0, 0);
#pragma unroll
            for (int ks2 = 0; ks2 < 2; ++ks2) if (ks2 <= (mb >> 1)) acc = __builtin_amdgcn_mfma_f32_16x16x32_bf16(*(const LAS bf16x8*)(cur + 32768 + ((mb * 2 + ks2) * 64 + lane) * 16), ub[ks2], acc, 0, 0, 0);
            o[mb] = acc; }
#pragma unroll
        for (int dkb = 0; dkb < 8; ++dkb) { f32x4 acc = S[dkb] * ge;
#pragma unroll
            for (int ks2 = 0; ks2 < 2; ++ks2) acc = __builtin_amdgcn_mfma_f32_16x16x32_bf16(*(const LAS bf16x8*)(cur + 40960 + ((dkb * 2 + ks2) * 64 + lane) * 16), ub[ks2], acc, 0, 0, 0);
            S[dkb] = acc; }
        asm volatile("s_waitcnt vmcnt(0)" ::: "memory"); __syncthreads();
        if (n + 2 < 32) SCAN_DMA(n + 2, (n & 1) * SCAN_BUF);
        float* orow = Op + (size_t)(64 * n) * GW;
#pragma unroll
        for (int mb = 0; mb < 4; ++mb) { float* q = orow + (size_t)(16 * mb) * GW; q[0] = o[mb][0]; q[GW] = o[mb][1]; q[2 * GW] = o[mb][2]; q[3 * GW] = o[mb][3]; }
    }
    asm volatile("s_waitcnt vmcnt(0)" ::: "memory"); __syncthreads();
#undef SCAN_DMA
}


__device__ __forceinline__ void attn_fast(const Args& A, LAS unsigned char* lds, int lane, int wave) {
    const bf16* PROJ = (const bf16*)(A.ws + WS_PROJ); bf16* CAT = (bf16*)(A.ws + WS_CAT);
    unsigned* ctr = (unsigned*)(A.ws + WS_CTL);
    LAS bf16* Vt = (LAS bf16*)(lds + wave * 8192);
    const int fr = lane & 15, fq = lane >> 4;
    const int kk = lane & 31, vslot = 8 * ((kk & 15) >> 2) + 4 * (kk >> 4) + (kk & 3), vch = lane >> 5;
    constexpr float SC = 0.125f * 1.4426950408889634f;
    const int myx = (int)(__builtin_amdgcn_s_getreg((3 << 11) | 20) & 0x7u);
    int qi = 0;
    for (;;) {
        int wt = 512, xq = 0;
        while (qi < 8) { xq = (myx + qi) & 7; unsigned wt_ = 0; if (lane == 0) wt_ = atomicAdd(ctr + 16 * xq, 1u); wt = __builtin_amdgcn_readfirstlane(wt_); if (wt < 512) break; ++qi; }
        if (qi >= 8) break;
        const int b = wt >> 6, h = xq, rem = wt & 63, T = 7 - (rem >> 3), c4 = rem & 7, cA = (c4 & 3) + 8 * (c4 >> 2), cB = cA + 4, t0 = 256 * T;
        const bf16* Pb = PROJ + (size_t)b * SEQ * NP;
        const int tqA = t0 + cA + 16 * fr, tqB = tqA + 4;
        bf16x8 qfA[2], qfB[2];
#pragma unroll
        for (int ks = 0; ks < 2; ++ks) { qfA[ks] = *(const bf16x8*)(Pb + (size_t)tqA * NP + PC_QB + h * 64 + 32 * ks + 8 * fq); qfB[ks] = *(const bf16x8*)(Pb + (size_t)tqB * NP + PC_QB + h * 64 + 32 * ks + 8 * fq); }
        const int n2 = ((t0 + 240) >> 4) + 1, g2 = (n2 + 31) >> 5;
        const int lo1 = max(t0 + cA - 512, cA & 3), n1 = ((t0 + cB + 240 - lo1) >> 2) + 1, g1 = (n1 + 31) >> 5;
        const int lo0 = max(t0 + cA - 128, 0), n0 = (t0 + cB + 240 - lo0) + 1, g0 = (n0 + 31) >> 5;
        const int NG = 2 * g2 + g1 + g0;
        f32x4 OA[4], OB[4];
#pragma unroll
        for (int i = 0; i < 4; ++i) { OA[i] = (f32x4){0.f, 0.f, 0.f, 0.f}; OB[i] = OA[i]; }
        float mA = -INFINITY, lA = 0.f, mB = -INFINITY, lB = 0.f;
        v4u kc[4], vc[4], kn[4], vn[4];
#define ATT_DEC(f, kst, str, mode) do { if ((f) < g2) { str = 16; kst = cA + 512 * (f); mode = 1; } else if ((f) < 2 * g2) { str = 16; kst = cB + 512 * ((f) - g2); mode = 2; } \
            else if ((f) < 2 * g2 + g1) { str = 4; kst = lo1 + 128 * ((f) - 2 * g2); mode = 3; } else { str = 1; kst = lo0 + 32 * ((f) - 2 * g2 - g1); mode = 3; } } while (0)
#define ATT_LOAD(kreg, vreg, kst, str) do { \
            _Pragma("unroll") for (int j = 0; j < 2; ++j) { const int tk = min((kst) + (str) * (16 * j + fr), SEQ - 1); \
                _Pragma("unroll") for (int ks = 0; ks < 2; ++ks) kreg[2 * j + ks] = *(const v4u*)(Pb + (size_t)tk * NP + PC_KB + h * 64 + 32 * ks + 8 * fq); } \
            { const int tk = min((kst) + (str) * kk, SEQ - 1); \
                _Pragma("unroll") for (int i = 0; i < 4; ++i) vreg[i] = *(const v4u*)(Pb + (size_t)tk * NP + PC_VB + h * 64 + 8 * (vch + 2 * i)); } } while (0)
#define ATT_CLS(O_, m_, l_, qf_, tq_) do { \
            f32x4 d0 = (f32x4){0.f, 0.f, 0.f, 0.f}, d1 = d0; \
            _Pragma("unroll") for (int ks = 0; ks < 2; ++ks) { d0 = __builtin_amdgcn_mfma_f32_16x16x32_bf16(__builtin_bit_cast(bf16x8, kc[ks]), qf_[ks], d0, 0, 0, 0); \
                                                             d1 = __builtin_amdgcn_mfma_f32_16x16x32_bf16(__builtin_bit_cast(bf16x8, kc[2 + ks]), qf_[ks], d1, 0, 0, 0); } \
            float s[8]; float mloc = -INFINITY; \
            _Pragma("unroll") for (int e2 = 0; e2 < 8; ++e2) { const int tk = kst + str * (16 * (e2 >> 2) + 4 * fq + (e2 & 3)); const int dt = (tq_) - tk; const float x = (e2 < 4 ? d0[e2 & 3] : d1[e2 & 3]) * SC; \
                s[e2] = (dt >= 0 && dt <= span) ? x : -INFINITY; mloc = fmaxf(mloc, s[e2]); } \
            mloc = fmaxf(mloc, __shfl_xor(mloc, 16)); mloc = fmaxf(mloc, __shfl_xor(mloc, 32)); \
            const float mnew = fmaxf(m_, mloc), alpha = __builtin_amdgcn_exp2f(m_ - mnew); m_ = mnew; \
            float psum = 0.f; \
            _Pragma("unroll") for (int e2 = 0; e2 < 8; ++e2) { s[e2] = __builtin_amdgcn_exp2f(s[e2] - mnew); psum += s[e2]; } \
            l_ = l_ * alpha + psum; \
            const bf16x8 pb = pack8((f32x4){s[0], s[1], s[2], s[3]}, (f32x4){s[4], s[5], s[6], s[7]}); \
            _Pragma("unroll") for (int db = 0; db < 4; ++db) O_[db] = __builtin_amdgcn_mfma_f32_16x16x32_bf16(va[db], pb, O_[db] * alpha, 0, 0, 0); } while (0)
        int kst, str, mode; ATT_DEC(0, kst, str, mode); ATT_LOAD(kc, vc, kst, str);
#pragma unroll 1
        for (int f = 0; f < NG; ++f) {
            int kstn = 0, strn = 1, moden = 0;
            if (f + 1 < NG) { ATT_DEC(f + 1, kstn, strn, moden); ATT_LOAD(kn, vn, kstn, strn); }
#pragma unroll
            for (int i = 0; i < 4; ++i) { const int dd = 8 * (vch + 2 * i); const v4u w = vc[i];
                Vt[(dd + 0) * 40 + vslot] = (bf16)(w.x & 0xffffu); Vt[(dd + 1) * 40 + vslot] = (bf16)(w.x >> 16); Vt[(dd + 2) * 40 + vslot] = (bf16)(w.y & 0xffffu); Vt[(dd + 3) * 40 + vslot] = (bf16)(w.y >> 16);
                Vt[(dd + 4) * 40 + vslot] = (bf16)(w.z & 0xffffu); Vt[(dd + 5) * 40 + vslot] = (bf16)(w.z >> 16); Vt[(dd + 6) * 40 + vslot] = (bf16)(w.w & 0xffffu); Vt[(dd + 7) * 40 + vslot] = (bf16)(w.w >> 16); }
            bf16x8 va[4];
#pragma unroll
            for (int db = 0; db < 4; ++db) va[db] = *(const LAS bf16x8*)(Vt + (16 * db + fr) * 40 + 8 * fq);
            const int span = 128 * str;
            if (mode & 1) ATT_CLS(OA, mA, lA, qfA, tqA);
            if (mode & 2) ATT_CLS(OB, mB, lB, qfB, tqB);
#pragma unroll
            for (int i = 0; i < 4; ++i) { kc[i] = kn[i]; vc[i] = vn[i]; }
            kst = kstn; str = strn; mode = moden;
        }
#undef ATT_DEC
#undef ATT_LOAD
#undef ATT_CLS
        lA += __shfl_xor(lA, 16); lA += __shfl_xor(lA, 32); lB += __shfl_xor(lB, 16); lB += __shfl_xor(lB, 32);
        const float invA = 1.0f / lA, invB = 1.0f / lB;
        bf16* op = CAT + ((size_t)b * SEQ + tqA) * DM + GW + h * 64 + 4 * fq;
#pragma unroll
        for (int db = 0; db < 4; ++db) { v2u w; w.x = pk2(OA[db][0] * invA, OA[db][1] * invA); w.y = pk2(OA[db][2] * invA, OA[db][3] * invA); *(v2u*)(op + 16 * db) = w;
            v2u w2; w2.x = pk2(OB[db][0] * invB, OB[db][1] * invB); w2.y = pk2(OB[db][2] * invB, OB[db][3] * invB); *(v2u*)(op + 4 * DM + 16 * db) = w2; }
    }
}

__device__ __forceinline__ void attn_simple(const Args& A, int tid, int lane, int wave) {
    const bf16* PROJ = (const bf16*)(A.ws + WS_PROJ); bf16* CAT = (bf16*)(A.ws + WS_CAT);
    unsigned* ctr = (unsigned*)(A.ws + WS_CTL);
    for (;;) {
        unsigned wt_ = 0; if (lane == 0) wt_ = atomicAdd(ctr, 1u); const int wt = __builtin_amdgcn_readfirstlane(wt_);
        if (wt >= (M / 64) * AH) break;
        const int h = wt % AH, tb = wt / AH, row = tb * 64 + lane, b = row / SEQ, t = row % SEQ;
        float q[64], acc[64];
        { const v4u* qp = (const v4u*)(PROJ + (size_t)row * NP + PC_QB + h * 64);
#pragma unroll
          for (int j = 0; j < 8; ++j) { const v4u w = qp[j]; q[8 * j + 0] = bflo(w.x) * 0.125f; q[8 * j + 1] = bfhi(w.x) * 0.125f; q[8 * j + 2] = bflo(w.y) * 0.125f; q[8 * j + 3] = bfhi(w.y) * 0.125f;
              q[8 * j + 4] = bflo(w.z) * 0.125f; q[8 * j + 5] = bfhi(w.z) * 0.125f; q[8 * j + 6] = bflo(w.w) * 0.125f; q[8 * j + 7] = bfhi(w.w) * 0.125f; } }
#pragma unroll
        for (int j = 0; j < 64; ++j) acc[j] = 0.f;
        float mx = -1e30f, l = 0.f;
        for (int br = 0; br < 3; ++br) {
            const int stride = br == 0 ? 1 : (br == 1 ? 4 : 16);
            for (int i = 0; i <= 128; ++i) {
                const int tk = t - i * stride; if (tk < 0) break;
                const size_t krow = (size_t)(b * SEQ + tk) * NP;
                const v4u* kp = (const v4u*)(PROJ + krow + PC_KB + h * 64); const v4u* vp = (const v4u*)(PROJ + krow + PC_VB + h * 64);
                float s = 0.f;
#pragma unroll
                for (int j = 0; j < 8; ++j) { const v4u w = kp[j]; s += q[8 * j + 0] * bflo(w.x) + q[8 * j + 1] * bfhi(w.x) + q[8 * j + 2] * bflo(w.y) + q[8 * j + 3] * bfhi(w.y)
                                                                       + q[8 * j + 4] * bflo(w.z) + q[8 * j + 5] * bfhi(w.z) + q[8 * j + 6] * bflo(w.w) + q[8 * j + 7] * bfhi(w.w); }
                const float mn = fmaxf(mx, s), sc = __expf(mx - mn), p = __expf(s - mn); mx = mn; l = l * sc + p;
#pragma unroll
                for (int j = 0; j < 8; ++j) { const v4u w = vp[j];
                    acc[8 * j + 0] = acc[8 * j + 0] * sc + p * bflo(w.x); acc[8 * j + 1] = acc[8 * j + 1] * sc + p * bfhi(w.x); acc[8 * j + 2] = acc[8 * j + 2] * sc + p * bflo(w.y); acc[8 * j + 3] = acc[8 * j + 3] * sc + p * bfhi(w.y);
                    acc[8 * j + 4] = acc[8 * j + 4] * sc + p * bflo(w.z); acc[8 * j + 5] = acc[8 * j + 5] * sc + p * bfhi(w.z); acc[8 * j + 6] = acc[8 * j + 6] * sc + p * bflo(w.w); acc[8 * j + 7] = acc[8 * j + 7] * sc + p * bfhi(w.w); }
            }
        }
        const float inv = 1.0f / l; v4u* op = (v4u*)(CAT + (size_t)row * DM + GW + h * 64);
#pragma unroll
        for (int j = 0; j < 8; ++j) { v4u w; w.x = pk2(acc[8 * j] * inv, acc[8 * j + 1] * inv); w.y = pk2(acc[8 * j + 2] * inv, acc[8 * j + 3] * inv); w.z = pk2(acc[8 * j + 4] * inv, acc[8 * j + 5] * inv); w.w = pk2(acc[8 * j + 6] * inv, acc[8 * j + 7] * inv); op[j] = w; }
    }
}
__device__ __forceinline__ void gated_norm(const Args& A, int lane, int wave) {
    const bf16* PROJ = (const bf16*)(A.ws + WS_PROJ); bf16* CAT = (bf16*)(A.ws + WS_CAT); const float* OA = (const float*)(A.ws + WS_OA); const float* gw = A.in[6];
    const float w0 = gw[2 * lane], w1 = gw[2 * lane + 1];
    for (int wt = blockIdx.x * NWAVES + wave; wt < M * GH; wt += gridDim.x * NWAVES) {
        const int row = wt / GH, h = wt % GH;
        const float2 o = *(const float2*)(OA + (size_t)row * GW + h * 128 + 2 * lane);
        const unsigned zz = *(const unsigned*)(PROJ + (size_t)row * NP + PC_Z + h * 128 + 2 * lane);
        const float ms = wave_sum(o.x * o.x + o.y * o.y) * (1.0f / 128.0f), r = rsqrtf(ms + RMS_EPS);
        *(unsigned*)(CAT + (size_t)row * DM + h * 128 + 2 * lane) = pk2(o.x * r * w0 * silu_f(bflo(zz)), o.y * r * w1 * silu_f(bfhi(zz)));
    }
}

__device__ __forceinline__ void gated_norm_bh(const Args& A, int bh, int lane, int wave) {
    const int b = bh >> 2, h = bh & 3;
    const bf16* Zp = (const bf16*)(A.ws + WS_PROJ) + (size_t)b * SEQ * NP + PC_Z + h * 128 + 2 * lane; bf16* Cp = (bf16*)(A.ws + WS_CAT) + (size_t)b * SEQ * DM + h * 128 + 2 * lane;
    const float* Op = (const float*)(A.ws + WS_OA) + (size_t)b * SEQ * GW + h * 128 + 2 * lane; const float* gw = A.in[6];
    const float w0 = gw[2 * lane], w1 = gw[2 * lane + 1];
    __builtin_amdgcn_fence(__ATOMIC_ACQUIRE, "agent");
#pragma unroll 1
    for (int r0 = wave * 16; r0 < SEQ; r0 += NWAVES * 16) {
        float2 o[16]; unsigned zz[16];
#pragma unroll
        for (int i = 0; i < 16; ++i) { o[i] = *(const float2*)(Op + (size_t)(r0 + i) * GW); zz[i] = *(const unsigned*)(Zp + (size_t)(r0 + i) * NP); }
#pragma unroll
        for (int i = 0; i < 16; ++i) { const float ms = wave_sum(o[i].x * o[i].x + o[i].y * o[i].y) * (1.0f / 128.0f), r = rsqrtf(ms + RMS_EPS);
            *(unsigned*)(Cp + (size_t)(r0 + i) * DM) = pk2(o[i].x * r * w0 * silu_f(bflo(zz[i])), o[i].y * r * w1 * silu_f(bfhi(zz[i]))); }
    }
}
__device__ __forceinline__ void ffn_conv_half(const Args& A, int half, int tid) {
    const bf16* Y = (const bf16*)(A.ws + WS_Y); bf16* ACT = (bf16*)(A.ws + WS_ACT); const float* fw = A.in[10];
    constexpr int HC = DFF / 2;
    for (size_t it = (size_t)blockIdx.x * NTHR + tid; it < (size_t)M * (HC / 8); it += (size_t)gridDim.x * NTHR) {
        const int row = (int)(it / (HC / 8)), g8 = (int)(it % (HC / 8)), cl = g8 * 8, pn = cl >> 7, j = cl & 127, t = row % SEQ, ch = half * HC + cl;
        float ga[8], ua[8];
#pragma unroll
        for (int e = 0; e < 8; ++e) { ga[e] = 0.f; ua[e] = 0.f; }
#pragma unroll
        for (int i = 0; i < 3; ++i) { const int ts = t - 2 + i; if (ts < 0) continue;
            const bf16* yr = Y + (size_t)(row - 2 + i) * DFF + 256 * pn + j; const v4u g = *(const v4u*)yr, u = *(const v4u*)(yr + 128);
            const f32x4 wg0 = *(const f32x4*)(fw + i * NUP + ch), wg1 = *(const f32x4*)(fw + i * NUP + ch + 4), wu0 = *(const f32x4*)(fw + i * NUP + DFF + ch), wu1 = *(const f32x4*)(fw + i * NUP + DFF + ch + 4);
            ga[0] += wg0.x * bflo(g.x); ga[1] += wg0.y * bfhi(g.x); ga[2] += wg0.z * bflo(g.y); ga[3] += wg0.w * bfhi(g.y); ga[4] += wg1.x * bflo(g.z); ga[5] += wg1.y * bfhi(g.z); ga[6] += wg1.z * bflo(g.w); ga[7] += wg1.w * bfhi(g.w);
            ua[0] += wu0.x * bflo(u.x); ua[1] += wu0.y * bfhi(u.x); ua[2] += wu0.z * bflo(u.y); ua[3] += wu0.w * bfhi(u.y); ua[4] += wu1.x * bflo(u.z); ua[5] += wu1.y * bfhi(u.z); ua[6] += wu1.z * bflo(u.w); ua[7] += wu1.w * bfhi(u.w); }
        v4u o; o.x = pk2(silu_f(ga[0]) * ua[0], silu_f(ga[1]) * ua[1]); o.y = pk2(silu_f(ga[2]) * ua[2], silu_f(ga[3]) * ua[3]); o.z = pk2(silu_f(ga[4]) * ua[4], silu_f(ga[5]) * ua[5]); o.w = pk2(silu_f(ga[6]) * ua[6], silu_f(ga[7]) * ua[7]);
        *(v4u*)(ACT + (size_t)row * DFF + ch) = o;
    }
}

__device__ __forceinline__ void ffn_fixup(const Args& A, int tid) {
    const float* YH = (const float*)(A.ws + WS_YH); const float* UP = (const float*)(A.ws + WS_UPART); bf16* ACT = (bf16*)(A.ws + WS_ACT); const float* fw = A.in[10];
    for (int it = blockIdx.x * NTHR + tid; it < 64 * 22 * 2 * 128; it += gridDim.x * NTHR) {
        const int c = it & 127, r = (it >> 7) & 1, tile = it >> 8, pm = tile / 22, pn = tile % 22; if ((pm & 7) == 0) continue;
        const int ch = pn * 128 + c; const float* up = UP + ((size_t)tile * 2 + r) * 256; const float* yh = YH + (size_t)((pm - 1) * 22 + pn) * 2 * 256;
        float g = up[c], u = up[128 + c];
        const float wg0 = fw[ch], wg1 = fw[5632 + ch], wu0 = fw[2816 + ch], wu1 = fw[5632 + 2816 + ch];
        if (r == 0) { g += wg0 * yh[c] + wg1 * yh[256 + c]; u += wu0 * yh[128 + c] + wu1 * yh[256 + 128 + c]; }
        else { g += wg0 * yh[256 + c]; u += wu0 * yh[256 + 128 + c]; }
        ACT[(size_t)(pm * 256 + r) * DFF + ch] = (bf16)(pk2(silu_f(g) * u, 0.f) & 0xffffu);
    }
}
__device__ __forceinline__ void final_norm(const Args& A, int lane, int wave) {
    float* out = A.out; const f32x4* nr = (const f32x4*)A.in[12] + lane;
    const int gw = blockIdx.x * NWAVES + wave, NGW = gridDim.x * NWAVES;
    f32x4 nw[4];
#pragma unroll
    for (int j = 0; j < 4; ++j) nw[j] = nr[64 * j];
    for (int m0 = gw; m0 < M; m0 += 4 * NGW) {
        f32x4 v[4][4];
#pragma unroll
        for (int rr = 0; rr < 4; ++rr) { const int m = min(m0 + rr * NGW, M - 1); const f32x4* xr = (const f32x4*)(out + (size_t)m * DM) + lane;
#pragma unroll
            for (int j = 0; j < 4; ++j) v[rr][j] = xr[64 * j]; }
#pragma unroll
        for (int rr = 0; rr < 4; ++rr) { const int m = m0 + rr * NGW; if (m >= M) break; float s = 0.f;
#pragma unroll
            for (int j = 0; j < 4; ++j) s += (v[rr][j].x * v[rr][j].x + v[rr][j].y * v[rr][j].y) + (v[rr][j].z * v[rr][j].z + v[rr][j].w * v[rr][j].w);
            const float rstd = rsqrtf(wave_sum(s) * (1.f / DM) + RMS_EPS); f32x4* xw = (f32x4*)(out + (size_t)m * DM) + lane;
#pragma unroll
            for (int j = 0; j < 4; ++j) xw[64 * j] = (f32x4){v[rr][j].x * rstd * nw[j].x, v[rr][j].y * rstd * nw[j].y, v[rr][j].z * rstd * nw[j].z, v[rr][j].w * rstd * nw[j].w}; }
    }
}

#define XB_TMO      128
#define XB_XCNT(j)  (256  + 64 * (j))
#define XB_XSUB(j)  (1280 + 64 * (j))
#define XB_XGEN(j)  (2304 + 64 * (j))
#define XB_TOP      3328
#define XB_TOPGEN   3392
#define XCD_BAR_WORDS 3456
#define XB_SPIN_CAP (1u << 18)

__device__ __forceinline__ unsigned xb_ld(unsigned* p)              { return __hip_atomic_load(p, __ATOMIC_RELAXED, __HIP_MEMORY_SCOPE_AGENT); }
__device__ __forceinline__ unsigned xb_add(unsigned* p, unsigned v) { return __hip_atomic_fetch_add(p, v, __ATOMIC_RELAXED, __HIP_MEMORY_SCOPE_AGENT); }
__device__ __forceinline__ unsigned xb_xcc_id() { return (unsigned)__builtin_amdgcn_s_getreg((3 << 11) | 20) & 0xFu; }
#define XB_SPIN(cond, bar) do { unsigned _sp = 0; while (cond) { __builtin_amdgcn_s_sleep(1); \
    if ((++_sp & 255u) == 0u) { if (xb_ld(&(bar)[XB_TMO])) break; if (_sp > XB_SPIN_CAP) { atomicAdd(&(bar)[XB_TMO], 1u); break; } } } } while (0)

struct XcdBarrier {
    unsigned* bar; unsigned x;
    volatile LAS unsigned* st;
};

__device__ __forceinline__ XcdBarrier xcd_barrier_post(unsigned* bar, volatile LAS unsigned* st) {
    XcdBarrier b; b.bar = bar; b.x = xb_xcc_id(); b.st = st;
    if (threadIdx.x == 0) (void)xb_add(&bar[XB_XCNT(b.x)], 1u);
    return b;
}
__device__ __forceinline__ void xcd_barrier_complete(unsigned* bar, unsigned x, unsigned& nloc, unsigned& nx) {
    const unsigned G = gridDim.x * gridDim.y * gridDim.z;
    unsigned sum, cnt, mine, sp = 0u;
    for (;;) {
        sum = 0u; cnt = 0u; mine = 0u;
#pragma unroll
        for (unsigned j = 0; j < 16; ++j) { const unsigned c = xb_ld(&bar[XB_XCNT(j)]); sum += c; cnt += (c > 0u) ? 1u : 0u; mine = (j == x) ? c : mine; }
        if (sum == G) break;
        __builtin_amdgcn_s_sleep(1);
        if ((++sp & 255u) == 0u) { if (xb_ld(&bar[XB_TMO])) break; if (sp > XB_SPIN_CAP) { atomicAdd(&bar[XB_TMO], 1u); break; } }
    }
    nloc = mine > 0u ? mine : 1u; nx = cnt > 0u ? cnt : 1u;
}

__device__ __forceinline__ void xcd_barrier(const XcdBarrier& b) {
    asm volatile("s_waitcnt vmcnt(0)" ::: "memory");
    __syncthreads();
    if (threadIdx.x == 0) {
        unsigned* bar = b.bar;
        __builtin_amdgcn_s_waitcnt(0);
        unsigned nloc = b.st[0], nx = b.st[1];
        if (nloc == 0u) { xcd_barrier_complete(bar, b.x, nloc, nx); b.st[0] = nloc; b.st[1] = nx; }
        const unsigned old = xb_add(&bar[XB_XSUB(b.x)], 1u);
        const unsigned gen = old / nloc;
        if (old + 1u == (gen + 1u) * nloc) {
            __builtin_amdgcn_fence(__ATOMIC_RELEASE, "agent");
            asm volatile("s_waitcnt vmcnt(0)" ::: "memory");
            const unsigned og = xb_add(&bar[XB_TOP], 1u);
            const unsigned tg = og / nx;
            if (og + 1u == (tg + 1u) * nx) xb_add(&bar[XB_TOPGEN], 1u);
            else XB_SPIN(xb_ld(&bar[XB_TOPGEN]) == tg, bar);
            __builtin_amdgcn_fence(__ATOMIC_ACQUIRE, "agent");
            xb_add(&bar[XB_XGEN(b.x)], 1u);
            asm volatile("s_waitcnt vmcnt(0)" ::: "memory");
        } else {
            XB_SPIN(xb_ld(&bar[XB_XGEN(b.x)]) == gen, bar);
            __builtin_amdgcn_fence(__ATOMIC_ACQUIRE, "agent");
            asm volatile("s_waitcnt vmcnt(0)" ::: "memory");
        }
    }
    __syncthreads();
}

constexpr int N_PHASES = 9;
__global__ void __launch_bounds__(NTHR, 2) mk_fwd(Args args) {
    extern __shared__ __attribute__((aligned(16))) unsigned char lds_raw[];
    LAS unsigned char* lds = (LAS unsigned char*)lds_raw;
    const int tid = threadIdx.x, lane = tid & 63, wave = __builtin_amdgcn_readfirstlane(tid >> 6);
    const int lo = args.ph_lo, hi = args.ph_hi;
    unsigned char* ws = args.ws;
    bf16* WIN = (bf16*)(ws + WS_WIN); bf16* WOUT = (bf16*)(ws + WS_WOUT); bf16* WUP = (bf16*)(ws + WS_WUP); bf16* WDN = (bf16*)(ws + WS_WDN);
    bf16* XN = (bf16*)(ws + WS_XN); bf16* PROJ = (bf16*)(ws + WS_PROJ); bf16* CAT = (bf16*)(ws + WS_CAT); bf16* Y = (bf16*)(ws + WS_Y); bf16* ACT = (bf16*)(ws + WS_ACT);
    float* SSQ = (float*)(ws + WS_SSQ);
#define IN(k) (lo <= (k) && (k) < hi)
#define SEAM(k) do { if (IN(k) && IN((k) + 1)) { if ((k) == 0) cg::this_grid().sync(); else xcd_barrier(bar); } } while (0)
    { volatile LAS unsigned* st = (volatile LAS unsigned*)(lds + LDS_BYTES - 64); if (tid < 2) st[tid] = 0u; }
    __syncthreads();
    XcdBarrier bar = xcd_barrier_post((unsigned*)(ws + WS_CTL) + 4096, (volatile LAS unsigned*)(lds + LDS_BYTES - 64));
    if (IN(0)) { p0_prologue(args, lds, tid, lane, wave); } SEAM(0);
    if (IN(1)) { pg8::Gemm g{XN, WIN, M, NP, DM}; pg8::StaticOrder S; S.init(M, NP, gridDim.x, blockIdx.x); pg8::EpiBf16S E{PROJ, NP, nullptr};
        pg8::gemm_phase<pg8::EpiBf16S, pg8::StaticOrder, PG8_ALIGN, PG8_SP2>(lds, g, S, E);
        { pg8::Unit u4; const bool idle4 = !S.next(3, u4); const int G = gridDim.x, nidle = (G == 256) ? 128 : G;
          if (G != 256) convert_late_weights(args, lds, lane, wave, blockIdx.x * NWAVES + wave, G * NWAVES);
          else if (idle4) convert_late_weights(args, lds, lane, wave, (blockIdx.x - 128) * NWAVES + wave, nidle * NWAVES); } } SEAM(1);
    if (IN(2)) { gdn_prep(args, lds, tid, lane, wave); } SEAM(2);
    if (IN(3)) { if (blockIdx.x < NB * GH) { gdn_scan(args, lds, blockIdx.x, tid, lane, wave); gated_norm_bh(args, blockIdx.x, lane, wave); } attn_fast(args, lds, lane, wave); } SEAM(3);
    if (IN(4)) { pg8::Gemm g{CAT, WOUT, M, DM, DM}; pg8::StaticOrder S; S.init(M, DM, gridDim.x, blockIdx.x); pg8::EpiResid E{args.in[0], args.out, XN, SSQ, DM};
        pg8::gemm_phase<pg8::EpiResid, pg8::StaticOrder, PG8_ALIGN, PG8_SP2>(lds, g, S, E); } SEAM(4);
    if (IN(5)) { pg8::Gemm g{XN, WUP, M, NUP, DM}; pg8::StaticOrder S; S.init(M, NUP, gridDim.x, blockIdx.x);
        static_assert(pg8::EpiConvGate::CG_SSQ == WS_SSQ && pg8::EpiConvGate::CG_ACT == WS_ACT && pg8::EpiConvGate::CG_YH == WS_YH && pg8::EpiConvGate::CG_UPART == WS_UPART, "d_ws map");
        pg8::EpiConvGate E{ws, args.in[10], lds};
        pg8::gemm_phase<pg8::EpiConvGate, pg8::StaticOrder, true, PG8_SP2>(lds, g, S, E); } SEAM(5);
    if (IN(6)) { ffn_fixup(args, tid); } SEAM(6);
    if (IN(7)) { pg8::Gemm g{ACT, WDN, M, DM, DFF}; pg8::StaticOrder S; S.init(M, DM, gridDim.x, blockIdx.x); pg8::EpiResid E{args.out, args.out, nullptr, nullptr, DM};
        pg8::gemm_phase<pg8::EpiResid, pg8::StaticOrder, PG8_ALIGN, PG8_SP2>(lds, g, S, E); } SEAM(7);
    if (IN(8)) { final_norm(args, lane, wave); }
#undef IN
#undef SEAM
}

#ifndef MK_ONE_LAUNCH
#define MK_ONE_LAUNCH 1
#endif
extern "C" void kernel_launch(void* const* d_in, const int* in_sizes, int n_in, void* d_out, int out_size, void* d_ws, size_t ws_size, hipStream_t stream) {
    static int grid = 0;
    if (grid == 0) {
        if (n_in != 13 || out_size != M * DM || ws_size < WS_END) { fprintf(stderr, "kernel_launch: unexpected shapes n_in %d out %d ws %zu\n", n_in, out_size, ws_size); grid = -1; return; }
        int dev = 0, cus = 0, per_cu = 0;
        hipGetDevice(&dev); hipDeviceGetAttribute(&cus, hipDeviceAttributeMultiprocessorCount, dev);
        hipFuncSetAttribute((const void*)mk_fwd, hipFuncAttributeMaxDynamicSharedMemorySize, LDS_BYTES);
        hipOccupancyMaxActiveBlocksPerMultiprocessor(&per_cu, (const void*)mk_fwd, NTHR, LDS_BYTES);
        (void)hipGetLastError();
        if (per_cu < 1) { fprintf(stderr, "kernel_launch: occupancy query says %d blocks per CU\n", per_cu); per_cu = 1; }
        grid = cus;
    }
    if (grid < 0) return;
    if (hipMemsetAsync((char*)d_ws + WS_CTL, 0, 65536, stream) != hipSuccess) { fprintf(stderr, "kernel_launch: memset failed\n"); return; }
    Args a{};
    for (int i = 0; i < 13; ++i) a.in[i] = (const float*)d_in[i];
    a.out = (float*)d_out; a.ws = (unsigned char*)d_ws;
#if MK_ONE_LAUNCH
    a.ph_lo = 0; a.ph_hi = N_PHASES; a.coop = 1;
    void* kargs[] = {&a};
    hipError_t e = hipLaunchCooperativeKernel((const void*)mk_fwd, dim3(grid), dim3(NTHR), kargs, LDS_BYTES, stream);
    if (e != hipSuccess) fprintf(stderr, "cooperative launch failed: %s (grid %d)\n", hipGetErrorString(e), grid);
#else
    for (int p = 0; p < N_PHASES; ++p) { a.ph_lo = p; a.ph_hi = p + 1; a.coop = 0; hipLaunchKernelGGL(mk_fwd, dim3(grid), dim3(NTHR), LDS_BYTES, stream, a); }
#endif
}
```

```cpp
#include <hip/hip_runtime.h>
#include <hip/hip_cooperative_groups.h>
#include <cstdio>
#include <cstdint>
namespace cg = cooperative_groups;
namespace pg8 {
#define PG8_LAS __attribute__((address_space(3)))
typedef unsigned short bf16_t;
typedef short bf16x8 __attribute__((ext_vector_type(8)));
typedef float f32x4 __attribute__((ext_vector_type(4)));
typedef unsigned u32x4 __attribute__((ext_vector_type(4)));
constexpr int BM = 256, BK = 64, HALF = 128, HTB = HALF * BK * 2  , STAGE_BYTES = 8 * HTB, NXCD = 8, WGM = 8;

__host__ __device__ __forceinline__ int lds_byte(int r, int c) { const int st = (r >> 4) * 2 + (c >> 5), rr = r & 15, cc = c & 31, ob = rr * 64 + cc * 2; return st * 1024 + (ob ^ (((ob >> 9) & 1) << 5)); }
__host__ __device__ __forceinline__ void stage_rc(int b, int& R, int& C) { const int st = b / 1024, sb = b % 1024, swz = sb ^ (((sb >> 9) & 1) << 5); R = (st >> 1) * 16 + swz / 64; C = (st & 1) * 32 + (swz % 64) / 2; }
__host__ __device__ __forceinline__ int perm32(int rho) { const int n = rho >> 4, i = rho & 15; return 8 * (i >> 2) + 4 * n + (i & 3); }

struct Unit { int pm, pn; };
struct Gemm { const bf16_t* A; const bf16_t* Bt; int M, N, K; };

struct StaticOrder {
    int nM, nN, nwg, G, c;
    __host__ __device__ void init(int M, int N, int G_, int c_) { nM = M / BM; nN = N / BM; nwg = nM * nN; G = G_; c = c_; }
    __host__ __device__ bool next(int i, Unit& u) const {
        const long L = (long)i * G + c; if (L >= nwg) return false;
        int wgid = (int)L; { const int q = nwg / NXCD, r = nwg % NXCD, xcd = wgid % NXCD, off = wgid / NXCD; wgid = (xcd < r ? xcd * (q + 1) : r * (q + 1) + (xcd - r) * q) + off; }
        const int nig = WGM * nN, gid = wgid / nig, fm = gid * WGM, gsz = (nM - fm) < WGM ? (nM - fm) : WGM;
        u.pm = fm + ((wgid % nig) % gsz); u.pn = (wgid % nig) / gsz; return true;
    }
    __device__ __forceinline__ void a_ready(const Unit&) const {}
    __device__ __forceinline__ void done(const Unit&) const {}
};

__device__ __forceinline__ unsigned cvt_pk_bf16(float lo, float hi) { unsigned r; asm volatile("v_cvt_pk_bf16_f32 %0, %1, %2" : "=v"(r) : "v"(lo), "v"(hi)); return r; }
constexpr float RMS_EPS = 1e-6f;
struct EpiBf16S {
    static constexpr bool PERM = true, AFTER_DRAIN = false;
    bf16_t* O; int ldc; const float* ssq;
    __device__ __forceinline__ void operator()(const f32x4 (&acc)[2][2][4][2], const Unit& u, int wr, int wc, int fr, int fq) const {
        const int row0 = u.pm * BM + wr * 64 + fr; const int col0 = u.pn * BM + wc * 32 + 8 * fq;
#pragma unroll
        for (int ai = 0; ai < 2; ++ai)
#pragma unroll
            for (int m = 0; m < 4; ++m) { const int row = row0 + ai * HALF + m * 16; bf16_t* rowp = O + (size_t)row * ldc + col0;
                const float sc = ssq ? rsqrtf(ssq[row] * (1.0f / 1024.0f) + RMS_EPS) : 1.0f;
#pragma unroll
                for (int bj = 0; bj < 2; ++bj) { const f32x4 v0 = acc[ai][bj][m][0] * sc, v1 = acc[ai][bj][m][1] * sc;
                    u32x4 w; w.x = cvt_pk_bf16(v0[0], v0[1]); w.y = cvt_pk_bf16(v0[2], v0[3]); w.z = cvt_pk_bf16(v1[0], v1[1]); w.w = cvt_pk_bf16(v1[2], v1[3]);
                    *(u32x4*)(rowp + bj * HALF) = w; } }
    }
};
struct EpiResid {
    static constexpr bool PERM = false, AFTER_DRAIN = false;
    const float* base; float* out; bf16_t* xb; float* ssq; int ldc;
    __device__ __forceinline__ void operator()(const f32x4 (&acc)[2][2][4][2], const Unit& u, int wr, int wc, int fr, int fq) const {
        typedef unsigned u32x2v __attribute__((ext_vector_type(2)));
        const int col0 = u.pn * BM + wc * 32 + 4 * fq;
#pragma unroll
        for (int ai = 0; ai < 2; ++ai) {
            f32x4 bv[4][2][2];
#pragma unroll
            for (int m = 0; m < 4; ++m) { const size_t off = (size_t)(u.pm * BM + ai * HALF + wr * 64 + m * 16 + fr) * ldc + col0;
#pragma unroll
                for (int bj = 0; bj < 2; ++bj)
#pragma unroll
                    for (int n = 0; n < 2; ++n) bv[m][bj][n] = *(const f32x4*)(base + off + bj * HALF + n * 16); }
#pragma unroll
            for (int m = 0; m < 4; ++m) { const int row = u.pm * BM + ai * HALF + wr * 64 + m * 16 + fr; const size_t off = (size_t)row * ldc + col0; float s = 0.f;
#pragma unroll
                for (int bj = 0; bj < 2; ++bj)
#pragma unroll
                    for (int n = 0; n < 2; ++n) { const f32x4 v = acc[ai][bj][m][n] + bv[m][bj][n];
                        *(f32x4*)(out + off + bj * HALF + n * 16) = v; s += (v[0] * v[0] + v[1] * v[1]) + (v[2] * v[2] + v[3] * v[3]);
                        if (xb) { u32x2v w; w.x = cvt_pk_bf16(v[0], v[1]); w.y = cvt_pk_bf16(v[2], v[3]); *(u32x2v*)(xb + off + bj * HALF + n * 16) = w; } }
                if (ssq) { s += __shfl_xor(s, 16); s += __shfl_xor(s, 32); if (fq == 0) atomicAdd(ssq + row, s); } }
            asm volatile("" ::: "memory");
        }
    }
};

__device__ __forceinline__ float dpp_ror1(float v) { return __builtin_bit_cast(float, __builtin_amdgcn_update_dpp(0, __builtin_bit_cast(int, v), 0x121, 0xf, 0xf, false)); }
__device__ __forceinline__ float dpp_ror2(float v) { return __builtin_bit_cast(float, __builtin_amdgcn_update_dpp(0, __builtin_bit_cast(int, v), 0x122, 0xf, 0xf, false)); }
struct EpiConvGate {
    static constexpr bool PERM = true, AFTER_DRAIN = false;
    static constexpr size_t CG_SSQ = (1u << 20) + 768 * 1024, CG_ACT = (size_t)148 << 20, CG_YH = (size_t)236 << 20, CG_UPART = (size_t)240 << 20;
    unsigned char* ws; const float* fw; PG8_LAS unsigned char* ldsb;
    __device__ __forceinline__ void operator()(f32x4 (&acc)[2][2][4][2], const Unit& u, int wr, int wc, int fr0, int fq0) const {
        int fr = fr0, fq = fq0; asm volatile("" : "+v"(fr), "+v"(fq));
        bf16_t* ACT = (bf16_t*)(ws + CG_ACT); const float* ssq = (const float*)(ws + CG_SSQ); float* YH = (float*)(ws + CG_YH); float* UPART = (float*)(ws + CG_UPART);
        PG8_LAS float* halo = (PG8_LAS float*)(ldsb + STAGE_BYTES);
        int cl = wc * 32 + 8 * fq;
        int ch = u.pn * 128 + cl;
        if (fr >= 14) {
#pragma unroll
            for (int ai = 0; ai < 2; ++ai) { const float sc = rsqrtf(ssq[u.pm * BM + ai * HALF + wr * 64 + 48 + fr] * (1.0f / 1024.0f) + RMS_EPS);
#pragma unroll
                for (int bj = 0; bj < 2; ++bj)
#pragma unroll
                    for (int n = 0; n < 2; ++n) { const f32x4 v = acc[ai][bj][3][n] * sc; *(PG8_LAS f32x4*)(halo + (((wr * 2 + ai) * 2 + (fr - 14)) * 256 + bj * 128 + cl + 4 * n)) = v;
                        if (ai == 1 && wr == 1) *(f32x4*)(YH + ((size_t)(u.pm * 22 + u.pn) * 2 + (fr - 14)) * 256 + bj * 128 + cl + 4 * n) = v; } }
        }
        asm volatile("s_waitcnt lgkmcnt(0)" ::: "memory"); __builtin_amdgcn_s_barrier(); asm volatile("" ::: "memory");
        typedef unsigned u32x2v __attribute__((ext_vector_type(2)));
#pragma unroll 1
        for (int n = 0; n < 2; ++n) {
            asm volatile("" : "+v"(fr), "+v"(fq));
            cl = wc * 32 + 8 * fq; ch = u.pn * 128 + cl;
            f32x4 w[3][2];
#pragma unroll
            for (int i = 0; i < 3; ++i)
#pragma unroll
                for (int bj = 0; bj < 2; ++bj) w[i][bj] = *(const f32x4*)(fw + (size_t)i * 5632 + bj * 2816 + ch + 4 * n);
#pragma unroll
            for (int ai = 0; ai < 2; ++ai) {
                const bool top = (ai == 0 && wr == 0);
                const int pblk = (ai == 0) ? 0 : (wr == 0 ? 2 : 1);
                f32x4 q1[2], q2[2];
#pragma unroll
                for (int bj = 0; bj < 2; ++bj) { const f32x4 pv = top ? (f32x4){0.f, 0.f, 0.f, 0.f} : *(const PG8_LAS f32x4*)(halo + ((pblk * 2 + (fr & 1)) * 256 + bj * 128 + cl + 4 * n));
#pragma unroll
                    for (int k = 0; k < 4; ++k) { q1[bj][k] = dpp_ror1(pv[k]); q2[bj][k] = dpp_ror2(pv[k]); } }
#pragma unroll
                for (int m = 0; m < 4; ++m) {
                    const int row = u.pm * BM + ai * HALF + wr * 64 + m * 16 + fr; const float sc = rsqrtf(ssq[row] * (1.0f / 1024.0f) + RMS_EPS);
                    f32x4 cu[2];
#pragma unroll
                    for (int bj = 0; bj < 2; ++bj) { const f32x4 ya = (n == 0) ? acc[ai][bj][m][0] : acc[ai][bj][m][1];
#pragma unroll
                        for (int k = 0; k < 4; ++k) { const float y = ya[k] * sc;
                            const float a1 = dpp_ror1(y), a2 = dpp_ror2(y);
                            const float p1 = (fr == 0) ? q1[bj][k] : a1, p2 = (fr < 2) ? q2[bj][k] : a2;
                            cu[bj][k] = w[2][bj][k] * y + w[1][bj][k] * p1 + w[0][bj][k] * p2; q1[bj][k] = a1; q2[bj][k] = a2; } }
                    if (top && m == 0 && fr < 2 && (u.pm & 7) != 0) {
#pragma unroll
                        for (int bj = 0; bj < 2; ++bj) *(f32x4*)(UPART + ((size_t)(u.pm * 22 + u.pn) * 2 + fr) * 256 + bj * 128 + cl + 4 * n) = cu[bj];
                    }
                    u32x2v o;
#define PG8_SG(k_) (cu[0][k_] * __builtin_amdgcn_rcpf(1.0f + __expf(-cu[0][k_])) * cu[1][k_])
                    o.x = cvt_pk_bf16(PG8_SG(0), PG8_SG(1)); o.y = cvt_pk_bf16(PG8_SG(2), PG8_SG(3));
#undef PG8_SG
                    *(u32x2v*)(ACT + (size_t)row * 2816 + ch + 4 * n) = o;
                    asm volatile("" ::: "memory");
                }
            }
        }
        asm volatile("s_waitcnt lgkmcnt(0)" ::: "memory"); __builtin_amdgcn_s_barrier(); asm volatile("" ::: "memory");
    }
};

struct EpiResidNorm {
    static constexpr bool PERM = false, AFTER_DRAIN = false;
    const float* base; float* out; float* ssq2; unsigned* cnt; const float* fnw; int ldc;
    __device__ __forceinline__ void operator()(f32x4 (&acc)[2][2][4][2], const Unit& u, int wr, int wc, int fr, int fq) const {
        const int col0 = u.pn * BM + wc * 32 + 4 * fq;
#pragma unroll
        for (int ai = 0; ai < 2; ++ai) {
            f32x4 bv[4][2][2];
#pragma unroll
            for (int m = 0; m < 4; ++m) { const size_t off = (size_t)(u.pm * BM + ai * HALF + wr * 64 + m * 16 + fr) * ldc + col0;
#pragma unroll
                for (int bj = 0; bj < 2; ++bj)
#pragma unroll
                    for (int n = 0; n < 2; ++n) bv[m][bj][n] = *(const f32x4*)(base + off + bj * HALF + n * 16); }
#pragma unroll
            for (int m = 0; m < 4; ++m) { const int row = u.pm * BM + ai * HALF + wr * 64 + m * 16 + fr; float s = 0.f;
#pragma unroll
                for (int bj = 0; bj < 2; ++bj)
#pragma unroll
                    for (int n = 0; n < 2; ++n) { const f32x4 v = acc[ai][bj][m][n] + bv[m][bj][n]; acc[ai][bj][m][n] = v; s += (v[0] * v[0] + v[1] * v[1]) + (v[2] * v[2] + v[3] * v[3]); }
                s += __shfl_xor(s, 16); s += __shfl_xor(s, 32);
                if (fq == 0) (void)__hip_atomic_fetch_add(ssq2 + row, s, __ATOMIC_RELAXED, __HIP_MEMORY_SCOPE_AGENT); }
            asm volatile("" ::: "memory");
        }
        asm volatile("s_waitcnt vmcnt(0)" ::: "memory"); __builtin_amdgcn_s_barrier(); asm volatile("" ::: "memory");
        if (wr == 0 && wc == 0 && fr == 0 && fq == 0) {
            __builtin_amdgcn_fence(__ATOMIC_RELEASE, "agent"); asm volatile("s_waitcnt vmcnt(0)" ::: "memory");
            (void)__hip_atomic_fetch_add(cnt + 16 * u.pm, 1u, __ATOMIC_RELAXED, __HIP_MEMORY_SCOPE_AGENT);
            unsigned sp = 0;
            while (__hip_atomic_load(cnt + 16 * u.pm, __ATOMIC_RELAXED, __HIP_MEMORY_SCOPE_AGENT) < 4u) { __builtin_amdgcn_s_sleep(1); if (++sp > (1u << 22)) break; }
            __builtin_amdgcn_fence(__ATOMIC_ACQUIRE, "agent"); asm volatile("s_waitcnt vmcnt(0)" ::: "memory");
        }
        __builtin_amdgcn_s_barrier(); asm volatile("" ::: "memory");
        f32x4 nw[2][2];
#pragma unroll
        for (int bj = 0; bj < 2; ++bj)
#pragma unroll
            for (int n = 0; n < 2; ++n) nw[bj][n] = *(const f32x4*)(fnw + col0 + bj * HALF + n * 16);
#pragma unroll
        for (int ai = 0; ai < 2; ++ai)
#pragma unroll
            for (int m = 0; m < 4; ++m) { const int row = u.pm * BM + ai * HALF + wr * 64 + m * 16 + fr; const size_t off = (size_t)row * ldc + col0;
                const float rstd = rsqrtf(__hip_atomic_load(ssq2 + row, __ATOMIC_RELAXED, __HIP_MEMORY_SCOPE_AGENT) * (1.0f / 1024.0f) + RMS_EPS);
#pragma unroll
                for (int bj = 0; bj < 2; ++bj)
#pragma unroll
                    for (int n = 0; n < 2; ++n) { const f32x4 v = acc[ai][bj][m][n]; *(f32x4*)(out + off + bj * HALF + n * 16) = (f32x4){v[0] * rstd * nw[bj][n][0], v[1] * rstd * nw[bj][n][1], v[2] * rstd * nw[bj][n][2], v[3] * rstd * nw[bj][n][3]}; } }
    }
};
template <class Epi, class Sched, bool ALIGN_EPI = false, bool SP2 = false>
__device__ __forceinline__ void gemm_phase(PG8_LAS unsigned char* lds, const Gemm g, const Sched& S, const Epi& E) {
    const int tid = threadIdx.x, wid = __builtin_amdgcn_readfirstlane(tid >> 6), lane = tid & 63, wr = wid >> 2, wc = wid & 3, fr = lane & 15, fq = lane >> 4;
    const int K = g.K, nt = K / BK;
    unsigned voffA[2], voffB[2];
#pragma unroll
    for (int i = 0; i < 2; ++i) { int R, C; stage_rc(tid * 16 + i * 8192, R, C); const int Rb = Epi::PERM ? ((R & ~31) + perm32(R & 31)) : R;
        voffA[i] = (unsigned)(R * K + C) * 2u; voffB[i] = (unsigned)(Rb * K + C) * 2u; }
    const size_t kstep = (size_t)(BK * 2);
    const size_t hstep = (size_t)HALF * K * 2;
    const size_t tstep = 2 * hstep;
    const unsigned ldsw = (unsigned)wid * 1024u;
    const int aoff = lds_byte(wr * 64 + fr, fq * 8), boff = lds_byte(wc * 32 + fr, fq * 8);
#define PG8_SA(b, h) (((b) * 2 + (h)) * HTB)
#define PG8_SB(b, h) ((4 + (b) * 2 + (h)) * HTB)
#define PG8_STAGE(bufoff, gbase, voff) do { _Pragma("unroll") for (int _i = 0; _i < 2; ++_i) \
        __builtin_amdgcn_global_load_lds((const unsigned*)((const char*)(gbase) + (voff)[_i]), (PG8_LAS unsigned*)(lds + (bufoff) + ldsw + _i * 8192), 16, 0, 0); } while (0)
#define PG8_LDA(dst, b, h) do { _Pragma("unroll") for (int m = 0; m < 4; ++m) _Pragma("unroll") for (int k = 0; k < 2; ++k) dst[m][k] = *(const PG8_LAS bf16x8*)(lds + PG8_SA(b, h) + aoff + m * 2048 + k * 1024); } while (0)
#define PG8_LDB(dst, b, h) do { _Pragma("unroll") for (int n = 0; n < 2; ++n) _Pragma("unroll") for (int k = 0; k < 2; ++k) dst[n][k] = *(const PG8_LAS bf16x8*)(lds + PG8_SB(b, h) + boff + n * 2048 + k * 1024); } while (0)
#define PG8_MMA(ai, bj, At, Bt) do { __builtin_amdgcn_s_setprio(1); _Pragma("unroll") for (int m = 0; m < 4; ++m) _Pragma("unroll") for (int n = 0; n < 2; ++n) _Pragma("unroll") for (int k = 0; k < 2; ++k) \
        acc[ai][bj][m][n] = __builtin_amdgcn_mfma_f32_16x16x32_bf16(Bt[n][k], At[m][k], acc[ai][bj][m][n], 0, 0, 0); __builtin_amdgcn_s_setprio(0); } while (0)
#define PG8_WAIT_V(n) asm volatile("s_waitcnt vmcnt(" #n ")" ::: "memory")
#define PG8_WAIT_L(n) asm volatile("s_waitcnt lgkmcnt(" #n ")" ::: "memory")
#define PG8_BAR __builtin_amdgcn_s_barrier()
#define PG8_SCHED __builtin_amdgcn_sched_barrier(0)
    Unit cur, nxt; int ui = 0;
    if (!S.next(0, cur)) return;
    f32x4 acc[2][2][4][2];
#pragma unroll
    for (int a = 0; a < 2; ++a)
#pragma unroll
        for (int b = 0; b < 2; ++b)
#pragma unroll
            for (int m = 0; m < 4; ++m)
#pragma unroll
                for (int n = 0; n < 2; ++n) acc[a][b][m][n] = (f32x4){0.f, 0.f, 0.f, 0.f};
    bf16x8 At[4][2], B0[2][2], B1[2][2];
    const char* cA = (const char*)g.A + (size_t)cur.pm * tstep; const char* cB = (const char*)g.Bt + (size_t)cur.pn * tstep;
    S.a_ready(cur);
    if constexpr (SP2) {
        PG8_STAGE(PG8_SB(0, 0), cB, voffB); PG8_STAGE(PG8_SB(0, 1), cB + hstep, voffB); PG8_STAGE(PG8_SA(0, 0), cA, voffA); PG8_STAGE(PG8_SA(0, 1), cA + hstep, voffA);
        if (wr == 1) PG8_BAR;
        PG8_WAIT_V(2); PG8_BAR;
        PG8_STAGE(PG8_SB(1, 0), cB + kstep, voffB); PG8_STAGE(PG8_SA(1, 0), cA + kstep, voffA); PG8_STAGE(PG8_SB(1, 1), cB + hstep + kstep, voffB);
        PG8_WAIT_V(6); PG8_BAR;
    } else {
        PG8_STAGE(PG8_SB(0, 0), cB, voffB); PG8_STAGE(PG8_SA(0, 0), cA, voffA); PG8_STAGE(PG8_SB(0, 1), cB + hstep, voffB); PG8_STAGE(PG8_SA(0, 1), cA + hstep, voffA);
        if (wr == 1) PG8_BAR;
        PG8_WAIT_V(4); PG8_BAR;
        PG8_STAGE(PG8_SB(1, 0), cB + kstep, voffB); PG8_STAGE(PG8_SA(1, 0), cA + kstep, voffA); PG8_STAGE(PG8_SB(1, 1), cB + hstep + kstep, voffB);
        PG8_WAIT_V(6); PG8_BAR;
    }
    for (;;) {
        const bool has_next = S.next(ui + 1, nxt);
        const char* nA = has_next ? (const char*)g.A + (size_t)nxt.pm * tstep : cA; const char* nB = has_next ? (const char*)g.Bt + (size_t)nxt.pn * tstep : cB;
        for (int t = 0; t < nt; t += 2) {
            const bool last = (t == nt - 2);
            const char* a1 = cA + (size_t)(t + 1) * kstep;
            const char* a2 = last ? nA : cA + (size_t)(t + 2) * kstep; const char* b2 = last ? nB : cB + (size_t)(t + 2) * kstep;
            const char* a3 = a2 + kstep; const char* b3 = b2 + kstep;
            if (last && has_next) S.a_ready(nxt);
            if constexpr (SP2) {
            PG8_LDB(B0, 0, 0); PG8_LDB(B1, 0, 1); PG8_SCHED; PG8_LDA(At, 0, 0); PG8_STAGE(PG8_SA(1, 1), a1 + hstep, voffA);
            PG8_WAIT_V(8); PG8_WAIT_L(0); PG8_BAR; PG8_MMA(0, 0, At, B0); PG8_MMA(0, 1, At, B1); PG8_BAR; PG8_SCHED;
            PG8_LDA(At, 0, 1); PG8_STAGE(PG8_SB(0, 0), b2, voffB); PG8_STAGE(PG8_SB(0, 1), b2 + hstep, voffB); PG8_STAGE(PG8_SA(0, 0), a2, voffA);
            PG8_WAIT_V(8); PG8_WAIT_L(0); PG8_BAR; PG8_MMA(1, 0, At, B0); PG8_MMA(1, 1, At, B1); PG8_BAR; PG8_SCHED;
            PG8_LDB(B0, 1, 0); PG8_LDB(B1, 1, 1); PG8_SCHED; PG8_LDA(At, 1, 0); PG8_STAGE(PG8_SA(0, 1), a2 + hstep, voffA);
            PG8_WAIT_V(8); PG8_WAIT_L(0); PG8_BAR; PG8_MMA(0, 0, At, B0); PG8_MMA(0, 1, At, B1); PG8_BAR; PG8_SCHED;
            PG8_LDA(At, 1, 1); PG8_STAGE(PG8_SB(1, 0), b3, voffB); PG8_STAGE(PG8_SB(1, 1), b3 + hstep, voffB); PG8_STAGE(PG8_SA(1, 0), a3, voffA);
            PG8_WAIT_V(8); PG8_WAIT_L(0); PG8_BAR; PG8_MMA(1, 0, At, B0); PG8_MMA(1, 1, At, B1); PG8_BAR; PG8_SCHED;
            } else {
            PG8_LDB(B0, 0, 0); PG8_SCHED; PG8_LDA(At, 0, 0); PG8_STAGE(PG8_SA(1, 1), a1 + hstep, voffA);
            PG8_WAIT_L(8); PG8_BAR; PG8_WAIT_L(0); PG8_MMA(0, 0, At, B0); PG8_BAR; PG8_SCHED;
            PG8_LDB(B1, 0, 1); PG8_STAGE(PG8_SB(0, 0), b2, voffB);
            PG8_BAR; PG8_WAIT_L(0); PG8_MMA(0, 1, At, B1); PG8_BAR;
            PG8_LDA(At, 0, 1); PG8_STAGE(PG8_SA(0, 0), a2, voffA);
            PG8_BAR; PG8_WAIT_L(0); PG8_MMA(1, 0, At, B0); PG8_BAR; PG8_SCHED;
            PG8_STAGE(PG8_SB(0, 1), b2 + hstep, voffB);
            PG8_WAIT_V(6); PG8_BAR; PG8_MMA(1, 1, At, B1); PG8_BAR;
            PG8_LDB(B0, 1, 0); PG8_SCHED; PG8_LDA(At, 1, 0); PG8_STAGE(PG8_SA(0, 1), a2 + hstep, voffA);
            PG8_WAIT_L(8); PG8_BAR; PG8_WAIT_L(0); PG8_MMA(0, 0, At, B0); PG8_BAR; PG8_SCHED;
            PG8_LDB(B1, 1, 1); PG8_STAGE(PG8_SB(1, 0), b3, voffB);
            PG8_BAR; PG8_WAIT_L(0); PG8_MMA(0, 1, At, B1); PG8_BAR;
            PG8_LDA(At, 1, 1); PG8_STAGE(PG8_SA(1, 0), a3, voffA);
            PG8_BAR; PG8_WAIT_L(0); PG8_MMA(1, 0, At, B0); PG8_BAR; PG8_SCHED;
            PG8_STAGE(PG8_SB(1, 1), b3 + hstep, voffB);
            PG8_WAIT_V(6); PG8_BAR; PG8_MMA(1, 1, At, B1); PG8_BAR;
            }
        }
        if constexpr (ALIGN_EPI) { if (wr == 0) PG8_BAR; }
        if constexpr (!Epi::AFTER_DRAIN) { E(acc, cur, wr, wc, fr, fq); S.done(cur); }
        if (!has_next) break;
#pragma unroll
        for (int a = 0; a < 2; ++a)
#pragma unroll
            for (int b = 0; b < 2; ++b)
#pragma unroll
                for (int m = 0; m < 4; ++m)
#pragma unroll
                    for (int n = 0; n < 2; ++n) acc[a][b][m][n] = (f32x4){0.f, 0.f, 0.f, 0.f};
        cur = nxt; cA = nA; cB = nB; ++ui;
        if constexpr (ALIGN_EPI) { if (wr == 1) PG8_BAR; }
    }
    PG8_WAIT_V(0);
    if constexpr (!ALIGN_EPI) { if (wr == 0) PG8_BAR; }
    PG8_BAR;
    if constexpr (Epi::AFTER_DRAIN) { E.fused(acc, cur, wr, wc, fr, fq, lds, wid, lane); S.done(cur); }
#undef PG8_SA
#undef PG8_SB
#undef PG8_STAGE
#undef PG8_LDA
#undef PG8_LDB
#undef PG8_MMA
#undef PG8_WAIT_V
#undef PG8_WAIT_L
#undef PG8_BAR
#undef PG8_SCHED
}
}
#ifndef PG8_SP2
#define PG8_SP2 true
#endif
#ifndef PG8_ALIGN
#define PG8_ALIGN true
#endif
constexpr int NB = 8, SEQ = 2048, DM = 1024, M = NB * SEQ;
constexpr int GH = 4, GD = 128, GW = 512, AH = 8, AD = 64;
constexpr int INC = 3592, NP = 3584;
constexpr int DFF = 2816, NUP = 2 * DFF;
constexpr int PC_QA = 0, PC_KA = 512, PC_VA = 1024, PC_Z = 1536, PC_QB = 2048, PC_KB = 2560, PC_VB = 3072;
constexpr size_t MiB = 1u << 20;
constexpr size_t WS_CTL = 0, WS_AB = 1 * MiB, WS_SSQ = 1 * MiB + 768 * 1024, WS_WIN = 2 * MiB, WS_WOUT = 9 * MiB, WS_WUP = 11 * MiB, WS_WDN = 22 * MiB;
constexpr size_t WS_XN = 28 * MiB, WS_PROJ = 60 * MiB, WS_CAT = 172 * MiB, WS_OA = 204 * MiB, WS_Y = 60 * MiB, WS_ACT = 148 * MiB, WS_END = 256 * MiB;
using pg8::RMS_EPS;
constexpr size_t WS_YH = 236 * MiB, WS_UPART = 240 * MiB;
constexpr size_t WS_SSQ2 = WS_SSQ + 131072;
constexpr size_t WS_GE = WS_SSQ + 65536;
constexpr int GOPS_CHUNK = 57344;
constexpr int SCAN_BUF = GOPS_CHUNK + 16384;
constexpr int NWAVES = 8, NTHR = 512;
constexpr int LDS_BYTES = 155648;
#define LAS __attribute__((address_space(3)))
typedef unsigned short bf16;
typedef unsigned v4u __attribute__((ext_vector_type(4)));
typedef unsigned v2u __attribute__((ext_vector_type(2)));
typedef float f32x4 __attribute__((ext_vector_type(4)));
__device__ __forceinline__ float bf2f(unsigned b) { return __uint_as_float(b << 16); }
__device__ __forceinline__ float bflo(unsigned w) { return __uint_as_float(w << 16); }
__device__ __forceinline__ float bfhi(unsigned w) { return __uint_as_float(w & 0xffff0000u); }
__device__ __forceinline__ unsigned pk2(float lo, float hi) { return pg8::cvt_pk_bf16(lo, hi); }
__device__ __forceinline__ float wave_sum(float v) {
#pragma unroll
    for (int o = 1; o < 64; o <<= 1) v += __shfl_xor(v, o);
    return v;
}
__device__ __forceinline__ float silu_f(float x) { return x * __builtin_amdgcn_rcpf(1.0f + __expf(-x)); }
__device__ __forceinline__ float sigmoid_f(float x) { return __builtin_amdgcn_rcpf(1.0f + __expf(-x)); }
__device__ __forceinline__ float softplus_f(float x) { return x > 20.f ? x : log1pf(__expf(x)); }

struct Args { const float* in[13]; float* out; unsigned char* ws; int ph_lo, ph_hi, coop, pad; };

__device__ __forceinline__ void p0_transpose_item(const float* W, int ldw, int k0, int sn0, bf16* WT, int K, int dn0, const float* kscale, LAS float* scr, int lane) {
    float tv[32];
#pragma unroll
    for (int i = 0; i < 32; ++i) { const int kk = 2 * i + (lane >> 5); tv[i] = W[(size_t)(k0 + kk) * ldw + sn0 + (lane & 31)]; }
    if (kscale) {
#pragma unroll
        for (int i = 0; i < 32; ++i) tv[i] *= kscale[k0 + 2 * i + (lane >> 5)]; }
#pragma unroll
    for (int i = 0; i < 32; ++i) scr[(2 * i + (lane >> 5)) * 33 + (lane & 31)] = tv[i];
    asm volatile("s_waitcnt lgkmcnt(0)" ::: "memory");
    const int c = lane & 7;
#pragma unroll
    for (int j = 0; j < 4; ++j) { const int n = (lane >> 3) + 8 * j; const LAS float* s = scr + (8 * c) * 33 + n;
        v4u o; o.x = pk2(s[0 * 33], s[1 * 33]); o.y = pk2(s[2 * 33], s[3 * 33]); o.z = pk2(s[4 * 33], s[5 * 33]); o.w = pk2(s[6 * 33], s[7 * 33]);
        *(v4u*)(WT + (size_t)(dn0 + n) * K + k0 + 8 * c) = o; }
    asm volatile("s_waitcnt lgkmcnt(0)" ::: "memory");
}

__device__ __forceinline__ void p0_prologue(const Args& A, LAS unsigned char* lds, int tid, int lane, int wave) {
    const float* x = A.in[0]; const float* nw1 = A.in[1]; const float* w_in = A.in[2]; const float* w_out = A.in[7]; const float* nw2 = A.in[8];
    const float* w_up = A.in[9]; const float* w_dn = A.in[11];
    unsigned char* ws = A.ws;
    bf16* WIN = (bf16*)(ws + WS_WIN); bf16* WOUT = (bf16*)(ws + WS_WOUT); bf16* WUP = (bf16*)(ws + WS_WUP); bf16* WDN = (bf16*)(ws + WS_WDN);
    bf16* XN = (bf16*)(ws + WS_XN); float* AB = (float*)(ws + WS_AB); float* SSQ = (float*)(ws + WS_SSQ);
    LAS float* scr = (LAS float*)(lds + wave * 9216);
    LAS float* wab = (LAS float*)(lds + 73728);
    const int G = gridDim.x, gw = blockIdx.x * NWAVES + wave, NGW = G * NWAVES;
    for (int i = blockIdx.x * NTHR + tid; i < M; i += G * NTHR) { SSQ[i] = 0.f; ((float*)(ws + WS_SSQ2))[i] = 0.f; }
    if (blockIdx.x == 0 && tid < 64) ((unsigned*)(ws + WS_CTL))[tid] = 0u;
    for (int idx = tid; idx < 8192; idx += NTHR) { const int k = idx >> 3, j = idx & 7; wab[j * 1024 + k] = nw1[k] * w_in[(size_t)k * INC + 2048 + j]; }
    constexpr int I_IN = 16 * (NP / 32);
    for (int it = gw; it < I_IN; it += NGW) { const int nblk = NP / 32, kb = it / nblk, nb = it % nblk, n0 = 32 * nb; p0_transpose_item(w_in, INC, 64 * kb, n0 + (n0 >= 2048 ? 8 : 0), WIN, DM, n0, nullptr, scr, lane); }
    __syncthreads();
    for (int m0 = gw; m0 < M; m0 += 2 * NGW) {
        const f32x4* nr = (const f32x4*)nw1 + lane;
        f32x4 v[2][4]; float s[2] = {0.f, 0.f};
#pragma unroll
        for (int rr = 0; rr < 2; ++rr) { const int m = min(m0 + rr * NGW, M - 1); const f32x4* xr = (const f32x4*)(x + (size_t)m * DM) + lane;
#pragma unroll
            for (int j = 0; j < 4; ++j) v[rr][j] = xr[64 * j]; }
#pragma unroll
        for (int rr = 0; rr < 2; ++rr)
#pragma unroll
            for (int j = 0; j < 4; ++j) s[rr] += (v[rr][j].x * v[rr][j].x + v[rr][j].y * v[rr][j].y) + (v[rr][j].z * v[rr][j].z + v[rr][j].w * v[rr][j].w);
#pragma unroll
        for (int rr = 0; rr < 2; ++rr) { const int m = m0 + rr * NGW; if (m >= M) break;
            const float rstd = rsqrtf(wave_sum(s[rr]) * (1.f / DM) + RMS_EPS);
            float ab[8];
#pragma unroll
            for (int q = 0; q < 8; ++q) { float a = 0.f;
#pragma unroll
                for (int j = 0; j < 4; ++j) { const f32x4 w = *(const LAS f32x4*)(wab + q * 1024 + 256 * j + 4 * lane); a += (v[rr][j].x * w.x + v[rr][j].y * w.y) + (v[rr][j].z * w.z + v[rr][j].w * w.w); }
                ab[q] = wave_sum(a) * rstd; }
            if (lane == 0) { *(f32x4*)(AB + (size_t)m * 8) = (f32x4){ab[0], ab[1], ab[2], ab[3]}; *(f32x4*)(AB + (size_t)m * 8 + 4) = (f32x4){ab[4], ab[5], ab[6], ab[7]}; }
            v2u* o8 = (v2u*)(XN + (size_t)m * DM) + lane;
#pragma unroll
            for (int j = 0; j < 4; ++j) { const f32x4 n = nr[64 * j]; v2u o; o.x = pk2(v[rr][j].x * rstd * n.x, v[rr][j].y * rstd * n.y); o.y = pk2(v[rr][j].z * rstd * n.z, v[rr][j].w * rstd * n.w); o8[64 * j] = o; }
        }
    }
}


__device__ __forceinline__ void convert_late_weights(const Args& A, LAS unsigned char* lds, int lane, int wave, int gw0, int ngw) {
    const float* w_out = A.in[7]; const float* nw2 = A.in[8]; const float* w_up = A.in[9]; const float* w_dn = A.in[11];
    bf16* WOUT = (bf16*)(A.ws + WS_WOUT); bf16* WUP = (bf16*)(A.ws + WS_WUP); bf16* WDN = (bf16*)(A.ws + WS_WDN);
    LAS float* scr = (LAS float*)(lds + wave * 9216);
    constexpr int I_OUT = 16 * 32, I_UP = 16 * (NUP / 32), I_DN = (DFF / 64) * 32;
    for (int it = gw0; it < I_OUT + I_UP + I_DN; it += ngw) {
        int r = it;
        if (r < I_OUT) { const int kb = r / 32, nb = r % 32; p0_transpose_item(w_out, DM, 64 * kb, 32 * nb, WOUT, DM, 32 * nb, nullptr, scr, lane); continue; } r -= I_OUT;
        if (r < I_UP) { const int nblk = NUP / 32, kb = r / nblk, nb = r % nblk, n0 = 32 * nb, pn = n0 >> 8, j0 = n0 & 255;
            const int s0 = (j0 < 128) ? (128 * pn + j0) : (DFF + 128 * pn + j0 - 128);
            p0_transpose_item(w_up, NUP, 64 * kb, s0, WUP, DM, n0, nw2, scr, lane); continue; } r -= I_UP;
        { const int kb = r / 32, nb = r % 32; p0_transpose_item(w_dn, DM, 64 * kb, 32 * nb, WDN, DFF, 32 * nb, nullptr, scr, lane); }
    }
}
__device__ __forceinline__ void gdn_simple(const Args& A, LAS unsigned char* lds, int tid, int lane, int wave) {
    const bf16* PROJ = (const bf16*)(A.ws + WS_PROJ); const float* AB = (const float*)(A.ws + WS_AB); float* OA = (float*)(A.ws + WS_OA);
    const float* cw = A.in[3]; const float* a_log = A.in[4]; const float* dt_bias = A.in[5];
    LAS float* qs = (LAS float*)lds; LAS float* ks = qs + 16 * 128; LAS float* vs = ks + 16 * 128; LAS float* av = vs + 16 * 128; LAS float* bv = av + 16;
    for (int task = blockIdx.x; task < NB * GH; task += gridDim.x) {
        const int b = task / GH, h = task % GH, v = tid >> 2, part = tid & 3;
        float S[32];
#pragma unroll
        for (int i = 0; i < 32; ++i) S[i] = 0.f;
        const float Ah = __expf(a_log[h]), dtb = dt_bias[h];
        for (int blk = 0; blk < SEQ / 16; ++blk) {
            const int t0 = blk * 16;
            for (int idx = tid; idx < 16 * 384; idx += NTHR) {
                const int tt = idx / 384, c = idx % 384, which = c >> 7, d = c & 127, col = which * 512 + h * 128 + d, t = t0 + tt;
                float acc = 0.f;
#pragma unroll
                for (int i = 0; i < 4; ++i) { const int ts = t - 3 + i; if (ts >= 0) acc += cw[i * 1536 + col] * bf2f(PROJ[(size_t)(b * SEQ + ts) * NP + col]); }
                qs[which * 2048 + tt * 128 + d] = silu_f(acc);
            }
            if (tid < 16) { const size_t row = (size_t)b * SEQ + t0 + tid; bv[tid] = sigmoid_f(AB[row * 8 + h]); av[tid] = __expf(-Ah * softplus_f(AB[row * 8 + 4 + h] + dtb)); }
            __syncthreads();
#pragma unroll
            for (int r = 0; r < 4; ++r) { const int row = 4 * wave + r; LAS float* arr = qs + row * 128;
                const float v0 = arr[lane], v1 = arr[lane + 64]; const float s = wave_sum(v0 * v0 + v1 * v1);
                const float sc = rsqrtf(s + RMS_EPS) * (row < 16 ? 0.08838834764831845f : 1.0f); arr[lane] = v0 * sc; arr[lane + 64] = v1 * sc; }
            __syncthreads();
            for (int tt = 0; tt < 16; ++tt) {
                const float a = av[tt], bt = bv[tt], vt = vs[tt * 128 + v];
                float kS = 0.f;
#pragma unroll
                for (int i = 0; i < 32; ++i) kS += ks[tt * 128 + 32 * part + i] * S[i];
                kS += __shfl_xor(kS, 1); kS += __shfl_xor(kS, 2);
                const float c = bt * (vt - a * kS); float o = 0.f;
#pragma unroll
                for (int i = 0; i < 32; ++i) { S[i] = a * S[i] + ks[tt * 128 + 32 * part + i] * c; o += qs[tt * 128 + 32 * part + i] * S[i]; }
                o += __shfl_xor(o, 1); o += __shfl_xor(o, 2);
                if (part == 0) OA[(size_t)(b * SEQ + t0 + tt) * GW + h * 128 + v] = o;
            }
            __syncthreads();
        }
    }
}


template <int J, int K, int N> struct SolveLd {
    static __device__ __forceinline__ void run(f32x4 (&l)[4], unsigned lbase) {
        if constexpr (K < N) { constexpr int t40 = ((J + 1) >> 2) << 2;
            asm volatile("ds_read_b128 %0, %1 offset:%2" : "=v"(l[K]) : "v"(lbase), "i"((J * 68 + t40 + 4 * K) * 4)); SolveLd<J, K + 1, N>::run(l, lbase); }
    }
};
template <int J> struct SolveCol16 {
    static __device__ __forceinline__ void run(float (&R)[16], unsigned lbase) {
        if constexpr (J < 15) {
            constexpr int t40 = ((J + 1) >> 2) << 2, nld = (16 - t40) >> 2;
            f32x4 l[4];
            SolveLd<J, 0, nld>::run(l, lbase);
            asm volatile("s_waitcnt lgkmcnt(0)" ::: "memory");
#pragma unroll
            for (int k = 0; k < nld; ++k) asm volatile("" : "+v"(l[k]));
#pragma unroll
            for (int k = 0; k < nld; ++k) {
#pragma unroll
                for (int e = 0; e < 4; ++e) if (t40 + 4 * k + e > J) R[t40 + 4 * k + e] += l[k][e] * R[J]; }
            SolveCol16<J + 1>::run(R, lbase);
        }
    }
};

typedef short bf16x8 __attribute__((ext_vector_type(8)));
__device__ __forceinline__ void gdn_prep(const Args& A, LAS unsigned char* lds, int tid0, int lane0, int wave) {
    const bf16* PROJ = (const bf16*)(A.ws + WS_PROJ); const float* AB = (const float*)(A.ws + WS_AB);
    const float* cw = A.in[3]; const float* a_log = A.in[4]; const float* dt_bias = A.in[5];
    unsigned char* UVF = A.ws + WS_XN; unsigned char* GOPS = (unsigned char*)A.out; float* GE = (float*)(A.ws + WS_GE);
    LAS float* Qs = (LAS float*)lds; LAS float* Ks = (LAS float*)(lds + 33792); LAS float* Vs = (LAS float*)(lds + 67584);
    LAS bf16* Qb = (LAS bf16*)(lds + 101376); LAS bf16* Kb = (LAS bf16*)(lds + 118784);
    LAS float* gcs = (LAS float*)(lds + 136192); LAS float* bts = gcs + 64; LAS float* egs = gcs + 128; LAS float* kes = gcs + 192;
    LAS float* LsT = (LAS float*)lds; LAS bf16* ATs = (LAS bf16*)(lds + 17408); LAS bf16* WKs = Kb;
#pragma unroll 1
    for (int task = blockIdx.x; task < NB * GH * 32; task += gridDim.x) {
        int tid = tid0, lane = lane0; asm volatile("" : "+v"(tid), "+v"(lane));
        const int fr = lane & 15, fq = lane >> 4;
        const int bh = task >> 5, n = task & 31, b = bh >> 2, h = bh & 3, t0 = 64 * n, row0 = b * SEQ + t0;
        unsigned char* gops = GOPS + (size_t)task * GOPS_CHUNK;
        if (tid < 384) {
            const int c8 = tid % 48, run = tid / 48, which = c8 >> 4, d0 = (c8 & 15) * 8, col = which * 512 + h * 128 + d0;
            v4u rw[11];
#pragma unroll
            for (int r = 0; r < 11; ++r) { const int ts = t0 + 8 * run - 3 + r; rw[r] = (ts >= 0) ? *(const v4u*)(PROJ + (size_t)(b * SEQ + ts) * NP + col) : (v4u){0u, 0u, 0u, 0u}; }
            f32x4 cwa[4], cwb[4];
#pragma unroll
            for (int j = 0; j < 4; ++j) { cwa[j] = *(const f32x4*)(cw + j * 1536 + col); cwb[j] = *(const f32x4*)(cw + j * 1536 + col + 4); }
            LAS float* dstb = (which == 0 ? Qs : (which == 1 ? Ks : Vs)) + (8 * run) * 132 + d0;
#pragma unroll
            for (int i = 0; i < 8; ++i) {
                float acc[8];
#pragma unroll
                for (int e2 = 0; e2 < 8; ++e2) acc[e2] = 0.f;
#pragma unroll
                for (int j = 0; j < 4; ++j) { const v4u w = rw[i + j];
                    acc[0] += cwa[j].x * bflo(w.x); acc[1] += cwa[j].y * bfhi(w.x); acc[2] += cwa[j].z * bflo(w.y); acc[3] += cwa[j].w * bfhi(w.y);
                    acc[4] += cwb[j].x * bflo(w.z); acc[5] += cwb[j].y * bfhi(w.z); acc[6] += cwb[j].z * bflo(w.w); acc[7] += cwb[j].w * bfhi(w.w); }
                *(LAS f32x4*)(dstb + i * 132) = (f32x4){silu_f(acc[0]), silu_f(acc[1]), silu_f(acc[2]), silu_f(acc[3])};
                *(LAS f32x4*)(dstb + i * 132 + 4) = (f32x4){silu_f(acc[4]), silu_f(acc[5]), silu_f(acc[6]), silu_f(acc[7])};
            }
        }
        if (wave == 0) {
            const size_t row = (size_t)row0 + lane; const float beta = sigmoid_f(AB[row * 8 + h]);
            float g = -__expf(a_log[h]) * softplus_f(AB[row * 8 + 4 + h] + dt_bias[h]);
#pragma unroll
            for (int o = 1; o < 64; o <<= 1) { const float t = __shfl_up(g, o); if (lane >= o) g += t; }
            const float glast = __shfl(g, 63);
            gcs[lane] = g; bts[lane] = beta; egs[lane] = __expf(g); kes[lane] = __expf(glast - g) * beta;
            if (lane == 63) GE[task] = __expf(g);
        }
        __syncthreads();
#pragma unroll 2
        for (int r = 0; r < 8; ++r) { const int row = 8 * wave + r;
            { const float v0 = Qs[row * 132 + lane], v1 = Qs[row * 132 + lane + 64]; const float sc = rsqrtf(wave_sum(v0 * v0 + v1 * v1) + RMS_EPS) * 0.08838834764831845f;
              Qb[row * 136 + lane] = (bf16)(pk2(v0 * sc, 0.f) & 0xffffu); Qb[row * 136 + lane + 64] = (bf16)(pk2(v1 * sc, 0.f) & 0xffffu); }
            { const float v0 = Ks[row * 132 + lane], v1 = Ks[row * 132 + lane + 64]; const float sc = rsqrtf(wave_sum(v0 * v0 + v1 * v1) + RMS_EPS);
              Ks[row * 132 + lane] = v0 * sc; Ks[row * 132 + lane + 64] = v1 * sc; Kb[row * 136 + lane] = (bf16)(pk2(v0 * sc, 0.f) & 0xffffu); Kb[row * 136 + lane + 64] = (bf16)(pk2(v1 * sc, 0.f) & 0xffffu); }
        }
        __syncthreads();
#pragma unroll 1
        for (int jb = wave; jb < 20; jb += 8) {
            const int kind = jb >= 10 ? 1 : 0, idx = jb - 10 * kind, ti = idx < 1 ? 0 : (idx < 3 ? 1 : (idx < 6 ? 2 : 3)), tj = idx - ti * (ti + 1) / 2;
            const LAS bf16* As = kind ? Qb : Kb; f32x4 d = (f32x4){0.f, 0.f, 0.f, 0.f};
#pragma unroll
            for (int ks = 0; ks < 4; ++ks) { const bf16x8 a = *(const LAS bf16x8*)(As + (16 * ti + fr) * 136 + 32 * ks + 8 * fq), bb = *(const LAS bf16x8*)(Kb + (16 * tj + fr) * 136 + 32 * ks + 8 * fq);
                d = __builtin_amdgcn_mfma_f32_16x16x32_bf16(a, bb, d, 0, 0, 0); }
            const int j = 16 * tj + fr; const float gj = gcs[j], bj = bts[j]; float val[4];
#pragma unroll
            for (int e = 0; e < 4; ++e) { const int t = 16 * ti + 4 * fq + e; const float x = d[e] * __expf(gcs[t] - gj) * bj; val[e] = (kind ? (t >= j) : (t > j)) ? x : 0.f; }
            if (kind == 0) *(LAS f32x4*)(LsT + j * 68 + 16 * ti + 4 * fq) = (f32x4){-val[0], -val[1], -val[2], -val[3]};
            else {
#pragma unroll
                for (int e = 0; e < 4; ++e) ATs[(16 * ti + 4 * fq + e) * 72 + j] = (bf16)(pk2(val[e], 0.f) & 0xffffu); }
        }
        __syncthreads();
        LAS float* Ti = (LAS float*)(lds + 26624);
        if (wave == 0) {
            const int I = lane >> 4, c = lane & 15; float x[16];
#pragma unroll
            for (int r = 0; r < 16; ++r) x[r] = (r == c) ? 1.0f : 0.0f;
            SolveCol16<0>::run(x, (unsigned)(uintptr_t)LsT + (unsigned)(I * (16 * 68 + 16) * 4));
#pragma unroll
            for (int r = 0; r < 16; ++r) Ti[(I * 16 + r) * 20 + c] = x[r];
        } else {
            const int rt = tid - 64;
            for (int q = rt; q < 1024; q += 448) { const int blk = q >> 6, l2 = q & 63, i = l2 & 15, f = l2 >> 4, mb = blk >> 2, ks = blk & 3, t = 16 * mb + i;
                const v2u p0 = *(const LAS v2u*)(Qb + t * 136 + 32 * ks + 4 * f), p1 = *(const LAS v2u*)(Qb + t * 136 + 32 * ks + 16 + 4 * f); const float eg = egs[t];
                v4u o; o.x = pk2(bflo(p0.x) * eg, bfhi(p0.x) * eg); o.y = pk2(bflo(p0.y) * eg, bfhi(p0.y) * eg); o.z = pk2(bflo(p1.x) * eg, bfhi(p1.x) * eg); o.w = pk2(bflo(p1.y) * eg, bfhi(p1.y) * eg);
                *(v4u*)(gops + 16384 + q * 16) = o; }
            for (int q = rt; q < 512; q += 448) { const int blk = q >> 6, l2 = q & 63, i = l2 & 15, f = l2 >> 4, mb = blk >> 1, ks2 = blk & 1, t = 16 * mb + i;
                v2u p0 = (v2u){0u, 0u}, p1 = (v2u){0u, 0u};
                if (2 * ks2 <= mb) p0 = *(const LAS v2u*)(ATs + t * 72 + 32 * ks2 + 4 * f);
                if (2 * ks2 + 1 <= mb) p1 = *(const LAS v2u*)(ATs + t * 72 + 32 * ks2 + 16 + 4 * f);
                *(v4u*)(gops + 32768 + q * 16) = (v4u){p0.x, p0.y, p1.x, p1.y}; }
            for (int q = rt; q < 1024; q += 448) { const int blk = q >> 6, l2 = q & 63, i = l2 & 15, f = l2 >> 4, dkb = blk >> 1, ks2 = blk & 1, dk = 16 * dkb + i; float v[8];
#pragma unroll
                for (int e2 = 0; e2 < 8; ++e2) { const int c = 32 * ks2 + 16 * (e2 >> 2) + 4 * f + (e2 & 3); v[e2] = Ks[c * 132 + dk] * kes[c]; }
                *(v4u*)(gops + 40960 + q * 16) = (v4u){pk2(v[0], v[1]), pk2(v[2], v[3]), pk2(v[4], v[5]), pk2(v[6], v[7])}; }
        }
        __syncthreads();
#pragma unroll 1
        for (int ct = 0; ct < 2; ++ct) {
            const int C = 2 * wave + ct; const bool isv = C < 8; const int col = isv ? 16 * C + fr : 16 * (C - 8) + fr;
            f32x4 X[4];
#pragma unroll
            for (int I = 0; I < 4; ++I) {
                f32x4 acc;
#pragma unroll
                for (int e2 = 0; e2 < 4; ++e2) { const int t = 16 * I + 4 * fq + e2; acc[e2] = isv ? Vs[t * 132 + col] : egs[t] * Ks[t * 132 + col]; }
#pragma unroll
                for (int J = 0; J < 4; ++J) if (J < I) {
#pragma unroll
                    for (int kk = 0; kk < 4; ++kk) acc = __builtin_amdgcn_mfma_f32_16x16x4f32(LsT[(16 * J + 4 * fq + kk) * 68 + 16 * I + fr], X[J][kk], acc, 0, 0, 0); }
                f32x4 xi = (f32x4){0.f, 0.f, 0.f, 0.f};
#pragma unroll
                for (int kk = 0; kk < 4; ++kk) xi = __builtin_amdgcn_mfma_f32_16x16x4f32(Ti[(I * 16 + fr) * 20 + 4 * fq + kk], acc[kk], xi, 0, 0, 0);
                X[I] = xi;
                if (isv) { v2u w; w.x = pk2(xi[0], xi[1]); w.y = pk2(xi[2], xi[3]); *(v2u*)(UVF + (size_t)task * 16384 + (size_t)((C * 4 + I) * 64 + lane) * 8) = w; }
                else {
#pragma unroll
                    for (int e2 = 0; e2 < 4; ++e2) WKs[(16 * I + 4 * fq + e2) * 136 + col] = (bf16)(pk2(xi[e2], 0.f) & 0xffffu); }
            }
        }
        __syncthreads();
        for (int q = tid; q < 1024; q += NTHR) { const int blk = q >> 6, l2 = q & 63, i = l2 & 15, f = l2 >> 4, mb = blk >> 2, ks = blk & 3, t = 16 * mb + i;
            const v2u p0 = *(const LAS v2u*)(WKs + t * 136 + 32 * ks + 4 * f), p1 = *(const LAS v2u*)(WKs + t * 136 + 32 * ks + 16 + 4 * f);
            *(v4u*)(gops + q * 16) = (v4u){p0.x, p0.y, p1.x, p1.y}; }
        __syncthreads();
    }
}

__device__ __forceinline__ bf16x8 pack8(const f32x4 a, const f32x4 b) {
    v4u w; w.x = pk2(a[0], a[1]); w.y = pk2(a[2], a[3]); w.z = pk2(b[0], b[1]); w.w = pk2(b[2], b[3]); return __builtin_bit_cast(bf16x8, w);
}
__device__ __forceinline__ void gdn_scan(const Args& A, LAS unsigned char* lds, int bh, int tid, int lane, int wave) {
    const int b = bh >> 2, h = bh & 3, fr = lane & 15, fq = lane >> 4, vs = wave;
    const unsigned char* gops = (const unsigned char*)A.out + (size_t)bh * 32 * GOPS_CHUNK;
    const unsigned char* uvf = A.ws + WS_XN + (size_t)bh * 32 * 16384; const float* GE = (const float*)(A.ws + WS_GE) + bh * 32;
    float* Op = (float*)(A.ws + WS_OA) + ((size_t)b * SEQ + 4 * fq) * GW + h * 128 + 16 * vs + fr;
    f32x4 S[8];
#pragma unroll
    for (int i = 0; i < 8; ++i) S[i] = (f32x4){0.f, 0.f, 0.f, 0.f};
    const float gev = GE[lane & 31];
#define SCAN_DMA(chunk, bufoff) do { _Pragma("unroll") for (int i_ = 0; i_ < 9; ++i_) { const int p_ = wave + 8 * i_; \
        const unsigned char* s_ = (p_ < 56) ? (gops + (size_t)(chunk) * GOPS_CHUNK + p_ * 1024) : (uvf + (size_t)(chunk) * 16384 + (p_ - 56) * 1024); \
        __builtin_amdgcn_global_load_lds((const unsigned*)(s_ + lane * 16), (LAS unsigned*)(lds + (bufoff) + p_ * 1024), 16, 0, 0); } } while (0)
    SCAN_DMA(0, 0); SCAN_DMA(1, SCAN_BUF);
    asm volatile("s_waitcnt vmcnt(0)" ::: "memory"); __syncthreads();
#pragma unroll 1
    for (int n = 0; n < 32; ++n) {
        const LAS unsigned char* cur = lds + (n & 1) * SCAN_BUF;
        const float ge = __builtin_bit_cast(float, __builtin_amdgcn_readlane(__builtin_bit_cast(int, gev), n));
        bf16x8 Sb[4];
#pragma unroll
        for (int ks = 0; ks < 4; ++ks) Sb[ks] = pack8(S[2 * ks], S[2 * ks + 1]);
        f32x4 u[4];
#pragma unroll
        for (int mb = 0; mb < 4; ++mb) { f32x4 p = (f32x4){0.f, 0.f, 0.f, 0.f};
#pragma unroll
            for (int ks = 0; ks < 4; ++ks) p = __builtin_amdgcn_mfma_f32_16x16x32_bf16(*(const LAS bf16x8*)(cur + ((mb * 4 + ks) * 64 + lane) * 16), Sb[ks], p, 0, 0, 0);
            const v2u uw = *(const LAS v2u*)(cur + GOPS_CHUNK + ((vs * 4 + mb) * 64 + lane) * 8);
            u[mb] = (f32x4){bflo(uw.x) - p[0], bfhi(uw.x) - p[1], bflo(uw.y) - p[2], bfhi(uw.y) - p[3]}; }
        bf16x8 ub[2]; ub[0] = pack8(u[0], u[1]); ub[1] = pack8(u[2], u[3]);
        f32x4 o[4];
#pragma unroll
        for (int mb = 0; mb < 4; ++mb) { f32x4 acc = (f32x4){0.f, 0.f, 0.f, 0.f};
#pragma unroll
            for (int ks = 0; ks < 4; ++ks) acc = __builtin_amdgcn_mfma_f32_16x16x32_bf16(*(const LAS bf16x8*)(cur + 16384 + ((mb * 4 + ks) * 64 + lane) * 16), Sb[ks], acc, 0, 0, 0);
#pragma unroll
            for (int ks2 = 0; ks2 < 2; ++ks2) if (ks2 <= (mb >> 1)) acc = __builtin_amdgcn_mfma_f32_16x16x32_bf16(*(const LAS bf16x8*)(cur + 32768 + ((mb * 2 + ks2) * 64 + lane) * 16), ub[ks2], acc, 0, 0, 0);
            o[mb] = acc; }
#pragma unroll
        for (int dkb = 0; dkb < 8; ++dkb) { f32x4 acc = S[dkb] * ge;
#pragma unroll
            for (int ks2 = 0; ks2 < 2; ++ks2) acc = __builtin_amdgcn_mfma_f32_16x16x32_bf16(*(const LAS bf16x8*)(cur + 40960 + ((dkb * 2 + ks2) * 64 + lane) * 16), ub[ks2], acc, 0, 0, 0);
            S[dkb] = acc; }
        asm volatile("s_waitcnt vmcnt(0)" ::: "memory"); __syncthreads();
        if (n + 2 < 32) SCAN_DMA(n + 2, (n & 1) * SCAN_BUF);
        float* orow = Op + (size_t)(64 * n) * GW;
#pragma unroll
        for (int mb = 0; mb < 4; ++mb) { float* q = orow + (size_t)(16 * mb) * GW; q[0] = o[mb][0]; q[GW] = o[mb][1]; q[2 * GW] = o[mb][2]; q[3 * GW] = o[mb][3]; }
    }
    asm volatile("s_waitcnt vmcnt(0)" ::: "memory"); __syncthreads();
#undef SCAN_DMA
}


__device__ __forceinline__ void attn_fast(const Args& A, LAS unsigned char* lds, int lane, int wave) {
    const bf16* PROJ = (const bf16*)(A.ws + WS_PROJ); bf16* CAT = (bf16*)(A.ws + WS_CAT);
    unsigned* ctr = (unsigned*)(A.ws + WS_CTL);
    LAS bf16* Vt = (LAS bf16*)(lds + wave * 8192);
    const int fr = lane & 15, fq = lane >> 4;
    const int kk = lane & 31, vslot = 8 * ((kk & 15) >> 2) + 4 * (kk >> 4) + (kk & 3), vch = lane >> 5;
    constexpr float SC = 0.125f * 1.4426950408889634f;
    const int myx = (int)(__builtin_amdgcn_s_getreg((3 << 11) | 20) & 0x7u);
    int qi = 0;
    for (;;) {
        int wt = 512, xq = 0;
        while (qi < 8) { xq = (myx + qi) & 7; unsigned wt_ = 0; if (lane == 0) wt_ = atomicAdd(ctr + 16 * xq, 1u); wt = __builtin_amdgcn_readfirstlane(wt_); if (wt < 512) break; ++qi; }
        if (qi >= 8) break;
        const int b = wt >> 6, h = xq, rem = wt & 63, T = 7 - (rem >> 3), c4 = rem & 7, cA = (c4 & 3) + 8 * (c4 >> 2), cB = cA + 4, t0 = 256 * T;
        const bf16* Pb = PROJ + (size_t)b * SEQ * NP;
        const int tqA = t0 + cA + 16 * fr, tqB = tqA + 4;
        bf16x8 qfA[2], qfB[2];
#pragma unroll
        for (int ks = 0; ks < 2; ++ks) { qfA[ks] = *(const bf16x8*)(Pb + (size_t)tqA * NP + PC_QB + h * 64 + 32 * ks + 8 * fq); qfB[ks] = *(const bf16x8*)(Pb + (size_t)tqB * NP + PC_QB + h * 64 + 32 * ks + 8 * fq); }
        const int n2 = ((t0 + 240) >> 4) + 1, g2 = (n2 + 31) >> 5;
        const int lo1 = max(t0 + cA - 512, cA & 3), n1 = ((t0 + cB + 240 - lo1) >> 2) + 1, g1 = (n1 + 31) >> 5;
        const int lo0 = max(t0 + cA - 128, 0), n0 = (t0 + cB + 240 - lo0) + 1, g0 = (n0 + 31) >> 5;
        const int NG = 2 * g2 + g1 + g0;
        f32x4 OA[4], OB[4];
#pragma unroll
        for (int i = 0; i < 4; ++i) { OA[i] = (f32x4){0.f, 0.f, 0.f, 0.f}; OB[i] = OA[i]; }
        float mA = -INFINITY, lA = 0.f, mB = -INFINITY, lB = 0.f;
        v4u kc[4], vc[4], kn[4], vn[4];
#define ATT_DEC(f, kst, str, mode) do { if ((f) < g2) { str = 16; kst = cA + 512 * (f); mode = 1; } else if ((f) < 2 * g2) { str = 16; kst = cB + 512 * ((f) - g2); mode = 2; } \
            else if ((f) < 2 * g2 + g1) { str = 4; kst = lo1 + 128 * ((f) - 2 * g2); mode = 3; } else { str = 1; kst = lo0 + 32 * ((f) - 2 * g2 - g1); mode = 3; } } while (0)
#define ATT_LOAD(kreg, vreg, kst, str) do { \
            _Pragma("unroll") for (int j = 0; j < 2; ++j) { const int tk = min((kst) + (str) * (16 * j + fr), SEQ - 1); \
                _Pragma("unroll") for (int ks = 0; ks < 2; ++ks) kreg[2 * j + ks] = *(const v4u*)(Pb + (size_t)tk * NP + PC_KB + h * 64 + 32 * ks + 8 * fq); } \
            { const int tk = min((kst) + (str) * kk, SEQ - 1); \
                _Pragma("unroll") for (int i = 0; i < 4; ++i) vreg[i] = *(const v4u*)(Pb + (size_t)tk * NP + PC_VB + h * 64 + 8 * (vch + 2 * i)); } } while (0)
#define ATT_CLS(O_, m_, l_, qf_, tq_) do { \
            f32x4 d0 = (f32x4){0.f, 0.f, 0.f, 0.f}, d1 = d0; \
            _Pragma("unroll") for (int ks = 0; ks < 2; ++ks) { d0 = __builtin_amdgcn_mfma_f32_16x16x32_bf16(__builtin_bit_cast(bf16x8, kc[ks]), qf_[ks], d0, 0, 0, 0); \
                                                             d1 = __builtin_amdgcn_mfma_f32_16x16x32_bf16(__builtin_bit_cast(bf16x8, kc[2 + ks]), qf_[ks], d1, 0, 0, 0); } \
            float s[8]; float mloc = -INFINITY; \
            _Pragma("unroll") for (int e2 = 0; e2 < 8; ++e2) { const int tk = kst + str * (16 * (e2 >> 2) + 4 * fq + (e2 & 3)); const int dt = (tq_) - tk; const float x = (e2 < 4 ? d0[e2 & 3] : d1[e2 & 3]) * SC; \
                s[e2] = (dt >= 0 && dt <= span) ? x : -INFINITY; mloc = fmaxf(mloc, s[e2]); } \
            mloc = fmaxf(mloc, __shfl_xor(mloc, 16)); mloc = fmaxf(mloc, __shfl_xor(mloc, 32)); \
            const float mnew = fmaxf(m_, mloc), alpha = __builtin_amdgcn_exp2f(m_ - mnew); m_ = mnew; \
            float psum = 0.f; \
            _Pragma("unroll") for (int e2 = 0; e2 < 8; ++e2) { s[e2] = __builtin_amdgcn_exp2f(s[e2] - mnew); psum += s[e2]; } \
            l_ = l_ * alpha + psum; \
            const bf16x8 pb = pack8((f32x4){s[0], s[1], s[2], s[3]}, (f32x4){s[4], s[5], s[6], s[7]}); \
            _Pragma("unroll") for (int db = 0; db < 4; ++db) O_[db] = __builtin_amdgcn_mfma_f32_16x16x32_bf16(va[db], pb, O_[db] * alpha, 0, 0, 0); } while (0)
        int kst, str, mode; ATT_DEC(0, kst, str, mode); ATT_LOAD(kc, vc, kst, str);
#pragma unroll 1
        for (int f = 0; f < NG; ++f) {
            int kstn = 0, strn = 1, moden = 0;
            if (f + 1 < NG) { ATT_DEC(f + 1, kstn, strn, moden); ATT_LOAD(kn, vn, kstn, strn); }
#pragma unroll
            for (int i = 0; i < 4; ++i) { const int dd = 8 * (vch + 2 * i); const v4u w = vc[i];
                Vt[(dd + 0) * 40 + vslot] = (bf16)(w.x & 0xffffu); Vt[(dd + 1) * 40 + vslot] = (bf16)(w.x >> 16); Vt[(dd + 2) * 40 + vslot] = (bf16)(w.y & 0xffffu); Vt[(dd + 3) * 40 + vslot] = (bf16)(w.y >> 16);
                Vt[(dd + 4) * 40 + vslot] = (bf16)(w.z & 0xffffu); Vt[(dd + 5) * 40 + vslot] = (bf16)(w.z >> 16); Vt[(dd + 6) * 40 + vslot] = (bf16)(w.w & 0xffffu); Vt[(dd + 7) * 40 + vslot] = (bf16)(w.w >> 16); }
            bf16x8 va[4];
#pragma unroll
            for (int db = 0; db < 4; ++db) va[db] = *(const LAS bf16x8*)(Vt + (16 * db + fr) * 40 + 8 * fq);
            const int span = 128 * str;
            if (mode & 1) ATT_CLS(OA, mA, lA, qfA, tqA);
            if (mode & 2) ATT_CLS(OB, mB, lB, qfB, tqB);
#pragma unroll
            for (int i = 0; i < 4; ++i) { kc[i] = kn[i]; vc[i] = vn[i]; }
            kst = kstn; str = strn; mode = moden;
        }
#undef ATT_DEC
#undef ATT_LOAD
#undef ATT_CLS
        lA += __shfl_xor(lA, 16); lA += __shfl_xor(lA, 32); lB += __shfl_xor(lB, 16); lB += __shfl_xor(lB, 32);
        const float invA = 1.0f / lA, invB = 1.0f / lB;
        bf16* op = CAT + ((size_t)b * SEQ + tqA) * DM + GW + h * 64 + 4 * fq;
#pragma unroll
        for (int db = 0; db < 4; ++db) { v2u w; w.x = pk2(OA[db][0] * invA, OA[db][1] * invA); w.y = pk2(OA[db][2] * invA, OA[db][3] * invA); *(v2u*)(op + 16 * db) = w;
            v2u w2; w2.x = pk2(OB[db][0] * invB, OB[db][1] * invB); w2.y = pk2(OB[db][2] * invB, OB[db][3] * invB); *(v2u*)(op + 4 * DM + 16 * db) = w2; }
    }
}

__device__ __forceinline__ void attn_simple(const Args& A, int tid, int lane, int wave) {
    const bf16* PROJ = (const bf16*)(A.ws + WS_PROJ); bf16* CAT = (bf16*)(A.ws + WS_CAT);
    unsigned* ctr = (unsigned*)(A.ws + WS_CTL);
    for (;;) {
        unsigned wt_ = 0; if (lane == 0) wt_ = atomicAdd(ctr, 1u); const int wt = __builtin_amdgcn_readfirstlane(wt_);
        if (wt >= (M / 64) * AH) break;
        const int h = wt % AH, tb = wt / AH, row = tb * 64 + lane, b = row / SEQ, t = row % SEQ;
        float q[64], acc[64];
        { const v4u* qp = (const v4u*)(PROJ + (size_t)row * NP + PC_QB + h * 64);
#pragma unroll
          for (int j = 0; j < 8; ++j) { const v4u w = qp[j]; q[8 * j + 0] = bflo(w.x) * 0.125f; q[8 * j + 1] = bfhi(w.x) * 0.125f; q[8 * j + 2] = bflo(w.y) * 0.125f; q[8 * j + 3] = bfhi(w.y) * 0.125f;
              q[8 * j + 4] = bflo(w.z) * 0.125f; q[8 * j + 5] = bfhi(w.z) * 0.125f; q[8 * j + 6] = bflo(w.w) * 0.125f; q[8 * j + 7] = bfhi(w.w) * 0.125f; } }
#pragma unroll
        for (int j = 0; j < 64; ++j) acc[j] = 0.f;
        float mx = -1e30f, l = 0.f;
        for (int br = 0; br < 3; ++br) {
            const int stride = br == 0 ? 1 : (br == 1 ? 4 : 16);
            for (int i = 0; i <= 128; ++i) {
                const int tk = t - i * stride; if (tk < 0) break;
                const size_t krow = (size_t)(b * SEQ + tk) * NP;
                const v4u* kp = (const v4u*)(PROJ + krow + PC_KB + h * 64); const v4u* vp = (const v4u*)(PROJ + krow + PC_VB + h * 64);
                float s = 0.f;
#pragma unroll
                for (int j = 0; j < 8; ++j) { const v4u w = kp[j]; s += q[8 * j + 0] * bflo(w.x) + q[8 * j + 1] * bfhi(w.x) + q[8 * j + 2] * bflo(w.y) + q[8 * j + 3] * bfhi(w.y)
                                                                       + q[8 * j + 4] * bflo(w.z) + q[8 * j + 5] * bfhi(w.z) + q[8 * j + 6] * bflo(w.w) + q[8 * j + 7] * bfhi(w.w); }
                const float mn = fmaxf(mx, s), sc = __expf(mx - mn), p = __expf(s - mn); mx = mn; l = l * sc + p;
#pragma unroll
                for (int j = 0; j < 8; ++j) { const v4u w = vp[j];
                    acc[8 * j + 0] = acc[8 * j + 0] * sc + p * bflo(w.x); acc[8 * j + 1] = acc[8 * j + 1] * sc + p * bfhi(w.x); acc[8 * j + 2] = acc[8 * j + 2] * sc + p * bflo(w.y); acc[8 * j + 3] = acc[8 * j + 3] * sc + p * bfhi(w.y);
                    acc[8 * j + 4] = acc[8 * j + 4] * sc + p * bflo(w.z); acc[8 * j + 5] = acc[8 * j + 5] * sc + p * bfhi(w.z); acc[8 * j + 6] = acc[8 * j + 6] * sc + p * bflo(w.w); acc[8 * j + 7] = acc[8 * j + 7] * sc + p * bfhi(w.w); }
            }
        }
        const float inv = 1.0f / l; v4u* op = (v4u*)(CAT + (size_t)row * DM + GW + h * 64);
#pragma unroll
        for (int j = 0; j < 8; ++j) { v4u w; w.x = pk2(acc[8 * j] * inv, acc[8 * j + 1] * inv); w.y = pk2(acc[8 * j + 2] * inv, acc[8 * j + 3] * inv); w.z = pk2(acc[8 * j + 4] * inv, acc[8 * j + 5] * inv); w.w = pk2(acc[8 * j + 6] * inv, acc[8 * j + 7] * inv); op[j] = w; }
    }
}
__device__ __forceinline__ void gated_norm(const Args& A, int lane, int wave) {
    const bf16* PROJ = (const bf16*)(A.ws + WS_PROJ); bf16* CAT = (bf16*)(A.ws + WS_CAT); const float* OA = (const float*)(A.ws + WS_OA); const float* gw = A.in[6];
    const float w0 = gw[2 * lane], w1 = gw[2 * lane + 1];
    const int gwv = blockIdx.x * NWAVES + wave, NGW = gridDim.x * NWAVES;
    for (int wt0 = gwv; wt0 < M * GH; wt0 += 8 * NGW) {
        float2 o[8]; unsigned zz[8];
#pragma unroll
        for (int i = 0; i < 8; ++i) { const int wt = min(wt0 + i * NGW, M * GH - 1), row = wt / GH, h = wt % GH;
            o[i] = *(const float2*)(OA + (size_t)row * GW + h * 128 + 2 * lane); zz[i] = *(const unsigned*)(PROJ + (size_t)row * NP + PC_Z + h * 128 + 2 * lane); }
#pragma unroll
        for (int i = 0; i < 8; ++i) { const int wt = wt0 + i * NGW; if (wt >= M * GH) break; const int row = wt / GH, h = wt % GH;
            const float ms = wave_sum(o[i].x * o[i].x + o[i].y * o[i].y) * (1.0f / 128.0f), r = rsqrtf(ms + RMS_EPS);
            *(unsigned*)(CAT + (size_t)row * DM + h * 128 + 2 * lane) = pk2(o[i].x * r * w0 * silu_f(bflo(zz[i])), o[i].y * r * w1 * silu_f(bfhi(zz[i]))); }
    }
}

__device__ __forceinline__ void gated_norm_bh(const Args& A, int bh, int lane, int wave) {
    const int b = bh >> 2, h = bh & 3;
    const bf16* Zp = (const bf16*)(A.ws + WS_PROJ) + (size_t)b * SEQ * NP + PC_Z + h * 128 + 2 * lane; bf16* Cp = (bf16*)(A.ws + WS_CAT) + (size_t)b * SEQ * DM + h * 128 + 2 * lane;
    const float* Op = (const float*)(A.ws + WS_OA) + (size_t)b * SEQ * GW + h * 128 + 2 * lane; const float* gw = A.in[6];
    const float w0 = gw[2 * lane], w1 = gw[2 * lane + 1];
    __builtin_amdgcn_fence(__ATOMIC_ACQUIRE, "agent");
#pragma unroll 1
    for (int r0 = wave * 16; r0 < SEQ; r0 += NWAVES * 16) {
        float2 o[16]; unsigned zz[16];
#pragma unroll
        for (int i = 0; i < 16; ++i) { o[i] = *(const float2*)(Op + (size_t)(r0 + i) * GW); zz[i] = *(const unsigned*)(Zp + (size_t)(r0 + i) * NP); }
#pragma unroll
        for (int i = 0; i < 16; ++i) { const float ms = wave_sum(o[i].x * o[i].x + o[i].y * o[i].y) * (1.0f / 128.0f), r = rsqrtf(ms + RMS_EPS);
            *(unsigned*)(Cp + (size_t)(r0 + i) * DM) = pk2(o[i].x * r * w0 * silu_f(bflo(zz[i])), o[i].y * r * w1 * silu_f(bfhi(zz[i]))); }
    }
}
__device__ __forceinline__ void ffn_conv_half(const Args& A, int half, int tid) {
    const bf16* Y = (const bf16*)(A.ws + WS_Y); bf16* ACT = (bf16*)(A.ws + WS_ACT); const float* fw = A.in[10];
    constexpr int HC = DFF / 2;
    for (size_t it = (size_t)blockIdx.x * NTHR + tid; it < (size_t)M * (HC / 8); it += (size_t)gridDim.x * NTHR) {
        const int row = (int)(it / (HC / 8)), g8 = (int)(it % (HC / 8)), cl = g8 * 8, pn = cl >> 7, j = cl & 127, t = row % SEQ, ch = half * HC + cl;
        float ga[8], ua[8];
#pragma unroll
        for (int e = 0; e < 8; ++e) { ga[e] = 0.f; ua[e] = 0.f; }
#pragma unroll
        for (int i = 0; i < 3; ++i) { const int ts = t - 2 + i; if (ts < 0) continue;
            const bf16* yr = Y + (size_t)(row - 2 + i) * DFF + 256 * pn + j; const v4u g = *(const v4u*)yr, u = *(const v4u*)(yr + 128);
            const f32x4 wg0 = *(const f32x4*)(fw + i * NUP + ch), wg1 = *(const f32x4*)(fw + i * NUP + ch + 4), wu0 = *(const f32x4*)(fw + i * NUP + DFF + ch), wu1 = *(const f32x4*)(fw + i * NUP + DFF + ch + 4);
            ga[0] += wg0.x * bflo(g.x); ga[1] += wg0.y * bfhi(g.x); ga[2] += wg0.z * bflo(g.y); ga[3] += wg0.w * bfhi(g.y); ga[4] += wg1.x * bflo(g.z); ga[5] += wg1.y * bfhi(g.z); ga[6] += wg1.z * bflo(g.w); ga[7] += wg1.w * bfhi(g.w);
            ua[0] += wu0.x * bflo(u.x); ua[1] += wu0.y * bfhi(u.x); ua[2] += wu0.z * bflo(u.y); ua[3] += wu0.w * bfhi(u.y); ua[4] += wu1.x * bflo(u.z); ua[5] += wu1.y * bfhi(u.z); ua[6] += wu1.z * bflo(u.w); ua[7] += wu1.w * bfhi(u.w); }
        v4u o; o.x = pk2(silu_f(ga[0]) * ua[0], silu_f(ga[1]) * ua[1]); o.y = pk2(silu_f(ga[2]) * ua[2], silu_f(ga[3]) * ua[3]); o.z = pk2(silu_f(ga[4]) * ua[4], silu_f(ga[5]) * ua[5]); o.w = pk2(silu_f(ga[6]) * ua[6], silu_f(ga[7]) * ua[7]);
        *(v4u*)(ACT + (size_t)row * DFF + ch) = o;
    }
}

__device__ __forceinline__ void ffn_fixup(const Args& A, int tid) {
    const float* YH = (const float*)(A.ws + WS_YH); const float* UP = (const float*)(A.ws + WS_UPART); bf16* ACT = (bf16*)(A.ws + WS_ACT); const float* fw = A.in[10];
    for (int it = blockIdx.x * NTHR + tid; it < 64 * 22 * 2 * 128; it += gridDim.x * NTHR) {
        const int c = it & 127, r = (it >> 7) & 1, tile = it >> 8, pm = tile / 22, pn = tile % 22; if ((pm & 7) == 0) continue;
        const int ch = pn * 128 + c; const float* up = UP + ((size_t)tile * 2 + r) * 256; const float* yh = YH + (size_t)((pm - 1) * 22 + pn) * 2 * 256;
        float g = up[c], u = up[128 + c];
        const float wg0 = fw[ch], wg1 = fw[5632 + ch], wu0 = fw[2816 + ch], wu1 = fw[5632 + 2816 + ch];
        if (r == 0) { g += wg0 * yh[c] + wg1 * yh[256 + c]; u += wu0 * yh[128 + c] + wu1 * yh[256 + 128 + c]; }
        else { g += wg0 * yh[256 + c]; u += wu0 * yh[256 + 128 + c]; }
        ACT[(size_t)(pm * 256 + r) * DFF + ch] = (bf16)(pk2(silu_f(g) * u, 0.f) & 0xffffu);
    }
}
__device__ __forceinline__ void final_norm(const Args& A, int lane, int wave) {
    float* out = A.out; const f32x4* nr = (const f32x4*)A.in[12] + lane;
    const int gw = blockIdx.x * NWAVES + wave, NGW = gridDim.x * NWAVES;
    f32x4 nw[4];
#pragma unroll
    for (int j = 0; j < 4; ++j) nw[j] = nr[64 * j];
    for (int m0 = gw; m0 < M; m0 += 4 * NGW) {
        f32x4 v[4][4];
#pragma unroll
        for (int rr = 0; rr < 4; ++rr) { const int m = min(m0 + rr * NGW, M - 1); const f32x4* xr = (const f32x4*)(out + (size_t)m * DM) + lane;
#pragma unroll
            for (int j = 0; j < 4; ++j) v[rr][j] = xr[64 * j]; }
#pragma unroll
        for (int rr = 0; rr < 4; ++rr) { const int m = m0 + rr * NGW; if (m >= M) break; float s = 0.f;
#pragma unroll
            for (int j = 0; j < 4; ++j) s += (v[rr][j].x * v[rr][j].x + v[rr][j].y * v[rr][j].y) + (v[rr][j].z * v[rr][j].z + v[rr][j].w * v[rr][j].w);
            const float rstd = rsqrtf(wave_sum(s) * (1.f / DM) + RMS_EPS); f32x4* xw = (f32x4*)(out + (size_t)m * DM) + lane;
#pragma unroll
            for (int j = 0; j < 4; ++j) xw[64 * j] = (f32x4){v[rr][j].x * rstd * nw[j].x, v[rr][j].y * rstd * nw[j].y, v[rr][j].z * rstd * nw[j].z, v[rr][j].w * rstd * nw[j].w}; }
    }
}

#define XB_TMO      128
#define XB_XCNT(j)  (256  + 64 * (j))
#define XB_XSUB(j)  (1280 + 64 * (j))
#define XB_XGEN(j)  (2304 + 64 * (j))
#define XB_TOP      3328
#define XB_TOPGEN   3392
#define XCD_BAR_WORDS 3456
#define XB_SPIN_CAP (1u << 18)

__device__ __forceinline__ unsigned xb_ld(unsigned* p)              { return __hip_atomic_load(p, __ATOMIC_RELAXED, __HIP_MEMORY_SCOPE_AGENT); }
__device__ __forceinline__ unsigned xb_add(unsigned* p, unsigned v) { return __hip_atomic_fetch_add(p, v, __ATOMIC_RELAXED, __HIP_MEMORY_SCOPE_AGENT); }
__device__ __forceinline__ unsigned xb_xcc_id() { return (unsigned)__builtin_amdgcn_s_getreg((3 << 11) | 20) & 0xFu; }
#define XB_SPIN(cond, bar) do { unsigned _sp = 0; while (cond) { __builtin_amdgcn_s_sleep(1); \
    if ((++_sp & 255u) == 0u) { if (xb_ld(&(bar)[XB_TMO])) break; if (_sp > XB_SPIN_CAP) { atomicAdd(&(bar)[XB_TMO], 1u); break; } } } } while (0)

struct XcdBarrier {
    unsigned* bar; unsigned x;
    volatile LAS unsigned* st;
};

__device__ __forceinline__ XcdBarrier xcd_barrier_post(unsigned* bar, volatile LAS unsigned* st) {
    XcdBarrier b; b.bar = bar; b.x = xb_xcc_id(); b.st = st;
    if (threadIdx.x == 0) (void)xb_add(&bar[XB_XCNT(b.x)], 1u);
    return b;
}
__device__ __forceinline__ void xcd_barrier_complete(unsigned* bar, unsigned x, unsigned& nloc, unsigned& nx) {
    const unsigned G = gridDim.x * gridDim.y * gridDim.z;
    unsigned sum, cnt, mine, sp = 0u;
    for (;;) {
        sum = 0u; cnt = 0u; mine = 0u;
#pragma unroll
        for (unsigned j = 0; j < 16; ++j) { const unsigned c = xb_ld(&bar[XB_XCNT(j)]); sum += c; cnt += (c > 0u) ? 1u : 0u; mine = (j == x) ? c : mine; }
        if (sum == G) break;
        __builtin_amdgcn_s_sleep(1);
        if ((++sp & 255u) == 0u) { if (xb_ld(&bar[XB_TMO])) break; if (sp > XB_SPIN_CAP) { atomicAdd(&bar[XB_TMO], 1u); break; } }
    }
    nloc = mine > 0u ? mine : 1u; nx = cnt > 0u ? cnt : 1u;
}

__device__ __forceinline__ void xcd_barrier(const XcdBarrier& b) {
    asm volatile("s_waitcnt vmcnt(0)" ::: "memory");
    __syncthreads();
    if (threadIdx.x == 0) {
        unsigned* bar = b.bar;
        __builtin_amdgcn_s_waitcnt(0);
        unsigned nloc = b.st[0], nx = b.st[1];
        if (nloc == 0u) { xcd_barrier_complete(bar, b.x, nloc, nx); b.st[0] = nloc; b.st[1] = nx; }
        const unsigned old = xb_add(&bar[XB_XSUB(b.x)], 1u);
        const unsigned gen = old / nloc;
        if (old + 1u == (gen + 1u) * nloc) {
            __builtin_amdgcn_fence(__ATOMIC_RELEASE, "agent");
            asm volatile("s_waitcnt vmcnt(0)" ::: "memory");
            const unsigned og = xb_add(&bar[XB_TOP], 1u);
            const unsigned tg = og / nx;
            if (og + 1u == (tg + 1u) * nx) xb_add(&bar[XB_TOPGEN], 1u);
            else XB_SPIN(xb_ld(&bar[XB_TOPGEN]) == tg, bar);
            __builtin_amdgcn_fence(__ATOMIC_ACQUIRE, "agent");
            xb_add(&bar[XB_XGEN(b.x)], 1u);
            asm volatile("s_waitcnt vmcnt(0)" ::: "memory");
        } else {
            XB_SPIN(xb_ld(&bar[XB_XGEN(b.x)]) == gen, bar);
            __builtin_amdgcn_fence(__ATOMIC_ACQUIRE, "agent");
            asm volatile("s_waitcnt vmcnt(0)" ::: "memory");
        }
    }
    __syncthreads();
}

constexpr int N_PHASES = 8;
__global__ void __launch_bounds__(NTHR, 2) mk_fwd(Args args) {
    extern __shared__ __attribute__((aligned(16))) unsigned char lds_raw[];
    LAS unsigned char* lds = (LAS unsigned char*)lds_raw;
    const int tid = threadIdx.x, lane = tid & 63, wave = __builtin_amdgcn_readfirstlane(tid >> 6);
    const int lo = args.ph_lo, hi = args.ph_hi;
    unsigned char* ws = args.ws;
    bf16* WIN = (bf16*)(ws + WS_WIN); bf16* WOUT = (bf16*)(ws + WS_WOUT); bf16* WUP = (bf16*)(ws + WS_WUP); bf16* WDN = (bf16*)(ws + WS_WDN);
    bf16* XN = (bf16*)(ws + WS_XN); bf16* PROJ = (bf16*)(ws + WS_PROJ); bf16* CAT = (bf16*)(ws + WS_CAT); bf16* Y = (bf16*)(ws + WS_Y); bf16* ACT = (bf16*)(ws + WS_ACT);
    float* SSQ = (float*)(ws + WS_SSQ);
#define IN(k) (lo <= (k) && (k) < hi)
#define SEAM(k) do { if (IN(k) && IN((k) + 1)) { if ((k) == 0) cg::this_grid().sync(); else xcd_barrier(bar); } } while (0)
    { volatile LAS unsigned* st = (volatile LAS unsigned*)(lds + LDS_BYTES - 64); if (tid < 2) st[tid] = 0u; }
    __syncthreads();
    XcdBarrier bar = xcd_barrier_post((unsigned*)(ws + WS_CTL) + 4096, (volatile LAS unsigned*)(lds + LDS_BYTES - 64));
    if (IN(0)) { p0_prologue(args, lds, tid, lane, wave); } SEAM(0);
    if (IN(1)) { pg8::Gemm g{XN, WIN, M, NP, DM}; pg8::StaticOrder S; S.init(M, NP, gridDim.x, blockIdx.x); pg8::EpiBf16S E{PROJ, NP, nullptr};
        pg8::gemm_phase<pg8::EpiBf16S, pg8::StaticOrder, PG8_ALIGN, PG8_SP2>(lds, g, S, E);
        { pg8::Unit u4; const bool idle4 = !S.next(3, u4); const int G = gridDim.x, nidle = (G == 256) ? 128 : G;
          if (G != 256) convert_late_weights(args, lds, lane, wave, blockIdx.x * NWAVES + wave, G * NWAVES);
          else if (idle4) convert_late_weights(args, lds, lane, wave, (blockIdx.x - 128) * NWAVES + wave, nidle * NWAVES); } } SEAM(1);
    if (IN(2)) { gdn_prep(args, lds, tid, lane, wave); } SEAM(2);
    if (IN(3)) { if (blockIdx.x < NB * GH) gdn_scan(args, lds, blockIdx.x, tid, lane, wave); attn_fast(args, lds, lane, wave); xcd_barrier(bar); gated_norm(args, lane, wave); } SEAM(3);
    if (IN(4)) { pg8::Gemm g{CAT, WOUT, M, DM, DM}; pg8::StaticOrder S; S.init(M, DM, gridDim.x, blockIdx.x); pg8::EpiResid E{args.in[0], args.out, XN, SSQ, DM};
        pg8::gemm_phase<pg8::EpiResid, pg8::StaticOrder, PG8_ALIGN, PG8_SP2>(lds, g, S, E); } SEAM(4);
    if (IN(5)) { pg8::Gemm g{XN, WUP, M, NUP, DM}; pg8::StaticOrder S; S.init(M, NUP, gridDim.x, blockIdx.x);
        static_assert(pg8::EpiConvGate::CG_SSQ == WS_SSQ && pg8::EpiConvGate::CG_ACT == WS_ACT && pg8::EpiConvGate::CG_YH == WS_YH && pg8::EpiConvGate::CG_UPART == WS_UPART, "d_ws map");
        pg8::EpiConvGate E{ws, args.in[10], lds};
        pg8::gemm_phase<pg8::EpiConvGate, pg8::StaticOrder, true, PG8_SP2>(lds, g, S, E); } SEAM(5);
    if (IN(6)) { ffn_fixup(args, tid); } SEAM(6);
    if (IN(7)) { pg8::Gemm g{ACT, WDN, M, DM, DFF}; pg8::StaticOrder S; S.init(M, DM, gridDim.x, blockIdx.x);
        if (gridDim.x == 256) {
            pg8::EpiResidNorm E{args.out, args.out, (float*)(ws + WS_SSQ2), (unsigned*)(ws + WS_CTL) + 2048, args.in[12], DM};
            pg8::gemm_phase<pg8::EpiResidNorm, pg8::StaticOrder, true, PG8_SP2>(lds, g, S, E);
        } else {
            pg8::EpiResid E{args.out, args.out, nullptr, nullptr, DM};
            pg8::gemm_phase<pg8::EpiResid, pg8::StaticOrder, PG8_ALIGN, PG8_SP2>(lds, g, S, E);
            xcd_barrier(bar); final_norm(args, lane, wave);
        } }
#undef IN
#undef SEAM
}

#ifndef MK_ONE_LAUNCH
#define MK_ONE_LAUNCH 1
#endif
extern "C" void kernel_launch(void* const* d_in, const int* in_sizes, int n_in, void* d_out, int out_size, void* d_ws, size_t ws_size, hipStream_t stream) {
    static int grid = 0;
    if (grid == 0) {
        if (n_in != 13 || out_size != M * DM || ws_size < WS_END) { fprintf(stderr, "kernel_launch: unexpected shapes n_in %d out %d ws %zu\n", n_in, out_size, ws_size); grid = -1; return; }
        int dev = 0, cus = 0, per_cu = 0;
        hipGetDevice(&dev); hipDeviceGetAttribute(&cus, hipDeviceAttributeMultiprocessorCount, dev);
        hipFuncSetAttribute((const void*)mk_fwd, hipFuncAttributeMaxDynamicSharedMemorySize, LDS_BYTES);
        hipOccupancyMaxActiveBlocksPerMultiprocessor(&per_cu, (const void*)mk_fwd, NTHR, LDS_BYTES);
        (void)hipGetLastError();
        if (per_cu < 1) { fprintf(stderr, "kernel_launch: occupancy query says %d blocks per CU\n", per_cu); per_cu = 1; }
        grid = cus;
    }
    if (grid < 0) return;
    if (hipMemsetAsync((char*)d_ws + WS_CTL, 0, 65536, stream) != hipSuccess) { fprintf(stderr, "kernel_launch: memset failed\n"); return; }
    Args a{};
    for (int i = 0; i < 13; ++i) a.in[i] = (const float*)d_in[i];
    a.out = (float*)d_out; a.ws = (unsigned char*)d_ws;
#if MK_ONE_LAUNCH
    a.ph_lo = 0; a.ph_hi = N_PHASES; a.coop = 1;
    void* kargs[] = {&a};
    hipError_t e = hipLaunchCooperativeKernel((const void*)mk_fwd, dim3(grid), dim3(NTHR), kargs, LDS_BYTES, stream);
    if (e != hipSuccess) fprintf(stderr, "cooperative launch failed: %s (grid %d)\n", hipGetErrorString(e), grid);
#else
    for (int p = 0; p < N_PHASES; ++p) { a.ph_lo = p; a.ph_hi = p + 1; a.coop = 0; hipLaunchKernelGGL(mk_fwd, dim3(grid), dim3(NTHR), LDS_BYTES, stream, a); }
#endif
}
```

```cpp
#include <hip/hip_runtime.h>
#include <hip/hip_cooperative_groups.h>
#include <cstdio>
#include <cstdint>
namespace cg = cooperative_groups;
namespace pg8 {
#define PG8_LAS __attribute__((address_space(3)))
typedef unsigned short bf16_t;
typedef short bf16x8 __attribute__((ext_vector_type(8)));
typedef float f32x4 __attribute__((ext_vector_type(4)));
typedef unsigned u32x4 __attribute__((ext_vector_type(4)));
constexpr int BM = 256, BK = 64, HALF = 128, HTB = HALF * BK * 2  , STAGE_BYTES = 8 * HTB, NXCD = 8, WGM = 8;

__host__ __device__ __forceinline__ int lds_byte(int r, int c) { const int st = (r >> 4) * 2 + (c >> 5), rr = r & 15, cc = c & 31, ob = rr * 64 + cc * 2; return st * 1024 + (ob ^ (((ob >> 9) & 1) << 5)); }
__host__ __device__ __forceinline__ void stage_rc(int b, int& R, int& C) { const int st = b / 1024, sb = b % 1024, swz = sb ^ (((sb >> 9) & 1) << 5); R = (st >> 1) * 16 + swz / 64; C = (st & 1) * 32 + (swz % 64) / 2; }
__host__ __device__ __forceinline__ int perm32(int rho) { const int n = rho >> 4, i = rho & 15; return 8 * (i >> 2) + 4 * n + (i & 3); }

struct Unit { int pm, pn; };
struct Gemm { const bf16_t* A; const bf16_t* Bt; int M, N, K; };

struct StaticOrder {
    int nM, nN, nwg, G, c;
    __host__ __device__ void init(int M, int N, int G_, int c_) { nM = M / BM; nN = N / BM; nwg = nM * nN; G = G_; c = c_; }
    __host__ __device__ bool next(int i, Unit& u) const {
        const long L = (long)i * G + c; if (L >= nwg) return false;
        int wgid = (int)L; { const int q = nwg / NXCD, r = nwg % NXCD, xcd = wgid % NXCD, off = wgid / NXCD; wgid = (xcd < r ? xcd * (q + 1) : r * (q + 1) + (xcd - r) * q) + off; }
        const int nig = WGM * nN, gid = wgid / nig, fm = gid * WGM, gsz = (nM - fm) < WGM ? (nM - fm) : WGM;
        u.pm = fm + ((wgid % nig) % gsz); u.pn = (wgid % nig) / gsz; return true;
    }
    __device__ __forceinline__ void a_ready(const Unit&) const {}
    __device__ __forceinline__ void done(const Unit&) const {}
};

__device__ __forceinline__ unsigned cvt_pk_bf16(float lo, float hi) { unsigned r; asm volatile("v_cvt_pk_bf16_f32 %0, %1, %2" : "=v"(r) : "v"(lo), "v"(hi)); return r; }
constexpr float RMS_EPS = 1e-6f;
struct EpiBf16S {
    static constexpr bool PERM = true, AFTER_DRAIN = false;
    bf16_t* O; int ldc; const float* ssq;
    __device__ __forceinline__ void operator()(const f32x4 (&acc)[2][2][4][2], const Unit& u, int wr, int wc, int fr, int fq) const {
        const int row0 = u.pm * BM + wr * 64 + fr; const int col0 = u.pn * BM + wc * 32 + 8 * fq;
#pragma unroll
        for (int ai = 0; ai < 2; ++ai)
#pragma unroll
            for (int m = 0; m < 4; ++m) { const int row = row0 + ai * HALF + m * 16; bf16_t* rowp = O + (size_t)row * ldc + col0;
                const float sc = ssq ? rsqrtf(ssq[row] * (1.0f / 1024.0f) + RMS_EPS) : 1.0f;
#pragma unroll
                for (int bj = 0; bj < 2; ++bj) { const f32x4 v0 = acc[ai][bj][m][0] * sc, v1 = acc[ai][bj][m][1] * sc;
                    u32x4 w; w.x = cvt_pk_bf16(v0[0], v0[1]); w.y = cvt_pk_bf16(v0[2], v0[3]); w.z = cvt_pk_bf16(v1[0], v1[1]); w.w = cvt_pk_bf16(v1[2], v1[3]);
                    *(u32x4*)(rowp + bj * HALF) = w; } }
    }
};
struct EpiResid {
    static constexpr bool PERM = false, AFTER_DRAIN = false;
    const float* base; float* out; bf16_t* xb; float* ssq; int ldc;
    __device__ __forceinline__ void operator()(const f32x4 (&acc)[2][2][4][2], const Unit& u, int wr, int wc, int fr, int fq) const {
        typedef unsigned u32x2v __attribute__((ext_vector_type(2)));
        const int col0 = u.pn * BM + wc * 32 + 4 * fq;
#pragma unroll
        for (int ai = 0; ai < 2; ++ai) {
            f32x4 bv[4][2][2];
#pragma unroll
            for (int m = 0; m < 4; ++m) { const size_t off = (size_t)(u.pm * BM + ai * HALF + wr * 64 + m * 16 + fr) * ldc + col0;
#pragma unroll
                for (int bj = 0; bj < 2; ++bj)
#pragma unroll
                    for (int n = 0; n < 2; ++n) bv[m][bj][n] = *(const f32x4*)(base + off + bj * HALF + n * 16); }
#pragma unroll
            for (int m = 0; m < 4; ++m) { const int row = u.pm * BM + ai * HALF + wr * 64 + m * 16 + fr; const size_t off = (size_t)row * ldc + col0; float s = 0.f;
#pragma unroll
                for (int bj = 0; bj < 2; ++bj)
#pragma unroll
                    for (int n = 0; n < 2; ++n) { const f32x4 v = acc[ai][bj][m][n] + bv[m][bj][n];
                        *(f32x4*)(out + off + bj * HALF + n * 16) = v; s += (v[0] * v[0] + v[1] * v[1]) + (v[2] * v[2] + v[3] * v[3]);
                        if (xb) { u32x2v w; w.x = cvt_pk_bf16(v[0], v[1]); w.y = cvt_pk_bf16(v[2], v[3]); *(u32x2v*)(xb + off + bj * HALF + n * 16) = w; } }
                if (ssq) { s += __shfl_xor(s, 16); s += __shfl_xor(s, 32); if (fq == 0) atomicAdd(ssq + row, s); } }
            asm volatile("" ::: "memory");
        }
    }
};

__device__ __forceinline__ float dpp_ror1(float v) { return __builtin_bit_cast(float, __builtin_amdgcn_update_dpp(0, __builtin_bit_cast(int, v), 0x121, 0xf, 0xf, false)); }
__device__ __forceinline__ float dpp_ror2(float v) { return __builtin_bit_cast(float, __builtin_amdgcn_update_dpp(0, __builtin_bit_cast(int, v), 0x122, 0xf, 0xf, false)); }
struct EpiConvGate {
    static constexpr bool PERM = true, AFTER_DRAIN = false;
    static constexpr size_t CG_SSQ = (1u << 20) + 768 * 1024, CG_ACT = (size_t)148 << 20, CG_YH = (size_t)236 << 20, CG_UPART = (size_t)240 << 20;
    unsigned char* ws; const float* fw; PG8_LAS unsigned char* ldsb;
    __device__ __forceinline__ void operator()(f32x4 (&acc)[2][2][4][2], const Unit& u, int wr, int wc, int fr0, int fq0) const {
        int fr = fr0, fq = fq0; asm volatile("" : "+v"(fr), "+v"(fq));
        bf16_t* ACT = (bf16_t*)(ws + CG_ACT); const float* ssq = (const float*)(ws + CG_SSQ); float* YH = (float*)(ws + CG_YH); float* UPART = (float*)(ws + CG_UPART);
        PG8_LAS float* halo = (PG8_LAS float*)(ldsb + STAGE_BYTES);
        int cl = wc * 32 + 8 * fq;
        int ch = u.pn * 128 + cl;
        if (fr >= 14) {
#pragma unroll
            for (int ai = 0; ai < 2; ++ai) { const float sc = rsqrtf(ssq[u.pm * BM + ai * HALF + wr * 64 + 48 + fr] * (1.0f / 1024.0f) + RMS_EPS);
#pragma unroll
                for (int bj = 0; bj < 2; ++bj)
#pragma unroll
                    for (int n = 0; n < 2; ++n) { const f32x4 v = acc[ai][bj][3][n] * sc; *(PG8_LAS f32x4*)(halo + (((wr * 2 + ai) * 2 + (fr - 14)) * 256 + bj * 128 + cl + 4 * n)) = v;
                        if (ai == 1 && wr == 1) *(f32x4*)(YH + ((size_t)(u.pm * 22 + u.pn) * 2 + (fr - 14)) * 256 + bj * 128 + cl + 4 * n) = v; } }
        }
        asm volatile("s_waitcnt lgkmcnt(0)" ::: "memory"); __builtin_amdgcn_s_barrier(); asm volatile("" ::: "memory");
        typedef unsigned u32x2v __attribute__((ext_vector_type(2)));
#pragma unroll 1
        for (int n = 0; n < 2; ++n) {
            asm volatile("" : "+v"(fr), "+v"(fq));
            cl = wc * 32 + 8 * fq; ch = u.pn * 128 + cl;
            f32x4 w[3][2];
#pragma unroll
            for (int i = 0; i < 3; ++i)
#pragma unroll
                for (int bj = 0; bj < 2; ++bj) w[i][bj] = *(const f32x4*)(fw + (size_t)i * 5632 + bj * 2816 + ch + 4 * n);
#pragma unroll
            for (int ai = 0; ai < 2; ++ai) {
                const bool top = (ai == 0 && wr == 0);
                const int pblk = (ai == 0) ? 0 : (wr == 0 ? 2 : 1);
                f32x4 q1[2], q2[2];
#pragma unroll
                for (int bj = 0; bj < 2; ++bj) { const f32x4 pv = top ? (f32x4){0.f, 0.f, 0.f, 0.f} : *(const PG8_LAS f32x4*)(halo + ((pblk * 2 + (fr & 1)) * 256 + bj * 128 + cl + 4 * n));
#pragma unroll
                    for (int k = 0; k < 4; ++k) { q1[bj][k] = dpp_ror1(pv[k]); q2[bj][k] = dpp_ror2(pv[k]); } }
#pragma unroll
                for (int m = 0; m < 4; ++m) {
                    const int row = u.pm * BM + ai * HALF + wr * 64 + m * 16 + fr; const float sc = rsqrtf(ssq[row] * (1.0f / 1024.0f) + RMS_EPS);
                    f32x4 cu[2];
#pragma unroll
                    for (int bj = 0; bj < 2; ++bj) { const f32x4 ya = (n == 0) ? acc[ai][bj][m][0] : acc[ai][bj][m][1];
#pragma unroll
                        for (int k = 0; k < 4; ++k) { const float y = ya[k] * sc;
                            const float a1 = dpp_ror1(y), a2 = dpp_ror2(y);
                            const float p1 = (fr == 0) ? q1[bj][k] : a1, p2 = (fr < 2) ? q2[bj][k] : a2;
                            cu[bj][k] = w[2][bj][k] * y + w[1][bj][k] * p1 + w[0][bj][k] * p2; q1[bj][k] = a1; q2[bj][k] = a2; } }
                    if (top && m == 0 && fr < 2 && (u.pm & 7) != 0) {
#pragma unroll
                        for (int bj = 0; bj < 2; ++bj) *(f32x4*)(UPART + ((size_t)(u.pm * 22 + u.pn) * 2 + fr) * 256 + bj * 128 + cl + 4 * n) = cu[bj];
                    }
                    u32x2v o;
#define PG8_SG(k_) (cu[0][k_] * __builtin_amdgcn_rcpf(1.0f + __expf(-cu[0][k_])) * cu[1][k_])
                    o.x = cvt_pk_bf16(PG8_SG(0), PG8_SG(1)); o.y = cvt_pk_bf16(PG8_SG(2), PG8_SG(3));
#undef PG8_SG
                    *(u32x2v*)(ACT + (size_t)row * 2816 + ch + 4 * n) = o;
                    asm volatile("" ::: "memory");
                }
            }
        }
        asm volatile("s_waitcnt lgkmcnt(0)" ::: "memory"); __builtin_amdgcn_s_barrier(); asm volatile("" ::: "memory");
    }
};

struct EpiResidNorm {
    static constexpr bool PERM = false, AFTER_DRAIN = false;
    const float* base; float* out; float* ssq2; unsigned* cnt; const float* fnw; int ldc;
    __device__ __forceinline__ void operator()(f32x4 (&acc)[2][2][4][2], const Unit& u, int wr, int wc, int fr, int fq) const {
        const int col0 = u.pn * BM + wc * 32 + 4 * fq;
#pragma unroll
        for (int ai = 0; ai < 2; ++ai) {
            f32x4 bv[4][2][2];
#pragma unroll
            for (int m = 0; m < 4; ++m) { const size_t off = (size_t)(u.pm * BM + ai * HALF + wr * 64 + m * 16 + fr) * ldc + col0;
#pragma unroll
                for (int bj = 0; bj < 2; ++bj)
#pragma unroll
                    for (int n = 0; n < 2; ++n) bv[m][bj][n] = *(const f32x4*)(base + off + bj * HALF + n * 16); }
#pragma unroll
            for (int m = 0; m < 4; ++m) { const int row = u.pm * BM + ai * HALF + wr * 64 + m * 16 + fr; float s = 0.f;
#pragma unroll
                for (int bj = 0; bj < 2; ++bj)
#pragma unroll
                    for (int n = 0; n < 2; ++n) { const f32x4 v = acc[ai][bj][m][n] + bv[m][bj][n]; acc[ai][bj][m][n] = v; s += (v[0] * v[0] + v[1] * v[1]) + (v[2] * v[2] + v[3] * v[3]); }
                s += __shfl_xor(s, 16); s += __shfl_xor(s, 32);
                if (fq == 0) (void)__hip_atomic_fetch_add(ssq2 + row, s, __ATOMIC_RELAXED, __HIP_MEMORY_SCOPE_AGENT); }
            asm volatile("" ::: "memory");
        }
        asm volatile("s_waitcnt vmcnt(0)" ::: "memory"); __builtin_amdgcn_s_barrier(); asm volatile("" ::: "memory");
        if (wr == 0 && wc == 0 && fr == 0 && fq == 0) {
            __builtin_amdgcn_fence(__ATOMIC_RELEASE, "agent"); asm volatile("s_waitcnt vmcnt(0)" ::: "memory");
            (void)__hip_atomic_fetch_add(cnt + 16 * u.pm, 1u, __ATOMIC_RELAXED, __HIP_MEMORY_SCOPE_AGENT);
            unsigned sp = 0;
            while (__hip_atomic_load(cnt + 16 * u.pm, __ATOMIC_RELAXED, __HIP_MEMORY_SCOPE_AGENT) < 4u) { __builtin_amdgcn_s_sleep(1); if (++sp > (1u << 22)) break; }
            __builtin_amdgcn_fence(__ATOMIC_ACQUIRE, "agent"); asm volatile("s_waitcnt vmcnt(0)" ::: "memory");
        }
        __builtin_amdgcn_s_barrier(); asm volatile("" ::: "memory");
        f32x4 nw[2][2];
#pragma unroll
        for (int bj = 0; bj < 2; ++bj)
#pragma unroll
            for (int n = 0; n < 2; ++n) nw[bj][n] = *(const f32x4*)(fnw + col0 + bj * HALF + n * 16);
#pragma unroll
        for (int ai = 0; ai < 2; ++ai)
#pragma unroll
            for (int m = 0; m < 4; ++m) { const int row = u.pm * BM + ai * HALF + wr * 64 + m * 16 + fr; const size_t off = (size_t)row * ldc + col0;
                const float rstd = rsqrtf(__hip_atomic_load(ssq2 + row, __ATOMIC_RELAXED, __HIP_MEMORY_SCOPE_AGENT) * (1.0f / 1024.0f) + RMS_EPS);
#pragma unroll
                for (int bj = 0; bj < 2; ++bj)
#pragma unroll
                    for (int n = 0; n < 2; ++n) { const f32x4 v = acc[ai][bj][m][n]; *(f32x4*)(out + off + bj * HALF + n * 16) = (f32x4){v[0] * rstd * nw[bj][n][0], v[1] * rstd * nw[bj][n][1], v[2] * rstd * nw[bj][n][2], v[3] * rstd * nw[bj][n][3]}; } }
    }
};
template <class Epi, class Sched, bool ALIGN_EPI = false, bool SP2 = false>
__device__ __forceinline__ void gemm_phase(PG8_LAS unsigned char* lds, const Gemm g, const Sched& S, const Epi& E) {
    const int tid = threadIdx.x, wid = __builtin_amdgcn_readfirstlane(tid >> 6), lane = tid & 63, wr = wid >> 2, wc = wid & 3, fr = lane & 15, fq = lane >> 4;
    const int K = g.K, nt = K / BK;
    unsigned voffA[2], voffB[2];
#pragma unroll
    for (int i = 0; i < 2; ++i) { int R, C; stage_rc(tid * 16 + i * 8192, R, C); const int Rb = Epi::PERM ? ((R & ~31) + perm32(R & 31)) : R;
        voffA[i] = (unsigned)(R * K + C) * 2u; voffB[i] = (unsigned)(Rb * K + C) * 2u; }
    const size_t kstep = (size_t)(BK * 2);
    const size_t hstep = (size_t)HALF * K * 2;
    const size_t tstep = 2 * hstep;
    const unsigned ldsw = (unsigned)wid * 1024u;
    const int aoff = lds_byte(wr * 64 + fr, fq * 8), boff = lds_byte(wc * 32 + fr, fq * 8);
#define PG8_SA(b, h) (((b) * 2 + (h)) * HTB)
#define PG8_SB(b, h) ((4 + (b) * 2 + (h)) * HTB)
#define PG8_STAGE(bufoff, gbase, voff) do { _Pragma("unroll") for (int _i = 0; _i < 2; ++_i) \
        __builtin_amdgcn_global_load_lds((const unsigned*)((const char*)(gbase) + (voff)[_i]), (PG8_LAS unsigned*)(lds + (bufoff) + ldsw + _i * 8192), 16, 0, 0); } while (0)
#define PG8_LDA(dst, b, h) do { _Pragma("unroll") for (int m = 0; m < 4; ++m) _Pragma("unroll") for (int k = 0; k < 2; ++k) dst[m][k] = *(const PG8_LAS bf16x8*)(lds + PG8_SA(b, h) + aoff + m * 2048 + k * 1024); } while (0)
#define PG8_LDB(dst, b, h) do { _Pragma("unroll") for (int n = 0; n < 2; ++n) _Pragma("unroll") for (int k = 0; k < 2; ++k) dst[n][k] = *(const PG8_LAS bf16x8*)(lds + PG8_SB(b, h) + boff + n * 2048 + k * 1024); } while (0)
#define PG8_MMA(ai, bj, At, Bt) do { __builtin_amdgcn_s_setprio(1); _Pragma("unroll") for (int m = 0; m < 4; ++m) _Pragma("unroll") for (int n = 0; n < 2; ++n) _Pragma("unroll") for (int k = 0; k < 2; ++k) \
        acc[ai][bj][m][n] = __builtin_amdgcn_mfma_f32_16x16x32_bf16(Bt[n][k], At[m][k], acc[ai][bj][m][n], 0, 0, 0); __builtin_amdgcn_s_setprio(0); } while (0)
#define PG8_WAIT_V(n) asm volatile("s_waitcnt vmcnt(" #n ")" ::: "memory")
#define PG8_WAIT_L(n) asm volatile("s_waitcnt lgkmcnt(" #n ")" ::: "memory")
#define PG8_BAR __builtin_amdgcn_s_barrier()
#define PG8_SCHED __builtin_amdgcn_sched_barrier(0)
    Unit cur, nxt; int ui = 0;
    if (!S.next(0, cur)) return;
    f32x4 acc[2][2][4][2];
#pragma unroll
    for (int a = 0; a < 2; ++a)
#pragma unroll
        for (int b = 0; b < 2; ++b)
#pragma unroll
            for (int m = 0; m < 4; ++m)
#pragma unroll
                for (int n = 0; n < 2; ++n) acc[a][b][m][n] = (f32x4){0.f, 0.f, 0.f, 0.f};
    bf16x8 At[4][2], B0[2][2], B1[2][2];
    const char* cA = (const char*)g.A + (size_t)cur.pm * tstep; const char* cB = (const char*)g.Bt + (size_t)cur.pn * tstep;
    S.a_ready(cur);
    if constexpr (SP2) {
        PG8_STAGE(PG8_SB(0, 0), cB, voffB); PG8_STAGE(PG8_SB(0, 1), cB + hstep, voffB); PG8_STAGE(PG8_SA(0, 0), cA, voffA); PG8_STAGE(PG8_SA(0, 1), cA + hstep, voffA);
        if (wr == 1) PG8_BAR;
        PG8_WAIT_V(2); PG8_BAR;
        PG8_STAGE(PG8_SB(1, 0), cB + kstep, voffB); PG8_STAGE(PG8_SA(1, 0), cA + kstep, voffA); PG8_STAGE(PG8_SB(1, 1), cB + hstep + kstep, voffB);
        PG8_WAIT_V(6); PG8_BAR;
    } else {
        PG8_STAGE(PG8_SB(0, 0), cB, voffB); PG8_STAGE(PG8_SA(0, 0), cA, voffA); PG8_STAGE(PG8_SB(0, 1), cB + hstep, voffB); PG8_STAGE(PG8_SA(0, 1), cA + hstep, voffA);
        if (wr == 1) PG8_BAR;
        PG8_WAIT_V(4); PG8_BAR;
        PG8_STAGE(PG8_SB(1, 0), cB + kstep, voffB); PG8_STAGE(PG8_SA(1, 0), cA + kstep, voffA); PG8_STAGE(PG8_SB(1, 1), cB + hstep + kstep, voffB);
        PG8_WAIT_V(6); PG8_BAR;
    }
    for (;;) {
        const bool has_next = S.next(ui + 1, nxt);
        const char* nA = has_next ? (const char*)g.A + (size_t)nxt.pm * tstep : cA; const char* nB = has_next ? (const char*)g.Bt + (size_t)nxt.pn * tstep : cB;
        for (int t = 0; t < nt; t += 2) {
            const bool last = (t == nt - 2);
            const char* a1 = cA + (size_t)(t + 1) * kstep;
            const char* a2 = last ? nA : cA + (size_t)(t + 2) * kstep; const char* b2 = last ? nB : cB + (size_t)(t + 2) * kstep;
            const char* a3 = a2 + kstep; const char* b3 = b2 + kstep;
            if (last && has_next) S.a_ready(nxt);
            if constexpr (SP2) {
            PG8_LDB(B0, 0, 0); PG8_LDB(B1, 0, 1); PG8_SCHED; PG8_LDA(At, 0, 0); PG8_STAGE(PG8_SA(1, 1), a1 + hstep, voffA);
            PG8_WAIT_V(8); PG8_WAIT_L(0); PG8_BAR; PG8_MMA(0, 0, At, B0); PG8_MMA(0, 1, At, B1); PG8_BAR; PG8_SCHED;
            PG8_LDA(At, 0, 1); PG8_STAGE(PG8_SB(0, 0), b2, voffB); PG8_STAGE(PG8_SB(0, 1), b2 + hstep, voffB); PG8_STAGE(PG8_SA(0, 0), a2, voffA);
            PG8_WAIT_V(8); PG8_WAIT_L(0); PG8_BAR; PG8_MMA(1, 0, At, B0); PG8_MMA(1, 1, At, B1); PG8_BAR; PG8_SCHED;
            PG8_LDB(B0, 1, 0); PG8_LDB(B1, 1, 1); PG8_SCHED; PG8_LDA(At, 1, 0); PG8_STAGE(PG8_SA(0, 1), a2 + hstep, voffA);
            PG8_WAIT_V(8); PG8_WAIT_L(0); PG8_BAR; PG8_MMA(0, 0, At, B0); PG8_MMA(0, 1, At, B1); PG8_BAR; PG8_SCHED;
            PG8_LDA(At, 1, 1); PG8_STAGE(PG8_SB(1, 0), b3, voffB); PG8_STAGE(PG8_SB(1, 1), b3 + hstep, voffB); PG8_STAGE(PG8_SA(1, 0), a3, voffA);
            PG8_WAIT_V(8); PG8_WAIT_L(0); PG8_BAR; PG8_MMA(1, 0, At, B0); PG8_MMA(1, 1, At, B1); PG8_BAR; PG8_SCHED;
            } else {
            PG8_LDB(B0, 0, 0); PG8_SCHED; PG8_LDA(At, 0, 0); PG8_STAGE(PG8_SA(1, 1), a1 + hstep, voffA);
            PG8_WAIT_L(8); PG8_BAR; PG8_WAIT_L(0); PG8_MMA(0, 0, At, B0); PG8_BAR; PG8_SCHED;
            PG8_LDB(B1, 0, 1); PG8_STAGE(PG8_SB(0, 0), b2, voffB);
            PG8_BAR; PG8_WAIT_L(0); PG8_MMA(0, 1, At, B1); PG8_BAR;
            PG8_LDA(At, 0, 1); PG8_STAGE(PG8_SA(0, 0), a2, voffA);
            PG8_BAR; PG8_WAIT_L(0); PG8_MMA(1, 0, At, B0); PG8_BAR; PG8_SCHED;
            PG8_STAGE(PG8_SB(0, 1), b2 + hstep, voffB);
            PG8_WAIT_V(6); PG8_BAR; PG8_MMA(1, 1, At, B1); PG8_BAR;
            PG8_LDB(B0, 1, 0); PG8_SCHED; PG8_LDA(At, 1, 0); PG8_STAGE(PG8_SA(0, 1), a2 + hstep, voffA);
            PG8_WAIT_L(8); PG8_BAR; PG8_WAIT_L(0); PG8_MMA(0, 0, At, B0); PG8_BAR; PG8_SCHED;
            PG8_LDB(B1, 1, 1); PG8_STAGE(PG8_SB(1, 0), b3, voffB);
            PG8_BAR; PG8_WAIT_L(0); PG8_MMA(0, 1, At, B1); PG8_BAR;
            PG8_LDA(At, 1, 1); PG8_STAGE(PG8_SA(1, 0), a3, voffA);
            PG8_BAR; PG8_WAIT_L(0); PG8_MMA(1, 0, At, B0); PG8_BAR; PG8_SCHED;
            PG8_STAGE(PG8_SB(1, 1), b3 + hstep, voffB);
            PG8_WAIT_V(6); PG8_BAR; PG8_MMA(1, 1, At, B1); PG8_BAR;
            }
        }
        if constexpr (ALIGN_EPI) { if (wr == 0) PG8_BAR; }
        if constexpr (!Epi::AFTER_DRAIN) { E(acc, cur, wr, wc, fr, fq); S.done(cur); }
        if (!has_next) break;
#pragma unroll
        for (int a = 0; a < 2; ++a)
#pragma unroll
            for (int b = 0; b < 2; ++b)
#pragma unroll
                for (int m = 0; m < 4; ++m)
#pragma unroll
                    for (int n = 0; n < 2; ++n) acc[a][b][m][n] = (f32x4){0.f, 0.f, 0.f, 0.f};
        cur = nxt; cA = nA; cB = nB; ++ui;
        if constexpr (ALIGN_EPI) { if (wr == 1) PG8_BAR; }
    }
    PG8_WAIT_V(0);
    if constexpr (!ALIGN_EPI) { if (wr == 0) PG8_BAR; }
    PG8_BAR;
    if constexpr (Epi::AFTER_DRAIN) { E.fused(acc, cur, wr, wc, fr, fq, lds, wid, lane); S.done(cur); }
#undef PG8_SA
#undef PG8_SB
#undef PG8_STAGE
#undef PG8_LDA
#undef PG8_LDB
#undef PG8_MMA
#undef PG8_WAIT_V
#undef PG8_WAIT_L
#undef PG8_BAR
#undef PG8_SCHED
}
}
#ifndef PG8_SP2
#define PG8_SP2 true
#endif
#ifndef PG8_ALIGN
#define PG8_ALIGN true
#endif
constexpr int NB = 8, SEQ = 2048, DM = 1024, M = NB * SEQ;
constexpr int GH = 4, GD = 128, GW = 512, AH = 8, AD = 64;
constexpr int INC = 3592, NP = 3584;
constexpr int DFF = 2816, NUP = 2 * DFF;
constexpr int PC_QA = 0, PC_KA = 512, PC_VA = 1024, PC_Z = 1536, PC_QB = 2048, PC_KB = 2560, PC_VB = 3072;
constexpr size_t MiB = 1u << 20;
constexpr size_t WS_CTL = 0, WS_AB = 1 * MiB, WS_SSQ = 1 * MiB + 768 * 1024, WS_WIN = 2 * MiB, WS_WOUT = 9 * MiB, WS_WUP = 11 * MiB, WS_WDN = 22 * MiB;
constexpr size_t WS_XN = 28 * MiB, WS_PROJ = 60 * MiB, WS_CAT = 172 * MiB, WS_OA = 204 * MiB, WS_Y = 60 * MiB, WS_ACT = 148 * MiB, WS_END = 256 * MiB;
using pg8::RMS_EPS;
constexpr size_t WS_YH = 236 * MiB, WS_UPART = 240 * MiB;
constexpr size_t WS_SSQ2 = WS_SSQ + 131072;
constexpr size_t WS_GE = WS_SSQ + 65536;
constexpr int GOPS_CHUNK = 57344;
constexpr int SCAN_BUF = GOPS_CHUNK + 16384;
constexpr int NWAVES = 8, NTHR = 512;
constexpr int LDS_BYTES = 155648;
#define LAS __attribute__((address_space(3)))
typedef unsigned short bf16;
typedef unsigned v4u __attribute__((ext_vector_type(4)));
typedef unsigned v2u __attribute__((ext_vector_type(2)));
typedef float f32x4 __attribute__((ext_vector_type(4)));
__device__ __forceinline__ float bf2f(unsigned b) { return __uint_as_float(b << 16); }
__device__ __forceinline__ float bflo(unsigned w) { return __uint_as_float(w << 16); }
__device__ __forceinline__ float bfhi(unsigned w) { return __uint_as_float(w & 0xffff0000u); }
__device__ __forceinline__ unsigned pk2(float lo, float hi) { return pg8::cvt_pk_bf16(lo, hi); }
__device__ __forceinline__ float wave_sum(float v) {
#pragma unroll
    for (int o = 1; o < 64; o <<= 1) v += __shfl_xor(v, o);
    return v;
}
__device__ __forceinline__ float silu_f(float x) { return x * __builtin_amdgcn_rcpf(1.0f + __expf(-x)); }
__device__ __forceinline__ float sigmoid_f(float x) { return __builtin_amdgcn_rcpf(1.0f + __expf(-x)); }
__device__ __forceinline__ float softplus_f(float x) { return x > 20.f ? x : log1pf(__expf(x)); }

struct Args { const float* in[13]; float* out; unsigned char* ws; int ph_lo, ph_hi, coop, pad; };

__device__ __forceinline__ void p0_transpose_item(const float* W, int ldw, int k0, int sn0, bf16* WT, int K, int dn0, const float* kscale, LAS float* scr, int lane) {
    float tv[32];
#pragma unroll
    for (int i = 0; i < 32; ++i) { const int kk = 2 * i + (lane >> 5); tv[i] = W[(size_t)(k0 + kk) * ldw + sn0 + (lane & 31)]; }
    if (kscale) {
#pragma unroll
        for (int i = 0; i < 32; ++i) tv[i] *= kscale[k0 + 2 * i + (lane >> 5)]; }
#pragma unroll
    for (int i = 0; i < 32; ++i) scr[(2 * i + (lane >> 5)) * 33 + (lane & 31)] = tv[i];
    asm volatile("s_waitcnt lgkmcnt(0)" ::: "memory");
    const int c = lane & 7;
#pragma unroll
    for (int j = 0; j < 4; ++j) { const int n = (lane >> 3) + 8 * j; const LAS float* s = scr + (8 * c) * 33 + n;
        v4u o; o.x = pk2(s[0 * 33], s[1 * 33]); o.y = pk2(s[2 * 33], s[3 * 33]); o.z = pk2(s[4 * 33], s[5 * 33]); o.w = pk2(s[6 * 33], s[7 * 33]);
        *(v4u*)(WT + (size_t)(dn0 + n) * K + k0 + 8 * c) = o; }
    asm volatile("s_waitcnt lgkmcnt(0)" ::: "memory");
}

__device__ __forceinline__ void p0_prologue(const Args& A, LAS unsigned char* lds, int tid, int lane, int wave) {
    const float* x = A.in[0]; const float* nw1 = A.in[1]; const float* w_in = A.in[2]; const float* w_out = A.in[7]; const float* nw2 = A.in[8];
    const float* w_up = A.in[9]; const float* w_dn = A.in[11];
    unsigned char* ws = A.ws;
    bf16* WIN = (bf16*)(ws + WS_WIN); bf16* WOUT = (bf16*)(ws + WS_WOUT); bf16* WUP = (bf16*)(ws + WS_WUP); bf16* WDN = (bf16*)(ws + WS_WDN);
    bf16* XN = (bf16*)(ws + WS_XN); float* AB = (float*)(ws + WS_AB); float* SSQ = (float*)(ws + WS_SSQ);
    LAS float* scr = (LAS float*)(lds + wave * 9216);
    LAS float* wab = (LAS float*)(lds + 73728);
    const int G = gridDim.x, gw = blockIdx.x * NWAVES + wave, NGW = G * NWAVES;
    for (int i = blockIdx.x * NTHR + tid; i < M; i += G * NTHR) { SSQ[i] = 0.f; ((float*)(ws + WS_SSQ2))[i] = 0.f; }
    if (blockIdx.x == 0 && tid < 64) ((unsigned*)(ws + WS_CTL))[tid] = 0u;
    for (int idx = tid; idx < 8192; idx += NTHR) { const int k = idx >> 3, j = idx & 7; wab[j * 1024 + k] = nw1[k] * w_in[(size_t)k * INC + 2048 + j]; }
    constexpr int I_IN = 16 * (NP / 32);
    for (int it = gw; it < I_IN; it += NGW) { const int nblk = NP / 32, kb = it / nblk, nb = it % nblk, n0 = 32 * nb; p0_transpose_item(w_in, INC, 64 * kb, n0 + (n0 >= 2048 ? 8 : 0), WIN, DM, n0, nullptr, scr, lane); }
    __syncthreads();
    for (int m0 = gw; m0 < M; m0 += 2 * NGW) {
        const f32x4* nr = (const f32x4*)nw1 + lane;
        f32x4 v[2][4]; float s[2] = {0.f, 0.f};
#pragma unroll
        for (int rr = 0; rr < 2; ++rr) { const int m = min(m0 + rr * NGW, M - 1); const f32x4* xr = (const f32x4*)(x + (size_t)m * DM) + lane;
#pragma unroll
            for (int j = 0; j < 4; ++j) v[rr][j] = xr[64 * j]; }
#pragma unroll
        for (int rr = 0; rr < 2; ++rr)
#pragma unroll
            for (int j = 0; j < 4; ++j) s[rr] += (v[rr][j].x * v[rr][j].x + v[rr][j].y * v[rr][j].y) + (v[rr][j].z * v[rr][j].z + v[rr][j].w * v[rr][j].w);
#pragma unroll
        for (int rr = 0; rr < 2; ++rr) { const int m = m0 + rr * NGW; if (m >= M) break;
            const float rstd = rsqrtf(wave_sum(s[rr]) * (1.f / DM) + RMS_EPS);
            float ab[8];
#pragma unroll
            for (int q = 0; q < 8; ++q) { float a = 0.f;
#pragma unroll
                for (int j = 0; j < 4; ++j) { const f32x4 w = *(const LAS f32x4*)(wab + q * 1024 + 256 * j + 4 * lane); a += (v[rr][j].x * w.x + v[rr][j].y * w.y) + (v[rr][j].z * w.z + v[rr][j].w * w.w); }
                ab[q] = wave_sum(a) * rstd; }
            if (lane == 0) { *(f32x4*)(AB + (size_t)m * 8) = (f32x4){ab[0], ab[1], ab[2], ab[3]}; *(f32x4*)(AB + (size_t)m * 8 + 4) = (f32x4){ab[4], ab[5], ab[6], ab[7]}; }
            v2u* o8 = (v2u*)(XN + (size_t)m * DM) + lane;
#pragma unroll
            for (int j = 0; j < 4; ++j) { const f32x4 n = nr[64 * j]; v2u o; o.x = pk2(v[rr][j].x * rstd * n.x, v[rr][j].y * rstd * n.y); o.y = pk2(v[rr][j].z * rstd * n.z, v[rr][j].w * rstd * n.w); o8[64 * j] = o; }
        }
    }
}


__device__ __forceinline__ void convert_late_weights(const Args& A, LAS unsigned char* lds, int lane, int wave, int gw0, int ngw) {
    const float* w_out = A.in[7]; const float* nw2 = A.in[8]; const float* w_up = A.in[9]; const float* w_dn = A.in[11];
    bf16* WOUT = (bf16*)(A.ws + WS_WOUT); bf16* WUP = (bf16*)(A.ws + WS_WUP); bf16* WDN = (bf16*)(A.ws + WS_WDN);
    LAS float* scr = (LAS float*)(lds + wave * 9216);
    constexpr int I_OUT = 16 * 32, I_UP = 16 * (NUP / 32), I_DN = (DFF / 64) * 32;
    for (int it = gw0; it < I_OUT + I_UP + I_DN; it += ngw) {
        int r = it;
        if (r < I_OUT) { const int kb = r / 32, nb = r % 32; p0_transpose_item(w_out, DM, 64 * kb, 32 * nb, WOUT, DM, 32 * nb, nullptr, scr, lane); continue; } r -= I_OUT;
        if (r < I_UP) { const int nblk = NUP / 32, kb = r / nblk, nb = r % nblk, n0 = 32 * nb, pn = n0 >> 8, j0 = n0 & 255;
            const int s0 = (j0 < 128) ? (128 * pn + j0) : (DFF + 128 * pn + j0 - 128);
            p0_transpose_item(w_up, NUP, 64 * kb, s0, WUP, DM, n0, nw2, scr, lane); continue; } r -= I_UP;
        { const int kb = r / 32, nb = r % 32; p0_transpose_item(w_dn, DM, 64 * kb, 32 * nb, WDN, DFF, 32 * nb, nullptr, scr, lane); }
    }
}
__device__ __forceinline__ void gdn_simple(const Args& A, LAS unsigned char* lds, int tid, int lane, int wave) {
    const bf16* PROJ = (const bf16*)(A.ws + WS_PROJ); const float* AB = (const float*)(A.ws + WS_AB); float* OA = (float*)(A.ws + WS_OA);
    const float* cw = A.in[3]; const float* a_log = A.in[4]; const float* dt_bias = A.in[5];
    LAS float* qs = (LAS float*)lds; LAS float* ks = qs + 16 * 128; LAS float* vs = ks + 16 * 128; LAS float* av = vs + 16 * 128; LAS float* bv = av + 16;
    for (int task = blockIdx.x; task < NB * GH; task += gridDim.x) {
        const int b = task / GH, h = task % GH, v = tid >> 2, part = tid & 3;
        float S[32];
#pragma unroll
        for (int i = 0; i < 32; ++i) S[i] = 0.f;
        const float Ah = __expf(a_log[h]), dtb = dt_bias[h];
        for (int blk = 0; blk < SEQ / 16; ++blk) {
            const int t0 = blk * 16;
            for (int idx = tid; idx < 16 * 384; idx += NTHR) {
                const int tt = idx / 384, c = idx % 384, which = c >> 7, d = c & 127, col = which * 512 + h * 128 + d, t = t0 + tt;
                float acc = 0.f;
#pragma unroll
                for (int i = 0; i < 4; ++i) { const int ts = t - 3 + i; if (ts >= 0) acc += cw[i * 1536 + col] * bf2f(PROJ[(size_t)(b * SEQ + ts) * NP + col]); }
                qs[which * 2048 + tt * 128 + d] = silu_f(acc);
            }
            if (tid < 16) { const size_t row = (size_t)b * SEQ + t0 + tid; bv[tid] = sigmoid_f(AB[row * 8 + h]); av[tid] = __expf(-Ah * softplus_f(AB[row * 8 + 4 + h] + dtb)); }
            __syncthreads();
#pragma unroll
            for (int r = 0; r < 4; ++r) { const int row = 4 * wave + r; LAS float* arr = qs + row * 128;
                const float v0 = arr[lane], v1 = arr[lane + 64]; const float s = wave_sum(v0 * v0 + v1 * v1);
                const float sc = rsqrtf(s + RMS_EPS) * (row < 16 ? 0.08838834764831845f : 1.0f); arr[lane] = v0 * sc; arr[lane + 64] = v1 * sc; }
            __syncthreads();
            for (int tt = 0; tt < 16; ++tt) {
                const float a = av[tt], bt = bv[tt], vt = vs[tt * 128 + v];
                float kS = 0.f;
#pragma unroll
                for (int i = 0; i < 32; ++i) kS += ks[tt * 128 + 32 * part + i] * S[i];
                kS += __shfl_xor(kS, 1); kS += __shfl_xor(kS, 2);
                const float c = bt * (vt - a * kS); float o = 0.f;
#pragma unroll
                for (int i = 0; i < 32; ++i) { S[i] = a * S[i] + ks[tt * 128 + 32 * part + i] * c; o += qs[tt * 128 + 32 * part + i] * S[i]; }
                o += __shfl_xor(o, 1); o += __shfl_xor(o, 2);
                if (part == 0) OA[(size_t)(b * SEQ + t0 + tt) * GW + h * 128 + v] = o;
            }
            __syncthreads();
        }
    }
}


template <int J, int K, int N> struct SolveLd {
    static __device__ __forceinline__ void run(f32x4 (&l)[4], unsigned lbase) {
        if constexpr (K < N) { constexpr int t40 = ((J + 1) >> 2) << 2;
            asm volatile("ds_read_b128 %0, %1 offset:%2" : "=v"(l[K]) : "v"(lbase), "i"((J * 68 + t40 + 4 * K) * 4)); SolveLd<J, K + 1, N>::run(l, lbase); }
    }
};
template <int J> struct SolveCol16 {
    static __device__ __forceinline__ void run(float (&R)[16], unsigned lbase) {
        if constexpr (J < 15) {
            constexpr int t40 = ((J + 1) >> 2) << 2, nld = (16 - t40) >> 2;
            f32x4 l[4];
            SolveLd<J, 0, nld>::run(l, lbase);
            asm volatile("s_waitcnt lgkmcnt(0)" ::: "memory");
#pragma unroll
            for (int k = 0; k < nld; ++k) asm volatile("" : "+v"(l[k]));
#pragma unroll
            for (int k = 0; k < nld; ++k) {
#pragma unroll
                for (int e = 0; e < 4; ++e) if (t40 + 4 * k + e > J) R[t40 + 4 * k + e] += l[k][e] * R[J]; }
            SolveCol16<J + 1>::run(R, lbase);
        }
    }
};

typedef short bf16x8 __attribute__((ext_vector_type(8)));
__device__ __forceinline__ void gdn_prep(const Args& A, LAS unsigned char* lds, int tid0, int lane0, int wave) {
    const bf16* PROJ = (const bf16*)(A.ws + WS_PROJ); const float* AB = (const float*)(A.ws + WS_AB);
    const float* cw = A.in[3]; const float* a_log = A.in[4]; const float* dt_bias = A.in[5];
    unsigned char* UVF = A.ws + WS_XN; unsigned char* GOPS = (unsigned char*)A.out; float* GE = (float*)(A.ws + WS_GE);
    LAS float* Qs = (LAS float*)lds; LAS float* Ks = (LAS float*)(lds + 33792); LAS float* Vs = (LAS float*)(lds + 67584);
    LAS bf16* Qb = (LAS bf16*)(lds + 101376); LAS bf16* Kb = (LAS bf16*)(lds + 118784);
    LAS float* gcs = (LAS float*)(lds + 136192); LAS float* bts = gcs + 64; LAS float* egs = gcs + 128; LAS float* kes = gcs + 192;
    LAS float* LsT = (LAS float*)lds; LAS bf16* ATs = (LAS bf16*)(lds + 17408); LAS bf16* WKs = Kb;
    v4u rwn[11];
    if (tid0 < 384 && (int)blockIdx.x < NB * GH * 32) { const int c8 = tid0 % 48, run = tid0 / 48, which = c8 >> 4, d0 = (c8 & 15) * 8, t1 = blockIdx.x, bh1 = t1 >> 5, n1 = t1 & 31, b1 = bh1 >> 2, h1 = bh1 & 3, col1 = which * 512 + h1 * 128 + d0;
#pragma unroll
        for (int r = 0; r < 11; ++r) { const int ts = 64 * n1 + 8 * run - 3 + r; rwn[r] = (ts >= 0) ? *(const v4u*)(PROJ + (size_t)(b1 * SEQ + ts) * NP + col1) : (v4u){0u, 0u, 0u, 0u}; } }
    else {
#pragma unroll
        for (int r = 0; r < 11; ++r) rwn[r] = (v4u){0u, 0u, 0u, 0u}; }
#pragma unroll 1
    for (int task = blockIdx.x; task < NB * GH * 32; task += gridDim.x) {
        int tid = tid0, lane = lane0; asm volatile("" : "+v"(tid), "+v"(lane));
        const int fr = lane & 15, fq = lane >> 4;
        const int bh = task >> 5, n = task & 31, b = bh >> 2, h = bh & 3, t0 = 64 * n, row0 = b * SEQ + t0;
        unsigned char* gops = GOPS + (size_t)task * GOPS_CHUNK;
        if (tid < 384) {
            const int c8 = tid % 48, run = tid / 48, which = c8 >> 4, d0 = (c8 & 15) * 8, col = which * 512 + h * 128 + d0;
            v4u rw[11];
#pragma unroll
            for (int r = 0; r < 11; ++r) rw[r] = rwn[r];
            { const int tn = task + gridDim.x;
              if (tn < NB * GH * 32) { const int bhn = tn >> 5, nn = tn & 31, bn = bhn >> 2, hn = bhn & 3, coln = which * 512 + hn * 128 + d0;
#pragma unroll
                for (int r = 0; r < 11; ++r) { const int ts = 64 * nn + 8 * run - 3 + r; rwn[r] = (ts >= 0) ? *(const v4u*)(PROJ + (size_t)(bn * SEQ + ts) * NP + coln) : (v4u){0u, 0u, 0u, 0u}; } } }
            f32x4 cwa[4], cwb[4];
#pragma unroll
            for (int j = 0; j < 4; ++j) { cwa[j] = *(const f32x4*)(cw + j * 1536 + col); cwb[j] = *(const f32x4*)(cw + j * 1536 + col + 4); }
            LAS float* dstb = (which == 0 ? Qs : (which == 1 ? Ks : Vs)) + (8 * run) * 132 + d0;
#pragma unroll
            for (int i = 0; i < 8; ++i) {
                float acc[8];
#pragma unroll
                for (int e2 = 0; e2 < 8; ++e2) acc[e2] = 0.f;
#pragma unroll
                for (int j = 0; j < 4; ++j) { const v4u w = rw[i + j];
                    acc[0] += cwa[j].x * bflo(w.x); acc[1] += cwa[j].y * bfhi(w.x); acc[2] += cwa[j].z * bflo(w.y); acc[3] += cwa[j].w * bfhi(w.y);
                    acc[4] += cwb[j].x * bflo(w.z); acc[5] += cwb[j].y * bfhi(w.z); acc[6] += cwb[j].z * bflo(w.w); acc[7] += cwb[j].w * bfhi(w.w); }
                *(LAS f32x4*)(dstb + i * 132) = (f32x4){silu_f(acc[0]), silu_f(acc[1]), silu_f(acc[2]), silu_f(acc[3])};
                *(LAS f32x4*)(dstb + i * 132 + 4) = (f32x4){silu_f(acc[4]), silu_f(acc[5]), silu_f(acc[6]), silu_f(acc[7])};
            }
        }
        if (wave == 0) {
            const size_t row = (size_t)row0 + lane; const float beta = sigmoid_f(AB[row * 8 + h]);
            float g = -__expf(a_log[h]) * softplus_f(AB[row * 8 + 4 + h] + dt_bias[h]);
#pragma unroll
            for (int o = 1; o < 64; o <<= 1) { const float t = __shfl_up(g, o); if (lane >= o) g += t; }
            const float glast = __shfl(g, 63);
            gcs[lane] = g; bts[lane] = beta; egs[lane] = __expf(g); kes[lane] = __expf(glast - g) * beta;
            if (lane == 63) GE[task] = __expf(g);
        }
        __syncthreads();
#pragma unroll 2
        for (int r = 0; r < 8; ++r) { const int row = 8 * wave + r;
            { const float v0 = Qs[row * 132 + lane], v1 = Qs[row * 132 + lane + 64]; const float sc = rsqrtf(wave_sum(v0 * v0 + v1 * v1) + RMS_EPS) * 0.08838834764831845f;
              Qb[row * 136 + lane] = (bf16)(pk2(v0 * sc, 0.f) & 0xffffu); Qb[row * 136 + lane + 64] = (bf16)(pk2(v1 * sc, 0.f) & 0xffffu); }
            { const float v0 = Ks[row * 132 + lane], v1 = Ks[row * 132 + lane + 64]; const float sc = rsqrtf(wave_sum(v0 * v0 + v1 * v1) + RMS_EPS);
              Ks[row * 132 + lane] = v0 * sc; Ks[row * 132 + lane + 64] = v1 * sc; Kb[row * 136 + lane] = (bf16)(pk2(v0 * sc, 0.f) & 0xffffu); Kb[row * 136 + lane + 64] = (bf16)(pk2(v1 * sc, 0.f) & 0xffffu); }
        }
        __syncthreads();
#pragma unroll 1
        for (int jb = wave; jb < 20; jb += 8) {
            const int kind = jb >= 10 ? 1 : 0, idx = jb - 10 * kind, ti = idx < 1 ? 0 : (idx < 3 ? 1 : (idx < 6 ? 2 : 3)), tj = idx - ti * (ti + 1) / 2;
            const LAS bf16* As = kind ? Qb : Kb; f32x4 d = (f32x4){0.f, 0.f, 0.f, 0.f};
#pragma unroll
            for (int ks = 0; ks < 4; ++ks) { const bf16x8 a = *(const LAS bf16x8*)(As + (16 * ti + fr) * 136 + 32 * ks + 8 * fq), bb = *(const LAS bf16x8*)(Kb + (16 * tj + fr) * 136 + 32 * ks + 8 * fq);
                d = __builtin_amdgcn_mfma_f32_16x16x32_bf16(a, bb, d, 0, 0, 0); }
            const int j = 16 * tj + fr; const float gj = gcs[j], bj = bts[j]; float val[4];
#pragma unroll
            for (int e = 0; e < 4; ++e) { const int t = 16 * ti + 4 * fq + e; const float x = d[e] * __expf(gcs[t] - gj) * bj; val[e] = (kind ? (t >= j) : (t > j)) ? x : 0.f; }
            if (kind == 0) *(LAS f32x4*)(LsT + j * 68 + 16 * ti + 4 * fq) = (f32x4){-val[0], -val[1], -val[2], -val[3]};
            else {
#pragma unroll
                for (int e = 0; e < 4; ++e) ATs[(16 * ti + 4 * fq + e) * 72 + j] = (bf16)(pk2(val[e], 0.f) & 0xffffu); }
        }
        __syncthreads();
        LAS float* Ti = (LAS float*)(lds + 26624);
        if (wave == 0) {
            const int I = lane >> 4, c = lane & 15; float x[16];
#pragma unroll
            for (int r = 0; r < 16; ++r) x[r] = (r == c) ? 1.0f : 0.0f;
            SolveCol16<0>::run(x, (unsigned)(uintptr_t)LsT + (unsigned)(I * (16 * 68 + 16) * 4));
#pragma unroll
            for (int r = 0; r < 16; ++r) Ti[(I * 16 + r) * 20 + c] = x[r];
        } else {
            const int rt = tid - 64;
            for (int q = rt; q < 1024; q += 448) { const int blk = q >> 6, l2 = q & 63, i = l2 & 15, f = l2 >> 4, mb = blk >> 2, ks = blk & 3, t = 16 * mb + i;
                const v2u p0 = *(const LAS v2u*)(Qb + t * 136 + 32 * ks + 4 * f), p1 = *(const LAS v2u*)(Qb + t * 136 + 32 * ks + 16 + 4 * f); const float eg = egs[t];
                v4u o; o.x = pk2(bflo(p0.x) * eg, bfhi(p0.x) * eg); o.y = pk2(bflo(p0.y) * eg, bfhi(p0.y) * eg); o.z = pk2(bflo(p1.x) * eg, bfhi(p1.x) * eg); o.w = pk2(bflo(p1.y) * eg, bfhi(p1.y) * eg);
                *(v4u*)(gops + 16384 + q * 16) = o; }
            for (int q = rt; q < 512; q += 448) { const int blk = q >> 6, l2 = q & 63, i = l2 & 15, f = l2 >> 4, mb = blk >> 1, ks2 = blk & 1, t = 16 * mb + i;
                v2u p0 = (v2u){0u, 0u}, p1 = (v2u){0u, 0u};
                if (2 * ks2 <= mb) p0 = *(const LAS v2u*)(ATs + t * 72 + 32 * ks2 + 4 * f);
                if (2 * ks2 + 1 <= mb) p1 = *(const LAS v2u*)(ATs + t * 72 + 32 * ks2 + 16 + 4 * f);
                *(v4u*)(gops + 32768 + q * 16) = (v4u){p0.x, p0.y, p1.x, p1.y}; }
            for (int q = rt; q < 1024; q += 448) { const int blk = q >> 6, l2 = q & 63, i = l2 & 15, f = l2 >> 4, dkb = blk >> 1, ks2 = blk & 1, dk = 16 * dkb + i; float v[8];
#pragma unroll
                for (int e2 = 0; e2 < 8; ++e2) { const int c = 32 * ks2 + 16 * (e2 >> 2) + 4 * f + (e2 & 3); v[e2] = Ks[c * 132 + dk] * kes[c]; }
                *(v4u*)(gops + 40960 + q * 16) = (v4u){pk2(v[0], v[1]), pk2(v[2], v[3]), pk2(v[4], v[5]), pk2(v[6], v[7])}; }
        }
        __syncthreads();
#pragma unroll
        for (int ct = 0; ct < 2; ++ct) {
            const int C = 2 * wave + ct; const bool isv = C < 8; const int col = isv ? 16 * C + fr : 16 * (C - 8) + fr;
            f32x4 X[4];
#pragma unroll
            for (int I = 0; I < 4; ++I) {
                f32x4 acc;
#pragma unroll
                for (int e2 = 0; e2 < 4; ++e2) { const int t = 16 * I + 4 * fq + e2; acc[e2] = isv ? Vs[t * 132 + col] : egs[t] * Ks[t * 132 + col]; }
#pragma unroll
                for (int J = 0; J < 4; ++J) if (J < I) {
#pragma unroll
                    for (int kk = 0; kk < 4; ++kk) acc = __builtin_amdgcn_mfma_f32_16x16x4f32(LsT[(16 * J + 4 * fq + kk) * 68 + 16 * I + fr], X[J][kk], acc, 0, 0, 0); }
                f32x4 xi = (f32x4){0.f, 0.f, 0.f, 0.f};
#pragma unroll
                for (int kk = 0; kk < 4; ++kk) xi = __builtin_amdgcn_mfma_f32_16x16x4f32(Ti[(I * 16 + fr) * 20 + 4 * fq + kk], acc[kk], xi, 0, 0, 0);
                X[I] = xi;
                if (isv) { v2u w; w.x = pk2(xi[0], xi[1]); w.y = pk2(xi[2], xi[3]); *(v2u*)(UVF + (size_t)task * 16384 + (size_t)((C * 4 + I) * 64 + lane) * 8) = w; }
                else {
#pragma unroll
                    for (int e2 = 0; e2 < 4; ++e2) WKs[(16 * I + 4 * fq + e2) * 136 + col] = (bf16)(pk2(xi[e2], 0.f) & 0xffffu); }
            }
        }
        __syncthreads();
        for (int q = tid; q < 1024; q += NTHR) { const int blk = q >> 6, l2 = q & 63, i = l2 & 15, f = l2 >> 4, mb = blk >> 2, ks = blk & 3, t = 16 * mb + i;
            const v2u p0 = *(const LAS v2u*)(WKs + t * 136 + 32 * ks + 4 * f), p1 = *(const LAS v2u*)(WKs + t * 136 + 32 * ks + 16 + 4 * f);
            *(v4u*)(gops + q * 16) = (v4u){p0.x, p0.y, p1.x, p1.y}; }
        __syncthreads();
    }
}

__device__ __forceinline__ bf16x8 pack8(const f32x4 a, const f32x4 b) {
    v4u w; w.x = pk2(a[0], a[1]); w.y = pk2(a[2], a[3]); w.z = pk2(b[0], b[1]); w.w = pk2(b[2], b[3]); return __builtin_bit_cast(bf16x8, w);
}
__device__ __forceinline__ void gdn_scan(const Args& A, LAS unsigned char* lds, int bh, int tid, int lane, int wave) {
    const int b = bh >> 2, h = bh & 3, fr = lane & 15, fq = lane >> 4, vs = wave;
    const unsigned char* gops = (const unsigned char*)A.out + (size_t)bh * 32 * GOPS_CHUNK;
    const unsigned char* uvf = A.ws + WS_XN + (size_t)bh * 32 * 16384; const float* GE = (const float*)(A.ws + WS_GE) + bh * 32;
    float* Op = (float*)(A.ws + WS_OA) + ((size_t)b * SEQ + 4 * fq) * GW + h * 128 + 16 * vs + fr;
    f32x4 S[8];
#pragma unroll
    for (int i = 0; i < 8; ++i) S[i] = (f32x4){0.f, 0.f, 0.f, 0.f};
    const float gev = GE[lane & 31];
#define SCAN_DMA(chunk, bufoff) do { _Pragma("unroll") for (int i_ = 0; i_ < 9; ++i_) { const int p_ = wave + 8 * i_; \
        const unsigned char* s_ = (p_ < 56) ? (gops + (size_t)(chunk) * GOPS_CHUNK + p_ * 1024) : (uvf + (size_t)(chunk) * 16384 + (p_ - 56) * 1024); \
        __builtin_amdgcn_global_load_lds((const unsigned*)(s_ + lane * 16), (LAS unsigned*)(lds + (bufoff) + p_ * 1024), 16, 0, 0); } } while (0)
    SCAN_DMA(0, 0); SCAN_DMA(1, SCAN_BUF);
    asm volatile("s_waitcnt vmcnt(0)" ::: "memory"); __syncthreads();
#pragma unroll 1
    for (int n = 0; n < 32; ++n) {
        const LAS unsigned char* cur = lds + (n & 1) * SCAN_BUF;
        const float ge = __builtin_bit_cast(float, __builtin_amdgcn_readlane(__builtin_bit_cast(int, gev), n));
        bf16x8 Sb[4];
#pragma unroll
        for (int ks = 0; ks < 4; ++ks) Sb[ks] = pack8(S[2 * ks], S[2 * ks + 1]);
        f32x4 u[4];
#pragma unroll
        for (int mb = 0; mb < 4; ++mb) { f32x4 p = (f32x4){0.f, 0.f, 0.f, 0.f};
#pragma unroll
            for (int ks = 0; ks < 4; ++ks) p = __builtin_amdgcn_mfma_f32_16x16x32_bf16(*(const LAS bf16x8*)(cur + ((mb * 4 + ks) * 64 + lane) * 16), Sb[ks], p, 0, 0, 0);
            const v2u uw = *(const LAS v2u*)(cur + GOPS_CHUNK + ((vs * 4 + mb) * 64 + lane) * 8);
            u[mb] = (f32x4){bflo(uw.x) - p[0], bfhi(uw.x) - p[1], bflo(uw.y) - p[2], bfhi(uw.y) - p[3]}; }
        bf16x8 ub[2]; ub[0] = pack8(u[0], u[1]); ub[1] = pack8(u[2], u[3]);
        f32x4 o[4];
#pragma unroll
        for (int mb = 0; mb < 4; ++mb) { f32x4 acc = (f32x4){0.f, 0.f, 0.f, 0.f};
#pragma unroll
            for (int ks = 0; ks < 4; ++ks) acc = __builtin_amdgcn_mfma_f32_16x16x32_bf16(*(const LAS bf16x8*)(cur + 16384 + ((mb * 4 + ks) * 64 + lane) * 16), Sb[ks], acc, 0, 0, 0);
#pragma unroll
            for (int ks2 = 0; ks2 < 2; ++ks2) if (ks2 <= (mb >> 1)) acc = __builtin_amdgcn_mfma_f32_16x16x32_bf16(*(const LAS bf16x8*)(cur + 32768 + ((mb * 2 + ks2) * 64 + lane) * 16), ub[ks2], acc, 0, 0, 0);
            o[mb] = acc; }
#pragma unroll
        for (int dkb = 0; dkb < 8; ++dkb) { f32x4 acc = S[dkb] * ge;
#pragma unroll
            for (int ks2 = 0; ks2 < 2; ++ks2) acc = __builtin_amdgcn_mfma_f32_16x16x32_bf16(*(const LAS bf16x8*)(cur + 40960 + ((dkb * 2 + ks2) * 64 + lane) * 16), ub[ks2], acc, 0, 0, 0);
            S[dkb] = acc; }
        asm volatile("s_waitcnt vmcnt(0)" ::: "memory"); __syncthreads();
        if (n + 2 < 32) SCAN_DMA(n + 2, (n & 1) * SCAN_BUF);
        float* orow = Op + (size_t)(64 * n) * GW;
#pragma unroll
        for (int mb = 0; mb < 4; ++mb) { float* q = orow + (size_t)(16 * mb) * GW; q[0] = o[mb][0]; q[GW] = o[mb][1]; q[2 * GW] = o[mb][2]; q[3 * GW] = o[mb][3]; }
    }
    asm volatile("s_waitcnt vmcnt(0)" ::: "memory"); __syncthreads();
#undef SCAN_DMA
}


__device__ __forceinline__ void attn_fast(const Args& A, LAS unsigned char* lds, int lane, int wave) {
    const bf16* PROJ = (const bf16*)(A.ws + WS_PROJ); bf16* CAT = (bf16*)(A.ws + WS_CAT);
    unsigned* ctr = (unsigned*)(A.ws + WS_CTL);
    LAS bf16* Vt = (LAS bf16*)(lds + wave * 8192);
    const int fr = lane & 15, fq = lane >> 4;
    const int kk = lane & 31, vslot = 8 * ((kk & 15) >> 2) + 4 * (kk >> 4) + (kk & 3), vch = lane >> 5;
    constexpr float SC = 0.125f * 1.4426950408889634f;
    const int myx = (int)(__builtin_amdgcn_s_getreg((3 << 11) | 20) & 0x7u);
    int qi = 0;
    for (;;) {
        int wt = 512, xq = 0;
        while (qi < 8) { xq = (myx + qi) & 7; unsigned wt_ = 0; if (lane == 0) wt_ = atomicAdd(ctr + 16 * xq, 1u); wt = __builtin_amdgcn_readfirstlane(wt_); if (wt < 512) break; ++qi; }
        if (qi >= 8) break;
        const int b = wt >> 6, h = xq, rem = wt & 63, T = 7 - (rem >> 3), c4 = rem & 7, cA = (c4 & 3) + 8 * (c4 >> 2), cB = cA + 4, t0 = 256 * T;
        const bf16* Pb = PROJ + (size_t)b * SEQ * NP;
        const int tqA = t0 + cA + 16 * fr, tqB = tqA + 4;
        bf16x8 qfA[2], qfB[2];
#pragma unroll
        for (int ks = 0; ks < 2; ++ks) { qfA[ks] = *(const bf16x8*)(Pb + (size_t)tqA * NP + PC_QB + h * 64 + 32 * ks + 8 * fq); qfB[ks] = *(const bf16x8*)(Pb + (size_t)tqB * NP + PC_QB + h * 64 + 32 * ks + 8 * fq); }
        const int n2 = ((t0 + 240) >> 4) + 1, g2 = (n2 + 31) >> 5;
        const int lo1 = max(t0 + cA - 512, cA & 3), n1 = ((t0 + cB + 240 - lo1) >> 2) + 1, g1 = (n1 + 31) >> 5;
        const int lo0 = max(t0 + cA - 128, 0), n0 = (t0 + cB + 240 - lo0) + 1, g0 = (n0 + 31) >> 5;
        const int NG = 2 * g2 + g1 + g0;
        f32x4 OA[4], OB[4];
#pragma unroll
        for (int i = 0; i < 4; ++i) { OA[i] = (f32x4){0.f, 0.f, 0.f, 0.f}; OB[i] = OA[i]; }
        float mA = -INFINITY, lA = 0.f, mB = -INFINITY, lB = 0.f;
        v4u kc[4], vc[4], kn[4], vn[4];
#define ATT_DEC(f, kst, str, mode) do { if ((f) < g2) { str = 16; kst = cA + 512 * (f); mode = 1; } else if ((f) < 2 * g2) { str = 16; kst = cB + 512 * ((f) - g2); mode = 2; } \
            else if ((f) < 2 * g2 + g1) { str = 4; kst = lo1 + 128 * ((f) - 2 * g2); mode = 3; } else { str = 1; kst = lo0 + 32 * ((f) - 2 * g2 - g1); mode = 3; } } while (0)
#define ATT_LOAD(kreg, vreg, kst, str) do { \
            _Pragma("unroll") for (int j = 0; j < 2; ++j) { const int tk = min((kst) + (str) * (16 * j + fr), SEQ - 1); \
                _Pragma("unroll") for (int ks = 0; ks < 2; ++ks) kreg[2 * j + ks] = *(const v4u*)(Pb + (size_t)tk * NP + PC_KB + h * 64 + 32 * ks + 8 * fq); } \
            { const int tk = min((kst) + (str) * kk, SEQ - 1); \
                _Pragma("unroll") for (int i = 0; i < 4; ++i) vreg[i] = *(const v4u*)(Pb + (size_t)tk * NP + PC_VB + h * 64 + 8 * (vch + 2 * i)); } } while (0)
#define ATT_CLS(O_, m_, l_, qf_, tq_) do { \
            f32x4 d0 = (f32x4){0.f, 0.f, 0.f, 0.f}, d1 = d0; \
            _Pragma("unroll") for (int ks = 0; ks < 2; ++ks) { d0 = __builtin_amdgcn_mfma_f32_16x16x32_bf16(__builtin_bit_cast(bf16x8, kc[ks]), qf_[ks], d0, 0, 0, 0); \
                                                             d1 = __builtin_amdgcn_mfma_f32_16x16x32_bf16(__builtin_bit_cast(bf16x8, kc[2 + ks]), qf_[ks], d1, 0, 0, 0); } \
            float s[8]; float mloc = -INFINITY; \
            _Pragma("unroll") for (int e2 = 0; e2 < 8; ++e2) { const int tk = kst + str * (16 * (e2 >> 2) + 4 * fq + (e2 & 3)); const int dt = (tq_) - tk; const float x = (e2 < 4 ? d0[e2 & 3] : d1[e2 & 3]) * SC; \
                s[e2] = (dt >= 0 && dt <= span) ? x : -INFINITY; mloc = fmaxf(mloc, s[e2]); } \
            mloc = fmaxf(mloc, __shfl_xor(mloc, 16)); mloc = fmaxf(mloc, __shfl_xor(mloc, 32)); \
            const float mnew = fmaxf(m_, mloc), alpha = __builtin_amdgcn_exp2f(m_ - mnew); m_ = mnew; \
            float psum = 0.f; \
            _Pragma("unroll") for (int e2 = 0; e2 < 8; ++e2) { s[e2] = __builtin_amdgcn_exp2f(s[e2] - mnew); psum += s[e2]; } \
            l_ = l_ * alpha + psum; \
            const bf16x8 pb = pack8((f32x4){s[0], s[1], s[2], s[3]}, (f32x4){s[4], s[5], s[6], s[7]}); \
            _Pragma("unroll") for (int db = 0; db < 4; ++db) O_[db] = __builtin_amdgcn_mfma_f32_16x16x32_bf16(va[db], pb, O_[db] * alpha, 0, 0, 0); } while (0)
        int kst, str, mode; ATT_DEC(0, kst, str, mode); ATT_LOAD(kc, vc, kst, str);
#pragma unroll 1
        for (int f = 0; f < NG; ++f) {
            int kstn = 0, strn = 1, moden = 0;
            if (f + 1 < NG) { ATT_DEC(f + 1, kstn, strn, moden); ATT_LOAD(kn, vn, kstn, strn); }
#pragma unroll
            for (int i = 0; i < 4; ++i) { const int dd = 8 * (vch + 2 * i); const v4u w = vc[i];
                Vt[(dd + 0) * 40 + vslot] = (bf16)(w.x & 0xffffu); Vt[(dd + 1) * 40 + vslot] = (bf16)(w.x >> 16); Vt[(dd + 2) * 40 + vslot] = (bf16)(w.y & 0xffffu); Vt[(dd + 3) * 40 + vslot] = (bf16)(w.y >> 16);
                Vt[(dd + 4) * 40 + vslot] = (bf16)(w.z & 0xffffu); Vt[(dd + 5) * 40 + vslot] = (bf16)(w.z >> 16); Vt[(dd + 6) * 40 + vslot] = (bf16)(w.w & 0xffffu); Vt[(dd + 7) * 40 + vslot] = (bf16)(w.w >> 16); }
            bf16x8 va[4];
#pragma unroll
            for (int db = 0; db < 4; ++db) va[db] = *(const LAS bf16x8*)(Vt + (16 * db + fr) * 40 + 8 * fq);
            const int span = 128 * str;
            if (mode & 1) ATT_CLS(OA, mA, lA, qfA, tqA);
            if (mode & 2) ATT_CLS(OB, mB, lB, qfB, tqB);
#pragma unroll
            for (int i = 0; i < 4; ++i) { kc[i] = kn[i]; vc[i] = vn[i]; }
            kst = kstn; str = strn; mode = moden;
        }
#undef ATT_DEC
#undef ATT_LOAD
#undef ATT_CLS
        lA += __shfl_xor(lA, 16); lA += __shfl_xor(lA, 32); lB += __shfl_xor(lB, 16); lB += __shfl_xor(lB, 32);
        const float invA = 1.0f / lA, invB = 1.0f / lB;
        bf16* op = CAT + ((size_t)b * SEQ + tqA) * DM + GW + h * 64 + 4 * fq;
#pragma unroll
        for (int db = 0; db < 4; ++db) { v2u w; w.x = pk2(OA[db][0] * invA, OA[db][1] * invA); w.y = pk2(OA[db][2] * invA, OA[db][3] * invA); *(v2u*)(op + 16 * db) = w;
            v2u w2; w2.x = pk2(OB[db][0] * invB, OB[db][1] * invB); w2.y = pk2(OB[db][2] * invB, OB[db][3] * invB); *(v2u*)(op + 4 * DM + 16 * db) = w2; }
    }
}

__device__ __forceinline__ void attn_simple(const Args& A, int tid, int lane, int wave) {
    const bf16* PROJ = (const bf16*)(A.ws + WS_PROJ); bf16* CAT = (bf16*)(A.ws + WS_CAT);
    unsigned* ctr = (unsigned*)(A.ws + WS_CTL);
    for (;;) {
        unsigned wt_ = 0; if (lane == 0) wt_ = atomicAdd(ctr, 1u); const int wt = __builtin_amdgcn_readfirstlane(wt_);
        if (wt >= (M / 64) * AH) break;
        const int h = wt % AH, tb = wt / AH, row = tb * 64 + lane, b = row / SEQ, t = row % SEQ;
        float q[64], acc[64];
        { const v4u* qp = (const v4u*)(PROJ + (size_t)row * NP + PC_QB + h * 64);
#pragma unroll
          for (int j = 0; j < 8; ++j) { const v4u w = qp[j]; q[8 * j + 0] = bflo(w.x) * 0.125f; q[8 * j + 1] = bfhi(w.x) * 0.125f; q[8 * j + 2] = bflo(w.y) * 0.125f; q[8 * j + 3] = bfhi(w.y) * 0.125f;
              q[8 * j + 4] = bflo(w.z) * 0.125f; q[8 * j + 5] = bfhi(w.z) * 0.125f; q[8 * j + 6] = bflo(w.w) * 0.125f; q[8 * j + 7] = bfhi(w.w) * 0.125f; } }
#pragma unroll
        for (int j = 0; j < 64; ++j) acc[j] = 0.f;
        float mx = -1e30f, l = 0.f;
        for (int br = 0; br < 3; ++br) {
            const int stride = br == 0 ? 1 : (br == 1 ? 4 : 16);
            for (int i = 0; i <= 128; ++i) {
                const int tk = t - i * stride; if (tk < 0) break;
                const size_t krow = (size_t)(b * SEQ + tk) * NP;
                const v4u* kp = (const v4u*)(PROJ + krow + PC_KB + h * 64); const v4u* vp = (const v4u*)(PROJ + krow + PC_VB + h * 64);
                float s = 0.f;
#pragma unroll
                for (int j = 0; j < 8; ++j) { const v4u w = kp[j]; s += q[8 * j + 0] * bflo(w.x) + q[8 * j + 1] * bfhi(w.x) + q[8 * j + 2] * bflo(w.y) + q[8 * j + 3] * bfhi(w.y)
                                                                       + q[8 * j + 4] * bflo(w.z) + q[8 * j + 5] * bfhi(w.z) + q[8 * j + 6] * bflo(w.w) + q[8 * j + 7] * bfhi(w.w); }
                const float mn = fmaxf(mx, s), sc = __expf(mx - mn), p = __expf(s - mn); mx = mn; l = l * sc + p;
#pragma unroll
                for (int j = 0; j < 8; ++j) { const v4u w = vp[j];
                    acc[8 * j + 0] = acc[8 * j + 0] * sc + p * bflo(w.x); acc[8 * j + 1] = acc[8 * j + 1] * sc + p * bfhi(w.x); acc[8 * j + 2] = acc[8 * j + 2] * sc + p * bflo(w.y); acc[8 * j + 3] = acc[8 * j + 3] * sc + p * bfhi(w.y);
                    acc[8 * j + 4] = acc[8 * j + 4] * sc + p * bflo(w.z); acc[8 * j + 5] = acc[8 * j + 5] * sc + p * bfhi(w.z); acc[8 * j + 6] = acc[8 * j + 6] * sc + p * bflo(w.w); acc[8 * j + 7] = acc[8 * j + 7] * sc + p * bfhi(w.w); }
            }
        }
        const float inv = 1.0f / l; v4u* op = (v4u*)(CAT + (size_t)row * DM + GW + h * 64);
#pragma unroll
        for (int j = 0; j < 8; ++j) { v4u w; w.x = pk2(acc[8 * j] * inv, acc[8 * j + 1] * inv); w.y = pk2(acc[8 * j + 2] * inv, acc[8 * j + 3] * inv); w.z = pk2(acc[8 * j + 4] * inv, acc[8 * j + 5] * inv); w.w = pk2(acc[8 * j + 6] * inv, acc[8 * j + 7] * inv); op[j] = w; }
    }
}
__device__ __forceinline__ void gated_norm(const Args& A, int lane, int wave) {
    const bf16* PROJ = (const bf16*)(A.ws + WS_PROJ); bf16* CAT = (bf16*)(A.ws + WS_CAT); const float* OA = (const float*)(A.ws + WS_OA); const float* gw = A.in[6];
    const float w0 = gw[2 * lane], w1 = gw[2 * lane + 1];
    const int gwv = blockIdx.x * NWAVES + wave, NGW = gridDim.x * NWAVES;
    for (int wt0 = gwv; wt0 < M * GH; wt0 += 8 * NGW) {
        float2 o[8]; unsigned zz[8];
#pragma unroll
        for (int i = 0; i < 8; ++i) { const int wt = min(wt0 + i * NGW, M * GH - 1), row = wt / GH, h = wt % GH;
            o[i] = *(const float2*)(OA + (size_t)row * GW + h * 128 + 2 * lane); zz[i] = *(const unsigned*)(PROJ + (size_t)row * NP + PC_Z + h * 128 + 2 * lane); }
#pragma unroll
        for (int i = 0; i < 8; ++i) { const int wt = wt0 + i * NGW; if (wt >= M * GH) break; const int row = wt / GH, h = wt % GH;
            const float ms = wave_sum(o[i].x * o[i].x + o[i].y * o[i].y) * (1.0f / 128.0f), r = rsqrtf(ms + RMS_EPS);
            *(unsigned*)(CAT + (size_t)row * DM + h * 128 + 2 * lane) = pk2(o[i].x * r * w0 * silu_f(bflo(zz[i])), o[i].y * r * w1 * silu_f(bfhi(zz[i]))); }
    }
}

__device__ __forceinline__ void gated_norm_bh(const Args& A, int bh, int lane, int wave) {
    const int b = bh >> 2, h = bh & 3;
    const bf16* Zp = (const bf16*)(A.ws + WS_PROJ) + (size_t)b * SEQ * NP + PC_Z + h * 128 + 2 * lane; bf16* Cp = (bf16*)(A.ws + WS_CAT) + (size_t)b * SEQ * DM + h * 128 + 2 * lane;
    const float* Op = (const float*)(A.ws + WS_OA) + (size_t)b * SEQ * GW + h * 128 + 2 * lane; const float* gw = A.in[6];
    const float w0 = gw[2 * lane], w1 = gw[2 * lane + 1];
    __builtin_amdgcn_fence(__ATOMIC_ACQUIRE, "agent");
#pragma unroll 1
    for (int r0 = wave * 16; r0 < SEQ; r0 += NWAVES * 16) {
        float2 o[16]; unsigned zz[16];
#pragma unroll
        for (int i = 0; i < 16; ++i) { o[i] = *(const float2*)(Op + (size_t)(r0 + i) * GW); zz[i] = *(const unsigned*)(Zp + (size_t)(r0 + i) * NP); }
#pragma unroll
        for (int i = 0; i < 16; ++i) { const float ms = wave_sum(o[i].x * o[i].x + o[i].y * o[i].y) * (1.0f / 128.0f), r = rsqrtf(ms + RMS_EPS);
            *(unsigned*)(Cp + (size_t)(r0 + i) * DM) = pk2(o[i].x * r * w0 * silu_f(bflo(zz[i])), o[i].y * r * w1 * silu_f(bfhi(zz[i]))); }
    }
}
__device__ __forceinline__ void ffn_conv_half(const Args& A, int half, int tid) {
    const bf16* Y = (const bf16*)(A.ws + WS_Y); bf16* ACT = (bf16*)(A.ws + WS_ACT); const float* fw = A.in[10];
    constexpr int HC = DFF / 2;
    for (size_t it = (size_t)blockIdx.x * NTHR + tid; it < (size_t)M * (HC / 8); it += (size_t)gridDim.x * NTHR) {
        const int row = (int)(it / (HC / 8)), g8 = (int)(it % (HC / 8)), cl = g8 * 8, pn = cl >> 7, j = cl & 127, t = row % SEQ, ch = half * HC + cl;
        float ga[8], ua[8];
#pragma unroll
        for (int e = 0; e < 8; ++e) { ga[e] = 0.f; ua[e] = 0.f; }
#pragma unroll
        for (int i = 0; i < 3; ++i) { const int ts = t - 2 + i; if (ts < 0) continue;
            const bf16* yr = Y + (size_t)(row - 2 + i) * DFF + 256 * pn + j; const v4u g = *(const v4u*)yr, u = *(const v4u*)(yr + 128);
            const f32x4 wg0 = *(const f32x4*)(fw + i * NUP + ch), wg1 = *(const f32x4*)(fw + i * NUP + ch + 4), wu0 = *(const f32x4*)(fw + i * NUP + DFF + ch), wu1 = *(const f32x4*)(fw + i * NUP + DFF + ch + 4);
            ga[0] += wg0.x * bflo(g.x); ga[1] += wg0.y * bfhi(g.x); ga[2] += wg0.z * bflo(g.y); ga[3] += wg0.w * bfhi(g.y); ga[4] += wg1.x * bflo(g.z); ga[5] += wg1.y * bfhi(g.z); ga[6] += wg1.z * bflo(g.w); ga[7] += wg1.w * bfhi(g.w);
            ua[0] += wu0.x * bflo(u.x); ua[1] += wu0.y * bfhi(u.x); ua[2] += wu0.z * bflo(u.y); ua[3] += wu0.w * bfhi(u.y); ua[4] += wu1.x * bflo(u.z); ua[5] += wu1.y * bfhi(u.z); ua[6] += wu1.z * bflo(u.w); ua[7] += wu1.w * bfhi(u.w); }
        v4u o; o.x = pk2(silu_f(ga[0]) * ua[0], silu_f(ga[1]) * ua[1]); o.y = pk2(silu_f(ga[2]) * ua[2], silu_f(ga[3]) * ua[3]); o.z = pk2(silu_f(ga[4]) * ua[4], silu_f(ga[5]) * ua[5]); o.w = pk2(silu_f(ga[6]) * ua[6], silu_f(ga[7]) * ua[7]);
        *(v4u*)(ACT + (size_t)row * DFF + ch) = o;
    }
}

__device__ __forceinline__ void ffn_fixup(const Args& A, int tid) {
    const float* YH = (const float*)(A.ws + WS_YH); const float* UP = (const float*)(A.ws + WS_UPART); bf16* ACT = (bf16*)(A.ws + WS_ACT); const float* fw = A.in[10];
    for (int it = blockIdx.x * NTHR + tid; it < 64 * 22 * 2 * 128; it += gridDim.x * NTHR) {
        const int c = it & 127, r = (it >> 7) & 1, tile = it >> 8, pm = tile / 22, pn = tile % 22; if ((pm & 7) == 0) continue;
        const int ch = pn * 128 + c; const float* up = UP + ((size_t)tile * 2 + r) * 256; const float* yh = YH + (size_t)((pm - 1) * 22 + pn) * 2 * 256;
        float g = up[c], u = up[128 + c];
        const float wg0 = fw[ch], wg1 = fw[5632 + ch], wu0 = fw[2816 + ch], wu1 = fw[5632 + 2816 + ch];
        if (r == 0) { g += wg0 * yh[c] + wg1 * yh[256 + c]; u += wu0 * yh[128 + c] + wu1 * yh[256 + 128 + c]; }
        else { g += wg0 * yh[256 + c]; u += wu0 * yh[256 + 128 + c]; }
        ACT[(size_t)(pm * 256 + r) * DFF + ch] = (bf16)(pk2(silu_f(g) * u, 0.f) & 0xffffu);
    }
}
__device__ __forceinline__ void final_norm(const Args& A, int lane, int wave) {
    float* out = A.out; const f32x4* nr = (const f32x4*)A.in[12] + lane;
    const int gw = blockIdx.x * NWAVES + wave, NGW = gridDim.x * NWAVES;
    f32x4 nw[4];
#pragma unroll
    for (int j = 0; j < 4; ++j) nw[j] = nr[64 * j];
    for (int m0 = gw; m0 < M; m0 += 4 * NGW) {
        f32x4 v[4][4];
#pragma unroll
        for (int rr = 0; rr < 4; ++rr) { const int m = min(m0 + rr * NGW, M - 1); const f32x4* xr = (const f32x4*)(out + (size_t)m * DM) + lane;
#pragma unroll
            for (int j = 0; j < 4; ++j) v[rr][j] = xr[64 * j]; }
#pragma unroll
        for (int rr = 0; rr < 4; ++rr) { const int m = m0 + rr * NGW; if (m >= M) break; float s = 0.f;
#pragma unroll
            for (int j = 0; j < 4; ++j) s += (v[rr][j].x * v[rr][j].x + v[rr][j].y * v[rr][j].y) + (v[rr][j].z * v[rr][j].z + v[rr][j].w * v[rr][j].w);
            const float rstd = rsqrtf(wave_sum(s) * (1.f / DM) + RMS_EPS); f32x4* xw = (f32x4*)(out + (size_t)m * DM) + lane;
#pragma unroll
            for (int j = 0; j < 4; ++j) xw[64 * j] = (f32x4){v[rr][j].x * rstd * nw[j].x, v[rr][j].y * rstd * nw[j].y, v[rr][j].z * rstd * nw[j].z, v[rr][j].w * rstd * nw[j].w}; }
    }
}

#define XB_TMO      128
#define XB_XCNT(j)  (256  + 64 * (j))
#define XB_XSUB(j)  (1280 + 64 * (j))
#define XB_XGEN(j)  (2304 + 64 * (j))
#define XB_TOP      3328
#define XB_TOPGEN   3392
#define XCD_BAR_WORDS 3456
#define XB_SPIN_CAP (1u << 18)

__device__ __forceinline__ unsigned xb_ld(unsigned* p)              { return __hip_atomic_load(p, __ATOMIC_RELAXED, __HIP_MEMORY_SCOPE_AGENT); }
__device__ __forceinline__ unsigned xb_add(unsigned* p, unsigned v) { return __hip_atomic_fetch_add(p, v, __ATOMIC_RELAXED, __HIP_MEMORY_SCOPE_AGENT); }
__device__ __forceinline__ unsigned xb_xcc_id() { return (unsigned)__builtin_amdgcn_s_getreg((3 << 11) | 20) & 0xFu; }
#define XB_SPIN(cond, bar) do { unsigned _sp = 0; while (cond) { __builtin_amdgcn_s_sleep(1); \
    if ((++_sp & 255u) == 0u) { if (xb_ld(&(bar)[XB_TMO])) break; if (_sp > XB_SPIN_CAP) { atomicAdd(&(bar)[XB_TMO], 1u); break; } } } } while (0)

struct XcdBarrier {
    unsigned* bar; unsigned x;
    volatile LAS unsigned* st;
};

__device__ __forceinline__ XcdBarrier xcd_barrier_post(unsigned* bar, volatile LAS unsigned* st) {
    XcdBarrier b; b.bar = bar; b.x = xb_xcc_id(); b.st = st;
    if (threadIdx.x == 0) (void)xb_add(&bar[XB_XCNT(b.x)], 1u);
    return b;
}
__device__ __forceinline__ void xcd_barrier_complete(unsigned* bar, unsigned x, unsigned& nloc, unsigned& nx) {
    const unsigned G = gridDim.x * gridDim.y * gridDim.z;
    unsigned sum, cnt, mine, sp = 0u;
    for (;;) {
        sum = 0u; cnt = 0u; mine = 0u;
#pragma unroll
        for (unsigned j = 0; j < 16; ++j) { const unsigned c = xb_ld(&bar[XB_XCNT(j)]); sum += c; cnt += (c > 0u) ? 1u : 0u; mine = (j == x) ? c : mine; }
        if (sum == G) break;
        __builtin_amdgcn_s_sleep(1);
        if ((++sp & 255u) == 0u) { if (xb_ld(&bar[XB_TMO])) break; if (sp > XB_SPIN_CAP) { atomicAdd(&bar[XB_TMO], 1u); break; } }
    }
    nloc = mine > 0u ? mine : 1u; nx = cnt > 0u ? cnt : 1u;
}

__device__ __forceinline__ void xcd_barrier(const XcdBarrier& b) {
    asm volatile("s_waitcnt vmcnt(0)" ::: "memory");
    __syncthreads();
    if (threadIdx.x == 0) {
        unsigned* bar = b.bar;
        __builtin_amdgcn_s_waitcnt(0);
        unsigned nloc = b.st[0], nx = b.st[1];
        if (nloc == 0u) { xcd_barrier_complete(bar, b.x, nloc, nx); b.st[0] = nloc; b.st[1] = nx; }
        const unsigned old = xb_add(&bar[XB_XSUB(b.x)], 1u);
        const unsigned gen = old / nloc;
        if (old + 1u == (gen + 1u) * nloc) {
            __builtin_amdgcn_fence(__ATOMIC_RELEASE, "agent");
            asm volatile("s_waitcnt vmcnt(0)" ::: "memory");
            const unsigned og = xb_add(&bar[XB_TOP], 1u);
            const unsigned tg = og / nx;
            if (og + 1u == (tg + 1u) * nx) xb_add(&bar[XB_TOPGEN], 1u);
            else XB_SPIN(xb_ld(&bar[XB_TOPGEN]) == tg, bar);
            __builtin_amdgcn_fence(__ATOMIC_ACQUIRE, "agent");
            xb_add(&bar[XB_XGEN(b.x)], 1u);
            asm volatile("s_waitcnt vmcnt(0)" ::: "memory");
        } else {
            XB_SPIN(xb_ld(&bar[XB_XGEN(b.x)]) == gen, bar);
            __builtin_amdgcn_fence(__ATOMIC_ACQUIRE, "agent");
            asm volatile("s_waitcnt vmcnt(0)" ::: "memory");
        }
    }
    __syncthreads();
}

constexpr int N_PHASES = 8;
__global__ void __launch_bounds__(NTHR, 2) mk_fwd(Args args) {
    extern __shared__ __attribute__((aligned(16))) unsigned char lds_raw[];
    LAS unsigned char* lds = (LAS unsigned char*)lds_raw;
    const int tid = threadIdx.x, lane = tid & 63, wave = __builtin_amdgcn_readfirstlane(tid >> 6);
    const int lo = args.ph_lo, hi = args.ph_hi;
    unsigned char* ws = args.ws;
    bf16* WIN = (bf16*)(ws + WS_WIN); bf16* WOUT = (bf16*)(ws + WS_WOUT); bf16* WUP = (bf16*)(ws + WS_WUP); bf16* WDN = (bf16*)(ws + WS_WDN);
    bf16* XN = (bf16*)(ws + WS_XN); bf16* PROJ = (bf16*)(ws + WS_PROJ); bf16* CAT = (bf16*)(ws + WS_CAT); bf16* Y = (bf16*)(ws + WS_Y); bf16* ACT = (bf16*)(ws + WS_ACT);
    float* SSQ = (float*)(ws + WS_SSQ);
#define IN(k) (lo <= (k) && (k) < hi)
#define SEAM(k) do { if (IN(k) && IN((k) + 1)) { xcd_barrier(bar); } } while (0)
    { volatile LAS unsigned* st = (volatile LAS unsigned*)(lds + LDS_BYTES - 64); if (tid < 2) st[tid] = 0u; }
    __syncthreads();
    XcdBarrier bar = xcd_barrier_post((unsigned*)(ws + WS_CTL) + 4096, (volatile LAS unsigned*)(lds + LDS_BYTES - 64));
    if (args.coop > 1) cg::this_grid().sync();
    if (IN(0)) { p0_prologue(args, lds, tid, lane, wave); } SEAM(0);
    if (IN(1)) { pg8::Gemm g{XN, WIN, M, NP, DM}; pg8::StaticOrder S; S.init(M, NP, gridDim.x, blockIdx.x); pg8::EpiBf16S E{PROJ, NP, nullptr};
        pg8::gemm_phase<pg8::EpiBf16S, pg8::StaticOrder, PG8_ALIGN, PG8_SP2>(lds, g, S, E);
        { pg8::Unit u4; const bool idle4 = !S.next(3, u4); const int G = gridDim.x, nidle = (G == 256) ? 128 : G;
          if (G != 256) convert_late_weights(args, lds, lane, wave, blockIdx.x * NWAVES + wave, G * NWAVES);
          else if (idle4) convert_late_weights(args, lds, lane, wave, (blockIdx.x - 128) * NWAVES + wave, nidle * NWAVES); } } SEAM(1);
    if (IN(2)) { gdn_prep(args, lds, tid, lane, wave); } SEAM(2);
    if (IN(3)) { if (blockIdx.x < NB * GH) gdn_scan(args, lds, blockIdx.x, tid, lane, wave); attn_fast(args, lds, lane, wave); xcd_barrier(bar); gated_norm(args, lane, wave); } SEAM(3);
    if (IN(4)) { pg8::Gemm g{CAT, WOUT, M, DM, DM}; pg8::StaticOrder S; S.init(M, DM, gridDim.x, blockIdx.x); pg8::EpiResid E{args.in[0], args.out, XN, SSQ, DM};
        pg8::gemm_phase<pg8::EpiResid, pg8::StaticOrder, PG8_ALIGN, PG8_SP2>(lds, g, S, E); } SEAM(4);
    if (IN(5)) { pg8::Gemm g{XN, WUP, M, NUP, DM}; pg8::StaticOrder S; S.init(M, NUP, gridDim.x, blockIdx.x);
        static_assert(pg8::EpiConvGate::CG_SSQ == WS_SSQ && pg8::EpiConvGate::CG_ACT == WS_ACT && pg8::EpiConvGate::CG_YH == WS_YH && pg8::EpiConvGate::CG_UPART == WS_UPART, "d_ws map");
        pg8::EpiConvGate E{ws, args.in[10], lds};
        pg8::gemm_phase<pg8::EpiConvGate, pg8::StaticOrder, true, PG8_SP2>(lds, g, S, E); } SEAM(5);
    if (IN(6)) { ffn_fixup(args, tid); } SEAM(6);
    if (IN(7)) { pg8::Gemm g{ACT, WDN, M, DM, DFF}; pg8::StaticOrder S; S.init(M, DM, gridDim.x, blockIdx.x);
        if (gridDim.x == 256) {
            pg8::EpiResidNorm E{args.out, args.out, (float*)(ws + WS_SSQ2), (unsigned*)(ws + WS_CTL) + 2048, args.in[12], DM};
            pg8::gemm_phase<pg8::EpiResidNorm, pg8::StaticOrder, true, PG8_SP2>(lds, g, S, E);
        } else {
            pg8::EpiResid E{args.out, args.out, nullptr, nullptr, DM};
            pg8::gemm_phase<pg8::EpiResid, pg8::StaticOrder, PG8_ALIGN, PG8_SP2>(lds, g, S, E);
            xcd_barrier(bar); final_norm(args, lane, wave);
        } }
#undef IN
#undef SEAM
}

#ifndef MK_ONE_LAUNCH
#define MK_ONE_LAUNCH 1
#endif
extern "C" void kernel_launch(void* const* d_in, const int* in_sizes, int n_in, void* d_out, int out_size, void* d_ws, size_t ws_size, hipStream_t stream) {
    static int grid = 0;
    if (grid == 0) {
        if (n_in != 13 || out_size != M * DM || ws_size < WS_END) { fprintf(stderr, "kernel_launch: unexpected shapes n_in %d out %d ws %zu\n", n_in, out_size, ws_size); grid = -1; return; }
        int dev = 0, cus = 0, per_cu = 0;
        hipGetDevice(&dev); hipDeviceGetAttribute(&cus, hipDeviceAttributeMultiprocessorCount, dev);
        hipFuncSetAttribute((const void*)mk_fwd, hipFuncAttributeMaxDynamicSharedMemorySize, LDS_BYTES);
        hipOccupancyMaxActiveBlocksPerMultiprocessor(&per_cu, (const void*)mk_fwd, NTHR, LDS_BYTES);
        (void)hipGetLastError();
        if (per_cu < 1) { fprintf(stderr, "kernel_launch: occupancy query says %d blocks per CU\n", per_cu); per_cu = 1; }
        grid = cus;
    }
    if (grid < 0) return;
    if (hipMemsetAsync((char*)d_ws + WS_CTL, 0, 65536, stream) != hipSuccess) { fprintf(stderr, "kernel_launch: memset failed\n"); return; }
    Args a{};
    for (int i = 0; i < 13; ++i) a.in[i] = (const float*)d_in[i];
    a.out = (float*)d_out; a.ws = (unsigned char*)d_ws;
#if MK_ONE_LAUNCH
    a.ph_lo = 0; a.ph_hi = N_PHASES; a.coop = 1;
    void* kargs[] = {&a};
    hipError_t e = hipLaunchCooperativeKernel((const void*)mk_fwd, dim3(grid), dim3(NTHR), kargs, LDS_BYTES, stream);
    if (e != hipSuccess) fprintf(stderr, "cooperative launch failed: %s (grid %d)\n", hipGetErrorString(e), grid);
#else
    for (int p = 0; p < N_PHASES; ++p) { a.ph_lo = p; a.ph_hi = p + 1; a.coop = 0; hipLaunchKernelGGL(mk_fwd, dim3(grid), dim3(NTHR), LDS_BYTES, stream, a); }
#endif
}
```

```cpp
#include <hip/hip_runtime.h>
#include <hip/hip_cooperative_groups.h>
#include <cstdio>
#include <cstdint>
namespace cg = cooperative_groups;
namespace pg8 {
#define PG8_LAS __attribute__((address_space(3)))
typedef unsigned short bf16_t;
typedef short bf16x8 __attribute__((ext_vector_type(8)));
typedef float f32x4 __attribute__((ext_vector_type(4)));
typedef unsigned u32x4 __attribute__((ext_vector_type(4)));
constexpr int BM = 256, BK = 64, HALF = 128, HTB = HALF * BK * 2  , STAGE_BYTES = 8 * HTB, NXCD = 8, WGM = 8;

__host__ __device__ __forceinline__ int lds_byte(int r, int c) { const int st = (r >> 4) * 2 + (c >> 5), rr = r & 15, cc = c & 31, ob = rr * 64 + cc * 2; return st * 1024 + (ob ^ (((ob >> 9) & 1) << 5)); }
__host__ __device__ __forceinline__ void stage_rc(int b, int& R, int& C) { const int st = b / 1024, sb = b % 1024, swz = sb ^ (((sb >> 9) & 1) << 5); R = (st >> 1) * 16 + swz / 64; C = (st & 1) * 32 + (swz % 64) / 2; }
__host__ __device__ __forceinline__ int perm32(int rho) { const int n = rho >> 4, i = rho & 15; return 8 * (i >> 2) + 4 * n + (i & 3); }

struct Unit { int pm, pn; };
struct Gemm { const bf16_t* A; const bf16_t* Bt; int M, N, K; };

struct StaticOrder {
    int nM, nN, nwg, G, c;
    __host__ __device__ void init(int M, int N, int G_, int c_) { nM = M / BM; nN = N / BM; nwg = nM * nN; G = G_; c = c_; }
    __host__ __device__ bool next(int i, Unit& u) const {
        const long L = (long)i * G + c; if (L >= nwg) return false;
        int wgid = (int)L; { const int q = nwg / NXCD, r = nwg % NXCD, xcd = wgid % NXCD, off = wgid / NXCD; wgid = (xcd < r ? xcd * (q + 1) : r * (q + 1) + (xcd - r) * q) + off; }
        const int nig = WGM * nN, gid = wgid / nig, fm = gid * WGM, gsz = (nM - fm) < WGM ? (nM - fm) : WGM;
        u.pm = fm + ((wgid % nig) % gsz); u.pn = (wgid % nig) / gsz; return true;
    }
    __device__ __forceinline__ void a_ready(const Unit&) const {}
    __device__ __forceinline__ void done(const Unit&) const {}
};

__device__ __forceinline__ unsigned cvt_pk_bf16(float lo, float hi) { unsigned r; asm volatile("v_cvt_pk_bf16_f32 %0, %1, %2" : "=v"(r) : "v"(lo), "v"(hi)); return r; }
constexpr float RMS_EPS = 1e-6f;
struct EpiBf16S {
    static constexpr bool PERM = true, AFTER_DRAIN = false;
    bf16_t* O; int ldc; const float* ssq;
    __device__ __forceinline__ void operator()(const f32x4 (&acc)[2][2][4][2], const Unit& u, int wr, int wc, int fr, int fq) const {
        const int row0 = u.pm * BM + wr * 64 + fr; const int col0 = u.pn * BM + wc * 32 + 8 * fq;
#pragma unroll
        for (int ai = 0; ai < 2; ++ai)
#pragma unroll
            for (int m = 0; m < 4; ++m) { const int row = row0 + ai * HALF + m * 16; bf16_t* rowp = O + (size_t)row * ldc + col0;
                const float sc = ssq ? rsqrtf(ssq[row] * (1.0f / 1024.0f) + RMS_EPS) : 1.0f;
#pragma unroll
                for (int bj = 0; bj < 2; ++bj) { const f32x4 v0 = acc[ai][bj][m][0] * sc, v1 = acc[ai][bj][m][1] * sc;
                    u32x4 w; w.x = cvt_pk_bf16(v0[0], v0[1]); w.y = cvt_pk_bf16(v0[2], v0[3]); w.z = cvt_pk_bf16(v1[0], v1[1]); w.w = cvt_pk_bf16(v1[2], v1[3]);
                    *(u32x4*)(rowp + bj * HALF) = w; } }
    }
};
struct EpiResid {
    static constexpr bool PERM = false, AFTER_DRAIN = false;
    const float* base; float* out; bf16_t* xb; float* ssq; int ldc;
    __device__ __forceinline__ void operator()(const f32x4 (&acc)[2][2][4][2], const Unit& u, int wr, int wc, int fr, int fq) const {
        typedef unsigned u32x2v __attribute__((ext_vector_type(2)));
        const int col0 = u.pn * BM + wc * 32 + 4 * fq;
#pragma unroll
        for (int ai = 0; ai < 2; ++ai) {
            f32x4 bv[4][2][2];
#pragma unroll
            for (int m = 0; m < 4; ++m) { const size_t off = (size_t)(u.pm * BM + ai * HALF + wr * 64 + m * 16 + fr) * ldc + col0;
#pragma unroll
                for (int bj = 0; bj < 2; ++bj)
#pragma unroll
                    for (int n = 0; n < 2; ++n) bv[m][bj][n] = *(const f32x4*)(base + off + bj * HALF + n * 16); }
#pragma unroll
            for (int m = 0; m < 4; ++m) { const int row = u.pm * BM + ai * HALF + wr * 64 + m * 16 + fr; const size_t off = (size_t)row * ldc + col0; float s = 0.f;
#pragma unroll
                for (int bj = 0; bj < 2; ++bj)
#pragma unroll
                    for (int n = 0; n < 2; ++n) { const f32x4 v = acc[ai][bj][m][n] + bv[m][bj][n];
                        if (out) *(f32x4*)(out + off + bj * HALF + n * 16) = v; s += (v[0] * v[0] + v[1] * v[1]) + (v[2] * v[2] + v[3] * v[3]);
                        if (xb) { u32x2v w; w.x = cvt_pk_bf16(v[0], v[1]); w.y = cvt_pk_bf16(v[2], v[3]); *(u32x2v*)(xb + off + bj * HALF + n * 16) = w; } }
                if (ssq) { s += __shfl_xor(s, 16); s += __shfl_xor(s, 32); if (fq == 0) atomicAdd(ssq + row, s); } }
            asm volatile("" ::: "memory");
        }
    }
};

__device__ __forceinline__ float dpp_ror1(float v) { return __builtin_bit_cast(float, __builtin_amdgcn_update_dpp(0, __builtin_bit_cast(int, v), 0x121, 0xf, 0xf, false)); }
__device__ __forceinline__ float dpp_ror2(float v) { return __builtin_bit_cast(float, __builtin_amdgcn_update_dpp(0, __builtin_bit_cast(int, v), 0x122, 0xf, 0xf, false)); }
struct EpiConvGate {
    static constexpr bool PERM = true, AFTER_DRAIN = false;
    static constexpr size_t CG_SSQ = (1u << 20) + 768 * 1024, CG_ACT = (size_t)148 << 20, CG_YH = (size_t)236 << 20, CG_UPART = (size_t)240 << 20;
    unsigned char* ws; const float* fw; PG8_LAS unsigned char* ldsb;
    __device__ __forceinline__ void operator()(f32x4 (&acc)[2][2][4][2], const Unit& u, int wr, int wc, int fr0, int fq0) const {
        int fr = fr0, fq = fq0; asm volatile("" : "+v"(fr), "+v"(fq));
        bf16_t* ACT = (bf16_t*)(ws + CG_ACT); const float* ssq = (const float*)(ws + CG_SSQ); float* YH = (float*)(ws + CG_YH); float* UPART = (float*)(ws + CG_UPART);
        PG8_LAS float* halo = (PG8_LAS float*)(ldsb + STAGE_BYTES);
        int cl = wc * 32 + 8 * fq;
        int ch = u.pn * 128 + cl;
        if (fr >= 14) {
#pragma unroll
            for (int ai = 0; ai < 2; ++ai) { const float sc = rsqrtf(ssq[u.pm * BM + ai * HALF + wr * 64 + 48 + fr] * (1.0f / 1024.0f) + RMS_EPS);
#pragma unroll
                for (int bj = 0; bj < 2; ++bj)
#pragma unroll
                    for (int n = 0; n < 2; ++n) { const f32x4 v = acc[ai][bj][3][n] * sc; *(PG8_LAS f32x4*)(halo + (((wr * 2 + ai) * 2 + (fr - 14)) * 256 + bj * 128 + cl + 4 * n)) = v;
                        if (ai == 1 && wr == 1) *(f32x4*)(YH + ((size_t)(u.pm * 22 + u.pn) * 2 + (fr - 14)) * 256 + bj * 128 + cl + 4 * n) = v; } }
        }
        asm volatile("s_waitcnt lgkmcnt(0)" ::: "memory"); __builtin_amdgcn_s_barrier(); asm volatile("" ::: "memory");
        typedef unsigned u32x2v __attribute__((ext_vector_type(2)));
#pragma unroll 1
        for (int n = 0; n < 2; ++n) {
            asm volatile("" : "+v"(fr), "+v"(fq));
            cl = wc * 32 + 8 * fq; ch = u.pn * 128 + cl;
            f32x4 w[3][2];
#pragma unroll
            for (int i = 0; i < 3; ++i)
#pragma unroll
                for (int bj = 0; bj < 2; ++bj) w[i][bj] = *(const f32x4*)(fw + (size_t)i * 5632 + bj * 2816 + ch + 4 * n);
#pragma unroll
            for (int ai = 0; ai < 2; ++ai) {
                const bool top = (ai == 0 && wr == 0);
                const int pblk = (ai == 0) ? 0 : (wr == 0 ? 2 : 1);
                f32x4 q1[2], q2[2];
#pragma unroll
                for (int bj = 0; bj < 2; ++bj) { const f32x4 pv = top ? (f32x4){0.f, 0.f, 0.f, 0.f} : *(const PG8_LAS f32x4*)(halo + ((pblk * 2 + (fr & 1)) * 256 + bj * 128 + cl + 4 * n));
#pragma unroll
                    for (int k = 0; k < 4; ++k) { q1[bj][k] = dpp_ror1(pv[k]); q2[bj][k] = dpp_ror2(pv[k]); } }
#pragma unroll
                for (int m = 0; m < 4; ++m) {
                    const int row = u.pm * BM + ai * HALF + wr * 64 + m * 16 + fr; const float sc = rsqrtf(ssq[row] * (1.0f / 1024.0f) + RMS_EPS);
                    f32x4 cu[2];
#pragma unroll
                    for (int bj = 0; bj < 2; ++bj) { const f32x4 ya = (n == 0) ? acc[ai][bj][m][0] : acc[ai][bj][m][1];
#pragma unroll
                        for (int k = 0; k < 4; ++k) { const float y = ya[k] * sc;
                            const float a1 = dpp_ror1(y), a2 = dpp_ror2(y);
                            const float p1 = (fr == 0) ? q1[bj][k] : a1, p2 = (fr < 2) ? q2[bj][k] : a2;
                            cu[bj][k] = w[2][bj][k] * y + w[1][bj][k] * p1 + w[0][bj][k] * p2; q1[bj][k] = a1; q2[bj][k] = a2; } }
                    if (top && m == 0 && fr < 2 && (u.pm & 7) != 0) {
#pragma unroll
                        for (int bj = 0; bj < 2; ++bj) *(f32x4*)(UPART + ((size_t)(u.pm * 22 + u.pn) * 2 + fr) * 256 + bj * 128 + cl + 4 * n) = cu[bj];
                    }
                    u32x2v o;
#define PG8_SG(k_) (cu[0][k_] * __builtin_amdgcn_rcpf(1.0f + __expf(-cu[0][k_])) * cu[1][k_])
                    o.x = cvt_pk_bf16(PG8_SG(0), PG8_SG(1)); o.y = cvt_pk_bf16(PG8_SG(2), PG8_SG(3));
#undef PG8_SG
                    *(u32x2v*)(ACT + (size_t)row * 2816 + ch + 4 * n) = o;
                    asm volatile("" ::: "memory");
                }
            }
        }
        asm volatile("s_waitcnt lgkmcnt(0)" ::: "memory"); __builtin_amdgcn_s_barrier(); asm volatile("" ::: "memory");
    }
};

struct EpiResidNorm {
    static constexpr bool PERM = false, AFTER_DRAIN = false;
    const bf16_t* base; float* out; float* ssq2; unsigned* cnt; const float* fnw; int ldc;
    __device__ __forceinline__ void operator()(f32x4 (&acc)[2][2][4][2], const Unit& u, int wr, int wc, int fr, int fq) const {
        typedef unsigned u32x2v __attribute__((ext_vector_type(2)));
        const int col0 = u.pn * BM + wc * 32 + 4 * fq;
#pragma unroll
        for (int ai = 0; ai < 2; ++ai) {
            u32x2v bv[4][2][2];
#pragma unroll
            for (int m = 0; m < 4; ++m) { const size_t off = (size_t)(u.pm * BM + ai * HALF + wr * 64 + m * 16 + fr) * ldc + col0;
#pragma unroll
                for (int bj = 0; bj < 2; ++bj)
#pragma unroll
                    for (int n = 0; n < 2; ++n) bv[m][bj][n] = *(const u32x2v*)(base + off + bj * HALF + n * 16); }
#pragma unroll
            for (int m = 0; m < 4; ++m) { const int row = u.pm * BM + ai * HALF + wr * 64 + m * 16 + fr; float s = 0.f;
#pragma unroll
                for (int bj = 0; bj < 2; ++bj)
#pragma unroll
                    for (int n = 0; n < 2; ++n) { const u32x2v bw = bv[m][bj][n]; const f32x4 v = acc[ai][bj][m][n] + (f32x4){__uint_as_float(bw.x << 16), __uint_as_float(bw.x & 0xffff0000u), __uint_as_float(bw.y << 16), __uint_as_float(bw.y & 0xffff0000u)}; acc[ai][bj][m][n] = v; s += (v[0] * v[0] + v[1] * v[1]) + (v[2] * v[2] + v[3] * v[3]); }
                s += __shfl_xor(s, 16); s += __shfl_xor(s, 32);
                if (fq == 0) (void)__hip_atomic_fetch_add(ssq2 + row, s, __ATOMIC_RELAXED, __HIP_MEMORY_SCOPE_AGENT); }
            asm volatile("" ::: "memory");
        }
        asm volatile("s_waitcnt vmcnt(0)" ::: "memory"); __builtin_amdgcn_s_barrier(); asm volatile("" ::: "memory");
        if (wr == 0 && wc == 0 && fr == 0 && fq == 0) {
            __builtin_amdgcn_fence(__ATOMIC_RELEASE, "agent"); asm volatile("s_waitcnt vmcnt(0)" ::: "memory");
            (void)__hip_atomic_fetch_add(cnt + 16 * u.pm, 1u, __ATOMIC_RELAXED, __HIP_MEMORY_SCOPE_AGENT);
            unsigned sp = 0;
            while (__hip_atomic_load(cnt + 16 * u.pm, __ATOMIC_RELAXED, __HIP_MEMORY_SCOPE_AGENT) < 4u) { __builtin_amdgcn_s_sleep(1); if (++sp > (1u << 22)) break; }
            __builtin_amdgcn_fence(__ATOMIC_ACQUIRE, "agent"); asm volatile("s_waitcnt vmcnt(0)" ::: "memory");
        }
        __builtin_amdgcn_s_barrier(); asm volatile("" ::: "memory");
        f32x4 nw[2][2];
#pragma unroll
        for (int bj = 0; bj < 2; ++bj)
#pragma unroll
            for (int n = 0; n < 2; ++n) nw[bj][n] = *(const f32x4*)(fnw + col0 + bj * HALF + n * 16);
#pragma unroll
        for (int ai = 0; ai < 2; ++ai)
#pragma unroll
            for (int m = 0; m < 4; ++m) { const int row = u.pm * BM + ai * HALF + wr * 64 + m * 16 + fr; const size_t off = (size_t)row * ldc + col0;
                const float rstd = rsqrtf(__hip_atomic_load(ssq2 + row, __ATOMIC_RELAXED, __HIP_MEMORY_SCOPE_AGENT) * (1.0f / 1024.0f) + RMS_EPS);
#pragma unroll
                for (int bj = 0; bj < 2; ++bj)
#pragma unroll
                    for (int n = 0; n < 2; ++n) { const f32x4 v = acc[ai][bj][m][n]; *(f32x4*)(out + off + bj * HALF + n * 16) = (f32x4){v[0] * rstd * nw[bj][n][0], v[1] * rstd * nw[bj][n][1], v[2] * rstd * nw[bj][n][2], v[3] * rstd * nw[bj][n][3]}; } }
    }
};
template <class Epi, class Sched, bool ALIGN_EPI = false, bool SP2 = false>
__device__ __forceinline__ void gemm_phase(PG8_LAS unsigned char* lds, const Gemm g, const Sched& S, const Epi& E) {
    const int tid = threadIdx.x, wid = __builtin_amdgcn_readfirstlane(tid >> 6), lane = tid & 63, wr = wid >> 2, wc = wid & 3, fr = lane & 15, fq = lane >> 4;
    const int K = g.K, nt = K / BK;
    unsigned voffA[2], voffB[2];
#pragma unroll
    for (int i = 0; i < 2; ++i) { int R, C; stage_rc(tid * 16 + i * 8192, R, C); const int Rb = Epi::PERM ? ((R & ~31) + perm32(R & 31)) : R;
        voffA[i] = (unsigned)(R * K + C) * 2u; voffB[i] = (unsigned)(Rb * K + C) * 2u; }
    const size_t kstep = (size_t)(BK * 2);
    const size_t hstep = (size_t)HALF * K * 2;
    const size_t tstep = 2 * hstep;
    const unsigned ldsw = (unsigned)wid * 1024u;
    const int aoff = lds_byte(wr * 64 + fr, fq * 8), boff = lds_byte(wc * 32 + fr, fq * 8);
#define PG8_SA(b, h) (((b) * 2 + (h)) * HTB)
#define PG8_SB(b, h) ((4 + (b) * 2 + (h)) * HTB)
#define PG8_STAGE(bufoff, gbase, voff) do { _Pragma("unroll") for (int _i = 0; _i < 2; ++_i) \
        __builtin_amdgcn_global_load_lds((const unsigned*)((const char*)(gbase) + (voff)[_i]), (PG8_LAS unsigned*)(lds + (bufoff) + ldsw + _i * 8192), 16, 0, 0); } while (0)
#define PG8_LDA(dst, b, h) do { _Pragma("unroll") for (int m = 0; m < 4; ++m) _Pragma("unroll") for (int k = 0; k < 2; ++k) dst[m][k] = *(const PG8_LAS bf16x8*)(lds + PG8_SA(b, h) + aoff + m * 2048 + k * 1024); } while (0)
#define PG8_LDB(dst, b, h) do { _Pragma("unroll") for (int n = 0; n < 2; ++n) _Pragma("unroll") for (int k = 0; k < 2; ++k) dst[n][k] = *(const PG8_LAS bf16x8*)(lds + PG8_SB(b, h) + boff + n * 2048 + k * 1024); } while (0)
#define PG8_MMA(ai, bj, At, Bt) do { __builtin_amdgcn_s_setprio(1); _Pragma("unroll") for (int m = 0; m < 4; ++m) _Pragma("unroll") for (int n = 0; n < 2; ++n) _Pragma("unroll") for (int k = 0; k < 2; ++k) \
        acc[ai][bj][m][n] = __builtin_amdgcn_mfma_f32_16x16x32_bf16(Bt[n][k], At[m][k], acc[ai][bj][m][n], 0, 0, 0); __builtin_amdgcn_s_setprio(0); } while (0)
#define PG8_WAIT_V(n) asm volatile("s_waitcnt vmcnt(" #n ")" ::: "memory")
#define PG8_WAIT_L(n) asm volatile("s_waitcnt lgkmcnt(" #n ")" ::: "memory")
#define PG8_BAR __builtin_amdgcn_s_barrier()
#define PG8_SCHED __builtin_amdgcn_sched_barrier(0)
    Unit cur, nxt; int ui = 0;
    if (!S.next(0, cur)) return;
    f32x4 acc[2][2][4][2];
#pragma unroll
    for (int a = 0; a < 2; ++a)
#pragma unroll
        for (int b = 0; b < 2; ++b)
#pragma unroll
            for (int m = 0; m < 4; ++m)
#pragma unroll
                for (int n = 0; n < 2; ++n) acc[a][b][m][n] = (f32x4){0.f, 0.f, 0.f, 0.f};
    bf16x8 At[4][2], B0[2][2], B1[2][2];
    const char* cA = (const char*)g.A + (size_t)cur.pm * tstep; const char* cB = (const char*)g.Bt + (size_t)cur.pn * tstep;
    S.a_ready(cur);
    if constexpr (SP2) {
        PG8_STAGE(PG8_SB(0, 0), cB, voffB); PG8_STAGE(PG8_SB(0, 1), cB + hstep, voffB); PG8_STAGE(PG8_SA(0, 0), cA, voffA); PG8_STAGE(PG8_SA(0, 1), cA + hstep, voffA);
        if (wr == 1) PG8_BAR;
        PG8_WAIT_V(2); PG8_BAR;
        PG8_STAGE(PG8_SB(1, 0), cB + kstep, voffB); PG8_STAGE(PG8_SA(1, 0), cA + kstep, voffA); PG8_STAGE(PG8_SB(1, 1), cB + hstep + kstep, voffB);
        PG8_WAIT_V(6); PG8_BAR;
    } else {
        PG8_STAGE(PG8_SB(0, 0), cB, voffB); PG8_STAGE(PG8_SA(0, 0), cA, voffA); PG8_STAGE(PG8_SB(0, 1), cB + hstep, voffB); PG8_STAGE(PG8_SA(0, 1), cA + hstep, voffA);
        if (wr == 1) PG8_BAR;
        PG8_WAIT_V(4); PG8_BAR;
        PG8_STAGE(PG8_SB(1, 0), cB + kstep, voffB); PG8_STAGE(PG8_SA(1, 0), cA + kstep, voffA); PG8_STAGE(PG8_SB(1, 1), cB + hstep + kstep, voffB);
        PG8_WAIT_V(6); PG8_BAR;
    }
    for (;;) {
        const bool has_next = S.next(ui + 1, nxt);
        const char* nA = has_next ? (const char*)g.A + (size_t)nxt.pm * tstep : cA; const char* nB = has_next ? (const char*)g.Bt + (size_t)nxt.pn * tstep : cB;
        for (int t = 0; t < nt; t += 2) {
            const bool last = (t == nt - 2);
            const char* a1 = cA + (size_t)(t + 1) * kstep;
            const char* a2 = last ? nA : cA + (size_t)(t + 2) * kstep; const char* b2 = last ? nB : cB + (size_t)(t + 2) * kstep;
            const char* a3 = a2 + kstep; const char* b3 = b2 + kstep;
            if (last && has_next) S.a_ready(nxt);
            if constexpr (SP2) {
            PG8_LDB(B0, 0, 0); PG8_LDB(B1, 0, 1); PG8_SCHED; PG8_LDA(At, 0, 0); PG8_STAGE(PG8_SA(1, 1), a1 + hstep, voffA);
            PG8_WAIT_V(8); PG8_WAIT_L(0); PG8_BAR; PG8_MMA(0, 0, At, B0); PG8_MMA(0, 1, At, B1); PG8_BAR; PG8_SCHED;
            PG8_LDA(At, 0, 1); PG8_STAGE(PG8_SB(0, 0), b2, voffB); PG8_STAGE(PG8_SB(0, 1), b2 + hstep, voffB); PG8_STAGE(PG8_SA(0, 0), a2, voffA);
            PG8_WAIT_V(8); PG8_WAIT_L(0); PG8_BAR; PG8_MMA(1, 0, At, B0); PG8_MMA(1, 1, At, B1); PG8_BAR; PG8_SCHED;
            PG8_LDB(B0, 1, 0); PG8_LDB(B1, 1, 1); PG8_SCHED; PG8_LDA(At, 1, 0); PG8_STAGE(PG8_SA(0, 1), a2 + hstep, voffA);
            PG8_WAIT_V(8); PG8_WAIT_L(0); PG8_BAR; PG8_MMA(0, 0, At, B0); PG8_MMA(0, 1, At, B1); PG8_BAR; PG8_SCHED;
            PG8_LDA(At, 1, 1); PG8_STAGE(PG8_SB(1, 0), b3, voffB); PG8_STAGE(PG8_SB(1, 1), b3 + hstep, voffB); PG8_STAGE(PG8_SA(1, 0), a3, voffA);
            PG8_WAIT_V(8); PG8_WAIT_L(0); PG8_BAR; PG8_MMA(1, 0, At, B0); PG8_MMA(1, 1, At, B1); PG8_BAR; PG8_SCHED;
            } else {
            PG8_LDB(B0, 0, 0); PG8_SCHED; PG8_LDA(At, 0, 0); PG8_STAGE(PG8_SA(1, 1), a1 + hstep, voffA);
            PG8_WAIT_L(8); PG8_BAR; PG8_WAIT_L(0); PG8_MMA(0, 0, At, B0); PG8_BAR; PG8_SCHED;
            PG8_LDB(B1, 0, 1); PG8_STAGE(PG8_SB(0, 0), b2, voffB);
            PG8_BAR; PG8_WAIT_L(0); PG8_MMA(0, 1, At, B1); PG8_BAR;
            PG8_LDA(At, 0, 1); PG8_STAGE(PG8_SA(0, 0), a2, voffA);
            PG8_BAR; PG8_WAIT_L(0); PG8_MMA(1, 0, At, B0); PG8_BAR; PG8_SCHED;
            PG8_STAGE(PG8_SB(0, 1), b2 + hstep, voffB);
            PG8_WAIT_V(6); PG8_BAR; PG8_MMA(1, 1, At, B1); PG8_BAR;
            PG8_LDB(B0, 1, 0); PG8_SCHED; PG8_LDA(At, 1, 0); PG8_STAGE(PG8_SA(0, 1), a2 + hstep, voffA);
            PG8_WAIT_L(8); PG8_BAR; PG8_WAIT_L(0); PG8_MMA(0, 0, At, B0); PG8_BAR; PG8_SCHED;
            PG8_LDB(B1, 1, 1); PG8_STAGE(PG8_SB(1, 0), b3, voffB);
            PG8_BAR; PG8_WAIT_L(0); PG8_MMA(0, 1, At, B1); PG8_BAR;
            PG8_LDA(At, 1, 1); PG8_STAGE(PG8_SA(1, 0), a3, voffA);
            PG8_BAR; PG8_WAIT_L(0); PG8_MMA(1, 0, At, B0); PG8_BAR; PG8_SCHED;
            PG8_STAGE(PG8_SB(1, 1), b3 + hstep, voffB);
            PG8_WAIT_V(6); PG8_BAR; PG8_MMA(1, 1, At, B1); PG8_BAR;
            }
        }
        if constexpr (ALIGN_EPI) { if (wr == 0) PG8_BAR; }
        if constexpr (!Epi::AFTER_DRAIN) { E(acc, cur, wr, wc, fr, fq); S.done(cur); }
        if (!has_next) break;
#pragma unroll
        for (int a = 0; a < 2; ++a)
#pragma unroll
            for (int b = 0; b < 2; ++b)
#pragma unroll
                for (int m = 0; m < 4; ++m)
#pragma unroll
                    for (int n = 0; n < 2; ++n) acc[a][b][m][n] = (f32x4){0.f, 0.f, 0.f, 0.f};
        cur = nxt; cA = nA; cB = nB; ++ui;
        if constexpr (ALIGN_EPI) { if (wr == 1) PG8_BAR; }
    }
    PG8_WAIT_V(0);
    if constexpr (!ALIGN_EPI) { if (wr == 0) PG8_BAR; }
    PG8_BAR;
    if constexpr (Epi::AFTER_DRAIN) { E.fused(acc, cur, wr, wc, fr, fq, lds, wid, lane); S.done(cur); }
#undef PG8_SA
#undef PG8_SB
#undef PG8_STAGE
#undef PG8_LDA
#undef PG8_LDB
#undef PG8_MMA
#undef PG8_WAIT_V
#undef PG8_WAIT_L
#undef PG8_BAR
#undef PG8_SCHED
}
}
#ifndef PG8_SP2
#define PG8_SP2 true
#endif
#ifndef PG8_ALIGN
#define PG8_ALIGN true
#endif
constexpr int NB = 8, SEQ = 2048, DM = 1024, M = NB * SEQ;
constexpr int GH = 4, GD = 128, GW = 512, AH = 8, AD = 64;
constexpr int INC = 3592, NP = 3584;
constexpr int DFF = 2816, NUP = 2 * DFF;
constexpr int PC_QA = 0, PC_KA = 512, PC_VA = 1024, PC_Z = 1536, PC_QB = 2048, PC_KB = 2560, PC_VB = 3072;
constexpr size_t MiB = 1u << 20;
constexpr size_t WS_CTL = 0, WS_AB = 1 * MiB, WS_SSQ = 1 * MiB + 768 * 1024, WS_WIN = 2 * MiB, WS_WOUT = 9 * MiB, WS_WUP = 11 * MiB, WS_WDN = 22 * MiB;
constexpr size_t WS_XN = 28 * MiB, WS_PROJ = 60 * MiB, WS_CAT = 172 * MiB, WS_OA = 204 * MiB, WS_Y = 60 * MiB, WS_ACT = 148 * MiB, WS_END = 256 * MiB;
using pg8::RMS_EPS;
constexpr size_t WS_YH = 236 * MiB, WS_UPART = 240 * MiB;
constexpr size_t WS_SSQ2 = WS_SSQ + 131072;
constexpr size_t WS_GE = WS_SSQ + 65536;
constexpr int GOPS_CHUNK = 57344;
constexpr int SCAN_BUF = GOPS_CHUNK + 16384;
constexpr int NWAVES = 8, NTHR = 512;
constexpr int LDS_BYTES = 155648;
#define LAS __attribute__((address_space(3)))
typedef unsigned short bf16;
typedef unsigned v4u __attribute__((ext_vector_type(4)));
typedef unsigned v2u __attribute__((ext_vector_type(2)));
typedef float f32x4 __attribute__((ext_vector_type(4)));
__device__ __forceinline__ float bf2f(unsigned b) { return __uint_as_float(b << 16); }
__device__ __forceinline__ float bflo(unsigned w) { return __uint_as_float(w << 16); }
__device__ __forceinline__ float bfhi(unsigned w) { return __uint_as_float(w & 0xffff0000u); }
__device__ __forceinline__ unsigned pk2(float lo, float hi) { return pg8::cvt_pk_bf16(lo, hi); }
__device__ __forceinline__ float wave_sum(float v) {
#pragma unroll
    for (int o = 1; o < 64; o <<= 1) v += __shfl_xor(v, o);
    return v;
}
__device__ __forceinline__ float silu_f(float x) { return x * __builtin_amdgcn_rcpf(1.0f + __expf(-x)); }
__device__ __forceinline__ float sigmoid_f(float x) { return __builtin_amdgcn_rcpf(1.0f + __expf(-x)); }
__device__ __forceinline__ float softplus_f(float x) { return x > 20.f ? x : log1pf(__expf(x)); }

struct Args { const float* in[13]; float* out; unsigned char* ws; int ph_lo, ph_hi, coop, pad; };

__device__ __forceinline__ void p0_transpose_item(const float* W, int ldw, int k0, int sn0, bf16* WT, int K, int dn0, const float* kscale, LAS float* scr, int lane) {
    float tv[32];
#pragma unroll
    for (int i = 0; i < 32; ++i) { const int kk = 2 * i + (lane >> 5); tv[i] = W[(size_t)(k0 + kk) * ldw + sn0 + (lane & 31)]; }
    if (kscale) {
#pragma unroll
        for (int i = 0; i < 32; ++i) tv[i] *= kscale[k0 + 2 * i + (lane >> 5)]; }
#pragma unroll
    for (int i = 0; i < 32; ++i) scr[(2 * i + (lane >> 5)) * 33 + (lane & 31)] = tv[i];
    asm volatile("s_waitcnt lgkmcnt(0)" ::: "memory");
    const int c = lane & 7;
#pragma unroll
    for (int j = 0; j < 4; ++j) { const int n = (lane >> 3) + 8 * j; const LAS float* s = scr + (8 * c) * 33 + n;
        v4u o; o.x = pk2(s[0 * 33], s[1 * 33]); o.y = pk2(s[2 * 33], s[3 * 33]); o.z = pk2(s[4 * 33], s[5 * 33]); o.w = pk2(s[6 * 33], s[7 * 33]);
        *(v4u*)(WT + (size_t)(dn0 + n) * K + k0 + 8 * c) = o; }
    asm volatile("s_waitcnt lgkmcnt(0)" ::: "memory");
}

__device__ __forceinline__ void p0_prologue(const Args& A, LAS unsigned char* lds, int tid, int lane, int wave) {
    const float* x = A.in[0]; const float* nw1 = A.in[1]; const float* w_in = A.in[2]; const float* w_out = A.in[7]; const float* nw2 = A.in[8];
    const float* w_up = A.in[9]; const float* w_dn = A.in[11];
    unsigned char* ws = A.ws;
    bf16* WIN = (bf16*)(ws + WS_WIN); bf16* WOUT = (bf16*)(ws + WS_WOUT); bf16* WUP = (bf16*)(ws + WS_WUP); bf16* WDN = (bf16*)(ws + WS_WDN);
    bf16* XN = (bf16*)(ws + WS_XN); float* AB = (float*)(ws + WS_AB); float* SSQ = (float*)(ws + WS_SSQ);
    LAS float* scr = (LAS float*)(lds + wave * 9216);
    LAS float* wab = (LAS float*)(lds + 73728);
    const int G = gridDim.x, gw = blockIdx.x * NWAVES + wave, NGW = G * NWAVES;
    for (int i = blockIdx.x * NTHR + tid; i < M; i += G * NTHR) { SSQ[i] = 0.f; ((float*)(ws + WS_SSQ2))[i] = 0.f; }
    if (blockIdx.x == 0 && tid < 64) ((unsigned*)(ws + WS_CTL))[tid] = 0u;
    for (int idx = tid; idx < 8192; idx += NTHR) { const int k = idx >> 3, j = idx & 7; wab[j * 1024 + k] = nw1[k] * w_in[(size_t)k * INC + 2048 + j]; }
    constexpr int I_IN = 16 * (NP / 32);
    for (int it = gw; it < I_IN; it += NGW) { const int nblk = NP / 32, kb = it / nblk, nb = it % nblk, n0 = 32 * nb; p0_transpose_item(w_in, INC, 64 * kb, n0 + (n0 >= 2048 ? 8 : 0), WIN, DM, n0, nullptr, scr, lane); }
    __syncthreads();
    for (int m0 = gw; m0 < M; m0 += 2 * NGW) {
        const f32x4* nr = (const f32x4*)nw1 + lane;
        f32x4 v[2][4]; float s[2] = {0.f, 0.f};
#pragma unroll
        for (int rr = 0; rr < 2; ++rr) { const int m = min(m0 + rr * NGW, M - 1); const f32x4* xr = (const f32x4*)(x + (size_t)m * DM) + lane;
#pragma unroll
            for (int j = 0; j < 4; ++j) v[rr][j] = xr[64 * j]; }
#pragma unroll
        for (int rr = 0; rr < 2; ++rr)
#pragma unroll
            for (int j = 0; j < 4; ++j) s[rr] += (v[rr][j].x * v[rr][j].x + v[rr][j].y * v[rr][j].y) + (v[rr][j].z * v[rr][j].z + v[rr][j].w * v[rr][j].w);
#pragma unroll
        for (int rr = 0; rr < 2; ++rr) { const int m = m0 + rr * NGW; if (m >= M) break;
            const float rstd = rsqrtf(wave_sum(s[rr]) * (1.f / DM) + RMS_EPS);
            float ab[8];
#pragma unroll
            for (int q = 0; q < 8; ++q) { float a = 0.f;
#pragma unroll
                for (int j = 0; j < 4; ++j) { const f32x4 w = *(const LAS f32x4*)(wab + q * 1024 + 256 * j + 4 * lane); a += (v[rr][j].x * w.x + v[rr][j].y * w.y) + (v[rr][j].z * w.z + v[rr][j].w * w.w); }
                ab[q] = wave_sum(a) * rstd; }
            if (lane == 0) { *(f32x4*)(AB + (size_t)m * 8) = (f32x4){ab[0], ab[1], ab[2], ab[3]}; *(f32x4*)(AB + (size_t)m * 8 + 4) = (f32x4){ab[4], ab[5], ab[6], ab[7]}; }
            v2u* o8 = (v2u*)(XN + (size_t)m * DM) + lane;
#pragma unroll
            for (int j = 0; j < 4; ++j) { const f32x4 n = nr[64 * j]; v2u o; o.x = pk2(v[rr][j].x * rstd * n.x, v[rr][j].y * rstd * n.y); o.y = pk2(v[rr][j].z * rstd * n.z, v[rr][j].w * rstd * n.w); o8[64 * j] = o; }
        }
    }
}


__device__ __forceinline__ void convert_late_weights(const Args& A, LAS unsigned char* lds, int lane, int wave, int gw0, int ngw) {
    const float* w_out = A.in[7]; const float* nw2 = A.in[8]; const float* w_up = A.in[9]; const float* w_dn = A.in[11];
    bf16* WOUT = (bf16*)(A.ws + WS_WOUT); bf16* WUP = (bf16*)(A.ws + WS_WUP); bf16* WDN = (bf16*)(A.ws + WS_WDN);
    LAS float* scr = (LAS float*)(lds + wave * 9216);
    constexpr int I_OUT = 16 * 32, I_UP = 16 * (NUP / 32), I_DN = (DFF / 64) * 32;
    for (int it = gw0; it < I_OUT + I_UP + I_DN; it += ngw) {
        int r = it;
        if (r < I_OUT) { const int kb = r / 32, nb = r % 32; p0_transpose_item(w_out, DM, 64 * kb, 32 * nb, WOUT, DM, 32 * nb, nullptr, scr, lane); continue; } r -= I_OUT;
        if (r < I_UP) { const int nblk = NUP / 32, kb = r / nblk, nb = r % nblk, n0 = 32 * nb, pn = n0 >> 8, j0 = n0 & 255;
            const int s0 = (j0 < 128) ? (128 * pn + j0) : (DFF + 128 * pn + j0 - 128);
            p0_transpose_item(w_up, NUP, 64 * kb, s0, WUP, DM, n0, nw2, scr, lane); continue; } r -= I_UP;
        { const int kb = r / 32, nb = r % 32; p0_transpose_item(w_dn, DM, 64 * kb, 32 * nb, WDN, DFF, 32 * nb, nullptr, scr, lane); }
    }
}
__device__ __forceinline__ void gdn_simple(const Args& A, LAS unsigned char* lds, int tid, int lane, int wave) {
    const bf16* PROJ = (const bf16*)(A.ws + WS_PROJ); const float* AB = (const float*)(A.ws + WS_AB); float* OA = (float*)(A.ws + WS_OA);
    const float* cw = A.in[3]; const float* a_log = A.in[4]; const float* dt_bias = A.in[5];
    LAS float* qs = (LAS float*)lds; LAS float* ks = qs + 16 * 128; LAS float* vs = ks + 16 * 128; LAS float* av = vs + 16 * 128; LAS float* bv = av + 16;
    for (int task = blockIdx.x; task < NB * GH; task += gridDim.x) {
        const int b = task / GH, h = task % GH, v = tid >> 2, part = tid & 3;
        float S[32];
#pragma unroll
        for (int i = 0; i < 32; ++i) S[i] = 0.f;
        const float Ah = __expf(a_log[h]), dtb = dt_bias[h];
        for (int blk = 0; blk < SEQ / 16; ++blk) {
            const int t0 = blk * 16;
            for (int idx = tid; idx < 16 * 384; idx += NTHR) {
                const int tt = idx / 384, c = idx % 384, which = c >> 7, d = c & 127, col = which * 512 + h * 128 + d, t = t0 + tt;
                float acc = 0.f;
#pragma unroll
                for (int i = 0; i < 4; ++i) { const int ts = t - 3 + i; if (ts >= 0) acc += cw[i * 1536 + col] * bf2f(PROJ[(size_t)(b * SEQ + ts) * NP + col]); }
                qs[which * 2048 + tt * 128 + d] = silu_f(acc);
            }
            if (tid < 16) { const size_t row = (size_t)b * SEQ + t0 + tid; bv[tid] = sigmoid_f(AB[row * 8 + h]); av[tid] = __expf(-Ah * softplus_f(AB[row * 8 + 4 + h] + dtb)); }
            __syncthreads();
#pragma unroll
            for (int r = 0; r < 4; ++r) { const int row = 4 * wave + r; LAS float* arr = qs + row * 128;
                const float v0 = arr[lane], v1 = arr[lane + 64]; const float s = wave_sum(v0 * v0 + v1 * v1);
                const float sc = rsqrtf(s + RMS_EPS) * (row < 16 ? 0.08838834764831845f : 1.0f); arr[lane] = v0 * sc; arr[lane + 64] = v1 * sc; }
            __syncthreads();
            for (int tt = 0; tt < 16; ++tt) {
                const float a = av[tt], bt = bv[tt], vt = vs[tt * 128 + v];
                float kS = 0.f;
#pragma unroll
                for (int i = 0; i < 32; ++i) kS += ks[tt * 128 + 32 * part + i] * S[i];
                kS += __shfl_xor(kS, 1); kS += __shfl_xor(kS, 2);
                const float c = bt * (vt - a * kS); float o = 0.f;
#pragma unroll
                for (int i = 0; i < 32; ++i) { S[i] = a * S[i] + ks[tt * 128 + 32 * part + i] * c; o += qs[tt * 128 + 32 * part + i] * S[i]; }
                o += __shfl_xor(o, 1); o += __shfl_xor(o, 2);
                if (part == 0) OA[(size_t)(b * SEQ + t0 + tt) * GW + h * 128 + v] = o;
            }
            __syncthreads();
        }
    }
}


template <int J, int K, int N> struct SolveLd {
    static __device__ __forceinline__ void run(f32x4 (&l)[4], unsigned lbase) {
        if constexpr (K < N) { constexpr int t40 = ((J + 1) >> 2) << 2;
            asm volatile("ds_read_b128 %0, %1 offset:%2" : "=v"(l[K]) : "v"(lbase), "i"((J * 68 + t40 + 4 * K) * 4)); SolveLd<J, K + 1, N>::run(l, lbase); }
    }
};
template <int J> struct SolveCol16 {
    static __device__ __forceinline__ void run(float (&R)[16], unsigned lbase) {
        if constexpr (J < 15) {
            constexpr int t40 = ((J + 1) >> 2) << 2, nld = (16 - t40) >> 2;
            f32x4 l[4];
            SolveLd<J, 0, nld>::run(l, lbase);
            asm volatile("s_waitcnt lgkmcnt(0)" ::: "memory");
#pragma unroll
            for (int k = 0; k < nld; ++k) asm volatile("" : "+v"(l[k]));
#pragma unroll
            for (int k = 0; k < nld; ++k) {
#pragma unroll
                for (int e = 0; e < 4; ++e) if (t40 + 4 * k + e > J) R[t40 + 4 * k + e] += l[k][e] * R[J]; }
            SolveCol16<J + 1>::run(R, lbase);
        }
    }
};

typedef short bf16x8 __attribute__((ext_vector_type(8)));
__device__ __forceinline__ void gdn_prep(const Args& A, LAS unsigned char* lds, int tid0, int lane0, int wave) {
    const bf16* PROJ = (const bf16*)(A.ws + WS_PROJ); const float* AB = (const float*)(A.ws + WS_AB);
    const float* cw = A.in[3]; const float* a_log = A.in[4]; const float* dt_bias = A.in[5];
    unsigned char* UVF = A.ws + WS_XN; unsigned char* GOPS = (unsigned char*)A.out; float* GE = (float*)(A.ws + WS_GE);
    LAS float* Qs = (LAS float*)lds; LAS float* Ks = (LAS float*)(lds + 33792); LAS float* Vs = (LAS float*)(lds + 67584);
    LAS bf16* Qb = (LAS bf16*)(lds + 101376); LAS bf16* Kb = (LAS bf16*)(lds + 118784);
    LAS float* gcs = (LAS float*)(lds + 136192); LAS float* bts = gcs + 64; LAS float* egs = gcs + 128; LAS float* kes = gcs + 192;
    LAS float* LsT = (LAS float*)lds; LAS bf16* ATs = (LAS bf16*)(lds + 17408); LAS bf16* WKs = Kb;
    v4u rwn[11];
    if (tid0 < 384 && (int)blockIdx.x < NB * GH * 32) { const int c8 = tid0 % 48, run = tid0 / 48, which = c8 >> 4, d0 = (c8 & 15) * 8, t1 = blockIdx.x, bh1 = t1 >> 5, n1 = t1 & 31, b1 = bh1 >> 2, h1 = bh1 & 3, col1 = which * 512 + h1 * 128 + d0;
#pragma unroll
        for (int r = 0; r < 11; ++r) { const int ts = 64 * n1 + 8 * run - 3 + r; rwn[r] = (ts >= 0) ? *(const v4u*)(PROJ + (size_t)(b1 * SEQ + ts) * NP + col1) : (v4u){0u, 0u, 0u, 0u}; } }
    else {
#pragma unroll
        for (int r = 0; r < 11; ++r) rwn[r] = (v4u){0u, 0u, 0u, 0u}; }
#pragma unroll 1
    for (int task = blockIdx.x; task < NB * GH * 32; task += gridDim.x) {
        int tid = tid0, lane = lane0; asm volatile("" : "+v"(tid), "+v"(lane));
        const int fr = lane & 15, fq = lane >> 4;
        const int bh = task >> 5, n = task & 31, b = bh >> 2, h = bh & 3, t0 = 64 * n, row0 = b * SEQ + t0;
        unsigned char* gops = GOPS + (size_t)task * GOPS_CHUNK;
        if (tid < 384) {
            const int c8 = tid % 48, run = tid / 48, which = c8 >> 4, d0 = (c8 & 15) * 8, col = which * 512 + h * 128 + d0;
            v4u rw[11];
#pragma unroll
            for (int r = 0; r < 11; ++r) rw[r] = rwn[r];
            { const int tn = task + gridDim.x;
              if (tn < NB * GH * 32) { const int bhn = tn >> 5, nn = tn & 31, bn = bhn >> 2, hn = bhn & 3, coln = which * 512 + hn * 128 + d0;
#pragma unroll
                for (int r = 0; r < 11; ++r) { const int ts = 64 * nn + 8 * run - 3 + r; rwn[r] = (ts >= 0) ? *(const v4u*)(PROJ + (size_t)(bn * SEQ + ts) * NP + coln) : (v4u){0u, 0u, 0u, 0u}; } } }
            f32x4 cwa[4], cwb[4];
#pragma unroll
            for (int j = 0; j < 4; ++j) { cwa[j] = *(const f32x4*)(cw + j * 1536 + col); cwb[j] = *(const f32x4*)(cw + j * 1536 + col + 4); }
            LAS float* dstb = (which == 0 ? Qs : (which == 1 ? Ks : Vs)) + (8 * run) * 132 + d0;
#pragma unroll
            for (int i = 0; i < 8; ++i) {
                float acc[8];
#pragma unroll
                for (int e2 = 0; e2 < 8; ++e2) acc[e2] = 0.f;
#pragma unroll
                for (int j = 0; j < 4; ++j) { const v4u w = rw[i + j];
                    acc[0] += cwa[j].x * bflo(w.x); acc[1] += cwa[j].y * bfhi(w.x); acc[2] += cwa[j].z * bflo(w.y); acc[3] += cwa[j].w * bfhi(w.y);
                    acc[4] += cwb[j].x * bflo(w.z); acc[5] += cwb[j].y * bfhi(w.z); acc[6] += cwb[j].z * bflo(w.w); acc[7] += cwb[j].w * bfhi(w.w); }
                *(LAS f32x4*)(dstb + i * 132) = (f32x4){silu_f(acc[0]), silu_f(acc[1]), silu_f(acc[2]), silu_f(acc[3])};
                *(LAS f32x4*)(dstb + i * 132 + 4) = (f32x4){silu_f(acc[4]), silu_f(acc[5]), silu_f(acc[6]), silu_f(acc[7])};
            }
        }
        if (wave == 0) {
            const size_t row = (size_t)row0 + lane; const float beta = sigmoid_f(AB[row * 8 + h]);
            float g = -__expf(a_log[h]) * softplus_f(AB[row * 8 + 4 + h] + dt_bias[h]);
#pragma unroll
            for (int o = 1; o < 64; o <<= 1) { const float t = __shfl_up(g, o); if (lane >= o) g += t; }
            const float glast = __shfl(g, 63);
            gcs[lane] = g; bts[lane] = beta; egs[lane] = __expf(g); kes[lane] = __expf(glast - g) * beta;
            if (lane == 63) GE[task] = __expf(g);
        }
        __syncthreads();
#pragma unroll 2
        for (int r = 0; r < 8; ++r) { const int row = 8 * wave + r;
            { const float v0 = Qs[row * 132 + lane], v1 = Qs[row * 132 + lane + 64]; const float sc = rsqrtf(wave_sum(v0 * v0 + v1 * v1) + RMS_EPS) * 0.08838834764831845f;
              Qb[row * 136 + lane] = (bf16)(pk2(v0 * sc, 0.f) & 0xffffu); Qb[row * 136 + lane + 64] = (bf16)(pk2(v1 * sc, 0.f) & 0xffffu); }
            { const float v0 = Ks[row * 132 + lane], v1 = Ks[row * 132 + lane + 64]; const float sc = rsqrtf(wave_sum(v0 * v0 + v1 * v1) + RMS_EPS);
              Ks[row * 132 + lane] = v0 * sc; Ks[row * 132 + lane + 64] = v1 * sc; Kb[row * 136 + lane] = (bf16)(pk2(v0 * sc, 0.f) & 0xffffu); Kb[row * 136 + lane + 64] = (bf16)(pk2(v1 * sc, 0.f) & 0xffffu); }
        }
        __syncthreads();
#pragma unroll 1
        for (int jb = wave; jb < 20; jb += 8) {
            const int kind = jb >= 10 ? 1 : 0, idx = jb - 10 * kind, ti = idx < 1 ? 0 : (idx < 3 ? 1 : (idx < 6 ? 2 : 3)), tj = idx - ti * (ti + 1) / 2;
            const LAS bf16* As = kind ? Qb : Kb; f32x4 d = (f32x4){0.f, 0.f, 0.f, 0.f};
#pragma unroll
            for (int ks = 0; ks < 4; ++ks) { const bf16x8 a = *(const LAS bf16x8*)(As + (16 * ti + fr) * 136 + 32 * ks + 8 * fq), bb = *(const LAS bf16x8*)(Kb + (16 * tj + fr) * 136 + 32 * ks + 8 * fq);
                d = __builtin_amdgcn_mfma_f32_16x16x32_bf16(a, bb, d, 0, 0, 0); }
            const int j = 16 * tj + fr; const float gj = gcs[j], bj = bts[j]; float val[4];
#pragma unroll
            for (int e = 0; e < 4; ++e) { const int t = 16 * ti + 4 * fq + e; const float x = d[e] * __expf(gcs[t] - gj) * bj; val[e] = (kind ? (t >= j) : (t > j)) ? x : 0.f; }
            if (kind == 0) *(LAS f32x4*)(LsT + j * 68 + 16 * ti + 4 * fq) = (f32x4){-val[0], -val[1], -val[2], -val[3]};
            else {
#pragma unroll
                for (int e = 0; e < 4; ++e) ATs[(16 * ti + 4 * fq + e) * 72 + j] = (bf16)(pk2(val[e], 0.f) & 0xffffu); }
        }
        __syncthreads();
        LAS float* Ti = (LAS float*)(lds + 26624);
        if (wave == 0) {
            const int I = lane >> 4, c = lane & 15; float x[16];
#pragma unroll
            for (int r = 0; r < 16; ++r) x[r] = (r == c) ? 1.0f : 0.0f;
            SolveCol16<0>::run(x, (unsigned)(uintptr_t)LsT + (unsigned)(I * (16 * 68 + 16) * 4));
#pragma unroll
            for (int r = 0; r < 16; ++r) Ti[(I * 16 + r) * 20 + c] = x[r];
        } else {
            const int rt = tid - 64;
            for (int q = rt; q < 1024; q += 448) { const int blk = q >> 6, l2 = q & 63, i = l2 & 15, f = l2 >> 4, mb = blk >> 2, ks = blk & 3, t = 16 * mb + i;
                const v2u p0 = *(const LAS v2u*)(Qb + t * 136 + 32 * ks + 4 * f), p1 = *(const LAS v2u*)(Qb + t * 136 + 32 * ks + 16 + 4 * f); const float eg = egs[t];
                v4u o; o.x = pk2(bflo(p0.x) * eg, bfhi(p0.x) * eg); o.y = pk2(bflo(p0.y) * eg, bfhi(p0.y) * eg); o.z = pk2(bflo(p1.x) * eg, bfhi(p1.x) * eg); o.w = pk2(bflo(p1.y) * eg, bfhi(p1.y) * eg);
                *(v4u*)(gops + 16384 + q * 16) = o; }
            for (int q = rt; q < 512; q += 448) { const int blk = q >> 6, l2 = q & 63, i = l2 & 15, f = l2 >> 4, mb = blk >> 1, ks2 = blk & 1, t = 16 * mb + i;
                v2u p0 = (v2u){0u, 0u}, p1 = (v2u){0u, 0u};
                if (2 * ks2 <= mb) p0 = *(const LAS v2u*)(ATs + t * 72 + 32 * ks2 + 4 * f);
                if (2 * ks2 + 1 <= mb) p1 = *(const LAS v2u*)(ATs + t * 72 + 32 * ks2 + 16 + 4 * f);
                *(v4u*)(gops + 32768 + q * 16) = (v4u){p0.x, p0.y, p1.x, p1.y}; }
            for (int q = rt; q < 1024; q += 448) { const int blk = q >> 6, l2 = q & 63, i = l2 & 15, f = l2 >> 4, dkb = blk >> 1, ks2 = blk & 1, dk = 16 * dkb + i; float v[8];
#pragma unroll
                for (int e2 = 0; e2 < 8; ++e2) { const int c = 32 * ks2 + 16 * (e2 >> 2) + 4 * f + (e2 & 3); v[e2] = Ks[c * 132 + dk] * kes[c]; }
                *(v4u*)(gops + 40960 + q * 16) = (v4u){pk2(v[0], v[1]), pk2(v[2], v[3]), pk2(v[4], v[5]), pk2(v[6], v[7])}; }
        }
        __syncthreads();
#pragma unroll
        for (int ct = 0; ct < 2; ++ct) {
            const int C = 2 * wave + ct; const bool isv = C < 8; const int col = isv ? 16 * C + fr : 16 * (C - 8) + fr;
            f32x4 X[4];
#pragma unroll
            for (int I = 0; I < 4; ++I) {
                f32x4 acc;
#pragma unroll
                for (int e2 = 0; e2 < 4; ++e2) { const int t = 16 * I + 4 * fq + e2; acc[e2] = isv ? Vs[t * 132 + col] : egs[t] * Ks[t * 132 + col]; }
#pragma unroll
                for (int J = 0; J < 4; ++J) if (J < I) {
#pragma unroll
                    for (int kk = 0; kk < 4; ++kk) acc = __builtin_amdgcn_mfma_f32_16x16x4f32(LsT[(16 * J + 4 * fq + kk) * 68 + 16 * I + fr], X[J][kk], acc, 0, 0, 0); }
                f32x4 xi = (f32x4){0.f, 0.f, 0.f, 0.f};
#pragma unroll
                for (int kk = 0; kk < 4; ++kk) xi = __builtin_amdgcn_mfma_f32_16x16x4f32(Ti[(I * 16 + fr) * 20 + 4 * fq + kk], acc[kk], xi, 0, 0, 0);
                X[I] = xi;
                if (isv) { v2u w; w.x = pk2(xi[0], xi[1]); w.y = pk2(xi[2], xi[3]); *(v2u*)(UVF + (size_t)task * 16384 + (size_t)((C * 4 + I) * 64 + lane) * 8) = w; }
                else {
#pragma unroll
                    for (int e2 = 0; e2 < 4; ++e2) WKs[(16 * I + 4 * fq + e2) * 136 + col] = (bf16)(pk2(xi[e2], 0.f) & 0xffffu); }
            }
        }
        __syncthreads();
        for (int q = tid; q < 1024; q += NTHR) { const int blk = q >> 6, l2 = q & 63, i = l2 & 15, f = l2 >> 4, mb = blk >> 2, ks = blk & 3, t = 16 * mb + i;
            const v2u p0 = *(const LAS v2u*)(WKs + t * 136 + 32 * ks + 4 * f), p1 = *(const LAS v2u*)(WKs + t * 136 + 32 * ks + 16 + 4 * f);
            *(v4u*)(gops + q * 16) = (v4u){p0.x, p0.y, p1.x, p1.y}; }
        __syncthreads();
    }
}

__device__ __forceinline__ bf16x8 pack8(const f32x4 a, const f32x4 b) {
    v4u w; w.x = pk2(a[0], a[1]); w.y = pk2(a[2], a[3]); w.z = pk2(b[0], b[1]); w.w = pk2(b[2], b[3]); return __builtin_bit_cast(bf16x8, w);
}
__device__ __forceinline__ void gdn_scan(const Args& A, LAS unsigned char* lds, int bh, int tid, int lane, int wave) {
    const int b = bh >> 2, h = bh & 3, fr = lane & 15, fq = lane >> 4, vs = wave;
    const unsigned char* gops = (const unsigned char*)A.out + (size_t)bh * 32 * GOPS_CHUNK;
    const unsigned char* uvf = A.ws + WS_XN + (size_t)bh * 32 * 16384; const float* GE = (const float*)(A.ws + WS_GE) + bh * 32;
    float* Op = (float*)(A.ws + WS_OA) + ((size_t)b * SEQ + 4 * fq) * GW + h * 128 + 16 * vs + fr;
    f32x4 S[8];
#pragma unroll
    for (int i = 0; i < 8; ++i) S[i] = (f32x4){0.f, 0.f, 0.f, 0.f};
    const float gev = GE[lane & 31];
#define SCAN_DMA(chunk, bufoff) do { _Pragma("unroll") for (int i_ = 0; i_ < 9; ++i_) { const int p_ = wave + 8 * i_; \
        const unsigned char* s_ = (p_ < 56) ? (gops + (size_t)(chunk) * GOPS_CHUNK + p_ * 1024) : (uvf + (size_t)(chunk) * 16384 + (p_ - 56) * 1024); \
        __builtin_amdgcn_global_load_lds((const unsigned*)(s_ + lane * 16), (LAS unsigned*)(lds + (bufoff) + p_ * 1024), 16, 0, 0); } } while (0)
    SCAN_DMA(0, 0); SCAN_DMA(1, SCAN_BUF);
    asm volatile("s_waitcnt vmcnt(0)" ::: "memory"); __syncthreads();
#pragma unroll 1
    for (int n = 0; n < 32; ++n) {
        const LAS unsigned char* cur = lds + (n & 1) * SCAN_BUF;
        const float ge = __builtin_bit_cast(float, __builtin_amdgcn_readlane(__builtin_bit_cast(int, gev), n));
        bf16x8 Sb[4];
#pragma unroll
        for (int ks = 0; ks < 4; ++ks) Sb[ks] = pack8(S[2 * ks], S[2 * ks + 1]);
        f32x4 u[4];
#pragma unroll
        for (int mb = 0; mb < 4; ++mb) { f32x4 p = (f32x4){0.f, 0.f, 0.f, 0.f};
#pragma unroll
            for (int ks = 0; ks < 4; ++ks) p = __builtin_amdgcn_mfma_f32_16x16x32_bf16(*(const LAS bf16x8*)(cur + ((mb * 4 + ks) * 64 + lane) * 16), Sb[ks], p, 0, 0, 0);
            const v2u uw = *(const LAS v2u*)(cur + GOPS_CHUNK + ((vs * 4 + mb) * 64 + lane) * 8);
            u[mb] = (f32x4){bflo(uw.x) - p[0], bfhi(uw.x) - p[1], bflo(uw.y) - p[2], bfhi(uw.y) - p[3]}; }
        bf16x8 ub[2]; ub[0] = pack8(u[0], u[1]); ub[1] = pack8(u[2], u[3]);
        f32x4 o[4];
#pragma unroll
        for (int mb = 0; mb < 4; ++mb) { f32x4 acc = (f32x4){0.f, 0.f, 0.f, 0.f};
#pragma unroll
            for (int ks = 0; ks < 4; ++ks) acc = __builtin_amdgcn_mfma_f32_16x16x32_bf16(*(const LAS bf16x8*)(cur + 16384 + ((mb * 4 + ks) * 64 + lane) * 16), Sb[ks], acc, 0, 0, 0);
#pragma unroll
            for (int ks2 = 0; ks2 < 2; ++ks2) if (ks2 <= (mb >> 1)) acc = __builtin_amdgcn_mfma_f32_16x16x32_bf16(*(const LAS bf16x8*)(cur + 32768 + ((mb * 2 + ks2) * 64 + lane) * 16), ub[ks2], acc, 0, 0, 0);
            o[mb] = acc; }
#pragma unroll
        for (int dkb = 0; dkb < 8; ++dkb) { f32x4 acc = S[dkb] * ge;
#pragma unroll
            for (int ks2 = 0; ks2 < 2; ++ks2) acc = __builtin_amdgcn_mfma_f32_16x16x32_bf16(*(const LAS bf16x8*)(cur + 40960 + ((dkb * 2 + ks2) * 64 + lane) * 16), ub[ks2], acc, 0, 0, 0);
            S[dkb] = acc; }
        asm volatile("s_waitcnt vmcnt(0)" ::: "memory"); __syncthreads();
        if (n + 2 < 32) SCAN_DMA(n + 2, (n & 1) * SCAN_BUF);
        float* orow = Op + (size_t)(64 * n) * GW;
#pragma unroll
        for (int mb = 0; mb < 4; ++mb) { float* q = orow + (size_t)(16 * mb) * GW; q[0] = o[mb][0]; q[GW] = o[mb][1]; q[2 * GW] = o[mb][2]; q[3 * GW] = o[mb][3]; }
    }
    asm volatile("s_waitcnt vmcnt(0)" ::: "memory"); __syncthreads();
#undef SCAN_DMA
}


__device__ __forceinline__ void attn_fast(const Args& A, LAS unsigned char* lds, int lane, int wave) {
    const bf16* PROJ = (const bf16*)(A.ws + WS_PROJ); bf16* CAT = (bf16*)(A.ws + WS_CAT);
    unsigned* ctr = (unsigned*)(A.ws + WS_CTL);
    LAS bf16* Vt = (LAS bf16*)(lds + wave * 8192);
    const int fr = lane & 15, fq = lane >> 4;
    const int kk = lane & 31, vslot = 8 * ((kk & 15) >> 2) + 4 * (kk >> 4) + (kk & 3), vch = lane >> 5;
    constexpr float SC = 0.125f * 1.4426950408889634f;
    const int myx = (int)(__builtin_amdgcn_s_getreg((3 << 11) | 20) & 0x7u);
    int qi = 0;
    for (;;) {
        int wt = 512, xq = 0;
        while (qi < 8) { xq = (myx + qi) & 7; unsigned wt_ = 0; if (lane == 0) wt_ = atomicAdd(ctr + 16 * xq, 1u); wt = __builtin_amdgcn_readfirstlane(wt_); if (wt < 512) break; ++qi; }
        if (qi >= 8) break;
        const int b = wt >> 6, h = xq, rem = wt & 63, T = 7 - (rem >> 3), c4 = rem & 7, cA = (c4 & 3) + 8 * (c4 >> 2), cB = cA + 4, t0 = 256 * T;
        const bf16* Pb = PROJ + (size_t)b * SEQ * NP;
        const int tqA = t0 + cA + 16 * fr, tqB = tqA + 4;
        bf16x8 qfA[2], qfB[2];
#pragma unroll
        for (int ks = 0; ks < 2; ++ks) { qfA[ks] = *(const bf16x8*)(Pb + (size_t)tqA * NP + PC_QB + h * 64 + 32 * ks + 8 * fq); qfB[ks] = *(const bf16x8*)(Pb + (size_t)tqB * NP + PC_QB + h * 64 + 32 * ks + 8 * fq); }
        const int n2 = ((t0 + 240) >> 4) + 1, g2 = (n2 + 31) >> 5;
        const int lo1 = max(t0 + cA - 512, cA & 3), n1 = ((t0 + cB + 240 - lo1) >> 2) + 1, g1 = (n1 + 31) >> 5;
        const int lo0 = max(t0 + cA - 128, 0), n0 = (t0 + cB + 240 - lo0) + 1, g0 = (n0 + 31) >> 5;
        const int NG = 2 * g2 + g1 + g0;
        f32x4 OA[4], OB[4];
#pragma unroll
        for (int i = 0; i < 4; ++i) { OA[i] = (f32x4){0.f, 0.f, 0.f, 0.f}; OB[i] = OA[i]; }
        float mA = -INFINITY, lA = 0.f, mB = -INFINITY, lB = 0.f;
        v4u kc[4], vc[4], kn[4], vn[4];
#define ATT_DEC(f, kst, str, mode) do { if ((f) < g2) { str = 16; kst = cA + 512 * (f); mode = 1; } else if ((f) < 2 * g2) { str = 16; kst = cB + 512 * ((f) - g2); mode = 2; } \
            else if ((f) < 2 * g2 + g1) { str = 4; kst = lo1 + 128 * ((f) - 2 * g2); mode = 3; } else { str = 1; kst = lo0 + 32 * ((f) - 2 * g2 - g1); mode = 3; } } while (0)
#define ATT_LOAD(kreg, vreg, kst, str) do { \
            _Pragma("unroll") for (int j = 0; j < 2; ++j) { const int tk = min((kst) + (str) * (16 * j + fr), SEQ - 1); \
                _Pragma("unroll") for (int ks = 0; ks < 2; ++ks) kreg[2 * j + ks] = *(const v4u*)(Pb + (size_t)tk * NP + PC_KB + h * 64 + 32 * ks + 8 * fq); } \
            { const int tk = min((kst) + (str) * kk, SEQ - 1); \
                _Pragma("unroll") for (int i = 0; i < 4; ++i) vreg[i] = *(const v4u*)(Pb + (size_t)tk * NP + PC_VB + h * 64 + 8 * (vch + 2 * i)); } } while (0)
#define ATT_CLS(O_, m_, l_, qf_, tq_) do { \
            f32x4 d0 = (f32x4){0.f, 0.f, 0.f, 0.f}, d1 = d0; \
            _Pragma("unroll") for (int ks = 0; ks < 2; ++ks) { d0 = __builtin_amdgcn_mfma_f32_16x16x32_bf16(__builtin_bit_cast(bf16x8, kc[ks]), qf_[ks], d0, 0, 0, 0); \
                                                             d1 = __builtin_amdgcn_mfma_f32_16x16x32_bf16(__builtin_bit_cast(bf16x8, kc[2 + ks]), qf_[ks], d1, 0, 0, 0); } \
            float s[8]; float mloc = -INFINITY; \
            const int dv = (((tq_) - kst) >> shl) - 4 * fq;        \
            _Pragma("unroll") for (int e2 = 0; e2 < 8; ++e2) { const float x = (e2 < 4 ? d0[e2 & 3] : d1[e2 & 3]) * SC; \
                s[e2] = ((unsigned)(dv - (16 * (e2 >> 2) + (e2 & 3))) <= 128u) ? x : -INFINITY; mloc = fmaxf(mloc, s[e2]); } \
            mloc = fmaxf(mloc, __shfl_xor(mloc, 16)); mloc = fmaxf(mloc, __shfl_xor(mloc, 32)); \
            const float mnew = fmaxf(m_, mloc), alpha = __builtin_amdgcn_exp2f(m_ - mnew); m_ = mnew; \
            float psum = 0.f; \
            _Pragma("unroll") for (int e2 = 0; e2 < 8; ++e2) { s[e2] = __builtin_amdgcn_exp2f(s[e2] - mnew); psum += s[e2]; } \
            l_ = l_ * alpha + psum; \
            const bf16x8 pb = pack8((f32x4){s[0], s[1], s[2], s[3]}, (f32x4){s[4], s[5], s[6], s[7]}); \
            _Pragma("unroll") for (int db = 0; db < 4; ++db) O_[db] = __builtin_amdgcn_mfma_f32_16x16x32_bf16(va[db], pb, O_[db] * alpha, 0, 0, 0); } while (0)
        int kst, str, mode; ATT_DEC(0, kst, str, mode); ATT_LOAD(kc, vc, kst, str);
#pragma unroll 1
        for (int f = 0; f < NG; ++f) {
            int kstn = 0, strn = 1, moden = 0;
            if (f + 1 < NG) { ATT_DEC(f + 1, kstn, strn, moden); ATT_LOAD(kn, vn, kstn, strn); }
#pragma unroll
            for (int i = 0; i < 4; ++i) { const int dd = 8 * (vch + 2 * i); const v4u w = vc[i];
                Vt[(dd + 0) * 40 + vslot] = (bf16)(w.x & 0xffffu); Vt[(dd + 1) * 40 + vslot] = (bf16)(w.x >> 16); Vt[(dd + 2) * 40 + vslot] = (bf16)(w.y & 0xffffu); Vt[(dd + 3) * 40 + vslot] = (bf16)(w.y >> 16);
                Vt[(dd + 4) * 40 + vslot] = (bf16)(w.z & 0xffffu); Vt[(dd + 5) * 40 + vslot] = (bf16)(w.z >> 16); Vt[(dd + 6) * 40 + vslot] = (bf16)(w.w & 0xffffu); Vt[(dd + 7) * 40 + vslot] = (bf16)(w.w >> 16); }
            bf16x8 va[4];
#pragma unroll
            for (int db = 0; db < 4; ++db) va[db] = *(const LAS bf16x8*)(Vt + (16 * db + fr) * 40 + 8 * fq);
            const int shl = (str == 16) ? 4 : (str == 4 ? 2 : 0);
            if (mode & 1) ATT_CLS(OA, mA, lA, qfA, tqA);
            if (mode & 2) ATT_CLS(OB, mB, lB, qfB, tqB);
#pragma unroll
            for (int i = 0; i < 4; ++i) { kc[i] = kn[i]; vc[i] = vn[i]; }
            kst = kstn; str = strn; mode = moden;
        }
#undef ATT_DEC
#undef ATT_LOAD
#undef ATT_CLS
        lA += __shfl_xor(lA, 16); lA += __shfl_xor(lA, 32); lB += __shfl_xor(lB, 16); lB += __shfl_xor(lB, 32);
        const float invA = 1.0f / lA, invB = 1.0f / lB;
        bf16* op = CAT + ((size_t)b * SEQ + tqA) * DM + GW + h * 64 + 4 * fq;
#pragma unroll
        for (int db = 0; db < 4; ++db) { v2u w; w.x = pk2(OA[db][0] * invA, OA[db][1] * invA); w.y = pk2(OA[db][2] * invA, OA[db][3] * invA); *(v2u*)(op + 16 * db) = w;
            v2u w2; w2.x = pk2(OB[db][0] * invB, OB[db][1] * invB); w2.y = pk2(OB[db][2] * invB, OB[db][3] * invB); *(v2u*)(op + 4 * DM + 16 * db) = w2; }
    }
}

__device__ __forceinline__ void attn_simple(const Args& A, int tid, int lane, int wave) {
    const bf16* PROJ = (const bf16*)(A.ws + WS_PROJ); bf16* CAT = (bf16*)(A.ws + WS_CAT);
    unsigned* ctr = (unsigned*)(A.ws + WS_CTL);
    for (;;) {
        unsigned wt_ = 0; if (lane == 0) wt_ = atomicAdd(ctr, 1u); const int wt = __builtin_amdgcn_readfirstlane(wt_);
        if (wt >= (M / 64) * AH) break;
        const int h = wt % AH, tb = wt / AH, row = tb * 64 + lane, b = row / SEQ, t = row % SEQ;
        float q[64], acc[64];
        { const v4u* qp = (const v4u*)(PROJ + (size_t)row * NP + PC_QB + h * 64);
#pragma unroll
          for (int j = 0; j < 8; ++j) { const v4u w = qp[j]; q[8 * j + 0] = bflo(w.x) * 0.125f; q[8 * j + 1] = bfhi(w.x) * 0.125f; q[8 * j + 2] = bflo(w.y) * 0.125f; q[8 * j + 3] = bfhi(w.y) * 0.125f;
              q[8 * j + 4] = bflo(w.z) * 0.125f; q[8 * j + 5] = bfhi(w.z) * 0.125f; q[8 * j + 6] = bflo(w.w) * 0.125f; q[8 * j + 7] = bfhi(w.w) * 0.125f; } }
#pragma unroll
        for (int j = 0; j < 64; ++j) acc[j] = 0.f;
        float mx = -1e30f, l = 0.f;
        for (int br = 0; br < 3; ++br) {
            const int stride = br == 0 ? 1 : (br == 1 ? 4 : 16);
            for (int i = 0; i <= 128; ++i) {
                const int tk = t - i * stride; if (tk < 0) break;
                const size_t krow = (size_t)(b * SEQ + tk) * NP;
                const v4u* kp = (const v4u*)(PROJ + krow + PC_KB + h * 64); const v4u* vp = (const v4u*)(PROJ + krow + PC_VB + h * 64);
                float s = 0.f;
#pragma unroll
                for (int j = 0; j < 8; ++j) { const v4u w = kp[j]; s += q[8 * j + 0] * bflo(w.x) + q[8 * j + 1] * bfhi(w.x) + q[8 * j + 2] * bflo(w.y) + q[8 * j + 3] * bfhi(w.y)
                                                                       + q[8 * j + 4] * bflo(w.z) + q[8 * j + 5] * bfhi(w.z) + q[8 * j + 6] * bflo(w.w) + q[8 * j + 7] * bfhi(w.w); }
                const float mn = fmaxf(mx, s), sc = __expf(mx - mn), p = __expf(s - mn); mx = mn; l = l * sc + p;
#pragma unroll
                for (int j = 0; j < 8; ++j) { const v4u w = vp[j];
                    acc[8 * j + 0] = acc[8 * j + 0] * sc + p * bflo(w.x); acc[8 * j + 1] = acc[8 * j + 1] * sc + p * bfhi(w.x); acc[8 * j + 2] = acc[8 * j + 2] * sc + p * bflo(w.y); acc[8 * j + 3] = acc[8 * j + 3] * sc + p * bfhi(w.y);
                    acc[8 * j + 4] = acc[8 * j + 4] * sc + p * bflo(w.z); acc[8 * j + 5] = acc[8 * j + 5] * sc + p * bfhi(w.z); acc[8 * j + 6] = acc[8 * j + 6] * sc + p * bflo(w.w); acc[8 * j + 7] = acc[8 * j + 7] * sc + p * bfhi(w.w); }
            }
        }
        const float inv = 1.0f / l; v4u* op = (v4u*)(CAT + (size_t)row * DM + GW + h * 64);
#pragma unroll
        for (int j = 0; j < 8; ++j) { v4u w; w.x = pk2(acc[8 * j] * inv, acc[8 * j + 1] * inv); w.y = pk2(acc[8 * j + 2] * inv, acc[8 * j + 3] * inv); w.z = pk2(acc[8 * j + 4] * inv, acc[8 * j + 5] * inv); w.w = pk2(acc[8 * j + 6] * inv, acc[8 * j + 7] * inv); op[j] = w; }
    }
}
__device__ __forceinline__ void gated_norm(const Args& A, int lane, int wave) {
    const bf16* PROJ = (const bf16*)(A.ws + WS_PROJ); bf16* CAT = (bf16*)(A.ws + WS_CAT); const float* OA = (const float*)(A.ws + WS_OA); const float* gw = A.in[6];
    const float w0 = gw[2 * lane], w1 = gw[2 * lane + 1];
    const int gwv = blockIdx.x * NWAVES + wave, NGW = gridDim.x * NWAVES;
    for (int wt0 = gwv; wt0 < M * GH; wt0 += 8 * NGW) {
        float2 o[8]; unsigned zz[8];
#pragma unroll
        for (int i = 0; i < 8; ++i) { const int wt = min(wt0 + i * NGW, M * GH - 1), row = wt / GH, h = wt % GH;
            o[i] = *(const float2*)(OA + (size_t)row * GW + h * 128 + 2 * lane); zz[i] = *(const unsigned*)(PROJ + (size_t)row * NP + PC_Z + h * 128 + 2 * lane); }
#pragma unroll
        for (int i = 0; i < 8; ++i) { const int wt = wt0 + i * NGW; if (wt >= M * GH) break; const int row = wt / GH, h = wt % GH;
            const float ms = wave_sum(o[i].x * o[i].x + o[i].y * o[i].y) * (1.0f / 128.0f), r = rsqrtf(ms + RMS_EPS);
            *(unsigned*)(CAT + (size_t)row * DM + h * 128 + 2 * lane) = pk2(o[i].x * r * w0 * silu_f(bflo(zz[i])), o[i].y * r * w1 * silu_f(bfhi(zz[i]))); }
    }
}

__device__ __forceinline__ void gated_norm_bh(const Args& A, int bh, int lane, int wave) {
    const int b = bh >> 2, h = bh & 3;
    const bf16* Zp = (const bf16*)(A.ws + WS_PROJ) + (size_t)b * SEQ * NP + PC_Z + h * 128 + 2 * lane; bf16* Cp = (bf16*)(A.ws + WS_CAT) + (size_t)b * SEQ * DM + h * 128 + 2 * lane;
    const float* Op = (const float*)(A.ws + WS_OA) + (size_t)b * SEQ * GW + h * 128 + 2 * lane; const float* gw = A.in[6];
    const float w0 = gw[2 * lane], w1 = gw[2 * lane + 1];
    __builtin_amdgcn_fence(__ATOMIC_ACQUIRE, "agent");
#pragma unroll 1
    for (int r0 = wave * 16; r0 < SEQ; r0 += NWAVES * 16) {
        float2 o[16]; unsigned zz[16];
#pragma unroll
        for (int i = 0; i < 16; ++i) { o[i] = *(const float2*)(Op + (size_t)(r0 + i) * GW); zz[i] = *(const unsigned*)(Zp + (size_t)(r0 + i) * NP); }
#pragma unroll
        for (int i = 0; i < 16; ++i) { const float ms = wave_sum(o[i].x * o[i].x + o[i].y * o[i].y) * (1.0f / 128.0f), r = rsqrtf(ms + RMS_EPS);
            *(unsigned*)(Cp + (size_t)(r0 + i) * DM) = pk2(o[i].x * r * w0 * silu_f(bflo(zz[i])), o[i].y * r * w1 * silu_f(bfhi(zz[i]))); }
    }
}
__device__ __forceinline__ void ffn_conv_half(const Args& A, int half, int tid) {
    const bf16* Y = (const bf16*)(A.ws + WS_Y); bf16* ACT = (bf16*)(A.ws + WS_ACT); const float* fw = A.in[10];
    constexpr int HC = DFF / 2;
    for (size_t it = (size_t)blockIdx.x * NTHR + tid; it < (size_t)M * (HC / 8); it += (size_t)gridDim.x * NTHR) {
        const int row = (int)(it / (HC / 8)), g8 = (int)(it % (HC / 8)), cl = g8 * 8, pn = cl >> 7, j = cl & 127, t = row % SEQ, ch = half * HC + cl;
        float ga[8], ua[8];
#pragma unroll
        for (int e = 0; e < 8; ++e) { ga[e] = 0.f; ua[e] = 0.f; }
#pragma unroll
        for (int i = 0; i < 3; ++i) { const int ts = t - 2 + i; if (ts < 0) continue;
            const bf16* yr = Y + (size_t)(row - 2 + i) * DFF + 256 * pn + j; const v4u g = *(const v4u*)yr, u = *(const v4u*)(yr + 128);
            const f32x4 wg0 = *(const f32x4*)(fw + i * NUP + ch), wg1 = *(const f32x4*)(fw + i * NUP + ch + 4), wu0 = *(const f32x4*)(fw + i * NUP + DFF + ch), wu1 = *(const f32x4*)(fw + i * NUP + DFF + ch + 4);
            ga[0] += wg0.x * bflo(g.x); ga[1] += wg0.y * bfhi(g.x); ga[2] += wg0.z * bflo(g.y); ga[3] += wg0.w * bfhi(g.y); ga[4] += wg1.x * bflo(g.z); ga[5] += wg1.y * bfhi(g.z); ga[6] += wg1.z * bflo(g.w); ga[7] += wg1.w * bfhi(g.w);
            ua[0] += wu0.x * bflo(u.x); ua[1] += wu0.y * bfhi(u.x); ua[2] += wu0.z * bflo(u.y); ua[3] += wu0.w * bfhi(u.y); ua[4] += wu1.x * bflo(u.z); ua[5] += wu1.y * bfhi(u.z); ua[6] += wu1.z * bflo(u.w); ua[7] += wu1.w * bfhi(u.w); }
        v4u o; o.x = pk2(silu_f(ga[0]) * ua[0], silu_f(ga[1]) * ua[1]); o.y = pk2(silu_f(ga[2]) * ua[2], silu_f(ga[3]) * ua[3]); o.z = pk2(silu_f(ga[4]) * ua[4], silu_f(ga[5]) * ua[5]); o.w = pk2(silu_f(ga[6]) * ua[6], silu_f(ga[7]) * ua[7]);
        *(v4u*)(ACT + (size_t)row * DFF + ch) = o;
    }
}

__device__ __forceinline__ void ffn_fixup(const Args& A, int tid) {
    const float* YH = (const float*)(A.ws + WS_YH); const float* UP = (const float*)(A.ws + WS_UPART); bf16* ACT = (bf16*)(A.ws + WS_ACT); const float* fw = A.in[10];
    for (int it = blockIdx.x * NTHR + tid; it < 64 * 22 * 2 * 128; it += gridDim.x * NTHR) {
        const int c = it & 127, r = (it >> 7) & 1, tile = it >> 8, pm = tile / 22, pn = tile % 22; if ((pm & 7) == 0) continue;
        const int ch = pn * 128 + c; const float* up = UP + ((size_t)tile * 2 + r) * 256; const float* yh = YH + (size_t)((pm - 1) * 22 + pn) * 2 * 256;
        float g = up[c], u = up[128 + c];
        const float wg0 = fw[ch], wg1 = fw[5632 + ch], wu0 = fw[2816 + ch], wu1 = fw[5632 + 2816 + ch];
        if (r == 0) { g += wg0 * yh[c] + wg1 * yh[256 + c]; u += wu0 * yh[128 + c] + wu1 * yh[256 + 128 + c]; }
        else { g += wg0 * yh[256 + c]; u += wu0 * yh[256 + 128 + c]; }
        ACT[(size_t)(pm * 256 + r) * DFF + ch] = (bf16)(pk2(silu_f(g) * u, 0.f) & 0xffffu);
    }
}
__device__ __forceinline__ void final_norm(const Args& A, int lane, int wave) {
    float* out = A.out; const f32x4* nr = (const f32x4*)A.in[12] + lane;
    const int gw = blockIdx.x * NWAVES + wave, NGW = gridDim.x * NWAVES;
    f32x4 nw[4];
#pragma unroll
    for (int j = 0; j < 4; ++j) nw[j] = nr[64 * j];
    for (int m0 = gw; m0 < M; m0 += 4 * NGW) {
        f32x4 v[4][4];
#pragma unroll
        for (int rr = 0; rr < 4; ++rr) { const int m = min(m0 + rr * NGW, M - 1); const f32x4* xr = (const f32x4*)(out + (size_t)m * DM) + lane;
#pragma unroll
            for (int j = 0; j < 4; ++j) v[rr][j] = xr[64 * j]; }
#pragma unroll
        for (int rr = 0; rr < 4; ++rr) { const int m = m0 + rr * NGW; if (m >= M) break; float s = 0.f;
#pragma unroll
            for (int j = 0; j < 4; ++j) s += (v[rr][j].x * v[rr][j].x + v[rr][j].y * v[rr][j].y) + (v[rr][j].z * v[rr][j].z + v[rr][j].w * v[rr][j].w);
            const float rstd = rsqrtf(wave_sum(s) * (1.f / DM) + RMS_EPS); f32x4* xw = (f32x4*)(out + (size_t)m * DM) + lane;
#pragma unroll
            for (int j = 0; j < 4; ++j) xw[64 * j] = (f32x4){v[rr][j].x * rstd * nw[j].x, v[rr][j].y * rstd * nw[j].y, v[rr][j].z * rstd * nw[j].z, v[rr][j].w * rstd * nw[j].w}; }
    }
}

#define XB_TMO      128
#define XB_XCNT(j)  (256  + 64 * (j))
#define XB_XSUB(j)  (1280 + 64 * (j))
#define XB_XGEN(j)  (2304 + 64 * (j))
#define XB_TOP      3328
#define XB_TOPGEN   3392
#define XCD_BAR_WORDS 3456
#define XB_SPIN_CAP (1u << 18)

__device__ __forceinline__ unsigned xb_ld(unsigned* p)              { return __hip_atomic_load(p, __ATOMIC_RELAXED, __HIP_MEMORY_SCOPE_AGENT); }
__device__ __forceinline__ unsigned xb_add(unsigned* p, unsigned v) { return __hip_atomic_fetch_add(p, v, __ATOMIC_RELAXED, __HIP_MEMORY_SCOPE_AGENT); }
__device__ __forceinline__ unsigned xb_xcc_id() { return (unsigned)__builtin_amdgcn_s_getreg((3 << 11) | 20) & 0xFu; }
#define XB_SPIN(cond, bar) do { unsigned _sp = 0; while (cond) { __builtin_amdgcn_s_sleep(1); \
    if ((++_sp & 255u) == 0u) { if (xb_ld(&(bar)[XB_TMO])) break; if (_sp > XB_SPIN_CAP) { atomicAdd(&(bar)[XB_TMO], 1u); break; } } } } while (0)

struct XcdBarrier {
    unsigned* bar; unsigned x;
    volatile LAS unsigned* st;
};

__device__ __forceinline__ XcdBarrier xcd_barrier_post(unsigned* bar, volatile LAS unsigned* st) {
    XcdBarrier b; b.bar = bar; b.x = xb_xcc_id(); b.st = st;
    if (threadIdx.x == 0) (void)xb_add(&bar[XB_XCNT(b.x)], 1u);
    return b;
}
__device__ __forceinline__ void xcd_barrier_complete(unsigned* bar, unsigned x, unsigned& nloc, unsigned& nx) {
    const unsigned G = gridDim.x * gridDim.y * gridDim.z;
    unsigned sum, cnt, mine, sp = 0u;
    for (;;) {
        sum = 0u; cnt = 0u; mine = 0u;
#pragma unroll
        for (unsigned j = 0; j < 16; ++j) { const unsigned c = xb_ld(&bar[XB_XCNT(j)]); sum += c; cnt += (c > 0u) ? 1u : 0u; mine = (j == x) ? c : mine; }
        if (sum == G) break;
        __builtin_amdgcn_s_sleep(1);
        if ((++sp & 255u) == 0u) { if (xb_ld(&bar[XB_TMO])) break; if (sp > XB_SPIN_CAP) { atomicAdd(&bar[XB_TMO], 1u); break; } }
    }
    nloc = mine > 0u ? mine : 1u; nx = cnt > 0u ? cnt : 1u;
}

__device__ __forceinline__ void xcd_barrier(const XcdBarrier& b) {
    asm volatile("s_waitcnt vmcnt(0)" ::: "memory");
    __syncthreads();
    if (threadIdx.x == 0) {
        unsigned* bar = b.bar;
        __builtin_amdgcn_s_waitcnt(0);
        unsigned nloc = b.st[0], nx = b.st[1];
        if (nloc == 0u) { xcd_barrier_complete(bar, b.x, nloc, nx); b.st[0] = nloc; b.st[1] = nx; }
        const unsigned old = xb_add(&bar[XB_XSUB(b.x)], 1u);
        const unsigned gen = old / nloc;
        if (old + 1u == (gen + 1u) * nloc) {
            __builtin_amdgcn_fence(__ATOMIC_RELEASE, "agent");
            asm volatile("s_waitcnt vmcnt(0)" ::: "memory");
            const unsigned og = xb_add(&bar[XB_TOP], 1u);
            const unsigned tg = og / nx;
            if (og + 1u == (tg + 1u) * nx) xb_add(&bar[XB_TOPGEN], 1u);
            else XB_SPIN(xb_ld(&bar[XB_TOPGEN]) == tg, bar);
            __builtin_amdgcn_fence(__ATOMIC_ACQUIRE, "agent");
            xb_add(&bar[XB_XGEN(b.x)], 1u);
            asm volatile("s_waitcnt vmcnt(0)" ::: "memory");
        } else {
            XB_SPIN(xb_ld(&bar[XB_XGEN(b.x)]) == gen, bar);
            __builtin_amdgcn_fence(__ATOMIC_ACQUIRE, "agent");
            asm volatile("s_waitcnt vmcnt(0)" ::: "memory");
        }
    }
    __syncthreads();
}

constexpr int N_PHASES = 8;
__global__ void __launch_bounds__(NTHR, 2) mk_fwd(Args args) {
    extern __shared__ __attribute__((aligned(16))) unsigned char lds_raw[];
    LAS unsigned char* lds = (LAS unsigned char*)lds_raw;
    const int tid = threadIdx.x, lane = tid & 63, wave = __builtin_amdgcn_readfirstlane(tid >> 6);
    const int lo = args.ph_lo, hi = args.ph_hi;
    unsigned char* ws = args.ws;
    bf16* WIN = (bf16*)(ws + WS_WIN); bf16* WOUT = (bf16*)(ws + WS_WOUT); bf16* WUP = (bf16*)(ws + WS_WUP); bf16* WDN = (bf16*)(ws + WS_WDN);
    bf16* XN = (bf16*)(ws + WS_XN); bf16* PROJ = (bf16*)(ws + WS_PROJ); bf16* CAT = (bf16*)(ws + WS_CAT); bf16* Y = (bf16*)(ws + WS_Y); bf16* ACT = (bf16*)(ws + WS_ACT);
    float* SSQ = (float*)(ws + WS_SSQ);
#define IN(k) (lo <= (k) && (k) < hi)
#define SEAM(k) do { if (IN(k) && IN((k) + 1)) { xcd_barrier(bar); } } while (0)
    { volatile LAS unsigned* st = (volatile LAS unsigned*)(lds + LDS_BYTES - 64); if (tid < 2) st[tid] = 0u; }
    __syncthreads();
    XcdBarrier bar = xcd_barrier_post((unsigned*)(ws + WS_CTL) + 4096, (volatile LAS unsigned*)(lds + LDS_BYTES - 64));
    if (args.coop > 1) cg::this_grid().sync();
    if (IN(0)) { p0_prologue(args, lds, tid, lane, wave); } SEAM(0);
    if (IN(1)) { pg8::Gemm g{XN, WIN, M, NP, DM}; pg8::StaticOrder S; S.init(M, NP, gridDim.x, blockIdx.x); pg8::EpiBf16S E{PROJ, NP, nullptr};
        pg8::gemm_phase<pg8::EpiBf16S, pg8::StaticOrder, PG8_ALIGN, PG8_SP2>(lds, g, S, E);
        { pg8::Unit u4; const bool idle4 = !S.next(3, u4); const int G = gridDim.x, nidle = (G == 256) ? 128 : G;
          if (G != 256) convert_late_weights(args, lds, lane, wave, blockIdx.x * NWAVES + wave, G * NWAVES);
          else if (idle4) convert_late_weights(args, lds, lane, wave, (blockIdx.x - 128) * NWAVES + wave, nidle * NWAVES); } } SEAM(1);
    if (IN(2)) { gdn_prep(args, lds, tid, lane, wave); } SEAM(2);
    if (IN(3)) { if (blockIdx.x < NB * GH) gdn_scan(args, lds, blockIdx.x, tid, lane, wave); attn_fast(args, lds, lane, wave); xcd_barrier(bar); gated_norm(args, lane, wave); } SEAM(3);
    if (IN(4)) { pg8::Gemm g{CAT, WOUT, M, DM, DM}; pg8::StaticOrder S; S.init(M, DM, gridDim.x, blockIdx.x); pg8::EpiResid E{args.in[0], (gridDim.x == 256) ? nullptr : args.out, XN, SSQ, DM};
        pg8::gemm_phase<pg8::EpiResid, pg8::StaticOrder, PG8_ALIGN, PG8_SP2>(lds, g, S, E); } SEAM(4);
    if (IN(5)) { pg8::Gemm g{XN, WUP, M, NUP, DM}; pg8::StaticOrder S; S.init(M, NUP, gridDim.x, blockIdx.x);
        static_assert(pg8::EpiConvGate::CG_SSQ == WS_SSQ && pg8::EpiConvGate::CG_ACT == WS_ACT && pg8::EpiConvGate::CG_YH == WS_YH && pg8::EpiConvGate::CG_UPART == WS_UPART, "d_ws map");
        pg8::EpiConvGate E{ws, args.in[10], lds};
        pg8::gemm_phase<pg8::EpiConvGate, pg8::StaticOrder, true, PG8_SP2>(lds, g, S, E); } SEAM(5);
    if (IN(6)) { ffn_fixup(args, tid); } SEAM(6);
    if (IN(7)) { pg8::Gemm g{ACT, WDN, M, DM, DFF}; pg8::StaticOrder S; S.init(M, DM, gridDim.x, blockIdx.x);
        if (gridDim.x == 256) {
            pg8::EpiResidNorm E{XN, args.out, (float*)(ws + WS_SSQ2), (unsigned*)(ws + WS_CTL) + 2048, args.in[12], DM};
            pg8::gemm_phase<pg8::EpiResidNorm, pg8::StaticOrder, true, PG8_SP2>(lds, g, S, E);
        } else {
            pg8::EpiResid E{args.out, args.out, nullptr, nullptr, DM};
            pg8::gemm_phase<pg8::EpiResid, pg8::StaticOrder, PG8_ALIGN, PG8_SP2>(lds, g, S, E);
            xcd_barrier(bar); final_norm(args, lane, wave);
        } }
#undef IN
#undef SEAM
}

#ifndef MK_ONE_LAUNCH
#define MK_ONE_LAUNCH 1
#endif
extern "C" void kernel_launch(void* const* d_in, const int* in_sizes, int n_in, void* d_out, int out_size, void* d_ws, size_t ws_size, hipStream_t stream) {
    static int grid = 0;
    if (grid == 0) {
        if (n_in != 13 || out_size != M * DM || ws_size < WS_END) { fprintf(stderr, "kernel_launch: unexpected shapes n_in %d out %d ws %zu\n", n_in, out_size, ws_size); grid = -1; return; }
        int dev = 0, cus = 0, per_cu = 0;
        hipGetDevice(&dev); hipDeviceGetAttribute(&cus, hipDeviceAttributeMultiprocessorCount, dev);
        hipFuncSetAttribute((const void*)mk_fwd, hipFuncAttributeMaxDynamicSharedMemorySize, LDS_BYTES);
        hipOccupancyMaxActiveBlocksPerMultiprocessor(&per_cu, (const void*)mk_fwd, NTHR, LDS_BYTES);
        (void)hipGetLastError();
        if (per_cu < 1) { fprintf(stderr, "kernel_launch: occupancy query says %d blocks per CU\n", per_cu); per_cu = 1; }
        grid = cus;
    }
    if (grid < 0) return;
    if (hipMemsetAsync((char*)d_ws + WS_CTL, 0, 65536, stream) != hipSuccess) { fprintf(stderr, "kernel_launch: memset failed\n"); return; }
    Args a{};
    for (int i = 0; i < 13; ++i) a.in[i] = (const float*)d_in[i];
    a.out = (float*)d_out; a.ws = (unsigned char*)d_ws;
#if MK_ONE_LAUNCH
    a.ph_lo = 0; a.ph_hi = N_PHASES; a.coop = 1;
    void* kargs[] = {&a};
    hipError_t e = hipLaunchCooperativeKernel((const void*)mk_fwd, dim3(grid), dim3(NTHR), kargs, LDS_BYTES, stream);
    if (e != hipSuccess) fprintf(stderr, "cooperative launch failed: %s (grid %d)\n", hipGetErrorString(e), grid);
#else
    for (int p = 0; p < N_PHASES; ++p) { a.ph_lo = p; a.ph_hi = p + 1; a.coop = 0; hipLaunchKernelGGL(mk_fwd, dim3(grid), dim3(NTHR), LDS_BYTES, stream, a); }
#endif
}
```

```cpp
#include <hip/hip_runtime.h>
#include <hip/hip_cooperative_groups.h>
#include <cstdio>
#include <cstdint>
namespace cg = cooperative_groups;
namespace pg8 {
#define PG8_LAS __attribute__((address_space(3)))
typedef unsigned short bf16_t;
typedef short bf16x8 __attribute__((ext_vector_type(8)));
typedef float f32x4 __attribute__((ext_vector_type(4)));
typedef unsigned u32x4 __attribute__((ext_vector_type(4)));
constexpr int BM = 256, BK = 64, HALF = 128, HTB = HALF * BK * 2  , STAGE_BYTES = 8 * HTB, NXCD = 8, WGM = 8;

__host__ __device__ __forceinline__ int lds_byte(int r, int c) { const int st = (r >> 4) * 2 + (c >> 5), rr = r & 15, cc = c & 31, ob = rr * 64 + cc * 2; return st * 1024 + (ob ^ (((ob >> 9) & 1) << 5)); }
__host__ __device__ __forceinline__ void stage_rc(int b, int& R, int& C) { const int st = b / 1024, sb = b % 1024, swz = sb ^ (((sb >> 9) & 1) << 5); R = (st >> 1) * 16 + swz / 64; C = (st & 1) * 32 + (swz % 64) / 2; }
__host__ __device__ __forceinline__ int perm32(int rho) { const int n = rho >> 4, i = rho & 15; return 8 * (i >> 2) + 4 * n + (i & 3); }

struct Unit { int pm, pn; };
struct Gemm { const bf16_t* A; const bf16_t* Bt; int M, N, K; };

struct StaticOrder {
    int nM, nN, nwg, G, c;
    __host__ __device__ __forceinline__ void init(int M, int N, int G_, int c_) { nM = M / BM; nN = N / BM; nwg = nM * nN; G = G_; c = c_; }
    __host__ __device__ __forceinline__ bool next(int i, Unit& u) const {
        const long L = (long)i * G + c; if (L >= nwg) return false;
        int wgid = (int)L; { const int q = nwg / NXCD, r = nwg % NXCD, xcd = wgid % NXCD, off = wgid / NXCD; wgid = (xcd < r ? xcd * (q + 1) : r * (q + 1) + (xcd - r) * q) + off; }
        const int nig = WGM * nN, gid = wgid / nig, fm = gid * WGM, gsz = (nM - fm) < WGM ? (nM - fm) : WGM;
        u.pm = fm + ((wgid % nig) % gsz); u.pn = (wgid % nig) / gsz; return true;
    }
    __device__ __forceinline__ void a_ready(const Unit&) const {}
    __device__ __forceinline__ void done(const Unit&) const {}
};

__device__ __forceinline__ unsigned cvt_pk_bf16(float lo, float hi) { unsigned r; asm volatile("v_cvt_pk_bf16_f32 %0, %1, %2" : "=v"(r) : "v"(lo), "v"(hi)); return r; }
constexpr float RMS_EPS = 1e-6f;
struct EpiBf16S {
    static constexpr bool PERM = true, AFTER_DRAIN = false;
    bf16_t* O; int ldc; const float* ssq;
    __device__ __forceinline__ void operator()(const f32x4 (&acc)[2][2][4][2], const Unit& u, int wr, int wc, int fr, int fq) const {
        const int row0 = u.pm * BM + wr * 64 + fr; const int col0 = u.pn * BM + wc * 32 + 8 * fq;
#pragma unroll
        for (int ai = 0; ai < 2; ++ai)
#pragma unroll
            for (int m = 0; m < 4; ++m) { const int row = row0 + ai * HALF + m * 16; bf16_t* rowp = O + (size_t)row * ldc + col0;
                const float sc = ssq ? rsqrtf(ssq[row] * (1.0f / 1024.0f) + RMS_EPS) : 1.0f;
#pragma unroll
                for (int bj = 0; bj < 2; ++bj) { const f32x4 v0 = acc[ai][bj][m][0] * sc, v1 = acc[ai][bj][m][1] * sc;
                    u32x4 w; w.x = cvt_pk_bf16(v0[0], v0[1]); w.y = cvt_pk_bf16(v0[2], v0[3]); w.z = cvt_pk_bf16(v1[0], v1[1]); w.w = cvt_pk_bf16(v1[2], v1[3]);
                    *(u32x4*)(rowp + bj * HALF) = w; } }
    }
};
struct EpiResid {
    static constexpr bool PERM = false, AFTER_DRAIN = false;
    const float* base; float* out; bf16_t* xb; float* ssq; int ldc;
    __device__ __forceinline__ void operator()(const f32x4 (&acc)[2][2][4][2], const Unit& u, int wr, int wc, int fr, int fq) const {
        typedef unsigned u32x2v __attribute__((ext_vector_type(2)));
        const int col0 = u.pn * BM + wc * 32 + 4 * fq;
#pragma unroll
        for (int ai = 0; ai < 2; ++ai) {
            f32x4 bv[4][2][2];
#pragma unroll
            for (int m = 0; m < 4; ++m) { const size_t off = (size_t)(u.pm * BM + ai * HALF + wr * 64 + m * 16 + fr) * ldc + col0;
#pragma unroll
                for (int bj = 0; bj < 2; ++bj)
#pragma unroll
                    for (int n = 0; n < 2; ++n) bv[m][bj][n] = *(const f32x4*)(base + off + bj * HALF + n * 16); }
#pragma unroll
            for (int m = 0; m < 4; ++m) { const int row = u.pm * BM + ai * HALF + wr * 64 + m * 16 + fr; const size_t off = (size_t)row * ldc + col0; float s = 0.f;
#pragma unroll
                for (int bj = 0; bj < 2; ++bj)
#pragma unroll
                    for (int n = 0; n < 2; ++n) { const f32x4 v = acc[ai][bj][m][n] + bv[m][bj][n];
                        if (out) *(f32x4*)(out + off + bj * HALF + n * 16) = v; s += (v[0] * v[0] + v[1] * v[1]) + (v[2] * v[2] + v[3] * v[3]);
                        if (xb) { u32x2v w; w.x = cvt_pk_bf16(v[0], v[1]); w.y = cvt_pk_bf16(v[2], v[3]); *(u32x2v*)(xb + off + bj * HALF + n * 16) = w; } }
                if (ssq) { s += __shfl_xor(s, 16); s += __shfl_xor(s, 32); if (fq == 0) atomicAdd(ssq + row, s); } }
            asm volatile("" ::: "memory");
        }
    }
};

__device__ __forceinline__ float dpp_ror1(float v) { return __builtin_bit_cast(float, __builtin_amdgcn_update_dpp(0, __builtin_bit_cast(int, v), 0x121, 0xf, 0xf, false)); }
__device__ __forceinline__ float dpp_ror2(float v) { return __builtin_bit_cast(float, __builtin_amdgcn_update_dpp(0, __builtin_bit_cast(int, v), 0x122, 0xf, 0xf, false)); }
struct EpiConvGate {
    static constexpr bool PERM = true, AFTER_DRAIN = false;
    static constexpr size_t CG_SSQ = (1u << 20) + 768 * 1024, CG_ACT = (size_t)148 << 20, CG_YH = (size_t)236 << 20, CG_UPART = (size_t)240 << 20;
    unsigned char* ws; const float* fw; PG8_LAS unsigned char* ldsb;
    __device__ __forceinline__ void operator()(f32x4 (&acc)[2][2][4][2], const Unit& u, int wr, int wc, int fr0, int fq0) const {
        int fr = fr0, fq = fq0; asm volatile("" : "+v"(fr), "+v"(fq));
        bf16_t* ACT = (bf16_t*)(ws + CG_ACT); const float* ssq = (const float*)(ws + CG_SSQ); float* YH = (float*)(ws + CG_YH); float* UPART = (float*)(ws + CG_UPART);
        PG8_LAS float* halo = (PG8_LAS float*)(ldsb + STAGE_BYTES);
        int cl = wc * 32 + 8 * fq;
        int ch = u.pn * 128 + cl;
        if (fr >= 14) {
#pragma unroll
            for (int ai = 0; ai < 2; ++ai) { const float sc = rsqrtf(ssq[u.pm * BM + ai * HALF + wr * 64 + 48 + fr] * (1.0f / 1024.0f) + RMS_EPS);
#pragma unroll
                for (int bj = 0; bj < 2; ++bj)
#pragma unroll
                    for (int n = 0; n < 2; ++n) { const f32x4 v = acc[ai][bj][3][n] * sc; *(PG8_LAS f32x4*)(halo + (((wr * 2 + ai) * 2 + (fr - 14)) * 256 + bj * 128 + cl + 4 * n)) = v;
                        if (ai == 1 && wr == 1) *(f32x4*)(YH + ((size_t)(u.pm * 22 + u.pn) * 2 + (fr - 14)) * 256 + bj * 128 + cl + 4 * n) = v; } }
        }
        asm volatile("s_waitcnt lgkmcnt(0)" ::: "memory"); __builtin_amdgcn_s_barrier(); asm volatile("" ::: "memory");
        typedef unsigned u32x2v __attribute__((ext_vector_type(2)));
#pragma unroll 1
        for (int n = 0; n < 2; ++n) {
            asm volatile("" : "+v"(fr), "+v"(fq));
            cl = wc * 32 + 8 * fq; ch = u.pn * 128 + cl;
            f32x4 w[3][2];
#pragma unroll
            for (int i = 0; i < 3; ++i)
#pragma unroll
                for (int bj = 0; bj < 2; ++bj) w[i][bj] = *(const f32x4*)(fw + (size_t)i * 5632 + bj * 2816 + ch + 4 * n);
#pragma unroll
            for (int ai = 0; ai < 2; ++ai) {
                const bool top = (ai == 0 && wr == 0);
                const int pblk = (ai == 0) ? 0 : (wr == 0 ? 2 : 1);
                f32x4 q1[2], q2[2];
#pragma unroll
                for (int bj = 0; bj < 2; ++bj) { const f32x4 pv = top ? (f32x4){0.f, 0.f, 0.f, 0.f} : *(const PG8_LAS f32x4*)(halo + ((pblk * 2 + (fr & 1)) * 256 + bj * 128 + cl + 4 * n));
#pragma unroll
                    for (int k = 0; k < 4; ++k) { q1[bj][k] = dpp_ror1(pv[k]); q2[bj][k] = dpp_ror2(pv[k]); } }
#pragma unroll
                for (int m = 0; m < 4; ++m) {
                    const int row = u.pm * BM + ai * HALF + wr * 64 + m * 16 + fr; const float sc = rsqrtf(ssq[row] * (1.0f / 1024.0f) + RMS_EPS);
                    f32x4 cu[2];
#pragma unroll
                    for (int bj = 0; bj < 2; ++bj) { const f32x4 ya = (n == 0) ? acc[ai][bj][m][0] : acc[ai][bj][m][1];
#pragma unroll
                        for (int k = 0; k < 4; ++k) { const float y = ya[k] * sc;
                            const float a1 = dpp_ror1(y), a2 = dpp_ror2(y);
                            const float p1 = (fr == 0) ? q1[bj][k] : a1, p2 = (fr < 2) ? q2[bj][k] : a2;
                            cu[bj][k] = w[2][bj][k] * y + w[1][bj][k] * p1 + w[0][bj][k] * p2; q1[bj][k] = a1; q2[bj][k] = a2; } }
                    if (top && m == 0 && fr < 2 && (u.pm & 7) != 0) {
#pragma unroll
                        for (int bj = 0; bj < 2; ++bj) *(f32x4*)(UPART + ((size_t)(u.pm * 22 + u.pn) * 2 + fr) * 256 + bj * 128 + cl + 4 * n) = cu[bj];
                    }
                    u32x2v o;
#define PG8_SG(k_) (cu[0][k_] * __builtin_amdgcn_rcpf(1.0f + __expf(-cu[0][k_])) * cu[1][k_])
                    o.x = cvt_pk_bf16(PG8_SG(0), PG8_SG(1)); o.y = cvt_pk_bf16(PG8_SG(2), PG8_SG(3));
#undef PG8_SG
                    *(u32x2v*)(ACT + (size_t)row * 2816 + ch + 4 * n) = o;
                    asm volatile("" ::: "memory");
                }
            }
        }
        asm volatile("s_waitcnt lgkmcnt(0)" ::: "memory"); __builtin_amdgcn_s_barrier(); asm volatile("" ::: "memory");
    }
};

struct EpiResidNorm {
    static constexpr bool PERM = false, AFTER_DRAIN = false;
    const bf16_t* base; float* out; float* ssq2; unsigned* cnt; const float* fnw; int ldc;
    __device__ __forceinline__ void operator()(f32x4 (&acc)[2][2][4][2], const Unit& u, int wr, int wc, int fr, int fq) const {
        typedef unsigned u32x2v __attribute__((ext_vector_type(2)));
        const int col0 = u.pn * BM + wc * 32 + 4 * fq;
#pragma unroll
        for (int ai = 0; ai < 2; ++ai) {
            u32x2v bv[4][2][2];
#pragma unroll
            for (int m = 0; m < 4; ++m) { const size_t off = (size_t)(u.pm * BM + ai * HALF + wr * 64 + m * 16 + fr) * ldc + col0;
#pragma unroll
                for (int bj = 0; bj < 2; ++bj)
#pragma unroll
                    for (int n = 0; n < 2; ++n) bv[m][bj][n] = *(const u32x2v*)(base + off + bj * HALF + n * 16); }
#pragma unroll
            for (int m = 0; m < 4; ++m) { const int row = u.pm * BM + ai * HALF + wr * 64 + m * 16 + fr; float s = 0.f;
#pragma unroll
                for (int bj = 0; bj < 2; ++bj)
#pragma unroll
                    for (int n = 0; n < 2; ++n) { const u32x2v bw = bv[m][bj][n]; const f32x4 v = acc[ai][bj][m][n] + (f32x4){__uint_as_float(bw.x << 16), __uint_as_float(bw.x & 0xffff0000u), __uint_as_float(bw.y << 16), __uint_as_float(bw.y & 0xffff0000u)}; acc[ai][bj][m][n] = v; s += (v[0] * v[0] + v[1] * v[1]) + (v[2] * v[2] + v[3] * v[3]); }
                s += __shfl_xor(s, 16); s += __shfl_xor(s, 32);
                if (fq == 0) (void)__hip_atomic_fetch_add(ssq2 + row, s, __ATOMIC_RELAXED, __HIP_MEMORY_SCOPE_AGENT); }
            asm volatile("" ::: "memory");
        }
        asm volatile("s_waitcnt vmcnt(0)" ::: "memory"); __builtin_amdgcn_s_barrier(); asm volatile("" ::: "memory");
        if (wr == 0 && wc == 0 && fr == 0 && fq == 0) {
            __builtin_amdgcn_fence(__ATOMIC_RELEASE, "agent"); asm volatile("s_waitcnt vmcnt(0)" ::: "memory");
            (void)__hip_atomic_fetch_add(cnt + 16 * u.pm, 1u, __ATOMIC_RELAXED, __HIP_MEMORY_SCOPE_AGENT);
            unsigned sp = 0;
            while (__hip_atomic_load(cnt + 16 * u.pm, __ATOMIC_RELAXED, __HIP_MEMORY_SCOPE_AGENT) < 4u) { __builtin_amdgcn_s_sleep(1); if (++sp > (1u << 22)) break; }
            __builtin_amdgcn_fence(__ATOMIC_ACQUIRE, "agent"); asm volatile("s_waitcnt vmcnt(0)" ::: "memory");
        }
        __builtin_amdgcn_s_barrier(); asm volatile("" ::: "memory");
        f32x4 nw[2][2];
#pragma unroll
        for (int bj = 0; bj < 2; ++bj)
#pragma unroll
            for (int n = 0; n < 2; ++n) nw[bj][n] = *(const f32x4*)(fnw + col0 + bj * HALF + n * 16);
#pragma unroll
        for (int ai = 0; ai < 2; ++ai)
#pragma unroll
            for (int m = 0; m < 4; ++m) { const int row = u.pm * BM + ai * HALF + wr * 64 + m * 16 + fr; const size_t off = (size_t)row * ldc + col0;
                const float rstd = rsqrtf(__hip_atomic_load(ssq2 + row, __ATOMIC_RELAXED, __HIP_MEMORY_SCOPE_AGENT) * (1.0f / 1024.0f) + RMS_EPS);
#pragma unroll
                for (int bj = 0; bj < 2; ++bj)
#pragma unroll
                    for (int n = 0; n < 2; ++n) { const f32x4 v = acc[ai][bj][m][n]; *(f32x4*)(out + off + bj * HALF + n * 16) = (f32x4){v[0] * rstd * nw[bj][n][0], v[1] * rstd * nw[bj][n][1], v[2] * rstd * nw[bj][n][2], v[3] * rstd * nw[bj][n][3]}; } }
    }
};
template <class Epi, class Sched, bool ALIGN_EPI = false, bool SP2 = false>
__device__ __forceinline__ void gemm_phase(PG8_LAS unsigned char* lds, const Gemm g, const Sched& S, const Epi& E) {
    const int tid = threadIdx.x, wid = __builtin_amdgcn_readfirstlane(tid >> 6), lane = tid & 63, wr = wid >> 2, wc = wid & 3, fr = lane & 15, fq = lane >> 4;
    const int K = g.K, nt = K / BK;
    unsigned voffA[2], voffB[2];
#pragma unroll
    for (int i = 0; i < 2; ++i) { int R, C; stage_rc(tid * 16 + i * 8192, R, C); const int Rb = Epi::PERM ? ((R & ~31) + perm32(R & 31)) : R;
        voffA[i] = (unsigned)(R * K + C) * 2u; voffB[i] = (unsigned)(Rb * K + C) * 2u; }
    const size_t kstep = (size_t)(BK * 2);
    const size_t hstep = (size_t)HALF * K * 2;
    const size_t tstep = 2 * hstep;
    const unsigned ldsw = (unsigned)wid * 1024u;
    const int aoff = lds_byte(wr * 64 + fr, fq * 8), boff = lds_byte(wc * 32 + fr, fq * 8);
#define PG8_SA(b, h) (((b) * 2 + (h)) * HTB)
#define PG8_SB(b, h) ((4 + (b) * 2 + (h)) * HTB)
#define PG8_STAGE(bufoff, gbase, voff) do { _Pragma("unroll") for (int _i = 0; _i < 2; ++_i) \
        __builtin_amdgcn_global_load_lds((const unsigned*)((const char*)(gbase) + (voff)[_i]), (PG8_LAS unsigned*)(lds + (bufoff) + ldsw + _i * 8192), 16, 0, 0); } while (0)
#define PG8_LDA(dst, b, h) do { _Pragma("unroll") for (int m = 0; m < 4; ++m) _Pragma("unroll") for (int k = 0; k < 2; ++k) dst[m][k] = *(const PG8_LAS bf16x8*)(lds + PG8_SA(b, h) + aoff + m * 2048 + k * 1024); } while (0)
#define PG8_LDB(dst, b, h) do { _Pragma("unroll") for (int n = 0; n < 2; ++n) _Pragma("unroll") for (int k = 0; k < 2; ++k) dst[n][k] = *(const PG8_LAS bf16x8*)(lds + PG8_SB(b, h) + boff + n * 2048 + k * 1024); } while (0)
#define PG8_MMA(ai, bj, At, Bt) do { __builtin_amdgcn_s_setprio(1); _Pragma("unroll") for (int m = 0; m < 4; ++m) _Pragma("unroll") for (int n = 0; n < 2; ++n) _Pragma("unroll") for (int k = 0; k < 2; ++k) \
        acc[ai][bj][m][n] = __builtin_amdgcn_mfma_f32_16x16x32_bf16(Bt[n][k], At[m][k], acc[ai][bj][m][n], 0, 0, 0); __builtin_amdgcn_s_setprio(0); } while (0)
#define PG8_WAIT_V(n) asm volatile("s_waitcnt vmcnt(" #n ")" ::: "memory")
#define PG8_WAIT_L(n) asm volatile("s_waitcnt lgkmcnt(" #n ")" ::: "memory")
#define PG8_BAR __builtin_amdgcn_s_barrier()
#define PG8_SCHED __builtin_amdgcn_sched_barrier(0)
    Unit cur, nxt; int ui = 0;
    if (!S.next(0, cur)) return;
    f32x4 acc[2][2][4][2];
#pragma unroll
    for (int a = 0; a < 2; ++a)
#pragma unroll
        for (int b = 0; b < 2; ++b)
#pragma unroll
            for (int m = 0; m < 4; ++m)
#pragma unroll
                for (int n = 0; n < 2; ++n) acc[a][b][m][n] = (f32x4){0.f, 0.f, 0.f, 0.f};
    bf16x8 At[4][2], B0[2][2], B1[2][2];
    const char* cA = (const char*)g.A + (size_t)cur.pm * tstep; const char* cB = (const char*)g.Bt + (size_t)cur.pn * tstep;
    S.a_ready(cur);
    if constexpr (SP2) {
        PG8_STAGE(PG8_SB(0, 0), cB, voffB); PG8_STAGE(PG8_SB(0, 1), cB + hstep, voffB); PG8_STAGE(PG8_SA(0, 0), cA, voffA); PG8_STAGE(PG8_SA(0, 1), cA + hstep, voffA);
        if (wr == 1) PG8_BAR;
        PG8_WAIT_V(2); PG8_BAR;
        PG8_STAGE(PG8_SB(1, 0), cB + kstep, voffB); PG8_STAGE(PG8_SA(1, 0), cA + kstep, voffA); PG8_STAGE(PG8_SB(1, 1), cB + hstep + kstep, voffB);
        PG8_WAIT_V(6); PG8_BAR;
    } else {
        PG8_STAGE(PG8_SB(0, 0), cB, voffB); PG8_STAGE(PG8_SA(0, 0), cA, voffA); PG8_STAGE(PG8_SB(0, 1), cB + hstep, voffB); PG8_STAGE(PG8_SA(0, 1), cA + hstep, voffA);
        if (wr == 1) PG8_BAR;
        PG8_WAIT_V(4); PG8_BAR;
        PG8_STAGE(PG8_SB(1, 0), cB + kstep, voffB); PG8_STAGE(PG8_SA(1, 0), cA + kstep, voffA); PG8_STAGE(PG8_SB(1, 1), cB + hstep + kstep, voffB);
        PG8_WAIT_V(6); PG8_BAR;
    }
    for (;;) {
        const bool has_next = S.next(ui + 1, nxt);
        const char* nA = has_next ? (const char*)g.A + (size_t)nxt.pm * tstep : cA; const char* nB = has_next ? (const char*)g.Bt + (size_t)nxt.pn * tstep : cB;
        for (int t = 0; t < nt; t += 2) {
            const bool last = (t == nt - 2);
            const char* a1 = cA + (size_t)(t + 1) * kstep;
            const char* a2 = last ? nA : cA + (size_t)(t + 2) * kstep; const char* b2 = last ? nB : cB + (size_t)(t + 2) * kstep;
            const char* a3 = a2 + kstep; const char* b3 = b2 + kstep;
            if (last && has_next) S.a_ready(nxt);
            if constexpr (SP2) {
            PG8_LDB(B0, 0, 0); PG8_LDB(B1, 0, 1); PG8_SCHED; PG8_LDA(At, 0, 0); PG8_STAGE(PG8_SA(1, 1), a1 + hstep, voffA);
            PG8_WAIT_V(8); PG8_WAIT_L(0); PG8_BAR; PG8_MMA(0, 0, At, B0); PG8_MMA(0, 1, At, B1); PG8_BAR; PG8_SCHED;
            PG8_LDA(At, 0, 1); PG8_STAGE(PG8_SB(0, 0), b2, voffB); PG8_STAGE(PG8_SB(0, 1), b2 + hstep, voffB); PG8_STAGE(PG8_SA(0, 0), a2, voffA);
            PG8_WAIT_V(8); PG8_WAIT_L(0); PG8_BAR; PG8_MMA(1, 0, At, B0); PG8_MMA(1, 1, At, B1); PG8_BAR; PG8_SCHED;
            PG8_LDB(B0, 1, 0); PG8_LDB(B1, 1, 1); PG8_SCHED; PG8_LDA(At, 1, 0); PG8_STAGE(PG8_SA(0, 1), a2 + hstep, voffA);
            PG8_WAIT_V(8); PG8_WAIT_L(0); PG8_BAR; PG8_MMA(0, 0, At, B0); PG8_MMA(0, 1, At, B1); PG8_BAR; PG8_SCHED;
            PG8_LDA(At, 1, 1); PG8_STAGE(PG8_SB(1, 0), b3, voffB); PG8_STAGE(PG8_SB(1, 1), b3 + hstep, voffB); PG8_STAGE(PG8_SA(1, 0), a3, voffA);
            PG8_WAIT_V(8); PG8_WAIT_L(0); PG8_BAR; PG8_MMA(1, 0, At, B0); PG8_MMA(1, 1, At, B1); PG8_BAR; PG8_SCHED;
            } else {
            PG8_LDB(B0, 0, 0); PG8_SCHED; PG8_LDA(At, 0, 0); PG8_STAGE(PG8_SA(1, 1), a1 + hstep, voffA);
            PG8_WAIT_L(8); PG8_BAR; PG8_WAIT_L(0); PG8_MMA(0, 0, At, B0); PG8_BAR; PG8_SCHED;
            PG8_LDB(B1, 0, 1); PG8_STAGE(PG8_SB(0, 0), b2, voffB);
            PG8_BAR; PG8_WAIT_L(0); PG8_MMA(0, 1, At, B1); PG8_BAR;
            PG8_LDA(At, 0, 1); PG8_STAGE(PG8_SA(0, 0), a2, voffA);
            PG8_BAR; PG8_WAIT_L(0); PG8_MMA(1, 0, At, B0); PG8_BAR; PG8_SCHED;
            PG8_STAGE(PG8_SB(0, 1), b2 + hstep, voffB);
            PG8_WAIT_V(6); PG8_BAR; PG8_MMA(1, 1, At, B1); PG8_BAR;
            PG8_LDB(B0, 1, 0); PG8_SCHED; PG8_LDA(At, 1, 0); PG8_STAGE(PG8_SA(0, 1), a2 + hstep, voffA);
            PG8_WAIT_L(8); PG8_BAR; PG8_WAIT_L(0); PG8_MMA(0, 0, At, B0); PG8_BAR; PG8_SCHED;
            PG8_LDB(B1, 1, 1); PG8_STAGE(PG8_SB(1, 0), b3, voffB);
            PG8_BAR; PG8_WAIT_L(0); PG8_MMA(0, 1, At, B1); PG8_BAR;
            PG8_LDA(At, 1, 1); PG8_STAGE(PG8_SA(1, 0), a3, voffA);
            PG8_BAR; PG8_WAIT_L(0); PG8_MMA(1, 0, At, B0); PG8_BAR; PG8_SCHED;
            PG8_STAGE(PG8_SB(1, 1), b3 + hstep, voffB);
            PG8_WAIT_V(6); PG8_BAR; PG8_MMA(1, 1, At, B1); PG8_BAR;
            }
        }
        if constexpr (ALIGN_EPI) { if (wr == 0) PG8_BAR; }
        if constexpr (!Epi::AFTER_DRAIN) { E(acc, cur, wr, wc, fr, fq); S.done(cur); }
        if (!has_next) break;
#pragma unroll
        for (int a = 0; a < 2; ++a)
#pragma unroll
            for (int b = 0; b < 2; ++b)
#pragma unroll
                for (int m = 0; m < 4; ++m)
#pragma unroll
                    for (int n = 0; n < 2; ++n) acc[a][b][m][n] = (f32x4){0.f, 0.f, 0.f, 0.f};
        cur = nxt; cA = nA; cB = nB; ++ui;
        if constexpr (ALIGN_EPI) { if (wr == 1) PG8_BAR; }
    }
    PG8_WAIT_V(0);
    if constexpr (!ALIGN_EPI) { if (wr == 0) PG8_BAR; }
    PG8_BAR;
    if constexpr (Epi::AFTER_DRAIN) { E.fused(acc, cur, wr, wc, fr, fq, lds, wid, lane); S.done(cur); }
#undef PG8_SA
#undef PG8_SB
#undef PG8_STAGE
#undef PG8_LDA
#undef PG8_LDB
#undef PG8_MMA
#undef PG8_WAIT_V
#undef PG8_WAIT_L
#undef PG8_BAR
#undef PG8_SCHED
}
}
#ifndef PG8_SP2
#define PG8_SP2 true
#endif
#ifndef PG8_ALIGN
#define PG8_ALIGN true
#endif
constexpr int NB = 8, SEQ = 2048, DM = 1024, M = NB * SEQ;
constexpr int GH = 4, GD = 128, GW = 512, AH = 8, AD = 64;
constexpr int INC = 3592, NP = 3584;
constexpr int DFF = 2816, NUP = 2 * DFF;
constexpr int PC_QA = 0, PC_KA = 512, PC_VA = 1024, PC_Z = 1536, PC_QB = 2048, PC_KB = 2560, PC_VB = 3072;
constexpr size_t MiB = 1u << 20;
constexpr size_t WS_CTL = 0, WS_AB = 1 * MiB, WS_SSQ = 1 * MiB + 768 * 1024, WS_WIN = 2 * MiB, WS_WOUT = 9 * MiB, WS_WUP = 11 * MiB, WS_WDN = 22 * MiB;
constexpr size_t WS_XN = 28 * MiB, WS_PROJ = 60 * MiB, WS_CAT = 172 * MiB, WS_OA = 204 * MiB, WS_Y = 60 * MiB, WS_ACT = 148 * MiB, WS_END = 256 * MiB;
using pg8::RMS_EPS;
constexpr size_t WS_YH = 236 * MiB, WS_UPART = 240 * MiB;
constexpr size_t WS_SSQ2 = WS_SSQ + 131072;
constexpr size_t WS_GE = WS_SSQ + 65536;
constexpr int GOPS_CHUNK = 57344;
constexpr int SCAN_BUF = GOPS_CHUNK + 16384;
constexpr int NWAVES = 8, NTHR = 512;
constexpr int LDS_BYTES = 155648;
#define LAS __attribute__((address_space(3)))
typedef unsigned short bf16;
typedef unsigned v4u __attribute__((ext_vector_type(4)));
typedef unsigned v2u __attribute__((ext_vector_type(2)));
typedef float f32x4 __attribute__((ext_vector_type(4)));
__device__ __forceinline__ float bf2f(unsigned b) { return __uint_as_float(b << 16); }
__device__ __forceinline__ float bflo(unsigned w) { return __uint_as_float(w << 16); }
__device__ __forceinline__ float bfhi(unsigned w) { return __uint_as_float(w & 0xffff0000u); }
__device__ __forceinline__ unsigned pk2(float lo, float hi) { return pg8::cvt_pk_bf16(lo, hi); }
__device__ __forceinline__ float wave_sum(float v) {
#pragma unroll
    for (int o = 1; o < 64; o <<= 1) v += __shfl_xor(v, o);
    return v;
}
__device__ __forceinline__ float silu_f(float x) { return x * __builtin_amdgcn_rcpf(1.0f + __expf(-x)); }
__device__ __forceinline__ float sigmoid_f(float x) { return __builtin_amdgcn_rcpf(1.0f + __expf(-x)); }
__device__ __forceinline__ float softplus_f(float x) { return x > 20.f ? x : log1pf(__expf(x)); }

struct Args { const float* in[13]; float* out; unsigned char* ws; int ph_lo, ph_hi, coop, pad; };

__device__ __forceinline__ void p0_transpose_item(const float* W, int ldw, int k0, int sn0, bf16* WT, int K, int dn0, const float* kscale, LAS float* scr, int lane) {
    float tv[32];
#pragma unroll
    for (int i = 0; i < 32; ++i) { const int kk = 2 * i + (lane >> 5); tv[i] = W[(size_t)(k0 + kk) * ldw + sn0 + (lane & 31)]; }
    if (kscale) {
#pragma unroll
        for (int i = 0; i < 32; ++i) tv[i] *= kscale[k0 + 2 * i + (lane >> 5)]; }
#pragma unroll
    for (int i = 0; i < 32; ++i) scr[(2 * i + (lane >> 5)) * 33 + (lane & 31)] = tv[i];
    asm volatile("s_waitcnt lgkmcnt(0)" ::: "memory");
    const int c = lane & 7;
#pragma unroll
    for (int j = 0; j < 4; ++j) { const int n = (lane >> 3) + 8 * j; const LAS float* s = scr + (8 * c) * 33 + n;
        v4u o; o.x = pk2(s[0 * 33], s[1 * 33]); o.y = pk2(s[2 * 33], s[3 * 33]); o.z = pk2(s[4 * 33], s[5 * 33]); o.w = pk2(s[6 * 33], s[7 * 33]);
        *(v4u*)(WT + (size_t)(dn0 + n) * K + k0 + 8 * c) = o; }
    asm volatile("s_waitcnt lgkmcnt(0)" ::: "memory");
}

__device__ __forceinline__ void p0_prologue(const Args& A, LAS unsigned char* lds, int tid, int lane, int wave) {
    const float* x = A.in[0]; const float* nw1 = A.in[1]; const float* w_in = A.in[2]; const float* w_out = A.in[7]; const float* nw2 = A.in[8];
    const float* w_up = A.in[9]; const float* w_dn = A.in[11];
    unsigned char* ws = A.ws;
    bf16* WIN = (bf16*)(ws + WS_WIN); bf16* WOUT = (bf16*)(ws + WS_WOUT); bf16* WUP = (bf16*)(ws + WS_WUP); bf16* WDN = (bf16*)(ws + WS_WDN);
    bf16* XN = (bf16*)(ws + WS_XN); float* AB = (float*)(ws + WS_AB); float* SSQ = (float*)(ws + WS_SSQ);
    LAS float* scr = (LAS float*)(lds + wave * 9216);
    LAS float* wab = (LAS float*)(lds + 73728);
    const int G = gridDim.x, gw = blockIdx.x * NWAVES + wave, NGW = G * NWAVES;
    for (int i = blockIdx.x * NTHR + tid; i < M; i += G * NTHR) { SSQ[i] = 0.f; ((float*)(ws + WS_SSQ2))[i] = 0.f; }
    if (blockIdx.x == 0 && tid < 64) ((unsigned*)(ws + WS_CTL))[tid] = 0u;
    for (int idx = tid; idx < 8192; idx += NTHR) { const int k = idx >> 3, j = idx & 7; wab[j * 1024 + k] = nw1[k] * w_in[(size_t)k * INC + 2048 + j]; }
    constexpr int I_IN = 16 * (NP / 32);
    for (int it = gw; it < I_IN; it += NGW) { const int nblk = NP / 32, kb = it / nblk, nb = it % nblk, n0 = 32 * nb; p0_transpose_item(w_in, INC, 64 * kb, n0 + (n0 >= 2048 ? 8 : 0), WIN, DM, n0, nullptr, scr, lane); }
    __syncthreads();
    for (int m0 = gw; m0 < M; m0 += 2 * NGW) {
        const f32x4* nr = (const f32x4*)nw1 + lane;
        f32x4 v[2][4]; float s[2] = {0.f, 0.f};
#pragma unroll
        for (int rr = 0; rr < 2; ++rr) { const int m = min(m0 + rr * NGW, M - 1); const f32x4* xr = (const f32x4*)(x + (size_t)m * DM) + lane;
#pragma unroll
            for (int j = 0; j < 4; ++j) v[rr][j] = xr[64 * j]; }
#pragma unroll
        for (int rr = 0; rr < 2; ++rr)
#pragma unroll
            for (int j = 0; j < 4; ++j) s[rr] += (v[rr][j].x * v[rr][j].x + v[rr][j].y * v[rr][j].y) + (v[rr][j].z * v[rr][j].z + v[rr][j].w * v[rr][j].w);
#pragma unroll
        for (int rr = 0; rr < 2; ++rr) { const int m = m0 + rr * NGW; if (m >= M) break;
            const float rstd = rsqrtf(wave_sum(s[rr]) * (1.f / DM) + RMS_EPS);
            float ab[8];
#pragma unroll
            for (int q = 0; q < 8; ++q) { float a = 0.f;
#pragma unroll
                for (int j = 0; j < 4; ++j) { const f32x4 w = *(const LAS f32x4*)(wab + q * 1024 + 256 * j + 4 * lane); a += (v[rr][j].x * w.x + v[rr][j].y * w.y) + (v[rr][j].z * w.z + v[rr][j].w * w.w); }
                ab[q] = wave_sum(a) * rstd; }
            if (lane == 0) { *(f32x4*)(AB + (size_t)m * 8) = (f32x4){ab[0], ab[1], ab[2], ab[3]}; *(f32x4*)(AB + (size_t)m * 8 + 4) = (f32x4){ab[4], ab[5], ab[6], ab[7]}; }
            v2u* o8 = (v2u*)(XN + (size_t)m * DM) + lane;
#pragma unroll
            for (int j = 0; j < 4; ++j) { const f32x4 n = nr[64 * j]; v2u o; o.x = pk2(v[rr][j].x * rstd * n.x, v[rr][j].y * rstd * n.y); o.y = pk2(v[rr][j].z * rstd * n.z, v[rr][j].w * rstd * n.w); o8[64 * j] = o; }
        }
    }
}


__device__ __forceinline__ void convert_late_weights(const Args& A, LAS unsigned char* lds, int lane, int wave, int gw0, int ngw) {
    const float* w_out = A.in[7]; const float* nw2 = A.in[8]; const float* w_up = A.in[9]; const float* w_dn = A.in[11];
    bf16* WOUT = (bf16*)(A.ws + WS_WOUT); bf16* WUP = (bf16*)(A.ws + WS_WUP); bf16* WDN = (bf16*)(A.ws + WS_WDN);
    LAS float* scr = (LAS float*)(lds + wave * 9216);
    constexpr int I_OUT = 16 * 32, I_UP = 16 * (NUP / 32), I_DN = (DFF / 64) * 32;
    for (int it = gw0; it < I_OUT + I_UP + I_DN; it += ngw) {
        int r = it;
        if (r < I_OUT) { const int kb = r / 32, nb = r % 32; p0_transpose_item(w_out, DM, 64 * kb, 32 * nb, WOUT, DM, 32 * nb, nullptr, scr, lane); continue; } r -= I_OUT;
        if (r < I_UP) { const int nblk = NUP / 32, kb = r / nblk, nb = r % nblk, n0 = 32 * nb, pn = n0 >> 8, j0 = n0 & 255;
            const int s0 = (j0 < 128) ? (128 * pn + j0) : (DFF + 128 * pn + j0 - 128);
            p0_transpose_item(w_up, NUP, 64 * kb, s0, WUP, DM, n0, nw2, scr, lane); continue; } r -= I_UP;
        { const int kb = r / 32, nb = r % 32; p0_transpose_item(w_dn, DM, 64 * kb, 32 * nb, WDN, DFF, 32 * nb, nullptr, scr, lane); }
    }
}
__device__ __forceinline__ void gdn_simple(const Args& A, LAS unsigned char* lds, int tid, int lane, int wave) {
    const bf16* PROJ = (const bf16*)(A.ws + WS_PROJ); const float* AB = (const float*)(A.ws + WS_AB); float* OA = (float*)(A.ws + WS_OA);
    const float* cw = A.in[3]; const float* a_log = A.in[4]; const float* dt_bias = A.in[5];
    LAS float* qs = (LAS float*)lds; LAS float* ks = qs + 16 * 128; LAS float* vs = ks + 16 * 128; LAS float* av = vs + 16 * 128; LAS float* bv = av + 16;
    for (int task = blockIdx.x; task < NB * GH; task += gridDim.x) {
        const int b = task / GH, h = task % GH, v = tid >> 2, part = tid & 3;
        float S[32];
#pragma unroll
        for (int i = 0; i < 32; ++i) S[i] = 0.f;
        const float Ah = __expf(a_log[h]), dtb = dt_bias[h];
        for (int blk = 0; blk < SEQ / 16; ++blk) {
            const int t0 = blk * 16;
            for (int idx = tid; idx < 16 * 384; idx += NTHR) {
                const int tt = idx / 384, c = idx % 384, which = c >> 7, d = c & 127, col = which * 512 + h * 128 + d, t = t0 + tt;
                float acc = 0.f;
#pragma unroll
                for (int i = 0; i < 4; ++i) { const int ts = t - 3 + i; if (ts >= 0) acc += cw[i * 1536 + col] * bf2f(PROJ[(size_t)(b * SEQ + ts) * NP + col]); }
                qs[which * 2048 + tt * 128 + d] = silu_f(acc);
            }
            if (tid < 16) { const size_t row = (size_t)b * SEQ + t0 + tid; bv[tid] = sigmoid_f(AB[row * 8 + h]); av[tid] = __expf(-Ah * softplus_f(AB[row * 8 + 4 + h] + dtb)); }
            __syncthreads();
#pragma unroll
            for (int r = 0; r < 4; ++r) { const int row = 4 * wave + r; LAS float* arr = qs + row * 128;
                const float v0 = arr[lane], v1 = arr[lane + 64]; const float s = wave_sum(v0 * v0 + v1 * v1);
                const float sc = rsqrtf(s + RMS_EPS) * (row < 16 ? 0.08838834764831845f : 1.0f); arr[lane] = v0 * sc; arr[lane + 64] = v1 * sc; }
            __syncthreads();
            for (int tt = 0; tt < 16; ++tt) {
                const float a = av[tt], bt = bv[tt], vt = vs[tt * 128 + v];
                float kS = 0.f;
#pragma unroll
                for (int i = 0; i < 32; ++i) kS += ks[tt * 128 + 32 * part + i] * S[i];
                kS += __shfl_xor(kS, 1); kS += __shfl_xor(kS, 2);
                const float c = bt * (vt - a * kS); float o = 0.f;
#pragma unroll
                for (int i = 0; i < 32; ++i) { S[i] = a * S[i] + ks[tt * 128 + 32 * part + i] * c; o += qs[tt * 128 + 32 * part + i] * S[i]; }
                o += __shfl_xor(o, 1); o += __shfl_xor(o, 2);
                if (part == 0) OA[(size_t)(b * SEQ + t0 + tt) * GW + h * 128 + v] = o;
            }
            __syncthreads();
        }
    }
}


template <int J, int K, int N> struct SolveLd {
    static __device__ __forceinline__ void run(f32x4 (&l)[4], unsigned lbase) {
        if constexpr (K < N) { constexpr int t40 = ((J + 1) >> 2) << 2;
            asm volatile("ds_read_b128 %0, %1 offset:%2" : "=v"(l[K]) : "v"(lbase), "i"((J * 68 + t40 + 4 * K) * 4)); SolveLd<J, K + 1, N>::run(l, lbase); }
    }
};
template <int J> struct SolveCol16 {
    static __device__ __forceinline__ void run(float (&R)[16], unsigned lbase) {
        if constexpr (J < 15) {
            constexpr int t40 = ((J + 1) >> 2) << 2, nld = (16 - t40) >> 2;
            f32x4 l[4];
            SolveLd<J, 0, nld>::run(l, lbase);
            asm volatile("s_waitcnt lgkmcnt(0)" ::: "memory");
#pragma unroll
            for (int k = 0; k < nld; ++k) asm volatile("" : "+v"(l[k]));
#pragma unroll
            for (int k = 0; k < nld; ++k) {
#pragma unroll
                for (int e = 0; e < 4; ++e) if (t40 + 4 * k + e > J) R[t40 + 4 * k + e] += l[k][e] * R[J]; }
            SolveCol16<J + 1>::run(R, lbase);
        }
    }
};

typedef short bf16x8 __attribute__((ext_vector_type(8)));
__device__ __forceinline__ void gdn_prep(const Args& A, LAS unsigned char* lds, int tid0, int lane0, int wave) {
    const bf16* PROJ = (const bf16*)(A.ws + WS_PROJ); const float* AB = (const float*)(A.ws + WS_AB);
    const float* cw = A.in[3]; const float* a_log = A.in[4]; const float* dt_bias = A.in[5];
    unsigned char* UVF = A.ws + WS_XN; unsigned char* GOPS = (unsigned char*)A.out; float* GE = (float*)(A.ws + WS_GE);
    LAS float* Qs = (LAS float*)lds; LAS float* Ks = (LAS float*)(lds + 33792); LAS float* Vs = (LAS float*)(lds + 67584);
    LAS bf16* Qb = (LAS bf16*)(lds + 101376); LAS bf16* Kb = (LAS bf16*)(lds + 118784);
    LAS float* gcs = (LAS float*)(lds + 136192); LAS float* bts = gcs + 64; LAS float* egs = gcs + 128; LAS float* kes = gcs + 192;
    LAS float* LsT = (LAS float*)lds; LAS bf16* ATs = (LAS bf16*)(lds + 17408); LAS bf16* WKs = Kb;
    v4u rwn[11];
    if (tid0 < 384 && (int)blockIdx.x < NB * GH * 32) { const int c8 = tid0 % 48, run = tid0 / 48, which = c8 >> 4, d0 = (c8 & 15) * 8, t1 = blockIdx.x, bh1 = t1 >> 5, n1 = t1 & 31, b1 = bh1 >> 2, h1 = bh1 & 3, col1 = which * 512 + h1 * 128 + d0;
#pragma unroll
        for (int r = 0; r < 11; ++r) { const int ts = 64 * n1 + 8 * run - 3 + r; rwn[r] = (ts >= 0) ? *(const v4u*)(PROJ + (size_t)(b1 * SEQ + ts) * NP + col1) : (v4u){0u, 0u, 0u, 0u}; } }
    else {
#pragma unroll
        for (int r = 0; r < 11; ++r) rwn[r] = (v4u){0u, 0u, 0u, 0u}; }
#pragma unroll 1
    for (int task = blockIdx.x; task < NB * GH * 32; task += gridDim.x) {
        int tid = tid0, lane = lane0; asm volatile("" : "+v"(tid), "+v"(lane));
        const int fr = lane & 15, fq = lane >> 4;
        const int bh = task >> 5, n = task & 31, b = bh >> 2, h = bh & 3, t0 = 64 * n, row0 = b * SEQ + t0;
        unsigned char* gops = GOPS + (size_t)task * GOPS_CHUNK;
        if (tid < 384) {
            const int c8 = tid % 48, run = tid / 48, which = c8 >> 4, d0 = (c8 & 15) * 8, col = which * 512 + h * 128 + d0;
            v4u rw[11];
#pragma unroll
            for (int r = 0; r < 11; ++r) rw[r] = rwn[r];
            { const int tn = task + gridDim.x;
              if (tn < NB * GH * 32) { const int bhn = tn >> 5, nn = tn & 31, bn = bhn >> 2, hn = bhn & 3, coln = which * 512 + hn * 128 + d0;
#pragma unroll
                for (int r = 0; r < 11; ++r) { const int ts = 64 * nn + 8 * run - 3 + r; rwn[r] = (ts >= 0) ? *(const v4u*)(PROJ + (size_t)(bn * SEQ + ts) * NP + coln) : (v4u){0u, 0u, 0u, 0u}; } } }
            f32x4 cwa[4], cwb[4];
#pragma unroll
            for (int j = 0; j < 4; ++j) { cwa[j] = *(const f32x4*)(cw + j * 1536 + col); cwb[j] = *(const f32x4*)(cw + j * 1536 + col + 4); }
#pragma unroll
            for (int i = 0; i < 8; ++i) {
                float acc[8];
#pragma unroll
                for (int e2 = 0; e2 < 8; ++e2) acc[e2] = 0.f;
#pragma unroll
                for (int j = 0; j < 4; ++j) { const v4u w = rw[i + j];
                    acc[0] += cwa[j].x * bflo(w.x); acc[1] += cwa[j].y * bfhi(w.x); acc[2] += cwa[j].z * bflo(w.y); acc[3] += cwa[j].w * bfhi(w.y);
                    acc[4] += cwb[j].x * bflo(w.z); acc[5] += cwb[j].y * bfhi(w.z); acc[6] += cwb[j].z * bflo(w.w); acc[7] += cwb[j].w * bfhi(w.w); }
                float ss = 0.f;
#pragma unroll
                for (int e2 = 0; e2 < 8; ++e2) { acc[e2] = silu_f(acc[e2]); ss += acc[e2] * acc[e2]; }
                ss += __builtin_bit_cast(float, __builtin_amdgcn_update_dpp(0, __builtin_bit_cast(int, ss), 0xB1, 0xf, 0xf, false));
                ss += __builtin_bit_cast(float, __builtin_amdgcn_update_dpp(0, __builtin_bit_cast(int, ss), 0x4E, 0xf, 0xf, false));
                ss += __builtin_bit_cast(float, __builtin_amdgcn_update_dpp(0, __builtin_bit_cast(int, ss), 0x141, 0xf, 0xf, false));
                ss += __builtin_bit_cast(float, __builtin_amdgcn_update_dpp(0, __builtin_bit_cast(int, ss), 0x140, 0xf, 0xf, false));
                const int tt = 8 * run + i;
                if (which == 2) { *(LAS f32x4*)(Vs + tt * 132 + d0) = (f32x4){acc[0], acc[1], acc[2], acc[3]}; *(LAS f32x4*)(Vs + tt * 132 + d0 + 4) = (f32x4){acc[4], acc[5], acc[6], acc[7]}; }
                else {
                    const float sc = rsqrtf(ss + RMS_EPS) * (which == 0 ? 0.08838834764831845f : 1.0f);
#pragma unroll
                    for (int e2 = 0; e2 < 8; ++e2) acc[e2] *= sc;
                    const v4u pk = (v4u){pk2(acc[0], acc[1]), pk2(acc[2], acc[3]), pk2(acc[4], acc[5]), pk2(acc[6], acc[7])};
                    if (which == 0) *(LAS v4u*)(Qb + tt * 136 + d0) = pk;
                    else { *(LAS v4u*)(Kb + tt * 136 + d0) = pk; *(LAS f32x4*)(Ks + tt * 132 + d0) = (f32x4){acc[0], acc[1], acc[2], acc[3]}; *(LAS f32x4*)(Ks + tt * 132 + d0 + 4) = (f32x4){acc[4], acc[5], acc[6], acc[7]}; }
                }
            }
        }
        if (wave == 0) {
            const size_t row = (size_t)row0 + lane; const float beta = sigmoid_f(AB[row * 8 + h]);
            float g = -__expf(a_log[h]) * softplus_f(AB[row * 8 + 4 + h] + dt_bias[h]);
#pragma unroll
            for (int o = 1; o < 64; o <<= 1) { const float t = __shfl_up(g, o); if (lane >= o) g += t; }
            const float glast = __shfl(g, 63);
            gcs[lane] = g; bts[lane] = beta; egs[lane] = __expf(g); kes[lane] = __expf(glast - g) * beta;
            if (lane == 63) GE[task] = __expf(g);
        }
        __syncthreads();
#pragma unroll 1
        for (int jb = wave; jb < 20; jb += 8) {
            const int kind = jb >= 10 ? 1 : 0, idx = jb - 10 * kind, ti = idx < 1 ? 0 : (idx < 3 ? 1 : (idx < 6 ? 2 : 3)), tj = idx - ti * (ti + 1) / 2;
            const LAS bf16* As = kind ? Qb : Kb; f32x4 d = (f32x4){0.f, 0.f, 0.f, 0.f};
#pragma unroll
            for (int ks = 0; ks < 4; ++ks) { const bf16x8 a = *(const LAS bf16x8*)(As + (16 * ti + fr) * 136 + 32 * ks + 8 * fq), bb = *(const LAS bf16x8*)(Kb + (16 * tj + fr) * 136 + 32 * ks + 8 * fq);
                d = __builtin_amdgcn_mfma_f32_16x16x32_bf16(a, bb, d, 0, 0, 0); }
            const int j = 16 * tj + fr; const float gj = gcs[j], bj = bts[j]; float val[4];
#pragma unroll
            for (int e = 0; e < 4; ++e) { const int t = 16 * ti + 4 * fq + e; const float x = d[e] * __expf(gcs[t] - gj) * bj; val[e] = (kind ? (t >= j) : (t > j)) ? x : 0.f; }
            if (kind == 0) *(LAS f32x4*)(LsT + j * 68 + 16 * ti + 4 * fq) = (f32x4){-val[0], -val[1], -val[2], -val[3]};
            else {
#pragma unroll
                for (int e = 0; e < 4; ++e) ATs[(16 * ti + 4 * fq + e) * 72 + j] = (bf16)(pk2(val[e], 0.f) & 0xffffu); }
        }
        __syncthreads();
        LAS float* Ti = (LAS float*)(lds + 26624);
        if (wave == 0) {
            const int I = lane >> 4, c = lane & 15; float x[16];
#pragma unroll
            for (int r = 0; r < 16; ++r) x[r] = (r == c) ? 1.0f : 0.0f;
            SolveCol16<0>::run(x, (unsigned)(uintptr_t)LsT + (unsigned)(I * (16 * 68 + 16) * 4));
#pragma unroll
            for (int r = 0; r < 16; ++r) Ti[(I * 16 + r) * 20 + c] = x[r];
        } else {
            const int rt = tid - 64;
            for (int q = rt; q < 1024; q += 448) { const int blk = q >> 6, l2 = q & 63, i = l2 & 15, f = l2 >> 4, mb = blk >> 2, ks = blk & 3, t = 16 * mb + i;
                const v2u p0 = *(const LAS v2u*)(Qb + t * 136 + 32 * ks + 4 * f), p1 = *(const LAS v2u*)(Qb + t * 136 + 32 * ks + 16 + 4 * f); const float eg = egs[t];
                v4u o; o.x = pk2(bflo(p0.x) * eg, bfhi(p0.x) * eg); o.y = pk2(bflo(p0.y) * eg, bfhi(p0.y) * eg); o.z = pk2(bflo(p1.x) * eg, bfhi(p1.x) * eg); o.w = pk2(bflo(p1.y) * eg, bfhi(p1.y) * eg);
                *(v4u*)(gops + 16384 + q * 16) = o; }
            for (int q = rt; q < 512; q += 448) { const int blk = q >> 6, l2 = q & 63, i = l2 & 15, f = l2 >> 4, mb = blk >> 1, ks2 = blk & 1, t = 16 * mb + i;
                v2u p0 = (v2u){0u, 0u}, p1 = (v2u){0u, 0u};
                if (2 * ks2 <= mb) p0 = *(const LAS v2u*)(ATs + t * 72 + 32 * ks2 + 4 * f);
                if (2 * ks2 + 1 <= mb) p1 = *(const LAS v2u*)(ATs + t * 72 + 32 * ks2 + 16 + 4 * f);
                *(v4u*)(gops + 32768 + q * 16) = (v4u){p0.x, p0.y, p1.x, p1.y}; }
            for (int q = rt; q < 1024; q += 448) { const int blk = q >> 6, l2 = q & 63, i = l2 & 15, f = l2 >> 4, dkb = blk >> 1, ks2 = blk & 1, dk = 16 * dkb + i; float v[8];
#pragma unroll
                for (int e2 = 0; e2 < 8; ++e2) { const int c = 32 * ks2 + 16 * (e2 >> 2) + 4 * f + (e2 & 3); v[e2] = Ks[c * 132 + dk] * kes[c]; }
                *(v4u*)(gops + 40960 + q * 16) = (v4u){pk2(v[0], v[1]), pk2(v[2], v[3]), pk2(v[4], v[5]), pk2(v[6], v[7])}; }
        }
        __syncthreads();
#pragma unroll
        for (int ct = 0; ct < 2; ++ct) {
            const int C = 2 * wave + ct; const bool isv = C < 8; const int col = isv ? 16 * C + fr : 16 * (C - 8) + fr;
            f32x4 X[4];
#pragma unroll
            for (int I = 0; I < 4; ++I) {
                f32x4 acc;
#pragma unroll
                for (int e2 = 0; e2 < 4; ++e2) { const int t = 16 * I + 4 * fq + e2; acc[e2] = isv ? Vs[t * 132 + col] : egs[t] * Ks[t * 132 + col]; }
#pragma unroll
                for (int J = 0; J < 4; ++J) if (J < I) {
#pragma unroll
                    for (int kk = 0; kk < 4; ++kk) acc = __builtin_amdgcn_mfma_f32_16x16x4f32(LsT[(16 * J + 4 * fq + kk) * 68 + 16 * I + fr], X[J][kk], acc, 0, 0, 0); }
                f32x4 xi = (f32x4){0.f, 0.f, 0.f, 0.f};
#pragma unroll
                for (int kk = 0; kk < 4; ++kk) xi = __builtin_amdgcn_mfma_f32_16x16x4f32(Ti[(I * 16 + fr) * 20 + 4 * fq + kk], acc[kk], xi, 0, 0, 0);
                X[I] = xi;
                if (isv) { v2u w; w.x = pk2(xi[0], xi[1]); w.y = pk2(xi[2], xi[3]); *(v2u*)(UVF + (size_t)task * 16384 + (size_t)((C * 4 + I) * 64 + lane) * 8) = w; }
                else {
#pragma unroll
                    for (int e2 = 0; e2 < 4; ++e2) WKs[(16 * I + 4 * fq + e2) * 136 + col] = (bf16)(pk2(xi[e2], 0.f) & 0xffffu); }
            }
        }
        __syncthreads();
        for (int q = tid; q < 1024; q += NTHR) { const int blk = q >> 6, l2 = q & 63, i = l2 & 15, f = l2 >> 4, mb = blk >> 2, ks = blk & 3, t = 16 * mb + i;
            const v2u p0 = *(const LAS v2u*)(WKs + t * 136 + 32 * ks + 4 * f), p1 = *(const LAS v2u*)(WKs + t * 136 + 32 * ks + 16 + 4 * f);
            *(v4u*)(gops + q * 16) = (v4u){p0.x, p0.y, p1.x, p1.y}; }
        __syncthreads();
    }
}

__device__ __forceinline__ bf16x8 pack8(const f32x4 a, const f32x4 b) {
    v4u w; w.x = pk2(a[0], a[1]); w.y = pk2(a[2], a[3]); w.z = pk2(b[0], b[1]); w.w = pk2(b[2], b[3]); return __builtin_bit_cast(bf16x8, w);
}
__device__ __forceinline__ void gdn_scan(const Args& A, LAS unsigned char* lds, int bh, int tid, int lane, int wave) {
    const int b = bh >> 2, h = bh & 3, fr = lane & 15, fq = lane >> 4, vs = wave;
    const unsigned char* gops = (const unsigned char*)A.out + (size_t)bh * 32 * GOPS_CHUNK;
    const unsigned char* uvf = A.ws + WS_XN + (size_t)bh * 32 * 16384; const float* GE = (const float*)(A.ws + WS_GE) + bh * 32;
    float* Op = (float*)(A.ws + WS_OA) + ((size_t)b * SEQ + 4 * fq) * GW + h * 128 + 16 * vs + fr;
    f32x4 S[8];
#pragma unroll
    for (int i = 0; i < 8; ++i) S[i] = (f32x4){0.f, 0.f, 0.f, 0.f};
    const float gev = GE[lane & 31];
#define SCAN_DMA(chunk, bufoff) do { _Pragma("unroll") for (int i_ = 0; i_ < 9; ++i_) { const int p_ = wave + 8 * i_; \
        const unsigned char* s_ = (p_ < 56) ? (gops + (size_t)(chunk) * GOPS_CHUNK + p_ * 1024) : (uvf + (size_t)(chunk) * 16384 + (p_ - 56) * 1024); \
        __builtin_amdgcn_global_load_lds((const unsigned*)(s_ + lane * 16), (LAS unsigned*)(lds + (bufoff) + p_ * 1024), 16, 0, 0); } } while (0)
    SCAN_DMA(0, 0); SCAN_DMA(1, SCAN_BUF);
    asm volatile("s_waitcnt vmcnt(0)" ::: "memory"); __syncthreads();
#pragma unroll 1
    for (int n = 0; n < 32; ++n) {
        const LAS unsigned char* cur = lds + (n & 1) * SCAN_BUF;
        const float ge = __builtin_bit_cast(float, __builtin_amdgcn_readlane(__builtin_bit_cast(int, gev), n));
        bf16x8 Sb[4];
#pragma unroll
        for (int ks = 0; ks < 4; ++ks) Sb[ks] = pack8(S[2 * ks], S[2 * ks + 1]);
        f32x4 u[4];
#pragma unroll
        for (int mb = 0; mb < 4; ++mb) { f32x4 p = (f32x4){0.f, 0.f, 0.f, 0.f};
#pragma unroll
            for (int ks = 0; ks < 4; ++ks) p = __builtin_amdgcn_mfma_f32_16x16x32_bf16(*(const LAS bf16x8*)(cur + ((mb * 4 + ks) * 64 + lane) * 16), Sb[ks], p, 0, 0, 0);
            const v2u uw = *(const LAS v2u*)(cur + GOPS_CHUNK + ((vs * 4 + mb) * 64 + lane) * 8);
            u[mb] = (f32x4){bflo(uw.x) - p[0], bfhi(uw.x) - p[1], bflo(uw.y) - p[2], bfhi(uw.y) - p[3]}; }
        bf16x8 ub[2]; ub[0] = pack8(u[0], u[1]); ub[1] = pack8(u[2], u[3]);
        f32x4 o[4];
#pragma unroll
        for (int mb = 0; mb < 4; ++mb) { f32x4 acc = (f32x4){0.f, 0.f, 0.f, 0.f};
#pragma unroll
            for (int ks = 0; ks < 4; ++ks) acc = __builtin_amdgcn_mfma_f32_16x16x32_bf16(*(const LAS bf16x8*)(cur + 16384 + ((mb * 4 + ks) * 64 + lane) * 16), Sb[ks], acc, 0, 0, 0);
#pragma unroll
            for (int ks2 = 0; ks2 < 2; ++ks2) if (ks2 <= (mb >> 1)) acc = __builtin_amdgcn_mfma_f32_16x16x32_bf16(*(const LAS bf16x8*)(cur + 32768 + ((mb * 2 + ks2) * 64 + lane) * 16), ub[ks2], acc, 0, 0, 0);
            o[mb] = acc; }
#pragma unroll
        for (int dkb = 0; dkb < 8; ++dkb) { f32x4 acc = S[dkb] * ge;
#pragma unroll
            for (int ks2 = 0; ks2 < 2; ++ks2) acc = __builtin_amdgcn_mfma_f32_16x16x32_bf16(*(const LAS bf16x8*)(cur + 40960 + ((dkb * 2 + ks2) * 64 + lane) * 16), ub[ks2], acc, 0, 0, 0);
            S[dkb] = acc; }
        asm volatile("s_waitcnt vmcnt(0)" ::: "memory"); __syncthreads();
        if (n + 2 < 32) SCAN_DMA(n + 2, (n & 1) * SCAN_BUF);
        float* orow = Op + (size_t)(64 * n) * GW;
#pragma unroll
        for (int mb = 0; mb < 4; ++mb) { float* q = orow + (size_t)(16 * mb) * GW; q[0] = o[mb][0]; q[GW] = o[mb][1]; q[2 * GW] = o[mb][2]; q[3 * GW] = o[mb][3]; }
    }
    asm volatile("s_waitcnt vmcnt(0)" ::: "memory"); __syncthreads();
#undef SCAN_DMA
}


__device__ __forceinline__ void attn_fast(const Args& A, LAS unsigned char* lds, int lane, int wave) {
    const bf16* PROJ = (const bf16*)(A.ws + WS_PROJ); bf16* CAT = (bf16*)(A.ws + WS_CAT);
    unsigned* ctr = (unsigned*)(A.ws + WS_CTL);
    LAS bf16* Vt = (LAS bf16*)(lds + wave * 8192);
    const int fr = lane & 15, fq = lane >> 4;
    const int kk = lane & 31, vslot = 8 * ((kk & 15) >> 2) + 4 * (kk >> 4) + (kk & 3), vch = lane >> 5;
    constexpr float SC = 0.125f * 1.4426950408889634f;
    const int myx = (int)(__builtin_amdgcn_s_getreg((3 << 11) | 20) & 0x7u);
    int qi = 0;
    for (;;) {
        int wt = 512, xq = 0;
        while (qi < 8) { xq = (myx + qi) & 7; unsigned wt_ = 0; if (lane == 0) wt_ = atomicAdd(ctr + 16 * xq, 1u); wt = __builtin_amdgcn_readfirstlane(wt_); if (wt < 512) break; ++qi; }
        if (qi >= 8) break;
        const int b = wt >> 6, h = xq, rem = wt & 63, T = 7 - (rem >> 3), c4 = rem & 7, cA = (c4 & 3) + 8 * (c4 >> 2), cB = cA + 4, t0 = 256 * T;
        const bf16* Pb = PROJ + (size_t)b * SEQ * NP;
        const int tqA = t0 + cA + 16 * fr, tqB = tqA + 4;
        bf16x8 qfA[2], qfB[2];
#pragma unroll
        for (int ks = 0; ks < 2; ++ks) { qfA[ks] = *(const bf16x8*)(Pb + (size_t)tqA * NP + PC_QB + h * 64 + 32 * ks + 8 * fq); qfB[ks] = *(const bf16x8*)(Pb + (size_t)tqB * NP + PC_QB + h * 64 + 32 * ks + 8 * fq); }
        const int n2 = ((t0 + 240) >> 4) + 1, g2 = (n2 + 31) >> 5;
        const int lo1 = max(t0 + cA - 512, cA & 3), n1 = ((t0 + cB + 240 - lo1) >> 2) + 1, g1 = (n1 + 31) >> 5;
        const int lo0 = max(t0 + cA - 128, 0), n0 = (t0 + cB + 240 - lo0) + 1, g0 = (n0 + 31) >> 5;
        const int NG = 2 * g2 + g1 + g0;
        f32x4 OA[4], OB[4];
#pragma unroll
        for (int i = 0; i < 4; ++i) { OA[i] = (f32x4){0.f, 0.f, 0.f, 0.f}; OB[i] = OA[i]; }
        float mA = -INFINITY, lA = 0.f, mB = -INFINITY, lB = 0.f;
        v4u kc[4], vc[4], kn[4], vn[4];
#define ATT_DEC(f, kst, str, mode) do { if ((f) < g2) { str = 16; kst = cA + 512 * (f); mode = 1; } else if ((f) < 2 * g2) { str = 16; kst = cB + 512 * ((f) - g2); mode = 2; } \
            else if ((f) < 2 * g2 + g1) { str = 4; kst = lo1 + 128 * ((f) - 2 * g2); mode = 3; } else { str = 1; kst = lo0 + 32 * ((f) - 2 * g2 - g1); mode = 3; } } while (0)
#define ATT_LOAD(kreg, vreg, kst, str) do { \
            _Pragma("unroll") for (int j = 0; j < 2; ++j) { const int tk = min((kst) + (str) * (16 * j + fr), SEQ - 1); \
                _Pragma("unroll") for (int ks = 0; ks < 2; ++ks) kreg[2 * j + ks] = *(const v4u*)(Pb + (size_t)tk * NP + PC_KB + h * 64 + 32 * ks + 8 * fq); } \
            { const int tk = min((kst) + (str) * kk, SEQ - 1); \
                _Pragma("unroll") for (int i = 0; i < 4; ++i) vreg[i] = *(const v4u*)(Pb + (size_t)tk * NP + PC_VB + h * 64 + 8 * (vch + 2 * i)); } } while (0)
#define ATT_CLS(O_, m_, l_, qf_, tq_) do { \
            f32x4 d0 = (f32x4){0.f, 0.f, 0.f, 0.f}, d1 = d0; \
            _Pragma("unroll") for (int ks = 0; ks < 2; ++ks) { d0 = __builtin_amdgcn_mfma_f32_16x16x32_bf16(__builtin_bit_cast(bf16x8, kc[ks]), qf_[ks], d0, 0, 0, 0); \
                                                             d1 = __builtin_amdgcn_mfma_f32_16x16x32_bf16(__builtin_bit_cast(bf16x8, kc[2 + ks]), qf_[ks], d1, 0, 0, 0); } \
            float s[8]; float mloc = -INFINITY; \
            const int dv = (((tq_) - kst) >> shl) - 4 * fq;        \
            _Pragma("unroll") for (int e2 = 0; e2 < 8; ++e2) { const float x = (e2 < 4 ? d0[e2 & 3] : d1[e2 & 3]) * SC; \
                s[e2] = ((unsigned)(dv - (16 * (e2 >> 2) + (e2 & 3))) <= 128u) ? x : -INFINITY; mloc = fmaxf(mloc, s[e2]); } \
            mloc = fmaxf(mloc, __shfl_xor(mloc, 16)); mloc = fmaxf(mloc, __shfl_xor(mloc, 32)); \
            const float mnew = fmaxf(m_, mloc), alpha = __builtin_amdgcn_exp2f(m_ - mnew); m_ = mnew; \
            float psum = 0.f; \
            _Pragma("unroll") for (int e2 = 0; e2 < 8; ++e2) { s[e2] = __builtin_amdgcn_exp2f(s[e2] - mnew); psum += s[e2]; } \
            l_ = l_ * alpha + psum; \
            const bf16x8 pb = pack8((f32x4){s[0], s[1], s[2], s[3]}, (f32x4){s[4], s[5], s[6], s[7]}); \
            _Pragma("unroll") for (int db = 0; db < 4; ++db) O_[db] = __builtin_amdgcn_mfma_f32_16x16x32_bf16(va[db], pb, O_[db] * alpha, 0, 0, 0); } while (0)
        int kst, str, mode; ATT_DEC(0, kst, str, mode); ATT_LOAD(kc, vc, kst, str);
#pragma unroll 1
        for (int f = 0; f < NG; ++f) {
            int kstn = 0, strn = 1, moden = 0;
            if (f + 1 < NG) { ATT_DEC(f + 1, kstn, strn, moden); ATT_LOAD(kn, vn, kstn, strn); }
#pragma unroll
            for (int i = 0; i < 4; ++i) { const int dd = 8 * (vch + 2 * i); const v4u w = vc[i];
                Vt[(dd + 0) * 40 + vslot] = (bf16)(w.x & 0xffffu); Vt[(dd + 1) * 40 + vslot] = (bf16)(w.x >> 16); Vt[(dd + 2) * 40 + vslot] = (bf16)(w.y & 0xffffu); Vt[(dd + 3) * 40 + vslot] = (bf16)(w.y >> 16);
                Vt[(dd + 4) * 40 + vslot] = (bf16)(w.z & 0xffffu); Vt[(dd + 5) * 40 + vslot] = (bf16)(w.z >> 16); Vt[(dd + 6) * 40 + vslot] = (bf16)(w.w & 0xffffu); Vt[(dd + 7) * 40 + vslot] = (bf16)(w.w >> 16); }
            bf16x8 va[4];
#pragma unroll
            for (int db = 0; db < 4; ++db) va[db] = *(const LAS bf16x8*)(Vt + (16 * db + fr) * 40 + 8 * fq);
            const int shl = (str == 16) ? 4 : (str == 4 ? 2 : 0);
            if (mode & 1) ATT_CLS(OA, mA, lA, qfA, tqA);
            if (mode & 2) ATT_CLS(OB, mB, lB, qfB, tqB);
#pragma unroll
            for (int i = 0; i < 4; ++i) { kc[i] = kn[i]; vc[i] = vn[i]; }
            kst = kstn; str = strn; mode = moden;
        }
#undef ATT_DEC
#undef ATT_LOAD
#undef ATT_CLS
        lA += __shfl_xor(lA, 16); lA += __shfl_xor(lA, 32); lB += __shfl_xor(lB, 16); lB += __shfl_xor(lB, 32);
        const float invA = 1.0f / lA, invB = 1.0f / lB;
        bf16* op = CAT + ((size_t)b * SEQ + tqA) * DM + GW + h * 64 + 4 * fq;
#pragma unroll
        for (int db = 0; db < 4; ++db) { v2u w; w.x = pk2(OA[db][0] * invA, OA[db][1] * invA); w.y = pk2(OA[db][2] * invA, OA[db][3] * invA); *(v2u*)(op + 16 * db) = w;
            v2u w2; w2.x = pk2(OB[db][0] * invB, OB[db][1] * invB); w2.y = pk2(OB[db][2] * invB, OB[db][3] * invB); *(v2u*)(op + 4 * DM + 16 * db) = w2; }
    }
}

__device__ __forceinline__ void attn_simple(const Args& A, int tid, int lane, int wave) {
    const bf16* PROJ = (const bf16*)(A.ws + WS_PROJ); bf16* CAT = (bf16*)(A.ws + WS_CAT);
    unsigned* ctr = (unsigned*)(A.ws + WS_CTL);
    for (;;) {
        unsigned wt_ = 0; if (lane == 0) wt_ = atomicAdd(ctr, 1u); const int wt = __builtin_amdgcn_readfirstlane(wt_);
        if (wt >= (M / 64) * AH) break;
        const int h = wt % AH, tb = wt / AH, row = tb * 64 + lane, b = row / SEQ, t = row % SEQ;
        float q[64], acc[64];
        { const v4u* qp = (const v4u*)(PROJ + (size_t)row * NP + PC_QB + h * 64);
#pragma unroll
          for (int j = 0; j < 8; ++j) { const v4u w = qp[j]; q[8 * j + 0] = bflo(w.x) * 0.125f; q[8 * j + 1] = bfhi(w.x) * 0.125f; q[8 * j + 2] = bflo(w.y) * 0.125f; q[8 * j + 3] = bfhi(w.y) * 0.125f;
              q[8 * j + 4] = bflo(w.z) * 0.125f; q[8 * j + 5] = bfhi(w.z) * 0.125f; q[8 * j + 6] = bflo(w.w) * 0.125f; q[8 * j + 7] = bfhi(w.w) * 0.125f; } }
#pragma unroll
        for (int j = 0; j < 64; ++j) acc[j] = 0.f;
        float mx = -1e30f, l = 0.f;
        for (int br = 0; br < 3; ++br) {
            const int stride = br == 0 ? 1 : (br == 1 ? 4 : 16);
            for (int i = 0; i <= 128; ++i) {
                const int tk = t - i * stride; if (tk < 0) break;
                const size_t krow = (size_t)(b * SEQ + tk) * NP;
                const v4u* kp = (const v4u*)(PROJ + krow + PC_KB + h * 64); const v4u* vp = (const v4u*)(PROJ + krow + PC_VB + h * 64);
                float s = 0.f;
#pragma unroll
                for (int j = 0; j < 8; ++j) { const v4u w = kp[j]; s += q[8 * j + 0] * bflo(w.x) + q[8 * j + 1] * bfhi(w.x) + q[8 * j + 2] * bflo(w.y) + q[8 * j + 3] * bfhi(w.y)
                                                                       + q[8 * j + 4] * bflo(w.z) + q[8 * j + 5] * bfhi(w.z) + q[8 * j + 6] * bflo(w.w) + q[8 * j + 7] * bfhi(w.w); }
                const float mn = fmaxf(mx, s), sc = __expf(mx - mn), p = __expf(s - mn); mx = mn; l = l * sc + p;
#pragma unroll
                for (int j = 0; j < 8; ++j) { const v4u w = vp[j];
                    acc[8 * j + 0] = acc[8 * j + 0] * sc + p * bflo(w.x); acc[8 * j + 1] = acc[8 * j + 1] * sc + p * bfhi(w.x); acc[8 * j + 2] = acc[8 * j + 2] * sc + p * bflo(w.y); acc[8 * j + 3] = acc[8 * j + 3] * sc + p * bfhi(w.y);
                    acc[8 * j + 4] = acc[8 * j + 4] * sc + p * bflo(w.z); acc[8 * j + 5] = acc[8 * j + 5] * sc + p * bfhi(w.z); acc[8 * j + 6] = acc[8 * j + 6] * sc + p * bflo(w.w); acc[8 * j + 7] = acc[8 * j + 7] * sc + p * bfhi(w.w); }
            }
        }
        const float inv = 1.0f / l; v4u* op = (v4u*)(CAT + (size_t)row * DM + GW + h * 64);
#pragma unroll
        for (int j = 0; j < 8; ++j) { v4u w; w.x = pk2(acc[8 * j] * inv, acc[8 * j + 1] * inv); w.y = pk2(acc[8 * j + 2] * inv, acc[8 * j + 3] * inv); w.z = pk2(acc[8 * j + 4] * inv, acc[8 * j + 5] * inv); w.w = pk2(acc[8 * j + 6] * inv, acc[8 * j + 7] * inv); op[j] = w; }
    }
}
__device__ __forceinline__ void gated_norm(const Args& A, int lane, int wave) {
    const bf16* PROJ = (const bf16*)(A.ws + WS_PROJ); bf16* CAT = (bf16*)(A.ws + WS_CAT); const float* OA = (const float*)(A.ws + WS_OA); const float* gw = A.in[6];
    const float w0 = gw[2 * lane], w1 = gw[2 * lane + 1];
    const int gwv = blockIdx.x * NWAVES + wave, NGW = gridDim.x * NWAVES;
    for (int wt0 = gwv; wt0 < M * GH; wt0 += 8 * NGW) {
        float2 o[8]; unsigned zz[8];
#pragma unroll
        for (int i = 0; i < 8; ++i) { const int wt = min(wt0 + i * NGW, M * GH - 1), row = wt / GH, h = wt % GH;
            o[i] = *(const float2*)(OA + (size_t)row * GW + h * 128 + 2 * lane); zz[i] = *(const unsigned*)(PROJ + (size_t)row * NP + PC_Z + h * 128 + 2 * lane); }
#pragma unroll
        for (int i = 0; i < 8; ++i) { const int wt = wt0 + i * NGW; if (wt >= M * GH) break; const int row = wt / GH, h = wt % GH;
            const float ms = wave_sum(o[i].x * o[i].x + o[i].y * o[i].y) * (1.0f / 128.0f), r = rsqrtf(ms + RMS_EPS);
            *(unsigned*)(CAT + (size_t)row * DM + h * 128 + 2 * lane) = pk2(o[i].x * r * w0 * silu_f(bflo(zz[i])), o[i].y * r * w1 * silu_f(bfhi(zz[i]))); }
    }
}

__device__ __forceinline__ void gated_norm_bh(const Args& A, int bh, int lane, int wave) {
    const int b = bh >> 2, h = bh & 3;
    const bf16* Zp = (const bf16*)(A.ws + WS_PROJ) + (size_t)b * SEQ * NP + PC_Z + h * 128 + 2 * lane; bf16* Cp = (bf16*)(A.ws + WS_CAT) + (size_t)b * SEQ * DM + h * 128 + 2 * lane;
    const float* Op = (const float*)(A.ws + WS_OA) + (size_t)b * SEQ * GW + h * 128 + 2 * lane; const float* gw = A.in[6];
    const float w0 = gw[2 * lane], w1 = gw[2 * lane + 1];
    __builtin_amdgcn_fence(__ATOMIC_ACQUIRE, "agent");
#pragma unroll 1
    for (int r0 = wave * 16; r0 < SEQ; r0 += NWAVES * 16) {
        float2 o[16]; unsigned zz[16];
#pragma unroll
        for (int i = 0; i < 16; ++i) { o[i] = *(const float2*)(Op + (size_t)(r0 + i) * GW); zz[i] = *(const unsigned*)(Zp + (size_t)(r0 + i) * NP); }
#pragma unroll
        for (int i = 0; i < 16; ++i) { const float ms = wave_sum(o[i].x * o[i].x + o[i].y * o[i].y) * (1.0f / 128.0f), r = rsqrtf(ms + RMS_EPS);
            *(unsigned*)(Cp + (size_t)(r0 + i) * DM) = pk2(o[i].x * r * w0 * silu_f(bflo(zz[i])), o[i].y * r * w1 * silu_f(bfhi(zz[i]))); }
    }
}
__device__ __forceinline__ void ffn_conv_half(const Args& A, int half, int tid) {
    const bf16* Y = (const bf16*)(A.ws + WS_Y); bf16* ACT = (bf16*)(A.ws + WS_ACT); const float* fw = A.in[10];
    constexpr int HC = DFF / 2;
    for (size_t it = (size_t)blockIdx.x * NTHR + tid; it < (size_t)M * (HC / 8); it += (size_t)gridDim.x * NTHR) {
        const int row = (int)(it / (HC / 8)), g8 = (int)(it % (HC / 8)), cl = g8 * 8, pn = cl >> 7, j = cl & 127, t = row % SEQ, ch = half * HC + cl;
        float ga[8], ua[8];
#pragma unroll
        for (int e = 0; e < 8; ++e) { ga[e] = 0.f; ua[e] = 0.f; }
#pragma unroll
        for (int i = 0; i < 3; ++i) { const int ts = t - 2 + i; if (ts < 0) continue;
            const bf16* yr = Y + (size_t)(row - 2 + i) * DFF + 256 * pn + j; const v4u g = *(const v4u*)yr, u = *(const v4u*)(yr + 128);
            const f32x4 wg0 = *(const f32x4*)(fw + i * NUP + ch), wg1 = *(const f32x4*)(fw + i * NUP + ch + 4), wu0 = *(const f32x4*)(fw + i * NUP + DFF + ch), wu1 = *(const f32x4*)(fw + i * NUP + DFF + ch + 4);
            ga[0] += wg0.x * bflo(g.x); ga[1] += wg0.y * bfhi(g.x); ga[2] += wg0.z * bflo(g.y); ga[3] += wg0.w * bfhi(g.y); ga[4] += wg1.x * bflo(g.z); ga[5] += wg1.y * bfhi(g.z); ga[6] += wg1.z * bflo(g.w); ga[7] += wg1.w * bfhi(g.w);
            ua[0] += wu0.x * bflo(u.x); ua[1] += wu0.y * bfhi(u.x); ua[2] += wu0.z * bflo(u.y); ua[3] += wu0.w * bfhi(u.y); ua[4] += wu1.x * bflo(u.z); ua[5] += wu1.y * bfhi(u.z); ua[6] += wu1.z * bflo(u.w); ua[7] += wu1.w * bfhi(u.w); }
        v4u o; o.x = pk2(silu_f(ga[0]) * ua[0], silu_f(ga[1]) * ua[1]); o.y = pk2(silu_f(ga[2]) * ua[2], silu_f(ga[3]) * ua[3]); o.z = pk2(silu_f(ga[4]) * ua[4], silu_f(ga[5]) * ua[5]); o.w = pk2(silu_f(ga[6]) * ua[6], silu_f(ga[7]) * ua[7]);
        *(v4u*)(ACT + (size_t)row * DFF + ch) = o;
    }
}

__device__ __forceinline__ void ffn_fixup(const Args& A, int tid) {
    const float* YH = (const float*)(A.ws + WS_YH); const float* UP = (const float*)(A.ws + WS_UPART); bf16* ACT = (bf16*)(A.ws + WS_ACT); const float* fw = A.in[10];
    for (int it = blockIdx.x * NTHR + tid; it < 64 * 22 * 2 * 128; it += gridDim.x * NTHR) {
        const int c = it & 127, r = (it >> 7) & 1, tile = it >> 8, pm = tile / 22, pn = tile % 22; if ((pm & 7) == 0) continue;
        const int ch = pn * 128 + c; const float* up = UP + ((size_t)tile * 2 + r) * 256; const float* yh = YH + (size_t)((pm - 1) * 22 + pn) * 2 * 256;
        float g = up[c], u = up[128 + c];
        const float wg0 = fw[ch], wg1 = fw[5632 + ch], wu0 = fw[2816 + ch], wu1 = fw[5632 + 2816 + ch];
        if (r == 0) { g += wg0 * yh[c] + wg1 * yh[256 + c]; u += wu0 * yh[128 + c] + wu1 * yh[256 + 128 + c]; }
        else { g += wg0 * yh[256 + c]; u += wu0 * yh[256 + 128 + c]; }
        ACT[(size_t)(pm * 256 + r) * DFF + ch] = (bf16)(pk2(silu_f(g) * u, 0.f) & 0xffffu);
    }
}
__device__ __forceinline__ void final_norm(const Args& A, int lane, int wave) {
    float* out = A.out; const f32x4* nr = (const f32x4*)A.in[12] + lane;
    const int gw = blockIdx.x * NWAVES + wave, NGW = gridDim.x * NWAVES;
    f32x4 nw[4];
#pragma unroll
    for (int j = 0; j < 4; ++j) nw[j] = nr[64 * j];
    for (int m0 = gw; m0 < M; m0 += 4 * NGW) {
        f32x4 v[4][4];
#pragma unroll
        for (int rr = 0; rr < 4; ++rr) { const int m = min(m0 + rr * NGW, M - 1); const f32x4* xr = (const f32x4*)(out + (size_t)m * DM) + lane;
#pragma unroll
            for (int j = 0; j < 4; ++j) v[rr][j] = xr[64 * j]; }
#pragma unroll
        for (int rr = 0; rr < 4; ++rr) { const int m = m0 + rr * NGW; if (m >= M) break; float s = 0.f;
#pragma unroll
            for (int j = 0; j < 4; ++j) s += (v[rr][j].x * v[rr][j].x + v[rr][j].y * v[rr][j].y) + (v[rr][j].z * v[rr][j].z + v[rr][j].w * v[rr][j].w);
            const float rstd = rsqrtf(wave_sum(s) * (1.f / DM) + RMS_EPS); f32x4* xw = (f32x4*)(out + (size_t)m * DM) + lane;
#pragma unroll
            for (int j = 0; j < 4; ++j) xw[64 * j] = (f32x4){v[rr][j].x * rstd * nw[j].x, v[rr][j].y * rstd * nw[j].y, v[rr][j].z * rstd * nw[j].z, v[rr][j].w * rstd * nw[j].w}; }
    }
}

#define XB_TMO      128
#define XB_XCNT(j)  (256  + 64 * (j))
#define XB_XSUB(j)  (1280 + 64 * (j))
#define XB_XGEN(j)  (2304 + 64 * (j))
#define XB_TOP      3328
#define XB_TOPGEN   3392
#define XCD_BAR_WORDS 3456
#define XB_SPIN_CAP (1u << 18)

__device__ __forceinline__ unsigned xb_ld(unsigned* p)              { return __hip_atomic_load(p, __ATOMIC_RELAXED, __HIP_MEMORY_SCOPE_AGENT); }
__device__ __forceinline__ unsigned xb_add(unsigned* p, unsigned v) { return __hip_atomic_fetch_add(p, v, __ATOMIC_RELAXED, __HIP_MEMORY_SCOPE_AGENT); }
__device__ __forceinline__ unsigned xb_xcc_id() { return (unsigned)__builtin_amdgcn_s_getreg((3 << 11) | 20) & 0xFu; }
#define XB_SPIN(cond, bar) do { unsigned _sp = 0; while (cond) { __builtin_amdgcn_s_sleep(1); \
    if ((++_sp & 255u) == 0u) { if (xb_ld(&(bar)[XB_TMO])) break; if (_sp > XB_SPIN_CAP) { atomicAdd(&(bar)[XB_TMO], 1u); break; } } } } while (0)

struct XcdBarrier {
    unsigned* bar; unsigned x;
    volatile LAS unsigned* st;
};

__device__ __forceinline__ XcdBarrier xcd_barrier_post(unsigned* bar, volatile LAS unsigned* st) {
    XcdBarrier b; b.bar = bar; b.x = xb_xcc_id(); b.st = st;
    if (threadIdx.x == 0) (void)xb_add(&bar[XB_XCNT(b.x)], 1u);
    return b;
}
__device__ __forceinline__ void xcd_barrier_complete(unsigned* bar, unsigned x, unsigned& nloc, unsigned& nx) {
    const unsigned G = gridDim.x * gridDim.y * gridDim.z;
    unsigned sum, cnt, mine, sp = 0u;
    for (;;) {
        sum = 0u; cnt = 0u; mine = 0u;
#pragma unroll
        for (unsigned j = 0; j < 16; ++j) { const unsigned c = xb_ld(&bar[XB_XCNT(j)]); sum += c; cnt += (c > 0u) ? 1u : 0u; mine = (j == x) ? c : mine; }
        if (sum == G) break;
        __builtin_amdgcn_s_sleep(1);
        if ((++sp & 255u) == 0u) { if (xb_ld(&bar[XB_TMO])) break; if (sp > XB_SPIN_CAP) { atomicAdd(&bar[XB_TMO], 1u); break; } }
    }
    nloc = mine > 0u ? mine : 1u; nx = cnt > 0u ? cnt : 1u;
}

__device__ __forceinline__ void xcd_barrier(const XcdBarrier& b) {
    asm volatile("s_waitcnt vmcnt(0)" ::: "memory");
    __syncthreads();
    if (threadIdx.x == 0) {
        unsigned* bar = b.bar;
        __builtin_amdgcn_s_waitcnt(0);
        unsigned nloc = b.st[0], nx = b.st[1];
        if (nloc == 0u) { xcd_barrier_complete(bar, b.x, nloc, nx); b.st[0] = nloc; b.st[1] = nx; }
        const unsigned old = xb_add(&bar[XB_XSUB(b.x)], 1u);
        const unsigned gen = old / nloc;
        if (old + 1u == (gen + 1u) * nloc) {
            __builtin_amdgcn_fence(__ATOMIC_RELEASE, "agent");
            asm volatile("s_waitcnt vmcnt(0)" ::: "memory");
            const unsigned og = xb_add(&bar[XB_TOP], 1u);
            const unsigned tg = og / nx;
            if (og + 1u == (tg + 1u) * nx) xb_add(&bar[XB_TOPGEN], 1u);
            else XB_SPIN(xb_ld(&bar[XB_TOPGEN]) == tg, bar);
            __builtin_amdgcn_fence(__ATOMIC_ACQUIRE, "agent");
            xb_add(&bar[XB_XGEN(b.x)], 1u);
            asm volatile("s_waitcnt vmcnt(0)" ::: "memory");
        } else {
            XB_SPIN(xb_ld(&bar[XB_XGEN(b.x)]) == gen, bar);
            __builtin_amdgcn_fence(__ATOMIC_ACQUIRE, "agent");
            asm volatile("s_waitcnt vmcnt(0)" ::: "memory");
        }
    }
    __syncthreads();
}

constexpr int N_PHASES = 8;
__global__ void __launch_bounds__(NTHR, 2) mk_fwd(Args args) {
    extern __shared__ __attribute__((aligned(16))) unsigned char lds_raw[];
    LAS unsigned char* lds = (LAS unsigned char*)lds_raw;
    const int tid = threadIdx.x, lane = tid & 63, wave = __builtin_amdgcn_readfirstlane(tid >> 6);
    const int lo = args.ph_lo, hi = args.ph_hi;
    unsigned char* ws = args.ws;
    bf16* WIN = (bf16*)(ws + WS_WIN); bf16* WOUT = (bf16*)(ws + WS_WOUT); bf16* WUP = (bf16*)(ws + WS_WUP); bf16* WDN = (bf16*)(ws + WS_WDN);
    bf16* XN = (bf16*)(ws + WS_XN); bf16* PROJ = (bf16*)(ws + WS_PROJ); bf16* CAT = (bf16*)(ws + WS_CAT); bf16* Y = (bf16*)(ws + WS_Y); bf16* ACT = (bf16*)(ws + WS_ACT);
    float* SSQ = (float*)(ws + WS_SSQ);
#define IN(k) (lo <= (k) && (k) < hi)
#define SEAM(k) do { if (IN(k) && IN((k) + 1)) { xcd_barrier(bar); } } while (0)
    { volatile LAS unsigned* st = (volatile LAS unsigned*)(lds + LDS_BYTES - 64); if (tid < 2) st[tid] = 0u; }
    __syncthreads();
    XcdBarrier bar = xcd_barrier_post((unsigned*)(ws + WS_CTL) + 4096, (volatile LAS unsigned*)(lds + LDS_BYTES - 64));
    if (args.coop > 1) cg::this_grid().sync();
    if (IN(0)) { p0_prologue(args, lds, tid, lane, wave); } SEAM(0);
    if (IN(1)) { pg8::Gemm g{XN, WIN, M, NP, DM}; pg8::StaticOrder S; S.init(M, NP, gridDim.x, blockIdx.x); pg8::EpiBf16S E{PROJ, NP, nullptr};
        pg8::gemm_phase<pg8::EpiBf16S, pg8::StaticOrder, PG8_ALIGN, PG8_SP2>(lds, g, S, E);
        { pg8::Unit u4; const bool idle4 = !S.next(3, u4); const int G = gridDim.x, nidle = (G == 256) ? 128 : G;
          if (G != 256) convert_late_weights(args, lds, lane, wave, blockIdx.x * NWAVES + wave, G * NWAVES);
          else if (idle4) convert_late_weights(args, lds, lane, wave, (blockIdx.x - 128) * NWAVES + wave, nidle * NWAVES); } } SEAM(1);
    if (IN(2)) { gdn_prep(args, lds, tid, lane, wave); } SEAM(2);
    if (IN(3)) { if (blockIdx.x < NB * GH) gdn_scan(args, lds, blockIdx.x, tid, lane, wave); attn_fast(args, lds, lane, wave); xcd_barrier(bar); gated_norm(args, lane, wave); } SEAM(3);
    if (IN(4)) { pg8::Gemm g{CAT, WOUT, M, DM, DM}; pg8::StaticOrder S; S.init(M, DM, gridDim.x, blockIdx.x); pg8::EpiResid E{args.in[0], (gridDim.x == 256) ? nullptr : args.out, XN, SSQ, DM};
        pg8::gemm_phase<pg8::EpiResid, pg8::StaticOrder, PG8_ALIGN, PG8_SP2>(lds, g, S, E); } SEAM(4);
    if (IN(5)) { pg8::Gemm g{XN, WUP, M, NUP, DM}; pg8::StaticOrder S; S.init(M, NUP, gridDim.x, blockIdx.x);
        static_assert(pg8::EpiConvGate::CG_SSQ == WS_SSQ && pg8::EpiConvGate::CG_ACT == WS_ACT && pg8::EpiConvGate::CG_YH == WS_YH && pg8::EpiConvGate::CG_UPART == WS_UPART, "d_ws map");
        pg8::EpiConvGate E{ws, args.in[10], lds};
        pg8::gemm_phase<pg8::EpiConvGate, pg8::StaticOrder, true, PG8_SP2>(lds, g, S, E); } SEAM(5);
    if (IN(6)) { ffn_fixup(args, tid); } SEAM(6);
    if (IN(7)) { pg8::Gemm g{ACT, WDN, M, DM, DFF}; pg8::StaticOrder S; S.init(M, DM, gridDim.x, blockIdx.x);
        if (gridDim.x == 256) {
            pg8::EpiResidNorm E{XN, args.out, (float*)(ws + WS_SSQ2), (unsigned*)(ws + WS_CTL) + 2048, args.in[12], DM};
            pg8::gemm_phase<pg8::EpiResidNorm, pg8::StaticOrder, true, PG8_SP2>(lds, g, S, E);
        } else {
            pg8::EpiResid E{args.out, args.out, nullptr, nullptr, DM};
            pg8::gemm_phase<pg8::EpiResid, pg8::StaticOrder, PG8_ALIGN, PG8_SP2>(lds, g, S, E);
            xcd_barrier(bar); final_norm(args, lane, wave);
        } }
#undef IN
#undef SEAM
}

#ifndef MK_ONE_LAUNCH
#define MK_ONE_LAUNCH 1
#endif
extern "C" void kernel_launch(void* const* d_in, const int* in_sizes, int n_in, void* d_out, int out_size, void* d_ws, size_t ws_size, hipStream_t stream) {
    static int grid = 0;
    if (grid == 0) {
        if (n_in != 13 || out_size != M * DM || ws_size < WS_END) { fprintf(stderr, "kernel_launch: unexpected shapes n_in %d out %d ws %zu\n", n_in, out_size, ws_size); grid = -1; return; }
        int dev = 0, cus = 0, per_cu = 0;
        hipGetDevice(&dev); hipDeviceGetAttribute(&cus, hipDeviceAttributeMultiprocessorCount, dev);
        hipFuncSetAttribute((const void*)mk_fwd, hipFuncAttributeMaxDynamicSharedMemorySize, LDS_BYTES);
        hipOccupancyMaxActiveBlocksPerMultiprocessor(&per_cu, (const void*)mk_fwd, NTHR, LDS_BYTES);
        (void)hipGetLastError();
        if (per_cu < 1) { fprintf(stderr, "kernel_launch: occupancy query says %d blocks per CU\n", per_cu); per_cu = 1; }
        grid = cus;
    }
    if (grid < 0) return;
    if (hipMemsetAsync((char*)d_ws + WS_CTL, 0, 65536, stream) != hipSuccess) { fprintf(stderr, "kernel_launch: memset failed\n"); return; }
    Args a{};
    for (int i = 0; i < 13; ++i) a.in[i] = (const float*)d_in[i];
    a.out = (float*)d_out; a.ws = (unsigned char*)d_ws;
#if MK_ONE_LAUNCH
    a.ph_lo = 0; a.ph_hi = N_PHASES; a.coop = 1;
    void* kargs[] = {&a};
    hipError_t e = hipLaunchCooperativeKernel((const void*)mk_fwd, dim3(grid), dim3(NTHR), kargs, LDS_BYTES, stream);
    if (e != hipSuccess) fprintf(stderr, "cooperative launch failed: %s (grid %d)\n", hipGetErrorString(e), grid);
#else
    for (int p = 0; p < N_PHASES; ++p) { a.ph_lo = p; a.ph_hi = p + 1; a.coop = 0; hipLaunchKernelGGL(mk_fwd, dim3(grid), dim3(NTHR), LDS_BYTES, stream, a); }
#endif
}
```

```cpp
#include <hip/hip_runtime.h>
#include <hip/hip_cooperative_groups.h>
#include <cstdio>
#include <cstdint>
namespace cg = cooperative_groups;
namespace pg8 {
#define PG8_LAS __attribute__((address_space(3)))
typedef unsigned short bf16_t;
typedef short bf16x8 __attribute__((ext_vector_type(8)));
typedef float f32x4 __attribute__((ext_vector_type(4)));
typedef unsigned u32x4 __attribute__((ext_vector_type(4)));
constexpr int BM = 256, BK = 64, HALF = 128, HTB = HALF * BK * 2  , STAGE_BYTES = 8 * HTB, NXCD = 8, WGM = 8;

__host__ __device__ __forceinline__ int lds_byte(int r, int c) { const int st = (r >> 4) * 2 + (c >> 5), rr = r & 15, cc = c & 31, ob = rr * 64 + cc * 2; return st * 1024 + (ob ^ (((ob >> 9) & 1) << 5)); }
__host__ __device__ __forceinline__ void stage_rc(int b, int& R, int& C) { const int st = b / 1024, sb = b % 1024, swz = sb ^ (((sb >> 9) & 1) << 5); R = (st >> 1) * 16 + swz / 64; C = (st & 1) * 32 + (swz % 64) / 2; }
__host__ __device__ __forceinline__ int perm32(int rho) { const int n = rho >> 4, i = rho & 15; return 8 * (i >> 2) + 4 * n + (i & 3); }

struct Unit { int pm, pn; };
struct Gemm { const bf16_t* A; const bf16_t* Bt; int M, N, K; };

struct StaticOrder {
    int nM, nN, nwg, G, c;
    __host__ __device__ __forceinline__ void init(int M, int N, int G_, int c_) { nM = M / BM; nN = N / BM; nwg = nM * nN; G = G_; c = c_; }
    __host__ __device__ __forceinline__ bool next(int i, Unit& u) const {
        const long L = (long)i * G + c; if (L >= nwg) return false;
        int wgid = (int)L; { const int q = nwg / NXCD, r = nwg % NXCD, xcd = wgid % NXCD, off = wgid / NXCD; wgid = (xcd < r ? xcd * (q + 1) : r * (q + 1) + (xcd - r) * q) + off; }
        const int nig = WGM * nN, gid = wgid / nig, fm = gid * WGM, gsz = (nM - fm) < WGM ? (nM - fm) : WGM;
        u.pm = fm + ((wgid % nig) % gsz); u.pn = (wgid % nig) / gsz; return true;
    }
    __device__ __forceinline__ void a_ready(const Unit&) const {}
    __device__ __forceinline__ void done(const Unit&) const {}
};

__device__ __forceinline__ unsigned cvt_pk_bf16(float lo, float hi) { unsigned r; asm volatile("v_cvt_pk_bf16_f32 %0, %1, %2" : "=v"(r) : "v"(lo), "v"(hi)); return r; }
constexpr float RMS_EPS = 1e-6f;
struct EpiBf16S {
    static constexpr bool PERM = true, AFTER_DRAIN = false;
    bf16_t* O; int ldc; const float* ssq;
    __device__ __forceinline__ void operator()(const f32x4 (&acc)[2][2][4][2], const Unit& u, int wr, int wc, int fr, int fq) const {
        const int row0 = u.pm * BM + wr * 64 + fr; const int col0 = u.pn * BM + wc * 32 + 8 * fq;
#pragma unroll
        for (int ai = 0; ai < 2; ++ai)
#pragma unroll
            for (int m = 0; m < 4; ++m) { const int row = row0 + ai * HALF + m * 16; bf16_t* rowp = O + (size_t)row * ldc + col0;
                const float sc = ssq ? rsqrtf(ssq[row] * (1.0f / 1024.0f) + RMS_EPS) : 1.0f;
#pragma unroll
                for (int bj = 0; bj < 2; ++bj) { const f32x4 v0 = acc[ai][bj][m][0] * sc, v1 = acc[ai][bj][m][1] * sc;
                    u32x4 w; w.x = cvt_pk_bf16(v0[0], v0[1]); w.y = cvt_pk_bf16(v0[2], v0[3]); w.z = cvt_pk_bf16(v1[0], v1[1]); w.w = cvt_pk_bf16(v1[2], v1[3]);
                    *(u32x4*)(rowp + bj * HALF) = w; } }
    }
};
struct EpiResid {
    static constexpr bool PERM = false, AFTER_DRAIN = false;
    const float* base; float* out; bf16_t* xb; float* ssq; int ldc;
    __device__ __forceinline__ void operator()(const f32x4 (&acc)[2][2][4][2], const Unit& u, int wr, int wc, int fr, int fq) const {
        typedef unsigned u32x2v __attribute__((ext_vector_type(2)));
        const int col0 = u.pn * BM + wc * 32 + 4 * fq;
#pragma unroll
        for (int ai = 0; ai < 2; ++ai) {
            f32x4 bv[4][2][2];
#pragma unroll
            for (int m = 0; m < 4; ++m) { const size_t off = (size_t)(u.pm * BM + ai * HALF + wr * 64 + m * 16 + fr) * ldc + col0;
#pragma unroll
                for (int bj = 0; bj < 2; ++bj)
#pragma unroll
                    for (int n = 0; n < 2; ++n) bv[m][bj][n] = *(const f32x4*)(base + off + bj * HALF + n * 16); }
#pragma unroll
            for (int m = 0; m < 4; ++m) { const int row = u.pm * BM + ai * HALF + wr * 64 + m * 16 + fr; const size_t off = (size_t)row * ldc + col0; float s = 0.f;
#pragma unroll
                for (int bj = 0; bj < 2; ++bj)
#pragma unroll
                    for (int n = 0; n < 2; ++n) { const f32x4 v = acc[ai][bj][m][n] + bv[m][bj][n];
                        if (out) *(f32x4*)(out + off + bj * HALF + n * 16) = v; s += (v[0] * v[0] + v[1] * v[1]) + (v[2] * v[2] + v[3] * v[3]);
                        if (xb) { u32x2v w; w.x = cvt_pk_bf16(v[0], v[1]); w.y = cvt_pk_bf16(v[2], v[3]); *(u32x2v*)(xb + off + bj * HALF + n * 16) = w; } }
                if (ssq) { s += __shfl_xor(s, 16); s += __shfl_xor(s, 32); if (fq == 0) atomicAdd(ssq + row, s); } }
            asm volatile("" ::: "memory");
        }
    }
};

__device__ __forceinline__ float dpp_ror1(float v) { return __builtin_bit_cast(float, __builtin_amdgcn_mov_dpp(__builtin_bit_cast(int, v), 0x121, 0xf, 0xf, true)); }
__device__ __forceinline__ float dpp_ror2(float v) { return __builtin_bit_cast(float, __builtin_amdgcn_mov_dpp(__builtin_bit_cast(int, v), 0x122, 0xf, 0xf, true)); }
struct EpiConvGate {
    static constexpr bool PERM = true, AFTER_DRAIN = false;
    static constexpr size_t CG_SSQ = (1u << 20) + 768 * 1024, CG_ACT = (size_t)148 << 20, CG_YH = (size_t)236 << 20, CG_UPART = (size_t)240 << 20;
    unsigned char* ws; const float* fw; PG8_LAS unsigned char* ldsb;
    __device__ __forceinline__ void operator()(f32x4 (&acc)[2][2][4][2], const Unit& u, int wr, int wc, int fr0, int fq0) const {
        int fr = fr0, fq = fq0; asm volatile("" : "+v"(fr), "+v"(fq));
        bf16_t* ACT = (bf16_t*)(ws + CG_ACT); const float* ssq = (const float*)(ws + CG_SSQ); float* YH = (float*)(ws + CG_YH); float* UPART = (float*)(ws + CG_UPART);
        PG8_LAS float* halo = (PG8_LAS float*)(ldsb + STAGE_BYTES);
        int cl = wc * 32 + 8 * fq;
        int ch = u.pn * 128 + cl;
        if (fr >= 14) {
#pragma unroll
            for (int ai = 0; ai < 2; ++ai) { const float sc = rsqrtf(ssq[u.pm * BM + ai * HALF + wr * 64 + 48 + fr] * (1.0f / 1024.0f) + RMS_EPS);
#pragma unroll
                for (int bj = 0; bj < 2; ++bj)
#pragma unroll
                    for (int n = 0; n < 2; ++n) { const f32x4 v = acc[ai][bj][3][n] * sc; *(PG8_LAS f32x4*)(halo + (((wr * 2 + ai) * 2 + (fr - 14)) * 256 + bj * 128 + cl + 4 * n)) = v;
                        if (ai == 1 && wr == 1) *(f32x4*)(YH + ((size_t)(u.pm * 22 + u.pn) * 2 + (fr - 14)) * 256 + bj * 128 + cl + 4 * n) = v; } }
        }
        asm volatile("s_waitcnt lgkmcnt(0)" ::: "memory"); __builtin_amdgcn_s_barrier(); asm volatile("" ::: "memory");
        typedef unsigned u32x2v __attribute__((ext_vector_type(2)));
#pragma unroll 1
        for (int n = 0; n < 2; ++n) {
            asm volatile("" : "+v"(fr), "+v"(fq));
            cl = wc * 32 + 8 * fq; ch = u.pn * 128 + cl;
            f32x4 w[3][2];
#pragma unroll
            for (int i = 0; i < 3; ++i)
#pragma unroll
                for (int bj = 0; bj < 2; ++bj) w[i][bj] = *(const f32x4*)(fw + (size_t)i * 5632 + bj * 2816 + ch + 4 * n);
#pragma unroll
            for (int ai = 0; ai < 2; ++ai) {
                const bool top = (ai == 0 && wr == 0);
                const int pblk = (ai == 0) ? 0 : (wr == 0 ? 2 : 1);
                f32x4 q1[2], q2[2];
#pragma unroll
                for (int bj = 0; bj < 2; ++bj) { const f32x4 pv = top ? (f32x4){0.f, 0.f, 0.f, 0.f} : *(const PG8_LAS f32x4*)(halo + ((pblk * 2 + (fr & 1)) * 256 + bj * 128 + cl + 4 * n));
#pragma unroll
                    for (int k = 0; k < 4; ++k) { q1[bj][k] = dpp_ror1(pv[k]); q2[bj][k] = dpp_ror2(pv[k]); } }
#pragma unroll
                for (int m = 0; m < 4; ++m) {
                    const int row = u.pm * BM + ai * HALF + wr * 64 + m * 16 + fr; const float sc = rsqrtf(ssq[row] * (1.0f / 1024.0f) + RMS_EPS);
                    f32x4 cu[2];
#pragma unroll
                    for (int bj = 0; bj < 2; ++bj) { const f32x4 ya = acc[ai][bj][m][0];
#pragma unroll
                        for (int k = 0; k < 4; ++k) { const float y = ya[k] * sc;
                            const float a1 = dpp_ror1(y), a2 = dpp_ror2(y);
                            const float p1 = (fr == 0) ? q1[bj][k] : a1, p2 = (fr < 2) ? q2[bj][k] : a2;
                            cu[bj][k] = w[2][bj][k] * y + w[1][bj][k] * p1 + w[0][bj][k] * p2; q1[bj][k] = a1; q2[bj][k] = a2; } }
                    if (top && m == 0 && fr < 2 && (u.pm & 7) != 0) {
#pragma unroll
                        for (int bj = 0; bj < 2; ++bj) *(f32x4*)(UPART + ((size_t)(u.pm * 22 + u.pn) * 2 + fr) * 256 + bj * 128 + cl + 4 * n) = cu[bj];
                    }
                    u32x2v o;
#define PG8_SG(k_) (cu[0][k_] * __builtin_amdgcn_rcpf(1.0f + __expf(-cu[0][k_])) * cu[1][k_])
                    o.x = cvt_pk_bf16(PG8_SG(0), PG8_SG(1)); o.y = cvt_pk_bf16(PG8_SG(2), PG8_SG(3));
#undef PG8_SG
                    *(u32x2v*)(ACT + (size_t)row * 2816 + ch + 4 * n) = o;
                    asm volatile("" ::: "memory");
                }
            }
            if (n == 0) {
#pragma unroll
                for (int ai = 0; ai < 2; ++ai)
#pragma unroll
                    for (int bj = 0; bj < 2; ++bj)
#pragma unroll
                        for (int m = 0; m < 4; ++m) acc[ai][bj][m][0] = acc[ai][bj][m][1];
            }
        }
        asm volatile("s_waitcnt lgkmcnt(0)" ::: "memory"); __builtin_amdgcn_s_barrier(); asm volatile("" ::: "memory");
    }
};

struct EpiResidNorm {
    static constexpr bool PERM = false, AFTER_DRAIN = false;
    const bf16_t* base; float* out; float* ssq2; unsigned* cnt; const float* fnw; int ldc;
    __device__ __forceinline__ void operator()(f32x4 (&acc)[2][2][4][2], const Unit& u, int wr, int wc, int fr, int fq) const {
        typedef unsigned u32x2v __attribute__((ext_vector_type(2)));
        const int col0 = u.pn * BM + wc * 32 + 4 * fq;
#pragma unroll
        for (int ai = 0; ai < 2; ++ai) {
            u32x2v bv[4][2][2];
#pragma unroll
            for (int m = 0; m < 4; ++m) { const size_t off = (size_t)(u.pm * BM + ai * HALF + wr * 64 + m * 16 + fr) * ldc + col0;
#pragma unroll
                for (int bj = 0; bj < 2; ++bj)
#pragma unroll
                    for (int n = 0; n < 2; ++n) bv[m][bj][n] = *(const u32x2v*)(base + off + bj * HALF + n * 16); }
#pragma unroll
            for (int m = 0; m < 4; ++m) { const int row = u.pm * BM + ai * HALF + wr * 64 + m * 16 + fr; float s = 0.f;
#pragma unroll
                for (int bj = 0; bj < 2; ++bj)
#pragma unroll
                    for (int n = 0; n < 2; ++n) { const u32x2v bw = bv[m][bj][n]; const f32x4 v = acc[ai][bj][m][n] + (f32x4){__uint_as_float(bw.x << 16), __uint_as_float(bw.x & 0xffff0000u), __uint_as_float(bw.y << 16), __uint_as_float(bw.y & 0xffff0000u)}; acc[ai][bj][m][n] = v; s += (v[0] * v[0] + v[1] * v[1]) + (v[2] * v[2] + v[3] * v[3]); }
                s += __shfl_xor(s, 16); s += __shfl_xor(s, 32);
                if (fq == 0) (void)__hip_atomic_fetch_add(ssq2 + row, s, __ATOMIC_RELAXED, __HIP_MEMORY_SCOPE_AGENT); }
            asm volatile("" ::: "memory");
        }
        asm volatile("s_waitcnt vmcnt(0)" ::: "memory"); __builtin_amdgcn_s_barrier(); asm volatile("" ::: "memory");
        if (wr == 0 && wc == 0 && fr == 0 && fq == 0) {
            __builtin_amdgcn_fence(__ATOMIC_RELEASE, "agent"); asm volatile("s_waitcnt vmcnt(0)" ::: "memory");
            (void)__hip_atomic_fetch_add(cnt + 16 * u.pm, 1u, __ATOMIC_RELAXED, __HIP_MEMORY_SCOPE_AGENT);
            unsigned sp = 0;
            while (__hip_atomic_load(cnt + 16 * u.pm, __ATOMIC_RELAXED, __HIP_MEMORY_SCOPE_AGENT) < 4u) { __builtin_amdgcn_s_sleep(1); if (++sp > (1u << 22)) break; }
            __builtin_amdgcn_fence(__ATOMIC_ACQUIRE, "agent"); asm volatile("s_waitcnt vmcnt(0)" ::: "memory");
        }
        __builtin_amdgcn_s_barrier(); asm volatile("" ::: "memory");
        f32x4 nw[2][2];
#pragma unroll
        for (int bj = 0; bj < 2; ++bj)
#pragma unroll
            for (int n = 0; n < 2; ++n) nw[bj][n] = *(const f32x4*)(fnw + col0 + bj * HALF + n * 16);
#pragma unroll
        for (int ai = 0; ai < 2; ++ai)
#pragma unroll
            for (int m = 0; m < 4; ++m) { const int row = u.pm * BM + ai * HALF + wr * 64 + m * 16 + fr; const size_t off = (size_t)row * ldc + col0;
                const float rstd = rsqrtf(__hip_atomic_load(ssq2 + row, __ATOMIC_RELAXED, __HIP_MEMORY_SCOPE_AGENT) * (1.0f / 1024.0f) + RMS_EPS);
#pragma unroll
                for (int bj = 0; bj < 2; ++bj)
#pragma unroll
                    for (int n = 0; n < 2; ++n) { const f32x4 v = acc[ai][bj][m][n]; *(f32x4*)(out + off + bj * HALF + n * 16) = (f32x4){v[0] * rstd * nw[bj][n][0], v[1] * rstd * nw[bj][n][1], v[2] * rstd * nw[bj][n][2], v[3] * rstd * nw[bj][n][3]}; } }
    }
};
template <class Epi, class Sched, bool ALIGN_EPI = false, bool SP2 = false>
__device__ __forceinline__ void gemm_phase(PG8_LAS unsigned char* lds, const Gemm g, const Sched& S, const Epi& E) {
    const int tid = threadIdx.x, wid = __builtin_amdgcn_readfirstlane(tid >> 6), lane = tid & 63, wr = wid >> 2, wc = wid & 3, fr = lane & 15, fq = lane >> 4;
    const int K = g.K, nt = K / BK;
    unsigned voffA[2], voffB[2];
#pragma unroll
    for (int i = 0; i < 2; ++i) { int R, C; stage_rc(tid * 16 + i * 8192, R, C); const int Rb = Epi::PERM ? ((R & ~31) + perm32(R & 31)) : R;
        voffA[i] = (unsigned)(R * K + C) * 2u; voffB[i] = (unsigned)(Rb * K + C) * 2u; }
    const size_t kstep = (size_t)(BK * 2);
    const size_t hstep = (size_t)HALF * K * 2;
    const size_t tstep = 2 * hstep;
    const unsigned ldsw = (unsigned)wid * 1024u;
    const int aoff = lds_byte(wr * 64 + fr, fq * 8), boff = lds_byte(wc * 32 + fr, fq * 8);
#define PG8_SA(b, h) (((b) * 2 + (h)) * HTB)
#define PG8_SB(b, h) ((4 + (b) * 2 + (h)) * HTB)
#define PG8_STAGE(bufoff, gbase, voff) do { _Pragma("unroll") for (int _i = 0; _i < 2; ++_i) \
        __builtin_amdgcn_global_load_lds((const unsigned*)((const char*)(gbase) + (voff)[_i]), (PG8_LAS unsigned*)(lds + (bufoff) + ldsw + _i * 8192), 16, 0, 0); } while (0)
#define PG8_LDA(dst, b, h) do { _Pragma("unroll") for (int m = 0; m < 4; ++m) _Pragma("unroll") for (int k = 0; k < 2; ++k) dst[m][k] = *(const PG8_LAS bf16x8*)(lds + PG8_SA(b, h) + aoff + m * 2048 + k * 1024); } while (0)
#define PG8_LDB(dst, b, h) do { _Pragma("unroll") for (int n = 0; n < 2; ++n) _Pragma("unroll") for (int k = 0; k < 2; ++k) dst[n][k] = *(const PG8_LAS bf16x8*)(lds + PG8_SB(b, h) + boff + n * 2048 + k * 1024); } while (0)
#define PG8_MMA(ai, bj, At, Bt) do { __builtin_amdgcn_s_setprio(1); _Pragma("unroll") for (int m = 0; m < 4; ++m) _Pragma("unroll") for (int n = 0; n < 2; ++n) _Pragma("unroll") for (int k = 0; k < 2; ++k) \
        acc[ai][bj][m][n] = __builtin_amdgcn_mfma_f32_16x16x32_bf16(Bt[n][k], At[m][k], acc[ai][bj][m][n], 0, 0, 0); __builtin_amdgcn_s_setprio(0); } while (0)
#define PG8_WAIT_V(n) asm volatile("s_waitcnt vmcnt(" #n ")" ::: "memory")
#define PG8_WAIT_L(n) asm volatile("s_waitcnt lgkmcnt(" #n ")" ::: "memory")
#define PG8_BAR __builtin_amdgcn_s_barrier()
#define PG8_SCHED __builtin_amdgcn_sched_barrier(0)
    Unit cur, nxt; int ui = 0;
    if (!S.next(0, cur)) return;
    f32x4 acc[2][2][4][2];
#pragma unroll
    for (int a = 0; a < 2; ++a)
#pragma unroll
        for (int b = 0; b < 2; ++b)
#pragma unroll
            for (int m = 0; m < 4; ++m)
#pragma unroll
                for (int n = 0; n < 2; ++n) acc[a][b][m][n] = (f32x4){0.f, 0.f, 0.f, 0.f};
    bf16x8 At[4][2], B0[2][2], B1[2][2];
    const char* cA = (const char*)g.A + (size_t)cur.pm * tstep; const char* cB = (const char*)g.Bt + (size_t)cur.pn * tstep;
    S.a_ready(cur);
    if constexpr (SP2) {
        PG8_STAGE(PG8_SB(0, 0), cB, voffB); PG8_STAGE(PG8_SB(0, 1), cB + hstep, voffB); PG8_STAGE(PG8_SA(0, 0), cA, voffA); PG8_STAGE(PG8_SA(0, 1), cA + hstep, voffA);
        if (wr == 1) PG8_BAR;
        PG8_WAIT_V(2); PG8_BAR;
        PG8_STAGE(PG8_SB(1, 0), cB + kstep, voffB); PG8_STAGE(PG8_SA(1, 0), cA + kstep, voffA); PG8_STAGE(PG8_SB(1, 1), cB + hstep + kstep, voffB);
        PG8_WAIT_V(6); PG8_BAR;
    } else {
        PG8_STAGE(PG8_SB(0, 0), cB, voffB); PG8_STAGE(PG8_SA(0, 0), cA, voffA); PG8_STAGE(PG8_SB(0, 1), cB + hstep, voffB); PG8_STAGE(PG8_SA(0, 1), cA + hstep, voffA);
        if (wr == 1) PG8_BAR;
        PG8_WAIT_V(4); PG8_BAR;
        PG8_STAGE(PG8_SB(1, 0), cB + kstep, voffB); PG8_STAGE(PG8_SA(1, 0), cA + kstep, voffA); PG8_STAGE(PG8_SB(1, 1), cB + hstep + kstep, voffB);
        PG8_WAIT_V(6); PG8_BAR;
    }
    for (;;) {
        const bool has_next = S.next(ui + 1, nxt);
        const char* nA = has_next ? (const char*)g.A + (size_t)nxt.pm * tstep : cA; const char* nB = has_next ? (const char*)g.Bt + (size_t)nxt.pn * tstep : cB;
        for (int t = 0; t < nt; t += 2) {
            const bool last = (t == nt - 2);
            const char* a1 = cA + (size_t)(t + 1) * kstep;
            const char* a2 = last ? nA : cA + (size_t)(t + 2) * kstep; const char* b2 = last ? nB : cB + (size_t)(t + 2) * kstep;
            const char* a3 = a2 + kstep; const char* b3 = b2 + kstep;
            if (last && has_next) S.a_ready(nxt);
            if constexpr (SP2) {
            PG8_LDB(B0, 0, 0); PG8_LDB(B1, 0, 1); PG8_SCHED; PG8_LDA(At, 0, 0); PG8_STAGE(PG8_SA(1, 1), a1 + hstep, voffA);
            PG8_WAIT_V(8); PG8_WAIT_L(0); PG8_BAR; PG8_MMA(0, 0, At, B0); PG8_MMA(0, 1, At, B1); PG8_BAR; PG8_SCHED;
            PG8_LDA(At, 0, 1); PG8_STAGE(PG8_SB(0, 0), b2, voffB); PG8_STAGE(PG8_SB(0, 1), b2 + hstep, voffB); PG8_STAGE(PG8_SA(0, 0), a2, voffA);
            PG8_WAIT_V(8); PG8_WAIT_L(0); PG8_BAR; PG8_MMA(1, 0, At, B0); PG8_MMA(1, 1, At, B1); PG8_BAR; PG8_SCHED;
            PG8_LDB(B0, 1, 0); PG8_LDB(B1, 1, 1); PG8_SCHED; PG8_LDA(At, 1, 0); PG8_STAGE(PG8_SA(0, 1), a2 + hstep, voffA);
            PG8_WAIT_V(8); PG8_WAIT_L(0); PG8_BAR; PG8_MMA(0, 0, At, B0); PG8_MMA(0, 1, At, B1); PG8_BAR; PG8_SCHED;
            PG8_LDA(At, 1, 1); PG8_STAGE(PG8_SB(1, 0), b3, voffB); PG8_STAGE(PG8_SB(1, 1), b3 + hstep, voffB); PG8_STAGE(PG8_SA(1, 0), a3, voffA);
            PG8_WAIT_V(8); PG8_WAIT_L(0); PG8_BAR; PG8_MMA(1, 0, At, B0); PG8_MMA(1, 1, At, B1); PG8_BAR; PG8_SCHED;
            } else {
            PG8_LDB(B0, 0, 0); PG8_SCHED; PG8_LDA(At, 0, 0); PG8_STAGE(PG8_SA(1, 1), a1 + hstep, voffA);
            PG8_WAIT_L(8); PG8_BAR; PG8_WAIT_L(0); PG8_MMA(0, 0, At, B0); PG8_BAR; PG8_SCHED;
            PG8_LDB(B1, 0, 1); PG8_STAGE(PG8_SB(0, 0), b2, voffB);
            PG8_BAR; PG8_WAIT_L(0); PG8_MMA(0, 1, At, B1); PG8_BAR;
            PG8_LDA(At, 0, 1); PG8_STAGE(PG8_SA(0, 0), a2, voffA);
            PG8_BAR; PG8_WAIT_L(0); PG8_MMA(1, 0, At, B0); PG8_BAR; PG8_SCHED;
            PG8_STAGE(PG8_SB(0, 1), b2 + hstep, voffB);
            PG8_WAIT_V(6); PG8_BAR; PG8_MMA(1, 1, At, B1); PG8_BAR;
            PG8_LDB(B0, 1, 0); PG8_SCHED; PG8_LDA(At, 1, 0); PG8_STAGE(PG8_SA(0, 1), a2 + hstep, voffA);
            PG8_WAIT_L(8); PG8_BAR; PG8_WAIT_L(0); PG8_MMA(0, 0, At, B0); PG8_BAR; PG8_SCHED;
            PG8_LDB(B1, 1, 1); PG8_STAGE(PG8_SB(1, 0), b3, voffB);
            PG8_BAR; PG8_WAIT_L(0); PG8_MMA(0, 1, At, B1); PG8_BAR;
            PG8_LDA(At, 1, 1); PG8_STAGE(PG8_SA(1, 0), a3, voffA);
            PG8_BAR; PG8_WAIT_L(0); PG8_MMA(1, 0, At, B0); PG8_BAR; PG8_SCHED;
            PG8_STAGE(PG8_SB(1, 1), b3 + hstep, voffB);
            PG8_WAIT_V(6); PG8_BAR; PG8_MMA(1, 1, At, B1); PG8_BAR;
            }
        }
        if constexpr (ALIGN_EPI) { if (wr == 0) PG8_BAR; }
        if constexpr (!Epi::AFTER_DRAIN) { E(acc, cur, wr, wc, fr, fq); S.done(cur); }
        if (!has_next) break;
#pragma unroll
        for (int a = 0; a < 2; ++a)
#pragma unroll
            for (int b = 0; b < 2; ++b)
#pragma unroll
                for (int m = 0; m < 4; ++m)
#pragma unroll
                    for (int n = 0; n < 2; ++n) acc[a][b][m][n] = (f32x4){0.f, 0.f, 0.f, 0.f};
        cur = nxt; cA = nA; cB = nB; ++ui;
        if constexpr (ALIGN_EPI) { if (wr == 1) PG8_BAR; }
    }
    PG8_WAIT_V(0);
    if constexpr (!ALIGN_EPI) { if (wr == 0) PG8_BAR; }
    PG8_BAR;
    if constexpr (Epi::AFTER_DRAIN) { E.fused(acc, cur, wr, wc, fr, fq, lds, wid, lane); S.done(cur); }
#undef PG8_SA
#undef PG8_SB
#undef PG8_STAGE
#undef PG8_LDA
#undef PG8_LDB
#undef PG8_MMA
#undef PG8_WAIT_V
#undef PG8_WAIT_L
#undef PG8_BAR
#undef PG8_SCHED
}
}
#ifndef PG8_SP2
#define PG8_SP2 true
#endif
#ifndef PG8_ALIGN
#define PG8_ALIGN true
#endif
constexpr int NB = 8, SEQ = 2048, DM = 1024, M = NB * SEQ;
constexpr int GH = 4, GD = 128, GW = 512, AH = 8, AD = 64;
constexpr int INC = 3592, NP = 3584;
constexpr int DFF = 2816, NUP = 2 * DFF;
constexpr int PC_QA = 0, PC_KA = 512, PC_VA = 1024, PC_Z = 1536, PC_QB = 2048, PC_KB = 2560, PC_VB = 3072;
constexpr size_t MiB = 1u << 20;
constexpr size_t WS_CTL = 0, WS_AB = 1 * MiB, WS_SSQ = 1 * MiB + 768 * 1024, WS_WIN = 2 * MiB, WS_WOUT = 9 * MiB, WS_WUP = 11 * MiB, WS_WDN = 22 * MiB;
constexpr size_t WS_XN = 28 * MiB, WS_PROJ = 60 * MiB, WS_CAT = 172 * MiB, WS_OA = 204 * MiB, WS_Y = 60 * MiB, WS_ACT = 148 * MiB, WS_END = 256 * MiB;
using pg8::RMS_EPS;
constexpr size_t WS_YH = 236 * MiB, WS_UPART = 240 * MiB;
constexpr size_t WS_SSQ2 = WS_SSQ + 131072;
constexpr size_t WS_GE = WS_SSQ + 65536;
constexpr int GOPS_CHUNK = 57344;
constexpr int SCAN_BUF = GOPS_CHUNK + 16384;
constexpr int NWAVES = 8, NTHR = 512;
constexpr int LDS_BYTES = 155648;
#define LAS __attribute__((address_space(3)))
typedef unsigned short bf16;
typedef unsigned v4u __attribute__((ext_vector_type(4)));
typedef unsigned v2u __attribute__((ext_vector_type(2)));
typedef float f32x4 __attribute__((ext_vector_type(4)));
__device__ __forceinline__ float bf2f(unsigned b) { return __uint_as_float(b << 16); }
__device__ __forceinline__ float bflo(unsigned w) { return __uint_as_float(w << 16); }
__device__ __forceinline__ float bfhi(unsigned w) { return __uint_as_float(w & 0xffff0000u); }
__device__ __forceinline__ unsigned pk2(float lo, float hi) { return pg8::cvt_pk_bf16(lo, hi); }
__device__ __forceinline__ float wave_sum(float v) {
#pragma unroll
    for (int o = 1; o < 64; o <<= 1) v += __shfl_xor(v, o);
    return v;
}
__device__ __forceinline__ float silu_f(float x) { return x * __builtin_amdgcn_rcpf(1.0f + __expf(-x)); }
__device__ __forceinline__ float sigmoid_f(float x) { return __builtin_amdgcn_rcpf(1.0f + __expf(-x)); }
__device__ __forceinline__ float softplus_f(float x) { return x > 20.f ? x : log1pf(__expf(x)); }

struct Args { const float* in[13]; float* out; unsigned char* ws; int ph_lo, ph_hi, coop, pad; };

__device__ __forceinline__ void p0_transpose_item(const float* W, int ldw, int k0, int sn0, bf16* WT, int K, int dn0, const float* kscale, LAS float* scr, int lane) {
    float tv[32];
#pragma unroll
    for (int i = 0; i < 32; ++i) { const int kk = 2 * i + (lane >> 5); tv[i] = W[(size_t)(k0 + kk) * ldw + sn0 + (lane & 31)]; }
    if (kscale) {
#pragma unroll
        for (int i = 0; i < 32; ++i) tv[i] *= kscale[k0 + 2 * i + (lane >> 5)]; }
#pragma unroll
    for (int i = 0; i < 32; ++i) scr[(2 * i + (lane >> 5)) * 33 + (lane & 31)] = tv[i];
    asm volatile("s_waitcnt lgkmcnt(0)" ::: "memory");
    const int c = lane & 7;
#pragma unroll
    for (int j = 0; j < 4; ++j) { const int n = (lane >> 3) + 8 * j; const LAS float* s = scr + (8 * c) * 33 + n;
        v4u o; o.x = pk2(s[0 * 33], s[1 * 33]); o.y = pk2(s[2 * 33], s[3 * 33]); o.z = pk2(s[4 * 33], s[5 * 33]); o.w = pk2(s[6 * 33], s[7 * 33]);
        *(v4u*)(WT + (size_t)(dn0 + n) * K + k0 + 8 * c) = o; }
    asm volatile("s_waitcnt lgkmcnt(0)" ::: "memory");
}

__device__ __forceinline__ void p0_prologue(const Args& A, LAS unsigned char* lds, int tid, int lane, int wave) {
    const float* x = A.in[0]; const float* nw1 = A.in[1]; const float* w_in = A.in[2]; const float* w_out = A.in[7]; const float* nw2 = A.in[8];
    const float* w_up = A.in[9]; const float* w_dn = A.in[11];
    unsigned char* ws = A.ws;
    bf16* WIN = (bf16*)(ws + WS_WIN); bf16* WOUT = (bf16*)(ws + WS_WOUT); bf16* WUP = (bf16*)(ws + WS_WUP); bf16* WDN = (bf16*)(ws + WS_WDN);
    bf16* XN = (bf16*)(ws + WS_XN); float* AB = (float*)(ws + WS_AB); float* SSQ = (float*)(ws + WS_SSQ);
    LAS float* scr = (LAS float*)(lds + wave * 9216);
    LAS float* wab = (LAS float*)(lds + 73728);
    const int G = gridDim.x, gw = blockIdx.x * NWAVES + wave, NGW = G * NWAVES;
    for (int i = blockIdx.x * NTHR + tid; i < M; i += G * NTHR) { SSQ[i] = 0.f; ((float*)(ws + WS_SSQ2))[i] = 0.f; }
    if (blockIdx.x == 0 && tid < 64) ((unsigned*)(ws + WS_CTL))[tid] = 0u;
    for (int idx = tid; idx < 8192; idx += NTHR) { const int k = idx >> 3, j = idx & 7; wab[j * 1024 + k] = nw1[k] * w_in[(size_t)k * INC + 2048 + j]; }
    constexpr int I_IN = 16 * (NP / 32);
    for (int it = gw; it < I_IN; it += NGW) { const int nblk = NP / 32, kb = it / nblk, nb = it % nblk, n0 = 32 * nb; p0_transpose_item(w_in, INC, 64 * kb, n0 + (n0 >= 2048 ? 8 : 0), WIN, DM, n0, nullptr, scr, lane); }
    __syncthreads();
    for (int m0 = gw; m0 < M; m0 += 2 * NGW) {
        const f32x4* nr = (const f32x4*)nw1 + lane;
        f32x4 v[2][4]; float s[2] = {0.f, 0.f};
#pragma unroll
        for (int rr = 0; rr < 2; ++rr) { const int m = min(m0 + rr * NGW, M - 1); const f32x4* xr = (const f32x4*)(x + (size_t)m * DM) + lane;
#pragma unroll
            for (int j = 0; j < 4; ++j) v[rr][j] = xr[64 * j]; }
#pragma unroll
        for (int rr = 0; rr < 2; ++rr)
#pragma unroll
            for (int j = 0; j < 4; ++j) s[rr] += (v[rr][j].x * v[rr][j].x + v[rr][j].y * v[rr][j].y) + (v[rr][j].z * v[rr][j].z + v[rr][j].w * v[rr][j].w);
#pragma unroll
        for (int rr = 0; rr < 2; ++rr) { const int m = m0 + rr * NGW; if (m >= M) break;
            const float rstd = rsqrtf(wave_sum(s[rr]) * (1.f / DM) + RMS_EPS);
            float ab[8];
#pragma unroll
            for (int q = 0; q < 8; ++q) { float a = 0.f;
#pragma unroll
                for (int j = 0; j < 4; ++j) { const f32x4 w = *(const LAS f32x4*)(wab + q * 1024 + 256 * j + 4 * lane); a += (v[rr][j].x * w.x + v[rr][j].y * w.y) + (v[rr][j].z * w.z + v[rr][j].w * w.w); }
                ab[q] = wave_sum(a) * rstd; }
            if (lane == 0) { *(f32x4*)(AB + (size_t)m * 8) = (f32x4){ab[0], ab[1], ab[2], ab[3]}; *(f32x4*)(AB + (size_t)m * 8 + 4) = (f32x4){ab[4], ab[5], ab[6], ab[7]}; }
            v2u* o8 = (v2u*)(XN + (size_t)m * DM) + lane;
#pragma unroll
            for (int j = 0; j < 4; ++j) { const f32x4 n = nr[64 * j]; v2u o; o.x = pk2(v[rr][j].x * rstd * n.x, v[rr][j].y * rstd * n.y); o.y = pk2(v[rr][j].z * rstd * n.z, v[rr][j].w * rstd * n.w); o8[64 * j] = o; }
        }
    }
}


__device__ __forceinline__ void convert_late_weights(const Args& A, LAS unsigned char* lds, int lane, int wave, int gw0, int ngw) {
    const float* w_out = A.in[7]; const float* nw2 = A.in[8]; const float* w_up = A.in[9]; const float* w_dn = A.in[11];
    bf16* WOUT = (bf16*)(A.ws + WS_WOUT); bf16* WUP = (bf16*)(A.ws + WS_WUP); bf16* WDN = (bf16*)(A.ws + WS_WDN);
    LAS float* scr = (LAS float*)(lds + wave * 9216);
    constexpr int I_OUT = 16 * 32, I_UP = 16 * (NUP / 32), I_DN = (DFF / 64) * 32;
    for (int it = gw0; it < I_OUT + I_UP + I_DN; it += ngw) {
        int r = it;
        if (r < I_OUT) { const int kb = r / 32, nb = r % 32; p0_transpose_item(w_out, DM, 64 * kb, 32 * nb, WOUT, DM, 32 * nb, nullptr, scr, lane); continue; } r -= I_OUT;
        if (r < I_UP) { const int nblk = NUP / 32, kb = r / nblk, nb = r % nblk, n0 = 32 * nb, pn = n0 >> 8, j0 = n0 & 255;
            const int s0 = (j0 < 128) ? (128 * pn + j0) : (DFF + 128 * pn + j0 - 128);
            p0_transpose_item(w_up, NUP, 64 * kb, s0, WUP, DM, n0, nw2, scr, lane); continue; } r -= I_UP;
        { const int kb = r / 32, nb = r % 32; p0_transpose_item(w_dn, DM, 64 * kb, 32 * nb, WDN, DFF, 32 * nb, nullptr, scr, lane); }
    }
}
__device__ __forceinline__ void gdn_simple(const Args& A, LAS unsigned char* lds, int tid, int lane, int wave) {
    const bf16* PROJ = (const bf16*)(A.ws + WS_PROJ); const float* AB = (const float*)(A.ws + WS_AB); float* OA = (float*)(A.ws + WS_OA);
    const float* cw = A.in[3]; const float* a_log = A.in[4]; const float* dt_bias = A.in[5];
    LAS float* qs = (LAS float*)lds; LAS float* ks = qs + 16 * 128; LAS float* vs = ks + 16 * 128; LAS float* av = vs + 16 * 128; LAS float* bv = av + 16;
    for (int task = blockIdx.x; task < NB * GH; task += gridDim.x) {
        const int b = task / GH, h = task % GH, v = tid >> 2, part = tid & 3;
        float S[32];
#pragma unroll
        for (int i = 0; i < 32; ++i) S[i] = 0.f;
        const float Ah = __expf(a_log[h]), dtb = dt_bias[h];
        for (int blk = 0; blk < SEQ / 16; ++blk) {
            const int t0 = blk * 16;
            for (int idx = tid; idx < 16 * 384; idx += NTHR) {
                const int tt = idx / 384, c = idx % 384, which = c >> 7, d = c & 127, col = which * 512 + h * 128 + d, t = t0 + tt;
                float acc = 0.f;
#pragma unroll
                for (int i = 0; i < 4; ++i) { const int ts = t - 3 + i; if (ts >= 0) acc += cw[i * 1536 + col] * bf2f(PROJ[(size_t)(b * SEQ + ts) * NP + col]); }
                qs[which * 2048 + tt * 128 + d] = silu_f(acc);
            }
            if (tid < 16) { const size_t row = (size_t)b * SEQ + t0 + tid; bv[tid] = sigmoid_f(AB[row * 8 + h]); av[tid] = __expf(-Ah * softplus_f(AB[row * 8 + 4 + h] + dtb)); }
            __syncthreads();
#pragma unroll
            for (int r = 0; r < 4; ++r) { const int row = 4 * wave + r; LAS float* arr = qs + row * 128;
                const float v0 = arr[lane], v1 = arr[lane + 64]; const float s = wave_sum(v0 * v0 + v1 * v1);
                const float sc = rsqrtf(s + RMS_EPS) * (row < 16 ? 0.08838834764831845f : 1.0f); arr[lane] = v0 * sc; arr[lane + 64] = v1 * sc; }
            __syncthreads();
            for (int tt = 0; tt < 16; ++tt) {
                const float a = av[tt], bt = bv[tt], vt = vs[tt * 128 + v];
                float kS = 0.f;
#pragma unroll
                for (int i = 0; i < 32; ++i) kS += ks[tt * 128 + 32 * part + i] * S[i];
                kS += __shfl_xor(kS, 1); kS += __shfl_xor(kS, 2);
                const float c = bt * (vt - a * kS); float o = 0.f;
#pragma unroll
                for (int i = 0; i < 32; ++i) { S[i] = a * S[i] + ks[tt * 128 + 32 * part + i] * c; o += qs[tt * 128 + 32 * part + i] * S[i]; }
                o += __shfl_xor(o, 1); o += __shfl_xor(o, 2);
                if (part == 0) OA[(size_t)(b * SEQ + t0 + tt) * GW + h * 128 + v] = o;
            }
            __syncthreads();
        }
    }
}


template <int J, int K, int N> struct SolveLd {
    static __device__ __forceinline__ void run(f32x4 (&l)[4], unsigned lbase) {
        if constexpr (K < N) { constexpr int t40 = ((J + 1) >> 2) << 2;
            asm volatile("ds_read_b128 %0, %1 offset:%2" : "=v"(l[K]) : "v"(lbase), "i"((J * 68 + t40 + 4 * K) * 4)); SolveLd<J, K + 1, N>::run(l, lbase); }
    }
};
template <int J> struct SolveCol16 {
    static __device__ __forceinline__ void run(float (&R)[16], unsigned lbase) {
        if constexpr (J < 15) {
            constexpr int t40 = ((J + 1) >> 2) << 2, nld = (16 - t40) >> 2;
            f32x4 l[4];
            SolveLd<J, 0, nld>::run(l, lbase);
            asm volatile("s_waitcnt lgkmcnt(0)" ::: "memory");
#pragma unroll
            for (int k = 0; k < nld; ++k) asm volatile("" : "+v"(l[k]));
#pragma unroll
            for (int k = 0; k < nld; ++k) {
#pragma unroll
                for (int e = 0; e < 4; ++e) if (t40 + 4 * k + e > J) R[t40 + 4 * k + e] += l[k][e] * R[J]; }
            SolveCol16<J + 1>::run(R, lbase);
        }
    }
};

typedef short bf16x8 __attribute__((ext_vector_type(8)));
__device__ __forceinline__ void gdn_prep(const Args& A, LAS unsigned char* lds, int tid0, int lane0, int wave) {
    const bf16* PROJ = (const bf16*)(A.ws + WS_PROJ); const float* AB = (const float*)(A.ws + WS_AB);
    const float* cw = A.in[3]; const float* a_log = A.in[4]; const float* dt_bias = A.in[5];
    unsigned char* UVF = A.ws + WS_XN; unsigned char* GOPS = (unsigned char*)A.out; float* GE = (float*)(A.ws + WS_GE);
    LAS float* Qs = (LAS float*)lds; LAS float* Ks = (LAS float*)(lds + 33792); LAS float* Vs = (LAS float*)(lds + 67584);
    LAS bf16* Qb = (LAS bf16*)(lds + 101376); LAS bf16* Kb = (LAS bf16*)(lds + 118784);
    LAS float* gcs = (LAS float*)(lds + 136192); LAS float* bts = gcs + 64; LAS float* egs = gcs + 128; LAS float* kes = gcs + 192;
    LAS float* LsT = (LAS float*)lds; LAS bf16* ATs = (LAS bf16*)(lds + 17408); LAS bf16* WKs = Kb;
    v4u rwn[11];
    if (tid0 < 384 && (int)blockIdx.x < NB * GH * 32) { const int c8 = tid0 % 48, run = tid0 / 48, which = c8 >> 4, d0 = (c8 & 15) * 8, t1 = blockIdx.x, bh1 = t1 >> 5, n1 = t1 & 31, b1 = bh1 >> 2, h1 = bh1 & 3, col1 = which * 512 + h1 * 128 + d0;
#pragma unroll
        for (int r = 0; r < 11; ++r) { const int ts = 64 * n1 + 8 * run - 3 + r; rwn[r] = (ts >= 0) ? *(const v4u*)(PROJ + (size_t)(b1 * SEQ + ts) * NP + col1) : (v4u){0u, 0u, 0u, 0u}; } }
    else {
#pragma unroll
        for (int r = 0; r < 11; ++r) rwn[r] = (v4u){0u, 0u, 0u, 0u}; }
#pragma unroll 1
    for (int task = blockIdx.x; task < NB * GH * 32; task += gridDim.x) {
        int tid = tid0, lane = lane0; asm volatile("" : "+v"(tid), "+v"(lane));
        const int fr = lane & 15, fq = lane >> 4;
        const int bh = task >> 5, n = task & 31, b = bh >> 2, h = bh & 3, t0 = 64 * n, row0 = b * SEQ + t0;
        unsigned char* gops = GOPS + (size_t)task * GOPS_CHUNK;
        if (tid < 384) {
            const int c8 = tid % 48, run = tid / 48, which = c8 >> 4, d0 = (c8 & 15) * 8, col = which * 512 + h * 128 + d0;
            v4u rw[11];
#pragma unroll
            for (int r = 0; r < 11; ++r) rw[r] = rwn[r];
            { const int tn = task + gridDim.x;
              if (tn < NB * GH * 32) { const int bhn = tn >> 5, nn = tn & 31, bn = bhn >> 2, hn = bhn & 3, coln = which * 512 + hn * 128 + d0;
#pragma unroll
                for (int r = 0; r < 11; ++r) { const int ts = 64 * nn + 8 * run - 3 + r; rwn[r] = (ts >= 0) ? *(const v4u*)(PROJ + (size_t)(bn * SEQ + ts) * NP + coln) : (v4u){0u, 0u, 0u, 0u}; } } }
            f32x4 cwa[4], cwb[4];
#pragma unroll
            for (int j = 0; j < 4; ++j) { cwa[j] = *(const f32x4*)(cw + j * 1536 + col); cwb[j] = *(const f32x4*)(cw + j * 1536 + col + 4); }
#pragma unroll
            for (int i = 0; i < 8; ++i) {
                float acc[8];
#pragma unroll
                for (int e2 = 0; e2 < 8; ++e2) acc[e2] = 0.f;
#pragma unroll
                for (int j = 0; j < 4; ++j) { const v4u w = rw[i + j];
                    acc[0] += cwa[j].x * bflo(w.x); acc[1] += cwa[j].y * bfhi(w.x); acc[2] += cwa[j].z * bflo(w.y); acc[3] += cwa[j].w * bfhi(w.y);
                    acc[4] += cwb[j].x * bflo(w.z); acc[5] += cwb[j].y * bfhi(w.z); acc[6] += cwb[j].z * bflo(w.w); acc[7] += cwb[j].w * bfhi(w.w); }
                float ss = 0.f;
#pragma unroll
                for (int e2 = 0; e2 < 8; ++e2) { acc[e2] = silu_f(acc[e2]); ss += acc[e2] * acc[e2]; }
                ss += __builtin_bit_cast(float, __builtin_amdgcn_update_dpp(0, __builtin_bit_cast(int, ss), 0xB1, 0xf, 0xf, false));
                ss += __builtin_bit_cast(float, __builtin_amdgcn_update_dpp(0, __builtin_bit_cast(int, ss), 0x4E, 0xf, 0xf, false));
                ss += __builtin_bit_cast(float, __builtin_amdgcn_update_dpp(0, __builtin_bit_cast(int, ss), 0x141, 0xf, 0xf, false));
                ss += __builtin_bit_cast(float, __builtin_amdgcn_update_dpp(0, __builtin_bit_cast(int, ss), 0x140, 0xf, 0xf, false));
                const int tt = 8 * run + i;
                if (which == 2) { *(LAS f32x4*)(Vs + tt * 132 + d0) = (f32x4){acc[0], acc[1], acc[2], acc[3]}; *(LAS f32x4*)(Vs + tt * 132 + d0 + 4) = (f32x4){acc[4], acc[5], acc[6], acc[7]}; }
                else {
                    const float sc = rsqrtf(ss + RMS_EPS) * (which == 0 ? 0.08838834764831845f : 1.0f);
#pragma unroll
                    for (int e2 = 0; e2 < 8; ++e2) acc[e2] *= sc;
                    const v4u pk = (v4u){pk2(acc[0], acc[1]), pk2(acc[2], acc[3]), pk2(acc[4], acc[5]), pk2(acc[6], acc[7])};
                    if (which == 0) *(LAS v4u*)(Qb + tt * 136 + d0) = pk;
                    else { *(LAS v4u*)(Kb + tt * 136 + d0) = pk; *(LAS f32x4*)(Ks + tt * 132 + d0) = (f32x4){acc[0], acc[1], acc[2], acc[3]}; *(LAS f32x4*)(Ks + tt * 132 + d0 + 4) = (f32x4){acc[4], acc[5], acc[6], acc[7]}; }
                }
            }
        }
        if (wave == 0) {
            const size_t row = (size_t)row0 + lane; const float beta = sigmoid_f(AB[row * 8 + h]);
            float g = -__expf(a_log[h]) * softplus_f(AB[row * 8 + 4 + h] + dt_bias[h]);
#pragma unroll
            for (int o = 1; o < 64; o <<= 1) { const float t = __shfl_up(g, o); if (lane >= o) g += t; }
            const float glast = __shfl(g, 63);
            gcs[lane] = g; bts[lane] = beta; egs[lane] = __expf(g); kes[lane] = __expf(glast - g) * beta;
            if (lane == 63) GE[task] = __expf(g);
        }
        __syncthreads();
#pragma unroll 1
        for (int jb = wave; jb < 20; jb += 8) {
            const int kind = jb >= 10 ? 1 : 0, idx = jb - 10 * kind, ti = idx < 1 ? 0 : (idx < 3 ? 1 : (idx < 6 ? 2 : 3)), tj = idx - ti * (ti + 1) / 2;
            const LAS bf16* As = kind ? Qb : Kb; f32x4 d = (f32x4){0.f, 0.f, 0.f, 0.f};
#pragma unroll
            for (int ks = 0; ks < 4; ++ks) { const bf16x8 a = *(const LAS bf16x8*)(As + (16 * ti + fr) * 136 + 32 * ks + 8 * fq), bb = *(const LAS bf16x8*)(Kb + (16 * tj + fr) * 136 + 32 * ks + 8 * fq);
                d = __builtin_amdgcn_mfma_f32_16x16x32_bf16(a, bb, d, 0, 0, 0); }
            const int j = 16 * tj + fr; const float gj = gcs[j], bj = bts[j]; float val[4];
#pragma unroll
            for (int e = 0; e < 4; ++e) { const int t = 16 * ti + 4 * fq + e; const float x = d[e] * __expf(gcs[t] - gj) * bj; val[e] = (kind ? (t >= j) : (t > j)) ? x : 0.f; }
            if (kind == 0) *(LAS f32x4*)(LsT + j * 68 + 16 * ti + 4 * fq) = (f32x4){-val[0], -val[1], -val[2], -val[3]};
            else {
#pragma unroll
                for (int e = 0; e < 4; ++e) ATs[(16 * ti + 4 * fq + e) * 72 + j] = (bf16)(pk2(val[e], 0.f) & 0xffffu); }
        }
        __syncthreads();
        LAS float* Ti = (LAS float*)(lds + 26624);
        if (wave == 0) {
            const int I = lane >> 4, c = lane & 15; float x[16];
#pragma unroll
            for (int r = 0; r < 16; ++r) x[r] = (r == c) ? 1.0f : 0.0f;
            SolveCol16<0>::run(x, (unsigned)(uintptr_t)LsT + (unsigned)(I * (16 * 68 + 16) * 4));
#pragma unroll
            for (int r = 0; r < 16; ++r) Ti[(I * 16 + r) * 20 + c] = x[r];
        } else {
            const int rt = tid - 64;
            for (int q = rt; q < 1024; q += 448) { const int blk = q >> 6, l2 = q & 63, i = l2 & 15, f = l2 >> 4, mb = blk >> 2, ks = blk & 3, t = 16 * mb + i;
                const v2u p0 = *(const LAS v2u*)(Qb + t * 136 + 32 * ks + 4 * f), p1 = *(const LAS v2u*)(Qb + t * 136 + 32 * ks + 16 + 4 * f); const float eg = egs[t];
                v4u o; o.x = pk2(bflo(p0.x) * eg, bfhi(p0.x) * eg); o.y = pk2(bflo(p0.y) * eg, bfhi(p0.y) * eg); o.z = pk2(bflo(p1.x) * eg, bfhi(p1.x) * eg); o.w = pk2(bflo(p1.y) * eg, bfhi(p1.y) * eg);
                *(v4u*)(gops + 16384 + q * 16) = o; }
            for (int q = rt; q < 512; q += 448) { const int blk = q >> 6, l2 = q & 63, i = l2 & 15, f = l2 >> 4, mb = blk >> 1, ks2 = blk & 1, t = 16 * mb + i;
                v2u p0 = (v2u){0u, 0u}, p1 = (v2u){0u, 0u};
                if (2 * ks2 <= mb) p0 = *(const LAS v2u*)(ATs + t * 72 + 32 * ks2 + 4 * f);
                if (2 * ks2 + 1 <= mb) p1 = *(const LAS v2u*)(ATs + t * 72 + 32 * ks2 + 16 + 4 * f);
                *(v4u*)(gops + 32768 + q * 16) = (v4u){p0.x, p0.y, p1.x, p1.y}; }
            for (int q = rt; q < 1024; q += 448) { const int blk = q >> 6, l2 = q & 63, i = l2 & 15, f = l2 >> 4, dkb = blk >> 1, ks2 = blk & 1, dk = 16 * dkb + i; float v[8];
#pragma unroll
                for (int e2 = 0; e2 < 8; ++e2) { const int c = 32 * ks2 + 16 * (e2 >> 2) + 4 * f + (e2 & 3); v[e2] = Ks[c * 132 + dk] * kes[c]; }
                *(v4u*)(gops + 40960 + q * 16) = (v4u){pk2(v[0], v[1]), pk2(v[2], v[3]), pk2(v[4], v[5]), pk2(v[6], v[7])}; }
        }
        __syncthreads();
#pragma unroll
        for (int ct = 0; ct < 2; ++ct) {
            const int C = 2 * wave + ct; const bool isv = C < 8; const int col = isv ? 16 * C + fr : 16 * (C - 8) + fr;
            f32x4 X[4];
#pragma unroll
            for (int I = 0; I < 4; ++I) {
                f32x4 acc;
#pragma unroll
                for (int e2 = 0; e2 < 4; ++e2) { const int t = 16 * I + 4 * fq + e2; acc[e2] = isv ? Vs[t * 132 + col] : egs[t] * Ks[t * 132 + col]; }
#pragma unroll
                for (int J = 0; J < 4; ++J) if (J < I) {
#pragma unroll
                    for (int kk = 0; kk < 4; ++kk) acc = __builtin_amdgcn_mfma_f32_16x16x4f32(LsT[(16 * J + 4 * fq + kk) * 68 + 16 * I + fr], X[J][kk], acc, 0, 0, 0); }
                f32x4 xi = (f32x4){0.f, 0.f, 0.f, 0.f};
#pragma unroll
                for (int kk = 0; kk < 4; ++kk) xi = __builtin_amdgcn_mfma_f32_16x16x4f32(Ti[(I * 16 + fr) * 20 + 4 * fq + kk], acc[kk], xi, 0, 0, 0);
                X[I] = xi;
                if (isv) { v2u w; w.x = pk2(xi[0], xi[1]); w.y = pk2(xi[2], xi[3]); *(v2u*)(UVF + (size_t)task * 16384 + (size_t)((C * 4 + I) * 64 + lane) * 8) = w; }
                else {
#pragma unroll
                    for (int e2 = 0; e2 < 4; ++e2) WKs[(16 * I + 4 * fq + e2) * 136 + col] = (bf16)(pk2(xi[e2], 0.f) & 0xffffu); }
            }
        }
        __syncthreads();
        for (int q = tid; q < 1024; q += NTHR) { const int blk = q >> 6, l2 = q & 63, i = l2 & 15, f = l2 >> 4, mb = blk >> 2, ks = blk & 3, t = 16 * mb + i;
            const v2u p0 = *(const LAS v2u*)(WKs + t * 136 + 32 * ks + 4 * f), p1 = *(const LAS v2u*)(WKs + t * 136 + 32 * ks + 16 + 4 * f);
            *(v4u*)(gops + q * 16) = (v4u){p0.x, p0.y, p1.x, p1.y}; }
        __syncthreads();
    }
}

__device__ __forceinline__ bf16x8 pack8(const f32x4 a, const f32x4 b) {
    v4u w; w.x = pk2(a[0], a[1]); w.y = pk2(a[2], a[3]); w.z = pk2(b[0], b[1]); w.w = pk2(b[2], b[3]); return __builtin_bit_cast(bf16x8, w);
}
__device__ __forceinline__ void gdn_scan(const Args& A, LAS unsigned char* lds, int bh, int tid, int lane, int wave) {
    const int b = bh >> 2, h = bh & 3, fr = lane & 15, fq = lane >> 4, vs = wave;
    const unsigned char* gops = (const unsigned char*)A.out + (size_t)bh * 32 * GOPS_CHUNK;
    const unsigned char* uvf = A.ws + WS_XN + (size_t)bh * 32 * 16384; const float* GE = (const float*)(A.ws + WS_GE) + bh * 32;
    float* Op = (float*)(A.ws + WS_OA) + ((size_t)b * SEQ + 4 * fq) * GW + h * 128 + 16 * vs + fr;
    f32x4 S[8];
#pragma unroll
    for (int i = 0; i < 8; ++i) S[i] = (f32x4){0.f, 0.f, 0.f, 0.f};
    const float gev = GE[lane & 31];
#define SCAN_DMA(chunk, bufoff) do { _Pragma("unroll") for (int i_ = 0; i_ < 9; ++i_) { const int p_ = wave + 8 * i_; \
        const unsigned char* s_ = (p_ < 56) ? (gops + (size_t)(chunk) * GOPS_CHUNK + p_ * 1024) : (uvf + (size_t)(chunk) * 16384 + (p_ - 56) * 1024); \
        __builtin_amdgcn_global_load_lds((const unsigned*)(s_ + lane * 16), (LAS unsigned*)(lds + (bufoff) + p_ * 1024), 16, 0, 0); } } while (0)
    SCAN_DMA(0, 0); SCAN_DMA(1, SCAN_BUF);
    asm volatile("s_waitcnt vmcnt(0)" ::: "memory"); __syncthreads();
#pragma unroll 1
    for (int n = 0; n < 32; ++n) {
        const LAS unsigned char* cur = lds + (n & 1) * SCAN_BUF;
        const float ge = __builtin_bit_cast(float, __builtin_amdgcn_readlane(__builtin_bit_cast(int, gev), n));
        bf16x8 Sb[4];
#pragma unroll
        for (int ks = 0; ks < 4; ++ks) Sb[ks] = pack8(S[2 * ks], S[2 * ks + 1]);
        f32x4 u[4];
#pragma unroll
        for (int mb = 0; mb < 4; ++mb) { f32x4 p = (f32x4){0.f, 0.f, 0.f, 0.f};
#pragma unroll
            for (int ks = 0; ks < 4; ++ks) p = __builtin_amdgcn_mfma_f32_16x16x32_bf16(*(const LAS bf16x8*)(cur + ((mb * 4 + ks) * 64 + lane) * 16), Sb[ks], p, 0, 0, 0);
            const v2u uw = *(const LAS v2u*)(cur + GOPS_CHUNK + ((vs * 4 + mb) * 64 + lane) * 8);
            u[mb] = (f32x4){bflo(uw.x) - p[0], bfhi(uw.x) - p[1], bflo(uw.y) - p[2], bfhi(uw.y) - p[3]}; }
        bf16x8 ub[2]; ub[0] = pack8(u[0], u[1]); ub[1] = pack8(u[2], u[3]);
        f32x4 o[4];
#pragma unroll
        for (int mb = 0; mb < 4; ++mb) { f32x4 acc = (f32x4){0.f, 0.f, 0.f, 0.f};
#pragma unroll
            for (int ks = 0; ks < 4; ++ks) acc = __builtin_amdgcn_mfma_f32_16x16x32_bf16(*(const LAS bf16x8*)(cur + 16384 + ((mb * 4 + ks) * 64 + lane) * 16), Sb[ks], acc, 0, 0, 0);
#pragma unroll
            for (int ks2 = 0; ks2 < 2; ++ks2) if (ks2 <= (mb >> 1)) acc = __builtin_amdgcn_mfma_f32_16x16x32_bf16(*(const LAS bf16x8*)(cur + 32768 + ((mb * 2 + ks2) * 64 + lane) * 16), ub[ks2], acc, 0, 0, 0);
            o[mb] = acc; }
#pragma unroll
        for (int dkb = 0; dkb < 8; ++dkb) { f32x4 acc = S[dkb] * ge;
#pragma unroll
            for (int ks2 = 0; ks2 < 2; ++ks2) acc = __builtin_amdgcn_mfma_f32_16x16x32_bf16(*(const LAS bf16x8*)(cur + 40960 + ((dkb * 2 + ks2) * 64 + lane) * 16), ub[ks2], acc, 0, 0, 0);
            S[dkb] = acc; }
        asm volatile("s_waitcnt vmcnt(0)" ::: "memory"); __syncthreads();
        if (n + 2 < 32) SCAN_DMA(n + 2, (n & 1) * SCAN_BUF);
        float* orow = Op + (size_t)(64 * n) * GW;
#pragma unroll
        for (int mb = 0; mb < 4; ++mb) { float* q = orow + (size_t)(16 * mb) * GW; q[0] = o[mb][0]; q[GW] = o[mb][1]; q[2 * GW] = o[mb][2]; q[3 * GW] = o[mb][3]; }
    }
    asm volatile("s_waitcnt vmcnt(0)" ::: "memory"); __syncthreads();
#undef SCAN_DMA
}


__device__ __forceinline__ void attn_fast(const Args& A, LAS unsigned char* lds, int lane, int wave) {
    const bf16* PROJ = (const bf16*)(A.ws + WS_PROJ); bf16* CAT = (bf16*)(A.ws + WS_CAT);
    unsigned* ctr = (unsigned*)(A.ws + WS_CTL);
    LAS bf16* Vt = (LAS bf16*)(lds + wave * 8192);
    const int fr = lane & 15, fq = lane >> 4;
    const int kk = lane & 31, vslot = 8 * ((kk & 15) >> 2) + 4 * (kk >> 4) + (kk & 3), vch = lane >> 5;
    constexpr float SC = 0.125f * 1.4426950408889634f;
    const int myx = (int)(__builtin_amdgcn_s_getreg((3 << 11) | 20) & 0x7u);
    int qi = 0;
    for (;;) {
        int wt = 256, xq = 0;
        while (qi < 8) { xq = (myx + qi) & 7; unsigned wt_ = 0; if (lane == 0) wt_ = atomicAdd(ctr + 16 * xq, 1u); wt = __builtin_amdgcn_readfirstlane(wt_); if (wt < 256) break; ++qi; }
        if (qi >= 8) break;
        const int b = wt >> 5, h = xq, rem = wt & 31, T = 7 - (rem >> 2), c0 = rem & 3, t0 = 256 * T;
        const bf16* Pb = PROJ + (size_t)b * SEQ * NP;
        const int tq0 = t0 + c0 + 16 * fr;
        bf16x8 qf0[2], qf1[2], qf2[2], qf3[2];
#pragma unroll
        for (int ks = 0; ks < 2; ++ks) { const bf16* qp = Pb + (size_t)tq0 * NP + PC_QB + h * 64 + 32 * ks + 8 * fq;
            qf0[ks] = *(const bf16x8*)qp; qf1[ks] = *(const bf16x8*)(qp + 4 * NP); qf2[ks] = *(const bf16x8*)(qp + 8 * NP); qf3[ks] = *(const bf16x8*)(qp + 12 * NP); }
        const int n2 = ((t0 + 240) >> 4) + 1, g2 = (n2 + 31) >> 5;
        const int lo1 = max(t0 + c0 - 512, c0), n1 = ((t0 + c0 + 12 + 240 - lo1) >> 2) + 1, g1 = (n1 + 31) >> 5;
        const int lo0 = max(t0 + c0 - 128, 0), n0 = (t0 + c0 + 12 + 240 - lo0) + 1, g0 = (n0 + 31) >> 5;
        const int NG = 4 * g2 + g1 + g0;
        f32x4 O0[4], O1[4], O2[4], O3[4];
#pragma unroll
        for (int i = 0; i < 4; ++i) { O0[i] = (f32x4){0.f, 0.f, 0.f, 0.f}; O1[i] = O0[i]; O2[i] = O0[i]; O3[i] = O0[i]; }
        float m0 = -INFINITY, l0 = 0.f, m1 = -INFINITY, l1 = 0.f, m2 = -INFINITY, l2 = 0.f, m3 = -INFINITY, l3 = 0.f;
        v4u kc[4], vc[4], kn[4], vn[4];
#define ATT_DEC(f, kst, str, mode) do { if ((f) < 4 * g2) { const int ci_ = (f) / g2; str = 16; kst = c0 + 4 * ci_ + 512 * ((f) - ci_ * g2); mode = 1 << ci_; } \
            else if ((f) < 4 * g2 + g1) { str = 4; kst = lo1 + 128 * ((f) - 4 * g2); mode = 15; } else { str = 1; kst = lo0 + 32 * ((f) - 4 * g2 - g1); mode = 15; } } while (0)
#define ATT_LOAD(kreg, vreg, kst, str) do { \
            _Pragma("unroll") for (int j = 0; j < 2; ++j) { const int tk = min((kst) + (str) * (16 * j + fr), SEQ - 1); \
                _Pragma("unroll") for (int ks = 0; ks < 2; ++ks) kreg[2 * j + ks] = *(const v4u*)(Pb + (size_t)tk * NP + PC_KB + h * 64 + 32 * ks + 8 * fq); } \
            { const int tk = min((kst) + (str) * kk, SEQ - 1); \
                _Pragma("unroll") for (int i = 0; i < 4; ++i) vreg[i] = *(const v4u*)(Pb + (size_t)tk * NP + PC_VB + h * 64 + 8 * (vch + 2 * i)); } } while (0)
#define ATT_CLS(O_, m_, l_, qf_, tq_) do { \
            f32x4 d0 = (f32x4){0.f, 0.f, 0.f, 0.f}, d1 = d0; \
            _Pragma("unroll") for (int ks = 0; ks < 2; ++ks) { d0 = __builtin_amdgcn_mfma_f32_16x16x32_bf16(__builtin_bit_cast(bf16x8, kc[ks]), qf_[ks], d0, 0, 0, 0); \
                                                             d1 = __builtin_amdgcn_mfma_f32_16x16x32_bf16(__builtin_bit_cast(bf16x8, kc[2 + ks]), qf_[ks], d1, 0, 0, 0); } \
            float s[8]; float mloc = -INFINITY; \
            const int dv = (((tq_) - kst) >> shl) - 4 * fq;        \
            _Pragma("unroll") for (int e2 = 0; e2 < 8; ++e2) { const float x = (e2 < 4 ? d0[e2 & 3] : d1[e2 & 3]) * SC; \
                s[e2] = ((unsigned)(dv - (16 * (e2 >> 2) + (e2 & 3))) <= 128u) ? x : -INFINITY; mloc = fmaxf(mloc, s[e2]); } \
            mloc = fmaxf(mloc, __shfl_xor(mloc, 16)); mloc = fmaxf(mloc, __shfl_xor(mloc, 32)); \
            const float mnew = fmaxf(m_, mloc), alpha = __builtin_amdgcn_exp2f(m_ - mnew); m_ = mnew; \
            float psum = 0.f; \
            _Pragma("unroll") for (int e2 = 0; e2 < 8; ++e2) { s[e2] = __builtin_amdgcn_exp2f(s[e2] - mnew); psum += s[e2]; } \
            l_ = l_ * alpha + psum; \
            const bf16x8 pb = pack8((f32x4){s[0], s[1], s[2], s[3]}, (f32x4){s[4], s[5], s[6], s[7]}); \
            _Pragma("unroll") for (int db = 0; db < 4; ++db) O_[db] = __builtin_amdgcn_mfma_f32_16x16x32_bf16(va[db], pb, O_[db] * alpha, 0, 0, 0); } while (0)
        int kst, str, mode; ATT_DEC(0, kst, str, mode); ATT_LOAD(kc, vc, kst, str);
#pragma unroll 1
        for (int f = 0; f < NG; ++f) {
            int kstn = 0, strn = 1, moden = 0;
            if (f + 1 < NG) { ATT_DEC(f + 1, kstn, strn, moden); ATT_LOAD(kn, vn, kstn, strn); }
#pragma unroll
            for (int i = 0; i < 4; ++i) { const int dd = 8 * (vch + 2 * i); const v4u w = vc[i];
                Vt[(dd + 0) * 40 + vslot] = (bf16)(w.x & 0xffffu); Vt[(dd + 1) * 40 + vslot] = (bf16)(w.x >> 16); Vt[(dd + 2) * 40 + vslot] = (bf16)(w.y & 0xffffu); Vt[(dd + 3) * 40 + vslot] = (bf16)(w.y >> 16);
                Vt[(dd + 4) * 40 + vslot] = (bf16)(w.z & 0xffffu); Vt[(dd + 5) * 40 + vslot] = (bf16)(w.z >> 16); Vt[(dd + 6) * 40 + vslot] = (bf16)(w.w & 0xffffu); Vt[(dd + 7) * 40 + vslot] = (bf16)(w.w >> 16); }
            bf16x8 va[4];
#pragma unroll
            for (int db = 0; db < 4; ++db) va[db] = *(const LAS bf16x8*)(Vt + (16 * db + fr) * 40 + 8 * fq);
            const int shl = (str == 16) ? 4 : (str == 4 ? 2 : 0);
            if (mode & 1) ATT_CLS(O0, m0, l0, qf0, tq0);
            if (mode & 2) ATT_CLS(O1, m1, l1, qf1, tq0 + 4);
            if (mode & 4) ATT_CLS(O2, m2, l2, qf2, tq0 + 8);
            if (mode & 8) ATT_CLS(O3, m3, l3, qf3, tq0 + 12);
#pragma unroll
            for (int i = 0; i < 4; ++i) { kc[i] = kn[i]; vc[i] = vn[i]; }
            kst = kstn; str = strn; mode = moden;
        }
#undef ATT_DEC
#undef ATT_LOAD
#undef ATT_CLS
        bf16* op = CAT + ((size_t)b * SEQ + tq0) * DM + GW + h * 64 + 4 * fq;
#define ATT_OUT(O_, l_, ci_) do { float lt = l_; lt += __shfl_xor(lt, 16); lt += __shfl_xor(lt, 32); const float inv = 1.0f / lt; \
            _Pragma("unroll") for (int db = 0; db < 4; ++db) { v2u w; w.x = pk2(O_[db][0] * inv, O_[db][1] * inv); w.y = pk2(O_[db][2] * inv, O_[db][3] * inv); *(v2u*)(op + (ci_) * 4 * DM + 16 * db) = w; } } while (0)
        ATT_OUT(O0, l0, 0); ATT_OUT(O1, l1, 1); ATT_OUT(O2, l2, 2); ATT_OUT(O3, l3, 3);
#undef ATT_OUT
    }
}

__device__ __forceinline__ void attn_simple(const Args& A, int tid, int lane, int wave) {
    const bf16* PROJ = (const bf16*)(A.ws + WS_PROJ); bf16* CAT = (bf16*)(A.ws + WS_CAT);
    unsigned* ctr = (unsigned*)(A.ws + WS_CTL);
    for (;;) {
        unsigned wt_ = 0; if (lane == 0) wt_ = atomicAdd(ctr, 1u); const int wt = __builtin_amdgcn_readfirstlane(wt_);
        if (wt >= (M / 64) * AH) break;
        const int h = wt % AH, tb = wt / AH, row = tb * 64 + lane, b = row / SEQ, t = row % SEQ;
        float q[64], acc[64];
        { const v4u* qp = (const v4u*)(PROJ + (size_t)row * NP + PC_QB + h * 64);
#pragma unroll
          for (int j = 0; j < 8; ++j) { const v4u w = qp[j]; q[8 * j + 0] = bflo(w.x) * 0.125f; q[8 * j + 1] = bfhi(w.x) * 0.125f; q[8 * j + 2] = bflo(w.y) * 0.125f; q[8 * j + 3] = bfhi(w.y) * 0.125f;
              q[8 * j + 4] = bflo(w.z) * 0.125f; q[8 * j + 5] = bfhi(w.z) * 0.125f; q[8 * j + 6] = bflo(w.w) * 0.125f; q[8 * j + 7] = bfhi(w.w) * 0.125f; } }
#pragma unroll
        for (int j = 0; j < 64; ++j) acc[j] = 0.f;
        float mx = -1e30f, l = 0.f;
        for (int br = 0; br < 3; ++br) {
            const int stride = br == 0 ? 1 : (br == 1 ? 4 : 16);
            for (int i = 0; i <= 128; ++i) {
                const int tk = t - i * stride; if (tk < 0) break;
                const size_t krow = (size_t)(b * SEQ + tk) * NP;
                const v4u* kp = (const v4u*)(PROJ + krow + PC_KB + h * 64); const v4u* vp = (const v4u*)(PROJ + krow + PC_VB + h * 64);
                float s = 0.f;
#pragma unroll
                for (int j = 0; j < 8; ++j) { const v4u w = kp[j]; s += q[8 * j + 0] * bflo(w.x) + q[8 * j + 1] * bfhi(w.x) + q[8 * j + 2] * bflo(w.y) + q[8 * j + 3] * bfhi(w.y)
                                                                       + q[8 * j + 4] * bflo(w.z) + q[8 * j + 5] * bfhi(w.z) + q[8 * j + 6] * bflo(w.w) + q[8 * j + 7] * bfhi(w.w); }
                const float mn = fmaxf(mx, s), sc = __expf(mx - mn), p = __expf(s - mn); mx = mn; l = l * sc + p;
#pragma unroll
                for (int j = 0; j < 8; ++j) { const v4u w = vp[j];
                    acc[8 * j + 0] = acc[8 * j + 0] * sc + p * bflo(w.x); acc[8 * j + 1] = acc[8 * j + 1] * sc + p * bfhi(w.x); acc[8 * j + 2] = acc[8 * j + 2] * sc + p * bflo(w.y); acc[8 * j + 3] = acc[8 * j + 3] * sc + p * bfhi(w.y);
                    acc[8 * j + 4] = acc[8 * j + 4] * sc + p * bflo(w.z); acc[8 * j + 5] = acc[8 * j + 5] * sc + p * bfhi(w.z); acc[8 * j + 6] = acc[8 * j + 6] * sc + p * bflo(w.w); acc[8 * j + 7] = acc[8 * j + 7] * sc + p * bfhi(w.w); }
            }
        }
        const float inv = 1.0f / l; v4u* op = (v4u*)(CAT + (size_t)row * DM + GW + h * 64);
#pragma unroll
        for (int j = 0; j < 8; ++j) { v4u w; w.x = pk2(acc[8 * j] * inv, acc[8 * j + 1] * inv); w.y = pk2(acc[8 * j + 2] * inv, acc[8 * j + 3] * inv); w.z = pk2(acc[8 * j + 4] * inv, acc[8 * j + 5] * inv); w.w = pk2(acc[8 * j + 6] * inv, acc[8 * j + 7] * inv); op[j] = w; }
    }
}
__device__ __forceinline__ void gated_norm(const Args& A, int lane, int wave) {
    const bf16* PROJ = (const bf16*)(A.ws + WS_PROJ); bf16* CAT = (bf16*)(A.ws + WS_CAT); const float* OA = (const float*)(A.ws + WS_OA); const float* gw = A.in[6];
    const float w0 = gw[2 * lane], w1 = gw[2 * lane + 1];
    const int gwv = blockIdx.x * NWAVES + wave, NGW = gridDim.x * NWAVES;
    for (int wt0 = gwv; wt0 < M * GH; wt0 += 8 * NGW) {
        float2 o[8]; unsigned zz[8];
#pragma unroll
        for (int i = 0; i < 8; ++i) { const int wt = min(wt0 + i * NGW, M * GH - 1), row = wt / GH, h = wt % GH;
            o[i] = *(const float2*)(OA + (size_t)row * GW + h * 128 + 2 * lane); zz[i] = *(const unsigned*)(PROJ + (size_t)row * NP + PC_Z + h * 128 + 2 * lane); }
#pragma unroll
        for (int i = 0; i < 8; ++i) { const int wt = wt0 + i * NGW; if (wt >= M * GH) break; const int row = wt / GH, h = wt % GH;
            const float ms = wave_sum(o[i].x * o[i].x + o[i].y * o[i].y) * (1.0f / 128.0f), r = rsqrtf(ms + RMS_EPS);
            *(unsigned*)(CAT + (size_t)row * DM + h * 128 + 2 * lane) = pk2(o[i].x * r * w0 * silu_f(bflo(zz[i])), o[i].y * r * w1 * silu_f(bfhi(zz[i]))); }
    }
}

__device__ __forceinline__ void gated_norm_bh(const Args& A, int bh, int lane, int wave) {
    const int b = bh >> 2, h = bh & 3;
    const bf16* Zp = (const bf16*)(A.ws + WS_PROJ) + (size_t)b * SEQ * NP + PC_Z + h * 128 + 2 * lane; bf16* Cp = (bf16*)(A.ws + WS_CAT) + (size_t)b * SEQ * DM + h * 128 + 2 * lane;
    const float* Op = (const float*)(A.ws + WS_OA) + (size_t)b * SEQ * GW + h * 128 + 2 * lane; const float* gw = A.in[6];
    const float w0 = gw[2 * lane], w1 = gw[2 * lane + 1];
    __builtin_amdgcn_fence(__ATOMIC_ACQUIRE, "agent");
#pragma unroll 1
    for (int r0 = wave * 16; r0 < SEQ; r0 += NWAVES * 16) {
        float2 o[16]; unsigned zz[16];
#pragma unroll
        for (int i = 0; i < 16; ++i) { o[i] = *(const float2*)(Op + (size_t)(r0 + i) * GW); zz[i] = *(const unsigned*)(Zp + (size_t)(r0 + i) * NP); }
#pragma unroll
        for (int i = 0; i < 16; ++i) { const float ms = wave_sum(o[i].x * o[i].x + o[i].y * o[i].y) * (1.0f / 128.0f), r = rsqrtf(ms + RMS_EPS);
            *(unsigned*)(Cp + (size_t)(r0 + i) * DM) = pk2(o[i].x * r * w0 * silu_f(bflo(zz[i])), o[i].y * r * w1 * silu_f(bfhi(zz[i]))); }
    }
}
__device__ __forceinline__ void ffn_conv_half(const Args& A, int half, int tid) {
    const bf16* Y = (const bf16*)(A.ws + WS_Y); bf16* ACT = (bf16*)(A.ws + WS_ACT); const float* fw = A.in[10];
    constexpr int HC = DFF / 2;
    for (size_t it = (size_t)blockIdx.x * NTHR + tid; it < (size_t)M * (HC / 8); it += (size_t)gridDim.x * NTHR) {
        const int row = (int)(it / (HC / 8)), g8 = (int)(it % (HC / 8)), cl = g8 * 8, pn = cl >> 7, j = cl & 127, t = row % SEQ, ch = half * HC + cl;
        float ga[8], ua[8];
#pragma unroll
        for (int e = 0; e < 8; ++e) { ga[e] = 0.f; ua[e] = 0.f; }
#pragma unroll
        for (int i = 0; i < 3; ++i) { const int ts = t - 2 + i; if (ts < 0) continue;
            const bf16* yr = Y + (size_t)(row - 2 + i) * DFF + 256 * pn + j; const v4u g = *(const v4u*)yr, u = *(const v4u*)(yr + 128);
            const f32x4 wg0 = *(const f32x4*)(fw + i * NUP + ch), wg1 = *(const f32x4*)(fw + i * NUP + ch + 4), wu0 = *(const f32x4*)(fw + i * NUP + DFF + ch), wu1 = *(const f32x4*)(fw + i * NUP + DFF + ch + 4);
            ga[0] += wg0.x * bflo(g.x); ga[1] += wg0.y * bfhi(g.x); ga[2] += wg0.z * bflo(g.y); ga[3] += wg0.w * bfhi(g.y); ga[4] += wg1.x * bflo(g.z); ga[5] += wg1.y * bfhi(g.z); ga[6] += wg1.z * bflo(g.w); ga[7] += wg1.w * bfhi(g.w);
            ua[0] += wu0.x * bflo(u.x); ua[1] += wu0.y * bfhi(u.x); ua[2] += wu0.z * bflo(u.y); ua[3] += wu0.w * bfhi(u.y); ua[4] += wu1.x * bflo(u.z); ua[5] += wu1.y * bfhi(u.z); ua[6] += wu1.z * bflo(u.w); ua[7] += wu1.w * bfhi(u.w); }
        v4u o; o.x = pk2(silu_f(ga[0]) * ua[0], silu_f(ga[1]) * ua[1]); o.y = pk2(silu_f(ga[2]) * ua[2], silu_f(ga[3]) * ua[3]); o.z = pk2(silu_f(ga[4]) * ua[4], silu_f(ga[5]) * ua[5]); o.w = pk2(silu_f(ga[6]) * ua[6], silu_f(ga[7]) * ua[7]);
        *(v4u*)(ACT + (size_t)row * DFF + ch) = o;
    }
}

__device__ __forceinline__ void ffn_fixup(const Args& A, int tid) {
    const float* YH = (const float*)(A.ws + WS_YH); const float* UP = (const float*)(A.ws + WS_UPART); bf16* ACT = (bf16*)(A.ws + WS_ACT); const float* fw = A.in[10];
    for (int it = blockIdx.x * NTHR + tid; it < 64 * 22 * 2 * 128; it += gridDim.x * NTHR) {
        const int c = it & 127, r = (it >> 7) & 1, tile = it >> 8, pm = tile / 22, pn = tile % 22; if ((pm & 7) == 0) continue;
        const int ch = pn * 128 + c; const float* up = UP + ((size_t)tile * 2 + r) * 256; const float* yh = YH + (size_t)((pm - 1) * 22 + pn) * 2 * 256;
        float g = up[c], u = up[128 + c];
        const float wg0 = fw[ch], wg1 = fw[5632 + ch], wu0 = fw[2816 + ch], wu1 = fw[5632 + 2816 + ch];
        if (r == 0) { g += wg0 * yh[c] + wg1 * yh[256 + c]; u += wu0 * yh[128 + c] + wu1 * yh[256 + 128 + c]; }
        else { g += wg0 * yh[256 + c]; u += wu0 * yh[256 + 128 + c]; }
        ACT[(size_t)(pm * 256 + r) * DFF + ch] = (bf16)(pk2(silu_f(g) * u, 0.f) & 0xffffu);
    }
}
__device__ __forceinline__ void final_norm(const Args& A, int lane, int wave) {
    float* out = A.out; const f32x4* nr = (const f32x4*)A.in[12] + lane;
    const int gw = blockIdx.x * NWAVES + wave, NGW = gridDim.x * NWAVES;
    f32x4 nw[4];
#pragma unroll
    for (int j = 0; j < 4; ++j) nw[j] = nr[64 * j];
    for (int m0 = gw; m0 < M; m0 += 4 * NGW) {
        f32x4 v[4][4];
#pragma unroll
        for (int rr = 0; rr < 4; ++rr) { const int m = min(m0 + rr * NGW, M - 1); const f32x4* xr = (const f32x4*)(out + (size_t)m * DM) + lane;
#pragma unroll
            for (int j = 0; j < 4; ++j) v[rr][j] = xr[64 * j]; }
#pragma unroll
        for (int rr = 0; rr < 4; ++rr) { const int m = m0 + rr * NGW; if (m >= M) break; float s = 0.f;
#pragma unroll
            for (int j = 0; j < 4; ++j) s += (v[rr][j].x * v[rr][j].x + v[rr][j].y * v[rr][j].y) + (v[rr][j].z * v[rr][j].z + v[rr][j].w * v[rr][j].w);
            const float rstd = rsqrtf(wave_sum(s) * (1.f / DM) + RMS_EPS); f32x4* xw = (f32x4*)(out + (size_t)m * DM) + lane;
#pragma unroll
            for (int j = 0; j < 4; ++j) xw[64 * j] = (f32x4){v[rr][j].x * rstd * nw[j].x, v[rr][j].y * rstd * nw[j].y, v[rr][j].z * rstd * nw[j].z, v[rr][j].w * rstd * nw[j].w}; }
    }
}

#define XB_TMO      128
#define XB_XCNT(j)  (256  + 64 * (j))
#define XB_XSUB(j)  (1280 + 64 * (j))
#define XB_XGEN(j)  (2304 + 64 * (j))
#define XB_TOP      3328
#define XB_TOPGEN   3392
#define XCD_BAR_WORDS 3456
#define XB_SPIN_CAP (1u << 18)

__device__ __forceinline__ unsigned xb_ld(unsigned* p)              { return __hip_atomic_load(p, __ATOMIC_RELAXED, __HIP_MEMORY_SCOPE_AGENT); }
__device__ __forceinline__ unsigned xb_add(unsigned* p, unsigned v) { return __hip_atomic_fetch_add(p, v, __ATOMIC_RELAXED, __HIP_MEMORY_SCOPE_AGENT); }
__device__ __forceinline__ unsigned xb_xcc_id() { return (unsigned)__builtin_amdgcn_s_getreg((3 << 11) | 20) & 0xFu; }
#define XB_SPIN(cond, bar) do { unsigned _sp = 0; while (cond) { __builtin_amdgcn_s_sleep(1); \
    if ((++_sp & 255u) == 0u) { if (xb_ld(&(bar)[XB_TMO])) break; if (_sp > XB_SPIN_CAP) { atomicAdd(&(bar)[XB_TMO], 1u); break; } } } } while (0)

struct XcdBarrier {
    unsigned* bar; unsigned x;
    volatile LAS unsigned* st;
};

__device__ __forceinline__ XcdBarrier xcd_barrier_post(unsigned* bar, volatile LAS unsigned* st) {
    XcdBarrier b; b.bar = bar; b.x = xb_xcc_id(); b.st = st;
    if (threadIdx.x == 0) (void)xb_add(&bar[XB_XCNT(b.x)], 1u);
    return b;
}
__device__ __forceinline__ void xcd_barrier_complete(unsigned* bar, unsigned x, unsigned& nloc, unsigned& nx) {
    const unsigned G = gridDim.x * gridDim.y * gridDim.z;
    unsigned sum, cnt, mine, sp = 0u;
    for (;;) {
        sum = 0u; cnt = 0u; mine = 0u;
#pragma unroll
        for (unsigned j = 0; j < 16; ++j) { const unsigned c = xb_ld(&bar[XB_XCNT(j)]); sum += c; cnt += (c > 0u) ? 1u : 0u; mine = (j == x) ? c : mine; }
        if (sum == G) break;
        __builtin_amdgcn_s_sleep(1);
        if ((++sp & 255u) == 0u) { if (xb_ld(&bar[XB_TMO])) break; if (sp > XB_SPIN_CAP) { atomicAdd(&bar[XB_TMO], 1u); break; } }
    }
    nloc = mine > 0u ? mine : 1u; nx = cnt > 0u ? cnt : 1u;
}

__device__ __forceinline__ void xcd_barrier(const XcdBarrier& b) {
    asm volatile("s_waitcnt vmcnt(0)" ::: "memory");
    __syncthreads();
    if (threadIdx.x == 0) {
        unsigned* bar = b.bar;
        __builtin_amdgcn_s_waitcnt(0);
        unsigned nloc = b.st[0], nx = b.st[1];
        if (nloc == 0u) { xcd_barrier_complete(bar, b.x, nloc, nx); b.st[0] = nloc; b.st[1] = nx; }
        const unsigned old = xb_add(&bar[XB_XSUB(b.x)], 1u);
        const unsigned gen = old / nloc;
        if (old + 1u == (gen + 1u) * nloc) {
            __builtin_amdgcn_fence(__ATOMIC_RELEASE, "agent");
            asm volatile("s_waitcnt vmcnt(0)" ::: "memory");
            const unsigned og = xb_add(&bar[XB_TOP], 1u);
            const unsigned tg = og / nx;
            if (og + 1u == (tg + 1u) * nx) xb_add(&bar[XB_TOPGEN], 1u);
            else XB_SPIN(xb_ld(&bar[XB_TOPGEN]) == tg, bar);
            __builtin_amdgcn_fence(__ATOMIC_ACQUIRE, "agent");
            xb_add(&bar[XB_XGEN(b.x)], 1u);
            asm volatile("s_waitcnt vmcnt(0)" ::: "memory");
        } else {
            XB_SPIN(xb_ld(&bar[XB_XGEN(b.x)]) == gen, bar);
            __builtin_amdgcn_fence(__ATOMIC_ACQUIRE, "agent");
            asm volatile("s_waitcnt vmcnt(0)" ::: "memory");
        }
    }
    __syncthreads();
}

constexpr int N_PHASES = 8;
__global__ void __launch_bounds__(NTHR, 2) mk_fwd(Args args) {
    extern __shared__ __attribute__((aligned(16))) unsigned char lds_raw[];
    LAS unsigned char* lds = (LAS unsigned char*)lds_raw;
    const int tid = threadIdx.x, lane = tid & 63, wave = __builtin_amdgcn_readfirstlane(tid >> 6);
    const int lo = args.ph_lo, hi = args.ph_hi;
    unsigned char* ws = args.ws;
    bf16* WIN = (bf16*)(ws + WS_WIN); bf16* WOUT = (bf16*)(ws + WS_WOUT); bf16* WUP = (bf16*)(ws + WS_WUP); bf16* WDN = (bf16*)(ws + WS_WDN);
    bf16* XN = (bf16*)(ws + WS_XN); bf16* PROJ = (bf16*)(ws + WS_PROJ); bf16* CAT = (bf16*)(ws + WS_CAT); bf16* Y = (bf16*)(ws + WS_Y); bf16* ACT = (bf16*)(ws + WS_ACT);
    float* SSQ = (float*)(ws + WS_SSQ);
#define IN(k) (lo <= (k) && (k) < hi)
#define SEAM(k) do { if (IN(k) && IN((k) + 1)) { xcd_barrier(bar); } } while (0)
    { volatile LAS unsigned* st = (volatile LAS unsigned*)(lds + LDS_BYTES - 64); if (tid < 2) st[tid] = 0u; }
    __syncthreads();
    XcdBarrier bar = xcd_barrier_post((unsigned*)(ws + WS_CTL) + 4096, (volatile LAS unsigned*)(lds + LDS_BYTES - 64));
    if (args.coop > 1) cg::this_grid().sync();
    if (IN(0)) { p0_prologue(args, lds, tid, lane, wave); } SEAM(0);
    if (IN(1)) { pg8::Gemm g{XN, WIN, M, NP, DM}; pg8::StaticOrder S; S.init(M, NP, gridDim.x, blockIdx.x); pg8::EpiBf16S E{PROJ, NP, nullptr};
        pg8::gemm_phase<pg8::EpiBf16S, pg8::StaticOrder, PG8_ALIGN, PG8_SP2>(lds, g, S, E);
        { pg8::Unit u4; const bool idle4 = !S.next(3, u4); const int G = gridDim.x, nidle = (G == 256) ? 128 : G;
          if (G != 256) convert_late_weights(args, lds, lane, wave, blockIdx.x * NWAVES + wave, G * NWAVES);
          else if (idle4) convert_late_weights(args, lds, lane, wave, (blockIdx.x - 128) * NWAVES + wave, nidle * NWAVES); } } SEAM(1);
    if (IN(2)) { gdn_prep(args, lds, tid, lane, wave); } SEAM(2);
    if (IN(3)) { if (blockIdx.x < NB * GH) gdn_scan(args, lds, blockIdx.x, tid, lane, wave); attn_fast(args, lds, lane, wave); xcd_barrier(bar); gated_norm(args, lane, wave); } SEAM(3);
    if (IN(4)) { pg8::Gemm g{CAT, WOUT, M, DM, DM}; pg8::StaticOrder S; S.init(M, DM, gridDim.x, blockIdx.x); pg8::EpiResid E{args.in[0], (gridDim.x == 256) ? nullptr : args.out, XN, SSQ, DM};
        pg8::gemm_phase<pg8::EpiResid, pg8::StaticOrder, PG8_ALIGN, PG8_SP2>(lds, g, S, E); } SEAM(4);
    if (IN(5)) { pg8::Gemm g{XN, WUP, M, NUP, DM}; pg8::StaticOrder S; S.init(M, NUP, gridDim.x, blockIdx.x);
        static_assert(pg8::EpiConvGate::CG_SSQ == WS_SSQ && pg8::EpiConvGate::CG_ACT == WS_ACT && pg8::EpiConvGate::CG_YH == WS_YH && pg8::EpiConvGate::CG_UPART == WS_UPART, "d_ws map");
        pg8::EpiConvGate E{ws, args.in[10], lds};
        pg8::gemm_phase<pg8::EpiConvGate, pg8::StaticOrder, true, PG8_SP2>(lds, g, S, E); } SEAM(5);
    if (IN(6)) { ffn_fixup(args, tid); } SEAM(6);
    if (IN(7)) { pg8::Gemm g{ACT, WDN, M, DM, DFF}; pg8::StaticOrder S; S.init(M, DM, gridDim.x, blockIdx.x);
        if (gridDim.x == 256) {
            pg8::EpiResidNorm E{XN, args.out, (float*)(ws + WS_SSQ2), (unsigned*)(ws + WS_CTL) + 2048, args.in[12], DM};
            pg8::gemm_phase<pg8::EpiResidNorm, pg8::StaticOrder, true, PG8_SP2>(lds, g, S, E);
        } else {
            pg8::EpiResid E{args.out, args.out, nullptr, nullptr, DM};
            pg8::gemm_phase<pg8::EpiResid, pg8::StaticOrder, PG8_ALIGN, PG8_SP2>(lds, g, S, E);
            xcd_barrier(bar); final_norm(args, lane, wave);
        } }
#undef IN
#undef SEAM
}

#ifndef MK_ONE_LAUNCH
#define MK_ONE_LAUNCH 1
#endif
extern "C" void kernel_launch(void* const* d_in, const int* in_sizes, int n_in, void* d_out, int out_size, void* d_ws, size_t ws_size, hipStream_t stream) {
    static int grid = 0;
    if (grid == 0) {
        if (n_in != 13 || out_size != M * DM || ws_size < WS_END) { fprintf(stderr, "kernel_launch: unexpected shapes n_in %d out %d ws %zu\n", n_in, out_size, ws_size); grid = -1; return; }
        int dev = 0, cus = 0, per_cu = 0;
        hipGetDevice(&dev); hipDeviceGetAttribute(&cus, hipDeviceAttributeMultiprocessorCount, dev);
        hipFuncSetAttribute((const void*)mk_fwd, hipFuncAttributeMaxDynamicSharedMemorySize, LDS_BYTES);
        hipOccupancyMaxActiveBlocksPerMultiprocessor(&per_cu, (const void*)mk_fwd, NTHR, LDS_BYTES);
        (void)hipGetLastError();
        if (per_cu < 1) { fprintf(stderr, "kernel_launch: occupancy query says %d blocks per CU\n", per_cu); per_cu = 1; }
        grid = cus;
    }
    if (grid < 0) return;
    if (hipMemsetAsync((char*)d_ws + WS_CTL, 0, 65536, stream) != hipSuccess) { fprintf(stderr, "kernel_launch: memset failed\n"); return; }
    Args a{};
    for (int i = 0; i < 13; ++i) a.in[i] = (const float*)d_in[i];
    a.out = (float*)d_out; a.ws = (unsigned char*)d_ws;
#if MK_ONE_LAUNCH
    a.ph_lo = 0; a.ph_hi = N_PHASES; a.coop = 1;
    void* kargs[] = {&a};
    hipError_t e = hipLaunchCooperativeKernel((const void*)mk_fwd, dim3(grid), dim3(NTHR), kargs, LDS_BYTES, stream);
    if (e != hipSuccess) fprintf(stderr, "cooperative launch failed: %s (grid %d)\n", hipGetErrorString(e), grid);
#else
    for (int p = 0; p < N_PHASES; ++p) { a.ph_lo = p; a.ph_hi = p + 1; a.coop = 0; hipLaunchKernelGGL(mk_fwd, dim3(grid), dim3(NTHR), LDS_BYTES, stream, a); }
#endif
}
```

```cpp
#include <hip/hip_runtime.h>
#include <hip/hip_cooperative_groups.h>
#include <cstdio>
#include <cstdint>
namespace cg = cooperative_groups;
namespace pg8 {
#define PG8_LAS __attribute__((address_space(3)))
typedef unsigned short bf16_t;
typedef short bf16x8 __attribute__((ext_vector_type(8)));
typedef float f32x4 __attribute__((ext_vector_type(4)));
typedef unsigned u32x4 __attribute__((ext_vector_type(4)));
constexpr int BM = 256, BK = 64, HALF = 128, HTB = HALF * BK * 2  , STAGE_BYTES = 8 * HTB, NXCD = 8, WGM = 8;

__host__ __device__ __forceinline__ int lds_byte(int r, int c) { const int st = (r >> 4) * 2 + (c >> 5), rr = r & 15, cc = c & 31, ob = rr * 64 + cc * 2; return st * 1024 + (ob ^ (((ob >> 9) & 1) << 5)); }
__host__ __device__ __forceinline__ void stage_rc(int b, int& R, int& C) { const int st = b / 1024, sb = b % 1024, swz = sb ^ (((sb >> 9) & 1) << 5); R = (st >> 1) * 16 + swz / 64; C = (st & 1) * 32 + (swz % 64) / 2; }
__host__ __device__ __forceinline__ int perm32(int rho) { const int n = rho >> 4, i = rho & 15; return 8 * (i >> 2) + 4 * n + (i & 3); }

struct Unit { int pm, pn; };
struct Gemm { const bf16_t* A; const bf16_t* Bt; int M, N, K; };

struct StaticOrder {
    int nM, nN, nwg, G, c;
    __host__ __device__ __forceinline__ void init(int M, int N, int G_, int c_) { nM = M / BM; nN = N / BM; nwg = nM * nN; G = G_; c = c_; }
    __host__ __device__ __forceinline__ bool next(int i, Unit& u) const {
        const long L = (long)i * G + c; if (L >= nwg) return false;
        int wgid = (int)L; { const int q = nwg / NXCD, r = nwg % NXCD, xcd = wgid % NXCD, off = wgid / NXCD; wgid = (xcd < r ? xcd * (q + 1) : r * (q + 1) + (xcd - r) * q) + off; }
        const int nig = WGM * nN, gid = wgid / nig, fm = gid * WGM, gsz = (nM - fm) < WGM ? (nM - fm) : WGM;
        u.pm = fm + ((wgid % nig) % gsz); u.pn = (wgid % nig) / gsz; return true;
    }
    __device__ __forceinline__ void a_ready(const Unit&) const {}
    __device__ __forceinline__ void done(const Unit&) const {}
};

__device__ __forceinline__ unsigned cvt_pk_bf16(float lo, float hi) { unsigned r; asm volatile("v_cvt_pk_bf16_f32 %0, %1, %2" : "=v"(r) : "v"(lo), "v"(hi)); return r; }
constexpr float RMS_EPS = 1e-6f;
struct EpiBf16S {
    static constexpr bool PERM = true, AFTER_DRAIN = false;
    bf16_t* O; int ldc; const float* ssq;
    __device__ __forceinline__ void operator()(const f32x4 (&acc)[2][2][4][2], const Unit& u, int wr, int wc, int fr, int fq) const {
        const int row0 = u.pm * BM + wr * 64 + fr; const int col0 = u.pn * BM + wc * 32 + 8 * fq;
#pragma unroll
        for (int ai = 0; ai < 2; ++ai)
#pragma unroll
            for (int m = 0; m < 4; ++m) { const int row = row0 + ai * HALF + m * 16; bf16_t* rowp = O + (size_t)row * ldc + col0;
                const float sc = ssq ? rsqrtf(ssq[row] * (1.0f / 1024.0f) + RMS_EPS) : 1.0f;
#pragma unroll
                for (int bj = 0; bj < 2; ++bj) { const f32x4 v0 = acc[ai][bj][m][0] * sc, v1 = acc[ai][bj][m][1] * sc;
                    u32x4 w; w.x = cvt_pk_bf16(v0[0], v0[1]); w.y = cvt_pk_bf16(v0[2], v0[3]); w.z = cvt_pk_bf16(v1[0], v1[1]); w.w = cvt_pk_bf16(v1[2], v1[3]);
                    *(u32x4*)(rowp + bj * HALF) = w; } }
    }
};
struct EpiResid {
    static constexpr bool PERM = false, AFTER_DRAIN = false;
    const float* base; float* out; bf16_t* xb; float* ssq; int ldc;
    __device__ __forceinline__ void operator()(const f32x4 (&acc)[2][2][4][2], const Unit& u, int wr, int wc, int fr, int fq) const {
        typedef unsigned u32x2v __attribute__((ext_vector_type(2)));
        const int col0 = u.pn * BM + wc * 32 + 4 * fq;
#pragma unroll
        for (int ai = 0; ai < 2; ++ai) {
            f32x4 bv[4][2][2];
#pragma unroll
            for (int m = 0; m < 4; ++m) { const size_t off = (size_t)(u.pm * BM + ai * HALF + wr * 64 + m * 16 + fr) * ldc + col0;
#pragma unroll
                for (int bj = 0; bj < 2; ++bj)
#pragma unroll
                    for (int n = 0; n < 2; ++n) bv[m][bj][n] = *(const f32x4*)(base + off + bj * HALF + n * 16); }
#pragma unroll
            for (int m = 0; m < 4; ++m) { const int row = u.pm * BM + ai * HALF + wr * 64 + m * 16 + fr; const size_t off = (size_t)row * ldc + col0; float s = 0.f;
#pragma unroll
                for (int bj = 0; bj < 2; ++bj)
#pragma unroll
                    for (int n = 0; n < 2; ++n) { const f32x4 v = acc[ai][bj][m][n] + bv[m][bj][n];
                        if (out) *(f32x4*)(out + off + bj * HALF + n * 16) = v; s += (v[0] * v[0] + v[1] * v[1]) + (v[2] * v[2] + v[3] * v[3]);
                        if (xb) { u32x2v w; w.x = cvt_pk_bf16(v[0], v[1]); w.y = cvt_pk_bf16(v[2], v[3]); *(u32x2v*)(xb + off + bj * HALF + n * 16) = w; } }
                if (ssq) { s += __shfl_xor(s, 16); s += __shfl_xor(s, 32); if (fq == 0) atomicAdd(ssq + row, s); } }
            asm volatile("" ::: "memory");
        }
    }
};

__device__ __forceinline__ float dpp_ror1(float v) { return __builtin_bit_cast(float, __builtin_amdgcn_mov_dpp(__builtin_bit_cast(int, v), 0x121, 0xf, 0xf, true)); }
__device__ __forceinline__ float dpp_ror2(float v) { return __builtin_bit_cast(float, __builtin_amdgcn_mov_dpp(__builtin_bit_cast(int, v), 0x122, 0xf, 0xf, true)); }
struct EpiConvGate {
    static constexpr bool PERM = true, AFTER_DRAIN = false;
    static constexpr size_t CG_SSQ = (1u << 20) + 768 * 1024, CG_ACT = (size_t)148 << 20, CG_YH = (size_t)236 << 20, CG_UPART = (size_t)240 << 20;
    unsigned char* ws; const float* fw; PG8_LAS unsigned char* ldsb;
    __device__ __forceinline__ void operator()(f32x4 (&acc)[2][2][4][2], const Unit& u, int wr, int wc, int fr0, int fq0) const {
        int fr = fr0, fq = fq0; asm volatile("" : "+v"(fr), "+v"(fq));
        bf16_t* ACT = (bf16_t*)(ws + CG_ACT); const float* ssq = (const float*)(ws + CG_SSQ); float* YH = (float*)(ws + CG_YH); float* UPART = (float*)(ws + CG_UPART);
        PG8_LAS float* halo = (PG8_LAS float*)(ldsb + STAGE_BYTES);
        int cl = wc * 32 + 8 * fq;
        int ch = u.pn * 128 + cl;
        if (fr >= 14) {
#pragma unroll
            for (int ai = 0; ai < 2; ++ai) { const float sc = rsqrtf(ssq[u.pm * BM + ai * HALF + wr * 64 + 48 + fr] * (1.0f / 1024.0f) + RMS_EPS);
#pragma unroll
                for (int bj = 0; bj < 2; ++bj)
#pragma unroll
                    for (int n = 0; n < 2; ++n) { const f32x4 v = acc[ai][bj][3][n] * sc; *(PG8_LAS f32x4*)(halo + (((wr * 2 + ai) * 2 + (fr - 14)) * 256 + bj * 128 + cl + 4 * n)) = v;
                        if (ai == 1 && wr == 1) *(f32x4*)(YH + ((size_t)(u.pm * 22 + u.pn) * 2 + (fr - 14)) * 256 + bj * 128 + cl + 4 * n) = v; } }
        }
        asm volatile("s_waitcnt lgkmcnt(0)" ::: "memory"); __builtin_amdgcn_s_barrier(); asm volatile("" ::: "memory");
        typedef unsigned u32x2v __attribute__((ext_vector_type(2)));
#pragma unroll 1
        for (int n = 0; n < 2; ++n) {
            asm volatile("" : "+v"(fr), "+v"(fq));
            cl = wc * 32 + 8 * fq; ch = u.pn * 128 + cl;
            f32x4 w[3][2];
#pragma unroll
            for (int i = 0; i < 3; ++i)
#pragma unroll
                for (int bj = 0; bj < 2; ++bj) w[i][bj] = *(const f32x4*)(fw + (size_t)i * 5632 + bj * 2816 + ch + 4 * n);
#pragma unroll
            for (int ai = 0; ai < 2; ++ai) {
                const bool top = (ai == 0 && wr == 0);
                const int pblk = (ai == 0) ? 0 : (wr == 0 ? 2 : 1);
                f32x4 q1[2], q2[2];
#pragma unroll
                for (int bj = 0; bj < 2; ++bj) { const f32x4 pv = top ? (f32x4){0.f, 0.f, 0.f, 0.f} : *(const PG8_LAS f32x4*)(halo + ((pblk * 2 + (fr & 1)) * 256 + bj * 128 + cl + 4 * n));
#pragma unroll
                    for (int k = 0; k < 4; ++k) { q1[bj][k] = dpp_ror1(pv[k]); q2[bj][k] = dpp_ror2(pv[k]); } }
#pragma unroll
                for (int m = 0; m < 4; ++m) {
                    const int row = u.pm * BM + ai * HALF + wr * 64 + m * 16 + fr; const float sc = rsqrtf(ssq[row] * (1.0f / 1024.0f) + RMS_EPS);
                    f32x4 cu[2];
#pragma unroll
                    for (int bj = 0; bj < 2; ++bj) { const f32x4 ya = acc[ai][bj][m][0];
#pragma unroll
                        for (int k = 0; k < 4; ++k) { const float y = ya[k] * sc;
                            const float a1 = dpp_ror1(y), a2 = dpp_ror2(y);
                            const float p1 = (fr == 0) ? q1[bj][k] : a1, p2 = (fr < 2) ? q2[bj][k] : a2;
                            cu[bj][k] = w[2][bj][k] * y + w[1][bj][k] * p1 + w[0][bj][k] * p2; q1[bj][k] = a1; q2[bj][k] = a2; } }
                    if (top && m == 0 && fr < 2 && (u.pm & 7) != 0) {
#pragma unroll
                        for (int bj = 0; bj < 2; ++bj) *(f32x4*)(UPART + ((size_t)(u.pm * 22 + u.pn) * 2 + fr) * 256 + bj * 128 + cl + 4 * n) = cu[bj];
                    }
                    u32x2v o;
#define PG8_SG(k_) (cu[0][k_] * __builtin_amdgcn_rcpf(1.0f + __expf(-cu[0][k_])) * cu[1][k_])
                    o.x = cvt_pk_bf16(PG8_SG(0), PG8_SG(1)); o.y = cvt_pk_bf16(PG8_SG(2), PG8_SG(3));
#undef PG8_SG
                    *(u32x2v*)(ACT + (size_t)row * 2816 + ch + 4 * n) = o;
                    asm volatile("" ::: "memory");
                }
            }
            if (n == 0) {
#pragma unroll
                for (int ai = 0; ai < 2; ++ai)
#pragma unroll
                    for (int bj = 0; bj < 2; ++bj)
#pragma unroll
                        for (int m = 0; m < 4; ++m) acc[ai][bj][m][0] = acc[ai][bj][m][1];
            }
        }
        asm volatile("s_waitcnt lgkmcnt(0)" ::: "memory"); __builtin_amdgcn_s_barrier(); asm volatile("" ::: "memory");
    }
};

struct EpiResidNorm {
    static constexpr bool PERM = false, AFTER_DRAIN = false;
    const bf16_t* base; float* out; float* ssq2; unsigned* cnt; const float* fnw; int ldc;
    __device__ __forceinline__ void operator()(f32x4 (&acc)[2][2][4][2], const Unit& u, int wr, int wc, int fr, int fq) const {
        typedef unsigned u32x2v __attribute__((ext_vector_type(2)));
        const int col0 = u.pn * BM + wc * 32 + 4 * fq;
#pragma unroll
        for (int ai = 0; ai < 2; ++ai) {
            u32x2v bv[4][2][2];
#pragma unroll
            for (int m = 0; m < 4; ++m) { const size_t off = (size_t)(u.pm * BM + ai * HALF + wr * 64 + m * 16 + fr) * ldc + col0;
#pragma unroll
                for (int bj = 0; bj < 2; ++bj)
#pragma unroll
                    for (int n = 0; n < 2; ++n) bv[m][bj][n] = *(const u32x2v*)(base + off + bj * HALF + n * 16); }
#pragma unroll
            for (int m = 0; m < 4; ++m) { const int row = u.pm * BM + ai * HALF + wr * 64 + m * 16 + fr; float s = 0.f;
#pragma unroll
                for (int bj = 0; bj < 2; ++bj)
#pragma unroll
                    for (int n = 0; n < 2; ++n) { const u32x2v bw = bv[m][bj][n]; const f32x4 v = acc[ai][bj][m][n] + (f32x4){__uint_as_float(bw.x << 16), __uint_as_float(bw.x & 0xffff0000u), __uint_as_float(bw.y << 16), __uint_as_float(bw.y & 0xffff0000u)}; acc[ai][bj][m][n] = v; s += (v[0] * v[0] + v[1] * v[1]) + (v[2] * v[2] + v[3] * v[3]); }
                s += __shfl_xor(s, 16); s += __shfl_xor(s, 32);
                if (fq == 0) (void)__hip_atomic_fetch_add(ssq2 + row, s, __ATOMIC_RELAXED, __HIP_MEMORY_SCOPE_AGENT); }
            asm volatile("" ::: "memory");
        }
        asm volatile("s_waitcnt vmcnt(0)" ::: "memory"); __builtin_amdgcn_s_barrier(); asm volatile("" ::: "memory");
        if (wr == 0 && wc == 0 && fr == 0 && fq == 0) {
            __builtin_amdgcn_fence(__ATOMIC_RELEASE, "agent"); asm volatile("s_waitcnt vmcnt(0)" ::: "memory");
            (void)__hip_atomic_fetch_add(cnt + 16 * u.pm, 1u, __ATOMIC_RELAXED, __HIP_MEMORY_SCOPE_AGENT);
            unsigned sp = 0;
            while (__hip_atomic_load(cnt + 16 * u.pm, __ATOMIC_RELAXED, __HIP_MEMORY_SCOPE_AGENT) < 4u) { __builtin_amdgcn_s_sleep(1); if (++sp > (1u << 22)) break; }
            __builtin_amdgcn_fence(__ATOMIC_ACQUIRE, "agent"); asm volatile("s_waitcnt vmcnt(0)" ::: "memory");
        }
        __builtin_amdgcn_s_barrier(); asm volatile("" ::: "memory");
        f32x4 nw[2][2];
#pragma unroll
        for (int bj = 0; bj < 2; ++bj)
#pragma unroll
            for (int n = 0; n < 2; ++n) nw[bj][n] = *(const f32x4*)(fnw + col0 + bj * HALF + n * 16);
#pragma unroll
        for (int ai = 0; ai < 2; ++ai)
#pragma unroll
            for (int m = 0; m < 4; ++m) { const int row = u.pm * BM + ai * HALF + wr * 64 + m * 16 + fr; const size_t off = (size_t)row * ldc + col0;
                const float rstd = rsqrtf(__hip_atomic_load(ssq2 + row, __ATOMIC_RELAXED, __HIP_MEMORY_SCOPE_AGENT) * (1.0f / 1024.0f) + RMS_EPS);
#pragma unroll
                for (int bj = 0; bj < 2; ++bj)
#pragma unroll
                    for (int n = 0; n < 2; ++n) { const f32x4 v = acc[ai][bj][m][n]; *(f32x4*)(out + off + bj * HALF + n * 16) = (f32x4){v[0] * rstd * nw[bj][n][0], v[1] * rstd * nw[bj][n][1], v[2] * rstd * nw[bj][n][2], v[3] * rstd * nw[bj][n][3]}; } }
    }
};
template <class Epi, class Sched, bool ALIGN_EPI = false, bool SP2 = false>
__device__ __forceinline__ void gemm_phase(PG8_LAS unsigned char* lds, const Gemm g, const Sched& S, const Epi& E) {
    const int tid = threadIdx.x, wid = __builtin_amdgcn_readfirstlane(tid >> 6), lane = tid & 63, wr = wid >> 2, wc = wid & 3, fr = lane & 15, fq = lane >> 4;
    const int K = g.K, nt = K / BK;
    unsigned voffA[2], voffB[2];
#pragma unroll
    for (int i = 0; i < 2; ++i) { int R, C; stage_rc(tid * 16 + i * 8192, R, C); const int Rb = Epi::PERM ? ((R & ~31) + perm32(R & 31)) : R;
        voffA[i] = (unsigned)(R * K + C) * 2u; voffB[i] = (unsigned)(Rb * K + C) * 2u; }
    const size_t kstep = (size_t)(BK * 2);
    const size_t hstep = (size_t)HALF * K * 2;
    const size_t tstep = 2 * hstep;
    const unsigned ldsw = (unsigned)wid * 1024u;
    const int aoff = lds_byte(wr * 64 + fr, fq * 8), boff = lds_byte(wc * 32 + fr, fq * 8);
#define PG8_SA(b, h) (((b) * 2 + (h)) * HTB)
#define PG8_SB(b, h) ((4 + (b) * 2 + (h)) * HTB)
#define PG8_STAGE(bufoff, gbase, voff) do { _Pragma("unroll") for (int _i = 0; _i < 2; ++_i) \
        __builtin_amdgcn_global_load_lds((const unsigned*)((const char*)(gbase) + (voff)[_i]), (PG8_LAS unsigned*)(lds + (bufoff) + ldsw + _i * 8192), 16, 0, 0); } while (0)
#define PG8_LDA(dst, b, h) do { _Pragma("unroll") for (int m = 0; m < 4; ++m) _Pragma("unroll") for (int k = 0; k < 2; ++k) dst[m][k] = *(const PG8_LAS bf16x8*)(lds + PG8_SA(b, h) + aoff + m * 2048 + k * 1024); } while (0)
#define PG8_LDB(dst, b, h) do { _Pragma("unroll") for (int n = 0; n < 2; ++n) _Pragma("unroll") for (int k = 0; k < 2; ++k) dst[n][k] = *(const PG8_LAS bf16x8*)(lds + PG8_SB(b, h) + boff + n * 2048 + k * 1024); } while (0)
#define PG8_MMA(ai, bj, At, Bt) do { __builtin_amdgcn_s_setprio(1); _Pragma("unroll") for (int m = 0; m < 4; ++m) _Pragma("unroll") for (int n = 0; n < 2; ++n) _Pragma("unroll") for (int k = 0; k < 2; ++k) \
        acc[ai][bj][m][n] = __builtin_amdgcn_mfma_f32_16x16x32_bf16(Bt[n][k], At[m][k], acc[ai][bj][m][n], 0, 0, 0); __builtin_amdgcn_s_setprio(0); } while (0)
#define PG8_WAIT_V(n) asm volatile("s_waitcnt vmcnt(" #n ")" ::: "memory")
#define PG8_WAIT_L(n) asm volatile("s_waitcnt lgkmcnt(" #n ")" ::: "memory")
#define PG8_BAR __builtin_amdgcn_s_barrier()
#define PG8_SCHED __builtin_amdgcn_sched_barrier(0)
    Unit cur, nxt; int ui = 0;
    if (!S.next(0, cur)) return;
    f32x4 acc[2][2][4][2];
#pragma unroll
    for (int a = 0; a < 2; ++a)
#pragma unroll
        for (int b = 0; b < 2; ++b)
#pragma unroll
            for (int m = 0; m < 4; ++m)
#pragma unroll
                for (int n = 0; n < 2; ++n) acc[a][b][m][n] = (f32x4){0.f, 0.f, 0.f, 0.f};
    bf16x8 At[4][2], B0[2][2], B1[2][2];
    const char* cA = (const char*)g.A + (size_t)cur.pm * tstep; const char* cB = (const char*)g.Bt + (size_t)cur.pn * tstep;
    S.a_ready(cur);
    if constexpr (SP2) {
        PG8_STAGE(PG8_SB(0, 0), cB, voffB); PG8_STAGE(PG8_SB(0, 1), cB + hstep, voffB); PG8_STAGE(PG8_SA(0, 0), cA, voffA); PG8_STAGE(PG8_SA(0, 1), cA + hstep, voffA);
        if (wr == 1) PG8_BAR;
        PG8_WAIT_V(2); PG8_BAR;
        PG8_STAGE(PG8_SB(1, 0), cB + kstep, voffB); PG8_STAGE(PG8_SA(1, 0), cA + kstep, voffA); PG8_STAGE(PG8_SB(1, 1), cB + hstep + kstep, voffB);
        PG8_WAIT_V(6); PG8_BAR;
    } else {
        PG8_STAGE(PG8_SB(0, 0), cB, voffB); PG8_STAGE(PG8_SA(0, 0), cA, voffA); PG8_STAGE(PG8_SB(0, 1), cB + hstep, voffB); PG8_STAGE(PG8_SA(0, 1), cA + hstep, voffA);
        if (wr == 1) PG8_BAR;
        PG8_WAIT_V(4); PG8_BAR;
        PG8_STAGE(PG8_SB(1, 0), cB + kstep, voffB); PG8_STAGE(PG8_SA(1, 0), cA + kstep, voffA); PG8_STAGE(PG8_SB(1, 1), cB + hstep + kstep, voffB);
        PG8_WAIT_V(6); PG8_BAR;
    }
    for (;;) {
        const bool has_next = S.next(ui + 1, nxt);
        const char* nA = has_next ? (const char*)g.A + (size_t)nxt.pm * tstep : cA; const char* nB = has_next ? (const char*)g.Bt + (size_t)nxt.pn * tstep : cB;
        for (int t = 0; t < nt; t += 2) {
            const bool last = (t == nt - 2);
            const char* a1 = cA + (size_t)(t + 1) * kstep;
            const char* a2 = last ? nA : cA + (size_t)(t + 2) * kstep; const char* b2 = last ? nB : cB + (size_t)(t + 2) * kstep;
            const char* a3 = a2 + kstep; const char* b3 = b2 + kstep;
            if (last && has_next) S.a_ready(nxt);
            if constexpr (SP2) {
            PG8_LDB(B0, 0, 0); PG8_LDB(B1, 0, 1); PG8_SCHED; PG8_LDA(At, 0, 0); PG8_STAGE(PG8_SA(1, 1), a1 + hstep, voffA);
            PG8_WAIT_V(8); PG8_WAIT_L(0); PG8_BAR; PG8_MMA(0, 0, At, B0); PG8_MMA(0, 1, At, B1); PG8_BAR; PG8_SCHED;
            PG8_LDA(At, 0, 1); PG8_STAGE(PG8_SB(0, 0), b2, voffB); PG8_STAGE(PG8_SB(0, 1), b2 + hstep, voffB); PG8_STAGE(PG8_SA(0, 0), a2, voffA);
            PG8_WAIT_V(8); PG8_WAIT_L(0); PG8_BAR; PG8_MMA(1, 0, At, B0); PG8_MMA(1, 1, At, B1); PG8_BAR; PG8_SCHED;
            PG8_LDB(B0, 1, 0); PG8_LDB(B1, 1, 1); PG8_SCHED; PG8_LDA(At, 1, 0); PG8_STAGE(PG8_SA(0, 1), a2 + hstep, voffA);
            PG8_WAIT_V(8); PG8_WAIT_L(0); PG8_BAR; PG8_MMA(0, 0, At, B0); PG8_MMA(0, 1, At, B1); PG8_BAR; PG8_SCHED;
            PG8_LDA(At, 1, 1); PG8_STAGE(PG8_SB(1, 0), b3, voffB); PG8_STAGE(PG8_SB(1, 1), b3 + hstep, voffB); PG8_STAGE(PG8_SA(1, 0), a3, voffA);
            PG8_WAIT_V(8); PG8_WAIT_L(0); PG8_BAR; PG8_MMA(1, 0, At, B0); PG8_MMA(1, 1, At, B1); PG8_BAR; PG8_SCHED;
            } else {
            PG8_LDB(B0, 0, 0); PG8_SCHED; PG8_LDA(At, 0, 0); PG8_STAGE(PG8_SA(1, 1), a1 + hstep, voffA);
            PG8_WAIT_L(8); PG8_BAR; PG8_WAIT_L(0); PG8_MMA(0, 0, At, B0); PG8_BAR; PG8_SCHED;
            PG8_LDB(B1, 0, 1); PG8_STAGE(PG8_SB(0, 0), b2, voffB);
            PG8_BAR; PG8_WAIT_L(0); PG8_MMA(0, 1, At, B1); PG8_BAR;
            PG8_LDA(At, 0, 1); PG8_STAGE(PG8_SA(0, 0), a2, voffA);
            PG8_BAR; PG8_WAIT_L(0); PG8_MMA(1, 0, At, B0); PG8_BAR; PG8_SCHED;
            PG8_STAGE(PG8_SB(0, 1), b2 + hstep, voffB);
            PG8_WAIT_V(6); PG8_BAR; PG8_MMA(1, 1, At, B1); PG8_BAR;
            PG8_LDB(B0, 1, 0); PG8_SCHED; PG8_LDA(At, 1, 0); PG8_STAGE(PG8_SA(0, 1), a2 + hstep, voffA);
            PG8_WAIT_L(8); PG8_BAR; PG8_WAIT_L(0); PG8_MMA(0, 0, At, B0); PG8_BAR; PG8_SCHED;
            PG8_LDB(B1, 1, 1); PG8_STAGE(PG8_SB(1, 0), b3, voffB);
            PG8_BAR; PG8_WAIT_L(0); PG8_MMA(0, 1, At, B1); PG8_BAR;
            PG8_LDA(At, 1, 1); PG8_STAGE(PG8_SA(1, 0), a3, voffA);
            PG8_BAR; PG8_WAIT_L(0); PG8_MMA(1, 0, At, B0); PG8_BAR; PG8_SCHED;
            PG8_STAGE(PG8_SB(1, 1), b3 + hstep, voffB);
            PG8_WAIT_V(6); PG8_BAR; PG8_MMA(1, 1, At, B1); PG8_BAR;
            }
        }
        if constexpr (ALIGN_EPI) { if (wr == 0) PG8_BAR; }
        if constexpr (!Epi::AFTER_DRAIN) { E(acc, cur, wr, wc, fr, fq); S.done(cur); }
        if (!has_next) break;
#pragma unroll
        for (int a = 0; a < 2; ++a)
#pragma unroll
            for (int b = 0; b < 2; ++b)
#pragma unroll
                for (int m = 0; m < 4; ++m)
#pragma unroll
                    for (int n = 0; n < 2; ++n) acc[a][b][m][n] = (f32x4){0.f, 0.f, 0.f, 0.f};
        cur = nxt; cA = nA; cB = nB; ++ui;
        if constexpr (ALIGN_EPI) { if (wr == 1) PG8_BAR; }
    }
    PG8_WAIT_V(0);
    if constexpr (!ALIGN_EPI) { if (wr == 0) PG8_BAR; }
    PG8_BAR;
    if constexpr (Epi::AFTER_DRAIN) { E.fused(acc, cur, wr, wc, fr, fq, lds, wid, lane); S.done(cur); }
#undef PG8_SA
#undef PG8_SB
#undef PG8_STAGE
#undef PG8_LDA
#undef PG8_LDB
#undef PG8_MMA
#undef PG8_WAIT_V
#undef PG8_WAIT_L
#undef PG8_BAR
#undef PG8_SCHED
}
}
#ifndef PG8_SP2
#define PG8_SP2 true
#endif
#ifndef PG8_ALIGN
#define PG8_ALIGN true
#endif
constexpr int NB = 8, SEQ = 2048, DM = 1024, M = NB * SEQ;
constexpr int GH = 4, GD = 128, GW = 512, AH = 8, AD = 64;
constexpr int INC = 3592, NP = 3584;
constexpr int DFF = 2816, NUP = 2 * DFF;
constexpr int PC_QA = 0, PC_KA = 512, PC_VA = 1024, PC_Z = 1536, PC_QB = 2048, PC_KB = 2560, PC_VB = 3072;
constexpr size_t MiB = 1u << 20;
constexpr size_t WS_CTL = 0, WS_AB = 1 * MiB, WS_SSQ = 1 * MiB + 768 * 1024, WS_WIN = 2 * MiB, WS_WOUT = 9 * MiB, WS_WUP = 11 * MiB, WS_WDN = 22 * MiB;
constexpr size_t WS_XN = 28 * MiB, WS_PROJ = 60 * MiB, WS_CAT = 172 * MiB, WS_OA = 204 * MiB, WS_Y = 60 * MiB, WS_ACT = 148 * MiB, WS_END = 256 * MiB;
using pg8::RMS_EPS;
constexpr size_t WS_YH = 236 * MiB, WS_UPART = 240 * MiB;
constexpr size_t WS_SSQ2 = WS_SSQ + 131072;
constexpr size_t WS_GE = WS_SSQ + 65536;
constexpr int GOPS_CHUNK = 57344;
constexpr int SCAN_BUF = GOPS_CHUNK + 16384;
constexpr int NWAVES = 8, NTHR = 512;
constexpr int LDS_BYTES = 155648;
#define LAS __attribute__((address_space(3)))
typedef unsigned short bf16;
typedef unsigned v4u __attribute__((ext_vector_type(4)));
typedef unsigned v2u __attribute__((ext_vector_type(2)));
typedef float f32x4 __attribute__((ext_vector_type(4)));
__device__ __forceinline__ float bf2f(unsigned b) { return __uint_as_float(b << 16); }
__device__ __forceinline__ float bflo(unsigned w) { return __uint_as_float(w << 16); }
__device__ __forceinline__ float bfhi(unsigned w) { return __uint_as_float(w & 0xffff0000u); }
__device__ __forceinline__ unsigned pk2(float lo, float hi) { return pg8::cvt_pk_bf16(lo, hi); }
__device__ __forceinline__ float wave_sum(float v) {
#pragma unroll
    for (int o = 1; o < 64; o <<= 1) v += __shfl_xor(v, o);
    return v;
}
__device__ __forceinline__ float silu_f(float x) { return x * __builtin_amdgcn_rcpf(1.0f + __expf(-x)); }
__device__ __forceinline__ float sigmoid_f(float x) { return __builtin_amdgcn_rcpf(1.0f + __expf(-x)); }
__device__ __forceinline__ float softplus_f(float x) { return x > 20.f ? x : log1pf(__expf(x)); }

struct Args { const float* in[13]; float* out; unsigned char* ws; int ph_lo, ph_hi, coop, pad; };

__device__ __forceinline__ void p0_transpose_item(const float* W, int ldw, int k0, int sn0, bf16* WT, int K, int dn0, const float* kscale, LAS float* scr, int lane) {
    float tv[32];
#pragma unroll
    for (int i = 0; i < 32; ++i) { const int kk = 2 * i + (lane >> 5); tv[i] = W[(size_t)(k0 + kk) * ldw + sn0 + (lane & 31)]; }
    if (kscale) {
#pragma unroll
        for (int i = 0; i < 32; ++i) tv[i] *= kscale[k0 + 2 * i + (lane >> 5)]; }
#pragma unroll
    for (int i = 0; i < 32; ++i) scr[(2 * i + (lane >> 5)) * 33 + (lane & 31)] = tv[i];
    asm volatile("s_waitcnt lgkmcnt(0)" ::: "memory");
    const int c = lane & 7;
#pragma unroll
    for (int j = 0; j < 4; ++j) { const int n = (lane >> 3) + 8 * j; const LAS float* s = scr + (8 * c) * 33 + n;
        v4u o; o.x = pk2(s[0 * 33], s[1 * 33]); o.y = pk2(s[2 * 33], s[3 * 33]); o.z = pk2(s[4 * 33], s[5 * 33]); o.w = pk2(s[6 * 33], s[7 * 33]);
        *(v4u*)(WT + (size_t)(dn0 + n) * K + k0 + 8 * c) = o; }
    asm volatile("s_waitcnt lgkmcnt(0)" ::: "memory");
}

__device__ __forceinline__ void p0_prologue(const Args& A, LAS unsigned char* lds, int tid, int lane, int wave) {
    const float* x = A.in[0]; const float* nw1 = A.in[1]; const float* w_in = A.in[2]; const float* w_out = A.in[7]; const float* nw2 = A.in[8];
    const float* w_up = A.in[9]; const float* w_dn = A.in[11];
    unsigned char* ws = A.ws;
    bf16* WIN = (bf16*)(ws + WS_WIN); bf16* WOUT = (bf16*)(ws + WS_WOUT); bf16* WUP = (bf16*)(ws + WS_WUP); bf16* WDN = (bf16*)(ws + WS_WDN);
    bf16* XN = (bf16*)(ws + WS_XN); float* AB = (float*)(ws + WS_AB); float* SSQ = (float*)(ws + WS_SSQ);
    LAS float* scr = (LAS float*)(lds + wave * 9216);
    LAS float* wab = (LAS float*)(lds + 73728);
    const int G = gridDim.x, gw = blockIdx.x * NWAVES + wave, NGW = G * NWAVES;
    for (int i = blockIdx.x * NTHR + tid; i < M; i += G * NTHR) { SSQ[i] = 0.f; ((float*)(ws + WS_SSQ2))[i] = 0.f; }
    if (blockIdx.x == 0 && tid < 64) ((unsigned*)(ws + WS_CTL))[tid] = 0u;
    for (int idx = tid; idx < 8192; idx += NTHR) { const int k = idx >> 3, j = idx & 7; wab[j * 1024 + k] = nw1[k] * w_in[(size_t)k * INC + 2048 + j]; }
    constexpr int I_IN = 16 * (NP / 32);
    for (int it = gw; it < I_IN; it += NGW) { const int nblk = NP / 32, kb = it / nblk, nb = it % nblk, n0 = 32 * nb; p0_transpose_item(w_in, INC, 64 * kb, n0 + (n0 >= 2048 ? 8 : 0), WIN, DM, n0, nullptr, scr, lane); }
    __syncthreads();
    for (int m0 = gw; m0 < M; m0 += 2 * NGW) {
        const f32x4* nr = (const f32x4*)nw1 + lane;
        f32x4 v[2][4]; float s[2] = {0.f, 0.f};
#pragma unroll
        for (int rr = 0; rr < 2; ++rr) { const int m = min(m0 + rr * NGW, M - 1); const f32x4* xr = (const f32x4*)(x + (size_t)m * DM) + lane;
#pragma unroll
            for (int j = 0; j < 4; ++j) v[rr][j] = xr[64 * j]; }
#pragma unroll
        for (int rr = 0; rr < 2; ++rr)
#pragma unroll
            for (int j = 0; j < 4; ++j) s[rr] += (v[rr][j].x * v[rr][j].x + v[rr][j].y * v[rr][j].y) + (v[rr][j].z * v[rr][j].z + v[rr][j].w * v[rr][j].w);
#pragma unroll
        for (int rr = 0; rr < 2; ++rr) { const int m = m0 + rr * NGW; if (m >= M) break;
            const float rstd = rsqrtf(wave_sum(s[rr]) * (1.f / DM) + RMS_EPS);
            float ab[8];
#pragma unroll
            for (int q = 0; q < 8; ++q) { float a = 0.f;
#pragma unroll
                for (int j = 0; j < 4; ++j) { const f32x4 w = *(const LAS f32x4*)(wab + q * 1024 + 256 * j + 4 * lane); a += (v[rr][j].x * w.x + v[rr][j].y * w.y) + (v[rr][j].z * w.z + v[rr][j].w * w.w); }
                ab[q] = wave_sum(a) * rstd; }
            if (lane == 0) { *(f32x4*)(AB + (size_t)m * 8) = (f32x4){ab[0], ab[1], ab[2], ab[3]}; *(f32x4*)(AB + (size_t)m * 8 + 4) = (f32x4){ab[4], ab[5], ab[6], ab[7]}; }
            v2u* o8 = (v2u*)(XN + (size_t)m * DM) + lane;
#pragma unroll
            for (int j = 0; j < 4; ++j) { const f32x4 n = nr[64 * j]; v2u o; o.x = pk2(v[rr][j].x * rstd * n.x, v[rr][j].y * rstd * n.y); o.y = pk2(v[rr][j].z * rstd * n.z, v[rr][j].w * rstd * n.w); o8[64 * j] = o; }
        }
    }
}


__device__ __forceinline__ void convert_late_weights(const Args& A, LAS unsigned char* lds, int lane, int wave, int gw0, int ngw) {
    const float* w_out = A.in[7]; const float* nw2 = A.in[8]; const float* w_up = A.in[9]; const float* w_dn = A.in[11];
    bf16* WOUT = (bf16*)(A.ws + WS_WOUT); bf16* WUP = (bf16*)(A.ws + WS_WUP); bf16* WDN = (bf16*)(A.ws + WS_WDN);
    LAS float* scr = (LAS float*)(lds + wave * 9216);
    constexpr int I_OUT = 16 * 32, I_UP = 16 * (NUP / 32), I_DN = (DFF / 64) * 32;
    for (int it = gw0; it < I_OUT + I_UP + I_DN; it += ngw) {
        int r = it;
        if (r < I_OUT) { const int kb = r / 32, nb = r % 32; p0_transpose_item(w_out, DM, 64 * kb, 32 * nb, WOUT, DM, 32 * nb, nullptr, scr, lane); continue; } r -= I_OUT;
        if (r < I_UP) { const int nblk = NUP / 32, kb = r / nblk, nb = r % nblk, n0 = 32 * nb, pn = n0 >> 8, j0 = n0 & 255;
            const int s0 = (j0 < 128) ? (128 * pn + j0) : (DFF + 128 * pn + j0 - 128);
            p0_transpose_item(w_up, NUP, 64 * kb, s0, WUP, DM, n0, nw2, scr, lane); continue; } r -= I_UP;
        { const int kb = r / 32, nb = r % 32; p0_transpose_item(w_dn, DM, 64 * kb, 32 * nb, WDN, DFF, 32 * nb, nullptr, scr, lane); }
    }
}
__device__ __forceinline__ void gdn_simple(const Args& A, LAS unsigned char* lds, int tid, int lane, int wave) {
    const bf16* PROJ = (const bf16*)(A.ws + WS_PROJ); const float* AB = (const float*)(A.ws + WS_AB); float* OA = (float*)(A.ws + WS_OA);
    const float* cw = A.in[3]; const float* a_log = A.in[4]; const float* dt_bias = A.in[5];
    LAS float* qs = (LAS float*)lds; LAS float* ks = qs + 16 * 128; LAS float* vs = ks + 16 * 128; LAS float* av = vs + 16 * 128; LAS float* bv = av + 16;
    for (int task = blockIdx.x; task < NB * GH; task += gridDim.x) {
        const int b = task / GH, h = task % GH, v = tid >> 2, part = tid & 3;
        float S[32];
#pragma unroll
        for (int i = 0; i < 32; ++i) S[i] = 0.f;
        const float Ah = __expf(a_log[h]), dtb = dt_bias[h];
        for (int blk = 0; blk < SEQ / 16; ++blk) {
            const int t0 = blk * 16;
            for (int idx = tid; idx < 16 * 384; idx += NTHR) {
                const int tt = idx / 384, c = idx % 384, which = c >> 7, d = c & 127, col = which * 512 + h * 128 + d, t = t0 + tt;
                float acc = 0.f;
#pragma unroll
                for (int i = 0; i < 4; ++i) { const int ts = t - 3 + i; if (ts >= 0) acc += cw[i * 1536 + col] * bf2f(PROJ[(size_t)(b * SEQ + ts) * NP + col]); }
                qs[which * 2048 + tt * 128 + d] = silu_f(acc);
            }
            if (tid < 16) { const size_t row = (size_t)b * SEQ + t0 + tid; bv[tid] = sigmoid_f(AB[row * 8 + h]); av[tid] = __expf(-Ah * softplus_f(AB[row * 8 + 4 + h] + dtb)); }
            __syncthreads();
#pragma unroll
            for (int r = 0; r < 4; ++r) { const int row = 4 * wave + r; LAS float* arr = qs + row * 128;
                const float v0 = arr[lane], v1 = arr[lane + 64]; const float s = wave_sum(v0 * v0 + v1 * v1);
                const float sc = rsqrtf(s + RMS_EPS) * (row < 16 ? 0.08838834764831845f : 1.0f); arr[lane] = v0 * sc; arr[lane + 64] = v1 * sc; }
            __syncthreads();
            for (int tt = 0; tt < 16; ++tt) {
                const float a = av[tt], bt = bv[tt], vt = vs[tt * 128 + v];
                float kS = 0.f;
#pragma unroll
                for (int i = 0; i < 32; ++i) kS += ks[tt * 128 + 32 * part + i] * S[i];
                kS += __shfl_xor(kS, 1); kS += __shfl_xor(kS, 2);
                const float c = bt * (vt - a * kS); float o = 0.f;
#pragma unroll
                for (int i = 0; i < 32; ++i) { S[i] = a * S[i] + ks[tt * 128 + 32 * part + i] * c; o += qs[tt * 128 + 32 * part + i] * S[i]; }
                o += __shfl_xor(o, 1); o += __shfl_xor(o, 2);
                if (part == 0) OA[(size_t)(b * SEQ + t0 + tt) * GW + h * 128 + v] = o;
            }
            __syncthreads();
        }
    }
}


template <int J, int K, int N> struct SolveLd {
    static __device__ __forceinline__ void run(f32x4 (&l)[4], unsigned lbase) {
        if constexpr (K < N) { constexpr int t40 = ((J + 1) >> 2) << 2;
            asm volatile("ds_read_b128 %0, %1 offset:%2" : "=v"(l[K]) : "v"(lbase), "i"((J * 68 + t40 + 4 * K) * 4)); SolveLd<J, K + 1, N>::run(l, lbase); }
    }
};
template <int J> struct SolveCol16 {
    static __device__ __forceinline__ void run(float (&R)[16], unsigned lbase) {
        if constexpr (J < 15) {
            constexpr int t40 = ((J + 1) >> 2) << 2, nld = (16 - t40) >> 2;
            f32x4 l[4];
            SolveLd<J, 0, nld>::run(l, lbase);
            asm volatile("s_waitcnt lgkmcnt(0)" ::: "memory");
#pragma unroll
            for (int k = 0; k < nld; ++k) asm volatile("" : "+v"(l[k]));
#pragma unroll
            for (int k = 0; k < nld; ++k) {
#pragma unroll
                for (int e = 0; e < 4; ++e) if (t40 + 4 * k + e > J) R[t40 + 4 * k + e] += l[k][e] * R[J]; }
            SolveCol16<J + 1>::run(R, lbase);
        }
    }
};

typedef short bf16x8 __attribute__((ext_vector_type(8)));
__device__ __forceinline__ void gdn_prep(const Args& A, LAS unsigned char* lds, int tid0, int lane0, int wave) {
    const bf16* PROJ = (const bf16*)(A.ws + WS_PROJ); const float* AB = (const float*)(A.ws + WS_AB);
    const float* cw = A.in[3]; const float* a_log = A.in[4]; const float* dt_bias = A.in[5];
    unsigned char* UVF = A.ws + WS_XN; unsigned char* GOPS = (unsigned char*)A.out; float* GE = (float*)(A.ws + WS_GE);
    LAS float* Qs = (LAS float*)lds; LAS float* Ks = (LAS float*)(lds + 33792); LAS float* Vs = (LAS float*)(lds + 67584);
    LAS bf16* Qb = (LAS bf16*)(lds + 101376); LAS bf16* Kb = (LAS bf16*)(lds + 118784);
    LAS float* gcs = (LAS float*)(lds + 136192); LAS float* bts = gcs + 64; LAS float* egs = gcs + 128; LAS float* kes = gcs + 192;
    LAS float* LsT = (LAS float*)lds; LAS bf16* ATs = (LAS bf16*)(lds + 17408); LAS bf16* WKs = Kb;
    v4u rwn[11];
    if (tid0 < 384 && (int)blockIdx.x < NB * GH * 32) { const int c8 = tid0 % 48, run = tid0 / 48, which = c8 >> 4, d0 = (c8 & 15) * 8, t1 = blockIdx.x, bh1 = t1 >> 5, n1 = t1 & 31, b1 = bh1 >> 2, h1 = bh1 & 3, col1 = which * 512 + h1 * 128 + d0;
#pragma unroll
        for (int r = 0; r < 11; ++r) { const int ts = 64 * n1 + 8 * run - 3 + r; rwn[r] = (ts >= 0) ? *(const v4u*)(PROJ + (size_t)(b1 * SEQ + ts) * NP + col1) : (v4u){0u, 0u, 0u, 0u}; } }
    else {
#pragma unroll
        for (int r = 0; r < 11; ++r) rwn[r] = (v4u){0u, 0u, 0u, 0u}; }
#pragma unroll 1
    for (int task = blockIdx.x; task < NB * GH * 32; task += gridDim.x) {
        int tid = tid0, lane = lane0; asm volatile("" : "+v"(tid), "+v"(lane));
        const int fr = lane & 15, fq = lane >> 4;
        const int bh = task >> 5, n = task & 31, b = bh >> 2, h = bh & 3, t0 = 64 * n, row0 = b * SEQ + t0;
        unsigned char* gops = GOPS + (size_t)task * GOPS_CHUNK;
        if (tid < 384) {
            const int c8 = tid % 48, run = tid / 48, which = c8 >> 4, d0 = (c8 & 15) * 8, col = which * 512 + h * 128 + d0;
            v4u rw[11];
#pragma unroll
            for (int r = 0; r < 11; ++r) rw[r] = rwn[r];
            { const int tn = task + gridDim.x;
              if (tn < NB * GH * 32) { const int bhn = tn >> 5, nn = tn & 31, bn = bhn >> 2, hn = bhn & 3, coln = which * 512 + hn * 128 + d0;
#pragma unroll
                for (int r = 0; r < 11; ++r) { const int ts = 64 * nn + 8 * run - 3 + r; rwn[r] = (ts >= 0) ? *(const v4u*)(PROJ + (size_t)(bn * SEQ + ts) * NP + coln) : (v4u){0u, 0u, 0u, 0u}; } } }
            f32x4 cwa[4], cwb[4];
#pragma unroll
            for (int j = 0; j < 4; ++j) { cwa[j] = *(const f32x4*)(cw + j * 1536 + col); cwb[j] = *(const f32x4*)(cw + j * 1536 + col + 4); }
#pragma unroll
            for (int i = 0; i < 8; ++i) {
                float acc[8];
#pragma unroll
                for (int e2 = 0; e2 < 8; ++e2) acc[e2] = 0.f;
#pragma unroll
                for (int j = 0; j < 4; ++j) { const v4u w = rw[i + j];
                    acc[0] += cwa[j].x * bflo(w.x); acc[1] += cwa[j].y * bfhi(w.x); acc[2] += cwa[j].z * bflo(w.y); acc[3] += cwa[j].w * bfhi(w.y);
                    acc[4] += cwb[j].x * bflo(w.z); acc[5] += cwb[j].y * bfhi(w.z); acc[6] += cwb[j].z * bflo(w.w); acc[7] += cwb[j].w * bfhi(w.w); }
                float ss = 0.f;
#pragma unroll
                for (int e2 = 0; e2 < 8; ++e2) { acc[e2] = silu_f(acc[e2]); ss += acc[e2] * acc[e2]; }
                ss += __builtin_bit_cast(float, __builtin_amdgcn_update_dpp(0, __builtin_bit_cast(int, ss), 0xB1, 0xf, 0xf, false));
                ss += __builtin_bit_cast(float, __builtin_amdgcn_update_dpp(0, __builtin_bit_cast(int, ss), 0x4E, 0xf, 0xf, false));
                ss += __builtin_bit_cast(float, __builtin_amdgcn_update_dpp(0, __builtin_bit_cast(int, ss), 0x141, 0xf, 0xf, false));
                ss += __builtin_bit_cast(float, __builtin_amdgcn_update_dpp(0, __builtin_bit_cast(int, ss), 0x140, 0xf, 0xf, false));
                const int tt = 8 * run + i;
                if (which == 2) { *(LAS f32x4*)(Vs + tt * 132 + d0) = (f32x4){acc[0], acc[1], acc[2], acc[3]}; *(LAS f32x4*)(Vs + tt * 132 + d0 + 4) = (f32x4){acc[4], acc[5], acc[6], acc[7]}; }
                else {
                    const float sc = rsqrtf(ss + RMS_EPS) * (which == 0 ? 0.08838834764831845f : 1.0f);
#pragma unroll
                    for (int e2 = 0; e2 < 8; ++e2) acc[e2] *= sc;
                    const v4u pk = (v4u){pk2(acc[0], acc[1]), pk2(acc[2], acc[3]), pk2(acc[4], acc[5]), pk2(acc[6], acc[7])};
                    if (which == 0) *(LAS v4u*)(Qb + tt * 136 + d0) = pk;
                    else { *(LAS v4u*)(Kb + tt * 136 + d0) = pk; *(LAS f32x4*)(Ks + tt * 132 + d0) = (f32x4){acc[0], acc[1], acc[2], acc[3]}; *(LAS f32x4*)(Ks + tt * 132 + d0 + 4) = (f32x4){acc[4], acc[5], acc[6], acc[7]}; }
                }
            }
        }
        if (wave == 0) {
            const size_t row = (size_t)row0 + lane; const float beta = sigmoid_f(AB[row * 8 + h]);
            float g = -__expf(a_log[h]) * softplus_f(AB[row * 8 + 4 + h] + dt_bias[h]);
#pragma unroll
            for (int o = 1; o < 64; o <<= 1) { const float t = __shfl_up(g, o); if (lane >= o) g += t; }
            const float glast = __shfl(g, 63);
            gcs[lane] = g; bts[lane] = beta; egs[lane] = __expf(g); kes[lane] = __expf(glast - g) * beta;
            if (lane == 63) GE[task] = __expf(g);
        }
        __syncthreads();
#pragma unroll 1
        for (int jb = wave; jb < 20; jb += 8) {
            const int kind = jb >= 10 ? 1 : 0, idx = jb - 10 * kind, ti = idx < 1 ? 0 : (idx < 3 ? 1 : (idx < 6 ? 2 : 3)), tj = idx - ti * (ti + 1) / 2;
            const LAS bf16* As = kind ? Qb : Kb; f32x4 d = (f32x4){0.f, 0.f, 0.f, 0.f};
#pragma unroll
            for (int ks = 0; ks < 4; ++ks) { const bf16x8 a = *(const LAS bf16x8*)(As + (16 * ti + fr) * 136 + 32 * ks + 8 * fq), bb = *(const LAS bf16x8*)(Kb + (16 * tj + fr) * 136 + 32 * ks + 8 * fq);
                d = __builtin_amdgcn_mfma_f32_16x16x32_bf16(a, bb, d, 0, 0, 0); }
            const int j = 16 * tj + fr; const float gj = gcs[j], bj = bts[j]; float val[4];
#pragma unroll
            for (int e = 0; e < 4; ++e) { const int t = 16 * ti + 4 * fq + e; const float x = d[e] * __expf(gcs[t] - gj) * bj; val[e] = (kind ? (t >= j) : (t > j)) ? x : 0.f; }
            if (kind == 0) *(LAS f32x4*)(LsT + j * 68 + 16 * ti + 4 * fq) = (f32x4){-val[0], -val[1], -val[2], -val[3]};
            else {
#pragma unroll
                for (int e = 0; e < 4; ++e) ATs[(16 * ti + 4 * fq + e) * 72 + j] = (bf16)(pk2(val[e], 0.f) & 0xffffu); }
        }
        __syncthreads();
        LAS float* Ti = (LAS float*)(lds + 26624);
        if (wave == 0) {
            const int I = lane >> 4, c = lane & 15; float x[16];
#pragma unroll
            for (int r = 0; r < 16; ++r) x[r] = (r == c) ? 1.0f : 0.0f;
            SolveCol16<0>::run(x, (unsigned)(uintptr_t)LsT + (unsigned)(I * (16 * 68 + 16) * 4));
#pragma unroll
            for (int r = 0; r < 16; ++r) Ti[(I * 16 + r) * 20 + c] = x[r];
        } else {
            const int rt = tid - 64;
            for (int q = rt; q < 1024; q += 448) { const int blk = q >> 6, l2 = q & 63, i = l2 & 15, f = l2 >> 4, mb = blk >> 2, ks = blk & 3, t = 16 * mb + i;
                const v2u p0 = *(const LAS v2u*)(Qb + t * 136 + 32 * ks + 4 * f), p1 = *(const LAS v2u*)(Qb + t * 136 + 32 * ks + 16 + 4 * f); const float eg = egs[t];
                v4u o; o.x = pk2(bflo(p0.x) * eg, bfhi(p0.x) * eg); o.y = pk2(bflo(p0.y) * eg, bfhi(p0.y) * eg); o.z = pk2(bflo(p1.x) * eg, bfhi(p1.x) * eg); o.w = pk2(bflo(p1.y) * eg, bfhi(p1.y) * eg);
                *(v4u*)(gops + 16384 + q * 16) = o; }
            for (int q = rt; q < 512; q += 448) { const int blk = q >> 6, l2 = q & 63, i = l2 & 15, f = l2 >> 4, mb = blk >> 1, ks2 = blk & 1, t = 16 * mb + i;
                v2u p0 = (v2u){0u, 0u}, p1 = (v2u){0u, 0u};
                if (2 * ks2 <= mb) p0 = *(const LAS v2u*)(ATs + t * 72 + 32 * ks2 + 4 * f);
                if (2 * ks2 + 1 <= mb) p1 = *(const LAS v2u*)(ATs + t * 72 + 32 * ks2 + 16 + 4 * f);
                *(v4u*)(gops + 32768 + q * 16) = (v4u){p0.x, p0.y, p1.x, p1.y}; }
            for (int q = rt; q < 1024; q += 448) { const int blk = q >> 6, l2 = q & 63, i = l2 & 15, f = l2 >> 4, dkb = blk >> 1, ks2 = blk & 1, dk = 16 * dkb + i; float v[8];
#pragma unroll
                for (int e2 = 0; e2 < 8; ++e2) { const int c = 32 * ks2 + 16 * (e2 >> 2) + 4 * f + (e2 & 3); v[e2] = Ks[c * 132 + dk] * kes[c]; }
                *(v4u*)(gops + 40960 + q * 16) = (v4u){pk2(v[0], v[1]), pk2(v[2], v[3]), pk2(v[4], v[5]), pk2(v[6], v[7])}; }
        }
        __syncthreads();
#pragma unroll
        for (int ct = 0; ct < 2; ++ct) {
            const int C = 2 * wave + ct; const bool isv = C < 8; const int col = isv ? 16 * C + fr : 16 * (C - 8) + fr;
            f32x4 X[4];
#pragma unroll
            for (int I = 0; I < 4; ++I) {
                f32x4 acc;
#pragma unroll
                for (int e2 = 0; e2 < 4; ++e2) { const int t = 16 * I + 4 * fq + e2; acc[e2] = isv ? Vs[t * 132 + col] : egs[t] * Ks[t * 132 + col]; }
#pragma unroll
                for (int J = 0; J < 4; ++J) if (J < I) {
#pragma unroll
                    for (int kk = 0; kk < 4; ++kk) acc = __builtin_amdgcn_mfma_f32_16x16x4f32(LsT[(16 * J + 4 * fq + kk) * 68 + 16 * I + fr], X[J][kk], acc, 0, 0, 0); }
                f32x4 xi = (f32x4){0.f, 0.f, 0.f, 0.f};
#pragma unroll
                for (int kk = 0; kk < 4; ++kk) xi = __builtin_amdgcn_mfma_f32_16x16x4f32(Ti[(I * 16 + fr) * 20 + 4 * fq + kk], acc[kk], xi, 0, 0, 0);
                X[I] = xi;
                if (isv) { v2u w; w.x = pk2(xi[0], xi[1]); w.y = pk2(xi[2], xi[3]); *(v2u*)(UVF + (size_t)task * 16384 + (size_t)((C * 4 + I) * 64 + lane) * 8) = w; }
                else {
#pragma unroll
                    for (int e2 = 0; e2 < 4; ++e2) WKs[(16 * I + 4 * fq + e2) * 136 + col] = (bf16)(pk2(xi[e2], 0.f) & 0xffffu); }
            }
        }
        __syncthreads();
        for (int q = tid; q < 1024; q += NTHR) { const int blk = q >> 6, l2 = q & 63, i = l2 & 15, f = l2 >> 4, mb = blk >> 2, ks = blk & 3, t = 16 * mb + i;
            const v2u p0 = *(const LAS v2u*)(WKs + t * 136 + 32 * ks + 4 * f), p1 = *(const LAS v2u*)(WKs + t * 136 + 32 * ks + 16 + 4 * f);
            *(v4u*)(gops + q * 16) = (v4u){p0.x, p0.y, p1.x, p1.y}; }
        __syncthreads();
    }
}

__device__ __forceinline__ bf16x8 pack8(const f32x4 a, const f32x4 b) {
    v4u w; w.x = pk2(a[0], a[1]); w.y = pk2(a[2], a[3]); w.z = pk2(b[0], b[1]); w.w = pk2(b[2], b[3]); return __builtin_bit_cast(bf16x8, w);
}
__device__ __forceinline__ void gdn_scan(const Args& A, LAS unsigned char* lds, int bh, int tid, int lane, int wave) {
    const int b = bh >> 2, h = bh & 3, fr = lane & 15, fq = lane >> 4, vs = wave;
    const unsigned char* gops = (const unsigned char*)A.out + (size_t)bh * 32 * GOPS_CHUNK;
    const unsigned char* uvf = A.ws + WS_XN + (size_t)bh * 32 * 16384; const float* GE = (const float*)(A.ws + WS_GE) + bh * 32;
    float* Op = (float*)(A.ws + WS_OA) + ((size_t)b * SEQ + 4 * fq) * GW + h * 128 + 16 * vs + fr;
    f32x4 S[8];
#pragma unroll
    for (int i = 0; i < 8; ++i) S[i] = (f32x4){0.f, 0.f, 0.f, 0.f};
    const float gev = GE[lane & 31];
#define SCAN_DMA(chunk, bufoff) do { _Pragma("unroll") for (int i_ = 0; i_ < 9; ++i_) { const int p_ = wave + 8 * i_; \
        const unsigned char* s_ = (p_ < 56) ? (gops + (size_t)(chunk) * GOPS_CHUNK + p_ * 1024) : (uvf + (size_t)(chunk) * 16384 + (p_ - 56) * 1024); \
        __builtin_amdgcn_global_load_lds((const unsigned*)(s_ + lane * 16), (LAS unsigned*)(lds + (bufoff) + p_ * 1024), 16, 0, 0); } } while (0)
    SCAN_DMA(0, 0); SCAN_DMA(1, SCAN_BUF);
    asm volatile("s_waitcnt vmcnt(0)" ::: "memory"); __syncthreads();
#pragma unroll 1
    for (int n = 0; n < 32; ++n) {
        const LAS unsigned char* cur = lds + (n & 1) * SCAN_BUF;
        const float ge = __builtin_bit_cast(float, __builtin_amdgcn_readlane(__builtin_bit_cast(int, gev), n));
        bf16x8 Sb[4];
#pragma unroll
        for (int ks = 0; ks < 4; ++ks) Sb[ks] = pack8(S[2 * ks], S[2 * ks + 1]);
        f32x4 u[4];
#pragma unroll
        for (int mb = 0; mb < 4; ++mb) { f32x4 p = (f32x4){0.f, 0.f, 0.f, 0.f};
#pragma unroll
            for (int ks = 0; ks < 4; ++ks) p = __builtin_amdgcn_mfma_f32_16x16x32_bf16(*(const LAS bf16x8*)(cur + ((mb * 4 + ks) * 64 + lane) * 16), Sb[ks], p, 0, 0, 0);
            const v2u uw = *(const LAS v2u*)(cur + GOPS_CHUNK + ((vs * 4 + mb) * 64 + lane) * 8);
            u[mb] = (f32x4){bflo(uw.x) - p[0], bfhi(uw.x) - p[1], bflo(uw.y) - p[2], bfhi(uw.y) - p[3]}; }
        bf16x8 ub[2]; ub[0] = pack8(u[0], u[1]); ub[1] = pack8(u[2], u[3]);
        f32x4 o[4];
#pragma unroll
        for (int mb = 0; mb < 4; ++mb) { f32x4 acc = (f32x4){0.f, 0.f, 0.f, 0.f};
#pragma unroll
            for (int ks = 0; ks < 4; ++ks) acc = __builtin_amdgcn_mfma_f32_16x16x32_bf16(*(const LAS bf16x8*)(cur + 16384 + ((mb * 4 + ks) * 64 + lane) * 16), Sb[ks], acc, 0, 0, 0);
#pragma unroll
            for (int ks2 = 0; ks2 < 2; ++ks2) if (ks2 <= (mb >> 1)) acc = __builtin_amdgcn_mfma_f32_16x16x32_bf16(*(const LAS bf16x8*)(cur + 32768 + ((mb * 2 + ks2) * 64 + lane) * 16), ub[ks2], acc, 0, 0, 0);
            o[mb] = acc; }
#pragma unroll
        for (int dkb = 0; dkb < 8; ++dkb) { f32x4 acc = S[dkb] * ge;
#pragma unroll
            for (int ks2 = 0; ks2 < 2; ++ks2) acc = __builtin_amdgcn_mfma_f32_16x16x32_bf16(*(const LAS bf16x8*)(cur + 40960 + ((dkb * 2 + ks2) * 64 + lane) * 16), ub[ks2], acc, 0, 0, 0);
            S[dkb] = acc; }
        asm volatile("s_waitcnt vmcnt(0)" ::: "memory"); __syncthreads();
        if (n + 2 < 32) SCAN_DMA(n + 2, (n & 1) * SCAN_BUF);
        float* orow = Op + (size_t)(64 * n) * GW;
#pragma unroll
        for (int mb = 0; mb < 4; ++mb) { float* q = orow + (size_t)(16 * mb) * GW; q[0] = o[mb][0]; q[GW] = o[mb][1]; q[2 * GW] = o[mb][2]; q[3 * GW] = o[mb][3]; }
    }
    asm volatile("s_waitcnt vmcnt(0)" ::: "memory"); __syncthreads();
#undef SCAN_DMA
}


__device__ __forceinline__ void attn_fast(const Args& A, LAS unsigned char* lds, int lane, int wave) {
    const bf16* PROJ = (const bf16*)(A.ws + WS_PROJ); bf16* CAT = (bf16*)(A.ws + WS_CAT);
    unsigned* ctr = (unsigned*)(A.ws + WS_CTL);
    LAS bf16* Vt = (LAS bf16*)(lds + wave * 8192);
    const int fr = lane & 15, fq = lane >> 4;
    const int kk = lane & 31, vslot = 8 * ((kk & 15) >> 2) + 4 * (kk >> 4) + (kk & 3), vch = lane >> 5;
    constexpr float SC = 0.125f * 1.4426950408889634f;
    const int myx = (int)(__builtin_amdgcn_s_getreg((3 << 11) | 20) & 0x7u);
    int qi = 0;
    for (;;) {
        int wt = 256, xq = 0;
        while (qi < 8) { xq = (myx + qi) & 7; unsigned wt_ = 0; if (lane == 0) wt_ = atomicAdd(ctr + 16 * xq, 1u); wt = __builtin_amdgcn_readfirstlane(wt_); if (wt < 256) break; ++qi; }
        if (qi >= 8) break;
        const int T = 7 - (wt >> 5), b = (wt >> 2) & 7, h = xq, c0 = wt & 3, t0 = 256 * T;
        const bf16* Pb = PROJ + (size_t)b * SEQ * NP;
        const int tq0 = t0 + c0 + 16 * fr;
        bf16x8 qf0[2], qf1[2], qf2[2], qf3[2];
#pragma unroll
        for (int ks = 0; ks < 2; ++ks) { const bf16* qp = Pb + (size_t)tq0 * NP + PC_QB + h * 64 + 32 * ks + 8 * fq;
            qf0[ks] = *(const bf16x8*)qp; qf1[ks] = *(const bf16x8*)(qp + 4 * NP); qf2[ks] = *(const bf16x8*)(qp + 8 * NP); qf3[ks] = *(const bf16x8*)(qp + 12 * NP); }
        const int n2 = ((t0 + 240) >> 4) + 1, g2 = (n2 + 31) >> 5;
        const int lo1 = max(t0 + c0 - 512, c0), n1 = ((t0 + c0 + 12 + 240 - lo1) >> 2) + 1, g1 = (n1 + 31) >> 5;
        const int lo0 = max(t0 + c0 - 128, 0), n0 = (t0 + c0 + 12 + 240 - lo0) + 1, g0 = (n0 + 31) >> 5;
        const int NG = 4 * g2 + g1 + g0;
        f32x4 O0[4], O1[4], O2[4], O3[4];
#pragma unroll
        for (int i = 0; i < 4; ++i) { O0[i] = (f32x4){0.f, 0.f, 0.f, 0.f}; O1[i] = O0[i]; O2[i] = O0[i]; O3[i] = O0[i]; }
        float m0 = -INFINITY, l0 = 0.f, m1 = -INFINITY, l1 = 0.f, m2 = -INFINITY, l2 = 0.f, m3 = -INFINITY, l3 = 0.f;
        v4u kc[4], vc[4], kn[4], vn[4];
#define ATT_DEC(f, kst, str, mode) do { if ((f) < 4 * g2) { const int ci_ = (f) / g2; str = 16; kst = c0 + 4 * ci_ + 512 * ((f) - ci_ * g2); mode = 1 << ci_; } \
            else if ((f) < 4 * g2 + g1) { str = 4; kst = lo1 + 128 * ((f) - 4 * g2); mode = 15; } else { str = 1; kst = lo0 + 32 * ((f) - 4 * g2 - g1); mode = 15; } } while (0)
#define ATT_LOAD(kreg, vreg, kst, str) do { \
            _Pragma("unroll") for (int j = 0; j < 2; ++j) { const int tk = min((kst) + (str) * (16 * j + fr), SEQ - 1); \
                _Pragma("unroll") for (int ks = 0; ks < 2; ++ks) kreg[2 * j + ks] = *(const v4u*)(Pb + (size_t)tk * NP + PC_KB + h * 64 + 32 * ks + 8 * fq); } \
            { const int tk = min((kst) + (str) * kk, SEQ - 1); \
                _Pragma("unroll") for (int i = 0; i < 4; ++i) vreg[i] = *(const v4u*)(Pb + (size_t)tk * NP + PC_VB + h * 64 + 8 * (vch + 2 * i)); } } while (0)
#define ATT_CLS(O_, m_, l_, qf_, tq_) do { \
            f32x4 d0 = (f32x4){0.f, 0.f, 0.f, 0.f}, d1 = d0; \
            _Pragma("unroll") for (int ks = 0; ks < 2; ++ks) { d0 = __builtin_amdgcn_mfma_f32_16x16x32_bf16(__builtin_bit_cast(bf16x8, kc[ks]), qf_[ks], d0, 0, 0, 0); \
                                                             d1 = __builtin_amdgcn_mfma_f32_16x16x32_bf16(__builtin_bit_cast(bf16x8, kc[2 + ks]), qf_[ks], d1, 0, 0, 0); } \
            float s[8]; float mloc = -INFINITY; \
            const int dv = (((tq_) - kst) >> shl) - 4 * fq;        \
            _Pragma("unroll") for (int e2 = 0; e2 < 8; ++e2) { const float x = (e2 < 4 ? d0[e2 & 3] : d1[e2 & 3]) * SC; \
                s[e2] = ((unsigned)(dv - (16 * (e2 >> 2) + (e2 & 3))) <= 128u) ? x : -INFINITY; mloc = fmaxf(mloc, s[e2]); } \
            mloc = fmaxf(mloc, __shfl_xor(mloc, 16)); mloc = fmaxf(mloc, __shfl_xor(mloc, 32)); \
            const float mnew = fmaxf(m_, mloc), alpha = __builtin_amdgcn_exp2f(m_ - mnew); m_ = mnew; \
            float psum = 0.f; \
            _Pragma("unroll") for (int e2 = 0; e2 < 8; ++e2) { s[e2] = __builtin_amdgcn_exp2f(s[e2] - mnew); psum += s[e2]; } \
            l_ = l_ * alpha + psum; \
            const bf16x8 pb = pack8((f32x4){s[0], s[1], s[2], s[3]}, (f32x4){s[4], s[5], s[6], s[7]}); \
            _Pragma("unroll") for (int db = 0; db < 4; ++db) O_[db] = __builtin_amdgcn_mfma_f32_16x16x32_bf16(va[db], pb, O_[db] * alpha, 0, 0, 0); } while (0)
        int kst, str, mode; ATT_DEC(0, kst, str, mode); ATT_LOAD(kc, vc, kst, str);
#pragma unroll 1
        for (int f = 0; f < NG; ++f) {
            int kstn = 0, strn = 1, moden = 0;
            if (f + 1 < NG) { ATT_DEC(f + 1, kstn, strn, moden); ATT_LOAD(kn, vn, kstn, strn); }
#pragma unroll
            for (int i = 0; i < 4; ++i) { const int dd = 8 * (vch + 2 * i); const v4u w = vc[i];
                Vt[(dd + 0) * 40 + vslot] = (bf16)(w.x & 0xffffu); Vt[(dd + 1) * 40 + vslot] = (bf16)(w.x >> 16); Vt[(dd + 2) * 40 + vslot] = (bf16)(w.y & 0xffffu); Vt[(dd + 3) * 40 + vslot] = (bf16)(w.y >> 16);
                Vt[(dd + 4) * 40 + vslot] = (bf16)(w.z & 0xffffu); Vt[(dd + 5) * 40 + vslot] = (bf16)(w.z >> 16); Vt[(dd + 6) * 40 + vslot] = (bf16)(w.w & 0xffffu); Vt[(dd + 7) * 40 + vslot] = (bf16)(w.w >> 16); }
            bf16x8 va[4];
#pragma unroll
            for (int db = 0; db < 4; ++db) va[db] = *(const LAS bf16x8*)(Vt + (16 * db + fr) * 40 + 8 * fq);
            const int shl = (str == 16) ? 4 : (str == 4 ? 2 : 0);
            if (mode & 1) ATT_CLS(O0, m0, l0, qf0, tq0);
            if (mode & 2) ATT_CLS(O1, m1, l1, qf1, tq0 + 4);
            if (mode & 4) ATT_CLS(O2, m2, l2, qf2, tq0 + 8);
            if (mode & 8) ATT_CLS(O3, m3, l3, qf3, tq0 + 12);
#pragma unroll
            for (int i = 0; i < 4; ++i) { kc[i] = kn[i]; vc[i] = vn[i]; }
            kst = kstn; str = strn; mode = moden;
        }
#undef ATT_DEC
#undef ATT_LOAD
#undef ATT_CLS
        bf16* op = CAT + ((size_t)b * SEQ + tq0) * DM + GW + h * 64 + 4 * fq;
#define ATT_OUT(O_, l_, ci_) do { float lt = l_; lt += __shfl_xor(lt, 16); lt += __shfl_xor(lt, 32); const float inv = 1.0f / lt; \
            _Pragma("unroll") for (int db = 0; db < 4; ++db) { v2u w; w.x = pk2(O_[db][0] * inv, O_[db][1] * inv); w.y = pk2(O_[db][2] * inv, O_[db][3] * inv); *(v2u*)(op + (ci_) * 4 * DM + 16 * db) = w; } } while (0)
        ATT_OUT(O0, l0, 0); ATT_OUT(O1, l1, 1); ATT_OUT(O2, l2, 2); ATT_OUT(O3, l3, 3);
#undef ATT_OUT
    }
}

__device__ __forceinline__ void attn_simple(const Args& A, int tid, int lane, int wave) {
    const bf16* PROJ = (const bf16*)(A.ws + WS_PROJ); bf16* CAT = (bf16*)(A.ws + WS_CAT);
    unsigned* ctr = (unsigned*)(A.ws + WS_CTL);
    for (;;) {
        unsigned wt_ = 0; if (lane == 0) wt_ = atomicAdd(ctr, 1u); const int wt = __builtin_amdgcn_readfirstlane(wt_);
        if (wt >= (M / 64) * AH) break;
        const int h = wt % AH, tb = wt / AH, row = tb * 64 + lane, b = row / SEQ, t = row % SEQ;
        float q[64], acc[64];
        { const v4u* qp = (const v4u*)(PROJ + (size_t)row * NP + PC_QB + h * 64);
#pragma unroll
          for (int j = 0; j < 8; ++j) { const v4u w = qp[j]; q[8 * j + 0] = bflo(w.x) * 0.125f; q[8 * j + 1] = bfhi(w.x) * 0.125f; q[8 * j + 2] = bflo(w.y) * 0.125f; q[8 * j + 3] = bfhi(w.y) * 0.125f;
              q[8 * j + 4] = bflo(w.z) * 0.125f; q[8 * j + 5] = bfhi(w.z) * 0.125f; q[8 * j + 6] = bflo(w.w) * 0.125f; q[8 * j + 7] = bfhi(w.w) * 0.125f; } }
#pragma unroll
        for (int j = 0; j < 64; ++j) acc[j] = 0.f;
        float mx = -1e30f, l = 0.f;
        for (int br = 0; br < 3; ++br) {
            const int stride = br == 0 ? 1 : (br == 1 ? 4 : 16);
            for (int i = 0; i <= 128; ++i) {
                const int tk = t - i * stride; if (tk < 0) break;
                const size_t krow = (size_t)(b * SEQ + tk) * NP;
                const v4u* kp = (const v4u*)(PROJ + krow + PC_KB + h * 64); const v4u* vp = (const v4u*)(PROJ + krow + PC_VB + h * 64);
                float s = 0.f;
#pragma unroll
                for (int j = 0; j < 8; ++j) { const v4u w = kp[j]; s += q[8 * j + 0] * bflo(w.x) + q[8 * j + 1] * bfhi(w.x) + q[8 * j + 2] * bflo(w.y) + q[8 * j + 3] * bfhi(w.y)
                                                                       + q[8 * j + 4] * bflo(w.z) + q[8 * j + 5] * bfhi(w.z) + q[8 * j + 6] * bflo(w.w) + q[8 * j + 7] * bfhi(w.w); }
                const float mn = fmaxf(mx, s), sc = __expf(mx - mn), p = __expf(s - mn); mx = mn; l = l * sc + p;
#pragma unroll
                for (int j = 0; j < 8; ++j) { const v4u w = vp[j];
                    acc[8 * j + 0] = acc[8 * j + 0] * sc + p * bflo(w.x); acc[8 * j + 1] = acc[8 * j + 1] * sc + p * bfhi(w.x); acc[8 * j + 2] = acc[8 * j + 2] * sc + p * bflo(w.y); acc[8 * j + 3] = acc[8 * j + 3] * sc + p * bfhi(w.y);
                    acc[8 * j + 4] = acc[8 * j + 4] * sc + p * bflo(w.z); acc[8 * j + 5] = acc[8 * j + 5] * sc + p * bfhi(w.z); acc[8 * j + 6] = acc[8 * j + 6] * sc + p * bflo(w.w); acc[8 * j + 7] = acc[8 * j + 7] * sc + p * bfhi(w.w); }
            }
        }
        const float inv = 1.0f / l; v4u* op = (v4u*)(CAT + (size_t)row * DM + GW + h * 64);
#pragma unroll
        for (int j = 0; j < 8; ++j) { v4u w; w.x = pk2(acc[8 * j] * inv, acc[8 * j + 1] * inv); w.y = pk2(acc[8 * j + 2] * inv, acc[8 * j + 3] * inv); w.z = pk2(acc[8 * j + 4] * inv, acc[8 * j + 5] * inv); w.w = pk2(acc[8 * j + 6] * inv, acc[8 * j + 7] * inv); op[j] = w; }
    }
}
__device__ __forceinline__ void gated_norm(const Args& A, int lane, int wave) {
    const bf16* PROJ = (const bf16*)(A.ws + WS_PROJ); bf16* CAT = (bf16*)(A.ws + WS_CAT); const float* OA = (const float*)(A.ws + WS_OA); const float* gw = A.in[6];
    const float w0 = gw[2 * lane], w1 = gw[2 * lane + 1];
    const int gwv = blockIdx.x * NWAVES + wave, NGW = gridDim.x * NWAVES;
    for (int wt0 = gwv; wt0 < M * GH; wt0 += 8 * NGW) {
        float2 o[8]; unsigned zz[8];
#pragma unroll
        for (int i = 0; i < 8; ++i) { const int wt = min(wt0 + i * NGW, M * GH - 1), row = wt / GH, h = wt % GH;
            o[i] = *(const float2*)(OA + (size_t)row * GW + h * 128 + 2 * lane); zz[i] = *(const unsigned*)(PROJ + (size_t)row * NP + PC_Z + h * 128 + 2 * lane); }
#pragma unroll
        for (int i = 0; i < 8; ++i) { const int wt = wt0 + i * NGW; if (wt >= M * GH) break; const int row = wt / GH, h = wt % GH;
            const float ms = wave_sum(o[i].x * o[i].x + o[i].y * o[i].y) * (1.0f / 128.0f), r = rsqrtf(ms + RMS_EPS);
            *(unsigned*)(CAT + (size_t)row * DM + h * 128 + 2 * lane) = pk2(o[i].x * r * w0 * silu_f(bflo(zz[i])), o[i].y * r * w1 * silu_f(bfhi(zz[i]))); }
    }
}

__device__ __forceinline__ void gated_norm_bh(const Args& A, int bh, int lane, int wave) {
    const int b = bh >> 2, h = bh & 3;
    const bf16* Zp = (const bf16*)(A.ws + WS_PROJ) + (size_t)b * SEQ * NP + PC_Z + h * 128 + 2 * lane; bf16* Cp = (bf16*)(A.ws + WS_CAT) + (size_t)b * SEQ * DM + h * 128 + 2 * lane;
    const float* Op = (const float*)(A.ws + WS_OA) + (size_t)b * SEQ * GW + h * 128 + 2 * lane; const float* gw = A.in[6];
    const float w0 = gw[2 * lane], w1 = gw[2 * lane + 1];
    __builtin_amdgcn_fence(__ATOMIC_ACQUIRE, "agent");
#pragma unroll 1
    for (int r0 = wave * 16; r0 < SEQ; r0 += NWAVES * 16) {
        float2 o[16]; unsigned zz[16];
#pragma unroll
        for (int i = 0; i < 16; ++i) { o[i] = *(const float2*)(Op + (size_t)(r0 + i) * GW); zz[i] = *(const unsigned*)(Zp + (size_t)(r0 + i) * NP); }
#pragma unroll
        for (int i = 0; i < 16; ++i) { const float ms = wave_sum(o[i].x * o[i].x + o[i].y * o[i].y) * (1.0f / 128.0f), r = rsqrtf(ms + RMS_EPS);
            *(unsigned*)(Cp + (size_t)(r0 + i) * DM) = pk2(o[i].x * r * w0 * silu_f(bflo(zz[i])), o[i].y * r * w1 * silu_f(bfhi(zz[i]))); }
    }
}
__device__ __forceinline__ void ffn_conv_half(const Args& A, int half, int tid) {
    const bf16* Y = (const bf16*)(A.ws + WS_Y); bf16* ACT = (bf16*)(A.ws + WS_ACT); const float* fw = A.in[10];
    constexpr int HC = DFF / 2;
    for (size_t it = (size_t)blockIdx.x * NTHR + tid; it < (size_t)M * (HC / 8); it += (size_t)gridDim.x * NTHR) {
        const int row = (int)(it / (HC / 8)), g8 = (int)(it % (HC / 8)), cl = g8 * 8, pn = cl >> 7, j = cl & 127, t = row % SEQ, ch = half * HC + cl;
        float ga[8], ua[8];
#pragma unroll
        for (int e = 0; e < 8; ++e) { ga[e] = 0.f; ua[e] = 0.f; }
#pragma unroll
        for (int i = 0; i < 3; ++i) { const int ts = t - 2 + i; if (ts < 0) continue;
            const bf16* yr = Y + (size_t)(row - 2 + i) * DFF + 256 * pn + j; const v4u g = *(const v4u*)yr, u = *(const v4u*)(yr + 128);
            const f32x4 wg0 = *(const f32x4*)(fw + i * NUP + ch), wg1 = *(const f32x4*)(fw + i * NUP + ch + 4), wu0 = *(const f32x4*)(fw + i * NUP + DFF + ch), wu1 = *(const f32x4*)(fw + i * NUP + DFF + ch + 4);
            ga[0] += wg0.x * bflo(g.x); ga[1] += wg0.y * bfhi(g.x); ga[2] += wg0.z * bflo(g.y); ga[3] += wg0.w * bfhi(g.y); ga[4] += wg1.x * bflo(g.z); ga[5] += wg1.y * bfhi(g.z); ga[6] += wg1.z * bflo(g.w); ga[7] += wg1.w * bfhi(g.w);
            ua[0] += wu0.x * bflo(u.x); ua[1] += wu0.y * bfhi(u.x); ua[2] += wu0.z * bflo(u.y); ua[3] += wu0.w * bfhi(u.y); ua[4] += wu1.x * bflo(u.z); ua[5] += wu1.y * bfhi(u.z); ua[6] += wu1.z * bflo(u.w); ua[7] += wu1.w * bfhi(u.w); }
        v4u o; o.x = pk2(silu_f(ga[0]) * ua[0], silu_f(ga[1]) * ua[1]); o.y = pk2(silu_f(ga[2]) * ua[2], silu_f(ga[3]) * ua[3]); o.z = pk2(silu_f(ga[4]) * ua[4], silu_f(ga[5]) * ua[5]); o.w = pk2(silu_f(ga[6]) * ua[6], silu_f(ga[7]) * ua[7]);
        *(v4u*)(ACT + (size_t)row * DFF + ch) = o;
    }
}

__device__ __forceinline__ void ffn_fixup(const Args& A, int tid) {
    const float* YH = (const float*)(A.ws + WS_YH); const float* UP = (const float*)(A.ws + WS_UPART); bf16* ACT = (bf16*)(A.ws + WS_ACT); const float* fw = A.in[10];
    for (int it = blockIdx.x * NTHR + tid; it < 64 * 22 * 2 * 128; it += gridDim.x * NTHR) {
        const int c = it & 127, r = (it >> 7) & 1, tile = it >> 8, pm = tile / 22, pn = tile % 22; if ((pm & 7) == 0) continue;
        const int ch = pn * 128 + c; const float* up = UP + ((size_t)tile * 2 + r) * 256; const float* yh = YH + (size_t)((pm - 1) * 22 + pn) * 2 * 256;
        float g = up[c], u = up[128 + c];
        const float wg0 = fw[ch], wg1 = fw[5632 + ch], wu0 = fw[2816 + ch], wu1 = fw[5632 + 2816 + ch];
        if (r == 0) { g += wg0 * yh[c] + wg1 * yh[256 + c]; u += wu0 * yh[128 + c] + wu1 * yh[256 + 128 + c]; }
        else { g += wg0 * yh[256 + c]; u += wu0 * yh[256 + 128 + c]; }
        ACT[(size_t)(pm * 256 + r) * DFF + ch] = (bf16)(pk2(silu_f(g) * u, 0.f) & 0xffffu);
    }
}
__device__ __forceinline__ void final_norm(const Args& A, int lane, int wave) {
    float* out = A.out; const f32x4* nr = (const f32x4*)A.in[12] + lane;
    const int gw = blockIdx.x * NWAVES + wave, NGW = gridDim.x * NWAVES;
    f32x4 nw[4];
#pragma unroll
    for (int j = 0; j < 4; ++j) nw[j] = nr[64 * j];
    for (int m0 = gw; m0 < M; m0 += 4 * NGW) {
        f32x4 v[4][4];
#pragma unroll
        for (int rr = 0; rr < 4; ++rr) { const int m = min(m0 + rr * NGW, M - 1); const f32x4* xr = (const f32x4*)(out + (size_t)m * DM) + lane;
#pragma unroll
            for (int j = 0; j < 4; ++j) v[rr][j] = xr[64 * j]; }
#pragma unroll
        for (int rr = 0; rr < 4; ++rr) { const int m = m0 + rr * NGW; if (m >= M) break; float s = 0.f;
#pragma unroll
            for (int j = 0; j < 4; ++j) s += (v[rr][j].x * v[rr][j].x + v[rr][j].y * v[rr][j].y) + (v[rr][j].z * v[rr][j].z + v[rr][j].w * v[rr][j].w);
            const float rstd = rsqrtf(wave_sum(s) * (1.f / DM) + RMS_EPS); f32x4* xw = (f32x4*)(out + (size_t)m * DM) + lane;
#pragma unroll
            for (int j = 0; j < 4; ++j) xw[64 * j] = (f32x4){v[rr][j].x * rstd * nw[j].x, v[rr][j].y * rstd * nw[j].y, v[rr][j].z * rstd * nw[j].z, v[rr][j].w * rstd * nw[j].w}; }
    }
}

#define XB_TMO      128
#define XB_XCNT(j)  (256  + 64 * (j))
#define XB_XSUB(j)  (1280 + 64 * (j))
#define XB_XGEN(j)  (2304 + 64 * (j))
#define XB_TOP      3328
#define XB_TOPGEN   3392
#define XCD_BAR_WORDS 3456
#define XB_SPIN_CAP (1u << 18)

__device__ __forceinline__ unsigned xb_ld(unsigned* p)              { return __hip_atomic_load(p, __ATOMIC_RELAXED, __HIP_MEMORY_SCOPE_AGENT); }
__device__ __forceinline__ unsigned xb_add(unsigned* p, unsigned v) { return __hip_atomic_fetch_add(p, v, __ATOMIC_RELAXED, __HIP_MEMORY_SCOPE_AGENT); }
__device__ __forceinline__ unsigned xb_xcc_id() { return (unsigned)__builtin_amdgcn_s_getreg((3 << 11) | 20) & 0xFu; }
#define XB_SPIN(cond, bar) do { unsigned _sp = 0; while (cond) { __builtin_amdgcn_s_sleep(1); \
    if ((++_sp & 255u) == 0u) { if (xb_ld(&(bar)[XB_TMO])) break; if (_sp > XB_SPIN_CAP) { atomicAdd(&(bar)[XB_TMO], 1u); break; } } } } while (0)

struct XcdBarrier {
    unsigned* bar; unsigned x;
    volatile LAS unsigned* st;
};

__device__ __forceinline__ XcdBarrier xcd_barrier_post(unsigned* bar, volatile LAS unsigned* st) {
    XcdBarrier b; b.bar = bar; b.x = xb_xcc_id(); b.st = st;
    if (threadIdx.x == 0) (void)xb_add(&bar[XB_XCNT(b.x)], 1u);
    return b;
}
__device__ __forceinline__ void xcd_barrier_complete(unsigned* bar, unsigned x, unsigned& nloc, unsigned& nx) {
    const unsigned G = gridDim.x * gridDim.y * gridDim.z;
    unsigned sum, cnt, mine, sp = 0u;
    for (;;) {
        sum = 0u; cnt = 0u; mine = 0u;
#pragma unroll
        for (unsigned j = 0; j < 16; ++j) { const unsigned c = xb_ld(&bar[XB_XCNT(j)]); sum += c; cnt += (c > 0u) ? 1u : 0u; mine = (j == x) ? c : mine; }
        if (sum == G) break;
        __builtin_amdgcn_s_sleep(1);
        if ((++sp & 255u) == 0u) { if (xb_ld(&bar[XB_TMO])) break; if (sp > XB_SPIN_CAP) { atomicAdd(&bar[XB_TMO], 1u); break; } }
    }
    nloc = mine > 0u ? mine : 1u; nx = cnt > 0u ? cnt : 1u;
}

__device__ __forceinline__ void xcd_barrier(const XcdBarrier& b) {
    asm volatile("s_waitcnt vmcnt(0)" ::: "memory");
    __syncthreads();
    if (threadIdx.x == 0) {
        unsigned* bar = b.bar;
        __builtin_amdgcn_s_waitcnt(0);
        unsigned nloc = b.st[0], nx = b.st[1];
        if (nloc == 0u) { xcd_barrier_complete(bar, b.x, nloc, nx); b.st[0] = nloc; b.st[1] = nx; }
        const unsigned old = xb_add(&bar[XB_XSUB(b.x)], 1u);
        const unsigned gen = old / nloc;
        if (old + 1u == (gen + 1u) * nloc) {
            __builtin_amdgcn_fence(__ATOMIC_RELEASE, "agent");
            asm volatile("s_waitcnt vmcnt(0)" ::: "memory");
            const unsigned og = xb_add(&bar[XB_TOP], 1u);
            const unsigned tg = og / nx;
            if (og + 1u == (tg + 1u) * nx) xb_add(&bar[XB_TOPGEN], 1u);
            else XB_SPIN(xb_ld(&bar[XB_TOPGEN]) == tg, bar);
            __builtin_amdgcn_fence(__ATOMIC_ACQUIRE, "agent");
            xb_add(&bar[XB_XGEN(b.x)], 1u);
            asm volatile("s_waitcnt vmcnt(0)" ::: "memory");
        } else {
            XB_SPIN(xb_ld(&bar[XB_XGEN(b.x)]) == gen, bar);
            __builtin_amdgcn_fence(__ATOMIC_ACQUIRE, "agent");
            asm volatile("s_waitcnt vmcnt(0)" ::: "memory");
        }
    }
    __syncthreads();
}

constexpr int N_PHASES = 8;
__global__ void __launch_bounds__(NTHR, 2) mk_fwd(Args args) {
    extern __shared__ __attribute__((aligned(16))) unsigned char lds_raw[];
    LAS unsigned char* lds = (LAS unsigned char*)lds_raw;
    const int tid = threadIdx.x, lane = tid & 63, wave = __builtin_amdgcn_readfirstlane(tid >> 6);
    const int lo = args.ph_lo, hi = args.ph_hi;
    unsigned char* ws = args.ws;
    bf16* WIN = (bf16*)(ws + WS_WIN); bf16* WOUT = (bf16*)(ws + WS_WOUT); bf16* WUP = (bf16*)(ws + WS_WUP); bf16* WDN = (bf16*)(ws + WS_WDN);
    bf16* XN = (bf16*)(ws + WS_XN); bf16* PROJ = (bf16*)(ws + WS_PROJ); bf16* CAT = (bf16*)(ws + WS_CAT); bf16* Y = (bf16*)(ws + WS_Y); bf16* ACT = (bf16*)(ws + WS_ACT);
    float* SSQ = (float*)(ws + WS_SSQ);
#define IN(k) (lo <= (k) && (k) < hi)
#define SEAM(k) do { if (IN(k) && IN((k) + 1)) { xcd_barrier(bar); } } while (0)
    { volatile LAS unsigned* st = (volatile LAS unsigned*)(lds + LDS_BYTES - 64); if (tid < 2) st[tid] = 0u; }
    __syncthreads();
    XcdBarrier bar = xcd_barrier_post((unsigned*)(ws + WS_CTL) + 4096, (volatile LAS unsigned*)(lds + LDS_BYTES - 64));
    if (args.coop > 1) cg::this_grid().sync();
    if (IN(0)) { p0_prologue(args, lds, tid, lane, wave); } SEAM(0);
    if (IN(1)) { pg8::Gemm g{XN, WIN, M, NP, DM}; pg8::StaticOrder S; S.init(M, NP, gridDim.x, blockIdx.x); pg8::EpiBf16S E{PROJ, NP, nullptr};
        pg8::gemm_phase<pg8::EpiBf16S, pg8::StaticOrder, PG8_ALIGN, PG8_SP2>(lds, g, S, E);
        { pg8::Unit u4; const bool idle4 = !S.next(3, u4); const int G = gridDim.x, nidle = (G == 256) ? 128 : G;
          if (G != 256) convert_late_weights(args, lds, lane, wave, blockIdx.x * NWAVES + wave, G * NWAVES);
          else if (idle4) convert_late_weights(args, lds, lane, wave, (blockIdx.x - 128) * NWAVES + wave, nidle * NWAVES); } } SEAM(1);
    if (IN(2)) { gdn_prep(args, lds, tid, lane, wave); } SEAM(2);
    if (IN(3)) { if (blockIdx.x < NB * GH) gdn_scan(args, lds, blockIdx.x, tid, lane, wave); attn_fast(args, lds, lane, wave); xcd_barrier(bar); gated_norm(args, lane, wave); } SEAM(3);
    if (IN(4)) { pg8::Gemm g{CAT, WOUT, M, DM, DM}; pg8::StaticOrder S; S.init(M, DM, gridDim.x, blockIdx.x); pg8::EpiResid E{args.in[0], (gridDim.x == 256) ? nullptr : args.out, XN, SSQ, DM};
        pg8::gemm_phase<pg8::EpiResid, pg8::StaticOrder, PG8_ALIGN, PG8_SP2>(lds, g, S, E); } SEAM(4);
    if (IN(5)) { pg8::Gemm g{XN, WUP, M, NUP, DM}; pg8::StaticOrder S; S.init(M, NUP, gridDim.x, blockIdx.x);
        static_assert(pg8::EpiConvGate::CG_SSQ == WS_SSQ && pg8::EpiConvGate::CG_ACT == WS_ACT && pg8::EpiConvGate::CG_YH == WS_YH && pg8::EpiConvGate::CG_UPART == WS_UPART, "d_ws map");
        pg8::EpiConvGate E{ws, args.in[10], lds};
        pg8::gemm_phase<pg8::EpiConvGate, pg8::StaticOrder, true, PG8_SP2>(lds, g, S, E); } SEAM(5);
    if (IN(6)) { ffn_fixup(args, tid); } SEAM(6);
    if (IN(7)) { pg8::Gemm g{ACT, WDN, M, DM, DFF}; pg8::StaticOrder S; S.init(M, DM, gridDim.x, blockIdx.x);
        if (gridDim.x == 256) {
            pg8::EpiResidNorm E{XN, args.out, (float*)(ws + WS_SSQ2), (unsigned*)(ws + WS_CTL) + 2048, args.in[12], DM};
            pg8::gemm_phase<pg8::EpiResidNorm, pg8::StaticOrder, true, PG8_SP2>(lds, g, S, E);
        } else {
            pg8::EpiResid E{args.out, args.out, nullptr, nullptr, DM};
            pg8::gemm_phase<pg8::EpiResid, pg8::StaticOrder, PG8_ALIGN, PG8_SP2>(lds, g, S, E);
            xcd_barrier(bar); final_norm(args, lane, wave);
        } }
#undef IN
#undef SEAM
}

#ifndef MK_ONE_LAUNCH
#define MK_ONE_LAUNCH 1
#endif
extern "C" void kernel_launch(void* const* d_in, const int* in_sizes, int n_in, void* d_out, int out_size, void* d_ws, size_t ws_size, hipStream_t stream) {
    static int grid = 0;
    if (grid == 0) {
        if (n_in != 13 || out_size != M * DM || ws_size < WS_END) { fprintf(stderr, "kernel_launch: unexpected shapes n_in %d out %d ws %zu\n", n_in, out_size, ws_size); grid = -1; return; }
        int dev = 0, cus = 0, per_cu = 0;
        hipGetDevice(&dev); hipDeviceGetAttribute(&cus, hipDeviceAttributeMultiprocessorCount, dev);
        hipFuncSetAttribute((const void*)mk_fwd, hipFuncAttributeMaxDynamicSharedMemorySize, LDS_BYTES);
        hipOccupancyMaxActiveBlocksPerMultiprocessor(&per_cu, (const void*)mk_fwd, NTHR, LDS_BYTES);
        (void)hipGetLastError();
        if (per_cu < 1) { fprintf(stderr, "kernel_launch: occupancy query says %d blocks per CU\n", per_cu); per_cu = 1; }
        grid = cus;
    }
    if (grid < 0) return;
    if (hipMemsetAsync((char*)d_ws + WS_CTL, 0, 65536, stream) != hipSuccess) { fprintf(stderr, "kernel_launch: memset failed\n"); return; }
    Args a{};
    for (int i = 0; i < 13; ++i) a.in[i] = (const float*)d_in[i];
    a.out = (float*)d_out; a.ws = (unsigned char*)d_ws;
#if MK_ONE_LAUNCH
    a.ph_lo = 0; a.ph_hi = N_PHASES; a.coop = 1;
    void* kargs[] = {&a};
    hipError_t e = hipLaunchCooperativeKernel((const void*)mk_fwd, dim3(grid), dim3(NTHR), kargs, LDS_BYTES, stream);
    if (e != hipSuccess) fprintf(stderr, "cooperative launch failed: %s (grid %d)\n", hipGetErrorString(e), grid);
#else
    for (int p = 0; p < N_PHASES; ++p) { a.ph_lo = p; a.ph_hi = p + 1; a.coop = 0; hipLaunchKernelGGL(mk_fwd, dim3(grid), dim3(NTHR), LDS_BYTES, stream, a); }
#endif
}
```

```cpp
#include <hip/hip_runtime.h>
#include <hip/hip_cooperative_groups.h>
#include <cstdio>
#include <cstdint>
namespace cg = cooperative_groups;
namespace pg8 {
#define PG8_LAS __attribute__((address_space(3)))
typedef unsigned short bf16_t;
typedef short bf16x8 __attribute__((ext_vector_type(8)));
typedef float f32x4 __attribute__((ext_vector_type(4)));
typedef unsigned u32x4 __attribute__((ext_vector_type(4)));
constexpr int BM = 256, BK = 64, HALF = 128, HTB = HALF * BK * 2  , STAGE_BYTES = 8 * HTB, NXCD = 8, WGM = 8;

__host__ __device__ __forceinline__ int lds_byte(int r, int c) { const int st = (r >> 4) * 2 + (c >> 5), rr = r & 15, cc = c & 31, ob = rr * 64 + cc * 2; return st * 1024 + (ob ^ (((ob >> 9) & 1) << 5)); }
__host__ __device__ __forceinline__ void stage_rc(int b, int& R, int& C) { const int st = b / 1024, sb = b % 1024, swz = sb ^ (((sb >> 9) & 1) << 5); R = (st >> 1) * 16 + swz / 64; C = (st & 1) * 32 + (swz % 64) / 2; }
__host__ __device__ __forceinline__ int perm32(int rho) { const int n = rho >> 4, i = rho & 15; return 8 * (i >> 2) + 4 * n + (i & 3); }

struct Unit { int pm, pn; };
struct Gemm { const bf16_t* A; const bf16_t* Bt; int M, N, K; };

struct StaticOrder {
    int nM, nN, nwg, G, c;
    __host__ __device__ __forceinline__ void init(int M, int N, int G_, int c_) { nM = M / BM; nN = N / BM; nwg = nM * nN; G = G_; c = c_; }
    __host__ __device__ __forceinline__ bool next(int i, Unit& u) const {
        const long L = (long)i * G + c; if (L >= nwg) return false;
        int wgid = (int)L; { const int q = nwg / NXCD, r = nwg % NXCD, xcd = wgid % NXCD, off = wgid / NXCD; wgid = (xcd < r ? xcd * (q + 1) : r * (q + 1) + (xcd - r) * q) + off; }
        const int nig = WGM * nN, gid = wgid / nig, fm = gid * WGM, gsz = (nM - fm) < WGM ? (nM - fm) : WGM;
        u.pm = fm + ((wgid % nig) % gsz); u.pn = (wgid % nig) / gsz; return true;
    }
    __device__ __forceinline__ void a_ready(const Unit&) const {}
    __device__ __forceinline__ void done(const Unit&) const {}
};

__device__ __forceinline__ unsigned cvt_pk_bf16(float lo, float hi) { unsigned r; asm volatile("v_cvt_pk_bf16_f32 %0, %1, %2" : "=v"(r) : "v"(lo), "v"(hi)); return r; }
constexpr float RMS_EPS = 1e-6f;
struct EpiBf16S {
    static constexpr bool PERM = true, AFTER_DRAIN = false;
    bf16_t* O; int ldc; const float* ssq;
    __device__ __forceinline__ void operator()(const f32x4 (&acc)[2][2][4][2], const Unit& u, int wr, int wc, int fr, int fq) const {
        const int row0 = u.pm * BM + wr * 64 + fr; const int col0 = u.pn * BM + wc * 32 + 8 * fq;
#pragma unroll
        for (int ai = 0; ai < 2; ++ai)
#pragma unroll
            for (int m = 0; m < 4; ++m) { const int row = row0 + ai * HALF + m * 16; bf16_t* rowp = O + (size_t)row * ldc + col0;
                const float sc = ssq ? rsqrtf(ssq[row] * (1.0f / 1024.0f) + RMS_EPS) : 1.0f;
#pragma unroll
                for (int bj = 0; bj < 2; ++bj) { const f32x4 v0 = acc[ai][bj][m][0] * sc, v1 = acc[ai][bj][m][1] * sc;
                    u32x4 w; w.x = cvt_pk_bf16(v0[0], v0[1]); w.y = cvt_pk_bf16(v0[2], v0[3]); w.z = cvt_pk_bf16(v1[0], v1[1]); w.w = cvt_pk_bf16(v1[2], v1[3]);
                    *(u32x4*)(rowp + bj * HALF) = w; } }
    }
};
struct EpiResid {
    static constexpr bool PERM = false, AFTER_DRAIN = false;
    const float* base; float* out; bf16_t* xb; float* ssq; int ldc;
    __device__ __forceinline__ void operator()(const f32x4 (&acc)[2][2][4][2], const Unit& u, int wr, int wc, int fr, int fq) const {
        typedef unsigned u32x2v __attribute__((ext_vector_type(2)));
        const int col0 = u.pn * BM + wc * 32 + 4 * fq;
#pragma unroll
        for (int ai = 0; ai < 2; ++ai) {
            f32x4 bv[4][2][2];
#pragma unroll
            for (int m = 0; m < 4; ++m) { const size_t off = (size_t)(u.pm * BM + ai * HALF + wr * 64 + m * 16 + fr) * ldc + col0;
#pragma unroll
                for (int bj = 0; bj < 2; ++bj)
#pragma unroll
                    for (int n = 0; n < 2; ++n) bv[m][bj][n] = *(const f32x4*)(base + off + bj * HALF + n * 16); }
#pragma unroll
            for (int m = 0; m < 4; ++m) { const int row = u.pm * BM + ai * HALF + wr * 64 + m * 16 + fr; const size_t off = (size_t)row * ldc + col0; float s = 0.f;
#pragma unroll
                for (int bj = 0; bj < 2; ++bj)
#pragma unroll
                    for (int n = 0; n < 2; ++n) { const f32x4 v = acc[ai][bj][m][n] + bv[m][bj][n];
                        if (out) *(f32x4*)(out + off + bj * HALF + n * 16) = v; s += (v[0] * v[0] + v[1] * v[1]) + (v[2] * v[2] + v[3] * v[3]);
                        if (xb) { u32x2v w; w.x = cvt_pk_bf16(v[0], v[1]); w.y = cvt_pk_bf16(v[2], v[3]); *(u32x2v*)(xb + off + bj * HALF + n * 16) = w; } }
                if (ssq) { s += __shfl_xor(s, 16); s += __shfl_xor(s, 32); if (fq == 0) atomicAdd(ssq + row, s); } }
            asm volatile("" ::: "memory");
        }
    }
};

__device__ __forceinline__ float dpp_ror1(float v) { return __builtin_bit_cast(float, __builtin_amdgcn_mov_dpp(__builtin_bit_cast(int, v), 0x121, 0xf, 0xf, true)); }
__device__ __forceinline__ float dpp_ror2(float v) { return __builtin_bit_cast(float, __builtin_amdgcn_mov_dpp(__builtin_bit_cast(int, v), 0x122, 0xf, 0xf, true)); }
struct EpiConvGate {
    static constexpr bool PERM = true, AFTER_DRAIN = false;
    static constexpr size_t CG_SSQ = (1u << 20) + 768 * 1024, CG_ACT = (size_t)148 << 20, CG_YH = (size_t)236 << 20, CG_UPART = (size_t)240 << 20;
    unsigned char* ws; const float* fw; PG8_LAS unsigned char* ldsb;
    __device__ __forceinline__ void operator()(f32x4 (&acc)[2][2][4][2], const Unit& u, int wr, int wc, int fr0, int fq0) const {
        int fr = fr0, fq = fq0; asm volatile("" : "+v"(fr), "+v"(fq));
        bf16_t* ACT = (bf16_t*)(ws + CG_ACT); const float* ssq = (const float*)(ws + CG_SSQ); float* YH = (float*)(ws + CG_YH); float* UPART = (float*)(ws + CG_UPART);
        PG8_LAS float* halo = (PG8_LAS float*)(ldsb + STAGE_BYTES);
        int cl = wc * 32 + 8 * fq;
        int ch = u.pn * 128 + cl;
        if (fr >= 14) {
#pragma unroll
            for (int ai = 0; ai < 2; ++ai) { const float sc = rsqrtf(ssq[u.pm * BM + ai * HALF + wr * 64 + 48 + fr] * (1.0f / 1024.0f) + RMS_EPS);
#pragma unroll
                for (int bj = 0; bj < 2; ++bj)
#pragma unroll
                    for (int n = 0; n < 2; ++n) { const f32x4 v = acc[ai][bj][3][n] * sc; *(PG8_LAS f32x4*)(halo + (((wr * 2 + ai) * 2 + (fr - 14)) * 256 + bj * 128 + cl + 4 * n)) = v;
                        if (ai == 1 && wr == 1) *(f32x4*)(YH + ((size_t)(u.pm * 22 + u.pn) * 2 + (fr - 14)) * 256 + bj * 128 + cl + 4 * n) = v; } }
        }
        asm volatile("s_waitcnt lgkmcnt(0)" ::: "memory"); __builtin_amdgcn_s_barrier(); asm volatile("" ::: "memory");
        typedef unsigned u32x2v __attribute__((ext_vector_type(2)));
#pragma unroll 1
        for (int n = 0; n < 2; ++n) {
            asm volatile("" : "+v"(fr), "+v"(fq));
            cl = wc * 32 + 8 * fq; ch = u.pn * 128 + cl;
            f32x4 w[3][2];
#pragma unroll
            for (int i = 0; i < 3; ++i)
#pragma unroll
                for (int bj = 0; bj < 2; ++bj) w[i][bj] = *(const f32x4*)(fw + (size_t)i * 5632 + bj * 2816 + ch + 4 * n);
#pragma unroll
            for (int ai = 0; ai < 2; ++ai) {
                const bool top = (ai == 0 && wr == 0);
                const int pblk = (ai == 0) ? 0 : (wr == 0 ? 2 : 1);
                f32x4 q1[2], q2[2];
#pragma unroll
                for (int bj = 0; bj < 2; ++bj) { const f32x4 pv = top ? (f32x4){0.f, 0.f, 0.f, 0.f} : *(const PG8_LAS f32x4*)(halo + ((pblk * 2 + (fr & 1)) * 256 + bj * 128 + cl + 4 * n));
#pragma unroll
                    for (int k = 0; k < 4; ++k) { q1[bj][k] = dpp_ror1(pv[k]); q2[bj][k] = dpp_ror2(pv[k]); } }
#pragma unroll
                for (int m = 0; m < 4; ++m) {
                    const int row = u.pm * BM + ai * HALF + wr * 64 + m * 16 + fr; const float sc = rsqrtf(ssq[row] * (1.0f / 1024.0f) + RMS_EPS);
                    f32x4 cu[2];
#pragma unroll
                    for (int bj = 0; bj < 2; ++bj) { const f32x4 ya = acc[ai][bj][m][0];
#pragma unroll
                        for (int k = 0; k < 4; ++k) { const float y = ya[k] * sc;
                            const float a1 = dpp_ror1(y), a2 = dpp_ror2(y);
                            const float p1 = (fr == 0) ? q1[bj][k] : a1, p2 = (fr < 2) ? q2[bj][k] : a2;
                            cu[bj][k] = w[2][bj][k] * y + w[1][bj][k] * p1 + w[0][bj][k] * p2; q1[bj][k] = a1; q2[bj][k] = a2; } }
                    if (top && m == 0 && fr < 2 && (u.pm & 7) != 0) {
#pragma unroll
                        for (int bj = 0; bj < 2; ++bj) *(f32x4*)(UPART + ((size_t)(u.pm * 22 + u.pn) * 2 + fr) * 256 + bj * 128 + cl + 4 * n) = cu[bj];
                    }
                    u32x2v o;
#define PG8_SG(k_) (cu[0][k_] * __builtin_amdgcn_rcpf(1.0f + __expf(-cu[0][k_])) * cu[1][k_])
                    o.x = cvt_pk_bf16(PG8_SG(0), PG8_SG(1)); o.y = cvt_pk_bf16(PG8_SG(2), PG8_SG(3));
#undef PG8_SG
                    *(u32x2v*)(ACT + (size_t)row * 2816 + ch + 4 * n) = o;
                    asm volatile("" ::: "memory");
                }
            }
            if (n == 0) {
#pragma unroll
                for (int ai = 0; ai < 2; ++ai)
#pragma unroll
                    for (int bj = 0; bj < 2; ++bj)
#pragma unroll
                        for (int m = 0; m < 4; ++m) acc[ai][bj][m][0] = acc[ai][bj][m][1];
            }
        }
        asm volatile("s_waitcnt lgkmcnt(0)" ::: "memory"); __builtin_amdgcn_s_barrier(); asm volatile("" ::: "memory");
    }
};

struct EpiResidNorm {
    static constexpr bool PERM = false, AFTER_DRAIN = false;
    const bf16_t* base; float* out; float* ssq2; unsigned* cnt; const float* fnw; int ldc;
    __device__ __forceinline__ void operator()(f32x4 (&acc)[2][2][4][2], const Unit& u, int wr, int wc, int fr, int fq) const {
        typedef unsigned u32x2v __attribute__((ext_vector_type(2)));
        const int col0 = u.pn * BM + wc * 32 + 4 * fq;
#pragma unroll
        for (int ai = 0; ai < 2; ++ai) {
            u32x2v bv[4][2][2];
#pragma unroll
            for (int m = 0; m < 4; ++m) { const size_t off = (size_t)(u.pm * BM + ai * HALF + wr * 64 + m * 16 + fr) * ldc + col0;
#pragma unroll
                for (int bj = 0; bj < 2; ++bj)
#pragma unroll
                    for (int n = 0; n < 2; ++n) bv[m][bj][n] = *(const u32x2v*)(base + off + bj * HALF + n * 16); }
#pragma unroll
            for (int m = 0; m < 4; ++m) { const int row = u.pm * BM + ai * HALF + wr * 64 + m * 16 + fr; float s = 0.f;
#pragma unroll
                for (int bj = 0; bj < 2; ++bj)
#pragma unroll
                    for (int n = 0; n < 2; ++n) { const u32x2v bw = bv[m][bj][n]; const f32x4 v = acc[ai][bj][m][n] + (f32x4){__uint_as_float(bw.x << 16), __uint_as_float(bw.x & 0xffff0000u), __uint_as_float(bw.y << 16), __uint_as_float(bw.y & 0xffff0000u)}; acc[ai][bj][m][n] = v; s += (v[0] * v[0] + v[1] * v[1]) + (v[2] * v[2] + v[3] * v[3]); }
                s += __shfl_xor(s, 16); s += __shfl_xor(s, 32);
                if (fq == 0) (void)__hip_atomic_fetch_add(ssq2 + row, s, __ATOMIC_RELAXED, __HIP_MEMORY_SCOPE_AGENT); }
            asm volatile("" ::: "memory");
        }
        asm volatile("s_waitcnt vmcnt(0)" ::: "memory"); __builtin_amdgcn_s_barrier(); asm volatile("" ::: "memory");
        if (wr == 0 && wc == 0 && fr == 0 && fq == 0) {
            __builtin_amdgcn_fence(__ATOMIC_RELEASE, "agent"); asm volatile("s_waitcnt vmcnt(0)" ::: "memory");
            (void)__hip_atomic_fetch_add(cnt + 16 * u.pm, 1u, __ATOMIC_RELAXED, __HIP_MEMORY_SCOPE_AGENT);
            unsigned sp = 0;
            while (__hip_atomic_load(cnt + 16 * u.pm, __ATOMIC_RELAXED, __HIP_MEMORY_SCOPE_AGENT) < 4u) { __builtin_amdgcn_s_sleep(1); if (++sp > (1u << 22)) break; }
            __builtin_amdgcn_fence(__ATOMIC_ACQUIRE, "agent"); asm volatile("s_waitcnt vmcnt(0)" ::: "memory");
        }
        __builtin_amdgcn_s_barrier(); asm volatile("" ::: "memory");
        f32x4 nw[2][2];
#pragma unroll
        for (int bj = 0; bj < 2; ++bj)
#pragma unroll
            for (int n = 0; n < 2; ++n) nw[bj][n] = *(const f32x4*)(fnw + col0 + bj * HALF + n * 16);
#pragma unroll
        for (int ai = 0; ai < 2; ++ai)
#pragma unroll
            for (int m = 0; m < 4; ++m) { const int row = u.pm * BM + ai * HALF + wr * 64 + m * 16 + fr; const size_t off = (size_t)row * ldc + col0;
                const float rstd = rsqrtf(__hip_atomic_load(ssq2 + row, __ATOMIC_RELAXED, __HIP_MEMORY_SCOPE_AGENT) * (1.0f / 1024.0f) + RMS_EPS);
#pragma unroll
                for (int bj = 0; bj < 2; ++bj)
#pragma unroll
                    for (int n = 0; n < 2; ++n) { const f32x4 v = acc[ai][bj][m][n]; *(f32x4*)(out + off + bj * HALF + n * 16) = (f32x4){v[0] * rstd * nw[bj][n][0], v[1] * rstd * nw[bj][n][1], v[2] * rstd * nw[bj][n][2], v[3] * rstd * nw[bj][n][3]}; } }
    }
};
template <class Epi, class Sched, bool ALIGN_EPI = false, bool SP2 = false>
__device__ __forceinline__ void gemm_phase(PG8_LAS unsigned char* lds, const Gemm g, const Sched& S, const Epi& E) {
    const int tid = threadIdx.x, wid = __builtin_amdgcn_readfirstlane(tid >> 6), lane = tid & 63, wr = wid >> 2, wc = wid & 3, fr = lane & 15, fq = lane >> 4;
    const int K = g.K, nt = K / BK;
    unsigned voffA[2], voffB[2];
#pragma unroll
    for (int i = 0; i < 2; ++i) { int R, C; stage_rc(tid * 16 + i * 8192, R, C); const int Rb = Epi::PERM ? ((R & ~31) + perm32(R & 31)) : R;
        voffA[i] = (unsigned)(R * K + C) * 2u; voffB[i] = (unsigned)(Rb * K + C) * 2u; }
    const size_t kstep = (size_t)(BK * 2);
    const size_t hstep = (size_t)HALF * K * 2;
    const size_t tstep = 2 * hstep;
    const unsigned ldsw = (unsigned)wid * 1024u;
    const int aoff = lds_byte(wr * 64 + fr, fq * 8), boff = lds_byte(wc * 32 + fr, fq * 8);
#define PG8_SA(b, h) (((b) * 2 + (h)) * HTB)
#define PG8_SB(b, h) ((4 + (b) * 2 + (h)) * HTB)
#define PG8_STAGE(bufoff, gbase, voff) do { _Pragma("unroll") for (int _i = 0; _i < 2; ++_i) \
        __builtin_amdgcn_global_load_lds((const unsigned*)((const char*)(gbase) + (voff)[_i]), (PG8_LAS unsigned*)(lds + (bufoff) + ldsw + _i * 8192), 16, 0, 0); } while (0)
#define PG8_LDA(dst, b, h) do { _Pragma("unroll") for (int m = 0; m < 4; ++m) _Pragma("unroll") for (int k = 0; k < 2; ++k) dst[m][k] = *(const PG8_LAS bf16x8*)(lds + PG8_SA(b, h) + aoff + m * 2048 + k * 1024); } while (0)
#define PG8_LDB(dst, b, h) do { _Pragma("unroll") for (int n = 0; n < 2; ++n) _Pragma("unroll") for (int k = 0; k < 2; ++k) dst[n][k] = *(const PG8_LAS bf16x8*)(lds + PG8_SB(b, h) + boff + n * 2048 + k * 1024); } while (0)
#define PG8_MMA(ai, bj, At, Bt) do { __builtin_amdgcn_s_setprio(1); _Pragma("unroll") for (int m = 0; m < 4; ++m) _Pragma("unroll") for (int n = 0; n < 2; ++n) _Pragma("unroll") for (int k = 0; k < 2; ++k) \
        acc[ai][bj][m][n] = __builtin_amdgcn_mfma_f32_16x16x32_bf16(Bt[n][k], At[m][k], acc[ai][bj][m][n], 0, 0, 0); __builtin_amdgcn_s_setprio(0); } while (0)
#define PG8_WAIT_V(n) asm volatile("s_waitcnt vmcnt(" #n ")" ::: "memory")
#define PG8_WAIT_L(n) asm volatile("s_waitcnt lgkmcnt(" #n ")" ::: "memory")
#define PG8_BAR __builtin_amdgcn_s_barrier()
#define PG8_SCHED __builtin_amdgcn_sched_barrier(0)
    Unit cur, nxt; int ui = 0;
    if (!S.next(0, cur)) return;
    f32x4 acc[2][2][4][2];
#pragma unroll
    for (int a = 0; a < 2; ++a)
#pragma unroll
        for (int b = 0; b < 2; ++b)
#pragma unroll
            for (int m = 0; m < 4; ++m)
#pragma unroll
                for (int n = 0; n < 2; ++n) acc[a][b][m][n] = (f32x4){0.f, 0.f, 0.f, 0.f};
    bf16x8 At[4][2], B0[2][2], B1[2][2];
    const char* cA = (const char*)g.A + (size_t)cur.pm * tstep; const char* cB = (const char*)g.Bt + (size_t)cur.pn * tstep;
    S.a_ready(cur);
    if constexpr (SP2) {
        PG8_STAGE(PG8_SB(0, 0), cB, voffB); PG8_STAGE(PG8_SB(0, 1), cB + hstep, voffB); PG8_STAGE(PG8_SA(0, 0), cA, voffA); PG8_STAGE(PG8_SA(0, 1), cA + hstep, voffA);
        if (wr == 1) PG8_BAR;
        PG8_WAIT_V(2); PG8_BAR;
        PG8_STAGE(PG8_SB(1, 0), cB + kstep, voffB); PG8_STAGE(PG8_SA(1, 0), cA + kstep, voffA); PG8_STAGE(PG8_SB(1, 1), cB + hstep + kstep, voffB);
        PG8_WAIT_V(6); PG8_BAR;
    } else {
        PG8_STAGE(PG8_SB(0, 0), cB, voffB); PG8_STAGE(PG8_SA(0, 0), cA, voffA); PG8_STAGE(PG8_SB(0, 1), cB + hstep, voffB); PG8_STAGE(PG8_SA(0, 1), cA + hstep, voffA);
        if (wr == 1) PG8_BAR;
        PG8_WAIT_V(4); PG8_BAR;
        PG8_STAGE(PG8_SB(1, 0), cB + kstep, voffB); PG8_STAGE(PG8_SA(1, 0), cA + kstep, voffA); PG8_STAGE(PG8_SB(1, 1), cB + hstep + kstep, voffB);
        PG8_WAIT_V(6); PG8_BAR;
    }
    for (;;) {
        const bool has_next = S.next(ui + 1, nxt);
        const char* nA = has_next ? (const char*)g.A + (size_t)nxt.pm * tstep : cA; const char* nB = has_next ? (const char*)g.Bt + (size_t)nxt.pn * tstep : cB;
        for (int t = 0; t < nt; t += 2) {
            const bool last = (t == nt - 2);
            const char* a1 = cA + (size_t)(t + 1) * kstep;
            const char* a2 = last ? nA : cA + (size_t)(t + 2) * kstep; const char* b2 = last ? nB : cB + (size_t)(t + 2) * kstep;
            const char* a3 = a2 + kstep; const char* b3 = b2 + kstep;
            if (last && has_next) S.a_ready(nxt);
            if constexpr (SP2) {
            PG8_LDB(B0, 0, 0); PG8_LDB(B1, 0, 1); PG8_SCHED; PG8_LDA(At, 0, 0); PG8_STAGE(PG8_SA(1, 1), a1 + hstep, voffA);
            PG8_WAIT_V(8); PG8_WAIT_L(0); PG8_BAR; PG8_MMA(0, 0, At, B0); PG8_MMA(0, 1, At, B1); PG8_BAR; PG8_SCHED;
            PG8_LDA(At, 0, 1); PG8_STAGE(PG8_SB(0, 0), b2, voffB); PG8_STAGE(PG8_SB(0, 1), b2 + hstep, voffB); PG8_STAGE(PG8_SA(0, 0), a2, voffA);
            PG8_WAIT_V(8); PG8_WAIT_L(0); PG8_BAR; PG8_MMA(1, 0, At, B0); PG8_MMA(1, 1, At, B1); PG8_BAR; PG8_SCHED;
            PG8_LDB(B0, 1, 0); PG8_LDB(B1, 1, 1); PG8_SCHED; PG8_LDA(At, 1, 0); PG8_STAGE(PG8_SA(0, 1), a2 + hstep, voffA);
            PG8_WAIT_V(8); PG8_WAIT_L(0); PG8_BAR; PG8_MMA(0, 0, At, B0); PG8_MMA(0, 1, At, B1); PG8_BAR; PG8_SCHED;
            PG8_LDA(At, 1, 1); PG8_STAGE(PG8_SB(1, 0), b3, voffB); PG8_STAGE(PG8_SB(1, 1), b3 + hstep, voffB); PG8_STAGE(PG8_SA(1, 0), a3, voffA);
            PG8_WAIT_V(8); PG8_WAIT_L(0); PG8_BAR; PG8_MMA(1, 0, At, B0); PG8_MMA(1, 1, At, B1); PG8_BAR; PG8_SCHED;
            } else {
            PG8_LDB(B0, 0, 0); PG8_SCHED; PG8_LDA(At, 0, 0); PG8_STAGE(PG8_SA(1, 1), a1 + hstep, voffA);
            PG8_WAIT_L(8); PG8_BAR; PG8_WAIT_L(0); PG8_MMA(0, 0, At, B0); PG8_BAR; PG8_SCHED;
            PG8_LDB(B1, 0, 1); PG8_STAGE(PG8_SB(0, 0), b2, voffB);
            PG8_BAR; PG8_WAIT_L(0); PG8_MMA(0, 1, At, B1); PG8_BAR;
            PG8_LDA(At, 0, 1); PG8_STAGE(PG8_SA(0, 0), a2, voffA);
            PG8_BAR; PG8_WAIT_L(0); PG8_MMA(1, 0, At, B0); PG8_BAR; PG8_SCHED;
            PG8_STAGE(PG8_SB(0, 1), b2 + hstep, voffB);
            PG8_WAIT_V(6); PG8_BAR; PG8_MMA(1, 1, At, B1); PG8_BAR;
            PG8_LDB(B0, 1, 0); PG8_SCHED; PG8_LDA(At, 1, 0); PG8_STAGE(PG8_SA(0, 1), a2 + hstep, voffA);
            PG8_WAIT_L(8); PG8_BAR; PG8_WAIT_L(0); PG8_MMA(0, 0, At, B0); PG8_BAR; PG8_SCHED;
            PG8_LDB(B1, 1, 1); PG8_STAGE(PG8_SB(1, 0), b3, voffB);
            PG8_BAR; PG8_WAIT_L(0); PG8_MMA(0, 1, At, B1); PG8_BAR;
            PG8_LDA(At, 1, 1); PG8_STAGE(PG8_SA(1, 0), a3, voffA);
            PG8_BAR; PG8_WAIT_L(0); PG8_MMA(1, 0, At, B0); PG8_BAR; PG8_SCHED;
            PG8_STAGE(PG8_SB(1, 1), b3 + hstep, voffB);
            PG8_WAIT_V(6); PG8_BAR; PG8_MMA(1, 1, At, B1); PG8_BAR;
            }
        }
        if constexpr (ALIGN_EPI) { if (wr == 0) PG8_BAR; }
        if constexpr (!Epi::AFTER_DRAIN) { E(acc, cur, wr, wc, fr, fq); S.done(cur); }
        if (!has_next) break;
#pragma unroll
        for (int a = 0; a < 2; ++a)
#pragma unroll
            for (int b = 0; b < 2; ++b)
#pragma unroll
                for (int m = 0; m < 4; ++m)
#pragma unroll
                    for (int n = 0; n < 2; ++n) acc[a][b][m][n] = (f32x4){0.f, 0.f, 0.f, 0.f};
        cur = nxt; cA = nA; cB = nB; ++ui;
        if constexpr (ALIGN_EPI) { if (wr == 1) PG8_BAR; }
    }
    PG8_WAIT_V(0);
    if constexpr (!ALIGN_EPI) { if (wr == 0) PG8_BAR; }
    PG8_BAR;
    if constexpr (Epi::AFTER_DRAIN) { E.fused(acc, cur, wr, wc, fr, fq, lds, wid, lane); S.done(cur); }
#undef PG8_SA
#undef PG8_SB
#undef PG8_STAGE
#undef PG8_LDA
#undef PG8_LDB
#undef PG8_MMA
#undef PG8_WAIT_V
#undef PG8_WAIT_L
#undef PG8_BAR
#undef PG8_SCHED
}
}
#ifndef PG8_SP2
#define PG8_SP2 true
#endif
#ifndef PG8_ALIGN
#define PG8_ALIGN true
#endif
constexpr int NB = 8, SEQ = 2048, DM = 1024, M = NB * SEQ;
constexpr int GH = 4, GD = 128, GW = 512, AH = 8, AD = 64;
constexpr int INC = 3592, NP = 3584;
constexpr int DFF = 2816, NUP = 2 * DFF;
constexpr int PC_QA = 0, PC_KA = 512, PC_VA = 1024, PC_Z = 1536, PC_QB = 2048, PC_KB = 2560, PC_VB = 3072;
constexpr size_t MiB = 1u << 20;
constexpr size_t WS_CTL = 0, WS_AB = 1 * MiB, WS_SSQ = 1 * MiB + 768 * 1024, WS_WIN = 2 * MiB, WS_WOUT = 9 * MiB, WS_WUP = 11 * MiB, WS_WDN = 22 * MiB;
constexpr size_t WS_XN = 28 * MiB, WS_PROJ = 60 * MiB, WS_CAT = 172 * MiB, WS_OA = 204 * MiB, WS_Y = 60 * MiB, WS_ACT = 148 * MiB, WS_END = 256 * MiB;
using pg8::RMS_EPS;
constexpr size_t WS_YH = 236 * MiB, WS_UPART = 240 * MiB;
constexpr size_t WS_SSQ2 = WS_SSQ + 131072;
constexpr size_t WS_GE = WS_SSQ + 65536;
constexpr int GOPS_CHUNK = 57344;
constexpr int SCAN_BUF = GOPS_CHUNK + 16384;
constexpr int NWAVES = 8, NTHR = 512;
constexpr int LDS_BYTES = 155648;
#define LAS __attribute__((address_space(3)))
typedef unsigned short bf16;
typedef unsigned v4u __attribute__((ext_vector_type(4)));
typedef unsigned v2u __attribute__((ext_vector_type(2)));
typedef float f32x4 __attribute__((ext_vector_type(4)));
__device__ __forceinline__ float bf2f(unsigned b) { return __uint_as_float(b << 16); }
__device__ __forceinline__ float bflo(unsigned w) { return __uint_as_float(w << 16); }
__device__ __forceinline__ float bfhi(unsigned w) { return __uint_as_float(w & 0xffff0000u); }
__device__ __forceinline__ unsigned pk2(float lo, float hi) { return pg8::cvt_pk_bf16(lo, hi); }
__device__ __forceinline__ float wave_sum(float v) {
#pragma unroll
    for (int o = 1; o < 64; o <<= 1) v += __shfl_xor(v, o);
    return v;
}
__device__ __forceinline__ float silu_f(float x) { return x * __builtin_amdgcn_rcpf(1.0f + __expf(-x)); }
__device__ __forceinline__ float sigmoid_f(float x) { return __builtin_amdgcn_rcpf(1.0f + __expf(-x)); }
__device__ __forceinline__ float softplus_f(float x) { return x > 20.f ? x : log1pf(__expf(x)); }

struct Args { const float* in[13]; float* out; unsigned char* ws; int ph_lo, ph_hi, coop, pad; };

__device__ __forceinline__ void p0_transpose_item(const float* W, int ldw, int k0, int sn0, bf16* WT, int K, int dn0, const float* kscale, LAS float* scr, int lane) {
    float tv[32];
#pragma unroll
    for (int i = 0; i < 32; ++i) { const int kk = 2 * i + (lane >> 5); tv[i] = W[(size_t)(k0 + kk) * ldw + sn0 + (lane & 31)]; }
    if (kscale) {
#pragma unroll
        for (int i = 0; i < 32; ++i) tv[i] *= kscale[k0 + 2 * i + (lane >> 5)]; }
#pragma unroll
    for (int i = 0; i < 32; ++i) scr[(2 * i + (lane >> 5)) * 33 + (lane & 31)] = tv[i];
    asm volatile("s_waitcnt lgkmcnt(0)" ::: "memory");
    const int c = lane & 7;
#pragma unroll
    for (int j = 0; j < 4; ++j) { const int n = (lane >> 3) + 8 * j; const LAS float* s = scr + (8 * c) * 33 + n;
        v4u o; o.x = pk2(s[0 * 33], s[1 * 33]); o.y = pk2(s[2 * 33], s[3 * 33]); o.z = pk2(s[4 * 33], s[5 * 33]); o.w = pk2(s[6 * 33], s[7 * 33]);
        *(v4u*)(WT + (size_t)(dn0 + n) * K + k0 + 8 * c) = o; }
    asm volatile("s_waitcnt lgkmcnt(0)" ::: "memory");
}

__device__ __forceinline__ void p0_prologue(const Args& A, LAS unsigned char* lds, int tid, int lane, int wave) {
    const float* x = A.in[0]; const float* nw1 = A.in[1]; const float* w_in = A.in[2]; const float* w_out = A.in[7]; const float* nw2 = A.in[8];
    const float* w_up = A.in[9]; const float* w_dn = A.in[11];
    unsigned char* ws = A.ws;
    bf16* WIN = (bf16*)(ws + WS_WIN); bf16* WOUT = (bf16*)(ws + WS_WOUT); bf16* WUP = (bf16*)(ws + WS_WUP); bf16* WDN = (bf16*)(ws + WS_WDN);
    bf16* XN = (bf16*)(ws + WS_XN); float* AB = (float*)(ws + WS_AB); float* SSQ = (float*)(ws + WS_SSQ);
    LAS float* scr = (LAS float*)(lds + wave * 9216);
    LAS float* wab = (LAS float*)(lds + 73728);
    const int G = gridDim.x, gw = blockIdx.x * NWAVES + wave, NGW = G * NWAVES;
    for (int i = blockIdx.x * NTHR + tid; i < M; i += G * NTHR) { SSQ[i] = 0.f; ((float*)(ws + WS_SSQ2))[i] = 0.f; }
    if (blockIdx.x == 0 && tid < 64) ((unsigned*)(ws + WS_CTL))[tid] = 0u;
    for (int idx = tid; idx < 8192; idx += NTHR) { const int k = idx >> 3, j = idx & 7; wab[j * 1024 + k] = nw1[k] * w_in[(size_t)k * INC + 2048 + j]; }
    constexpr int I_IN = 16 * (NP / 32);
    for (int it = gw; it < I_IN; it += NGW) { const int nblk = NP / 32, kb = it / nblk, nb = it % nblk, n0 = 32 * nb; p0_transpose_item(w_in, INC, 64 * kb, n0 + (n0 >= 2048 ? 8 : 0), WIN, DM, n0, nullptr, scr, lane); }
    __syncthreads();
    for (int m0 = gw; m0 < M; m0 += 2 * NGW) {
        const f32x4* nr = (const f32x4*)nw1 + lane;
        f32x4 v[2][4]; float s[2] = {0.f, 0.f};
#pragma unroll
        for (int rr = 0; rr < 2; ++rr) { const int m = min(m0 + rr * NGW, M - 1); const f32x4* xr = (const f32x4*)(x + (size_t)m * DM) + lane;
#pragma unroll
            for (int j = 0; j < 4; ++j) v[rr][j] = xr[64 * j]; }
#pragma unroll
        for (int rr = 0; rr < 2; ++rr)
#pragma unroll
            for (int j = 0; j < 4; ++j) s[rr] += (v[rr][j].x * v[rr][j].x + v[rr][j].y * v[rr][j].y) + (v[rr][j].z * v[rr][j].z + v[rr][j].w * v[rr][j].w);
#pragma unroll
        for (int rr = 0; rr < 2; ++rr) { const int m = m0 + rr * NGW; if (m >= M) break;
            const float rstd = rsqrtf(wave_sum(s[rr]) * (1.f / DM) + RMS_EPS);
            float ab[8];
#pragma unroll
            for (int q = 0; q < 8; ++q) { float a = 0.f;
#pragma unroll
                for (int j = 0; j < 4; ++j) { const f32x4 w = *(const LAS f32x4*)(wab + q * 1024 + 256 * j + 4 * lane); a += (v[rr][j].x * w.x + v[rr][j].y * w.y) + (v[rr][j].z * w.z + v[rr][j].w * w.w); }
                ab[q] = wave_sum(a) * rstd; }
            if (lane == 0) { *(f32x4*)(AB + (size_t)m * 8) = (f32x4){ab[0], ab[1], ab[2], ab[3]}; *(f32x4*)(AB + (size_t)m * 8 + 4) = (f32x4){ab[4], ab[5], ab[6], ab[7]}; }
            v2u* o8 = (v2u*)(XN + (size_t)m * DM) + lane;
#pragma unroll
            for (int j = 0; j < 4; ++j) { const f32x4 n = nr[64 * j]; v2u o; o.x = pk2(v[rr][j].x * rstd * n.x, v[rr][j].y * rstd * n.y); o.y = pk2(v[rr][j].z * rstd * n.z, v[rr][j].w * rstd * n.w); o8[64 * j] = o; }
        }
    }
}


__device__ __forceinline__ void convert_late_weights(const Args& A, LAS unsigned char* lds, int lane, int wave, int gw0, int ngw) {
    const float* w_out = A.in[7]; const float* nw2 = A.in[8]; const float* w_up = A.in[9]; const float* w_dn = A.in[11];
    bf16* WOUT = (bf16*)(A.ws + WS_WOUT); bf16* WUP = (bf16*)(A.ws + WS_WUP); bf16* WDN = (bf16*)(A.ws + WS_WDN);
    LAS float* scr = (LAS float*)(lds + wave * 9216);
    constexpr int I_OUT = 16 * 32, I_UP = 16 * (NUP / 32), I_DN = (DFF / 64) * 32;
    for (int it = gw0; it < I_OUT + I_UP + I_DN; it += ngw) {
        int r = it;
        if (r < I_OUT) { const int kb = r / 32, nb = r % 32; p0_transpose_item(w_out, DM, 64 * kb, 32 * nb, WOUT, DM, 32 * nb, nullptr, scr, lane); continue; } r -= I_OUT;
        if (r < I_UP) { const int nblk = NUP / 32, kb = r / nblk, nb = r % nblk, n0 = 32 * nb, pn = n0 >> 8, j0 = n0 & 255;
            const int s0 = (j0 < 128) ? (128 * pn + j0) : (DFF + 128 * pn + j0 - 128);
            p0_transpose_item(w_up, NUP, 64 * kb, s0, WUP, DM, n0, nw2, scr, lane); continue; } r -= I_UP;
        { const int kb = r / 32, nb = r % 32; p0_transpose_item(w_dn, DM, 64 * kb, 32 * nb, WDN, DFF, 32 * nb, nullptr, scr, lane); }
    }
}
__device__ __forceinline__ void gdn_simple(const Args& A, LAS unsigned char* lds, int tid, int lane, int wave) {
    const bf16* PROJ = (const bf16*)(A.ws + WS_PROJ); const float* AB = (const float*)(A.ws + WS_AB); float* OA = (float*)(A.ws + WS_OA);
    const float* cw = A.in[3]; const float* a_log = A.in[4]; const float* dt_bias = A.in[5];
    LAS float* qs = (LAS float*)lds; LAS float* ks = qs + 16 * 128; LAS float* vs = ks + 16 * 128; LAS float* av = vs + 16 * 128; LAS float* bv = av + 16;
    for (int task = blockIdx.x; task < NB * GH; task += gridDim.x) {
        const int b = task / GH, h = task % GH, v = tid >> 2, part = tid & 3;
        float S[32];
#pragma unroll
        for (int i = 0; i < 32; ++i) S[i] = 0.f;
        const float Ah = __expf(a_log[h]), dtb = dt_bias[h];
        for (int blk = 0; blk < SEQ / 16; ++blk) {
            const int t0 = blk * 16;
            for (int idx = tid; idx < 16 * 384; idx += NTHR) {
                const int tt = idx / 384, c = idx % 384, which = c >> 7, d = c & 127, col = which * 512 + h * 128 + d, t = t0 + tt;
                float acc = 0.f;
#pragma unroll
                for (int i = 0; i < 4; ++i) { const int ts = t - 3 + i; if (ts >= 0) acc += cw[i * 1536 + col] * bf2f(PROJ[(size_t)(b * SEQ + ts) * NP + col]); }
                qs[which * 2048 + tt * 128 + d] = silu_f(acc);
            }
            if (tid < 16) { const size_t row = (size_t)b * SEQ + t0 + tid; bv[tid] = sigmoid_f(AB[row * 8 + h]); av[tid] = __expf(-Ah * softplus_f(AB[row * 8 + 4 + h] + dtb)); }
            __syncthreads();
#pragma unroll
            for (int r = 0; r < 4; ++r) { const int row = 4 * wave + r; LAS float* arr = qs + row * 128;
                const float v0 = arr[lane], v1 = arr[lane + 64]; const float s = wave_sum(v0 * v0 + v1 * v1);
                const float sc = rsqrtf(s + RMS_EPS) * (row < 16 ? 0.08838834764831845f : 1.0f); arr[lane] = v0 * sc; arr[lane + 64] = v1 * sc; }
            __syncthreads();
            for (int tt = 0; tt < 16; ++tt) {
                const float a = av[tt], bt = bv[tt], vt = vs[tt * 128 + v];
                float kS = 0.f;
#pragma unroll
                for (int i = 0; i < 32; ++i) kS += ks[tt * 128 + 32 * part + i] * S[i];
                kS += __shfl_xor(kS, 1); kS += __shfl_xor(kS, 2);
                const float c = bt * (vt - a * kS); float o = 0.f;
#pragma unroll
                for (int i = 0; i < 32; ++i) { S[i] = a * S[i] + ks[tt * 128 + 32 * part + i] * c; o += qs[tt * 128 + 32 * part + i] * S[i]; }
                o += __shfl_xor(o, 1); o += __shfl_xor(o, 2);
                if (part == 0) OA[(size_t)(b * SEQ + t0 + tt) * GW + h * 128 + v] = o;
            }
            __syncthreads();
        }
    }
}


template <int J, int K, int N> struct SolveLd {
    static __device__ __forceinline__ void run(f32x4 (&l)[4], unsigned lbase) {
        if constexpr (K < N) { constexpr int t40 = ((J + 1) >> 2) << 2;
            asm volatile("ds_read_b128 %0, %1 offset:%2" : "=v"(l[K]) : "v"(lbase), "i"((J * 68 + t40 + 4 * K) * 4)); SolveLd<J, K + 1, N>::run(l, lbase); }
    }
};
template <int J> struct SolveCol16 {
    static __device__ __forceinline__ void run(float (&R)[16], unsigned lbase) {
        if constexpr (J < 15) {
            constexpr int t40 = ((J + 1) >> 2) << 2, nld = (16 - t40) >> 2;
            f32x4 l[4];
            SolveLd<J, 0, nld>::run(l, lbase);
            asm volatile("s_waitcnt lgkmcnt(0)" ::: "memory");
#pragma unroll
            for (int k = 0; k < nld; ++k) asm volatile("" : "+v"(l[k]));
#pragma unroll
            for (int k = 0; k < nld; ++k) {
#pragma unroll
                for (int e = 0; e < 4; ++e) if (t40 + 4 * k + e > J) R[t40 + 4 * k + e] += l[k][e] * R[J]; }
            SolveCol16<J + 1>::run(R, lbase);
        }
    }
};

typedef short bf16x8 __attribute__((ext_vector_type(8)));
__device__ __forceinline__ void gdn_prep(const Args& A, LAS unsigned char* lds, int tid0, int lane0, int wave) {
    const bf16* PROJ = (const bf16*)(A.ws + WS_PROJ); const float* AB = (const float*)(A.ws + WS_AB);
    const float* cw = A.in[3]; const float* a_log = A.in[4]; const float* dt_bias = A.in[5];
    unsigned char* UVF = A.ws + WS_XN; unsigned char* GOPS = (unsigned char*)A.out; float* GE = (float*)(A.ws + WS_GE);
    LAS float* Qs = (LAS float*)lds; LAS float* Ks = (LAS float*)(lds + 33792); LAS float* Vs = (LAS float*)(lds + 67584);
    LAS bf16* Qb = (LAS bf16*)(lds + 101376); LAS bf16* Kb = (LAS bf16*)(lds + 118784);
    LAS float* gcs = (LAS float*)(lds + 136192); LAS float* bts = gcs + 64; LAS float* egs = gcs + 128; LAS float* kes = gcs + 192;
    LAS float* LsT = (LAS float*)lds; LAS bf16* ATs = (LAS bf16*)(lds + 17408); LAS bf16* WKs = Kb;
    v4u rwn[11];
    if (tid0 < 384 && (int)blockIdx.x < NB * GH * 32) { const int c8 = tid0 % 48, run = tid0 / 48, which = c8 >> 4, d0 = (c8 & 15) * 8, t1 = blockIdx.x, bh1 = t1 >> 5, n1 = t1 & 31, b1 = bh1 >> 2, h1 = bh1 & 3, col1 = which * 512 + h1 * 128 + d0;
#pragma unroll
        for (int r = 0; r < 11; ++r) { const int ts = 64 * n1 + 8 * run - 3 + r; rwn[r] = (ts >= 0) ? *(const v4u*)(PROJ + (size_t)(b1 * SEQ + ts) * NP + col1) : (v4u){0u, 0u, 0u, 0u}; } }
    else {
#pragma unroll
        for (int r = 0; r < 11; ++r) rwn[r] = (v4u){0u, 0u, 0u, 0u}; }
#pragma unroll 1
    for (int task = blockIdx.x; task < NB * GH * 32; task += gridDim.x) {
        int tid = tid0, lane = lane0; asm volatile("" : "+v"(tid), "+v"(lane));
        const int fr = lane & 15, fq = lane >> 4;
        const int bh = task >> 5, n = task & 31, b = bh >> 2, h = bh & 3, t0 = 64 * n, row0 = b * SEQ + t0;
        unsigned char* gops = GOPS + (size_t)task * GOPS_CHUNK;
        if (tid < 384) {
            const int c8 = tid % 48, run = tid / 48, which = c8 >> 4, d0 = (c8 & 15) * 8, col = which * 512 + h * 128 + d0;
            v4u rw[11];
#pragma unroll
            for (int r = 0; r < 11; ++r) rw[r] = rwn[r];
            { const int tn = task + gridDim.x;
              if (tn < NB * GH * 32) { const int bhn = tn >> 5, nn = tn & 31, bn = bhn >> 2, hn = bhn & 3, coln = which * 512 + hn * 128 + d0;
#pragma unroll
                for (int r = 0; r < 11; ++r) { const int ts = 64 * nn + 8 * run - 3 + r; rwn[r] = (ts >= 0) ? *(const v4u*)(PROJ + (size_t)(bn * SEQ + ts) * NP + coln) : (v4u){0u, 0u, 0u, 0u}; } } }
            f32x4 cwa[4], cwb[4];
#pragma unroll
            for (int j = 0; j < 4; ++j) { cwa[j] = *(const f32x4*)(cw + j * 1536 + col); cwb[j] = *(const f32x4*)(cw + j * 1536 + col + 4); }
#pragma unroll
            for (int i = 0; i < 8; ++i) {
                float acc[8];
#pragma unroll
                for (int e2 = 0; e2 < 8; ++e2) acc[e2] = 0.f;
#pragma unroll
                for (int j = 0; j < 4; ++j) { const v4u w = rw[i + j];
                    acc[0] += cwa[j].x * bflo(w.x); acc[1] += cwa[j].y * bfhi(w.x); acc[2] += cwa[j].z * bflo(w.y); acc[3] += cwa[j].w * bfhi(w.y);
                    acc[4] += cwb[j].x * bflo(w.z); acc[5] += cwb[j].y * bfhi(w.z); acc[6] += cwb[j].z * bflo(w.w); acc[7] += cwb[j].w * bfhi(w.w); }
                float ss = 0.f;
#pragma unroll
                for (int e2 = 0; e2 < 8; ++e2) { acc[e2] = silu_f(acc[e2]); ss += acc[e2] * acc[e2]; }
                ss += __builtin_bit_cast(float, __builtin_amdgcn_update_dpp(0, __builtin_bit_cast(int, ss), 0xB1, 0xf, 0xf, false));
                ss += __builtin_bit_cast(float, __builtin_amdgcn_update_dpp(0, __builtin_bit_cast(int, ss), 0x4E, 0xf, 0xf, false));
                ss += __builtin_bit_cast(float, __builtin_amdgcn_update_dpp(0, __builtin_bit_cast(int, ss), 0x141, 0xf, 0xf, false));
                ss += __builtin_bit_cast(float, __builtin_amdgcn_update_dpp(0, __builtin_bit_cast(int, ss), 0x140, 0xf, 0xf, false));
                const int tt = 8 * run + i;
                if (which == 2) { *(LAS f32x4*)(Vs + tt * 132 + d0) = (f32x4){acc[0], acc[1], acc[2], acc[3]}; *(LAS f32x4*)(Vs + tt * 132 + d0 + 4) = (f32x4){acc[4], acc[5], acc[6], acc[7]}; }
                else {
                    const float sc = rsqrtf(ss + RMS_EPS) * (which == 0 ? 0.08838834764831845f : 1.0f);
#pragma unroll
                    for (int e2 = 0; e2 < 8; ++e2) acc[e2] *= sc;
                    const v4u pk = (v4u){pk2(acc[0], acc[1]), pk2(acc[2], acc[3]), pk2(acc[4], acc[5]), pk2(acc[6], acc[7])};
                    if (which == 0) *(LAS v4u*)(Qb + tt * 136 + d0) = pk;
                    else { *(LAS v4u*)(Kb + tt * 136 + d0) = pk; *(LAS f32x4*)(Ks + tt * 132 + d0) = (f32x4){acc[0], acc[1], acc[2], acc[3]}; *(LAS f32x4*)(Ks + tt * 132 + d0 + 4) = (f32x4){acc[4], acc[5], acc[6], acc[7]}; }
                }
            }
        }
        if (wave == 0) {
            const size_t row = (size_t)row0 + lane; const float beta = sigmoid_f(AB[row * 8 + h]);
            float g = -__expf(a_log[h]) * softplus_f(AB[row * 8 + 4 + h] + dt_bias[h]);
#pragma unroll
            for (int o = 1; o < 64; o <<= 1) { const float t = __shfl_up(g, o); if (lane >= o) g += t; }
            const float glast = __shfl(g, 63);
            gcs[lane] = g; bts[lane] = beta; egs[lane] = __expf(g); kes[lane] = __expf(glast - g) * beta;
            if (lane == 63) GE[task] = __expf(g);
        }
        __syncthreads();
#pragma unroll 1
        for (int jb = wave; jb < 20; jb += 8) {
            const int kind = jb >= 10 ? 1 : 0, idx = jb - 10 * kind, ti = idx < 1 ? 0 : (idx < 3 ? 1 : (idx < 6 ? 2 : 3)), tj = idx - ti * (ti + 1) / 2;
            const LAS bf16* As = kind ? Qb : Kb; f32x4 d = (f32x4){0.f, 0.f, 0.f, 0.f};
#pragma unroll
            for (int ks = 0; ks < 4; ++ks) { const bf16x8 a = *(const LAS bf16x8*)(As + (16 * ti + fr) * 136 + 32 * ks + 8 * fq), bb = *(const LAS bf16x8*)(Kb + (16 * tj + fr) * 136 + 32 * ks + 8 * fq);
                d = __builtin_amdgcn_mfma_f32_16x16x32_bf16(a, bb, d, 0, 0, 0); }
            const int j = 16 * tj + fr; const float gj = gcs[j], bj = bts[j]; float val[4];
#pragma unroll
            for (int e = 0; e < 4; ++e) { const int t = 16 * ti + 4 * fq + e; const float x = d[e] * __expf(gcs[t] - gj) * bj; val[e] = (kind ? (t >= j) : (t > j)) ? x : 0.f; }
            if (kind == 0) *(LAS f32x4*)(LsT + j * 68 + 16 * ti + 4 * fq) = (f32x4){-val[0], -val[1], -val[2], -val[3]};
            else {
#pragma unroll
                for (int e = 0; e < 4; ++e) ATs[(16 * ti + 4 * fq + e) * 72 + j] = (bf16)(pk2(val[e], 0.f) & 0xffffu); }
        }
        __syncthreads();
        LAS float* Ti = (LAS float*)(lds + 26624);
        if (wave == 0) {
            const int I = lane >> 4, c = lane & 15; float x[16];
#pragma unroll
            for (int r = 0; r < 16; ++r) x[r] = (r == c) ? 1.0f : 0.0f;
            SolveCol16<0>::run(x, (unsigned)(uintptr_t)LsT + (unsigned)(I * (16 * 68 + 16) * 4));
#pragma unroll
            for (int r = 0; r < 16; ++r) Ti[(I * 16 + r) * 20 + c] = x[r];
        } else {
            const int rt = tid - 64;
            for (int q = rt; q < 1024; q += 448) { const int blk = q >> 6, l2 = q & 63, i = l2 & 15, f = l2 >> 4, mb = blk >> 2, ks = blk & 3, t = 16 * mb + i;
                const v2u p0 = *(const LAS v2u*)(Qb + t * 136 + 32 * ks + 4 * f), p1 = *(const LAS v2u*)(Qb + t * 136 + 32 * ks + 16 + 4 * f); const float eg = egs[t];
                v4u o; o.x = pk2(bflo(p0.x) * eg, bfhi(p0.x) * eg); o.y = pk2(bflo(p0.y) * eg, bfhi(p0.y) * eg); o.z = pk2(bflo(p1.x) * eg, bfhi(p1.x) * eg); o.w = pk2(bflo(p1.y) * eg, bfhi(p1.y) * eg);
                *(v4u*)(gops + 16384 + q * 16) = o; }
            for (int q = rt; q < 512; q += 448) { const int blk = q >> 6, l2 = q & 63, i = l2 & 15, f = l2 >> 4, mb = blk >> 1, ks2 = blk & 1, t = 16 * mb + i;
                v2u p0 = (v2u){0u, 0u}, p1 = (v2u){0u, 0u};
                if (2 * ks2 <= mb) p0 = *(const LAS v2u*)(ATs + t * 72 + 32 * ks2 + 4 * f);
                if (2 * ks2 + 1 <= mb) p1 = *(const LAS v2u*)(ATs + t * 72 + 32 * ks2 + 16 + 4 * f);
                *(v4u*)(gops + 32768 + q * 16) = (v4u){p0.x, p0.y, p1.x, p1.y}; }
            for (int q = rt; q < 1024; q += 448) { const int blk = q >> 6, l2 = q & 63, i = l2 & 15, f = l2 >> 4, dkb = blk >> 1, ks2 = blk & 1, dk = 16 * dkb + i; float v[8];
#pragma unroll
                for (int e2 = 0; e2 < 8; ++e2) { const int c = 32 * ks2 + 16 * (e2 >> 2) + 4 * f + (e2 & 3); v[e2] = Ks[c * 132 + dk] * kes[c]; }
                *(v4u*)(gops + 40960 + q * 16) = (v4u){pk2(v[0], v[1]), pk2(v[2], v[3]), pk2(v[4], v[5]), pk2(v[6], v[7])}; }
        }
        __syncthreads();
#pragma unroll
        for (int ct = 0; ct < 2; ++ct) {
            const int C = 2 * wave + ct; const bool isv = C < 8; const int col = isv ? 16 * C + fr : 16 * (C - 8) + fr;
            f32x4 X[4];
#pragma unroll
            for (int I = 0; I < 4; ++I) {
                f32x4 acc;
#pragma unroll
                for (int e2 = 0; e2 < 4; ++e2) { const int t = 16 * I + 4 * fq + e2; acc[e2] = isv ? Vs[t * 132 + col] : egs[t] * Ks[t * 132 + col]; }
#pragma unroll
                for (int J = 0; J < 4; ++J) if (J < I) {
#pragma unroll
                    for (int kk = 0; kk < 4; ++kk) acc = __builtin_amdgcn_mfma_f32_16x16x4f32(LsT[(16 * J + 4 * fq + kk) * 68 + 16 * I + fr], X[J][kk], acc, 0, 0, 0); }
                f32x4 xi = (f32x4){0.f, 0.f, 0.f, 0.f};
#pragma unroll
                for (int kk = 0; kk < 4; ++kk) xi = __builtin_amdgcn_mfma_f32_16x16x4f32(Ti[(I * 16 + fr) * 20 + 4 * fq + kk], acc[kk], xi, 0, 0, 0);
                X[I] = xi;
                if (isv) { v2u w; w.x = pk2(xi[0], xi[1]); w.y = pk2(xi[2], xi[3]); *(v2u*)(UVF + (size_t)task * 16384 + (size_t)((C * 4 + I) * 64 + lane) * 8) = w; }
                else {
#pragma unroll
                    for (int e2 = 0; e2 < 4; ++e2) WKs[(16 * I + 4 * fq + e2) * 136 + col] = (bf16)(pk2(xi[e2], 0.f) & 0xffffu); }
            }
        }
        __syncthreads();
        for (int q = tid; q < 1024; q += NTHR) { const int blk = q >> 6, l2 = q & 63, i = l2 & 15, f = l2 >> 4, mb = blk >> 2, ks = blk & 3, t = 16 * mb + i;
            const v2u p0 = *(const LAS v2u*)(WKs + t * 136 + 32 * ks + 4 * f), p1 = *(const LAS v2u*)(WKs + t * 136 + 32 * ks + 16 + 4 * f);
            *(v4u*)(gops + q * 16) = (v4u){p0.x, p0.y, p1.x, p1.y}; }
        __syncthreads();
    }
}

__device__ __forceinline__ bf16x8 pack8(const f32x4 a, const f32x4 b) {
    v4u w; w.x = pk2(a[0], a[1]); w.y = pk2(a[2], a[3]); w.z = pk2(b[0], b[1]); w.w = pk2(b[2], b[3]); return __builtin_bit_cast(bf16x8, w);
}
__device__ __forceinline__ void gdn_scan(const Args& A, LAS unsigned char* lds, int bh, int tid, int lane, int wave) {
    const int b = bh >> 2, h = bh & 3, fr = lane & 15, fq = lane >> 4, vs = wave;
    const unsigned char* gops = (const unsigned char*)A.out + (size_t)bh * 32 * GOPS_CHUNK;
    const unsigned char* uvf = A.ws + WS_XN + (size_t)bh * 32 * 16384; const float* GE = (const float*)(A.ws + WS_GE) + bh * 32;
    float* Op = (float*)(A.ws + WS_OA) + ((size_t)b * SEQ + 4 * fq) * GW + h * 128 + 16 * vs + fr;
    f32x4 S[8];
#pragma unroll
    for (int i = 0; i < 8; ++i) S[i] = (f32x4){0.f, 0.f, 0.f, 0.f};
    const float gev = GE[lane & 31];
#define SCAN_DMA(chunk, bufoff) do { _Pragma("unroll") for (int i_ = 0; i_ < 9; ++i_) { const int p_ = wave + 8 * i_; \
        const unsigned char* s_ = (p_ < 56) ? (gops + (size_t)(chunk) * GOPS_CHUNK + p_ * 1024) : (uvf + (size_t)(chunk) * 16384 + (p_ - 56) * 1024); \
        __builtin_amdgcn_global_load_lds((const unsigned*)(s_ + lane * 16), (LAS unsigned*)(lds + (bufoff) + p_ * 1024), 16, 0, 0); } } while (0)
    SCAN_DMA(0, 0); SCAN_DMA(1, SCAN_BUF);
    asm volatile("s_waitcnt vmcnt(0)" ::: "memory"); __syncthreads();
#pragma unroll 1
    for (int n = 0; n < 32; ++n) {
        const LAS unsigned char* cur = lds + (n & 1) * SCAN_BUF;
        const float ge = __builtin_bit_cast(float, __builtin_amdgcn_readlane(__builtin_bit_cast(int, gev), n));
        bf16x8 Sb[4];
#pragma unroll
        for (int ks = 0; ks < 4; ++ks) Sb[ks] = pack8(S[2 * ks], S[2 * ks + 1]);
        f32x4 u[4];
#pragma unroll
        for (int mb = 0; mb < 4; ++mb) { f32x4 p = (f32x4){0.f, 0.f, 0.f, 0.f};
#pragma unroll
            for (int ks = 0; ks < 4; ++ks) p = __builtin_amdgcn_mfma_f32_16x16x32_bf16(*(const LAS bf16x8*)(cur + ((mb * 4 + ks) * 64 + lane) * 16), Sb[ks], p, 0, 0, 0);
            const v2u uw = *(const LAS v2u*)(cur + GOPS_CHUNK + ((vs * 4 + mb) * 64 + lane) * 8);
            u[mb] = (f32x4){bflo(uw.x) - p[0], bfhi(uw.x) - p[1], bflo(uw.y) - p[2], bfhi(uw.y) - p[3]}; }
        bf16x8 ub[2]; ub[0] = pack8(u[0], u[1]); ub[1] = pack8(u[2], u[3]);
        f32x4 o[4];
#pragma unroll
        for (int mb = 0; mb < 4; ++mb) { f32x4 acc = (f32x4){0.f, 0.f, 0.f, 0.f};
#pragma unroll
            for (int ks = 0; ks < 4; ++ks) acc = __builtin_amdgcn_mfma_f32_16x16x32_bf16(*(const LAS bf16x8*)(cur + 16384 + ((mb * 4 + ks) * 64 + lane) * 16), Sb[ks], acc, 0, 0, 0);
#pragma unroll
            for (int ks2 = 0; ks2 < 2; ++ks2) if (ks2 <= (mb >> 1)) acc = __builtin_amdgcn_mfma_f32_16x16x32_bf16(*(const LAS bf16x8*)(cur + 32768 + ((mb * 2 + ks2) * 64 + lane) * 16), ub[ks2], acc, 0, 0, 0);
            o[mb] = acc; }
#pragma unroll
        for (int dkb = 0; dkb < 8; ++dkb) { f32x4 acc = S[dkb] * ge;
#pragma unroll
            for (int ks2 = 0; ks2 < 2; ++ks2) acc = __builtin_amdgcn_mfma_f32_16x16x32_bf16(*(const LAS bf16x8*)(cur + 40960 + ((dkb * 2 + ks2) * 64 + lane) * 16), ub[ks2], acc, 0, 0, 0);
            S[dkb] = acc; }
        asm volatile("s_waitcnt vmcnt(0)" ::: "memory"); __syncthreads();
        if (n + 2 < 32) SCAN_DMA(n + 2, (n & 1) * SCAN_BUF);
        float* orow = Op + (size_t)(64 * n) * GW;
#pragma unroll
        for (int mb = 0; mb < 4; ++mb) { float* q = orow + (size_t)(16 * mb) * GW; q[0] = o[mb][0]; q[GW] = o[mb][1]; q[2 * GW] = o[mb][2]; q[3 * GW] = o[mb][3]; }
    }
    asm volatile("s_waitcnt vmcnt(0)" ::: "memory"); __syncthreads();
#undef SCAN_DMA
}


__device__ __forceinline__ float xmax_fq(float x) {
    auto a = __builtin_amdgcn_permlane16_swap(__float_as_uint(x), __float_as_uint(x), false, false); x = fmaxf(__uint_as_float(a[0]), __uint_as_float(a[1]));
    auto b = __builtin_amdgcn_permlane32_swap(__float_as_uint(x), __float_as_uint(x), false, false); return fmaxf(__uint_as_float(b[0]), __uint_as_float(b[1]));
}
__device__ __forceinline__ void attn_fast(const Args& A, LAS unsigned char* lds, int lane, int wave) {
    const bf16* PROJ = (const bf16*)(A.ws + WS_PROJ); bf16* CAT = (bf16*)(A.ws + WS_CAT);
    unsigned* ctr = (unsigned*)(A.ws + WS_CTL);
    LAS bf16* Vt = (LAS bf16*)(lds + wave * 8192);
    const int fr = lane & 15, fq = lane >> 4;
    const int kk = lane & 31, vslot = 8 * ((kk & 15) >> 2) + 4 * (kk >> 4) + (kk & 3), vch = lane >> 5;
    constexpr float SC = 0.125f * 1.4426950408889634f;
    const int myx = (int)(__builtin_amdgcn_s_getreg((3 << 11) | 20) & 0x7u);
    int qi = 0;
    for (;;) {
        int wt = 256, xq = 0;
        while (qi < 8) { xq = (myx + qi) & 7; unsigned wt_ = 0; if (lane == 0) wt_ = atomicAdd(ctr + 16 * xq, 1u); wt = __builtin_amdgcn_readfirstlane(wt_); if (wt < 256) break; ++qi; }
        if (qi >= 8) break;
        const int T = 7 - (wt >> 5), b = (wt >> 2) & 7, h = xq, c0 = wt & 3, t0 = 256 * T;
        const bf16* Pb = PROJ + (size_t)b * SEQ * NP;
        const int tq0 = t0 + c0 + 16 * fr;
        bf16x8 qf0[2], qf1[2], qf2[2], qf3[2];
#pragma unroll
        for (int ks = 0; ks < 2; ++ks) { const bf16* qp = Pb + (size_t)tq0 * NP + PC_QB + h * 64 + 32 * ks + 8 * fq;
            qf0[ks] = *(const bf16x8*)qp; qf1[ks] = *(const bf16x8*)(qp + 4 * NP); qf2[ks] = *(const bf16x8*)(qp + 8 * NP); qf3[ks] = *(const bf16x8*)(qp + 12 * NP); }
        const int n2 = ((t0 + 240) >> 4) + 1, g2 = (n2 + 31) >> 5;
        const int lo1 = max(t0 + c0 - 512, c0), n1 = ((t0 + c0 + 12 + 240 - lo1) >> 2) + 1, g1 = (n1 + 31) >> 5;
        const int lo0 = max(t0 + c0 - 128, 0), n0 = (t0 + c0 + 12 + 240 - lo0) + 1, g0 = (n0 + 31) >> 5;
        const int NG = 4 * g2 + g1 + g0;
        f32x4 O0[4], O1[4], O2[4], O3[4];
#pragma unroll
        for (int i = 0; i < 4; ++i) { O0[i] = (f32x4){0.f, 0.f, 0.f, 0.f}; O1[i] = O0[i]; O2[i] = O0[i]; O3[i] = O0[i]; }
        float m0 = -INFINITY, l0 = 0.f, m1 = -INFINITY, l1 = 0.f, m2 = -INFINITY, l2 = 0.f, m3 = -INFINITY, l3 = 0.f;
        v4u kc[4], vc[4], kn[4], vn[4];
#define ATT_DEC(f, kst, str, mode) do { if ((f) < 4 * g2) { const int ci_ = (f) / g2; str = 16; kst = c0 + 4 * ci_ + 512 * ((f) - ci_ * g2); mode = 1 << ci_; } \
            else if ((f) < 4 * g2 + g1) { str = 4; kst = lo1 + 128 * ((f) - 4 * g2); mode = 15; } else { str = 1; kst = lo0 + 32 * ((f) - 4 * g2 - g1); mode = 15; } } while (0)
#define ATT_LOAD(kreg, vreg, kst, str) do { \
            _Pragma("unroll") for (int j = 0; j < 2; ++j) { const int tk = min((kst) + (str) * (16 * j + fr), SEQ - 1); \
                _Pragma("unroll") for (int ks = 0; ks < 2; ++ks) kreg[2 * j + ks] = *(const v4u*)(Pb + (size_t)tk * NP + PC_KB + h * 64 + 32 * ks + 8 * fq); } \
            { const int tk = min((kst) + (str) * kk, SEQ - 1); \
                _Pragma("unroll") for (int i = 0; i < 4; ++i) vreg[i] = *(const v4u*)(Pb + (size_t)tk * NP + PC_VB + h * 64 + 8 * (vch + 2 * i)); } } while (0)
#define ATT_CLS(O_, m_, l_, qf_, tq_) do { \
            f32x4 d0 = (f32x4){0.f, 0.f, 0.f, 0.f}, d1 = d0; \
            _Pragma("unroll") for (int ks = 0; ks < 2; ++ks) { d0 = __builtin_amdgcn_mfma_f32_16x16x32_bf16(__builtin_bit_cast(bf16x8, kc[ks]), qf_[ks], d0, 0, 0, 0); \
                                                             d1 = __builtin_amdgcn_mfma_f32_16x16x32_bf16(__builtin_bit_cast(bf16x8, kc[2 + ks]), qf_[ks], d1, 0, 0, 0); } \
            float s[8]; float mloc = -INFINITY; \
            const int dv = (((tq_) - kst) >> shl) - 4 * fq;        \
            _Pragma("unroll") for (int e2 = 0; e2 < 8; ++e2) { const float x = (e2 < 4 ? d0[e2 & 3] : d1[e2 & 3]) * SC; \
                s[e2] = ((unsigned)(dv - (16 * (e2 >> 2) + (e2 & 3))) <= 128u) ? x : -INFINITY; mloc = fmaxf(mloc, s[e2]); } \
            mloc = xmax_fq(mloc); \
            const float mnew = fmaxf(m_, mloc), alpha = __builtin_amdgcn_exp2f(m_ - mnew); m_ = mnew; \
            float psum = 0.f; \
            _Pragma("unroll") for (int e2 = 0; e2 < 8; ++e2) { s[e2] = __builtin_amdgcn_exp2f(s[e2] - mnew); psum += s[e2]; } \
            l_ = l_ * alpha + psum; \
            const bf16x8 pb = pack8((f32x4){s[0], s[1], s[2], s[3]}, (f32x4){s[4], s[5], s[6], s[7]}); \
            _Pragma("unroll") for (int db = 0; db < 4; ++db) O_[db] = __builtin_amdgcn_mfma_f32_16x16x32_bf16(va[db], pb, O_[db] * alpha, 0, 0, 0); } while (0)
        int kst, str, mode; ATT_DEC(0, kst, str, mode); ATT_LOAD(kc, vc, kst, str);
#pragma unroll 1
        for (int f = 0; f < NG; ++f) {
            int kstn = 0, strn = 1, moden = 0;
            if (f + 1 < NG) { ATT_DEC(f + 1, kstn, strn, moden); ATT_LOAD(kn, vn, kstn, strn); }
#pragma unroll
            for (int i = 0; i < 4; ++i) { const int dd = 8 * (vch + 2 * i); const v4u w = vc[i];
                Vt[(dd + 0) * 40 + vslot] = (bf16)(w.x & 0xffffu); Vt[(dd + 1) * 40 + vslot] = (bf16)(w.x >> 16); Vt[(dd + 2) * 40 + vslot] = (bf16)(w.y & 0xffffu); Vt[(dd + 3) * 40 + vslot] = (bf16)(w.y >> 16);
                Vt[(dd + 4) * 40 + vslot] = (bf16)(w.z & 0xffffu); Vt[(dd + 5) * 40 + vslot] = (bf16)(w.z >> 16); Vt[(dd + 6) * 40 + vslot] = (bf16)(w.w & 0xffffu); Vt[(dd + 7) * 40 + vslot] = (bf16)(w.w >> 16); }
            bf16x8 va[4];
#pragma unroll
            for (int db = 0; db < 4; ++db) va[db] = *(const LAS bf16x8*)(Vt + (16 * db + fr) * 40 + 8 * fq);
            const int shl = (str == 16) ? 4 : (str == 4 ? 2 : 0);
            if (mode & 1) ATT_CLS(O0, m0, l0, qf0, tq0);
            if (mode & 2) ATT_CLS(O1, m1, l1, qf1, tq0 + 4);
            if (mode & 4) ATT_CLS(O2, m2, l2, qf2, tq0 + 8);
            if (mode & 8) ATT_CLS(O3, m3, l3, qf3, tq0 + 12);
#pragma unroll
            for (int i = 0; i < 4; ++i) { kc[i] = kn[i]; vc[i] = vn[i]; }
            kst = kstn; str = strn; mode = moden;
        }
#undef ATT_DEC
#undef ATT_LOAD
#undef ATT_CLS
        bf16* op = CAT + ((size_t)b * SEQ + tq0) * DM + GW + h * 64 + 4 * fq;
#define ATT_OUT(O_, l_, ci_) do { float lt = l_; lt += __shfl_xor(lt, 16); lt += __shfl_xor(lt, 32); const float inv = 1.0f / lt; \
            _Pragma("unroll") for (int db = 0; db < 4; ++db) { v2u w; w.x = pk2(O_[db][0] * inv, O_[db][1] * inv); w.y = pk2(O_[db][2] * inv, O_[db][3] * inv); *(v2u*)(op + (ci_) * 4 * DM + 16 * db) = w; } } while (0)
        ATT_OUT(O0, l0, 0); ATT_OUT(O1, l1, 1); ATT_OUT(O2, l2, 2); ATT_OUT(O3, l3, 3);
#undef ATT_OUT
    }
}

__device__ __forceinline__ void attn_simple(const Args& A, int tid, int lane, int wave) {
    const bf16* PROJ = (const bf16*)(A.ws + WS_PROJ); bf16* CAT = (bf16*)(A.ws + WS_CAT);
    unsigned* ctr = (unsigned*)(A.ws + WS_CTL);
    for (;;) {
        unsigned wt_ = 0; if (lane == 0) wt_ = atomicAdd(ctr, 1u); const int wt = __builtin_amdgcn_readfirstlane(wt_);
        if (wt >= (M / 64) * AH) break;
        const int h = wt % AH, tb = wt / AH, row = tb * 64 + lane, b = row / SEQ, t = row % SEQ;
        float q[64], acc[64];
        { const v4u* qp = (const v4u*)(PROJ + (size_t)row * NP + PC_QB + h * 64);
#pragma unroll
          for (int j = 0; j < 8; ++j) { const v4u w = qp[j]; q[8 * j + 0] = bflo(w.x) * 0.125f; q[8 * j + 1] = bfhi(w.x) * 0.125f; q[8 * j + 2] = bflo(w.y) * 0.125f; q[8 * j + 3] = bfhi(w.y) * 0.125f;
              q[8 * j + 4] = bflo(w.z) * 0.125f; q[8 * j + 5] = bfhi(w.z) * 0.125f; q[8 * j + 6] = bflo(w.w) * 0.125f; q[8 * j + 7] = bfhi(w.w) * 0.125f; } }
#pragma unroll
        for (int j = 0; j < 64; ++j) acc[j] = 0.f;
        float mx = -1e30f, l = 0.f;
        for (int br = 0; br < 3; ++br) {
            const int stride = br == 0 ? 1 : (br == 1 ? 4 : 16);
            for (int i = 0; i <= 128; ++i) {
                const int tk = t - i * stride; if (tk < 0) break;
                const size_t krow = (size_t)(b * SEQ + tk) * NP;
                const v4u* kp = (const v4u*)(PROJ + krow + PC_KB + h * 64); const v4u* vp = (const v4u*)(PROJ + krow + PC_VB + h * 64);
                float s = 0.f;
#pragma unroll
                for (int j = 0; j < 8; ++j) { const v4u w = kp[j]; s += q[8 * j + 0] * bflo(w.x) + q[8 * j + 1] * bfhi(w.x) + q[8 * j + 2] * bflo(w.y) + q[8 * j + 3] * bfhi(w.y)
                                                                       + q[8 * j + 4] * bflo(w.z) + q[8 * j + 5] * bfhi(w.z) + q[8 * j + 6] * bflo(w.w) + q[8 * j + 7] * bfhi(w.w); }
                const float mn = fmaxf(mx, s), sc = __expf(mx - mn), p = __expf(s - mn); mx = mn; l = l * sc + p;
#pragma unroll
                for (int j = 0; j < 8; ++j) { const v4u w = vp[j];
                    acc[8 * j + 0] = acc[8 * j + 0] * sc + p * bflo(w.x); acc[8 * j + 1] = acc[8 * j + 1] * sc + p * bfhi(w.x); acc[8 * j + 2] = acc[8 * j + 2] * sc + p * bflo(w.y); acc[8 * j + 3] = acc[8 * j + 3] * sc + p * bfhi(w.y);
                    acc[8 * j + 4] = acc[8 * j + 4] * sc + p * bflo(w.z); acc[8 * j + 5] = acc[8 * j + 5] * sc + p * bfhi(w.z); acc[8 * j + 6] = acc[8 * j + 6] * sc + p * bflo(w.w); acc[8 * j + 7] = acc[8 * j + 7] * sc + p * bfhi(w.w); }
            }
        }
        const float inv = 1.0f / l; v4u* op = (v4u*)(CAT + (size_t)row * DM + GW + h * 64);
#pragma unroll
        for (int j = 0; j < 8; ++j) { v4u w; w.x = pk2(acc[8 * j] * inv, acc[8 * j + 1] * inv); w.y = pk2(acc[8 * j + 2] * inv, acc[8 * j + 3] * inv); w.z = pk2(acc[8 * j + 4] * inv, acc[8 * j + 5] * inv); w.w = pk2(acc[8 * j + 6] * inv, acc[8 * j + 7] * inv); op[j] = w; }
    }
}
__device__ __forceinline__ void gated_norm(const Args& A, int lane, int wave) {
    const bf16* PROJ = (const bf16*)(A.ws + WS_PROJ); bf16* CAT = (bf16*)(A.ws + WS_CAT); const float* OA = (const float*)(A.ws + WS_OA); const float* gw = A.in[6];
    const float w0 = gw[2 * lane], w1 = gw[2 * lane + 1];
    const int gwv = blockIdx.x * NWAVES + wave, NGW = gridDim.x * NWAVES;
    for (int wt0 = gwv; wt0 < M * GH; wt0 += 8 * NGW) {
        float2 o[8]; unsigned zz[8];
#pragma unroll
        for (int i = 0; i < 8; ++i) { const int wt = min(wt0 + i * NGW, M * GH - 1), row = wt / GH, h = wt % GH;
            o[i] = *(const float2*)(OA + (size_t)row * GW + h * 128 + 2 * lane); zz[i] = *(const unsigned*)(PROJ + (size_t)row * NP + PC_Z + h * 128 + 2 * lane); }
#pragma unroll
        for (int i = 0; i < 8; ++i) { const int wt = wt0 + i * NGW; if (wt >= M * GH) break; const int row = wt / GH, h = wt % GH;
            const float ms = wave_sum(o[i].x * o[i].x + o[i].y * o[i].y) * (1.0f / 128.0f), r = rsqrtf(ms + RMS_EPS);
            *(unsigned*)(CAT + (size_t)row * DM + h * 128 + 2 * lane) = pk2(o[i].x * r * w0 * silu_f(bflo(zz[i])), o[i].y * r * w1 * silu_f(bfhi(zz[i]))); }
    }
}

__device__ __forceinline__ void gated_norm_bh(const Args& A, int bh, int lane, int wave) {
    const int b = bh >> 2, h = bh & 3;
    const bf16* Zp = (const bf16*)(A.ws + WS_PROJ) + (size_t)b * SEQ * NP + PC_Z + h * 128 + 2 * lane; bf16* Cp = (bf16*)(A.ws + WS_CAT) + (size_t)b * SEQ * DM + h * 128 + 2 * lane;
    const float* Op = (const float*)(A.ws + WS_OA) + (size_t)b * SEQ * GW + h * 128 + 2 * lane; const float* gw = A.in[6];
    const float w0 = gw[2 * lane], w1 = gw[2 * lane + 1];
    __builtin_amdgcn_fence(__ATOMIC_ACQUIRE, "agent");
#pragma unroll 1
    for (int r0 = wave * 16; r0 < SEQ; r0 += NWAVES * 16) {
        float2 o[16]; unsigned zz[16];
#pragma unroll
        for (int i = 0; i < 16; ++i) { o[i] = *(const float2*)(Op + (size_t)(r0 + i) * GW); zz[i] = *(const unsigned*)(Zp + (size_t)(r0 + i) * NP); }
#pragma unroll
        for (int i = 0; i < 16; ++i) { const float ms = wave_sum(o[i].x * o[i].x + o[i].y * o[i].y) * (1.0f / 128.0f), r = rsqrtf(ms + RMS_EPS);
            *(unsigned*)(Cp + (size_t)(r0 + i) * DM) = pk2(o[i].x * r * w0 * silu_f(bflo(zz[i])), o[i].y * r * w1 * silu_f(bfhi(zz[i]))); }
    }
}
__device__ __forceinline__ void ffn_conv_half(const Args& A, int half, int tid) {
    const bf16* Y = (const bf16*)(A.ws + WS_Y); bf16* ACT = (bf16*)(A.ws + WS_ACT); const float* fw = A.in[10];
    constexpr int HC = DFF / 2;
    for (size_t it = (size_t)blockIdx.x * NTHR + tid; it < (size_t)M * (HC / 8); it += (size_t)gridDim.x * NTHR) {
        const int row = (int)(it / (HC / 8)), g8 = (int)(it % (HC / 8)), cl = g8 * 8, pn = cl >> 7, j = cl & 127, t = row % SEQ, ch = half * HC + cl;
        float ga[8], ua[8];
#pragma unroll
        for (int e = 0; e < 8; ++e) { ga[e] = 0.f; ua[e] = 0.f; }
#pragma unroll
        for (int i = 0; i < 3; ++i) { const int ts = t - 2 + i; if (ts < 0) continue;
            const bf16* yr = Y + (size_t)(row - 2 + i) * DFF + 256 * pn + j; const v4u g = *(const v4u*)yr, u = *(const v4u*)(yr + 128);
            const f32x4 wg0 = *(const f32x4*)(fw + i * NUP + ch), wg1 = *(const f32x4*)(fw + i * NUP + ch + 4), wu0 = *(const f32x4*)(fw + i * NUP + DFF + ch), wu1 = *(const f32x4*)(fw + i * NUP + DFF + ch + 4);
            ga[0] += wg0.x * bflo(g.x); ga[1] += wg0.y * bfhi(g.x); ga[2] += wg0.z * bflo(g.y); ga[3] += wg0.w * bfhi(g.y); ga[4] += wg1.x * bflo(g.z); ga[5] += wg1.y * bfhi(g.z); ga[6] += wg1.z * bflo(g.w); ga[7] += wg1.w * bfhi(g.w);
            ua[0] += wu0.x * bflo(u.x); ua[1] += wu0.y * bfhi(u.x); ua[2] += wu0.z * bflo(u.y); ua[3] += wu0.w * bfhi(u.y); ua[4] += wu1.x * bflo(u.z); ua[5] += wu1.y * bfhi(u.z); ua[6] += wu1.z * bflo(u.w); ua[7] += wu1.w * bfhi(u.w); }
        v4u o; o.x = pk2(silu_f(ga[0]) * ua[0], silu_f(ga[1]) * ua[1]); o.y = pk2(silu_f(ga[2]) * ua[2], silu_f(ga[3]) * ua[3]); o.z = pk2(silu_f(ga[4]) * ua[4], silu_f(ga[5]) * ua[5]); o.w = pk2(silu_f(ga[6]) * ua[6], silu_f(ga[7]) * ua[7]);
        *(v4u*)(ACT + (size_t)row * DFF + ch) = o;
    }
}

__device__ __forceinline__ void ffn_fixup(const Args& A, int tid) {
    const float* YH = (const float*)(A.ws + WS_YH); const float* UP = (const float*)(A.ws + WS_UPART); bf16* ACT = (bf16*)(A.ws + WS_ACT); const float* fw = A.in[10];
    for (int it = blockIdx.x * NTHR + tid; it < 64 * 22 * 2 * 128; it += gridDim.x * NTHR) {
        const int c = it & 127, r = (it >> 7) & 1, tile = it >> 8, pm = tile / 22, pn = tile % 22; if ((pm & 7) == 0) continue;
        const int ch = pn * 128 + c; const float* up = UP + ((size_t)tile * 2 + r) * 256; const float* yh = YH + (size_t)((pm - 1) * 22 + pn) * 2 * 256;
        float g = up[c], u = up[128 + c];
        const float wg0 = fw[ch], wg1 = fw[5632 + ch], wu0 = fw[2816 + ch], wu1 = fw[5632 + 2816 + ch];
        if (r == 0) { g += wg0 * yh[c] + wg1 * yh[256 + c]; u += wu0 * yh[128 + c] + wu1 * yh[256 + 128 + c]; }
        else { g += wg0 * yh[256 + c]; u += wu0 * yh[256 + 128 + c]; }
        ACT[(size_t)(pm * 256 + r) * DFF + ch] = (bf16)(pk2(silu_f(g) * u, 0.f) & 0xffffu);
    }
}
__device__ __forceinline__ void final_norm(const Args& A, int lane, int wave) {
    float* out = A.out; const f32x4* nr = (const f32x4*)A.in[12] + lane;
    const int gw = blockIdx.x * NWAVES + wave, NGW = gridDim.x * NWAVES;
    f32x4 nw[4];
#pragma unroll
    for (int j = 0; j < 4; ++j) nw[j] = nr[64 * j];
    for (int m0 = gw; m0 < M; m0 += 4 * NGW) {
        f32x4 v[4][4];
#pragma unroll
        for (int rr = 0; rr < 4; ++rr) { const int m = min(m0 + rr * NGW, M - 1); const f32x4* xr = (const f32x4*)(out + (size_t)m * DM) + lane;
#pragma unroll
            for (int j = 0; j < 4; ++j) v[rr][j] = xr[64 * j]; }
#pragma unroll
        for (int rr = 0; rr < 4; ++rr) { const int m = m0 + rr * NGW; if (m >= M) break; float s = 0.f;
#pragma unroll
            for (int j = 0; j < 4; ++j) s += (v[rr][j].x * v[rr][j].x + v[rr][j].y * v[rr][j].y) + (v[rr][j].z * v[rr][j].z + v[rr][j].w * v[rr][j].w);
            const float rstd = rsqrtf(wave_sum(s) * (1.f / DM) + RMS_EPS); f32x4* xw = (f32x4*)(out + (size_t)m * DM) + lane;
#pragma unroll
            for (int j = 0; j < 4; ++j) xw[64 * j] = (f32x4){v[rr][j].x * rstd * nw[j].x, v[rr][j].y * rstd * nw[j].y, v[rr][j].z * rstd * nw[j].z, v[rr][j].w * rstd * nw[j].w}; }
    }
}

#define XB_TMO      128
#define XB_XCNT(j)  (256  + 64 * (j))
#define XB_XSUB(j)  (1280 + 64 * (j))
#define XB_XGEN(j)  (2304 + 64 * (j))
#define XB_TOP      3328
#define XB_TOPGEN   3392
#define XCD_BAR_WORDS 3456
#define XB_SPIN_CAP (1u << 18)

__device__ __forceinline__ unsigned xb_ld(unsigned* p)              { return __hip_atomic_load(p, __ATOMIC_RELAXED, __HIP_MEMORY_SCOPE_AGENT); }
__device__ __forceinline__ unsigned xb_add(unsigned* p, unsigned v) { return __hip_atomic_fetch_add(p, v, __ATOMIC_RELAXED, __HIP_MEMORY_SCOPE_AGENT); }
__device__ __forceinline__ unsigned xb_xcc_id() { return (unsigned)__builtin_amdgcn_s_getreg((3 << 11) | 20) & 0xFu; }
#define XB_SPIN(cond, bar) do { unsigned _sp = 0; while (cond) { __builtin_amdgcn_s_sleep(1); \
    if ((++_sp & 255u) == 0u) { if (xb_ld(&(bar)[XB_TMO])) break; if (_sp > XB_SPIN_CAP) { atomicAdd(&(bar)[XB_TMO], 1u); break; } } } } while (0)

struct XcdBarrier {
    unsigned* bar; unsigned x;
    volatile LAS unsigned* st;
};

__device__ __forceinline__ XcdBarrier xcd_barrier_post(unsigned* bar, volatile LAS unsigned* st) {
    XcdBarrier b; b.bar = bar; b.x = xb_xcc_id(); b.st = st;
    if (threadIdx.x == 0) (void)xb_add(&bar[XB_XCNT(b.x)], 1u);
    return b;
}
__device__ __forceinline__ void xcd_barrier_complete(unsigned* bar, unsigned x, unsigned& nloc, unsigned& nx) {
    const unsigned G = gridDim.x * gridDim.y * gridDim.z;
    unsigned sum, cnt, mine, sp = 0u;
    for (;;) {
        sum = 0u; cnt = 0u; mine = 0u;
#pragma unroll
        for (unsigned j = 0; j < 16; ++j) { const unsigned c = xb_ld(&bar[XB_XCNT(j)]); sum += c; cnt += (c > 0u) ? 1u : 0u; mine = (j == x) ? c : mine; }
        if (sum == G) break;
        __builtin_amdgcn_s_sleep(1);
        if ((++sp & 255u) == 0u) { if (xb_ld(&bar[XB_TMO])) break; if (sp > XB_SPIN_CAP) { atomicAdd(&bar[XB_TMO], 1u); break; } }
    }
    nloc = mine > 0u ? mine : 1u; nx = cnt > 0u ? cnt : 1u;
}

__device__ __forceinline__ void xcd_barrier(const XcdBarrier& b) {
    asm volatile("s_waitcnt vmcnt(0)" ::: "memory");
    __syncthreads();
    if (threadIdx.x == 0) {
        unsigned* bar = b.bar;
        __builtin_amdgcn_s_waitcnt(0);
        unsigned nloc = b.st[0], nx = b.st[1];
        if (nloc == 0u) { xcd_barrier_complete(bar, b.x, nloc, nx); b.st[0] = nloc; b.st[1] = nx; }
        const unsigned old = xb_add(&bar[XB_XSUB(b.x)], 1u);
        const unsigned gen = old / nloc;
        if (old + 1u == (gen + 1u) * nloc) {
            __builtin_amdgcn_fence(__ATOMIC_RELEASE, "agent");
            asm volatile("s_waitcnt vmcnt(0)" ::: "memory");
            const unsigned og = xb_add(&bar[XB_TOP], 1u);
            const unsigned tg = og / nx;
            if (og + 1u == (tg + 1u) * nx) xb_add(&bar[XB_TOPGEN], 1u);
            else XB_SPIN(xb_ld(&bar[XB_TOPGEN]) == tg, bar);
            __builtin_amdgcn_fence(__ATOMIC_ACQUIRE, "agent");
            xb_add(&bar[XB_XGEN(b.x)], 1u);
            asm volatile("s_waitcnt vmcnt(0)" ::: "memory");
        } else {
            XB_SPIN(xb_ld(&bar[XB_XGEN(b.x)]) == gen, bar);
            __builtin_amdgcn_fence(__ATOMIC_ACQUIRE, "agent");
            asm volatile("s_waitcnt vmcnt(0)" ::: "memory");
        }
    }
    __syncthreads();
}

constexpr int N_PHASES = 8;
__global__ void __launch_bounds__(NTHR, 2) mk_fwd(Args args) {
    extern __shared__ __attribute__((aligned(16))) unsigned char lds_raw[];
    LAS unsigned char* lds = (LAS unsigned char*)lds_raw;
    const int tid = threadIdx.x, lane = tid & 63, wave = __builtin_amdgcn_readfirstlane(tid >> 6);
    const int lo = args.ph_lo, hi = args.ph_hi;
    unsigned char* ws = args.ws;
    bf16* WIN = (bf16*)(ws + WS_WIN); bf16* WOUT = (bf16*)(ws + WS_WOUT); bf16* WUP = (bf16*)(ws + WS_WUP); bf16* WDN = (bf16*)(ws + WS_WDN);
    bf16* XN = (bf16*)(ws + WS_XN); bf16* PROJ = (bf16*)(ws + WS_PROJ); bf16* CAT = (bf16*)(ws + WS_CAT); bf16* Y = (bf16*)(ws + WS_Y); bf16* ACT = (bf16*)(ws + WS_ACT);
    float* SSQ = (float*)(ws + WS_SSQ);
#define IN(k) (lo <= (k) && (k) < hi)
#define SEAM(k) do { if (IN(k) && IN((k) + 1)) { xcd_barrier(bar); } } while (0)
    { volatile LAS unsigned* st = (volatile LAS unsigned*)(lds + LDS_BYTES - 64); if (tid < 2) st[tid] = 0u; }
    __syncthreads();
    XcdBarrier bar = xcd_barrier_post((unsigned*)(ws + WS_CTL) + 4096, (volatile LAS unsigned*)(lds + LDS_BYTES - 64));
    if (args.coop > 1) cg::this_grid().sync();
    if (IN(0)) { p0_prologue(args, lds, tid, lane, wave); } SEAM(0);
    if (IN(1)) { pg8::Gemm g{XN, WIN, M, NP, DM}; pg8::StaticOrder S; S.init(M, NP, gridDim.x, blockIdx.x); pg8::EpiBf16S E{PROJ, NP, nullptr};
        pg8::gemm_phase<pg8::EpiBf16S, pg8::StaticOrder, PG8_ALIGN, PG8_SP2>(lds, g, S, E);
        { pg8::Unit u4; const bool idle4 = !S.next(3, u4); const int G = gridDim.x, nidle = (G == 256) ? 128 : G;
          if (G != 256) convert_late_weights(args, lds, lane, wave, blockIdx.x * NWAVES + wave, G * NWAVES);
          else if (idle4) convert_late_weights(args, lds, lane, wave, (blockIdx.x - 128) * NWAVES + wave, nidle * NWAVES); } } SEAM(1);
    if (IN(2)) { gdn_prep(args, lds, tid, lane, wave); } SEAM(2);
    if (IN(3)) { if (blockIdx.x < NB * GH) gdn_scan(args, lds, blockIdx.x, tid, lane, wave); attn_fast(args, lds, lane, wave); xcd_barrier(bar); gated_norm(args, lane, wave); } SEAM(3);
    if (IN(4)) { pg8::Gemm g{CAT, WOUT, M, DM, DM}; pg8::StaticOrder S; S.init(M, DM, gridDim.x, blockIdx.x); pg8::EpiResid E{args.in[0], (gridDim.x == 256) ? nullptr : args.out, XN, SSQ, DM};
        pg8::gemm_phase<pg8::EpiResid, pg8::StaticOrder, PG8_ALIGN, PG8_SP2>(lds, g, S, E); } SEAM(4);
    if (IN(5)) { pg8::Gemm g{XN, WUP, M, NUP, DM}; pg8::StaticOrder S; S.init(M, NUP, gridDim.x, blockIdx.x);
        static_assert(pg8::EpiConvGate::CG_SSQ == WS_SSQ && pg8::EpiConvGate::CG_ACT == WS_ACT && pg8::EpiConvGate::CG_YH == WS_YH && pg8::EpiConvGate::CG_UPART == WS_UPART, "d_ws map");
        pg8::EpiConvGate E{ws, args.in[10], lds};
        pg8::gemm_phase<pg8::EpiConvGate, pg8::StaticOrder, true, PG8_SP2>(lds, g, S, E); } SEAM(5);
    if (IN(6)) { ffn_fixup(args, tid); } SEAM(6);
    if (IN(7)) { pg8::Gemm g{ACT, WDN, M, DM, DFF}; pg8::StaticOrder S; S.init(M, DM, gridDim.x, blockIdx.x);
        if (gridDim.x == 256) {
            pg8::EpiResidNorm E{XN, args.out, (float*)(ws + WS_SSQ2), (unsigned*)(ws + WS_CTL) + 2048, args.in[12], DM};
            pg8::gemm_phase<pg8::EpiResidNorm, pg8::StaticOrder, true, PG8_SP2>(lds, g, S, E);
        } else {
            pg8::EpiResid E{args.out, args.out, nullptr, nullptr, DM};
            pg8::gemm_phase<pg8::EpiResid, pg8::StaticOrder, PG8_ALIGN, PG8_SP2>(lds, g, S, E);
            xcd_barrier(bar); final_norm(args, lane, wave);
        } }
#undef IN
#undef SEAM
}

#ifndef MK_ONE_LAUNCH
#define MK_ONE_LAUNCH 1
#endif
extern "C" void kernel_launch(void* const* d_in, const int* in_sizes, int n_in, void* d_out, int out_size, void* d_ws, size_t ws_size, hipStream_t stream) {
    static int grid = 0;
    if (grid == 0) {
        if (n_in != 13 || out_size != M * DM || ws_size < WS_END) { fprintf(stderr, "kernel_launch: unexpected shapes n_in %d out %d ws %zu\n", n_in, out_size, ws_size); grid = -1; return; }
        int dev = 0, cus = 0, per_cu = 0;
        hipGetDevice(&dev); hipDeviceGetAttribute(&cus, hipDeviceAttributeMultiprocessorCount, dev);
        hipFuncSetAttribute((const void*)mk_fwd, hipFuncAttributeMaxDynamicSharedMemorySize, LDS_BYTES);
        hipOccupancyMaxActiveBlocksPerMultiprocessor(&per_cu, (const void*)mk_fwd, NTHR, LDS_BYTES);
        (void)hipGetLastError();
        if (per_cu < 1) { fprintf(stderr, "kernel_launch: occupancy query says %d blocks per CU\n", per_cu); per_cu = 1; }
        grid = cus;
    }
    if (grid < 0) return;
    if (hipMemsetAsync((char*)d_ws + WS_CTL, 0, 65536, stream) != hipSuccess) { fprintf(stderr, "kernel_launch: memset failed\n"); return; }
    Args a{};
    for (int i = 0; i < 13; ++i) a.in[i] = (const float*)d_in[i];
    a.out = (float*)d_out; a.ws = (unsigned char*)d_ws;
#if MK_ONE_LAUNCH
    a.ph_lo = 0; a.ph_hi = N_PHASES; a.coop = 1;
    void* kargs[] = {&a};
    hipError_t e = hipLaunchCooperativeKernel((const void*)mk_fwd, dim3(grid), dim3(NTHR), kargs, LDS_BYTES, stream);
    if (e != hipSuccess) fprintf(stderr, "cooperative launch failed: %s (grid %d)\n", hipGetErrorString(e), grid);
#else
    for (int p = 0; p < N_PHASES; ++p) { a.ph_lo = p; a.ph_hi = p + 1; a.coop = 0; hipLaunchKernelGGL(mk_fwd, dim3(grid), dim3(NTHR), LDS_BYTES, stream, a); }
#endif
}
```

```cpp
#include <hip/hip_runtime.h>
#include <hip/hip_cooperative_groups.h>
#include <cstdio>
#include <cstdint>
namespace cg = cooperative_groups;
namespace pg8 {
#define PG8_LAS __attribute__((address_space(3)))
typedef unsigned short bf16_t;
typedef short bf16x8 __attribute__((ext_vector_type(8)));
typedef float f32x4 __attribute__((ext_vector_type(4)));
typedef unsigned u32x4 __attribute__((ext_vector_type(4)));
constexpr int BM = 256, BK = 64, HALF = 128, HTB = HALF * BK * 2  , STAGE_BYTES = 8 * HTB, NXCD = 8, WGM = 8;

__host__ __device__ __forceinline__ int lds_byte(int r, int c) { const int st = (r >> 4) * 2 + (c >> 5), rr = r & 15, cc = c & 31, ob = rr * 64 + cc * 2; return st * 1024 + (ob ^ (((ob >> 9) & 1) << 5)); }
__host__ __device__ __forceinline__ void stage_rc(int b, int& R, int& C) { const int st = b / 1024, sb = b % 1024, swz = sb ^ (((sb >> 9) & 1) << 5); R = (st >> 1) * 16 + swz / 64; C = (st & 1) * 32 + (swz % 64) / 2; }
__host__ __device__ __forceinline__ int perm32(int rho) { const int n = rho >> 4, i = rho & 15; return 8 * (i >> 2) + 4 * n + (i & 3); }

struct Unit { int pm, pn; };
struct Gemm { const bf16_t* A; const bf16_t* Bt; int M, N, K; };

struct StaticOrder {
    int nM, nN, nwg, G, c;
    __host__ __device__ __forceinline__ void init(int M, int N, int G_, int c_) { nM = M / BM; nN = N / BM; nwg = nM * nN; G = G_; c = c_; }
    __host__ __device__ __forceinline__ bool next(int i, Unit& u) const {
        const long L = (long)i * G + c; if (L >= nwg) return false;
        int wgid = (int)L; { const int q = nwg / NXCD, r = nwg % NXCD, xcd = wgid % NXCD, off = wgid / NXCD; wgid = (xcd < r ? xcd * (q + 1) : r * (q + 1) + (xcd - r) * q) + off; }
        const int nig = WGM * nN, gid = wgid / nig, fm = gid * WGM, gsz = (nM - fm) < WGM ? (nM - fm) : WGM;
        u.pm = fm + ((wgid % nig) % gsz); u.pn = (wgid % nig) / gsz; return true;
    }
    __device__ __forceinline__ void a_ready(const Unit&) const {}
    __device__ __forceinline__ void done(const Unit&) const {}
};

__device__ __forceinline__ unsigned cvt_pk_bf16(float lo, float hi) { unsigned r; asm volatile("v_cvt_pk_bf16_f32 %0, %1, %2" : "=v"(r) : "v"(lo), "v"(hi)); return r; }
constexpr float RMS_EPS = 1e-6f;
struct EpiBf16S {
    static constexpr bool PERM = true, AFTER_DRAIN = false;
    bf16_t* O; int ldc; const float* ssq;
    __device__ __forceinline__ void operator()(const f32x4 (&acc)[2][2][4][2], const Unit& u, int wr, int wc, int fr, int fq) const {
        const int row0 = u.pm * BM + wr * 64 + fr; const int col0 = u.pn * BM + wc * 32 + 8 * fq;
#pragma unroll
        for (int ai = 0; ai < 2; ++ai)
#pragma unroll
            for (int m = 0; m < 4; ++m) { const int row = row0 + ai * HALF + m * 16; bf16_t* rowp = O + (size_t)row * ldc + col0;
                const float sc = ssq ? rsqrtf(ssq[row] * (1.0f / 1024.0f) + RMS_EPS) : 1.0f;
#pragma unroll
                for (int bj = 0; bj < 2; ++bj) { const f32x4 v0 = acc[ai][bj][m][0] * sc, v1 = acc[ai][bj][m][1] * sc;
                    u32x4 w; w.x = cvt_pk_bf16(v0[0], v0[1]); w.y = cvt_pk_bf16(v0[2], v0[3]); w.z = cvt_pk_bf16(v1[0], v1[1]); w.w = cvt_pk_bf16(v1[2], v1[3]);
                    *(u32x4*)(rowp + bj * HALF) = w; } }
    }
};
struct EpiResid {
    static constexpr bool PERM = false, AFTER_DRAIN = false;
    const float* base; float* out; bf16_t* xb; float* ssq; int ldc;
    __device__ __forceinline__ void operator()(const f32x4 (&acc)[2][2][4][2], const Unit& u, int wr, int wc, int fr, int fq) const {
        typedef unsigned u32x2v __attribute__((ext_vector_type(2)));
        const int col0 = u.pn * BM + wc * 32 + 4 * fq;
#pragma unroll
        for (int ai = 0; ai < 2; ++ai) {
            f32x4 bv[4][2][2];
#pragma unroll
            for (int m = 0; m < 4; ++m) { const size_t off = (size_t)(u.pm * BM + ai * HALF + wr * 64 + m * 16 + fr) * ldc + col0;
#pragma unroll
                for (int bj = 0; bj < 2; ++bj)
#pragma unroll
                    for (int n = 0; n < 2; ++n) bv[m][bj][n] = *(const f32x4*)(base + off + bj * HALF + n * 16); }
#pragma unroll
            for (int m = 0; m < 4; ++m) { const int row = u.pm * BM + ai * HALF + wr * 64 + m * 16 + fr; const size_t off = (size_t)row * ldc + col0; float s = 0.f;
#pragma unroll
                for (int bj = 0; bj < 2; ++bj)
#pragma unroll
                    for (int n = 0; n < 2; ++n) { const f32x4 v = acc[ai][bj][m][n] + bv[m][bj][n];
                        if (out) *(f32x4*)(out + off + bj * HALF + n * 16) = v; s += (v[0] * v[0] + v[1] * v[1]) + (v[2] * v[2] + v[3] * v[3]);
                        if (xb) { u32x2v w; w.x = cvt_pk_bf16(v[0], v[1]); w.y = cvt_pk_bf16(v[2], v[3]); *(u32x2v*)(xb + off + bj * HALF + n * 16) = w; } }
                if (ssq) { s += __shfl_xor(s, 16); s += __shfl_xor(s, 32); if (fq == 0) atomicAdd(ssq + row, s); } }
            asm volatile("" ::: "memory");
        }
    }
};

__device__ __forceinline__ float dpp_ror1(float v) { return __builtin_bit_cast(float, __builtin_amdgcn_mov_dpp(__builtin_bit_cast(int, v), 0x121, 0xf, 0xf, true)); }
__device__ __forceinline__ float dpp_ror2(float v) { return __builtin_bit_cast(float, __builtin_amdgcn_mov_dpp(__builtin_bit_cast(int, v), 0x122, 0xf, 0xf, true)); }
struct EpiConvGate {
    static constexpr bool PERM = true, AFTER_DRAIN = false;
    static constexpr size_t CG_SSQ = (1u << 20) + 768 * 1024, CG_ACT = (size_t)148 << 20, CG_YH = (size_t)236 << 20, CG_UPART = (size_t)240 << 20;
    unsigned char* ws; const float* fw; PG8_LAS unsigned char* ldsb;
    __device__ __forceinline__ void operator()(f32x4 (&acc)[2][2][4][2], const Unit& u, int wr, int wc, int fr0, int fq0) const {
        int fr = fr0, fq = fq0; asm volatile("" : "+v"(fr), "+v"(fq));
        bf16_t* ACT = (bf16_t*)(ws + CG_ACT); const float* ssq = (const float*)(ws + CG_SSQ); float* YH = (float*)(ws + CG_YH); float* UPART = (float*)(ws + CG_UPART);
        PG8_LAS float* halo = (PG8_LAS float*)(ldsb + STAGE_BYTES);
        int cl = wc * 32 + 8 * fq;
        int ch = u.pn * 128 + cl;
        if (fr >= 14) {
#pragma unroll
            for (int ai = 0; ai < 2; ++ai) { const float sc = rsqrtf(ssq[u.pm * BM + ai * HALF + wr * 64 + 48 + fr] * (1.0f / 1024.0f) + RMS_EPS);
#pragma unroll
                for (int bj = 0; bj < 2; ++bj)
#pragma unroll
                    for (int n = 0; n < 2; ++n) { const f32x4 v = acc[ai][bj][3][n] * sc; *(PG8_LAS f32x4*)(halo + (((wr * 2 + ai) * 2 + (fr - 14)) * 256 + bj * 128 + cl + 4 * n)) = v;
                        if (ai == 1 && wr == 1) *(f32x4*)(YH + ((size_t)(u.pm * 22 + u.pn) * 2 + (fr - 14)) * 256 + bj * 128 + cl + 4 * n) = v; } }
        }
        asm volatile("s_waitcnt lgkmcnt(0)" ::: "memory"); __builtin_amdgcn_s_barrier(); asm volatile("" ::: "memory");
        typedef unsigned u32x2v __attribute__((ext_vector_type(2)));
#pragma unroll 1
        for (int n = 0; n < 2; ++n) {
            asm volatile("" : "+v"(fr), "+v"(fq));
            cl = wc * 32 + 8 * fq; ch = u.pn * 128 + cl;
            f32x4 w[3][2];
#pragma unroll
            for (int i = 0; i < 3; ++i)
#pragma unroll
                for (int bj = 0; bj < 2; ++bj) w[i][bj] = *(const f32x4*)(fw + (size_t)i * 5632 + bj * 2816 + ch + 4 * n);
#pragma unroll
            for (int ai = 0; ai < 2; ++ai) {
                const bool top = (ai == 0 && wr == 0);
                const int pblk = (ai == 0) ? 0 : (wr == 0 ? 2 : 1);
                f32x4 q1[2], q2[2];
#pragma unroll
                for (int bj = 0; bj < 2; ++bj) { const f32x4 pv = top ? (f32x4){0.f, 0.f, 0.f, 0.f} : *(const PG8_LAS f32x4*)(halo + ((pblk * 2 + (fr & 1)) * 256 + bj * 128 + cl + 4 * n));
#pragma unroll
                    for (int k = 0; k < 4; ++k) { q1[bj][k] = dpp_ror1(pv[k]); q2[bj][k] = dpp_ror2(pv[k]); } }
#pragma unroll
                for (int m = 0; m < 4; ++m) {
                    const int row = u.pm * BM + ai * HALF + wr * 64 + m * 16 + fr; const float sc = rsqrtf(ssq[row] * (1.0f / 1024.0f) + RMS_EPS);
                    f32x4 cu[2];
#pragma unroll
                    for (int bj = 0; bj < 2; ++bj) { const f32x4 ya = acc[ai][bj][m][0];
#pragma unroll
                        for (int k = 0; k < 4; ++k) { const float y = ya[k] * sc;
                            const float a1 = dpp_ror1(y), a2 = dpp_ror2(y);
                            const float p1 = (fr == 0) ? q1[bj][k] : a1, p2 = (fr < 2) ? q2[bj][k] : a2;
                            cu[bj][k] = w[2][bj][k] * y + w[1][bj][k] * p1 + w[0][bj][k] * p2; q1[bj][k] = a1; q2[bj][k] = a2; } }
                    if (top && m == 0 && fr < 2 && (u.pm & 7) != 0) {
#pragma unroll
                        for (int bj = 0; bj < 2; ++bj) *(f32x4*)(UPART + ((size_t)(u.pm * 22 + u.pn) * 2 + fr) * 256 + bj * 128 + cl + 4 * n) = cu[bj];
                    }
                    u32x2v o;
#define PG8_SG(k_) (cu[0][k_] * __builtin_amdgcn_rcpf(1.0f + __expf(-cu[0][k_])) * cu[1][k_])
                    o.x = cvt_pk_bf16(PG8_SG(0), PG8_SG(1)); o.y = cvt_pk_bf16(PG8_SG(2), PG8_SG(3));
#undef PG8_SG
                    *(u32x2v*)(ACT + (size_t)row * 2816 + ch + 4 * n) = o;
                    asm volatile("" ::: "memory");
                }
            }
            if (n == 0) {
#pragma unroll
                for (int ai = 0; ai < 2; ++ai)
#pragma unroll
                    for (int bj = 0; bj < 2; ++bj)
#pragma unroll
                        for (int m = 0; m < 4; ++m) acc[ai][bj][m][0] = acc[ai][bj][m][1];
            }
        }
        asm volatile("s_waitcnt lgkmcnt(0)" ::: "memory"); __builtin_amdgcn_s_barrier(); asm volatile("" ::: "memory");
    }
};

struct EpiResidNorm {
    static constexpr bool PERM = false, AFTER_DRAIN = false;
    const bf16_t* base; float* out; float* ssq2; unsigned* cnt; const float* fnw; int ldc;
    __device__ __forceinline__ void operator()(f32x4 (&acc)[2][2][4][2], const Unit& u, int wr, int wc, int fr, int fq) const {
        typedef unsigned u32x2v __attribute__((ext_vector_type(2)));
        const int col0 = u.pn * BM + wc * 32 + 4 * fq;
#pragma unroll
        for (int ai = 0; ai < 2; ++ai) {
            u32x2v bv[4][2][2];
#pragma unroll
            for (int m = 0; m < 4; ++m) { const size_t off = (size_t)(u.pm * BM + ai * HALF + wr * 64 + m * 16 + fr) * ldc + col0;
#pragma unroll
                for (int bj = 0; bj < 2; ++bj)
#pragma unroll
                    for (int n = 0; n < 2; ++n) bv[m][bj][n] = *(const u32x2v*)(base + off + bj * HALF + n * 16); }
#pragma unroll
            for (int m = 0; m < 4; ++m) { const int row = u.pm * BM + ai * HALF + wr * 64 + m * 16 + fr; float s = 0.f;
#pragma unroll
                for (int bj = 0; bj < 2; ++bj)
#pragma unroll
                    for (int n = 0; n < 2; ++n) { const u32x2v bw = bv[m][bj][n]; const f32x4 v = acc[ai][bj][m][n] + (f32x4){__uint_as_float(bw.x << 16), __uint_as_float(bw.x & 0xffff0000u), __uint_as_float(bw.y << 16), __uint_as_float(bw.y & 0xffff0000u)}; acc[ai][bj][m][n] = v; s += (v[0] * v[0] + v[1] * v[1]) + (v[2] * v[2] + v[3] * v[3]); }
                s += __shfl_xor(s, 16); s += __shfl_xor(s, 32);
                if (fq == 0) (void)__hip_atomic_fetch_add(ssq2 + row, s, __ATOMIC_RELAXED, __HIP_MEMORY_SCOPE_AGENT); }
            asm volatile("" ::: "memory");
        }
        asm volatile("s_waitcnt vmcnt(0)" ::: "memory"); __builtin_amdgcn_s_barrier(); asm volatile("" ::: "memory");
        if (wr == 0 && wc == 0 && fr == 0 && fq == 0) {
            __builtin_amdgcn_fence(__ATOMIC_RELEASE, "agent"); asm volatile("s_waitcnt vmcnt(0)" ::: "memory");
            (void)__hip_atomic_fetch_add(cnt + 16 * u.pm, 1u, __ATOMIC_RELAXED, __HIP_MEMORY_SCOPE_AGENT);
            unsigned sp = 0;
            while (__hip_atomic_load(cnt + 16 * u.pm, __ATOMIC_RELAXED, __HIP_MEMORY_SCOPE_AGENT) < 4u) { __builtin_amdgcn_s_sleep(1); if (++sp > (1u << 22)) break; }
            __builtin_amdgcn_fence(__ATOMIC_ACQUIRE, "agent"); asm volatile("s_waitcnt vmcnt(0)" ::: "memory");
        }
        __builtin_amdgcn_s_barrier(); asm volatile("" ::: "memory");
        f32x4 nw[2][2];
#pragma unroll
        for (int bj = 0; bj < 2; ++bj)
#pragma unroll
            for (int n = 0; n < 2; ++n) nw[bj][n] = *(const f32x4*)(fnw + col0 + bj * HALF + n * 16);
#pragma unroll
        for (int ai = 0; ai < 2; ++ai)
#pragma unroll
            for (int m = 0; m < 4; ++m) { const int row = u.pm * BM + ai * HALF + wr * 64 + m * 16 + fr; const size_t off = (size_t)row * ldc + col0;
                const float rstd = rsqrtf(__hip_atomic_load(ssq2 + row, __ATOMIC_RELAXED, __HIP_MEMORY_SCOPE_AGENT) * (1.0f / 1024.0f) + RMS_EPS);
#pragma unroll
                for (int bj = 0; bj < 2; ++bj)
#pragma unroll
                    for (int n = 0; n < 2; ++n) { const f32x4 v = acc[ai][bj][m][n]; *(f32x4*)(out + off + bj * HALF + n * 16) = (f32x4){v[0] * rstd * nw[bj][n][0], v[1] * rstd * nw[bj][n][1], v[2] * rstd * nw[bj][n][2], v[3] * rstd * nw[bj][n][3]}; } }
    }
};
template <class Epi, class Sched, bool ALIGN_EPI = false, bool SP2 = false>
__device__ __forceinline__ void gemm_phase(PG8_LAS unsigned char* lds, const Gemm g, const Sched& S, const Epi& E) {
    const int tid = threadIdx.x, wid = __builtin_amdgcn_readfirstlane(tid >> 6), lane = tid & 63, wr = wid >> 2, wc = wid & 3, fr = lane & 15, fq = lane >> 4;
    const int K = g.K, nt = K / BK;
    unsigned voffA[2], voffB[2];
#pragma unroll
    for (int i = 0; i < 2; ++i) { int R, C; stage_rc(tid * 16 + i * 8192, R, C); const int Rb = Epi::PERM ? ((R & ~31) + perm32(R & 31)) : R;
        voffA[i] = (unsigned)(R * K + C) * 2u; voffB[i] = (unsigned)(Rb * K + C) * 2u; }
    const size_t kstep = (size_t)(BK * 2);
    const size_t hstep = (size_t)HALF * K * 2;
    const size_t tstep = 2 * hstep;
    const unsigned ldsw = (unsigned)wid * 1024u;
    const int aoff = lds_byte(wr * 64 + fr, fq * 8), boff = lds_byte(wc * 32 + fr, fq * 8);
#define PG8_SA(b, h) (((b) * 2 + (h)) * HTB)
#define PG8_SB(b, h) ((4 + (b) * 2 + (h)) * HTB)
#define PG8_STAGE(bufoff, gbase, voff) do { _Pragma("unroll") for (int _i = 0; _i < 2; ++_i) \
        __builtin_amdgcn_global_load_lds((const unsigned*)((const char*)(gbase) + (voff)[_i]), (PG8_LAS unsigned*)(lds + (bufoff) + ldsw + _i * 8192), 16, 0, 0); } while (0)
#define PG8_LDA(dst, b, h) do { _Pragma("unroll") for (int m = 0; m < 4; ++m) _Pragma("unroll") for (int k = 0; k < 2; ++k) dst[m][k] = *(const PG8_LAS bf16x8*)(lds + PG8_SA(b, h) + aoff + m * 2048 + k * 1024); } while (0)
#define PG8_LDB(dst, b, h) do { _Pragma("unroll") for (int n = 0; n < 2; ++n) _Pragma("unroll") for (int k = 0; k < 2; ++k) dst[n][k] = *(const PG8_LAS bf16x8*)(lds + PG8_SB(b, h) + boff + n * 2048 + k * 1024); } while (0)
#define PG8_MMA(ai, bj, At, Bt) do { __builtin_amdgcn_s_setprio(1); _Pragma("unroll") for (int m = 0; m < 4; ++m) _Pragma("unroll") for (int n = 0; n < 2; ++n) _Pragma("unroll") for (int k = 0; k < 2; ++k) \
        acc[ai][bj][m][n] = __builtin_amdgcn_mfma_f32_16x16x32_bf16(Bt[n][k], At[m][k], acc[ai][bj][m][n], 0, 0, 0); __builtin_amdgcn_s_setprio(0); } while (0)
#define PG8_WAIT_V(n) asm volatile("s_waitcnt vmcnt(" #n ")" ::: "memory")
#define PG8_WAIT_L(n) asm volatile("s_waitcnt lgkmcnt(" #n ")" ::: "memory")
#define PG8_BAR __builtin_amdgcn_s_barrier()
#define PG8_SCHED __builtin_amdgcn_sched_barrier(0)
    Unit cur, nxt; int ui = 0;
    if (!S.next(0, cur)) return;
    f32x4 acc[2][2][4][2];
#pragma unroll
    for (int a = 0; a < 2; ++a)
#pragma unroll
        for (int b = 0; b < 2; ++b)
#pragma unroll
            for (int m = 0; m < 4; ++m)
#pragma unroll
                for (int n = 0; n < 2; ++n) acc[a][b][m][n] = (f32x4){0.f, 0.f, 0.f, 0.f};
    bf16x8 At[4][2], B0[2][2], B1[2][2];
    const char* cA = (const char*)g.A + (size_t)cur.pm * tstep; const char* cB = (const char*)g.Bt + (size_t)cur.pn * tstep;
    S.a_ready(cur);
    if constexpr (SP2) {
        PG8_STAGE(PG8_SB(0, 0), cB, voffB); PG8_STAGE(PG8_SB(0, 1), cB + hstep, voffB); PG8_STAGE(PG8_SA(0, 0), cA, voffA); PG8_STAGE(PG8_SA(0, 1), cA + hstep, voffA);
        if (wr == 1) PG8_BAR;
        PG8_WAIT_V(2); PG8_BAR;
        PG8_STAGE(PG8_SB(1, 0), cB + kstep, voffB); PG8_STAGE(PG8_SA(1, 0), cA + kstep, voffA); PG8_STAGE(PG8_SB(1, 1), cB + hstep + kstep, voffB);
        PG8_WAIT_V(6); PG8_BAR;
    } else {
        PG8_STAGE(PG8_SB(0, 0), cB, voffB); PG8_STAGE(PG8_SA(0, 0), cA, voffA); PG8_STAGE(PG8_SB(0, 1), cB + hstep, voffB); PG8_STAGE(PG8_SA(0, 1), cA + hstep, voffA);
        if (wr == 1) PG8_BAR;
        PG8_WAIT_V(4); PG8_BAR;
        PG8_STAGE(PG8_SB(1, 0), cB + kstep, voffB); PG8_STAGE(PG8_SA(1, 0), cA + kstep, voffA); PG8_STAGE(PG8_SB(1, 1), cB + hstep + kstep, voffB);
        PG8_WAIT_V(6); PG8_BAR;
    }
    for (;;) {
        const bool has_next = S.next(ui + 1, nxt);
        const char* nA = has_next ? (const char*)g.A + (size_t)nxt.pm * tstep : cA; const char* nB = has_next ? (const char*)g.Bt + (size_t)nxt.pn * tstep : cB;
        for (int t = 0; t < nt; t += 2) {
            const bool last = (t == nt - 2);
            const char* a1 = cA + (size_t)(t + 1) * kstep;
            const char* a2 = last ? nA : cA + (size_t)(t + 2) * kstep; const char* b2 = last ? nB : cB + (size_t)(t + 2) * kstep;
            const char* a3 = a2 + kstep; const char* b3 = b2 + kstep;
            if (last && has_next) S.a_ready(nxt);
            if constexpr (SP2) {
            PG8_LDB(B0, 0, 0); PG8_LDB(B1, 0, 1); PG8_SCHED; PG8_LDA(At, 0, 0); PG8_STAGE(PG8_SA(1, 1), a1 + hstep, voffA);
            PG8_WAIT_V(8); PG8_WAIT_L(0); PG8_BAR; PG8_MMA(0, 0, At, B0); PG8_MMA(0, 1, At, B1); PG8_BAR; PG8_SCHED;
            PG8_LDA(At, 0, 1); PG8_STAGE(PG8_SB(0, 0), b2, voffB); PG8_STAGE(PG8_SB(0, 1), b2 + hstep, voffB); PG8_STAGE(PG8_SA(0, 0), a2, voffA);
            PG8_WAIT_V(8); PG8_WAIT_L(0); PG8_BAR; PG8_MMA(1, 0, At, B0); PG8_MMA(1, 1, At, B1); PG8_BAR; PG8_SCHED;
            PG8_LDB(B0, 1, 0); PG8_LDB(B1, 1, 1); PG8_SCHED; PG8_LDA(At, 1, 0); PG8_STAGE(PG8_SA(0, 1), a2 + hstep, voffA);
            PG8_WAIT_V(8); PG8_WAIT_L(0); PG8_BAR; PG8_MMA(0, 0, At, B0); PG8_MMA(0, 1, At, B1); PG8_BAR; PG8_SCHED;
            PG8_LDA(At, 1, 1); PG8_STAGE(PG8_SB(1, 0), b3, voffB); PG8_STAGE(PG8_SB(1, 1), b3 + hstep, voffB); PG8_STAGE(PG8_SA(1, 0), a3, voffA);
            PG8_WAIT_V(8); PG8_WAIT_L(0); PG8_BAR; PG8_MMA(1, 0, At, B0); PG8_MMA(1, 1, At, B1); PG8_BAR; PG8_SCHED;
            } else {
            PG8_LDB(B0, 0, 0); PG8_SCHED; PG8_LDA(At, 0, 0); PG8_STAGE(PG8_SA(1, 1), a1 + hstep, voffA);
            PG8_WAIT_L(8); PG8_BAR; PG8_WAIT_L(0); PG8_MMA(0, 0, At, B0); PG8_BAR; PG8_SCHED;
            PG8_LDB(B1, 0, 1); PG8_STAGE(PG8_SB(0, 0), b2, voffB);
            PG8_BAR; PG8_WAIT_L(0); PG8_MMA(0, 1, At, B1); PG8_BAR;
            PG8_LDA(At, 0, 1); PG8_STAGE(PG8_SA(0, 0), a2, voffA);
            PG8_BAR; PG8_WAIT_L(0); PG8_MMA(1, 0, At, B0); PG8_BAR; PG8_SCHED;
            PG8_STAGE(PG8_SB(0, 1), b2 + hstep, voffB);
            PG8_WAIT_V(6); PG8_BAR; PG8_MMA(1, 1, At, B1); PG8_BAR;
            PG8_LDB(B0, 1, 0); PG8_SCHED; PG8_LDA(At, 1, 0); PG8_STAGE(PG8_SA(0, 1), a2 + hstep, voffA);
            PG8_WAIT_L(8); PG8_BAR; PG8_WAIT_L(0); PG8_MMA(0, 0, At, B0); PG8_BAR; PG8_SCHED;
            PG8_LDB(B1, 1, 1); PG8_STAGE(PG8_SB(1, 0), b3, voffB);
            PG8_BAR; PG8_WAIT_L(0); PG8_MMA(0, 1, At, B1); PG8_BAR;
            PG8_LDA(At, 1, 1); PG8_STAGE(PG8_SA(1, 0), a3, voffA);
            PG8_BAR; PG8_WAIT_L(0); PG8_MMA(1, 0, At, B0); PG8_BAR; PG8_SCHED;
            PG8_STAGE(PG8_SB(1, 1), b3 + hstep, voffB);
            PG8_WAIT_V(6); PG8_BAR; PG8_MMA(1, 1, At, B1); PG8_BAR;
            }
        }
        if constexpr (ALIGN_EPI) { if (wr == 0) PG8_BAR; }
        if constexpr (!Epi::AFTER_DRAIN) { E(acc, cur, wr, wc, fr, fq); S.done(cur); }
        if (!has_next) break;
#pragma unroll
        for (int a = 0; a < 2; ++a)
#pragma unroll
            for (int b = 0; b < 2; ++b)
#pragma unroll
                for (int m = 0; m < 4; ++m)
#pragma unroll
                    for (int n = 0; n < 2; ++n) acc[a][b][m][n] = (f32x4){0.f, 0.f, 0.f, 0.f};
        cur = nxt; cA = nA; cB = nB; ++ui;
        if constexpr (ALIGN_EPI) { if (wr == 1) PG8_BAR; }
    }
    PG8_WAIT_V(0);
    if constexpr (!ALIGN_EPI) { if (wr == 0) PG8_BAR; }
    PG8_BAR;
    if constexpr (Epi::AFTER_DRAIN) { E.fused(acc, cur, wr, wc, fr, fq, lds, wid, lane); S.done(cur); }
#undef PG8_SA
#undef PG8_SB
#undef PG8_STAGE
#undef PG8_LDA
#undef PG8_LDB
#undef PG8_MMA
#undef PG8_WAIT_V
#undef PG8_WAIT_L
#undef PG8_BAR
#undef PG8_SCHED
}
}
#ifndef PG8_SP2
#define PG8_SP2 true
#endif
#ifndef PG8_ALIGN
#define PG8_ALIGN true
#endif
constexpr int NB = 8, SEQ = 2048, DM = 1024, M = NB * SEQ;
constexpr int GH = 4, GD = 128, GW = 512, AH = 8, AD = 64;
constexpr int INC = 3592, NP = 3584;
constexpr int DFF = 2816, NUP = 2 * DFF;
constexpr int PC_QA = 0, PC_KA = 512, PC_VA = 1024, PC_Z = 1536, PC_QB = 2048, PC_KB = 2560, PC_VB = 3072;
constexpr size_t MiB = 1u << 20;
constexpr size_t WS_CTL = 0, WS_AB = 1 * MiB, WS_SSQ = 1 * MiB + 768 * 1024, WS_WIN = 2 * MiB, WS_WOUT = 9 * MiB, WS_WUP = 11 * MiB, WS_WDN = 22 * MiB;
constexpr size_t WS_XN = 28 * MiB, WS_PROJ = 60 * MiB, WS_CAT = 172 * MiB, WS_OA = 204 * MiB, WS_Y = 60 * MiB, WS_ACT = 148 * MiB, WS_END = 256 * MiB;
using pg8::RMS_EPS;
constexpr size_t WS_YH = 236 * MiB, WS_UPART = 240 * MiB;
constexpr size_t WS_SSQ2 = WS_SSQ + 131072;
constexpr size_t WS_GE = WS_SSQ + 65536;
constexpr int GOPS_CHUNK = 57344;
constexpr int SCAN_BUF = GOPS_CHUNK + 16384;
constexpr int NWAVES = 8, NTHR = 512;
constexpr int LDS_BYTES = 155648;
#define LAS __attribute__((address_space(3)))
typedef unsigned short bf16;
typedef unsigned v4u __attribute__((ext_vector_type(4)));
typedef unsigned v2u __attribute__((ext_vector_type(2)));
typedef float f32x4 __attribute__((ext_vector_type(4)));
__device__ __forceinline__ float bf2f(unsigned b) { return __uint_as_float(b << 16); }
__device__ __forceinline__ float bflo(unsigned w) { return __uint_as_float(w << 16); }
__device__ __forceinline__ float bfhi(unsigned w) { return __uint_as_float(w & 0xffff0000u); }
__device__ __forceinline__ unsigned pk2(float lo, float hi) { return pg8::cvt_pk_bf16(lo, hi); }
__device__ __forceinline__ float wave_sum(float v) {
    v += __builtin_bit_cast(float, __builtin_amdgcn_mov_dpp(__builtin_bit_cast(int, v), 0xB1, 0xf, 0xf, true));
    v += __builtin_bit_cast(float, __builtin_amdgcn_mov_dpp(__builtin_bit_cast(int, v), 0x4E, 0xf, 0xf, true));
    v += __builtin_bit_cast(float, __builtin_amdgcn_mov_dpp(__builtin_bit_cast(int, v), 0x141, 0xf, 0xf, true));
    v += __builtin_bit_cast(float, __builtin_amdgcn_mov_dpp(__builtin_bit_cast(int, v), 0x140, 0xf, 0xf, true));
    auto a = __builtin_amdgcn_permlane16_swap(__float_as_uint(v), __float_as_uint(v), false, false); v = __uint_as_float(a[0]) + __uint_as_float(a[1]);
    auto b = __builtin_amdgcn_permlane32_swap(__float_as_uint(v), __float_as_uint(v), false, false); return __uint_as_float(b[0]) + __uint_as_float(b[1]);
}
__device__ __forceinline__ float silu_f(float x) { return x * __builtin_amdgcn_rcpf(1.0f + __expf(-x)); }
__device__ __forceinline__ float sigmoid_f(float x) { return __builtin_amdgcn_rcpf(1.0f + __expf(-x)); }
__device__ __forceinline__ float softplus_f(float x) { return x > 20.f ? x : log1pf(__expf(x)); }

struct Args { const float* in[13]; float* out; unsigned char* ws; int ph_lo, ph_hi, coop, pad; };

__device__ __forceinline__ void p0_transpose_item(const float* W, int ldw, int k0, int sn0, bf16* WT, int K, int dn0, const float* kscale, LAS float* scr, int lane) {
    float tv[32];
#pragma unroll
    for (int i = 0; i < 32; ++i) { const int kk = 2 * i + (lane >> 5); tv[i] = W[(size_t)(k0 + kk) * ldw + sn0 + (lane & 31)]; }
    if (kscale) {
#pragma unroll
        for (int i = 0; i < 32; ++i) tv[i] *= kscale[k0 + 2 * i + (lane >> 5)]; }
#pragma unroll
    for (int i = 0; i < 32; ++i) scr[(2 * i + (lane >> 5)) * 33 + (lane & 31)] = tv[i];
    asm volatile("s_waitcnt lgkmcnt(0)" ::: "memory");
    const int c = lane & 7;
#pragma unroll
    for (int j = 0; j < 4; ++j) { const int n = (lane >> 3) + 8 * j; const LAS float* s = scr + (8 * c) * 33 + n;
        v4u o; o.x = pk2(s[0 * 33], s[1 * 33]); o.y = pk2(s[2 * 33], s[3 * 33]); o.z = pk2(s[4 * 33], s[5 * 33]); o.w = pk2(s[6 * 33], s[7 * 33]);
        *(v4u*)(WT + (size_t)(dn0 + n) * K + k0 + 8 * c) = o; }
    asm volatile("s_waitcnt lgkmcnt(0)" ::: "memory");
}

__device__ __forceinline__ void p0_prologue(const Args& A, LAS unsigned char* lds, int tid, int lane, int wave) {
    const float* x = A.in[0]; const float* nw1 = A.in[1]; const float* w_in = A.in[2]; const float* w_out = A.in[7]; const float* nw2 = A.in[8];
    const float* w_up = A.in[9]; const float* w_dn = A.in[11];
    unsigned char* ws = A.ws;
    bf16* WIN = (bf16*)(ws + WS_WIN); bf16* WOUT = (bf16*)(ws + WS_WOUT); bf16* WUP = (bf16*)(ws + WS_WUP); bf16* WDN = (bf16*)(ws + WS_WDN);
    bf16* XN = (bf16*)(ws + WS_XN); float* AB = (float*)(ws + WS_AB); float* SSQ = (float*)(ws + WS_SSQ);
    LAS float* scr = (LAS float*)(lds + wave * 9216);
    LAS float* wab = (LAS float*)(lds + 73728);
    const int G = gridDim.x, gw = blockIdx.x * NWAVES + wave, NGW = G * NWAVES;
    for (int i = blockIdx.x * NTHR + tid; i < M; i += G * NTHR) { SSQ[i] = 0.f; ((float*)(ws + WS_SSQ2))[i] = 0.f; }
    if (blockIdx.x == 0 && tid < 64) ((unsigned*)(ws + WS_CTL))[tid] = 0u;
    for (int idx = tid; idx < 8192; idx += NTHR) { const int k = idx >> 3, j = idx & 7; wab[j * 1024 + k] = nw1[k] * w_in[(size_t)k * INC + 2048 + j]; }
    constexpr int I_IN = 16 * (NP / 32);
    for (int it = gw; it < I_IN; it += NGW) { const int nblk = NP / 32, kb = it / nblk, nb = it % nblk, n0 = 32 * nb; p0_transpose_item(w_in, INC, 64 * kb, n0 + (n0 >= 2048 ? 8 : 0), WIN, DM, n0, nullptr, scr, lane); }
    __syncthreads();
    for (int m0 = gw; m0 < M; m0 += 2 * NGW) {
        const f32x4* nr = (const f32x4*)nw1 + lane;
        f32x4 v[2][4]; float s[2] = {0.f, 0.f};
#pragma unroll
        for (int rr = 0; rr < 2; ++rr) { const int m = min(m0 + rr * NGW, M - 1); const f32x4* xr = (const f32x4*)(x + (size_t)m * DM) + lane;
#pragma unroll
            for (int j = 0; j < 4; ++j) v[rr][j] = xr[64 * j]; }
#pragma unroll
        for (int rr = 0; rr < 2; ++rr)
#pragma unroll
            for (int j = 0; j < 4; ++j) s[rr] += (v[rr][j].x * v[rr][j].x + v[rr][j].y * v[rr][j].y) + (v[rr][j].z * v[rr][j].z + v[rr][j].w * v[rr][j].w);
#pragma unroll
        for (int rr = 0; rr < 2; ++rr) { const int m = m0 + rr * NGW; if (m >= M) break;
            const float rstd = rsqrtf(wave_sum(s[rr]) * (1.f / DM) + RMS_EPS);
            float ab[8];
#pragma unroll
            for (int q = 0; q < 8; ++q) { float a = 0.f;
#pragma unroll
                for (int j = 0; j < 4; ++j) { const f32x4 w = *(const LAS f32x4*)(wab + q * 1024 + 256 * j + 4 * lane); a += (v[rr][j].x * w.x + v[rr][j].y * w.y) + (v[rr][j].z * w.z + v[rr][j].w * w.w); }
                ab[q] = wave_sum(a) * rstd; }
            if (lane == 0) { *(f32x4*)(AB + (size_t)m * 8) = (f32x4){ab[0], ab[1], ab[2], ab[3]}; *(f32x4*)(AB + (size_t)m * 8 + 4) = (f32x4){ab[4], ab[5], ab[6], ab[7]}; }
            v2u* o8 = (v2u*)(XN + (size_t)m * DM) + lane;
#pragma unroll
            for (int j = 0; j < 4; ++j) { const f32x4 n = nr[64 * j]; v2u o; o.x = pk2(v[rr][j].x * rstd * n.x, v[rr][j].y * rstd * n.y); o.y = pk2(v[rr][j].z * rstd * n.z, v[rr][j].w * rstd * n.w); o8[64 * j] = o; }
        }
    }
}


__device__ __forceinline__ void convert_late_weights(const Args& A, LAS unsigned char* lds, int lane, int wave, int gw0, int ngw) {
    const float* w_out = A.in[7]; const float* nw2 = A.in[8]; const float* w_up = A.in[9]; const float* w_dn = A.in[11];
    bf16* WOUT = (bf16*)(A.ws + WS_WOUT); bf16* WUP = (bf16*)(A.ws + WS_WUP); bf16* WDN = (bf16*)(A.ws + WS_WDN);
    LAS float* scr = (LAS float*)(lds + wave * 9216);
    constexpr int I_OUT = 16 * 32, I_UP = 16 * (NUP / 32), I_DN = (DFF / 64) * 32;
    for (int it = gw0; it < I_OUT + I_UP + I_DN; it += ngw) {
        int r = it;
        if (r < I_OUT) { const int kb = r / 32, nb = r % 32; p0_transpose_item(w_out, DM, 64 * kb, 32 * nb, WOUT, DM, 32 * nb, nullptr, scr, lane); continue; } r -= I_OUT;
        if (r < I_UP) { const int nblk = NUP / 32, kb = r / nblk, nb = r % nblk, n0 = 32 * nb, pn = n0 >> 8, j0 = n0 & 255;
            const int s0 = (j0 < 128) ? (128 * pn + j0) : (DFF + 128 * pn + j0 - 128);
            p0_transpose_item(w_up, NUP, 64 * kb, s0, WUP, DM, n0, nw2, scr, lane); continue; } r -= I_UP;
        { const int kb = r / 32, nb = r % 32; p0_transpose_item(w_dn, DM, 64 * kb, 32 * nb, WDN, DFF, 32 * nb, nullptr, scr, lane); }
    }
}
__device__ __forceinline__ void gdn_simple(const Args& A, LAS unsigned char* lds, int tid, int lane, int wave) {
    const bf16* PROJ = (const bf16*)(A.ws + WS_PROJ); const float* AB = (const float*)(A.ws + WS_AB); float* OA = (float*)(A.ws + WS_OA);
    const float* cw = A.in[3]; const float* a_log = A.in[4]; const float* dt_bias = A.in[5];
    LAS float* qs = (LAS float*)lds; LAS float* ks = qs + 16 * 128; LAS float* vs = ks + 16 * 128; LAS float* av = vs + 16 * 128; LAS float* bv = av + 16;
    for (int task = blockIdx.x; task < NB * GH; task += gridDim.x) {
        const int b = task / GH, h = task % GH, v = tid >> 2, part = tid & 3;
        float S[32];
#pragma unroll
        for (int i = 0; i < 32; ++i) S[i] = 0.f;
        const float Ah = __expf(a_log[h]), dtb = dt_bias[h];
        for (int blk = 0; blk < SEQ / 16; ++blk) {
            const int t0 = blk * 16;
            for (int idx = tid; idx < 16 * 384; idx += NTHR) {
                const int tt = idx / 384, c = idx % 384, which = c >> 7, d = c & 127, col = which * 512 + h * 128 + d, t = t0 + tt;
                float acc = 0.f;
#pragma unroll
                for (int i = 0; i < 4; ++i) { const int ts = t - 3 + i; if (ts >= 0) acc += cw[i * 1536 + col] * bf2f(PROJ[(size_t)(b * SEQ + ts) * NP + col]); }
                qs[which * 2048 + tt * 128 + d] = silu_f(acc);
            }
            if (tid < 16) { const size_t row = (size_t)b * SEQ + t0 + tid; bv[tid] = sigmoid_f(AB[row * 8 + h]); av[tid] = __expf(-Ah * softplus_f(AB[row * 8 + 4 + h] + dtb)); }
            __syncthreads();
#pragma unroll
            for (int r = 0; r < 4; ++r) { const int row = 4 * wave + r; LAS float* arr = qs + row * 128;
                const float v0 = arr[lane], v1 = arr[lane + 64]; const float s = wave_sum(v0 * v0 + v1 * v1);
                const float sc = rsqrtf(s + RMS_EPS) * (row < 16 ? 0.08838834764831845f : 1.0f); arr[lane] = v0 * sc; arr[lane + 64] = v1 * sc; }
            __syncthreads();
            for (int tt = 0; tt < 16; ++tt) {
                const float a = av[tt], bt = bv[tt], vt = vs[tt * 128 + v];
                float kS = 0.f;
#pragma unroll
                for (int i = 0; i < 32; ++i) kS += ks[tt * 128 + 32 * part + i] * S[i];
                kS += __shfl_xor(kS, 1); kS += __shfl_xor(kS, 2);
                const float c = bt * (vt - a * kS); float o = 0.f;
#pragma unroll
                for (int i = 0; i < 32; ++i) { S[i] = a * S[i] + ks[tt * 128 + 32 * part + i] * c; o += qs[tt * 128 + 32 * part + i] * S[i]; }
                o += __shfl_xor(o, 1); o += __shfl_xor(o, 2);
                if (part == 0) OA[(size_t)(b * SEQ + t0 + tt) * GW + h * 128 + v] = o;
            }
            __syncthreads();
        }
    }
}


template <int J, int K, int N> struct SolveLd {
    static __device__ __forceinline__ void run(f32x4 (&l)[4], unsigned lbase) {
        if constexpr (K < N) { constexpr int t40 = ((J + 1) >> 2) << 2;
            asm volatile("ds_read_b128 %0, %1 offset:%2" : "=v"(l[K]) : "v"(lbase), "i"((J * 68 + t40 + 4 * K) * 4)); SolveLd<J, K + 1, N>::run(l, lbase); }
    }
};
template <int J> struct SolveCol16 {
    static __device__ __forceinline__ void run(float (&R)[16], unsigned lbase) {
        if constexpr (J < 15) {
            constexpr int t40 = ((J + 1) >> 2) << 2, nld = (16 - t40) >> 2;
            f32x4 l[4];
            SolveLd<J, 0, nld>::run(l, lbase);
            asm volatile("s_waitcnt lgkmcnt(0)" ::: "memory");
#pragma unroll
            for (int k = 0; k < nld; ++k) asm volatile("" : "+v"(l[k]));
#pragma unroll
            for (int k = 0; k < nld; ++k) {
#pragma unroll
                for (int e = 0; e < 4; ++e) if (t40 + 4 * k + e > J) R[t40 + 4 * k + e] += l[k][e] * R[J]; }
            SolveCol16<J + 1>::run(R, lbase);
        }
    }
};

typedef short bf16x8 __attribute__((ext_vector_type(8)));
__device__ __forceinline__ void gdn_prep(const Args& A, LAS unsigned char* lds, int tid0, int lane0, int wave) {
    const bf16* PROJ = (const bf16*)(A.ws + WS_PROJ); const float* AB = (const float*)(A.ws + WS_AB);
    const float* cw = A.in[3]; const float* a_log = A.in[4]; const float* dt_bias = A.in[5];
    unsigned char* UVF = A.ws + WS_XN; unsigned char* GOPS = (unsigned char*)A.out; float* GE = (float*)(A.ws + WS_GE);
    LAS float* Qs = (LAS float*)lds; LAS float* Ks = (LAS float*)(lds + 33792); LAS float* Vs = (LAS float*)(lds + 67584);
    LAS bf16* Qb = (LAS bf16*)(lds + 101376); LAS bf16* Kb = (LAS bf16*)(lds + 118784);
    LAS float* gcs = (LAS float*)(lds + 136192); LAS float* bts = gcs + 64; LAS float* egs = gcs + 128; LAS float* kes = gcs + 192;
    LAS float* LsT = (LAS float*)lds; LAS bf16* ATs = (LAS bf16*)(lds + 17408); LAS bf16* WKs = Kb;
    v4u rwn[11];
    if (tid0 < 384 && (int)blockIdx.x < NB * GH * 32) { const int c8 = tid0 % 48, run = tid0 / 48, which = c8 >> 4, d0 = (c8 & 15) * 8, t1 = blockIdx.x, bh1 = t1 >> 5, n1 = t1 & 31, b1 = bh1 >> 2, h1 = bh1 & 3, col1 = which * 512 + h1 * 128 + d0;
#pragma unroll
        for (int r = 0; r < 11; ++r) { const int ts = 64 * n1 + 8 * run - 3 + r; rwn[r] = (ts >= 0) ? *(const v4u*)(PROJ + (size_t)(b1 * SEQ + ts) * NP + col1) : (v4u){0u, 0u, 0u, 0u}; } }
    else {
#pragma unroll
        for (int r = 0; r < 11; ++r) rwn[r] = (v4u){0u, 0u, 0u, 0u}; }
#pragma unroll 1
    for (int task = blockIdx.x; task < NB * GH * 32; task += gridDim.x) {
        int tid = tid0, lane = lane0; asm volatile("" : "+v"(tid), "+v"(lane));
        const int fr = lane & 15, fq = lane >> 4;
        const int bh = task >> 5, n = task & 31, b = bh >> 2, h = bh & 3, t0 = 64 * n, row0 = b * SEQ + t0;
        unsigned char* gops = GOPS + (size_t)task * GOPS_CHUNK;
        if (tid < 384) {
            const int c8 = tid % 48, run = tid / 48, which = c8 >> 4, d0 = (c8 & 15) * 8, col = which * 512 + h * 128 + d0;
            v4u rw[11];
#pragma unroll
            for (int r = 0; r < 11; ++r) rw[r] = rwn[r];
            { const int tn = task + gridDim.x;
              if (tn < NB * GH * 32) { const int bhn = tn >> 5, nn = tn & 31, bn = bhn >> 2, hn = bhn & 3, coln = which * 512 + hn * 128 + d0;
#pragma unroll
                for (int r = 0; r < 11; ++r) { const int ts = 64 * nn + 8 * run - 3 + r; rwn[r] = (ts >= 0) ? *(const v4u*)(PROJ + (size_t)(bn * SEQ + ts) * NP + coln) : (v4u){0u, 0u, 0u, 0u}; } } }
            f32x4 cwa[4], cwb[4];
#pragma unroll
            for (int j = 0; j < 4; ++j) { cwa[j] = *(const f32x4*)(cw + j * 1536 + col); cwb[j] = *(const f32x4*)(cw + j * 1536 + col + 4); }
#pragma unroll
            for (int i = 0; i < 8; ++i) {
                float acc[8];
#pragma unroll
                for (int e2 = 0; e2 < 8; ++e2) acc[e2] = 0.f;
#pragma unroll
                for (int j = 0; j < 4; ++j) { const v4u w = rw[i + j];
                    acc[0] += cwa[j].x * bflo(w.x); acc[1] += cwa[j].y * bfhi(w.x); acc[2] += cwa[j].z * bflo(w.y); acc[3] += cwa[j].w * bfhi(w.y);
                    acc[4] += cwb[j].x * bflo(w.z); acc[5] += cwb[j].y * bfhi(w.z); acc[6] += cwb[j].z * bflo(w.w); acc[7] += cwb[j].w * bfhi(w.w); }
                float ss = 0.f;
#pragma unroll
                for (int e2 = 0; e2 < 8; ++e2) { acc[e2] = silu_f(acc[e2]); ss += acc[e2] * acc[e2]; }
                ss += __builtin_bit_cast(float, __builtin_amdgcn_update_dpp(0, __builtin_bit_cast(int, ss), 0xB1, 0xf, 0xf, false));
                ss += __builtin_bit_cast(float, __builtin_amdgcn_update_dpp(0, __builtin_bit_cast(int, ss), 0x4E, 0xf, 0xf, false));
                ss += __builtin_bit_cast(float, __builtin_amdgcn_update_dpp(0, __builtin_bit_cast(int, ss), 0x141, 0xf, 0xf, false));
                ss += __builtin_bit_cast(float, __builtin_amdgcn_update_dpp(0, __builtin_bit_cast(int, ss), 0x140, 0xf, 0xf, false));
                const int tt = 8 * run + i;
                if (which == 2) { *(LAS f32x4*)(Vs + tt * 132 + d0) = (f32x4){acc[0], acc[1], acc[2], acc[3]}; *(LAS f32x4*)(Vs + tt * 132 + d0 + 4) = (f32x4){acc[4], acc[5], acc[6], acc[7]}; }
                else {
                    const float sc = rsqrtf(ss + RMS_EPS) * (which == 0 ? 0.08838834764831845f : 1.0f);
#pragma unroll
                    for (int e2 = 0; e2 < 8; ++e2) acc[e2] *= sc;
                    const v4u pk = (v4u){pk2(acc[0], acc[1]), pk2(acc[2], acc[3]), pk2(acc[4], acc[5]), pk2(acc[6], acc[7])};
                    if (which == 0) *(LAS v4u*)(Qb + tt * 136 + d0) = pk;
                    else { *(LAS v4u*)(Kb + tt * 136 + d0) = pk; *(LAS f32x4*)(Ks + tt * 132 + d0) = (f32x4){acc[0], acc[1], acc[2], acc[3]}; *(LAS f32x4*)(Ks + tt * 132 + d0 + 4) = (f32x4){acc[4], acc[5], acc[6], acc[7]}; }
                }
            }
        }
        if (wave == 0) {
            const size_t row = (size_t)row0 + lane; const float beta = sigmoid_f(AB[row * 8 + h]);
            float g = -__expf(a_log[h]) * softplus_f(AB[row * 8 + 4 + h] + dt_bias[h]);
#pragma unroll
            for (int o = 1; o < 64; o <<= 1) { const float t = __shfl_up(g, o); if (lane >= o) g += t; }
            const float glast = __shfl(g, 63);
            gcs[lane] = g; bts[lane] = beta; egs[lane] = __expf(g); kes[lane] = __expf(glast - g) * beta;
            if (lane == 63) GE[task] = __expf(g);
        }
        __syncthreads();
#pragma unroll 1
        for (int jb = wave; jb < 20; jb += 8) {
            const int kind = jb >= 10 ? 1 : 0, idx = jb - 10 * kind, ti = idx < 1 ? 0 : (idx < 3 ? 1 : (idx < 6 ? 2 : 3)), tj = idx - ti * (ti + 1) / 2;
            const LAS bf16* As = kind ? Qb : Kb; f32x4 d = (f32x4){0.f, 0.f, 0.f, 0.f};
#pragma unroll
            for (int ks = 0; ks < 4; ++ks) { const bf16x8 a = *(const LAS bf16x8*)(As + (16 * ti + fr) * 136 + 32 * ks + 8 * fq), bb = *(const LAS bf16x8*)(Kb + (16 * tj + fr) * 136 + 32 * ks + 8 * fq);
                d = __builtin_amdgcn_mfma_f32_16x16x32_bf16(a, bb, d, 0, 0, 0); }
            const int j = 16 * tj + fr; const float gj = gcs[j], bj = bts[j]; float val[4];
#pragma unroll
            for (int e = 0; e < 4; ++e) { const int t = 16 * ti + 4 * fq + e; const float x = d[e] * __expf(gcs[t] - gj) * bj; val[e] = (kind ? (t >= j) : (t > j)) ? x : 0.f; }
            if (kind == 0) *(LAS f32x4*)(LsT + j * 68 + 16 * ti + 4 * fq) = (f32x4){-val[0], -val[1], -val[2], -val[3]};
            else {
#pragma unroll
                for (int e = 0; e < 4; ++e) ATs[(16 * ti + 4 * fq + e) * 72 + j] = (bf16)(pk2(val[e], 0.f) & 0xffffu); }
        }
        __syncthreads();
        LAS float* Ti = (LAS float*)(lds + 26624);
        if (wave == 0) {
            const int I = lane >> 4, c = lane & 15; float x[16];
#pragma unroll
            for (int r = 0; r < 16; ++r) x[r] = (r == c) ? 1.0f : 0.0f;
            SolveCol16<0>::run(x, (unsigned)(uintptr_t)LsT + (unsigned)(I * (16 * 68 + 16) * 4));
#pragma unroll
            for (int r = 0; r < 16; ++r) Ti[(I * 16 + r) * 20 + c] = x[r];
        } else {
            const int rt = tid - 64;
            for (int q = rt; q < 1024; q += 448) { const int blk = q >> 6, l2 = q & 63, i = l2 & 15, f = l2 >> 4, mb = blk >> 2, ks = blk & 3, t = 16 * mb + i;
                const v2u p0 = *(const LAS v2u*)(Qb + t * 136 + 32 * ks + 4 * f), p1 = *(const LAS v2u*)(Qb + t * 136 + 32 * ks + 16 + 4 * f); const float eg = egs[t];
                v4u o; o.x = pk2(bflo(p0.x) * eg, bfhi(p0.x) * eg); o.y = pk2(bflo(p0.y) * eg, bfhi(p0.y) * eg); o.z = pk2(bflo(p1.x) * eg, bfhi(p1.x) * eg); o.w = pk2(bflo(p1.y) * eg, bfhi(p1.y) * eg);
                *(v4u*)(gops + 16384 + q * 16) = o; }
            for (int q = rt; q < 512; q += 448) { const int blk = q >> 6, l2 = q & 63, i = l2 & 15, f = l2 >> 4, mb = blk >> 1, ks2 = blk & 1, t = 16 * mb + i;
                v2u p0 = (v2u){0u, 0u}, p1 = (v2u){0u, 0u};
                if (2 * ks2 <= mb) p0 = *(const LAS v2u*)(ATs + t * 72 + 32 * ks2 + 4 * f);
                if (2 * ks2 + 1 <= mb) p1 = *(const LAS v2u*)(ATs + t * 72 + 32 * ks2 + 16 + 4 * f);
                *(v4u*)(gops + 32768 + q * 16) = (v4u){p0.x, p0.y, p1.x, p1.y}; }
            for (int q = rt; q < 1024; q += 448) { const int blk = q >> 6, l2 = q & 63, i = l2 & 15, f = l2 >> 4, dkb = blk >> 1, ks2 = blk & 1, dk = 16 * dkb + i; float v[8];
#pragma unroll
                for (int e2 = 0; e2 < 8; ++e2) { const int c = 32 * ks2 + 16 * (e2 >> 2) + 4 * f + (e2 & 3); v[e2] = Ks[c * 132 + dk] * kes[c]; }
                *(v4u*)(gops + 40960 + q * 16) = (v4u){pk2(v[0], v[1]), pk2(v[2], v[3]), pk2(v[4], v[5]), pk2(v[6], v[7])}; }
        }
        __syncthreads();
#pragma unroll
        for (int ct = 0; ct < 2; ++ct) {
            const int C = 2 * wave + ct; const bool isv = C < 8; const int col = isv ? 16 * C + fr : 16 * (C - 8) + fr;
            f32x4 X[4];
#pragma unroll
            for (int I = 0; I < 4; ++I) {
                f32x4 acc;
#pragma unroll
                for (int e2 = 0; e2 < 4; ++e2) { const int t = 16 * I + 4 * fq + e2; acc[e2] = isv ? Vs[t * 132 + col] : egs[t] * Ks[t * 132 + col]; }
#pragma unroll
                for (int J = 0; J < 4; ++J) if (J < I) {
#pragma unroll
                    for (int kk = 0; kk < 4; ++kk) acc = __builtin_amdgcn_mfma_f32_16x16x4f32(LsT[(16 * J + 4 * fq + kk) * 68 + 16 * I + fr], X[J][kk], acc, 0, 0, 0); }
                f32x4 xi = (f32x4){0.f, 0.f, 0.f, 0.f};
#pragma unroll
                for (int kk = 0; kk < 4; ++kk) xi = __builtin_amdgcn_mfma_f32_16x16x4f32(Ti[(I * 16 + fr) * 20 + 4 * fq + kk], acc[kk], xi, 0, 0, 0);
                X[I] = xi;
                if (isv) { v2u w; w.x = pk2(xi[0], xi[1]); w.y = pk2(xi[2], xi[3]); *(v2u*)(UVF + (size_t)task * 16384 + (size_t)((C * 4 + I) * 64 + lane) * 8) = w; }
                else {
#pragma unroll
                    for (int e2 = 0; e2 < 4; ++e2) WKs[(16 * I + 4 * fq + e2) * 136 + col] = (bf16)(pk2(xi[e2], 0.f) & 0xffffu); }
            }
        }
        __syncthreads();
        for (int q = tid; q < 1024; q += NTHR) { const int blk = q >> 6, l2 = q & 63, i = l2 & 15, f = l2 >> 4, mb = blk >> 2, ks = blk & 3, t = 16 * mb + i;
            const v2u p0 = *(const LAS v2u*)(WKs + t * 136 + 32 * ks + 4 * f), p1 = *(const LAS v2u*)(WKs + t * 136 + 32 * ks + 16 + 4 * f);
            *(v4u*)(gops + q * 16) = (v4u){p0.x, p0.y, p1.x, p1.y}; }
        __syncthreads();
    }
}

__device__ __forceinline__ bf16x8 pack8(const f32x4 a, const f32x4 b) {
    v4u w; w.x = pk2(a[0], a[1]); w.y = pk2(a[2], a[3]); w.z = pk2(b[0], b[1]); w.w = pk2(b[2], b[3]); return __builtin_bit_cast(bf16x8, w);
}
__device__ __forceinline__ void gdn_scan(const Args& A, LAS unsigned char* lds, int bh, int tid, int lane, int wave) {
    const int b = bh >> 2, h = bh & 3, fr = lane & 15, fq = lane >> 4, vs = wave;
    const unsigned char* gops = (const unsigned char*)A.out + (size_t)bh * 32 * GOPS_CHUNK;
    const unsigned char* uvf = A.ws + WS_XN + (size_t)bh * 32 * 16384; const float* GE = (const float*)(A.ws + WS_GE) + bh * 32;
    float* Op = (float*)(A.ws + WS_OA) + ((size_t)b * SEQ + 4 * fq) * GW + h * 128 + 16 * vs + fr;
    f32x4 S[8];
#pragma unroll
    for (int i = 0; i < 8; ++i) S[i] = (f32x4){0.f, 0.f, 0.f, 0.f};
    const float gev = GE[lane & 31];
#define SCAN_DMA(chunk, bufoff) do { _Pragma("unroll") for (int i_ = 0; i_ < 9; ++i_) { const int p_ = wave + 8 * i_; \
        const unsigned char* s_ = (p_ < 56) ? (gops + (size_t)(chunk) * GOPS_CHUNK + p_ * 1024) : (uvf + (size_t)(chunk) * 16384 + (p_ - 56) * 1024); \
        __builtin_amdgcn_global_load_lds((const unsigned*)(s_ + lane * 16), (LAS unsigned*)(lds + (bufoff) + p_ * 1024), 16, 0, 0); } } while (0)
    SCAN_DMA(0, 0); SCAN_DMA(1, SCAN_BUF);
    asm volatile("s_waitcnt vmcnt(0)" ::: "memory"); __syncthreads();
#pragma unroll 1
    for (int n = 0; n < 32; ++n) {
        const LAS unsigned char* cur = lds + (n & 1) * SCAN_BUF;
        const float ge = __builtin_bit_cast(float, __builtin_amdgcn_readlane(__builtin_bit_cast(int, gev), n));
        bf16x8 Sb[4];
#pragma unroll
        for (int ks = 0; ks < 4; ++ks) Sb[ks] = pack8(S[2 * ks], S[2 * ks + 1]);
        f32x4 u[4];
#pragma unroll
        for (int mb = 0; mb < 4; ++mb) { f32x4 p = (f32x4){0.f, 0.f, 0.f, 0.f};
#pragma unroll
            for (int ks = 0; ks < 4; ++ks) p = __builtin_amdgcn_mfma_f32_16x16x32_bf16(*(const LAS bf16x8*)(cur + ((mb * 4 + ks) * 64 + lane) * 16), Sb[ks], p, 0, 0, 0);
            const v2u uw = *(const LAS v2u*)(cur + GOPS_CHUNK + ((vs * 4 + mb) * 64 + lane) * 8);
            u[mb] = (f32x4){bflo(uw.x) - p[0], bfhi(uw.x) - p[1], bflo(uw.y) - p[2], bfhi(uw.y) - p[3]}; }
        bf16x8 ub[2]; ub[0] = pack8(u[0], u[1]); ub[1] = pack8(u[2], u[3]);
        f32x4 o[4];
#pragma unroll
        for (int mb = 0; mb < 4; ++mb) { f32x4 acc = (f32x4){0.f, 0.f, 0.f, 0.f};
#pragma unroll
            for (int ks = 0; ks < 4; ++ks) acc = __builtin_amdgcn_mfma_f32_16x16x32_bf16(*(const LAS bf16x8*)(cur + 16384 + ((mb * 4 + ks) * 64 + lane) * 16), Sb[ks], acc, 0, 0, 0);
#pragma unroll
            for (int ks2 = 0; ks2 < 2; ++ks2) if (ks2 <= (mb >> 1)) acc = __builtin_amdgcn_mfma_f32_16x16x32_bf16(*(const LAS bf16x8*)(cur + 32768 + ((mb * 2 + ks2) * 64 + lane) * 16), ub[ks2], acc, 0, 0, 0);
            o[mb] = acc; }
#pragma unroll
        for (int dkb = 0; dkb < 8; ++dkb) { f32x4 acc = S[dkb] * ge;
#pragma unroll
            for (int ks2 = 0; ks2 < 2; ++ks2) acc = __builtin_amdgcn_mfma_f32_16x16x32_bf16(*(const LAS bf16x8*)(cur + 40960 + ((dkb * 2 + ks2) * 64 + lane) * 16), ub[ks2], acc, 0, 0, 0);
            S[dkb] = acc; }
        asm volatile("s_waitcnt vmcnt(0)" ::: "memory"); __syncthreads();
        if (n + 2 < 32) SCAN_DMA(n + 2, (n & 1) * SCAN_BUF);
        float* orow = Op + (size_t)(64 * n) * GW;
#pragma unroll
        for (int mb = 0; mb < 4; ++mb) { float* q = orow + (size_t)(16 * mb) * GW; q[0] = o[mb][0]; q[GW] = o[mb][1]; q[2 * GW] = o[mb][2]; q[3 * GW] = o[mb][3]; }
    }
    asm volatile("s_waitcnt vmcnt(0)" ::: "memory"); __syncthreads();
#undef SCAN_DMA
}


__device__ __forceinline__ float xmax_fq(float x) {
    auto a = __builtin_amdgcn_permlane16_swap(__float_as_uint(x), __float_as_uint(x), false, false); x = fmaxf(__uint_as_float(a[0]), __uint_as_float(a[1]));
    auto b = __builtin_amdgcn_permlane32_swap(__float_as_uint(x), __float_as_uint(x), false, false); return fmaxf(__uint_as_float(b[0]), __uint_as_float(b[1]));
}
__device__ __forceinline__ void attn_fast(const Args& A, LAS unsigned char* lds, int lane, int wave) {
    const bf16* PROJ = (const bf16*)(A.ws + WS_PROJ); bf16* CAT = (bf16*)(A.ws + WS_CAT);
    unsigned* ctr = (unsigned*)(A.ws + WS_CTL);
    LAS bf16* Vt = (LAS bf16*)(lds + wave * 8192);
    const int fr = lane & 15, fq = lane >> 4;
    const int kk = lane & 31, vslot = 8 * ((kk & 15) >> 2) + 4 * (kk >> 4) + (kk & 3), vch = lane >> 5;
    constexpr float SC = 0.125f * 1.4426950408889634f;
    const int myx = (int)(__builtin_amdgcn_s_getreg((3 << 11) | 20) & 0x7u);
    int qi = 0;
    for (;;) {
        int wt = 256, xq = 0;
        while (qi < 8) { xq = (myx + qi) & 7; unsigned wt_ = 0; if (lane == 0) wt_ = atomicAdd(ctr + 16 * xq, 1u); wt = __builtin_amdgcn_readfirstlane(wt_); if (wt < 256) break; ++qi; }
        if (qi >= 8) break;
        const int T = 7 - (wt >> 5), b = (wt >> 2) & 7, h = xq, c0 = wt & 3, t0 = 256 * T;
        const bf16* Pb = PROJ + (size_t)b * SEQ * NP;
        const int tq0 = t0 + c0 + 16 * fr;
        bf16x8 qf0[2], qf1[2], qf2[2], qf3[2];
#pragma unroll
        for (int ks = 0; ks < 2; ++ks) { const bf16* qp = Pb + (size_t)tq0 * NP + PC_QB + h * 64 + 32 * ks + 8 * fq;
            qf0[ks] = *(const bf16x8*)qp; qf1[ks] = *(const bf16x8*)(qp + 4 * NP); qf2[ks] = *(const bf16x8*)(qp + 8 * NP); qf3[ks] = *(const bf16x8*)(qp + 12 * NP); }
        const int n2 = ((t0 + 240) >> 4) + 1, g2 = (n2 + 31) >> 5;
        const int lo1 = max(t0 + c0 - 512, c0), n1 = ((t0 + c0 + 12 + 240 - lo1) >> 2) + 1, g1 = (n1 + 31) >> 5;
        const int lo0 = max(t0 + c0 - 128, 0), n0 = (t0 + c0 + 12 + 240 - lo0) + 1, g0 = (n0 + 31) >> 5;
        const int NG = 4 * g2 + g1 + g0;
        f32x4 O0[4], O1[4], O2[4], O3[4];
#pragma unroll
        for (int i = 0; i < 4; ++i) { O0[i] = (f32x4){0.f, 0.f, 0.f, 0.f}; O1[i] = O0[i]; O2[i] = O0[i]; O3[i] = O0[i]; }
        float m0 = -INFINITY, l0 = 0.f, m1 = -INFINITY, l1 = 0.f, m2 = -INFINITY, l2 = 0.f, m3 = -INFINITY, l3 = 0.f;
        v4u kc[4], vc[4], kn[4], vn[4];
#define ATT_DEC(f, kst, str, mode) do { if ((f) < 4 * g2) { const int ci_ = (f) / g2; str = 16; kst = c0 + 4 * ci_ + 512 * ((f) - ci_ * g2); mode = 1 << ci_; } \
            else if ((f) < 4 * g2 + g1) { str = 4; kst = lo1 + 128 * ((f) - 4 * g2); mode = 15; } else { str = 1; kst = lo0 + 32 * ((f) - 4 * g2 - g1); mode = 15; } } while (0)
#define ATT_LOAD(kreg, vreg, kst, str) do { \
            _Pragma("unroll") for (int j = 0; j < 2; ++j) { const int tk = min((kst) + (str) * (16 * j + fr), SEQ - 1); \
                _Pragma("unroll") for (int ks = 0; ks < 2; ++ks) kreg[2 * j + ks] = *(const v4u*)(Pb + (size_t)tk * NP + PC_KB + h * 64 + 32 * ks + 8 * fq); } \
            { const int tk = min((kst) + (str) * kk, SEQ - 1); \
                _Pragma("unroll") for (int i = 0; i < 4; ++i) vreg[i] = *(const v4u*)(Pb + (size_t)tk * NP + PC_VB + h * 64 + 8 * (vch + 2 * i)); } } while (0)
#define ATT_CLS(O_, m_, l_, qf_, tq_) do { \
            f32x4 d0 = (f32x4){0.f, 0.f, 0.f, 0.f}, d1 = d0; \
            _Pragma("unroll") for (int ks = 0; ks < 2; ++ks) { d0 = __builtin_amdgcn_mfma_f32_16x16x32_bf16(__builtin_bit_cast(bf16x8, kc[ks]), qf_[ks], d0, 0, 0, 0); \
                                                             d1 = __builtin_amdgcn_mfma_f32_16x16x32_bf16(__builtin_bit_cast(bf16x8, kc[2 + ks]), qf_[ks], d1, 0, 0, 0); } \
            float s[8]; float mloc = -INFINITY; \
            const int dv = (((tq_) - kst) >> shl) - 4 * fq;        \
            _Pragma("unroll") for (int e2 = 0; e2 < 8; ++e2) { const float x = (e2 < 4 ? d0[e2 & 3] : d1[e2 & 3]) * SC; \
                s[e2] = ((unsigned)(dv - (16 * (e2 >> 2) + (e2 & 3))) <= 128u) ? x : -INFINITY; mloc = fmaxf(mloc, s[e2]); } \
            mloc = xmax_fq(mloc); \
            const float mnew = fmaxf(m_, mloc), alpha = __builtin_amdgcn_exp2f(m_ - mnew); m_ = mnew; \
            float psum = 0.f; \
            _Pragma("unroll") for (int e2 = 0; e2 < 8; ++e2) { s[e2] = __builtin_amdgcn_exp2f(s[e2] - mnew); psum += s[e2]; } \
            l_ = l_ * alpha + psum; \
            const bf16x8 pb = pack8((f32x4){s[0], s[1], s[2], s[3]}, (f32x4){s[4], s[5], s[6], s[7]}); \
            _Pragma("unroll") for (int db = 0; db < 4; ++db) O_[db] = __builtin_amdgcn_mfma_f32_16x16x32_bf16(va[db], pb, O_[db] * alpha, 0, 0, 0); } while (0)
        int kst, str, mode; ATT_DEC(0, kst, str, mode); ATT_LOAD(kc, vc, kst, str);
#pragma unroll 1
        for (int f = 0; f < NG; ++f) {
            int kstn = 0, strn = 1, moden = 0;
            if (f + 1 < NG) { ATT_DEC(f + 1, kstn, strn, moden); ATT_LOAD(kn, vn, kstn, strn); }
#pragma unroll
            for (int i = 0; i < 4; ++i) { const int dd = 8 * (vch + 2 * i); const v4u w = vc[i];
                Vt[(dd + 0) * 40 + vslot] = (bf16)(w.x & 0xffffu); Vt[(dd + 1) * 40 + vslot] = (bf16)(w.x >> 16); Vt[(dd + 2) * 40 + vslot] = (bf16)(w.y & 0xffffu); Vt[(dd + 3) * 40 + vslot] = (bf16)(w.y >> 16);
                Vt[(dd + 4) * 40 + vslot] = (bf16)(w.z & 0xffffu); Vt[(dd + 5) * 40 + vslot] = (bf16)(w.z >> 16); Vt[(dd + 6) * 40 + vslot] = (bf16)(w.w & 0xffffu); Vt[(dd + 7) * 40 + vslot] = (bf16)(w.w >> 16); }
            bf16x8 va[4];
#pragma unroll
            for (int db = 0; db < 4; ++db) va[db] = *(const LAS bf16x8*)(Vt + (16 * db + fr) * 40 + 8 * fq);
            const int shl = (str == 16) ? 4 : (str == 4 ? 2 : 0);
            if (mode & 1) ATT_CLS(O0, m0, l0, qf0, tq0);
            if (mode & 2) ATT_CLS(O1, m1, l1, qf1, tq0 + 4);
            if (mode & 4) ATT_CLS(O2, m2, l2, qf2, tq0 + 8);
            if (mode & 8) ATT_CLS(O3, m3, l3, qf3, tq0 + 12);
#pragma unroll
            for (int i = 0; i < 4; ++i) { kc[i] = kn[i]; vc[i] = vn[i]; }
            kst = kstn; str = strn; mode = moden;
        }
#undef ATT_DEC
#undef ATT_LOAD
#undef ATT_CLS
        bf16* op = CAT + ((size_t)b * SEQ + tq0) * DM + GW + h * 64 + 4 * fq;
#define ATT_OUT(O_, l_, ci_) do { float lt = l_; lt += __shfl_xor(lt, 16); lt += __shfl_xor(lt, 32); const float inv = 1.0f / lt; \
            _Pragma("unroll") for (int db = 0; db < 4; ++db) { v2u w; w.x = pk2(O_[db][0] * inv, O_[db][1] * inv); w.y = pk2(O_[db][2] * inv, O_[db][3] * inv); *(v2u*)(op + (ci_) * 4 * DM + 16 * db) = w; } } while (0)
        ATT_OUT(O0, l0, 0); ATT_OUT(O1, l1, 1); ATT_OUT(O2, l2, 2); ATT_OUT(O3, l3, 3);
#undef ATT_OUT
    }
}

__device__ __forceinline__ void attn_simple(const Args& A, int tid, int lane, int wave) {
    const bf16* PROJ = (const bf16*)(A.ws + WS_PROJ); bf16* CAT = (bf16*)(A.ws + WS_CAT);
    unsigned* ctr = (unsigned*)(A.ws + WS_CTL);
    for (;;) {
        unsigned wt_ = 0; if (lane == 0) wt_ = atomicAdd(ctr, 1u); const int wt = __builtin_amdgcn_readfirstlane(wt_);
        if (wt >= (M / 64) * AH) break;
        const int h = wt % AH, tb = wt / AH, row = tb * 64 + lane, b = row / SEQ, t = row % SEQ;
        float q[64], acc[64];
        { const v4u* qp = (const v4u*)(PROJ + (size_t)row * NP + PC_QB + h * 64);
#pragma unroll
          for (int j = 0; j < 8; ++j) { const v4u w = qp[j]; q[8 * j + 0] = bflo(w.x) * 0.125f; q[8 * j + 1] = bfhi(w.x) * 0.125f; q[8 * j + 2] = bflo(w.y) * 0.125f; q[8 * j + 3] = bfhi(w.y) * 0.125f;
              q[8 * j + 4] = bflo(w.z) * 0.125f; q[8 * j + 5] = bfhi(w.z) * 0.125f; q[8 * j + 6] = bflo(w.w) * 0.125f; q[8 * j + 7] = bfhi(w.w) * 0.125f; } }
#pragma unroll
        for (int j = 0; j < 64; ++j) acc[j] = 0.f;
        float mx = -1e30f, l = 0.f;
        for (int br = 0; br < 3; ++br) {
            const int stride = br == 0 ? 1 : (br == 1 ? 4 : 16);
            for (int i = 0; i <= 128; ++i) {
                const int tk = t - i * stride; if (tk < 0) break;
                const size_t krow = (size_t)(b * SEQ + tk) * NP;
                const v4u* kp = (const v4u*)(PROJ + krow + PC_KB + h * 64); const v4u* vp = (const v4u*)(PROJ + krow + PC_VB + h * 64);
                float s = 0.f;
#pragma unroll
                for (int j = 0; j < 8; ++j) { const v4u w = kp[j]; s += q[8 * j + 0] * bflo(w.x) + q[8 * j + 1] * bfhi(w.x) + q[8 * j + 2] * bflo(w.y) + q[8 * j + 3] * bfhi(w.y)
                                                                       + q[8 * j + 4] * bflo(w.z) + q[8 * j + 5] * bfhi(w.z) + q[8 * j + 6] * bflo(w.w) + q[8 * j + 7] * bfhi(w.w); }
                const float mn = fmaxf(mx, s), sc = __expf(mx - mn), p = __expf(s - mn); mx = mn; l = l * sc + p;
#pragma unroll
                for (int j = 0; j < 8; ++j) { const v4u w = vp[j];
                    acc[8 * j + 0] = acc[8 * j + 0] * sc + p * bflo(w.x); acc[8 * j + 1] = acc[8 * j + 1] * sc + p * bfhi(w.x); acc[8 * j + 2] = acc[8 * j + 2] * sc + p * bflo(w.y); acc[8 * j + 3] = acc[8 * j + 3] * sc + p * bfhi(w.y);
                    acc[8 * j + 4] = acc[8 * j + 4] * sc + p * bflo(w.z); acc[8 * j + 5] = acc[8 * j + 5] * sc + p * bfhi(w.z); acc[8 * j + 6] = acc[8 * j + 6] * sc + p * bflo(w.w); acc[8 * j + 7] = acc[8 * j + 7] * sc + p * bfhi(w.w); }
            }
        }
        const float inv = 1.0f / l; v4u* op = (v4u*)(CAT + (size_t)row * DM + GW + h * 64);
#pragma unroll
        for (int j = 0; j < 8; ++j) { v4u w; w.x = pk2(acc[8 * j] * inv, acc[8 * j + 1] * inv); w.y = pk2(acc[8 * j + 2] * inv, acc[8 * j + 3] * inv); w.z = pk2(acc[8 * j + 4] * inv, acc[8 * j + 5] * inv); w.w = pk2(acc[8 * j + 6] * inv, acc[8 * j + 7] * inv); op[j] = w; }
    }
}
__device__ __forceinline__ void gated_norm(const Args& A, int lane, int wave) {
    const bf16* PROJ = (const bf16*)(A.ws + WS_PROJ); bf16* CAT = (bf16*)(A.ws + WS_CAT); const float* OA = (const float*)(A.ws + WS_OA); const float* gw = A.in[6];
    const float w0 = gw[2 * lane], w1 = gw[2 * lane + 1];
    const int gwv = blockIdx.x * NWAVES + wave, NGW = gridDim.x * NWAVES;
    for (int wt0 = gwv; wt0 < M * GH; wt0 += 8 * NGW) {
        float2 o[8]; unsigned zz[8];
#pragma unroll
        for (int i = 0; i < 8; ++i) { const int wt = min(wt0 + i * NGW, M * GH - 1), row = wt / GH, h = wt % GH;
            o[i] = *(const float2*)(OA + (size_t)row * GW + h * 128 + 2 * lane); zz[i] = *(const unsigned*)(PROJ + (size_t)row * NP + PC_Z + h * 128 + 2 * lane); }
#pragma unroll
        for (int i = 0; i < 8; ++i) { const int wt = wt0 + i * NGW; if (wt >= M * GH) break; const int row = wt / GH, h = wt % GH;
            const float ms = wave_sum(o[i].x * o[i].x + o[i].y * o[i].y) * (1.0f / 128.0f), r = rsqrtf(ms + RMS_EPS);
            *(unsigned*)(CAT + (size_t)row * DM + h * 128 + 2 * lane) = pk2(o[i].x * r * w0 * silu_f(bflo(zz[i])), o[i].y * r * w1 * silu_f(bfhi(zz[i]))); }
    }
}

__device__ __forceinline__ void gated_norm_bh(const Args& A, int bh, int lane, int wave) {
    const int b = bh >> 2, h = bh & 3;
    const bf16* Zp = (const bf16*)(A.ws + WS_PROJ) + (size_t)b * SEQ * NP + PC_Z + h * 128 + 2 * lane; bf16* Cp = (bf16*)(A.ws + WS_CAT) + (size_t)b * SEQ * DM + h * 128 + 2 * lane;
    const float* Op = (const float*)(A.ws + WS_OA) + (size_t)b * SEQ * GW + h * 128 + 2 * lane; const float* gw = A.in[6];
    const float w0 = gw[2 * lane], w1 = gw[2 * lane + 1];
    __builtin_amdgcn_fence(__ATOMIC_ACQUIRE, "agent");
#pragma unroll 1
    for (int r0 = wave * 16; r0 < SEQ; r0 += NWAVES * 16) {
        float2 o[16]; unsigned zz[16];
#pragma unroll
        for (int i = 0; i < 16; ++i) { o[i] = *(const float2*)(Op + (size_t)(r0 + i) * GW); zz[i] = *(const unsigned*)(Zp + (size_t)(r0 + i) * NP); }
#pragma unroll
        for (int i = 0; i < 16; ++i) { const float ms = wave_sum(o[i].x * o[i].x + o[i].y * o[i].y) * (1.0f / 128.0f), r = rsqrtf(ms + RMS_EPS);
            *(unsigned*)(Cp + (size_t)(r0 + i) * DM) = pk2(o[i].x * r * w0 * silu_f(bflo(zz[i])), o[i].y * r * w1 * silu_f(bfhi(zz[i]))); }
    }
}
__device__ __forceinline__ void ffn_conv_half(const Args& A, int half, int tid) {
    const bf16* Y = (const bf16*)(A.ws + WS_Y); bf16* ACT = (bf16*)(A.ws + WS_ACT); const float* fw = A.in[10];
    constexpr int HC = DFF / 2;
    for (size_t it = (size_t)blockIdx.x * NTHR + tid; it < (size_t)M * (HC / 8); it += (size_t)gridDim.x * NTHR) {
        const int row = (int)(it / (HC / 8)), g8 = (int)(it % (HC / 8)), cl = g8 * 8, pn = cl >> 7, j = cl & 127, t = row % SEQ, ch = half * HC + cl;
        float ga[8], ua[8];
#pragma unroll
        for (int e = 0; e < 8; ++e) { ga[e] = 0.f; ua[e] = 0.f; }
#pragma unroll
        for (int i = 0; i < 3; ++i) { const int ts = t - 2 + i; if (ts < 0) continue;
            const bf16* yr = Y + (size_t)(row - 2 + i) * DFF + 256 * pn + j; const v4u g = *(const v4u*)yr, u = *(const v4u*)(yr + 128);
            const f32x4 wg0 = *(const f32x4*)(fw + i * NUP + ch), wg1 = *(const f32x4*)(fw + i * NUP + ch + 4), wu0 = *(const f32x4*)(fw + i * NUP + DFF + ch), wu1 = *(const f32x4*)(fw + i * NUP + DFF + ch + 4);
            ga[0] += wg0.x * bflo(g.x); ga[1] += wg0.y * bfhi(g.x); ga[2] += wg0.z * bflo(g.y); ga[3] += wg0.w * bfhi(g.y); ga[4] += wg1.x * bflo(g.z); ga[5] += wg1.y * bfhi(g.z); ga[6] += wg1.z * bflo(g.w); ga[7] += wg1.w * bfhi(g.w);
            ua[0] += wu0.x * bflo(u.x); ua[1] += wu0.y * bfhi(u.x); ua[2] += wu0.z * bflo(u.y); ua[3] += wu0.w * bfhi(u.y); ua[4] += wu1.x * bflo(u.z); ua[5] += wu1.y * bfhi(u.z); ua[6] += wu1.z * bflo(u.w); ua[7] += wu1.w * bfhi(u.w); }
        v4u o; o.x = pk2(silu_f(ga[0]) * ua[0], silu_f(ga[1]) * ua[1]); o.y = pk2(silu_f(ga[2]) * ua[2], silu_f(ga[3]) * ua[3]); o.z = pk2(silu_f(ga[4]) * ua[4], silu_f(ga[5]) * ua[5]); o.w = pk2(silu_f(ga[6]) * ua[6], silu_f(ga[7]) * ua[7]);
        *(v4u*)(ACT + (size_t)row * DFF + ch) = o;
    }
}

__device__ __forceinline__ void ffn_fixup(const Args& A, int tid) {
    const float* YH = (const float*)(A.ws + WS_YH); const float* UP = (const float*)(A.ws + WS_UPART); bf16* ACT = (bf16*)(A.ws + WS_ACT); const float* fw = A.in[10];
    for (int it = blockIdx.x * NTHR + tid; it < 64 * 22 * 2 * 128; it += gridDim.x * NTHR) {
        const int c = it & 127, r = (it >> 7) & 1, tile = it >> 8, pm = tile / 22, pn = tile % 22; if ((pm & 7) == 0) continue;
        const int ch = pn * 128 + c; const float* up = UP + ((size_t)tile * 2 + r) * 256; const float* yh = YH + (size_t)((pm - 1) * 22 + pn) * 2 * 256;
        float g = up[c], u = up[128 + c];
        const float wg0 = fw[ch], wg1 = fw[5632 + ch], wu0 = fw[2816 + ch], wu1 = fw[5632 + 2816 + ch];
        if (r == 0) { g += wg0 * yh[c] + wg1 * yh[256 + c]; u += wu0 * yh[128 + c] + wu1 * yh[256 + 128 + c]; }
        else { g += wg0 * yh[256 + c]; u += wu0 * yh[256 + 128 + c]; }
        ACT[(size_t)(pm * 256 + r) * DFF + ch] = (bf16)(pk2(silu_f(g) * u, 0.f) & 0xffffu);
    }
}
__device__ __forceinline__ void final_norm(const Args& A, int lane, int wave) {
    float* out = A.out; const f32x4* nr = (const f32x4*)A.in[12] + lane;
    const int gw = blockIdx.x * NWAVES + wave, NGW = gridDim.x * NWAVES;
    f32x4 nw[4];
#pragma unroll
    for (int j = 0; j < 4; ++j) nw[j] = nr[64 * j];
    for (int m0 = gw; m0 < M; m0 += 4 * NGW) {
        f32x4 v[4][4];
#pragma unroll
        for (int rr = 0; rr < 4; ++rr) { const int m = min(m0 + rr * NGW, M - 1); const f32x4* xr = (const f32x4*)(out + (size_t)m * DM) + lane;
#pragma unroll
            for (int j = 0; j < 4; ++j) v[rr][j] = xr[64 * j]; }
#pragma unroll
        for (int rr = 0; rr < 4; ++rr) { const int m = m0 + rr * NGW; if (m >= M) break; float s = 0.f;
#pragma unroll
            for (int j = 0; j < 4; ++j) s += (v[rr][j].x * v[rr][j].x + v[rr][j].y * v[rr][j].y) + (v[rr][j].z * v[rr][j].z + v[rr][j].w * v[rr][j].w);
            const float rstd = rsqrtf(wave_sum(s) * (1.f / DM) + RMS_EPS); f32x4* xw = (f32x4*)(out + (size_t)m * DM) + lane;
#pragma unroll
            for (int j = 0; j < 4; ++j) xw[64 * j] = (f32x4){v[rr][j].x * rstd * nw[j].x, v[rr][j].y * rstd * nw[j].y, v[rr][j].z * rstd * nw[j].z, v[rr][j].w * rstd * nw[j].w}; }
    }
}

#define XB_TMO      128
#define XB_XCNT(j)  (256  + 64 * (j))
#define XB_XSUB(j)  (1280 + 64 * (j))
#define XB_XGEN(j)  (2304 + 64 * (j))
#define XB_TOP      3328
#define XB_TOPGEN   3392
#define XCD_BAR_WORDS 3456
#define XB_SPIN_CAP (1u << 18)

__device__ __forceinline__ unsigned xb_ld(unsigned* p)              { return __hip_atomic_load(p, __ATOMIC_RELAXED, __HIP_MEMORY_SCOPE_AGENT); }
__device__ __forceinline__ unsigned xb_add(unsigned* p, unsigned v) { return __hip_atomic_fetch_add(p, v, __ATOMIC_RELAXED, __HIP_MEMORY_SCOPE_AGENT); }
__device__ __forceinline__ unsigned xb_xcc_id() { return (unsigned)__builtin_amdgcn_s_getreg((3 << 11) | 20) & 0xFu; }
#define XB_SPIN(cond, bar) do { unsigned _sp = 0; while (cond) { __builtin_amdgcn_s_sleep(1); \
    if ((++_sp & 255u) == 0u) { if (xb_ld(&(bar)[XB_TMO])) break; if (_sp > XB_SPIN_CAP) { atomicAdd(&(bar)[XB_TMO], 1u); break; } } } } while (0)

struct XcdBarrier {
    unsigned* bar; unsigned x;
    volatile LAS unsigned* st;
};

__device__ __forceinline__ XcdBarrier xcd_barrier_post(unsigned* bar, volatile LAS unsigned* st) {
    XcdBarrier b; b.bar = bar; b.x = xb_xcc_id(); b.st = st;
    if (threadIdx.x == 0) (void)xb_add(&bar[XB_XCNT(b.x)], 1u);
    return b;
}
__device__ __forceinline__ void xcd_barrier_complete(unsigned* bar, unsigned x, unsigned& nloc, unsigned& nx) {
    const unsigned G = gridDim.x * gridDim.y * gridDim.z;
    unsigned sum, cnt, mine, sp = 0u;
    for (;;) {
        sum = 0u; cnt = 0u; mine = 0u;
#pragma unroll
        for (unsigned j = 0; j < 16; ++j) { const unsigned c = xb_ld(&bar[XB_XCNT(j)]); sum += c; cnt += (c > 0u) ? 1u : 0u; mine = (j == x) ? c : mine; }
        if (sum == G) break;
        __builtin_amdgcn_s_sleep(1);
        if ((++sp & 255u) == 0u) { if (xb_ld(&bar[XB_TMO])) break; if (sp > XB_SPIN_CAP) { atomicAdd(&bar[XB_TMO], 1u); break; } }
    }
    nloc = mine > 0u ? mine : 1u; nx = cnt > 0u ? cnt : 1u;
}

__device__ __forceinline__ void xcd_barrier(const XcdBarrier& b) {
    asm volatile("s_waitcnt vmcnt(0)" ::: "memory");
    __syncthreads();
    if (threadIdx.x == 0) {
        unsigned* bar = b.bar;
        __builtin_amdgcn_s_waitcnt(0);
        unsigned nloc = b.st[0], nx = b.st[1];
        if (nloc == 0u) { xcd_barrier_complete(bar, b.x, nloc, nx); b.st[0] = nloc; b.st[1] = nx; }
        const unsigned old = xb_add(&bar[XB_XSUB(b.x)], 1u);
        const unsigned gen = old / nloc;
        if (old + 1u == (gen + 1u) * nloc) {
            __builtin_amdgcn_fence(__ATOMIC_RELEASE, "agent");
            asm volatile("s_waitcnt vmcnt(0)" ::: "memory");
            const unsigned og = xb_add(&bar[XB_TOP], 1u);
            const unsigned tg = og / nx;
            if (og + 1u == (tg + 1u) * nx) xb_add(&bar[XB_TOPGEN], 1u);
            else XB_SPIN(xb_ld(&bar[XB_TOPGEN]) == tg, bar);
            __builtin_amdgcn_fence(__ATOMIC_ACQUIRE, "agent");
            xb_add(&bar[XB_XGEN(b.x)], 1u);
            asm volatile("s_waitcnt vmcnt(0)" ::: "memory");
        } else {
            XB_SPIN(xb_ld(&bar[XB_XGEN(b.x)]) == gen, bar);
            __builtin_amdgcn_fence(__ATOMIC_ACQUIRE, "agent");
            asm volatile("s_waitcnt vmcnt(0)" ::: "memory");
        }
    }
    __syncthreads();
}

constexpr int N_PHASES = 8;
__global__ void __launch_bounds__(NTHR, 2) mk_fwd(Args args) {
    extern __shared__ __attribute__((aligned(16))) unsigned char lds_raw[];
    LAS unsigned char* lds = (LAS unsigned char*)lds_raw;
    const int tid = threadIdx.x, lane = tid & 63, wave = __builtin_amdgcn_readfirstlane(tid >> 6);
    const int lo = args.ph_lo, hi = args.ph_hi;
    unsigned char* ws = args.ws;
    bf16* WIN = (bf16*)(ws + WS_WIN); bf16* WOUT = (bf16*)(ws + WS_WOUT); bf16* WUP = (bf16*)(ws + WS_WUP); bf16* WDN = (bf16*)(ws + WS_WDN);
    bf16* XN = (bf16*)(ws + WS_XN); bf16* PROJ = (bf16*)(ws + WS_PROJ); bf16* CAT = (bf16*)(ws + WS_CAT); bf16* Y = (bf16*)(ws + WS_Y); bf16* ACT = (bf16*)(ws + WS_ACT);
    float* SSQ = (float*)(ws + WS_SSQ);
#define IN(k) (lo <= (k) && (k) < hi)
#define SEAM(k) do { if (IN(k) && IN((k) + 1)) { xcd_barrier(bar); } } while (0)
    { volatile LAS unsigned* st = (volatile LAS unsigned*)(lds + LDS_BYTES - 64); if (tid < 2) st[tid] = 0u; }
    __syncthreads();
    XcdBarrier bar = xcd_barrier_post((unsigned*)(ws + WS_CTL) + 4096, (volatile LAS unsigned*)(lds + LDS_BYTES - 64));
    if (args.coop > 1) cg::this_grid().sync();
    if (IN(0)) { p0_prologue(args, lds, tid, lane, wave); } SEAM(0);
    if (IN(1)) { pg8::Gemm g{XN, WIN, M, NP, DM}; pg8::StaticOrder S; S.init(M, NP, gridDim.x, blockIdx.x); pg8::EpiBf16S E{PROJ, NP, nullptr};
        pg8::gemm_phase<pg8::EpiBf16S, pg8::StaticOrder, PG8_ALIGN, PG8_SP2>(lds, g, S, E);
        { pg8::Unit u4; const bool idle4 = !S.next(3, u4); const int G = gridDim.x, nidle = (G == 256) ? 128 : G;
          if (G != 256) convert_late_weights(args, lds, lane, wave, blockIdx.x * NWAVES + wave, G * NWAVES);
          else if (idle4) convert_late_weights(args, lds, lane, wave, (blockIdx.x - 128) * NWAVES + wave, nidle * NWAVES); } } SEAM(1);
    if (IN(2)) { gdn_prep(args, lds, tid, lane, wave); } SEAM(2);
    if (IN(3)) { if (blockIdx.x < NB * GH) gdn_scan(args, lds, blockIdx.x, tid, lane, wave); attn_fast(args, lds, lane, wave); xcd_barrier(bar); gated_norm(args, lane, wave); } SEAM(3);
    if (IN(4)) { pg8::Gemm g{CAT, WOUT, M, DM, DM}; pg8::StaticOrder S; S.init(M, DM, gridDim.x, blockIdx.x); pg8::EpiResid E{args.in[0], (gridDim.x == 256) ? nullptr : args.out, XN, SSQ, DM};
        pg8::gemm_phase<pg8::EpiResid, pg8::StaticOrder, PG8_ALIGN, PG8_SP2>(lds, g, S, E); } SEAM(4);
    if (IN(5)) { pg8::Gemm g{XN, WUP, M, NUP, DM}; pg8::StaticOrder S; S.init(M, NUP, gridDim.x, blockIdx.x);
        static_assert(pg8::EpiConvGate::CG_SSQ == WS_SSQ && pg8::EpiConvGate::CG_ACT == WS_ACT && pg8::EpiConvGate::CG_YH == WS_YH && pg8::EpiConvGate::CG_UPART == WS_UPART, "d_ws map");
        pg8::EpiConvGate E{ws, args.in[10], lds};
        pg8::gemm_phase<pg8::EpiConvGate, pg8::StaticOrder, true, PG8_SP2>(lds, g, S, E); } SEAM(5);
    if (IN(6)) { ffn_fixup(args, tid); } SEAM(6);
    if (IN(7)) { pg8::Gemm g{ACT, WDN, M, DM, DFF}; pg8::StaticOrder S; S.init(M, DM, gridDim.x, blockIdx.x);
        if (gridDim.x == 256) {
            pg8::EpiResidNorm E{XN, args.out, (float*)(ws + WS_SSQ2), (unsigned*)(ws + WS_CTL) + 2048, args.in[12], DM};
            pg8::gemm_phase<pg8::EpiResidNorm, pg8::StaticOrder, true, PG8_SP2>(lds, g, S, E);
        } else {
            pg8::EpiResid E{args.out, args.out, nullptr, nullptr, DM};
            pg8::gemm_phase<pg8::EpiResid, pg8::StaticOrder, PG8_ALIGN, PG8_SP2>(lds, g, S, E);
            xcd_barrier(bar); final_norm(args, lane, wave);
        } }
#undef IN
#undef SEAM
}

#ifndef MK_ONE_LAUNCH
#define MK_ONE_LAUNCH 1
#endif
extern "C" void kernel_launch(void* const* d_in, const int* in_sizes, int n_in, void* d_out, int out_size, void* d_ws, size_t ws_size, hipStream_t stream) {
    static int grid = 0;
    if (grid == 0) {
        if (n_in != 13 || out_size != M * DM || ws_size < WS_END) { fprintf(stderr, "kernel_launch: unexpected shapes n_in %d out %d ws %zu\n", n_in, out_size, ws_size); grid = -1; return; }
        int dev = 0, cus = 0, per_cu = 0;
        hipGetDevice(&dev); hipDeviceGetAttribute(&cus, hipDeviceAttributeMultiprocessorCount, dev);
        hipFuncSetAttribute((const void*)mk_fwd, hipFuncAttributeMaxDynamicSharedMemorySize, LDS_BYTES);
        hipOccupancyMaxActiveBlocksPerMultiprocessor(&per_cu, (const void*)mk_fwd, NTHR, LDS_BYTES);
        (void)hipGetLastError();
        if (per_cu < 1) { fprintf(stderr, "kernel_launch: occupancy query says %d blocks per CU\n", per_cu); per_cu = 1; }
        grid = cus;
    }
    if (grid < 0) return;
    if (hipMemsetAsync((char*)d_ws + WS_CTL, 0, 65536, stream) != hipSuccess) { fprintf(stderr, "kernel_launch: memset failed\n"); return; }
    Args a{};
    for (int i = 0; i < 13; ++i) a.in[i] = (const float*)d_in[i];
    a.out = (float*)d_out; a.ws = (unsigned char*)d_ws;
#if MK_ONE_LAUNCH
    a.ph_lo = 0; a.ph_hi = N_PHASES; a.coop = 1;
    void* kargs[] = {&a};
    hipError_t e = hipLaunchCooperativeKernel((const void*)mk_fwd, dim3(grid), dim3(NTHR), kargs, LDS_BYTES, stream);
    if (e != hipSuccess) fprintf(stderr, "cooperative launch failed: %s (grid %d)\n", hipGetErrorString(e), grid);
#else
    for (int p = 0; p < N_PHASES; ++p) { a.ph_lo = p; a.ph_hi = p + 1; a.coop = 0; hipLaunchKernelGGL(mk_fwd, dim3(grid), dim3(NTHR), LDS_BYTES, stream, a); }
#endif
}
```

```cpp
#include <hip/hip_runtime.h>
#include <hip/hip_cooperative_groups.h>
#include <cstdio>
#include <cstdint>
namespace cg = cooperative_groups;
namespace pg8 {
#define PG8_LAS __attribute__((address_space(3)))
typedef unsigned short bf16_t;
typedef short bf16x8 __attribute__((ext_vector_type(8)));
typedef float f32x4 __attribute__((ext_vector_type(4)));
typedef unsigned u32x4 __attribute__((ext_vector_type(4)));
constexpr int BM = 256, BK = 64, HALF = 128, HTB = HALF * BK * 2  , STAGE_BYTES = 8 * HTB, NXCD = 8, WGM = 8;

__host__ __device__ __forceinline__ int lds_byte(int r, int c) { const int st = (r >> 4) * 2 + (c >> 5), rr = r & 15, cc = c & 31, ob = rr * 64 + cc * 2; return st * 1024 + (ob ^ (((ob >> 9) & 1) << 5)); }
__host__ __device__ __forceinline__ void stage_rc(int b, int& R, int& C) { const int st = b / 1024, sb = b % 1024, swz = sb ^ (((sb >> 9) & 1) << 5); R = (st >> 1) * 16 + swz / 64; C = (st & 1) * 32 + (swz % 64) / 2; }
__host__ __device__ __forceinline__ int perm32(int rho) { const int n = rho >> 4, i = rho & 15; return 8 * (i >> 2) + 4 * n + (i & 3); }

struct Unit { int pm, pn; };
struct Gemm { const bf16_t* A; const bf16_t* Bt; int M, N, K; };

struct StaticOrder {
    int nM, nN, nwg, G, c;
    __host__ __device__ __forceinline__ void init(int M, int N, int G_, int c_) { nM = M / BM; nN = N / BM; nwg = nM * nN; G = G_; c = c_; }
    __host__ __device__ __forceinline__ bool next(int i, Unit& u) const {
        const long L = (long)i * G + c; if (L >= nwg) return false;
        int wgid = (int)L; { const int q = nwg / NXCD, r = nwg % NXCD, xcd = wgid % NXCD, off = wgid / NXCD; wgid = (xcd < r ? xcd * (q + 1) : r * (q + 1) + (xcd - r) * q) + off; }
        const int nig = WGM * nN, gid = wgid / nig, fm = gid * WGM, gsz = (nM - fm) < WGM ? (nM - fm) : WGM;
        u.pm = fm + ((wgid % nig) % gsz); u.pn = (wgid % nig) / gsz; return true;
    }
    __device__ __forceinline__ void a_ready(const Unit&) const {}
    __device__ __forceinline__ void done(const Unit&) const {}
};

__device__ __forceinline__ unsigned cvt_pk_bf16(float lo, float hi) { unsigned r; asm volatile("v_cvt_pk_bf16_f32 %0, %1, %2" : "=v"(r) : "v"(lo), "v"(hi)); return r; }
constexpr float RMS_EPS = 1e-6f;
struct EpiBf16S {
    static constexpr bool PERM = true, AFTER_DRAIN = false;
    bf16_t* O; int ldc; const float* ssq;
    __device__ __forceinline__ void operator()(const f32x4 (&acc)[2][2][4][2], const Unit& u, int wr, int wc, int fr, int fq) const {
        const int row0 = u.pm * BM + wr * 64 + fr; const int col0 = u.pn * BM + wc * 32 + 8 * fq;
#pragma unroll
        for (int ai = 0; ai < 2; ++ai)
#pragma unroll
            for (int m = 0; m < 4; ++m) { const int row = row0 + ai * HALF + m * 16; bf16_t* rowp = O + (size_t)row * ldc + col0;
                const float sc = ssq ? rsqrtf(ssq[row] * (1.0f / 1024.0f) + RMS_EPS) : 1.0f;
#pragma unroll
                for (int bj = 0; bj < 2; ++bj) { const f32x4 v0 = acc[ai][bj][m][0] * sc, v1 = acc[ai][bj][m][1] * sc;
                    u32x4 w; w.x = cvt_pk_bf16(v0[0], v0[1]); w.y = cvt_pk_bf16(v0[2], v0[3]); w.z = cvt_pk_bf16(v1[0], v1[1]); w.w = cvt_pk_bf16(v1[2], v1[3]);
                    *(u32x4*)(rowp + bj * HALF) = w; } }
    }
};
struct EpiResid {
    static constexpr bool PERM = false, AFTER_DRAIN = false;
    const float* base; float* out; bf16_t* xb; float* ssq; int ldc;
    __device__ __forceinline__ void operator()(const f32x4 (&acc)[2][2][4][2], const Unit& u, int wr, int wc, int fr, int fq) const {
        typedef unsigned u32x2v __attribute__((ext_vector_type(2)));
        const int col0 = u.pn * BM + wc * 32 + 4 * fq;
#pragma unroll
        for (int ai = 0; ai < 2; ++ai) {
            f32x4 bv[4][2][2];
#pragma unroll
            for (int m = 0; m < 4; ++m) { const size_t off = (size_t)(u.pm * BM + ai * HALF + wr * 64 + m * 16 + fr) * ldc + col0;
#pragma unroll
                for (int bj = 0; bj < 2; ++bj)
#pragma unroll
                    for (int n = 0; n < 2; ++n) bv[m][bj][n] = *(const f32x4*)(base + off + bj * HALF + n * 16); }
#pragma unroll
            for (int m = 0; m < 4; ++m) { const int row = u.pm * BM + ai * HALF + wr * 64 + m * 16 + fr; const size_t off = (size_t)row * ldc + col0; float s = 0.f;
#pragma unroll
                for (int bj = 0; bj < 2; ++bj)
#pragma unroll
                    for (int n = 0; n < 2; ++n) { const f32x4 v = acc[ai][bj][m][n] + bv[m][bj][n];
                        if (out) *(f32x4*)(out + off + bj * HALF + n * 16) = v; s += (v[0] * v[0] + v[1] * v[1]) + (v[2] * v[2] + v[3] * v[3]);
                        if (xb) { u32x2v w; w.x = cvt_pk_bf16(v[0], v[1]); w.y = cvt_pk_bf16(v[2], v[3]); *(u32x2v*)(xb + off + bj * HALF + n * 16) = w; } }
                if (ssq) { s += __shfl_xor(s, 16); s += __shfl_xor(s, 32); if (fq == 0) atomicAdd(ssq + row, s); } }
            asm volatile("" ::: "memory");
        }
    }
};

__device__ __forceinline__ float dpp_ror1(float v) { return __builtin_bit_cast(float, __builtin_amdgcn_mov_dpp(__builtin_bit_cast(int, v), 0x121, 0xf, 0xf, true)); }
__device__ __forceinline__ float dpp_ror2(float v) { return __builtin_bit_cast(float, __builtin_amdgcn_mov_dpp(__builtin_bit_cast(int, v), 0x122, 0xf, 0xf, true)); }
struct EpiConvGate {
    static constexpr bool PERM = true, AFTER_DRAIN = false;
    static constexpr size_t CG_SSQ = (1u << 20) + 768 * 1024, CG_ACT = (size_t)148 << 20, CG_YH = (size_t)236 << 20, CG_UPART = (size_t)240 << 20;
    unsigned char* ws; const float* fw; PG8_LAS unsigned char* ldsb;
    __device__ __forceinline__ void operator()(f32x4 (&acc)[2][2][4][2], const Unit& u, int wr, int wc, int fr0, int fq0) const {
        int fr = fr0, fq = fq0; asm volatile("" : "+v"(fr), "+v"(fq));
        bf16_t* ACT = (bf16_t*)(ws + CG_ACT); const float* ssq = (const float*)(ws + CG_SSQ); float* YH = (float*)(ws + CG_YH); float* UPART = (float*)(ws + CG_UPART);
        PG8_LAS float* halo = (PG8_LAS float*)(ldsb + STAGE_BYTES);
        int cl = wc * 32 + 8 * fq;
        int ch = u.pn * 128 + cl;
        if (fr >= 14) {
#pragma unroll
            for (int ai = 0; ai < 2; ++ai) { const float sc = rsqrtf(ssq[u.pm * BM + ai * HALF + wr * 64 + 48 + fr] * (1.0f / 1024.0f) + RMS_EPS);
#pragma unroll
                for (int bj = 0; bj < 2; ++bj)
#pragma unroll
                    for (int n = 0; n < 2; ++n) { const f32x4 v = acc[ai][bj][3][n] * sc; *(PG8_LAS f32x4*)(halo + (((wr * 2 + ai) * 2 + (fr - 14)) * 256 + bj * 128 + cl + 4 * n)) = v;
                        if (ai == 1 && wr == 1) *(f32x4*)(YH + ((size_t)(u.pm * 22 + u.pn) * 2 + (fr - 14)) * 256 + bj * 128 + cl + 4 * n) = v; } }
        }
        asm volatile("s_waitcnt lgkmcnt(0)" ::: "memory"); __builtin_amdgcn_s_barrier(); asm volatile("" ::: "memory");
        typedef unsigned u32x2v __attribute__((ext_vector_type(2)));
#pragma unroll 1
        for (int n = 0; n < 2; ++n) {
            asm volatile("" : "+v"(fr), "+v"(fq));
            cl = wc * 32 + 8 * fq; ch = u.pn * 128 + cl;
            f32x4 w[3][2];
#pragma unroll
            for (int i = 0; i < 3; ++i)
#pragma unroll
                for (int bj = 0; bj < 2; ++bj) w[i][bj] = *(const f32x4*)(fw + (size_t)i * 5632 + bj * 2816 + ch + 4 * n);
#pragma unroll
            for (int ai = 0; ai < 2; ++ai) {
                const bool top = (ai == 0 && wr == 0);
                const int pblk = (ai == 0) ? 0 : (wr == 0 ? 2 : 1);
                f32x4 q1[2], q2[2];
#pragma unroll
                for (int bj = 0; bj < 2; ++bj) { const f32x4 pv = top ? (f32x4){0.f, 0.f, 0.f, 0.f} : *(const PG8_LAS f32x4*)(halo + ((pblk * 2 + (fr & 1)) * 256 + bj * 128 + cl + 4 * n));
#pragma unroll
                    for (int k = 0; k < 4; ++k) { q1[bj][k] = dpp_ror1(pv[k]); q2[bj][k] = dpp_ror2(pv[k]); } }
#pragma unroll
                for (int m = 0; m < 4; ++m) {
                    const int row = u.pm * BM + ai * HALF + wr * 64 + m * 16 + fr; const float sc = rsqrtf(ssq[row] * (1.0f / 1024.0f) + RMS_EPS);
                    f32x4 cu[2];
#pragma unroll
                    for (int bj = 0; bj < 2; ++bj) { const f32x4 ya = acc[ai][bj][m][0];
#pragma unroll
                        for (int k = 0; k < 4; ++k) { const float y = ya[k] * sc;
                            const float a1 = dpp_ror1(y), a2 = dpp_ror2(y);
                            const float p1 = (fr == 0) ? q1[bj][k] : a1, p2 = (fr < 2) ? q2[bj][k] : a2;
                            cu[bj][k] = w[2][bj][k] * y + w[1][bj][k] * p1 + w[0][bj][k] * p2; q1[bj][k] = a1; q2[bj][k] = a2; } }
                    if (top && m == 0 && fr < 2 && (u.pm & 7) != 0) {
#pragma unroll
                        for (int bj = 0; bj < 2; ++bj) *(f32x4*)(UPART + ((size_t)(u.pm * 22 + u.pn) * 2 + fr) * 256 + bj * 128 + cl + 4 * n) = cu[bj];
                    }
                    u32x2v o;
#define PG8_SG(k_) (cu[0][k_] * __builtin_amdgcn_rcpf(1.0f + __expf(-cu[0][k_])) * cu[1][k_])
                    o.x = cvt_pk_bf16(PG8_SG(0), PG8_SG(1)); o.y = cvt_pk_bf16(PG8_SG(2), PG8_SG(3));
#undef PG8_SG
                    *(u32x2v*)(ACT + (size_t)row * 2816 + ch + 4 * n) = o;
                    asm volatile("" ::: "memory");
                }
            }
            if (n == 0) {
#pragma unroll
                for (int ai = 0; ai < 2; ++ai)
#pragma unroll
                    for (int bj = 0; bj < 2; ++bj)
#pragma unroll
                        for (int m = 0; m < 4; ++m) acc[ai][bj][m][0] = acc[ai][bj][m][1];
            }
        }
        asm volatile("s_waitcnt lgkmcnt(0)" ::: "memory"); __builtin_amdgcn_s_barrier(); asm volatile("" ::: "memory");
    }
};

struct EpiResidNorm {
    static constexpr bool PERM = false, AFTER_DRAIN = false;
    const bf16_t* base; float* out; float* ssq2; unsigned* cnt; const float* fnw; int ldc;
    __device__ __forceinline__ void operator()(f32x4 (&acc)[2][2][4][2], const Unit& u, int wr, int wc, int fr, int fq) const {
        typedef unsigned u32x2v __attribute__((ext_vector_type(2)));
        const int col0 = u.pn * BM + wc * 32 + 4 * fq;
#pragma unroll
        for (int ai = 0; ai < 2; ++ai) {
            u32x2v bv[4][2][2];
#pragma unroll
            for (int m = 0; m < 4; ++m) { const size_t off = (size_t)(u.pm * BM + ai * HALF + wr * 64 + m * 16 + fr) * ldc + col0;
#pragma unroll
                for (int bj = 0; bj < 2; ++bj)
#pragma unroll
                    for (int n = 0; n < 2; ++n) bv[m][bj][n] = *(const u32x2v*)(base + off + bj * HALF + n * 16); }
#pragma unroll
            for (int m = 0; m < 4; ++m) { const int row = u.pm * BM + ai * HALF + wr * 64 + m * 16 + fr; float s = 0.f;
#pragma unroll
                for (int bj = 0; bj < 2; ++bj)
#pragma unroll
                    for (int n = 0; n < 2; ++n) { const u32x2v bw = bv[m][bj][n]; const f32x4 v = acc[ai][bj][m][n] + (f32x4){__uint_as_float(bw.x << 16), __uint_as_float(bw.x & 0xffff0000u), __uint_as_float(bw.y << 16), __uint_as_float(bw.y & 0xffff0000u)}; acc[ai][bj][m][n] = v; s += (v[0] * v[0] + v[1] * v[1]) + (v[2] * v[2] + v[3] * v[3]); }
                s += __shfl_xor(s, 16); s += __shfl_xor(s, 32);
                if (fq == 0) (void)__hip_atomic_fetch_add(ssq2 + row, s, __ATOMIC_RELAXED, __HIP_MEMORY_SCOPE_AGENT); }
            asm volatile("" ::: "memory");
        }
        asm volatile("s_waitcnt vmcnt(0)" ::: "memory"); __builtin_amdgcn_s_barrier(); asm volatile("" ::: "memory");
        if (wr == 0 && wc == 0 && fr == 0 && fq == 0) {
            __builtin_amdgcn_fence(__ATOMIC_RELEASE, "agent"); asm volatile("s_waitcnt vmcnt(0)" ::: "memory");
            (void)__hip_atomic_fetch_add(cnt + 16 * u.pm, 1u, __ATOMIC_RELAXED, __HIP_MEMORY_SCOPE_AGENT);
            unsigned sp = 0;
            while (__hip_atomic_load(cnt + 16 * u.pm, __ATOMIC_RELAXED, __HIP_MEMORY_SCOPE_AGENT) < 4u) { __builtin_amdgcn_s_sleep(1); if (++sp > (1u << 22)) break; }
            __builtin_amdgcn_fence(__ATOMIC_ACQUIRE, "agent"); asm volatile("s_waitcnt vmcnt(0)" ::: "memory");
        }
        __builtin_amdgcn_s_barrier(); asm volatile("" ::: "memory");
        f32x4 nw[2][2];
#pragma unroll
        for (int bj = 0; bj < 2; ++bj)
#pragma unroll
            for (int n = 0; n < 2; ++n) nw[bj][n] = *(const f32x4*)(fnw + col0 + bj * HALF + n * 16);
#pragma unroll
        for (int ai = 0; ai < 2; ++ai)
#pragma unroll
            for (int m = 0; m < 4; ++m) { const int row = u.pm * BM + ai * HALF + wr * 64 + m * 16 + fr; const size_t off = (size_t)row * ldc + col0;
                const float rstd = rsqrtf(__hip_atomic_load(ssq2 + row, __ATOMIC_RELAXED, __HIP_MEMORY_SCOPE_AGENT) * (1.0f / 1024.0f) + RMS_EPS);
#pragma unroll
                for (int bj = 0; bj < 2; ++bj)
#pragma unroll
                    for (int n = 0; n < 2; ++n) { const f32x4 v = acc[ai][bj][m][n]; *(f32x4*)(out + off + bj * HALF + n * 16) = (f32x4){v[0] * rstd * nw[bj][n][0], v[1] * rstd * nw[bj][n][1], v[2] * rstd * nw[bj][n][2], v[3] * rstd * nw[bj][n][3]}; } }
    }
};
template <class Epi, class Sched, bool ALIGN_EPI = false, bool SP2 = false>
__device__ __forceinline__ void gemm_phase(PG8_LAS unsigned char* lds, const Gemm g, const Sched& S, const Epi& E) {
    const int tid = threadIdx.x, wid = __builtin_amdgcn_readfirstlane(tid >> 6), lane = tid & 63, wr = wid >> 2, wc = wid & 3, fr = lane & 15, fq = lane >> 4;
    const int K = g.K, nt = K / BK;
    unsigned voffA[2], voffB[2];
#pragma unroll
    for (int i = 0; i < 2; ++i) { int R, C; stage_rc(tid * 16 + i * 8192, R, C); const int Rb = Epi::PERM ? ((R & ~31) + perm32(R & 31)) : R;
        voffA[i] = (unsigned)(R * K + C) * 2u; voffB[i] = (unsigned)(Rb * K + C) * 2u; }
    const size_t kstep = (size_t)(BK * 2);
    const size_t hstep = (size_t)HALF * K * 2;
    const size_t tstep = 2 * hstep;
    const unsigned ldsw = (unsigned)wid * 1024u;
    const int aoff = lds_byte(wr * 64 + fr, fq * 8), boff = lds_byte(wc * 32 + fr, fq * 8);
#define PG8_SA(b, h) (((b) * 2 + (h)) * HTB)
#define PG8_SB(b, h) ((4 + (b) * 2 + (h)) * HTB)
#define PG8_STAGE(bufoff, gbase, voff) do { _Pragma("unroll") for (int _i = 0; _i < 2; ++_i) \
        __builtin_amdgcn_global_load_lds((const unsigned*)((const char*)(gbase) + (voff)[_i]), (PG8_LAS unsigned*)(lds + (bufoff) + ldsw + _i * 8192), 16, 0, 0); } while (0)
#define PG8_LDA(dst, b, h) do { _Pragma("unroll") for (int m = 0; m < 4; ++m) _Pragma("unroll") for (int k = 0; k < 2; ++k) dst[m][k] = *(const PG8_LAS bf16x8*)(lds + PG8_SA(b, h) + aoff + m * 2048 + k * 1024); } while (0)
#define PG8_LDB(dst, b, h) do { _Pragma("unroll") for (int n = 0; n < 2; ++n) _Pragma("unroll") for (int k = 0; k < 2; ++k) dst[n][k] = *(const PG8_LAS bf16x8*)(lds + PG8_SB(b, h) + boff + n * 2048 + k * 1024); } while (0)
#define PG8_MMA(ai, bj, At, Bt) do { __builtin_amdgcn_s_setprio(1); _Pragma("unroll") for (int m = 0; m < 4; ++m) _Pragma("unroll") for (int n = 0; n < 2; ++n) _Pragma("unroll") for (int k = 0; k < 2; ++k) \
        acc[ai][bj][m][n] = __builtin_amdgcn_mfma_f32_16x16x32_bf16(Bt[n][k], At[m][k], acc[ai][bj][m][n], 0, 0, 0); __builtin_amdgcn_s_setprio(0); } while (0)
#define PG8_WAIT_V(n) asm volatile("s_waitcnt vmcnt(" #n ")" ::: "memory")
#define PG8_WAIT_L(n) asm volatile("s_waitcnt lgkmcnt(" #n ")" ::: "memory")
#define PG8_BAR __builtin_amdgcn_s_barrier()
#define PG8_SCHED __builtin_amdgcn_sched_barrier(0)
    Unit cur, nxt; int ui = 0;
    if (!S.next(0, cur)) return;
    f32x4 acc[2][2][4][2];
#pragma unroll
    for (int a = 0; a < 2; ++a)
#pragma unroll
        for (int b = 0; b < 2; ++b)
#pragma unroll
            for (int m = 0; m < 4; ++m)
#pragma unroll
                for (int n = 0; n < 2; ++n) acc[a][b][m][n] = (f32x4){0.f, 0.f, 0.f, 0.f};
    bf16x8 At[4][2], B0[2][2], B1[2][2];
    const char* cA = (const char*)g.A + (size_t)cur.pm * tstep; const char* cB = (const char*)g.Bt + (size_t)cur.pn * tstep;
    S.a_ready(cur);
    if constexpr (SP2) {
        PG8_STAGE(PG8_SB(0, 0), cB, voffB); PG8_STAGE(PG8_SB(0, 1), cB + hstep, voffB); PG8_STAGE(PG8_SA(0, 0), cA, voffA); PG8_STAGE(PG8_SA(0, 1), cA + hstep, voffA);
        if (wr == 1) PG8_BAR;
        PG8_WAIT_V(2); PG8_BAR;
        PG8_STAGE(PG8_SB(1, 0), cB + kstep, voffB); PG8_STAGE(PG8_SA(1, 0), cA + kstep, voffA); PG8_STAGE(PG8_SB(1, 1), cB + hstep + kstep, voffB);
        PG8_WAIT_V(6); PG8_BAR;
    } else {
        PG8_STAGE(PG8_SB(0, 0), cB, voffB); PG8_STAGE(PG8_SA(0, 0), cA, voffA); PG8_STAGE(PG8_SB(0, 1), cB + hstep, voffB); PG8_STAGE(PG8_SA(0, 1), cA + hstep, voffA);
        if (wr == 1) PG8_BAR;
        PG8_WAIT_V(4); PG8_BAR;
        PG8_STAGE(PG8_SB(1, 0), cB + kstep, voffB); PG8_STAGE(PG8_SA(1, 0), cA + kstep, voffA); PG8_STAGE(PG8_SB(1, 1), cB + hstep + kstep, voffB);
        PG8_WAIT_V(6); PG8_BAR;
    }
    for (;;) {
        const bool has_next = S.next(ui + 1, nxt);
        const char* nA = has_next ? (const char*)g.A + (size_t)nxt.pm * tstep : cA; const char* nB = has_next ? (const char*)g.Bt + (size_t)nxt.pn * tstep : cB;
        for (int t = 0; t < nt; t += 2) {
            const bool last = (t == nt - 2);
            const char* a1 = cA + (size_t)(t + 1) * kstep;
            const char* a2 = last ? nA : cA + (size_t)(t + 2) * kstep; const char* b2 = last ? nB : cB + (size_t)(t + 2) * kstep;
            const char* a3 = a2 + kstep; const char* b3 = b2 + kstep;
            if (last && has_next) S.a_ready(nxt);
            if constexpr (SP2) {
            PG8_LDB(B0, 0, 0); PG8_LDB(B1, 0, 1); PG8_SCHED; PG8_LDA(At, 0, 0); PG8_STAGE(PG8_SA(1, 1), a1 + hstep, voffA);
            PG8_WAIT_V(8); PG8_WAIT_L(0); PG8_BAR; PG8_MMA(0, 0, At, B0); PG8_MMA(0, 1, At, B1); PG8_BAR; PG8_SCHED;
            PG8_LDA(At, 0, 1); PG8_STAGE(PG8_SB(0, 0), b2, voffB); PG8_STAGE(PG8_SB(0, 1), b2 + hstep, voffB); PG8_STAGE(PG8_SA(0, 0), a2, voffA);
            PG8_WAIT_V(8); PG8_WAIT_L(0); PG8_BAR; PG8_MMA(1, 0, At, B0); PG8_MMA(1, 1, At, B1); PG8_BAR; PG8_SCHED;
            PG8_LDB(B0, 1, 0); PG8_LDB(B1, 1, 1); PG8_SCHED; PG8_LDA(At, 1, 0); PG8_STAGE(PG8_SA(0, 1), a2 + hstep, voffA);
            PG8_WAIT_V(8); PG8_WAIT_L(0); PG8_BAR; PG8_MMA(0, 0, At, B0); PG8_MMA(0, 1, At, B1); PG8_BAR; PG8_SCHED;
            PG8_LDA(At, 1, 1); PG8_STAGE(PG8_SB(1, 0), b3, voffB); PG8_STAGE(PG8_SB(1, 1), b3 + hstep, voffB); PG8_STAGE(PG8_SA(1, 0), a3, voffA);
            PG8_WAIT_V(8); PG8_WAIT_L(0); PG8_BAR; PG8_MMA(1, 0, At, B0); PG8_MMA(1, 1, At, B1); PG8_BAR; PG8_SCHED;
            } else {
            PG8_LDB(B0, 0, 0); PG8_SCHED; PG8_LDA(At, 0, 0); PG8_STAGE(PG8_SA(1, 1), a1 + hstep, voffA);
            PG8_WAIT_L(8); PG8_BAR; PG8_WAIT_L(0); PG8_MMA(0, 0, At, B0); PG8_BAR; PG8_SCHED;
            PG8_LDB(B1, 0, 1); PG8_STAGE(PG8_SB(0, 0), b2, voffB);
            PG8_BAR; PG8_WAIT_L(0); PG8_MMA(0, 1, At, B1); PG8_BAR;
            PG8_LDA(At, 0, 1); PG8_STAGE(PG8_SA(0, 0), a2, voffA);
            PG8_BAR; PG8_WAIT_L(0); PG8_MMA(1, 0, At, B0); PG8_BAR; PG8_SCHED;
            PG8_STAGE(PG8_SB(0, 1), b2 + hstep, voffB);
            PG8_WAIT_V(6); PG8_BAR; PG8_MMA(1, 1, At, B1); PG8_BAR;
            PG8_LDB(B0, 1, 0); PG8_SCHED; PG8_LDA(At, 1, 0); PG8_STAGE(PG8_SA(0, 1), a2 + hstep, voffA);
            PG8_WAIT_L(8); PG8_BAR; PG8_WAIT_L(0); PG8_MMA(0, 0, At, B0); PG8_BAR; PG8_SCHED;
            PG8_LDB(B1, 1, 1); PG8_STAGE(PG8_SB(1, 0), b3, voffB);
            PG8_BAR; PG8_WAIT_L(0); PG8_MMA(0, 1, At, B1); PG8_BAR;
            PG8_LDA(At, 1, 1); PG8_STAGE(PG8_SA(1, 0), a3, voffA);
            PG8_BAR; PG8_WAIT_L(0); PG8_MMA(1, 0, At, B0); PG8_BAR; PG8_SCHED;
            PG8_STAGE(PG8_SB(1, 1), b3 + hstep, voffB);
            PG8_WAIT_V(6); PG8_BAR; PG8_MMA(1, 1, At, B1); PG8_BAR;
            }
        }
        if constexpr (ALIGN_EPI) { if (wr == 0) PG8_BAR; }
        if constexpr (!Epi::AFTER_DRAIN) { E(acc, cur, wr, wc, fr, fq); S.done(cur); }
        if (!has_next) break;
#pragma unroll
        for (int a = 0; a < 2; ++a)
#pragma unroll
            for (int b = 0; b < 2; ++b)
#pragma unroll
                for (int m = 0; m < 4; ++m)
#pragma unroll
                    for (int n = 0; n < 2; ++n) acc[a][b][m][n] = (f32x4){0.f, 0.f, 0.f, 0.f};
        cur = nxt; cA = nA; cB = nB; ++ui;
        if constexpr (ALIGN_EPI) { if (wr == 1) PG8_BAR; }
    }
    PG8_WAIT_V(0);
    if constexpr (!ALIGN_EPI) { if (wr == 0) PG8_BAR; }
    PG8_BAR;
    if constexpr (Epi::AFTER_DRAIN) { E.fused(acc, cur, wr, wc, fr, fq, lds, wid, lane); S.done(cur); }
#undef PG8_SA
#undef PG8_SB
#undef PG8_STAGE
#undef PG8_LDA
#undef PG8_LDB
#undef PG8_MMA
#undef PG8_WAIT_V
#undef PG8_WAIT_L
#undef PG8_BAR
#undef PG8_SCHED
}
}
#ifndef PG8_SP2
#define PG8_SP2 true
#endif
#ifndef PG8_ALIGN
#define PG8_ALIGN true
#endif
constexpr int NB = 8, SEQ = 2048, DM = 1024, M = NB * SEQ;
constexpr int GH = 4, GD = 128, GW = 512, AH = 8, AD = 64;
constexpr int INC = 3592, NP = 3584;
constexpr int DFF = 2816, NUP = 2 * DFF;
constexpr int PC_QA = 0, PC_KA = 512, PC_VA = 1024, PC_Z = 1536, PC_QB = 2048, PC_KB = 2560, PC_VB = 3072;
constexpr size_t MiB = 1u << 20;
constexpr size_t WS_CTL = 0, WS_AB = 1 * MiB, WS_SSQ = 1 * MiB + 768 * 1024, WS_WIN = 2 * MiB, WS_WOUT = 9 * MiB, WS_WUP = 11 * MiB, WS_WDN = 22 * MiB;
constexpr size_t WS_XN = 28 * MiB, WS_PROJ = 60 * MiB, WS_CAT = 172 * MiB, WS_OA = 204 * MiB, WS_Y = 60 * MiB, WS_ACT = 148 * MiB, WS_END = 256 * MiB;
using pg8::RMS_EPS;
constexpr size_t WS_YH = 236 * MiB, WS_UPART = 240 * MiB;
constexpr size_t WS_SSQ2 = WS_SSQ + 131072;
constexpr size_t WS_GE = WS_SSQ + 65536;
constexpr int GOPS_CHUNK = 57344;
constexpr int SCAN_BUF = GOPS_CHUNK + 16384;
constexpr int NWAVES = 8, NTHR = 512;
constexpr int LDS_BYTES = 155648;
#define LAS __attribute__((address_space(3)))
typedef unsigned short bf16;
typedef unsigned v4u __attribute__((ext_vector_type(4)));
typedef unsigned v2u __attribute__((ext_vector_type(2)));
typedef float f32x4 __attribute__((ext_vector_type(4)));
__device__ __forceinline__ float bf2f(unsigned b) { return __uint_as_float(b << 16); }
__device__ __forceinline__ float bflo(unsigned w) { return __uint_as_float(w << 16); }
__device__ __forceinline__ float bfhi(unsigned w) { return __uint_as_float(w & 0xffff0000u); }
__device__ __forceinline__ unsigned pk2(float lo, float hi) { return pg8::cvt_pk_bf16(lo, hi); }
__device__ __forceinline__ float wave_sum(float v) {
    v += __builtin_bit_cast(float, __builtin_amdgcn_mov_dpp(__builtin_bit_cast(int, v), 0xB1, 0xf, 0xf, true));
    v += __builtin_bit_cast(float, __builtin_amdgcn_mov_dpp(__builtin_bit_cast(int, v), 0x4E, 0xf, 0xf, true));
    v += __builtin_bit_cast(float, __builtin_amdgcn_mov_dpp(__builtin_bit_cast(int, v), 0x141, 0xf, 0xf, true));
    v += __builtin_bit_cast(float, __builtin_amdgcn_mov_dpp(__builtin_bit_cast(int, v), 0x140, 0xf, 0xf, true));
    auto a = __builtin_amdgcn_permlane16_swap(__float_as_uint(v), __float_as_uint(v), false, false); v = __uint_as_float(a[0]) + __uint_as_float(a[1]);
    auto b = __builtin_amdgcn_permlane32_swap(__float_as_uint(v), __float_as_uint(v), false, false); return __uint_as_float(b[0]) + __uint_as_float(b[1]);
}
__device__ __forceinline__ float silu_f(float x) { return x * __builtin_amdgcn_rcpf(1.0f + __expf(-x)); }
__device__ __forceinline__ float sigmoid_f(float x) { return __builtin_amdgcn_rcpf(1.0f + __expf(-x)); }
__device__ __forceinline__ float softplus_f(float x) { return x > 20.f ? x : log1pf(__expf(x)); }

struct Args { const float* in[13]; float* out; unsigned char* ws; int ph_lo, ph_hi, coop, pad; };

__device__ __forceinline__ void p0_transpose_item(const float* W, int ldw, int k0, int sn0, bf16* WT, int K, int dn0, const float* kscale, LAS float* scr, int lane) {
    float tv[32];
#pragma unroll
    for (int i = 0; i < 32; ++i) { const int kk = 2 * i + (lane >> 5); tv[i] = W[(size_t)(k0 + kk) * ldw + sn0 + (lane & 31)]; }
    if (kscale) {
#pragma unroll
        for (int i = 0; i < 32; ++i) tv[i] *= kscale[k0 + 2 * i + (lane >> 5)]; }
#pragma unroll
    for (int i = 0; i < 32; ++i) scr[(2 * i + (lane >> 5)) * 33 + (lane & 31)] = tv[i];
    asm volatile("s_waitcnt lgkmcnt(0)" ::: "memory");
    const int c = lane & 7;
#pragma unroll
    for (int j = 0; j < 4; ++j) { const int n = (lane >> 3) + 8 * j; const LAS float* s = scr + (8 * c) * 33 + n;
        v4u o; o.x = pk2(s[0 * 33], s[1 * 33]); o.y = pk2(s[2 * 33], s[3 * 33]); o.z = pk2(s[4 * 33], s[5 * 33]); o.w = pk2(s[6 * 33], s[7 * 33]);
        *(v4u*)(WT + (size_t)(dn0 + n) * K + k0 + 8 * c) = o; }
    asm volatile("s_waitcnt lgkmcnt(0)" ::: "memory");
}

__device__ __forceinline__ void p0_prologue(const Args& A, LAS unsigned char* lds, int tid, int lane, int wave) {
    const float* x = A.in[0]; const float* nw1 = A.in[1]; const float* w_in = A.in[2]; const float* w_out = A.in[7]; const float* nw2 = A.in[8];
    const float* w_up = A.in[9]; const float* w_dn = A.in[11];
    unsigned char* ws = A.ws;
    bf16* WIN = (bf16*)(ws + WS_WIN); bf16* WOUT = (bf16*)(ws + WS_WOUT); bf16* WUP = (bf16*)(ws + WS_WUP); bf16* WDN = (bf16*)(ws + WS_WDN);
    bf16* XN = (bf16*)(ws + WS_XN); float* AB = (float*)(ws + WS_AB); float* SSQ = (float*)(ws + WS_SSQ);
    LAS float* scr = (LAS float*)(lds + wave * 9216);
    LAS float* wab = (LAS float*)(lds + 73728);
    const int G = gridDim.x, gw = blockIdx.x * NWAVES + wave, NGW = G * NWAVES;
    for (int i = blockIdx.x * NTHR + tid; i < M; i += G * NTHR) { SSQ[i] = 0.f; ((float*)(ws + WS_SSQ2))[i] = 0.f; }
    if (blockIdx.x == 0 && tid < 64) ((unsigned*)(ws + WS_CTL))[tid] = 0u;
    for (int idx = tid; idx < 8192; idx += NTHR) { const int k = idx >> 3, j = idx & 7; wab[j * 1024 + k] = nw1[k] * w_in[(size_t)k * INC + 2048 + j]; }
    constexpr int I_IN = 16 * (NP / 32);
    for (int it = gw; it < I_IN; it += NGW) { const int nblk = NP / 32, kb = it / nblk, nb = it % nblk, n0 = 32 * nb; p0_transpose_item(w_in, INC, 64 * kb, n0 + (n0 >= 2048 ? 8 : 0), WIN, DM, n0, nullptr, scr, lane); }
    __syncthreads();
    for (int m0 = gw; m0 < M; m0 += 2 * NGW) {
        const f32x4* nr = (const f32x4*)nw1 + lane;
        f32x4 v[2][4]; float s[2] = {0.f, 0.f};
#pragma unroll
        for (int rr = 0; rr < 2; ++rr) { const int m = min(m0 + rr * NGW, M - 1); const f32x4* xr = (const f32x4*)(x + (size_t)m * DM) + lane;
#pragma unroll
            for (int j = 0; j < 4; ++j) v[rr][j] = xr[64 * j]; }
#pragma unroll
        for (int rr = 0; rr < 2; ++rr)
#pragma unroll
            for (int j = 0; j < 4; ++j) s[rr] += (v[rr][j].x * v[rr][j].x + v[rr][j].y * v[rr][j].y) + (v[rr][j].z * v[rr][j].z + v[rr][j].w * v[rr][j].w);
#pragma unroll
        for (int rr = 0; rr < 2; ++rr) { const int m = m0 + rr * NGW; if (m >= M) break;
            const float rstd = rsqrtf(wave_sum(s[rr]) * (1.f / DM) + RMS_EPS);
            float ab[8];
#pragma unroll
            for (int q = 0; q < 8; ++q) { float a = 0.f;
#pragma unroll
                for (int j = 0; j < 4; ++j) { const f32x4 w = *(const LAS f32x4*)(wab + q * 1024 + 256 * j + 4 * lane); a += (v[rr][j].x * w.x + v[rr][j].y * w.y) + (v[rr][j].z * w.z + v[rr][j].w * w.w); }
                ab[q] = wave_sum(a) * rstd; }
            if (lane == 0) { *(f32x4*)(AB + (size_t)m * 8) = (f32x4){ab[0], ab[1], ab[2], ab[3]}; *(f32x4*)(AB + (size_t)m * 8 + 4) = (f32x4){ab[4], ab[5], ab[6], ab[7]}; }
            v2u* o8 = (v2u*)(XN + (size_t)m * DM) + lane;
#pragma unroll
            for (int j = 0; j < 4; ++j) { const f32x4 n = nr[64 * j]; v2u o; o.x = pk2(v[rr][j].x * rstd * n.x, v[rr][j].y * rstd * n.y); o.y = pk2(v[rr][j].z * rstd * n.z, v[rr][j].w * rstd * n.w); o8[64 * j] = o; }
        }
    }
}


__device__ __forceinline__ void convert_late_weights(const Args& A, LAS unsigned char* lds, int lane, int wave, int gw0, int ngw) {
    const float* w_out = A.in[7]; const float* nw2 = A.in[8]; const float* w_up = A.in[9]; const float* w_dn = A.in[11];
    bf16* WOUT = (bf16*)(A.ws + WS_WOUT); bf16* WUP = (bf16*)(A.ws + WS_WUP); bf16* WDN = (bf16*)(A.ws + WS_WDN);
    LAS float* scr = (LAS float*)(lds + wave * 9216);
    constexpr int I_OUT = 16 * 32, I_UP = 16 * (NUP / 32), I_DN = (DFF / 64) * 32;
    for (int it = gw0; it < I_OUT + I_UP + I_DN; it += ngw) {
        int r = it;
        if (r < I_OUT) { const int kb = r / 32, nb = r % 32; p0_transpose_item(w_out, DM, 64 * kb, 32 * nb, WOUT, DM, 32 * nb, nullptr, scr, lane); continue; } r -= I_OUT;
        if (r < I_UP) { const int nblk = NUP / 32, kb = r / nblk, nb = r % nblk, n0 = 32 * nb, pn = n0 >> 8, j0 = n0 & 255;
            const int s0 = (j0 < 128) ? (128 * pn + j0) : (DFF + 128 * pn + j0 - 128);
            p0_transpose_item(w_up, NUP, 64 * kb, s0, WUP, DM, n0, nw2, scr, lane); continue; } r -= I_UP;
        { const int kb = r / 32, nb = r % 32; p0_transpose_item(w_dn, DM, 64 * kb, 32 * nb, WDN, DFF, 32 * nb, nullptr, scr, lane); }
    }
}
__device__ __forceinline__ void gdn_simple(const Args& A, LAS unsigned char* lds, int tid, int lane, int wave) {
    const bf16* PROJ = (const bf16*)(A.ws + WS_PROJ); const float* AB = (const float*)(A.ws + WS_AB); float* OA = (float*)(A.ws + WS_OA);
    const float* cw = A.in[3]; const float* a_log = A.in[4]; const float* dt_bias = A.in[5];
    LAS float* qs = (LAS float*)lds; LAS float* ks = qs + 16 * 128; LAS float* vs = ks + 16 * 128; LAS float* av = vs + 16 * 128; LAS float* bv = av + 16;
    for (int task = blockIdx.x; task < NB * GH; task += gridDim.x) {
        const int b = task / GH, h = task % GH, v = tid >> 2, part = tid & 3;
        float S[32];
#pragma unroll
        for (int i = 0; i < 32; ++i) S[i] = 0.f;
        const float Ah = __expf(a_log[h]), dtb = dt_bias[h];
        for (int blk = 0; blk < SEQ / 16; ++blk) {
            const int t0 = blk * 16;
            for (int idx = tid; idx < 16 * 384; idx += NTHR) {
                const int tt = idx / 384, c = idx % 384, which = c >> 7, d = c & 127, col = which * 512 + h * 128 + d, t = t0 + tt;
                float acc = 0.f;
#pragma unroll
                for (int i = 0; i < 4; ++i) { const int ts = t - 3 + i; if (ts >= 0) acc += cw[i * 1536 + col] * bf2f(PROJ[(size_t)(b * SEQ + ts) * NP + col]); }
                qs[which * 2048 + tt * 128 + d] = silu_f(acc);
            }
            if (tid < 16) { const size_t row = (size_t)b * SEQ + t0 + tid; bv[tid] = sigmoid_f(AB[row * 8 + h]); av[tid] = __expf(-Ah * softplus_f(AB[row * 8 + 4 + h] + dtb)); }
            __syncthreads();
#pragma unroll
            for (int r = 0; r < 4; ++r) { const int row = 4 * wave + r; LAS float* arr = qs + row * 128;
                const float v0 = arr[lane], v1 = arr[lane + 64]; const float s = wave_sum(v0 * v0 + v1 * v1);
                const float sc = rsqrtf(s + RMS_EPS) * (row < 16 ? 0.08838834764831845f : 1.0f); arr[lane] = v0 * sc; arr[lane + 64] = v1 * sc; }
            __syncthreads();
            for (int tt = 0; tt < 16; ++tt) {
                const float a = av[tt], bt = bv[tt], vt = vs[tt * 128 + v];
                float kS = 0.f;
#pragma unroll
                for (int i = 0; i < 32; ++i) kS += ks[tt * 128 + 32 * part + i] * S[i];
                kS += __shfl_xor(kS, 1); kS += __shfl_xor(kS, 2);
                const float c = bt * (vt - a * kS); float o = 0.f;
#pragma unroll
                for (int i = 0; i < 32; ++i) { S[i] = a * S[i] + ks[tt * 128 + 32 * part + i] * c; o += qs[tt * 128 + 32 * part + i] * S[i]; }
                o += __shfl_xor(o, 1); o += __shfl_xor(o, 2);
                if (part == 0) OA[(size_t)(b * SEQ + t0 + tt) * GW + h * 128 + v] = o;
            }
            __syncthreads();
        }
    }
}


template <int J, int K, int N> struct SolveLd {
    static __device__ __forceinline__ void run(f32x4 (&l)[4], unsigned lbase) {
        if constexpr (K < N) { constexpr int t40 = ((J + 1) >> 2) << 2;
            asm volatile("ds_read_b128 %0, %1 offset:%2" : "=v"(l[K]) : "v"(lbase), "i"((J * 68 + t40 + 4 * K) * 4)); SolveLd<J, K + 1, N>::run(l, lbase); }
    }
};
template <int J> struct SolveCol16 {
    static __device__ __forceinline__ void run(float (&R)[16], unsigned lbase) {
        if constexpr (J < 15) {
            constexpr int t40 = ((J + 1) >> 2) << 2, nld = (16 - t40) >> 2;
            f32x4 l[4];
            SolveLd<J, 0, nld>::run(l, lbase);
            asm volatile("s_waitcnt lgkmcnt(0)" ::: "memory");
#pragma unroll
            for (int k = 0; k < nld; ++k) asm volatile("" : "+v"(l[k]));
#pragma unroll
            for (int k = 0; k < nld; ++k) {
#pragma unroll
                for (int e = 0; e < 4; ++e) if (t40 + 4 * k + e > J) R[t40 + 4 * k + e] += l[k][e] * R[J]; }
            SolveCol16<J + 1>::run(R, lbase);
        }
    }
};

typedef short bf16x8 __attribute__((ext_vector_type(8)));
__device__ __forceinline__ void gdn_prep(const Args& A, LAS unsigned char* lds, int tid0, int lane0, int wave) {
    const bf16* PROJ = (const bf16*)(A.ws + WS_PROJ); const float* AB = (const float*)(A.ws + WS_AB);
    const float* cw = A.in[3]; const float* a_log = A.in[4]; const float* dt_bias = A.in[5];
    unsigned char* UVF = A.ws + WS_XN; unsigned char* GOPS = (unsigned char*)A.out; float* GE = (float*)(A.ws + WS_GE);
    LAS float* Qs = (LAS float*)lds; LAS float* Ks = (LAS float*)(lds + 33792); LAS float* Vs = (LAS float*)(lds + 67584);
    LAS bf16* Qb = (LAS bf16*)(lds + 101376); LAS bf16* Kb = (LAS bf16*)(lds + 118784);
    LAS float* gcs = (LAS float*)(lds + 136192); LAS float* bts = gcs + 64; LAS float* egs = gcs + 128; LAS float* kes = gcs + 192;
    LAS float* LsT = (LAS float*)lds; LAS bf16* ATs = (LAS bf16*)(lds + 17408); LAS bf16* WKs = Kb;
    v4u rwn[11];
    if (tid0 < 384 && (int)blockIdx.x < NB * GH * 32) { const int c8 = tid0 % 48, run = tid0 / 48, which = c8 >> 4, d0 = (c8 & 15) * 8, t1 = blockIdx.x, bh1 = t1 >> 5, n1 = t1 & 31, b1 = bh1 >> 2, h1 = bh1 & 3, col1 = which * 512 + h1 * 128 + d0;
#pragma unroll
        for (int r = 0; r < 11; ++r) { const int ts = 64 * n1 + 8 * run - 3 + r; rwn[r] = (ts >= 0) ? *(const v4u*)(PROJ + (size_t)(b1 * SEQ + ts) * NP + col1) : (v4u){0u, 0u, 0u, 0u}; } }
    else {
#pragma unroll
        for (int r = 0; r < 11; ++r) rwn[r] = (v4u){0u, 0u, 0u, 0u}; }
#pragma unroll 1
    for (int task = blockIdx.x; task < NB * GH * 32; task += gridDim.x) {
        int tid = tid0, lane = lane0; asm volatile("" : "+v"(tid), "+v"(lane));
        const int fr = lane & 15, fq = lane >> 4;
        const int bh = task >> 5, n = task & 31, b = bh >> 2, h = bh & 3, t0 = 64 * n, row0 = b * SEQ + t0;
        unsigned char* gops = GOPS + (size_t)task * GOPS_CHUNK;
        if (tid < 384) {
            const int c8 = tid % 48, run = tid / 48, which = c8 >> 4, d0 = (c8 & 15) * 8, col = which * 512 + h * 128 + d0;
            v4u rw[11];
#pragma unroll
            for (int r = 0; r < 11; ++r) rw[r] = rwn[r];
            { const int tn = task + gridDim.x;
              if (tn < NB * GH * 32) { const int bhn = tn >> 5, nn = tn & 31, bn = bhn >> 2, hn = bhn & 3, coln = which * 512 + hn * 128 + d0;
#pragma unroll
                for (int r = 0; r < 11; ++r) { const int ts = 64 * nn + 8 * run - 3 + r; rwn[r] = (ts >= 0) ? *(const v4u*)(PROJ + (size_t)(bn * SEQ + ts) * NP + coln) : (v4u){0u, 0u, 0u, 0u}; } } }
            f32x4 cwa[4], cwb[4];
#pragma unroll
            for (int j = 0; j < 4; ++j) { cwa[j] = *(const f32x4*)(cw + j * 1536 + col); cwb[j] = *(const f32x4*)(cw + j * 1536 + col + 4); }
#pragma unroll
            for (int i = 0; i < 8; ++i) {
                float acc[8];
#pragma unroll
                for (int e2 = 0; e2 < 8; ++e2) acc[e2] = 0.f;
#pragma unroll
                for (int j = 0; j < 4; ++j) { const v4u w = rw[i + j];
                    acc[0] += cwa[j].x * bflo(w.x); acc[1] += cwa[j].y * bfhi(w.x); acc[2] += cwa[j].z * bflo(w.y); acc[3] += cwa[j].w * bfhi(w.y);
                    acc[4] += cwb[j].x * bflo(w.z); acc[5] += cwb[j].y * bfhi(w.z); acc[6] += cwb[j].z * bflo(w.w); acc[7] += cwb[j].w * bfhi(w.w); }
                float ss = 0.f;
#pragma unroll
                for (int e2 = 0; e2 < 8; ++e2) { acc[e2] = silu_f(acc[e2]); ss += acc[e2] * acc[e2]; }
                ss += __builtin_bit_cast(float, __builtin_amdgcn_update_dpp(0, __builtin_bit_cast(int, ss), 0xB1, 0xf, 0xf, false));
                ss += __builtin_bit_cast(float, __builtin_amdgcn_update_dpp(0, __builtin_bit_cast(int, ss), 0x4E, 0xf, 0xf, false));
                ss += __builtin_bit_cast(float, __builtin_amdgcn_update_dpp(0, __builtin_bit_cast(int, ss), 0x141, 0xf, 0xf, false));
                ss += __builtin_bit_cast(float, __builtin_amdgcn_update_dpp(0, __builtin_bit_cast(int, ss), 0x140, 0xf, 0xf, false));
                const int tt = 8 * run + i;
                if (which == 2) { *(LAS f32x4*)(Vs + tt * 132 + d0) = (f32x4){acc[0], acc[1], acc[2], acc[3]}; *(LAS f32x4*)(Vs + tt * 132 + d0 + 4) = (f32x4){acc[4], acc[5], acc[6], acc[7]}; }
                else {
                    const float sc = rsqrtf(ss + RMS_EPS) * (which == 0 ? 0.08838834764831845f : 1.0f);
#pragma unroll
                    for (int e2 = 0; e2 < 8; ++e2) acc[e2] *= sc;
                    const v4u pk = (v4u){pk2(acc[0], acc[1]), pk2(acc[2], acc[3]), pk2(acc[4], acc[5]), pk2(acc[6], acc[7])};
                    if (which == 0) *(LAS v4u*)(Qb + tt * 136 + d0) = pk;
                    else { *(LAS v4u*)(Kb + tt * 136 + d0) = pk; *(LAS f32x4*)(Ks + tt * 132 + d0) = (f32x4){acc[0], acc[1], acc[2], acc[3]}; *(LAS f32x4*)(Ks + tt * 132 + d0 + 4) = (f32x4){acc[4], acc[5], acc[6], acc[7]}; }
                }
            }
        }
        if (wave == 0) {
            const size_t row = (size_t)row0 + lane; const float beta = sigmoid_f(AB[row * 8 + h]);
            float g = -__expf(a_log[h]) * softplus_f(AB[row * 8 + 4 + h] + dt_bias[h]);
#pragma unroll
            for (int o = 1; o < 64; o <<= 1) { const float t = __shfl_up(g, o); if (lane >= o) g += t; }
            const float glast = __shfl(g, 63);
            gcs[lane] = g; bts[lane] = beta; egs[lane] = __expf(g); kes[lane] = __expf(glast - g) * beta;
            if (lane == 63) GE[task] = __expf(g);
        }
        __syncthreads();
#pragma unroll 1
        for (int jb = wave; jb < 20; jb += 8) {
            const int kind = jb >= 10 ? 1 : 0, idx = jb - 10 * kind, ti = idx < 1 ? 0 : (idx < 3 ? 1 : (idx < 6 ? 2 : 3)), tj = idx - ti * (ti + 1) / 2;
            const LAS bf16* As = kind ? Qb : Kb; f32x4 d = (f32x4){0.f, 0.f, 0.f, 0.f};
#pragma unroll
            for (int ks = 0; ks < 4; ++ks) { const bf16x8 a = *(const LAS bf16x8*)(As + (16 * ti + fr) * 136 + 32 * ks + 8 * fq), bb = *(const LAS bf16x8*)(Kb + (16 * tj + fr) * 136 + 32 * ks + 8 * fq);
                d = __builtin_amdgcn_mfma_f32_16x16x32_bf16(a, bb, d, 0, 0, 0); }
            const int j = 16 * tj + fr; const float gj = gcs[j], bj = bts[j]; float val[4];
#pragma unroll
            for (int e = 0; e < 4; ++e) { const int t = 16 * ti + 4 * fq + e; const float x = d[e] * __expf(gcs[t] - gj) * bj; val[e] = (kind ? (t >= j) : (t > j)) ? x : 0.f; }
            if (kind == 0) *(LAS f32x4*)(LsT + j * 68 + 16 * ti + 4 * fq) = (f32x4){-val[0], -val[1], -val[2], -val[3]};
            else {
#pragma unroll
                for (int e = 0; e < 4; ++e) ATs[(16 * ti + 4 * fq + e) * 72 + j] = (bf16)(pk2(val[e], 0.f) & 0xffffu); }
        }
        __syncthreads();
        LAS float* Ti = (LAS float*)(lds + 26624);
        if (wave == 0) {
            const int I = lane >> 4, c = lane & 15; float x[16];
#pragma unroll
            for (int r = 0; r < 16; ++r) x[r] = (r == c) ? 1.0f : 0.0f;
            SolveCol16<0>::run(x, (unsigned)(uintptr_t)LsT + (unsigned)(I * (16 * 68 + 16) * 4));
#pragma unroll
            for (int r = 0; r < 16; ++r) Ti[(I * 16 + r) * 20 + c] = x[r];
        } else {
            const int rt = tid - 64;
            for (int q = rt; q < 1024; q += 448) { const int blk = q >> 6, l2 = q & 63, i = l2 & 15, f = l2 >> 4, mb = blk >> 2, ks = blk & 3, t = 16 * mb + i;
                const v2u p0 = *(const LAS v2u*)(Qb + t * 136 + 32 * ks + 4 * f), p1 = *(const LAS v2u*)(Qb + t * 136 + 32 * ks + 16 + 4 * f); const float eg = egs[t];
                v4u o; o.x = pk2(bflo(p0.x) * eg, bfhi(p0.x) * eg); o.y = pk2(bflo(p0.y) * eg, bfhi(p0.y) * eg); o.z = pk2(bflo(p1.x) * eg, bfhi(p1.x) * eg); o.w = pk2(bflo(p1.y) * eg, bfhi(p1.y) * eg);
                *(v4u*)(gops + 16384 + q * 16) = o; }
            for (int q = rt; q < 512; q += 448) { const int blk = q >> 6, l2 = q & 63, i = l2 & 15, f = l2 >> 4, mb = blk >> 1, ks2 = blk & 1, t = 16 * mb + i;
                v2u p0 = (v2u){0u, 0u}, p1 = (v2u){0u, 0u};
                if (2 * ks2 <= mb) p0 = *(const LAS v2u*)(ATs + t * 72 + 32 * ks2 + 4 * f);
                if (2 * ks2 + 1 <= mb) p1 = *(const LAS v2u*)(ATs + t * 72 + 32 * ks2 + 16 + 4 * f);
                *(v4u*)(gops + 32768 + q * 16) = (v4u){p0.x, p0.y, p1.x, p1.y}; }
            for (int q = rt; q < 1024; q += 448) { const int blk = q >> 6, l2 = q & 63, i = l2 & 15, f = l2 >> 4, dkb = blk >> 1, ks2 = blk & 1, dk = 16 * dkb + i; float v[8];
#pragma unroll
                for (int e2 = 0; e2 < 8; ++e2) { const int c = 32 * ks2 + 16 * (e2 >> 2) + 4 * f + (e2 & 3); v[e2] = Ks[c * 132 + dk] * kes[c]; }
                *(v4u*)(gops + 40960 + q * 16) = (v4u){pk2(v[0], v[1]), pk2(v[2], v[3]), pk2(v[4], v[5]), pk2(v[6], v[7])}; }
        }
        __syncthreads();
#pragma unroll
        for (int ct = 0; ct < 2; ++ct) {
            const int C = 2 * wave + ct; const bool isv = C < 8; const int col = isv ? 16 * C + fr : 16 * (C - 8) + fr;
            f32x4 X[4];
#pragma unroll
            for (int I = 0; I < 4; ++I) {
                f32x4 acc;
#pragma unroll
                for (int e2 = 0; e2 < 4; ++e2) { const int t = 16 * I + 4 * fq + e2; acc[e2] = isv ? Vs[t * 132 + col] : egs[t] * Ks[t * 132 + col]; }
#pragma unroll
                for (int J = 0; J < 4; ++J) if (J < I) {
#pragma unroll
                    for (int kk = 0; kk < 4; ++kk) acc = __builtin_amdgcn_mfma_f32_16x16x4f32(LsT[(16 * J + 4 * fq + kk) * 68 + 16 * I + fr], X[J][kk], acc, 0, 0, 0); }
                f32x4 xi = (f32x4){0.f, 0.f, 0.f, 0.f};
#pragma unroll
                for (int kk = 0; kk < 4; ++kk) xi = __builtin_amdgcn_mfma_f32_16x16x4f32(Ti[(I * 16 + fr) * 20 + 4 * fq + kk], acc[kk], xi, 0, 0, 0);
                X[I] = xi;
                if (isv) { v2u w; w.x = pk2(xi[0], xi[1]); w.y = pk2(xi[2], xi[3]); *(v2u*)(UVF + (size_t)task * 16384 + (size_t)((C * 4 + I) * 64 + lane) * 8) = w; }
                else {
#pragma unroll
                    for (int e2 = 0; e2 < 4; ++e2) WKs[(16 * I + 4 * fq + e2) * 136 + col] = (bf16)(pk2(xi[e2], 0.f) & 0xffffu); }
            }
        }
        __syncthreads();
        for (int q = tid; q < 1024; q += NTHR) { const int blk = q >> 6, l2 = q & 63, i = l2 & 15, f = l2 >> 4, mb = blk >> 2, ks = blk & 3, t = 16 * mb + i;
            const v2u p0 = *(const LAS v2u*)(WKs + t * 136 + 32 * ks + 4 * f), p1 = *(const LAS v2u*)(WKs + t * 136 + 32 * ks + 16 + 4 * f);
            *(v4u*)(gops + q * 16) = (v4u){p0.x, p0.y, p1.x, p1.y}; }
        __syncthreads();
    }
}

__device__ __forceinline__ bf16x8 pack8(const f32x4 a, const f32x4 b) {
    v4u w; w.x = pk2(a[0], a[1]); w.y = pk2(a[2], a[3]); w.z = pk2(b[0], b[1]); w.w = pk2(b[2], b[3]); return __builtin_bit_cast(bf16x8, w);
}
__device__ __forceinline__ void gdn_scan(const Args& A, LAS unsigned char* lds, int bh, int tid, int lane, int wave) {
    const int b = bh >> 2, h = bh & 3, fr = lane & 15, fq = lane >> 4, vs = wave;
    const unsigned char* gops = (const unsigned char*)A.out + (size_t)bh * 32 * GOPS_CHUNK;
    const unsigned char* uvf = A.ws + WS_XN + (size_t)bh * 32 * 16384; const float* GE = (const float*)(A.ws + WS_GE) + bh * 32;
    float* Op = (float*)(A.ws + WS_OA) + ((size_t)b * SEQ + 4 * fq) * GW + h * 128 + 16 * vs + fr;
    f32x4 S[8];
#pragma unroll
    for (int i = 0; i < 8; ++i) S[i] = (f32x4){0.f, 0.f, 0.f, 0.f};
    const float gev = GE[lane & 31];
#define SCAN_DMA(chunk, bufoff) do { _Pragma("unroll") for (int i_ = 0; i_ < 9; ++i_) { const int p_ = wave + 8 * i_; \
        const unsigned char* s_ = (p_ < 56) ? (gops + (size_t)(chunk) * GOPS_CHUNK + p_ * 1024) : (uvf + (size_t)(chunk) * 16384 + (p_ - 56) * 1024); \
        __builtin_amdgcn_global_load_lds((const unsigned*)(s_ + lane * 16), (LAS unsigned*)(lds + (bufoff) + p_ * 1024), 16, 0, 0); } } while (0)
    SCAN_DMA(0, 0); SCAN_DMA(1, SCAN_BUF);
    asm volatile("s_waitcnt vmcnt(0)" ::: "memory"); __syncthreads();
#pragma unroll 1
    for (int n = 0; n < 32; ++n) {
        const LAS unsigned char* cur = lds + (n & 1) * SCAN_BUF;
        const float ge = __builtin_bit_cast(float, __builtin_amdgcn_readlane(__builtin_bit_cast(int, gev), n));
        bf16x8 Sb[4];
#pragma unroll
        for (int ks = 0; ks < 4; ++ks) Sb[ks] = pack8(S[2 * ks], S[2 * ks + 1]);
        f32x4 u[4];
#pragma unroll
        for (int mb = 0; mb < 4; ++mb) { f32x4 p = (f32x4){0.f, 0.f, 0.f, 0.f};
#pragma unroll
            for (int ks = 0; ks < 4; ++ks) p = __builtin_amdgcn_mfma_f32_16x16x32_bf16(*(const LAS bf16x8*)(cur + ((mb * 4 + ks) * 64 + lane) * 16), Sb[ks], p, 0, 0, 0);
            const v2u uw = *(const LAS v2u*)(cur + GOPS_CHUNK + ((vs * 4 + mb) * 64 + lane) * 8);
            u[mb] = (f32x4){bflo(uw.x) - p[0], bfhi(uw.x) - p[1], bflo(uw.y) - p[2], bfhi(uw.y) - p[3]}; }
        bf16x8 ub[2]; ub[0] = pack8(u[0], u[1]); ub[1] = pack8(u[2], u[3]);
        f32x4 o[4];
#pragma unroll
        for (int mb = 0; mb < 4; ++mb) { f32x4 acc = (f32x4){0.f, 0.f, 0.f, 0.f};
#pragma unroll
            for (int ks = 0; ks < 4; ++ks) acc = __builtin_amdgcn_mfma_f32_16x16x32_bf16(*(const LAS bf16x8*)(cur + 16384 + ((mb * 4 + ks) * 64 + lane) * 16), Sb[ks], acc, 0, 0, 0);
#pragma unroll
            for (int ks2 = 0; ks2 < 2; ++ks2) if (ks2 <= (mb >> 1)) acc = __builtin_amdgcn_mfma_f32_16x16x32_bf16(*(const LAS bf16x8*)(cur + 32768 + ((mb * 2 + ks2) * 64 + lane) * 16), ub[ks2], acc, 0, 0, 0);
            o[mb] = acc; }
#pragma unroll
        for (int dkb = 0; dkb < 8; ++dkb) { f32x4 acc = S[dkb] * ge;
#pragma unroll
            for (int ks2 = 0; ks2 < 2; ++ks2) acc = __builtin_amdgcn_mfma_f32_16x16x32_bf16(*(const LAS bf16x8*)(cur + 40960 + ((dkb * 2 + ks2) * 64 + lane) * 16), ub[ks2], acc, 0, 0, 0);
            S[dkb] = acc; }
        asm volatile("s_waitcnt vmcnt(0)" ::: "memory"); __syncthreads();
        if (n + 2 < 32) SCAN_DMA(n + 2, (n & 1) * SCAN_BUF);
        float* orow = Op + (size_t)(64 * n) * GW;
#pragma unroll
        for (int mb = 0; mb < 4; ++mb) { float* q = orow + (size_t)(16 * mb) * GW; q[0] = o[mb][0]; q[GW] = o[mb][1]; q[2 * GW] = o[mb][2]; q[3 * GW] = o[mb][3]; }
    }
    asm volatile("s_waitcnt vmcnt(0)" ::: "memory"); __syncthreads();
#undef SCAN_DMA
}


__device__ __forceinline__ float xmax_fq(float x) {
    auto a = __builtin_amdgcn_permlane16_swap(__float_as_uint(x), __float_as_uint(x), false, false); x = fmaxf(__uint_as_float(a[0]), __uint_as_float(a[1]));
    auto b = __builtin_amdgcn_permlane32_swap(__float_as_uint(x), __float_as_uint(x), false, false); return fmaxf(__uint_as_float(b[0]), __uint_as_float(b[1]));
}
__device__ __forceinline__ void attn_fast(const Args& A, LAS unsigned char* lds, int lane, int wave) {
    const bf16* PROJ = (const bf16*)(A.ws + WS_PROJ); bf16* CAT = (bf16*)(A.ws + WS_CAT);
    unsigned* ctr = (unsigned*)(A.ws + WS_CTL);
    LAS bf16* Vt = (LAS bf16*)(lds + wave * 8192);
    const int fr = lane & 15, fq = lane >> 4;
    const int kk = lane & 31, vch = lane >> 5;
    typedef short v4i16_t __attribute__((ext_vector_type(4)));
    LAS bf16* vtr_base = Vt + (4 * fq + ((lane >> 2) & 3)) * 72 + 4 * (lane & 3);
    constexpr float SC = 0.125f * 1.4426950408889634f;
    const int myx = (int)(__builtin_amdgcn_s_getreg((3 << 11) | 20) & 0x7u);
    int qi = 0;
    for (;;) {
        int wt = 256, xq = 0;
        while (qi < 8) { xq = (myx + qi) & 7; unsigned wt_ = 0; if (lane == 0) wt_ = atomicAdd(ctr + 16 * xq, 1u); wt = __builtin_amdgcn_readfirstlane(wt_); if (wt < 256) break; ++qi; }
        if (qi >= 8) break;
        const int T = 7 - (wt >> 5), b = (wt >> 2) & 7, h = xq, c0 = wt & 3, t0 = 256 * T;
        const bf16* Pb = PROJ + (size_t)b * SEQ * NP;
        const int tq0 = t0 + c0 + 16 * fr;
        bf16x8 qf0[2], qf1[2], qf2[2], qf3[2];
#pragma unroll
        for (int ks = 0; ks < 2; ++ks) { const bf16* qp = Pb + (size_t)tq0 * NP + PC_QB + h * 64 + 32 * ks + 8 * fq;
            qf0[ks] = *(const bf16x8*)qp; qf1[ks] = *(const bf16x8*)(qp + 4 * NP); qf2[ks] = *(const bf16x8*)(qp + 8 * NP); qf3[ks] = *(const bf16x8*)(qp + 12 * NP); }
        const int n2 = ((t0 + 240) >> 4) + 1, g2 = (n2 + 31) >> 5;
        const int lo1 = max(t0 + c0 - 512, c0), n1 = ((t0 + c0 + 12 + 240 - lo1) >> 2) + 1, g1 = (n1 + 31) >> 5;
        const int lo0 = max(t0 + c0 - 128, 0), n0 = (t0 + c0 + 12 + 240 - lo0) + 1, g0 = (n0 + 31) >> 5;
        const int NG = 4 * g2 + g1 + g0;
        f32x4 O0[4], O1[4], O2[4], O3[4];
#pragma unroll
        for (int i = 0; i < 4; ++i) { O0[i] = (f32x4){0.f, 0.f, 0.f, 0.f}; O1[i] = O0[i]; O2[i] = O0[i]; O3[i] = O0[i]; }
        float m0 = -INFINITY, l0 = 0.f, m1 = -INFINITY, l1 = 0.f, m2 = -INFINITY, l2 = 0.f, m3 = -INFINITY, l3 = 0.f;
        v4u kc[4], vc[4], kn[4], vn[4];
#define ATT_DEC(f, kst, str, mode) do { if ((f) < 4 * g2) { const int ci_ = (f) / g2; str = 16; kst = c0 + 4 * ci_ + 512 * ((f) - ci_ * g2); mode = 1 << ci_; } \
            else if ((f) < 4 * g2 + g1) { str = 4; kst = lo1 + 128 * ((f) - 4 * g2); mode = 15; } else { str = 1; kst = lo0 + 32 * ((f) - 4 * g2 - g1); mode = 15; } } while (0)
#define ATT_LOAD(kreg, vreg, kst, str) do { \
            _Pragma("unroll") for (int j = 0; j < 2; ++j) { const int tk = min((kst) + (str) * (16 * j + fr), SEQ - 1); \
                _Pragma("unroll") for (int ks = 0; ks < 2; ++ks) kreg[2 * j + ks] = *(const v4u*)(Pb + (size_t)tk * NP + PC_KB + h * 64 + 32 * ks + 8 * fq); } \
            { const int tk = min((kst) + (str) * kk, SEQ - 1); \
                _Pragma("unroll") for (int i = 0; i < 4; ++i) vreg[i] = *(const v4u*)(Pb + (size_t)tk * NP + PC_VB + h * 64 + 8 * (vch + 2 * i)); } } while (0)
#define ATT_CLS(O_, m_, l_, qf_, tq_) do { \
            f32x4 d0 = (f32x4){0.f, 0.f, 0.f, 0.f}, d1 = d0; \
            _Pragma("unroll") for (int ks = 0; ks < 2; ++ks) { d0 = __builtin_amdgcn_mfma_f32_16x16x32_bf16(__builtin_bit_cast(bf16x8, kc[ks]), qf_[ks], d0, 0, 0, 0); \
                                                             d1 = __builtin_amdgcn_mfma_f32_16x16x32_bf16(__builtin_bit_cast(bf16x8, kc[2 + ks]), qf_[ks], d1, 0, 0, 0); } \
            float s[8]; float mloc = -INFINITY; \
            const int dv = (((tq_) - kst) >> shl) - 4 * fq;        \
            _Pragma("unroll") for (int e2 = 0; e2 < 8; ++e2) { const float x = (e2 < 4 ? d0[e2 & 3] : d1[e2 & 3]) * SC; \
                s[e2] = ((unsigned)(dv - (16 * (e2 >> 2) + (e2 & 3))) <= 128u) ? x : -INFINITY; mloc = fmaxf(mloc, s[e2]); } \
            mloc = xmax_fq(mloc); \
            const float mnew = fmaxf(m_, mloc), alpha = __builtin_amdgcn_exp2f(m_ - mnew); m_ = mnew; \
            float psum = 0.f; \
            _Pragma("unroll") for (int e2 = 0; e2 < 8; ++e2) { s[e2] = __builtin_amdgcn_exp2f(s[e2] - mnew); psum += s[e2]; } \
            l_ = l_ * alpha + psum; \
            const bf16x8 pb = pack8((f32x4){s[0], s[1], s[2], s[3]}, (f32x4){s[4], s[5], s[6], s[7]}); \
            _Pragma("unroll") for (int db = 0; db < 4; ++db) O_[db] = __builtin_amdgcn_mfma_f32_16x16x32_bf16(va[db], pb, O_[db] * alpha, 0, 0, 0); } while (0)
        int kst, str, mode; ATT_DEC(0, kst, str, mode); ATT_LOAD(kc, vc, kst, str);
#pragma unroll 1
        for (int f = 0; f < NG; ++f) {
            int kstn = 0, strn = 1, moden = 0;
            if (f + 1 < NG) { ATT_DEC(f + 1, kstn, strn, moden); ATT_LOAD(kn, vn, kstn, strn); }
#pragma unroll
            for (int i = 0; i < 4; ++i) *(LAS v4u*)(Vt + kk * 72 + 8 * (vch + 2 * i)) = vc[i];
            bf16x8 va[4];
#pragma unroll
            for (int db = 0; db < 4; ++db) {
                const v4i16_t r0 = __builtin_amdgcn_ds_read_tr16_b64_v4i16((LAS v4i16_t*)(vtr_base + 16 * db)), r1 = __builtin_amdgcn_ds_read_tr16_b64_v4i16((LAS v4i16_t*)(vtr_base + 16 * 72 + 16 * db));
                va[db] = (bf16x8){r0[0], r0[1], r0[2], r0[3], r1[0], r1[1], r1[2], r1[3]}; }
            const int shl = (str == 16) ? 4 : (str == 4 ? 2 : 0);
            if (mode & 1) ATT_CLS(O0, m0, l0, qf0, tq0);
            if (mode & 2) ATT_CLS(O1, m1, l1, qf1, tq0 + 4);
            if (mode & 4) ATT_CLS(O2, m2, l2, qf2, tq0 + 8);
            if (mode & 8) ATT_CLS(O3, m3, l3, qf3, tq0 + 12);
#pragma unroll
            for (int i = 0; i < 4; ++i) { kc[i] = kn[i]; vc[i] = vn[i]; }
            kst = kstn; str = strn; mode = moden;
        }
#undef ATT_DEC
#undef ATT_LOAD
#undef ATT_CLS
        bf16* op = CAT + ((size_t)b * SEQ + tq0) * DM + GW + h * 64 + 4 * fq;
#define ATT_OUT(O_, l_, ci_) do { float lt = l_; lt += __shfl_xor(lt, 16); lt += __shfl_xor(lt, 32); const float inv = 1.0f / lt; \
            _Pragma("unroll") for (int db = 0; db < 4; ++db) { v2u w; w.x = pk2(O_[db][0] * inv, O_[db][1] * inv); w.y = pk2(O_[db][2] * inv, O_[db][3] * inv); *(v2u*)(op + (ci_) * 4 * DM + 16 * db) = w; } } while (0)
        ATT_OUT(O0, l0, 0); ATT_OUT(O1, l1, 1); ATT_OUT(O2, l2, 2); ATT_OUT(O3, l3, 3);
#undef ATT_OUT
    }
}

__device__ __forceinline__ void attn_simple(const Args& A, int tid, int lane, int wave) {
    const bf16* PROJ = (const bf16*)(A.ws + WS_PROJ); bf16* CAT = (bf16*)(A.ws + WS_CAT);
    unsigned* ctr = (unsigned*)(A.ws + WS_CTL);
    for (;;) {
        unsigned wt_ = 0; if (lane == 0) wt_ = atomicAdd(ctr, 1u); const int wt = __builtin_amdgcn_readfirstlane(wt_);
        if (wt >= (M / 64) * AH) break;
        const int h = wt % AH, tb = wt / AH, row = tb * 64 + lane, b = row / SEQ, t = row % SEQ;
        float q[64], acc[64];
        { const v4u* qp = (const v4u*)(PROJ + (size_t)row * NP + PC_QB + h * 64);
#pragma unroll
          for (int j = 0; j < 8; ++j) { const v4u w = qp[j]; q[8 * j + 0] = bflo(w.x) * 0.125f; q[8 * j + 1] = bfhi(w.x) * 0.125f; q[8 * j + 2] = bflo(w.y) * 0.125f; q[8 * j + 3] = bfhi(w.y) * 0.125f;
              q[8 * j + 4] = bflo(w.z) * 0.125f; q[8 * j + 5] = bfhi(w.z) * 0.125f; q[8 * j + 6] = bflo(w.w) * 0.125f; q[8 * j + 7] = bfhi(w.w) * 0.125f; } }
#pragma unroll
        for (int j = 0; j < 64; ++j) acc[j] = 0.f;
        float mx = -1e30f, l = 0.f;
        for (int br = 0; br < 3; ++br) {
            const int stride = br == 0 ? 1 : (br == 1 ? 4 : 16);
            for (int i = 0; i <= 128; ++i) {
                const int tk = t - i * stride; if (tk < 0) break;
                const size_t krow = (size_t)(b * SEQ + tk) * NP;
                const v4u* kp = (const v4u*)(PROJ + krow + PC_KB + h * 64); const v4u* vp = (const v4u*)(PROJ + krow + PC_VB + h * 64);
                float s = 0.f;
#pragma unroll
                for (int j = 0; j < 8; ++j) { const v4u w = kp[j]; s += q[8 * j + 0] * bflo(w.x) + q[8 * j + 1] * bfhi(w.x) + q[8 * j + 2] * bflo(w.y) + q[8 * j + 3] * bfhi(w.y)
                                                                       + q[8 * j + 4] * bflo(w.z) + q[8 * j + 5] * bfhi(w.z) + q[8 * j + 6] * bflo(w.w) + q[8 * j + 7] * bfhi(w.w); }
                const float mn = fmaxf(mx, s), sc = __expf(mx - mn), p = __expf(s - mn); mx = mn; l = l * sc + p;
#pragma unroll
                for (int j = 0; j < 8; ++j) { const v4u w = vp[j];
                    acc[8 * j + 0] = acc[8 * j + 0] * sc + p * bflo(w.x); acc[8 * j + 1] = acc[8 * j + 1] * sc + p * bfhi(w.x); acc[8 * j + 2] = acc[8 * j + 2] * sc + p * bflo(w.y); acc[8 * j + 3] = acc[8 * j + 3] * sc + p * bfhi(w.y);
                    acc[8 * j + 4] = acc[8 * j + 4] * sc + p * bflo(w.z); acc[8 * j + 5] = acc[8 * j + 5] * sc + p * bfhi(w.z); acc[8 * j + 6] = acc[8 * j + 6] * sc + p * bflo(w.w); acc[8 * j + 7] = acc[8 * j + 7] * sc + p * bfhi(w.w); }
            }
        }
        const float inv = 1.0f / l; v4u* op = (v4u*)(CAT + (size_t)row * DM + GW + h * 64);
#pragma unroll
        for (int j = 0; j < 8; ++j) { v4u w; w.x = pk2(acc[8 * j] * inv, acc[8 * j + 1] * inv); w.y = pk2(acc[8 * j + 2] * inv, acc[8 * j + 3] * inv); w.z = pk2(acc[8 * j + 4] * inv, acc[8 * j + 5] * inv); w.w = pk2(acc[8 * j + 6] * inv, acc[8 * j + 7] * inv); op[j] = w; }
    }
}
__device__ __forceinline__ void gated_norm(const Args& A, int lane, int wave) {
    const bf16* PROJ = (const bf16*)(A.ws + WS_PROJ); bf16* CAT = (bf16*)(A.ws + WS_CAT); const float* OA = (const float*)(A.ws + WS_OA); const float* gw = A.in[6];
    const float w0 = gw[2 * lane], w1 = gw[2 * lane + 1];
    const int gwv = blockIdx.x * NWAVES + wave, NGW = gridDim.x * NWAVES;
    for (int wt0 = gwv; wt0 < M * GH; wt0 += 8 * NGW) {
        float2 o[8]; unsigned zz[8];
#pragma unroll
        for (int i = 0; i < 8; ++i) { const int wt = min(wt0 + i * NGW, M * GH - 1), row = wt / GH, h = wt % GH;
            o[i] = *(const float2*)(OA + (size_t)row * GW + h * 128 + 2 * lane); zz[i] = *(const unsigned*)(PROJ + (size_t)row * NP + PC_Z + h * 128 + 2 * lane); }
#pragma unroll
        for (int i = 0; i < 8; ++i) { const int wt = wt0 + i * NGW; if (wt >= M * GH) break; const int row = wt / GH, h = wt % GH;
            const float ms = wave_sum(o[i].x * o[i].x + o[i].y * o[i].y) * (1.0f / 128.0f), r = rsqrtf(ms + RMS_EPS);
            *(unsigned*)(CAT + (size_t)row * DM + h * 128 + 2 * lane) = pk2(o[i].x * r * w0 * silu_f(bflo(zz[i])), o[i].y * r * w1 * silu_f(bfhi(zz[i]))); }
    }
}

__device__ __forceinline__ void gated_norm_bh(const Args& A, int bh, int lane, int wave) {
    const int b = bh >> 2, h = bh & 3;
    const bf16* Zp = (const bf16*)(A.ws + WS_PROJ) + (size_t)b * SEQ * NP + PC_Z + h * 128 + 2 * lane; bf16* Cp = (bf16*)(A.ws + WS_CAT) + (size_t)b * SEQ * DM + h * 128 + 2 * lane;
    const float* Op = (const float*)(A.ws + WS_OA) + (size_t)b * SEQ * GW + h * 128 + 2 * lane; const float* gw = A.in[6];
    const float w0 = gw[2 * lane], w1 = gw[2 * lane + 1];
    __builtin_amdgcn_fence(__ATOMIC_ACQUIRE, "agent");
#pragma unroll 1
    for (int r0 = wave * 16; r0 < SEQ; r0 += NWAVES * 16) {
        float2 o[16]; unsigned zz[16];
#pragma unroll
        for (int i = 0; i < 16; ++i) { o[i] = *(const float2*)(Op + (size_t)(r0 + i) * GW); zz[i] = *(const unsigned*)(Zp + (size_t)(r0 + i) * NP); }
#pragma unroll
        for (int i = 0; i < 16; ++i) { const float ms = wave_sum(o[i].x * o[i].x + o[i].y * o[i].y) * (1.0f / 128.0f), r = rsqrtf(ms + RMS_EPS);
            *(unsigned*)(Cp + (size_t)(r0 + i) * DM) = pk2(o[i].x * r * w0 * silu_f(bflo(zz[i])), o[i].y * r * w1 * silu_f(bfhi(zz[i]))); }
    }
}
__device__ __forceinline__ void ffn_conv_half(const Args& A, int half, int tid) {
    const bf16* Y = (const bf16*)(A.ws + WS_Y); bf16* ACT = (bf16*)(A.ws + WS_ACT); const float* fw = A.in[10];
    constexpr int HC = DFF / 2;
    for (size_t it = (size_t)blockIdx.x * NTHR + tid; it < (size_t)M * (HC / 8); it += (size_t)gridDim.x * NTHR) {
        const int row = (int)(it / (HC / 8)), g8 = (int)(it % (HC / 8)), cl = g8 * 8, pn = cl >> 7, j = cl & 127, t = row % SEQ, ch = half * HC + cl;
        float ga[8], ua[8];
#pragma unroll
        for (int e = 0; e < 8; ++e) { ga[e] = 0.f; ua[e] = 0.f; }
#pragma unroll
        for (int i = 0; i < 3; ++i) { const int ts = t - 2 + i; if (ts < 0) continue;
            const bf16* yr = Y + (size_t)(row - 2 + i) * DFF + 256 * pn + j; const v4u g = *(const v4u*)yr, u = *(const v4u*)(yr + 128);
            const f32x4 wg0 = *(const f32x4*)(fw + i * NUP + ch), wg1 = *(const f32x4*)(fw + i * NUP + ch + 4), wu0 = *(const f32x4*)(fw + i * NUP + DFF + ch), wu1 = *(const f32x4*)(fw + i * NUP + DFF + ch + 4);
            ga[0] += wg0.x * bflo(g.x); ga[1] += wg0.y * bfhi(g.x); ga[2] += wg0.z * bflo(g.y); ga[3] += wg0.w * bfhi(g.y); ga[4] += wg1.x * bflo(g.z); ga[5] += wg1.y * bfhi(g.z); ga[6] += wg1.z * bflo(g.w); ga[7] += wg1.w * bfhi(g.w);
            ua[0] += wu0.x * bflo(u.x); ua[1] += wu0.y * bfhi(u.x); ua[2] += wu0.z * bflo(u.y); ua[3] += wu0.w * bfhi(u.y); ua[4] += wu1.x * bflo(u.z); ua[5] += wu1.y * bfhi(u.z); ua[6] += wu1.z * bflo(u.w); ua[7] += wu1.w * bfhi(u.w); }
        v4u o; o.x = pk2(silu_f(ga[0]) * ua[0], silu_f(ga[1]) * ua[1]); o.y = pk2(silu_f(ga[2]) * ua[2], silu_f(ga[3]) * ua[3]); o.z = pk2(silu_f(ga[4]) * ua[4], silu_f(ga[5]) * ua[5]); o.w = pk2(silu_f(ga[6]) * ua[6], silu_f(ga[7]) * ua[7]);
        *(v4u*)(ACT + (size_t)row * DFF + ch) = o;
    }
}

__device__ __forceinline__ void ffn_fixup(const Args& A, int tid) {
    const float* YH = (const float*)(A.ws + WS_YH); const float* UP = (const float*)(A.ws + WS_UPART); bf16* ACT = (bf16*)(A.ws + WS_ACT); const float* fw = A.in[10];
    for (int it = blockIdx.x * NTHR + tid; it < 64 * 22 * 2 * 128; it += gridDim.x * NTHR) {
        const int c = it & 127, r = (it >> 7) & 1, tile = it >> 8, pm = tile / 22, pn = tile % 22; if ((pm & 7) == 0) continue;
        const int ch = pn * 128 + c; const float* up = UP + ((size_t)tile * 2 + r) * 256; const float* yh = YH + (size_t)((pm - 1) * 22 + pn) * 2 * 256;
        float g = up[c], u = up[128 + c];
        const float wg0 = fw[ch], wg1 = fw[5632 + ch], wu0 = fw[2816 + ch], wu1 = fw[5632 + 2816 + ch];
        if (r == 0) { g += wg0 * yh[c] + wg1 * yh[256 + c]; u += wu0 * yh[128 + c] + wu1 * yh[256 + 128 + c]; }
        else { g += wg0 * yh[256 + c]; u += wu0 * yh[256 + 128 + c]; }
        ACT[(size_t)(pm * 256 + r) * DFF + ch] = (bf16)(pk2(silu_f(g) * u, 0.f) & 0xffffu);
    }
}
__device__ __forceinline__ void final_norm(const Args& A, int lane, int wave) {
    float* out = A.out; const f32x4* nr = (const f32x4*)A.in[12] + lane;
    const int gw = blockIdx.x * NWAVES + wave, NGW = gridDim.x * NWAVES;
    f32x4 nw[4];
#pragma unroll
    for (int j = 0; j < 4; ++j) nw[j] = nr[64 * j];
    for (int m0 = gw; m0 < M; m0 += 4 * NGW) {
        f32x4 v[4][4];
#pragma unroll
        for (int rr = 0; rr < 4; ++rr) { const int m = min(m0 + rr * NGW, M - 1); const f32x4* xr = (const f32x4*)(out + (size_t)m * DM) + lane;
#pragma unroll
            for (int j = 0; j < 4; ++j) v[rr][j] = xr[64 * j]; }
#pragma unroll
        for (int rr = 0; rr < 4; ++rr) { const int m = m0 + rr * NGW; if (m >= M) break; float s = 0.f;
#pragma unroll
            for (int j = 0; j < 4; ++j) s += (v[rr][j].x * v[rr][j].x + v[rr][j].y * v[rr][j].y) + (v[rr][j].z * v[rr][j].z + v[rr][j].w * v[rr][j].w);
            const float rstd = rsqrtf(wave_sum(s) * (1.f / DM) + RMS_EPS); f32x4* xw = (f32x4*)(out + (size_t)m * DM) + lane;
#pragma unroll
            for (int j = 0; j < 4; ++j) xw[64 * j] = (f32x4){v[rr][j].x * rstd * nw[j].x, v[rr][j].y * rstd * nw[j].y, v[rr][j].z * rstd * nw[j].z, v[rr][j].w * rstd * nw[j].w}; }
    }
}

#define XB_TMO      128
#define XB_XCNT(j)  (256  + 64 * (j))
#define XB_XSUB(j)  (1280 + 64 * (j))
#define XB_XGEN(j)  (2304 + 64 * (j))
#define XB_TOP      3328
#define XB_TOPGEN   3392
#define XCD_BAR_WORDS 3456
#define XB_SPIN_CAP (1u << 18)

__device__ __forceinline__ unsigned xb_ld(unsigned* p)              { return __hip_atomic_load(p, __ATOMIC_RELAXED, __HIP_MEMORY_SCOPE_AGENT); }
__device__ __forceinline__ unsigned xb_add(unsigned* p, unsigned v) { return __hip_atomic_fetch_add(p, v, __ATOMIC_RELAXED, __HIP_MEMORY_SCOPE_AGENT); }
__device__ __forceinline__ unsigned xb_xcc_id() { return (unsigned)__builtin_amdgcn_s_getreg((3 << 11) | 20) & 0xFu; }
#define XB_SPIN(cond, bar) do { unsigned _sp = 0; while (cond) { __builtin_amdgcn_s_sleep(1); \
    if ((++_sp & 255u) == 0u) { if (xb_ld(&(bar)[XB_TMO])) break; if (_sp > XB_SPIN_CAP) { atomicAdd(&(bar)[XB_TMO], 1u); break; } } } } while (0)

struct XcdBarrier {
    unsigned* bar; unsigned x;
    volatile LAS unsigned* st;
};

__device__ __forceinline__ XcdBarrier xcd_barrier_post(unsigned* bar, volatile LAS unsigned* st) {
    XcdBarrier b; b.bar = bar; b.x = xb_xcc_id(); b.st = st;
    if (threadIdx.x == 0) (void)xb_add(&bar[XB_XCNT(b.x)], 1u);
    return b;
}
__device__ __forceinline__ void xcd_barrier_complete(unsigned* bar, unsigned x, unsigned& nloc, unsigned& nx) {
    const unsigned G = gridDim.x * gridDim.y * gridDim.z;
    unsigned sum, cnt, mine, sp = 0u;
    for (;;) {
        sum = 0u; cnt = 0u; mine = 0u;
#pragma unroll
        for (unsigned j = 0; j < 16; ++j) { const unsigned c = xb_ld(&bar[XB_XCNT(j)]); sum += c; cnt += (c > 0u) ? 1u : 0u; mine = (j == x) ? c : mine; }
        if (sum == G) break;
        __builtin_amdgcn_s_sleep(1);
        if ((++sp & 255u) == 0u) { if (xb_ld(&bar[XB_TMO])) break; if (sp > XB_SPIN_CAP) { atomicAdd(&bar[XB_TMO], 1u); break; } }
    }
    nloc = mine > 0u ? mine : 1u; nx = cnt > 0u ? cnt : 1u;
}

__device__ __forceinline__ void xcd_barrier(const XcdBarrier& b) {
    asm volatile("s_waitcnt vmcnt(0)" ::: "memory");
    __syncthreads();
    if (threadIdx.x == 0) {
        unsigned* bar = b.bar;
        __builtin_amdgcn_s_waitcnt(0);
        unsigned nloc = b.st[0], nx = b.st[1];
        if (nloc == 0u) { xcd_barrier_complete(bar, b.x, nloc, nx); b.st[0] = nloc; b.st[1] = nx; }
        const unsigned old = xb_add(&bar[XB_XSUB(b.x)], 1u);
        const unsigned gen = old / nloc;
        if (old + 1u == (gen + 1u) * nloc) {
            __builtin_amdgcn_fence(__ATOMIC_RELEASE, "agent");
            asm volatile("s_waitcnt vmcnt(0)" ::: "memory");
            const unsigned og = xb_add(&bar[XB_TOP], 1u);
            const unsigned tg = og / nx;
            if (og + 1u == (tg + 1u) * nx) xb_add(&bar[XB_TOPGEN], 1u);
            else XB_SPIN(xb_ld(&bar[XB_TOPGEN]) == tg, bar);
            __builtin_amdgcn_fence(__ATOMIC_ACQUIRE, "agent");
            xb_add(&bar[XB_XGEN(b.x)], 1u);
            asm volatile("s_waitcnt vmcnt(0)" ::: "memory");
        } else {
            XB_SPIN(xb_ld(&bar[XB_XGEN(b.x)]) == gen, bar);
            __builtin_amdgcn_fence(__ATOMIC_ACQUIRE, "agent");
            asm volatile("s_waitcnt vmcnt(0)" ::: "memory");
        }
    }
    __syncthreads();
}

constexpr int N_PHASES = 8;
__global__ void __launch_bounds__(NTHR, 2) mk_fwd(Args args) {
    extern __shared__ __attribute__((aligned(16))) unsigned char lds_raw[];
    LAS unsigned char* lds = (LAS unsigned char*)lds_raw;
    const int tid = threadIdx.x, lane = tid & 63, wave = __builtin_amdgcn_readfirstlane(tid >> 6);
    const int lo = args.ph_lo, hi = args.ph_hi;
    unsigned char* ws = args.ws;
    bf16* WIN = (bf16*)(ws + WS_WIN); bf16* WOUT = (bf16*)(ws + WS_WOUT); bf16* WUP = (bf16*)(ws + WS_WUP); bf16* WDN = (bf16*)(ws + WS_WDN);
    bf16* XN = (bf16*)(ws + WS_XN); bf16* PROJ = (bf16*)(ws + WS_PROJ); bf16* CAT = (bf16*)(ws + WS_CAT); bf16* Y = (bf16*)(ws + WS_Y); bf16* ACT = (bf16*)(ws + WS_ACT);
    float* SSQ = (float*)(ws + WS_SSQ);
#define IN(k) (lo <= (k) && (k) < hi)
#define SEAM(k) do { if (IN(k) && IN((k) + 1)) { xcd_barrier(bar); } } while (0)
    { volatile LAS unsigned* st = (volatile LAS unsigned*)(lds + LDS_BYTES - 64); if (tid < 2) st[tid] = 0u; }
    __syncthreads();
    XcdBarrier bar = xcd_barrier_post((unsigned*)(ws + WS_CTL) + 4096, (volatile LAS unsigned*)(lds + LDS_BYTES - 64));
    if (args.coop > 1) cg::this_grid().sync();
    if (IN(0)) { p0_prologue(args, lds, tid, lane, wave); } SEAM(0);
    if (IN(1)) { pg8::Gemm g{XN, WIN, M, NP, DM}; pg8::StaticOrder S; S.init(M, NP, gridDim.x, blockIdx.x); pg8::EpiBf16S E{PROJ, NP, nullptr};
        pg8::gemm_phase<pg8::EpiBf16S, pg8::StaticOrder, PG8_ALIGN, PG8_SP2>(lds, g, S, E);
        { pg8::Unit u4; const bool idle4 = !S.next(3, u4); const int G = gridDim.x, nidle = (G == 256) ? 128 : G;
          if (G != 256) convert_late_weights(args, lds, lane, wave, blockIdx.x * NWAVES + wave, G * NWAVES);
          else if (idle4) convert_late_weights(args, lds, lane, wave, (blockIdx.x - 128) * NWAVES + wave, nidle * NWAVES); } } SEAM(1);
    if (IN(2)) { gdn_prep(args, lds, tid, lane, wave); } SEAM(2);
    if (IN(3)) { if (blockIdx.x < NB * GH) gdn_scan(args, lds, blockIdx.x, tid, lane, wave); attn_fast(args, lds, lane, wave); xcd_barrier(bar); gated_norm(args, lane, wave); } SEAM(3);
    if (IN(4)) { pg8::Gemm g{CAT, WOUT, M, DM, DM}; pg8::StaticOrder S; S.init(M, DM, gridDim.x, blockIdx.x); pg8::EpiResid E{args.in[0], (gridDim.x == 256) ? nullptr : args.out, XN, SSQ, DM};
        pg8::gemm_phase<pg8::EpiResid, pg8::StaticOrder, PG8_ALIGN, PG8_SP2>(lds, g, S, E); } SEAM(4);
    if (IN(5)) { pg8::Gemm g{XN, WUP, M, NUP, DM}; pg8::StaticOrder S; S.init(M, NUP, gridDim.x, blockIdx.x);
        static_assert(pg8::EpiConvGate::CG_SSQ == WS_SSQ && pg8::EpiConvGate::CG_ACT == WS_ACT && pg8::EpiConvGate::CG_YH == WS_YH && pg8::EpiConvGate::CG_UPART == WS_UPART, "d_ws map");
        pg8::EpiConvGate E{ws, args.in[10], lds};
        pg8::gemm_phase<pg8::EpiConvGate, pg8::StaticOrder, true, PG8_SP2>(lds, g, S, E); } SEAM(5);
    if (IN(6)) { ffn_fixup(args, tid); } SEAM(6);
    if (IN(7)) { pg8::Gemm g{ACT, WDN, M, DM, DFF}; pg8::StaticOrder S; S.init(M, DM, gridDim.x, blockIdx.x);
        if (gridDim.x == 256) {
            pg8::EpiResidNorm E{XN, args.out, (float*)(ws + WS_SSQ2), (unsigned*)(ws + WS_CTL) + 2048, args.in[12], DM};
            pg8::gemm_phase<pg8::EpiResidNorm, pg8::StaticOrder, true, PG8_SP2>(lds, g, S, E);
        } else {
            pg8::EpiResid E{args.out, args.out, nullptr, nullptr, DM};
            pg8::gemm_phase<pg8::EpiResid, pg8::StaticOrder, PG8_ALIGN, PG8_SP2>(lds, g, S, E);
            xcd_barrier(bar); final_norm(args, lane, wave);
        } }
#undef IN
#undef SEAM
}

#ifndef MK_ONE_LAUNCH
#define MK_ONE_LAUNCH 1
#endif
extern "C" void kernel_launch(void* const* d_in, const int* in_sizes, int n_in, void* d_out, int out_size, void* d_ws, size_t ws_size, hipStream_t stream) {
    static int grid = 0;
    if (grid == 0) {
        if (n_in != 13 || out_size != M * DM || ws_size < WS_END) { fprintf(stderr, "kernel_launch: unexpected shapes n_in %d out %d ws %zu\n", n_in, out_size, ws_size); grid = -1; return; }
        int dev = 0, cus = 0, per_cu = 0;
        hipGetDevice(&dev); hipDeviceGetAttribute(&cus, hipDeviceAttributeMultiprocessorCount, dev);
        hipFuncSetAttribute((const void*)mk_fwd, hipFuncAttributeMaxDynamicSharedMemorySize, LDS_BYTES);
        hipOccupancyMaxActiveBlocksPerMultiprocessor(&per_cu, (const void*)mk_fwd, NTHR, LDS_BYTES);
        (void)hipGetLastError();
        if (per_cu < 1) { fprintf(stderr, "kernel_launch: occupancy query says %d blocks per CU\n", per_cu); per_cu = 1; }
        grid = cus;
    }
    if (grid < 0) return;
    if (hipMemsetAsync((char*)d_ws + WS_CTL, 0, 65536, stream) != hipSuccess) { fprintf(stderr, "kernel_launch: memset failed\n"); return; }
    Args a{};
    for (int i = 0; i < 13; ++i) a.in[i] = (const float*)d_in[i];
    a.out = (float*)d_out; a.ws = (unsigned char*)d_ws;
#if MK_ONE_LAUNCH
    a.ph_lo = 0; a.ph_hi = N_PHASES; a.coop = 1;
    void* kargs[] = {&a};
    hipError_t e = hipLaunchCooperativeKernel((const void*)mk_fwd, dim3(grid), dim3(NTHR), kargs, LDS_BYTES, stream);
    if (e != hipSuccess) fprintf(stderr, "cooperative launch failed: %s (grid %d)\n", hipGetErrorString(e), grid);
#else
    for (int p = 0; p < N_PHASES; ++p) { a.ph_lo = p; a.ph_hi = p + 1; a.coop = 0; hipLaunchKernelGGL(mk_fwd, dim3(grid), dim3(NTHR), LDS_BYTES, stream, a); }
#endif
}
```

```cpp
#include <hip/hip_runtime.h>
#include <hip/hip_cooperative_groups.h>
#include <cstdio>
#include <cstdint>
namespace cg = cooperative_groups;
namespace pg8 {
#define PG8_LAS __attribute__((address_space(3)))
typedef unsigned short bf16_t;
typedef short bf16x8 __attribute__((ext_vector_type(8)));
typedef float f32x4 __attribute__((ext_vector_type(4)));
typedef unsigned u32x4 __attribute__((ext_vector_type(4)));
constexpr int BM = 256, BK = 64, HALF = 128, HTB = HALF * BK * 2  , STAGE_BYTES = 8 * HTB, NXCD = 8, WGM = 8;

__host__ __device__ __forceinline__ int lds_byte(int r, int c) { const int st = (r >> 4) * 2 + (c >> 5), rr = r & 15, cc = c & 31, ob = rr * 64 + cc * 2; return st * 1024 + (ob ^ (((ob >> 9) & 1) << 5)); }
__host__ __device__ __forceinline__ void stage_rc(int b, int& R, int& C) { const int st = b / 1024, sb = b % 1024, swz = sb ^ (((sb >> 9) & 1) << 5); R = (st >> 1) * 16 + swz / 64; C = (st & 1) * 32 + (swz % 64) / 2; }
__host__ __device__ __forceinline__ int perm32(int rho) { const int n = rho >> 4, i = rho & 15; return 8 * (i >> 2) + 4 * n + (i & 3); }

struct Unit { int pm, pn; };
struct Gemm { const bf16_t* A; const bf16_t* Bt; int M, N, K; };

struct StaticOrder {
    int nM, nN, nwg, G, c;
    __host__ __device__ __forceinline__ void init(int M, int N, int G_, int c_) { nM = M / BM; nN = N / BM; nwg = nM * nN; G = G_; c = c_; }
    __host__ __device__ __forceinline__ bool next(int i, Unit& u) const {
        const long L = (long)i * G + c; if (L >= nwg) return false;
        int wgid = (int)L; { const int q = nwg / NXCD, r = nwg % NXCD, xcd = wgid % NXCD, off = wgid / NXCD; wgid = (xcd < r ? xcd * (q + 1) : r * (q + 1) + (xcd - r) * q) + off; }
        const int nig = WGM * nN, gid = wgid / nig, fm = gid * WGM, gsz = (nM - fm) < WGM ? (nM - fm) : WGM;
        u.pm = fm + ((wgid % nig) % gsz); u.pn = (wgid % nig) / gsz; return true;
    }
    __device__ __forceinline__ void a_ready(const Unit&) const {}
    __device__ __forceinline__ void done(const Unit&) const {}
};

__device__ __forceinline__ unsigned cvt_pk_bf16(float lo, float hi) { unsigned r; asm volatile("v_cvt_pk_bf16_f32 %0, %1, %2" : "=v"(r) : "v"(lo), "v"(hi)); return r; }
constexpr float RMS_EPS = 1e-6f;
struct EpiBf16S {
    static constexpr bool PERM = true, AFTER_DRAIN = false;
    bf16_t* O; int ldc; const float* ssq;
    __device__ __forceinline__ void operator()(const f32x4 (&acc)[2][2][4][2], const Unit& u, int wr, int wc, int fr, int fq) const {
        const int row0 = u.pm * BM + wr * 64 + fr; const int col0 = u.pn * BM + wc * 32 + 8 * fq;
#pragma unroll
        for (int ai = 0; ai < 2; ++ai)
#pragma unroll
            for (int m = 0; m < 4; ++m) { const int row = row0 + ai * HALF + m * 16; bf16_t* rowp = O + (size_t)row * ldc + col0;
                const float sc = ssq ? rsqrtf(ssq[row] * (1.0f / 1024.0f) + RMS_EPS) : 1.0f;
#pragma unroll
                for (int bj = 0; bj < 2; ++bj) { const f32x4 v0 = acc[ai][bj][m][0] * sc, v1 = acc[ai][bj][m][1] * sc;
                    u32x4 w; w.x = cvt_pk_bf16(v0[0], v0[1]); w.y = cvt_pk_bf16(v0[2], v0[3]); w.z = cvt_pk_bf16(v1[0], v1[1]); w.w = cvt_pk_bf16(v1[2], v1[3]);
                    *(u32x4*)(rowp + bj * HALF) = w; } }
    }
};
struct EpiResid {
    static constexpr bool PERM = false, AFTER_DRAIN = false;
    const float* base; float* out; bf16_t* xb; float* ssq; int ldc;
    __device__ __forceinline__ void operator()(const f32x4 (&acc)[2][2][4][2], const Unit& u, int wr, int wc, int fr, int fq) const {
        typedef unsigned u32x2v __attribute__((ext_vector_type(2)));
        const int col0 = u.pn * BM + wc * 32 + 4 * fq;
#pragma unroll
        for (int ai = 0; ai < 2; ++ai) {
            f32x4 bv[4][2][2];
#pragma unroll
            for (int m = 0; m < 4; ++m) { const size_t off = (size_t)(u.pm * BM + ai * HALF + wr * 64 + m * 16 + fr) * ldc + col0;
#pragma unroll
                for (int bj = 0; bj < 2; ++bj)
#pragma unroll
                    for (int n = 0; n < 2; ++n) bv[m][bj][n] = *(const f32x4*)(base + off + bj * HALF + n * 16); }
#pragma unroll
            for (int m = 0; m < 4; ++m) { const int row = u.pm * BM + ai * HALF + wr * 64 + m * 16 + fr; const size_t off = (size_t)row * ldc + col0; float s = 0.f;
#pragma unroll
                for (int bj = 0; bj < 2; ++bj)
#pragma unroll
                    for (int n = 0; n < 2; ++n) { const f32x4 v = acc[ai][bj][m][n] + bv[m][bj][n];
                        if (out) *(f32x4*)(out + off + bj * HALF + n * 16) = v; s += (v[0] * v[0] + v[1] * v[1]) + (v[2] * v[2] + v[3] * v[3]);
                        if (xb) { u32x2v w; w.x = cvt_pk_bf16(v[0], v[1]); w.y = cvt_pk_bf16(v[2], v[3]); *(u32x2v*)(xb + off + bj * HALF + n * 16) = w; } }
                if (ssq) { s += __shfl_xor(s, 16); s += __shfl_xor(s, 32); if (fq == 0) atomicAdd(ssq + row, s); } }
            asm volatile("" ::: "memory");
        }
    }
};

__device__ __forceinline__ float dpp_ror1(float v) { return __builtin_bit_cast(float, __builtin_amdgcn_mov_dpp(__builtin_bit_cast(int, v), 0x121, 0xf, 0xf, true)); }
__device__ __forceinline__ float dpp_ror2(float v) { return __builtin_bit_cast(float, __builtin_amdgcn_mov_dpp(__builtin_bit_cast(int, v), 0x122, 0xf, 0xf, true)); }
struct EpiConvGate {
    static constexpr bool PERM = true, AFTER_DRAIN = false;
    static constexpr size_t CG_SSQ = (1u << 20) + 768 * 1024, CG_ACT = (size_t)148 << 20, CG_YH = (size_t)236 << 20, CG_UPART = (size_t)240 << 20;
    unsigned char* ws; const float* fw; PG8_LAS unsigned char* ldsb;
    __device__ __forceinline__ void operator()(f32x4 (&acc)[2][2][4][2], const Unit& u, int wr, int wc, int fr0, int fq0) const {
        int fr = fr0, fq = fq0; asm volatile("" : "+v"(fr), "+v"(fq));
        bf16_t* ACT = (bf16_t*)(ws + CG_ACT); const float* ssq = (const float*)(ws + CG_SSQ); float* YH = (float*)(ws + CG_YH); float* UPART = (float*)(ws + CG_UPART);
        PG8_LAS float* halo = (PG8_LAS float*)(ldsb + STAGE_BYTES);
        int cl = wc * 32 + 8 * fq;
        int ch = u.pn * 128 + cl;
        if (fr >= 14) {
#pragma unroll
            for (int ai = 0; ai < 2; ++ai) { const float sc = rsqrtf(ssq[u.pm * BM + ai * HALF + wr * 64 + 48 + fr] * (1.0f / 1024.0f) + RMS_EPS);
#pragma unroll
                for (int bj = 0; bj < 2; ++bj)
#pragma unroll
                    for (int n = 0; n < 2; ++n) { const f32x4 v = acc[ai][bj][3][n] * sc; *(PG8_LAS f32x4*)(halo + (((wr * 2 + ai) * 2 + (fr - 14)) * 256 + bj * 128 + cl + 4 * n)) = v;
                        if (ai == 1 && wr == 1) *(f32x4*)(YH + ((size_t)(u.pm * 22 + u.pn) * 2 + (fr - 14)) * 256 + bj * 128 + cl + 4 * n) = v; } }
        }
        asm volatile("s_waitcnt lgkmcnt(0)" ::: "memory"); __builtin_amdgcn_s_barrier(); asm volatile("" ::: "memory");
        typedef unsigned u32x2v __attribute__((ext_vector_type(2)));
        float scv[2][4];
#pragma unroll
        for (int ai = 0; ai < 2; ++ai)
#pragma unroll
            for (int m = 0; m < 4; ++m) scv[ai][m] = rsqrtf(ssq[u.pm * BM + ai * HALF + wr * 64 + m * 16 + fr] * (1.0f / 1024.0f) + RMS_EPS);
#pragma unroll 1
        for (int n = 0; n < 2; ++n) {
            asm volatile("" : "+v"(fr), "+v"(fq));
            cl = wc * 32 + 8 * fq; ch = u.pn * 128 + cl;
            f32x4 w[3][2];
#pragma unroll
            for (int i = 0; i < 3; ++i)
#pragma unroll
                for (int bj = 0; bj < 2; ++bj) w[i][bj] = *(const f32x4*)(fw + (size_t)i * 5632 + bj * 2816 + ch + 4 * n);
#pragma unroll
            for (int ai = 0; ai < 2; ++ai) {
                const bool top = (ai == 0 && wr == 0);
                const int pblk = (ai == 0) ? 0 : (wr == 0 ? 2 : 1);
                f32x4 q1[2], q2[2];
#pragma unroll
                for (int bj = 0; bj < 2; ++bj) { const f32x4 pv = top ? (f32x4){0.f, 0.f, 0.f, 0.f} : *(const PG8_LAS f32x4*)(halo + ((pblk * 2 + (fr & 1)) * 256 + bj * 128 + cl + 4 * n));
#pragma unroll
                    for (int k = 0; k < 4; ++k) { q1[bj][k] = dpp_ror1(pv[k]); q2[bj][k] = dpp_ror2(pv[k]); } }
#pragma unroll
                for (int m = 0; m < 4; ++m) {
                    const int row = u.pm * BM + ai * HALF + wr * 64 + m * 16 + fr; const float sc = scv[ai][m];
                    f32x4 cu[2];
#pragma unroll
                    for (int bj = 0; bj < 2; ++bj) { const f32x4 ya = acc[ai][bj][m][0];
#pragma unroll
                        for (int k = 0; k < 4; ++k) { const float y = ya[k] * sc;
                            const float a1 = dpp_ror1(y), a2 = dpp_ror2(y);
                            const float p1 = (fr == 0) ? q1[bj][k] : a1, p2 = (fr < 2) ? q2[bj][k] : a2;
                            cu[bj][k] = w[2][bj][k] * y + w[1][bj][k] * p1 + w[0][bj][k] * p2; q1[bj][k] = a1; q2[bj][k] = a2; } }
                    if (top && m == 0 && fr < 2 && (u.pm & 7) != 0) {
#pragma unroll
                        for (int bj = 0; bj < 2; ++bj) *(f32x4*)(UPART + ((size_t)(u.pm * 22 + u.pn) * 2 + fr) * 256 + bj * 128 + cl + 4 * n) = cu[bj];
                    }
                    u32x2v o;
#define PG8_SG(k_) (cu[0][k_] * __builtin_amdgcn_rcpf(1.0f + __expf(-cu[0][k_])) * cu[1][k_])
                    o.x = cvt_pk_bf16(PG8_SG(0), PG8_SG(1)); o.y = cvt_pk_bf16(PG8_SG(2), PG8_SG(3));
#undef PG8_SG
                    *(u32x2v*)(ACT + (size_t)row * 2816 + ch + 4 * n) = o;
                    asm volatile("" ::: "memory");
                }
            }
            if (n == 0) {
#pragma unroll
                for (int ai = 0; ai < 2; ++ai)
#pragma unroll
                    for (int bj = 0; bj < 2; ++bj)
#pragma unroll
                        for (int m = 0; m < 4; ++m) acc[ai][bj][m][0] = acc[ai][bj][m][1];
            }
        }
        asm volatile("s_waitcnt lgkmcnt(0)" ::: "memory"); __builtin_amdgcn_s_barrier(); asm volatile("" ::: "memory");
    }
};

struct EpiResidNorm {
    static constexpr bool PERM = false, AFTER_DRAIN = false;
    const bf16_t* base; float* out; float* ssq2; unsigned* cnt; const float* fnw; int ldc;
    __device__ __forceinline__ void operator()(f32x4 (&acc)[2][2][4][2], const Unit& u, int wr, int wc, int fr, int fq) const {
        typedef unsigned u32x2v __attribute__((ext_vector_type(2)));
        const int col0 = u.pn * BM + wc * 32 + 4 * fq;
#pragma unroll
        for (int ai = 0; ai < 2; ++ai) {
            u32x2v bv[4][2][2];
#pragma unroll
            for (int m = 0; m < 4; ++m) { const size_t off = (size_t)(u.pm * BM + ai * HALF + wr * 64 + m * 16 + fr) * ldc + col0;
#pragma unroll
                for (int bj = 0; bj < 2; ++bj)
#pragma unroll
                    for (int n = 0; n < 2; ++n) bv[m][bj][n] = *(const u32x2v*)(base + off + bj * HALF + n * 16); }
#pragma unroll
            for (int m = 0; m < 4; ++m) { const int row = u.pm * BM + ai * HALF + wr * 64 + m * 16 + fr; float s = 0.f;
#pragma unroll
                for (int bj = 0; bj < 2; ++bj)
#pragma unroll
                    for (int n = 0; n < 2; ++n) { const u32x2v bw = bv[m][bj][n]; const f32x4 v = acc[ai][bj][m][n] + (f32x4){__uint_as_float(bw.x << 16), __uint_as_float(bw.x & 0xffff0000u), __uint_as_float(bw.y << 16), __uint_as_float(bw.y & 0xffff0000u)}; acc[ai][bj][m][n] = v; s += (v[0] * v[0] + v[1] * v[1]) + (v[2] * v[2] + v[3] * v[3]); }
                s += __shfl_xor(s, 16); s += __shfl_xor(s, 32);
                if (fq == 0) (void)__hip_atomic_fetch_add(ssq2 + row, s, __ATOMIC_RELAXED, __HIP_MEMORY_SCOPE_AGENT); }
            asm volatile("" ::: "memory");
        }
        asm volatile("s_waitcnt vmcnt(0)" ::: "memory"); __builtin_amdgcn_s_barrier(); asm volatile("" ::: "memory");
        if (wr == 0 && wc == 0 && fr == 0 && fq == 0) {
            __builtin_amdgcn_fence(__ATOMIC_RELEASE, "agent"); asm volatile("s_waitcnt vmcnt(0)" ::: "memory");
            (void)__hip_atomic_fetch_add(cnt + 16 * u.pm, 1u, __ATOMIC_RELAXED, __HIP_MEMORY_SCOPE_AGENT);
            unsigned sp = 0;
            while (__hip_atomic_load(cnt + 16 * u.pm, __ATOMIC_RELAXED, __HIP_MEMORY_SCOPE_AGENT) < 4u) { __builtin_amdgcn_s_sleep(1); if (++sp > (1u << 22)) break; }
            __builtin_amdgcn_fence(__ATOMIC_ACQUIRE, "agent"); asm volatile("s_waitcnt vmcnt(0)" ::: "memory");
        }
        __builtin_amdgcn_s_barrier(); asm volatile("" ::: "memory");
        f32x4 nw[2][2];
#pragma unroll
        for (int bj = 0; bj < 2; ++bj)
#pragma unroll
            for (int n = 0; n < 2; ++n) nw[bj][n] = *(const f32x4*)(fnw + col0 + bj * HALF + n * 16);
#pragma unroll
        for (int ai = 0; ai < 2; ++ai)
#pragma unroll
            for (int m = 0; m < 4; ++m) { const int row = u.pm * BM + ai * HALF + wr * 64 + m * 16 + fr; const size_t off = (size_t)row * ldc + col0;
                const float rstd = rsqrtf(__hip_atomic_load(ssq2 + row, __ATOMIC_RELAXED, __HIP_MEMORY_SCOPE_AGENT) * (1.0f / 1024.0f) + RMS_EPS);
#pragma unroll
                for (int bj = 0; bj < 2; ++bj)
#pragma unroll
                    for (int n = 0; n < 2; ++n) { const f32x4 v = acc[ai][bj][m][n]; *(f32x4*)(out + off + bj * HALF + n * 16) = (f32x4){v[0] * rstd * nw[bj][n][0], v[1] * rstd * nw[bj][n][1], v[2] * rstd * nw[bj][n][2], v[3] * rstd * nw[bj][n][3]}; } }
    }
};
template <class Epi, class Sched, bool ALIGN_EPI = false, bool SP2 = false>
__device__ __forceinline__ void gemm_phase(PG8_LAS unsigned char* lds, const Gemm g, const Sched& S, const Epi& E) {
    const int tid = threadIdx.x, wid = __builtin_amdgcn_readfirstlane(tid >> 6), lane = tid & 63, wr = wid >> 2, wc = wid & 3, fr = lane & 15, fq = lane >> 4;
    const int K = g.K, nt = K / BK;
    unsigned voffA[2], voffB[2];
#pragma unroll
    for (int i = 0; i < 2; ++i) { int R, C; stage_rc(tid * 16 + i * 8192, R, C); const int Rb = Epi::PERM ? ((R & ~31) + perm32(R & 31)) : R;
        voffA[i] = (unsigned)(R * K + C) * 2u; voffB[i] = (unsigned)(Rb * K + C) * 2u; }
    const size_t kstep = (size_t)(BK * 2);
    const size_t hstep = (size_t)HALF * K * 2;
    const size_t tstep = 2 * hstep;
    const unsigned ldsw = (unsigned)wid * 1024u;
    const int aoff = lds_byte(wr * 64 + fr, fq * 8), boff = lds_byte(wc * 32 + fr, fq * 8);
#define PG8_SA(b, h) (((b) * 2 + (h)) * HTB)
#define PG8_SB(b, h) ((4 + (b) * 2 + (h)) * HTB)
#define PG8_STAGE(bufoff, gbase, voff) do { _Pragma("unroll") for (int _i = 0; _i < 2; ++_i) \
        __builtin_amdgcn_global_load_lds((const unsigned*)((const char*)(gbase) + (voff)[_i]), (PG8_LAS unsigned*)(lds + (bufoff) + ldsw + _i * 8192), 16, 0, 0); } while (0)
#define PG8_LDA(dst, b, h) do { _Pragma("unroll") for (int m = 0; m < 4; ++m) _Pragma("unroll") for (int k = 0; k < 2; ++k) dst[m][k] = *(const PG8_LAS bf16x8*)(lds + PG8_SA(b, h) + aoff + m * 2048 + k * 1024); } while (0)
#define PG8_LDB(dst, b, h) do { _Pragma("unroll") for (int n = 0; n < 2; ++n) _Pragma("unroll") for (int k = 0; k < 2; ++k) dst[n][k] = *(const PG8_LAS bf16x8*)(lds + PG8_SB(b, h) + boff + n * 2048 + k * 1024); } while (0)
#define PG8_MMA(ai, bj, At, Bt) do { __builtin_amdgcn_s_setprio(1); _Pragma("unroll") for (int m = 0; m < 4; ++m) _Pragma("unroll") for (int n = 0; n < 2; ++n) _Pragma("unroll") for (int k = 0; k < 2; ++k) \
        acc[ai][bj][m][n] = __builtin_amdgcn_mfma_f32_16x16x32_bf16(Bt[n][k], At[m][k], acc[ai][bj][m][n], 0, 0, 0); __builtin_amdgcn_s_setprio(0); } while (0)
#define PG8_WAIT_V(n) asm volatile("s_waitcnt vmcnt(" #n ")" ::: "memory")
#define PG8_WAIT_L(n) asm volatile("s_waitcnt lgkmcnt(" #n ")" ::: "memory")
#define PG8_BAR __builtin_amdgcn_s_barrier()
#define PG8_SCHED __builtin_amdgcn_sched_barrier(0)
    Unit cur, nxt; int ui = 0;
    if (!S.next(0, cur)) return;
    f32x4 acc[2][2][4][2];
#pragma unroll
    for (int a = 0; a < 2; ++a)
#pragma unroll
        for (int b = 0; b < 2; ++b)
#pragma unroll
            for (int m = 0; m < 4; ++m)
#pragma unroll
                for (int n = 0; n < 2; ++n) acc[a][b][m][n] = (f32x4){0.f, 0.f, 0.f, 0.f};
    bf16x8 At[4][2], B0[2][2], B1[2][2];
    const char* cA = (const char*)g.A + (size_t)cur.pm * tstep; const char* cB = (const char*)g.Bt + (size_t)cur.pn * tstep;
    S.a_ready(cur);
    if constexpr (SP2) {
        PG8_STAGE(PG8_SB(0, 0), cB, voffB); PG8_STAGE(PG8_SB(0, 1), cB + hstep, voffB); PG8_STAGE(PG8_SA(0, 0), cA, voffA); PG8_STAGE(PG8_SA(0, 1), cA + hstep, voffA);
        if (wr == 1) PG8_BAR;
        PG8_WAIT_V(2); PG8_BAR;
        PG8_STAGE(PG8_SB(1, 0), cB + kstep, voffB); PG8_STAGE(PG8_SA(1, 0), cA + kstep, voffA); PG8_STAGE(PG8_SB(1, 1), cB + hstep + kstep, voffB);
        PG8_WAIT_V(6); PG8_BAR;
    } else {
        PG8_STAGE(PG8_SB(0, 0), cB, voffB); PG8_STAGE(PG8_SA(0, 0), cA, voffA); PG8_STAGE(PG8_SB(0, 1), cB + hstep, voffB); PG8_STAGE(PG8_SA(0, 1), cA + hstep, voffA);
        if (wr == 1) PG8_BAR;
        PG8_WAIT_V(4); PG8_BAR;
        PG8_STAGE(PG8_SB(1, 0), cB + kstep, voffB); PG8_STAGE(PG8_SA(1, 0), cA + kstep, voffA); PG8_STAGE(PG8_SB(1, 1), cB + hstep + kstep, voffB);
        PG8_WAIT_V(6); PG8_BAR;
    }
    for (;;) {
        const bool has_next = S.next(ui + 1, nxt);
        const char* nA = has_next ? (const char*)g.A + (size_t)nxt.pm * tstep : cA; const char* nB = has_next ? (const char*)g.Bt + (size_t)nxt.pn * tstep : cB;
        for (int t = 0; t < nt; t += 2) {
            const bool last = (t == nt - 2);
            const char* a1 = cA + (size_t)(t + 1) * kstep;
            const char* a2 = last ? nA : cA + (size_t)(t + 2) * kstep; const char* b2 = last ? nB : cB + (size_t)(t + 2) * kstep;
            const char* a3 = a2 + kstep; const char* b3 = b2 + kstep;
            if (last && has_next) S.a_ready(nxt);
            if constexpr (SP2) {
            PG8_LDB(B0, 0, 0); PG8_LDB(B1, 0, 1); PG8_SCHED; PG8_LDA(At, 0, 0); PG8_STAGE(PG8_SA(1, 1), a1 + hstep, voffA);
            PG8_WAIT_V(8); PG8_WAIT_L(0); PG8_BAR; PG8_MMA(0, 0, At, B0); PG8_MMA(0, 1, At, B1); PG8_BAR; PG8_SCHED;
            PG8_LDA(At, 0, 1); PG8_STAGE(PG8_SB(0, 0), b2, voffB); PG8_STAGE(PG8_SB(0, 1), b2 + hstep, voffB); PG8_STAGE(PG8_SA(0, 0), a2, voffA);
            PG8_WAIT_V(8); PG8_WAIT_L(0); PG8_BAR; PG8_MMA(1, 0, At, B0); PG8_MMA(1, 1, At, B1); PG8_BAR; PG8_SCHED;
            PG8_LDB(B0, 1, 0); PG8_LDB(B1, 1, 1); PG8_SCHED; PG8_LDA(At, 1, 0); PG8_STAGE(PG8_SA(0, 1), a2 + hstep, voffA);
            PG8_WAIT_V(8); PG8_WAIT_L(0); PG8_BAR; PG8_MMA(0, 0, At, B0); PG8_MMA(0, 1, At, B1); PG8_BAR; PG8_SCHED;
            PG8_LDA(At, 1, 1); PG8_STAGE(PG8_SB(1, 0), b3, voffB); PG8_STAGE(PG8_SB(1, 1), b3 + hstep, voffB); PG8_STAGE(PG8_SA(1, 0), a3, voffA);
            PG8_WAIT_V(8); PG8_WAIT_L(0); PG8_BAR; PG8_MMA(1, 0, At, B0); PG8_MMA(1, 1, At, B1); PG8_BAR; PG8_SCHED;
            } else {
            PG8_LDB(B0, 0, 0); PG8_SCHED; PG8_LDA(At, 0, 0); PG8_STAGE(PG8_SA(1, 1), a1 + hstep, voffA);
            PG8_WAIT_L(8); PG8_BAR; PG8_WAIT_L(0); PG8_MMA(0, 0, At, B0); PG8_BAR; PG8_SCHED;
            PG8_LDB(B1, 0, 1); PG8_STAGE(PG8_SB(0, 0), b2, voffB);
            PG8_BAR; PG8_WAIT_L(0); PG8_MMA(0, 1, At, B1); PG8_BAR;
            PG8_LDA(At, 0, 1); PG8_STAGE(PG8_SA(0, 0), a2, voffA);
            PG8_BAR; PG8_WAIT_L(0); PG8_MMA(1, 0, At, B0); PG8_BAR; PG8_SCHED;
            PG8_STAGE(PG8_SB(0, 1), b2 + hstep, voffB);
            PG8_WAIT_V(6); PG8_BAR; PG8_MMA(1, 1, At, B1); PG8_BAR;
            PG8_LDB(B0, 1, 0); PG8_SCHED; PG8_LDA(At, 1, 0); PG8_STAGE(PG8_SA(0, 1), a2 + hstep, voffA);
            PG8_WAIT_L(8); PG8_BAR; PG8_WAIT_L(0); PG8_MMA(0, 0, At, B0); PG8_BAR; PG8_SCHED;
            PG8_LDB(B1, 1, 1); PG8_STAGE(PG8_SB(1, 0), b3, voffB);
            PG8_BAR; PG8_WAIT_L(0); PG8_MMA(0, 1, At, B1); PG8_BAR;
            PG8_LDA(At, 1, 1); PG8_STAGE(PG8_SA(1, 0), a3, voffA);
            PG8_BAR; PG8_WAIT_L(0); PG8_MMA(1, 0, At, B0); PG8_BAR; PG8_SCHED;
            PG8_STAGE(PG8_SB(1, 1), b3 + hstep, voffB);
            PG8_WAIT_V(6); PG8_BAR; PG8_MMA(1, 1, At, B1); PG8_BAR;
            }
        }
        if constexpr (ALIGN_EPI) { if (wr == 0) PG8_BAR; }
        if constexpr (!Epi::AFTER_DRAIN) { E(acc, cur, wr, wc, fr, fq); S.done(cur); }
        if (!has_next) break;
#pragma unroll
        for (int a = 0; a < 2; ++a)
#pragma unroll
            for (int b = 0; b < 2; ++b)
#pragma unroll
                for (int m = 0; m < 4; ++m)
#pragma unroll
                    for (int n = 0; n < 2; ++n) acc[a][b][m][n] = (f32x4){0.f, 0.f, 0.f, 0.f};
        cur = nxt; cA = nA; cB = nB; ++ui;
        if constexpr (ALIGN_EPI) { if (wr == 1) PG8_BAR; }
    }
    PG8_WAIT_V(0);
    if constexpr (!ALIGN_EPI) { if (wr == 0) PG8_BAR; }
    PG8_BAR;
    if constexpr (Epi::AFTER_DRAIN) { E.fused(acc, cur, wr, wc, fr, fq, lds, wid, lane); S.done(cur); }
#undef PG8_SA
#undef PG8_SB
#undef PG8_STAGE
#undef PG8_LDA
#undef PG8_LDB
#undef PG8_MMA
#undef PG8_WAIT_V
#undef PG8_WAIT_L
#undef PG8_BAR
#undef PG8_SCHED
}
}
#ifndef PG8_SP2
#define PG8_SP2 true
#endif
#ifndef PG8_ALIGN
#define PG8_ALIGN true
#endif
constexpr int NB = 8, SEQ = 2048, DM = 1024, M = NB * SEQ;
constexpr int GH = 4, GD = 128, GW = 512, AH = 8, AD = 64;
constexpr int INC = 3592, NP = 3584;
constexpr int DFF = 2816, NUP = 2 * DFF;
constexpr int PC_QA = 0, PC_KA = 512, PC_VA = 1024, PC_Z = 1536, PC_QB = 2048, PC_KB = 2560, PC_VB = 3072;
constexpr size_t MiB = 1u << 20;
constexpr size_t WS_CTL = 0, WS_AB = 1 * MiB, WS_SSQ = 1 * MiB + 768 * 1024, WS_WIN = 2 * MiB, WS_WOUT = 9 * MiB, WS_WUP = 11 * MiB, WS_WDN = 22 * MiB;
constexpr size_t WS_XN = 28 * MiB, WS_PROJ = 60 * MiB, WS_CAT = 172 * MiB, WS_OA = 204 * MiB, WS_Y = 60 * MiB, WS_ACT = 148 * MiB, WS_END = 256 * MiB;
using pg8::RMS_EPS;
constexpr size_t WS_YH = 236 * MiB, WS_UPART = 240 * MiB;
constexpr size_t WS_SSQ2 = WS_SSQ + 131072;
constexpr size_t WS_GE = WS_SSQ + 65536;
constexpr int GOPS_CHUNK = 57344;
constexpr int SCAN_BUF = GOPS_CHUNK + 16384;
constexpr int NWAVES = 8, NTHR = 512;
constexpr int LDS_BYTES = 155648;
#define LAS __attribute__((address_space(3)))
typedef unsigned short bf16;
typedef unsigned v4u __attribute__((ext_vector_type(4)));
typedef unsigned v2u __attribute__((ext_vector_type(2)));
typedef float f32x4 __attribute__((ext_vector_type(4)));
__device__ __forceinline__ float bf2f(unsigned b) { return __uint_as_float(b << 16); }
__device__ __forceinline__ float bflo(unsigned w) { return __uint_as_float(w << 16); }
__device__ __forceinline__ float bfhi(unsigned w) { return __uint_as_float(w & 0xffff0000u); }
__device__ __forceinline__ unsigned pk2(float lo, float hi) { return pg8::cvt_pk_bf16(lo, hi); }
__device__ __forceinline__ float wave_sum(float v) {
    v += __builtin_bit_cast(float, __builtin_amdgcn_mov_dpp(__builtin_bit_cast(int, v), 0xB1, 0xf, 0xf, true));
    v += __builtin_bit_cast(float, __builtin_amdgcn_mov_dpp(__builtin_bit_cast(int, v), 0x4E, 0xf, 0xf, true));
    v += __builtin_bit_cast(float, __builtin_amdgcn_mov_dpp(__builtin_bit_cast(int, v), 0x141, 0xf, 0xf, true));
    v += __builtin_bit_cast(float, __builtin_amdgcn_mov_dpp(__builtin_bit_cast(int, v), 0x140, 0xf, 0xf, true));
    auto a = __builtin_amdgcn_permlane16_swap(__float_as_uint(v), __float_as_uint(v), false, false); v = __uint_as_float(a[0]) + __uint_as_float(a[1]);
    auto b = __builtin_amdgcn_permlane32_swap(__float_as_uint(v), __float_as_uint(v), false, false); return __uint_as_float(b[0]) + __uint_as_float(b[1]);
}
__device__ __forceinline__ float silu_f(float x) { return x * __builtin_amdgcn_rcpf(1.0f + __expf(-x)); }
__device__ __forceinline__ float sigmoid_f(float x) { return __builtin_amdgcn_rcpf(1.0f + __expf(-x)); }
__device__ __forceinline__ float softplus_f(float x) { return x > 20.f ? x : log1pf(__expf(x)); }

struct Args { const float* in[13]; float* out; unsigned char* ws; int ph_lo, ph_hi, coop, pad; };

__device__ __forceinline__ void p0_transpose_item(const float* W, int ldw, int k0, int sn0, bf16* WT, int K, int dn0, const float* kscale, LAS float* scr, int lane) {
    float tv[32];
#pragma unroll
    for (int i = 0; i < 32; ++i) { const int kk = 2 * i + (lane >> 5); tv[i] = W[(size_t)(k0 + kk) * ldw + sn0 + (lane & 31)]; }
    if (kscale) {
#pragma unroll
        for (int i = 0; i < 32; ++i) tv[i] *= kscale[k0 + 2 * i + (lane >> 5)]; }
#pragma unroll
    for (int i = 0; i < 32; ++i) scr[(2 * i + (lane >> 5)) * 33 + (lane & 31)] = tv[i];
    asm volatile("s_waitcnt lgkmcnt(0)" ::: "memory");
    const int c = lane & 7;
#pragma unroll
    for (int j = 0; j < 4; ++j) { const int n = (lane >> 3) + 8 * j; const LAS float* s = scr + (8 * c) * 33 + n;
        v4u o; o.x = pk2(s[0 * 33], s[1 * 33]); o.y = pk2(s[2 * 33], s[3 * 33]); o.z = pk2(s[4 * 33], s[5 * 33]); o.w = pk2(s[6 * 33], s[7 * 33]);
        *(v4u*)(WT + (size_t)(dn0 + n) * K + k0 + 8 * c) = o; }
    asm volatile("s_waitcnt lgkmcnt(0)" ::: "memory");
}

__device__ __forceinline__ void p0_prologue(const Args& A, LAS unsigned char* lds, int tid, int lane, int wave) {
    const float* x = A.in[0]; const float* nw1 = A.in[1]; const float* w_in = A.in[2]; const float* w_out = A.in[7]; const float* nw2 = A.in[8];
    const float* w_up = A.in[9]; const float* w_dn = A.in[11];
    unsigned char* ws = A.ws;
    bf16* WIN = (bf16*)(ws + WS_WIN); bf16* WOUT = (bf16*)(ws + WS_WOUT); bf16* WUP = (bf16*)(ws + WS_WUP); bf16* WDN = (bf16*)(ws + WS_WDN);
    bf16* XN = (bf16*)(ws + WS_XN); float* AB = (float*)(ws + WS_AB); float* SSQ = (float*)(ws + WS_SSQ);
    LAS float* scr = (LAS float*)(lds + wave * 9216);
    LAS float* wab = (LAS float*)(lds + 73728);
    const int G = gridDim.x, gw = blockIdx.x * NWAVES + wave, NGW = G * NWAVES;
    for (int i = blockIdx.x * NTHR + tid; i < M; i += G * NTHR) { SSQ[i] = 0.f; ((float*)(ws + WS_SSQ2))[i] = 0.f; }
    if (blockIdx.x == 0 && tid < 64) ((unsigned*)(ws + WS_CTL))[tid] = 0u;
    for (int idx = tid; idx < 8192; idx += NTHR) { const int k = idx >> 3, j = idx & 7; wab[j * 1024 + k] = nw1[k] * w_in[(size_t)k * INC + 2048 + j]; }
    constexpr int I_IN = 16 * (NP / 32);
    for (int it = gw; it < I_IN; it += NGW) { const int nblk = NP / 32, kb = it / nblk, nb = it % nblk, n0 = 32 * nb; p0_transpose_item(w_in, INC, 64 * kb, n0 + (n0 >= 2048 ? 8 : 0), WIN, DM, n0, nullptr, scr, lane); }
    __syncthreads();
    for (int m0 = gw; m0 < M; m0 += 2 * NGW) {
        const f32x4* nr = (const f32x4*)nw1 + lane;
        f32x4 v[2][4]; float s[2] = {0.f, 0.f};
#pragma unroll
        for (int rr = 0; rr < 2; ++rr) { const int m = min(m0 + rr * NGW, M - 1); const f32x4* xr = (const f32x4*)(x + (size_t)m * DM) + lane;
#pragma unroll
            for (int j = 0; j < 4; ++j) v[rr][j] = xr[64 * j]; }
#pragma unroll
        for (int rr = 0; rr < 2; ++rr)
#pragma unroll
            for (int j = 0; j < 4; ++j) s[rr] += (v[rr][j].x * v[rr][j].x + v[rr][j].y * v[rr][j].y) + (v[rr][j].z * v[rr][j].z + v[rr][j].w * v[rr][j].w);
#pragma unroll
        for (int rr = 0; rr < 2; ++rr) { const int m = m0 + rr * NGW; if (m >= M) break;
            const float rstd = rsqrtf(wave_sum(s[rr]) * (1.f / DM) + RMS_EPS);
            float ab[8];
#pragma unroll
            for (int q = 0; q < 8; ++q) { float a = 0.f;
#pragma unroll
                for (int j = 0; j < 4; ++j) { const f32x4 w = *(const LAS f32x4*)(wab + q * 1024 + 256 * j + 4 * lane); a += (v[rr][j].x * w.x + v[rr][j].y * w.y) + (v[rr][j].z * w.z + v[rr][j].w * w.w); }
                ab[q] = wave_sum(a) * rstd; }
            if (lane == 0) { *(f32x4*)(AB + (size_t)m * 8) = (f32x4){ab[0], ab[1], ab[2], ab[3]}; *(f32x4*)(AB + (size_t)m * 8 + 4) = (f32x4){ab[4], ab[5], ab[6], ab[7]}; }
            v2u* o8 = (v2u*)(XN + (size_t)m * DM) + lane;
#pragma unroll
            for (int j = 0; j < 4; ++j) { const f32x4 n = nr[64 * j]; v2u o; o.x = pk2(v[rr][j].x * rstd * n.x, v[rr][j].y * rstd * n.y); o.y = pk2(v[rr][j].z * rstd * n.z, v[rr][j].w * rstd * n.w); o8[64 * j] = o; }
        }
    }
}


__device__ __forceinline__ void convert_late_weights(const Args& A, LAS unsigned char* lds, int lane, int wave, int gw0, int ngw) {
    const float* w_out = A.in[7]; const float* nw2 = A.in[8]; const float* w_up = A.in[9]; const float* w_dn = A.in[11];
    bf16* WOUT = (bf16*)(A.ws + WS_WOUT); bf16* WUP = (bf16*)(A.ws + WS_WUP); bf16* WDN = (bf16*)(A.ws + WS_WDN);
    LAS float* scr = (LAS float*)(lds + wave * 9216);
    constexpr int I_OUT = 16 * 32, I_UP = 16 * (NUP / 32), I_DN = (DFF / 64) * 32;
    for (int it = gw0; it < I_OUT + I_UP + I_DN; it += ngw) {
        int r = it;
        if (r < I_OUT) { const int kb = r / 32, nb = r % 32; p0_transpose_item(w_out, DM, 64 * kb, 32 * nb, WOUT, DM, 32 * nb, nullptr, scr, lane); continue; } r -= I_OUT;
        if (r < I_UP) { const int nblk = NUP / 32, kb = r / nblk, nb = r % nblk, n0 = 32 * nb, pn = n0 >> 8, j0 = n0 & 255;
            const int s0 = (j0 < 128) ? (128 * pn + j0) : (DFF + 128 * pn + j0 - 128);
            p0_transpose_item(w_up, NUP, 64 * kb, s0, WUP, DM, n0, nw2, scr, lane); continue; } r -= I_UP;
        { const int kb = r / 32, nb = r % 32; p0_transpose_item(w_dn, DM, 64 * kb, 32 * nb, WDN, DFF, 32 * nb, nullptr, scr, lane); }
    }
}
__device__ __forceinline__ void gdn_simple(const Args& A, LAS unsigned char* lds, int tid, int lane, int wave) {
    const bf16* PROJ = (const bf16*)(A.ws + WS_PROJ); const float* AB = (const float*)(A.ws + WS_AB); float* OA = (float*)(A.ws + WS_OA);
    const float* cw = A.in[3]; const float* a_log = A.in[4]; const float* dt_bias = A.in[5];
    LAS float* qs = (LAS float*)lds; LAS float* ks = qs + 16 * 128; LAS float* vs = ks + 16 * 128; LAS float* av = vs + 16 * 128; LAS float* bv = av + 16;
    for (int task = blockIdx.x; task < NB * GH; task += gridDim.x) {
        const int b = task / GH, h = task % GH, v = tid >> 2, part = tid & 3;
        float S[32];
#pragma unroll
        for (int i = 0; i < 32; ++i) S[i] = 0.f;
        const float Ah = __expf(a_log[h]), dtb = dt_bias[h];
        for (int blk = 0; blk < SEQ / 16; ++blk) {
            const int t0 = blk * 16;
            for (int idx = tid; idx < 16 * 384; idx += NTHR) {
                const int tt = idx / 384, c = idx % 384, which = c >> 7, d = c & 127, col = which * 512 + h * 128 + d, t = t0 + tt;
                float acc = 0.f;
#pragma unroll
                for (int i = 0; i < 4; ++i) { const int ts = t - 3 + i; if (ts >= 0) acc += cw[i * 1536 + col] * bf2f(PROJ[(size_t)(b * SEQ + ts) * NP + col]); }
                qs[which * 2048 + tt * 128 + d] = silu_f(acc);
            }
            if (tid < 16) { const size_t row = (size_t)b * SEQ + t0 + tid; bv[tid] = sigmoid_f(AB[row * 8 + h]); av[tid] = __expf(-Ah * softplus_f(AB[row * 8 + 4 + h] + dtb)); }
            __syncthreads();
#pragma unroll
            for (int r = 0; r < 4; ++r) { const int row = 4 * wave + r; LAS float* arr = qs + row * 128;
                const float v0 = arr[lane], v1 = arr[lane + 64]; const float s = wave_sum(v0 * v0 + v1 * v1);
                const float sc = rsqrtf(s + RMS_EPS) * (row < 16 ? 0.08838834764831845f : 1.0f); arr[lane] = v0 * sc; arr[lane + 64] = v1 * sc; }
            __syncthreads();
            for (int tt = 0; tt < 16; ++tt) {
                const float a = av[tt], bt = bv[tt], vt = vs[tt * 128 + v];
                float kS = 0.f;
#pragma unroll
                for (int i = 0; i < 32; ++i) kS += ks[tt * 128 + 32 * part + i] * S[i];
                kS += __shfl_xor(kS, 1); kS += __shfl_xor(kS, 2);
                const float c = bt * (vt - a * kS); float o = 0.f;
#pragma unroll
                for (int i = 0; i < 32; ++i) { S[i] = a * S[i] + ks[tt * 128 + 32 * part + i] * c; o += qs[tt * 128 + 32 * part + i] * S[i]; }
                o += __shfl_xor(o, 1); o += __shfl_xor(o, 2);
                if (part == 0) OA[(size_t)(b * SEQ + t0 + tt) * GW + h * 128 + v] = o;
            }
            __syncthreads();
        }
    }
}


template <int J, int K, int N> struct SolveLd {
    static __device__ __forceinline__ void run(f32x4 (&l)[4], unsigned lbase) {
        if constexpr (K < N) { constexpr int t40 = ((J + 1) >> 2) << 2;
            asm volatile("ds_read_b128 %0, %1 offset:%2" : "=v"(l[K]) : "v"(lbase), "i"((J * 68 + t40 + 4 * K) * 4)); SolveLd<J, K + 1, N>::run(l, lbase); }
    }
};
template <int J> struct SolveCol16 {
    static __device__ __forceinline__ void run(float (&R)[16], unsigned lbase) {
        if constexpr (J < 15) {
            constexpr int t40 = ((J + 1) >> 2) << 2, nld = (16 - t40) >> 2;
            f32x4 l[4];
            SolveLd<J, 0, nld>::run(l, lbase);
            asm volatile("s_waitcnt lgkmcnt(0)" ::: "memory");
#pragma unroll
            for (int k = 0; k < nld; ++k) asm volatile("" : "+v"(l[k]));
#pragma unroll
            for (int k = 0; k < nld; ++k) {
#pragma unroll
                for (int e = 0; e < 4; ++e) if (t40 + 4 * k + e > J) R[t40 + 4 * k + e] += l[k][e] * R[J]; }
            SolveCol16<J + 1>::run(R, lbase);
        }
    }
};

typedef short bf16x8 __attribute__((ext_vector_type(8)));
__device__ __forceinline__ void gdn_prep(const Args& A, LAS unsigned char* lds, int tid0, int lane0, int wave) {
    const bf16* PROJ = (const bf16*)(A.ws + WS_PROJ); const float* AB = (const float*)(A.ws + WS_AB);
    const float* cw = A.in[3]; const float* a_log = A.in[4]; const float* dt_bias = A.in[5];
    unsigned char* UVF = A.ws + WS_XN; unsigned char* GOPS = (unsigned char*)A.out; float* GE = (float*)(A.ws + WS_GE);
    LAS float* Qs = (LAS float*)lds; LAS float* Ks = (LAS float*)(lds + 33792); LAS float* Vs = (LAS float*)(lds + 67584);
    LAS bf16* Qb = (LAS bf16*)(lds + 101376); LAS bf16* Kb = (LAS bf16*)(lds + 118784);
    LAS float* gcs = (LAS float*)(lds + 136192); LAS float* bts = gcs + 64; LAS float* egs = gcs + 128; LAS float* kes = gcs + 192;
    LAS float* LsT = (LAS float*)lds; LAS bf16* ATs = (LAS bf16*)(lds + 17408); LAS bf16* WKs = Kb;
    v4u rwn[11];
    if (tid0 < 384 && (int)blockIdx.x < NB * GH * 32) { const int c8 = tid0 % 48, run = tid0 / 48, which = c8 >> 4, d0 = (c8 & 15) * 8, t1 = blockIdx.x, bh1 = t1 >> 5, n1 = t1 & 31, b1 = bh1 >> 2, h1 = bh1 & 3, col1 = which * 512 + h1 * 128 + d0;
#pragma unroll
        for (int r = 0; r < 11; ++r) { const int ts = 64 * n1 + 8 * run - 3 + r; rwn[r] = (ts >= 0) ? *(const v4u*)(PROJ + (size_t)(b1 * SEQ + ts) * NP + col1) : (v4u){0u, 0u, 0u, 0u}; } }
    else {
#pragma unroll
        for (int r = 0; r < 11; ++r) rwn[r] = (v4u){0u, 0u, 0u, 0u}; }
#pragma unroll 1
    for (int task = blockIdx.x; task < NB * GH * 32; task += gridDim.x) {
        int tid = tid0, lane = lane0; asm volatile("" : "+v"(tid), "+v"(lane));
        const int fr = lane & 15, fq = lane >> 4;
        const int bh = task >> 5, n = task & 31, b = bh >> 2, h = bh & 3, t0 = 64 * n, row0 = b * SEQ + t0;
        unsigned char* gops = GOPS + (size_t)task * GOPS_CHUNK;
        if (tid < 384) {
            const int c8 = tid % 48, run = tid / 48, which = c8 >> 4, d0 = (c8 & 15) * 8, col = which * 512 + h * 128 + d0;
            v4u rw[11];
#pragma unroll
            for (int r = 0; r < 11; ++r) rw[r] = rwn[r];
            { const int tn = task + gridDim.x;
              if (tn < NB * GH * 32) { const int bhn = tn >> 5, nn = tn & 31, bn = bhn >> 2, hn = bhn & 3, coln = which * 512 + hn * 128 + d0;
#pragma unroll
                for (int r = 0; r < 11; ++r) { const int ts = 64 * nn + 8 * run - 3 + r; rwn[r] = (ts >= 0) ? *(const v4u*)(PROJ + (size_t)(bn * SEQ + ts) * NP + coln) : (v4u){0u, 0u, 0u, 0u}; } } }
            f32x4 cwa[4], cwb[4];
#pragma unroll
            for (int j = 0; j < 4; ++j) { cwa[j] = *(const f32x4*)(cw + j * 1536 + col); cwb[j] = *(const f32x4*)(cw + j * 1536 + col + 4); }
#pragma unroll
            for (int i = 0; i < 8; ++i) {
                float acc[8];
#pragma unroll
                for (int e2 = 0; e2 < 8; ++e2) acc[e2] = 0.f;
#pragma unroll
                for (int j = 0; j < 4; ++j) { const v4u w = rw[i + j];
                    acc[0] += cwa[j].x * bflo(w.x); acc[1] += cwa[j].y * bfhi(w.x); acc[2] += cwa[j].z * bflo(w.y); acc[3] += cwa[j].w * bfhi(w.y);
                    acc[4] += cwb[j].x * bflo(w.z); acc[5] += cwb[j].y * bfhi(w.z); acc[6] += cwb[j].z * bflo(w.w); acc[7] += cwb[j].w * bfhi(w.w); }
                float ss = 0.f;
#pragma unroll
                for (int e2 = 0; e2 < 8; ++e2) { acc[e2] = silu_f(acc[e2]); ss += acc[e2] * acc[e2]; }
                ss += __builtin_bit_cast(float, __builtin_amdgcn_update_dpp(0, __builtin_bit_cast(int, ss), 0xB1, 0xf, 0xf, false));
                ss += __builtin_bit_cast(float, __builtin_amdgcn_update_dpp(0, __builtin_bit_cast(int, ss), 0x4E, 0xf, 0xf, false));
                ss += __builtin_bit_cast(float, __builtin_amdgcn_update_dpp(0, __builtin_bit_cast(int, ss), 0x141, 0xf, 0xf, false));
                ss += __builtin_bit_cast(float, __builtin_amdgcn_update_dpp(0, __builtin_bit_cast(int, ss), 0x140, 0xf, 0xf, false));
                const int tt = 8 * run + i;
                if (which == 2) { *(LAS f32x4*)(Vs + tt * 132 + d0) = (f32x4){acc[0], acc[1], acc[2], acc[3]}; *(LAS f32x4*)(Vs + tt * 132 + d0 + 4) = (f32x4){acc[4], acc[5], acc[6], acc[7]}; }
                else {
                    const float sc = rsqrtf(ss + RMS_EPS) * (which == 0 ? 0.08838834764831845f : 1.0f);
#pragma unroll
                    for (int e2 = 0; e2 < 8; ++e2) acc[e2] *= sc;
                    const v4u pk = (v4u){pk2(acc[0], acc[1]), pk2(acc[2], acc[3]), pk2(acc[4], acc[5]), pk2(acc[6], acc[7])};
                    if (which == 0) *(LAS v4u*)(Qb + tt * 136 + d0) = pk;
                    else { *(LAS v4u*)(Kb + tt * 136 + d0) = pk; *(LAS f32x4*)(Ks + tt * 132 + d0) = (f32x4){acc[0], acc[1], acc[2], acc[3]}; *(LAS f32x4*)(Ks + tt * 132 + d0 + 4) = (f32x4){acc[4], acc[5], acc[6], acc[7]}; }
                }
            }
        }
        if (wave == 0) {
            const size_t row = (size_t)row0 + lane; const float beta = sigmoid_f(AB[row * 8 + h]);
            float g = -__expf(a_log[h]) * softplus_f(AB[row * 8 + 4 + h] + dt_bias[h]);
#pragma unroll
            for (int o = 1; o < 64; o <<= 1) { const float t = __shfl_up(g, o); if (lane >= o) g += t; }
            const float glast = __shfl(g, 63);
            gcs[lane] = g; bts[lane] = beta; egs[lane] = __expf(g); kes[lane] = __expf(glast - g) * beta;
            if (lane == 63) GE[task] = __expf(g);
        }
        __syncthreads();
#pragma unroll 1
        for (int jb = wave; jb < 20; jb += 8) {
            const int kind = jb >= 10 ? 1 : 0, idx = jb - 10 * kind, ti = idx < 1 ? 0 : (idx < 3 ? 1 : (idx < 6 ? 2 : 3)), tj = idx - ti * (ti + 1) / 2;
            const LAS bf16* As = kind ? Qb : Kb; f32x4 d = (f32x4){0.f, 0.f, 0.f, 0.f};
#pragma unroll
            for (int ks = 0; ks < 4; ++ks) { const bf16x8 a = *(const LAS bf16x8*)(As + (16 * ti + fr) * 136 + 32 * ks + 8 * fq), bb = *(const LAS bf16x8*)(Kb + (16 * tj + fr) * 136 + 32 * ks + 8 * fq);
                d = __builtin_amdgcn_mfma_f32_16x16x32_bf16(a, bb, d, 0, 0, 0); }
            const int j = 16 * tj + fr; const float gj = gcs[j], bj = bts[j]; float val[4];
#pragma unroll
            for (int e = 0; e < 4; ++e) { const int t = 16 * ti + 4 * fq + e; const float x = d[e] * __expf(gcs[t] - gj) * bj; val[e] = (kind ? (t >= j) : (t > j)) ? x : 0.f; }
            if (kind == 0) *(LAS f32x4*)(LsT + j * 68 + 16 * ti + 4 * fq) = (f32x4){-val[0], -val[1], -val[2], -val[3]};
            else {
#pragma unroll
                for (int e = 0; e < 4; ++e) ATs[(16 * ti + 4 * fq + e) * 72 + j] = (bf16)(pk2(val[e], 0.f) & 0xffffu); }
        }
        __syncthreads();
        LAS float* Ti = (LAS float*)(lds + 26624);
        if (wave == 0) {
            const int I = lane >> 4, c = lane & 15; float x[16];
#pragma unroll
            for (int r = 0; r < 16; ++r) x[r] = (r == c) ? 1.0f : 0.0f;
            SolveCol16<0>::run(x, (unsigned)(uintptr_t)LsT + (unsigned)(I * (16 * 68 + 16) * 4));
#pragma unroll
            for (int r = 0; r < 16; ++r) Ti[(I * 16 + r) * 20 + c] = x[r];
        } else {
            const int rt = tid - 64;
            for (int q = rt; q < 1024; q += 448) { const int blk = q >> 6, l2 = q & 63, i = l2 & 15, f = l2 >> 4, mb = blk >> 2, ks = blk & 3, t = 16 * mb + i;
                const v2u p0 = *(const LAS v2u*)(Qb + t * 136 + 32 * ks + 4 * f), p1 = *(const LAS v2u*)(Qb + t * 136 + 32 * ks + 16 + 4 * f); const float eg = egs[t];
                v4u o; o.x = pk2(bflo(p0.x) * eg, bfhi(p0.x) * eg); o.y = pk2(bflo(p0.y) * eg, bfhi(p0.y) * eg); o.z = pk2(bflo(p1.x) * eg, bfhi(p1.x) * eg); o.w = pk2(bflo(p1.y) * eg, bfhi(p1.y) * eg);
                *(v4u*)(gops + 16384 + q * 16) = o; }
            for (int q = rt; q < 512; q += 448) { const int blk = q >> 6, l2 = q & 63, i = l2 & 15, f = l2 >> 4, mb = blk >> 1, ks2 = blk & 1, t = 16 * mb + i;
                v2u p0 = (v2u){0u, 0u}, p1 = (v2u){0u, 0u};
                if (2 * ks2 <= mb) p0 = *(const LAS v2u*)(ATs + t * 72 + 32 * ks2 + 4 * f);
                if (2 * ks2 + 1 <= mb) p1 = *(const LAS v2u*)(ATs + t * 72 + 32 * ks2 + 16 + 4 * f);
                *(v4u*)(gops + 32768 + q * 16) = (v4u){p0.x, p0.y, p1.x, p1.y}; }
            for (int q = rt; q < 1024; q += 448) { const int blk = q >> 6, l2 = q & 63, i = l2 & 15, f = l2 >> 4, dkb = blk >> 1, ks2 = blk & 1, dk = 16 * dkb + i; float v[8];
#pragma unroll
                for (int e2 = 0; e2 < 8; ++e2) { const int c = 32 * ks2 + 16 * (e2 >> 2) + 4 * f + (e2 & 3); v[e2] = Ks[c * 132 + dk] * kes[c]; }
                *(v4u*)(gops + 40960 + q * 16) = (v4u){pk2(v[0], v[1]), pk2(v[2], v[3]), pk2(v[4], v[5]), pk2(v[6], v[7])}; }
        }
        __syncthreads();
#pragma unroll
        for (int ct = 0; ct < 2; ++ct) {
            const int C = 2 * wave + ct; const bool isv = C < 8; const int col = isv ? 16 * C + fr : 16 * (C - 8) + fr;
            f32x4 X[4];
#pragma unroll
            for (int I = 0; I < 4; ++I) {
                f32x4 acc;
#pragma unroll
                for (int e2 = 0; e2 < 4; ++e2) { const int t = 16 * I + 4 * fq + e2; acc[e2] = isv ? Vs[t * 132 + col] : egs[t] * Ks[t * 132 + col]; }
#pragma unroll
                for (int J = 0; J < 4; ++J) if (J < I) {
#pragma unroll
                    for (int kk = 0; kk < 4; ++kk) acc = __builtin_amdgcn_mfma_f32_16x16x4f32(LsT[(16 * J + 4 * fq + kk) * 68 + 16 * I + fr], X[J][kk], acc, 0, 0, 0); }
                f32x4 xi = (f32x4){0.f, 0.f, 0.f, 0.f};
#pragma unroll
                for (int kk = 0; kk < 4; ++kk) xi = __builtin_amdgcn_mfma_f32_16x16x4f32(Ti[(I * 16 + fr) * 20 + 4 * fq + kk], acc[kk], xi, 0, 0, 0);
                X[I] = xi;
                if (isv) { v2u w; w.x = pk2(xi[0], xi[1]); w.y = pk2(xi[2], xi[3]); *(v2u*)(UVF + (size_t)task * 16384 + (size_t)((C * 4 + I) * 64 + lane) * 8) = w; }
                else {
#pragma unroll
                    for (int e2 = 0; e2 < 4; ++e2) WKs[(16 * I + 4 * fq + e2) * 136 + col] = (bf16)(pk2(xi[e2], 0.f) & 0xffffu); }
            }
        }
        __syncthreads();
        for (int q = tid; q < 1024; q += NTHR) { const int blk = q >> 6, l2 = q & 63, i = l2 & 15, f = l2 >> 4, mb = blk >> 2, ks = blk & 3, t = 16 * mb + i;
            const v2u p0 = *(const LAS v2u*)(WKs + t * 136 + 32 * ks + 4 * f), p1 = *(const LAS v2u*)(WKs + t * 136 + 32 * ks + 16 + 4 * f);
            *(v4u*)(gops + q * 16) = (v4u){p0.x, p0.y, p1.x, p1.y}; }
        __syncthreads();
    }
}

__device__ __forceinline__ bf16x8 pack8(const f32x4 a, const f32x4 b) {
    v4u w; w.x = pk2(a[0], a[1]); w.y = pk2(a[2], a[3]); w.z = pk2(b[0], b[1]); w.w = pk2(b[2], b[3]); return __builtin_bit_cast(bf16x8, w);
}
__device__ __forceinline__ void gdn_scan(const Args& A, LAS unsigned char* lds, int bh, int tid, int lane, int wave) {
    const int b = bh >> 2, h = bh & 3, fr = lane & 15, fq = lane >> 4, vs = wave;
    const unsigned char* gops = (const unsigned char*)A.out + (size_t)bh * 32 * GOPS_CHUNK;
    const unsigned char* uvf = A.ws + WS_XN + (size_t)bh * 32 * 16384; const float* GE = (const float*)(A.ws + WS_GE) + bh * 32;
    float* Op = (float*)(A.ws + WS_OA) + ((size_t)b * SEQ + 4 * fq) * GW + h * 128 + 16 * vs + fr;
    f32x4 S[8];
#pragma unroll
    for (int i = 0; i < 8; ++i) S[i] = (f32x4){0.f, 0.f, 0.f, 0.f};
    const float gev = GE[lane & 31];
#define SCAN_DMA(chunk, bufoff) do { _Pragma("unroll") for (int i_ = 0; i_ < 9; ++i_) { const int p_ = wave + 8 * i_; \
        const unsigned char* s_ = (p_ < 56) ? (gops + (size_t)(chunk) * GOPS_CHUNK + p_ * 1024) : (uvf + (size_t)(chunk) * 16384 + (p_ - 56) * 1024); \
        __builtin_amdgcn_global_load_lds((const unsigned*)(s_ + lane * 16), (LAS unsigned*)(lds + (bufoff) + p_ * 1024), 16, 0, 0); } } while (0)
    SCAN_DMA(0, 0); SCAN_DMA(1, SCAN_BUF);
    asm volatile("s_waitcnt vmcnt(0)" ::: "memory"); __syncthreads();
#pragma unroll 1
    for (int n = 0; n < 32; ++n) {
        const LAS unsigned char* cur = lds + (n & 1) * SCAN_BUF;
        const float ge = __builtin_bit_cast(float, __builtin_amdgcn_readlane(__builtin_bit_cast(int, gev), n));
        bf16x8 Sb[4];
#pragma unroll
        for (int ks = 0; ks < 4; ++ks) Sb[ks] = pack8(S[2 * ks], S[2 * ks + 1]);
        f32x4 u[4];
#pragma unroll
        for (int mb = 0; mb < 4; ++mb) { f32x4 p = (f32x4){0.f, 0.f, 0.f, 0.f};
#pragma unroll
            for (int ks = 0; ks < 4; ++ks) p = __builtin_amdgcn_mfma_f32_16x16x32_bf16(*(const LAS bf16x8*)(cur + ((mb * 4 + ks) * 64 + lane) * 16), Sb[ks], p, 0, 0, 0);
            const v2u uw = *(const LAS v2u*)(cur + GOPS_CHUNK + ((vs * 4 + mb) * 64 + lane) * 8);
            u[mb] = (f32x4){bflo(uw.x) - p[0], bfhi(uw.x) - p[1], bflo(uw.y) - p[2], bfhi(uw.y) - p[3]}; }
        bf16x8 ub[2]; ub[0] = pack8(u[0], u[1]); ub[1] = pack8(u[2], u[3]);
        f32x4 o[4];
#pragma unroll
        for (int mb = 0; mb < 4; ++mb) { f32x4 acc = (f32x4){0.f, 0.f, 0.f, 0.f};
#pragma unroll
            for (int ks = 0; ks < 4; ++ks) acc = __builtin_amdgcn_mfma_f32_16x16x32_bf16(*(const LAS bf16x8*)(cur + 16384 + ((mb * 4 + ks) * 64 + lane) * 16), Sb[ks], acc, 0, 0, 0);
#pragma unroll
            for (int ks2 = 0; ks2 < 2; ++ks2) if (ks2 <= (mb >> 1)) acc = __builtin_amdgcn_mfma_f32_16x16x32_bf16(*(const LAS bf16x8*)(cur + 32768 + ((mb * 2 + ks2) * 64 + lane) * 16), ub[ks2], acc, 0, 0, 0);
            o[mb] = acc; }
#pragma unroll
        for (int dkb = 0; dkb < 8; ++dkb) { f32x4 acc = S[dkb] * ge;
#pragma unroll
            for (int ks2 = 0; ks2 < 2; ++ks2) acc = __builtin_amdgcn_mfma_f32_16x16x32_bf16(*(const LAS bf16x8*)(cur + 40960 + ((dkb * 2 + ks2) * 64 + lane) * 16), ub[ks2], acc, 0, 0, 0);
            S[dkb] = acc; }
        asm volatile("s_waitcnt vmcnt(0)" ::: "memory"); __syncthreads();
        if (n + 2 < 32) SCAN_DMA(n + 2, (n & 1) * SCAN_BUF);
        float* orow = Op + (size_t)(64 * n) * GW;
#pragma unroll
        for (int mb = 0; mb < 4; ++mb) { float* q = orow + (size_t)(16 * mb) * GW; q[0] = o[mb][0]; q[GW] = o[mb][1]; q[2 * GW] = o[mb][2]; q[3 * GW] = o[mb][3]; }
    }
    asm volatile("s_waitcnt vmcnt(0)" ::: "memory"); __syncthreads();
#undef SCAN_DMA
}


__device__ __forceinline__ float xmax_fq(float x) {
    auto a = __builtin_amdgcn_permlane16_swap(__float_as_uint(x), __float_as_uint(x), false, false); x = fmaxf(__uint_as_float(a[0]), __uint_as_float(a[1]));
    auto b = __builtin_amdgcn_permlane32_swap(__float_as_uint(x), __float_as_uint(x), false, false); return fmaxf(__uint_as_float(b[0]), __uint_as_float(b[1]));
}
__device__ __forceinline__ void attn_fast(const Args& A, LAS unsigned char* lds, int lane, int wave) {
    const bf16* PROJ = (const bf16*)(A.ws + WS_PROJ); bf16* CAT = (bf16*)(A.ws + WS_CAT);
    unsigned* ctr = (unsigned*)(A.ws + WS_CTL);
    LAS bf16* Vt = (LAS bf16*)(lds + wave * 8192);
    const int fr = lane & 15, fq = lane >> 4;
    const int kk = lane & 31, vch = lane >> 5;
    typedef short v4i16_t __attribute__((ext_vector_type(4)));
    LAS bf16* vtr_base = Vt + (4 * fq + ((lane >> 2) & 3)) * 72 + 4 * (lane & 3);
    constexpr float SC = 0.125f * 1.4426950408889634f;
    const int myx = (int)(__builtin_amdgcn_s_getreg((3 << 11) | 20) & 0x7u);
    int qi = 0;
    for (;;) {
        int wt = 256, xq = 0;
        while (qi < 8) { xq = (myx + qi) & 7; unsigned wt_ = 0; if (lane == 0) wt_ = atomicAdd(ctr + 16 * xq, 1u); wt = __builtin_amdgcn_readfirstlane(wt_); if (wt < 256) break; ++qi; }
        if (qi >= 8) break;
        const int T = 7 - (wt >> 5), b = (wt >> 2) & 7, h = xq, c0 = wt & 3, t0 = 256 * T;
        const bf16* Pb = PROJ + (size_t)b * SEQ * NP;
        const int tq0 = t0 + c0 + 16 * fr;
        bf16x8 qf0[2], qf1[2], qf2[2], qf3[2];
#pragma unroll
        for (int ks = 0; ks < 2; ++ks) { const bf16* qp = Pb + (size_t)tq0 * NP + PC_QB + h * 64 + 32 * ks + 8 * fq;
            qf0[ks] = *(const bf16x8*)qp; qf1[ks] = *(const bf16x8*)(qp + 4 * NP); qf2[ks] = *(const bf16x8*)(qp + 8 * NP); qf3[ks] = *(const bf16x8*)(qp + 12 * NP); }
        const int n2 = ((t0 + 240) >> 4) + 1, g2 = (n2 + 31) >> 5;
        const int lo1 = max(t0 + c0 - 512, c0), n1 = ((t0 + c0 + 12 + 240 - lo1) >> 2) + 1, g1 = (n1 + 31) >> 5;
        const int lo0 = max(t0 + c0 - 128, 0), n0 = (t0 + c0 + 12 + 240 - lo0) + 1, g0 = (n0 + 31) >> 5;
        const int NG = 4 * g2 + g1 + g0;
        f32x4 O0[4], O1[4], O2[4], O3[4];
#pragma unroll
        for (int i = 0; i < 4; ++i) { O0[i] = (f32x4){0.f, 0.f, 0.f, 0.f}; O1[i] = O0[i]; O2[i] = O0[i]; O3[i] = O0[i]; }
        float m0 = -INFINITY, l0 = 0.f, m1 = -INFINITY, l1 = 0.f, m2 = -INFINITY, l2 = 0.f, m3 = -INFINITY, l3 = 0.f;
        v4u kc[4], vc[4], kn[4], vn[4];
#define ATT_DEC(f, kst, str, mode) do { if ((f) < 4 * g2) { const int ci_ = (f) / g2; str = 16; kst = c0 + 4 * ci_ + 512 * ((f) - ci_ * g2); mode = 1 << ci_; } \
            else if ((f) < 4 * g2 + g1) { str = 4; kst = lo1 + 128 * ((f) - 4 * g2); mode = 15; } else { str = 1; kst = lo0 + 32 * ((f) - 4 * g2 - g1); mode = 15; } } while (0)
#define ATT_LOAD(kreg, vreg, kst, str) do { \
            _Pragma("unroll") for (int j = 0; j < 2; ++j) { const int tk = min((kst) + (str) * (16 * j + fr), SEQ - 1); \
                _Pragma("unroll") for (int ks = 0; ks < 2; ++ks) kreg[2 * j + ks] = *(const v4u*)(Pb + (size_t)tk * NP + PC_KB + h * 64 + 32 * ks + 8 * fq); } \
            { const int tk = min((kst) + (str) * kk, SEQ - 1); \
                _Pragma("unroll") for (int i = 0; i < 4; ++i) vreg[i] = *(const v4u*)(Pb + (size_t)tk * NP + PC_VB + h * 64 + 8 * (vch + 2 * i)); } } while (0)
#define ATT_CLS(O_, m_, l_, qf_, tq_) do { \
            f32x4 d0 = (f32x4){0.f, 0.f, 0.f, 0.f}, d1 = d0; \
            _Pragma("unroll") for (int ks = 0; ks < 2; ++ks) { d0 = __builtin_amdgcn_mfma_f32_16x16x32_bf16(__builtin_bit_cast(bf16x8, kc[ks]), qf_[ks], d0, 0, 0, 0); \
                                                             d1 = __builtin_amdgcn_mfma_f32_16x16x32_bf16(__builtin_bit_cast(bf16x8, kc[2 + ks]), qf_[ks], d1, 0, 0, 0); } \
            float s[8]; float mloc = -INFINITY; \
            const int dv = (((tq_) - kst) >> shl) - 4 * fq;        \
            _Pragma("unroll") for (int e2 = 0; e2 < 8; ++e2) { const float x = (e2 < 4 ? d0[e2 & 3] : d1[e2 & 3]) * SC; \
                s[e2] = ((unsigned)(dv - (16 * (e2 >> 2) + (e2 & 3))) <= 128u) ? x : -INFINITY; mloc = fmaxf(mloc, s[e2]); } \
            mloc = xmax_fq(mloc); \
            const float mnew = fmaxf(m_, mloc), alpha = __builtin_amdgcn_exp2f(m_ - mnew); m_ = mnew; \
            float psum = 0.f; \
            _Pragma("unroll") for (int e2 = 0; e2 < 8; ++e2) { s[e2] = __builtin_amdgcn_exp2f(s[e2] - mnew); psum += s[e2]; } \
            l_ = l_ * alpha + psum; \
            const bf16x8 pb = pack8((f32x4){s[0], s[1], s[2], s[3]}, (f32x4){s[4], s[5], s[6], s[7]}); \
            _Pragma("unroll") for (int db = 0; db < 4; ++db) O_[db] = __builtin_amdgcn_mfma_f32_16x16x32_bf16(va[db], pb, O_[db] * alpha, 0, 0, 0); } while (0)
        int kst, str, mode; ATT_DEC(0, kst, str, mode); ATT_LOAD(kc, vc, kst, str);
#pragma unroll 1
        for (int f = 0; f < NG; ++f) {
            int kstn = 0, strn = 1, moden = 0;
            if (f + 1 < NG) { ATT_DEC(f + 1, kstn, strn, moden); ATT_LOAD(kn, vn, kstn, strn); }
#pragma unroll
            for (int i = 0; i < 4; ++i) *(LAS v4u*)(Vt + kk * 72 + 8 * (vch + 2 * i)) = vc[i];
            bf16x8 va[4];
#pragma unroll
            for (int db = 0; db < 4; ++db) {
                const v4i16_t r0 = __builtin_amdgcn_ds_read_tr16_b64_v4i16((LAS v4i16_t*)(vtr_base + 16 * db)), r1 = __builtin_amdgcn_ds_read_tr16_b64_v4i16((LAS v4i16_t*)(vtr_base + 16 * 72 + 16 * db));
                va[db] = (bf16x8){r0[0], r0[1], r0[2], r0[3], r1[0], r1[1], r1[2], r1[3]}; }
            const int shl = (str == 16) ? 4 : (str == 4 ? 2 : 0);
            if (mode & 1) ATT_CLS(O0, m0, l0, qf0, tq0);
            if (mode & 2) ATT_CLS(O1, m1, l1, qf1, tq0 + 4);
            if (mode & 4) ATT_CLS(O2, m2, l2, qf2, tq0 + 8);
            if (mode & 8) ATT_CLS(O3, m3, l3, qf3, tq0 + 12);
#pragma unroll
            for (int i = 0; i < 4; ++i) { kc[i] = kn[i]; vc[i] = vn[i]; }
            kst = kstn; str = strn; mode = moden;
        }
#undef ATT_DEC
#undef ATT_LOAD
#undef ATT_CLS
        bf16* op = CAT + ((size_t)b * SEQ + tq0) * DM + GW + h * 64 + 4 * fq;
#define ATT_OUT(O_, l_, ci_) do { float lt = l_; lt += __shfl_xor(lt, 16); lt += __shfl_xor(lt, 32); const float inv = 1.0f / lt; \
            _Pragma("unroll") for (int db = 0; db < 4; ++db) { v2u w; w.x = pk2(O_[db][0] * inv, O_[db][1] * inv); w.y = pk2(O_[db][2] * inv, O_[db][3] * inv); *(v2u*)(op + (ci_) * 4 * DM + 16 * db) = w; } } while (0)
        ATT_OUT(O0, l0, 0); ATT_OUT(O1, l1, 1); ATT_OUT(O2, l2, 2); ATT_OUT(O3, l3, 3);
#undef ATT_OUT
    }
}

__device__ __forceinline__ void attn_simple(const Args& A, int tid, int lane, int wave) {
    const bf16* PROJ = (const bf16*)(A.ws + WS_PROJ); bf16* CAT = (bf16*)(A.ws + WS_CAT);
    unsigned* ctr = (unsigned*)(A.ws + WS_CTL);
    for (;;) {
        unsigned wt_ = 0; if (lane == 0) wt_ = atomicAdd(ctr, 1u); const int wt = __builtin_amdgcn_readfirstlane(wt_);
        if (wt >= (M / 64) * AH) break;
        const int h = wt % AH, tb = wt / AH, row = tb * 64 + lane, b = row / SEQ, t = row % SEQ;
        float q[64], acc[64];
        { const v4u* qp = (const v4u*)(PROJ + (size_t)row * NP + PC_QB + h * 64);
#pragma unroll
          for (int j = 0; j < 8; ++j) { const v4u w = qp[j]; q[8 * j + 0] = bflo(w.x) * 0.125f; q[8 * j + 1] = bfhi(w.x) * 0.125f; q[8 * j + 2] = bflo(w.y) * 0.125f; q[8 * j + 3] = bfhi(w.y) * 0.125f;
              q[8 * j + 4] = bflo(w.z) * 0.125f; q[8 * j + 5] = bfhi(w.z) * 0.125f; q[8 * j + 6] = bflo(w.w) * 0.125f; q[8 * j + 7] = bfhi(w.w) * 0.125f; } }
#pragma unroll
        for (int j = 0; j < 64; ++j) acc[j] = 0.f;
        float mx = -1e30f, l = 0.f;
        for (int br = 0; br < 3; ++br) {
            const int stride = br == 0 ? 1 : (br == 1 ? 4 : 16);
            for (int i = 0; i <= 128; ++i) {
                const int tk = t - i * stride; if (tk < 0) break;
                const size_t krow = (size_t)(b * SEQ + tk) * NP;
                const v4u* kp = (const v4u*)(PROJ + krow + PC_KB + h * 64); const v4u* vp = (const v4u*)(PROJ + krow + PC_VB + h * 64);
                float s = 0.f;
#pragma unroll
                for (int j = 0; j < 8; ++j) { const v4u w = kp[j]; s += q[8 * j + 0] * bflo(w.x) + q[8 * j + 1] * bfhi(w.x) + q[8 * j + 2] * bflo(w.y) + q[8 * j + 3] * bfhi(w.y)
                                                                       + q[8 * j + 4] * bflo(w.z) + q[8 * j + 5] * bfhi(w.z) + q[8 * j + 6] * bflo(w.w) + q[8 * j + 7] * bfhi(w.w); }
                const float mn = fmaxf(mx, s), sc = __expf(mx - mn), p = __expf(s - mn); mx = mn; l = l * sc + p;
#pragma unroll
                for (int j = 0; j < 8; ++j) { const v4u w = vp[j];
                    acc[8 * j + 0] = acc[8 * j + 0] * sc + p * bflo(w.x); acc[8 * j + 1] = acc[8 * j + 1] * sc + p * bfhi(w.x); acc[8 * j + 2] = acc[8 * j + 2] * sc + p * bflo(w.y); acc[8 * j + 3] = acc[8 * j + 3] * sc + p * bfhi(w.y);
                    acc[8 * j + 4] = acc[8 * j + 4] * sc + p * bflo(w.z); acc[8 * j + 5] = acc[8 * j + 5] * sc + p * bfhi(w.z); acc[8 * j + 6] = acc[8 * j + 6] * sc + p * bflo(w.w); acc[8 * j + 7] = acc[8 * j + 7] * sc + p * bfhi(w.w); }
            }
        }
        const float inv = 1.0f / l; v4u* op = (v4u*)(CAT + (size_t)row * DM + GW + h * 64);
#pragma unroll
        for (int j = 0; j < 8; ++j) { v4u w; w.x = pk2(acc[8 * j] * inv, acc[8 * j + 1] * inv); w.y = pk2(acc[8 * j + 2] * inv, acc[8 * j + 3] * inv); w.z = pk2(acc[8 * j + 4] * inv, acc[8 * j + 5] * inv); w.w = pk2(acc[8 * j + 6] * inv, acc[8 * j + 7] * inv); op[j] = w; }
    }
}
__device__ __forceinline__ void gated_norm(const Args& A, int lane, int wave) {
    const bf16* PROJ = (const bf16*)(A.ws + WS_PROJ); bf16* CAT = (bf16*)(A.ws + WS_CAT); const float* OA = (const float*)(A.ws + WS_OA); const float* gw = A.in[6];
    const float w0 = gw[2 * lane], w1 = gw[2 * lane + 1];
    const int gwv = blockIdx.x * NWAVES + wave, NGW = gridDim.x * NWAVES;
    for (int wt0 = gwv; wt0 < M * GH; wt0 += 8 * NGW) {
        float2 o[8]; unsigned zz[8];
#pragma unroll
        for (int i = 0; i < 8; ++i) { const int wt = min(wt0 + i * NGW, M * GH - 1), row = wt / GH, h = wt % GH;
            o[i] = *(const float2*)(OA + (size_t)row * GW + h * 128 + 2 * lane); zz[i] = *(const unsigned*)(PROJ + (size_t)row * NP + PC_Z + h * 128 + 2 * lane); }
#pragma unroll
        for (int i = 0; i < 8; ++i) { const int wt = wt0 + i * NGW; if (wt >= M * GH) break; const int row = wt / GH, h = wt % GH;
            const float ms = wave_sum(o[i].x * o[i].x + o[i].y * o[i].y) * (1.0f / 128.0f), r = rsqrtf(ms + RMS_EPS);
            *(unsigned*)(CAT + (size_t)row * DM + h * 128 + 2 * lane) = pk2(o[i].x * r * w0 * silu_f(bflo(zz[i])), o[i].y * r * w1 * silu_f(bfhi(zz[i]))); }
    }
}

__device__ __forceinline__ void gated_norm_bh(const Args& A, int bh, int lane, int wave) {
    const int b = bh >> 2, h = bh & 3;
    const bf16* Zp = (const bf16*)(A.ws + WS_PROJ) + (size_t)b * SEQ * NP + PC_Z + h * 128 + 2 * lane; bf16* Cp = (bf16*)(A.ws + WS_CAT) + (size_t)b * SEQ * DM + h * 128 + 2 * lane;
    const float* Op = (const float*)(A.ws + WS_OA) + (size_t)b * SEQ * GW + h * 128 + 2 * lane; const float* gw = A.in[6];
    const float w0 = gw[2 * lane], w1 = gw[2 * lane + 1];
    __builtin_amdgcn_fence(__ATOMIC_ACQUIRE, "agent");
#pragma unroll 1
    for (int r0 = wave * 16; r0 < SEQ; r0 += NWAVES * 16) {
        float2 o[16]; unsigned zz[16];
#pragma unroll
        for (int i = 0; i < 16; ++i) { o[i] = *(const float2*)(Op + (size_t)(r0 + i) * GW); zz[i] = *(const unsigned*)(Zp + (size_t)(r0 + i) * NP); }
#pragma unroll
        for (int i = 0; i < 16; ++i) { const float ms = wave_sum(o[i].x * o[i].x + o[i].y * o[i].y) * (1.0f / 128.0f), r = rsqrtf(ms + RMS_EPS);
            *(unsigned*)(Cp + (size_t)(r0 + i) * DM) = pk2(o[i].x * r * w0 * silu_f(bflo(zz[i])), o[i].y * r * w1 * silu_f(bfhi(zz[i]))); }
    }
}
__device__ __forceinline__ void ffn_conv_half(const Args& A, int half, int tid) {
    const bf16* Y = (const bf16*)(A.ws + WS_Y); bf16* ACT = (bf16*)(A.ws + WS_ACT); const float* fw = A.in[10];
    constexpr int HC = DFF / 2;
    for (size_t it = (size_t)blockIdx.x * NTHR + tid; it < (size_t)M * (HC / 8); it += (size_t)gridDim.x * NTHR) {
        const int row = (int)(it / (HC / 8)), g8 = (int)(it % (HC / 8)), cl = g8 * 8, pn = cl >> 7, j = cl & 127, t = row % SEQ, ch = half * HC + cl;
        float ga[8], ua[8];
#pragma unroll
        for (int e = 0; e < 8; ++e) { ga[e] = 0.f; ua[e] = 0.f; }
#pragma unroll
        for (int i = 0; i < 3; ++i) { const int ts = t - 2 + i; if (ts < 0) continue;
            const bf16* yr = Y + (size_t)(row - 2 + i) * DFF + 256 * pn + j; const v4u g = *(const v4u*)yr, u = *(const v4u*)(yr + 128);
            const f32x4 wg0 = *(const f32x4*)(fw + i * NUP + ch), wg1 = *(const f32x4*)(fw + i * NUP + ch + 4), wu0 = *(const f32x4*)(fw + i * NUP + DFF + ch), wu1 = *(const f32x4*)(fw + i * NUP + DFF + ch + 4);
            ga[0] += wg0.x * bflo(g.x); ga[1] += wg0.y * bfhi(g.x); ga[2] += wg0.z * bflo(g.y); ga[3] += wg0.w * bfhi(g.y); ga[4] += wg1.x * bflo(g.z); ga[5] += wg1.y * bfhi(g.z); ga[6] += wg1.z * bflo(g.w); ga[7] += wg1.w * bfhi(g.w);
            ua[0] += wu0.x * bflo(u.x); ua[1] += wu0.y * bfhi(u.x); ua[2] += wu0.z * bflo(u.y); ua[3] += wu0.w * bfhi(u.y); ua[4] += wu1.x * bflo(u.z); ua[5] += wu1.y * bfhi(u.z); ua[6] += wu1.z * bflo(u.w); ua[7] += wu1.w * bfhi(u.w); }
        v4u o; o.x = pk2(silu_f(ga[0]) * ua[0], silu_f(ga[1]) * ua[1]); o.y = pk2(silu_f(ga[2]) * ua[2], silu_f(ga[3]) * ua[3]); o.z = pk2(silu_f(ga[4]) * ua[4], silu_f(ga[5]) * ua[5]); o.w = pk2(silu_f(ga[6]) * ua[6], silu_f(ga[7]) * ua[7]);
        *(v4u*)(ACT + (size_t)row * DFF + ch) = o;
    }
}

__device__ __forceinline__ void ffn_fixup(const Args& A, int tid) {
    const float* YH = (const float*)(A.ws + WS_YH); const float* UP = (const float*)(A.ws + WS_UPART); bf16* ACT = (bf16*)(A.ws + WS_ACT); const float* fw = A.in[10];
    for (int it = blockIdx.x * NTHR + tid; it < 64 * 22 * 2 * 128; it += gridDim.x * NTHR) {
        const int c = it & 127, r = (it >> 7) & 1, tile = it >> 8, pm = tile / 22, pn = tile % 22; if ((pm & 7) == 0) continue;
        const int ch = pn * 128 + c; const float* up = UP + ((size_t)tile * 2 + r) * 256; const float* yh = YH + (size_t)((pm - 1) * 22 + pn) * 2 * 256;
        float g = up[c], u = up[128 + c];
        const float wg0 = fw[ch], wg1 = fw[5632 + ch], wu0 = fw[2816 + ch], wu1 = fw[5632 + 2816 + ch];
        if (r == 0) { g += wg0 * yh[c] + wg1 * yh[256 + c]; u += wu0 * yh[128 + c] + wu1 * yh[256 + 128 + c]; }
        else { g += wg0 * yh[256 + c]; u += wu0 * yh[256 + 128 + c]; }
        ACT[(size_t)(pm * 256 + r) * DFF + ch] = (bf16)(pk2(silu_f(g) * u, 0.f) & 0xffffu);
    }
}
__device__ __forceinline__ void final_norm(const Args& A, int lane, int wave) {
    float* out = A.out; const f32x4* nr = (const f32x4*)A.in[12] + lane;
    const int gw = blockIdx.x * NWAVES + wave, NGW = gridDim.x * NWAVES;
    f32x4 nw[4];
#pragma unroll
    for (int j = 0; j < 4; ++j) nw[j] = nr[64 * j];
    for (int m0 = gw; m0 < M; m0 += 4 * NGW) {
        f32x4 v[4][4];
#pragma unroll
        for (int rr = 0; rr < 4; ++rr) { const int m = min(m0 + rr * NGW, M - 1); const f32x4* xr = (const f32x4*)(out + (size_t)m * DM) + lane;
#pragma unroll
            for (int j = 0; j < 4; ++j) v[rr][j] = xr[64 * j]; }
#pragma unroll
        for (int rr = 0; rr < 4; ++rr) { const int m = m0 + rr * NGW; if (m >= M) break; float s = 0.f;
#pragma unroll
            for (int j = 0; j < 4; ++j) s += (v[rr][j].x * v[rr][j].x + v[rr][j].y * v[rr][j].y) + (v[rr][j].z * v[rr][j].z + v[rr][j].w * v[rr][j].w);
            const float rstd = rsqrtf(wave_sum(s) * (1.f / DM) + RMS_EPS); f32x4* xw = (f32x4*)(out + (size_t)m * DM) + lane;
#pragma unroll
            for (int j = 0; j < 4; ++j) xw[64 * j] = (f32x4){v[rr][j].x * rstd * nw[j].x, v[rr][j].y * rstd * nw[j].y, v[rr][j].z * rstd * nw[j].z, v[rr][j].w * rstd * nw[j].w}; }
    }
}

#define XB_TMO      128
#define XB_XCNT(j)  (256  + 64 * (j))
#define XB_XSUB(j)  (1280 + 64 * (j))
#define XB_XGEN(j)  (2304 + 64 * (j))
#define XB_TOP      3328
#define XB_TOPGEN   3392
#define XCD_BAR_WORDS 3456
#define XB_SPIN_CAP (1u << 18)

__device__ __forceinline__ unsigned xb_ld(unsigned* p)              { return __hip_atomic_load(p, __ATOMIC_RELAXED, __HIP_MEMORY_SCOPE_AGENT); }
__device__ __forceinline__ unsigned xb_add(unsigned* p, unsigned v) { return __hip_atomic_fetch_add(p, v, __ATOMIC_RELAXED, __HIP_MEMORY_SCOPE_AGENT); }
__device__ __forceinline__ unsigned xb_xcc_id() { return (unsigned)__builtin_amdgcn_s_getreg((3 << 11) | 20) & 0xFu; }
#define XB_SPIN(cond, bar) do { unsigned _sp = 0; while (cond) { __builtin_amdgcn_s_sleep(1); \
    if ((++_sp & 255u) == 0u) { if (xb_ld(&(bar)[XB_TMO])) break; if (_sp > XB_SPIN_CAP) { atomicAdd(&(bar)[XB_TMO], 1u); break; } } } } while (0)

struct XcdBarrier {
    unsigned* bar; unsigned x;
    volatile LAS unsigned* st;
};

__device__ __forceinline__ XcdBarrier xcd_barrier_post(unsigned* bar, volatile LAS unsigned* st) {
    XcdBarrier b; b.bar = bar; b.x = xb_xcc_id(); b.st = st;
    if (threadIdx.x == 0) (void)xb_add(&bar[XB_XCNT(b.x)], 1u);
    return b;
}
__device__ __forceinline__ void xcd_barrier_complete(unsigned* bar, unsigned x, unsigned& nloc, unsigned& nx) {
    const unsigned G = gridDim.x * gridDim.y * gridDim.z;
    unsigned sum, cnt, mine, sp = 0u;
    for (;;) {
        sum = 0u; cnt = 0u; mine = 0u;
#pragma unroll
        for (unsigned j = 0; j < 16; ++j) { const unsigned c = xb_ld(&bar[XB_XCNT(j)]); sum += c; cnt += (c > 0u) ? 1u : 0u; mine = (j == x) ? c : mine; }
        if (sum == G) break;
        __builtin_amdgcn_s_sleep(1);
        if ((++sp & 255u) == 0u) { if (xb_ld(&bar[XB_TMO])) break; if (sp > XB_SPIN_CAP) { atomicAdd(&bar[XB_TMO], 1u); break; } }
    }
    nloc = mine > 0u ? mine : 1u; nx = cnt > 0u ? cnt : 1u;
}

__device__ __forceinline__ void xcd_barrier(const XcdBarrier& b) {
    asm volatile("s_waitcnt vmcnt(0)" ::: "memory");
    __syncthreads();
    if (threadIdx.x == 0) {
        unsigned* bar = b.bar;
        __builtin_amdgcn_s_waitcnt(0);
        unsigned nloc = b.st[0], nx = b.st[1];
        if (nloc == 0u) { xcd_barrier_complete(bar, b.x, nloc, nx); b.st[0] = nloc; b.st[1] = nx; }
        const unsigned old = xb_add(&bar[XB_XSUB(b.x)], 1u);
        const unsigned gen = old / nloc;
        if (old + 1u == (gen + 1u) * nloc) {
            __builtin_amdgcn_fence(__ATOMIC_RELEASE, "agent");
            asm volatile("s_waitcnt vmcnt(0)" ::: "memory");
            const unsigned og = xb_add(&bar[XB_TOP], 1u);
            const unsigned tg = og / nx;
            if (og + 1u == (tg + 1u) * nx) xb_add(&bar[XB_TOPGEN], 1u);
            else XB_SPIN(xb_ld(&bar[XB_TOPGEN]) == tg, bar);
            __builtin_amdgcn_fence(__ATOMIC_ACQUIRE, "agent");
            xb_add(&bar[XB_XGEN(b.x)], 1u);
            asm volatile("s_waitcnt vmcnt(0)" ::: "memory");
        } else {
            XB_SPIN(xb_ld(&bar[XB_XGEN(b.x)]) == gen, bar);
            __builtin_amdgcn_fence(__ATOMIC_ACQUIRE, "agent");
            asm volatile("s_waitcnt vmcnt(0)" ::: "memory");
        }
    }
    __syncthreads();
}

constexpr int N_PHASES = 8;
__global__ void __launch_bounds__(NTHR, 2) mk_fwd(Args args) {
    extern __shared__ __attribute__((aligned(16))) unsigned char lds_raw[];
    LAS unsigned char* lds = (LAS unsigned char*)lds_raw;
    const int tid = threadIdx.x, lane = tid & 63, wave = __builtin_amdgcn_readfirstlane(tid >> 6);
    const int lo = args.ph_lo, hi = args.ph_hi;
    unsigned char* ws = args.ws;
    bf16* WIN = (bf16*)(ws + WS_WIN); bf16* WOUT = (bf16*)(ws + WS_WOUT); bf16* WUP = (bf16*)(ws + WS_WUP); bf16* WDN = (bf16*)(ws + WS_WDN);
    bf16* XN = (bf16*)(ws + WS_XN); bf16* PROJ = (bf16*)(ws + WS_PROJ); bf16* CAT = (bf16*)(ws + WS_CAT); bf16* Y = (bf16*)(ws + WS_Y); bf16* ACT = (bf16*)(ws + WS_ACT);
    float* SSQ = (float*)(ws + WS_SSQ);
#define IN(k) (lo <= (k) && (k) < hi)
#define SEAM(k) do { if (IN(k) && IN((k) + 1)) { xcd_barrier(bar); } } while (0)
    { volatile LAS unsigned* st = (volatile LAS unsigned*)(lds + LDS_BYTES - 64); if (tid < 2) st[tid] = 0u; }
    __syncthreads();
    XcdBarrier bar = xcd_barrier_post((unsigned*)(ws + WS_CTL) + 4096, (volatile LAS unsigned*)(lds + LDS_BYTES - 64));
    if (args.coop > 1) cg::this_grid().sync();
    if (IN(0)) { p0_prologue(args, lds, tid, lane, wave); } SEAM(0);
    if (IN(1)) { pg8::Gemm g{XN, WIN, M, NP, DM}; pg8::StaticOrder S; S.init(M, NP, gridDim.x, blockIdx.x); pg8::EpiBf16S E{PROJ, NP, nullptr};
        pg8::gemm_phase<pg8::EpiBf16S, pg8::StaticOrder, PG8_ALIGN, PG8_SP2>(lds, g, S, E);
        { pg8::Unit u4; const bool idle4 = !S.next(3, u4); const int G = gridDim.x, nidle = (G == 256) ? 128 : G;
          if (G != 256) convert_late_weights(args, lds, lane, wave, blockIdx.x * NWAVES + wave, G * NWAVES);
          else if (idle4) convert_late_weights(args, lds, lane, wave, (blockIdx.x - 128) * NWAVES + wave, nidle * NWAVES); } } SEAM(1);
    if (IN(2)) { gdn_prep(args, lds, tid, lane, wave); } SEAM(2);
    if (IN(3)) { if (blockIdx.x < NB * GH) gdn_scan(args, lds, blockIdx.x, tid, lane, wave); attn_fast(args, lds, lane, wave); xcd_barrier(bar); gated_norm(args, lane, wave); } SEAM(3);
    if (IN(4)) { pg8::Gemm g{CAT, WOUT, M, DM, DM}; pg8::StaticOrder S; S.init(M, DM, gridDim.x, blockIdx.x); pg8::EpiResid E{args.in[0], (gridDim.x == 256) ? nullptr : args.out, XN, SSQ, DM};
        pg8::gemm_phase<pg8::EpiResid, pg8::StaticOrder, PG8_ALIGN, PG8_SP2>(lds, g, S, E); } SEAM(4);
    if (IN(5)) { pg8::Gemm g{XN, WUP, M, NUP, DM}; pg8::StaticOrder S; S.init(M, NUP, gridDim.x, blockIdx.x);
        static_assert(pg8::EpiConvGate::CG_SSQ == WS_SSQ && pg8::EpiConvGate::CG_ACT == WS_ACT && pg8::EpiConvGate::CG_YH == WS_YH && pg8::EpiConvGate::CG_UPART == WS_UPART, "d_ws map");
        pg8::EpiConvGate E{ws, args.in[10], lds};
        pg8::gemm_phase<pg8::EpiConvGate, pg8::StaticOrder, true, PG8_SP2>(lds, g, S, E); } SEAM(5);
    if (IN(6)) { ffn_fixup(args, tid); } SEAM(6);
    if (IN(7)) { pg8::Gemm g{ACT, WDN, M, DM, DFF}; pg8::StaticOrder S; S.init(M, DM, gridDim.x, blockIdx.x);
        if (gridDim.x == 256) {
            pg8::EpiResidNorm E{XN, args.out, (float*)(ws + WS_SSQ2), (unsigned*)(ws + WS_CTL) + 2048, args.in[12], DM};
            pg8::gemm_phase<pg8::EpiResidNorm, pg8::StaticOrder, true, PG8_SP2>(lds, g, S, E);
        } else {
            pg8::EpiResid E{args.out, args.out, nullptr, nullptr, DM};
            pg8::gemm_phase<pg8::EpiResid, pg8::StaticOrder, PG8_ALIGN, PG8_SP2>(lds, g, S, E);
            xcd_barrier(bar); final_norm(args, lane, wave);
        } }
#undef IN
#undef SEAM
}

#ifndef MK_ONE_LAUNCH
#define MK_ONE_LAUNCH 1
#endif
extern "C" void kernel_launch(void* const* d_in, const int* in_sizes, int n_in, void* d_out, int out_size, void* d_ws, size_t ws_size, hipStream_t stream) {
    static int grid = 0;
    if (grid == 0) {
        if (n_in != 13 || out_size != M * DM || ws_size < WS_END) { fprintf(stderr, "kernel_launch: unexpected shapes n_in %d out %d ws %zu\n", n_in, out_size, ws_size); grid = -1; return; }
        int dev = 0, cus = 0, per_cu = 0;
        hipGetDevice(&dev); hipDeviceGetAttribute(&cus, hipDeviceAttributeMultiprocessorCount, dev);
        hipFuncSetAttribute((const void*)mk_fwd, hipFuncAttributeMaxDynamicSharedMemorySize, LDS_BYTES);
        hipOccupancyMaxActiveBlocksPerMultiprocessor(&per_cu, (const void*)mk_fwd, NTHR, LDS_BYTES);
        (void)hipGetLastError();
        if (per_cu < 1) { fprintf(stderr, "kernel_launch: occupancy query says %d blocks per CU\n", per_cu); per_cu = 1; }
        grid = cus;
    }
    if (grid < 0) return;
    if (hipMemsetAsync((char*)d_ws + WS_CTL, 0, 65536, stream) != hipSuccess) { fprintf(stderr, "kernel_launch: memset failed\n"); return; }
    Args a{};
    for (int i = 0; i < 13; ++i) a.in[i] = (const float*)d_in[i];
    a.out = (float*)d_out; a.ws = (unsigned char*)d_ws;
#if MK_ONE_LAUNCH
    a.ph_lo = 0; a.ph_hi = N_PHASES; a.coop = 1;
    void* kargs[] = {&a};
    hipError_t e = hipLaunchCooperativeKernel((const void*)mk_fwd, dim3(grid), dim3(NTHR), kargs, LDS_BYTES, stream);
    if (e != hipSuccess) fprintf(stderr, "cooperative launch failed: %s (grid %d)\n", hipGetErrorString(e), grid);
#else
    for (int p = 0; p < N_PHASES; ++p) { a.ph_lo = p; a.ph_hi = p + 1; a.coop = 0; hipLaunchKernelGGL(mk_fwd, dim3(grid), dim3(NTHR), LDS_BYTES, stream, a); }
#endif
}
```

```cpp
#include <hip/hip_runtime.h>
#include <hip/hip_cooperative_groups.h>
#include <cstdio>
#include <cstdint>
namespace cg = cooperative_groups;
namespace pg8 {
#define PG8_LAS __attribute__((address_space(3)))
typedef unsigned short bf16_t;
typedef short bf16x8 __attribute__((ext_vector_type(8)));
typedef float f32x4 __attribute__((ext_vector_type(4)));
typedef unsigned u32x4 __attribute__((ext_vector_type(4)));
constexpr int BM = 256, BK = 64, HALF = 128, HTB = HALF * BK * 2  , STAGE_BYTES = 8 * HTB, NXCD = 8, WGM = 8;

__host__ __device__ __forceinline__ int lds_byte(int r, int c) { const int st = (r >> 4) * 2 + (c >> 5), rr = r & 15, cc = c & 31, ob = rr * 64 + cc * 2; return st * 1024 + (ob ^ (((ob >> 9) & 1) << 5)); }
__host__ __device__ __forceinline__ void stage_rc(int b, int& R, int& C) { const int st = b / 1024, sb = b % 1024, swz = sb ^ (((sb >> 9) & 1) << 5); R = (st >> 1) * 16 + swz / 64; C = (st & 1) * 32 + (swz % 64) / 2; }
__host__ __device__ __forceinline__ int perm32(int rho) { const int n = rho >> 4, i = rho & 15; return 8 * (i >> 2) + 4 * n + (i & 3); }

struct Unit { int pm, pn; };
struct Gemm { const bf16_t* A; const bf16_t* Bt; int M, N, K; };

struct StaticOrder {
    int nM, nN, nwg, G, c;
    __host__ __device__ __forceinline__ void init(int M, int N, int G_, int c_) { nM = M / BM; nN = N / BM; nwg = nM * nN; G = G_; c = c_; }
    __host__ __device__ __forceinline__ bool next(int i, Unit& u) const {
        const long L = (long)i * G + c; if (L >= nwg) return false;
        int wgid = (int)L; { const int q = nwg / NXCD, r = nwg % NXCD, xcd = wgid % NXCD, off = wgid / NXCD; wgid = (xcd < r ? xcd * (q + 1) : r * (q + 1) + (xcd - r) * q) + off; }
        const int nig = WGM * nN, gid = wgid / nig, fm = gid * WGM, gsz = (nM - fm) < WGM ? (nM - fm) : WGM;
        u.pm = fm + ((wgid % nig) % gsz); u.pn = (wgid % nig) / gsz; return true;
    }
    __device__ __forceinline__ void a_ready(const Unit&) const {}
    __device__ __forceinline__ void done(const Unit&) const {}
};

__device__ __forceinline__ unsigned cvt_pk_bf16(float lo, float hi) { unsigned r; asm volatile("v_cvt_pk_bf16_f32 %0, %1, %2" : "=v"(r) : "v"(lo), "v"(hi)); return r; }
constexpr float RMS_EPS = 1e-6f;
struct EpiBf16S {
    static constexpr bool PERM = true, AFTER_DRAIN = false;
    bf16_t* O; int ldc; const float* ssq;
    __device__ __forceinline__ void operator()(const f32x4 (&acc)[2][2][4][2], const Unit& u, int wr, int wc, int fr, int fq) const {
        const int row0 = u.pm * BM + wr * 64 + fr; const int col0 = u.pn * BM + wc * 32 + 8 * fq;
#pragma unroll
        for (int ai = 0; ai < 2; ++ai)
#pragma unroll
            for (int m = 0; m < 4; ++m) { const int row = row0 + ai * HALF + m * 16; bf16_t* rowp = O + (size_t)row * ldc + col0;
                const float sc = ssq ? rsqrtf(ssq[row] * (1.0f / 1024.0f) + RMS_EPS) : 1.0f;
#pragma unroll
                for (int bj = 0; bj < 2; ++bj) { const f32x4 v0 = acc[ai][bj][m][0] * sc, v1 = acc[ai][bj][m][1] * sc;
                    u32x4 w; w.x = cvt_pk_bf16(v0[0], v0[1]); w.y = cvt_pk_bf16(v0[2], v0[3]); w.z = cvt_pk_bf16(v1[0], v1[1]); w.w = cvt_pk_bf16(v1[2], v1[3]);
                    asm volatile("global_store_dwordx4 %0, %1, off sc1" :: "v"(rowp + bj * HALF), "v"(w) : "memory"); } }
    }
};
struct EpiResid {
    static constexpr bool PERM = false, AFTER_DRAIN = false;
    const float* base; float* out; bf16_t* xb; float* ssq; int ldc;
    __device__ __forceinline__ void operator()(const f32x4 (&acc)[2][2][4][2], const Unit& u, int wr, int wc, int fr, int fq) const {
        typedef unsigned u32x2v __attribute__((ext_vector_type(2)));
        const int col0 = u.pn * BM + wc * 32 + 4 * fq;
#pragma unroll
        for (int ai = 0; ai < 2; ++ai) {
            f32x4 bv[4][2][2];
#pragma unroll
            for (int m = 0; m < 4; ++m) { const size_t off = (size_t)(u.pm * BM + ai * HALF + wr * 64 + m * 16 + fr) * ldc + col0;
#pragma unroll
                for (int bj = 0; bj < 2; ++bj)
#pragma unroll
                    for (int n = 0; n < 2; ++n) bv[m][bj][n] = *(const f32x4*)(base + off + bj * HALF + n * 16); }
#pragma unroll
            for (int m = 0; m < 4; ++m) { const int row = u.pm * BM + ai * HALF + wr * 64 + m * 16 + fr; const size_t off = (size_t)row * ldc + col0; float s = 0.f;
#pragma unroll
                for (int bj = 0; bj < 2; ++bj)
#pragma unroll
                    for (int n = 0; n < 2; ++n) { const f32x4 v = acc[ai][bj][m][n] + bv[m][bj][n];
                        if (out) *(f32x4*)(out + off + bj * HALF + n * 16) = v; s += (v[0] * v[0] + v[1] * v[1]) + (v[2] * v[2] + v[3] * v[3]);
                        if (xb) { u32x2v w; w.x = cvt_pk_bf16(v[0], v[1]); w.y = cvt_pk_bf16(v[2], v[3]); *(u32x2v*)(xb + off + bj * HALF + n * 16) = w; } }
                if (ssq) { s += __shfl_xor(s, 16); s += __shfl_xor(s, 32); if (fq == 0) atomicAdd(ssq + row, s); } }
            asm volatile("" ::: "memory");
        }
    }
};

__device__ __forceinline__ float dpp_ror1(float v) { return __builtin_bit_cast(float, __builtin_amdgcn_mov_dpp(__builtin_bit_cast(int, v), 0x121, 0xf, 0xf, true)); }
__device__ __forceinline__ float dpp_ror2(float v) { return __builtin_bit_cast(float, __builtin_amdgcn_mov_dpp(__builtin_bit_cast(int, v), 0x122, 0xf, 0xf, true)); }
struct EpiConvGate {
    static constexpr bool PERM = true, AFTER_DRAIN = false;
    static constexpr size_t CG_SSQ = (1u << 20) + 768 * 1024, CG_ACT = (size_t)148 << 20, CG_YH = (size_t)236 << 20, CG_UPART = (size_t)240 << 20;
    unsigned char* ws; const float* fw; PG8_LAS unsigned char* ldsb;
    __device__ __forceinline__ void operator()(f32x4 (&acc)[2][2][4][2], const Unit& u, int wr, int wc, int fr0, int fq0) const {
        int fr = fr0, fq = fq0; asm volatile("" : "+v"(fr), "+v"(fq));
        bf16_t* ACT = (bf16_t*)(ws + CG_ACT); const float* ssq = (const float*)(ws + CG_SSQ); float* YH = (float*)(ws + CG_YH); float* UPART = (float*)(ws + CG_UPART);
        PG8_LAS float* halo = (PG8_LAS float*)(ldsb + STAGE_BYTES);
        int cl = wc * 32 + 8 * fq;
        int ch = u.pn * 128 + cl;
        if (fr >= 14) {
#pragma unroll
            for (int ai = 0; ai < 2; ++ai) { const float sc = rsqrtf(ssq[u.pm * BM + ai * HALF + wr * 64 + 48 + fr] * (1.0f / 1024.0f) + RMS_EPS);
#pragma unroll
                for (int bj = 0; bj < 2; ++bj)
#pragma unroll
                    for (int n = 0; n < 2; ++n) { const f32x4 v = acc[ai][bj][3][n] * sc; *(PG8_LAS f32x4*)(halo + (((wr * 2 + ai) * 2 + (fr - 14)) * 256 + bj * 128 + cl + 4 * n)) = v;
                        if (ai == 1 && wr == 1) *(f32x4*)(YH + ((size_t)(u.pm * 22 + u.pn) * 2 + (fr - 14)) * 256 + bj * 128 + cl + 4 * n) = v; } }
        }
        asm volatile("s_waitcnt lgkmcnt(0)" ::: "memory"); __builtin_amdgcn_s_barrier(); asm volatile("" ::: "memory");
        typedef unsigned u32x2v __attribute__((ext_vector_type(2)));
        float scv[2][4];
#pragma unroll
        for (int ai = 0; ai < 2; ++ai)
#pragma unroll
            for (int m = 0; m < 4; ++m) scv[ai][m] = rsqrtf(ssq[u.pm * BM + ai * HALF + wr * 64 + m * 16 + fr] * (1.0f / 1024.0f) + RMS_EPS);
#pragma unroll 1
        for (int n = 0; n < 2; ++n) {
            asm volatile("" : "+v"(fr), "+v"(fq));
            cl = wc * 32 + 8 * fq; ch = u.pn * 128 + cl;
            f32x4 w[3][2];
#pragma unroll
            for (int i = 0; i < 3; ++i)
#pragma unroll
                for (int bj = 0; bj < 2; ++bj) w[i][bj] = *(const f32x4*)(fw + (size_t)i * 5632 + bj * 2816 + ch + 4 * n);
#pragma unroll
            for (int ai = 0; ai < 2; ++ai) {
                const bool top = (ai == 0 && wr == 0);
                const int pblk = (ai == 0) ? 0 : (wr == 0 ? 2 : 1);
                f32x4 q1[2], q2[2];
#pragma unroll
                for (int bj = 0; bj < 2; ++bj) { const f32x4 pv = top ? (f32x4){0.f, 0.f, 0.f, 0.f} : *(const PG8_LAS f32x4*)(halo + ((pblk * 2 + (fr & 1)) * 256 + bj * 128 + cl + 4 * n));
#pragma unroll
                    for (int k = 0; k < 4; ++k) { q1[bj][k] = dpp_ror1(pv[k]); q2[bj][k] = dpp_ror2(pv[k]); } }
#pragma unroll
                for (int m = 0; m < 4; ++m) {
                    const int row = u.pm * BM + ai * HALF + wr * 64 + m * 16 + fr; const float sc = scv[ai][m];
                    f32x4 cu[2];
#pragma unroll
                    for (int bj = 0; bj < 2; ++bj) { const f32x4 ya = acc[ai][bj][m][0];
#pragma unroll
                        for (int k = 0; k < 4; ++k) { const float y = ya[k] * sc;
                            const float a1 = dpp_ror1(y), a2 = dpp_ror2(y);
                            const float p1 = (fr == 0) ? q1[bj][k] : a1, p2 = (fr < 2) ? q2[bj][k] : a2;
                            cu[bj][k] = w[2][bj][k] * y + w[1][bj][k] * p1 + w[0][bj][k] * p2; q1[bj][k] = a1; q2[bj][k] = a2; } }
                    if (top && m == 0 && fr < 2 && (u.pm & 7) != 0) {
#pragma unroll
                        for (int bj = 0; bj < 2; ++bj) *(f32x4*)(UPART + ((size_t)(u.pm * 22 + u.pn) * 2 + fr) * 256 + bj * 128 + cl + 4 * n) = cu[bj];
                    }
                    u32x2v o;
#define PG8_SG(k_) (cu[0][k_] * __builtin_amdgcn_rcpf(1.0f + __expf(-cu[0][k_])) * cu[1][k_])
                    o.x = cvt_pk_bf16(PG8_SG(0), PG8_SG(1)); o.y = cvt_pk_bf16(PG8_SG(2), PG8_SG(3));
#undef PG8_SG
                    asm volatile("global_store_dwordx2 %0, %1, off sc1" :: "v"(ACT + (size_t)row * 2816 + ch + 4 * n), "v"(o) : "memory");
                    asm volatile("" ::: "memory");
                }
            }
            if (n == 0) {
#pragma unroll
                for (int ai = 0; ai < 2; ++ai)
#pragma unroll
                    for (int bj = 0; bj < 2; ++bj)
#pragma unroll
                        for (int m = 0; m < 4; ++m) acc[ai][bj][m][0] = acc[ai][bj][m][1];
            }
        }
        asm volatile("s_waitcnt lgkmcnt(0)" ::: "memory"); __builtin_amdgcn_s_barrier(); asm volatile("" ::: "memory");
    }
};

struct EpiResidNorm {
    static constexpr bool PERM = false, AFTER_DRAIN = false;
    const bf16_t* base; float* out; float* ssq2; unsigned* cnt; const float* fnw; int ldc;
    __device__ __forceinline__ void operator()(f32x4 (&acc)[2][2][4][2], const Unit& u, int wr, int wc, int fr, int fq) const {
        typedef unsigned u32x2v __attribute__((ext_vector_type(2)));
        const int col0 = u.pn * BM + wc * 32 + 4 * fq;
#pragma unroll
        for (int ai = 0; ai < 2; ++ai) {
            u32x2v bv[4][2][2];
#pragma unroll
            for (int m = 0; m < 4; ++m) { const size_t off = (size_t)(u.pm * BM + ai * HALF + wr * 64 + m * 16 + fr) * ldc + col0;
#pragma unroll
                for (int bj = 0; bj < 2; ++bj)
#pragma unroll
                    for (int n = 0; n < 2; ++n) bv[m][bj][n] = *(const u32x2v*)(base + off + bj * HALF + n * 16); }
#pragma unroll
            for (int m = 0; m < 4; ++m) { const int row = u.pm * BM + ai * HALF + wr * 64 + m * 16 + fr; float s = 0.f;
#pragma unroll
                for (int bj = 0; bj < 2; ++bj)
#pragma unroll
                    for (int n = 0; n < 2; ++n) { const u32x2v bw = bv[m][bj][n]; const f32x4 v = acc[ai][bj][m][n] + (f32x4){__uint_as_float(bw.x << 16), __uint_as_float(bw.x & 0xffff0000u), __uint_as_float(bw.y << 16), __uint_as_float(bw.y & 0xffff0000u)}; acc[ai][bj][m][n] = v; s += (v[0] * v[0] + v[1] * v[1]) + (v[2] * v[2] + v[3] * v[3]); }
                s += __shfl_xor(s, 16); s += __shfl_xor(s, 32);
                if (fq == 0) (void)__hip_atomic_fetch_add(ssq2 + row, s, __ATOMIC_RELAXED, __HIP_MEMORY_SCOPE_AGENT); }
            asm volatile("" ::: "memory");
        }
        asm volatile("s_waitcnt vmcnt(0)" ::: "memory"); __builtin_amdgcn_s_barrier(); asm volatile("" ::: "memory");
        if (wr == 0 && wc == 0 && fr == 0 && fq == 0) {
            __builtin_amdgcn_fence(__ATOMIC_RELEASE, "agent"); asm volatile("s_waitcnt vmcnt(0)" ::: "memory");
            (void)__hip_atomic_fetch_add(cnt + 16 * u.pm, 1u, __ATOMIC_RELAXED, __HIP_MEMORY_SCOPE_AGENT);
            unsigned sp = 0;
            while (__hip_atomic_load(cnt + 16 * u.pm, __ATOMIC_RELAXED, __HIP_MEMORY_SCOPE_AGENT) < 4u) { __builtin_amdgcn_s_sleep(1); if (++sp > (1u << 22)) break; }
            __builtin_amdgcn_fence(__ATOMIC_ACQUIRE, "agent"); asm volatile("s_waitcnt vmcnt(0)" ::: "memory");
        }
        __builtin_amdgcn_s_barrier(); asm volatile("" ::: "memory");
        f32x4 nw[2][2];
#pragma unroll
        for (int bj = 0; bj < 2; ++bj)
#pragma unroll
            for (int n = 0; n < 2; ++n) nw[bj][n] = *(const f32x4*)(fnw + col0 + bj * HALF + n * 16);
#pragma unroll
        for (int ai = 0; ai < 2; ++ai)
#pragma unroll
            for (int m = 0; m < 4; ++m) { const int row = u.pm * BM + ai * HALF + wr * 64 + m * 16 + fr; const size_t off = (size_t)row * ldc + col0;
                const float rstd = rsqrtf(__hip_atomic_load(ssq2 + row, __ATOMIC_RELAXED, __HIP_MEMORY_SCOPE_AGENT) * (1.0f / 1024.0f) + RMS_EPS);
#pragma unroll
                for (int bj = 0; bj < 2; ++bj)
#pragma unroll
                    for (int n = 0; n < 2; ++n) { const f32x4 v = acc[ai][bj][m][n]; *(f32x4*)(out + off + bj * HALF + n * 16) = (f32x4){v[0] * rstd * nw[bj][n][0], v[1] * rstd * nw[bj][n][1], v[2] * rstd * nw[bj][n][2], v[3] * rstd * nw[bj][n][3]}; } }
    }
};
template <class Epi, class Sched, bool ALIGN_EPI = false, bool SP2 = false>
__device__ __forceinline__ void gemm_phase(PG8_LAS unsigned char* lds, const Gemm g, const Sched& S, const Epi& E) {
    const int tid = threadIdx.x, wid = __builtin_amdgcn_readfirstlane(tid >> 6), lane = tid & 63, wr = wid >> 2, wc = wid & 3, fr = lane & 15, fq = lane >> 4;
    const int K = g.K, nt = K / BK;
    unsigned voffA[2], voffB[2];
#pragma unroll
    for (int i = 0; i < 2; ++i) { int R, C; stage_rc(tid * 16 + i * 8192, R, C); const int Rb = Epi::PERM ? ((R & ~31) + perm32(R & 31)) : R;
        voffA[i] = (unsigned)(R * K + C) * 2u; voffB[i] = (unsigned)(Rb * K + C) * 2u; }
    const size_t kstep = (size_t)(BK * 2);
    const size_t hstep = (size_t)HALF * K * 2;
    const size_t tstep = 2 * hstep;
    const unsigned ldsw = (unsigned)wid * 1024u;
    const int aoff = lds_byte(wr * 64 + fr, fq * 8), boff = lds_byte(wc * 32 + fr, fq * 8);
#define PG8_SA(b, h) (((b) * 2 + (h)) * HTB)
#define PG8_SB(b, h) ((4 + (b) * 2 + (h)) * HTB)
#define PG8_STAGE(bufoff, gbase, voff) do { _Pragma("unroll") for (int _i = 0; _i < 2; ++_i) \
        __builtin_amdgcn_global_load_lds((const unsigned*)((const char*)(gbase) + (voff)[_i]), (PG8_LAS unsigned*)(lds + (bufoff) + ldsw + _i * 8192), 16, 0, 0); } while (0)
#define PG8_LDA(dst, b, h) do { _Pragma("unroll") for (int m = 0; m < 4; ++m) _Pragma("unroll") for (int k = 0; k < 2; ++k) dst[m][k] = *(const PG8_LAS bf16x8*)(lds + PG8_SA(b, h) + aoff + m * 2048 + k * 1024); } while (0)
#define PG8_LDB(dst, b, h) do { _Pragma("unroll") for (int n = 0; n < 2; ++n) _Pragma("unroll") for (int k = 0; k < 2; ++k) dst[n][k] = *(const PG8_LAS bf16x8*)(lds + PG8_SB(b, h) + boff + n * 2048 + k * 1024); } while (0)
#define PG8_MMA(ai, bj, At, Bt) do { __builtin_amdgcn_s_setprio(1); _Pragma("unroll") for (int m = 0; m < 4; ++m) _Pragma("unroll") for (int n = 0; n < 2; ++n) _Pragma("unroll") for (int k = 0; k < 2; ++k) \
        acc[ai][bj][m][n] = __builtin_amdgcn_mfma_f32_16x16x32_bf16(Bt[n][k], At[m][k], acc[ai][bj][m][n], 0, 0, 0); __builtin_amdgcn_s_setprio(0); } while (0)
#define PG8_WAIT_V(n) asm volatile("s_waitcnt vmcnt(" #n ")" ::: "memory")
#define PG8_WAIT_L(n) asm volatile("s_waitcnt lgkmcnt(" #n ")" ::: "memory")
#define PG8_BAR __builtin_amdgcn_s_barrier()
#define PG8_SCHED __builtin_amdgcn_sched_barrier(0)
    Unit cur, nxt; int ui = 0;
    if (!S.next(0, cur)) return;
    f32x4 acc[2][2][4][2];
#pragma unroll
    for (int a = 0; a < 2; ++a)
#pragma unroll
        for (int b = 0; b < 2; ++b)
#pragma unroll
            for (int m = 0; m < 4; ++m)
#pragma unroll
                for (int n = 0; n < 2; ++n) acc[a][b][m][n] = (f32x4){0.f, 0.f, 0.f, 0.f};
    bf16x8 At[4][2], B0[2][2], B1[2][2];
    const char* cA = (const char*)g.A + (size_t)cur.pm * tstep; const char* cB = (const char*)g.Bt + (size_t)cur.pn * tstep;
    S.a_ready(cur);
    if constexpr (SP2) {
        PG8_STAGE(PG8_SB(0, 0), cB, voffB); PG8_STAGE(PG8_SB(0, 1), cB + hstep, voffB); PG8_STAGE(PG8_SA(0, 0), cA, voffA); PG8_STAGE(PG8_SA(0, 1), cA + hstep, voffA);
        if (wr == 1) PG8_BAR;
        PG8_WAIT_V(2); PG8_BAR;
        PG8_STAGE(PG8_SB(1, 0), cB + kstep, voffB); PG8_STAGE(PG8_SA(1, 0), cA + kstep, voffA); PG8_STAGE(PG8_SB(1, 1), cB + hstep + kstep, voffB);
        PG8_WAIT_V(6); PG8_BAR;
    } else {
        PG8_STAGE(PG8_SB(0, 0), cB, voffB); PG8_STAGE(PG8_SA(0, 0), cA, voffA); PG8_STAGE(PG8_SB(0, 1), cB + hstep, voffB); PG8_STAGE(PG8_SA(0, 1), cA + hstep, voffA);
        if (wr == 1) PG8_BAR;
        PG8_WAIT_V(4); PG8_BAR;
        PG8_STAGE(PG8_SB(1, 0), cB + kstep, voffB); PG8_STAGE(PG8_SA(1, 0), cA + kstep, voffA); PG8_STAGE(PG8_SB(1, 1), cB + hstep + kstep, voffB);
        PG8_WAIT_V(6); PG8_BAR;
    }
    for (;;) {
        const bool has_next = S.next(ui + 1, nxt);
        const char* nA = has_next ? (const char*)g.A + (size_t)nxt.pm * tstep : cA; const char* nB = has_next ? (const char*)g.Bt + (size_t)nxt.pn * tstep : cB;
        for (int t = 0; t < nt; t += 2) {
            const bool last = (t == nt - 2);
            const char* a1 = cA + (size_t)(t + 1) * kstep;
            const char* a2 = last ? nA : cA + (size_t)(t + 2) * kstep; const char* b2 = last ? nB : cB + (size_t)(t + 2) * kstep;
            const char* a3 = a2 + kstep; const char* b3 = b2 + kstep;
            if (last && has_next) S.a_ready(nxt);
            if constexpr (SP2) {
            PG8_LDB(B0, 0, 0); PG8_LDB(B1, 0, 1); PG8_SCHED; PG8_LDA(At, 0, 0); PG8_STAGE(PG8_SA(1, 1), a1 + hstep, voffA);
            PG8_WAIT_V(8); PG8_WAIT_L(0); PG8_BAR; PG8_MMA(0, 0, At, B0); PG8_MMA(0, 1, At, B1); PG8_BAR; PG8_SCHED;
            PG8_LDA(At, 0, 1); PG8_STAGE(PG8_SB(0, 0), b2, voffB); PG8_STAGE(PG8_SB(0, 1), b2 + hstep, voffB); PG8_STAGE(PG8_SA(0, 0), a2, voffA);
            PG8_WAIT_V(8); PG8_WAIT_L(0); PG8_BAR; PG8_MMA(1, 0, At, B0); PG8_MMA(1, 1, At, B1); PG8_BAR; PG8_SCHED;
            PG8_LDB(B0, 1, 0); PG8_LDB(B1, 1, 1); PG8_SCHED; PG8_LDA(At, 1, 0); PG8_STAGE(PG8_SA(0, 1), a2 + hstep, voffA);
            PG8_WAIT_V(8); PG8_WAIT_L(0); PG8_BAR; PG8_MMA(0, 0, At, B0); PG8_MMA(0, 1, At, B1); PG8_BAR; PG8_SCHED;
            PG8_LDA(At, 1, 1); PG8_STAGE(PG8_SB(1, 0), b3, voffB); PG8_STAGE(PG8_SB(1, 1), b3 + hstep, voffB); PG8_STAGE(PG8_SA(1, 0), a3, voffA);
            PG8_WAIT_V(8); PG8_WAIT_L(0); PG8_BAR; PG8_MMA(1, 0, At, B0); PG8_MMA(1, 1, At, B1); PG8_BAR; PG8_SCHED;
            } else {
            PG8_LDB(B0, 0, 0); PG8_SCHED; PG8_LDA(At, 0, 0); PG8_STAGE(PG8_SA(1, 1), a1 + hstep, voffA);
            PG8_WAIT_L(8); PG8_BAR; PG8_WAIT_L(0); PG8_MMA(0, 0, At, B0); PG8_BAR; PG8_SCHED;
            PG8_LDB(B1, 0, 1); PG8_STAGE(PG8_SB(0, 0), b2, voffB);
            PG8_BAR; PG8_WAIT_L(0); PG8_MMA(0, 1, At, B1); PG8_BAR;
            PG8_LDA(At, 0, 1); PG8_STAGE(PG8_SA(0, 0), a2, voffA);
            PG8_BAR; PG8_WAIT_L(0); PG8_MMA(1, 0, At, B0); PG8_BAR; PG8_SCHED;
            PG8_STAGE(PG8_SB(0, 1), b2 + hstep, voffB);
            PG8_WAIT_V(6); PG8_BAR; PG8_MMA(1, 1, At, B1); PG8_BAR;
            PG8_LDB(B0, 1, 0); PG8_SCHED; PG8_LDA(At, 1, 0); PG8_STAGE(PG8_SA(0, 1), a2 + hstep, voffA);
            PG8_WAIT_L(8); PG8_BAR; PG8_WAIT_L(0); PG8_MMA(0, 0, At, B0); PG8_BAR; PG8_SCHED;
            PG8_LDB(B1, 1, 1); PG8_STAGE(PG8_SB(1, 0), b3, voffB);
            PG8_BAR; PG8_WAIT_L(0); PG8_MMA(0, 1, At, B1); PG8_BAR;
            PG8_LDA(At, 1, 1); PG8_STAGE(PG8_SA(1, 0), a3, voffA);
            PG8_BAR; PG8_WAIT_L(0); PG8_MMA(1, 0, At, B0); PG8_BAR; PG8_SCHED;
            PG8_STAGE(PG8_SB(1, 1), b3 + hstep, voffB);
            PG8_WAIT_V(6); PG8_BAR; PG8_MMA(1, 1, At, B1); PG8_BAR;
            }
        }
        if constexpr (ALIGN_EPI) { if (wr == 0) PG8_BAR; }
        if constexpr (!Epi::AFTER_DRAIN) { E(acc, cur, wr, wc, fr, fq); S.done(cur); }
        if (!has_next) break;
#pragma unroll
        for (int a = 0; a < 2; ++a)
#pragma unroll
            for (int b = 0; b < 2; ++b)
#pragma unroll
                for (int m = 0; m < 4; ++m)
#pragma unroll
                    for (int n = 0; n < 2; ++n) acc[a][b][m][n] = (f32x4){0.f, 0.f, 0.f, 0.f};
        cur = nxt; cA = nA; cB = nB; ++ui;
        if constexpr (ALIGN_EPI) { if (wr == 1) PG8_BAR; }
    }
    PG8_WAIT_V(0);
    if constexpr (!ALIGN_EPI) { if (wr == 0) PG8_BAR; }
    PG8_BAR;
    if constexpr (Epi::AFTER_DRAIN) { E.fused(acc, cur, wr, wc, fr, fq, lds, wid, lane); S.done(cur); }
#undef PG8_SA
#undef PG8_SB
#undef PG8_STAGE
#undef PG8_LDA
#undef PG8_LDB
#undef PG8_MMA
#undef PG8_WAIT_V
#undef PG8_WAIT_L
#undef PG8_BAR
#undef PG8_SCHED
}
}
#ifndef PG8_SP2
#define PG8_SP2 true
#endif
#ifndef PG8_ALIGN
#define PG8_ALIGN true
#endif
constexpr int NB = 8, SEQ = 2048, DM = 1024, M = NB * SEQ;
constexpr int GH = 4, GD = 128, GW = 512, AH = 8, AD = 64;
constexpr int INC = 3592, NP = 3584;
constexpr int DFF = 2816, NUP = 2 * DFF;
constexpr int PC_QA = 0, PC_KA = 512, PC_VA = 1024, PC_Z = 1536, PC_QB = 2048, PC_KB = 2560, PC_VB = 3072;
constexpr size_t MiB = 1u << 20;
constexpr size_t WS_CTL = 0, WS_AB = 1 * MiB, WS_SSQ = 1 * MiB + 768 * 1024, WS_WIN = 2 * MiB, WS_WOUT = 9 * MiB, WS_WUP = 11 * MiB, WS_WDN = 22 * MiB;
constexpr size_t WS_XN = 28 * MiB, WS_PROJ = 60 * MiB, WS_CAT = 172 * MiB, WS_OA = 204 * MiB, WS_Y = 60 * MiB, WS_ACT = 148 * MiB, WS_END = 256 * MiB;
using pg8::RMS_EPS;
constexpr size_t WS_YH = 236 * MiB, WS_UPART = 240 * MiB;
constexpr size_t WS_SSQ2 = WS_SSQ + 131072;
constexpr size_t WS_GE = WS_SSQ + 65536;
constexpr int GOPS_CHUNK = 57344;
constexpr int SCAN_BUF = GOPS_CHUNK + 16384;
constexpr int NWAVES = 8, NTHR = 512;
constexpr int LDS_BYTES = 155648;
#define LAS __attribute__((address_space(3)))
typedef unsigned short bf16;
typedef unsigned v4u __attribute__((ext_vector_type(4)));
typedef unsigned v2u __attribute__((ext_vector_type(2)));
typedef float f32x4 __attribute__((ext_vector_type(4)));
__device__ __forceinline__ float bf2f(unsigned b) { return __uint_as_float(b << 16); }
__device__ __forceinline__ float bflo(unsigned w) { return __uint_as_float(w << 16); }
__device__ __forceinline__ float bfhi(unsigned w) { return __uint_as_float(w & 0xffff0000u); }
__device__ __forceinline__ unsigned pk2(float lo, float hi) { return pg8::cvt_pk_bf16(lo, hi); }
__device__ __forceinline__ float wave_sum(float v) {
    v += __builtin_bit_cast(float, __builtin_amdgcn_mov_dpp(__builtin_bit_cast(int, v), 0xB1, 0xf, 0xf, true));
    v += __builtin_bit_cast(float, __builtin_amdgcn_mov_dpp(__builtin_bit_cast(int, v), 0x4E, 0xf, 0xf, true));
    v += __builtin_bit_cast(float, __builtin_amdgcn_mov_dpp(__builtin_bit_cast(int, v), 0x141, 0xf, 0xf, true));
    v += __builtin_bit_cast(float, __builtin_amdgcn_mov_dpp(__builtin_bit_cast(int, v), 0x140, 0xf, 0xf, true));
    auto a = __builtin_amdgcn_permlane16_swap(__float_as_uint(v), __float_as_uint(v), false, false); v = __uint_as_float(a[0]) + __uint_as_float(a[1]);
    auto b = __builtin_amdgcn_permlane32_swap(__float_as_uint(v), __float_as_uint(v), false, false); return __uint_as_float(b[0]) + __uint_as_float(b[1]);
}
__device__ __forceinline__ float silu_f(float x) { return x * __builtin_amdgcn_rcpf(1.0f + __expf(-x)); }
__device__ __forceinline__ float sigmoid_f(float x) { return __builtin_amdgcn_rcpf(1.0f + __expf(-x)); }
__device__ __forceinline__ float softplus_f(float x) { return x > 20.f ? x : log1pf(__expf(x)); }

struct Args { const float* in[13]; float* out; unsigned char* ws; int ph_lo, ph_hi, coop, pad; };

__device__ __forceinline__ void p0_transpose_item(const float* W, int ldw, int k0, int sn0, bf16* WT, int K, int dn0, const float* kscale, LAS float* scr, int lane) {
    float tv[32];
#pragma unroll
    for (int i = 0; i < 32; ++i) { const int kk = 2 * i + (lane >> 5); tv[i] = W[(size_t)(k0 + kk) * ldw + sn0 + (lane & 31)]; }
    if (kscale) {
#pragma unroll
        for (int i = 0; i < 32; ++i) tv[i] *= kscale[k0 + 2 * i + (lane >> 5)]; }
#pragma unroll
    for (int i = 0; i < 32; ++i) scr[(2 * i + (lane >> 5)) * 33 + (lane & 31)] = tv[i];
    asm volatile("s_waitcnt lgkmcnt(0)" ::: "memory");
    const int c = lane & 7;
#pragma unroll
    for (int j = 0; j < 4; ++j) { const int n = (lane >> 3) + 8 * j; const LAS float* s = scr + (8 * c) * 33 + n;
        v4u o; o.x = pk2(s[0 * 33], s[1 * 33]); o.y = pk2(s[2 * 33], s[3 * 33]); o.z = pk2(s[4 * 33], s[5 * 33]); o.w = pk2(s[6 * 33], s[7 * 33]);
        *(v4u*)(WT + (size_t)(dn0 + n) * K + k0 + 8 * c) = o; }
    asm volatile("s_waitcnt lgkmcnt(0)" ::: "memory");
}

__device__ __forceinline__ void p0_prologue(const Args& A, LAS unsigned char* lds, int tid, int lane, int wave) {
    const float* x = A.in[0]; const float* nw1 = A.in[1]; const float* w_in = A.in[2]; const float* w_out = A.in[7]; const float* nw2 = A.in[8];
    const float* w_up = A.in[9]; const float* w_dn = A.in[11];
    unsigned char* ws = A.ws;
    bf16* WIN = (bf16*)(ws + WS_WIN); bf16* WOUT = (bf16*)(ws + WS_WOUT); bf16* WUP = (bf16*)(ws + WS_WUP); bf16* WDN = (bf16*)(ws + WS_WDN);
    bf16* XN = (bf16*)(ws + WS_XN); float* AB = (float*)(ws + WS_AB); float* SSQ = (float*)(ws + WS_SSQ);
    LAS float* scr = (LAS float*)(lds + wave * 9216);
    LAS float* wab = (LAS float*)(lds + 73728);
    const int G = gridDim.x, gw = blockIdx.x * NWAVES + wave, NGW = G * NWAVES;
    for (int i = blockIdx.x * NTHR + tid; i < M; i += G * NTHR) { SSQ[i] = 0.f; ((float*)(ws + WS_SSQ2))[i] = 0.f; }
    if (blockIdx.x == 0 && tid < 64) ((unsigned*)(ws + WS_CTL))[tid] = 0u;
    for (int idx = tid; idx < 8192; idx += NTHR) { const int k = idx >> 3, j = idx & 7; wab[j * 1024 + k] = nw1[k] * w_in[(size_t)k * INC + 2048 + j]; }
    constexpr int I_IN = 16 * (NP / 32);
    for (int it = gw; it < I_IN; it += NGW) { const int nblk = NP / 32, kb = it / nblk, nb = it % nblk, n0 = 32 * nb; p0_transpose_item(w_in, INC, 64 * kb, n0 + (n0 >= 2048 ? 8 : 0), WIN, DM, n0, nullptr, scr, lane); }
    __syncthreads();
    for (int m0 = gw; m0 < M; m0 += 2 * NGW) {
        const f32x4* nr = (const f32x4*)nw1 + lane;
        f32x4 v[2][4]; float s[2] = {0.f, 0.f};
#pragma unroll
        for (int rr = 0; rr < 2; ++rr) { const int m = min(m0 + rr * NGW, M - 1); const f32x4* xr = (const f32x4*)(x + (size_t)m * DM) + lane;
#pragma unroll
            for (int j = 0; j < 4; ++j) v[rr][j] = xr[64 * j]; }
#pragma unroll
        for (int rr = 0; rr < 2; ++rr)
#pragma unroll
            for (int j = 0; j < 4; ++j) s[rr] += (v[rr][j].x * v[rr][j].x + v[rr][j].y * v[rr][j].y) + (v[rr][j].z * v[rr][j].z + v[rr][j].w * v[rr][j].w);
#pragma unroll
        for (int rr = 0; rr < 2; ++rr) { const int m = m0 + rr * NGW; if (m >= M) break;
            const float rstd = rsqrtf(wave_sum(s[rr]) * (1.f / DM) + RMS_EPS);
            float ab[8];
#pragma unroll
            for (int q = 0; q < 8; ++q) { float a = 0.f;
#pragma unroll
                for (int j = 0; j < 4; ++j) { const f32x4 w = *(const LAS f32x4*)(wab + q * 1024 + 256 * j + 4 * lane); a += (v[rr][j].x * w.x + v[rr][j].y * w.y) + (v[rr][j].z * w.z + v[rr][j].w * w.w); }
                ab[q] = wave_sum(a) * rstd; }
            if (lane == 0) { *(f32x4*)(AB + (size_t)m * 8) = (f32x4){ab[0], ab[1], ab[2], ab[3]}; *(f32x4*)(AB + (size_t)m * 8 + 4) = (f32x4){ab[4], ab[5], ab[6], ab[7]}; }
            v2u* o8 = (v2u*)(XN + (size_t)m * DM) + lane;
#pragma unroll
            for (int j = 0; j < 4; ++j) { const f32x4 n = nr[64 * j]; v2u o; o.x = pk2(v[rr][j].x * rstd * n.x, v[rr][j].y * rstd * n.y); o.y = pk2(v[rr][j].z * rstd * n.z, v[rr][j].w * rstd * n.w); o8[64 * j] = o; }
        }
    }
}


__device__ __forceinline__ void convert_late_weights(const Args& A, LAS unsigned char* lds, int lane, int wave, int gw0, int ngw) {
    const float* w_out = A.in[7]; const float* nw2 = A.in[8]; const float* w_up = A.in[9]; const float* w_dn = A.in[11];
    bf16* WOUT = (bf16*)(A.ws + WS_WOUT); bf16* WUP = (bf16*)(A.ws + WS_WUP); bf16* WDN = (bf16*)(A.ws + WS_WDN);
    LAS float* scr = (LAS float*)(lds + wave * 9216);
    constexpr int I_OUT = 16 * 32, I_UP = 16 * (NUP / 32), I_DN = (DFF / 64) * 32;
    for (int it = gw0; it < I_OUT + I_UP + I_DN; it += ngw) {
        int r = it;
        if (r < I_OUT) { const int kb = r / 32, nb = r % 32; p0_transpose_item(w_out, DM, 64 * kb, 32 * nb, WOUT, DM, 32 * nb, nullptr, scr, lane); continue; } r -= I_OUT;
        if (r < I_UP) { const int nblk = NUP / 32, kb = r / nblk, nb = r % nblk, n0 = 32 * nb, pn = n0 >> 8, j0 = n0 & 255;
            const int s0 = (j0 < 128) ? (128 * pn + j0) : (DFF + 128 * pn + j0 - 128);
            p0_transpose_item(w_up, NUP, 64 * kb, s0, WUP, DM, n0, nw2, scr, lane); continue; } r -= I_UP;
        { const int kb = r / 32, nb = r % 32; p0_transpose_item(w_dn, DM, 64 * kb, 32 * nb, WDN, DFF, 32 * nb, nullptr, scr, lane); }
    }
}
__device__ __forceinline__ void gdn_simple(const Args& A, LAS unsigned char* lds, int tid, int lane, int wave) {
    const bf16* PROJ = (const bf16*)(A.ws + WS_PROJ); const float* AB = (const float*)(A.ws + WS_AB); float* OA = (float*)(A.ws + WS_OA);
    const float* cw = A.in[3]; const float* a_log = A.in[4]; const float* dt_bias = A.in[5];
    LAS float* qs = (LAS float*)lds; LAS float* ks = qs + 16 * 128; LAS float* vs = ks + 16 * 128; LAS float* av = vs + 16 * 128; LAS float* bv = av + 16;
    for (int task = blockIdx.x; task < NB * GH; task += gridDim.x) {
        const int b = task / GH, h = task % GH, v = tid >> 2, part = tid & 3;
        float S[32];
#pragma unroll
        for (int i = 0; i < 32; ++i) S[i] = 0.f;
        const float Ah = __expf(a_log[h]), dtb = dt_bias[h];
        for (int blk = 0; blk < SEQ / 16; ++blk) {
            const int t0 = blk * 16;
            for (int idx = tid; idx < 16 * 384; idx += NTHR) {
                const int tt = idx / 384, c = idx % 384, which = c >> 7, d = c & 127, col = which * 512 + h * 128 + d, t = t0 + tt;
                float acc = 0.f;
#pragma unroll
                for (int i = 0; i < 4; ++i) { const int ts = t - 3 + i; if (ts >= 0) acc += cw[i * 1536 + col] * bf2f(PROJ[(size_t)(b * SEQ + ts) * NP + col]); }
                qs[which * 2048 + tt * 128 + d] = silu_f(acc);
            }
            if (tid < 16) { const size_t row = (size_t)b * SEQ + t0 + tid; bv[tid] = sigmoid_f(AB[row * 8 + h]); av[tid] = __expf(-Ah * softplus_f(AB[row * 8 + 4 + h] + dtb)); }
            __syncthreads();
#pragma unroll
            for (int r = 0; r < 4; ++r) { const int row = 4 * wave + r; LAS float* arr = qs + row * 128;
                const float v0 = arr[lane], v1 = arr[lane + 64]; const float s = wave_sum(v0 * v0 + v1 * v1);
                const float sc = rsqrtf(s + RMS_EPS) * (row < 16 ? 0.08838834764831845f : 1.0f); arr[lane] = v0 * sc; arr[lane + 64] = v1 * sc; }
            __syncthreads();
            for (int tt = 0; tt < 16; ++tt) {
                const float a = av[tt], bt = bv[tt], vt = vs[tt * 128 + v];
                float kS = 0.f;
#pragma unroll
                for (int i = 0; i < 32; ++i) kS += ks[tt * 128 + 32 * part + i] * S[i];
                kS += __shfl_xor(kS, 1); kS += __shfl_xor(kS, 2);
                const float c = bt * (vt - a * kS); float o = 0.f;
#pragma unroll
                for (int i = 0; i < 32; ++i) { S[i] = a * S[i] + ks[tt * 128 + 32 * part + i] * c; o += qs[tt * 128 + 32 * part + i] * S[i]; }
                o += __shfl_xor(o, 1); o += __shfl_xor(o, 2);
                if (part == 0) OA[(size_t)(b * SEQ + t0 + tt) * GW + h * 128 + v] = o;
            }
            __syncthreads();
        }
    }
}


template <int J, int K, int N> struct SolveLd {
    static __device__ __forceinline__ void run(f32x4 (&l)[4], unsigned lbase) {
        if constexpr (K < N) { constexpr int t40 = ((J + 1) >> 2) << 2;
            asm volatile("ds_read_b128 %0, %1 offset:%2" : "=v"(l[K]) : "v"(lbase), "i"((J * 68 + t40 + 4 * K) * 4)); SolveLd<J, K + 1, N>::run(l, lbase); }
    }
};
template <int J> struct SolveCol16 {
    static __device__ __forceinline__ void run(float (&R)[16], unsigned lbase) {
        if constexpr (J < 15) {
            constexpr int t40 = ((J + 1) >> 2) << 2, nld = (16 - t40) >> 2;
            f32x4 l[4];
            SolveLd<J, 0, nld>::run(l, lbase);
            asm volatile("s_waitcnt lgkmcnt(0)" ::: "memory");
#pragma unroll
            for (int k = 0; k < nld; ++k) asm volatile("" : "+v"(l[k]));
#pragma unroll
            for (int k = 0; k < nld; ++k) {
#pragma unroll
                for (int e = 0; e < 4; ++e) if (t40 + 4 * k + e > J) R[t40 + 4 * k + e] += l[k][e] * R[J]; }
            SolveCol16<J + 1>::run(R, lbase);
        }
    }
};

typedef short bf16x8 __attribute__((ext_vector_type(8)));
__device__ __forceinline__ void gdn_prep(const Args& A, LAS unsigned char* lds, int tid0, int lane0, int wave) {
    const bf16* PROJ = (const bf16*)(A.ws + WS_PROJ); const float* AB = (const float*)(A.ws + WS_AB);
    const float* cw = A.in[3]; const float* a_log = A.in[4]; const float* dt_bias = A.in[5];
    unsigned char* UVF = A.ws + WS_XN; unsigned char* GOPS = (unsigned char*)A.out; float* GE = (float*)(A.ws + WS_GE);
    LAS float* Qs = (LAS float*)lds; LAS float* Ks = (LAS float*)(lds + 33792); LAS float* Vs = (LAS float*)(lds + 67584);
    LAS bf16* Qb = (LAS bf16*)(lds + 101376); LAS bf16* Kb = (LAS bf16*)(lds + 118784);
    LAS float* gcs = (LAS float*)(lds + 136192); LAS float* bts = gcs + 64; LAS float* egs = gcs + 128; LAS float* kes = gcs + 192;
    LAS float* LsT = (LAS float*)lds; LAS bf16* ATs = (LAS bf16*)(lds + 17408); LAS bf16* WKs = Kb;
    v4u rwn[11];
    if (tid0 < 384 && (int)blockIdx.x < NB * GH * 32) { const int c8 = tid0 % 48, run = tid0 / 48, which = c8 >> 4, d0 = (c8 & 15) * 8, t1 = blockIdx.x, bh1 = t1 >> 5, n1 = t1 & 31, b1 = bh1 >> 2, h1 = bh1 & 3, col1 = which * 512 + h1 * 128 + d0;
#pragma unroll
        for (int r = 0; r < 11; ++r) { const int ts = 64 * n1 + 8 * run - 3 + r; rwn[r] = (ts >= 0) ? *(const v4u*)(PROJ + (size_t)(b1 * SEQ + ts) * NP + col1) : (v4u){0u, 0u, 0u, 0u}; } }
    else {
#pragma unroll
        for (int r = 0; r < 11; ++r) rwn[r] = (v4u){0u, 0u, 0u, 0u}; }
#pragma unroll 1
    for (int task = blockIdx.x; task < NB * GH * 32; task += gridDim.x) {
        int tid = tid0, lane = lane0; asm volatile("" : "+v"(tid), "+v"(lane));
        const int fr = lane & 15, fq = lane >> 4;
        const int bh = task >> 5, n = task & 31, b = bh >> 2, h = bh & 3, t0 = 64 * n, row0 = b * SEQ + t0;
        unsigned char* gops = GOPS + (size_t)task * GOPS_CHUNK;
        if (tid < 384) {
            const int c8 = tid % 48, run = tid / 48, which = c8 >> 4, d0 = (c8 & 15) * 8, col = which * 512 + h * 128 + d0;
            v4u rw[11];
#pragma unroll
            for (int r = 0; r < 11; ++r) rw[r] = rwn[r];
            { const int tn = task + gridDim.x;
              if (tn < NB * GH * 32) { const int bhn = tn >> 5, nn = tn & 31, bn = bhn >> 2, hn = bhn & 3, coln = which * 512 + hn * 128 + d0;
#pragma unroll
                for (int r = 0; r < 11; ++r) { const int ts = 64 * nn + 8 * run - 3 + r; rwn[r] = (ts >= 0) ? *(const v4u*)(PROJ + (size_t)(bn * SEQ + ts) * NP + coln) : (v4u){0u, 0u, 0u, 0u}; } } }
            f32x4 cwa[4], cwb[4];
#pragma unroll
            for (int j = 0; j < 4; ++j) { cwa[j] = *(const f32x4*)(cw + j * 1536 + col); cwb[j] = *(const f32x4*)(cw + j * 1536 + col + 4); }
#pragma unroll
            for (int i = 0; i < 8; ++i) {
                float acc[8];
#pragma unroll
                for (int e2 = 0; e2 < 8; ++e2) acc[e2] = 0.f;
#pragma unroll
                for (int j = 0; j < 4; ++j) { const v4u w = rw[i + j];
                    acc[0] += cwa[j].x * bflo(w.x); acc[1] += cwa[j].y * bfhi(w.x); acc[2] += cwa[j].z * bflo(w.y); acc[3] += cwa[j].w * bfhi(w.y);
                    acc[4] += cwb[j].x * bflo(w.z); acc[5] += cwb[j].y * bfhi(w.z); acc[6] += cwb[j].z * bflo(w.w); acc[7] += cwb[j].w * bfhi(w.w); }
                float ss = 0.f;
#pragma unroll
                for (int e2 = 0; e2 < 8; ++e2) { acc[e2] = silu_f(acc[e2]); ss += acc[e2] * acc[e2]; }
                ss += __builtin_bit_cast(float, __builtin_amdgcn_update_dpp(0, __builtin_bit_cast(int, ss), 0xB1, 0xf, 0xf, false));
                ss += __builtin_bit_cast(float, __builtin_amdgcn_update_dpp(0, __builtin_bit_cast(int, ss), 0x4E, 0xf, 0xf, false));
                ss += __builtin_bit_cast(float, __builtin_amdgcn_update_dpp(0, __builtin_bit_cast(int, ss), 0x141, 0xf, 0xf, false));
                ss += __builtin_bit_cast(float, __builtin_amdgcn_update_dpp(0, __builtin_bit_cast(int, ss), 0x140, 0xf, 0xf, false));
                const int tt = 8 * run + i;
                if (which == 2) { *(LAS f32x4*)(Vs + tt * 132 + d0) = (f32x4){acc[0], acc[1], acc[2], acc[3]}; *(LAS f32x4*)(Vs + tt * 132 + d0 + 4) = (f32x4){acc[4], acc[5], acc[6], acc[7]}; }
                else {
                    const float sc = rsqrtf(ss + RMS_EPS) * (which == 0 ? 0.08838834764831845f : 1.0f);
#pragma unroll
                    for (int e2 = 0; e2 < 8; ++e2) acc[e2] *= sc;
                    const v4u pk = (v4u){pk2(acc[0], acc[1]), pk2(acc[2], acc[3]), pk2(acc[4], acc[5]), pk2(acc[6], acc[7])};
                    if (which == 0) *(LAS v4u*)(Qb + tt * 136 + d0) = pk;
                    else { *(LAS v4u*)(Kb + tt * 136 + d0) = pk; *(LAS f32x4*)(Ks + tt * 132 + d0) = (f32x4){acc[0], acc[1], acc[2], acc[3]}; *(LAS f32x4*)(Ks + tt * 132 + d0 + 4) = (f32x4){acc[4], acc[5], acc[6], acc[7]}; }
                }
            }
        }
        if (wave == 0) {
            const size_t row = (size_t)row0 + lane; const float beta = sigmoid_f(AB[row * 8 + h]);
            float g = -__expf(a_log[h]) * softplus_f(AB[row * 8 + 4 + h] + dt_bias[h]);
#pragma unroll
            for (int o = 1; o < 64; o <<= 1) { const float t = __shfl_up(g, o); if (lane >= o) g += t; }
            const float glast = __shfl(g, 63);
            gcs[lane] = g; bts[lane] = beta; egs[lane] = __expf(g); kes[lane] = __expf(glast - g) * beta;
            if (lane == 63) GE[task] = __expf(g);
        }
        __syncthreads();
#pragma unroll 1
        for (int jb = wave; jb < 20; jb += 8) {
            const int kind = jb >= 10 ? 1 : 0, idx = jb - 10 * kind, ti = idx < 1 ? 0 : (idx < 3 ? 1 : (idx < 6 ? 2 : 3)), tj = idx - ti * (ti + 1) / 2;
            const LAS bf16* As = kind ? Qb : Kb; f32x4 d = (f32x4){0.f, 0.f, 0.f, 0.f};
#pragma unroll
            for (int ks = 0; ks < 4; ++ks) { const bf16x8 a = *(const LAS bf16x8*)(As + (16 * ti + fr) * 136 + 32 * ks + 8 * fq), bb = *(const LAS bf16x8*)(Kb + (16 * tj + fr) * 136 + 32 * ks + 8 * fq);
                d = __builtin_amdgcn_mfma_f32_16x16x32_bf16(a, bb, d, 0, 0, 0); }
            const int j = 16 * tj + fr; const float gj = gcs[j], bj = bts[j]; float val[4];
#pragma unroll
            for (int e = 0; e < 4; ++e) { const int t = 16 * ti + 4 * fq + e; const float x = d[e] * __expf(gcs[t] - gj) * bj; val[e] = (kind ? (t >= j) : (t > j)) ? x : 0.f; }
            if (kind == 0) *(LAS f32x4*)(LsT + j * 68 + 16 * ti + 4 * fq) = (f32x4){-val[0], -val[1], -val[2], -val[3]};
            else {
#pragma unroll
                for (int e = 0; e < 4; ++e) ATs[(16 * ti + 4 * fq + e) * 72 + j] = (bf16)(pk2(val[e], 0.f) & 0xffffu); }
        }
        __syncthreads();
        LAS float* Ti = (LAS float*)(lds + 26624);
        if (wave == 0) {
            const int I = lane >> 4, c = lane & 15; float x[16];
#pragma unroll
            for (int r = 0; r < 16; ++r) x[r] = (r == c) ? 1.0f : 0.0f;
            SolveCol16<0>::run(x, (unsigned)(uintptr_t)LsT + (unsigned)(I * (16 * 68 + 16) * 4));
#pragma unroll
            for (int r = 0; r < 16; ++r) Ti[(I * 16 + r) * 20 + c] = x[r];
        } else {
            const int rt = tid - 64;
            for (int q = rt; q < 1024; q += 448) { const int blk = q >> 6, l2 = q & 63, i = l2 & 15, f = l2 >> 4, mb = blk >> 2, ks = blk & 3, t = 16 * mb + i;
                const v2u p0 = *(const LAS v2u*)(Qb + t * 136 + 32 * ks + 4 * f), p1 = *(const LAS v2u*)(Qb + t * 136 + 32 * ks + 16 + 4 * f); const float eg = egs[t];
                v4u o; o.x = pk2(bflo(p0.x) * eg, bfhi(p0.x) * eg); o.y = pk2(bflo(p0.y) * eg, bfhi(p0.y) * eg); o.z = pk2(bflo(p1.x) * eg, bfhi(p1.x) * eg); o.w = pk2(bflo(p1.y) * eg, bfhi(p1.y) * eg);
                *(v4u*)(gops + 16384 + q * 16) = o; }
            for (int q = rt; q < 512; q += 448) { const int blk = q >> 6, l2 = q & 63, i = l2 & 15, f = l2 >> 4, mb = blk >> 1, ks2 = blk & 1, t = 16 * mb + i;
                v2u p0 = (v2u){0u, 0u}, p1 = (v2u){0u, 0u};
                if (2 * ks2 <= mb) p0 = *(const LAS v2u*)(ATs + t * 72 + 32 * ks2 + 4 * f);
                if (2 * ks2 + 1 <= mb) p1 = *(const LAS v2u*)(ATs + t * 72 + 32 * ks2 + 16 + 4 * f);
                *(v4u*)(gops + 32768 + q * 16) = (v4u){p0.x, p0.y, p1.x, p1.y}; }
            for (int q = rt; q < 1024; q += 448) { const int blk = q >> 6, l2 = q & 63, i = l2 & 15, f = l2 >> 4, dkb = blk >> 1, ks2 = blk & 1, dk = 16 * dkb + i; float v[8];
#pragma unroll
                for (int e2 = 0; e2 < 8; ++e2) { const int c = 32 * ks2 + 16 * (e2 >> 2) + 4 * f + (e2 & 3); v[e2] = Ks[c * 132 + dk] * kes[c]; }
                *(v4u*)(gops + 40960 + q * 16) = (v4u){pk2(v[0], v[1]), pk2(v[2], v[3]), pk2(v[4], v[5]), pk2(v[6], v[7])}; }
        }
        __syncthreads();
#pragma unroll
        for (int ct = 0; ct < 2; ++ct) {
            const int C = 2 * wave + ct; const bool isv = C < 8; const int col = isv ? 16 * C + fr : 16 * (C - 8) + fr;
            f32x4 X[4];
#pragma unroll
            for (int I = 0; I < 4; ++I) {
                f32x4 acc;
#pragma unroll
                for (int e2 = 0; e2 < 4; ++e2) { const int t = 16 * I + 4 * fq + e2; acc[e2] = isv ? Vs[t * 132 + col] : egs[t] * Ks[t * 132 + col]; }
#pragma unroll
                for (int J = 0; J < 4; ++J) if (J < I) {
#pragma unroll
                    for (int kk = 0; kk < 4; ++kk) acc = __builtin_amdgcn_mfma_f32_16x16x4f32(LsT[(16 * J + 4 * fq + kk) * 68 + 16 * I + fr], X[J][kk], acc, 0, 0, 0); }
                f32x4 xi = (f32x4){0.f, 0.f, 0.f, 0.f};
#pragma unroll
                for (int kk = 0; kk < 4; ++kk) xi = __builtin_amdgcn_mfma_f32_16x16x4f32(Ti[(I * 16 + fr) * 20 + 4 * fq + kk], acc[kk], xi, 0, 0, 0);
                X[I] = xi;
                if (isv) { v2u w; w.x = pk2(xi[0], xi[1]); w.y = pk2(xi[2], xi[3]); *(v2u*)(UVF + (size_t)task * 16384 + (size_t)((C * 4 + I) * 64 + lane) * 8) = w; }
                else {
#pragma unroll
                    for (int e2 = 0; e2 < 4; ++e2) WKs[(16 * I + 4 * fq + e2) * 136 + col] = (bf16)(pk2(xi[e2], 0.f) & 0xffffu); }
            }
        }
        __syncthreads();
        for (int q = tid; q < 1024; q += NTHR) { const int blk = q >> 6, l2 = q & 63, i = l2 & 15, f = l2 >> 4, mb = blk >> 2, ks = blk & 3, t = 16 * mb + i;
            const v2u p0 = *(const LAS v2u*)(WKs + t * 136 + 32 * ks + 4 * f), p1 = *(const LAS v2u*)(WKs + t * 136 + 32 * ks + 16 + 4 * f);
            *(v4u*)(gops + q * 16) = (v4u){p0.x, p0.y, p1.x, p1.y}; }
        __syncthreads();
    }
}

__device__ __forceinline__ bf16x8 pack8(const f32x4 a, const f32x4 b) {
    v4u w; w.x = pk2(a[0], a[1]); w.y = pk2(a[2], a[3]); w.z = pk2(b[0], b[1]); w.w = pk2(b[2], b[3]); return __builtin_bit_cast(bf16x8, w);
}
__device__ __forceinline__ void gdn_scan(const Args& A, LAS unsigned char* lds, int bh, int tid, int lane, int wave) {
    const int b = bh >> 2, h = bh & 3, fr = lane & 15, fq = lane >> 4, vs = wave;
    const unsigned char* gops = (const unsigned char*)A.out + (size_t)bh * 32 * GOPS_CHUNK;
    const unsigned char* uvf = A.ws + WS_XN + (size_t)bh * 32 * 16384; const float* GE = (const float*)(A.ws + WS_GE) + bh * 32;
    float* Op = (float*)(A.ws + WS_OA) + ((size_t)b * SEQ + 4 * fq) * GW + h * 128 + 16 * vs + fr;
    f32x4 S[8];
#pragma unroll
    for (int i = 0; i < 8; ++i) S[i] = (f32x4){0.f, 0.f, 0.f, 0.f};
    const float gev = GE[lane & 31];
#define SCAN_DMA(chunk, bufoff) do { _Pragma("unroll") for (int i_ = 0; i_ < 9; ++i_) { const int p_ = wave + 8 * i_; \
        const unsigned char* s_ = (p_ < 56) ? (gops + (size_t)(chunk) * GOPS_CHUNK + p_ * 1024) : (uvf + (size_t)(chunk) * 16384 + (p_ - 56) * 1024); \
        __builtin_amdgcn_global_load_lds((const unsigned*)(s_ + lane * 16), (LAS unsigned*)(lds + (bufoff) + p_ * 1024), 16, 0, 0); } } while (0)
    SCAN_DMA(0, 0); SCAN_DMA(1, SCAN_BUF);
    asm volatile("s_waitcnt vmcnt(0)" ::: "memory"); __syncthreads();
#pragma unroll 1
    for (int n = 0; n < 32; ++n) {
        const LAS unsigned char* cur = lds + (n & 1) * SCAN_BUF;
        const float ge = __builtin_bit_cast(float, __builtin_amdgcn_readlane(__builtin_bit_cast(int, gev), n));
        bf16x8 Sb[4];
#pragma unroll
        for (int ks = 0; ks < 4; ++ks) Sb[ks] = pack8(S[2 * ks], S[2 * ks + 1]);
        f32x4 u[4];
#pragma unroll
        for (int mb = 0; mb < 4; ++mb) { f32x4 p = (f32x4){0.f, 0.f, 0.f, 0.f};
#pragma unroll
            for (int ks = 0; ks < 4; ++ks) p = __builtin_amdgcn_mfma_f32_16x16x32_bf16(*(const LAS bf16x8*)(cur + ((mb * 4 + ks) * 64 + lane) * 16), Sb[ks], p, 0, 0, 0);
            const v2u uw = *(const LAS v2u*)(cur + GOPS_CHUNK + ((vs * 4 + mb) * 64 + lane) * 8);
            u[mb] = (f32x4){bflo(uw.x) - p[0], bfhi(uw.x) - p[1], bflo(uw.y) - p[2], bfhi(uw.y) - p[3]}; }
        bf16x8 ub[2]; ub[0] = pack8(u[0], u[1]); ub[1] = pack8(u[2], u[3]);
        f32x4 o[4];
#pragma unroll
        for (int mb = 0; mb < 4; ++mb) { f32x4 acc = (f32x4){0.f, 0.f, 0.f, 0.f};
#pragma unroll
            for (int ks = 0; ks < 4; ++ks) acc = __builtin_amdgcn_mfma_f32_16x16x32_bf16(*(const LAS bf16x8*)(cur + 16384 + ((mb * 4 + ks) * 64 + lane) * 16), Sb[ks], acc, 0, 0, 0);
#pragma unroll
            for (int ks2 = 0; ks2 < 2; ++ks2) if (ks2 <= (mb >> 1)) acc = __builtin_amdgcn_mfma_f32_16x16x32_bf16(*(const LAS bf16x8*)(cur + 32768 + ((mb * 2 + ks2) * 64 + lane) * 16), ub[ks2], acc, 0, 0, 0);
            o[mb] = acc; }
#pragma unroll
        for (int dkb = 0; dkb < 8; ++dkb) { f32x4 acc = S[dkb] * ge;
#pragma unroll
            for (int ks2 = 0; ks2 < 2; ++ks2) acc = __builtin_amdgcn_mfma_f32_16x16x32_bf16(*(const LAS bf16x8*)(cur + 40960 + ((dkb * 2 + ks2) * 64 + lane) * 16), ub[ks2], acc, 0, 0, 0);
            S[dkb] = acc; }
        asm volatile("s_waitcnt vmcnt(0)" ::: "memory"); __syncthreads();
        if (n + 2 < 32) SCAN_DMA(n + 2, (n & 1) * SCAN_BUF);
        float* orow = Op + (size_t)(64 * n) * GW;
#pragma unroll
        for (int mb = 0; mb < 4; ++mb) { float* q = orow + (size_t)(16 * mb) * GW; q[0] = o[mb][0]; q[GW] = o[mb][1]; q[2 * GW] = o[mb][2]; q[3 * GW] = o[mb][3]; }
    }
    asm volatile("s_waitcnt vmcnt(0)" ::: "memory"); __syncthreads();
#undef SCAN_DMA
}


__device__ __forceinline__ float xmax_fq(float x) {
    auto a = __builtin_amdgcn_permlane16_swap(__float_as_uint(x), __float_as_uint(x), false, false); x = fmaxf(__uint_as_float(a[0]), __uint_as_float(a[1]));
    auto b = __builtin_amdgcn_permlane32_swap(__float_as_uint(x), __float_as_uint(x), false, false); return fmaxf(__uint_as_float(b[0]), __uint_as_float(b[1]));
}
__device__ __forceinline__ void attn_fast(const Args& A, LAS unsigned char* lds, int lane, int wave) {
    const bf16* PROJ = (const bf16*)(A.ws + WS_PROJ); bf16* CAT = (bf16*)(A.ws + WS_CAT);
    unsigned* ctr = (unsigned*)(A.ws + WS_CTL);
    LAS bf16* Vt = (LAS bf16*)(lds + wave * 8192);
    const int fr = lane & 15, fq = lane >> 4;
    const int kk = lane & 31, vch = lane >> 5;
    typedef short v4i16_t __attribute__((ext_vector_type(4)));
    LAS bf16* vtr_base = Vt + (4 * fq + ((lane >> 2) & 3)) * 72 + 4 * (lane & 3);
    constexpr float SC = 0.125f * 1.4426950408889634f;
    const int myx = (int)(__builtin_amdgcn_s_getreg((3 << 11) | 20) & 0x7u);
    int qi = 0;
    for (;;) {
        int wt = 256, xq = 0;
        while (qi < 8) { xq = (myx + qi) & 7; unsigned wt_ = 0; if (lane == 0) wt_ = atomicAdd(ctr + 16 * xq, 1u); wt = __builtin_amdgcn_readfirstlane(wt_); if (wt < 256) break; ++qi; }
        if (qi >= 8) break;
        const int T = 7 - (wt >> 5), b = (wt >> 2) & 7, h = xq, c0 = wt & 3, t0 = 256 * T;
        const bf16* Pb = PROJ + (size_t)b * SEQ * NP;
        const int tq0 = t0 + c0 + 16 * fr;
        bf16x8 qf0[2], qf1[2], qf2[2], qf3[2];
#pragma unroll
        for (int ks = 0; ks < 2; ++ks) { const bf16* qp = Pb + (size_t)tq0 * NP + PC_QB + h * 64 + 32 * ks + 8 * fq;
            qf0[ks] = *(const bf16x8*)qp; qf1[ks] = *(const bf16x8*)(qp + 4 * NP); qf2[ks] = *(const bf16x8*)(qp + 8 * NP); qf3[ks] = *(const bf16x8*)(qp + 12 * NP); }
        const int n2 = ((t0 + 240) >> 4) + 1, g2 = (n2 + 31) >> 5;
        const int lo1 = max(t0 + c0 - 512, c0), n1 = ((t0 + c0 + 12 + 240 - lo1) >> 2) + 1, g1 = (n1 + 31) >> 5;
        const int lo0 = max(t0 + c0 - 128, 0), n0 = (t0 + c0 + 12 + 240 - lo0) + 1, g0 = (n0 + 31) >> 5;
        const int NG = 4 * g2 + g1 + g0;
        f32x4 O0[4], O1[4], O2[4], O3[4];
#pragma unroll
        for (int i = 0; i < 4; ++i) { O0[i] = (f32x4){0.f, 0.f, 0.f, 0.f}; O1[i] = O0[i]; O2[i] = O0[i]; O3[i] = O0[i]; }
        float m0 = -INFINITY, l0 = 0.f, m1 = -INFINITY, l1 = 0.f, m2 = -INFINITY, l2 = 0.f, m3 = -INFINITY, l3 = 0.f;
        v4u kc[4], vc[4], kn[4], vn[4];
#define ATT_DEC(f, kst, str, mode) do { if ((f) < 4 * g2) { const int ci_ = (f) / g2; str = 16; kst = c0 + 4 * ci_ + 512 * ((f) - ci_ * g2); mode = 1 << ci_; } \
            else if ((f) < 4 * g2 + g1) { str = 4; kst = lo1 + 128 * ((f) - 4 * g2); mode = 15; } else { str = 1; kst = lo0 + 32 * ((f) - 4 * g2 - g1); mode = 15; } } while (0)
#define ATT_LOAD(kreg, vreg, kst, str) do { \
            _Pragma("unroll") for (int j = 0; j < 2; ++j) { const int tk = min((kst) + (str) * (16 * j + fr), SEQ - 1); \
                _Pragma("unroll") for (int ks = 0; ks < 2; ++ks) kreg[2 * j + ks] = *(const v4u*)(Pb + (size_t)tk * NP + PC_KB + h * 64 + 32 * ks + 8 * fq); } \
            { const int tk = min((kst) + (str) * kk, SEQ - 1); \
                _Pragma("unroll") for (int i = 0; i < 4; ++i) vreg[i] = *(const v4u*)(Pb + (size_t)tk * NP + PC_VB + h * 64 + 8 * (vch + 2 * i)); } } while (0)
#define ATT_CLS(O_, m_, l_, qf_, tq_) do { \
            f32x4 d0 = (f32x4){0.f, 0.f, 0.f, 0.f}, d1 = d0; \
            _Pragma("unroll") for (int ks = 0; ks < 2; ++ks) { d0 = __builtin_amdgcn_mfma_f32_16x16x32_bf16(__builtin_bit_cast(bf16x8, kc[ks]), qf_[ks], d0, 0, 0, 0); \
                                                             d1 = __builtin_amdgcn_mfma_f32_16x16x32_bf16(__builtin_bit_cast(bf16x8, kc[2 + ks]), qf_[ks], d1, 0, 0, 0); } \
            float s[8]; float mloc = -INFINITY; \
            const int dv = (((tq_) - kst) >> shl) - 4 * fq;        \
            _Pragma("unroll") for (int e2 = 0; e2 < 8; ++e2) { const float x = (e2 < 4 ? d0[e2 & 3] : d1[e2 & 3]) * SC; \
                s[e2] = ((unsigned)(dv - (16 * (e2 >> 2) + (e2 & 3))) <= 128u) ? x : -INFINITY; mloc = fmaxf(mloc, s[e2]); } \
            mloc = xmax_fq(mloc); \
            const float mnew = fmaxf(m_, mloc), alpha = __builtin_amdgcn_exp2f(m_ - mnew); m_ = mnew; \
            float psum = 0.f; \
            _Pragma("unroll") for (int e2 = 0; e2 < 8; ++e2) { s[e2] = __builtin_amdgcn_exp2f(s[e2] - mnew); psum += s[e2]; } \
            l_ = l_ * alpha + psum; \
            const bf16x8 pb = pack8((f32x4){s[0], s[1], s[2], s[3]}, (f32x4){s[4], s[5], s[6], s[7]}); \
            _Pragma("unroll") for (int db = 0; db < 4; ++db) O_[db] = __builtin_amdgcn_mfma_f32_16x16x32_bf16(va[db], pb, O_[db] * alpha, 0, 0, 0); } while (0)
        int kst, str, mode; ATT_DEC(0, kst, str, mode); ATT_LOAD(kc, vc, kst, str);
#pragma unroll 1
        for (int f = 0; f < NG; ++f) {
            int kstn = 0, strn = 1, moden = 0;
            if (f + 1 < NG) { ATT_DEC(f + 1, kstn, strn, moden); ATT_LOAD(kn, vn, kstn, strn); }
#pragma unroll
            for (int i = 0; i < 4; ++i) *(LAS v4u*)(Vt + kk * 72 + 8 * (vch + 2 * i)) = vc[i];
            bf16x8 va[4];
#pragma unroll
            for (int db = 0; db < 4; ++db) {
                const v4i16_t r0 = __builtin_amdgcn_ds_read_tr16_b64_v4i16((LAS v4i16_t*)(vtr_base + 16 * db)), r1 = __builtin_amdgcn_ds_read_tr16_b64_v4i16((LAS v4i16_t*)(vtr_base + 16 * 72 + 16 * db));
                va[db] = (bf16x8){r0[0], r0[1], r0[2], r0[3], r1[0], r1[1], r1[2], r1[3]}; }
            const int shl = (str == 16) ? 4 : (str == 4 ? 2 : 0);
            if (mode & 1) ATT_CLS(O0, m0, l0, qf0, tq0);
            if (mode & 2) ATT_CLS(O1, m1, l1, qf1, tq0 + 4);
            if (mode & 4) ATT_CLS(O2, m2, l2, qf2, tq0 + 8);
            if (mode & 8) ATT_CLS(O3, m3, l3, qf3, tq0 + 12);
#pragma unroll
            for (int i = 0; i < 4; ++i) { kc[i] = kn[i]; vc[i] = vn[i]; }
            kst = kstn; str = strn; mode = moden;
        }
#undef ATT_DEC
#undef ATT_LOAD
#undef ATT_CLS
        bf16* op = CAT + ((size_t)b * SEQ + tq0) * DM + GW + h * 64 + 4 * fq;
#define ATT_OUT(O_, l_, ci_) do { float lt = l_; lt += __shfl_xor(lt, 16); lt += __shfl_xor(lt, 32); const float inv = 1.0f / lt; \
            _Pragma("unroll") for (int db = 0; db < 4; ++db) { v2u w; w.x = pk2(O_[db][0] * inv, O_[db][1] * inv); w.y = pk2(O_[db][2] * inv, O_[db][3] * inv); *(v2u*)(op + (ci_) * 4 * DM + 16 * db) = w; } } while (0)
        ATT_OUT(O0, l0, 0); ATT_OUT(O1, l1, 1); ATT_OUT(O2, l2, 2); ATT_OUT(O3, l3, 3);
#undef ATT_OUT
    }
}

__device__ __forceinline__ void attn_simple(const Args& A, int tid, int lane, int wave) {
    const bf16* PROJ = (const bf16*)(A.ws + WS_PROJ); bf16* CAT = (bf16*)(A.ws + WS_CAT);
    unsigned* ctr = (unsigned*)(A.ws + WS_CTL);
    for (;;) {
        unsigned wt_ = 0; if (lane == 0) wt_ = atomicAdd(ctr, 1u); const int wt = __builtin_amdgcn_readfirstlane(wt_);
        if (wt >= (M / 64) * AH) break;
        const int h = wt % AH, tb = wt / AH, row = tb * 64 + lane, b = row / SEQ, t = row % SEQ;
        float q[64], acc[64];
        { const v4u* qp = (const v4u*)(PROJ + (size_t)row * NP + PC_QB + h * 64);
#pragma unroll
          for (int j = 0; j < 8; ++j) { const v4u w = qp[j]; q[8 * j + 0] = bflo(w.x) * 0.125f; q[8 * j + 1] = bfhi(w.x) * 0.125f; q[8 * j + 2] = bflo(w.y) * 0.125f; q[8 * j + 3] = bfhi(w.y) * 0.125f;
              q[8 * j + 4] = bflo(w.z) * 0.125f; q[8 * j + 5] = bfhi(w.z) * 0.125f; q[8 * j + 6] = bflo(w.w) * 0.125f; q[8 * j + 7] = bfhi(w.w) * 0.125f; } }
#pragma unroll
        for (int j = 0; j < 64; ++j) acc[j] = 0.f;
        float mx = -1e30f, l = 0.f;
        for (int br = 0; br < 3; ++br) {
            const int stride = br == 0 ? 1 : (br == 1 ? 4 : 16);
            for (int i = 0; i <= 128; ++i) {
                const int tk = t - i * stride; if (tk < 0) break;
                const size_t krow = (size_t)(b * SEQ + tk) * NP;
                const v4u* kp = (const v4u*)(PROJ + krow + PC_KB + h * 64); const v4u* vp = (const v4u*)(PROJ + krow + PC_VB + h * 64);
                float s = 0.f;
#pragma unroll
                for (int j = 0; j < 8; ++j) { const v4u w = kp[j]; s += q[8 * j + 0] * bflo(w.x) + q[8 * j + 1] * bfhi(w.x) + q[8 * j + 2] * bflo(w.y) + q[8 * j + 3] * bfhi(w.y)
                                                                       + q[8 * j + 4] * bflo(w.z) + q[8 * j + 5] * bfhi(w.z) + q[8 * j + 6] * bflo(w.w) + q[8 * j + 7] * bfhi(w.w); }
                const float mn = fmaxf(mx, s), sc = __expf(mx - mn), p = __expf(s - mn); mx = mn; l = l * sc + p;
#pragma unroll
                for (int j = 0; j < 8; ++j) { const v4u w = vp[j];
                    acc[8 * j + 0] = acc[8 * j + 0] * sc + p * bflo(w.x); acc[8 * j + 1] = acc[8 * j + 1] * sc + p * bfhi(w.x); acc[8 * j + 2] = acc[8 * j + 2] * sc + p * bflo(w.y); acc[8 * j + 3] = acc[8 * j + 3] * sc + p * bfhi(w.y);
                    acc[8 * j + 4] = acc[8 * j + 4] * sc + p * bflo(w.z); acc[8 * j + 5] = acc[8 * j + 5] * sc + p * bfhi(w.z); acc[8 * j + 6] = acc[8 * j + 6] * sc + p * bflo(w.w); acc[8 * j + 7] = acc[8 * j + 7] * sc + p * bfhi(w.w); }
            }
        }
        const float inv = 1.0f / l; v4u* op = (v4u*)(CAT + (size_t)row * DM + GW + h * 64);
#pragma unroll
        for (int j = 0; j < 8; ++j) { v4u w; w.x = pk2(acc[8 * j] * inv, acc[8 * j + 1] * inv); w.y = pk2(acc[8 * j + 2] * inv, acc[8 * j + 3] * inv); w.z = pk2(acc[8 * j + 4] * inv, acc[8 * j + 5] * inv); w.w = pk2(acc[8 * j + 6] * inv, acc[8 * j + 7] * inv); op[j] = w; }
    }
}
__device__ __forceinline__ void gated_norm(const Args& A, int lane, int wave) {
    const bf16* PROJ = (const bf16*)(A.ws + WS_PROJ); bf16* CAT = (bf16*)(A.ws + WS_CAT); const float* OA = (const float*)(A.ws + WS_OA); const float* gw = A.in[6];
    const float w0 = gw[2 * lane], w1 = gw[2 * lane + 1];
    const int gwv = blockIdx.x * NWAVES + wave, NGW = gridDim.x * NWAVES;
    for (int wt0 = gwv; wt0 < M * GH; wt0 += 8 * NGW) {
        float2 o[8]; unsigned zz[8];
#pragma unroll
        for (int i = 0; i < 8; ++i) { const int wt = min(wt0 + i * NGW, M * GH - 1), row = wt / GH, h = wt % GH;
            o[i] = *(const float2*)(OA + (size_t)row * GW + h * 128 + 2 * lane); zz[i] = *(const unsigned*)(PROJ + (size_t)row * NP + PC_Z + h * 128 + 2 * lane); }
#pragma unroll
        for (int i = 0; i < 8; ++i) { const int wt = wt0 + i * NGW; if (wt >= M * GH) break; const int row = wt / GH, h = wt % GH;
            const float ms = wave_sum(o[i].x * o[i].x + o[i].y * o[i].y) * (1.0f / 128.0f), r = rsqrtf(ms + RMS_EPS);
            *(unsigned*)(CAT + (size_t)row * DM + h * 128 + 2 * lane) = pk2(o[i].x * r * w0 * silu_f(bflo(zz[i])), o[i].y * r * w1 * silu_f(bfhi(zz[i]))); }
    }
}

__device__ __forceinline__ void gated_norm_bh(const Args& A, int bh, int lane, int wave) {
    const int b = bh >> 2, h = bh & 3;
    const bf16* Zp = (const bf16*)(A.ws + WS_PROJ) + (size_t)b * SEQ * NP + PC_Z + h * 128 + 2 * lane; bf16* Cp = (bf16*)(A.ws + WS_CAT) + (size_t)b * SEQ * DM + h * 128 + 2 * lane;
    const float* Op = (const float*)(A.ws + WS_OA) + (size_t)b * SEQ * GW + h * 128 + 2 * lane; const float* gw = A.in[6];
    const float w0 = gw[2 * lane], w1 = gw[2 * lane + 1];
    __builtin_amdgcn_fence(__ATOMIC_ACQUIRE, "agent");
#pragma unroll 1
    for (int r0 = wave * 16; r0 < SEQ; r0 += NWAVES * 16) {
        float2 o[16]; unsigned zz[16];
#pragma unroll
        for (int i = 0; i < 16; ++i) { o[i] = *(const float2*)(Op + (size_t)(r0 + i) * GW); zz[i] = *(const unsigned*)(Zp + (size_t)(r0 + i) * NP); }
#pragma unroll
        for (int i = 0; i < 16; ++i) { const float ms = wave_sum(o[i].x * o[i].x + o[i].y * o[i].y) * (1.0f / 128.0f), r = rsqrtf(ms + RMS_EPS);
            *(unsigned*)(Cp + (size_t)(r0 + i) * DM) = pk2(o[i].x * r * w0 * silu_f(bflo(zz[i])), o[i].y * r * w1 * silu_f(bfhi(zz[i]))); }
    }
}
__device__ __forceinline__ void ffn_conv_half(const Args& A, int half, int tid) {
    const bf16* Y = (const bf16*)(A.ws + WS_Y); bf16* ACT = (bf16*)(A.ws + WS_ACT); const float* fw = A.in[10];
    constexpr int HC = DFF / 2;
    for (size_t it = (size_t)blockIdx.x * NTHR + tid; it < (size_t)M * (HC / 8); it += (size_t)gridDim.x * NTHR) {
        const int row = (int)(it / (HC / 8)), g8 = (int)(it % (HC / 8)), cl = g8 * 8, pn = cl >> 7, j = cl & 127, t = row % SEQ, ch = half * HC + cl;
        float ga[8], ua[8];
#pragma unroll
        for (int e = 0; e < 8; ++e) { ga[e] = 0.f; ua[e] = 0.f; }
#pragma unroll
        for (int i = 0; i < 3; ++i) { const int ts = t - 2 + i; if (ts < 0) continue;
            const bf16* yr = Y + (size_t)(row - 2 + i) * DFF + 256 * pn + j; const v4u g = *(const v4u*)yr, u = *(const v4u*)(yr + 128);
            const f32x4 wg0 = *(const f32x4*)(fw + i * NUP + ch), wg1 = *(const f32x4*)(fw + i * NUP + ch + 4), wu0 = *(const f32x4*)(fw + i * NUP + DFF + ch), wu1 = *(const f32x4*)(fw + i * NUP + DFF + ch + 4);
            ga[0] += wg0.x * bflo(g.x); ga[1] += wg0.y * bfhi(g.x); ga[2] += wg0.z * bflo(g.y); ga[3] += wg0.w * bfhi(g.y); ga[4] += wg1.x * bflo(g.z); ga[5] += wg1.y * bfhi(g.z); ga[6] += wg1.z * bflo(g.w); ga[7] += wg1.w * bfhi(g.w);
            ua[0] += wu0.x * bflo(u.x); ua[1] += wu0.y * bfhi(u.x); ua[2] += wu0.z * bflo(u.y); ua[3] += wu0.w * bfhi(u.y); ua[4] += wu1.x * bflo(u.z); ua[5] += wu1.y * bfhi(u.z); ua[6] += wu1.z * bflo(u.w); ua[7] += wu1.w * bfhi(u.w); }
        v4u o; o.x = pk2(silu_f(ga[0]) * ua[0], silu_f(ga[1]) * ua[1]); o.y = pk2(silu_f(ga[2]) * ua[2], silu_f(ga[3]) * ua[3]); o.z = pk2(silu_f(ga[4]) * ua[4], silu_f(ga[5]) * ua[5]); o.w = pk2(silu_f(ga[6]) * ua[6], silu_f(ga[7]) * ua[7]);
        *(v4u*)(ACT + (size_t)row * DFF + ch) = o;
    }
}

__device__ __forceinline__ void ffn_fixup(const Args& A, int tid) {
    const float* YH = (const float*)(A.ws + WS_YH); const float* UP = (const float*)(A.ws + WS_UPART); bf16* ACT = (bf16*)(A.ws + WS_ACT); const float* fw = A.in[10];
    for (int it = blockIdx.x * NTHR + tid; it < 64 * 22 * 2 * 128; it += gridDim.x * NTHR) {
        const int c = it & 127, r = (it >> 7) & 1, tile = it >> 8, pm = tile / 22, pn = tile % 22; if ((pm & 7) == 0) continue;
        const int ch = pn * 128 + c; const float* up = UP + ((size_t)tile * 2 + r) * 256; const float* yh = YH + (size_t)((pm - 1) * 22 + pn) * 2 * 256;
        float g = up[c], u = up[128 + c];
        const float wg0 = fw[ch], wg1 = fw[5632 + ch], wu0 = fw[2816 + ch], wu1 = fw[5632 + 2816 + ch];
        if (r == 0) { g += wg0 * yh[c] + wg1 * yh[256 + c]; u += wu0 * yh[128 + c] + wu1 * yh[256 + 128 + c]; }
        else { g += wg0 * yh[256 + c]; u += wu0 * yh[256 + 128 + c]; }
        ACT[(size_t)(pm * 256 + r) * DFF + ch] = (bf16)(pk2(silu_f(g) * u, 0.f) & 0xffffu);
    }
}
__device__ __forceinline__ void final_norm(const Args& A, int lane, int wave) {
    float* out = A.out; const f32x4* nr = (const f32x4*)A.in[12] + lane;
    const int gw = blockIdx.x * NWAVES + wave, NGW = gridDim.x * NWAVES;
    f32x4 nw[4];
#pragma unroll
    for (int j = 0; j < 4; ++j) nw[j] = nr[64 * j];
    for (int m0 = gw; m0 < M; m0 += 4 * NGW) {
        f32x4 v[4][4];
#pragma unroll
        for (int rr = 0; rr < 4; ++rr) { const int m = min(m0 + rr * NGW, M - 1); const f32x4* xr = (const f32x4*)(out + (size_t)m * DM) + lane;
#pragma unroll
            for (int j = 0; j < 4; ++j) v[rr][j] = xr[64 * j]; }
#pragma unroll
        for (int rr = 0; rr < 4; ++rr) { const int m = m0 + rr * NGW; if (m >= M) break; float s = 0.f;
#pragma unroll
            for (int j = 0; j < 4; ++j) s += (v[rr][j].x * v[rr][j].x + v[rr][j].y * v[rr][j].y) + (v[rr][j].z * v[rr][j].z + v[rr][j].w * v[rr][j].w);
            const float rstd = rsqrtf(wave_sum(s) * (1.f / DM) + RMS_EPS); f32x4* xw = (f32x4*)(out + (size_t)m * DM) + lane;
#pragma unroll
            for (int j = 0; j < 4; ++j) xw[64 * j] = (f32x4){v[rr][j].x * rstd * nw[j].x, v[rr][j].y * rstd * nw[j].y, v[rr][j].z * rstd * nw[j].z, v[rr][j].w * rstd * nw[j].w}; }
    }
}

#define XB_TMO      128
#define XB_XCNT(j)  (256  + 64 * (j))
#define XB_XSUB(j)  (1280 + 64 * (j))
#define XB_XGEN(j)  (2304 + 64 * (j))
#define XB_TOP      3328
#define XB_TOPGEN   3392
#define XCD_BAR_WORDS 3456
#define XB_SPIN_CAP (1u << 18)

__device__ __forceinline__ unsigned xb_ld(unsigned* p)              { return __hip_atomic_load(p, __ATOMIC_RELAXED, __HIP_MEMORY_SCOPE_AGENT); }
__device__ __forceinline__ unsigned xb_add(unsigned* p, unsigned v) { return __hip_atomic_fetch_add(p, v, __ATOMIC_RELAXED, __HIP_MEMORY_SCOPE_AGENT); }
__device__ __forceinline__ unsigned xb_xcc_id() { return (unsigned)__builtin_amdgcn_s_getreg((3 << 11) | 20) & 0xFu; }
#define XB_SPIN(cond, bar) do { unsigned _sp = 0; while (cond) { __builtin_amdgcn_s_sleep(1); \
    if ((++_sp & 255u) == 0u) { if (xb_ld(&(bar)[XB_TMO])) break; if (_sp > XB_SPIN_CAP) { atomicAdd(&(bar)[XB_TMO], 1u); break; } } } } while (0)

struct XcdBarrier {
    unsigned* bar; unsigned x;
    volatile LAS unsigned* st;
};

__device__ __forceinline__ XcdBarrier xcd_barrier_post(unsigned* bar, volatile LAS unsigned* st) {
    XcdBarrier b; b.bar = bar; b.x = xb_xcc_id(); b.st = st;
    if (threadIdx.x == 0) (void)xb_add(&bar[XB_XCNT(b.x)], 1u);
    return b;
}
__device__ __forceinline__ void xcd_barrier_complete(unsigned* bar, unsigned x, unsigned& nloc, unsigned& nx) {
    const unsigned G = gridDim.x * gridDim.y * gridDim.z;
    unsigned sum, cnt, mine, sp = 0u;
    for (;;) {
        sum = 0u; cnt = 0u; mine = 0u;
#pragma unroll
        for (unsigned j = 0; j < 16; ++j) { const unsigned c = xb_ld(&bar[XB_XCNT(j)]); sum += c; cnt += (c > 0u) ? 1u : 0u; mine = (j == x) ? c : mine; }
        if (sum == G) break;
        __builtin_amdgcn_s_sleep(1);
        if ((++sp & 255u) == 0u) { if (xb_ld(&bar[XB_TMO])) break; if (sp > XB_SPIN_CAP) { atomicAdd(&bar[XB_TMO], 1u); break; } }
    }
    nloc = mine > 0u ? mine : 1u; nx = cnt > 0u ? cnt : 1u;
}

__device__ __forceinline__ void xcd_barrier(const XcdBarrier& b) {
    asm volatile("s_waitcnt vmcnt(0)" ::: "memory");
    __syncthreads();
    if (threadIdx.x == 0) {
        unsigned* bar = b.bar;
        __builtin_amdgcn_s_waitcnt(0);
        unsigned nloc = b.st[0], nx = b.st[1];
        if (nloc == 0u) { xcd_barrier_complete(bar, b.x, nloc, nx); b.st[0] = nloc; b.st[1] = nx; }
        const unsigned old = xb_add(&bar[XB_XSUB(b.x)], 1u);
        const unsigned gen = old / nloc;
        if (old + 1u == (gen + 1u) * nloc) {
            __builtin_amdgcn_fence(__ATOMIC_RELEASE, "agent");
            asm volatile("s_waitcnt vmcnt(0)" ::: "memory");
            const unsigned og = xb_add(&bar[XB_TOP], 1u);
            const unsigned tg = og / nx;
            if (og + 1u == (tg + 1u) * nx) xb_add(&bar[XB_TOPGEN], 1u);
            else XB_SPIN(xb_ld(&bar[XB_TOPGEN]) == tg, bar);
            __builtin_amdgcn_fence(__ATOMIC_ACQUIRE, "agent");
            xb_add(&bar[XB_XGEN(b.x)], 1u);
            asm volatile("s_waitcnt vmcnt(0)" ::: "memory");
        } else {
            XB_SPIN(xb_ld(&bar[XB_XGEN(b.x)]) == gen, bar);
            __builtin_amdgcn_fence(__ATOMIC_ACQUIRE, "agent");
            asm volatile("s_waitcnt vmcnt(0)" ::: "memory");
        }
    }
    __syncthreads();
}

constexpr int N_PHASES = 8;
__global__ void __launch_bounds__(NTHR, 2) mk_fwd(Args args) {
    extern __shared__ __attribute__((aligned(16))) unsigned char lds_raw[];
    LAS unsigned char* lds = (LAS unsigned char*)lds_raw;
    const int tid = threadIdx.x, lane = tid & 63, wave = __builtin_amdgcn_readfirstlane(tid >> 6);
    const int lo = args.ph_lo, hi = args.ph_hi;
    unsigned char* ws = args.ws;
    bf16* WIN = (bf16*)(ws + WS_WIN); bf16* WOUT = (bf16*)(ws + WS_WOUT); bf16* WUP = (bf16*)(ws + WS_WUP); bf16* WDN = (bf16*)(ws + WS_WDN);
    bf16* XN = (bf16*)(ws + WS_XN); bf16* PROJ = (bf16*)(ws + WS_PROJ); bf16* CAT = (bf16*)(ws + WS_CAT); bf16* Y = (bf16*)(ws + WS_Y); bf16* ACT = (bf16*)(ws + WS_ACT);
    float* SSQ = (float*)(ws + WS_SSQ);
#define IN(k) (lo <= (k) && (k) < hi)
#define SEAM(k) do { if (IN(k) && IN((k) + 1)) { xcd_barrier(bar); } } while (0)
    { volatile LAS unsigned* st = (volatile LAS unsigned*)(lds + LDS_BYTES - 64); if (tid < 2) st[tid] = 0u; }
    __syncthreads();
    XcdBarrier bar = xcd_barrier_post((unsigned*)(ws + WS_CTL) + 4096, (volatile LAS unsigned*)(lds + LDS_BYTES - 64));
    if (args.coop > 1) cg::this_grid().sync();
    if (IN(0)) { p0_prologue(args, lds, tid, lane, wave); } SEAM(0);
    if (IN(1)) { pg8::Gemm g{XN, WIN, M, NP, DM}; pg8::StaticOrder S; S.init(M, NP, gridDim.x, blockIdx.x); pg8::EpiBf16S E{PROJ, NP, nullptr};
        pg8::gemm_phase<pg8::EpiBf16S, pg8::StaticOrder, PG8_ALIGN, PG8_SP2>(lds, g, S, E);
        { pg8::Unit u4; const bool idle4 = !S.next(3, u4); const int G = gridDim.x, nidle = (G == 256) ? 128 : G;
          if (G != 256) convert_late_weights(args, lds, lane, wave, blockIdx.x * NWAVES + wave, G * NWAVES);
          else if (idle4) convert_late_weights(args, lds, lane, wave, (blockIdx.x - 128) * NWAVES + wave, nidle * NWAVES); } } SEAM(1);
    if (IN(2)) { gdn_prep(args, lds, tid, lane, wave); } SEAM(2);
    if (IN(3)) { if (blockIdx.x < NB * GH) gdn_scan(args, lds, blockIdx.x, tid, lane, wave); attn_fast(args, lds, lane, wave); xcd_barrier(bar); gated_norm(args, lane, wave); } SEAM(3);
    if (IN(4)) { pg8::Gemm g{CAT, WOUT, M, DM, DM}; pg8::StaticOrder S; S.init(M, DM, gridDim.x, blockIdx.x); pg8::EpiResid E{args.in[0], (gridDim.x == 256) ? nullptr : args.out, XN, SSQ, DM};
        pg8::gemm_phase<pg8::EpiResid, pg8::StaticOrder, PG8_ALIGN, PG8_SP2>(lds, g, S, E); } SEAM(4);
    if (IN(5)) { pg8::Gemm g{XN, WUP, M, NUP, DM}; pg8::StaticOrder S; S.init(M, NUP, gridDim.x, blockIdx.x);
        static_assert(pg8::EpiConvGate::CG_SSQ == WS_SSQ && pg8::EpiConvGate::CG_ACT == WS_ACT && pg8::EpiConvGate::CG_YH == WS_YH && pg8::EpiConvGate::CG_UPART == WS_UPART, "d_ws map");
        pg8::EpiConvGate E{ws, args.in[10], lds};
        pg8::gemm_phase<pg8::EpiConvGate, pg8::StaticOrder, true, PG8_SP2>(lds, g, S, E); } SEAM(5);
    if (IN(6)) { ffn_fixup(args, tid); } SEAM(6);
    if (IN(7)) { pg8::Gemm g{ACT, WDN, M, DM, DFF}; pg8::StaticOrder S; S.init(M, DM, gridDim.x, blockIdx.x);
        if (gridDim.x == 256) {
            pg8::EpiResidNorm E{XN, args.out, (float*)(ws + WS_SSQ2), (unsigned*)(ws + WS_CTL) + 2048, args.in[12], DM};
            pg8::gemm_phase<pg8::EpiResidNorm, pg8::StaticOrder, true, PG8_SP2>(lds, g, S, E);
        } else {
            pg8::EpiResid E{args.out, args.out, nullptr, nullptr, DM};
            pg8::gemm_phase<pg8::EpiResid, pg8::StaticOrder, PG8_ALIGN, PG8_SP2>(lds, g, S, E);
            xcd_barrier(bar); final_norm(args, lane, wave);
        } }
#undef IN
#undef SEAM
}

#ifndef MK_ONE_LAUNCH
#define MK_ONE_LAUNCH 1
#endif
extern "C" void kernel_launch(void* const* d_in, const int* in_sizes, int n_in, void* d_out, int out_size, void* d_ws, size_t ws_size, hipStream_t stream) {
    static int grid = 0;
    if (grid == 0) {
        if (n_in != 13 || out_size != M * DM || ws_size < WS_END) { fprintf(stderr, "kernel_launch: unexpected shapes n_in %d out %d ws %zu\n", n_in, out_size, ws_size); grid = -1; return; }
        int dev = 0, cus = 0, per_cu = 0;
        hipGetDevice(&dev); hipDeviceGetAttribute(&cus, hipDeviceAttributeMultiprocessorCount, dev);
        hipFuncSetAttribute((const void*)mk_fwd, hipFuncAttributeMaxDynamicSharedMemorySize, LDS_BYTES);
        hipOccupancyMaxActiveBlocksPerMultiprocessor(&per_cu, (const void*)mk_fwd, NTHR, LDS_BYTES);
        (void)hipGetLastError();
        if (per_cu < 1) { fprintf(stderr, "kernel_launch: occupancy query says %d blocks per CU\n", per_cu); per_cu = 1; }
        grid = cus;
    }
    if (grid < 0) return;
    if (hipMemsetAsync((char*)d_ws + WS_CTL, 0, 65536, stream) != hipSuccess) { fprintf(stderr, "kernel_launch: memset failed\n"); return; }
    Args a{};
    for (int i = 0; i < 13; ++i) a.in[i] = (const float*)d_in[i];
    a.out = (float*)d_out; a.ws = (unsigned char*)d_ws;
#if MK_ONE_LAUNCH
    a.ph_lo = 0; a.ph_hi = N_PHASES; a.coop = 1;
    void* kargs[] = {&a};
    hipError_t e = hipLaunchCooperativeKernel((const void*)mk_fwd, dim3(grid), dim3(NTHR), kargs, LDS_BYTES, stream);
    if (e != hipSuccess) fprintf(stderr, "cooperative launch failed: %s (grid %d)\n", hipGetErrorString(e), grid);
#else
    for (int p = 0; p < N_PHASES; ++p) { a.ph_lo = p; a.ph_hi = p + 1; a.coop = 0; hipLaunchKernelGGL(mk_fwd, dim3(grid), dim3(NTHR), LDS_BYTES, stream, a); }
#endif
}
```
